# Optimizing an MI355X kernel written in HIP

```python
import math
import jax, jax.numpy as jnp
from jax import lax
import numpy as np

D_MODEL = 1024
BATCH = 16
SEQ = 2048
DEPTH = 1

HEAD_DIM = 64
SB_HEADS = 8
SB_WIDTH = SB_HEADS * HEAD_DIM
RWKV_HEADS = 8
RWKV_WIDTH = RWKV_HEADS * HEAD_DIM
DECAY_RANK = 64
ICLR_RANK = 64
GATE_RANK = 128
RWKV_COLS = 3 * RWKV_WIDTH + DECAY_RANK + ICLR_RANK + GATE_RANK
IN_COLS = 3 * SB_WIDTH + RWKV_COLS + 2 * D_MODEL
PLE_DIM = 256
N_EXPERTS = 32
TOP_K = 4
EXPERT_HIDDEN = D_MODEL
SWIGLU_LIMIT = 7.0
SWIGLU_ALPHA = 1.702
Q_BLOCK = 128
MOE_BLOCK = 256
RMS_EPS = 1e-5
GN_EPS = 64e-5

kernel_name = "hybrid_stickbreak_rwkv7_moe_block"


def rmsnorm(x, g):
    xf = x.astype(jnp.float32)
    y = xf * lax.rsqrt(jnp.mean(xf * xf, axis=-1, keepdims=True) + RMS_EPS)
    return (y * g.astype(jnp.float32)).astype(x.dtype)


def stick_breaking_attention(q, k, v):
    S = q.shape[2]
    scale = HEAD_DIM ** -0.5
    outs = []
    for blk in range(S // Q_BLOCK):
        t0 = blk * Q_BLOCK
        kl = t0 + Q_BLOCK
        qb = q[:, :, t0:kl]
        kb = k[:, :, :kl]
        vb = v[:, :, :kl]
        z = jnp.einsum('bhqd,bhkd->bhqk', qb, kb).astype(jnp.float32) * scale
        t_idx = t0 + jnp.arange(Q_BLOCK)[:, None]
        s_idx = jnp.arange(kl)[None, :]
        mask = s_idx < t_idx
        log1m = jnp.where(mask, -jax.nn.softplus(z), 0.0)
        after = lax.cumsum(log1m, axis=3, reverse=True) - log1m
        log_a = jax.nn.log_sigmoid(z) + after
        att = jnp.where(mask, jnp.exp(log_a), 0.0)
        outs.append(jnp.einsum('bhqk,bhkd->bhqd', att.astype(vb.dtype), vb))
    return jnp.concatenate(outs, axis=2)


def rwkv7_scan(r, w, k, v, kk, a):
    B, S, H, N = r.shape

    def step(state, inp):
        r_t, w_t, k_t, v_t, kk_t, a_t = inp
        sa = jnp.einsum('bhij,bhj->bhi', state, -kk_t)
        state = (state * w_t[:, :, None, :]
                 + sa[..., None] * (kk_t * a_t)[:, :, None, :]
                 + v_t[..., None] * k_t[:, :, None, :])
        y = jnp.einsum('bhij,bhj->bhi', state, r_t)
        return state, y

    xs = tuple(jnp.moveaxis(t, 1, 0) for t in (r, w, k, v, kk, a))
    state0 = jnp.zeros((B, H, N, N), jnp.float32)
    _, ys = lax.scan(step, state0, xs)
    return jnp.moveaxis(ys, 0, 1)


def rwkv7_branch(zr, mu, w0, w_up, a0, a_up, g_up, k_k, k_a, r_k, lnx_w, lnx_b):
    B, S, _ = zr.shape
    prev = jnp.pad(zr, ((0, 0), (1, 0), (0, 0)))[:, :-1]
    zr = zr + mu * (prev - zr)
    c1, c2, c3 = RWKV_WIDTH, 2 * RWKV_WIDTH, 3 * RWKV_WIDTH
    c4, c5 = c3 + DECAY_RANK, c3 + DECAY_RANK + ICLR_RANK
    r, k, v = zr[..., :c1], zr[..., c1:c2], zr[..., c2:c3]
    xw, xa, xg = zr[..., c3:c4], zr[..., c4:c5], zr[..., c5:]
    w_log = -jax.nn.softplus(-(w0 + jnp.tanh(xw) @ w_up)) - 0.5
    decay = jnp.exp(-jnp.exp(w_log.astype(jnp.float32)))
    a = jax.nn.sigmoid(a0 + xa @ a_up)
    g = jax.nn.sigmoid(xg) @ g_up
    kk = k * k_k
    hs = lambda t: t.astype(jnp.float32).reshape(B, S, RWKV_HEADS, HEAD_DIM)
    r_h, k_h, v_h, kk_h, a_h, w_h = hs(r), hs(k), hs(v), hs(kk), hs(a), hs(decay)
    kk_h = kk_h / jnp.maximum(jnp.linalg.norm(kk_h, axis=-1, keepdims=True), 1e-12)
    k_h = k_h * (1.0 + (a_h - 1.0) * hs(k_a * jnp.ones_like(k)))
    y = rwkv7_scan(r_h, w_h, k_h, v_h, kk_h, a_h)
    mean = jnp.mean(y, axis=-1, keepdims=True)
    var = jnp.mean(jnp.square(y - mean), axis=-1, keepdims=True)
    y = (y - mean) * lax.rsqrt(var + GN_EPS)
    y = y.reshape(B, S, RWKV_WIDTH) * lnx_w + lnx_b
    bonus = jnp.sum(r_h * k_h * r_k.astype(jnp.float32), axis=-1, keepdims=True) * v_h
    y = y + bonus.reshape(B, S, RWKV_WIDTH)
    return (y * g).astype(zr.dtype)


def moe_ffn(h, router_w, router_b, w1, b1, w2, b2):
    Bsz, S, D = h.shape
    N = Bsz * S
    NK = N * TOP_K
    hf = h.reshape(N, D)
    logits = (hf @ router_w + router_b).astype(jnp.float32)
    top_val, top_idx = lax.top_k(logits, TOP_K)
    gate = jax.nn.softmax(top_val, axis=-1)
    flat_e = top_idx.reshape(-1).astype(jnp.int32)
    flat_tok = jnp.arange(NK, dtype=jnp.int32) // TOP_K
    flat_w = gate.reshape(-1)
    order = jnp.argsort(flat_e)
    sorted_e = flat_e[order]
    counts = jnp.zeros((N_EXPERTS,), jnp.int32).at[flat_e].add(1)
    offsets = jnp.cumsum(counts) - counts
    padded = (counts + MOE_BLOCK - 1) // MOE_BLOCK * MOE_BLOCK
    pad_end = jnp.cumsum(padded)
    pad_off = pad_end - padded
    rank = jnp.arange(NK, dtype=jnp.int32) - offsets[sorted_e]
    dest = pad_off[sorted_e] + rank
    n_blocks = -(-NK // MOE_BLOCK) + N_EXPERTS
    P = n_blocks * MOE_BLOCK
    buf_tok = jnp.zeros((P,), jnp.int32).at[dest].set(flat_tok[order])
    buf_w = jnp.zeros((P,), jnp.float32).at[dest].set(flat_w[order])
    block_start = jnp.arange(n_blocks, dtype=jnp.int32) * MOE_BLOCK
    block_e = jnp.minimum(jnp.searchsorted(pad_end, block_start, side='right'), N_EXPERTS - 1)

    def expert_block(args):
        e, tok = args
        xb = hf[tok]
        gu = xb @ w1[e] + b1[e]
        g_lin, u_lin = gu[:, ::2], gu[:, 1::2]
        g_lin = jnp.minimum(g_lin, SWIGLU_LIMIT)
        u_lin = jnp.clip(u_lin, -SWIGLU_LIMIT, SWIGLU_LIMIT)
        glu = g_lin * jax.nn.sigmoid(SWIGLU_ALPHA * g_lin)
        return ((u_lin + 1.0) * glu) @ w2[e] + b2[e]

    y = lax.map(expert_block, (block_e, buf_tok.reshape(n_blocks, MOE_BLOCK)))
    y = y.reshape(P, D) * buf_w[:, None].astype(y.dtype)
    out = jnp.zeros((N, D), h.dtype).at[buf_tok].add(y.astype(h.dtype))
    return out.reshape(Bsz, S, D)


def setup_inputs(seed: int = 0) -> dict:
    key = jax.random.key(seed)
    ks = jax.random.split(key, 32)
    L, D, E, F = DEPTH, D_MODEL, N_EXPERTS, EXPERT_HIDDEN
    nrm = lambda k, shape, s: jax.random.normal(k, shape, jnp.float32) * s
    return {
        "x": nrm(ks[0], (BATCH, SEQ, D), 1.0),
        "p": nrm(ks[1], (L, BATCH, SEQ, PLE_DIM), 1.0),
        "mix_norm_g": 1.0 + nrm(ks[2], (L, D), 0.02),
        "w_in": nrm(ks[3], (L, D, IN_COLS), D ** -0.5),
        "rwkv_mu": jax.random.uniform(ks[4], (L, RWKV_COLS), jnp.float32),
        "rwkv_w0": jax.random.uniform(ks[5], (L, RWKV_WIDTH), jnp.float32, -4.0, 1.0),
        "rwkv_w_up": nrm(ks[6], (L, DECAY_RANK, RWKV_WIDTH), 0.5 * DECAY_RANK ** -0.5),
        "rwkv_a0": nrm(ks[7], (L, RWKV_WIDTH), 0.1),
        "rwkv_a_up": nrm(ks[8], (L, ICLR_RANK, RWKV_WIDTH), ICLR_RANK ** -0.5),
        "rwkv_g_up": nrm(ks[9], (L, GATE_RANK, RWKV_WIDTH), GATE_RANK ** -0.5),
        "rwkv_k_k": 0.85 + nrm(ks[10], (L, RWKV_WIDTH), 0.05),
        "rwkv_k_a": 1.0 + nrm(ks[11], (L, RWKV_WIDTH), 0.05),
        "rwkv_r_k": nrm(ks[12], (L, RWKV_HEADS, HEAD_DIM), 0.1),
        "rwkv_lnx_w": 1.0 + nrm(ks[13], (L, RWKV_WIDTH), 0.02),
        "rwkv_lnx_b": nrm(ks[14], (L, RWKV_WIDTH), 0.01),
        "w_out_a": nrm(ks[15], (L, SB_WIDTH, D), SB_WIDTH ** -0.5),
        "w_out_b": nrm(ks[16], (L, RWKV_WIDTH, D), RWKV_WIDTH ** -0.5),
        "w_out": nrm(ks[17], (L, D, D), D ** -0.5),
        "ffn_norm_g": 1.0 + nrm(ks[18], (L, D), 0.02),
        "router_w": nrm(ks[19], (L, D, E), D ** -0.5),
        "router_b": nrm(ks[20], (L, E), 0.01),
        "exp_w1": nrm(ks[21], (L, E, D, 2 * F), D ** -0.5),
        "exp_b1": nrm(ks[22], (L, E, 2 * F), 0.01),
        "exp_w2": nrm(ks[23], (L, E, F, D), F ** -0.5),
        "exp_b2": nrm(ks[24], (L, E, D), 0.01),
        "ple_norm_g": 1.0 + nrm(ks[25], (L, D), 0.02),
        "ple_gate_w": nrm(ks[26], (L, D, D), D ** -0.5),
        "ple_proj_w": nrm(ks[27], (L, PLE_DIM, D), PLE_DIM ** -0.5),
        "final_norm_g": 1.0 + nrm(ks[28], (D,), 0.02),
    }


def reference(x, p, mix_norm_g, w_in, rwkv_mu, rwkv_w0, rwkv_w_up, rwkv_a0, rwkv_a_up,
              rwkv_g_up, rwkv_k_k, rwkv_k_a, rwkv_r_k, rwkv_lnx_w, rwkv_lnx_b,
              w_out_a, w_out_b, w_out, ffn_norm_g, router_w, router_b,
              exp_w1, exp_b1, exp_w2, exp_b2, ple_norm_g, ple_gate_w, ple_proj_w,
              final_norm_g):
    B, S, D = x.shape
    for i in range(DEPTH):
        h = rmsnorm(x, mix_norm_g[i])
        z = h @ w_in[i]
        c_sb = 3 * SB_WIDTH
        c_rw = c_sb + RWKV_COLS
        zq, zk, zv = (z[..., j * SB_WIDTH:(j + 1) * SB_WIDTH] for j in range(3))
        to_heads = lambda t: t.reshape(B, S, SB_HEADS, HEAD_DIM).transpose(0, 2, 1, 3)
        ya = stick_breaking_attention(to_heads(zq), to_heads(zk), to_heads(zv))
        ya = ya.transpose(0, 2, 1, 3).reshape(B, S, SB_WIDTH)
        yb = rwkv7_branch(z[..., c_sb:c_rw], rwkv_mu[i], rwkv_w0[i], rwkv_w_up[i], rwkv_a0[i],
                          rwkv_a_up[i], rwkv_g_up[i], rwkv_k_k[i], rwkv_k_a[i], rwkv_r_k[i],
                          rwkv_lnx_w[i], rwkv_lnx_b[i])
        gate_a = jax.nn.sigmoid(z[..., c_rw:c_rw + D])
        gate_b = jax.nn.sigmoid(z[..., c_rw + D:])
        merged = gate_a * (ya @ w_out_a[i]) + gate_b * (yb @ w_out_b[i])
        x = x + (merged @ w_out[i]).astype(x.dtype)
        x = x + moe_ffn(rmsnorm(x, ffn_norm_g[i]), router_w[i], router_b[i],
                        exp_w1[i], exp_b1[i], exp_w2[i], exp_b2[i])
        hp = rmsnorm(x, ple_norm_g[i])
        x = x + (jax.nn.sigmoid(hp @ ple_gate_w[i]) * (p[i] @ ple_proj_w[i])).astype(x.dtype)
    return rmsnorm(x, final_norm_g)
```

```cpp
#include <hip/hip_runtime.h>
#include <cstdio>
#include <cstdint>

#ifndef MK_PER_PHASE
#define MK_PER_PHASE 1
#endif

#define LAS __attribute__((address_space(3)))
#define GAS __attribute__((address_space(1)))
typedef unsigned short bf16;
typedef short bf16x8 __attribute__((ext_vector_type(8)));
typedef float f32x2 __attribute__((ext_vector_type(2)));
typedef float f32x4 __attribute__((ext_vector_type(4)));
typedef float f32x16 __attribute__((ext_vector_type(16)));
typedef unsigned u32x2 __attribute__((ext_vector_type(2)));
typedef unsigned u32x4 __attribute__((ext_vector_type(4)));
typedef __bf16 bf16x2_t __attribute__((ext_vector_type(2)));

constexpr int NB = 16, SEQ = 2048, D = 1024, M = NB * SEQ;
constexpr int NH = 8, HD = 64, AW = 512, RW = 512, RWC = 1792, INC = 5376;
constexpr int NE = 32, FH = 1024, F2 = 2048, PLE = 256, TOPK = 4;
constexpr int LORA_K = 256, LORA_N = 1536;
constexpr int CAP = 32768;
constexpr int MAXROWS = M * TOPK + NE * 256;
constexpr float RMS_EPS = 1e-5f, GN_EPS = 64e-5f;

constexpr size_t MiB = 1u << 20;
constexpr size_t WS_CTL = 0, CTL_ZERO_BYTES = 1 * MiB;
constexpr size_t WS_WIN = 1 * MiB;
constexpr size_t WS_WA = 12 * MiB, WS_WB = 13 * MiB, WS_WO = 14 * MiB, WS_WG = 16 * MiB, WS_WP = 18 * MiB;
constexpr size_t WS_WL = 18 * MiB + 512 * 1024;
constexpr size_t WS_GW = 19 * MiB + 256 * 1024;
constexpr size_t WS_W1 = 20 * MiB;
constexpr size_t WS_W2 = 148 * MiB;
constexpr size_t WS_PB = 212 * MiB;
constexpr size_t WS_RSTD0 = 228 * MiB, WS_RSTD2 = WS_RSTD0 + 128 * 1024, WS_ROWSS = WS_RSTD0 + 256 * 1024;
constexpr size_t WS_GATEW = WS_RSTD0 + 512 * 1024;
constexpr size_t WS_ROWSLOT = 229 * MiB;
constexpr size_t WS_LIST = 230 * MiB;
constexpr size_t WS_X1 = 236 * MiB;
constexpr size_t WS_YA = 236 * MiB, WS_YB = 268 * MiB, WS_ALORA = 300 * MiB;
constexpr size_t WS_GT = 364 * MiB;
constexpr size_t WS_Q = 492 * MiB, WS_K = 524 * MiB, WS_VT = 556 * MiB;
constexpr size_t WS_ZR = 588 * MiB;
constexpr size_t WS_XB = 700 * MiB;
constexpr size_t WS_DEC = 764 * MiB, WS_AA = 828 * MiB, WS_GG = 892 * MiB;
constexpr size_t WS_MERGED = 492 * MiB;
constexpr size_t WS_XS = 364 * MiB;
constexpr size_t WS_ACT = 636 * MiB;
constexpr size_t WS_HN = 636 * MiB;
constexpr size_t WS_YBUF = 364 * MiB;
constexpr size_t WS_X2B = 636 * MiB;
constexpr size_t WS_END = 924 * MiB;
constexpr int CW_CNT = 64;
constexpr int CW_BAR = 4096;

constexpr int RING_BYTES = 131072;
constexpr int LDSCTL_OFF = RING_BYTES;
constexpr int MOE_OFF = RING_BYTES + 1024;
constexpr int MOE_TE = RING_BYTES + 2048;
constexpr int LDS_BYTES = 147456;

#define RLX_AGENT __ATOMIC_RELAXED, __HIP_MEMORY_SCOPE_AGENT
__device__ __forceinline__ unsigned pk2(float lo, float hi) { f32x2 v = {lo, hi}; bf16x2_t b = __builtin_convertvector(v, bf16x2_t); return __builtin_bit_cast(unsigned, b); }
__device__ __forceinline__ float bflo(unsigned u) { return __uint_as_float(u << 16); }
__device__ __forceinline__ float bfhi(unsigned u) { return __uint_as_float(u & 0xffff0000u); }
__device__ __forceinline__ float sigm(float x) { return __builtin_amdgcn_rcpf(1.f + __expf(-x)); }
__device__ __forceinline__ float wave_sum(float v) {
#pragma unroll
    for (int o = 1; o < 64; o <<= 1) v += __shfl_xor(v, o);
    return v;
}
template <int CTRL> __device__ __forceinline__ float dppf(float v) { return __builtin_bit_cast(float, __builtin_amdgcn_update_dpp(0, __builtin_bit_cast(int, v), CTRL, 0xF, 0xF, true)); }
__device__ __forceinline__ float red8(float v) { v += dppf<0xB1>(v); v += dppf<0x4E>(v); v += dppf<0x141>(v); return v; }
__device__ __forceinline__ int lane_now() { int l; asm volatile("v_mbcnt_lo_u32_b32 %0, -1, 0\n\tv_mbcnt_hi_u32_b32 %0, -1, %0" : "=v"(l)); return l; }
__device__ __forceinline__ int crow(int r, int hi) { return (r & 3) + 8 * (r >> 2) + 4 * hi; }

namespace pg8 {
#define PG8_LAS __attribute__((address_space(3)))
typedef unsigned short bf16_t;
constexpr int BM = 256, BK = 64, HALF = 128, HTB = HALF * BK * 2, STAGE_BYTES = 8 * HTB, NXCD = 8, WGM = 8;
__host__ __device__ __forceinline__ int lds_byte(int r, int c) { const int st = (r >> 4) * 2 + (c >> 5), rr = r & 15, cc = c & 31, ob = rr * 64 + cc * 2; return st * 1024 + (ob ^ (((ob >> 9) & 1) << 5)); }
__host__ __device__ __forceinline__ void stage_rc(int b, int& R, int& C) { const int st = b / 1024, sb = b % 1024, swz = sb ^ (((sb >> 9) & 1) << 5); R = (st >> 1) * 16 + swz / 64; C = (st & 1) * 32 + (swz % 64) / 2; }
__host__ __device__ __forceinline__ int perm32(int rho) { const int n = rho >> 4, i = rho & 15; return 8 * (i >> 2) + 4 * n + (i & 3); }

struct Unit { int pm, pn, e; };
struct Gemm { const bf16_t* A; const bf16_t* Bt; int M, N, K; size_t bsel_bytes; };

struct StaticOrder {
    int nM, nN, nwg, G, c;
    __device__ void init(int M_, int N_, int G_, int c_) { nM = M_ / BM; nN = N_ / BM; nwg = nM * nN; G = G_; c = c_; }
    __device__ bool next(int i, Unit& u) const {
        const long L = (long)i * G + c; if (L >= nwg) return false;
        int wgid = (int)L; { const int q = nwg / NXCD, r = nwg % NXCD, xcd = wgid % NXCD, off = wgid / NXCD; wgid = (xcd < r ? xcd * (q + 1) : r * (q + 1) + (xcd - r) * q) + off; }
        const int nig = WGM * nN, gid = wgid / nig, fm = gid * WGM, gsz = (nM - fm) < WGM ? (nM - fm) : WGM;
        u.pm = fm + ((wgid % nig) % gsz); u.pn = (wgid % nig) / gsz; u.e = 0; return true;
    }
};
struct LoraOrder {
    int pm, half, nu;
    __device__ bool next(int i, Unit& u) const { if (i >= nu) return false; u.pm = pm; u.pn = 3 * half + i; u.e = 0; return true; }
};
struct MoeOrder {
    int ntiles, npn, G, c; const PG8_LAS unsigned char* te;
    __device__ bool next(int i, Unit& u) const {
        const long L = (long)i * G + c; if (L >= (long)ntiles * npn) return false;
        const int rt = (int)(L / npn); u.pm = rt; u.pn = (int)(L % npn); u.e = te[rt]; return true;
    }
};

template <class Epi, class Sched>
__device__ __forceinline__ void gemm_phase(PG8_LAS unsigned char* lds, const Gemm g, const Sched& S, const Epi& E, const int wid) {
    const int lane = lane_now(), tid = wid * 64 + lane,
              wr = wid >> 2, wc = wid & 3, fr = lane & 15, fq = lane >> 4;
    const int K = g.K, nt = K / BK;
    unsigned voffA[2], voffB[2];
#pragma unroll
    for (int i = 0; i < 2; ++i) { int R, C; stage_rc(tid * 16 + i * 8192, R, C); const int Rb = Epi::PERM ? ((R & ~31) + perm32(R & 31)) : R;
        voffA[i] = (unsigned)(R * K + C) * 2u; voffB[i] = (unsigned)(Rb * K + C) * 2u; }
    const size_t kstep = (size_t)(BK * 2);
    const size_t hstep = (size_t)HALF * K * 2;
    const size_t tstep = 2 * hstep;
    const unsigned ldsw = (unsigned)wid * 1024u;
    const int aoff = lds_byte(wr * 64 + fr, fq * 8), boff = lds_byte(wc * 32 + fr, fq * 8);
#define PG8_SA(b, h) (((b) * 2 + (h)) * HTB)
#define PG8_SB(b, h) ((4 + (b) * 2 + (h)) * HTB)
#define PG8_STAGE(bufoff, gbase, voff) do { _Pragma("unroll") for (int _i = 0; _i < 2; ++_i) \
        __builtin_amdgcn_global_load_lds((const unsigned*)((const char*)(gbase) + (voff)[_i]), (PG8_LAS unsigned*)(lds + (bufoff) + ldsw + _i * 8192), 16, 0, 0); } while (0)
#define PG8_LDA(dst, b, h) do { _Pragma("unroll") for (int m = 0; m < 4; ++m) _Pragma("unroll") for (int k = 0; k < 2; ++k) dst[m][k] = *(const PG8_LAS bf16x8*)(lds + PG8_SA(b, h) + aoff + m * 2048 + k * 1024); } while (0)
#define PG8_LDB(dst, b, h) do { _Pragma("unroll") for (int n = 0; n < 2; ++n) _Pragma("unroll") for (int k = 0; k < 2; ++k) dst[n][k] = *(const PG8_LAS bf16x8*)(lds + PG8_SB(b, h) + boff + n * 2048 + k * 1024); } while (0)
#define PG8_MMA(ai, bj, At, Bt) do { __builtin_amdgcn_s_setprio(1); _Pragma("unroll") for (int m = 0; m < 4; ++m) _Pragma("unroll") for (int n = 0; n < 2; ++n) _Pragma("unroll") for (int k = 0; k < 2; ++k) \
        acc[ai][bj][m][n] = __builtin_amdgcn_mfma_f32_16x16x32_bf16(Bt[n][k], At[m][k], acc[ai][bj][m][n], 0, 0, 0); __builtin_amdgcn_s_setprio(0); } while (0)
#define PG8_WAIT_V(n) asm volatile("s_waitcnt vmcnt(" #n ")" ::: "memory")
#define PG8_WAIT_L(n) asm volatile("s_waitcnt lgkmcnt(" #n ")" ::: "memory")
#define PG8_BAR __builtin_amdgcn_s_barrier()
#define PG8_SCHED __builtin_amdgcn_sched_barrier(0)
    Unit cur, nxt; int ui = 0;
    if (!S.next(0, cur)) return;
    f32x4 acc[2][2][4][2];
#pragma unroll
    for (int a = 0; a < 2; ++a)
#pragma unroll
        for (int b = 0; b < 2; ++b)
#pragma unroll
            for (int m = 0; m < 4; ++m)
#pragma unroll
                for (int n = 0; n < 2; ++n) acc[a][b][m][n] = (f32x4){0.f, 0.f, 0.f, 0.f};
    bf16x8 At[4][2], B0[2][2], B1[2][2];
    const char* cA = (const char*)g.A + (size_t)cur.pm * tstep; const char* cB = (const char*)g.Bt + (size_t)cur.e * g.bsel_bytes + (size_t)cur.pn * tstep;
    PG8_STAGE(PG8_SB(0, 0), cB, voffB); PG8_STAGE(PG8_SB(0, 1), cB + hstep, voffB); PG8_STAGE(PG8_SA(0, 0), cA, voffA); PG8_STAGE(PG8_SA(0, 1), cA + hstep, voffA);
    if (wr == 1) PG8_BAR;
    PG8_WAIT_V(2); PG8_BAR;
    PG8_STAGE(PG8_SB(1, 0), cB + kstep, voffB); PG8_STAGE(PG8_SA(1, 0), cA + kstep, voffA); PG8_STAGE(PG8_SB(1, 1), cB + hstep + kstep, voffB);
    PG8_WAIT_V(6); PG8_BAR;
    for (;;) {
        const bool has_next = S.next(ui + 1, nxt);
        const char* nA = has_next ? (const char*)g.A + (size_t)nxt.pm * tstep : cA;
        const char* nB = has_next ? (const char*)g.Bt + (size_t)nxt.e * g.bsel_bytes + (size_t)nxt.pn * tstep : cB;
        for (int t = 0; t < nt; t += 2) {
            const bool last = (t == nt - 2);
            const char* a1 = cA + (size_t)(t + 1) * kstep;
            const char* a2 = last ? nA : cA + (size_t)(t + 2) * kstep; const char* b2 = last ? nB : cB + (size_t)(t + 2) * kstep;
            const char* a3 = a2 + kstep; const char* b3 = b2 + kstep;
            PG8_LDB(B0, 0, 0); PG8_LDB(B1, 0, 1); PG8_SCHED; PG8_LDA(At, 0, 0); PG8_STAGE(PG8_SA(1, 1), a1 + hstep, voffA);
            PG8_WAIT_V(8); PG8_WAIT_L(0); PG8_BAR; PG8_MMA(0, 0, At, B0); PG8_MMA(0, 1, At, B1); PG8_BAR; PG8_SCHED;
            PG8_LDA(At, 0, 1); PG8_STAGE(PG8_SB(0, 0), b2, voffB); PG8_STAGE(PG8_SB(0, 1), b2 + hstep, voffB); PG8_STAGE(PG8_SA(0, 0), a2, voffA);
            PG8_WAIT_V(8); PG8_WAIT_L(0); PG8_BAR; PG8_MMA(1, 0, At, B0); PG8_MMA(1, 1, At, B1); PG8_BAR; PG8_SCHED;
            PG8_LDB(B0, 1, 0); PG8_LDB(B1, 1, 1); PG8_SCHED; PG8_LDA(At, 1, 0); PG8_STAGE(PG8_SA(0, 1), a2 + hstep, voffA);
            PG8_WAIT_V(8); PG8_WAIT_L(0); PG8_BAR; PG8_MMA(0, 0, At, B0); PG8_MMA(0, 1, At, B1); PG8_BAR; PG8_SCHED;
            PG8_LDA(At, 1, 1); PG8_STAGE(PG8_SB(1, 0), b3, voffB); PG8_STAGE(PG8_SB(1, 1), b3 + hstep, voffB); PG8_STAGE(PG8_SA(1, 0), a3, voffA);
            PG8_WAIT_V(8); PG8_WAIT_L(0); PG8_BAR; PG8_MMA(1, 0, At, B0); PG8_MMA(1, 1, At, B1); PG8_BAR; PG8_SCHED;
        }
        if (wr == 0) PG8_BAR;
        E(acc, cur, wr, wc, fr, fq);
        if (!has_next) break;
#pragma unroll
        for (int a = 0; a < 2; ++a)
#pragma unroll
            for (int b = 0; b < 2; ++b)
#pragma unroll
                for (int m = 0; m < 4; ++m)
#pragma unroll
                    for (int n = 0; n < 2; ++n) acc[a][b][m][n] = (f32x4){0.f, 0.f, 0.f, 0.f};
        cur = nxt; cA = nA; cB = nB; ++ui;
        if (wr == 1) PG8_BAR;
    }
    PG8_WAIT_V(0);
    PG8_BAR;
#undef PG8_SA
#undef PG8_SB
#undef PG8_STAGE
#undef PG8_LDA
#undef PG8_LDB
#undef PG8_MMA
#undef PG8_WAIT_V
#undef PG8_WAIT_L
#undef PG8_BAR
#undef PG8_SCHED
}
}
using pg8::Unit;
typedef const f32x4 (&AccRef)[2][2][4][2];

#define XB_TMO      128
#define XB_XCNT(j)  (256  + 64 * (j))
#define XB_XSUB(j)  (1280 + 64 * (j))
#define XB_XGEN(j)  (2304 + 64 * (j))
#define XB_TOP      3328
#define XB_TOPGEN   3392
#define XCD_BAR_WORDS 3456
#define XB_SPIN_CAP (1u << 22)
__device__ __forceinline__ unsigned xb_ld(unsigned* p)              { return __hip_atomic_load(p, __ATOMIC_RELAXED, __HIP_MEMORY_SCOPE_AGENT); }
__device__ __forceinline__ unsigned xb_add(unsigned* p, unsigned v) { return __hip_atomic_fetch_add(p, v, __ATOMIC_RELAXED, __HIP_MEMORY_SCOPE_AGENT); }
__device__ __forceinline__ unsigned xb_xcc_id() { return (unsigned)__builtin_amdgcn_s_getreg((3 << 11) | 20) & 0xFu; }
#define XB_SPIN(cond, bar) do { unsigned _sp = 0; while (cond) { __builtin_amdgcn_s_sleep(1); \
    if ((++_sp & 255u) == 0u) { if (xb_ld(&(bar)[XB_TMO])) break; if (_sp > XB_SPIN_CAP) { atomicAdd(&(bar)[XB_TMO], 1u); break; } } } } while (0)
struct XcdBarrier { unsigned* bar; unsigned x; volatile LAS unsigned* st; };
__device__ __forceinline__ XcdBarrier xcd_barrier_post(unsigned* bar, volatile LAS unsigned* st, int tid) {
    XcdBarrier b; b.bar = bar; b.x = xb_xcc_id(); b.st = st;
    if (tid == 0) (void)xb_add(&bar[XB_XCNT(b.x)], 1u);
    return b;
}
__device__ __forceinline__ void xcd_barrier_complete(unsigned* bar, unsigned x, unsigned& nloc, unsigned& nx) {
    const unsigned G = gridDim.x * gridDim.y * gridDim.z;
    unsigned sum, cnt, mine, sp = 0u;
    for (;;) {
        sum = 0u; cnt = 0u; mine = 0u;
#pragma unroll
        for (unsigned j = 0; j < 16; ++j) { const unsigned c = xb_ld(&bar[XB_XCNT(j)]); sum += c; cnt += (c > 0u) ? 1u : 0u; mine = (j == x) ? c : mine; }
        if (sum == G) break;
        __builtin_amdgcn_s_sleep(1);
        if ((++sp & 255u) == 0u) { if (xb_ld(&bar[XB_TMO])) break; if (sp > XB_SPIN_CAP) { atomicAdd(&bar[XB_TMO], 1u); break; } }
    }
    nloc = mine > 0u ? mine : 1u; nx = cnt > 0u ? cnt : 1u;
}
__device__ __forceinline__ void xcd_barrier(const XcdBarrier& b, int wave) {
    asm volatile("s_waitcnt vmcnt(0)" ::: "memory");
    __syncthreads();
    if (wave == 0 && lane_now() == 0) {
        unsigned* bar = b.bar;
        __builtin_amdgcn_s_waitcnt(0);
        unsigned nloc = b.st[0], nx = b.st[1];
        if (nloc == 0u) { xcd_barrier_complete(bar, b.x, nloc, nx); b.st[0] = nloc; b.st[1] = nx; }
        const unsigned old = xb_add(&bar[XB_XSUB(b.x)], 1u);
        const unsigned gen = old / nloc;
        if (old + 1u == (gen + 1u) * nloc) {
            __builtin_amdgcn_fence(__ATOMIC_RELEASE, "agent");
            asm volatile("s_waitcnt vmcnt(0)" ::: "memory");
            const unsigned og = xb_add(&bar[XB_TOP], 1u);
            const unsigned tg = og / nx;
            if (og + 1u == (tg + 1u) * nx) xb_add(&bar[XB_TOPGEN], 1u);
            else XB_SPIN(xb_ld(&bar[XB_TOPGEN]) == tg, bar);
            __builtin_amdgcn_fence(__ATOMIC_ACQUIRE, "agent");
            xb_add(&bar[XB_XGEN(b.x)], 1u);
            asm volatile("s_waitcnt vmcnt(0)" ::: "memory");
        } else {
            XB_SPIN(xb_ld(&bar[XB_XGEN(b.x)]) == gen, bar);
            __builtin_amdgcn_fence(__ATOMIC_ACQUIRE, "agent");
            asm volatile("s_waitcnt vmcnt(0)" ::: "memory");
        }
    }
    __syncthreads();
}

struct Frame {
    LAS unsigned char* lds;
    unsigned* ctl;
    int tid, lane, wave, vcu, G;
    unsigned char* ws;
    float* out;
};
#define WSP(T, off) ((T*)(F.ws + (off)))
struct Args { const float* in[29]; float* out; unsigned char* ws; int ph_lo, ph_hi; };
#define FIN(i) (args.in[i])

__device__ __forceinline__ void p0_transpose_item(const float* W, int K, int N, bf16* WT, LAS float* scr, int item, int lane, const float* kscale) {
    const int nblk = N / 32, kb = item / nblk, nb = item % nblk, k0 = 64 * kb, n0 = 32 * nb;
#pragma unroll 8
    for (int i = 0; i < 32; ++i) { const int kk = 2 * i + (lane >> 5); float v = W[(size_t)(k0 + kk) * N + n0 + (lane & 31)]; if (kscale) v *= kscale[k0 + kk]; scr[kk * 33 + (lane & 31)] = v; }
    asm volatile("s_waitcnt lgkmcnt(0)" ::: "memory");
    const int c = lane & 7;
#pragma unroll
    for (int j = 0; j < 4; ++j) { const int n = (lane >> 3) + 8 * j; const LAS float* s = scr + (8 * c) * 33 + n;
        u32x4 o; o.x = pk2(s[0 * 33], s[1 * 33]); o.y = pk2(s[2 * 33], s[3 * 33]); o.z = pk2(s[4 * 33], s[5 * 33]); o.w = pk2(s[6 * 33], s[7 * 33]);
        *(u32x4*)(WT + (size_t)(n0 + n) * K + k0 + 8 * c) = o; }
    asm volatile("s_waitcnt lgkmcnt(0)" ::: "memory");
}
__device__ __forceinline__ void p0_prologue(const Args& args, Frame& F) {
    LAS float* scr = (LAS float*)(F.lds + F.wave * 16384);
    const int gw = F.vcu * 8 + F.wave, NGW = F.G * 8, lane = F.lane;
    constexpr int I_IN = (D / 64) * (INC / 32), I_A = (AW / 64) * (D / 32), I_O = (D / 64) * (D / 32), I_P = (PLE / 64) * (D / 32);
    constexpr int I_W1 = (D / 64) * (F2 / 32), I_W2 = (FH / 64) * (D / 32);
    constexpr int NITEMS = I_IN + 2 * I_A + 2 * I_O + I_P + NE * (I_W1 + I_W2);
    for (int it = gw; it < NITEMS; it += NGW) {
        int r = it;
        if (r < I_IN) { p0_transpose_item(FIN(3), D, INC, WSP(bf16, WS_WIN), scr, r, lane, FIN(2)); continue; } r -= I_IN;
        if (r < I_A) { p0_transpose_item(FIN(15), AW, D, WSP(bf16, WS_WA), scr, r, lane, nullptr); continue; } r -= I_A;
        if (r < I_A) { p0_transpose_item(FIN(16), RW, D, WSP(bf16, WS_WB), scr, r, lane, nullptr); continue; } r -= I_A;
        if (r < I_O) { p0_transpose_item(FIN(17), D, D, WSP(bf16, WS_WO), scr, r, lane, nullptr); continue; } r -= I_O;
        if (r < I_O) { p0_transpose_item(FIN(26), D, D, WSP(bf16, WS_WG), scr, r, lane, FIN(25)); continue; } r -= I_O;
        if (r < I_P) { p0_transpose_item(FIN(27), PLE, D, WSP(bf16, WS_WP), scr, r, lane, nullptr); continue; } r -= I_P;
        if (r < NE * I_W1) { const int e = r / I_W1; p0_transpose_item(FIN(21) + (size_t)e * D * F2, D, F2, WSP(bf16, WS_W1) + (size_t)e * F2 * D, scr, r % I_W1, lane, nullptr); continue; } r -= NE * I_W1;
        { const int e = r / I_W2; p0_transpose_item(FIN(23) + (size_t)e * FH * D, FH, D, WSP(bf16, WS_W2) + (size_t)e * D * FH, scr, r % I_W2, lane, nullptr); }
    }
    { const int gt = (F.vcu * 512 + F.tid), NT = F.G * 512;
      bf16* WL = WSP(bf16, WS_WL);
      for (int i = gt; i < LORA_N * LORA_K; i += NT) { const int n = i >> 8, k = i & 255; float v = 0.f;
          if (n < 512) { if (k < 64) v = FIN(6)[k * 512 + n]; }
          else if (n < 1024) { if (k >= 64 && k < 128) v = FIN(8)[(k - 64) * 512 + (n - 512)]; }
          else { if (k >= 128) v = FIN(9)[(k - 128) * 512 + (n - 1024)]; }
          WL[i] = (bf16)(pk2(v, 0.f) & 0xffffu); }
      float* GW = WSP(float, WS_GW);
      for (int i = gt; i < D * NE; i += NT) GW[i] = FIN(19)[i] * FIN(18)[i >> 5];
    }
    { bf16* XB = WSP(bf16, WS_XB); float* R0 = WSP(float, WS_RSTD0); bf16* PB = WSP(bf16, WS_PB);
      for (int m = gw; m < M; m += NGW) {
          const f32x4* xr = (const f32x4*)(FIN(0) + (size_t)m * D) + lane;
          f32x4 v[4]; float s = 0.f;
#pragma unroll
          for (int j = 0; j < 4; ++j) { v[j] = xr[64 * j]; s += (v[j].x * v[j].x + v[j].y * v[j].y) + (v[j].z * v[j].z + v[j].w * v[j].w); }
          s = wave_sum(s);
          u32x2* o = (u32x2*)(XB + (size_t)m * D) + lane;
#pragma unroll
          for (int j = 0; j < 4; ++j) { u32x2 w; w.x = pk2(v[j].x, v[j].y); w.y = pk2(v[j].z, v[j].w); o[64 * j] = w; }
          if (lane == 0) R0[m] = 1.0f / sqrtf(s * (1.f / D) + RMS_EPS);
          const f32x4 pv = ((const f32x4*)(FIN(1) + (size_t)m * PLE))[lane];
          u32x2 w; w.x = pk2(pv.x, pv.y); w.y = pk2(pv.z, pv.w); ((u32x2*)(PB + (size_t)m * PLE))[lane] = w;
      }
    }
}

struct EpiG1 {
    static constexpr bool PERM = true;
    const float* rstd; bf16 *Q, *K, *VT, *ZR, *GT;
    __device__ __forceinline__ void operator()(AccRef acc, const Unit& u, int wr, int wc, int fr, int fq) const {
        const int pn = u.pn, rowb = u.pm * 256 + wr * 64 + fr, cl = wc * 32 + 8 * fq;
#pragma unroll
        for (int ai = 0; ai < 2; ++ai)
#pragma unroll
            for (int m = 0; m < 4; ++m) {
                const int row = rowb + ai * 128 + m * 16; const float rs = rstd[row];
                if (pn < 4) {
                    bf16* base = (pn < 2 ? Q : K) + (size_t)row * 512 + (pn & 1) * 256 + cl; const float sc = pn < 2 ? rs * 0.125f : rs;
#pragma unroll
                    for (int bj = 0; bj < 2; ++bj) { const f32x4 v0 = acc[ai][bj][m][0] * sc, v1 = acc[ai][bj][m][1] * sc;
                        u32x4 w; w.x = pk2(v0[0], v0[1]); w.y = pk2(v0[2], v0[3]); w.z = pk2(v1[0], v1[1]); w.w = pk2(v1[2], v1[3]); *(u32x4*)(base + bj * 128) = w; }
                } else if (pn < 6) {
                    const int b = row >> 11, s = row & 2047;
#pragma unroll
                    for (int bj = 0; bj < 2; ++bj)
#pragma unroll
                        for (int n = 0; n < 2; ++n)
#pragma unroll
                            for (int j = 0; j < 4; ++j) { const int c = (pn - 4) * 256 + cl + bj * 128 + 4 * n + j; const int hh = c >> 6, d = c & 63;
                                VT[((size_t)((b * 8 + hh) * 64 + d)) * SEQ + s] = (bf16)(pk2(acc[ai][bj][m][n][j] * rs, 0.f) & 0xffffu); }
                } else if (pn < 13) {
                    bf16* base = ZR + (size_t)row * RWC + (pn - 6) * 256 + cl;
#pragma unroll
                    for (int bj = 0; bj < 2; ++bj) { const f32x4 v0 = acc[ai][bj][m][0] * rs, v1 = acc[ai][bj][m][1] * rs;
                        u32x4 w; w.x = pk2(v0[0], v0[1]); w.y = pk2(v0[2], v0[3]); w.z = pk2(v1[0], v1[1]); w.w = pk2(v1[2], v1[3]); *(u32x4*)(base + bj * 128) = w; }
                } else {
                    bf16* base = GT + (size_t)row * 2048 + (pn - 13) * 256 + cl;
#pragma unroll
                    for (int bj = 0; bj < 2; ++bj) { const f32x4 v0 = acc[ai][bj][m][0] * rs, v1 = acc[ai][bj][m][1] * rs;
                        u32x4 w; w.x = pk2(sigm(v0[0]), sigm(v0[1])); w.y = pk2(sigm(v0[2]), sigm(v0[3])); w.z = pk2(sigm(v1[0]), sigm(v1[1])); w.w = pk2(sigm(v1[2]), sigm(v1[3])); *(u32x4*)(base + bj * 128) = w; }
                }
            }
    }
};
struct EpiLora {
    static constexpr bool PERM = false;
    const float *w0, *a0; float *DEC, *AA; bf16* GG;
    template <int MODE> __device__ __forceinline__ void body(AccRef acc, int rowb, int cb) const {
#pragma unroll
        for (int ai = 0; ai < 2; ++ai)
#pragma unroll
            for (int m = 0; m < 4; ++m) {
                const int row = rowb + ai * 128 + m * 16;
#pragma unroll
                for (int bj = 0; bj < 2; ++bj)
#pragma unroll
                    for (int n = 0; n < 2; ++n) {
                        const int c = cb + bj * 128 + n * 16;
                        f32x4 v = acc[ai][bj][m][n];
                        if (MODE == 0) { v = v + *(const f32x4*)(w0 + c); f32x4 o;
#pragma unroll
                            for (int j = 0; j < 4; ++j) { const float y = -v[j]; const float sp = y > 20.f ? y : __logf(1.f + __expf(y)); o[j] = __expf(-__expf(-sp - 0.5f)); }
                            *(f32x4*)(DEC + (size_t)row * 512 + c) = o;
                        } else if (MODE == 1) { v = v + *(const f32x4*)(a0 + c); f32x4 o;
#pragma unroll
                            for (int j = 0; j < 4; ++j) o[j] = sigm(v[j]);
                            *(f32x4*)(AA + (size_t)row * 512 + c) = o;
                        } else { u32x2 w; w.x = pk2(v[0], v[1]); w.y = pk2(v[2], v[3]); *(u32x2*)(GG + (size_t)row * 512 + c) = w; }
                    }
                asm volatile("" ::: "memory");
            }
    }
    __device__ __forceinline__ void operator()(AccRef acc, const Unit& u, int wr, int wc, int fr, int fq) const {
        const int pn = u.pn, rowb = u.pm * 256 + wr * 64 + fr, cb = (pn & 1) * 256 + wc * 32 + 4 * fq;
        if (pn < 2) body<0>(acc, rowb, cb); else if (pn < 4) body<1>(acc, rowb, cb); else body<2>(acc, rowb, cb);
    }
};
template <int SECOND> struct EpiMerge {
    static constexpr bool PERM = true;
    const bf16* GT; bf16* MG;
    __device__ __forceinline__ void operator()(AccRef acc, const Unit& u, int wr, int wc, int fr, int fq) const {
        const int rowb = u.pm * 256 + wr * 64 + fr, c0 = u.pn * 256 + wc * 32 + 8 * fq;
#pragma unroll
        for (int ai = 0; ai < 2; ++ai)
#pragma unroll
            for (int m = 0; m < 4; ++m) { const int row = rowb + ai * 128 + m * 16;
#pragma unroll
                for (int bj = 0; bj < 2; ++bj) {
                    const int c = c0 + bj * 128; const u32x4 gv = *(const u32x4*)(GT + (size_t)row * 2048 + SECOND * 1024 + c);
                    const f32x4 v0 = acc[ai][bj][m][0], v1 = acc[ai][bj][m][1];
                    float o[8] = {v0[0] * bflo(gv.x), v0[1] * bfhi(gv.x), v0[2] * bflo(gv.y), v0[3] * bfhi(gv.y), v1[0] * bflo(gv.z), v1[1] * bfhi(gv.z), v1[2] * bflo(gv.w), v1[3] * bfhi(gv.w)};
                    bf16* dst = MG + (size_t)row * 1024 + c;
                    if (SECOND) { const u32x4 ov = *(const u32x4*)dst; o[0] += bflo(ov.x); o[1] += bfhi(ov.x); o[2] += bflo(ov.y); o[3] += bfhi(ov.y); o[4] += bflo(ov.z); o[5] += bfhi(ov.z); o[6] += bflo(ov.w); o[7] += bfhi(ov.w); }
                    u32x4 w; w.x = pk2(o[0], o[1]); w.y = pk2(o[2], o[3]); w.z = pk2(o[4], o[5]); w.w = pk2(o[6], o[7]); *(u32x4*)dst = w; } }
    }
};
struct EpiX1 {
    static constexpr bool PERM = false;
    const float* X; float* X1;
    __device__ __forceinline__ void operator()(AccRef acc, const Unit& u, int wr, int wc, int fr, int fq) const {
        const int rowb = u.pm * 256 + wr * 64 + fr, c0 = u.pn * 256 + wc * 32 + 4 * fq;
#pragma unroll
        for (int ai = 0; ai < 2; ++ai)
#pragma unroll
            for (int m = 0; m < 4; ++m) { const size_t off = (size_t)(rowb + ai * 128 + m * 16) * D + c0;
#pragma unroll
                for (int bj = 0; bj < 2; ++bj)
#pragma unroll
                    for (int n = 0; n < 2; ++n) { const f32x4 xv = *(const f32x4*)(X + off + bj * 128 + n * 16); *(f32x4*)(X1 + off + bj * 128 + n * 16) = xv + acc[ai][bj][m][n]; } }
    }
};
struct EpiSwiglu {
    static constexpr bool PERM = true;
    const float* b1; bf16* ACT;
    __device__ __forceinline__ void operator()(AccRef acc, const Unit& u, int wr, int wc, int fr, int fq) const {
        const int rowb = u.pm * 256 + wr * 64 + fr, c0 = u.pn * 256 + wc * 32 + 8 * fq;
        const float* bb = b1 + (size_t)u.e * F2;
#pragma unroll
        for (int bj = 0; bj < 2; ++bj) {
            const f32x4 bv0 = *(const f32x4*)(bb + c0 + bj * 128), bv1 = *(const f32x4*)(bb + c0 + bj * 128 + 4);
#pragma unroll
            for (int ai = 0; ai < 2; ++ai)
#pragma unroll
                for (int m = 0; m < 4; ++m) { const int row = rowb + ai * 128 + m * 16;
                    const f32x4 v0 = acc[ai][bj][m][0] + bv0, v1 = acc[ai][bj][m][1] + bv1;
                    float o[4];
#pragma unroll
                    for (int p = 0; p < 4; ++p) { float gl = p < 2 ? v0[2 * p] : v1[2 * p - 4], ul = p < 2 ? v0[2 * p + 1] : v1[2 * p - 3];
                        gl = fminf(gl, 7.f); ul = fminf(fmaxf(ul, -7.f), 7.f); o[p] = (ul + 1.f) * gl * sigm(1.702f * gl); }
                    u32x2 w; w.x = pk2(o[0], o[1]); w.y = pk2(o[2], o[3]); *(u32x2*)(ACT + (size_t)row * FH + ((c0 + bj * 128) >> 1)) = w; } }
    }
};
struct EpiY {
    static constexpr bool PERM = true;
    const float* b2; const int* rowslot; const float* gatew; bf16* YB;
    __device__ __forceinline__ void operator()(AccRef acc, const Unit& u, int wr, int wc, int fr, int fq) const {
        const int rowb = u.pm * 256 + wr * 64 + fr, c0 = u.pn * 256 + wc * 32 + 8 * fq;
        const float* bb = b2 + (size_t)u.e * D;
#pragma unroll
        for (int ai = 0; ai < 2; ++ai)
#pragma unroll
            for (int m = 0; m < 4; ++m) { const int row = rowb + ai * 128 + m * 16; const int slot = rowslot[row];
                if (slot >= 0) { const float gt = gatew[slot];
#pragma unroll
                    for (int bj = 0; bj < 2; ++bj) { const int c = c0 + bj * 128;
                        const f32x4 v0 = (acc[ai][bj][m][0] + *(const f32x4*)(bb + c)) * gt, v1 = (acc[ai][bj][m][1] + *(const f32x4*)(bb + c + 4)) * gt;
                        u32x4 w; w.x = pk2(v0[0], v0[1]); w.y = pk2(v0[2], v0[3]); w.z = pk2(v1[0], v1[1]); w.w = pk2(v1[2], v1[3]); *(u32x4*)(YB + (size_t)slot * D + c) = w; } } }
    }
};
struct EpiProj {
    static constexpr bool PERM = false;
    float* O;
    __device__ __forceinline__ void operator()(AccRef acc, const Unit& u, int wr, int wc, int fr, int fq) const {
        const int rowb = u.pm * 256 + wr * 64 + fr, c0 = u.pn * 256 + wc * 32 + 4 * fq;
#pragma unroll
        for (int ai = 0; ai < 2; ++ai)
#pragma unroll
            for (int m = 0; m < 4; ++m) { const size_t off = (size_t)(rowb + ai * 128 + m * 16) * D + c0;
#pragma unroll
                for (int bj = 0; bj < 2; ++bj)
#pragma unroll
                    for (int n = 0; n < 2; ++n) *(f32x4*)(O + off + bj * 128 + n * 16) = acc[ai][bj][m][n]; }
    }
};
struct EpiPle {
    static constexpr bool PERM = false;
    const float* X2; const float* rstd2; float* O; float* rowss;
    __device__ __forceinline__ void operator()(AccRef acc, const Unit& u, int wr, int wc, int fr, int fq) const {
        const int rowb = u.pm * 256 + wr * 64 + fr, c0 = u.pn * 256 + wc * 32 + 4 * fq;
#pragma unroll
        for (int ai = 0; ai < 2; ++ai)
#pragma unroll
            for (int m = 0; m < 4; ++m) { const int row = rowb + ai * 128 + m * 16; const size_t off = (size_t)row * D + c0; const float rs = rstd2[row]; float ss = 0.f;
#pragma unroll
                for (int bj = 0; bj < 2; ++bj)
#pragma unroll
                    for (int n = 0; n < 2; ++n) { const size_t o2 = off + bj * 128 + n * 16; const f32x4 pr = *(const f32x4*)(O + o2), xv = *(const f32x4*)(X2 + o2), a = acc[ai][bj][m][n]; f32x4 x3;
#pragma unroll
                        for (int j = 0; j < 4; ++j) { x3[j] = xv[j] + sigm(rs * a[j]) * pr[j]; ss += x3[j] * x3[j]; }
                        *(f32x4*)(O + o2) = x3; asm volatile("" ::: "memory"); }
                ss += __shfl_xor(ss, 16); ss += __shfl_xor(ss, 32);
                if (fq == 0) atomicAdd(rowss + row, ss);
                asm volatile("" ::: "memory"); }
    }
};

__device__ __forceinline__ void build_alora(const Args& args, Frame& F, int pm) {
    const bf16* ZR = WSP(bf16, WS_ZR); bf16* AL = WSP(bf16, WS_ALORA); const float* mu = FIN(4) + 1536;
#pragma unroll 2
    for (int i = 0; i < 16; ++i) {
        const int id = F.tid + 512 * i, row = pm * 256 + (id >> 5), cc = (id & 31) * 8;
        const u32x4 zc = *(const u32x4*)(ZR + (size_t)row * RWC + 1536 + cc);
        u32x4 zp = (u32x4){0u, 0u, 0u, 0u}; if ((row & (SEQ - 1)) != 0) zp = *(const u32x4*)(ZR + (size_t)(row - 1) * RWC + 1536 + cc);
        const unsigned zcw[4] = {zc.x, zc.y, zc.z, zc.w}, zpw[4] = {zp.x, zp.y, zp.z, zp.w}; float o[8];
#pragma unroll
        for (int j = 0; j < 8; ++j) { const float c = (j & 1) ? bfhi(zcw[j >> 1]) : bflo(zcw[j >> 1]), p = (j & 1) ? bfhi(zpw[j >> 1]) : bflo(zpw[j >> 1]);
            const float xs = c + mu[cc + j] * (p - c);
            o[j] = cc < 64 ? (1.f - 2.f * __builtin_amdgcn_rcpf(1.f + __expf(2.f * xs))) : (cc < 128 ? xs : sigm(xs)); }
        u32x4 w; w.x = pk2(o[0], o[1]); w.y = pk2(o[2], o[3]); w.z = pk2(o[4], o[5]); w.w = pk2(o[6], o[7]);
        *(u32x4*)(AL + (size_t)row * LORA_K + cc) = w;
    }
}

__device__ __forceinline__ void scan_unit(const Args& args, Frame& F, int bh) {
    const int b = bh >> 3, h = bh & 7, tid = F.tid;
    LAS float* LW = (LAS float*)F.lds;
    LAS float* LKK = LW + 4096, *LBB = LW + 8192, *LKP = LW + 12288, *LRR = LW + 16384, *LVV = LW + 20480, *LYY = LW + 24576, *LBON = LW + 28672;
    const bf16* ZR = WSP(bf16, WS_ZR); const float* DEC = WSP(float, WS_DEC); const float* AA = WSP(float, WS_AA); const bf16* GG = WSP(bf16, WS_GG); bf16* YB = WSP(bf16, WS_YB);
    const float* mu = FIN(4); const float* k_k = FIN(10) + h * 64; const float* k_a = FIN(11) + h * 64; const float* r_k = FIN(12) + h * 64;
    const float* lnw = FIN(13) + h * 64; const float* lnb = FIN(14) + h * 64;
    const int tt_p = tid >> 3, j0 = 8 * (tid & 7);
    const int row = tid >> 3, cg = tid & 7;
    float S[8];
#pragma unroll
    for (int j = 0; j < 8; ++j) S[j] = 0.f;
    float mur[8], muk[8], muv[8], kk_c[8], ka_c[8], rk_c[8];
#pragma unroll
    for (int j = 0; j < 8; ++j) { mur[j] = mu[h * 64 + j0 + j]; muk[j] = mu[512 + h * 64 + j0 + j]; muv[j] = mu[1024 + h * 64 + j0 + j]; kk_c[j] = k_k[j0 + j]; ka_c[j] = k_a[j0 + j]; rk_c[j] = r_k[j0 + j]; }
    for (int c0 = 0; c0 < SEQ; c0 += 64) {
        __syncthreads();
        {
            const size_t tok = (size_t)b * SEQ + c0 + tt_p; const bool first = (c0 + tt_p) == 0;
            const bf16* zc = ZR + tok * RWC + h * 64 + j0; const bf16* zp = zc - RWC;
            u32x4 cr = *(const u32x4*)zc, ck = *(const u32x4*)(zc + 512), cv = *(const u32x4*)(zc + 1024);
            u32x4 pr = (u32x4){0u, 0u, 0u, 0u}, pk = pr, pv = pr;
            if (!first) { pr = *(const u32x4*)zp; pk = *(const u32x4*)(zp + 512); pv = *(const u32x4*)(zp + 1024); }
            const f32x4 d0 = *(const f32x4*)(DEC + tok * 512 + h * 64 + j0), d1 = *(const f32x4*)(DEC + tok * 512 + h * 64 + j0 + 4);
            const f32x4 a0 = *(const f32x4*)(AA + tok * 512 + h * 64 + j0), a1 = *(const f32x4*)(AA + tok * 512 + h * 64 + j0 + 4);
            const unsigned crw[4] = {cr.x, cr.y, cr.z, cr.w}, ckw[4] = {ck.x, ck.y, ck.z, ck.w}, cvw[4] = {cv.x, cv.y, cv.z, cv.w};
            const unsigned prw[4] = {pr.x, pr.y, pr.z, pr.w}, pkw[4] = {pk.x, pk.y, pk.z, pk.w}, pvw[4] = {pv.x, pv.y, pv.z, pv.w};
            float r[8], k[8], v[8], kk[8], a[8], dec[8]; float ss = 0.f;
#pragma unroll
            for (int j = 0; j < 8; ++j) {
                const float rc = (j & 1) ? bfhi(crw[j >> 1]) : bflo(crw[j >> 1]), rp = (j & 1) ? bfhi(prw[j >> 1]) : bflo(prw[j >> 1]);
                const float kc = (j & 1) ? bfhi(ckw[j >> 1]) : bflo(ckw[j >> 1]), kp = (j & 1) ? bfhi(pkw[j >> 1]) : bflo(pkw[j >> 1]);
                const float vc = (j & 1) ? bfhi(cvw[j >> 1]) : bflo(cvw[j >> 1]), vp = (j & 1) ? bfhi(pvw[j >> 1]) : bflo(pvw[j >> 1]);
                r[j] = rc + mur[j] * (rp - rc); k[j] = kc + muk[j] * (kp - kc); v[j] = vc + muv[j] * (vp - vc);
                kk[j] = k[j] * kk_c[j]; ss += kk[j] * kk[j];
                a[j] = j < 4 ? a0[j] : a1[j - 4]; dec[j] = j < 4 ? d0[j] : d1[j - 4];
            }
            ss = red8(ss);
            const float inv = 1.0f / fmaxf(sqrtf(ss), 1e-12f);
            float bon = 0.f; float kpv[8], bbv[8];
#pragma unroll
            for (int j = 0; j < 8; ++j) { kk[j] *= inv; bbv[j] = kk[j] * a[j]; kpv[j] = k[j] * (1.f + (a[j] - 1.f) * ka_c[j]); bon += r[j] * kpv[j] * rk_c[j]; }
            bon = red8(bon);
            const int o = tt_p * 64 + j0;
            *(LAS f32x4*)(LW + o) = (f32x4){dec[0], dec[1], dec[2], dec[3]}; *(LAS f32x4*)(LW + o + 4) = (f32x4){dec[4], dec[5], dec[6], dec[7]};
            *(LAS f32x4*)(LKK + o) = (f32x4){kk[0], kk[1], kk[2], kk[3]}; *(LAS f32x4*)(LKK + o + 4) = (f32x4){kk[4], kk[5], kk[6], kk[7]};
            *(LAS f32x4*)(LBB + o) = (f32x4){bbv[0], bbv[1], bbv[2], bbv[3]}; *(LAS f32x4*)(LBB + o + 4) = (f32x4){bbv[4], bbv[5], bbv[6], bbv[7]};
            *(LAS f32x4*)(LKP + o) = (f32x4){kpv[0], kpv[1], kpv[2], kpv[3]}; *(LAS f32x4*)(LKP + o + 4) = (f32x4){kpv[4], kpv[5], kpv[6], kpv[7]};
            *(LAS f32x4*)(LRR + o) = (f32x4){r[0], r[1], r[2], r[3]}; *(LAS f32x4*)(LRR + o + 4) = (f32x4){r[4], r[5], r[6], r[7]};
            *(LAS f32x4*)(LVV + o) = (f32x4){v[0], v[1], v[2], v[3]}; *(LAS f32x4*)(LVV + o + 4) = (f32x4){v[4], v[5], v[6], v[7]};
            if ((tid & 7) == 0) LBON[tt_p] = bon;
        }
        __syncthreads();
#pragma unroll 2
        for (int tt = 0; tt < 64; ++tt) {
            const int o = tt * 64 + 8 * cg;
            const f32x4 k0 = *(const LAS f32x4*)(LKK + o), k1 = *(const LAS f32x4*)(LKK + o + 4);
            const f32x4 w0 = *(const LAS f32x4*)(LW + o), w1 = *(const LAS f32x4*)(LW + o + 4);
            const f32x4 b0 = *(const LAS f32x4*)(LBB + o), b1 = *(const LAS f32x4*)(LBB + o + 4);
            const f32x4 p0 = *(const LAS f32x4*)(LKP + o), p1 = *(const LAS f32x4*)(LKP + o + 4);
            const f32x4 r0 = *(const LAS f32x4*)(LRR + o), r1 = *(const LAS f32x4*)(LRR + o + 4);
            const float vi = LVV[tt * 64 + row];
            float sa = (S[0] * k0[0] + S[1] * k0[1]) + (S[2] * k0[2] + S[3] * k0[3]) + (S[4] * k1[0] + S[5] * k1[1]) + (S[6] * k1[2] + S[7] * k1[3]);
            sa = -red8(sa);
#pragma unroll
            for (int j = 0; j < 4; ++j) { S[j] = S[j] * w0[j] + (sa * b0[j] + vi * p0[j]); S[4 + j] = S[4 + j] * w1[j] + (sa * b1[j] + vi * p1[j]); }
            float y = (S[0] * r0[0] + S[1] * r0[1]) + (S[2] * r0[2] + S[3] * r0[3]) + (S[4] * r1[0] + S[5] * r1[1]) + (S[6] * r1[2] + S[7] * r1[3]);
            y = red8(y);
            if (cg == 0) LYY[tt * 64 + row] = y;
        }
        __syncthreads();
        {
            const size_t tok = (size_t)b * SEQ + c0 + tt_p; const int o = tt_p * 64 + j0;
            const f32x4 y0 = *(const LAS f32x4*)(LYY + o), y1 = *(const LAS f32x4*)(LYY + o + 4);
            const f32x4 v0 = *(const LAS f32x4*)(LVV + o), v1 = *(const LAS f32x4*)(LVV + o + 4);
            float s = (y0[0] + y0[1]) + (y0[2] + y0[3]) + (y1[0] + y1[1]) + (y1[2] + y1[3]);
            const float mean = red8(s) * (1.f / 64.f); float q = 0.f;
#pragma unroll
            for (int j = 0; j < 4; ++j) { const float d0 = y0[j] - mean, d1 = y1[j] - mean; q += d0 * d0 + d1 * d1; }
            const float rs = 1.0f / sqrtf(red8(q) * (1.f / 64.f) + GN_EPS); const float bon = LBON[tt_p];
            const u32x4 gv = *(const u32x4*)(GG + tok * 512 + h * 64 + j0); const unsigned gw[4] = {gv.x, gv.y, gv.z, gv.w}; float ov[8];
#pragma unroll
            for (int j = 0; j < 8; ++j) { const float yy = j < 4 ? y0[j] : y1[j - 4], vv = j < 4 ? v0[j] : v1[j - 4]; const float g = (j & 1) ? bfhi(gw[j >> 1]) : bflo(gw[j >> 1]);
                ov[j] = ((yy - mean) * rs * lnw[j0 + j] + lnb[j0 + j] + bon * vv) * g; }
            u32x4 w; w.x = pk2(ov[0], ov[1]); w.y = pk2(ov[2], ov[3]); w.z = pk2(ov[4], ov[5]); w.w = pk2(ov[6], ov[7]);
            *(u32x4*)(YB + tok * 512 + h * 64 + j0) = w;
        }
    }
    __syncthreads();
}

__device__ __forceinline__ void attn_tile(Frame& F, int bh, int qt) {
    const int lane = F.lane, q = lane & 31, hi = lane >> 5, b = bh >> 3, h = bh & 7, t0 = 32 * qt;
    const size_t tokbase = (size_t)b * SEQ;
    const bf16* QB = WSP(bf16, WS_Q); const bf16* KB = WSP(bf16, WS_K); const bf16* VT = WSP(bf16, WS_VT); bf16* YA = WSP(bf16, WS_YA);
    bf16x8 qf[4];
    { const bf16* Qp = QB + (tokbase + t0 + q) * 512 + h * 64 + 8 * hi;
#pragma unroll
      for (int d0 = 0; d0 < 4; ++d0) qf[d0] = *(const bf16x8*)(Qp + 16 * d0); }
    f32x16 y0, y1;
#pragma unroll
    for (int r = 0; r < 16; ++r) { y0[r] = 0.f; y1[r] = 0.f; }
    float carry = 1.f;
    const bf16* Vrow = VT + ((size_t)(bh * 64) + q) * SEQ + 4 * hi;
    for (int s0 = t0; s0 >= 0; s0 -= 32) {
        bf16x8 kf[4];
        { const bf16* Kp = KB + (tokbase + s0 + q) * 512 + h * 64 + 8 * hi;
#pragma unroll
          for (int d0 = 0; d0 < 4; ++d0) kf[d0] = *(const bf16x8*)(Kp + 16 * d0); }
        u32x2 vlo[2][2], vhi[2][2];
#pragma unroll
        for (int dt = 0; dt < 2; ++dt)
#pragma unroll
            for (int s = 0; s < 2; ++s) { const bf16* vp = Vrow + (size_t)dt * 32 * SEQ + s0 + 16 * s; vlo[dt][s] = *(const u32x2*)vp; vhi[dt][s] = *(const u32x2*)(vp + 8); }
        f32x16 p;
#pragma unroll
        for (int r = 0; r < 16; ++r) p[r] = 0.f;
#pragma unroll
        for (int d0 = 0; d0 < 4; ++d0) p = __builtin_amdgcn_mfma_f32_32x32x16_bf16(kf[d0], qf[d0], p, 0, 0, 0);
        float om[16], be[16];
#pragma unroll
        for (int r = 0; r < 16; ++r) {
            const int kv = crow(r, hi); const bool valid = (s0 + kv) < (t0 + q);
            const float z = fminf(p[r], 80.f); const float t = __expf(z); const float o = __builtin_amdgcn_rcpf(1.f + t);
            om[r] = valid ? o : 1.f; be[r] = valid ? t * o : 0.f;
        }
        float el[16], G[4], PG[4];
#pragma unroll
        for (int i = 0; i < 4; ++i) { el[4 * i + 3] = 1.f; el[4 * i + 2] = om[4 * i + 3]; el[4 * i + 1] = el[4 * i + 2] * om[4 * i + 2]; el[4 * i] = el[4 * i + 1] * om[4 * i + 1]; G[i] = el[4 * i] * om[4 * i]; }
#pragma unroll
        for (int i = 0; i < 4; ++i) PG[i] = __shfl_xor(G[i], 32);
        float sG[4], sP[4];
        sG[3] = 1.f; sG[2] = G[3]; sG[1] = G[3] * G[2]; sG[0] = sG[1] * G[1];
        sP[3] = 1.f; sP[2] = PG[3]; sP[1] = PG[3] * PG[2]; sP[0] = sP[1] * PG[1];
        const float total = (sG[0] * G[0]) * (sP[0] * PG[0]);
        float A[16];
#pragma unroll
        for (int i = 0; i < 4; ++i) { const float eg = sG[i] * (hi ? sP[i] : sP[i] * PG[i]) * carry;
#pragma unroll
            for (int j = 0; j < 4; ++j) A[4 * i + j] = be[4 * i + j] * el[4 * i + j] * eg; }
        carry *= total;
        bf16x8 pf[2];
#pragma unroll
        for (int s = 0; s < 2; ++s) { u32x4 w; w.x = pk2(A[8 * s], A[8 * s + 1]); w.y = pk2(A[8 * s + 2], A[8 * s + 3]); w.z = pk2(A[8 * s + 4], A[8 * s + 5]); w.w = pk2(A[8 * s + 6], A[8 * s + 7]); pf[s] = __builtin_bit_cast(bf16x8, w); }
#pragma unroll
        for (int s = 0; s < 2; ++s) {
            const u32x4 a0 = (u32x4){vlo[0][s].x, vlo[0][s].y, vhi[0][s].x, vhi[0][s].y}, a1 = (u32x4){vlo[1][s].x, vlo[1][s].y, vhi[1][s].x, vhi[1][s].y};
            y0 = __builtin_amdgcn_mfma_f32_32x32x16_bf16(__builtin_bit_cast(bf16x8, a0), pf[s], y0, 0, 0, 0);
            y1 = __builtin_amdgcn_mfma_f32_32x32x16_bf16(__builtin_bit_cast(bf16x8, a1), pf[s], y1, 0, 0, 0);
        }
        if (__all(carry < 5.6e-14f)) break;
    }
    bf16* Yp = YA + (tokbase + t0 + q) * 512 + h * 64 + 4 * hi;
#pragma unroll
    for (int i = 0; i < 4; ++i) {
        u32x2 w0, w1; w0.x = pk2(y0[4 * i], y0[4 * i + 1]); w0.y = pk2(y0[4 * i + 2], y0[4 * i + 3]); w1.x = pk2(y1[4 * i], y1[4 * i + 1]); w1.y = pk2(y1[4 * i + 2], y1[4 * i + 3]);
        *(u32x2*)(Yp + 8 * i) = w0; *(u32x2*)(Yp + 32 + 8 * i) = w1;
    }
}

__device__ __forceinline__ void p5a_router(const Args& args, Frame& F) {
    LAS float* LG = (LAS float*)F.lds;
    LAS unsigned* HIST = (LAS unsigned*)(F.lds + 32768); LAS unsigned* BASE = HIST + 32; LAS float* RSTD = (LAS float*)(F.lds + 32768 + 512);
    const float* X1 = WSP(float, WS_X1); const float* GW = WSP(float, WS_GW); const float* rb = FIN(20); const float* gn = FIN(18);
    unsigned* cnt = F.ctl + CW_CNT; int* LIST = WSP(int, WS_LIST); float* GATEW = WSP(float, WS_GATEW); bf16* HN = WSP(bf16, WS_HN);
    const int tid = F.tid, lane = F.lane, wave = F.wave;
    for (int tb = blockIdx.x; tb < M / 128; tb += F.G) {
        if (tid < 32) HIST[tid] = 0u;
        __syncthreads();
        int ex[4] = {0, 0, 0, 0}; float gt[4] = {0.f, 0.f, 0.f, 0.f}; unsigned lr[4] = {0u, 0u, 0u, 0u}; int tok = 0;
        if (wave < 4) {
            const int i = lane & 31, kh = lane >> 5; tok = tb * 128 + wave * 32 + i;
            const float* xr = X1 + (size_t)tok * D + 4 * kh;
            f32x16 acc;
#pragma unroll
            for (int r = 0; r < 16; ++r) acc[r] = 0.f;
            float ss = 0.f;
#pragma unroll 4
            for (int u = 0; u < 128; ++u) {
                const f32x4 a = *(const f32x4*)(xr + 8 * u); ss += (a[0] * a[0] + a[1] * a[1]) + (a[2] * a[2] + a[3] * a[3]);
                const float* gp = GW + (size_t)(8 * u + 4 * kh) * 32 + i;
#pragma unroll
                for (int j = 0; j < 4; ++j) acc = __builtin_amdgcn_mfma_f32_32x32x2f32(a[j], gp[32 * j], acc, 0, 0, 0);
            }
            ss += __shfl_xor(ss, 32);
            const float rstd = 1.0f / sqrtf(ss * (1.f / D) + RMS_EPS);
            if (kh == 0) RSTD[wave * 32 + i] = rstd;
            LAS float* L = LG + wave * (32 * 33);
#pragma unroll
            for (int r = 0; r < 16; ++r) L[crow(r, kh) * 33 + i] = acc[r];
            asm volatile("s_waitcnt lgkmcnt(0)" ::: "memory");
            if (kh == 0) {
                float v0 = -3.0e38f, v1 = -3.0e38f, v2 = -3.0e38f, v3 = -3.0e38f; int i0 = 0, i1 = 0, i2 = 0, i3 = 0;
                for (int e = 0; e < 32; ++e) { const float v = L[i * 33 + e] * rstd + rb[e];
                    if (v > v3) { if (v > v2) { v3 = v2; i3 = i2; if (v > v1) { v2 = v1; i2 = i1; if (v > v0) { v1 = v0; i1 = i0; v0 = v; i0 = e; } else { v1 = v; i1 = e; } } else { v2 = v; i2 = e; } } else { v3 = v; i3 = e; } } }
                const float e1 = __expf(v1 - v0), e2 = __expf(v2 - v0), e3 = __expf(v3 - v0), inv = 1.0f / (1.f + e1 + e2 + e3);
                ex[0] = i0; ex[1] = i1; ex[2] = i2; ex[3] = i3; gt[0] = inv; gt[1] = e1 * inv; gt[2] = e2 * inv; gt[3] = e3 * inv;
#pragma unroll
                for (int k = 0; k < 4; ++k) lr[k] = __hip_atomic_fetch_add(&HIST[ex[k]], 1u, __ATOMIC_RELAXED, __HIP_MEMORY_SCOPE_WORKGROUP);
            }
        }
        __syncthreads();
        if (tid < 32) BASE[tid] = __hip_atomic_fetch_add(cnt + tid, HIST[tid], RLX_AGENT);
        __syncthreads();
        if (wave < 4 && lane < 32) {
#pragma unroll
            for (int k = 0; k < 4; ++k) { const unsigned pos = BASE[ex[k]] + lr[k]; LIST[(size_t)ex[k] * CAP + pos] = tok * 4 + k; GATEW[tok * 4 + k] = gt[k]; }
        }
        for (int rr = 0; rr < 16; ++rr) { const int lt = wave * 16 + rr, t = tb * 128 + lt; const float rs = RSTD[lt];
            const f32x4* xr = (const f32x4*)(X1 + (size_t)t * D) + lane; u32x2* o = (u32x2*)(HN + (size_t)t * D) + lane;
#pragma unroll
            for (int j = 0; j < 4; ++j) { const f32x4 v = xr[64 * j]; const f32x4 g = ((const f32x4*)gn)[64 * j + lane]; u32x2 w; w.x = pk2(v.x * rs * g.x, v.y * rs * g.y); w.y = pk2(v.z * rs * g.z, v.w * rs * g.w); o[64 * j] = w; } }
        __syncthreads();
    }
}
__device__ __forceinline__ int moe_tables(Frame& F) {
    LAS int* CS = (LAS int*)(F.lds + MOE_OFF); LAS int* OFF = CS + 32; LAS unsigned char* TE = F.lds + MOE_TE;
    if (F.tid < 32) { int c = (int)__hip_atomic_load(F.ctl + CW_CNT + F.tid, RLX_AGENT); CS[F.tid] = c > CAP ? CAP : c; }
    __syncthreads();
    if (F.tid == 0) { int off = 0; for (int e = 0; e < 32; ++e) { OFF[e] = off; off += ((CS[e] + 255) >> 8) << 8; } OFF[32] = off; }
    __syncthreads();
    const int ntiles = OFF[32] >> 8;
    for (int t = F.tid; t < ntiles; t += 512) { int e = 0; while (e < 31 && OFF[e + 1] <= t * 256) ++e; TE[t] = (unsigned char)e; }
    __syncthreads();
    return ntiles;
}
__device__ __forceinline__ void p5b_gather(Frame& F) {
    const int ntiles = moe_tables(F);
    LAS int* CS = (LAS int*)(F.lds + MOE_OFF); LAS int* OFF = CS + 32; LAS unsigned char* TE = F.lds + MOE_TE;
    const int* LIST = WSP(int, WS_LIST); const bf16* HN = WSP(bf16, WS_HN); bf16* XS = WSP(bf16, WS_XS); int* RS = WSP(int, WS_ROWSLOT);
    const int gw = F.vcu * 8 + F.wave, NGW = F.G * 8, lane = F.lane;
    for (int rho = gw; rho < ntiles * 256; rho += NGW) {
        const int e = TE[rho >> 8], r = rho - OFF[e];
        if (r < CS[e]) { const int slot = LIST[(size_t)e * CAP + r]; const u32x4* src = (const u32x4*)(HN + (size_t)(slot >> 2) * D); u32x4* dst = (u32x4*)(XS + (size_t)rho * D);
            const u32x4 a = src[lane], b2 = src[64 + lane]; dst[lane] = a; dst[64 + lane] = b2; if (lane == 0) RS[rho] = slot; }
        else if (lane == 0) RS[rho] = -1;
    }
}
__device__ __forceinline__ void p8_combine(Frame& F) {
    float* X1 = WSP(float, WS_X1); const bf16* YBF = WSP(bf16, WS_YBUF); bf16* X2B = WSP(bf16, WS_X2B); float* R2 = WSP(float, WS_RSTD2); float* RSS = WSP(float, WS_ROWSS);
    const int gw = F.vcu * 8 + F.wave, NGW = F.G * 8, lane = F.lane;
    for (int t = gw; t < M; t += NGW) {
        f32x4* xr = (f32x4*)(X1 + (size_t)t * D) + lane; f32x4 v[4]; float s = 0.f;
#pragma unroll
        for (int j = 0; j < 4; ++j) v[j] = xr[64 * j];
#pragma unroll
        for (int k = 0; k < 4; ++k) { const u32x2* yr = (const u32x2*)(YBF + (size_t)(4 * t + k) * D) + lane;
#pragma unroll
            for (int j = 0; j < 4; ++j) { const u32x2 w = yr[64 * j]; v[j].x += bflo(w.x); v[j].y += bfhi(w.x); v[j].z += bflo(w.y); v[j].w += bfhi(w.y); } }
        u32x2* o = (u32x2*)(X2B + (size_t)t * D) + lane;
#pragma unroll
        for (int j = 0; j < 4; ++j) { s += (v[j].x * v[j].x + v[j].y * v[j].y) + (v[j].z * v[j].z + v[j].w * v[j].w); xr[64 * j] = v[j]; u32x2 w; w.x = pk2(v[j].x, v[j].y); w.y = pk2(v[j].z, v[j].w); o[64 * j] = w; }
        s = wave_sum(s);
        if (lane == 0) { R2[t] = 1.0f / sqrtf(s * (1.f / D) + RMS_EPS); RSS[t] = 0.f; }
    }
}
__device__ __forceinline__ void p10_final(const Args& args, Frame& F) {
    const float* RSS = WSP(float, WS_ROWSS); const float* fg = FIN(28);
    const int gw = F.vcu * 8 + F.wave, NGW = F.G * 8, lane = F.lane;
    f32x4 g[4];
#pragma unroll
    for (int j = 0; j < 4; ++j) g[j] = ((const f32x4*)fg)[64 * j + lane];
    for (int t = gw; t < M; t += NGW) {
        f32x4* xr = (f32x4*)(F.out + (size_t)t * D) + lane; const float rs = 1.0f / sqrtf(RSS[t] * (1.f / D) + RMS_EPS);
#pragma unroll
        for (int j = 0; j < 4; ++j) { f32x4 v = xr[64 * j]; v = v * rs * g[j]; xr[64 * j] = v; }
    }
}

constexpr int NPHASE = 13;
__global__ void __launch_bounds__(512, 2) mega_fwd(Args args) {
    extern __shared__ __attribute__((aligned(16))) unsigned char lds[];
    Frame F;
    F.lds = (LAS unsigned char*)lds;
    F.wave = __builtin_amdgcn_readfirstlane((int)threadIdx.x >> 6); F.lane = lane_now(); F.tid = F.wave * 64 + F.lane;
    F.G = gridDim.x; { const int bx = blockIdx.x; F.vcu = (F.G % 8 == 0) ? (bx % 8) * (F.G / 8) + bx / 8 : bx; }
    F.ws = args.ws; F.ctl = (unsigned*)(args.ws + WS_CTL); F.out = args.out;
    volatile LAS unsigned* MISC = (volatile LAS unsigned*)(F.lds + LDSCTL_OFF);
    if (F.tid < 64) MISC[F.tid] = 0u;
    __syncthreads();
    const int lo = args.ph_lo, hi = args.ph_hi;
    XcdBarrier bar; bar.bar = F.ctl + CW_BAR; bar.x = 0; bar.st = nullptr;
    if (hi - lo > 1) bar = xcd_barrier_post(F.ctl + CW_BAR, MISC + 8, F.tid);
#ifndef PH_MASK
#define PH_MASK 0xFFFF
#endif
#define IN(k) ((((PH_MASK) >> (k)) & 1) && lo <= (k) && (k) < hi)
#define SEAM(k) do { if (IN(k) && IN((k) + 1)) xcd_barrier(bar, F.wave); F.lane = lane_now(); F.tid = F.wave * 64 + F.lane; } while (0)
    LAS unsigned char* ring = F.lds;

    if (IN(0)) { p0_prologue(args, F); } SEAM(0);

    if (IN(1)) {
        pg8::Gemm g{WSP(bf16, WS_XB), WSP(bf16, WS_WIN), M, INC, D, 0}; pg8::StaticOrder S; S.init(M, INC, F.G, (int)blockIdx.x);
        EpiG1 E{WSP(float, WS_RSTD0), WSP(bf16, WS_Q), WSP(bf16, WS_K), WSP(bf16, WS_VT), WSP(bf16, WS_ZR), WSP(bf16, WS_GT)};
        pg8::gemm_phase(ring, g, S, E, F.wave);
    } SEAM(1);

    if (IN(2)) {
        for (int c = blockIdx.x; c < 256; c += F.G) {
            const int x = c & 7, y = c >> 3; pg8::LoraOrder S; S.half = y & 1; S.pm = x + 8 * (y >> 1); S.nu = 3 + (F.G >> 30);
            build_alora(args, F, S.pm);
            asm volatile("s_waitcnt vmcnt(0)" ::: "memory"); __syncthreads();
            pg8::Gemm g{WSP(bf16, WS_ALORA), WSP(bf16, WS_WL), M, LORA_N, LORA_K, 0};
            EpiLora E{FIN(5), FIN(7), WSP(float, WS_DEC), WSP(float, WS_AA), WSP(bf16, WS_GG)};
            pg8::gemm_phase(ring, g, S, E, F.wave);
        }
    } SEAM(2);

    if (IN(3)) {
        for (int u = blockIdx.x; u < 256; u += F.G) {
            if (u < 128) scan_unit(args, F, u);
            else { const int bh = u - 128; for (int i = 0; i < 8; ++i) attn_tile(F, bh, F.wave + 8 * i); }
        }
    } SEAM(3);

    if (IN(4)) {
        pg8::StaticOrder S; S.init(M, D, F.G, (int)blockIdx.x);
        { pg8::Gemm g{WSP(bf16, WS_YA), WSP(bf16, WS_WA), M, D, AW, 0}; EpiMerge<0> E{WSP(bf16, WS_GT), WSP(bf16, WS_MERGED)}; pg8::gemm_phase(ring, g, S, E, F.wave); }
        { pg8::Gemm g{WSP(bf16, WS_YB), WSP(bf16, WS_WB), M, D, RW, 0}; EpiMerge<1> E{WSP(bf16, WS_GT), WSP(bf16, WS_MERGED)}; pg8::gemm_phase(ring, g, S, E, F.wave); }
    } SEAM(4);

    if (IN(5)) {
        pg8::Gemm g{WSP(bf16, WS_MERGED), WSP(bf16, WS_WO), M, D, D, 0}; pg8::StaticOrder S; S.init(M, D, F.G, (int)blockIdx.x);
        EpiX1 E{FIN(0), WSP(float, WS_X1)};
        pg8::gemm_phase(ring, g, S, E, F.wave);
    } SEAM(5);

    if (IN(6)) { p5a_router(args, F); } SEAM(6);
    if (IN(7)) { p5b_gather(F); } SEAM(7);

    if (IN(8)) {
        const int ntiles = moe_tables(F);
        pg8::Gemm g{WSP(bf16, WS_XS), WSP(bf16, WS_W1), MAXROWS, F2, D, (size_t)F2 * D * 2};
        pg8::MoeOrder S{ntiles, F2 / 256, F.G, (int)blockIdx.x, F.lds + MOE_TE};
        EpiSwiglu E{FIN(22), WSP(bf16, WS_ACT)};
        pg8::gemm_phase(ring, g, S, E, F.wave);
    } SEAM(8);

    if (IN(9)) {
        const int ntiles = moe_tables(F);
        pg8::Gemm g{WSP(bf16, WS_ACT), WSP(bf16, WS_W2), MAXROWS, D, FH, (size_t)D * FH * 2};
        pg8::MoeOrder S{ntiles, D / 256, F.G, (int)blockIdx.x, F.lds + MOE_TE};
        EpiY E{FIN(24), WSP(int, WS_ROWSLOT), WSP(float, WS_GATEW), WSP(bf16, WS_YBUF)};
        pg8::gemm_phase(ring, g, S, E, F.wave);
    } SEAM(9);

    if (IN(10)) { p8_combine(F); } SEAM(10);

    if (IN(11)) {
        pg8::StaticOrder S; S.init(M, D, F.G, (int)blockIdx.x);
        { pg8::Gemm g{WSP(bf16, WS_PB), WSP(bf16, WS_WP), M, D, PLE, 0}; EpiProj E{F.out}; pg8::gemm_phase(ring, g, S, E, F.wave); }
        { pg8::Gemm g{WSP(bf16, WS_X2B), WSP(bf16, WS_WG), M, D, D, 0}; EpiPle E{WSP(float, WS_X1), WSP(float, WS_RSTD2), F.out, WSP(float, WS_ROWSS)}; pg8::gemm_phase(ring, g, S, E, F.wave); }
    } SEAM(11);

    if (IN(12)) { p10_final(args, F); }
#undef IN
#undef SEAM
}

extern "C" void kernel_launch(void* const* d_in, const int* in_sizes, int n_in, void* d_out, int out_size, void* d_ws, size_t ws_size, hipStream_t stream) {
    static int grid = 0;
    if (grid == 0) {
        if (n_in != 29 || in_sizes[0] != M * D || out_size != M * D || ws_size < WS_END) {
            fprintf(stderr, "kernel_launch: unexpected shapes (n_in %d, in0 %d, out %d, ws %zu < %zu); nothing launched\n", n_in, n_in > 0 ? in_sizes[0] : -1, out_size, ws_size, (size_t)WS_END); grid = -1; return; }
        int dev = 0, cus = 0, per_cu = 0;
        if (hipGetDevice(&dev) != hipSuccess || hipDeviceGetAttribute(&cus, hipDeviceAttributeMultiprocessorCount, dev) != hipSuccess) { grid = -1; return; }
        if (hipFuncSetAttribute((const void*)mega_fwd, hipFuncAttributeMaxDynamicSharedMemorySize, LDS_BYTES) != hipSuccess) { fprintf(stderr, "kernel_launch: hipFuncSetAttribute failed\n"); grid = -1; return; }
        if (hipOccupancyMaxActiveBlocksPerMultiprocessor(&per_cu, (const void*)mega_fwd, 512, LDS_BYTES) != hipSuccess || per_cu < 1) { fprintf(stderr, "kernel_launch: occupancy query says %d blocks/CU\n", per_cu); }
        (void)hipGetLastError();
        grid = cus;
    }
    if (grid < 0) return;
    (void)hipMemsetAsync((char*)d_ws + WS_CTL, 0, CTL_ZERO_BYTES, stream);
    Args a{};
    for (int i = 0; i < 29; ++i) a.in[i] = (const float*)d_in[i];
    a.out = (float*)d_out; a.ws = (unsigned char*)d_ws;
#if MK_PER_PHASE
    for (int p = 0; p < NPHASE; ++p) { a.ph_lo = p; a.ph_hi = p + 1; hipLaunchKernelGGL(mega_fwd, dim3(grid), dim3(512), LDS_BYTES, stream, a); }
#else
    a.ph_lo = 0; a.ph_hi = NPHASE; hipLaunchKernelGGL(mega_fwd, dim3(grid), dim3(512), LDS_BYTES, stream, a);
#endif
}
```

```cpp
#include <hip/hip_runtime.h>
#include <cstdio>
#include <cstdint>

#ifndef P3_ONLY
#define P3_ONLY 0
#endif
#ifndef SCAN_STUB
#define SCAN_STUB 0
#endif
#ifndef TS_PROBE
#define TS_PROBE -1
#endif
#ifndef MK_PER_PHASE
#define MK_PER_PHASE 0
#endif

#define LAS __attribute__((address_space(3)))
#define GAS __attribute__((address_space(1)))
typedef unsigned short bf16;
typedef short bf16x8 __attribute__((ext_vector_type(8)));
typedef float f32x2 __attribute__((ext_vector_type(2)));
typedef float f32x4 __attribute__((ext_vector_type(4)));
typedef float f32x16 __attribute__((ext_vector_type(16)));
typedef unsigned u32x2 __attribute__((ext_vector_type(2)));
typedef unsigned u32x4 __attribute__((ext_vector_type(4)));
typedef __bf16 bf16x2_t __attribute__((ext_vector_type(2)));

constexpr int NB = 16, SEQ = 2048, D = 1024, M = NB * SEQ;
constexpr int NH = 8, HD = 64, AW = 512, RW = 512, RWC = 1792, INC = 5376;
constexpr int NE = 32, FH = 1024, F2 = 2048, PLE = 256, TOPK = 4;
constexpr int LORA_K = 256, LORA_N = 1536;
constexpr int CAP = 32768;
constexpr int MAXROWS = M * TOPK + NE * 256;
constexpr float RMS_EPS = 1e-5f, GN_EPS = 64e-5f;

constexpr size_t MiB = 1u << 20;
constexpr size_t WS_CTL = 0, CTL_ZERO_BYTES = 1 * MiB;
constexpr size_t WS_WIN = 1 * MiB;
constexpr size_t WS_WA = 12 * MiB, WS_WB = 13 * MiB, WS_WO = 14 * MiB, WS_WG = 16 * MiB, WS_WP = 18 * MiB;
constexpr size_t WS_WL = 18 * MiB + 512 * 1024;
constexpr size_t WS_GW = 19 * MiB + 256 * 1024;
constexpr size_t WS_W1 = 20 * MiB;
constexpr size_t WS_W2 = 148 * MiB;
constexpr size_t WS_PB = 212 * MiB;
constexpr size_t WS_RSTD0 = 228 * MiB, WS_RSTD2 = WS_RSTD0 + 128 * 1024, WS_ROWSS = WS_RSTD0 + 256 * 1024;
constexpr size_t WS_GATEW = WS_RSTD0 + 512 * 1024;
constexpr size_t WS_ROWSLOT = 229 * MiB;
constexpr size_t WS_LIST = 230 * MiB;
constexpr size_t WS_X1 = 236 * MiB;
constexpr size_t WS_YA = 236 * MiB, WS_YB = 268 * MiB, WS_ALORA = 300 * MiB;
constexpr size_t WS_GT = 364 * MiB;
constexpr size_t WS_Q = 492 * MiB, WS_K = 524 * MiB, WS_VT = 556 * MiB;
constexpr size_t WS_ZR = 588 * MiB;
constexpr size_t WS_XB = 700 * MiB;
constexpr size_t WS_DEC = 764 * MiB, WS_AA = 828 * MiB, WS_GG = 892 * MiB;
constexpr size_t WS_MERGED = 492 * MiB;
constexpr size_t WS_XS = 364 * MiB;
constexpr size_t WS_ACT = 636 * MiB;
constexpr size_t WS_HN = 636 * MiB;
constexpr size_t WS_YBUF = 364 * MiB;
constexpr size_t WS_X2B = 636 * MiB;
constexpr size_t WS_END = 924 * MiB;
constexpr int CW_CNT = 64;
constexpr int CW_BAR = 4096;

constexpr int RING_BYTES = 131072;
constexpr int LDSCTL_OFF = RING_BYTES;
constexpr int MOE_OFF = RING_BYTES + 1024;
constexpr int MOE_TE = RING_BYTES + 2048;
constexpr int LDS_BYTES = 147456;

#define RLX_AGENT __ATOMIC_RELAXED, __HIP_MEMORY_SCOPE_AGENT
__device__ __forceinline__ unsigned pk2(float lo, float hi) { f32x2 v = {lo, hi}; bf16x2_t b = __builtin_convertvector(v, bf16x2_t); return __builtin_bit_cast(unsigned, b); }
__device__ __forceinline__ float bflo(unsigned u) { return __uint_as_float(u << 16); }
__device__ __forceinline__ float bfhi(unsigned u) { return __uint_as_float(u & 0xffff0000u); }
__device__ __forceinline__ float sigm(float x) { return __builtin_amdgcn_rcpf(1.f + __expf(-x)); }
__device__ __forceinline__ float wave_sum(float v) {
#pragma unroll
    for (int o = 1; o < 64; o <<= 1) v += __shfl_xor(v, o);
    return v;
}
template <int CTRL> __device__ __forceinline__ float dppf(float v) { return __builtin_bit_cast(float, __builtin_amdgcn_update_dpp(0, __builtin_bit_cast(int, v), CTRL, 0xF, 0xF, true)); }
__device__ __forceinline__ float red8(float v) { v += dppf<0xB1>(v); v += dppf<0x4E>(v); v += dppf<0x141>(v); return v; }
__device__ __forceinline__ int lane_now() { int l; asm volatile("v_mbcnt_lo_u32_b32 %0, -1, 0\n\tv_mbcnt_hi_u32_b32 %0, -1, %0" : "=v"(l)); return l; }
__device__ __forceinline__ int crow(int r, int hi) { return (r & 3) + 8 * (r >> 2) + 4 * hi; }

namespace pg8 {
#define PG8_LAS __attribute__((address_space(3)))
typedef unsigned short bf16_t;
constexpr int BM = 256, BK = 64, HALF = 128, HTB = HALF * BK * 2, STAGE_BYTES = 8 * HTB, NXCD = 8, WGM = 8;
__host__ __device__ __forceinline__ int lds_byte(int r, int c) { const int st = (r >> 4) * 2 + (c >> 5), rr = r & 15, cc = c & 31, ob = rr * 64 + cc * 2; return st * 1024 + (ob ^ (((ob >> 9) & 1) << 5)); }
__host__ __device__ __forceinline__ void stage_rc(int b, int& R, int& C) { const int st = b / 1024, sb = b % 1024, swz = sb ^ (((sb >> 9) & 1) << 5); R = (st >> 1) * 16 + swz / 64; C = (st & 1) * 32 + (swz % 64) / 2; }
__host__ __device__ __forceinline__ int perm32(int rho) { const int n = rho >> 4, i = rho & 15; return 8 * (i >> 2) + 4 * n + (i & 3); }

struct Unit { int pm, pn, e; };
struct Gemm { const bf16_t* A; const bf16_t* Bt; int M, N, K; size_t bsel_bytes; };

struct StaticOrder {
    int nM, nN, nwg, G, c;
    __device__ void init(int M_, int N_, int G_, int c_) { nM = M_ / BM; nN = N_ / BM; nwg = nM * nN; G = G_; c = c_; }
    __device__ bool next(int i, Unit& u) const {
        const long L = (long)i * G + c; if (L >= nwg) return false;
        int wgid = (int)L; { const int q = nwg / NXCD, r = nwg % NXCD, xcd = wgid % NXCD, off = wgid / NXCD; wgid = (xcd < r ? xcd * (q + 1) : r * (q + 1) + (xcd - r) * q) + off; }
        const int nig = WGM * nN, gid = wgid / nig, fm = gid * WGM, gsz = (nM - fm) < WGM ? (nM - fm) : WGM;
        u.pm = fm + ((wgid % nig) % gsz); u.pn = (wgid % nig) / gsz; u.e = 0; return true;
    }
};
struct LoraOrder {
    int pm, half, nu;
    __device__ bool next(int i, Unit& u) const { if (i >= nu) return false; u.pm = pm; u.pn = 3 * half + i; u.e = 0; return true; }
};
struct MoeOrder {
    int ntiles, npn, G, c; const PG8_LAS unsigned char* te;
    __device__ bool next(int i, Unit& u) const {
        const long L = (long)i * G + c; if (L >= (long)ntiles * npn) return false;
        const int rt = (int)(L / npn); u.pm = rt; u.pn = (int)(L % npn); u.e = te[rt]; return true;
    }
};

template <class Epi, class Sched>
__device__ __forceinline__ void gemm_phase(PG8_LAS unsigned char* lds, const Gemm g, const Sched& S, const Epi& E, const int wid) {
    const int lane = lane_now(), tid = wid * 64 + lane,
              wr = wid >> 2, wc = wid & 3, fr = lane & 15, fq = lane >> 4;
    const int K = g.K, nt = K / BK;
    unsigned voffA[2], voffB[2];
#pragma unroll
    for (int i = 0; i < 2; ++i) { int R, C; stage_rc(tid * 16 + i * 8192, R, C); const int Rb = Epi::PERM ? ((R & ~31) + perm32(R & 31)) : R;
        voffA[i] = (unsigned)(R * K + C) * 2u; voffB[i] = (unsigned)(Rb * K + C) * 2u; }
    const size_t kstep = (size_t)(BK * 2);
    const size_t hstep = (size_t)HALF * K * 2;
    const size_t tstep = 2 * hstep;
    const unsigned ldsw = (unsigned)wid * 1024u;
    const int aoff = lds_byte(wr * 64 + fr, fq * 8), boff = lds_byte(wc * 32 + fr, fq * 8);
#define PG8_SA(b, h) (((b) * 2 + (h)) * HTB)
#define PG8_SB(b, h) ((4 + (b) * 2 + (h)) * HTB)
#define PG8_STAGE(bufoff, gbase, voff) do { _Pragma("unroll") for (int _i = 0; _i < 2; ++_i) \
        __builtin_amdgcn_global_load_lds((const unsigned*)((const char*)(gbase) + (voff)[_i]), (PG8_LAS unsigned*)(lds + (bufoff) + ldsw + _i * 8192), 16, 0, 0); } while (0)
#define PG8_LDA(dst, b, h) do { _Pragma("unroll") for (int m = 0; m < 4; ++m) _Pragma("unroll") for (int k = 0; k < 2; ++k) dst[m][k] = *(const PG8_LAS bf16x8*)(lds + PG8_SA(b, h) + aoff + m * 2048 + k * 1024); } while (0)
#define PG8_LDB(dst, b, h) do { _Pragma("unroll") for (int n = 0; n < 2; ++n) _Pragma("unroll") for (int k = 0; k < 2; ++k) dst[n][k] = *(const PG8_LAS bf16x8*)(lds + PG8_SB(b, h) + boff + n * 2048 + k * 1024); } while (0)
#define PG8_MMA(ai, bj, At, Bt) do { __builtin_amdgcn_s_setprio(1); _Pragma("unroll") for (int m = 0; m < 4; ++m) _Pragma("unroll") for (int n = 0; n < 2; ++n) _Pragma("unroll") for (int k = 0; k < 2; ++k) \
        acc[ai][bj][m][n] = __builtin_amdgcn_mfma_f32_16x16x32_bf16(Bt[n][k], At[m][k], acc[ai][bj][m][n], 0, 0, 0); __builtin_amdgcn_s_setprio(0); } while (0)
#define PG8_WAIT_V(n) asm volatile("s_waitcnt vmcnt(" #n ")" ::: "memory")
#define PG8_WAIT_L(n) asm volatile("s_waitcnt lgkmcnt(" #n ")" ::: "memory")
#define PG8_BAR __builtin_amdgcn_s_barrier()
#define PG8_SCHED __builtin_amdgcn_sched_barrier(0)
    Unit cur, nxt; int ui = 0;
    if (!S.next(0, cur)) return;
    f32x4 acc[2][2][4][2];
#pragma unroll
    for (int a = 0; a < 2; ++a)
#pragma unroll
        for (int b = 0; b < 2; ++b)
#pragma unroll
            for (int m = 0; m < 4; ++m)
#pragma unroll
                for (int n = 0; n < 2; ++n) acc[a][b][m][n] = (f32x4){0.f, 0.f, 0.f, 0.f};
    bf16x8 At[4][2], B0[2][2], B1[2][2];
    const char* cA = (const char*)g.A + (size_t)cur.pm * tstep; const char* cB = (const char*)g.Bt + (size_t)cur.e * g.bsel_bytes + (size_t)cur.pn * tstep;
    PG8_STAGE(PG8_SB(0, 0), cB, voffB); PG8_STAGE(PG8_SB(0, 1), cB + hstep, voffB); PG8_STAGE(PG8_SA(0, 0), cA, voffA); PG8_STAGE(PG8_SA(0, 1), cA + hstep, voffA);
    if (wr == 1) PG8_BAR;
    PG8_WAIT_V(2); PG8_BAR;
    PG8_STAGE(PG8_SB(1, 0), cB + kstep, voffB); PG8_STAGE(PG8_SA(1, 0), cA + kstep, voffA); PG8_STAGE(PG8_SB(1, 1), cB + hstep + kstep, voffB);
    PG8_WAIT_V(6); PG8_BAR;
    for (;;) {
        const bool has_next = S.next(ui + 1, nxt);
        const char* nA = has_next ? (const char*)g.A + (size_t)nxt.pm * tstep : cA;
        const char* nB = has_next ? (const char*)g.Bt + (size_t)nxt.e * g.bsel_bytes + (size_t)nxt.pn * tstep : cB;
        for (int t = 0; t < nt; t += 2) {
            const bool last = (t == nt - 2);
            const char* a1 = cA + (size_t)(t + 1) * kstep;
            const char* a2 = last ? nA : cA + (size_t)(t + 2) * kstep; const char* b2 = last ? nB : cB + (size_t)(t + 2) * kstep;
            const char* a3 = a2 + kstep; const char* b3 = b2 + kstep;
            PG8_LDB(B0, 0, 0); PG8_LDB(B1, 0, 1); PG8_SCHED; PG8_LDA(At, 0, 0); PG8_STAGE(PG8_SA(1, 1), a1 + hstep, voffA);
            PG8_WAIT_V(8); PG8_WAIT_L(0); PG8_BAR; PG8_MMA(0, 0, At, B0); PG8_MMA(0, 1, At, B1); PG8_BAR; PG8_SCHED;
            PG8_LDA(At, 0, 1); PG8_STAGE(PG8_SB(0, 0), b2, voffB); PG8_STAGE(PG8_SB(0, 1), b2 + hstep, voffB); PG8_STAGE(PG8_SA(0, 0), a2, voffA);
            PG8_WAIT_V(8); PG8_WAIT_L(0); PG8_BAR; PG8_MMA(1, 0, At, B0); PG8_MMA(1, 1, At, B1); PG8_BAR; PG8_SCHED;
            PG8_LDB(B0, 1, 0); PG8_LDB(B1, 1, 1); PG8_SCHED; PG8_LDA(At, 1, 0); PG8_STAGE(PG8_SA(0, 1), a2 + hstep, voffA);
            PG8_WAIT_V(8); PG8_WAIT_L(0); PG8_BAR; PG8_MMA(0, 0, At, B0); PG8_MMA(0, 1, At, B1); PG8_BAR; PG8_SCHED;
            PG8_LDA(At, 1, 1); PG8_STAGE(PG8_SB(1, 0), b3, voffB); PG8_STAGE(PG8_SB(1, 1), b3 + hstep, voffB); PG8_STAGE(PG8_SA(1, 0), a3, voffA);
            PG8_WAIT_V(8); PG8_WAIT_L(0); PG8_BAR; PG8_MMA(1, 0, At, B0); PG8_MMA(1, 1, At, B1); PG8_BAR; PG8_SCHED;
        }
        if (wr == 0) PG8_BAR;
        E(acc, cur, wr, wc, fr, fq);
        if (!has_next) break;
#pragma unroll
        for (int a = 0; a < 2; ++a)
#pragma unroll
            for (int b = 0; b < 2; ++b)
#pragma unroll
                for (int m = 0; m < 4; ++m)
#pragma unroll
                    for (int n = 0; n < 2; ++n) acc[a][b][m][n] = (f32x4){0.f, 0.f, 0.f, 0.f};
        cur = nxt; cA = nA; cB = nB; ++ui;
        if (wr == 1) PG8_BAR;
    }
    PG8_WAIT_V(0);
    PG8_BAR;
#undef PG8_SA
#undef PG8_SB
#undef PG8_STAGE
#undef PG8_LDA
#undef PG8_LDB
#undef PG8_MMA
#undef PG8_WAIT_V
#undef PG8_WAIT_L
#undef PG8_BAR
#undef PG8_SCHED
}
}
using pg8::Unit;
typedef const f32x4 (&AccRef)[2][2][4][2];

#define XB_TMO      128
#define XB_XCNT(j)  (256  + 64 * (j))
#define XB_XSUB(j)  (1280 + 64 * (j))
#define XB_XGEN(j)  (2304 + 64 * (j))
#define XB_TOP      3328
#define XB_TOPGEN   3392
#define XCD_BAR_WORDS 3456
#define XB_SPIN_CAP (1u << 22)
__device__ __forceinline__ unsigned xb_ld(unsigned* p)              { return __hip_atomic_load(p, __ATOMIC_RELAXED, __HIP_MEMORY_SCOPE_AGENT); }
__device__ __forceinline__ unsigned xb_add(unsigned* p, unsigned v) { return __hip_atomic_fetch_add(p, v, __ATOMIC_RELAXED, __HIP_MEMORY_SCOPE_AGENT); }
__device__ __forceinline__ unsigned xb_xcc_id() { return (unsigned)__builtin_amdgcn_s_getreg((3 << 11) | 20) & 0xFu; }
#define XB_SPIN(cond, bar) do { unsigned _sp = 0; while (cond) { __builtin_amdgcn_s_sleep(1); \
    if ((++_sp & 255u) == 0u) { if (xb_ld(&(bar)[XB_TMO])) break; if (_sp > XB_SPIN_CAP) { atomicAdd(&(bar)[XB_TMO], 1u); break; } } } } while (0)
struct XcdBarrier { unsigned* bar; unsigned x; volatile LAS unsigned* st; };
__device__ __forceinline__ XcdBarrier xcd_barrier_post(unsigned* bar, volatile LAS unsigned* st, int tid) {
    XcdBarrier b; b.bar = bar; b.x = xb_xcc_id(); b.st = st;
    if (tid == 0) (void)xb_add(&bar[XB_XCNT(b.x)], 1u);
    return b;
}
__device__ __forceinline__ void xcd_barrier_complete(unsigned* bar, unsigned x, unsigned& nloc, unsigned& nx) {
    const unsigned G = gridDim.x * gridDim.y * gridDim.z;
    unsigned sum, cnt, mine, sp = 0u;
    for (;;) {
        sum = 0u; cnt = 0u; mine = 0u;
#pragma unroll
        for (unsigned j = 0; j < 16; ++j) { const unsigned c = xb_ld(&bar[XB_XCNT(j)]); sum += c; cnt += (c > 0u) ? 1u : 0u; mine = (j == x) ? c : mine; }
        if (sum == G) break;
        __builtin_amdgcn_s_sleep(1);
        if ((++sp & 255u) == 0u) { if (xb_ld(&bar[XB_TMO])) break; if (sp > XB_SPIN_CAP) { atomicAdd(&bar[XB_TMO], 1u); break; } }
    }
    nloc = mine > 0u ? mine : 1u; nx = cnt > 0u ? cnt : 1u;
}
__device__ __forceinline__ void xcd_barrier(const XcdBarrier& b, int wave) {
    asm volatile("s_waitcnt vmcnt(0)" ::: "memory");
    __syncthreads();
    if (wave == 0 && lane_now() == 0) {
        unsigned* bar = b.bar;
        __builtin_amdgcn_s_waitcnt(0);
        unsigned nloc = b.st[0], nx = b.st[1];
        if (nloc == 0u) { xcd_barrier_complete(bar, b.x, nloc, nx); b.st[0] = nloc; b.st[1] = nx; }
        const unsigned old = xb_add(&bar[XB_XSUB(b.x)], 1u);
        const unsigned gen = old / nloc;
        if (old + 1u == (gen + 1u) * nloc) {
            __builtin_amdgcn_fence(__ATOMIC_RELEASE, "agent");
            asm volatile("s_waitcnt vmcnt(0)" ::: "memory");
            const unsigned og = xb_add(&bar[XB_TOP], 1u);
            const unsigned tg = og / nx;
            if (og + 1u == (tg + 1u) * nx) xb_add(&bar[XB_TOPGEN], 1u);
            else XB_SPIN(xb_ld(&bar[XB_TOPGEN]) == tg, bar);
            __builtin_amdgcn_fence(__ATOMIC_ACQUIRE, "agent");
            xb_add(&bar[XB_XGEN(b.x)], 1u);
            asm volatile("s_waitcnt vmcnt(0)" ::: "memory");
        } else {
            XB_SPIN(xb_ld(&bar[XB_XGEN(b.x)]) == gen, bar);
            __builtin_amdgcn_fence(__ATOMIC_ACQUIRE, "agent");
            asm volatile("s_waitcnt vmcnt(0)" ::: "memory");
        }
    }
    __syncthreads();
}

struct Frame {
    LAS unsigned char* lds;
    unsigned* ctl;
    int tid, lane, wave, vcu, G;
    unsigned char* ws;
    float* out;
};
#define WSP(T, off) ((T*)(F.ws + (off)))
struct Args { const float* in[29]; float* out; unsigned char* ws; int ph_lo, ph_hi; };
#define FIN(i) (args.in[i])

__device__ __forceinline__ void p0_transpose_item(const float* W, int K, int N, bf16* WT, LAS float* scr, int item, int lane, const float* kscale) {
    const int nblk = N / 32, kb = item / nblk, nb = item % nblk, k0 = 64 * kb, n0 = 32 * nb;
#pragma unroll 8
    for (int i = 0; i < 32; ++i) { const int kk = 2 * i + (lane >> 5); float v = W[(size_t)(k0 + kk) * N + n0 + (lane & 31)]; if (kscale) v *= kscale[k0 + kk]; scr[kk * 33 + (lane & 31)] = v; }
    asm volatile("s_waitcnt lgkmcnt(0)" ::: "memory");
    const int c = lane & 7;
#pragma unroll
    for (int j = 0; j < 4; ++j) { const int n = (lane >> 3) + 8 * j; const LAS float* s = scr + (8 * c) * 33 + n;
        u32x4 o; o.x = pk2(s[0 * 33], s[1 * 33]); o.y = pk2(s[2 * 33], s[3 * 33]); o.z = pk2(s[4 * 33], s[5 * 33]); o.w = pk2(s[6 * 33], s[7 * 33]);
        *(u32x4*)(WT + (size_t)(n0 + n) * K + k0 + 8 * c) = o; }
    asm volatile("s_waitcnt lgkmcnt(0)" ::: "memory");
}
__device__ __forceinline__ void p0_prologue(const Args& args, Frame& F) {
    LAS float* scr = (LAS float*)(F.lds + F.wave * 16384);
    const int gw = F.vcu * 8 + F.wave, NGW = F.G * 8, lane = F.lane;
    constexpr int I_IN = (D / 64) * (INC / 32), I_A = (AW / 64) * (D / 32), I_O = (D / 64) * (D / 32), I_P = (PLE / 64) * (D / 32);
    constexpr int I_W1 = (D / 64) * (F2 / 32), I_W2 = (FH / 64) * (D / 32);
    constexpr int NITEMS = I_IN + 2 * I_A + 2 * I_O + I_P;
    for (int it = gw; it < NITEMS; it += NGW) {
        int r = it;
        if (r < I_IN) { p0_transpose_item(FIN(3), D, INC, WSP(bf16, WS_WIN), scr, r, lane, FIN(2)); continue; } r -= I_IN;
        if (r < I_A) { p0_transpose_item(FIN(15), AW, D, WSP(bf16, WS_WA), scr, r, lane, nullptr); continue; } r -= I_A;
        if (r < I_A) { p0_transpose_item(FIN(16), RW, D, WSP(bf16, WS_WB), scr, r, lane, nullptr); continue; } r -= I_A;
        if (r < I_O) { p0_transpose_item(FIN(17), D, D, WSP(bf16, WS_WO), scr, r, lane, nullptr); continue; } r -= I_O;
        if (r < I_O) { p0_transpose_item(FIN(26), D, D, WSP(bf16, WS_WG), scr, r, lane, FIN(25)); continue; } r -= I_O;
        p0_transpose_item(FIN(27), PLE, D, WSP(bf16, WS_WP), scr, r, lane, nullptr);
    }
    { const int gt = (F.vcu * 512 + F.tid), NT = F.G * 512;
      bf16* WL = WSP(bf16, WS_WL);
      for (int i = gt; i < LORA_N * LORA_K; i += NT) { const int n = i >> 8, k = i & 255; float v = 0.f;
          if (n < 512) { if (k < 64) v = FIN(6)[k * 512 + n]; }
          else if (n < 1024) { if (k >= 64 && k < 128) v = FIN(8)[(k - 64) * 512 + (n - 512)]; }
          else { if (k >= 128) v = FIN(9)[(k - 128) * 512 + (n - 1024)]; }
          WL[i] = (bf16)(pk2(v, 0.f) & 0xffffu); }
      float* GW = WSP(float, WS_GW);
      for (int i = gt; i < D * NE; i += NT) GW[i] = FIN(19)[i] * FIN(18)[i >> 5];
    }
    { bf16* XB = WSP(bf16, WS_XB); float* R0 = WSP(float, WS_RSTD0); bf16* PB = WSP(bf16, WS_PB);
      for (int m = gw; m < M; m += NGW) {
          const f32x4* xr = (const f32x4*)(FIN(0) + (size_t)m * D) + lane;
          f32x4 v[4]; float s = 0.f;
#pragma unroll
          for (int j = 0; j < 4; ++j) { v[j] = xr[64 * j]; s += (v[j].x * v[j].x + v[j].y * v[j].y) + (v[j].z * v[j].z + v[j].w * v[j].w); }
          s = wave_sum(s);
          u32x2* o = (u32x2*)(XB + (size_t)m * D) + lane;
#pragma unroll
          for (int j = 0; j < 4; ++j) { u32x2 w; w.x = pk2(v[j].x, v[j].y); w.y = pk2(v[j].z, v[j].w); o[64 * j] = w; }
          if (lane == 0) R0[m] = 1.0f / sqrtf(s * (1.f / D) + RMS_EPS);
          const f32x4 pv = ((const f32x4*)(FIN(1) + (size_t)m * PLE))[lane];
          u32x2 w; w.x = pk2(pv.x, pv.y); w.y = pk2(pv.z, pv.w); ((u32x2*)(PB + (size_t)m * PLE))[lane] = w;
      }
    }
}

__device__ __forceinline__ void expert_convert(const Args& args, Frame& F, int wv, int NW) {
    LAS float* scr = (LAS float*)(F.lds + F.wave * 16384);
    constexpr int I_W1 = (D / 64) * (F2 / 32), I_W2 = (FH / 64) * (D / 32);
    for (int it = wv; it < NE * (I_W1 + I_W2); it += NW) {
        int r = it;
        if (r < NE * I_W1) { const int e = r / I_W1; p0_transpose_item(FIN(21) + (size_t)e * D * F2, D, F2, WSP(bf16, WS_W1) + (size_t)e * F2 * D, scr, r % I_W1, F.lane, nullptr); continue; } r -= NE * I_W1;
        { const int e = r / I_W2; p0_transpose_item(FIN(23) + (size_t)e * FH * D, FH, D, WSP(bf16, WS_W2) + (size_t)e * D * FH, scr, r % I_W2, F.lane, nullptr); }
    }
}
struct EpiG1 {
    static constexpr bool PERM = true;
    const float* rstd; bf16 *Q, *K, *VT, *ZR, *GT;
    __device__ __forceinline__ void operator()(AccRef acc, const Unit& u, int wr, int wc, int fr, int fq) const {
        const int pn = u.pn, rowb = u.pm * 256 + wr * 64 + fr, cl = wc * 32 + 8 * fq;
#pragma unroll
        for (int ai = 0; ai < 2; ++ai)
#pragma unroll
            for (int m = 0; m < 4; ++m) {
                const int row = rowb + ai * 128 + m * 16; const float rs = rstd[row];
                if (pn < 4) {
                    bf16* base = (pn < 2 ? Q : K) + (size_t)row * 512 + (pn & 1) * 256 + cl; const float sc = pn < 2 ? rs * 0.125f : rs;
#pragma unroll
                    for (int bj = 0; bj < 2; ++bj) { const f32x4 v0 = acc[ai][bj][m][0] * sc, v1 = acc[ai][bj][m][1] * sc;
                        u32x4 w; w.x = pk2(v0[0], v0[1]); w.y = pk2(v0[2], v0[3]); w.z = pk2(v1[0], v1[1]); w.w = pk2(v1[2], v1[3]); *(u32x4*)(base + bj * 128) = w; }
                } else if (pn < 6) {
                    const int b = row >> 11, s = row & 2047;
#pragma unroll
                    for (int bj = 0; bj < 2; ++bj)
#pragma unroll
                        for (int n = 0; n < 2; ++n)
#pragma unroll
                            for (int j = 0; j < 4; ++j) { const int c = (pn - 4) * 256 + cl + bj * 128 + 4 * n + j; const int hh = c >> 6, d = c & 63;
                                VT[((size_t)((b * 8 + hh) * 64 + d)) * SEQ + s] = (bf16)(pk2(acc[ai][bj][m][n][j] * rs, 0.f) & 0xffffu); }
                } else if (pn < 13) {
                    bf16* base = ZR + (size_t)row * RWC + (pn - 6) * 256 + cl;
#pragma unroll
                    for (int bj = 0; bj < 2; ++bj) { const f32x4 v0 = acc[ai][bj][m][0] * rs, v1 = acc[ai][bj][m][1] * rs;
                        u32x4 w; w.x = pk2(v0[0], v0[1]); w.y = pk2(v0[2], v0[3]); w.z = pk2(v1[0], v1[1]); w.w = pk2(v1[2], v1[3]); *(u32x4*)(base + bj * 128) = w; }
                } else {
                    bf16* base = GT + (size_t)row * 2048 + (pn - 13) * 256 + cl;
#pragma unroll
                    for (int bj = 0; bj < 2; ++bj) { const f32x4 v0 = acc[ai][bj][m][0] * rs, v1 = acc[ai][bj][m][1] * rs;
                        u32x4 w; w.x = pk2(sigm(v0[0]), sigm(v0[1])); w.y = pk2(sigm(v0[2]), sigm(v0[3])); w.z = pk2(sigm(v1[0]), sigm(v1[1])); w.w = pk2(sigm(v1[2]), sigm(v1[3])); *(u32x4*)(base + bj * 128) = w; }
                }
            }
    }
};
struct EpiLora {
    static constexpr bool PERM = false;
    const float *w0, *a0; float *DEC, *AA; bf16* GG;
    template <int MODE> __device__ __forceinline__ void body(AccRef acc, int rowb, int cb) const {
#pragma unroll
        for (int ai = 0; ai < 2; ++ai)
#pragma unroll
            for (int m = 0; m < 4; ++m) {
                const int row = rowb + ai * 128 + m * 16;
#pragma unroll
                for (int bj = 0; bj < 2; ++bj)
#pragma unroll
                    for (int n = 0; n < 2; ++n) {
                        const int c = cb + bj * 128 + n * 16;
                        f32x4 v = acc[ai][bj][m][n];
                        if (MODE == 0) { v = v + *(const f32x4*)(w0 + c); f32x4 o;
#pragma unroll
                            for (int j = 0; j < 4; ++j) { const float y = -v[j]; const float sp = y > 20.f ? y : __logf(1.f + __expf(y)); o[j] = __expf(-__expf(-sp - 0.5f)); }
                            *(f32x4*)(DEC + (size_t)row * 512 + c) = o;
                        } else if (MODE == 1) { v = v + *(const f32x4*)(a0 + c); f32x4 o;
#pragma unroll
                            for (int j = 0; j < 4; ++j) o[j] = sigm(v[j]);
                            *(f32x4*)(AA + (size_t)row * 512 + c) = o;
                        } else { u32x2 w; w.x = pk2(v[0], v[1]); w.y = pk2(v[2], v[3]); *(u32x2*)(GG + (size_t)row * 512 + c) = w; }
                    }
                asm volatile("" ::: "memory");
            }
    }
    __device__ __forceinline__ void operator()(AccRef acc, const Unit& u, int wr, int wc, int fr, int fq) const {
        const int pn = u.pn, rowb = u.pm * 256 + wr * 64 + fr, cb = (pn & 1) * 256 + wc * 32 + 4 * fq;
        if (pn < 2) body<0>(acc, rowb, cb); else if (pn < 4) body<1>(acc, rowb, cb); else body<2>(acc, rowb, cb);
    }
};
template <int SECOND> struct EpiMerge {
    static constexpr bool PERM = true;
    const bf16* GT; bf16* MG;
    __device__ __forceinline__ void operator()(AccRef acc, const Unit& u, int wr, int wc, int fr, int fq) const {
        const int rowb = u.pm * 256 + wr * 64 + fr, c0 = u.pn * 256 + wc * 32 + 8 * fq;
#pragma unroll
        for (int ai = 0; ai < 2; ++ai)
#pragma unroll
            for (int m = 0; m < 4; ++m) { const int row = rowb + ai * 128 + m * 16;
#pragma unroll
                for (int bj = 0; bj < 2; ++bj) {
                    const int c = c0 + bj * 128; const u32x4 gv = *(const u32x4*)(GT + (size_t)row * 2048 + SECOND * 1024 + c);
                    const f32x4 v0 = acc[ai][bj][m][0], v1 = acc[ai][bj][m][1];
                    float o[8] = {v0[0] * bflo(gv.x), v0[1] * bfhi(gv.x), v0[2] * bflo(gv.y), v0[3] * bfhi(gv.y), v1[0] * bflo(gv.z), v1[1] * bfhi(gv.z), v1[2] * bflo(gv.w), v1[3] * bfhi(gv.w)};
                    bf16* dst = MG + (size_t)row * 1024 + c;
                    if (SECOND) { const u32x4 ov = *(const u32x4*)dst; o[0] += bflo(ov.x); o[1] += bfhi(ov.x); o[2] += bflo(ov.y); o[3] += bfhi(ov.y); o[4] += bflo(ov.z); o[5] += bfhi(ov.z); o[6] += bflo(ov.w); o[7] += bfhi(ov.w); }
                    u32x4 w; w.x = pk2(o[0], o[1]); w.y = pk2(o[2], o[3]); w.z = pk2(o[4], o[5]); w.w = pk2(o[6], o[7]); *(u32x4*)dst = w; } }
    }
};
struct EpiX1 {
    static constexpr bool PERM = false;
    const float* X; float* X1;
    __device__ __forceinline__ void operator()(AccRef acc, const Unit& u, int wr, int wc, int fr, int fq) const {
        const int rowb = u.pm * 256 + wr * 64 + fr, c0 = u.pn * 256 + wc * 32 + 4 * fq;
#pragma unroll
        for (int ai = 0; ai < 2; ++ai)
#pragma unroll
            for (int m = 0; m < 4; ++m) { const size_t off = (size_t)(rowb + ai * 128 + m * 16) * D + c0;
#pragma unroll
                for (int bj = 0; bj < 2; ++bj)
#pragma unroll
                    for (int n = 0; n < 2; ++n) { const f32x4 xv = *(const f32x4*)(X + off + bj * 128 + n * 16); *(f32x4*)(X1 + off + bj * 128 + n * 16) = xv + acc[ai][bj][m][n]; } }
    }
};
struct EpiSwiglu {
    static constexpr bool PERM = true;
    const float* b1; bf16* ACT;
    __device__ __forceinline__ void operator()(AccRef acc, const Unit& u, int wr, int wc, int fr, int fq) const {
        const int rowb = u.pm * 256 + wr * 64 + fr, c0 = u.pn * 256 + wc * 32 + 8 * fq;
        const float* bb = b1 + (size_t)u.e * F2;
#pragma unroll
        for (int bj = 0; bj < 2; ++bj) {
            const f32x4 bv0 = *(const f32x4*)(bb + c0 + bj * 128), bv1 = *(const f32x4*)(bb + c0 + bj * 128 + 4);
#pragma unroll
            for (int ai = 0; ai < 2; ++ai)
#pragma unroll
                for (int m = 0; m < 4; ++m) { const int row = rowb + ai * 128 + m * 16;
                    const f32x4 v0 = acc[ai][bj][m][0] + bv0, v1 = acc[ai][bj][m][1] + bv1;
                    float o[4];
#pragma unroll
                    for (int p = 0; p < 4; ++p) { float gl = p < 2 ? v0[2 * p] : v1[2 * p - 4], ul = p < 2 ? v0[2 * p + 1] : v1[2 * p - 3];
                        gl = fminf(gl, 7.f); ul = fminf(fmaxf(ul, -7.f), 7.f); o[p] = (ul + 1.f) * gl * sigm(1.702f * gl); }
                    u32x2 w; w.x = pk2(o[0], o[1]); w.y = pk2(o[2], o[3]); *(u32x2*)(ACT + (size_t)row * FH + ((c0 + bj * 128) >> 1)) = w; } }
    }
};
struct EpiY {
    static constexpr bool PERM = true;
    const float* b2; const int* rowslot; const float* gatew; bf16* YB;
    __device__ __forceinline__ void operator()(AccRef acc, const Unit& u, int wr, int wc, int fr, int fq) const {
        const int rowb = u.pm * 256 + wr * 64 + fr, c0 = u.pn * 256 + wc * 32 + 8 * fq;
        const float* bb = b2 + (size_t)u.e * D;
#pragma unroll
        for (int ai = 0; ai < 2; ++ai)
#pragma unroll
            for (int m = 0; m < 4; ++m) { const int row = rowb + ai * 128 + m * 16; const int slot = rowslot[row];
                if (slot >= 0) { const float gt = gatew[slot];
#pragma unroll
                    for (int bj = 0; bj < 2; ++bj) { const int c = c0 + bj * 128;
                        const f32x4 v0 = (acc[ai][bj][m][0] + *(const f32x4*)(bb + c)) * gt, v1 = (acc[ai][bj][m][1] + *(const f32x4*)(bb + c + 4)) * gt;
                        u32x4 w; w.x = pk2(v0[0], v0[1]); w.y = pk2(v0[2], v0[3]); w.z = pk2(v1[0], v1[1]); w.w = pk2(v1[2], v1[3]); *(u32x4*)(YB + (size_t)slot * D + c) = w; } } }
    }
};
struct EpiProj {
    static constexpr bool PERM = false;
    float* O;
    __device__ __forceinline__ void operator()(AccRef acc, const Unit& u, int wr, int wc, int fr, int fq) const {
        const int rowb = u.pm * 256 + wr * 64 + fr, c0 = u.pn * 256 + wc * 32 + 4 * fq;
#pragma unroll
        for (int ai = 0; ai < 2; ++ai)
#pragma unroll
            for (int m = 0; m < 4; ++m) { const size_t off = (size_t)(rowb + ai * 128 + m * 16) * D + c0;
#pragma unroll
                for (int bj = 0; bj < 2; ++bj)
#pragma unroll
                    for (int n = 0; n < 2; ++n) *(f32x4*)(O + off + bj * 128 + n * 16) = acc[ai][bj][m][n]; }
    }
};
struct EpiPle {
    static constexpr bool PERM = false;
    const float* X2; const float* rstd2; float* O; float* rowss;
    __device__ __forceinline__ void operator()(AccRef acc, const Unit& u, int wr, int wc, int fr, int fq) const {
        const int rowb = u.pm * 256 + wr * 64 + fr, c0 = u.pn * 256 + wc * 32 + 4 * fq;
#pragma unroll
        for (int ai = 0; ai < 2; ++ai)
#pragma unroll
            for (int m = 0; m < 4; ++m) { const int row = rowb + ai * 128 + m * 16; const size_t off = (size_t)row * D + c0; const float rs = rstd2[row]; float ss = 0.f;
#pragma unroll
                for (int bj = 0; bj < 2; ++bj)
#pragma unroll
                    for (int n = 0; n < 2; ++n) { const size_t o2 = off + bj * 128 + n * 16; const f32x4 pr = *(const f32x4*)(O + o2), xv = *(const f32x4*)(X2 + o2), a = acc[ai][bj][m][n]; f32x4 x3;
#pragma unroll
                        for (int j = 0; j < 4; ++j) { x3[j] = xv[j] + sigm(rs * a[j]) * pr[j]; ss += x3[j] * x3[j]; }
                        *(f32x4*)(O + o2) = x3; asm volatile("" ::: "memory"); }
                ss += __shfl_xor(ss, 16); ss += __shfl_xor(ss, 32);
                if (fq == 0) atomicAdd(rowss + row, ss);
                asm volatile("" ::: "memory"); }
    }
};

__device__ __forceinline__ void build_alora(const Args& args, Frame& F, int pm) {
    const bf16* ZR = WSP(bf16, WS_ZR); bf16* AL = WSP(bf16, WS_ALORA); const float* mu = FIN(4) + 1536;
#pragma unroll 2
    for (int i = 0; i < 16; ++i) {
        const int id = F.tid + 512 * i, row = pm * 256 + (id >> 5), cc = (id & 31) * 8;
        const u32x4 zc = *(const u32x4*)(ZR + (size_t)row * RWC + 1536 + cc);
        u32x4 zp = (u32x4){0u, 0u, 0u, 0u}; if ((row & (SEQ - 1)) != 0) zp = *(const u32x4*)(ZR + (size_t)(row - 1) * RWC + 1536 + cc);
        const unsigned zcw[4] = {zc.x, zc.y, zc.z, zc.w}, zpw[4] = {zp.x, zp.y, zp.z, zp.w}; float o[8];
#pragma unroll
        for (int j = 0; j < 8; ++j) { const float c = (j & 1) ? bfhi(zcw[j >> 1]) : bflo(zcw[j >> 1]), p = (j & 1) ? bfhi(zpw[j >> 1]) : bflo(zpw[j >> 1]);
            const float xs = c + mu[cc + j] * (p - c);
            o[j] = cc < 64 ? (1.f - 2.f * __builtin_amdgcn_rcpf(1.f + __expf(2.f * xs))) : (cc < 128 ? xs : sigm(xs)); }
        u32x4 w; w.x = pk2(o[0], o[1]); w.y = pk2(o[2], o[3]); w.z = pk2(o[4], o[5]); w.w = pk2(o[6], o[7]);
        *(u32x4*)(AL + (size_t)row * LORA_K + cc) = w;
    }
}

__device__ __forceinline__ void scan_unit(const Args& args, Frame& F, int bh) {
    const int b = bh >> 3, h = bh & 7, tid = F.tid;
    LAS float* LW = (LAS float*)F.lds;
    LAS float* LKK = LW + 4096, *LBB = LW + 8192, *LKP = LW + 12288, *LRR = LW + 16384, *LVV = LW + 20480, *LYY = LW + 24576, *LBON = LW + 28672;
    const bf16* ZR = WSP(bf16, WS_ZR); const float* DEC = WSP(float, WS_DEC); const float* AA = WSP(float, WS_AA); const bf16* GG = WSP(bf16, WS_GG); bf16* YB = WSP(bf16, WS_YB);
    const float* mu = FIN(4); const float* k_k = FIN(10) + h * 64; const float* k_a = FIN(11) + h * 64; const float* r_k = FIN(12) + h * 64;
    const float* lnw = FIN(13) + h * 64; const float* lnb = FIN(14) + h * 64;
    const int tt_p = tid >> 3, j0 = 8 * (tid & 7);
    const int row = tid >> 3, cg = tid & 7;
    float S[8];
#pragma unroll
    for (int j = 0; j < 8; ++j) S[j] = 0.f;
    float mur[8], muk[8], muv[8], kk_c[8], ka_c[8], rk_c[8];
#pragma unroll
    for (int j = 0; j < 8; ++j) { mur[j] = mu[h * 64 + j0 + j]; muk[j] = mu[512 + h * 64 + j0 + j]; muv[j] = mu[1024 + h * 64 + j0 + j]; kk_c[j] = k_k[j0 + j]; ka_c[j] = k_a[j0 + j]; rk_c[j] = r_k[j0 + j]; }
    for (int c0 = 0; c0 < SEQ; c0 += 64) {
        __syncthreads();
        {
            const size_t tok = (size_t)b * SEQ + c0 + tt_p; const bool first = (c0 + tt_p) == 0;
            const bf16* zc = ZR + tok * RWC + h * 64 + j0; const bf16* zp = zc - RWC;
            u32x4 cr = *(const u32x4*)zc, ck = *(const u32x4*)(zc + 512), cv = *(const u32x4*)(zc + 1024);
            u32x4 pr = (u32x4){0u, 0u, 0u, 0u}, pk = pr, pv = pr;
            if (!first) { pr = *(const u32x4*)zp; pk = *(const u32x4*)(zp + 512); pv = *(const u32x4*)(zp + 1024); }
            const f32x4 d0 = *(const f32x4*)(DEC + tok * 512 + h * 64 + j0), d1 = *(const f32x4*)(DEC + tok * 512 + h * 64 + j0 + 4);
            const f32x4 a0 = *(const f32x4*)(AA + tok * 512 + h * 64 + j0), a1 = *(const f32x4*)(AA + tok * 512 + h * 64 + j0 + 4);
            const unsigned crw[4] = {cr.x, cr.y, cr.z, cr.w}, ckw[4] = {ck.x, ck.y, ck.z, ck.w}, cvw[4] = {cv.x, cv.y, cv.z, cv.w};
            const unsigned prw[4] = {pr.x, pr.y, pr.z, pr.w}, pkw[4] = {pk.x, pk.y, pk.z, pk.w}, pvw[4] = {pv.x, pv.y, pv.z, pv.w};
            float r[8], k[8], v[8], kk[8], a[8], dec[8]; float ss = 0.f;
#pragma unroll
            for (int j = 0; j < 8; ++j) {
                const float rc = (j & 1) ? bfhi(crw[j >> 1]) : bflo(crw[j >> 1]), rp = (j & 1) ? bfhi(prw[j >> 1]) : bflo(prw[j >> 1]);
                const float kc = (j & 1) ? bfhi(ckw[j >> 1]) : bflo(ckw[j >> 1]), kp = (j & 1) ? bfhi(pkw[j >> 1]) : bflo(pkw[j >> 1]);
                const float vc = (j & 1) ? bfhi(cvw[j >> 1]) : bflo(cvw[j >> 1]), vp = (j & 1) ? bfhi(pvw[j >> 1]) : bflo(pvw[j >> 1]);
                r[j] = rc + mur[j] * (rp - rc); k[j] = kc + muk[j] * (kp - kc); v[j] = vc + muv[j] * (vp - vc);
                kk[j] = k[j] * kk_c[j]; ss += kk[j] * kk[j];
                a[j] = j < 4 ? a0[j] : a1[j - 4]; dec[j] = j < 4 ? d0[j] : d1[j - 4];
            }
            ss = red8(ss);
            const float inv = 1.0f / fmaxf(sqrtf(ss), 1e-12f);
            float bon = 0.f; float kpv[8], bbv[8];
#pragma unroll
            for (int j = 0; j < 8; ++j) { kk[j] *= inv; bbv[j] = kk[j] * a[j]; kpv[j] = k[j] * (1.f + (a[j] - 1.f) * ka_c[j]); bon += r[j] * kpv[j] * rk_c[j]; }
            bon = red8(bon);
            const int o = tt_p * 64 + j0;
            *(LAS f32x4*)(LW + o) = (f32x4){dec[0], dec[1], dec[2], dec[3]}; *(LAS f32x4*)(LW + o + 4) = (f32x4){dec[4], dec[5], dec[6], dec[7]};
            *(LAS f32x4*)(LKK + o) = (f32x4){kk[0], kk[1], kk[2], kk[3]}; *(LAS f32x4*)(LKK + o + 4) = (f32x4){kk[4], kk[5], kk[6], kk[7]};
            *(LAS f32x4*)(LBB + o) = (f32x4){bbv[0], bbv[1], bbv[2], bbv[3]}; *(LAS f32x4*)(LBB + o + 4) = (f32x4){bbv[4], bbv[5], bbv[6], bbv[7]};
            *(LAS f32x4*)(LKP + o) = (f32x4){kpv[0], kpv[1], kpv[2], kpv[3]}; *(LAS f32x4*)(LKP + o + 4) = (f32x4){kpv[4], kpv[5], kpv[6], kpv[7]};
            *(LAS f32x4*)(LRR + o) = (f32x4){r[0], r[1], r[2], r[3]}; *(LAS f32x4*)(LRR + o + 4) = (f32x4){r[4], r[5], r[6], r[7]};
            *(LAS f32x4*)(LVV + o) = (f32x4){v[0], v[1], v[2], v[3]}; *(LAS f32x4*)(LVV + o + 4) = (f32x4){v[4], v[5], v[6], v[7]};
            if ((tid & 7) == 0) LBON[tt_p] = bon;
        }
        __syncthreads();
#pragma unroll 2
        for (int tt = 0; tt < 64; ++tt) {
            const int o = tt * 64 + 8 * cg;
            const f32x4 k0 = *(const LAS f32x4*)(LKK + o), k1 = *(const LAS f32x4*)(LKK + o + 4);
            const f32x4 w0 = *(const LAS f32x4*)(LW + o), w1 = *(const LAS f32x4*)(LW + o + 4);
            const f32x4 b0 = *(const LAS f32x4*)(LBB + o), b1 = *(const LAS f32x4*)(LBB + o + 4);
            const f32x4 p0 = *(const LAS f32x4*)(LKP + o), p1 = *(const LAS f32x4*)(LKP + o + 4);
            const f32x4 r0 = *(const LAS f32x4*)(LRR + o), r1 = *(const LAS f32x4*)(LRR + o + 4);
            const float vi = LVV[tt * 64 + row];
            float sa = (S[0] * k0[0] + S[1] * k0[1]) + (S[2] * k0[2] + S[3] * k0[3]) + (S[4] * k1[0] + S[5] * k1[1]) + (S[6] * k1[2] + S[7] * k1[3]);
            sa = -red8(sa);
#pragma unroll
            for (int j = 0; j < 4; ++j) { S[j] = S[j] * w0[j] + (sa * b0[j] + vi * p0[j]); S[4 + j] = S[4 + j] * w1[j] + (sa * b1[j] + vi * p1[j]); }
            float y = (S[0] * r0[0] + S[1] * r0[1]) + (S[2] * r0[2] + S[3] * r0[3]) + (S[4] * r1[0] + S[5] * r1[1]) + (S[6] * r1[2] + S[7] * r1[3]);
            y = red8(y);
            if (cg == 0) LYY[tt * 64 + row] = y;
        }
        __syncthreads();
        {
            const size_t tok = (size_t)b * SEQ + c0 + tt_p; const int o = tt_p * 64 + j0;
            const f32x4 y0 = *(const LAS f32x4*)(LYY + o), y1 = *(const LAS f32x4*)(LYY + o + 4);
            const f32x4 v0 = *(const LAS f32x4*)(LVV + o), v1 = *(const LAS f32x4*)(LVV + o + 4);
            float s = (y0[0] + y0[1]) + (y0[2] + y0[3]) + (y1[0] + y1[1]) + (y1[2] + y1[3]);
            const float mean = red8(s) * (1.f / 64.f); float q = 0.f;
#pragma unroll
            for (int j = 0; j < 4; ++j) { const float d0 = y0[j] - mean, d1 = y1[j] - mean; q += d0 * d0 + d1 * d1; }
            const float rs = 1.0f / sqrtf(red8(q) * (1.f / 64.f) + GN_EPS); const float bon = LBON[tt_p];
            const u32x4 gv = *(const u32x4*)(GG + tok * 512 + h * 64 + j0); const unsigned gw[4] = {gv.x, gv.y, gv.z, gv.w}; float ov[8];
#pragma unroll
            for (int j = 0; j < 8; ++j) { const float yy = j < 4 ? y0[j] : y1[j - 4], vv = j < 4 ? v0[j] : v1[j - 4]; const float g = (j & 1) ? bfhi(gw[j >> 1]) : bflo(gw[j >> 1]);
                ov[j] = ((yy - mean) * rs * lnw[j0 + j] + lnb[j0 + j] + bon * vv) * g; }
            u32x4 w; w.x = pk2(ov[0], ov[1]); w.y = pk2(ov[2], ov[3]); w.z = pk2(ov[4], ov[5]); w.w = pk2(ov[6], ov[7]);
            *(u32x4*)(YB + tok * 512 + h * 64 + j0) = w;
        }
    }
    __syncthreads();
}

constexpr int LDA = 72, LDT = 40, LDF = 36;
constexpr int SC_WF = 0, SC_AT = 8192, SC_RT = SC_AT + 4608, SC_BT = SC_RT + 4608, SC_KT = SC_BT + 4608;
constexpr int SC_BCT = SC_KT + 4608, SC_KCT = SC_BCT + 5120, SC_VT = SC_KCT + 5120, SC_AHT = SC_VT + 5120, SC_UHT = SC_AHT + 5120;
constexpr int SC_AAB = SC_UHT + 5120, SC_ARB = SC_AAB + 4608, SC_ARK = SC_ARB + 2560, SC_RHS2 = SC_ARK + 2560, SC_YF = SC_RHS2 + 16384, SC_HT = SC_YF + 8192, SC_BON = SC_HT + 9216;
static_assert(SC_BON + 128 + 2048 <= RING_BYTES, "scan LDS map");
__device__ __forceinline__ float red16(float v) { v += dppf<0xB1>(v); v += dppf<0x4E>(v); v += dppf<0x141>(v); v += dppf<0x140>(v); return v; }
__device__ __forceinline__ bf16x8 ld16(const LAS bf16* p) { return *(const LAS bf16x8*)p; }
__device__ __forceinline__ bf16x8 ld8x2(const LAS bf16* p) { const u32x2 lo = *(const LAS u32x2*)p, hi = *(const LAS u32x2*)(p + 8); const u32x4 w = (u32x4){lo.x, lo.y, hi.x, hi.y}; return __builtin_bit_cast(bf16x8, w); }
__device__ __forceinline__ bf16x8 packq(const f32x16& x, int q) { u32x4 w; w.x = pk2(x[8 * q], x[8 * q + 1]); w.y = pk2(x[8 * q + 2], x[8 * q + 3]); w.z = pk2(x[8 * q + 4], x[8 * q + 5]); w.w = pk2(x[8 * q + 6], x[8 * q + 7]); return __builtin_bit_cast(bf16x8, w); }
#define MFMA32(a, b, c) __builtin_amdgcn_mfma_f32_32x32x16_bf16((a), (b), (c), 0, 0, 0)
struct ScanLoad { u32x2 cr, ck, cv, pr, pk, pv, g; f32x4 dec, eta; };
__device__ __forceinline__ void scan_load(ScanLoad& L, const bf16* ZR, const float* DEC, const float* AA, const bf16* GG, size_t tok, int hc, bool first) {
    const bf16* zc = ZR + tok * RWC + hc; const bf16* zp = zc - RWC;
    L.cr = *(const u32x2*)zc; L.ck = *(const u32x2*)(zc + 512); L.cv = *(const u32x2*)(zc + 1024);
    L.pr = (u32x2){0u, 0u}; L.pk = L.pr; L.pv = L.pr;
    if (!first) { L.pr = *(const u32x2*)zp; L.pk = *(const u32x2*)(zp + 512); L.pv = *(const u32x2*)(zp + 1024); }
    L.dec = *(const f32x4*)(DEC + tok * 512 + hc); L.eta = *(const f32x4*)(AA + tok * 512 + hc); L.g = *(const u32x2*)(GG + tok * 512 + hc);
}
#define LBAR() do { asm volatile("s_waitcnt lgkmcnt(0)" ::: "memory"); __builtin_amdgcn_s_barrier(); asm volatile("" ::: "memory"); } while (0)
__device__ __forceinline__ void scan_unit_chunked(const Args& args, Frame& F, int bh) {
    const int b = bh >> 3, h = bh & 7, tid = F.tid, w = F.wave;
    LAS unsigned char* L = F.lds;
    LAS float* WF = (LAS float*)(L + SC_WF); LAS float* AAB = (LAS float*)(L + SC_AAB); LAS float* RHS2 = (LAS float*)(L + SC_RHS2); LAS float* YF = (LAS float*)(L + SC_YF); LAS float* BON = (LAS float*)(L + SC_BON);
    LAS bf16* AT = (LAS bf16*)(L + SC_AT); LAS bf16* RT = (LAS bf16*)(L + SC_RT); LAS bf16* BT = (LAS bf16*)(L + SC_BT); LAS bf16* KT = (LAS bf16*)(L + SC_KT);
    LAS bf16* BCT = (LAS bf16*)(L + SC_BCT); LAS bf16* KCT = (LAS bf16*)(L + SC_KCT); LAS bf16* VT = (LAS bf16*)(L + SC_VT); LAS bf16* AHT = (LAS bf16*)(L + SC_AHT); LAS bf16* UHT = (LAS bf16*)(L + SC_UHT);
    LAS bf16* ARB = (LAS bf16*)(L + SC_ARB); LAS bf16* ARK = (LAS bf16*)(L + SC_ARK); LAS bf16* HT = (LAS bf16*)(L + SC_HT);
    const bf16* ZR = WSP(bf16, WS_ZR); const float* DEC = WSP(float, WS_DEC); const float* AA = WSP(float, WS_AA); const bf16* GG = WSP(bf16, WS_GG); bf16* YB = WSP(bf16, WS_YB);
    const int t = tid >> 4, j0 = 4 * (tid & 15), hc = h * 64 + j0;
    LAS float* CST = (LAS float*)(L + SC_BON + 128);
    { const int c = tid >> 6, j = tid & 63; const float* src = c == 0 ? FIN(4) : c == 1 ? FIN(4) + 512 : c == 2 ? FIN(4) + 1024 : c == 3 ? FIN(10) : c == 4 ? FIN(11) : c == 5 ? FIN(12) : c == 6 ? FIN(13) : FIN(14);
      CST[c * 64 + j] = src[h * 64 + j]; }
    for (int i = tid; i < 64 * LDA / 2; i += 512) ((LAS unsigned*)HT)[i] = 0u;
    ScanLoad cur; scan_load(cur, ZR, DEC, AA, GG, (size_t)b * SEQ + t, hc, t == 0);
    LBAR();
    for (int c0 = 0; c0 < SEQ; c0 += 32) {
        const size_t tok = (size_t)b * SEQ + c0 + t;
        float r[4], kp[4], v[4], al[4], be[4], gq[4];
        {
            const f32x4 mur = *(const LAS f32x4*)(CST + j0), muk = *(const LAS f32x4*)(CST + 64 + j0), muv = *(const LAS f32x4*)(CST + 128 + j0), kkc = *(const LAS f32x4*)(CST + 192 + j0), kac = *(const LAS f32x4*)(CST + 256 + j0), rkc = *(const LAS f32x4*)(CST + 320 + j0);
            const unsigned crw[2] = {cur.cr.x, cur.cr.y}, ckw[2] = {cur.ck.x, cur.ck.y}, cvw[2] = {cur.cv.x, cur.cv.y}, prw[2] = {cur.pr.x, cur.pr.y}, pkw[2] = {cur.pk.x, cur.pk.y}, pvw[2] = {cur.pv.x, cur.pv.y}, gw2[2] = {cur.g.x, cur.g.y};
            float k[4], kk[4]; float ss = 0.f;
#pragma unroll
            for (int j = 0; j < 4; ++j) {
                const float rc = (j & 1) ? bfhi(crw[j >> 1]) : bflo(crw[j >> 1]), rp = (j & 1) ? bfhi(prw[j >> 1]) : bflo(prw[j >> 1]);
                const float kc = (j & 1) ? bfhi(ckw[j >> 1]) : bflo(ckw[j >> 1]), kq = (j & 1) ? bfhi(pkw[j >> 1]) : bflo(pkw[j >> 1]);
                const float vc = (j & 1) ? bfhi(cvw[j >> 1]) : bflo(cvw[j >> 1]), vq = (j & 1) ? bfhi(pvw[j >> 1]) : bflo(pvw[j >> 1]);
                r[j] = rc + mur[j] * (rp - rc); k[j] = kc + muk[j] * (kq - kc); v[j] = vc + muv[j] * (vq - vc);
                kk[j] = k[j] * kkc[j]; ss += kk[j] * kk[j]; gq[j] = (j & 1) ? bfhi(gw2[j >> 1]) : bflo(gw2[j >> 1]);
            }
            ss = red16(ss);
            const float inv = 1.0f / fmaxf(sqrtf(ss), 1e-12f); float bon = 0.f;
#pragma unroll
            for (int j = 0; j < 4; ++j) { kk[j] *= inv; al[j] = -kk[j]; be[j] = kk[j] * cur.eta[j]; kp[j] = k[j] * (1.f + (cur.eta[j] - 1.f) * kac[j]); bon += r[j] * kp[j] * rkc[j]; }
            bon = red16(bon);
            *(LAS f32x4*)(WF + t * 64 + j0) = cur.dec;
            if ((tid & 15) == 0) BON[t] = bon;
        }
        if (c0 + 32 < SEQ) scan_load(cur, ZR, DEC, AA, GG, tok + 32, hc, false);
        LBAR();
        if (w == 0 && !(SCAN_STUB & 8)) { float g = 1.f; const int lane = lane_now();
#pragma unroll
            for (int tt = 0; tt < 32; ++tt) { g *= WF[tt * 64 + lane]; WF[tt * 64 + lane] = g; } }
        LBAR();
        {
            const f32x4 gt = *(const LAS f32x4*)(WF + t * 64 + j0), gC = *(const LAS f32x4*)(WF + 31 * 64 + j0);
            f32x4 gp = (f32x4){1.f, 1.f, 1.f, 1.f}; if (t > 0) gp = *(const LAS f32x4*)(WF + (t - 1) * 64 + j0);
            float a_[4], r_[4], b_[4], k_[4], bc[4], kc[4];
#pragma unroll
            for (int j = 0; j < 4; ++j) { const float ig = 1.0f / gt[j]; a_[j] = al[j] * gp[j]; r_[j] = r[j] * gt[j]; b_[j] = be[j] * ig; k_[j] = kp[j] * ig; bc[j] = b_[j] * gC[j]; kc[j] = k_[j] * gC[j]; }
            *(LAS f32x4*)(RHS2 + t * 128 + j0) = (f32x4){a_[0], a_[1], a_[2], a_[3]};
            u32x2 wv; wv.x = pk2(a_[0], a_[1]); wv.y = pk2(a_[2], a_[3]); *(LAS u32x2*)(AT + t * LDA + j0) = wv;
            wv.x = pk2(r_[0], r_[1]); wv.y = pk2(r_[2], r_[3]); *(LAS u32x2*)(RT + t * LDA + j0) = wv;
            wv.x = pk2(b_[0], b_[1]); wv.y = pk2(b_[2], b_[3]); *(LAS u32x2*)(BT + t * LDA + j0) = wv;
            wv.x = pk2(k_[0], k_[1]); wv.y = pk2(k_[2], k_[3]); *(LAS u32x2*)(KT + t * LDA + j0) = wv;
#pragma unroll
            for (int j = 0; j < 4; ++j) { BCT[(j0 + j) * LDT + t] = (bf16)(pk2(bc[j], 0.f) & 0xffffu); KCT[(j0 + j) * LDT + t] = (bf16)(pk2(kc[j], 0.f) & 0xffffu); VT[(j0 + j) * LDT + t] = (bf16)(pk2(v[j], 0.f) & 0xffffu); }
        }
        LBAR();
        if (w < 4 && !(SCAN_STUB & 1)) {
            const int lane = lane_now(), r32 = lane & 31, hh = lane >> 5;
            const LAS bf16* Aop = ((w & 1) ? KT : BT) + r32 * LDA + 8 * hh; const LAS bf16* Bop = ((w < 2) ? AT : RT) + r32 * LDA + 8 * hh;
            f32x16 x;
#pragma unroll
            for (int i = 0; i < 16; ++i) x[i] = 0.f;
#pragma unroll
            for (int q = 0; q < 4; ++q) x = MFMA32(ld16(Aop + 16 * q), ld16(Bop + 16 * q), x);
#pragma unroll
            for (int i = 0; i < 16; ++i) { const int s_ = crow(i, hh); const bool keep = (w < 2) ? (s_ < r32) : (s_ <= r32); x[i] = keep ? x[i] : 0.f; }
            if (w == 0) {
#pragma unroll
                for (int i4 = 0; i4 < 4; ++i4) *(LAS f32x4*)(AAB + r32 * LDF + 8 * i4 + 4 * hh) = (f32x4){x[4 * i4], x[4 * i4 + 1], x[4 * i4 + 2], x[4 * i4 + 3]};
            } else if (w == 1) {
#pragma unroll
                for (int it = 0; it < 2; ++it) { f32x16 z;
#pragma unroll
                    for (int i = 0; i < 16; ++i) z[i] = 0.f;
#pragma unroll
                    for (int q = 0; q < 2; ++q) z = MFMA32(packq(x, q), ld8x2(VT + (32 * it + r32) * LDT + 16 * q + 4 * hh), z);
#pragma unroll
                    for (int i = 0; i < 16; ++i) RHS2[crow(i, hh) * 128 + 64 + 32 * it + r32] = z[i]; }
            } else {
                LAS bf16* dst = (w == 2 ? ARB : ARK) + r32 * LDT + 4 * hh;
#pragma unroll
                for (int i4 = 0; i4 < 4; ++i4) { u32x2 wv; wv.x = pk2(x[4 * i4], x[4 * i4 + 1]); wv.y = pk2(x[4 * i4 + 2], x[4 * i4 + 3]); *(LAS u32x2*)(dst + 8 * i4) = wv; }
            }
        }
        LBAR();
        if (w < 2) {
            const int lane = lane_now();
            float x[32]; const int col = 64 * w + lane;
            if (SCAN_STUB & 2) { for (int i = 0; i < 32; ++i) x[i] = RHS2[i * 128 + col]; }
            f32x4 avc[8], avn[8]; float rc = RHS2[col], rn = 0.f;
#pragma unroll
            for (int i = 0; i < 8; ++i) { avc[i] = (f32x4){0.f, 0.f, 0.f, 0.f}; avn[i] = avc[i]; }
#pragma unroll
            for (int tt = 0; tt < ((SCAN_STUB & 2) ? 0 : 32); ++tt) {
                if (tt + 1 < 32) {
#pragma unroll
                    for (int s4 = 0; s4 < (tt + 4) / 4; ++s4) avn[s4] = *(const LAS f32x4*)(AAB + (tt + 1) * LDF + 4 * s4);
                    rn = RHS2[(tt + 1) * 128 + col];
                }
                float a0 = rc, a1 = 0.f;
#pragma unroll
                for (int s = 0; s < tt; ++s) { if (s & 1) a1 += avc[s >> 2][s & 3] * x[s]; else a0 += avc[s >> 2][s & 3] * x[s]; }
                x[tt] = a0 + a1;
                asm volatile("" : "+v"(x[tt]) :: "memory");
#pragma unroll
                for (int i = 0; i < 8; ++i) avc[i] = avn[i];
                rc = rn;
            }
            LAS bf16* dst = AHT + (w * (SC_UHT - SC_AHT) / 2) + lane * LDT;
#pragma unroll
            for (int q = 0; q < 4; ++q) { u32x4 wv; wv.x = pk2(x[8 * q], x[8 * q + 1]); wv.y = pk2(x[8 * q + 2], x[8 * q + 3]); wv.z = pk2(x[8 * q + 4], x[8 * q + 5]); wv.w = pk2(x[8 * q + 6], x[8 * q + 7]); *(LAS u32x4*)(dst + 8 * q) = wv; }
        }
        LBAR();
        f32x16 hn;
        if (SCAN_STUB & 4) { for (int i = 0; i < 16; ++i) hn[i] = 0.f; } else if (w < 4) {
            const int lane = lane_now(), r32 = lane & 31, hh = lane >> 5;
            const int jb = w >> 1, ib = w & 1;
            f32x16 pt[2];
#pragma unroll
            for (int a = 0; a < 2; ++a) {
#pragma unroll
                for (int i = 0; i < 16; ++i) pt[a][i] = 0.f;
#pragma unroll
                for (int q = 0; q < 2; ++q) pt[a] = MFMA32(ld16(AHT + (32 * a + r32) * LDT + 16 * q + 8 * hh), ld16(BCT + (32 * jb + r32) * LDT + 16 * q + 8 * hh), pt[a]);
            }
            { const float gC = WF[31 * 64 + 32 * jb + r32];
#pragma unroll
              for (int i = 0; i < 16; ++i) { const float add = (crow(i, hh) == r32) ? gC : 0.f; pt[0][i] += (jb == 0) ? add : 0.f; pt[1][i] += (jb == 0) ? 0.f : add; } }
#pragma unroll
            for (int i = 0; i < 16; ++i) hn[i] = 0.f;
#pragma unroll
            for (int q = 0; q < 2; ++q) {
                hn = MFMA32(ld16(BCT + (32 * jb + r32) * LDT + 16 * q + 8 * hh), ld16(UHT + (32 * ib + r32) * LDT + 16 * q + 8 * hh), hn);
                hn = MFMA32(ld16(KCT + (32 * jb + r32) * LDT + 16 * q + 8 * hh), ld16(VT + (32 * ib + r32) * LDT + 16 * q + 8 * hh), hn);
            }
#pragma unroll
            for (int a = 0; a < 2; ++a)
#pragma unroll
                for (int q = 0; q < 2; ++q) hn = MFMA32(packq(pt[a], q), ld8x2(HT + (32 * ib + r32) * LDA + 32 * a + 16 * q + 4 * hh), hn);
        } else if (w < 6) {
            const int lane = lane_now(), r32 = lane & 31, hh = lane >> 5;
            const int ib = w & 1;
            f32x16 rt[2];
#pragma unroll
            for (int a = 0; a < 2; ++a) {
#pragma unroll
                for (int i = 0; i < 16; ++i) rt[a][i] = bflo((unsigned)RT[r32 * LDA + 32 * a + crow(i, hh)]);
#pragma unroll
                for (int q = 0; q < 2; ++q) rt[a] = MFMA32(ld16(AHT + (32 * a + r32) * LDT + 16 * q + 8 * hh), ld16(ARB + r32 * LDT + 16 * q + 8 * hh), rt[a]);
            }
            f32x16 y;
#pragma unroll
            for (int i = 0; i < 16; ++i) y[i] = 0.f;
#pragma unroll
            for (int q = 0; q < 2; ++q) {
                y = MFMA32(ld16(ARB + r32 * LDT + 16 * q + 8 * hh), ld16(UHT + (32 * ib + r32) * LDT + 16 * q + 8 * hh), y);
                y = MFMA32(ld16(ARK + r32 * LDT + 16 * q + 8 * hh), ld16(VT + (32 * ib + r32) * LDT + 16 * q + 8 * hh), y);
            }
#pragma unroll
            for (int a = 0; a < 2; ++a)
#pragma unroll
                for (int q = 0; q < 2; ++q) y = MFMA32(packq(rt[a], q), ld8x2(HT + (32 * ib + r32) * LDA + 32 * a + 16 * q + 4 * hh), y);
#pragma unroll
            for (int i = 0; i < 16; ++i) YF[crow(i, hh) * 64 + 32 * ib + r32] = y[i];
        }
        LBAR();
        if (w < 4) {
            const int lane = lane_now(), r32 = lane & 31, hh = lane >> 5;
            const int jb = w >> 1, ib = w & 1; LAS bf16* dst = HT + (32 * ib + r32) * LDA + 32 * jb + 4 * hh;
#pragma unroll
            for (int i4 = 0; i4 < 4; ++i4) { u32x2 wv; wv.x = pk2(hn[4 * i4], hn[4 * i4 + 1]); wv.y = pk2(hn[4 * i4 + 2], hn[4 * i4 + 3]); *(LAS u32x2*)(dst + 8 * i4) = wv; }
        }
        {
            const f32x4 y4 = *(const LAS f32x4*)(YF + t * 64 + j0);
            const float mean = red16((y4[0] + y4[1]) + (y4[2] + y4[3])) * (1.f / 64.f); float qv = 0.f;
#pragma unroll
            for (int j = 0; j < 4; ++j) { const float d = y4[j] - mean; qv += d * d; }
            const float rs = 1.0f / sqrtf(red16(qv) * (1.f / 64.f) + GN_EPS); const float bon = BON[t]; float ov[4];
            const f32x4 lnw = *(const LAS f32x4*)(CST + 384 + j0), lnb = *(const LAS f32x4*)(CST + 448 + j0);
#pragma unroll
            for (int j = 0; j < 4; ++j) ov[j] = ((y4[j] - mean) * rs * lnw[j] + lnb[j] + bon * v[j]) * gq[j];
            u32x2 wv; wv.x = pk2(ov[0], ov[1]); wv.y = pk2(ov[2], ov[3]); *(u32x2*)(YB + tok * 512 + hc) = wv;
        }
        LBAR();
    }
}

__device__ __forceinline__ void attn_tile(Frame& F, int bh, int qt) {
    const int lane = F.lane, q = lane & 31, hi = lane >> 5, b = bh >> 3, h = bh & 7, t0 = 32 * qt;
    const size_t tokbase = (size_t)b * SEQ;
    const bf16* QB = WSP(bf16, WS_Q); const bf16* KB = WSP(bf16, WS_K); const bf16* VT = WSP(bf16, WS_VT); bf16* YA = WSP(bf16, WS_YA);
    bf16x8 qf[4];
    { const bf16* Qp = QB + (tokbase + t0 + q) * 512 + h * 64 + 8 * hi;
#pragma unroll
      for (int d0 = 0; d0 < 4; ++d0) qf[d0] = *(const bf16x8*)(Qp + 16 * d0); }
    f32x16 y0, y1;
#pragma unroll
    for (int r = 0; r < 16; ++r) { y0[r] = 0.f; y1[r] = 0.f; }
    float carry = 1.f;
    const bf16* Vrow = VT + ((size_t)(bh * 64) + q) * SEQ + 4 * hi;
    for (int s0 = t0; s0 >= 0; s0 -= 32) {
        bf16x8 kf[4];
        { const bf16* Kp = KB + (tokbase + s0 + q) * 512 + h * 64 + 8 * hi;
#pragma unroll
          for (int d0 = 0; d0 < 4; ++d0) kf[d0] = *(const bf16x8*)(Kp + 16 * d0); }
        u32x2 vlo[2][2], vhi[2][2];
#pragma unroll
        for (int dt = 0; dt < 2; ++dt)
#pragma unroll
            for (int s = 0; s < 2; ++s) { const bf16* vp = Vrow + (size_t)dt * 32 * SEQ + s0 + 16 * s; vlo[dt][s] = *(const u32x2*)vp; vhi[dt][s] = *(const u32x2*)(vp + 8); }
        f32x16 p;
#pragma unroll
        for (int r = 0; r < 16; ++r) p[r] = 0.f;
#pragma unroll
        for (int d0 = 0; d0 < 4; ++d0) p = __builtin_amdgcn_mfma_f32_32x32x16_bf16(kf[d0], qf[d0], p, 0, 0, 0);
        float om[16], be[16];
#pragma unroll
        for (int r = 0; r < 16; ++r) {
            const int kv = crow(r, hi); const bool valid = (s0 + kv) < (t0 + q);
            const float z = fminf(p[r], 80.f); const float t = __expf(z); const float o = __builtin_amdgcn_rcpf(1.f + t);
            om[r] = valid ? o : 1.f; be[r] = valid ? t * o : 0.f;
        }
        float el[16], G[4], PG[4];
#pragma unroll
        for (int i = 0; i < 4; ++i) { el[4 * i + 3] = 1.f; el[4 * i + 2] = om[4 * i + 3]; el[4 * i + 1] = el[4 * i + 2] * om[4 * i + 2]; el[4 * i] = el[4 * i + 1] * om[4 * i + 1]; G[i] = el[4 * i] * om[4 * i]; }
#pragma unroll
        for (int i = 0; i < 4; ++i) PG[i] = __shfl_xor(G[i], 32);
        float sG[4], sP[4];
        sG[3] = 1.f; sG[2] = G[3]; sG[1] = G[3] * G[2]; sG[0] = sG[1] * G[1];
        sP[3] = 1.f; sP[2] = PG[3]; sP[1] = PG[3] * PG[2]; sP[0] = sP[1] * PG[1];
        const float total = (sG[0] * G[0]) * (sP[0] * PG[0]);
        float A[16];
#pragma unroll
        for (int i = 0; i < 4; ++i) { const float eg = sG[i] * (hi ? sP[i] : sP[i] * PG[i]) * carry;
#pragma unroll
            for (int j = 0; j < 4; ++j) A[4 * i + j] = be[4 * i + j] * el[4 * i + j] * eg; }
        carry *= total;
        bf16x8 pf[2];
#pragma unroll
        for (int s = 0; s < 2; ++s) { u32x4 w; w.x = pk2(A[8 * s], A[8 * s + 1]); w.y = pk2(A[8 * s + 2], A[8 * s + 3]); w.z = pk2(A[8 * s + 4], A[8 * s + 5]); w.w = pk2(A[8 * s + 6], A[8 * s + 7]); pf[s] = __builtin_bit_cast(bf16x8, w); }
#pragma unroll
        for (int s = 0; s < 2; ++s) {
            const u32x4 a0 = (u32x4){vlo[0][s].x, vlo[0][s].y, vhi[0][s].x, vhi[0][s].y}, a1 = (u32x4){vlo[1][s].x, vlo[1][s].y, vhi[1][s].x, vhi[1][s].y};
            y0 = __builtin_amdgcn_mfma_f32_32x32x16_bf16(__builtin_bit_cast(bf16x8, a0), pf[s], y0, 0, 0, 0);
            y1 = __builtin_amdgcn_mfma_f32_32x32x16_bf16(__builtin_bit_cast(bf16x8, a1), pf[s], y1, 0, 0, 0);
        }
        if (__all(carry < 5.6e-14f)) break;
    }
    bf16* Yp = YA + (tokbase + t0 + q) * 512 + h * 64 + 4 * hi;
#pragma unroll
    for (int i = 0; i < 4; ++i) {
        u32x2 w0, w1; w0.x = pk2(y0[4 * i], y0[4 * i + 1]); w0.y = pk2(y0[4 * i + 2], y0[4 * i + 3]); w1.x = pk2(y1[4 * i], y1[4 * i + 1]); w1.y = pk2(y1[4 * i + 2], y1[4 * i + 3]);
        *(u32x2*)(Yp + 8 * i) = w0; *(u32x2*)(Yp + 32 + 8 * i) = w1;
    }
}

__device__ __forceinline__ void p5a_router(const Args& args, Frame& F) {
    LAS float* LG = (LAS float*)F.lds;
    LAS unsigned* HIST = (LAS unsigned*)(F.lds + 32768); LAS unsigned* BASE = HIST + 32; LAS float* RSTD = (LAS float*)(F.lds + 32768 + 512);
    const float* X1 = WSP(float, WS_X1); const float* GW = WSP(float, WS_GW); const float* rb = FIN(20); const float* gn = FIN(18);
    unsigned* cnt = F.ctl + CW_CNT; int* LIST = WSP(int, WS_LIST); float* GATEW = WSP(float, WS_GATEW); bf16* HN = WSP(bf16, WS_HN);
    const int tid = F.tid, lane = F.lane, wave = F.wave;
    for (int tb = blockIdx.x; tb < M / 128; tb += F.G) {
        if (tid < 32) HIST[tid] = 0u;
        __syncthreads();
        int ex[4] = {0, 0, 0, 0}; float gt[4] = {0.f, 0.f, 0.f, 0.f}; unsigned lr[4] = {0u, 0u, 0u, 0u}; int tok = 0;
        if (wave < 4) {
            const int i = lane & 31, kh = lane >> 5; tok = tb * 128 + wave * 32 + i;
            const float* xr = X1 + (size_t)tok * D + 4 * kh;
            f32x16 acc;
#pragma unroll
            for (int r = 0; r < 16; ++r) acc[r] = 0.f;
            float ss = 0.f;
#pragma unroll 4
            for (int u = 0; u < 128; ++u) {
                const f32x4 a = *(const f32x4*)(xr + 8 * u); ss += (a[0] * a[0] + a[1] * a[1]) + (a[2] * a[2] + a[3] * a[3]);
                const float* gp = GW + (size_t)(8 * u + 4 * kh) * 32 + i;
#pragma unroll
                for (int j = 0; j < 4; ++j) acc = __builtin_amdgcn_mfma_f32_32x32x2f32(a[j], gp[32 * j], acc, 0, 0, 0);
            }
            ss += __shfl_xor(ss, 32);
            const float rstd = 1.0f / sqrtf(ss * (1.f / D) + RMS_EPS);
            if (kh == 0) RSTD[wave * 32 + i] = rstd;
            LAS float* L = LG + wave * (32 * 33);
#pragma unroll
            for (int r = 0; r < 16; ++r) L[crow(r, kh) * 33 + i] = acc[r];
            asm volatile("s_waitcnt lgkmcnt(0)" ::: "memory");
            if (kh == 0) {
                float v0 = -3.0e38f, v1 = -3.0e38f, v2 = -3.0e38f, v3 = -3.0e38f; int i0 = 0, i1 = 0, i2 = 0, i3 = 0;
                for (int e = 0; e < 32; ++e) { const float v = L[i * 33 + e] * rstd + rb[e];
                    if (v > v3) { if (v > v2) { v3 = v2; i3 = i2; if (v > v1) { v2 = v1; i2 = i1; if (v > v0) { v1 = v0; i1 = i0; v0 = v; i0 = e; } else { v1 = v; i1 = e; } } else { v2 = v; i2 = e; } } else { v3 = v; i3 = e; } } }
                const float e1 = __expf(v1 - v0), e2 = __expf(v2 - v0), e3 = __expf(v3 - v0), inv = 1.0f / (1.f + e1 + e2 + e3);
                ex[0] = i0; ex[1] = i1; ex[2] = i2; ex[3] = i3; gt[0] = inv; gt[1] = e1 * inv; gt[2] = e2 * inv; gt[3] = e3 * inv;
#pragma unroll
                for (int k = 0; k < 4; ++k) lr[k] = __hip_atomic_fetch_add(&HIST[ex[k]], 1u, __ATOMIC_RELAXED, __HIP_MEMORY_SCOPE_WORKGROUP);
            }
        }
        __syncthreads();
        if (tid < 32) BASE[tid] = __hip_atomic_fetch_add(cnt + tid, HIST[tid], RLX_AGENT);
        __syncthreads();
        if (wave < 4 && lane < 32) {
#pragma unroll
            for (int k = 0; k < 4; ++k) { const unsigned pos = BASE[ex[k]] + lr[k]; LIST[(size_t)ex[k] * CAP + pos] = tok * 4 + k; GATEW[tok * 4 + k] = gt[k]; }
        }
        for (int rr = 0; rr < 16; ++rr) { const int lt = wave * 16 + rr, t = tb * 128 + lt; const float rs = RSTD[lt];
            const f32x4* xr = (const f32x4*)(X1 + (size_t)t * D) + lane; u32x2* o = (u32x2*)(HN + (size_t)t * D) + lane;
#pragma unroll
            for (int j = 0; j < 4; ++j) { const f32x4 v = xr[64 * j]; const f32x4 g = ((const f32x4*)gn)[64 * j + lane]; u32x2 w; w.x = pk2(v.x * rs * g.x, v.y * rs * g.y); w.y = pk2(v.z * rs * g.z, v.w * rs * g.w); o[64 * j] = w; } }
        __syncthreads();
    }
}
__device__ __forceinline__ int moe_tables(Frame& F) {
    LAS int* CS = (LAS int*)(F.lds + MOE_OFF); LAS int* OFF = CS + 32; LAS unsigned char* TE = F.lds + MOE_TE;
    if (F.tid < 32) { int c = (int)__hip_atomic_load(F.ctl + CW_CNT + F.tid, RLX_AGENT); CS[F.tid] = c > CAP ? CAP : c; }
    __syncthreads();
    if (F.tid == 0) { int off = 0; for (int e = 0; e < 32; ++e) { OFF[e] = off; off += ((CS[e] + 255) >> 8) << 8; } OFF[32] = off; }
    __syncthreads();
    const int ntiles = OFF[32] >> 8;
    for (int t = F.tid; t < ntiles; t += 512) { int e = 0; while (e < 31 && OFF[e + 1] <= t * 256) ++e; TE[t] = (unsigned char)e; }
    __syncthreads();
    return ntiles;
}
__device__ __forceinline__ void p5b_gather(Frame& F) {
    const int ntiles = moe_tables(F);
    LAS int* CS = (LAS int*)(F.lds + MOE_OFF); LAS int* OFF = CS + 32; LAS unsigned char* TE = F.lds + MOE_TE;
    const int* LIST = WSP(int, WS_LIST); const bf16* HN = WSP(bf16, WS_HN); bf16* XS = WSP(bf16, WS_XS); int* RS = WSP(int, WS_ROWSLOT);
    const int gw = F.vcu * 8 + F.wave, NGW = F.G * 8, lane = F.lane;
    for (int rho = gw; rho < ntiles * 256; rho += NGW) {
        const int e = TE[rho >> 8], r = rho - OFF[e];
        if (r < CS[e]) { const int slot = LIST[(size_t)e * CAP + r]; const u32x4* src = (const u32x4*)(HN + (size_t)(slot >> 2) * D); u32x4* dst = (u32x4*)(XS + (size_t)rho * D);
            const u32x4 a = src[lane], b2 = src[64 + lane]; dst[lane] = a; dst[64 + lane] = b2; if (lane == 0) RS[rho] = slot; }
        else if (lane == 0) RS[rho] = -1;
    }
}
__device__ __forceinline__ void p8_combine(Frame& F) {
    float* X1 = WSP(float, WS_X1); const bf16* YBF = WSP(bf16, WS_YBUF); bf16* X2B = WSP(bf16, WS_X2B); float* R2 = WSP(float, WS_RSTD2); float* RSS = WSP(float, WS_ROWSS);
    const int gw = F.vcu * 8 + F.wave, NGW = F.G * 8, lane = F.lane;
    for (int t = gw; t < M; t += NGW) {
        f32x4* xr = (f32x4*)(X1 + (size_t)t * D) + lane; f32x4 v[4]; float s = 0.f;
#pragma unroll
        for (int j = 0; j < 4; ++j) v[j] = xr[64 * j];
#pragma unroll
        for (int k = 0; k < 4; ++k) { const u32x2* yr = (const u32x2*)(YBF + (size_t)(4 * t + k) * D) + lane;
#pragma unroll
            for (int j = 0; j < 4; ++j) { const u32x2 w = yr[64 * j]; v[j].x += bflo(w.x); v[j].y += bfhi(w.x); v[j].z += bflo(w.y); v[j].w += bfhi(w.y); } }
        u32x2* o = (u32x2*)(X2B + (size_t)t * D) + lane;
#pragma unroll
        for (int j = 0; j < 4; ++j) { s += (v[j].x * v[j].x + v[j].y * v[j].y) + (v[j].z * v[j].z + v[j].w * v[j].w); xr[64 * j] = v[j]; u32x2 w; w.x = pk2(v[j].x, v[j].y); w.y = pk2(v[j].z, v[j].w); o[64 * j] = w; }
        s = wave_sum(s);
        if (lane == 0) { R2[t] = 1.0f / sqrtf(s * (1.f / D) + RMS_EPS); RSS[t] = 0.f; }
    }
}
__device__ __forceinline__ void p10_final(const Args& args, Frame& F) {
    const float* RSS = WSP(float, WS_ROWSS); const float* fg = FIN(28);
    const int gw = F.vcu * 8 + F.wave, NGW = F.G * 8, lane = F.lane;
    f32x4 g[4];
#pragma unroll
    for (int j = 0; j < 4; ++j) g[j] = ((const f32x4*)fg)[64 * j + lane];
    for (int t = gw; t < M; t += NGW) {
        f32x4* xr = (f32x4*)(F.out + (size_t)t * D) + lane; const float rs = 1.0f / sqrtf(RSS[t] * (1.f / D) + RMS_EPS);
#pragma unroll
        for (int j = 0; j < 4; ++j) { f32x4 v = xr[64 * j]; v = v * rs * g[j];
            if (TS_PROBE >= 0 && t == 0 && lane == 0 && j == 0) { const unsigned long long* ts = (const unsigned long long*)(F.ctl + 2048); { const unsigned long long dt = ts[TS_PROBE + 1] - ts[TS_PROBE]; v.x += P3_ONLY ? (float)((dt + 800) / 1600) * 16.f : (float)((dt + 800) / 1600) * 4.f; } }
            xr[64 * j] = v; }
    }
}

constexpr int NPHASE = 13;
__global__ void __launch_bounds__(512, 2) mega_fwd(Args args) {
    extern __shared__ __attribute__((aligned(16))) unsigned char lds[];
    Frame F;
    F.lds = (LAS unsigned char*)lds;
    F.wave = __builtin_amdgcn_readfirstlane((int)threadIdx.x >> 6); F.lane = lane_now(); F.tid = F.wave * 64 + F.lane;
    F.G = gridDim.x; { const int bx = blockIdx.x; F.vcu = (F.G % 8 == 0) ? (bx % 8) * (F.G / 8) + bx / 8 : bx; }
    F.ws = args.ws; F.ctl = (unsigned*)(args.ws + WS_CTL); F.out = args.out;
    volatile LAS unsigned* MISC = (volatile LAS unsigned*)(F.lds + LDSCTL_OFF);
    if (F.tid < 64) MISC[F.tid] = 0u;
    __syncthreads();
    const int lo = args.ph_lo, hi = args.ph_hi;
    XcdBarrier bar; bar.bar = F.ctl + CW_BAR; bar.x = 0; bar.st = nullptr;
    if (hi - lo > 1) bar = xcd_barrier_post(F.ctl + CW_BAR, MISC + 8, F.tid);
#ifndef PH_MASK
#define PH_MASK 0xFFFF
#endif
#define IN(k) ((((PH_MASK) >> (k)) & 1) && lo <= (k) && (k) < hi)
#define STAMP(k) do { if (TS_PROBE >= 0 && blockIdx.x == 0 && F.tid == 0) ((unsigned long long*)(F.ctl + 2048))[k] = __builtin_amdgcn_s_memrealtime(); } while (0)
#define SEAM(k) do { if (IN(k) && IN((k) + 1)) xcd_barrier(bar, F.wave); F.lane = lane_now(); F.tid = F.wave * 64 + F.lane; STAMP((k) + 1); } while (0)
    LAS unsigned char* ring = F.lds;
    STAMP(0);

    if (IN(0)) { p0_prologue(args, F); if (F.G < 256) expert_convert(args, F, F.vcu * 8 + F.wave, F.G * 8); } SEAM(0);

    if (IN(1)) {
        pg8::Gemm g{WSP(bf16, WS_XB), WSP(bf16, WS_WIN), M, INC, D, 0}; pg8::StaticOrder S; S.init(M, INC, F.G, (int)blockIdx.x);
        EpiG1 E{WSP(float, WS_RSTD0), WSP(bf16, WS_Q), WSP(bf16, WS_K), WSP(bf16, WS_VT), WSP(bf16, WS_ZR), WSP(bf16, WS_GT)};
        pg8::gemm_phase(ring, g, S, E, F.wave);
    } SEAM(1);

    if (IN(2)) {
        for (int c = blockIdx.x; c < 256; c += F.G) {
            const int x = c & 7, y = c >> 3; pg8::LoraOrder S; S.half = y & 1; S.pm = x + 8 * (y >> 1); S.nu = 3 + (F.G >> 30);
            build_alora(args, F, S.pm);
            asm volatile("s_waitcnt vmcnt(0)" ::: "memory"); __syncthreads();
            pg8::Gemm g{WSP(bf16, WS_ALORA), WSP(bf16, WS_WL), M, LORA_N, LORA_K, 0};
            EpiLora E{FIN(5), FIN(7), WSP(float, WS_DEC), WSP(float, WS_AA), WSP(bf16, WS_GG)};
            pg8::gemm_phase(ring, g, S, E, F.wave);
        }
    } SEAM(2);

    if (IN(3)) {
        for (int u = blockIdx.x; u < 256; u += F.G) {
#ifndef P3_ONLY
#define P3_ONLY 0
#endif
            if (u < 128) { if (P3_ONLY != 2) scan_unit_chunked(args, F, u); else { bf16* YB = WSP(bf16, WS_YB); const int b = u >> 3, h = u & 7; for (int i = F.tid; i < SEQ * 8; i += 512) { const int tk = i >> 3, c8 = (i & 7) * 8; *(u32x4*)(YB + ((size_t)b * SEQ + tk) * 512 + h * 64 + c8) = (u32x4){0u, 0u, 0u, 0u}; } } }
            else if (P3_ONLY == 1) { bf16* YAz = WSP(bf16, WS_YA); const int bh = u - 128, b = bh >> 3, h = bh & 7; for (int i = F.tid; i < SEQ * 8; i += 512) { const int tk = i >> 3, c8 = (i & 7) * 8; *(u32x4*)(YAz + ((size_t)b * SEQ + tk) * 512 + h * 64 + c8) = (u32x4){0u, 0u, 0u, 0u}; } }
            else { const int bh = u - 128; for (int i = 0; i < 8; ++i) attn_tile(F, bh, F.wave + 8 * i);
                   if (F.G >= 256) expert_convert(args, F, bh * 8 + F.wave, 1024); }
        }
    } SEAM(3);

    if (IN(4)) {
        pg8::StaticOrder S; S.init(M, D, F.G, (int)blockIdx.x);
        { pg8::Gemm g{WSP(bf16, WS_YA), WSP(bf16, WS_WA), M, D, AW, 0}; EpiMerge<0> E{WSP(bf16, WS_GT), WSP(bf16, WS_MERGED)}; pg8::gemm_phase(ring, g, S, E, F.wave); }
        { pg8::Gemm g{WSP(bf16, WS_YB), WSP(bf16, WS_WB), M, D, RW, 0}; EpiMerge<1> E{WSP(bf16, WS_GT), WSP(bf16, WS_MERGED)}; pg8::gemm_phase(ring, g, S, E, F.wave); }
    } SEAM(4);

    if (IN(5)) {
        pg8::Gemm g{WSP(bf16, WS_MERGED), WSP(bf16, WS_WO), M, D, D, 0}; pg8::StaticOrder S; S.init(M, D, F.G, (int)blockIdx.x);
        EpiX1 E{FIN(0), WSP(float, WS_X1)};
        pg8::gemm_phase(ring, g, S, E, F.wave);
    } SEAM(5);

    if (IN(6)) { p5a_router(args, F); } SEAM(6);
    if (IN(7)) { p5b_gather(F); } SEAM(7);

    if (IN(8)) {
        const int ntiles = moe_tables(F);
        pg8::Gemm g{WSP(bf16, WS_XS), WSP(bf16, WS_W1), MAXROWS, F2, D, (size_t)F2 * D * 2};
        pg8::MoeOrder S{ntiles, F2 / 256, F.G, (int)blockIdx.x, F.lds + MOE_TE};
        EpiSwiglu E{FIN(22), WSP(bf16, WS_ACT)};
        pg8::gemm_phase(ring, g, S, E, F.wave);
    } SEAM(8);

    if (IN(9)) {
        const int ntiles = moe_tables(F);
        pg8::Gemm g{WSP(bf16, WS_ACT), WSP(bf16, WS_W2), MAXROWS, D, FH, (size_t)D * FH * 2};
        pg8::MoeOrder S{ntiles, D / 256, F.G, (int)blockIdx.x, F.lds + MOE_TE};
        EpiY E{FIN(24), WSP(int, WS_ROWSLOT), WSP(float, WS_GATEW), WSP(bf16, WS_YBUF)};
        pg8::gemm_phase(ring, g, S, E, F.wave);
    } SEAM(9);

    if (IN(10)) { p8_combine(F); } SEAM(10);

    if (IN(11)) {
        pg8::StaticOrder S; S.init(M, D, F.G, (int)blockIdx.x);
        { pg8::Gemm g{WSP(bf16, WS_PB), WSP(bf16, WS_WP), M, D, PLE, 0}; EpiProj E{F.out}; pg8::gemm_phase(ring, g, S, E, F.wave); }
        { pg8::Gemm g{WSP(bf16, WS_X2B), WSP(bf16, WS_WG), M, D, D, 0}; EpiPle E{WSP(float, WS_X1), WSP(float, WS_RSTD2), F.out, WSP(float, WS_ROWSS)}; pg8::gemm_phase(ring, g, S, E, F.wave); }
    } SEAM(11);

    if (IN(12)) { p10_final(args, F); }
#undef IN
#undef SEAM
}

extern "C" void kernel_launch(void* const* d_in, const int* in_sizes, int n_in, void* d_out, int out_size, void* d_ws, size_t ws_size, hipStream_t stream) {
    static int grid = 0;
    if (grid == 0) {
        if (n_in != 29 || in_sizes[0] != M * D || out_size != M * D || ws_size < WS_END) {
            fprintf(stderr, "kernel_launch: unexpected shapes (n_in %d, in0 %d, out %d, ws %zu < %zu); nothing launched\n", n_in, n_in > 0 ? in_sizes[0] : -1, out_size, ws_size, (size_t)WS_END); grid = -1; return; }
        int dev = 0, cus = 0, per_cu = 0;
        if (hipGetDevice(&dev) != hipSuccess || hipDeviceGetAttribute(&cus, hipDeviceAttributeMultiprocessorCount, dev) != hipSuccess) { grid = -1; return; }
        if (hipFuncSetAttribute((const void*)mega_fwd, hipFuncAttributeMaxDynamicSharedMemorySize, LDS_BYTES) != hipSuccess) { fprintf(stderr, "kernel_launch: hipFuncSetAttribute failed\n"); grid = -1; return; }
        if (hipOccupancyMaxActiveBlocksPerMultiprocessor(&per_cu, (const void*)mega_fwd, 512, LDS_BYTES) != hipSuccess || per_cu < 1) { fprintf(stderr, "kernel_launch: occupancy query says %d blocks/CU\n", per_cu); }
        (void)hipGetLastError();
        grid = cus;
    }
    if (grid < 0) return;
    (void)hipMemsetAsync((char*)d_ws + WS_CTL, 0, CTL_ZERO_BYTES, stream);
    Args a{};
    for (int i = 0; i < 29; ++i) a.in[i] = (const float*)d_in[i];
    a.out = (float*)d_out; a.ws = (unsigned char*)d_ws;
#if MK_PER_PHASE
    for (int p = 0; p < NPHASE; ++p) { a.ph_lo = p; a.ph_hi = p + 1; hipLaunchKernelGGL(mega_fwd, dim3(grid), dim3(512), LDS_BYTES, stream, a); }
#else
    a.ph_lo = 0; a.ph_hi = NPHASE; hipLaunchKernelGGL(mega_fwd, dim3(grid), dim3(512), LDS_BYTES, stream, a);
#endif
}
```

```cpp
#include <hip/hip_runtime.h>
#include <cstdio>
#include <cstdint>

#ifndef P3_ONLY
#define P3_ONLY 0
#endif
#ifndef SCAN_STUB
#define SCAN_STUB 0
#endif
#ifndef TS_PROBE
#define TS_PROBE -1
#endif
#ifndef MK_PER_PHASE
#define MK_PER_PHASE 0
#endif

#define LAS __attribute__((address_space(3)))
#define GAS __attribute__((address_space(1)))
typedef unsigned short bf16;
typedef short bf16x8 __attribute__((ext_vector_type(8)));
typedef float f32x2 __attribute__((ext_vector_type(2)));
typedef float f32x4 __attribute__((ext_vector_type(4)));
typedef float f32x16 __attribute__((ext_vector_type(16)));
typedef unsigned u32x2 __attribute__((ext_vector_type(2)));
typedef unsigned u32x4 __attribute__((ext_vector_type(4)));
typedef __bf16 bf16x2_t __attribute__((ext_vector_type(2)));

constexpr int NB = 16, SEQ = 2048, D = 1024, M = NB * SEQ;
constexpr int NH = 8, HD = 64, AW = 512, RW = 512, RWC = 1792, INC = 5376;
constexpr int NE = 32, FH = 1024, F2 = 2048, PLE = 256, TOPK = 4;
constexpr int LORA_K = 256, LORA_N = 1536;
constexpr int CAP = 32768;
constexpr int MAXROWS = M * TOPK + NE * 256;
constexpr float RMS_EPS = 1e-5f, GN_EPS = 64e-5f;

constexpr size_t MiB = 1u << 20;
constexpr size_t WS_CTL = 0, CTL_ZERO_BYTES = 1 * MiB;
constexpr size_t WS_WIN = 1 * MiB;
constexpr size_t WS_WA = 12 * MiB, WS_WB = 13 * MiB, WS_WO = 14 * MiB, WS_WG = 16 * MiB, WS_WP = 18 * MiB;
constexpr size_t WS_WL = 18 * MiB + 512 * 1024;
constexpr size_t WS_GW = 19 * MiB + 256 * 1024;
constexpr size_t WS_W1 = 20 * MiB;
constexpr size_t WS_W2 = 148 * MiB;
constexpr size_t WS_PB = 212 * MiB;
constexpr size_t WS_RSTD0 = 228 * MiB, WS_RSTD2 = WS_RSTD0 + 128 * 1024, WS_ROWSS = WS_RSTD0 + 256 * 1024;
constexpr size_t WS_RSTD1 = WS_RSTD0 + 384 * 1024;
constexpr size_t WS_GATEW = WS_RSTD0 + 512 * 1024;
constexpr size_t WS_ROWSLOT = 229 * MiB;
constexpr size_t WS_LIST = 230 * MiB;
constexpr size_t WS_X1 = 236 * MiB;
constexpr size_t WS_YA = 236 * MiB, WS_YB = 268 * MiB, WS_ALORA = 300 * MiB;
constexpr size_t WS_GT = 364 * MiB;
constexpr size_t WS_Q = 492 * MiB, WS_K = 524 * MiB, WS_VT = 556 * MiB;
constexpr size_t WS_ZR = 588 * MiB;
constexpr size_t WS_XB = 700 * MiB;
constexpr size_t WS_DEC = 764 * MiB, WS_AA = 828 * MiB, WS_GG = 892 * MiB;
constexpr size_t WS_MERGED = 492 * MiB;
constexpr size_t WS_XS = 364 * MiB;
constexpr size_t WS_ACT = 684 * MiB;
constexpr size_t WS_HN = 364 * MiB;
constexpr size_t WS_YBUF = 428 * MiB;
constexpr size_t WS_X2B = 684 * MiB;
constexpr size_t WS_PGT = 748 * MiB;
constexpr size_t WS_END = 956 * MiB;
constexpr int CW_CNT = 64;
constexpr int CW_BAR = 4096;

constexpr int RING_BYTES = 131072;
constexpr int LDSCTL_OFF = RING_BYTES;
constexpr int MOE_OFF = RING_BYTES + 1024;
constexpr int MOE_TE = RING_BYTES + 2048;
constexpr int LDS_BYTES = 147456;

#define RLX_AGENT __ATOMIC_RELAXED, __HIP_MEMORY_SCOPE_AGENT
__device__ __forceinline__ unsigned pk2(float lo, float hi) { f32x2 v = {lo, hi}; bf16x2_t b = __builtin_convertvector(v, bf16x2_t); return __builtin_bit_cast(unsigned, b); }
__device__ __forceinline__ float bflo(unsigned u) { return __uint_as_float(u << 16); }
__device__ __forceinline__ float bfhi(unsigned u) { return __uint_as_float(u & 0xffff0000u); }
__device__ __forceinline__ float sigm(float x) { return __builtin_amdgcn_rcpf(1.f + __expf(-x)); }
__device__ __forceinline__ float wave_sum(float v) {
#pragma unroll
    for (int o = 1; o < 64; o <<= 1) v += __shfl_xor(v, o);
    return v;
}
template <int CTRL> __device__ __forceinline__ float dppf(float v) { return __builtin_bit_cast(float, __builtin_amdgcn_update_dpp(0, __builtin_bit_cast(int, v), CTRL, 0xF, 0xF, true)); }
__device__ __forceinline__ float red8(float v) { v += dppf<0xB1>(v); v += dppf<0x4E>(v); v += dppf<0x141>(v); return v; }
__device__ __forceinline__ int lane_now() { int l; asm volatile("v_mbcnt_lo_u32_b32 %0, -1, 0\n\tv_mbcnt_hi_u32_b32 %0, -1, %0" : "=v"(l)); return l; }
__device__ __forceinline__ int crow(int r, int hi) { return (r & 3) + 8 * (r >> 2) + 4 * hi; }

namespace pg8 {
#define PG8_LAS __attribute__((address_space(3)))
typedef unsigned short bf16_t;
constexpr int BM = 256, BK = 64, HALF = 128, HTB = HALF * BK * 2, STAGE_BYTES = 8 * HTB, NXCD = 8, WGM = 8;
__host__ __device__ __forceinline__ int lds_byte(int r, int c) { const int st = (r >> 4) * 2 + (c >> 5), rr = r & 15, cc = c & 31, ob = rr * 64 + cc * 2; return st * 1024 + (ob ^ (((ob >> 9) & 1) << 5)); }
__host__ __device__ __forceinline__ void stage_rc(int b, int& R, int& C) { const int st = b / 1024, sb = b % 1024, swz = sb ^ (((sb >> 9) & 1) << 5); R = (st >> 1) * 16 + swz / 64; C = (st & 1) * 32 + (swz % 64) / 2; }
__host__ __device__ __forceinline__ int perm32(int rho) { const int n = rho >> 4, i = rho & 15; return 8 * (i >> 2) + 4 * n + (i & 3); }

struct Unit { int pm, pn, e; };
struct Gemm { const bf16_t* A; const bf16_t* Bt; int M, N, K; size_t bsel_bytes; const int* glist; const PG8_LAS int* goff; const PG8_LAS int* gcnt; };

struct StaticOrder {
    int nM, nN, nwg, G, c;
    __device__ void init(int M_, int N_, int G_, int c_) { nM = M_ / BM; nN = N_ / BM; nwg = nM * nN; G = G_; c = c_; }
    __device__ bool next(int i, Unit& u) const {
        const long L = (long)i * G + c; if (L >= nwg) return false;
        int wgid = (int)L; { const int q = nwg / NXCD, r = nwg % NXCD, xcd = wgid % NXCD, off = wgid / NXCD; wgid = (xcd < r ? xcd * (q + 1) : r * (q + 1) + (xcd - r) * q) + off; }
        const int nig = WGM * nN, gid = wgid / nig, fm = gid * WGM, gsz = (nM - fm) < WGM ? (nM - fm) : WGM;
        u.pm = fm + ((wgid % nig) % gsz); u.pn = (wgid % nig) / gsz; u.e = 0; return true;
    }
};
struct LoraOrder {
    int pm, half, nu;
    __device__ bool next(int i, Unit& u) const { if (i >= nu) return false; u.pm = pm; u.pn = 3 * half + i; u.e = 0; return true; }
};
struct MoeOrder {
    int ntiles, npn, G, c; const PG8_LAS unsigned char* te;
    __device__ bool next(int i, Unit& u) const {
        int rt, pn;
        if ((G & 255) == 0 && (npn == 8 || npn == 4)) { const int x = c & 7, j = (c >> 3) & 31, rpx = 32 / npn, blk = c >> 8; rt = ((i * (G >> 8) + blk) * 8 + x) * rpx + j / npn; pn = j % npn; }
        else { const long L = (long)i * G + c; rt = (int)(L / npn); pn = (int)(L % npn); }
        if (rt >= ntiles) return false;
        u.pm = rt; u.pn = pn; u.e = te[rt]; return true;
    }
};

template <class Epi, class Sched, bool GATHER = false>
__device__ __forceinline__ void gemm_phase(PG8_LAS unsigned char* lds, const Gemm g, const Sched& S, const Epi& E, const int wid) {
    const int lane = lane_now(), tid = wid * 64 + lane,
              wr = wid >> 2, wc = wid & 3, fr = lane & 15, fq = lane >> 4;
    const int K = g.K, nt = K / BK;
    unsigned voffA[2], voffB[2];
#pragma unroll
    for (int i = 0; i < 2; ++i) { int R, C; stage_rc(tid * 16 + i * 8192, R, C); const int Rb = Epi::PERM ? ((R & ~31) + perm32(R & 31)) : R;
        voffA[i] = (unsigned)(R * K + C) * 2u; voffB[i] = (unsigned)(Rb * K + C) * 2u; }
    const size_t kstep = (size_t)(BK * 2);
    const size_t hstep = (size_t)HALF * K * 2;
    const size_t tstep = 2 * hstep;
    const unsigned ldsw = (unsigned)wid * 1024u;
    const int aoff = lds_byte(wr * 64 + fr, fq * 8), boff = lds_byte(wc * 32 + fr, fq * 8);
    unsigned vgC[2][2] = {{0u, 0u}, {0u, 0u}}, vgN[2][2] = {{0u, 0u}, {0u, 0u}};
#define PG8_GOFF(u, vo) do { _Pragma("unroll") for (int _h = 0; _h < 2; ++_h) _Pragma("unroll") for (int _i = 0; _i < 2; ++_i) { int R_, C_; stage_rc(tid * 16 + _i * 8192, R_, C_); \
        const int r_ = (u).pm * BM + _h * HALF + R_ - g.goff[(u).e]; int tok_ = 0; if (r_ < g.gcnt[(u).e]) tok_ = g.glist[(size_t)(u).e * 32768 + r_] >> 2; (vo)[_h][_i] = (unsigned)(tok_ * K + C_) * 2u; } } while (0)
#define PG8_SA(b, h) (((b) * 2 + (h)) * HTB)
#define PG8_SB(b, h) ((4 + (b) * 2 + (h)) * HTB)
#define PG8_STAGE(bufoff, gbase, voff) do { _Pragma("unroll") for (int _i = 0; _i < 2; ++_i) \
        __builtin_amdgcn_global_load_lds((const unsigned*)((const char*)(gbase) + (voff)[_i]), (PG8_LAS unsigned*)(lds + (bufoff) + ldsw + _i * 8192), 16, 0, 0); } while (0)
#define PG8_STA(bufoff, h, ptr, kbyte, usenext) do { if constexpr (GATHER) { unsigned vo_[2] = {(usenext) ? vgN[h][0] : vgC[h][0], (usenext) ? vgN[h][1] : vgC[h][1]}; PG8_STAGE(bufoff, (const char*)g.A + (kbyte), vo_); } else { PG8_STAGE(bufoff, ptr, voffA); } } while (0)
#define PG8_LDA(dst, b, h) do { _Pragma("unroll") for (int m = 0; m < 4; ++m) _Pragma("unroll") for (int k = 0; k < 2; ++k) dst[m][k] = *(const PG8_LAS bf16x8*)(lds + PG8_SA(b, h) + aoff + m * 2048 + k * 1024); } while (0)
#define PG8_LDB(dst, b, h) do { _Pragma("unroll") for (int n = 0; n < 2; ++n) _Pragma("unroll") for (int k = 0; k < 2; ++k) dst[n][k] = *(const PG8_LAS bf16x8*)(lds + PG8_SB(b, h) + boff + n * 2048 + k * 1024); } while (0)
#define PG8_MMA(ai, bj, At, Bt) do { __builtin_amdgcn_s_setprio(1); _Pragma("unroll") for (int m = 0; m < 4; ++m) _Pragma("unroll") for (int n = 0; n < 2; ++n) _Pragma("unroll") for (int k = 0; k < 2; ++k) \
        acc[ai][bj][m][n] = __builtin_amdgcn_mfma_f32_16x16x32_bf16(Bt[n][k], At[m][k], acc[ai][bj][m][n], 0, 0, 0); __builtin_amdgcn_s_setprio(0); } while (0)
#define PG8_WAIT_V(n) asm volatile("s_waitcnt vmcnt(" #n ")" ::: "memory")
#define PG8_WAIT_L(n) asm volatile("s_waitcnt lgkmcnt(" #n ")" ::: "memory")
#define PG8_BAR __builtin_amdgcn_s_barrier()
#define PG8_SCHED __builtin_amdgcn_sched_barrier(0)
    Unit cur, nxt; int ui = 0;
    if (!S.next(0, cur)) return;
    f32x4 acc[2][2][4][2];
#pragma unroll
    for (int a = 0; a < 2; ++a)
#pragma unroll
        for (int b = 0; b < 2; ++b)
#pragma unroll
            for (int m = 0; m < 4; ++m)
#pragma unroll
                for (int n = 0; n < 2; ++n) acc[a][b][m][n] = (f32x4){0.f, 0.f, 0.f, 0.f};
    bf16x8 At[4][2], B0[2][2], B1[2][2];
    const char* cA = (const char*)g.A + (size_t)cur.pm * tstep; const char* cB = (const char*)g.Bt + (size_t)cur.e * g.bsel_bytes + (size_t)cur.pn * tstep;
    if constexpr (GATHER) PG8_GOFF(cur, vgC);
    PG8_STAGE(PG8_SB(0, 0), cB, voffB); PG8_STAGE(PG8_SB(0, 1), cB + hstep, voffB); PG8_STA(PG8_SA(0, 0), 0, cA, 0, false); PG8_STA(PG8_SA(0, 1), 1, cA + hstep, 0, false);
    if (wr == 1) PG8_BAR;
    PG8_WAIT_V(2); PG8_BAR;
    PG8_STAGE(PG8_SB(1, 0), cB + kstep, voffB); PG8_STA(PG8_SA(1, 0), 0, cA + kstep, kstep, false); PG8_STAGE(PG8_SB(1, 1), cB + hstep + kstep, voffB);
    PG8_WAIT_V(6); PG8_BAR;
    for (;;) {
        const bool has_next = S.next(ui + 1, nxt);
        if constexpr (GATHER) { if (has_next) PG8_GOFF(nxt, vgN); else { vgN[0][0] = vgC[0][0]; vgN[0][1] = vgC[0][1]; vgN[1][0] = vgC[1][0]; vgN[1][1] = vgC[1][1]; } }
        const char* nA = has_next ? (const char*)g.A + (size_t)nxt.pm * tstep : cA;
        const char* nB = has_next ? (const char*)g.Bt + (size_t)nxt.e * g.bsel_bytes + (size_t)nxt.pn * tstep : cB;
        for (int t = 0; t < nt; t += 2) {
            const bool last = (t == nt - 2);
            const char* a1 = cA + (size_t)(t + 1) * kstep;
            const char* a2 = last ? nA : cA + (size_t)(t + 2) * kstep; const char* b2 = last ? nB : cB + (size_t)(t + 2) * kstep;
            const char* a3 = a2 + kstep; const char* b3 = b2 + kstep;
            const size_t k2 = last ? 0 : (size_t)(t + 2) * kstep;
            PG8_LDB(B0, 0, 0); PG8_LDB(B1, 0, 1); PG8_SCHED; PG8_LDA(At, 0, 0); PG8_STA(PG8_SA(1, 1), 1, a1 + hstep, (size_t)(t + 1) * kstep, false);
            PG8_WAIT_V(8); PG8_WAIT_L(0); PG8_BAR; PG8_MMA(0, 0, At, B0); PG8_MMA(0, 1, At, B1); PG8_BAR; PG8_SCHED;
            PG8_LDA(At, 0, 1); PG8_STAGE(PG8_SB(0, 0), b2, voffB); PG8_STAGE(PG8_SB(0, 1), b2 + hstep, voffB); PG8_STA(PG8_SA(0, 0), 0, a2, k2, last);
            PG8_WAIT_V(8); PG8_WAIT_L(0); PG8_BAR; PG8_MMA(1, 0, At, B0); PG8_MMA(1, 1, At, B1); PG8_BAR; PG8_SCHED;
            PG8_LDB(B0, 1, 0); PG8_LDB(B1, 1, 1); PG8_SCHED; PG8_LDA(At, 1, 0); PG8_STA(PG8_SA(0, 1), 1, a2 + hstep, k2, last);
            PG8_WAIT_V(8); PG8_WAIT_L(0); PG8_BAR; PG8_MMA(0, 0, At, B0); PG8_MMA(0, 1, At, B1); PG8_BAR; PG8_SCHED;
            PG8_LDA(At, 1, 1); PG8_STAGE(PG8_SB(1, 0), b3, voffB); PG8_STAGE(PG8_SB(1, 1), b3 + hstep, voffB); PG8_STA(PG8_SA(1, 0), 0, a3, k2 + kstep, last);
            PG8_WAIT_V(8); PG8_WAIT_L(0); PG8_BAR; PG8_MMA(1, 0, At, B0); PG8_MMA(1, 1, At, B1); PG8_BAR; PG8_SCHED;
        }
        if (wr == 0) PG8_BAR;
        E(acc, cur, wr, wc, fr, fq);
        if (!has_next) break;
#pragma unroll
        for (int a = 0; a < 2; ++a)
#pragma unroll
            for (int b = 0; b < 2; ++b)
#pragma unroll
                for (int m = 0; m < 4; ++m)
#pragma unroll
                    for (int n = 0; n < 2; ++n) acc[a][b][m][n] = (f32x4){0.f, 0.f, 0.f, 0.f};
        cur = nxt; cA = nA; cB = nB; ++ui;
        if constexpr (GATHER) { vgC[0][0] = vgN[0][0]; vgC[0][1] = vgN[0][1]; vgC[1][0] = vgN[1][0]; vgC[1][1] = vgN[1][1]; }
        if (wr == 1) PG8_BAR;
    }
    PG8_WAIT_V(0);
    PG8_BAR;
#undef PG8_SA
#undef PG8_SB
#undef PG8_STAGE
#undef PG8_LDA
#undef PG8_STA
#undef PG8_GOFF
#undef PG8_LDB
#undef PG8_MMA
#undef PG8_WAIT_V
#undef PG8_WAIT_L
#undef PG8_BAR
#undef PG8_SCHED
}
}
using pg8::Unit;
typedef const f32x4 (&AccRef)[2][2][4][2];

#define XB_TMO      128
#define XB_XCNT(j)  (256  + 64 * (j))
#define XB_XSUB(j)  (1280 + 64 * (j))
#define XB_XGEN(j)  (2304 + 64 * (j))
#define XB_TOP      3328
#define XB_TOPGEN   3392
#define XCD_BAR_WORDS 3456
#define XB_SPIN_CAP (1u << 22)
__device__ __forceinline__ unsigned xb_ld(unsigned* p)              { return __hip_atomic_load(p, __ATOMIC_RELAXED, __HIP_MEMORY_SCOPE_AGENT); }
__device__ __forceinline__ unsigned xb_add(unsigned* p, unsigned v) { return __hip_atomic_fetch_add(p, v, __ATOMIC_RELAXED, __HIP_MEMORY_SCOPE_AGENT); }
__device__ __forceinline__ unsigned xb_xcc_id() { return (unsigned)__builtin_amdgcn_s_getreg((3 << 11) | 20) & 0xFu; }
#define XB_SPIN(cond, bar) do { unsigned _sp = 0; while (cond) { __builtin_amdgcn_s_sleep(1); \
    if ((++_sp & 255u) == 0u) { if (xb_ld(&(bar)[XB_TMO])) break; if (_sp > XB_SPIN_CAP) { atomicAdd(&(bar)[XB_TMO], 1u); break; } } } } while (0)
struct XcdBarrier { unsigned* bar; unsigned x; volatile LAS unsigned* st; };
__device__ __forceinline__ XcdBarrier xcd_barrier_post(unsigned* bar, volatile LAS unsigned* st, int tid) {
    XcdBarrier b; b.bar = bar; b.x = xb_xcc_id(); b.st = st;
    if (tid == 0) (void)xb_add(&bar[XB_XCNT(b.x)], 1u);
    return b;
}
__device__ __forceinline__ void xcd_barrier_complete(unsigned* bar, unsigned x, unsigned& nloc, unsigned& nx) {
    const unsigned G = gridDim.x * gridDim.y * gridDim.z;
    unsigned sum, cnt, mine, sp = 0u;
    for (;;) {
        sum = 0u; cnt = 0u; mine = 0u;
#pragma unroll
        for (unsigned j = 0; j < 16; ++j) { const unsigned c = xb_ld(&bar[XB_XCNT(j)]); sum += c; cnt += (c > 0u) ? 1u : 0u; mine = (j == x) ? c : mine; }
        if (sum == G) break;
        __builtin_amdgcn_s_sleep(1);
        if ((++sp & 255u) == 0u) { if (xb_ld(&bar[XB_TMO])) break; if (sp > XB_SPIN_CAP) { atomicAdd(&bar[XB_TMO], 1u); break; } }
    }
    nloc = mine > 0u ? mine : 1u; nx = cnt > 0u ? cnt : 1u;
}
__device__ __forceinline__ void xcd_barrier(const XcdBarrier& b, int wave) {
    asm volatile("s_waitcnt vmcnt(0)" ::: "memory");
    __syncthreads();
    if (wave == 0 && lane_now() == 0) {
        unsigned* bar = b.bar;
        __builtin_amdgcn_s_waitcnt(0);
        unsigned nloc = b.st[0], nx = b.st[1];
        if (nloc == 0u) { xcd_barrier_complete(bar, b.x, nloc, nx); b.st[0] = nloc; b.st[1] = nx; }
        const unsigned old = xb_add(&bar[XB_XSUB(b.x)], 1u);
        const unsigned gen = old / nloc;
        if (old + 1u == (gen + 1u) * nloc) {
            __builtin_amdgcn_fence(__ATOMIC_RELEASE, "agent");
            asm volatile("s_waitcnt vmcnt(0)" ::: "memory");
            const unsigned og = xb_add(&bar[XB_TOP], 1u);
            const unsigned tg = og / nx;
            if (og + 1u == (tg + 1u) * nx) xb_add(&bar[XB_TOPGEN], 1u);
            else XB_SPIN(xb_ld(&bar[XB_TOPGEN]) == tg, bar);
            __builtin_amdgcn_fence(__ATOMIC_ACQUIRE, "agent");
            xb_add(&bar[XB_XGEN(b.x)], 1u);
            asm volatile("s_waitcnt vmcnt(0)" ::: "memory");
        } else {
            XB_SPIN(xb_ld(&bar[XB_XGEN(b.x)]) == gen, bar);
            __builtin_amdgcn_fence(__ATOMIC_ACQUIRE, "agent");
            asm volatile("s_waitcnt vmcnt(0)" ::: "memory");
        }
    }
    __syncthreads();
}

struct Frame {
    LAS unsigned char* lds;
    unsigned* ctl;
    int tid, lane, wave, vcu, G;
    unsigned char* ws;
    float* out;
};
#define WSP(T, off) ((T*)(F.ws + (off)))
struct Args { const float* in[29]; float* out; unsigned char* ws; int ph_lo, ph_hi; };
#define FIN(i) (args.in[i])

__device__ __forceinline__ void p0_transpose_item(const float* W, int K, int N, bf16* WT, LAS float* scr, int item, int lane, const float* kscale) {
    const int nblk = N / 32, kb = item / nblk, nb = item % nblk, k0 = 64 * kb, n0 = 32 * nb;
#pragma unroll 8
    for (int i = 0; i < 32; ++i) { const int kk = 2 * i + (lane >> 5); float v = W[(size_t)(k0 + kk) * N + n0 + (lane & 31)]; if (kscale) v *= kscale[k0 + kk]; scr[kk * 33 + (lane & 31)] = v; }
    asm volatile("s_waitcnt lgkmcnt(0)" ::: "memory");
    const int c = lane & 7;
#pragma unroll
    for (int j = 0; j < 4; ++j) { const int n = (lane >> 3) + 8 * j; const LAS float* s = scr + (8 * c) * 33 + n;
        u32x4 o; o.x = pk2(s[0 * 33], s[1 * 33]); o.y = pk2(s[2 * 33], s[3 * 33]); o.z = pk2(s[4 * 33], s[5 * 33]); o.w = pk2(s[6 * 33], s[7 * 33]);
        *(u32x4*)(WT + (size_t)(n0 + n) * K + k0 + 8 * c) = o; }
    asm volatile("s_waitcnt lgkmcnt(0)" ::: "memory");
}
__device__ __forceinline__ void p0_prologue(const Args& args, Frame& F) {
    LAS float* scr = (LAS float*)(F.lds + F.wave * 16384);
    const int gw = F.vcu * 8 + F.wave, NGW = F.G * 8, lane = F.lane;
    constexpr int I_IN = (D / 64) * (INC / 32), I_A = (AW / 64) * (D / 32), I_O = (D / 64) * (D / 32), I_P = (PLE / 64) * (D / 32);
    constexpr int I_W1 = (D / 64) * (F2 / 32), I_W2 = (FH / 64) * (D / 32);
    constexpr int NITEMS = I_IN + 2 * I_A + 2 * I_O + I_P;
    for (int it = gw; it < NITEMS; it += NGW) {
        int r = it;
        if (r < I_IN) { p0_transpose_item(FIN(3), D, INC, WSP(bf16, WS_WIN), scr, r, lane, FIN(2)); continue; } r -= I_IN;
        if (r < I_A) { p0_transpose_item(FIN(15), AW, D, WSP(bf16, WS_WA), scr, r, lane, nullptr); continue; } r -= I_A;
        if (r < I_A) { p0_transpose_item(FIN(16), RW, D, WSP(bf16, WS_WB), scr, r, lane, nullptr); continue; } r -= I_A;
        if (r < I_O) { p0_transpose_item(FIN(17), D, D, WSP(bf16, WS_WO), scr, r, lane, nullptr); continue; } r -= I_O;
        if (r < I_O) { p0_transpose_item(FIN(26), D, D, WSP(bf16, WS_WG), scr, r, lane, FIN(25)); continue; } r -= I_O;
        p0_transpose_item(FIN(27), PLE, D, WSP(bf16, WS_WP), scr, r, lane, nullptr);
    }
    { const int gt = (F.vcu * 512 + F.tid), NT = F.G * 512;
      bf16* WL = WSP(bf16, WS_WL);
      for (int i = gt; i < LORA_N * LORA_K; i += NT) { const int n = i >> 8, k = i & 255; float v = 0.f;
          if (n < 512) { if (k < 64) v = FIN(6)[k * 512 + n]; }
          else if (n < 1024) { if (k >= 64 && k < 128) v = FIN(8)[(k - 64) * 512 + (n - 512)]; }
          else { if (k >= 128) v = FIN(9)[(k - 128) * 512 + (n - 1024)]; }
          WL[i] = (bf16)(pk2(v, 0.f) & 0xffffu); }
      float* GW = WSP(float, WS_GW);
      for (int i = gt; i < D * NE; i += NT) GW[i] = FIN(19)[i] * FIN(18)[i >> 5];
    }
    { bf16* XB = WSP(bf16, WS_XB); float* R0 = WSP(float, WS_RSTD0); bf16* PB = WSP(bf16, WS_PB);
      for (int m = gw; m < M; m += NGW) {
          const f32x4* xr = (const f32x4*)(FIN(0) + (size_t)m * D) + lane;
          f32x4 v[4]; float s = 0.f;
#pragma unroll
          for (int j = 0; j < 4; ++j) { v[j] = xr[64 * j]; s += (v[j].x * v[j].x + v[j].y * v[j].y) + (v[j].z * v[j].z + v[j].w * v[j].w); }
          s = wave_sum(s);
          u32x2* o = (u32x2*)(XB + (size_t)m * D) + lane;
#pragma unroll
          for (int j = 0; j < 4; ++j) { u32x2 w; w.x = pk2(v[j].x, v[j].y); w.y = pk2(v[j].z, v[j].w); o[64 * j] = w; }
          if (lane == 0) R0[m] = 1.0f / sqrtf(s * (1.f / D) + RMS_EPS);
          const f32x4 pv = ((const f32x4*)(FIN(1) + (size_t)m * PLE))[lane];
          u32x2 w; w.x = pk2(pv.x, pv.y); w.y = pk2(pv.z, pv.w); ((u32x2*)(PB + (size_t)m * PLE))[lane] = w;
      }
    }
}

__device__ __forceinline__ void expert_convert(const Args& args, Frame& F, int wv, int NW) {
    LAS float* scr = (LAS float*)(F.lds + F.wave * 16384);
    constexpr int I_W1 = (D / 64) * (F2 / 32), I_W2 = (FH / 64) * (D / 32);
    for (int it = wv; it < NE * (I_W1 + I_W2); it += NW) {
        int r = it;
        if (r < NE * I_W1) { const int e = r / I_W1; p0_transpose_item(FIN(21) + (size_t)e * D * F2, D, F2, WSP(bf16, WS_W1) + (size_t)e * F2 * D, scr, r % I_W1, F.lane, nullptr); continue; } r -= NE * I_W1;
        { const int e = r / I_W2; p0_transpose_item(FIN(23) + (size_t)e * FH * D, FH, D, WSP(bf16, WS_W2) + (size_t)e * D * FH, scr, r % I_W2, F.lane, nullptr); }
    }
}
struct EpiG1 {
    static constexpr bool PERM = true;
    const float* rstd; bf16 *Q, *K, *VT, *ZR, *GT;
    __device__ __forceinline__ void operator()(AccRef acc, const Unit& u, int wr, int wc, int fr, int fq) const {
        const int pn = u.pn, rowb = u.pm * 256 + wr * 64 + fr, cl = wc * 32 + 8 * fq;
#pragma unroll
        for (int ai = 0; ai < 2; ++ai)
#pragma unroll
            for (int m = 0; m < 4; ++m) {
                const int row = rowb + ai * 128 + m * 16; const float rs = rstd[row];
                if (pn < 4) {
                    bf16* base = (pn < 2 ? Q : K) + (size_t)row * 512 + (pn & 1) * 256 + cl; const float sc = pn < 2 ? rs * 0.125f : rs;
#pragma unroll
                    for (int bj = 0; bj < 2; ++bj) { const f32x4 v0 = acc[ai][bj][m][0] * sc, v1 = acc[ai][bj][m][1] * sc;
                        u32x4 w; w.x = pk2(v0[0], v0[1]); w.y = pk2(v0[2], v0[3]); w.z = pk2(v1[0], v1[1]); w.w = pk2(v1[2], v1[3]); *(u32x4*)(base + bj * 128) = w; }
                } else if (pn < 6) {
                    const int b = row >> 11, s = row & 2047;
#pragma unroll
                    for (int bj = 0; bj < 2; ++bj)
#pragma unroll
                        for (int n = 0; n < 2; ++n)
#pragma unroll
                            for (int j = 0; j < 4; ++j) { const int c = (pn - 4) * 256 + cl + bj * 128 + 4 * n + j; const int hh = c >> 6, d = c & 63;
                                VT[((size_t)((b * 8 + hh) * 64 + d)) * SEQ + s] = (bf16)(pk2(acc[ai][bj][m][n][j] * rs, 0.f) & 0xffffu); }
                } else if (pn < 13) {
                    bf16* base = ZR + (size_t)row * RWC + (pn - 6) * 256 + cl;
#pragma unroll
                    for (int bj = 0; bj < 2; ++bj) { const f32x4 v0 = acc[ai][bj][m][0] * rs, v1 = acc[ai][bj][m][1] * rs;
                        u32x4 w; w.x = pk2(v0[0], v0[1]); w.y = pk2(v0[2], v0[3]); w.z = pk2(v1[0], v1[1]); w.w = pk2(v1[2], v1[3]); *(u32x4*)(base + bj * 128) = w; }
                } else {
                    bf16* base = GT + (size_t)row * 2048 + (pn - 13) * 256 + cl;
#pragma unroll
                    for (int bj = 0; bj < 2; ++bj) { const f32x4 v0 = acc[ai][bj][m][0] * rs, v1 = acc[ai][bj][m][1] * rs;
                        u32x4 w; w.x = pk2(sigm(v0[0]), sigm(v0[1])); w.y = pk2(sigm(v0[2]), sigm(v0[3])); w.z = pk2(sigm(v1[0]), sigm(v1[1])); w.w = pk2(sigm(v1[2]), sigm(v1[3])); *(u32x4*)(base + bj * 128) = w; }
                }
            }
    }
};
struct EpiLora {
    static constexpr bool PERM = false;
    const float *w0, *a0; float *DEC, *AA; bf16* GG;
    template <int MODE> __device__ __forceinline__ void body(AccRef acc, int rowb, int cb) const {
#pragma unroll
        for (int ai = 0; ai < 2; ++ai)
#pragma unroll
            for (int m = 0; m < 4; ++m) {
                const int row = rowb + ai * 128 + m * 16;
#pragma unroll
                for (int bj = 0; bj < 2; ++bj)
#pragma unroll
                    for (int n = 0; n < 2; ++n) {
                        const int c = cb + bj * 128 + n * 16;
                        f32x4 v = acc[ai][bj][m][n];
                        if (MODE == 0) { v = v + *(const f32x4*)(w0 + c); f32x4 o;
#pragma unroll
                            for (int j = 0; j < 4; ++j) { const float y = -v[j]; const float sp = y > 20.f ? y : __logf(1.f + __expf(y)); o[j] = __expf(-__expf(-sp - 0.5f)); }
                            *(f32x4*)(DEC + (size_t)row * 512 + c) = o;
                        } else if (MODE == 1) { v = v + *(const f32x4*)(a0 + c); f32x4 o;
#pragma unroll
                            for (int j = 0; j < 4; ++j) o[j] = sigm(v[j]);
                            *(f32x4*)(AA + (size_t)row * 512 + c) = o;
                        } else { u32x2 w; w.x = pk2(v[0], v[1]); w.y = pk2(v[2], v[3]); *(u32x2*)(GG + (size_t)row * 512 + c) = w; }
                    }
                asm volatile("" ::: "memory");
            }
    }
    __device__ __forceinline__ void operator()(AccRef acc, const Unit& u, int wr, int wc, int fr, int fq) const {
        const int pn = u.pn, rowb = u.pm * 256 + wr * 64 + fr, cb = (pn & 1) * 256 + wc * 32 + 4 * fq;
        if (pn < 2) body<0>(acc, rowb, cb); else if (pn < 4) body<1>(acc, rowb, cb); else body<2>(acc, rowb, cb);
    }
};
template <int SECOND> struct EpiMerge {
    static constexpr bool PERM = true;
    const bf16* GT; bf16* MG;
    __device__ __forceinline__ void operator()(AccRef acc, const Unit& u, int wr, int wc, int fr, int fq) const {
        const int rowb = u.pm * 256 + wr * 64 + fr, c0 = u.pn * 256 + wc * 32 + 8 * fq;
#pragma unroll
        for (int ai = 0; ai < 2; ++ai)
#pragma unroll
            for (int m = 0; m < 4; ++m) { const int row = rowb + ai * 128 + m * 16;
#pragma unroll
                for (int bj = 0; bj < 2; ++bj) {
                    const int c = c0 + bj * 128; const u32x4 gv = *(const u32x4*)(GT + (size_t)row * 2048 + SECOND * 1024 + c);
                    const f32x4 v0 = acc[ai][bj][m][0], v1 = acc[ai][bj][m][1];
                    float o[8] = {v0[0] * bflo(gv.x), v0[1] * bfhi(gv.x), v0[2] * bflo(gv.y), v0[3] * bfhi(gv.y), v1[0] * bflo(gv.z), v1[1] * bfhi(gv.z), v1[2] * bflo(gv.w), v1[3] * bfhi(gv.w)};
                    bf16* dst = MG + (size_t)row * 1024 + c;
                    if (SECOND) { const u32x4 ov = *(const u32x4*)dst; o[0] += bflo(ov.x); o[1] += bfhi(ov.x); o[2] += bflo(ov.y); o[3] += bfhi(ov.y); o[4] += bflo(ov.z); o[5] += bfhi(ov.z); o[6] += bflo(ov.w); o[7] += bfhi(ov.w); }
                    u32x4 w; w.x = pk2(o[0], o[1]); w.y = pk2(o[2], o[3]); w.z = pk2(o[4], o[5]); w.w = pk2(o[6], o[7]); *(u32x4*)dst = w; } }
    }
};
struct EpiX1 {
    static constexpr bool PERM = false;
    const float* X; float* X1; const float* gn; bf16* HN;
    __device__ __forceinline__ void operator()(AccRef acc, const Unit& u, int wr, int wc, int fr, int fq) const {
        const int rowb = u.pm * 256 + wr * 64 + fr, c0 = u.pn * 256 + wc * 32 + 4 * fq;
#pragma unroll
        for (int bj = 0; bj < 2; ++bj)
#pragma unroll
            for (int n = 0; n < 2; ++n) { const f32x4 gv = *(const f32x4*)(gn + c0 + bj * 128 + n * 16);
#pragma unroll
                for (int ai = 0; ai < 2; ++ai)
#pragma unroll
                    for (int m = 0; m < 4; ++m) { const size_t off = (size_t)(rowb + ai * 128 + m * 16) * D + c0 + bj * 128 + n * 16;
                        const f32x4 xv = *(const f32x4*)(X + off) + acc[ai][bj][m][n]; *(f32x4*)(X1 + off) = xv;
                        u32x2 w; w.x = pk2(xv[0] * gv[0], xv[1] * gv[1]); w.y = pk2(xv[2] * gv[2], xv[3] * gv[3]); *(u32x2*)(HN + off) = w; } }
    }
};
struct EpiSwiglu {
    static constexpr bool PERM = true;
    const float* b1; bf16* ACT; const int* LIST; const float* R1; const LAS int* OFF; const LAS int* CS;
    __device__ __forceinline__ void operator()(AccRef acc, const Unit& u, int wr, int wc, int fr, int fq) const {
        const int rowb = u.pm * 256 + wr * 64 + fr, c0 = u.pn * 256 + wc * 32 + 8 * fq;
        const float* bb = b1 + (size_t)u.e * F2; const int rbase = rowb - OFF[u.e], cnt = CS[u.e];
        float rs[2][4];
#pragma unroll
        for (int ai = 0; ai < 2; ++ai)
#pragma unroll
            for (int m = 0; m < 4; ++m) { const int r = rbase + ai * 128 + m * 16; rs[ai][m] = 0.f; if (r < cnt) rs[ai][m] = R1[LIST[(size_t)u.e * CAP + r] >> 2]; }
#pragma unroll
        for (int bj = 0; bj < 2; ++bj) {
            const f32x4 bv0 = *(const f32x4*)(bb + c0 + bj * 128), bv1 = *(const f32x4*)(bb + c0 + bj * 128 + 4);
#pragma unroll
            for (int ai = 0; ai < 2; ++ai)
#pragma unroll
                for (int m = 0; m < 4; ++m) { const int row = rowb + ai * 128 + m * 16;
                    const f32x4 v0 = acc[ai][bj][m][0] * rs[ai][m] + bv0, v1 = acc[ai][bj][m][1] * rs[ai][m] + bv1;
                    float o[4];
#pragma unroll
                    for (int p = 0; p < 4; ++p) { float gl = p < 2 ? v0[2 * p] : v1[2 * p - 4], ul = p < 2 ? v0[2 * p + 1] : v1[2 * p - 3];
                        gl = fminf(gl, 7.f); ul = fminf(fmaxf(ul, -7.f), 7.f); o[p] = (ul + 1.f) * gl * sigm(1.702f * gl); }
                    u32x2 w; w.x = pk2(o[0], o[1]); w.y = pk2(o[2], o[3]); *(u32x2*)(ACT + (size_t)row * FH + ((c0 + bj * 128) >> 1)) = w; } }
    }
};
struct EpiY {
    static constexpr bool PERM = true;
    const float* b2; const int* LIST; const float* gatew; bf16* YB; const LAS int* OFF; const LAS int* CS;
    __device__ __forceinline__ void operator()(AccRef acc, const Unit& u, int wr, int wc, int fr, int fq) const {
        const int rowb = u.pm * 256 + wr * 64 + fr, c0 = u.pn * 256 + wc * 32 + 8 * fq;
        const float* bb = b2 + (size_t)u.e * D; const int rbase = rowb - OFF[u.e], cnt = CS[u.e];
#pragma unroll
        for (int ai = 0; ai < 2; ++ai)
#pragma unroll
            for (int m = 0; m < 4; ++m) { const int r = rbase + ai * 128 + m * 16;
                if (r < cnt) { const int slot = LIST[(size_t)u.e * CAP + r]; const float gt = gatew[slot];
#pragma unroll
                    for (int bj = 0; bj < 2; ++bj) { const int c = c0 + bj * 128;
                        const f32x4 v0 = (acc[ai][bj][m][0] + *(const f32x4*)(bb + c)) * gt, v1 = (acc[ai][bj][m][1] + *(const f32x4*)(bb + c + 4)) * gt;
                        u32x4 w; w.x = pk2(v0[0], v0[1]); w.y = pk2(v0[2], v0[3]); w.z = pk2(v1[0], v1[1]); w.w = pk2(v1[2], v1[3]); *(u32x4*)(YB + (size_t)slot * D + c) = w; } } }
    }
};
struct EpiGate {
    static constexpr bool PERM = true;
    const float* rstd2; bf16* GT;
    __device__ __forceinline__ void operator()(AccRef acc, const Unit& u, int wr, int wc, int fr, int fq) const {
        const int rowb = u.pm * 256 + wr * 64 + fr, c0 = u.pn * 256 + wc * 32 + 8 * fq;
#pragma unroll
        for (int ai = 0; ai < 2; ++ai)
#pragma unroll
            for (int m = 0; m < 4; ++m) { const int row = rowb + ai * 128 + m * 16; const float rs = rstd2[row];
#pragma unroll
                for (int bj = 0; bj < 2; ++bj) { const f32x4 v0 = acc[ai][bj][m][0] * rs, v1 = acc[ai][bj][m][1] * rs;
                    u32x4 w; w.x = pk2(sigm(v0[0]), sigm(v0[1])); w.y = pk2(sigm(v0[2]), sigm(v0[3])); w.z = pk2(sigm(v1[0]), sigm(v1[1])); w.w = pk2(sigm(v1[2]), sigm(v1[3]));
                    *(u32x4*)(GT + (size_t)row * D + c0 + bj * 128) = w; } }
    }
};
struct EpiPle {
    static constexpr bool PERM = true;
    const bf16* X2B; const bf16* GT; float* O; float* rowss;
    __device__ __forceinline__ void operator()(AccRef acc, const Unit& u, int wr, int wc, int fr, int fq) const {
        const int rowb = u.pm * 256 + wr * 64 + fr, c0 = u.pn * 256 + wc * 32 + 8 * fq;
#pragma unroll
        for (int ai = 0; ai < 2; ++ai)
#pragma unroll
            for (int m = 0; m < 4; ++m) { const int row = rowb + ai * 128 + m * 16; float ss = 0.f;
#pragma unroll
                for (int bj = 0; bj < 2; ++bj) { const size_t off = (size_t)row * D + c0 + bj * 128;
                    const u32x4 xv = *(const u32x4*)(X2B + off), gv = *(const u32x4*)(GT + off); const f32x4 a0 = acc[ai][bj][m][0], a1 = acc[ai][bj][m][1];
                    f32x4 o0, o1;
                    o0[0] = bflo(xv.x) + bflo(gv.x) * a0[0]; o0[1] = bfhi(xv.x) + bfhi(gv.x) * a0[1]; o0[2] = bflo(xv.y) + bflo(gv.y) * a0[2]; o0[3] = bfhi(xv.y) + bfhi(gv.y) * a0[3];
                    o1[0] = bflo(xv.z) + bflo(gv.z) * a1[0]; o1[1] = bfhi(xv.z) + bfhi(gv.z) * a1[1]; o1[2] = bflo(xv.w) + bflo(gv.w) * a1[2]; o1[3] = bfhi(xv.w) + bfhi(gv.w) * a1[3];
#pragma unroll
                    for (int j = 0; j < 4; ++j) ss += o0[j] * o0[j] + o1[j] * o1[j];
                    *(f32x4*)(O + off) = o0; *(f32x4*)(O + off + 4) = o1; }
                ss += __shfl_xor(ss, 16); ss += __shfl_xor(ss, 32);
                if (fq == 0) atomicAdd(rowss + row, ss);
                asm volatile("" ::: "memory"); }
    }
};

__device__ __forceinline__ void build_alora(const Args& args, Frame& F, int pm) {
    const bf16* ZR = WSP(bf16, WS_ZR); bf16* AL = WSP(bf16, WS_ALORA); const float* mu = FIN(4) + 1536;
#pragma unroll 2
    for (int i = 0; i < 16; ++i) {
        const int id = F.tid + 512 * i, row = pm * 256 + (id >> 5), cc = (id & 31) * 8;
        const u32x4 zc = *(const u32x4*)(ZR + (size_t)row * RWC + 1536 + cc);
        u32x4 zp = (u32x4){0u, 0u, 0u, 0u}; if ((row & (SEQ - 1)) != 0) zp = *(const u32x4*)(ZR + (size_t)(row - 1) * RWC + 1536 + cc);
        const unsigned zcw[4] = {zc.x, zc.y, zc.z, zc.w}, zpw[4] = {zp.x, zp.y, zp.z, zp.w}; float o[8];
#pragma unroll
        for (int j = 0; j < 8; ++j) { const float c = (j & 1) ? bfhi(zcw[j >> 1]) : bflo(zcw[j >> 1]), p = (j & 1) ? bfhi(zpw[j >> 1]) : bflo(zpw[j >> 1]);
            const float xs = c + mu[cc + j] * (p - c);
            o[j] = cc < 64 ? (1.f - 2.f * __builtin_amdgcn_rcpf(1.f + __expf(2.f * xs))) : (cc < 128 ? xs : sigm(xs)); }
        u32x4 w; w.x = pk2(o[0], o[1]); w.y = pk2(o[2], o[3]); w.z = pk2(o[4], o[5]); w.w = pk2(o[6], o[7]);
        *(u32x4*)(AL + (size_t)row * LORA_K + cc) = w;
    }
}

__device__ __forceinline__ void scan_unit(const Args& args, Frame& F, int bh) {
    const int b = bh >> 3, h = bh & 7, tid = F.tid;
    LAS float* LW = (LAS float*)F.lds;
    LAS float* LKK = LW + 4096, *LBB = LW + 8192, *LKP = LW + 12288, *LRR = LW + 16384, *LVV = LW + 20480, *LYY = LW + 24576, *LBON = LW + 28672;
    const bf16* ZR = WSP(bf16, WS_ZR); const float* DEC = WSP(float, WS_DEC); const float* AA = WSP(float, WS_AA); const bf16* GG = WSP(bf16, WS_GG); bf16* YB = WSP(bf16, WS_YB);
    const float* mu = FIN(4); const float* k_k = FIN(10) + h * 64; const float* k_a = FIN(11) + h * 64; const float* r_k = FIN(12) + h * 64;
    const float* lnw = FIN(13) + h * 64; const float* lnb = FIN(14) + h * 64;
    const int tt_p = tid >> 3, j0 = 8 * (tid & 7);
    const int row = tid >> 3, cg = tid & 7;
    float S[8];
#pragma unroll
    for (int j = 0; j < 8; ++j) S[j] = 0.f;
    float mur[8], muk[8], muv[8], kk_c[8], ka_c[8], rk_c[8];
#pragma unroll
    for (int j = 0; j < 8; ++j) { mur[j] = mu[h * 64 + j0 + j]; muk[j] = mu[512 + h * 64 + j0 + j]; muv[j] = mu[1024 + h * 64 + j0 + j]; kk_c[j] = k_k[j0 + j]; ka_c[j] = k_a[j0 + j]; rk_c[j] = r_k[j0 + j]; }
    for (int c0 = 0; c0 < SEQ; c0 += 64) {
        __syncthreads();
        {
            const size_t tok = (size_t)b * SEQ + c0 + tt_p; const bool first = (c0 + tt_p) == 0;
            const bf16* zc = ZR + tok * RWC + h * 64 + j0; const bf16* zp = zc - RWC;
            u32x4 cr = *(const u32x4*)zc, ck = *(const u32x4*)(zc + 512), cv = *(const u32x4*)(zc + 1024);
            u32x4 pr = (u32x4){0u, 0u, 0u, 0u}, pk = pr, pv = pr;
            if (!first) { pr = *(const u32x4*)zp; pk = *(const u32x4*)(zp + 512); pv = *(const u32x4*)(zp + 1024); }
            const f32x4 d0 = *(const f32x4*)(DEC + tok * 512 + h * 64 + j0), d1 = *(const f32x4*)(DEC + tok * 512 + h * 64 + j0 + 4);
            const f32x4 a0 = *(const f32x4*)(AA + tok * 512 + h * 64 + j0), a1 = *(const f32x4*)(AA + tok * 512 + h * 64 + j0 + 4);
            const unsigned crw[4] = {cr.x, cr.y, cr.z, cr.w}, ckw[4] = {ck.x, ck.y, ck.z, ck.w}, cvw[4] = {cv.x, cv.y, cv.z, cv.w};
            const unsigned prw[4] = {pr.x, pr.y, pr.z, pr.w}, pkw[4] = {pk.x, pk.y, pk.z, pk.w}, pvw[4] = {pv.x, pv.y, pv.z, pv.w};
            float r[8], k[8], v[8], kk[8], a[8], dec[8]; float ss = 0.f;
#pragma unroll
            for (int j = 0; j < 8; ++j) {
                const float rc = (j & 1) ? bfhi(crw[j >> 1]) : bflo(crw[j >> 1]), rp = (j & 1) ? bfhi(prw[j >> 1]) : bflo(prw[j >> 1]);
                const float kc = (j & 1) ? bfhi(ckw[j >> 1]) : bflo(ckw[j >> 1]), kp = (j & 1) ? bfhi(pkw[j >> 1]) : bflo(pkw[j >> 1]);
                const float vc = (j & 1) ? bfhi(cvw[j >> 1]) : bflo(cvw[j >> 1]), vp = (j & 1) ? bfhi(pvw[j >> 1]) : bflo(pvw[j >> 1]);
                r[j] = rc + mur[j] * (rp - rc); k[j] = kc + muk[j] * (kp - kc); v[j] = vc + muv[j] * (vp - vc);
                kk[j] = k[j] * kk_c[j]; ss += kk[j] * kk[j];
                a[j] = j < 4 ? a0[j] : a1[j - 4]; dec[j] = j < 4 ? d0[j] : d1[j - 4];
            }
            ss = red8(ss);
            const float inv = 1.0f / fmaxf(sqrtf(ss), 1e-12f);
            float bon = 0.f; float kpv[8], bbv[8];
#pragma unroll
            for (int j = 0; j < 8; ++j) { kk[j] *= inv; bbv[j] = kk[j] * a[j]; kpv[j] = k[j] * (1.f + (a[j] - 1.f) * ka_c[j]); bon += r[j] * kpv[j] * rk_c[j]; }
            bon = red8(bon);
            const int o = tt_p * 64 + j0;
            *(LAS f32x4*)(LW + o) = (f32x4){dec[0], dec[1], dec[2], dec[3]}; *(LAS f32x4*)(LW + o + 4) = (f32x4){dec[4], dec[5], dec[6], dec[7]};
            *(LAS f32x4*)(LKK + o) = (f32x4){kk[0], kk[1], kk[2], kk[3]}; *(LAS f32x4*)(LKK + o + 4) = (f32x4){kk[4], kk[5], kk[6], kk[7]};
            *(LAS f32x4*)(LBB + o) = (f32x4){bbv[0], bbv[1], bbv[2], bbv[3]}; *(LAS f32x4*)(LBB + o + 4) = (f32x4){bbv[4], bbv[5], bbv[6], bbv[7]};
            *(LAS f32x4*)(LKP + o) = (f32x4){kpv[0], kpv[1], kpv[2], kpv[3]}; *(LAS f32x4*)(LKP + o + 4) = (f32x4){kpv[4], kpv[5], kpv[6], kpv[7]};
            *(LAS f32x4*)(LRR + o) = (f32x4){r[0], r[1], r[2], r[3]}; *(LAS f32x4*)(LRR + o + 4) = (f32x4){r[4], r[5], r[6], r[7]};
            *(LAS f32x4*)(LVV + o) = (f32x4){v[0], v[1], v[2], v[3]}; *(LAS f32x4*)(LVV + o + 4) = (f32x4){v[4], v[5], v[6], v[7]};
            if ((tid & 7) == 0) LBON[tt_p] = bon;
        }
        __syncthreads();
#pragma unroll 2
        for (int tt = 0; tt < 64; ++tt) {
            const int o = tt * 64 + 8 * cg;
            const f32x4 k0 = *(const LAS f32x4*)(LKK + o), k1 = *(const LAS f32x4*)(LKK + o + 4);
            const f32x4 w0 = *(const LAS f32x4*)(LW + o), w1 = *(const LAS f32x4*)(LW + o + 4);
            const f32x4 b0 = *(const LAS f32x4*)(LBB + o), b1 = *(const LAS f32x4*)(LBB + o + 4);
            const f32x4 p0 = *(const LAS f32x4*)(LKP + o), p1 = *(const LAS f32x4*)(LKP + o + 4);
            const f32x4 r0 = *(const LAS f32x4*)(LRR + o), r1 = *(const LAS f32x4*)(LRR + o + 4);
            const float vi = LVV[tt * 64 + row];
            float sa = (S[0] * k0[0] + S[1] * k0[1]) + (S[2] * k0[2] + S[3] * k0[3]) + (S[4] * k1[0] + S[5] * k1[1]) + (S[6] * k1[2] + S[7] * k1[3]);
            sa = -red8(sa);
#pragma unroll
            for (int j = 0; j < 4; ++j) { S[j] = S[j] * w0[j] + (sa * b0[j] + vi * p0[j]); S[4 + j] = S[4 + j] * w1[j] + (sa * b1[j] + vi * p1[j]); }
            float y = (S[0] * r0[0] + S[1] * r0[1]) + (S[2] * r0[2] + S[3] * r0[3]) + (S[4] * r1[0] + S[5] * r1[1]) + (S[6] * r1[2] + S[7] * r1[3]);
            y = red8(y);
            if (cg == 0) LYY[tt * 64 + row] = y;
        }
        __syncthreads();
        {
            const size_t tok = (size_t)b * SEQ + c0 + tt_p; const int o = tt_p * 64 + j0;
            const f32x4 y0 = *(const LAS f32x4*)(LYY + o), y1 = *(const LAS f32x4*)(LYY + o + 4);
            const f32x4 v0 = *(const LAS f32x4*)(LVV + o), v1 = *(const LAS f32x4*)(LVV + o + 4);
            float s = (y0[0] + y0[1]) + (y0[2] + y0[3]) + (y1[0] + y1[1]) + (y1[2] + y1[3]);
            const float mean = red8(s) * (1.f / 64.f); float q = 0.f;
#pragma unroll
            for (int j = 0; j < 4; ++j) { const float d0 = y0[j] - mean, d1 = y1[j] - mean; q += d0 * d0 + d1 * d1; }
            const float rs = 1.0f / sqrtf(red8(q) * (1.f / 64.f) + GN_EPS); const float bon = LBON[tt_p];
            const u32x4 gv = *(const u32x4*)(GG + tok * 512 + h * 64 + j0); const unsigned gw[4] = {gv.x, gv.y, gv.z, gv.w}; float ov[8];
#pragma unroll
            for (int j = 0; j < 8; ++j) { const float yy = j < 4 ? y0[j] : y1[j - 4], vv = j < 4 ? v0[j] : v1[j - 4]; const float g = (j & 1) ? bfhi(gw[j >> 1]) : bflo(gw[j >> 1]);
                ov[j] = ((yy - mean) * rs * lnw[j0 + j] + lnb[j0 + j] + bon * vv) * g; }
            u32x4 w; w.x = pk2(ov[0], ov[1]); w.y = pk2(ov[2], ov[3]); w.z = pk2(ov[4], ov[5]); w.w = pk2(ov[6], ov[7]);
            *(u32x4*)(YB + tok * 512 + h * 64 + j0) = w;
        }
    }
    __syncthreads();
}

constexpr int LDA = 72, LDT = 40, LDF = 36;
constexpr int SC_WF = 0, SC_AT = 8192, SC_RT = SC_AT + 4608, SC_BT = SC_RT + 4608, SC_KT = SC_BT + 4608;
constexpr int SC_BCT = SC_KT + 4608, SC_KCT = SC_BCT + 5120, SC_VT = SC_KCT + 5120, SC_AHT = SC_VT + 5120, SC_UHT = SC_AHT + 5120;
constexpr int SC_AAB = SC_UHT + 5120, SC_ARB = SC_AAB + 4608, SC_ARK = SC_ARB + 2560, SC_RHS2 = SC_ARK + 2560, SC_YF = SC_RHS2 + 16384, SC_HT = SC_YF + 8192, SC_BON = SC_HT + 9216;
static_assert(SC_BON + 128 + 2048 <= RING_BYTES, "scan LDS map");
__device__ __forceinline__ float red16(float v) { v += dppf<0xB1>(v); v += dppf<0x4E>(v); v += dppf<0x141>(v); v += dppf<0x140>(v); return v; }
__device__ __forceinline__ bf16x8 ld16(const LAS bf16* p) { return *(const LAS bf16x8*)p; }
__device__ __forceinline__ bf16x8 ld8x2(const LAS bf16* p) { const u32x2 lo = *(const LAS u32x2*)p, hi = *(const LAS u32x2*)(p + 8); const u32x4 w = (u32x4){lo.x, lo.y, hi.x, hi.y}; return __builtin_bit_cast(bf16x8, w); }
__device__ __forceinline__ bf16x8 packq(const f32x16& x, int q) { u32x4 w; w.x = pk2(x[8 * q], x[8 * q + 1]); w.y = pk2(x[8 * q + 2], x[8 * q + 3]); w.z = pk2(x[8 * q + 4], x[8 * q + 5]); w.w = pk2(x[8 * q + 6], x[8 * q + 7]); return __builtin_bit_cast(bf16x8, w); }
#define MFMA32(a, b, c) __builtin_amdgcn_mfma_f32_32x32x16_bf16((a), (b), (c), 0, 0, 0)
struct ScanLoad { u32x2 cr, ck, cv, pr, pk, pv, g; f32x4 dec, eta; };
__device__ __forceinline__ void scan_load(ScanLoad& L, const bf16* ZR, const float* DEC, const float* AA, const bf16* GG, size_t tok, int hc, bool first) {
    const bf16* zc = ZR + tok * RWC + hc; const bf16* zp = zc - RWC;
    L.cr = *(const u32x2*)zc; L.ck = *(const u32x2*)(zc + 512); L.cv = *(const u32x2*)(zc + 1024);
    L.pr = (u32x2){0u, 0u}; L.pk = L.pr; L.pv = L.pr;
    if (!first) { L.pr = *(const u32x2*)zp; L.pk = *(const u32x2*)(zp + 512); L.pv = *(const u32x2*)(zp + 1024); }
    L.dec = *(const f32x4*)(DEC + tok * 512 + hc); L.eta = *(const f32x4*)(AA + tok * 512 + hc); L.g = *(const u32x2*)(GG + tok * 512 + hc);
}
#define LBAR() do { asm volatile("s_waitcnt lgkmcnt(0)" ::: "memory"); __builtin_amdgcn_s_barrier(); asm volatile("" ::: "memory"); } while (0)
__device__ __forceinline__ void scan_unit_chunked(const Args& args, Frame& F, int bh) {
    const int b = bh >> 3, h = bh & 7, tid = F.tid, w = F.wave;
    LAS unsigned char* L = F.lds;
    LAS float* WF = (LAS float*)(L + SC_WF); LAS float* AAB = (LAS float*)(L + SC_AAB); LAS float* RHS2 = (LAS float*)(L + SC_RHS2); LAS float* YF = (LAS float*)(L + SC_YF); LAS float* BON = (LAS float*)(L + SC_BON);
    LAS bf16* AT = (LAS bf16*)(L + SC_AT); LAS bf16* RT = (LAS bf16*)(L + SC_RT); LAS bf16* BT = (LAS bf16*)(L + SC_BT); LAS bf16* KT = (LAS bf16*)(L + SC_KT);
    LAS bf16* BCT = (LAS bf16*)(L + SC_BCT); LAS bf16* KCT = (LAS bf16*)(L + SC_KCT); LAS bf16* VT = (LAS bf16*)(L + SC_VT); LAS bf16* AHT = (LAS bf16*)(L + SC_AHT); LAS bf16* UHT = (LAS bf16*)(L + SC_UHT);
    LAS bf16* ARB = (LAS bf16*)(L + SC_ARB); LAS bf16* ARK = (LAS bf16*)(L + SC_ARK); LAS bf16* HT = (LAS bf16*)(L + SC_HT);
    const bf16* ZR = WSP(bf16, WS_ZR); const float* DEC = WSP(float, WS_DEC); const float* AA = WSP(float, WS_AA); const bf16* GG = WSP(bf16, WS_GG); bf16* YB = WSP(bf16, WS_YB);
    const int t = tid >> 4, j0 = 4 * (tid & 15), hc = h * 64 + j0;
    LAS float* CST = (LAS float*)(L + SC_BON + 128);
    { const int c = tid >> 6, j = tid & 63; const float* src = c == 0 ? FIN(4) : c == 1 ? FIN(4) + 512 : c == 2 ? FIN(4) + 1024 : c == 3 ? FIN(10) : c == 4 ? FIN(11) : c == 5 ? FIN(12) : c == 6 ? FIN(13) : FIN(14);
      CST[c * 64 + j] = src[h * 64 + j]; }
    for (int i = tid; i < 64 * LDA / 2; i += 512) ((LAS unsigned*)HT)[i] = 0u;
    ScanLoad cur; scan_load(cur, ZR, DEC, AA, GG, (size_t)b * SEQ + t, hc, t == 0);
    LBAR();
    for (int c0 = 0; c0 < SEQ; c0 += 32) {
        const size_t tok = (size_t)b * SEQ + c0 + t;
        float r[4], kp[4], v[4], al[4], be[4], gq[4];
        {
            const f32x4 mur = *(const LAS f32x4*)(CST + j0), muk = *(const LAS f32x4*)(CST + 64 + j0), muv = *(const LAS f32x4*)(CST + 128 + j0), kkc = *(const LAS f32x4*)(CST + 192 + j0), kac = *(const LAS f32x4*)(CST + 256 + j0), rkc = *(const LAS f32x4*)(CST + 320 + j0);
            const unsigned crw[2] = {cur.cr.x, cur.cr.y}, ckw[2] = {cur.ck.x, cur.ck.y}, cvw[2] = {cur.cv.x, cur.cv.y}, prw[2] = {cur.pr.x, cur.pr.y}, pkw[2] = {cur.pk.x, cur.pk.y}, pvw[2] = {cur.pv.x, cur.pv.y}, gw2[2] = {cur.g.x, cur.g.y};
            float k[4], kk[4]; float ss = 0.f;
#pragma unroll
            for (int j = 0; j < 4; ++j) {
                const float rc = (j & 1) ? bfhi(crw[j >> 1]) : bflo(crw[j >> 1]), rp = (j & 1) ? bfhi(prw[j >> 1]) : bflo(prw[j >> 1]);
                const float kc = (j & 1) ? bfhi(ckw[j >> 1]) : bflo(ckw[j >> 1]), kq = (j & 1) ? bfhi(pkw[j >> 1]) : bflo(pkw[j >> 1]);
                const float vc = (j & 1) ? bfhi(cvw[j >> 1]) : bflo(cvw[j >> 1]), vq = (j & 1) ? bfhi(pvw[j >> 1]) : bflo(pvw[j >> 1]);
                r[j] = rc + mur[j] * (rp - rc); k[j] = kc + muk[j] * (kq - kc); v[j] = vc + muv[j] * (vq - vc);
                kk[j] = k[j] * kkc[j]; ss += kk[j] * kk[j]; gq[j] = (j & 1) ? bfhi(gw2[j >> 1]) : bflo(gw2[j >> 1]);
            }
            ss = red16(ss);
            const float inv = 1.0f / fmaxf(sqrtf(ss), 1e-12f); float bon = 0.f;
#pragma unroll
            for (int j = 0; j < 4; ++j) { kk[j] *= inv; al[j] = -kk[j]; be[j] = kk[j] * cur.eta[j]; kp[j] = k[j] * (1.f + (cur.eta[j] - 1.f) * kac[j]); bon += r[j] * kp[j] * rkc[j]; }
            bon = red16(bon);
            *(LAS f32x4*)(WF + t * 64 + j0) = cur.dec;
            if ((tid & 15) == 0) BON[t] = bon;
        }
        if (c0 + 32 < SEQ) scan_load(cur, ZR, DEC, AA, GG, tok + 32, hc, false);
        LBAR();
        if (w == 0 && !(SCAN_STUB & 8)) { float g = 1.f; const int lane = lane_now();
#pragma unroll
            for (int tt = 0; tt < 32; ++tt) { g *= WF[tt * 64 + lane]; WF[tt * 64 + lane] = g; } }
        LBAR();
        {
            const f32x4 gt = *(const LAS f32x4*)(WF + t * 64 + j0), gC = *(const LAS f32x4*)(WF + 31 * 64 + j0);
            f32x4 gp = (f32x4){1.f, 1.f, 1.f, 1.f}; if (t > 0) gp = *(const LAS f32x4*)(WF + (t - 1) * 64 + j0);
            float a_[4], r_[4], b_[4], k_[4], bc[4], kc[4];
#pragma unroll
            for (int j = 0; j < 4; ++j) { const float ig = 1.0f / gt[j]; a_[j] = al[j] * gp[j]; r_[j] = r[j] * gt[j]; b_[j] = be[j] * ig; k_[j] = kp[j] * ig; bc[j] = b_[j] * gC[j]; kc[j] = k_[j] * gC[j]; }
            u32x2 wv; wv.x = pk2(a_[0], a_[1]); wv.y = pk2(a_[2], a_[3]); *(LAS u32x2*)(AT + t * LDA + j0) = wv;
            wv.x = pk2(r_[0], r_[1]); wv.y = pk2(r_[2], r_[3]); *(LAS u32x2*)(RT + t * LDA + j0) = wv;
            wv.x = pk2(b_[0], b_[1]); wv.y = pk2(b_[2], b_[3]); *(LAS u32x2*)(BT + t * LDA + j0) = wv;
            wv.x = pk2(k_[0], k_[1]); wv.y = pk2(k_[2], k_[3]); *(LAS u32x2*)(KT + t * LDA + j0) = wv;
#pragma unroll
            for (int j = 0; j < 4; ++j) { BCT[(j0 + j) * LDT + t] = (bf16)(pk2(bc[j], 0.f) & 0xffffu); KCT[(j0 + j) * LDT + t] = (bf16)(pk2(kc[j], 0.f) & 0xffffu); VT[(j0 + j) * LDT + t] = (bf16)(pk2(v[j], 0.f) & 0xffffu); }
        }
        LBAR();
        if (w < 4 && !(SCAN_STUB & 1)) {
            const int lane = lane_now(), r32 = lane & 31, hh = lane >> 5;
            f32x16 mT, mN;
#pragma unroll
            for (int i = 0; i < 16; ++i) { mT[i] = 0.f; mN[i] = 0.f; }
#pragma unroll
            for (int q = 0; q < 4; ++q) { const bf16x8 bfr = ld16(BT + r32 * LDA + 8 * hh + 16 * q), afr = ld16(AT + r32 * LDA + 8 * hh + 16 * q);
                mT = MFMA32(bfr, afr, mT);
                mN = MFMA32(afr, bfr, mN); }
#pragma unroll
            for (int i = 0; i < 16; ++i) { const int c_ = crow(i, hh); mT[i] = (c_ < r32) ? mT[i] : 0.f; mN[i] = (r32 < c_) ? mN[i] : 0.f; }
            f32x16 X;
            if (w < 2) {
#pragma unroll
                for (int i = 0; i < 16; ++i) X[i] = bflo((unsigned)AT[crow(i, hh) * LDA + 32 * w + r32]);
            } else {
                f32x16 kT;
#pragma unroll
                for (int i = 0; i < 16; ++i) { kT[i] = 0.f; X[i] = 0.f; }
#pragma unroll
                for (int q = 0; q < 4; ++q) kT = MFMA32(ld16(KT + r32 * LDA + 8 * hh + 16 * q), ld16(AT + r32 * LDA + 8 * hh + 16 * q), kT);
#pragma unroll
                for (int i = 0; i < 16; ++i) kT[i] = (crow(i, hh) < r32) ? kT[i] : 0.f;
#pragma unroll
                for (int q = 0; q < 2; ++q) X = MFMA32(packq(kT, q), ld8x2(VT + (32 * (w - 2) + r32) * LDT + 16 * q + 4 * hh), X);
            }
#pragma unroll
            for (int k = 0; k < 5; ++k) {
                const bf16x8 t0 = packq(mT, 0), t1 = packq(mT, 1), x0 = packq(X, 0), x1 = packq(X, 1);
                X = MFMA32(t0, x0, X); X = MFMA32(t1, x1, X);
                if (k < 4) {
                    const bf16x8 n0 = packq(mN, 0), n1 = packq(mN, 1);
                    f32x16 zT, zN;
#pragma unroll
                    for (int i = 0; i < 16; ++i) { zT[i] = 0.f; zN[i] = 0.f; }
                    zT = MFMA32(n0, t0, zT); zT = MFMA32(n1, t1, zT);
                    zN = MFMA32(t0, n0, zN); zN = MFMA32(t1, n1, zN);
                    mT = zT; mN = zN;
                }
            }
            LAS bf16* dst = ((w < 2) ? AHT : UHT) + (32 * (w & 1) + r32) * LDT + 4 * hh;
#pragma unroll
            for (int i4 = 0; i4 < 4; ++i4) { u32x2 wv; wv.x = pk2(X[4 * i4], X[4 * i4 + 1]); wv.y = pk2(X[4 * i4 + 2], X[4 * i4 + 3]); *(LAS u32x2*)(dst + 8 * i4) = wv; }
        } else if (w < 6 && !(SCAN_STUB & 1)) {
            const int lane = lane_now(), r32 = lane & 31, hh = lane >> 5;
            const LAS bf16* Aop = ((w & 1) ? KT : BT) + r32 * LDA + 8 * hh; const LAS bf16* Bop = RT + r32 * LDA + 8 * hh;
            f32x16 x;
#pragma unroll
            for (int i = 0; i < 16; ++i) x[i] = 0.f;
#pragma unroll
            for (int q = 0; q < 4; ++q) x = MFMA32(ld16(Aop + 16 * q), ld16(Bop + 16 * q), x);
#pragma unroll
            for (int i = 0; i < 16; ++i) x[i] = (crow(i, hh) <= r32) ? x[i] : 0.f;
            LAS bf16* dst = ((w & 1) ? ARK : ARB) + r32 * LDT + 4 * hh;
#pragma unroll
            for (int i4 = 0; i4 < 4; ++i4) { u32x2 wv; wv.x = pk2(x[4 * i4], x[4 * i4 + 1]); wv.y = pk2(x[4 * i4 + 2], x[4 * i4 + 3]); *(LAS u32x2*)(dst + 8 * i4) = wv; }
        }
        LBAR();
        f32x16 hn;
        if (SCAN_STUB & 4) { for (int i = 0; i < 16; ++i) hn[i] = 0.f; } else if (w < 4) {
            const int lane = lane_now(), r32 = lane & 31, hh = lane >> 5;
            const int jb = w >> 1, ib = w & 1;
            f32x16 pt[2];
#pragma unroll
            for (int a = 0; a < 2; ++a) {
#pragma unroll
                for (int i = 0; i < 16; ++i) pt[a][i] = 0.f;
#pragma unroll
                for (int q = 0; q < 2; ++q) pt[a] = MFMA32(ld16(AHT + (32 * a + r32) * LDT + 16 * q + 8 * hh), ld16(BCT + (32 * jb + r32) * LDT + 16 * q + 8 * hh), pt[a]);
            }
            { const float gC = WF[31 * 64 + 32 * jb + r32];
#pragma unroll
              for (int i = 0; i < 16; ++i) { const float add = (crow(i, hh) == r32) ? gC : 0.f; pt[0][i] += (jb == 0) ? add : 0.f; pt[1][i] += (jb == 0) ? 0.f : add; } }
#pragma unroll
            for (int i = 0; i < 16; ++i) hn[i] = 0.f;
#pragma unroll
            for (int q = 0; q < 2; ++q) {
                hn = MFMA32(ld16(BCT + (32 * jb + r32) * LDT + 16 * q + 8 * hh), ld16(UHT + (32 * ib + r32) * LDT + 16 * q + 8 * hh), hn);
                hn = MFMA32(ld16(KCT + (32 * jb + r32) * LDT + 16 * q + 8 * hh), ld16(VT + (32 * ib + r32) * LDT + 16 * q + 8 * hh), hn);
            }
#pragma unroll
            for (int a = 0; a < 2; ++a)
#pragma unroll
                for (int q = 0; q < 2; ++q) hn = MFMA32(packq(pt[a], q), ld8x2(HT + (32 * ib + r32) * LDA + 32 * a + 16 * q + 4 * hh), hn);
        } else if (w < 6) {
            const int lane = lane_now(), r32 = lane & 31, hh = lane >> 5;
            const int ib = w & 1;
            f32x16 rt[2];
#pragma unroll
            for (int a = 0; a < 2; ++a) {
#pragma unroll
                for (int i = 0; i < 16; ++i) rt[a][i] = bflo((unsigned)RT[r32 * LDA + 32 * a + crow(i, hh)]);
#pragma unroll
                for (int q = 0; q < 2; ++q) rt[a] = MFMA32(ld16(AHT + (32 * a + r32) * LDT + 16 * q + 8 * hh), ld16(ARB + r32 * LDT + 16 * q + 8 * hh), rt[a]);
            }
            f32x16 y;
#pragma unroll
            for (int i = 0; i < 16; ++i) y[i] = 0.f;
#pragma unroll
            for (int q = 0; q < 2; ++q) {
                y = MFMA32(ld16(ARB + r32 * LDT + 16 * q + 8 * hh), ld16(UHT + (32 * ib + r32) * LDT + 16 * q + 8 * hh), y);
                y = MFMA32(ld16(ARK + r32 * LDT + 16 * q + 8 * hh), ld16(VT + (32 * ib + r32) * LDT + 16 * q + 8 * hh), y);
            }
#pragma unroll
            for (int a = 0; a < 2; ++a)
#pragma unroll
                for (int q = 0; q < 2; ++q) y = MFMA32(packq(rt[a], q), ld8x2(HT + (32 * ib + r32) * LDA + 32 * a + 16 * q + 4 * hh), y);
#pragma unroll
            for (int i = 0; i < 16; ++i) YF[crow(i, hh) * 64 + 32 * ib + r32] = y[i];
        }
        LBAR();
        if (w < 4) {
            const int lane = lane_now(), r32 = lane & 31, hh = lane >> 5;
            const int jb = w >> 1, ib = w & 1; LAS bf16* dst = HT + (32 * ib + r32) * LDA + 32 * jb + 4 * hh;
#pragma unroll
            for (int i4 = 0; i4 < 4; ++i4) { u32x2 wv; wv.x = pk2(hn[4 * i4], hn[4 * i4 + 1]); wv.y = pk2(hn[4 * i4 + 2], hn[4 * i4 + 3]); *(LAS u32x2*)(dst + 8 * i4) = wv; }
        }
        {
            const f32x4 y4 = *(const LAS f32x4*)(YF + t * 64 + j0);
            const float mean = red16((y4[0] + y4[1]) + (y4[2] + y4[3])) * (1.f / 64.f); float qv = 0.f;
#pragma unroll
            for (int j = 0; j < 4; ++j) { const float d = y4[j] - mean; qv += d * d; }
            const float rs = 1.0f / sqrtf(red16(qv) * (1.f / 64.f) + GN_EPS); const float bon = BON[t]; float ov[4];
            const f32x4 lnw = *(const LAS f32x4*)(CST + 384 + j0), lnb = *(const LAS f32x4*)(CST + 448 + j0);
#pragma unroll
            for (int j = 0; j < 4; ++j) ov[j] = ((y4[j] - mean) * rs * lnw[j] + lnb[j] + bon * v[j]) * gq[j];
            u32x2 wv; wv.x = pk2(ov[0], ov[1]); wv.y = pk2(ov[2], ov[3]); *(u32x2*)(YB + tok * 512 + hc) = wv;
        }
        LBAR();
    }
}

__device__ __forceinline__ void attn_tile(Frame& F, int bh, int qt) {
    const int lane = F.lane, q = lane & 31, hi = lane >> 5, b = bh >> 3, h = bh & 7, t0 = 32 * qt;
    const size_t tokbase = (size_t)b * SEQ;
    const bf16* QB = WSP(bf16, WS_Q); const bf16* KB = WSP(bf16, WS_K); const bf16* VT = WSP(bf16, WS_VT); bf16* YA = WSP(bf16, WS_YA);
    bf16x8 qf[4];
    { const bf16* Qp = QB + (tokbase + t0 + q) * 512 + h * 64 + 8 * hi;
#pragma unroll
      for (int d0 = 0; d0 < 4; ++d0) qf[d0] = *(const bf16x8*)(Qp + 16 * d0); }
    f32x16 y0, y1;
#pragma unroll
    for (int r = 0; r < 16; ++r) { y0[r] = 0.f; y1[r] = 0.f; }
    float carry = 1.f;
    const bf16* Vrow = VT + ((size_t)(bh * 64) + q) * SEQ + 4 * hi;
    for (int s0 = t0; s0 >= 0; s0 -= 32) {
        bf16x8 kf[4];
        { const bf16* Kp = KB + (tokbase + s0 + q) * 512 + h * 64 + 8 * hi;
#pragma unroll
          for (int d0 = 0; d0 < 4; ++d0) kf[d0] = *(const bf16x8*)(Kp + 16 * d0); }
        u32x2 vlo[2][2], vhi[2][2];
#pragma unroll
        for (int dt = 0; dt < 2; ++dt)
#pragma unroll
            for (int s = 0; s < 2; ++s) { const bf16* vp = Vrow + (size_t)dt * 32 * SEQ + s0 + 16 * s; vlo[dt][s] = *(const u32x2*)vp; vhi[dt][s] = *(const u32x2*)(vp + 8); }
        f32x16 p;
#pragma unroll
        for (int r = 0; r < 16; ++r) p[r] = 0.f;
#pragma unroll
        for (int d0 = 0; d0 < 4; ++d0) p = __builtin_amdgcn_mfma_f32_32x32x16_bf16(kf[d0], qf[d0], p, 0, 0, 0);
        float om[16], be[16];
#pragma unroll
        for (int r = 0; r < 16; ++r) {
            const int kv = crow(r, hi); const bool valid = (s0 + kv) < (t0 + q);
            const float z = fminf(p[r], 80.f); const float t = __expf(z); const float o = __builtin_amdgcn_rcpf(1.f + t);
            om[r] = valid ? o : 1.f; be[r] = valid ? t * o : 0.f;
        }
        float el[16], G[4], PG[4];
#pragma unroll
        for (int i = 0; i < 4; ++i) { el[4 * i + 3] = 1.f; el[4 * i + 2] = om[4 * i + 3]; el[4 * i + 1] = el[4 * i + 2] * om[4 * i + 2]; el[4 * i] = el[4 * i + 1] * om[4 * i + 1]; G[i] = el[4 * i] * om[4 * i]; }
#pragma unroll
        for (int i = 0; i < 4; ++i) PG[i] = __shfl_xor(G[i], 32);
        float sG[4], sP[4];
        sG[3] = 1.f; sG[2] = G[3]; sG[1] = G[3] * G[2]; sG[0] = sG[1] * G[1];
        sP[3] = 1.f; sP[2] = PG[3]; sP[1] = PG[3] * PG[2]; sP[0] = sP[1] * PG[1];
        const float total = (sG[0] * G[0]) * (sP[0] * PG[0]);
        float A[16];
#pragma unroll
        for (int i = 0; i < 4; ++i) { const float eg = sG[i] * (hi ? sP[i] : sP[i] * PG[i]) * carry;
#pragma unroll
            for (int j = 0; j < 4; ++j) A[4 * i + j] = be[4 * i + j] * el[4 * i + j] * eg; }
        carry *= total;
        bf16x8 pf[2];
#pragma unroll
        for (int s = 0; s < 2; ++s) { u32x4 w; w.x = pk2(A[8 * s], A[8 * s + 1]); w.y = pk2(A[8 * s + 2], A[8 * s + 3]); w.z = pk2(A[8 * s + 4], A[8 * s + 5]); w.w = pk2(A[8 * s + 6], A[8 * s + 7]); pf[s] = __builtin_bit_cast(bf16x8, w); }
#pragma unroll
        for (int s = 0; s < 2; ++s) {
            const u32x4 a0 = (u32x4){vlo[0][s].x, vlo[0][s].y, vhi[0][s].x, vhi[0][s].y}, a1 = (u32x4){vlo[1][s].x, vlo[1][s].y, vhi[1][s].x, vhi[1][s].y};
            y0 = __builtin_amdgcn_mfma_f32_32x32x16_bf16(__builtin_bit_cast(bf16x8, a0), pf[s], y0, 0, 0, 0);
            y1 = __builtin_amdgcn_mfma_f32_32x32x16_bf16(__builtin_bit_cast(bf16x8, a1), pf[s], y1, 0, 0, 0);
        }
        if (__all(carry < 5.6e-14f)) break;
    }
    bf16* Yp = YA + (tokbase + t0 + q) * 512 + h * 64 + 4 * hi;
#pragma unroll
    for (int i = 0; i < 4; ++i) {
        u32x2 w0, w1; w0.x = pk2(y0[4 * i], y0[4 * i + 1]); w0.y = pk2(y0[4 * i + 2], y0[4 * i + 3]); w1.x = pk2(y1[4 * i], y1[4 * i + 1]); w1.y = pk2(y1[4 * i + 2], y1[4 * i + 3]);
        *(u32x2*)(Yp + 8 * i) = w0; *(u32x2*)(Yp + 32 + 8 * i) = w1;
    }
}

__device__ __forceinline__ void p5a_router(const Args& args, Frame& F) {
    LAS float* LG = (LAS float*)F.lds;
    LAS unsigned* HIST = (LAS unsigned*)(F.lds + 32768); LAS unsigned* BASE = HIST + 32;
    const float* X1 = WSP(float, WS_X1); const float* GW = WSP(float, WS_GW); const float* rb = FIN(20);
    unsigned* cnt = F.ctl + CW_CNT; int* LIST = WSP(int, WS_LIST); float* GATEW = WSP(float, WS_GATEW); float* R1 = WSP(float, WS_RSTD1);
    const int tid = F.tid, lane = F.lane, wave = F.wave;
    for (int tb = blockIdx.x; tb < M / 128; tb += F.G) {
        if (tid < 32) HIST[tid] = 0u;
        __syncthreads();
        int ex[4] = {0, 0, 0, 0}; float gt[4] = {0.f, 0.f, 0.f, 0.f}; unsigned lr[4] = {0u, 0u, 0u, 0u}; int tok = 0;
        if (wave < 4) {
            const int i = lane & 31, kh = lane >> 5; tok = tb * 128 + wave * 32 + i;
            const float* xr = X1 + (size_t)tok * D + 4 * kh;
            f32x16 acc;
#pragma unroll
            for (int r = 0; r < 16; ++r) acc[r] = 0.f;
            float ss = 0.f;
#pragma unroll 4
            for (int u = 0; u < 128; ++u) {
                const f32x4 a = *(const f32x4*)(xr + 8 * u); ss += (a[0] * a[0] + a[1] * a[1]) + (a[2] * a[2] + a[3] * a[3]);
                const float* gp = GW + (size_t)(8 * u + 4 * kh) * 32 + i;
#pragma unroll
                for (int j = 0; j < 4; ++j) acc = __builtin_amdgcn_mfma_f32_32x32x2f32(a[j], gp[32 * j], acc, 0, 0, 0);
            }
            ss += __shfl_xor(ss, 32);
            const float rstd = 1.0f / sqrtf(ss * (1.f / D) + RMS_EPS);
            if (kh == 0) R1[tok] = rstd;
            LAS float* L = LG + wave * (32 * 33);
#pragma unroll
            for (int r = 0; r < 16; ++r) L[crow(r, kh) * 33 + i] = acc[r];
            asm volatile("s_waitcnt lgkmcnt(0)" ::: "memory");
            if (kh == 0) {
                float v0 = -3.0e38f, v1 = -3.0e38f, v2 = -3.0e38f, v3 = -3.0e38f; int i0 = 0, i1 = 0, i2 = 0, i3 = 0;
                for (int e = 0; e < 32; ++e) { const float v = L[i * 33 + e] * rstd + rb[e];
                    if (v > v3) { if (v > v2) { v3 = v2; i3 = i2; if (v > v1) { v2 = v1; i2 = i1; if (v > v0) { v1 = v0; i1 = i0; v0 = v; i0 = e; } else { v1 = v; i1 = e; } } else { v2 = v; i2 = e; } } else { v3 = v; i3 = e; } } }
                const float e1 = __expf(v1 - v0), e2 = __expf(v2 - v0), e3 = __expf(v3 - v0), inv = 1.0f / (1.f + e1 + e2 + e3);
                ex[0] = i0; ex[1] = i1; ex[2] = i2; ex[3] = i3; gt[0] = inv; gt[1] = e1 * inv; gt[2] = e2 * inv; gt[3] = e3 * inv;
#pragma unroll
                for (int k = 0; k < 4; ++k) lr[k] = __hip_atomic_fetch_add(&HIST[ex[k]], 1u, __ATOMIC_RELAXED, __HIP_MEMORY_SCOPE_WORKGROUP);
            }
        }
        __syncthreads();
        if (tid < 32) BASE[tid] = __hip_atomic_fetch_add(cnt + tid, HIST[tid], RLX_AGENT);
        __syncthreads();
        if (wave < 4 && lane < 32) {
#pragma unroll
            for (int k = 0; k < 4; ++k) { const unsigned pos = BASE[ex[k]] + lr[k]; LIST[(size_t)ex[k] * CAP + pos] = tok * 4 + k; GATEW[tok * 4 + k] = gt[k]; }
        }
        __syncthreads();
    }
}
__device__ __forceinline__ int moe_tables(Frame& F) {
    LAS int* CS = (LAS int*)(F.lds + MOE_OFF); LAS int* OFF = CS + 32; LAS unsigned char* TE = F.lds + MOE_TE;
    if (F.tid < 32) { int c = (int)__hip_atomic_load(F.ctl + CW_CNT + F.tid, RLX_AGENT); CS[F.tid] = c > CAP ? CAP : c; }
    __syncthreads();
    if (F.tid == 0) { int off = 0; for (int e = 0; e < 32; ++e) { OFF[e] = off; off += ((CS[e] + 255) >> 8) << 8; } OFF[32] = off; }
    __syncthreads();
    const int ntiles = OFF[32] >> 8;
    for (int t = F.tid; t < ntiles; t += 512) { int e = 0; while (e < 31 && OFF[e + 1] <= t * 256) ++e; TE[t] = (unsigned char)e; }
    __syncthreads();
    return ntiles;
}
__device__ __forceinline__ void p8_combine(Frame& F) {
    float* X1 = WSP(float, WS_X1); const bf16* YBF = WSP(bf16, WS_YBUF); bf16* X2B = WSP(bf16, WS_X2B); float* R2 = WSP(float, WS_RSTD2); float* RSS = WSP(float, WS_ROWSS);
    const int gw = F.vcu * 8 + F.wave, NGW = F.G * 8, lane = F.lane;
    for (int t = gw; t < M; t += NGW) {
        f32x4* xr = (f32x4*)(X1 + (size_t)t * D) + lane; f32x4 v[4]; float s = 0.f;
#pragma unroll
        for (int j = 0; j < 4; ++j) v[j] = xr[64 * j];
#pragma unroll
        for (int k = 0; k < 4; ++k) { const u32x2* yr = (const u32x2*)(YBF + (size_t)(4 * t + k) * D) + lane;
#pragma unroll
            for (int j = 0; j < 4; ++j) { const u32x2 w = yr[64 * j]; v[j].x += bflo(w.x); v[j].y += bfhi(w.x); v[j].z += bflo(w.y); v[j].w += bfhi(w.y); } }
        u32x2* o = (u32x2*)(X2B + (size_t)t * D) + lane;
#pragma unroll
        for (int j = 0; j < 4; ++j) { s += (v[j].x * v[j].x + v[j].y * v[j].y) + (v[j].z * v[j].z + v[j].w * v[j].w); u32x2 w; w.x = pk2(v[j].x, v[j].y); w.y = pk2(v[j].z, v[j].w); o[64 * j] = w; }
        s = wave_sum(s);
        if (lane == 0) { R2[t] = 1.0f / sqrtf(s * (1.f / D) + RMS_EPS); RSS[t] = 0.f; }
    }
}
__device__ __forceinline__ void p10_final(const Args& args, Frame& F) {
    const float* RSS = WSP(float, WS_ROWSS); const float* fg = FIN(28);
    const int gw = F.vcu * 8 + F.wave, NGW = F.G * 8, lane = F.lane;
    f32x4 g[4];
#pragma unroll
    for (int j = 0; j < 4; ++j) g[j] = ((const f32x4*)fg)[64 * j + lane];
    for (int t = gw; t < M; t += 2 * NGW) {
        const int t2 = t + NGW;
        f32x4* xr = (f32x4*)(F.out + (size_t)t * D) + lane; f32x4* xr2 = (f32x4*)(F.out + (size_t)(t2 < M ? t2 : t) * D) + lane;
        const float rs = 1.0f / sqrtf(RSS[t] * (1.f / D) + RMS_EPS), rs2 = 1.0f / sqrtf(RSS[t2 < M ? t2 : t] * (1.f / D) + RMS_EPS);
        f32x4 v[4], v2[4];
#pragma unroll
        for (int j = 0; j < 4; ++j) { v[j] = xr[64 * j]; v2[j] = xr2[64 * j]; }
#pragma unroll
        for (int j = 0; j < 4; ++j) { v[j] = v[j] * rs * g[j];
            if (TS_PROBE >= 0 && t == 0 && lane == 0 && j == 0) { const unsigned long long* ts = (const unsigned long long*)(F.ctl + 2048); const unsigned long long dt = ts[TS_PROBE + 1] - ts[TS_PROBE]; v[j].x += (float)((dt + 800) / 1600) * 4.f; }
            xr[64 * j] = v[j]; }
        if (t2 < M) {
#pragma unroll
            for (int j = 0; j < 4; ++j) xr2[64 * j] = v2[j] * rs2 * g[j]; }
    }
}

constexpr int NPHASE = 12;
__global__ void __launch_bounds__(512, 2) mega_fwd(Args args) {
    extern __shared__ __attribute__((aligned(16))) unsigned char lds[];
    Frame F;
    F.lds = (LAS unsigned char*)lds;
    F.wave = __builtin_amdgcn_readfirstlane((int)threadIdx.x >> 6); F.lane = lane_now(); F.tid = F.wave * 64 + F.lane;
    F.G = gridDim.x; { const int bx = blockIdx.x; F.vcu = (F.G % 8 == 0) ? (bx % 8) * (F.G / 8) + bx / 8 : bx; }
    F.ws = args.ws; F.ctl = (unsigned*)(args.ws + WS_CTL); F.out = args.out;
    volatile LAS unsigned* MISC = (volatile LAS unsigned*)(F.lds + LDSCTL_OFF);
    if (F.tid < 64) MISC[F.tid] = 0u;
    __syncthreads();
    const int lo = args.ph_lo, hi = args.ph_hi;
    XcdBarrier bar; bar.bar = F.ctl + CW_BAR; bar.x = 0; bar.st = nullptr;
    if (hi - lo > 1) bar = xcd_barrier_post(F.ctl + CW_BAR, MISC + 8, F.tid);
#ifndef PH_MASK
#define PH_MASK 0xFFFF
#endif
#define IN(k) ((((PH_MASK) >> (k)) & 1) && lo <= (k) && (k) < hi)
#define STAMP(k) do { if (TS_PROBE >= 0 && blockIdx.x == 0 && F.tid == 0) ((unsigned long long*)(F.ctl + 2048))[k] = __builtin_amdgcn_s_memrealtime(); } while (0)
#define SEAM(k) do { if (IN(k) && IN((k) + 1)) xcd_barrier(bar, F.wave); F.lane = lane_now(); F.tid = F.wave * 64 + F.lane; STAMP((k) + 1); } while (0)
    LAS unsigned char* ring = F.lds;
    STAMP(0);

    if (IN(0)) { p0_prologue(args, F); if (F.G < 256) expert_convert(args, F, F.vcu * 8 + F.wave, F.G * 8); } SEAM(0);

    if (IN(1)) {
        pg8::Gemm g{WSP(bf16, WS_XB), WSP(bf16, WS_WIN), M, INC, D, 0, nullptr, nullptr, nullptr}; pg8::StaticOrder S; S.init(M, INC, F.G, (int)blockIdx.x);
        EpiG1 E{WSP(float, WS_RSTD0), WSP(bf16, WS_Q), WSP(bf16, WS_K), WSP(bf16, WS_VT), WSP(bf16, WS_ZR), WSP(bf16, WS_GT)};
        pg8::gemm_phase(ring, g, S, E, F.wave);
    } SEAM(1);

    if (IN(2)) {
        for (int c = blockIdx.x; c < 256; c += F.G) {
            const int x = c & 7, y = c >> 3; pg8::LoraOrder S; S.half = y & 1; S.pm = x + 8 * (y >> 1); S.nu = 3 + (F.G >> 30);
            build_alora(args, F, S.pm);
            asm volatile("s_waitcnt vmcnt(0)" ::: "memory"); __syncthreads();
            pg8::Gemm g{WSP(bf16, WS_ALORA), WSP(bf16, WS_WL), M, LORA_N, LORA_K, 0, nullptr, nullptr, nullptr};
            EpiLora E{FIN(5), FIN(7), WSP(float, WS_DEC), WSP(float, WS_AA), WSP(bf16, WS_GG)};
            pg8::gemm_phase(ring, g, S, E, F.wave);
        }
    } SEAM(2);

    if (IN(3)) {
        for (int u = blockIdx.x; u < 256; u += F.G) {
#ifndef P3_ONLY
#define P3_ONLY 0
#endif
            if (u < 128) { if (P3_ONLY != 2) scan_unit_chunked(args, F, u); else { bf16* YB = WSP(bf16, WS_YB); const int b = u >> 3, h = u & 7; for (int i = F.tid; i < SEQ * 8; i += 512) { const int tk = i >> 3, c8 = (i & 7) * 8; *(u32x4*)(YB + ((size_t)b * SEQ + tk) * 512 + h * 64 + c8) = (u32x4){0u, 0u, 0u, 0u}; } } }
            else if (P3_ONLY == 1) { bf16* YAz = WSP(bf16, WS_YA); const int bh = u - 128, b = bh >> 3, h = bh & 7; for (int i = F.tid; i < SEQ * 8; i += 512) { const int tk = i >> 3, c8 = (i & 7) * 8; *(u32x4*)(YAz + ((size_t)b * SEQ + tk) * 512 + h * 64 + c8) = (u32x4){0u, 0u, 0u, 0u}; } }
            else { const int bh = u - 128; for (int i = 0; i < 8; ++i) attn_tile(F, bh, F.wave + 8 * i);
                   if (F.G >= 256) expert_convert(args, F, bh * 8 + F.wave, 1024); }
        }
    } SEAM(3);

    if (IN(4)) {
        pg8::StaticOrder S; S.init(M, D, F.G, (int)blockIdx.x);
        { pg8::Gemm g{WSP(bf16, WS_YA), WSP(bf16, WS_WA), M, D, AW, 0, nullptr, nullptr, nullptr}; EpiMerge<0> E{WSP(bf16, WS_GT), WSP(bf16, WS_MERGED)}; pg8::gemm_phase(ring, g, S, E, F.wave); }
        { pg8::Gemm g{WSP(bf16, WS_YB), WSP(bf16, WS_WB), M, D, RW, 0, nullptr, nullptr, nullptr}; EpiMerge<1> E{WSP(bf16, WS_GT), WSP(bf16, WS_MERGED)}; pg8::gemm_phase(ring, g, S, E, F.wave); }
    } SEAM(4);

    if (IN(5)) {
        pg8::Gemm g{WSP(bf16, WS_MERGED), WSP(bf16, WS_WO), M, D, D, 0, nullptr, nullptr, nullptr}; pg8::StaticOrder S; S.init(M, D, F.G, (int)blockIdx.x);
        EpiX1 E{FIN(0), WSP(float, WS_X1), FIN(18), WSP(bf16, WS_HN)};
        pg8::gemm_phase(ring, g, S, E, F.wave);
    } SEAM(5);

    if (IN(6)) { p5a_router(args, F); } SEAM(6);

    if (IN(7)) {
        const int ntiles = moe_tables(F);
        pg8::Gemm g{WSP(bf16, WS_HN), WSP(bf16, WS_W1), MAXROWS, F2, D, (size_t)F2 * D * 2, WSP(int, WS_LIST), (const LAS int*)(F.lds + MOE_OFF) + 32, (const LAS int*)(F.lds + MOE_OFF)};
        pg8::MoeOrder S{ntiles, F2 / 256, F.G, (int)blockIdx.x, F.lds + MOE_TE};
        EpiSwiglu E{FIN(22), WSP(bf16, WS_ACT), WSP(int, WS_LIST), WSP(float, WS_RSTD1), (const LAS int*)(F.lds + MOE_OFF) + 32, (const LAS int*)(F.lds + MOE_OFF)};
        pg8::gemm_phase<EpiSwiglu, pg8::MoeOrder, true>(ring, g, S, E, F.wave);
    } SEAM(7);

    if (IN(8)) {
        const int ntiles = moe_tables(F);
        pg8::Gemm g{WSP(bf16, WS_ACT), WSP(bf16, WS_W2), MAXROWS, D, FH, (size_t)D * FH * 2, nullptr, nullptr, nullptr};
        pg8::MoeOrder S{ntiles, D / 256, F.G, (int)blockIdx.x, F.lds + MOE_TE};
        EpiY E{FIN(24), WSP(int, WS_LIST), WSP(float, WS_GATEW), WSP(bf16, WS_YBUF), (const LAS int*)(F.lds + MOE_OFF) + 32, (const LAS int*)(F.lds + MOE_OFF)};
        pg8::gemm_phase(ring, g, S, E, F.wave);
    } SEAM(8);

    if (IN(9)) { p8_combine(F); } SEAM(9);

    if (IN(10)) {
        pg8::StaticOrder S; S.init(M, D, F.G, (int)blockIdx.x);
        { pg8::Gemm g{WSP(bf16, WS_X2B), WSP(bf16, WS_WG), M, D, D, 0, nullptr, nullptr, nullptr}; EpiGate E{WSP(float, WS_RSTD2), WSP(bf16, WS_PGT)}; pg8::gemm_phase(ring, g, S, E, F.wave); }
        { pg8::Gemm g{WSP(bf16, WS_PB), WSP(bf16, WS_WP), M, D, PLE, 0, nullptr, nullptr, nullptr}; EpiPle E{WSP(bf16, WS_X2B), WSP(bf16, WS_PGT), F.out, WSP(float, WS_ROWSS)}; pg8::gemm_phase(ring, g, S, E, F.wave); }
    } SEAM(10);

    if (IN(11)) { p10_final(args, F); }
#undef IN
#undef SEAM
}

extern "C" void kernel_launch(void* const* d_in, const int* in_sizes, int n_in, void* d_out, int out_size, void* d_ws, size_t ws_size, hipStream_t stream) {
    static int grid = 0;
    if (grid == 0) {
        if (n_in != 29 || in_sizes[0] != M * D || out_size != M * D || ws_size < WS_END) {
            fprintf(stderr, "kernel_launch: unexpected shapes (n_in %d, in0 %d, out %d, ws %zu < %zu); nothing launched\n", n_in, n_in > 0 ? in_sizes[0] : -1, out_size, ws_size, (size_t)WS_END); grid = -1; return; }
        int dev = 0, cus = 0, per_cu = 0;
        if (hipGetDevice(&dev) != hipSuccess || hipDeviceGetAttribute(&cus, hipDeviceAttributeMultiprocessorCount, dev) != hipSuccess) { grid = -1; return; }
        if (hipFuncSetAttribute((const void*)mega_fwd, hipFuncAttributeMaxDynamicSharedMemorySize, LDS_BYTES) != hipSuccess) { fprintf(stderr, "kernel_launch: hipFuncSetAttribute failed\n"); grid = -1; return; }
        if (hipOccupancyMaxActiveBlocksPerMultiprocessor(&per_cu, (const void*)mega_fwd, 512, LDS_BYTES) != hipSuccess || per_cu < 1) { fprintf(stderr, "kernel_launch: occupancy query says %d blocks/CU\n", per_cu); }
        (void)hipGetLastError();
        grid = cus;
    }
    if (grid < 0) return;
    (void)hipMemsetAsync((char*)d_ws + WS_CTL, 0, CTL_ZERO_BYTES, stream);
    Args a{};
    for (int i = 0; i < 29; ++i) a.in[i] = (const float*)d_in[i];
    a.out = (float*)d_out; a.ws = (unsigned char*)d_ws;
#if MK_PER_PHASE
    for (int p = 0; p < NPHASE; ++p) { a.ph_lo = p; a.ph_hi = p + 1; hipLaunchKernelGGL(mega_fwd, dim3(grid), dim3(512), LDS_BYTES, stream, a); }
#else
    a.ph_lo = 0; a.ph_hi = NPHASE; hipLaunchKernelGGL(mega_fwd, dim3(grid), dim3(512), LDS_BYTES, stream, a);
#endif
}
```

```cpp
#include <hip/hip_runtime.h>
#include <cstdio>
#include <cstdint>

#ifndef P3_ONLY
#define P3_ONLY 0
#endif
#ifndef SCAN_STUB
#define SCAN_STUB 0
#endif
#ifndef TS_PROBE
#define TS_PROBE -1
#endif
#ifndef MK_PER_PHASE
#define MK_PER_PHASE 0
#endif

#define LAS __attribute__((address_space(3)))
#define GAS __attribute__((address_space(1)))
typedef unsigned short bf16;
typedef short bf16x8 __attribute__((ext_vector_type(8)));
typedef float f32x2 __attribute__((ext_vector_type(2)));
typedef float f32x4 __attribute__((ext_vector_type(4)));
typedef float f32x16 __attribute__((ext_vector_type(16)));
typedef unsigned u32x2 __attribute__((ext_vector_type(2)));
typedef unsigned u32x4 __attribute__((ext_vector_type(4)));
typedef __bf16 bf16x2_t __attribute__((ext_vector_type(2)));

constexpr int NB = 16, SEQ = 2048, D = 1024, M = NB * SEQ;
constexpr int NH = 8, HD = 64, AW = 512, RW = 512, RWC = 1792, INC = 5376;
constexpr int NE = 32, FH = 1024, F2 = 2048, PLE = 256, TOPK = 4;
constexpr int LORA_K = 256, LORA_N = 1536;
constexpr int CAP = 32768;
constexpr int MAXROWS = M * TOPK + NE * 256;
constexpr float RMS_EPS = 1e-5f, GN_EPS = 64e-5f;

constexpr size_t MiB = 1u << 20;
constexpr size_t WS_CTL = 0, CTL_ZERO_BYTES = 1 * MiB;
constexpr size_t WS_WIN = 1 * MiB;
constexpr size_t WS_WA = 12 * MiB, WS_WB = 13 * MiB, WS_WO = 14 * MiB, WS_WG = 16 * MiB, WS_WP = 18 * MiB;
constexpr size_t WS_WL = 18 * MiB + 512 * 1024;
constexpr size_t WS_GW = 19 * MiB + 256 * 1024;
constexpr size_t WS_W1 = 20 * MiB;
constexpr size_t WS_W2 = 148 * MiB;
constexpr size_t WS_PB = 212 * MiB;
constexpr size_t WS_RSTD0 = 228 * MiB, WS_RSTD2 = WS_RSTD0 + 128 * 1024, WS_ROWSS = WS_RSTD0 + 256 * 1024;
constexpr size_t WS_RSTD1 = WS_RSTD0 + 384 * 1024;
constexpr size_t WS_GATEW = WS_RSTD0 + 512 * 1024;
constexpr size_t WS_ROWSLOT = 229 * MiB;
constexpr size_t WS_LIST = 230 * MiB;
constexpr size_t WS_X1 = 236 * MiB;
constexpr size_t WS_YA = 236 * MiB, WS_YB = 268 * MiB, WS_ALORA = 300 * MiB;
constexpr size_t WS_GT = 364 * MiB;
constexpr size_t WS_Q = 492 * MiB, WS_K = 524 * MiB, WS_VT = 556 * MiB;
constexpr size_t WS_ZR = 588 * MiB;
constexpr size_t WS_XB = 700 * MiB;
constexpr size_t WS_DEC = 764 * MiB, WS_AA = 828 * MiB, WS_GG = 892 * MiB;
constexpr size_t WS_MERGED = 492 * MiB;
constexpr size_t WS_XS = 364 * MiB;
constexpr size_t WS_ACT = 684 * MiB;
constexpr size_t WS_HN = 364 * MiB;
constexpr size_t WS_YBUF = 428 * MiB;
constexpr size_t WS_X2B = 684 * MiB;
constexpr size_t WS_PGT = 748 * MiB;
constexpr size_t WS_END = 956 * MiB;
constexpr int CW_CNT = 64;
constexpr int CW_PCNT = 8192;
constexpr int CW_BAR = 4096;

constexpr int RING_BYTES = 131072;
constexpr int LDSCTL_OFF = RING_BYTES;
constexpr int MOE_OFF = RING_BYTES + 1024;
constexpr int MOE_TE = RING_BYTES + 2048;
constexpr int LDS_BYTES = 147456;

#define RLX_AGENT __ATOMIC_RELAXED, __HIP_MEMORY_SCOPE_AGENT
__device__ __forceinline__ unsigned pk2(float lo, float hi) { f32x2 v = {lo, hi}; bf16x2_t b = __builtin_convertvector(v, bf16x2_t); return __builtin_bit_cast(unsigned, b); }
__device__ __forceinline__ float bflo(unsigned u) { return __uint_as_float(u << 16); }
__device__ __forceinline__ float bfhi(unsigned u) { return __uint_as_float(u & 0xffff0000u); }
__device__ __forceinline__ float sigm(float x) { return __builtin_amdgcn_rcpf(1.f + __expf(-x)); }
__device__ __forceinline__ float wave_sum(float v) {
#pragma unroll
    for (int o = 1; o < 64; o <<= 1) v += __shfl_xor(v, o);
    return v;
}
template <int CTRL> __device__ __forceinline__ float dppf(float v) { return __builtin_bit_cast(float, __builtin_amdgcn_update_dpp(0, __builtin_bit_cast(int, v), CTRL, 0xF, 0xF, true)); }
__device__ __forceinline__ float red8(float v) { v += dppf<0xB1>(v); v += dppf<0x4E>(v); v += dppf<0x141>(v); return v; }
__device__ __forceinline__ int lane_now() { int l; asm volatile("v_mbcnt_lo_u32_b32 %0, -1, 0\n\tv_mbcnt_hi_u32_b32 %0, -1, %0" : "=v"(l)); return l; }
__device__ __forceinline__ int crow(int r, int hi) { return (r & 3) + 8 * (r >> 2) + 4 * hi; }

namespace pg8 {
#define PG8_LAS __attribute__((address_space(3)))
typedef unsigned short bf16_t;
constexpr int BM = 256, BK = 64, HALF = 128, HTB = HALF * BK * 2, STAGE_BYTES = 8 * HTB, NXCD = 8, WGM = 8;
__host__ __device__ __forceinline__ int lds_byte(int r, int c) { const int st = (r >> 4) * 2 + (c >> 5), rr = r & 15, cc = c & 31, ob = rr * 64 + cc * 2; return st * 1024 + (ob ^ (((ob >> 9) & 1) << 5)); }
__host__ __device__ __forceinline__ void stage_rc(int b, int& R, int& C) { const int st = b / 1024, sb = b % 1024, swz = sb ^ (((sb >> 9) & 1) << 5); R = (st >> 1) * 16 + swz / 64; C = (st & 1) * 32 + (swz % 64) / 2; }
__host__ __device__ __forceinline__ int perm32(int rho) { const int n = rho >> 4, i = rho & 15; return 8 * (i >> 2) + 4 * n + (i & 3); }

struct Unit { int pm, pn, e; };
struct Gemm { const bf16_t* A; const bf16_t* Bt; int M, N, K; size_t bsel_bytes; const int* glist; const PG8_LAS int* goff; const PG8_LAS int* gcnt; };

struct StaticOrder {
    int nM, nN, nwg, G, c;
    __device__ void init(int M_, int N_, int G_, int c_) { nM = M_ / BM; nN = N_ / BM; nwg = nM * nN; G = G_; c = c_; }
    __device__ bool next(int i, Unit& u) const {
        const long L = (long)i * G + c; if (L >= nwg) return false;
        int wgid = (int)L; { const int q = nwg / NXCD, r = nwg % NXCD, xcd = wgid % NXCD, off = wgid / NXCD; wgid = (xcd < r ? xcd * (q + 1) : r * (q + 1) + (xcd - r) * q) + off; }
        const int nig = WGM * nN, gid = wgid / nig, fm = gid * WGM, gsz = (nM - fm) < WGM ? (nM - fm) : WGM;
        u.pm = fm + ((wgid % nig) % gsz); u.pn = (wgid % nig) / gsz; u.e = 0; return true;
    }
};
struct LoraOrder {
    int pm, half, nu;
    __device__ bool next(int i, Unit& u) const { if (i >= nu) return false; u.pm = pm; u.pn = 3 * half + i; u.e = 0; return true; }
};
struct MoeOrder {
    int ntiles, npn, G, c; const PG8_LAS unsigned char* te;
    __device__ bool next(int i, Unit& u) const {
        int rt, pn;
        if ((G & 255) == 0 && (npn == 8 || npn == 4)) { const int x = c & 7, j = (c >> 3) & 31, rpx = 32 / npn, blk = c >> 8; rt = ((i * (G >> 8) + blk) * 8 + x) * rpx + j / npn; pn = j % npn; }
        else { const long L = (long)i * G + c; rt = (int)(L / npn); pn = (int)(L % npn); }
        if (rt >= ntiles) return false;
        u.pm = rt; u.pn = pn; u.e = te[rt]; return true;
    }
};

template <class Epi, class Sched, bool GATHER = false>
__device__ __forceinline__ void gemm_phase(PG8_LAS unsigned char* lds, const Gemm g, const Sched& S, const Epi& E, const int wid) {
    const int lane = lane_now(), tid = wid * 64 + lane,
              wr = wid >> 2, wc = wid & 3, fr = lane & 15, fq = lane >> 4;
    const int K = g.K, nt = K / BK;
    unsigned voffA[2], voffB[2];
#pragma unroll
    for (int i = 0; i < 2; ++i) { int R, C; stage_rc(tid * 16 + i * 8192, R, C); const int Rb = Epi::PERM ? ((R & ~31) + perm32(R & 31)) : R;
        voffA[i] = (unsigned)(R * K + C) * 2u; voffB[i] = (unsigned)(Rb * K + C) * 2u; }
    const size_t kstep = (size_t)(BK * 2);
    const size_t hstep = (size_t)HALF * K * 2;
    const size_t tstep = 2 * hstep;
    const unsigned ldsw = (unsigned)wid * 1024u;
    const int aoff = lds_byte(wr * 64 + fr, fq * 8), boff = lds_byte(wc * 32 + fr, fq * 8);
    unsigned vgC[2][2] = {{0u, 0u}, {0u, 0u}}, vgN[2][2] = {{0u, 0u}, {0u, 0u}};
#define PG8_GOFF(u, vo) do { _Pragma("unroll") for (int _h = 0; _h < 2; ++_h) _Pragma("unroll") for (int _i = 0; _i < 2; ++_i) { int R_, C_; stage_rc(tid * 16 + _i * 8192, R_, C_); \
        const int r_ = (u).pm * BM + _h * HALF + R_ - g.goff[(u).e]; int tok_ = 0; if (r_ < g.gcnt[(u).e]) tok_ = g.glist[(size_t)(u).e * 32768 + r_] >> 2; (vo)[_h][_i] = (unsigned)(tok_ * K + C_) * 2u; } } while (0)
#define PG8_SA(b, h) (((b) * 2 + (h)) * HTB)
#define PG8_SB(b, h) ((4 + (b) * 2 + (h)) * HTB)
#define PG8_STAGE(bufoff, gbase, voff) do { _Pragma("unroll") for (int _i = 0; _i < 2; ++_i) \
        __builtin_amdgcn_global_load_lds((const unsigned*)((const char*)(gbase) + (voff)[_i]), (PG8_LAS unsigned*)(lds + (bufoff) + ldsw + _i * 8192), 16, 0, 0); } while (0)
#define PG8_STA(bufoff, h, ptr, kbyte, usenext) do { if constexpr (GATHER) { unsigned vo_[2] = {(usenext) ? vgN[h][0] : vgC[h][0], (usenext) ? vgN[h][1] : vgC[h][1]}; PG8_STAGE(bufoff, (const char*)g.A + (kbyte), vo_); } else { PG8_STAGE(bufoff, ptr, voffA); } } while (0)
#define PG8_LDA(dst, b, h) do { _Pragma("unroll") for (int m = 0; m < 4; ++m) _Pragma("unroll") for (int k = 0; k < 2; ++k) dst[m][k] = *(const PG8_LAS bf16x8*)(lds + PG8_SA(b, h) + aoff + m * 2048 + k * 1024); } while (0)
#define PG8_LDB(dst, b, h) do { _Pragma("unroll") for (int n = 0; n < 2; ++n) _Pragma("unroll") for (int k = 0; k < 2; ++k) dst[n][k] = *(const PG8_LAS bf16x8*)(lds + PG8_SB(b, h) + boff + n * 2048 + k * 1024); } while (0)
#define PG8_MMA(ai, bj, At, Bt) do { __builtin_amdgcn_s_setprio(1); _Pragma("unroll") for (int m = 0; m < 4; ++m) _Pragma("unroll") for (int n = 0; n < 2; ++n) _Pragma("unroll") for (int k = 0; k < 2; ++k) \
        acc[ai][bj][m][n] = __builtin_amdgcn_mfma_f32_16x16x32_bf16(Bt[n][k], At[m][k], acc[ai][bj][m][n], 0, 0, 0); __builtin_amdgcn_s_setprio(0); } while (0)
#define PG8_WAIT_V(n) asm volatile("s_waitcnt vmcnt(" #n ")" ::: "memory")
#define PG8_WAIT_L(n) asm volatile("s_waitcnt lgkmcnt(" #n ")" ::: "memory")
#define PG8_BAR __builtin_amdgcn_s_barrier()
#define PG8_SCHED __builtin_amdgcn_sched_barrier(0)
    Unit cur, nxt; int ui = 0;
    if (!S.next(0, cur)) return;
    f32x4 acc[2][2][4][2];
#pragma unroll
    for (int a = 0; a < 2; ++a)
#pragma unroll
        for (int b = 0; b < 2; ++b)
#pragma unroll
            for (int m = 0; m < 4; ++m)
#pragma unroll
                for (int n = 0; n < 2; ++n) acc[a][b][m][n] = (f32x4){0.f, 0.f, 0.f, 0.f};
    bf16x8 At[4][2], B0[2][2], B1[2][2];
    const char* cA = (const char*)g.A + (size_t)cur.pm * tstep; const char* cB = (const char*)g.Bt + (size_t)cur.e * g.bsel_bytes + (size_t)cur.pn * tstep;
    if constexpr (GATHER) PG8_GOFF(cur, vgC);
    PG8_STAGE(PG8_SB(0, 0), cB, voffB); PG8_STAGE(PG8_SB(0, 1), cB + hstep, voffB); PG8_STA(PG8_SA(0, 0), 0, cA, 0, false); PG8_STA(PG8_SA(0, 1), 1, cA + hstep, 0, false);
    if (wr == 1) PG8_BAR;
    PG8_WAIT_V(2); PG8_BAR;
    PG8_STAGE(PG8_SB(1, 0), cB + kstep, voffB); PG8_STA(PG8_SA(1, 0), 0, cA + kstep, kstep, false); PG8_STAGE(PG8_SB(1, 1), cB + hstep + kstep, voffB);
    PG8_WAIT_V(6); PG8_BAR;
    for (;;) {
        const bool has_next = S.next(ui + 1, nxt);
        if constexpr (GATHER) { if (has_next) PG8_GOFF(nxt, vgN); else { vgN[0][0] = vgC[0][0]; vgN[0][1] = vgC[0][1]; vgN[1][0] = vgC[1][0]; vgN[1][1] = vgC[1][1]; } }
        const char* nA = has_next ? (const char*)g.A + (size_t)nxt.pm * tstep : cA;
        const char* nB = has_next ? (const char*)g.Bt + (size_t)nxt.e * g.bsel_bytes + (size_t)nxt.pn * tstep : cB;
        for (int t = 0; t < nt; t += 2) {
            const bool last = (t == nt - 2);
            const char* a1 = cA + (size_t)(t + 1) * kstep;
            const char* a2 = last ? nA : cA + (size_t)(t + 2) * kstep; const char* b2 = last ? nB : cB + (size_t)(t + 2) * kstep;
            const char* a3 = a2 + kstep; const char* b3 = b2 + kstep;
            const size_t k2 = last ? 0 : (size_t)(t + 2) * kstep;
            PG8_LDB(B0, 0, 0); PG8_LDB(B1, 0, 1); PG8_SCHED; PG8_LDA(At, 0, 0); PG8_STA(PG8_SA(1, 1), 1, a1 + hstep, (size_t)(t + 1) * kstep, false);
            PG8_WAIT_V(8); PG8_WAIT_L(0); PG8_BAR; PG8_MMA(0, 0, At, B0); PG8_MMA(0, 1, At, B1); PG8_BAR; PG8_SCHED;
            PG8_LDA(At, 0, 1); PG8_STAGE(PG8_SB(0, 0), b2, voffB); PG8_STAGE(PG8_SB(0, 1), b2 + hstep, voffB); PG8_STA(PG8_SA(0, 0), 0, a2, k2, last);
            PG8_WAIT_V(8); PG8_WAIT_L(0); PG8_BAR; PG8_MMA(1, 0, At, B0); PG8_MMA(1, 1, At, B1); PG8_BAR; PG8_SCHED;
            PG8_LDB(B0, 1, 0); PG8_LDB(B1, 1, 1); PG8_SCHED; PG8_LDA(At, 1, 0); PG8_STA(PG8_SA(0, 1), 1, a2 + hstep, k2, last);
            PG8_WAIT_V(8); PG8_WAIT_L(0); PG8_BAR; PG8_MMA(0, 0, At, B0); PG8_MMA(0, 1, At, B1); PG8_BAR; PG8_SCHED;
            PG8_LDA(At, 1, 1); PG8_STAGE(PG8_SB(1, 0), b3, voffB); PG8_STAGE(PG8_SB(1, 1), b3 + hstep, voffB); PG8_STA(PG8_SA(1, 0), 0, a3, k2 + kstep, last);
            PG8_WAIT_V(8); PG8_WAIT_L(0); PG8_BAR; PG8_MMA(1, 0, At, B0); PG8_MMA(1, 1, At, B1); PG8_BAR; PG8_SCHED;
        }
        if (wr == 0) PG8_BAR;
        E(acc, cur, wr, wc, fr, fq);
        if (!has_next) break;
#pragma unroll
        for (int a = 0; a < 2; ++a)
#pragma unroll
            for (int b = 0; b < 2; ++b)
#pragma unroll
                for (int m = 0; m < 4; ++m)
#pragma unroll
                    for (int n = 0; n < 2; ++n) acc[a][b][m][n] = (f32x4){0.f, 0.f, 0.f, 0.f};
        cur = nxt; cA = nA; cB = nB; ++ui;
        if constexpr (GATHER) { vgC[0][0] = vgN[0][0]; vgC[0][1] = vgN[0][1]; vgC[1][0] = vgN[1][0]; vgC[1][1] = vgN[1][1]; }
        if (wr == 1) PG8_BAR;
    }
    PG8_WAIT_V(0);
    PG8_BAR;
#undef PG8_SA
#undef PG8_SB
#undef PG8_STAGE
#undef PG8_LDA
#undef PG8_STA
#undef PG8_GOFF
#undef PG8_LDB
#undef PG8_MMA
#undef PG8_WAIT_V
#undef PG8_WAIT_L
#undef PG8_BAR
#undef PG8_SCHED
}
}
using pg8::Unit;
typedef const f32x4 (&AccRef)[2][2][4][2];

#define XB_TMO      128
#define XB_XCNT(j)  (256  + 64 * (j))
#define XB_XSUB(j)  (1280 + 64 * (j))
#define XB_XGEN(j)  (2304 + 64 * (j))
#define XB_TOP      3328
#define XB_TOPGEN   3392
#define XCD_BAR_WORDS 3456
#define XB_SPIN_CAP (1u << 22)
__device__ __forceinline__ unsigned xb_ld(unsigned* p)              { return __hip_atomic_load(p, __ATOMIC_RELAXED, __HIP_MEMORY_SCOPE_AGENT); }
__device__ __forceinline__ unsigned xb_add(unsigned* p, unsigned v) { return __hip_atomic_fetch_add(p, v, __ATOMIC_RELAXED, __HIP_MEMORY_SCOPE_AGENT); }
__device__ __forceinline__ unsigned xb_xcc_id() { return (unsigned)__builtin_amdgcn_s_getreg((3 << 11) | 20) & 0xFu; }
#define XB_SPIN(cond, bar) do { unsigned _sp = 0; while (cond) { __builtin_amdgcn_s_sleep(1); \
    if ((++_sp & 255u) == 0u) { if (xb_ld(&(bar)[XB_TMO])) break; if (_sp > XB_SPIN_CAP) { atomicAdd(&(bar)[XB_TMO], 1u); break; } } } } while (0)
struct XcdBarrier { unsigned* bar; unsigned x; volatile LAS unsigned* st; };
__device__ __forceinline__ XcdBarrier xcd_barrier_post(unsigned* bar, volatile LAS unsigned* st, int tid) {
    XcdBarrier b; b.bar = bar; b.x = xb_xcc_id(); b.st = st;
    if (tid == 0) (void)xb_add(&bar[XB_XCNT(b.x)], 1u);
    return b;
}
__device__ __forceinline__ void xcd_barrier_complete(unsigned* bar, unsigned x, unsigned& nloc, unsigned& nx) {
    const unsigned G = gridDim.x * gridDim.y * gridDim.z;
    unsigned sum, cnt, mine, sp = 0u;
    for (;;) {
        sum = 0u; cnt = 0u; mine = 0u;
#pragma unroll
        for (unsigned j = 0; j < 16; ++j) { const unsigned c = xb_ld(&bar[XB_XCNT(j)]); sum += c; cnt += (c > 0u) ? 1u : 0u; mine = (j == x) ? c : mine; }
        if (sum == G) break;
        __builtin_amdgcn_s_sleep(1);
        if ((++sp & 255u) == 0u) { if (xb_ld(&bar[XB_TMO])) break; if (sp > XB_SPIN_CAP) { atomicAdd(&bar[XB_TMO], 1u); break; } }
    }
    nloc = mine > 0u ? mine : 1u; nx = cnt > 0u ? cnt : 1u;
}
__device__ __forceinline__ void xcd_barrier(const XcdBarrier& b, int wave) {
    asm volatile("s_waitcnt vmcnt(0)" ::: "memory");
    __syncthreads();
    if (wave == 0 && lane_now() == 0) {
        unsigned* bar = b.bar;
        __builtin_amdgcn_s_waitcnt(0);
        unsigned nloc = b.st[0], nx = b.st[1];
        if (nloc == 0u) { xcd_barrier_complete(bar, b.x, nloc, nx); b.st[0] = nloc; b.st[1] = nx; }
        const unsigned old = xb_add(&bar[XB_XSUB(b.x)], 1u);
        const unsigned gen = old / nloc;
        if (old + 1u == (gen + 1u) * nloc) {
            __builtin_amdgcn_fence(__ATOMIC_RELEASE, "agent");
            asm volatile("s_waitcnt vmcnt(0)" ::: "memory");
            const unsigned og = xb_add(&bar[XB_TOP], 1u);
            const unsigned tg = og / nx;
            if (og + 1u == (tg + 1u) * nx) xb_add(&bar[XB_TOPGEN], 1u);
            else XB_SPIN(xb_ld(&bar[XB_TOPGEN]) == tg, bar);
            __builtin_amdgcn_fence(__ATOMIC_ACQUIRE, "agent");
            xb_add(&bar[XB_XGEN(b.x)], 1u);
            asm volatile("s_waitcnt vmcnt(0)" ::: "memory");
        } else {
            XB_SPIN(xb_ld(&bar[XB_XGEN(b.x)]) == gen, bar);
            __builtin_amdgcn_fence(__ATOMIC_ACQUIRE, "agent");
            asm volatile("s_waitcnt vmcnt(0)" ::: "memory");
        }
    }
    __syncthreads();
}

struct Frame {
    LAS unsigned char* lds;
    unsigned* ctl;
    int tid, lane, wave, vcu, G;
    unsigned char* ws;
    float* out;
};
#define WSP(T, off) ((T*)(F.ws + (off)))
struct Args { const float* in[29]; float* out; unsigned char* ws; int ph_lo, ph_hi; };
#define FIN(i) (args.in[i])

template <bool SWZ = false>
__device__ __forceinline__ void p0_transpose_item(const float* W, int K, int N, bf16* WT, LAS float* scr, int item, int lane, const float* kscale) {
    const int nblk = N / 32, kb = item / nblk, nb = item % nblk, k0 = 64 * kb, n0 = 32 * nb;
#pragma unroll 8
    for (int i = 0; i < 32; ++i) { const int kk = 2 * i + (lane >> 5); float v = W[(size_t)(k0 + kk) * N + n0 + (lane & 31)]; if (kscale) v *= kscale[k0 + kk]; scr[kk * 33 + (lane & 31)] = v; }
    asm volatile("s_waitcnt lgkmcnt(0)" ::: "memory");
    const int c = lane & 7;
#pragma unroll
    for (int j = 0; j < 4; ++j) { const int n = (lane >> 3) + 8 * j; const LAS float* s = scr + (8 * c) * 33 + n;
        u32x4 o; o.x = pk2(s[0 * 33], s[1 * 33]); o.y = pk2(s[2 * 33], s[3 * 33]); o.z = pk2(s[4 * 33], s[5 * 33]); o.w = pk2(s[6 * 33], s[7 * 33]);
        int nr = n0 + n; if (SWZ) { const int cl = nr & 255; nr = (nr & ~255) + 128 * ((cl >> 3) & 1) + 32 * (cl >> 6) + 8 * ((cl >> 4) & 3) + (cl & 7); }
        *(u32x4*)(WT + (size_t)nr * K + k0 + 8 * c) = o; }
    asm volatile("s_waitcnt lgkmcnt(0)" ::: "memory");
}
__device__ __forceinline__ void p0_prologue(const Args& args, Frame& F) {
    LAS float* scr = (LAS float*)(F.lds + F.wave * 16384);
    const int gw = F.vcu * 8 + F.wave, NGW = F.G * 8, lane = F.lane;
    constexpr int I_IN = (D / 64) * (INC / 32), I_A = (AW / 64) * (D / 32), I_O = (D / 64) * (D / 32), I_P = (PLE / 64) * (D / 32);
    constexpr int I_W1 = (D / 64) * (F2 / 32), I_W2 = (FH / 64) * (D / 32);
    constexpr int NITEMS = I_IN + 2 * I_A + 2 * I_O + I_P;
    for (int it = gw; it < NITEMS; it += NGW) {
        int r = it;
        if (r < I_IN) { p0_transpose_item(FIN(3), D, INC, WSP(bf16, WS_WIN), scr, r, lane, FIN(2)); continue; } r -= I_IN;
        if (r < I_A) { p0_transpose_item(FIN(15), AW, D, WSP(bf16, WS_WA), scr, r, lane, nullptr); continue; } r -= I_A;
        if (r < I_A) { p0_transpose_item(FIN(16), RW, D, WSP(bf16, WS_WB), scr, r, lane, nullptr); continue; } r -= I_A;
        if (r < I_O) { p0_transpose_item(FIN(17), D, D, WSP(bf16, WS_WO), scr, r, lane, nullptr); continue; } r -= I_O;
        if (r < I_O) { p0_transpose_item(FIN(26), D, D, WSP(bf16, WS_WG), scr, r, lane, FIN(25)); continue; } r -= I_O;
        p0_transpose_item(FIN(27), PLE, D, WSP(bf16, WS_WP), scr, r, lane, nullptr);
    }
    { const int gt = (F.vcu * 512 + F.tid), NT = F.G * 512;
      bf16* WL = WSP(bf16, WS_WL);
      for (int i = gt; i < LORA_N * LORA_K; i += NT) { const int n = i >> 8, k = i & 255; float v = 0.f;
          if (n < 512) { if (k < 64) v = FIN(6)[k * 512 + n]; }
          else if (n < 1024) { if (k >= 64 && k < 128) v = FIN(8)[(k - 64) * 512 + (n - 512)]; }
          else { if (k >= 128) v = FIN(9)[(k - 128) * 512 + (n - 1024)]; }
          WL[i] = (bf16)(pk2(v, 0.f) & 0xffffu); }
      float* GW = WSP(float, WS_GW);
      for (int i = gt; i < D * NE; i += NT) GW[i] = FIN(19)[i] * FIN(18)[i >> 5];
    }
    { bf16* XB = WSP(bf16, WS_XB); float* R0 = WSP(float, WS_RSTD0); bf16* PB = WSP(bf16, WS_PB);
      for (int m = gw; m < M; m += NGW) {
          const f32x4* xr = (const f32x4*)(FIN(0) + (size_t)m * D) + lane;
          f32x4 v[4]; float s = 0.f;
#pragma unroll
          for (int j = 0; j < 4; ++j) { v[j] = xr[64 * j]; s += (v[j].x * v[j].x + v[j].y * v[j].y) + (v[j].z * v[j].z + v[j].w * v[j].w); }
          s = wave_sum(s);
          u32x2* o = (u32x2*)(XB + (size_t)m * D) + lane;
#pragma unroll
          for (int j = 0; j < 4; ++j) { u32x2 w; w.x = pk2(v[j].x, v[j].y); w.y = pk2(v[j].z, v[j].w); o[64 * j] = w; }
          if (lane == 0) R0[m] = 1.0f / sqrtf(s * (1.f / D) + RMS_EPS);
          const f32x4 pv = ((const f32x4*)(FIN(1) + (size_t)m * PLE))[lane];
          u32x2 w; w.x = pk2(pv.x, pv.y); w.y = pk2(pv.z, pv.w); ((u32x2*)(PB + (size_t)m * PLE))[lane] = w;
      }
    }
}

__device__ __forceinline__ void expert_convert(const Args& args, Frame& F, int wv, int NW, int which) {
    LAS float* scr = (LAS float*)(F.lds + F.wave * 16384);
    constexpr int I_W1 = (D / 64) * (F2 / 32), I_W2 = (FH / 64) * (D / 32);
    if (which & 1) for (int it = wv; it < NE * I_W1; it += NW) { const int e = it / I_W1; p0_transpose_item<true>(FIN(21) + (size_t)e * D * F2, D, F2, WSP(bf16, WS_W1) + (size_t)e * F2 * D, scr, it % I_W1, F.lane, nullptr); }
    if (which & 2) for (int it = wv; it < NE * I_W2; it += NW) { const int e = it / I_W2; p0_transpose_item(FIN(23) + (size_t)e * FH * D, FH, D, WSP(bf16, WS_W2) + (size_t)e * D * FH, scr, it % I_W2, F.lane, nullptr); }
}
struct EpiG1 {
    static constexpr bool PERM = true;
    const float* rstd; bf16 *Q, *K, *VT, *ZR, *GT;
    __device__ __forceinline__ void operator()(AccRef acc, const Unit& u, int wr, int wc, int fr, int fq) const {
        const int pn = u.pn, rowb = u.pm * 256 + wr * 64 + fr, cl = wc * 32 + 8 * fq;
#pragma unroll
        for (int ai = 0; ai < 2; ++ai)
#pragma unroll
            for (int m = 0; m < 4; ++m) {
                const int row = rowb + ai * 128 + m * 16; const float rs = rstd[row];
                if (pn < 4) {
                    bf16* base = (pn < 2 ? Q : K) + (size_t)row * 512 + (pn & 1) * 256 + cl; const float sc = pn < 2 ? rs * 0.125f : rs;
#pragma unroll
                    for (int bj = 0; bj < 2; ++bj) { const f32x4 v0 = acc[ai][bj][m][0] * sc, v1 = acc[ai][bj][m][1] * sc;
                        u32x4 w; w.x = pk2(v0[0], v0[1]); w.y = pk2(v0[2], v0[3]); w.z = pk2(v1[0], v1[1]); w.w = pk2(v1[2], v1[3]); *(u32x4*)(base + bj * 128) = w; }
                } else if (pn < 6) {
                    const int b = row >> 11, s = row & 2047;
#pragma unroll
                    for (int bj = 0; bj < 2; ++bj)
#pragma unroll
                        for (int n = 0; n < 2; ++n)
#pragma unroll
                            for (int j = 0; j < 4; ++j) { const int c = (pn - 4) * 256 + cl + bj * 128 + 4 * n + j; const int hh = c >> 6, d = c & 63;
                                VT[((size_t)((b * 8 + hh) * 64 + d)) * SEQ + s] = (bf16)(pk2(acc[ai][bj][m][n][j] * rs, 0.f) & 0xffffu); }
                } else if (pn < 13) {
                    bf16* base = ZR + (size_t)row * RWC + (pn - 6) * 256 + cl;
#pragma unroll
                    for (int bj = 0; bj < 2; ++bj) { const f32x4 v0 = acc[ai][bj][m][0] * rs, v1 = acc[ai][bj][m][1] * rs;
                        u32x4 w; w.x = pk2(v0[0], v0[1]); w.y = pk2(v0[2], v0[3]); w.z = pk2(v1[0], v1[1]); w.w = pk2(v1[2], v1[3]); *(u32x4*)(base + bj * 128) = w; }
                } else {
                    bf16* base = GT + (size_t)row * 2048 + (pn - 13) * 256 + cl;
#pragma unroll
                    for (int bj = 0; bj < 2; ++bj) { const f32x4 v0 = acc[ai][bj][m][0] * rs, v1 = acc[ai][bj][m][1] * rs;
                        u32x4 w; w.x = pk2(sigm(v0[0]), sigm(v0[1])); w.y = pk2(sigm(v0[2]), sigm(v0[3])); w.z = pk2(sigm(v1[0]), sigm(v1[1])); w.w = pk2(sigm(v1[2]), sigm(v1[3])); *(u32x4*)(base + bj * 128) = w; }
                }
            }
    }
};
struct EpiLora {
    static constexpr bool PERM = false;
    const float *w0, *a0; float *DEC, *AA; bf16* GG;
    template <int MODE> __device__ __forceinline__ void body(AccRef acc, int rowb, int cb) const {
#pragma unroll
        for (int ai = 0; ai < 2; ++ai)
#pragma unroll
            for (int m = 0; m < 4; ++m) {
                const int row = rowb + ai * 128 + m * 16;
#pragma unroll
                for (int bj = 0; bj < 2; ++bj)
#pragma unroll
                    for (int n = 0; n < 2; ++n) {
                        const int c = cb + bj * 128 + n * 16;
                        f32x4 v = acc[ai][bj][m][n];
                        if (MODE == 0) { v = v + *(const f32x4*)(w0 + c); f32x4 o;
#pragma unroll
                            for (int j = 0; j < 4; ++j) { const float y = -v[j]; const float sp = y > 20.f ? y : __logf(1.f + __expf(y)); o[j] = __expf(-__expf(-sp - 0.5f)); }
                            *(f32x4*)(DEC + (size_t)row * 512 + c) = o;
                        } else if (MODE == 1) { v = v + *(const f32x4*)(a0 + c); f32x4 o;
#pragma unroll
                            for (int j = 0; j < 4; ++j) o[j] = sigm(v[j]);
                            *(f32x4*)(AA + (size_t)row * 512 + c) = o;
                        } else { u32x2 w; w.x = pk2(v[0], v[1]); w.y = pk2(v[2], v[3]); *(u32x2*)(GG + (size_t)row * 512 + c) = w; }
                    }
                asm volatile("" ::: "memory");
            }
    }
    __device__ __forceinline__ void operator()(AccRef acc, const Unit& u, int wr, int wc, int fr, int fq) const {
        const int pn = u.pn, rowb = u.pm * 256 + wr * 64 + fr, cb = (pn & 1) * 256 + wc * 32 + 4 * fq;
        if (pn < 2) body<0>(acc, rowb, cb); else if (pn < 4) body<1>(acc, rowb, cb); else body<2>(acc, rowb, cb);
    }
};
template <int SECOND> struct EpiMerge {
    static constexpr bool PERM = true;
    const bf16* GT; bf16* MG;
    __device__ __forceinline__ void operator()(AccRef acc, const Unit& u, int wr, int wc, int fr, int fq) const {
        const int rowb = u.pm * 256 + wr * 64 + fr, c0 = u.pn * 256 + wc * 32 + 8 * fq;
#pragma unroll
        for (int ai = 0; ai < 2; ++ai)
#pragma unroll
            for (int m = 0; m < 4; ++m) { const int row = rowb + ai * 128 + m * 16;
#pragma unroll
                for (int bj = 0; bj < 2; ++bj) {
                    const int c = c0 + bj * 128; const u32x4 gv = *(const u32x4*)(GT + (size_t)row * 2048 + SECOND * 1024 + c);
                    const f32x4 v0 = acc[ai][bj][m][0], v1 = acc[ai][bj][m][1];
                    float o[8] = {v0[0] * bflo(gv.x), v0[1] * bfhi(gv.x), v0[2] * bflo(gv.y), v0[3] * bfhi(gv.y), v1[0] * bflo(gv.z), v1[1] * bfhi(gv.z), v1[2] * bflo(gv.w), v1[3] * bfhi(gv.w)};
                    bf16* dst = MG + (size_t)row * 1024 + c;
                    if (SECOND) { const u32x4 ov = *(const u32x4*)dst; o[0] += bflo(ov.x); o[1] += bfhi(ov.x); o[2] += bflo(ov.y); o[3] += bfhi(ov.y); o[4] += bflo(ov.z); o[5] += bfhi(ov.z); o[6] += bflo(ov.w); o[7] += bfhi(ov.w); }
                    u32x4 w; w.x = pk2(o[0], o[1]); w.y = pk2(o[2], o[3]); w.z = pk2(o[4], o[5]); w.w = pk2(o[6], o[7]); *(u32x4*)dst = w; } }
    }
};
struct EpiX1 {
    static constexpr bool PERM = true;
    const float* X; float* X1; const float* gn; bf16* HN;
    __device__ __forceinline__ void operator()(AccRef acc, const Unit& u, int wr, int wc, int fr, int fq) const {
        const int rowb = u.pm * 256 + wr * 64 + fr, c0 = u.pn * 256 + wc * 32 + 8 * fq;
#pragma unroll
        for (int bj = 0; bj < 2; ++bj) { const f32x4 g0 = *(const f32x4*)(gn + c0 + bj * 128), g1 = *(const f32x4*)(gn + c0 + bj * 128 + 4);
#pragma unroll
            for (int ai = 0; ai < 2; ++ai)
#pragma unroll
                for (int m = 0; m < 4; ++m) { const size_t off = (size_t)(rowb + ai * 128 + m * 16) * D + c0 + bj * 128;
                    const f32x4 x0 = *(const f32x4*)(X + off) + acc[ai][bj][m][0], x1 = *(const f32x4*)(X + off + 4) + acc[ai][bj][m][1];
                    *(f32x4*)(X1 + off) = x0; *(f32x4*)(X1 + off + 4) = x1;
                    u32x4 w; w.x = pk2(x0[0] * g0[0], x0[1] * g0[1]); w.y = pk2(x0[2] * g0[2], x0[3] * g0[3]); w.z = pk2(x1[0] * g1[0], x1[1] * g1[1]); w.w = pk2(x1[2] * g1[2], x1[3] * g1[3]); *(u32x4*)(HN + off) = w; } }
    }
};
struct EpiSwiglu {
    static constexpr bool PERM = true;
    const float* b1; bf16* ACT; const int* LIST; const float* R1; const LAS int* OFF; const LAS int* CS;
    __device__ __forceinline__ void operator()(AccRef acc, const Unit& u, int wr, int wc, int fr, int fq) const {
        const int rowb = u.pm * 256 + wr * 64 + fr, c0 = u.pn * 256 + wc * 64 + 16 * fq;
        const float* bb = b1 + (size_t)u.e * F2 + c0; const int rbase = rowb - OFF[u.e], cnt = CS[u.e];
        const f32x4 bv0 = *(const f32x4*)(bb), bv1 = *(const f32x4*)(bb + 4), bv2 = *(const f32x4*)(bb + 8), bv3 = *(const f32x4*)(bb + 12);
#pragma unroll
        for (int ai = 0; ai < 2; ++ai)
#pragma unroll
            for (int m = 0; m < 4; ++m) { const int r = rbase + ai * 128 + m * 16, row = rowb + ai * 128 + m * 16; float rs = 0.f; if (r < cnt) rs = R1[LIST[(size_t)u.e * CAP + r] >> 2];
                const f32x4 v[4] = {acc[ai][0][m][0] * rs + bv0, acc[ai][0][m][1] * rs + bv1, acc[ai][1][m][0] * rs + bv2, acc[ai][1][m][1] * rs + bv3};
                float o[8];
#pragma unroll
                for (int p = 0; p < 8; ++p) { float gl = v[p >> 1][2 * (p & 1)], ul = v[p >> 1][2 * (p & 1) + 1];
                    gl = fminf(gl, 7.f); ul = fminf(fmaxf(ul, -7.f), 7.f); o[p] = (ul + 1.f) * gl * sigm(1.702f * gl); }
                u32x4 w; w.x = pk2(o[0], o[1]); w.y = pk2(o[2], o[3]); w.z = pk2(o[4], o[5]); w.w = pk2(o[6], o[7]); *(u32x4*)(ACT + (size_t)row * FH + (c0 >> 1)) = w;
                asm volatile("" ::: "memory"); }
    }
};
struct EpiY {
    static constexpr bool PERM = true;
    const float* b2; const int* LIST; const float* gatew; bf16* YB; const LAS int* OFF; const LAS int* CS;
    __device__ __forceinline__ void operator()(AccRef acc, const Unit& u, int wr, int wc, int fr, int fq) const {
        const int rowb = u.pm * 256 + wr * 64 + fr, c0 = u.pn * 256 + wc * 32 + 8 * fq;
        const float* bb = b2 + (size_t)u.e * D; const int rbase = rowb - OFF[u.e], cnt = CS[u.e];
#pragma unroll
        for (int ai = 0; ai < 2; ++ai)
#pragma unroll
            for (int m = 0; m < 4; ++m) { const int r = rbase + ai * 128 + m * 16;
                if (r < cnt) { const int slot = LIST[(size_t)u.e * CAP + r]; const float gt = gatew[slot];
#pragma unroll
                    for (int bj = 0; bj < 2; ++bj) { const int c = c0 + bj * 128;
                        const f32x4 v0 = (acc[ai][bj][m][0] + *(const f32x4*)(bb + c)) * gt, v1 = (acc[ai][bj][m][1] + *(const f32x4*)(bb + c + 4)) * gt;
                        u32x4 w; w.x = pk2(v0[0], v0[1]); w.y = pk2(v0[2], v0[3]); w.z = pk2(v1[0], v1[1]); w.w = pk2(v1[2], v1[3]); *(u32x4*)(YB + (size_t)slot * D + c) = w; } } }
    }
};
struct EpiGate {
    static constexpr bool PERM = true;
    const float* rstd2; bf16* GT;
    __device__ __forceinline__ void operator()(AccRef acc, const Unit& u, int wr, int wc, int fr, int fq) const {
        const int rowb = u.pm * 256 + wr * 64 + fr, c0 = u.pn * 256 + wc * 32 + 8 * fq;
#pragma unroll
        for (int ai = 0; ai < 2; ++ai)
#pragma unroll
            for (int m = 0; m < 4; ++m) { const int row = rowb + ai * 128 + m * 16; const float rs = rstd2[row];
#pragma unroll
                for (int bj = 0; bj < 2; ++bj) { const f32x4 v0 = acc[ai][bj][m][0] * rs, v1 = acc[ai][bj][m][1] * rs;
                    u32x4 w; w.x = pk2(sigm(v0[0]), sigm(v0[1])); w.y = pk2(sigm(v0[2]), sigm(v0[3])); w.z = pk2(sigm(v1[0]), sigm(v1[1])); w.w = pk2(sigm(v1[2]), sigm(v1[3]));
                    *(u32x4*)(GT + (size_t)row * D + c0 + bj * 128) = w; } }
    }
};
struct EpiPle {
    static constexpr bool PERM = true;
    const bf16* X2B; const bf16* GT; float* O; float* rowss; unsigned* pcnt; const float* fg; const unsigned* ctl;
    __device__ __forceinline__ void x3_of(AccRef acc, int ai, int m, int bj, size_t off, f32x4& o0, f32x4& o1) const {
        const u32x4 xv = *(const u32x4*)(X2B + off), gv = *(const u32x4*)(GT + off); const f32x4 a0 = acc[ai][bj][m][0], a1 = acc[ai][bj][m][1];
        o0[0] = bflo(xv.x) + bflo(gv.x) * a0[0]; o0[1] = bfhi(xv.x) + bfhi(gv.x) * a0[1]; o0[2] = bflo(xv.y) + bflo(gv.y) * a0[2]; o0[3] = bfhi(xv.y) + bfhi(gv.y) * a0[3];
        o1[0] = bflo(xv.z) + bflo(gv.z) * a1[0]; o1[1] = bfhi(xv.z) + bfhi(gv.z) * a1[1]; o1[2] = bflo(xv.w) + bflo(gv.w) * a1[2]; o1[3] = bfhi(xv.w) + bfhi(gv.w) * a1[3];
    }
    __device__ __forceinline__ void operator()(AccRef acc, const Unit& u, int wr, int wc, int fr, int fq) const {
        const int rowb = u.pm * 256 + wr * 64 + fr, c0 = u.pn * 256 + wc * 32 + 8 * fq;
#pragma unroll
        for (int ai = 0; ai < 2; ++ai)
#pragma unroll
            for (int m = 0; m < 4; ++m) { const int row = rowb + ai * 128 + m * 16; float ss = 0.f;
#pragma unroll
                for (int bj = 0; bj < 2; ++bj) { f32x4 o0, o1; x3_of(acc, ai, m, bj, (size_t)row * D + c0 + bj * 128, o0, o1);
#pragma unroll
                    for (int j = 0; j < 4; ++j) ss += o0[j] * o0[j] + o1[j] * o1[j]; }
                ss += __shfl_xor(ss, 16); ss += __shfl_xor(ss, 32);
                if (fq == 0) atomicAdd(rowss + row, ss);
                asm volatile("" ::: "memory"); }
        asm volatile("s_waitcnt vmcnt(0)" ::: "memory");
        __builtin_amdgcn_s_barrier();
        if (wr == 0 && wc == 0) {
            unsigned* pc = pcnt + 64 * u.pm;
            if (fr == 0 && fq == 0) __hip_atomic_fetch_add(pc, 1u, RLX_AGENT);
            unsigned spins = 0; while ((unsigned)__builtin_amdgcn_readfirstlane(__hip_atomic_load(pc, RLX_AGENT)) < 4u && ++spins < (1u << 20)) __builtin_amdgcn_s_sleep(4);
        }
        asm volatile("s_waitcnt vmcnt(0)" ::: "memory");
        __builtin_amdgcn_s_barrier();
        asm volatile("" ::: "memory");
#pragma unroll
        for (int ai = 0; ai < 2; ++ai)
#pragma unroll
            for (int m = 0; m < 4; ++m) { const int row = rowb + ai * 128 + m * 16; const float rs = 1.0f / sqrtf(__hip_atomic_load(rowss + row, RLX_AGENT) * (1.f / D) + RMS_EPS);
#pragma unroll
                for (int bj = 0; bj < 2; ++bj) { const size_t off = (size_t)row * D + c0 + bj * 128; f32x4 o0, o1; x3_of(acc, ai, m, bj, off, o0, o1);
                    o0 = o0 * rs * *(const f32x4*)(fg + c0 + bj * 128); o1 = o1 * rs * *(const f32x4*)(fg + c0 + bj * 128 + 4);
                    if (TS_PROBE >= 0 && row == 0 && c0 == 0 && bj == 0) { const unsigned long long* ts = (const unsigned long long*)(ctl + 2048); const unsigned long long dt = ts[TS_PROBE + 1] - ts[TS_PROBE]; o0[0] += (float)((dt + 300) / 1600) * 4.f; }
                    *(f32x4*)(O + off) = o0; *(f32x4*)(O + off + 4) = o1; }
                asm volatile("" ::: "memory"); }
    }
};

__device__ __forceinline__ void build_alora(const Args& args, Frame& F, int pm) {
    const bf16* ZR = WSP(bf16, WS_ZR); bf16* AL = WSP(bf16, WS_ALORA); const float* mu = FIN(4) + 1536;
#pragma unroll 1
    for (int i = 0; i < 16; ++i) {
        const int id = F.tid + 512 * i, row = pm * 256 + (id >> 5), cc = (id & 31) * 8;
        const u32x4 zc = *(const u32x4*)(ZR + (size_t)row * RWC + 1536 + cc);
        u32x4 zp = (u32x4){0u, 0u, 0u, 0u}; if ((row & (SEQ - 1)) != 0) zp = *(const u32x4*)(ZR + (size_t)(row - 1) * RWC + 1536 + cc);
        const unsigned zcw[4] = {zc.x, zc.y, zc.z, zc.w}, zpw[4] = {zp.x, zp.y, zp.z, zp.w}; float o[8];
#pragma unroll
        for (int j = 0; j < 8; ++j) { const float c = (j & 1) ? bfhi(zcw[j >> 1]) : bflo(zcw[j >> 1]), p = (j & 1) ? bfhi(zpw[j >> 1]) : bflo(zpw[j >> 1]);
            const float xs = c + mu[cc + j] * (p - c);
            o[j] = cc < 64 ? (1.f - 2.f * __builtin_amdgcn_rcpf(1.f + __expf(2.f * xs))) : (cc < 128 ? xs : sigm(xs)); }
        u32x4 w; w.x = pk2(o[0], o[1]); w.y = pk2(o[2], o[3]); w.z = pk2(o[4], o[5]); w.w = pk2(o[6], o[7]);
        *(u32x4*)(AL + (size_t)row * LORA_K + cc) = w;
    }
}

__device__ __forceinline__ void scan_unit(const Args& args, Frame& F, int bh) {
    const int b = bh >> 3, h = bh & 7, tid = F.tid;
    LAS float* LW = (LAS float*)F.lds;
    LAS float* LKK = LW + 4096, *LBB = LW + 8192, *LKP = LW + 12288, *LRR = LW + 16384, *LVV = LW + 20480, *LYY = LW + 24576, *LBON = LW + 28672;
    const bf16* ZR = WSP(bf16, WS_ZR); const float* DEC = WSP(float, WS_DEC); const float* AA = WSP(float, WS_AA); const bf16* GG = WSP(bf16, WS_GG); bf16* YB = WSP(bf16, WS_YB);
    const float* mu = FIN(4); const float* k_k = FIN(10) + h * 64; const float* k_a = FIN(11) + h * 64; const float* r_k = FIN(12) + h * 64;
    const float* lnw = FIN(13) + h * 64; const float* lnb = FIN(14) + h * 64;
    const int tt_p = tid >> 3, j0 = 8 * (tid & 7);
    const int row = tid >> 3, cg = tid & 7;
    float S[8];
#pragma unroll
    for (int j = 0; j < 8; ++j) S[j] = 0.f;
    float mur[8], muk[8], muv[8], kk_c[8], ka_c[8], rk_c[8];
#pragma unroll
    for (int j = 0; j < 8; ++j) { mur[j] = mu[h * 64 + j0 + j]; muk[j] = mu[512 + h * 64 + j0 + j]; muv[j] = mu[1024 + h * 64 + j0 + j]; kk_c[j] = k_k[j0 + j]; ka_c[j] = k_a[j0 + j]; rk_c[j] = r_k[j0 + j]; }
    for (int c0 = 0; c0 < SEQ; c0 += 64) {
        __syncthreads();
        {
            const size_t tok = (size_t)b * SEQ + c0 + tt_p; const bool first = (c0 + tt_p) == 0;
            const bf16* zc = ZR + tok * RWC + h * 64 + j0; const bf16* zp = zc - RWC;
            u32x4 cr = *(const u32x4*)zc, ck = *(const u32x4*)(zc + 512), cv = *(const u32x4*)(zc + 1024);
            u32x4 pr = (u32x4){0u, 0u, 0u, 0u}, pk = pr, pv = pr;
            if (!first) { pr = *(const u32x4*)zp; pk = *(const u32x4*)(zp + 512); pv = *(const u32x4*)(zp + 1024); }
            const f32x4 d0 = *(const f32x4*)(DEC + tok * 512 + h * 64 + j0), d1 = *(const f32x4*)(DEC + tok * 512 + h * 64 + j0 + 4);
            const f32x4 a0 = *(const f32x4*)(AA + tok * 512 + h * 64 + j0), a1 = *(const f32x4*)(AA + tok * 512 + h * 64 + j0 + 4);
            const unsigned crw[4] = {cr.x, cr.y, cr.z, cr.w}, ckw[4] = {ck.x, ck.y, ck.z, ck.w}, cvw[4] = {cv.x, cv.y, cv.z, cv.w};
            const unsigned prw[4] = {pr.x, pr.y, pr.z, pr.w}, pkw[4] = {pk.x, pk.y, pk.z, pk.w}, pvw[4] = {pv.x, pv.y, pv.z, pv.w};
            float r[8], k[8], v[8], kk[8], a[8], dec[8]; float ss = 0.f;
#pragma unroll
            for (int j = 0; j < 8; ++j) {
                const float rc = (j & 1) ? bfhi(crw[j >> 1]) : bflo(crw[j >> 1]), rp = (j & 1) ? bfhi(prw[j >> 1]) : bflo(prw[j >> 1]);
                const float kc = (j & 1) ? bfhi(ckw[j >> 1]) : bflo(ckw[j >> 1]), kp = (j & 1) ? bfhi(pkw[j >> 1]) : bflo(pkw[j >> 1]);
                const float vc = (j & 1) ? bfhi(cvw[j >> 1]) : bflo(cvw[j >> 1]), vp = (j & 1) ? bfhi(pvw[j >> 1]) : bflo(pvw[j >> 1]);
                r[j] = rc + mur[j] * (rp - rc); k[j] = kc + muk[j] * (kp - kc); v[j] = vc + muv[j] * (vp - vc);
                kk[j] = k[j] * kk_c[j]; ss += kk[j] * kk[j];
                a[j] = j < 4 ? a0[j] : a1[j - 4]; dec[j] = j < 4 ? d0[j] : d1[j - 4];
            }
            ss = red8(ss);
            const float inv = 1.0f / fmaxf(sqrtf(ss), 1e-12f);
            float bon = 0.f; float kpv[8], bbv[8];
#pragma unroll
            for (int j = 0; j < 8; ++j) { kk[j] *= inv; bbv[j] = kk[j] * a[j]; kpv[j] = k[j] * (1.f + (a[j] - 1.f) * ka_c[j]); bon += r[j] * kpv[j] * rk_c[j]; }
            bon = red8(bon);
            const int o = tt_p * 64 + j0;
            *(LAS f32x4*)(LW + o) = (f32x4){dec[0], dec[1], dec[2], dec[3]}; *(LAS f32x4*)(LW + o + 4) = (f32x4){dec[4], dec[5], dec[6], dec[7]};
            *(LAS f32x4*)(LKK + o) = (f32x4){kk[0], kk[1], kk[2], kk[3]}; *(LAS f32x4*)(LKK + o + 4) = (f32x4){kk[4], kk[5], kk[6], kk[7]};
            *(LAS f32x4*)(LBB + o) = (f32x4){bbv[0], bbv[1], bbv[2], bbv[3]}; *(LAS f32x4*)(LBB + o + 4) = (f32x4){bbv[4], bbv[5], bbv[6], bbv[7]};
            *(LAS f32x4*)(LKP + o) = (f32x4){kpv[0], kpv[1], kpv[2], kpv[3]}; *(LAS f32x4*)(LKP + o + 4) = (f32x4){kpv[4], kpv[5], kpv[6], kpv[7]};
            *(LAS f32x4*)(LRR + o) = (f32x4){r[0], r[1], r[2], r[3]}; *(LAS f32x4*)(LRR + o + 4) = (f32x4){r[4], r[5], r[6], r[7]};
            *(LAS f32x4*)(LVV + o) = (f32x4){v[0], v[1], v[2], v[3]}; *(LAS f32x4*)(LVV + o + 4) = (f32x4){v[4], v[5], v[6], v[7]};
            if ((tid & 7) == 0) LBON[tt_p] = bon;
        }
        __syncthreads();
#pragma unroll 2
        for (int tt = 0; tt < 64; ++tt) {
            const int o = tt * 64 + 8 * cg;
            const f32x4 k0 = *(const LAS f32x4*)(LKK + o), k1 = *(const LAS f32x4*)(LKK + o + 4);
            const f32x4 w0 = *(const LAS f32x4*)(LW + o), w1 = *(const LAS f32x4*)(LW + o + 4);
            const f32x4 b0 = *(const LAS f32x4*)(LBB + o), b1 = *(const LAS f32x4*)(LBB + o + 4);
            const f32x4 p0 = *(const LAS f32x4*)(LKP + o), p1 = *(const LAS f32x4*)(LKP + o + 4);
            const f32x4 r0 = *(const LAS f32x4*)(LRR + o), r1 = *(const LAS f32x4*)(LRR + o + 4);
            const float vi = LVV[tt * 64 + row];
            float sa = (S[0] * k0[0] + S[1] * k0[1]) + (S[2] * k0[2] + S[3] * k0[3]) + (S[4] * k1[0] + S[5] * k1[1]) + (S[6] * k1[2] + S[7] * k1[3]);
            sa = -red8(sa);
#pragma unroll
            for (int j = 0; j < 4; ++j) { S[j] = S[j] * w0[j] + (sa * b0[j] + vi * p0[j]); S[4 + j] = S[4 + j] * w1[j] + (sa * b1[j] + vi * p1[j]); }
            float y = (S[0] * r0[0] + S[1] * r0[1]) + (S[2] * r0[2] + S[3] * r0[3]) + (S[4] * r1[0] + S[5] * r1[1]) + (S[6] * r1[2] + S[7] * r1[3]);
            y = red8(y);
            if (cg == 0) LYY[tt * 64 + row] = y;
        }
        __syncthreads();
        {
            const size_t tok = (size_t)b * SEQ + c0 + tt_p; const int o = tt_p * 64 + j0;
            const f32x4 y0 = *(const LAS f32x4*)(LYY + o), y1 = *(const LAS f32x4*)(LYY + o + 4);
            const f32x4 v0 = *(const LAS f32x4*)(LVV + o), v1 = *(const LAS f32x4*)(LVV + o + 4);
            float s = (y0[0] + y0[1]) + (y0[2] + y0[3]) + (y1[0] + y1[1]) + (y1[2] + y1[3]);
            const float mean = red8(s) * (1.f / 64.f); float q = 0.f;
#pragma unroll
            for (int j = 0; j < 4; ++j) { const float d0 = y0[j] - mean, d1 = y1[j] - mean; q += d0 * d0 + d1 * d1; }
            const float rs = 1.0f / sqrtf(red8(q) * (1.f / 64.f) + GN_EPS); const float bon = LBON[tt_p];
            const u32x4 gv = *(const u32x4*)(GG + tok * 512 + h * 64 + j0); const unsigned gw[4] = {gv.x, gv.y, gv.z, gv.w}; float ov[8];
#pragma unroll
            for (int j = 0; j < 8; ++j) { const float yy = j < 4 ? y0[j] : y1[j - 4], vv = j < 4 ? v0[j] : v1[j - 4]; const float g = (j & 1) ? bfhi(gw[j >> 1]) : bflo(gw[j >> 1]);
                ov[j] = ((yy - mean) * rs * lnw[j0 + j] + lnb[j0 + j] + bon * vv) * g; }
            u32x4 w; w.x = pk2(ov[0], ov[1]); w.y = pk2(ov[2], ov[3]); w.z = pk2(ov[4], ov[5]); w.w = pk2(ov[6], ov[7]);
            *(u32x4*)(YB + tok * 512 + h * 64 + j0) = w;
        }
    }
    __syncthreads();
}

constexpr int LDA = 72, LDT = 40, LDF = 36;
constexpr int SC_WF = 0, SC_AT = 8192, SC_RT = SC_AT + 4608, SC_BT = SC_RT + 4608, SC_KT = SC_BT + 4608;
constexpr int SC_BCT = SC_KT + 4608, SC_KCT = SC_BCT + 5120, SC_VT = SC_KCT + 5120, SC_AHT = SC_VT + 5120, SC_UHT = SC_AHT + 5120;
constexpr int SC_AAB = SC_UHT + 5120, SC_ARB = SC_AAB + 4608, SC_ARK = SC_ARB + 2560, SC_RHS2 = SC_ARK + 2560, SC_YF = SC_RHS2 + 16384, SC_HT = SC_YF + 8192, SC_BON = SC_HT + 9216;
static_assert(SC_BON + 128 + 2048 <= RING_BYTES, "scan LDS map");
__device__ __forceinline__ float red16(float v) { v += dppf<0xB1>(v); v += dppf<0x4E>(v); v += dppf<0x141>(v); v += dppf<0x140>(v); return v; }
__device__ __forceinline__ bf16x8 ld16(const LAS bf16* p) { return *(const LAS bf16x8*)p; }
__device__ __forceinline__ bf16x8 ld8x2(const LAS bf16* p) { const u32x2 lo = *(const LAS u32x2*)p, hi = *(const LAS u32x2*)(p + 8); const u32x4 w = (u32x4){lo.x, lo.y, hi.x, hi.y}; return __builtin_bit_cast(bf16x8, w); }
__device__ __forceinline__ bf16x8 packq(const f32x16& x, int q) { u32x4 w; w.x = pk2(x[8 * q], x[8 * q + 1]); w.y = pk2(x[8 * q + 2], x[8 * q + 3]); w.z = pk2(x[8 * q + 4], x[8 * q + 5]); w.w = pk2(x[8 * q + 6], x[8 * q + 7]); return __builtin_bit_cast(bf16x8, w); }
#define MFMA32(a, b, c) __builtin_amdgcn_mfma_f32_32x32x16_bf16((a), (b), (c), 0, 0, 0)
struct ScanLoad { u32x2 cr, ck, cv, pr, pk, pv, g; f32x4 dec, eta; };
__device__ __forceinline__ void scan_load(ScanLoad& L, const bf16* ZR, const float* DEC, const float* AA, const bf16* GG, size_t tok, int hc, bool first) {
    const bf16* zc = ZR + tok * RWC + hc; const bf16* zp = zc - RWC;
    L.cr = *(const u32x2*)zc; L.ck = *(const u32x2*)(zc + 512); L.cv = *(const u32x2*)(zc + 1024);
    L.pr = (u32x2){0u, 0u}; L.pk = L.pr; L.pv = L.pr;
    if (!first) { L.pr = *(const u32x2*)zp; L.pk = *(const u32x2*)(zp + 512); L.pv = *(const u32x2*)(zp + 1024); }
    L.dec = *(const f32x4*)(DEC + tok * 512 + hc); L.eta = *(const f32x4*)(AA + tok * 512 + hc); L.g = *(const u32x2*)(GG + tok * 512 + hc);
}
#define LBAR() do { asm volatile("s_waitcnt lgkmcnt(0)" ::: "memory"); __builtin_amdgcn_s_barrier(); asm volatile("" ::: "memory"); } while (0)
__device__ __forceinline__ void scan_unit_chunked(const Args& args, Frame& F, int bh) {
    const int b = bh >> 3, h = bh & 7, tid = F.tid, w = F.wave;
    LAS unsigned char* L = F.lds;
    LAS float* WF = (LAS float*)(L + SC_WF); LAS float* AAB = (LAS float*)(L + SC_AAB); LAS float* RHS2 = (LAS float*)(L + SC_RHS2); LAS float* YF = (LAS float*)(L + SC_YF); LAS float* BON = (LAS float*)(L + SC_BON);
    LAS bf16* AT = (LAS bf16*)(L + SC_AT); LAS bf16* RT = (LAS bf16*)(L + SC_RT); LAS bf16* BT = (LAS bf16*)(L + SC_BT); LAS bf16* KT = (LAS bf16*)(L + SC_KT);
    LAS bf16* BCT = (LAS bf16*)(L + SC_BCT); LAS bf16* KCT = (LAS bf16*)(L + SC_KCT); LAS bf16* VT = (LAS bf16*)(L + SC_VT); LAS bf16* AHT = (LAS bf16*)(L + SC_AHT); LAS bf16* UHT = (LAS bf16*)(L + SC_UHT);
    LAS bf16* ARB = (LAS bf16*)(L + SC_ARB); LAS bf16* ARK = (LAS bf16*)(L + SC_ARK); LAS bf16* HT = (LAS bf16*)(L + SC_HT);
    const bf16* ZR = WSP(bf16, WS_ZR); const float* DEC = WSP(float, WS_DEC); const float* AA = WSP(float, WS_AA); const bf16* GG = WSP(bf16, WS_GG); bf16* YB = WSP(bf16, WS_YB);
    const int t = tid >> 4, j0 = 4 * (tid & 15), hc = h * 64 + j0;
    LAS float* CST = (LAS float*)(L + SC_BON + 128);
    { const int c = tid >> 6, j = tid & 63; const float* src = c == 0 ? FIN(4) : c == 1 ? FIN(4) + 512 : c == 2 ? FIN(4) + 1024 : c == 3 ? FIN(10) : c == 4 ? FIN(11) : c == 5 ? FIN(12) : c == 6 ? FIN(13) : FIN(14);
      CST[c * 64 + j] = src[h * 64 + j]; }
    for (int i = tid; i < 64 * LDA / 2; i += 512) ((LAS unsigned*)HT)[i] = 0u;
    ScanLoad cur; scan_load(cur, ZR, DEC, AA, GG, (size_t)b * SEQ + t, hc, t == 0);
    LBAR();
    u32x2 pend = (u32x2){0u, 0u};
    for (int c0 = 0; c0 < SEQ; c0 += 32) {
        const size_t tok = (size_t)b * SEQ + c0 + t;
        float r[4], kp[4], v[4], al[4], be[4], gq[4];
        {
            const f32x4 mur = *(const LAS f32x4*)(CST + j0), muk = *(const LAS f32x4*)(CST + 64 + j0), muv = *(const LAS f32x4*)(CST + 128 + j0), kkc = *(const LAS f32x4*)(CST + 192 + j0), kac = *(const LAS f32x4*)(CST + 256 + j0), rkc = *(const LAS f32x4*)(CST + 320 + j0);
            const unsigned crw[2] = {cur.cr.x, cur.cr.y}, ckw[2] = {cur.ck.x, cur.ck.y}, cvw[2] = {cur.cv.x, cur.cv.y}, prw[2] = {cur.pr.x, cur.pr.y}, pkw[2] = {cur.pk.x, cur.pk.y}, pvw[2] = {cur.pv.x, cur.pv.y}, gw2[2] = {cur.g.x, cur.g.y};
            float k[4], kk[4]; float ss = 0.f;
#pragma unroll
            for (int j = 0; j < 4; ++j) {
                const float rc = (j & 1) ? bfhi(crw[j >> 1]) : bflo(crw[j >> 1]), rp = (j & 1) ? bfhi(prw[j >> 1]) : bflo(prw[j >> 1]);
                const float kc = (j & 1) ? bfhi(ckw[j >> 1]) : bflo(ckw[j >> 1]), kq = (j & 1) ? bfhi(pkw[j >> 1]) : bflo(pkw[j >> 1]);
                const float vc = (j & 1) ? bfhi(cvw[j >> 1]) : bflo(cvw[j >> 1]), vq = (j & 1) ? bfhi(pvw[j >> 1]) : bflo(pvw[j >> 1]);
                r[j] = rc + mur[j] * (rp - rc); k[j] = kc + muk[j] * (kq - kc); v[j] = vc + muv[j] * (vq - vc);
                kk[j] = k[j] * kkc[j]; ss += kk[j] * kk[j]; gq[j] = (j & 1) ? bfhi(gw2[j >> 1]) : bflo(gw2[j >> 1]);
            }
            ss = red16(ss);
            const float inv = 1.0f / fmaxf(sqrtf(ss), 1e-12f); float bon = 0.f;
#pragma unroll
            for (int j = 0; j < 4; ++j) { kk[j] *= inv; al[j] = -kk[j]; be[j] = kk[j] * cur.eta[j]; kp[j] = k[j] * (1.f + (cur.eta[j] - 1.f) * kac[j]); bon += r[j] * kp[j] * rkc[j]; }
            bon = red16(bon);
            *(LAS f32x4*)(WF + t * 64 + j0) = cur.dec;
            if ((tid & 15) == 0) BON[t] = bon;
        }
        if (c0 + 32 < SEQ && !(SCAN_STUB & 32)) scan_load(cur, ZR, DEC, AA, GG, tok + 32, hc, false);
        if (c0 > 0) { const bf16* yp = YB + (tok - 32) * 512 + hc; asm volatile("global_store_dwordx2 %0, %1, off" :: "v"(yp), "v"(pend) : "memory"); }
        LBAR();
        if (w == 0 && !(SCAN_STUB & 8)) { float g = 1.f; const int lane = lane_now();
#pragma unroll
            for (int tt = 0; tt < 32; ++tt) { g *= WF[tt * 64 + lane]; WF[tt * 64 + lane] = g; } }
        LBAR();
        {
            const f32x4 gt = *(const LAS f32x4*)(WF + t * 64 + j0), gC = *(const LAS f32x4*)(WF + 31 * 64 + j0);
            f32x4 gp = (f32x4){1.f, 1.f, 1.f, 1.f}; if (t > 0) gp = *(const LAS f32x4*)(WF + (t - 1) * 64 + j0);
            float a_[4], r_[4], b_[4], k_[4], bc[4], kc[4];
#pragma unroll
            for (int j = 0; j < 4; ++j) { const float ig = 1.0f / gt[j]; a_[j] = al[j] * gp[j]; r_[j] = r[j] * gt[j]; b_[j] = be[j] * ig; k_[j] = kp[j] * ig; bc[j] = b_[j] * gC[j]; kc[j] = k_[j] * gC[j]; }
            u32x2 wv; wv.x = pk2(a_[0], a_[1]); wv.y = pk2(a_[2], a_[3]); *(LAS u32x2*)(AT + t * LDA + j0) = wv;
            wv.x = pk2(r_[0], r_[1]); wv.y = pk2(r_[2], r_[3]); *(LAS u32x2*)(RT + t * LDA + j0) = wv;
            wv.x = pk2(b_[0], b_[1]); wv.y = pk2(b_[2], b_[3]); *(LAS u32x2*)(BT + t * LDA + j0) = wv;
            wv.x = pk2(k_[0], k_[1]); wv.y = pk2(k_[2], k_[3]); *(LAS u32x2*)(KT + t * LDA + j0) = wv;
#pragma unroll
            for (int j = 0; j < ((SCAN_STUB & 16) ? 0 : 4); ++j) { BCT[(j0 + j) * LDT + t] = (bf16)(pk2(bc[j], 0.f) & 0xffffu); KCT[(j0 + j) * LDT + t] = (bf16)(pk2(kc[j], 0.f) & 0xffffu); VT[(j0 + j) * LDT + t] = (bf16)(pk2(v[j], 0.f) & 0xffffu); }
        }
        LBAR();
        if (w < 4 && !(SCAN_STUB & 1)) {
            const int lane = lane_now(), r32 = lane & 31, hh = lane >> 5;
            f32x16 mT, mN;
#pragma unroll
            for (int i = 0; i < 16; ++i) { mT[i] = 0.f; mN[i] = 0.f; }
#pragma unroll
            for (int q = 0; q < 4; ++q) { const bf16x8 bfr = ld16(BT + r32 * LDA + 8 * hh + 16 * q), afr = ld16(AT + r32 * LDA + 8 * hh + 16 * q);
                mT = MFMA32(bfr, afr, mT);
                mN = MFMA32(afr, bfr, mN); }
#pragma unroll
            for (int i = 0; i < 16; ++i) { const int c_ = crow(i, hh); mT[i] = (c_ < r32) ? mT[i] : 0.f; mN[i] = (r32 < c_) ? mN[i] : 0.f; }
            f32x16 X;
            if (w < 2) {
#pragma unroll
                for (int i = 0; i < 16; ++i) X[i] = bflo((unsigned)AT[crow(i, hh) * LDA + 32 * w + r32]);
            } else {
                f32x16 kT;
#pragma unroll
                for (int i = 0; i < 16; ++i) { kT[i] = 0.f; X[i] = 0.f; }
#pragma unroll
                for (int q = 0; q < 4; ++q) kT = MFMA32(ld16(KT + r32 * LDA + 8 * hh + 16 * q), ld16(AT + r32 * LDA + 8 * hh + 16 * q), kT);
#pragma unroll
                for (int i = 0; i < 16; ++i) kT[i] = (crow(i, hh) < r32) ? kT[i] : 0.f;
#pragma unroll
                for (int q = 0; q < 2; ++q) X = MFMA32(packq(kT, q), ld8x2(VT + (32 * (w - 2) + r32) * LDT + 16 * q + 4 * hh), X);
            }
#pragma unroll
            for (int k = 0; k < 5; ++k) {
                const bf16x8 t0 = packq(mT, 0), t1 = packq(mT, 1), x0 = packq(X, 0), x1 = packq(X, 1);
                X = MFMA32(t0, x0, X); X = MFMA32(t1, x1, X);
                if (k < 4) {
                    const bf16x8 n0 = packq(mN, 0), n1 = packq(mN, 1);
                    f32x16 zT, zN;
#pragma unroll
                    for (int i = 0; i < 16; ++i) { zT[i] = 0.f; zN[i] = 0.f; }
                    zT = MFMA32(n0, t0, zT); zT = MFMA32(n1, t1, zT);
                    zN = MFMA32(t0, n0, zN); zN = MFMA32(t1, n1, zN);
                    mT = zT; mN = zN;
                }
            }
            LAS bf16* dst = ((w < 2) ? AHT : UHT) + (32 * (w & 1) + r32) * LDT + 4 * hh;
#pragma unroll
            for (int i4 = 0; i4 < 4; ++i4) { u32x2 wv; wv.x = pk2(X[4 * i4], X[4 * i4 + 1]); wv.y = pk2(X[4 * i4 + 2], X[4 * i4 + 3]); *(LAS u32x2*)(dst + 8 * i4) = wv; }
        } else if (w < 6 && !(SCAN_STUB & 1)) {
            const int lane = lane_now(), r32 = lane & 31, hh = lane >> 5;
            const LAS bf16* Aop = ((w & 1) ? KT : BT) + r32 * LDA + 8 * hh; const LAS bf16* Bop = RT + r32 * LDA + 8 * hh;
            f32x16 x;
#pragma unroll
            for (int i = 0; i < 16; ++i) x[i] = 0.f;
#pragma unroll
            for (int q = 0; q < 4; ++q) x = MFMA32(ld16(Aop + 16 * q), ld16(Bop + 16 * q), x);
#pragma unroll
            for (int i = 0; i < 16; ++i) x[i] = (crow(i, hh) <= r32) ? x[i] : 0.f;
            LAS bf16* dst = ((w & 1) ? ARK : ARB) + r32 * LDT + 4 * hh;
#pragma unroll
            for (int i4 = 0; i4 < 4; ++i4) { u32x2 wv; wv.x = pk2(x[4 * i4], x[4 * i4 + 1]); wv.y = pk2(x[4 * i4 + 2], x[4 * i4 + 3]); *(LAS u32x2*)(dst + 8 * i4) = wv; }
        }
        LBAR();
        f32x16 hn;
        if (SCAN_STUB & 4) { for (int i = 0; i < 16; ++i) hn[i] = 0.f; } else if (w < 4) {
            const int lane = lane_now(), r32 = lane & 31, hh = lane >> 5;
            const int jb = w >> 1, ib = w & 1;
            f32x16 pt[2];
#pragma unroll
            for (int a = 0; a < 2; ++a) {
#pragma unroll
                for (int i = 0; i < 16; ++i) pt[a][i] = 0.f;
#pragma unroll
                for (int q = 0; q < 2; ++q) pt[a] = MFMA32(ld16(AHT + (32 * a + r32) * LDT + 16 * q + 8 * hh), ld16(BCT + (32 * jb + r32) * LDT + 16 * q + 8 * hh), pt[a]);
            }
            { const float gC = WF[31 * 64 + 32 * jb + r32];
#pragma unroll
              for (int i = 0; i < 16; ++i) { const float add = (crow(i, hh) == r32) ? gC : 0.f; pt[0][i] += (jb == 0) ? add : 0.f; pt[1][i] += (jb == 0) ? 0.f : add; } }
#pragma unroll
            for (int i = 0; i < 16; ++i) hn[i] = 0.f;
#pragma unroll
            for (int q = 0; q < 2; ++q) {
                hn = MFMA32(ld16(BCT + (32 * jb + r32) * LDT + 16 * q + 8 * hh), ld16(UHT + (32 * ib + r32) * LDT + 16 * q + 8 * hh), hn);
                hn = MFMA32(ld16(KCT + (32 * jb + r32) * LDT + 16 * q + 8 * hh), ld16(VT + (32 * ib + r32) * LDT + 16 * q + 8 * hh), hn);
            }
#pragma unroll
            for (int a = 0; a < 2; ++a)
#pragma unroll
                for (int q = 0; q < 2; ++q) hn = MFMA32(packq(pt[a], q), ld8x2(HT + (32 * ib + r32) * LDA + 32 * a + 16 * q + 4 * hh), hn);
        } else if (w < 6) {
            const int lane = lane_now(), r32 = lane & 31, hh = lane >> 5;
            const int ib = w & 1;
            f32x16 rt[2];
#pragma unroll
            for (int a = 0; a < 2; ++a) {
#pragma unroll
                for (int i = 0; i < 16; ++i) rt[a][i] = bflo((unsigned)RT[r32 * LDA + 32 * a + crow(i, hh)]);
#pragma unroll
                for (int q = 0; q < 2; ++q) rt[a] = MFMA32(ld16(AHT + (32 * a + r32) * LDT + 16 * q + 8 * hh), ld16(ARB + r32 * LDT + 16 * q + 8 * hh), rt[a]);
            }
            f32x16 y;
#pragma unroll
            for (int i = 0; i < 16; ++i) y[i] = 0.f;
#pragma unroll
            for (int q = 0; q < 2; ++q) {
                y = MFMA32(ld16(ARB + r32 * LDT + 16 * q + 8 * hh), ld16(UHT + (32 * ib + r32) * LDT + 16 * q + 8 * hh), y);
                y = MFMA32(ld16(ARK + r32 * LDT + 16 * q + 8 * hh), ld16(VT + (32 * ib + r32) * LDT + 16 * q + 8 * hh), y);
            }
#pragma unroll
            for (int a = 0; a < 2; ++a)
#pragma unroll
                for (int q = 0; q < 2; ++q) y = MFMA32(packq(rt[a], q), ld8x2(HT + (32 * ib + r32) * LDA + 32 * a + 16 * q + 4 * hh), y);
#pragma unroll
            for (int i = 0; i < 16; ++i) YF[crow(i, hh) * 64 + 32 * ib + r32] = y[i];
        }
        LBAR();
        if (w < 4) {
            const int lane = lane_now(), r32 = lane & 31, hh = lane >> 5;
            const int jb = w >> 1, ib = w & 1; LAS bf16* dst = HT + (32 * ib + r32) * LDA + 32 * jb + 4 * hh;
#pragma unroll
            for (int i4 = 0; i4 < 4; ++i4) { u32x2 wv; wv.x = pk2(hn[4 * i4], hn[4 * i4 + 1]); wv.y = pk2(hn[4 * i4 + 2], hn[4 * i4 + 3]); *(LAS u32x2*)(dst + 8 * i4) = wv; }
        }
        {
            const f32x4 y4 = *(const LAS f32x4*)(YF + t * 64 + j0);
            const float mean = red16((y4[0] + y4[1]) + (y4[2] + y4[3])) * (1.f / 64.f); float qv = 0.f;
#pragma unroll
            for (int j = 0; j < 4; ++j) { const float d = y4[j] - mean; qv += d * d; }
            const float rs = 1.0f / sqrtf(red16(qv) * (1.f / 64.f) + GN_EPS); const float bon = BON[t]; float ov[4];
            const f32x4 lnw = *(const LAS f32x4*)(CST + 384 + j0), lnb = *(const LAS f32x4*)(CST + 448 + j0);
#pragma unroll
            for (int j = 0; j < 4; ++j) ov[j] = ((y4[j] - mean) * rs * lnw[j] + lnb[j] + bon * v[j]) * gq[j];
            pend.x = pk2(ov[0], ov[1]); pend.y = pk2(ov[2], ov[3]);
        }
        LBAR();
    }
    *(u32x2*)(YB + ((size_t)b * SEQ + SEQ - 32 + t) * 512 + hc) = pend;
}

__device__ __forceinline__ void attn_tile(Frame& F, int bh, int qt) {
    const int lane = F.lane, q = lane & 31, hi = lane >> 5, b = bh >> 3, h = bh & 7, t0 = 32 * qt;
    const size_t tokbase = (size_t)b * SEQ;
    const bf16* QB = WSP(bf16, WS_Q); const bf16* KB = WSP(bf16, WS_K); const bf16* VT = WSP(bf16, WS_VT); bf16* YA = WSP(bf16, WS_YA);
    bf16x8 qf[4];
    { const bf16* Qp = QB + (tokbase + t0 + q) * 512 + h * 64 + 8 * hi;
#pragma unroll
      for (int d0 = 0; d0 < 4; ++d0) qf[d0] = *(const bf16x8*)(Qp + 16 * d0); }
    f32x16 y0, y1;
#pragma unroll
    for (int r = 0; r < 16; ++r) { y0[r] = 0.f; y1[r] = 0.f; }
    float carry = 1.f;
    const bf16* Vrow = VT + ((size_t)(bh * 64) + q) * SEQ + 4 * hi;
    for (int s0 = t0; s0 >= 0; s0 -= 32) {
        bf16x8 kf[4];
        { const bf16* Kp = KB + (tokbase + s0 + q) * 512 + h * 64 + 8 * hi;
#pragma unroll
          for (int d0 = 0; d0 < 4; ++d0) kf[d0] = *(const bf16x8*)(Kp + 16 * d0); }
        u32x2 vlo[2][2], vhi[2][2];
#pragma unroll
        for (int dt = 0; dt < 2; ++dt)
#pragma unroll
            for (int s = 0; s < 2; ++s) { const bf16* vp = Vrow + (size_t)dt * 32 * SEQ + s0 + 16 * s; vlo[dt][s] = *(const u32x2*)vp; vhi[dt][s] = *(const u32x2*)(vp + 8); }
        f32x16 p;
#pragma unroll
        for (int r = 0; r < 16; ++r) p[r] = 0.f;
#pragma unroll
        for (int d0 = 0; d0 < 4; ++d0) p = __builtin_amdgcn_mfma_f32_32x32x16_bf16(kf[d0], qf[d0], p, 0, 0, 0);
        float om[16], be[16];
#pragma unroll
        for (int r = 0; r < 16; ++r) {
            const int kv = crow(r, hi); const bool valid = (s0 + kv) < (t0 + q);
            const float z = fminf(p[r], 80.f); const float t = __expf(z); const float o = __builtin_amdgcn_rcpf(1.f + t);
            om[r] = valid ? o : 1.f; be[r] = valid ? t * o : 0.f;
        }
        float el[16], G[4], PG[4];
#pragma unroll
        for (int i = 0; i < 4; ++i) { el[4 * i + 3] = 1.f; el[4 * i + 2] = om[4 * i + 3]; el[4 * i + 1] = el[4 * i + 2] * om[4 * i + 2]; el[4 * i] = el[4 * i + 1] * om[4 * i + 1]; G[i] = el[4 * i] * om[4 * i]; }
#pragma unroll
        for (int i = 0; i < 4; ++i) PG[i] = __shfl_xor(G[i], 32);
        float sG[4], sP[4];
        sG[3] = 1.f; sG[2] = G[3]; sG[1] = G[3] * G[2]; sG[0] = sG[1] * G[1];
        sP[3] = 1.f; sP[2] = PG[3]; sP[1] = PG[3] * PG[2]; sP[0] = sP[1] * PG[1];
        const float total = (sG[0] * G[0]) * (sP[0] * PG[0]);
        float A[16];
#pragma unroll
        for (int i = 0; i < 4; ++i) { const float eg = sG[i] * (hi ? sP[i] : sP[i] * PG[i]) * carry;
#pragma unroll
            for (int j = 0; j < 4; ++j) A[4 * i + j] = be[4 * i + j] * el[4 * i + j] * eg; }
        carry *= total;
        bf16x8 pf[2];
#pragma unroll
        for (int s = 0; s < 2; ++s) { u32x4 w; w.x = pk2(A[8 * s], A[8 * s + 1]); w.y = pk2(A[8 * s + 2], A[8 * s + 3]); w.z = pk2(A[8 * s + 4], A[8 * s + 5]); w.w = pk2(A[8 * s + 6], A[8 * s + 7]); pf[s] = __builtin_bit_cast(bf16x8, w); }
#pragma unroll
        for (int s = 0; s < 2; ++s) {
            const u32x4 a0 = (u32x4){vlo[0][s].x, vlo[0][s].y, vhi[0][s].x, vhi[0][s].y}, a1 = (u32x4){vlo[1][s].x, vlo[1][s].y, vhi[1][s].x, vhi[1][s].y};
            y0 = __builtin_amdgcn_mfma_f32_32x32x16_bf16(__builtin_bit_cast(bf16x8, a0), pf[s], y0, 0, 0, 0);
            y1 = __builtin_amdgcn_mfma_f32_32x32x16_bf16(__builtin_bit_cast(bf16x8, a1), pf[s], y1, 0, 0, 0);
        }
        if (__all(carry < 5.6e-14f)) break;
    }
    bf16* Yp = YA + (tokbase + t0 + q) * 512 + h * 64 + 4 * hi;
#pragma unroll
    for (int i = 0; i < 4; ++i) {
        u32x2 w0, w1; w0.x = pk2(y0[4 * i], y0[4 * i + 1]); w0.y = pk2(y0[4 * i + 2], y0[4 * i + 3]); w1.x = pk2(y1[4 * i], y1[4 * i + 1]); w1.y = pk2(y1[4 * i + 2], y1[4 * i + 3]);
        *(u32x2*)(Yp + 8 * i) = w0; *(u32x2*)(Yp + 32 + 8 * i) = w1;
    }
}

__device__ __forceinline__ void p5a_router(const Args& args, Frame& F) {
    LAS float* LG = (LAS float*)F.lds;
    LAS unsigned* HIST = (LAS unsigned*)(F.lds + 32768); LAS unsigned* BASE = HIST + 32;
    const float* X1 = WSP(float, WS_X1); const float* GW = WSP(float, WS_GW); const float* rb = FIN(20);
    unsigned* cnt = F.ctl + CW_CNT; int* LIST = WSP(int, WS_LIST); float* GATEW = WSP(float, WS_GATEW); float* R1 = WSP(float, WS_RSTD1);
    const int tid = F.tid, lane = F.lane, wave = F.wave;
    for (int tb = blockIdx.x; tb < M / 128; tb += F.G) {
        if (tid < 32) HIST[tid] = 0u;
        __syncthreads();
        int ex[4] = {0, 0, 0, 0}; float gt[4] = {0.f, 0.f, 0.f, 0.f}; unsigned lr[4] = {0u, 0u, 0u, 0u}; int tok = 0;
        if (wave < 4) {
            const int i = lane & 31, kh = lane >> 5; tok = tb * 128 + wave * 32 + i;
            const float* xr = X1 + (size_t)tok * D + 4 * kh;
            f32x16 acc;
#pragma unroll
            for (int r = 0; r < 16; ++r) acc[r] = 0.f;
            float ss = 0.f;
#pragma unroll 4
            for (int u = 0; u < 128; ++u) {
                const f32x4 a = *(const f32x4*)(xr + 8 * u); ss += (a[0] * a[0] + a[1] * a[1]) + (a[2] * a[2] + a[3] * a[3]);
                const float* gp = GW + (size_t)(8 * u + 4 * kh) * 32 + i;
#pragma unroll
                for (int j = 0; j < 4; ++j) acc = __builtin_amdgcn_mfma_f32_32x32x2f32(a[j], gp[32 * j], acc, 0, 0, 0);
            }
            ss += __shfl_xor(ss, 32);
            const float rstd = 1.0f / sqrtf(ss * (1.f / D) + RMS_EPS);
            if (kh == 0) R1[tok] = rstd;
            LAS float* L = LG + wave * (32 * 33);
#pragma unroll
            for (int r = 0; r < 16; ++r) L[crow(r, kh) * 33 + i] = acc[r];
            asm volatile("s_waitcnt lgkmcnt(0)" ::: "memory");
            if (kh == 0) {
                float v0 = -3.0e38f, v1 = -3.0e38f, v2 = -3.0e38f, v3 = -3.0e38f; int i0 = 0, i1 = 0, i2 = 0, i3 = 0;
                for (int e = 0; e < 32; ++e) { const float v = L[i * 33 + e] * rstd + rb[e];
                    if (v > v3) { if (v > v2) { v3 = v2; i3 = i2; if (v > v1) { v2 = v1; i2 = i1; if (v > v0) { v1 = v0; i1 = i0; v0 = v; i0 = e; } else { v1 = v; i1 = e; } } else { v2 = v; i2 = e; } } else { v3 = v; i3 = e; } } }
                const float e1 = __expf(v1 - v0), e2 = __expf(v2 - v0), e3 = __expf(v3 - v0), inv = 1.0f / (1.f + e1 + e2 + e3);
                ex[0] = i0; ex[1] = i1; ex[2] = i2; ex[3] = i3; gt[0] = inv; gt[1] = e1 * inv; gt[2] = e2 * inv; gt[3] = e3 * inv;
#pragma unroll
                for (int k = 0; k < 4; ++k) lr[k] = __hip_atomic_fetch_add(&HIST[ex[k]], 1u, __ATOMIC_RELAXED, __HIP_MEMORY_SCOPE_WORKGROUP);
            }
        }
        __syncthreads();
        if (tid < 32) BASE[tid] = __hip_atomic_fetch_add(cnt + tid, HIST[tid], RLX_AGENT);
        __syncthreads();
        if (wave < 4 && lane < 32) {
#pragma unroll
            for (int k = 0; k < 4; ++k) { const unsigned pos = BASE[ex[k]] + lr[k]; LIST[(size_t)ex[k] * CAP + pos] = tok * 4 + k; GATEW[tok * 4 + k] = gt[k]; }
        }
        __syncthreads();
    }
}
__device__ __forceinline__ int moe_tables(Frame& F) {
    LAS int* CS = (LAS int*)(F.lds + MOE_OFF); LAS int* OFF = CS + 32; LAS unsigned char* TE = F.lds + MOE_TE;
    if (F.tid < 32) { int c = (int)__hip_atomic_load(F.ctl + CW_CNT + F.tid, RLX_AGENT); CS[F.tid] = c > CAP ? CAP : c; }
    __syncthreads();
    if (F.tid == 0) { int off = 0; for (int e = 0; e < 32; ++e) { OFF[e] = off; off += ((CS[e] + 255) >> 8) << 8; } OFF[32] = off; }
    __syncthreads();
    const int ntiles = OFF[32] >> 8;
    for (int t = F.tid; t < ntiles; t += 512) { int e = 0; while (e < 31 && OFF[e + 1] <= t * 256) ++e; TE[t] = (unsigned char)e; }
    __syncthreads();
    return ntiles;
}
__device__ __forceinline__ void p8_combine(Frame& F) {
    float* X1 = WSP(float, WS_X1); const bf16* YBF = WSP(bf16, WS_YBUF); bf16* X2B = WSP(bf16, WS_X2B); float* R2 = WSP(float, WS_RSTD2); float* RSS = WSP(float, WS_ROWSS);
    const int gw = F.vcu * 8 + F.wave, NGW = F.G * 8, lane = F.lane;
    for (int t = gw; t < M; t += NGW) {
        f32x4* xr = (f32x4*)(X1 + (size_t)t * D) + lane; f32x4 v[4]; float s = 0.f;
#pragma unroll
        for (int j = 0; j < 4; ++j) v[j] = xr[64 * j];
#pragma unroll
        for (int k = 0; k < 4; ++k) { const u32x2* yr = (const u32x2*)(YBF + (size_t)(4 * t + k) * D) + lane;
#pragma unroll
            for (int j = 0; j < 4; ++j) { const u32x2 w = yr[64 * j]; v[j].x += bflo(w.x); v[j].y += bfhi(w.x); v[j].z += bflo(w.y); v[j].w += bfhi(w.y); } }
        u32x2* o = (u32x2*)(X2B + (size_t)t * D) + lane;
#pragma unroll
        for (int j = 0; j < 4; ++j) { s += (v[j].x * v[j].x + v[j].y * v[j].y) + (v[j].z * v[j].z + v[j].w * v[j].w); u32x2 w; w.x = pk2(v[j].x, v[j].y); w.y = pk2(v[j].z, v[j].w); o[64 * j] = w; }
        s = wave_sum(s);
        if (lane == 0) { R2[t] = 1.0f / sqrtf(s * (1.f / D) + RMS_EPS); RSS[t] = 0.f; }
    }
}
constexpr int NPHASE = 11;
__global__ void __launch_bounds__(512, 2) mega_fwd(Args args) {
    extern __shared__ __attribute__((aligned(16))) unsigned char lds[];
    Frame F;
    F.lds = (LAS unsigned char*)lds;
    F.wave = __builtin_amdgcn_readfirstlane((int)threadIdx.x >> 6); F.lane = lane_now(); F.tid = F.wave * 64 + F.lane;
    F.G = gridDim.x; { const int bx = blockIdx.x; F.vcu = (F.G % 8 == 0) ? (bx % 8) * (F.G / 8) + bx / 8 : bx; }
    F.ws = args.ws; F.ctl = (unsigned*)(args.ws + WS_CTL); F.out = args.out;
    volatile LAS unsigned* MISC = (volatile LAS unsigned*)(F.lds + LDSCTL_OFF);
    if (F.tid < 64) MISC[F.tid] = 0u;
    __syncthreads();
    const int lo = args.ph_lo, hi = args.ph_hi;
    XcdBarrier bar; bar.bar = F.ctl + CW_BAR; bar.x = 0; bar.st = nullptr;
    if (hi - lo > 1) bar = xcd_barrier_post(F.ctl + CW_BAR, MISC + 8, F.tid);
#ifndef PH_MASK
#define PH_MASK 0xFFFF
#endif
#define IN(k) ((((PH_MASK) >> (k)) & 1) && lo <= (k) && (k) < hi)
#define STAMP(k) do { if (TS_PROBE >= 0 && blockIdx.x == 0 && F.tid == 0) ((unsigned long long*)(F.ctl + 2048))[k] = __builtin_amdgcn_s_memrealtime(); } while (0)
#define SEAM(k) do { if (IN(k) && IN((k) + 1)) xcd_barrier(bar, F.wave); F.lane = lane_now(); F.tid = F.wave * 64 + F.lane; STAMP((k) + 1); } while (0)
    LAS unsigned char* ring = F.lds;
    STAMP(0);

    if (IN(0)) { p0_prologue(args, F); expert_convert(args, F, F.vcu * 8 + F.wave, F.G * 8, F.G < 256 ? 3 : 2); } SEAM(0);

    if (IN(1)) {
        pg8::Gemm g{WSP(bf16, WS_XB), WSP(bf16, WS_WIN), M, INC, D, 0, nullptr, nullptr, nullptr}; pg8::StaticOrder S; S.init(M, INC, F.G, (int)blockIdx.x);
        EpiG1 E{WSP(float, WS_RSTD0), WSP(bf16, WS_Q), WSP(bf16, WS_K), WSP(bf16, WS_VT), WSP(bf16, WS_ZR), WSP(bf16, WS_GT)};
        pg8::gemm_phase(ring, g, S, E, F.wave);
    } SEAM(1);

    if (IN(2)) {
        for (int c = blockIdx.x; c < 256; c += F.G) {
            const int x = c & 7, y = c >> 3; pg8::LoraOrder S; S.half = y & 1; S.pm = x + 8 * (y >> 1); S.nu = 3 + (F.G >> 30);
            build_alora(args, F, S.pm);
            asm volatile("s_waitcnt vmcnt(0)" ::: "memory"); __syncthreads();
            pg8::Gemm g{WSP(bf16, WS_ALORA), WSP(bf16, WS_WL), M, LORA_N, LORA_K, 0, nullptr, nullptr, nullptr};
            EpiLora E{FIN(5), FIN(7), WSP(float, WS_DEC), WSP(float, WS_AA), WSP(bf16, WS_GG)};
            pg8::gemm_phase(ring, g, S, E, F.wave);
        }
    } SEAM(2);

    if (IN(3)) {
        for (int u = blockIdx.x; u < 256; u += F.G) {
#ifndef P3_ONLY
#define P3_ONLY 0
#endif
            if (u < 128) { if (P3_ONLY != 2) scan_unit_chunked(args, F, u); else { bf16* YB = WSP(bf16, WS_YB); const int b = u >> 3, h = u & 7; for (int i = F.tid; i < SEQ * 8; i += 512) { const int tk = i >> 3, c8 = (i & 7) * 8; *(u32x4*)(YB + ((size_t)b * SEQ + tk) * 512 + h * 64 + c8) = (u32x4){0u, 0u, 0u, 0u}; } } }
            else if (P3_ONLY == 1) { bf16* YAz = WSP(bf16, WS_YA); const int bh = u - 128, b = bh >> 3, h = bh & 7; for (int i = F.tid; i < SEQ * 8; i += 512) { const int tk = i >> 3, c8 = (i & 7) * 8; *(u32x4*)(YAz + ((size_t)b * SEQ + tk) * 512 + h * 64 + c8) = (u32x4){0u, 0u, 0u, 0u}; } }
            else { const int bh = u - 128; for (int i = 0; i < 8; ++i) attn_tile(F, bh, F.wave + 8 * i);
                   if (F.G >= 256) expert_convert(args, F, bh * 8 + F.wave, 1024, 1); }
        }
    } SEAM(3);

    if (IN(4)) {
        pg8::StaticOrder S; S.init(M, D, F.G, (int)blockIdx.x);
        { pg8::Gemm g{WSP(bf16, WS_YA), WSP(bf16, WS_WA), M, D, AW, 0, nullptr, nullptr, nullptr}; EpiMerge<0> E{WSP(bf16, WS_GT), WSP(bf16, WS_MERGED)}; pg8::gemm_phase(ring, g, S, E, F.wave); }
        { pg8::Gemm g{WSP(bf16, WS_YB), WSP(bf16, WS_WB), M, D, RW, 0, nullptr, nullptr, nullptr}; EpiMerge<1> E{WSP(bf16, WS_GT), WSP(bf16, WS_MERGED)}; pg8::gemm_phase(ring, g, S, E, F.wave); }
    } SEAM(4);

    if (IN(5)) {
        pg8::Gemm g{WSP(bf16, WS_MERGED), WSP(bf16, WS_WO), M, D, D, 0, nullptr, nullptr, nullptr}; pg8::StaticOrder S; S.init(M, D, F.G, (int)blockIdx.x);
        EpiX1 E{FIN(0), WSP(float, WS_X1), FIN(18), WSP(bf16, WS_HN)};
        pg8::gemm_phase(ring, g, S, E, F.wave);
    } SEAM(5);

    if (IN(6)) { p5a_router(args, F); } SEAM(6);

    if (IN(7)) {
        const int ntiles = moe_tables(F);
        pg8::Gemm g{WSP(bf16, WS_HN), WSP(bf16, WS_W1), MAXROWS, F2, D, (size_t)F2 * D * 2, WSP(int, WS_LIST), (const LAS int*)(F.lds + MOE_OFF) + 32, (const LAS int*)(F.lds + MOE_OFF)};
        pg8::MoeOrder S{ntiles, F2 / 256, F.G, (int)blockIdx.x, F.lds + MOE_TE};
        EpiSwiglu E{FIN(22), WSP(bf16, WS_ACT), WSP(int, WS_LIST), WSP(float, WS_RSTD1), (const LAS int*)(F.lds + MOE_OFF) + 32, (const LAS int*)(F.lds + MOE_OFF)};
        pg8::gemm_phase<EpiSwiglu, pg8::MoeOrder, true>(ring, g, S, E, F.wave);
    } SEAM(7);

    if (IN(8)) {
        const int ntiles = moe_tables(F);
        pg8::Gemm g{WSP(bf16, WS_ACT), WSP(bf16, WS_W2), MAXROWS, D, FH, (size_t)D * FH * 2, nullptr, nullptr, nullptr};
        pg8::MoeOrder S{ntiles, D / 256, F.G, (int)blockIdx.x, F.lds + MOE_TE};
        EpiY E{FIN(24), WSP(int, WS_LIST), WSP(float, WS_GATEW), WSP(bf16, WS_YBUF), (const LAS int*)(F.lds + MOE_OFF) + 32, (const LAS int*)(F.lds + MOE_OFF)};
        pg8::gemm_phase(ring, g, S, E, F.wave);
    } SEAM(8);

    if (IN(9)) { p8_combine(F); } SEAM(9);

    if (IN(10)) {
        pg8::StaticOrder S; S.init(M, D, F.G, (int)blockIdx.x);
        { pg8::Gemm g{WSP(bf16, WS_X2B), WSP(bf16, WS_WG), M, D, D, 0, nullptr, nullptr, nullptr}; EpiGate E{WSP(float, WS_RSTD2), WSP(bf16, WS_PGT)}; pg8::gemm_phase(ring, g, S, E, F.wave); }
        { pg8::Gemm g{WSP(bf16, WS_PB), WSP(bf16, WS_WP), M, D, PLE, 0, nullptr, nullptr, nullptr}; EpiPle E{WSP(bf16, WS_X2B), WSP(bf16, WS_PGT), F.out, WSP(float, WS_ROWSS), F.ctl + CW_PCNT, FIN(28), F.ctl}; pg8::gemm_phase(ring, g, S, E, F.wave); }
    }
#undef IN
#undef SEAM
}

extern "C" void kernel_launch(void* const* d_in, const int* in_sizes, int n_in, void* d_out, int out_size, void* d_ws, size_t ws_size, hipStream_t stream) {
    static int grid = 0;
    if (grid == 0) {
        if (n_in != 29 || in_sizes[0] != M * D || out_size != M * D || ws_size < WS_END) {
            fprintf(stderr, "kernel_launch: unexpected shapes (n_in %d, in0 %d, out %d, ws %zu < %zu); nothing launched\n", n_in, n_in > 0 ? in_sizes[0] : -1, out_size, ws_size, (size_t)WS_END); grid = -1; return; }
        int dev = 0, cus = 0, per_cu = 0;
        if (hipGetDevice(&dev) != hipSuccess || hipDeviceGetAttribute(&cus, hipDeviceAttributeMultiprocessorCount, dev) != hipSuccess) { grid = -1; return; }
        if (hipFuncSetAttribute((const void*)mega_fwd, hipFuncAttributeMaxDynamicSharedMemorySize, LDS_BYTES) != hipSuccess) { fprintf(stderr, "kernel_launch: hipFuncSetAttribute failed\n"); grid = -1; return; }
        if (hipOccupancyMaxActiveBlocksPerMultiprocessor(&per_cu, (const void*)mega_fwd, 512, LDS_BYTES) != hipSuccess || per_cu < 1) { fprintf(stderr, "kernel_launch: occupancy query says %d blocks/CU\n", per_cu); }
        (void)hipGetLastError();
        grid = cus;
    }
    if (grid < 0) return;
    (void)hipMemsetAsync((char*)d_ws + WS_CTL, 0, CTL_ZERO_BYTES, stream);
    Args a{};
    for (int i = 0; i < 29; ++i) a.in[i] = (const float*)d_in[i];
    a.out = (float*)d_out; a.ws = (unsigned char*)d_ws;
#if MK_PER_PHASE
    for (int p = 0; p < NPHASE; ++p) { a.ph_lo = p; a.ph_hi = p + 1; hipLaunchKernelGGL(mega_fwd, dim3(grid), dim3(512), LDS_BYTES, stream, a); }
#else
    a.ph_lo = 0; a.ph_hi = NPHASE; hipLaunchKernelGGL(mega_fwd, dim3(grid), dim3(512), LDS_BYTES, stream, a);
#endif
}
```

```cpp
#include <hip/hip_runtime.h>
#include <cstdio>
#include <cstdint>

#ifndef P3_ONLY
#define P3_ONLY 0
#endif
#ifndef SCAN_STUB
#define SCAN_STUB 0
#endif
#ifndef ATT_FORCE
#define ATT_FORCE 0
#endif
#ifndef TS_PROBE
#define TS_PROBE -1
#endif
#ifndef MK_PER_PHASE
#define MK_PER_PHASE 0
#endif

#define LAS __attribute__((address_space(3)))
#define GAS __attribute__((address_space(1)))
typedef unsigned short bf16;
typedef short bf16x8 __attribute__((ext_vector_type(8)));
typedef float f32x2 __attribute__((ext_vector_type(2)));
typedef float f32x4 __attribute__((ext_vector_type(4)));
typedef float f32x16 __attribute__((ext_vector_type(16)));
typedef unsigned u32x2 __attribute__((ext_vector_type(2)));
typedef unsigned u32x4 __attribute__((ext_vector_type(4)));
typedef __bf16 bf16x2_t __attribute__((ext_vector_type(2)));

constexpr int NB = 16, SEQ = 2048, D = 1024, M = NB * SEQ;
constexpr int NH = 8, HD = 64, AW = 512, RW = 512, RWC = 1792, INC = 5376;
constexpr int NE = 32, FH = 1024, F2 = 2048, PLE = 256, TOPK = 4;
constexpr int LORA_K = 256, LORA_N = 1536;
constexpr int CAP = 32768;
constexpr int MAXROWS = M * TOPK + NE * 256;
constexpr float RMS_EPS = 1e-5f, GN_EPS = 64e-5f;

constexpr size_t MiB = 1u << 20;
constexpr size_t WS_CTL = 0, CTL_ZERO_BYTES = 1 * MiB;
constexpr size_t WS_WIN = 1 * MiB;
constexpr size_t WS_WA = 12 * MiB, WS_WB = 13 * MiB, WS_WO = 14 * MiB, WS_WG = 16 * MiB, WS_WP = 18 * MiB;
constexpr size_t WS_WL = 18 * MiB + 512 * 1024;
constexpr size_t WS_GW = 19 * MiB + 256 * 1024;
constexpr size_t WS_W1 = 20 * MiB;
constexpr size_t WS_W2 = 148 * MiB;
constexpr size_t WS_PB = 212 * MiB;
constexpr size_t WS_RSTD0 = 228 * MiB, WS_RSTD2 = WS_RSTD0 + 128 * 1024, WS_ROWSS = WS_RSTD0 + 256 * 1024;
constexpr size_t WS_RSTD1 = WS_RSTD0 + 384 * 1024;
constexpr size_t WS_GATEW = WS_RSTD0 + 512 * 1024;
constexpr size_t WS_ROWSLOT = 229 * MiB;
constexpr size_t WS_LIST = 230 * MiB;
constexpr size_t WS_X1 = 236 * MiB;
constexpr size_t WS_YA = 236 * MiB, WS_YB = 268 * MiB, WS_ALORA = 300 * MiB;
constexpr size_t WS_GT = 364 * MiB;
constexpr size_t WS_Q = 492 * MiB, WS_K = 524 * MiB, WS_VT = 556 * MiB;
constexpr size_t WS_ZR = 588 * MiB;
constexpr size_t WS_XB = 700 * MiB;
constexpr size_t WS_DEC = 764 * MiB, WS_AA = 828 * MiB, WS_GG = 892 * MiB;
constexpr size_t WS_MERGED = 492 * MiB;
constexpr size_t WS_XS = 364 * MiB;
constexpr size_t WS_ACT = 684 * MiB;
constexpr size_t WS_HN = 364 * MiB;
constexpr size_t WS_YBUF = 428 * MiB;
constexpr size_t WS_X2B = 684 * MiB;
constexpr size_t WS_PGT = 748 * MiB;
constexpr size_t WS_END = 956 * MiB;
constexpr int CW_CNT = 64;
constexpr int CW_PCNT = 8192;
constexpr int CW_BAR = 4096;

constexpr int RING_BYTES = 131072;
constexpr int LDSCTL_OFF = RING_BYTES;
constexpr int MOE_OFF = RING_BYTES + 1024;
constexpr int MOE_TE = RING_BYTES + 2048;
constexpr int LDS_BYTES = 147456;

#define RLX_AGENT __ATOMIC_RELAXED, __HIP_MEMORY_SCOPE_AGENT
__device__ __forceinline__ unsigned pk2(float lo, float hi) { f32x2 v = {lo, hi}; bf16x2_t b = __builtin_convertvector(v, bf16x2_t); return __builtin_bit_cast(unsigned, b); }
__device__ __forceinline__ float bflo(unsigned u) { return __uint_as_float(u << 16); }
__device__ __forceinline__ float bfhi(unsigned u) { return __uint_as_float(u & 0xffff0000u); }
__device__ __forceinline__ float sigm(float x) { return __builtin_amdgcn_rcpf(1.f + __expf(-x)); }
__device__ __forceinline__ float wave_sum(float v) {
#pragma unroll
    for (int o = 1; o < 64; o <<= 1) v += __shfl_xor(v, o);
    return v;
}
template <int CTRL> __device__ __forceinline__ float dppf(float v) { return __builtin_bit_cast(float, __builtin_amdgcn_update_dpp(0, __builtin_bit_cast(int, v), CTRL, 0xF, 0xF, true)); }
__device__ __forceinline__ float red8(float v) { v += dppf<0xB1>(v); v += dppf<0x4E>(v); v += dppf<0x141>(v); return v; }
__device__ __forceinline__ int lane_now() { int l; asm volatile("v_mbcnt_lo_u32_b32 %0, -1, 0\n\tv_mbcnt_hi_u32_b32 %0, -1, %0" : "=v"(l)); return l; }
__device__ __forceinline__ int crow(int r, int hi) { return (r & 3) + 8 * (r >> 2) + 4 * hi; }

namespace pg8 {
#define PG8_LAS __attribute__((address_space(3)))
typedef unsigned short bf16_t;
constexpr int BM = 256, BK = 64, HALF = 128, HTB = HALF * BK * 2, STAGE_BYTES = 8 * HTB, NXCD = 8, WGM = 8;
__host__ __device__ __forceinline__ int lds_byte(int r, int c) { const int st = (r >> 4) * 2 + (c >> 5), rr = r & 15, cc = c & 31, ob = rr * 64 + cc * 2; return st * 1024 + (ob ^ (((ob >> 9) & 1) << 5)); }
__host__ __device__ __forceinline__ void stage_rc(int b, int& R, int& C) { const int st = b / 1024, sb = b % 1024, swz = sb ^ (((sb >> 9) & 1) << 5); R = (st >> 1) * 16 + swz / 64; C = (st & 1) * 32 + (swz % 64) / 2; }
__host__ __device__ __forceinline__ int perm32(int rho) { const int n = rho >> 4, i = rho & 15; return 8 * (i >> 2) + 4 * n + (i & 3); }

struct Unit { int pm, pn, e; };
struct Gemm { const bf16_t* A; const bf16_t* Bt; int M, N, K; size_t bsel_bytes; const int* glist; const PG8_LAS int* goff; const PG8_LAS int* gcnt; };

struct StaticOrder {
    int nM, nN, nwg, G, c;
    __device__ void init(int M_, int N_, int G_, int c_) { nM = M_ / BM; nN = N_ / BM; nwg = nM * nN; G = G_; c = c_; }
    __device__ bool next(int i, Unit& u) const {
        const long L = (long)i * G + c; if (L >= nwg) return false;
        int wgid = (int)L; { const int q = nwg / NXCD, r = nwg % NXCD, xcd = wgid % NXCD, off = wgid / NXCD; wgid = (xcd < r ? xcd * (q + 1) : r * (q + 1) + (xcd - r) * q) + off; }
        const int nig = WGM * nN, gid = wgid / nig, fm = gid * WGM, gsz = (nM - fm) < WGM ? (nM - fm) : WGM;
        u.pm = fm + ((wgid % nig) % gsz); u.pn = (wgid % nig) / gsz; u.e = 0; return true;
    }
};
struct LoraOrder {
    int pm, half, nu;
    __device__ bool next(int i, Unit& u) const { if (i >= nu) return false; u.pm = pm; u.pn = 3 * half + i; u.e = 0; return true; }
};
struct MoeOrder {
    int ntiles, npn, G, c; const PG8_LAS unsigned char* te;
    __device__ bool next(int i, Unit& u) const {
        int rt, pn;
        if ((G & 255) == 0 && (npn == 8 || npn == 4)) { const int x = c & 7, j = (c >> 3) & 31, rpx = 32 / npn, blk = c >> 8; rt = ((i * (G >> 8) + blk) * 8 + x) * rpx + j / npn; pn = j % npn; }
        else { const long L = (long)i * G + c; rt = (int)(L / npn); pn = (int)(L % npn); }
        if (rt >= ntiles) return false;
        u.pm = rt; u.pn = pn; u.e = te[rt]; return true;
    }
};

template <class Epi, class Sched, bool GATHER = false>
__device__ __forceinline__ void gemm_phase(PG8_LAS unsigned char* lds, const Gemm g, const Sched& S, const Epi& E, const int wid) {
    const int lane = lane_now(), tid = wid * 64 + lane,
              wr = wid >> 2, wc = wid & 3, fr = lane & 15, fq = lane >> 4;
    const int K = g.K, nt = K / BK;
    unsigned voffA[2], voffB[2];
#pragma unroll
    for (int i = 0; i < 2; ++i) { int R, C; stage_rc(tid * 16 + i * 8192, R, C); const int Rb = Epi::PERM ? ((R & ~31) + perm32(R & 31)) : R;
        voffA[i] = (unsigned)(R * K + C) * 2u; voffB[i] = (unsigned)(Rb * K + C) * 2u; }
    const size_t kstep = (size_t)(BK * 2);
    const size_t hstep = (size_t)HALF * K * 2;
    const size_t tstep = 2 * hstep;
    const unsigned ldsw = (unsigned)wid * 1024u;
    const int aoff = lds_byte(wr * 64 + fr, fq * 8), boff = lds_byte(wc * 32 + fr, fq * 8);
    unsigned vgC[2][2] = {{0u, 0u}, {0u, 0u}}, vgN[2][2] = {{0u, 0u}, {0u, 0u}};
#define PG8_GOFF(u, vo) do { _Pragma("unroll") for (int _h = 0; _h < 2; ++_h) _Pragma("unroll") for (int _i = 0; _i < 2; ++_i) { int R_, C_; stage_rc(tid * 16 + _i * 8192, R_, C_); \
        const int r_ = (u).pm * BM + _h * HALF + R_ - g.goff[(u).e]; int tok_ = 0; if (r_ < g.gcnt[(u).e]) tok_ = g.glist[(size_t)(u).e * 32768 + r_] >> 2; (vo)[_h][_i] = (unsigned)(tok_ * K + C_) * 2u; } } while (0)
#define PG8_SA(b, h) (((b) * 2 + (h)) * HTB)
#define PG8_SB(b, h) ((4 + (b) * 2 + (h)) * HTB)
#define PG8_STAGE(bufoff, gbase, voff) do { _Pragma("unroll") for (int _i = 0; _i < 2; ++_i) \
        __builtin_amdgcn_global_load_lds((const unsigned*)((const char*)(gbase) + (voff)[_i]), (PG8_LAS unsigned*)(lds + (bufoff) + ldsw + _i * 8192), 16, 0, 0); } while (0)
#define PG8_STA(bufoff, h, ptr, kbyte, usenext) do { if constexpr (GATHER) { unsigned vo_[2] = {(usenext) ? vgN[h][0] : vgC[h][0], (usenext) ? vgN[h][1] : vgC[h][1]}; PG8_STAGE(bufoff, (const char*)g.A + (kbyte), vo_); } else { PG8_STAGE(bufoff, ptr, voffA); } } while (0)
#define PG8_LDA(dst, b, h) do { _Pragma("unroll") for (int m = 0; m < 4; ++m) _Pragma("unroll") for (int k = 0; k < 2; ++k) dst[m][k] = *(const PG8_LAS bf16x8*)(lds + PG8_SA(b, h) + aoff + m * 2048 + k * 1024); } while (0)
#define PG8_LDB(dst, b, h) do { _Pragma("unroll") for (int n = 0; n < 2; ++n) _Pragma("unroll") for (int k = 0; k < 2; ++k) dst[n][k] = *(const PG8_LAS bf16x8*)(lds + PG8_SB(b, h) + boff + n * 2048 + k * 1024); } while (0)
#define PG8_MMA(ai, bj, At, Bt) do { __builtin_amdgcn_s_setprio(1); _Pragma("unroll") for (int m = 0; m < 4; ++m) _Pragma("unroll") for (int n = 0; n < 2; ++n) _Pragma("unroll") for (int k = 0; k < 2; ++k) \
        acc[ai][bj][m][n] = __builtin_amdgcn_mfma_f32_16x16x32_bf16(Bt[n][k], At[m][k], acc[ai][bj][m][n], 0, 0, 0); __builtin_amdgcn_s_setprio(0); } while (0)
#define PG8_WAIT_V(n) asm volatile("s_waitcnt vmcnt(" #n ")" ::: "memory")
#define PG8_WAIT_L(n) asm volatile("s_waitcnt lgkmcnt(" #n ")" ::: "memory")
#define PG8_BAR __builtin_amdgcn_s_barrier()
#define PG8_SCHED __builtin_amdgcn_sched_barrier(0)
    Unit cur, nxt; int ui = 0;
    if (!S.next(0, cur)) return;
    f32x4 acc[2][2][4][2];
#pragma unroll
    for (int a = 0; a < 2; ++a)
#pragma unroll
        for (int b = 0; b < 2; ++b)
#pragma unroll
            for (int m = 0; m < 4; ++m)
#pragma unroll
                for (int n = 0; n < 2; ++n) acc[a][b][m][n] = (f32x4){0.f, 0.f, 0.f, 0.f};
    bf16x8 At[4][2], B0[2][2], B1[2][2];
    const char* cA = (const char*)g.A + (size_t)cur.pm * tstep; const char* cB = (const char*)g.Bt + (size_t)cur.e * g.bsel_bytes + (size_t)cur.pn * tstep;
    if constexpr (GATHER) PG8_GOFF(cur, vgC);
    PG8_STAGE(PG8_SB(0, 0), cB, voffB); PG8_STAGE(PG8_SB(0, 1), cB + hstep, voffB); PG8_STA(PG8_SA(0, 0), 0, cA, 0, false); PG8_STA(PG8_SA(0, 1), 1, cA + hstep, 0, false);
    if (wr == 1) PG8_BAR;
    PG8_WAIT_V(2); PG8_BAR;
    PG8_STAGE(PG8_SB(1, 0), cB + kstep, voffB); PG8_STA(PG8_SA(1, 0), 0, cA + kstep, kstep, false); PG8_STAGE(PG8_SB(1, 1), cB + hstep + kstep, voffB);
    PG8_WAIT_V(6); PG8_BAR;
    for (;;) {
        const bool has_next = S.next(ui + 1, nxt);
        if constexpr (GATHER) { if (has_next) PG8_GOFF(nxt, vgN); else { vgN[0][0] = vgC[0][0]; vgN[0][1] = vgC[0][1]; vgN[1][0] = vgC[1][0]; vgN[1][1] = vgC[1][1]; } }
        const char* nA = has_next ? (const char*)g.A + (size_t)nxt.pm * tstep : cA;
        const char* nB = has_next ? (const char*)g.Bt + (size_t)nxt.e * g.bsel_bytes + (size_t)nxt.pn * tstep : cB;
        for (int t = 0; t < nt; t += 2) {
            const bool last = (t == nt - 2);
            const char* a1 = cA + (size_t)(t + 1) * kstep;
            const char* a2 = last ? nA : cA + (size_t)(t + 2) * kstep; const char* b2 = last ? nB : cB + (size_t)(t + 2) * kstep;
            const char* a3 = a2 + kstep; const char* b3 = b2 + kstep;
            const size_t k2 = last ? 0 : (size_t)(t + 2) * kstep;
            PG8_LDB(B0, 0, 0); PG8_LDB(B1, 0, 1); PG8_SCHED; PG8_LDA(At, 0, 0); PG8_STA(PG8_SA(1, 1), 1, a1 + hstep, (size_t)(t + 1) * kstep, false);
            PG8_WAIT_V(8); PG8_WAIT_L(0); PG8_BAR; PG8_MMA(0, 0, At, B0); PG8_MMA(0, 1, At, B1); PG8_BAR; PG8_SCHED;
            PG8_LDA(At, 0, 1); PG8_STAGE(PG8_SB(0, 0), b2, voffB); PG8_STAGE(PG8_SB(0, 1), b2 + hstep, voffB); PG8_STA(PG8_SA(0, 0), 0, a2, k2, last);
            PG8_WAIT_V(8); PG8_WAIT_L(0); PG8_BAR; PG8_MMA(1, 0, At, B0); PG8_MMA(1, 1, At, B1); PG8_BAR; PG8_SCHED;
            PG8_LDB(B0, 1, 0); PG8_LDB(B1, 1, 1); PG8_SCHED; PG8_LDA(At, 1, 0); PG8_STA(PG8_SA(0, 1), 1, a2 + hstep, k2, last);
            PG8_WAIT_V(8); PG8_WAIT_L(0); PG8_BAR; PG8_MMA(0, 0, At, B0); PG8_MMA(0, 1, At, B1); PG8_BAR; PG8_SCHED;
            PG8_LDA(At, 1, 1); PG8_STAGE(PG8_SB(1, 0), b3, voffB); PG8_STAGE(PG8_SB(1, 1), b3 + hstep, voffB); PG8_STA(PG8_SA(1, 0), 0, a3, k2 + kstep, last);
            PG8_WAIT_V(8); PG8_WAIT_L(0); PG8_BAR; PG8_MMA(1, 0, At, B0); PG8_MMA(1, 1, At, B1); PG8_BAR; PG8_SCHED;
        }
        if (wr == 0) PG8_BAR;
        E(acc, cur, wr, wc, fr, fq);
        if (!has_next) break;
#pragma unroll
        for (int a = 0; a < 2; ++a)
#pragma unroll
            for (int b = 0; b < 2; ++b)
#pragma unroll
                for (int m = 0; m < 4; ++m)
#pragma unroll
                    for (int n = 0; n < 2; ++n) acc[a][b][m][n] = (f32x4){0.f, 0.f, 0.f, 0.f};
        cur = nxt; cA = nA; cB = nB; ++ui;
        if constexpr (GATHER) { vgC[0][0] = vgN[0][0]; vgC[0][1] = vgN[0][1]; vgC[1][0] = vgN[1][0]; vgC[1][1] = vgN[1][1]; }
        if (wr == 1) PG8_BAR;
    }
    PG8_WAIT_V(0);
    PG8_BAR;
#undef PG8_SA
#undef PG8_SB
#undef PG8_STAGE
#undef PG8_LDA
#undef PG8_STA
#undef PG8_GOFF
#undef PG8_LDB
#undef PG8_MMA
#undef PG8_WAIT_V
#undef PG8_WAIT_L
#undef PG8_BAR
#undef PG8_SCHED
}
}
using pg8::Unit;
typedef const f32x4 (&AccRef)[2][2][4][2];

#define XB_TMO      128
#define XB_XCNT(j)  (256  + 64 * (j))
#define XB_XSUB(j)  (1280 + 64 * (j))
#define XB_XGEN(j)  (2304 + 64 * (j))
#define XB_TOP      3328
#define XB_TOPGEN   3392
#define XCD_BAR_WORDS 3456
#define XB_SPIN_CAP (1u << 22)
__device__ __forceinline__ unsigned xb_ld(unsigned* p)              { return __hip_atomic_load(p, __ATOMIC_RELAXED, __HIP_MEMORY_SCOPE_AGENT); }
__device__ __forceinline__ unsigned xb_add(unsigned* p, unsigned v) { return __hip_atomic_fetch_add(p, v, __ATOMIC_RELAXED, __HIP_MEMORY_SCOPE_AGENT); }
__device__ __forceinline__ unsigned xb_xcc_id() { return (unsigned)__builtin_amdgcn_s_getreg((3 << 11) | 20) & 0xFu; }
#define XB_SPIN(cond, bar) do { unsigned _sp = 0; while (cond) { __builtin_amdgcn_s_sleep(1); \
    if ((++_sp & 255u) == 0u) { if (xb_ld(&(bar)[XB_TMO])) break; if (_sp > XB_SPIN_CAP) { atomicAdd(&(bar)[XB_TMO], 1u); break; } } } } while (0)
struct XcdBarrier { unsigned* bar; unsigned x; volatile LAS unsigned* st; };
__device__ __forceinline__ XcdBarrier xcd_barrier_post(unsigned* bar, volatile LAS unsigned* st, int tid) {
    XcdBarrier b; b.bar = bar; b.x = xb_xcc_id(); b.st = st;
    if (tid == 0) (void)xb_add(&bar[XB_XCNT(b.x)], 1u);
    return b;
}
__device__ __forceinline__ void xcd_barrier_complete(unsigned* bar, unsigned x, unsigned& nloc, unsigned& nx) {
    const unsigned G = gridDim.x * gridDim.y * gridDim.z;
    unsigned sum, cnt, mine, sp = 0u;
    for (;;) {
        sum = 0u; cnt = 0u; mine = 0u;
#pragma unroll
        for (unsigned j = 0; j < 16; ++j) { const unsigned c = xb_ld(&bar[XB_XCNT(j)]); sum += c; cnt += (c > 0u) ? 1u : 0u; mine = (j == x) ? c : mine; }
        if (sum == G) break;
        __builtin_amdgcn_s_sleep(1);
        if ((++sp & 255u) == 0u) { if (xb_ld(&bar[XB_TMO])) break; if (sp > XB_SPIN_CAP) { atomicAdd(&bar[XB_TMO], 1u); break; } }
    }
    nloc = mine > 0u ? mine : 1u; nx = cnt > 0u ? cnt : 1u;
}
__device__ __forceinline__ void xcd_barrier(const XcdBarrier& b, int wave) {
    asm volatile("s_waitcnt vmcnt(0)" ::: "memory");
    __syncthreads();
    if (wave == 0 && lane_now() == 0) {
        unsigned* bar = b.bar;
        __builtin_amdgcn_s_waitcnt(0);
        unsigned nloc = b.st[0], nx = b.st[1];
        if (nloc == 0u) { xcd_barrier_complete(bar, b.x, nloc, nx); b.st[0] = nloc; b.st[1] = nx; }
        const unsigned old = xb_add(&bar[XB_XSUB(b.x)], 1u);
        const unsigned gen = old / nloc;
        if (old + 1u == (gen + 1u) * nloc) {
            __builtin_amdgcn_fence(__ATOMIC_RELEASE, "agent");
            asm volatile("s_waitcnt vmcnt(0)" ::: "memory");
            const unsigned og = xb_add(&bar[XB_TOP], 1u);
            const unsigned tg = og / nx;
            if (og + 1u == (tg + 1u) * nx) xb_add(&bar[XB_TOPGEN], 1u);
            else XB_SPIN(xb_ld(&bar[XB_TOPGEN]) == tg, bar);
            __builtin_amdgcn_fence(__ATOMIC_ACQUIRE, "agent");
            xb_add(&bar[XB_XGEN(b.x)], 1u);
            asm volatile("s_waitcnt vmcnt(0)" ::: "memory");
        } else {
            XB_SPIN(xb_ld(&bar[XB_XGEN(b.x)]) == gen, bar);
            __builtin_amdgcn_fence(__ATOMIC_ACQUIRE, "agent");
            asm volatile("s_waitcnt vmcnt(0)" ::: "memory");
        }
    }
    __syncthreads();
}

struct Frame {
    LAS unsigned char* lds;
    unsigned* ctl;
    int tid, lane, wave, vcu, G;
    unsigned char* ws;
    float* out;
};
#define WSP(T, off) ((T*)(F.ws + (off)))
struct Args { const float* in[29]; float* out; unsigned char* ws; int ph_lo, ph_hi; };
#define FIN(i) (args.in[i])

template <bool SWZ = false>
__device__ __forceinline__ void p0_transpose_item(const float* W, int K, int N, bf16* WT, LAS float* scr, int item, int lane, const float* kscale) {
    const int nblk = N / 32, kb = item / nblk, nb = item % nblk, k0 = 64 * kb, n0 = 32 * nb;
#pragma unroll 8
    for (int i = 0; i < 32; ++i) { const int kk = 2 * i + (lane >> 5); float v = W[(size_t)(k0 + kk) * N + n0 + (lane & 31)]; if (kscale) v *= kscale[k0 + kk]; scr[kk * 33 + (lane & 31)] = v; }
    asm volatile("s_waitcnt lgkmcnt(0)" ::: "memory");
    const int c = lane & 7;
#pragma unroll
    for (int j = 0; j < 4; ++j) { const int n = (lane >> 3) + 8 * j; const LAS float* s = scr + (8 * c) * 33 + n;
        u32x4 o; o.x = pk2(s[0 * 33], s[1 * 33]); o.y = pk2(s[2 * 33], s[3 * 33]); o.z = pk2(s[4 * 33], s[5 * 33]); o.w = pk2(s[6 * 33], s[7 * 33]);
        int nr = n0 + n; if (SWZ) { const int cl = nr & 255; nr = (nr & ~255) + 128 * ((cl >> 3) & 1) + 32 * (cl >> 6) + 8 * ((cl >> 4) & 3) + (cl & 7); }
        *(u32x4*)(WT + (size_t)nr * K + k0 + 8 * c) = o; }
    asm volatile("s_waitcnt lgkmcnt(0)" ::: "memory");
}
__device__ __forceinline__ void p0_prologue(const Args& args, Frame& F) {
    LAS float* scr = (LAS float*)(F.lds + F.wave * 16384);
    const int gw = F.vcu * 8 + F.wave, NGW = F.G * 8, lane = F.lane;
    constexpr int I_IN = (D / 64) * (INC / 32), I_A = (AW / 64) * (D / 32), I_O = (D / 64) * (D / 32), I_P = (PLE / 64) * (D / 32);
    constexpr int I_W1 = (D / 64) * (F2 / 32), I_W2 = (FH / 64) * (D / 32);
    constexpr int NITEMS = I_IN + 2 * I_A + 2 * I_O + I_P;
    for (int it = gw; it < NITEMS; it += NGW) {
        int r = it;
        if (r < I_IN) { p0_transpose_item(FIN(3), D, INC, WSP(bf16, WS_WIN), scr, r, lane, FIN(2)); continue; } r -= I_IN;
        if (r < I_A) { p0_transpose_item(FIN(15), AW, D, WSP(bf16, WS_WA), scr, r, lane, nullptr); continue; } r -= I_A;
        if (r < I_A) { p0_transpose_item(FIN(16), RW, D, WSP(bf16, WS_WB), scr, r, lane, nullptr); continue; } r -= I_A;
        if (r < I_O) { p0_transpose_item(FIN(17), D, D, WSP(bf16, WS_WO), scr, r, lane, nullptr); continue; } r -= I_O;
        if (r < I_O) { p0_transpose_item(FIN(26), D, D, WSP(bf16, WS_WG), scr, r, lane, FIN(25)); continue; } r -= I_O;
        p0_transpose_item(FIN(27), PLE, D, WSP(bf16, WS_WP), scr, r, lane, nullptr);
    }
    { const int gt = (F.vcu * 512 + F.tid), NT = F.G * 512;
      bf16* WL = WSP(bf16, WS_WL);
      for (int i = gt; i < LORA_N * LORA_K; i += NT) { const int n = i >> 8, k = i & 255; float v = 0.f;
          if (n < 512) { if (k < 64) v = FIN(6)[k * 512 + n]; }
          else if (n < 1024) { if (k >= 64 && k < 128) v = FIN(8)[(k - 64) * 512 + (n - 512)]; }
          else { if (k >= 128) v = FIN(9)[(k - 128) * 512 + (n - 1024)]; }
          WL[i] = (bf16)(pk2(v, 0.f) & 0xffffu); }
      float* GW = WSP(float, WS_GW);
      for (int i = gt; i < D * NE; i += NT) GW[i] = FIN(19)[i] * FIN(18)[i >> 5];
    }
    { bf16* XB = WSP(bf16, WS_XB); float* R0 = WSP(float, WS_RSTD0); bf16* PB = WSP(bf16, WS_PB);
      for (int m = gw; m < M; m += NGW) {
          const f32x4* xr = (const f32x4*)(FIN(0) + (size_t)m * D) + lane;
          f32x4 v[4]; float s = 0.f;
#pragma unroll
          for (int j = 0; j < 4; ++j) { v[j] = xr[64 * j]; s += (v[j].x * v[j].x + v[j].y * v[j].y) + (v[j].z * v[j].z + v[j].w * v[j].w); }
          s = wave_sum(s);
          u32x2* o = (u32x2*)(XB + (size_t)m * D) + lane;
#pragma unroll
          for (int j = 0; j < 4; ++j) { u32x2 w; w.x = pk2(v[j].x, v[j].y); w.y = pk2(v[j].z, v[j].w); o[64 * j] = w; }
          if (lane == 0) R0[m] = 1.0f / sqrtf(s * (1.f / D) + RMS_EPS);
          const f32x4 pv = ((const f32x4*)(FIN(1) + (size_t)m * PLE))[lane];
          u32x2 w; w.x = pk2(pv.x, pv.y); w.y = pk2(pv.z, pv.w); ((u32x2*)(PB + (size_t)m * PLE))[lane] = w;
      }
    }
}

__device__ __forceinline__ void expert_convert(const Args& args, Frame& F, int wv, int NW, int which) {
    LAS float* scr = (LAS float*)(F.lds + F.wave * 16384);
    constexpr int I_W1 = (D / 64) * (F2 / 32), I_W2 = (FH / 64) * (D / 32);
    if (which & 1) for (int it = wv; it < NE * I_W1; it += NW) { const int e = it / I_W1; p0_transpose_item<true>(FIN(21) + (size_t)e * D * F2, D, F2, WSP(bf16, WS_W1) + (size_t)e * F2 * D, scr, it % I_W1, F.lane, nullptr); }
    if (which & 2) for (int it = wv; it < NE * I_W2; it += NW) { const int e = it / I_W2; p0_transpose_item(FIN(23) + (size_t)e * FH * D, FH, D, WSP(bf16, WS_W2) + (size_t)e * D * FH, scr, it % I_W2, F.lane, nullptr); }
}
struct EpiG1 {
    static constexpr bool PERM = true;
    const float* rstd; bf16 *Q, *K, *VT, *ZR, *GT;
    __device__ __forceinline__ void operator()(AccRef acc, const Unit& u, int wr, int wc, int fr, int fq) const {
        const int pn = u.pn, rowb = u.pm * 256 + wr * 64 + fr, cl = wc * 32 + 8 * fq;
#pragma unroll
        for (int ai = 0; ai < 2; ++ai)
#pragma unroll
            for (int m = 0; m < 4; ++m) {
                const int row = rowb + ai * 128 + m * 16; const float rs = rstd[row];
                if (pn < 4) {
                    bf16* base = (pn < 2 ? Q : K) + (size_t)row * 512 + (pn & 1) * 256 + cl; const float sc = pn < 2 ? rs * 0.125f : rs;
#pragma unroll
                    for (int bj = 0; bj < 2; ++bj) { const f32x4 v0 = acc[ai][bj][m][0] * sc, v1 = acc[ai][bj][m][1] * sc;
                        u32x4 w; w.x = pk2(v0[0], v0[1]); w.y = pk2(v0[2], v0[3]); w.z = pk2(v1[0], v1[1]); w.w = pk2(v1[2], v1[3]); *(u32x4*)(base + bj * 128) = w; }
                } else if (pn < 6) {
                    const int b = row >> 11, s = row & 2047;
#pragma unroll
                    for (int bj = 0; bj < 2; ++bj)
#pragma unroll
                        for (int n = 0; n < 2; ++n)
#pragma unroll
                            for (int j = 0; j < 4; ++j) { const int c = (pn - 4) * 256 + cl + bj * 128 + 4 * n + j; const int hh = c >> 6, d = c & 63;
                                VT[((size_t)(((b * 8 + hh) * 128 + (s >> 4)) * 64 + d)) * 16 + (s & 15)] = (bf16)(pk2(acc[ai][bj][m][n][j] * rs, 0.f) & 0xffffu); }
                } else if (pn < 13) {
                    bf16* base = ZR + (size_t)row * RWC + (pn - 6) * 256 + cl;
#pragma unroll
                    for (int bj = 0; bj < 2; ++bj) { const f32x4 v0 = acc[ai][bj][m][0] * rs, v1 = acc[ai][bj][m][1] * rs;
                        u32x4 w; w.x = pk2(v0[0], v0[1]); w.y = pk2(v0[2], v0[3]); w.z = pk2(v1[0], v1[1]); w.w = pk2(v1[2], v1[3]); *(u32x4*)(base + bj * 128) = w; }
                } else {
                    bf16* base = GT + (size_t)row * 2048 + (pn - 13) * 256 + cl;
#pragma unroll
                    for (int bj = 0; bj < 2; ++bj) { const f32x4 v0 = acc[ai][bj][m][0] * rs, v1 = acc[ai][bj][m][1] * rs;
                        u32x4 w; w.x = pk2(sigm(v0[0]), sigm(v0[1])); w.y = pk2(sigm(v0[2]), sigm(v0[3])); w.z = pk2(sigm(v1[0]), sigm(v1[1])); w.w = pk2(sigm(v1[2]), sigm(v1[3])); *(u32x4*)(base + bj * 128) = w; }
                }
            }
    }
};
struct EpiLora {
    static constexpr bool PERM = false;
    const float *w0, *a0; float *DEC, *AA; bf16* GG;
    template <int MODE> __device__ __forceinline__ void body(AccRef acc, int rowb, int cb) const {
#pragma unroll
        for (int ai = 0; ai < 2; ++ai)
#pragma unroll
            for (int m = 0; m < 4; ++m) {
                const int row = rowb + ai * 128 + m * 16;
#pragma unroll
                for (int bj = 0; bj < 2; ++bj)
#pragma unroll
                    for (int n = 0; n < 2; ++n) {
                        const int c = cb + bj * 128 + n * 16;
                        f32x4 v = acc[ai][bj][m][n];
                        if (MODE == 0) { v = v + *(const f32x4*)(w0 + c); f32x4 o;
#pragma unroll
                            for (int j = 0; j < 4; ++j) { const float y = -v[j]; const float sp = y > 20.f ? y : __logf(1.f + __expf(y)); o[j] = __expf(-__expf(-sp - 0.5f)); }
                            *(f32x4*)(DEC + (size_t)row * 512 + c) = o;
                        } else if (MODE == 1) { v = v + *(const f32x4*)(a0 + c); f32x4 o;
#pragma unroll
                            for (int j = 0; j < 4; ++j) o[j] = sigm(v[j]);
                            *(f32x4*)(AA + (size_t)row * 512 + c) = o;
                        } else { u32x2 w; w.x = pk2(v[0], v[1]); w.y = pk2(v[2], v[3]); *(u32x2*)(GG + (size_t)row * 512 + c) = w; }
                    }
                asm volatile("" ::: "memory");
            }
    }
    __device__ __forceinline__ void operator()(AccRef acc, const Unit& u, int wr, int wc, int fr, int fq) const {
        const int pn = u.pn, rowb = u.pm * 256 + wr * 64 + fr, cb = (pn & 1) * 256 + wc * 32 + 4 * fq;
        if (pn < 2) body<0>(acc, rowb, cb); else if (pn < 4) body<1>(acc, rowb, cb); else body<2>(acc, rowb, cb);
    }
};
template <int SECOND> struct EpiMerge {
    static constexpr bool PERM = true;
    const bf16* GT; bf16* MG;
    __device__ __forceinline__ void operator()(AccRef acc, const Unit& u, int wr, int wc, int fr, int fq) const {
        const int rowb = u.pm * 256 + wr * 64 + fr, c0 = u.pn * 256 + wc * 32 + 8 * fq;
#pragma unroll
        for (int ai = 0; ai < 2; ++ai)
#pragma unroll
            for (int m = 0; m < 4; ++m) { const int row = rowb + ai * 128 + m * 16;
#pragma unroll
                for (int bj = 0; bj < 2; ++bj) {
                    const int c = c0 + bj * 128; const u32x4 gv = *(const u32x4*)(GT + (size_t)row * 2048 + SECOND * 1024 + c);
                    const f32x4 v0 = acc[ai][bj][m][0], v1 = acc[ai][bj][m][1];
                    float o[8] = {v0[0] * bflo(gv.x), v0[1] * bfhi(gv.x), v0[2] * bflo(gv.y), v0[3] * bfhi(gv.y), v1[0] * bflo(gv.z), v1[1] * bfhi(gv.z), v1[2] * bflo(gv.w), v1[3] * bfhi(gv.w)};
                    bf16* dst = MG + (size_t)row * 1024 + c;
                    if (SECOND) { const u32x4 ov = *(const u32x4*)dst; o[0] += bflo(ov.x); o[1] += bfhi(ov.x); o[2] += bflo(ov.y); o[3] += bfhi(ov.y); o[4] += bflo(ov.z); o[5] += bfhi(ov.z); o[6] += bflo(ov.w); o[7] += bfhi(ov.w); }
                    u32x4 w; w.x = pk2(o[0], o[1]); w.y = pk2(o[2], o[3]); w.z = pk2(o[4], o[5]); w.w = pk2(o[6], o[7]); *(u32x4*)dst = w; } }
    }
};
struct EpiX1 {
    static constexpr bool PERM = true;
    const float* X; float* X1; const float* gn; bf16* HN;
    __device__ __forceinline__ void operator()(AccRef acc, const Unit& u, int wr, int wc, int fr, int fq) const {
        const int rowb = u.pm * 256 + wr * 64 + fr, c0 = u.pn * 256 + wc * 32 + 8 * fq;
#pragma unroll
        for (int bj = 0; bj < 2; ++bj) { const f32x4 g0 = *(const f32x4*)(gn + c0 + bj * 128), g1 = *(const f32x4*)(gn + c0 + bj * 128 + 4);
#pragma unroll
            for (int ai = 0; ai < 2; ++ai)
#pragma unroll
                for (int m = 0; m < 4; ++m) { const size_t off = (size_t)(rowb + ai * 128 + m * 16) * D + c0 + bj * 128;
                    const f32x4 x0 = *(const f32x4*)(X + off) + acc[ai][bj][m][0], x1 = *(const f32x4*)(X + off + 4) + acc[ai][bj][m][1];
                    *(f32x4*)(X1 + off) = x0; *(f32x4*)(X1 + off + 4) = x1;
                    u32x4 w; w.x = pk2(x0[0] * g0[0], x0[1] * g0[1]); w.y = pk2(x0[2] * g0[2], x0[3] * g0[3]); w.z = pk2(x1[0] * g1[0], x1[1] * g1[1]); w.w = pk2(x1[2] * g1[2], x1[3] * g1[3]); *(u32x4*)(HN + off) = w; } }
    }
};
struct EpiSwiglu {
    static constexpr bool PERM = true;
    const float* b1; bf16* ACT; const int* LIST; const float* R1; const LAS int* OFF; const LAS int* CS;
    __device__ __forceinline__ void operator()(AccRef acc, const Unit& u, int wr, int wc, int fr, int fq) const {
        const int rowb = u.pm * 256 + wr * 64 + fr, c0 = u.pn * 256 + wc * 64 + 16 * fq;
        const float* bb = b1 + (size_t)u.e * F2 + c0; const int rbase = rowb - OFF[u.e], cnt = CS[u.e];
        const f32x4 bv0 = *(const f32x4*)(bb), bv1 = *(const f32x4*)(bb + 4), bv2 = *(const f32x4*)(bb + 8), bv3 = *(const f32x4*)(bb + 12);
#pragma unroll
        for (int ai = 0; ai < 2; ++ai)
#pragma unroll
            for (int m = 0; m < 4; ++m) { const int r = rbase + ai * 128 + m * 16, row = rowb + ai * 128 + m * 16; float rs = 0.f; if (r < cnt) rs = R1[LIST[(size_t)u.e * CAP + r] >> 2];
                const f32x4 v[4] = {acc[ai][0][m][0] * rs + bv0, acc[ai][0][m][1] * rs + bv1, acc[ai][1][m][0] * rs + bv2, acc[ai][1][m][1] * rs + bv3};
                float o[8];
#pragma unroll
                for (int p = 0; p < 8; ++p) { float gl = v[p >> 1][2 * (p & 1)], ul = v[p >> 1][2 * (p & 1) + 1];
                    gl = fminf(gl, 7.f); ul = fminf(fmaxf(ul, -7.f), 7.f); o[p] = (ul + 1.f) * gl * sigm(1.702f * gl); }
                u32x4 w; w.x = pk2(o[0], o[1]); w.y = pk2(o[2], o[3]); w.z = pk2(o[4], o[5]); w.w = pk2(o[6], o[7]); *(u32x4*)(ACT + (size_t)row * FH + (c0 >> 1)) = w;
                asm volatile("" ::: "memory"); }
    }
};
struct EpiY {
    static constexpr bool PERM = true;
    const float* b2; const int* LIST; const float* gatew; bf16* YB; const LAS int* OFF; const LAS int* CS;
    __device__ __forceinline__ void operator()(AccRef acc, const Unit& u, int wr, int wc, int fr, int fq) const {
        const int rowb = u.pm * 256 + wr * 64 + fr, c0 = u.pn * 256 + wc * 32 + 8 * fq;
        const float* bb = b2 + (size_t)u.e * D; const int rbase = rowb - OFF[u.e], cnt = CS[u.e];
#pragma unroll
        for (int ai = 0; ai < 2; ++ai)
#pragma unroll
            for (int m = 0; m < 4; ++m) { const int r = rbase + ai * 128 + m * 16;
                if (r < cnt) { const int slot = LIST[(size_t)u.e * CAP + r]; const float gt = gatew[slot];
#pragma unroll
                    for (int bj = 0; bj < 2; ++bj) { const int c = c0 + bj * 128;
                        const f32x4 v0 = (acc[ai][bj][m][0] + *(const f32x4*)(bb + c)) * gt, v1 = (acc[ai][bj][m][1] + *(const f32x4*)(bb + c + 4)) * gt;
                        u32x4 w; w.x = pk2(v0[0], v0[1]); w.y = pk2(v0[2], v0[3]); w.z = pk2(v1[0], v1[1]); w.w = pk2(v1[2], v1[3]); *(u32x4*)(YB + (size_t)slot * D + c) = w; } } }
    }
};
struct EpiGate {
    static constexpr bool PERM = true;
    const float* rstd2; bf16* GT;
    __device__ __forceinline__ void operator()(AccRef acc, const Unit& u, int wr, int wc, int fr, int fq) const {
        const int rowb = u.pm * 256 + wr * 64 + fr, c0 = u.pn * 256 + wc * 32 + 8 * fq;
#pragma unroll
        for (int ai = 0; ai < 2; ++ai)
#pragma unroll
            for (int m = 0; m < 4; ++m) { const int row = rowb + ai * 128 + m * 16; const float rs = rstd2[row];
#pragma unroll
                for (int bj = 0; bj < 2; ++bj) { const f32x4 v0 = acc[ai][bj][m][0] * rs, v1 = acc[ai][bj][m][1] * rs;
                    u32x4 w; w.x = pk2(sigm(v0[0]), sigm(v0[1])); w.y = pk2(sigm(v0[2]), sigm(v0[3])); w.z = pk2(sigm(v1[0]), sigm(v1[1])); w.w = pk2(sigm(v1[2]), sigm(v1[3]));
                    *(u32x4*)(GT + (size_t)row * D + c0 + bj * 128) = w; } }
    }
};
struct EpiPle {
    static constexpr bool PERM = true;
    const bf16* X2B; const bf16* GT; float* O; float* rowss; unsigned* pcnt; const float* fg; const unsigned* ctl;
    __device__ __forceinline__ void operator()(f32x4 (&acc)[2][2][4][2], const Unit& u, int wr, int wc, int fr, int fq) const {
        const int rowb = u.pm * 256 + wr * 64 + fr, c0 = u.pn * 256 + wc * 32 + 8 * fq;
#pragma unroll
        for (int ai = 0; ai < 2; ++ai)
#pragma unroll
            for (int m = 0; m < 4; ++m) { const int row = rowb + ai * 128 + m * 16; float ss = 0.f;
#pragma unroll
                for (int bj = 0; bj < 2; ++bj) { const size_t off = (size_t)row * D + c0 + bj * 128;
                    const u32x4 xv = *(const u32x4*)(X2B + off), gv = *(const u32x4*)(GT + off); f32x4 a0 = acc[ai][bj][m][0], a1 = acc[ai][bj][m][1];
                    a0[0] = bflo(xv.x) + bflo(gv.x) * a0[0]; a0[1] = bfhi(xv.x) + bfhi(gv.x) * a0[1]; a0[2] = bflo(xv.y) + bflo(gv.y) * a0[2]; a0[3] = bfhi(xv.y) + bfhi(gv.y) * a0[3];
                    a1[0] = bflo(xv.z) + bflo(gv.z) * a1[0]; a1[1] = bfhi(xv.z) + bfhi(gv.z) * a1[1]; a1[2] = bflo(xv.w) + bflo(gv.w) * a1[2]; a1[3] = bfhi(xv.w) + bfhi(gv.w) * a1[3];
#pragma unroll
                    for (int j = 0; j < 4; ++j) ss += a0[j] * a0[j] + a1[j] * a1[j];
                    acc[ai][bj][m][0] = a0; acc[ai][bj][m][1] = a1; }
                ss += __shfl_xor(ss, 16); ss += __shfl_xor(ss, 32);
                if (fq == 0) atomicAdd(rowss + row, ss);
                asm volatile("" ::: "memory"); }
        asm volatile("s_waitcnt vmcnt(0)" ::: "memory");
        __builtin_amdgcn_s_barrier();
        if (wr == 0 && wc == 0) {
            unsigned* pc = pcnt + 64 * u.pm;
            if (fr == 0 && fq == 0) __hip_atomic_fetch_add(pc, 1u, RLX_AGENT);
            unsigned spins = 0; while ((unsigned)__builtin_amdgcn_readfirstlane(__hip_atomic_load(pc, RLX_AGENT)) < 4u && ++spins < (1u << 20)) __builtin_amdgcn_s_sleep(4);
        }
        asm volatile("s_waitcnt vmcnt(0)" ::: "memory");
        __builtin_amdgcn_s_barrier();
        asm volatile("" ::: "memory");
#pragma unroll
        for (int ai = 0; ai < 2; ++ai)
#pragma unroll
            for (int m = 0; m < 4; ++m) { const int row = rowb + ai * 128 + m * 16; const float rs = 1.0f / sqrtf(__hip_atomic_load(rowss + row, RLX_AGENT) * (1.f / D) + RMS_EPS);
#pragma unroll
                for (int bj = 0; bj < 2; ++bj) { const size_t off = (size_t)row * D + c0 + bj * 128;
                    f32x4 o0 = acc[ai][bj][m][0] * rs * *(const f32x4*)(fg + c0 + bj * 128), o1 = acc[ai][bj][m][1] * rs * *(const f32x4*)(fg + c0 + bj * 128 + 4);
                    if (TS_PROBE >= 0 && row == 0 && c0 == 0 && bj == 0) { const unsigned long long* ts = (const unsigned long long*)(ctl + 2048); const unsigned long long dt = ts[TS_PROBE + 1] - ts[TS_PROBE]; o0[0] += (float)((dt + 300) / 1600) * 4.f; }
                    *(f32x4*)(O + off) = o0; *(f32x4*)(O + off + 4) = o1; }
                asm volatile("" ::: "memory"); }
    }
};

__device__ __forceinline__ void build_alora(const Args& args, Frame& F, int pm) {
    const bf16* ZR = WSP(bf16, WS_ZR); bf16* AL = WSP(bf16, WS_ALORA); const float* mu = FIN(4) + 1536;
#pragma unroll 1
    for (int half = 0; half < 2; ++half) {
        u32x4 zc[8], zp[8];
#pragma unroll
        for (int i = 0; i < 8; ++i) {
            const int id = F.tid + 512 * (8 * half + i), row = pm * 256 + (id >> 5), cc = (id & 31) * 8;
            zc[i] = *(const u32x4*)(ZR + (size_t)row * RWC + 1536 + cc);
            zp[i] = (u32x4){0u, 0u, 0u, 0u}; if ((row & (SEQ - 1)) != 0) zp[i] = *(const u32x4*)(ZR + (size_t)(row - 1) * RWC + 1536 + cc);
        }
#pragma unroll
        for (int i = 0; i < 8; ++i) {
            const int id = F.tid + 512 * (8 * half + i), row = pm * 256 + (id >> 5), cc = (id & 31) * 8;
            const unsigned zcw[4] = {zc[i].x, zc[i].y, zc[i].z, zc[i].w}, zpw[4] = {zp[i].x, zp[i].y, zp[i].z, zp[i].w}; float o[8];
#pragma unroll
            for (int j = 0; j < 8; ++j) { const float c = (j & 1) ? bfhi(zcw[j >> 1]) : bflo(zcw[j >> 1]), p = (j & 1) ? bfhi(zpw[j >> 1]) : bflo(zpw[j >> 1]);
                const float xs = c + mu[cc + j] * (p - c);
                o[j] = cc < 64 ? (1.f - 2.f * __builtin_amdgcn_rcpf(1.f + __expf(2.f * xs))) : (cc < 128 ? xs : sigm(xs)); }
            u32x4 w; w.x = pk2(o[0], o[1]); w.y = pk2(o[2], o[3]); w.z = pk2(o[4], o[5]); w.w = pk2(o[6], o[7]);
            *(u32x4*)(AL + (size_t)row * LORA_K + cc) = w;
        }
    }
}

__device__ __forceinline__ void scan_unit(const Args& args, Frame& F, int bh) {
    const int b = bh >> 3, h = bh & 7, tid = F.tid;
    LAS float* LW = (LAS float*)F.lds;
    LAS float* LKK = LW + 4096, *LBB = LW + 8192, *LKP = LW + 12288, *LRR = LW + 16384, *LVV = LW + 20480, *LYY = LW + 24576, *LBON = LW + 28672;
    const bf16* ZR = WSP(bf16, WS_ZR); const float* DEC = WSP(float, WS_DEC); const float* AA = WSP(float, WS_AA); const bf16* GG = WSP(bf16, WS_GG); bf16* YB = WSP(bf16, WS_YB);
    const float* mu = FIN(4); const float* k_k = FIN(10) + h * 64; const float* k_a = FIN(11) + h * 64; const float* r_k = FIN(12) + h * 64;
    const float* lnw = FIN(13) + h * 64; const float* lnb = FIN(14) + h * 64;
    const int tt_p = tid >> 3, j0 = 8 * (tid & 7);
    const int row = tid >> 3, cg = tid & 7;
    float S[8];
#pragma unroll
    for (int j = 0; j < 8; ++j) S[j] = 0.f;
    float mur[8], muk[8], muv[8], kk_c[8], ka_c[8], rk_c[8];
#pragma unroll
    for (int j = 0; j < 8; ++j) { mur[j] = mu[h * 64 + j0 + j]; muk[j] = mu[512 + h * 64 + j0 + j]; muv[j] = mu[1024 + h * 64 + j0 + j]; kk_c[j] = k_k[j0 + j]; ka_c[j] = k_a[j0 + j]; rk_c[j] = r_k[j0 + j]; }
    for (int c0 = 0; c0 < SEQ; c0 += 64) {
        __syncthreads();
        {
            const size_t tok = (size_t)b * SEQ + c0 + tt_p; const bool first = (c0 + tt_p) == 0;
            const bf16* zc = ZR + tok * RWC + h * 64 + j0; const bf16* zp = zc - RWC;
            u32x4 cr = *(const u32x4*)zc, ck = *(const u32x4*)(zc + 512), cv = *(const u32x4*)(zc + 1024);
            u32x4 pr = (u32x4){0u, 0u, 0u, 0u}, pk = pr, pv = pr;
            if (!first) { pr = *(const u32x4*)zp; pk = *(const u32x4*)(zp + 512); pv = *(const u32x4*)(zp + 1024); }
            const f32x4 d0 = *(const f32x4*)(DEC + tok * 512 + h * 64 + j0), d1 = *(const f32x4*)(DEC + tok * 512 + h * 64 + j0 + 4);
            const f32x4 a0 = *(const f32x4*)(AA + tok * 512 + h * 64 + j0), a1 = *(const f32x4*)(AA + tok * 512 + h * 64 + j0 + 4);
            const unsigned crw[4] = {cr.x, cr.y, cr.z, cr.w}, ckw[4] = {ck.x, ck.y, ck.z, ck.w}, cvw[4] = {cv.x, cv.y, cv.z, cv.w};
            const unsigned prw[4] = {pr.x, pr.y, pr.z, pr.w}, pkw[4] = {pk.x, pk.y, pk.z, pk.w}, pvw[4] = {pv.x, pv.y, pv.z, pv.w};
            float r[8], k[8], v[8], kk[8], a[8], dec[8]; float ss = 0.f;
#pragma unroll
            for (int j = 0; j < 8; ++j) {
                const float rc = (j & 1) ? bfhi(crw[j >> 1]) : bflo(crw[j >> 1]), rp = (j & 1) ? bfhi(prw[j >> 1]) : bflo(prw[j >> 1]);
                const float kc = (j & 1) ? bfhi(ckw[j >> 1]) : bflo(ckw[j >> 1]), kp = (j & 1) ? bfhi(pkw[j >> 1]) : bflo(pkw[j >> 1]);
                const float vc = (j & 1) ? bfhi(cvw[j >> 1]) : bflo(cvw[j >> 1]), vp = (j & 1) ? bfhi(pvw[j >> 1]) : bflo(pvw[j >> 1]);
                r[j] = rc + mur[j] * (rp - rc); k[j] = kc + muk[j] * (kp - kc); v[j] = vc + muv[j] * (vp - vc);
                kk[j] = k[j] * kk_c[j]; ss += kk[j] * kk[j];
                a[j] = j < 4 ? a0[j] : a1[j - 4]; dec[j] = j < 4 ? d0[j] : d1[j - 4];
            }
            ss = red8(ss);
            const float inv = 1.0f / fmaxf(sqrtf(ss), 1e-12f);
            float bon = 0.f; float kpv[8], bbv[8];
#pragma unroll
            for (int j = 0; j < 8; ++j) { kk[j] *= inv; bbv[j] = kk[j] * a[j]; kpv[j] = k[j] * (1.f + (a[j] - 1.f) * ka_c[j]); bon += r[j] * kpv[j] * rk_c[j]; }
            bon = red8(bon);
            const int o = tt_p * 64 + j0;
            *(LAS f32x4*)(LW + o) = (f32x4){dec[0], dec[1], dec[2], dec[3]}; *(LAS f32x4*)(LW + o + 4) = (f32x4){dec[4], dec[5], dec[6], dec[7]};
            *(LAS f32x4*)(LKK + o) = (f32x4){kk[0], kk[1], kk[2], kk[3]}; *(LAS f32x4*)(LKK + o + 4) = (f32x4){kk[4], kk[5], kk[6], kk[7]};
            *(LAS f32x4*)(LBB + o) = (f32x4){bbv[0], bbv[1], bbv[2], bbv[3]}; *(LAS f32x4*)(LBB + o + 4) = (f32x4){bbv[4], bbv[5], bbv[6], bbv[7]};
            *(LAS f32x4*)(LKP + o) = (f32x4){kpv[0], kpv[1], kpv[2], kpv[3]}; *(LAS f32x4*)(LKP + o + 4) = (f32x4){kpv[4], kpv[5], kpv[6], kpv[7]};
            *(LAS f32x4*)(LRR + o) = (f32x4){r[0], r[1], r[2], r[3]}; *(LAS f32x4*)(LRR + o + 4) = (f32x4){r[4], r[5], r[6], r[7]};
            *(LAS f32x4*)(LVV + o) = (f32x4){v[0], v[1], v[2], v[3]}; *(LAS f32x4*)(LVV + o + 4) = (f32x4){v[4], v[5], v[6], v[7]};
            if ((tid & 7) == 0) LBON[tt_p] = bon;
        }
        __syncthreads();
#pragma unroll 2
        for (int tt = 0; tt < 64; ++tt) {
            const int o = tt * 64 + 8 * cg;
            const f32x4 k0 = *(const LAS f32x4*)(LKK + o), k1 = *(const LAS f32x4*)(LKK + o + 4);
            const f32x4 w0 = *(const LAS f32x4*)(LW + o), w1 = *(const LAS f32x4*)(LW + o + 4);
            const f32x4 b0 = *(const LAS f32x4*)(LBB + o), b1 = *(const LAS f32x4*)(LBB + o + 4);
            const f32x4 p0 = *(const LAS f32x4*)(LKP + o), p1 = *(const LAS f32x4*)(LKP + o + 4);
            const f32x4 r0 = *(const LAS f32x4*)(LRR + o), r1 = *(const LAS f32x4*)(LRR + o + 4);
            const float vi = LVV[tt * 64 + row];
            float sa = (S[0] * k0[0] + S[1] * k0[1]) + (S[2] * k0[2] + S[3] * k0[3]) + (S[4] * k1[0] + S[5] * k1[1]) + (S[6] * k1[2] + S[7] * k1[3]);
            sa = -red8(sa);
#pragma unroll
            for (int j = 0; j < 4; ++j) { S[j] = S[j] * w0[j] + (sa * b0[j] + vi * p0[j]); S[4 + j] = S[4 + j] * w1[j] + (sa * b1[j] + vi * p1[j]); }
            float y = (S[0] * r0[0] + S[1] * r0[1]) + (S[2] * r0[2] + S[3] * r0[3]) + (S[4] * r1[0] + S[5] * r1[1]) + (S[6] * r1[2] + S[7] * r1[3]);
            y = red8(y);
            if (cg == 0) LYY[tt * 64 + row] = y;
        }
        __syncthreads();
        {
            const size_t tok = (size_t)b * SEQ + c0 + tt_p; const int o = tt_p * 64 + j0;
            const f32x4 y0 = *(const LAS f32x4*)(LYY + o), y1 = *(const LAS f32x4*)(LYY + o + 4);
            const f32x4 v0 = *(const LAS f32x4*)(LVV + o), v1 = *(const LAS f32x4*)(LVV + o + 4);
            float s = (y0[0] + y0[1]) + (y0[2] + y0[3]) + (y1[0] + y1[1]) + (y1[2] + y1[3]);
            const float mean = red8(s) * (1.f / 64.f); float q = 0.f;
#pragma unroll
            for (int j = 0; j < 4; ++j) { const float d0 = y0[j] - mean, d1 = y1[j] - mean; q += d0 * d0 + d1 * d1; }
            const float rs = 1.0f / sqrtf(red8(q) * (1.f / 64.f) + GN_EPS); const float bon = LBON[tt_p];
            const u32x4 gv = *(const u32x4*)(GG + tok * 512 + h * 64 + j0); const unsigned gw[4] = {gv.x, gv.y, gv.z, gv.w}; float ov[8];
#pragma unroll
            for (int j = 0; j < 8; ++j) { const float yy = j < 4 ? y0[j] : y1[j - 4], vv = j < 4 ? v0[j] : v1[j - 4]; const float g = (j & 1) ? bfhi(gw[j >> 1]) : bflo(gw[j >> 1]);
                ov[j] = ((yy - mean) * rs * lnw[j0 + j] + lnb[j0 + j] + bon * vv) * g; }
            u32x4 w; w.x = pk2(ov[0], ov[1]); w.y = pk2(ov[2], ov[3]); w.z = pk2(ov[4], ov[5]); w.w = pk2(ov[6], ov[7]);
            *(u32x4*)(YB + tok * 512 + h * 64 + j0) = w;
        }
    }
    __syncthreads();
}

constexpr int LDA = 72, LDT = 40, LDF = 36;
constexpr int SC_WF = 0, SC_AT = 8192, SC_RT = SC_AT + 4608, SC_BT = SC_RT + 4608, SC_KT = SC_BT + 4608;
constexpr int SC_BCT = SC_KT + 4608, SC_KCT = SC_BCT + 5120, SC_VT = SC_KCT + 5120, SC_AHT = SC_VT + 5120, SC_UHT = SC_AHT + 5120;
constexpr int SC_AAB = SC_UHT + 5120, SC_ARB = SC_AAB + 4608, SC_ARK = SC_ARB + 2560, SC_RHS2 = SC_ARK + 2560, SC_YF = SC_RHS2 + 16384, SC_HT = SC_YF + 8192, SC_BON = SC_HT + 9216;
static_assert(SC_BON + 128 + 2048 <= RING_BYTES, "scan LDS map");
__device__ __forceinline__ float red16(float v) { v += dppf<0xB1>(v); v += dppf<0x4E>(v); v += dppf<0x141>(v); v += dppf<0x140>(v); return v; }
__device__ __forceinline__ bf16x8 ld16(const LAS bf16* p) { return *(const LAS bf16x8*)p; }
__device__ __forceinline__ bf16x8 ld8x2(const LAS bf16* p) { const u32x2 lo = *(const LAS u32x2*)p, hi = *(const LAS u32x2*)(p + 8); const u32x4 w = (u32x4){lo.x, lo.y, hi.x, hi.y}; return __builtin_bit_cast(bf16x8, w); }
__device__ __forceinline__ bf16x8 packq(const f32x16& x, int q) { u32x4 w; w.x = pk2(x[8 * q], x[8 * q + 1]); w.y = pk2(x[8 * q + 2], x[8 * q + 3]); w.z = pk2(x[8 * q + 4], x[8 * q + 5]); w.w = pk2(x[8 * q + 6], x[8 * q + 7]); return __builtin_bit_cast(bf16x8, w); }
#define MFMA32(a, b, c) __builtin_amdgcn_mfma_f32_32x32x16_bf16((a), (b), (c), 0, 0, 0)
struct ScanLoad { u32x2 cr, ck, cv, pr, pk, pv, g; f32x4 dec, eta; };
__device__ __forceinline__ void scan_load(ScanLoad& L, const bf16* ZR, const float* DEC, const float* AA, const bf16* GG, size_t tok, int hc, bool first) {
    const bf16* zc = ZR + tok * RWC + hc; const bf16* zp = zc - RWC;
    L.cr = *(const u32x2*)zc; L.ck = *(const u32x2*)(zc + 512); L.cv = *(const u32x2*)(zc + 1024);
    L.pr = (u32x2){0u, 0u}; L.pk = L.pr; L.pv = L.pr;
    if (!first) { L.pr = *(const u32x2*)zp; L.pk = *(const u32x2*)(zp + 512); L.pv = *(const u32x2*)(zp + 1024); }
    L.dec = *(const f32x4*)(DEC + tok * 512 + hc); L.eta = *(const f32x4*)(AA + tok * 512 + hc); L.g = *(const u32x2*)(GG + tok * 512 + hc);
}
#define LBAR() do { asm volatile("s_waitcnt lgkmcnt(0)" ::: "memory"); __builtin_amdgcn_s_barrier(); asm volatile("" ::: "memory"); } while (0)
typedef short v4i16_t __attribute__((ext_vector_type(4)));
__device__ __forceinline__ bf16x8 trfrag(const LAS bf16* X, int k0a, int k0b, int cbase, int lane) {
    const int g = lane >> 4, i = lane & 15, col = cbase + 16 * (g & 1) + 4 * (i & 3), rq = i >> 2;
    const v4i16_t lo = __builtin_amdgcn_ds_read_tr16_b64_v4i16((LAS v4i16_t*)(X + (k0a + rq) * LDA + col));
    const v4i16_t hi = __builtin_amdgcn_ds_read_tr16_b64_v4i16((LAS v4i16_t*)(X + (k0b + rq) * LDA + col));
    return (bf16x8){lo[0], lo[1], lo[2], lo[3], hi[0], hi[1], hi[2], hi[3]};
}
__device__ __forceinline__ void scan_unit_chunked(const Args& args, Frame& F, int bh) {
    const int b = bh >> 3, h = bh & 7, tid = F.tid, w = F.wave;
    LAS unsigned char* L = F.lds;
    LAS float* WF = (LAS float*)(L + SC_WF); LAS float* AAB = (LAS float*)(L + SC_AAB); LAS float* RHS2 = (LAS float*)(L + SC_RHS2); LAS float* YF = (LAS float*)(L + SC_YF); LAS float* BON = (LAS float*)(L + SC_BON);
    LAS bf16* AT = (LAS bf16*)(L + SC_AT); LAS bf16* RT = (LAS bf16*)(L + SC_RT); LAS bf16* BT = (LAS bf16*)(L + SC_BT); LAS bf16* KT = (LAS bf16*)(L + SC_KT);
    LAS bf16* BCT = (LAS bf16*)(L + SC_BCT); LAS bf16* KCT = (LAS bf16*)(L + SC_KCT); LAS bf16* VT = (LAS bf16*)(L + SC_VT); LAS bf16* AHT = (LAS bf16*)(L + SC_AHT); LAS bf16* UHT = (LAS bf16*)(L + SC_UHT);
    LAS bf16* ARB = (LAS bf16*)(L + SC_ARB); LAS bf16* ARK = (LAS bf16*)(L + SC_ARK); LAS bf16* HT = (LAS bf16*)(L + SC_HT);
    const bf16* ZR = WSP(bf16, WS_ZR); const float* DEC = WSP(float, WS_DEC); const float* AA = WSP(float, WS_AA); const bf16* GG = WSP(bf16, WS_GG); bf16* YB = WSP(bf16, WS_YB);
    const int t = tid >> 4, j0 = 4 * (tid & 15), hc = h * 64 + j0;
    LAS float* CST = (LAS float*)(L + SC_BON + 128);
    { const int c = tid >> 6, j = tid & 63; const float* src = c == 0 ? FIN(4) : c == 1 ? FIN(4) + 512 : c == 2 ? FIN(4) + 1024 : c == 3 ? FIN(10) : c == 4 ? FIN(11) : c == 5 ? FIN(12) : c == 6 ? FIN(13) : FIN(14);
      CST[c * 64 + j] = src[h * 64 + j]; }
    for (int i = tid; i < 64 * LDA / 2; i += 512) ((LAS unsigned*)HT)[i] = 0u;
    ScanLoad cur; scan_load(cur, ZR, DEC, AA, GG, (size_t)b * SEQ + t, hc, t == 0);
    LBAR();
    u32x2 pend = (u32x2){0u, 0u};
    for (int c0 = 0; c0 < SEQ; c0 += 32) {
        const size_t tok = (size_t)b * SEQ + c0 + t;
        float r[4], kp[4], v[4], al[4], be[4], gq[4]; f32x4 gl, gpl;
        {
            const f32x4 mur = *(const LAS f32x4*)(CST + j0), muk = *(const LAS f32x4*)(CST + 64 + j0), muv = *(const LAS f32x4*)(CST + 128 + j0), kkc = *(const LAS f32x4*)(CST + 192 + j0), kac = *(const LAS f32x4*)(CST + 256 + j0), rkc = *(const LAS f32x4*)(CST + 320 + j0);
            const unsigned crw[2] = {cur.cr.x, cur.cr.y}, ckw[2] = {cur.ck.x, cur.ck.y}, cvw[2] = {cur.cv.x, cur.cv.y}, prw[2] = {cur.pr.x, cur.pr.y}, pkw[2] = {cur.pk.x, cur.pk.y}, pvw[2] = {cur.pv.x, cur.pv.y}, gw2[2] = {cur.g.x, cur.g.y};
            float k[4], kk[4]; float ss = 0.f;
#pragma unroll
            for (int j = 0; j < 4; ++j) {
                const float rc = (j & 1) ? bfhi(crw[j >> 1]) : bflo(crw[j >> 1]), rp = (j & 1) ? bfhi(prw[j >> 1]) : bflo(prw[j >> 1]);
                const float kc = (j & 1) ? bfhi(ckw[j >> 1]) : bflo(ckw[j >> 1]), kq = (j & 1) ? bfhi(pkw[j >> 1]) : bflo(pkw[j >> 1]);
                const float vc = (j & 1) ? bfhi(cvw[j >> 1]) : bflo(cvw[j >> 1]), vq = (j & 1) ? bfhi(pvw[j >> 1]) : bflo(pvw[j >> 1]);
                r[j] = rc + mur[j] * (rp - rc); k[j] = kc + muk[j] * (kq - kc); v[j] = vc + muv[j] * (vq - vc);
                kk[j] = k[j] * kkc[j]; ss += kk[j] * kk[j]; gq[j] = (j & 1) ? bfhi(gw2[j >> 1]) : bflo(gw2[j >> 1]);
            }
            ss = red16(ss);
            const float inv = __builtin_amdgcn_rsqf(fmaxf(ss, 1e-24f)); float bon = 0.f;
#pragma unroll
            for (int j = 0; j < 4; ++j) { kk[j] *= inv; al[j] = -kk[j]; be[j] = kk[j] * cur.eta[j]; kp[j] = k[j] * (1.f + (cur.eta[j] - 1.f) * kac[j]); bon += r[j] * kp[j] * rkc[j]; }
            bon = red16(bon);
            gl = cur.dec; gpl = (f32x4){1.f, 1.f, 1.f, 1.f};
            { const int ln = tid & 63;
#pragma unroll
              for (int j = 0; j < 4; ++j) { const float u1 = __shfl_up(gl[j], 16); gl[j] = (ln >= 16) ? gl[j] * u1 : gl[j]; }
#pragma unroll
              for (int j = 0; j < 4; ++j) { const float u2 = __shfl_up(gl[j], 32); gl[j] = (ln >= 32) ? gl[j] * u2 : gl[j]; }
#pragma unroll
              for (int j = 0; j < 4; ++j) { const float u3 = __shfl_up(gl[j], 16); gpl[j] = (ln >= 16) ? u3 : 1.f; }
              if (ln >= 48) *(LAS f32x4*)(WF + w * 64 + j0) = gl; }
            if ((tid & 15) == 0) BON[t] = bon;
        }
        if (c0 + 32 < SEQ && !(SCAN_STUB & 32)) scan_load(cur, ZR, DEC, AA, GG, tok + 32, hc, false);
        if (c0 > 0) { const bf16* yp = YB + (tok - 32) * 512 + hc; asm volatile("global_store_dwordx2 %0, %1, off" :: "v"(yp), "v"(pend) : "memory"); }
        LBAR();
        {
            f32x4 pre = (f32x4){1.f, 1.f, 1.f, 1.f}, gC = pre;
#pragma unroll
            for (int ww = 0; ww < 8; ++ww) { const f32x4 wt = *(const LAS f32x4*)(WF + ww * 64 + j0); gC = gC * wt; if (ww < w) pre = pre * wt; }
            const f32x4 gt = pre * gl, gp = pre * gpl;
            if (t == 31) *(LAS f32x4*)(WF + 512 + j0) = gC;
            float a_[4], r_[4], b_[4], k_[4], bc[4], kc[4];
#pragma unroll
            for (int j = 0; j < 4; ++j) { const float ig = __builtin_amdgcn_rcpf(gt[j]); a_[j] = al[j] * gp[j]; r_[j] = r[j] * gt[j]; b_[j] = be[j] * ig; k_[j] = kp[j] * ig; bc[j] = b_[j] * gC[j]; kc[j] = k_[j] * gC[j]; }
            u32x2 wv; wv.x = pk2(a_[0], a_[1]); wv.y = pk2(a_[2], a_[3]); *(LAS u32x2*)(AT + t * LDA + j0) = wv;
            wv.x = pk2(r_[0], r_[1]); wv.y = pk2(r_[2], r_[3]); *(LAS u32x2*)(RT + t * LDA + j0) = wv;
            wv.x = pk2(b_[0], b_[1]); wv.y = pk2(b_[2], b_[3]); *(LAS u32x2*)(BT + t * LDA + j0) = wv;
            wv.x = pk2(k_[0], k_[1]); wv.y = pk2(k_[2], k_[3]); *(LAS u32x2*)(KT + t * LDA + j0) = wv;
            wv.x = pk2(bc[0], bc[1]); wv.y = pk2(bc[2], bc[3]); *(LAS u32x2*)(BCT + t * LDA + j0) = wv;
            wv.x = pk2(kc[0], kc[1]); wv.y = pk2(kc[2], kc[3]); *(LAS u32x2*)(KCT + t * LDA + j0) = wv;
            wv.x = pk2(v[0], v[1]); wv.y = pk2(v[2], v[3]); *(LAS u32x2*)(VT + t * LDA + j0) = wv;
        }
        LBAR();
        if (w < 4 && !(SCAN_STUB & 1)) {
            const int lane = lane_now(), r32 = lane & 31, hh = lane >> 5;
            f32x16 mT, mN;
#pragma unroll
            for (int i = 0; i < 16; ++i) { mT[i] = 0.f; mN[i] = 0.f; }
#pragma unroll
            for (int q = 0; q < 4; ++q) { const bf16x8 bfr = ld16(BT + r32 * LDA + 8 * hh + 16 * q), afr = ld16(AT + r32 * LDA + 8 * hh + 16 * q);
                mT = MFMA32(bfr, afr, mT);
                mN = MFMA32(afr, bfr, mN); }
#pragma unroll
            for (int i = 0; i < 16; ++i) { const int c_ = crow(i, hh); mT[i] = (c_ < r32) ? mT[i] : 0.f; mN[i] = (r32 < c_) ? mN[i] : 0.f; }
            f32x16 X;
            if (w < 2) {
#pragma unroll
                for (int i = 0; i < 16; ++i) X[i] = bflo((unsigned)AT[crow(i, hh) * LDA + 32 * w + r32]);
            } else {
                f32x16 kT;
#pragma unroll
                for (int i = 0; i < 16; ++i) { kT[i] = 0.f; X[i] = 0.f; }
#pragma unroll
                for (int q = 0; q < 4; ++q) kT = MFMA32(ld16(KT + r32 * LDA + 8 * hh + 16 * q), ld16(AT + r32 * LDA + 8 * hh + 16 * q), kT);
#pragma unroll
                for (int i = 0; i < 16; ++i) kT[i] = (crow(i, hh) < r32) ? kT[i] : 0.f;
#pragma unroll
                for (int q = 0; q < 2; ++q) X = MFMA32(packq(kT, q), trfrag(VT, 16 * q + 4 * hh, 16 * q + 8 + 4 * hh, 32 * (w - 2), lane), X);
            }
#pragma unroll
            for (int k = 0; k < 5; ++k) {
                const bf16x8 t0 = packq(mT, 0), t1 = packq(mT, 1), x0 = packq(X, 0), x1 = packq(X, 1);
                X = MFMA32(t0, x0, X); X = MFMA32(t1, x1, X);
                if (k < 4) {
                    const bf16x8 n0 = packq(mN, 0), n1 = packq(mN, 1);
                    f32x16 zT, zN;
#pragma unroll
                    for (int i = 0; i < 16; ++i) { zT[i] = 0.f; zN[i] = 0.f; }
                    zT = MFMA32(n0, t0, zT); zT = MFMA32(n1, t1, zT);
                    zN = MFMA32(t0, n0, zN); zN = MFMA32(t1, n1, zN);
                    mT = zT; mN = zN;
                }
            }
            LAS bf16* dst = ((w < 2) ? AHT : UHT) + (32 * (w & 1) + r32) * LDT + 4 * hh;
#pragma unroll
            for (int i4 = 0; i4 < 4; ++i4) { u32x2 wv; wv.x = pk2(X[4 * i4], X[4 * i4 + 1]); wv.y = pk2(X[4 * i4 + 2], X[4 * i4 + 3]); *(LAS u32x2*)(dst + 8 * i4) = wv; }
        } else if (w < 6 && !(SCAN_STUB & 1)) {
            const int lane = lane_now(), r32 = lane & 31, hh = lane >> 5;
            const LAS bf16* Aop = ((w & 1) ? KT : BT) + r32 * LDA + 8 * hh; const LAS bf16* Bop = RT + r32 * LDA + 8 * hh;
            f32x16 x;
#pragma unroll
            for (int i = 0; i < 16; ++i) x[i] = 0.f;
#pragma unroll
            for (int q = 0; q < 4; ++q) x = MFMA32(ld16(Aop + 16 * q), ld16(Bop + 16 * q), x);
#pragma unroll
            for (int i = 0; i < 16; ++i) x[i] = (crow(i, hh) <= r32) ? x[i] : 0.f;
            LAS bf16* dst = ((w & 1) ? ARK : ARB) + r32 * LDT + 4 * hh;
#pragma unroll
            for (int i4 = 0; i4 < 4; ++i4) { u32x2 wv; wv.x = pk2(x[4 * i4], x[4 * i4 + 1]); wv.y = pk2(x[4 * i4 + 2], x[4 * i4 + 3]); *(LAS u32x2*)(dst + 8 * i4) = wv; }
        }
        LBAR();
        f32x16 hn;
        if (SCAN_STUB & 4) { for (int i = 0; i < 16; ++i) hn[i] = 0.f; } else if (w < 4) {
            const int lane = lane_now(), r32 = lane & 31, hh = lane >> 5;
            const int jb = w >> 1, ib = w & 1;
            f32x16 pt[2];
#pragma unroll
            for (int a = 0; a < 2; ++a) {
#pragma unroll
                for (int i = 0; i < 16; ++i) pt[a][i] = 0.f;
#pragma unroll
                for (int q = 0; q < 2; ++q) pt[a] = MFMA32(ld16(AHT + (32 * a + r32) * LDT + 16 * q + 8 * hh), trfrag(BCT, 16 * q + 8 * hh, 16 * q + 8 * hh + 4, 32 * jb, lane), pt[a]);
            }
            { const float gC = WF[512 + 32 * jb + r32];
#pragma unroll
              for (int i = 0; i < 16; ++i) { const float add = (crow(i, hh) == r32) ? gC : 0.f; pt[0][i] += (jb == 0) ? add : 0.f; pt[1][i] += (jb == 0) ? 0.f : add; } }
#pragma unroll
            for (int i = 0; i < 16; ++i) hn[i] = 0.f;
#pragma unroll
            for (int q = 0; q < 2; ++q) {
                hn = MFMA32(trfrag(BCT, 16 * q + 8 * hh, 16 * q + 8 * hh + 4, 32 * jb, lane), ld16(UHT + (32 * ib + r32) * LDT + 16 * q + 8 * hh), hn);
                hn = MFMA32(trfrag(KCT, 16 * q + 8 * hh, 16 * q + 8 * hh + 4, 32 * jb, lane), trfrag(VT, 16 * q + 8 * hh, 16 * q + 8 * hh + 4, 32 * ib, lane), hn);
            }
#pragma unroll
            for (int a = 0; a < 2; ++a)
#pragma unroll
                for (int q = 0; q < 2; ++q) hn = MFMA32(packq(pt[a], q), ld8x2(HT + (32 * ib + r32) * LDA + 32 * a + 16 * q + 4 * hh), hn);
        } else if (w < 6) {
            const int lane = lane_now(), r32 = lane & 31, hh = lane >> 5;
            const int ib = w & 1;
            f32x16 rt[2];
#pragma unroll
            for (int a = 0; a < 2; ++a) {
#pragma unroll
                for (int i = 0; i < 16; ++i) rt[a][i] = bflo((unsigned)RT[r32 * LDA + 32 * a + crow(i, hh)]);
#pragma unroll
                for (int q = 0; q < 2; ++q) rt[a] = MFMA32(ld16(AHT + (32 * a + r32) * LDT + 16 * q + 8 * hh), ld16(ARB + r32 * LDT + 16 * q + 8 * hh), rt[a]);
            }
            f32x16 y;
#pragma unroll
            for (int i = 0; i < 16; ++i) y[i] = 0.f;
#pragma unroll
            for (int q = 0; q < 2; ++q) {
                y = MFMA32(ld16(ARB + r32 * LDT + 16 * q + 8 * hh), ld16(UHT + (32 * ib + r32) * LDT + 16 * q + 8 * hh), y);
                y = MFMA32(ld16(ARK + r32 * LDT + 16 * q + 8 * hh), trfrag(VT, 16 * q + 8 * hh, 16 * q + 8 * hh + 4, 32 * ib, lane), y);
            }
#pragma unroll
            for (int a = 0; a < 2; ++a)
#pragma unroll
                for (int q = 0; q < 2; ++q) y = MFMA32(packq(rt[a], q), ld8x2(HT + (32 * ib + r32) * LDA + 32 * a + 16 * q + 4 * hh), y);
#pragma unroll
            for (int i = 0; i < 16; ++i) YF[crow(i, hh) * 64 + 32 * ib + r32] = y[i];
        }
        LBAR();
        if (w < 4) {
            const int lane = lane_now(), r32 = lane & 31, hh = lane >> 5;
            const int jb = w >> 1, ib = w & 1; LAS bf16* dst = HT + (32 * ib + r32) * LDA + 32 * jb + 4 * hh;
#pragma unroll
            for (int i4 = 0; i4 < 4; ++i4) { u32x2 wv; wv.x = pk2(hn[4 * i4], hn[4 * i4 + 1]); wv.y = pk2(hn[4 * i4 + 2], hn[4 * i4 + 3]); *(LAS u32x2*)(dst + 8 * i4) = wv; }
        }
        {
            const f32x4 y4 = *(const LAS f32x4*)(YF + t * 64 + j0);
            const float mean = red16((y4[0] + y4[1]) + (y4[2] + y4[3])) * (1.f / 64.f); float qv = 0.f;
#pragma unroll
            for (int j = 0; j < 4; ++j) { const float d = y4[j] - mean; qv += d * d; }
            const float rs = __builtin_amdgcn_rsqf(red16(qv) * (1.f / 64.f) + GN_EPS); const float bon = BON[t]; float ov[4];
            const f32x4 lnw = *(const LAS f32x4*)(CST + 384 + j0), lnb = *(const LAS f32x4*)(CST + 448 + j0);
#pragma unroll
            for (int j = 0; j < 4; ++j) ov[j] = ((y4[j] - mean) * rs * lnw[j] + lnb[j] + bon * v[j]) * gq[j];
            pend.x = pk2(ov[0], ov[1]); pend.y = pk2(ov[2], ov[3]);
        }
    }
    *(u32x2*)(YB + ((size_t)b * SEQ + SEQ - 32 + t) * 512 + hc) = pend;
}

__device__ __forceinline__ void attn_tile(Frame& F, int bh, int qt) {
    const int lane = F.lane, q = lane & 31, hi = lane >> 5, b = bh >> 3, h = bh & 7, t0 = 32 * qt;
    const size_t tokbase = (size_t)b * SEQ;
    const bf16* QB = WSP(bf16, WS_Q); const bf16* KB = WSP(bf16, WS_K); const bf16* VT = WSP(bf16, WS_VT); bf16* YA = WSP(bf16, WS_YA);
    bf16x8 qf[4];
    { const bf16* Qp = QB + (tokbase + t0 + q) * 512 + h * 64 + 8 * hi;
#pragma unroll
      for (int d0 = 0; d0 < 4; ++d0) qf[d0] = *(const bf16x8*)(Qp + 16 * d0); }
    f32x16 y0, y1;
#pragma unroll
    for (int r = 0; r < 16; ++r) { y0[r] = 0.f; y1[r] = 0.f; }
    float carry = 1.f;
    const bf16* Vrow = VT + (size_t)bh * 128 * 1024 + q * 16 + 4 * hi;
    bf16x8 kf[4], kfn[4], kfm[4]; u32x2 vlo[2][2], vhi[2][2], vlon[2][2], vhin[2][2], vlom[2][2], vhim[2][2];
#define ATT_LOAD(KF, VLO, VHI, S0) do { const bf16* Kp_ = KB + (tokbase + (S0) + q) * 512 + h * 64 + 8 * hi; \
        _Pragma("unroll") for (int d0 = 0; d0 < 4; ++d0) KF[d0] = *(const bf16x8*)(Kp_ + 16 * d0); \
        _Pragma("unroll") for (int dt = 0; dt < 2; ++dt) _Pragma("unroll") for (int s_ = 0; s_ < 2; ++s_) { const bf16* vp_ = Vrow + (size_t)(((S0) >> 4) + s_) * 1024 + dt * 512; VLO[dt][s_] = *(const u32x2*)vp_; VHI[dt][s_] = *(const u32x2*)(vp_ + 8); } } while (0)
    ATT_LOAD(kf, vlo, vhi, t0);
    if (t0 >= 32) ATT_LOAD(kfn, vlon, vhin, t0 - 32);
    for (int s0 = t0; s0 >= 0; s0 -= 32) {
        if (s0 >= 64) ATT_LOAD(kfm, vlom, vhim, s0 - 64);
        f32x16 p;
#pragma unroll
        for (int r = 0; r < 16; ++r) p[r] = 0.f;
#pragma unroll
        for (int d0 = 0; d0 < 4; ++d0) p = __builtin_amdgcn_mfma_f32_32x32x16_bf16(kf[d0], qf[d0], p, 0, 0, 0);
        float om[16], be[16];
#pragma unroll
        for (int r = 0; r < 16; ++r) {
            const int kv = crow(r, hi); const bool valid = (s0 + kv) < (t0 + q);
            const float z = fminf(p[r], 80.f); const float t = __expf(z); const float o = __builtin_amdgcn_rcpf(1.f + t);
            om[r] = valid ? o : 1.f; be[r] = valid ? t * o : 0.f;
        }
        float el[16], G[4], PG[4];
#pragma unroll
        for (int i = 0; i < 4; ++i) { el[4 * i + 3] = 1.f; el[4 * i + 2] = om[4 * i + 3]; el[4 * i + 1] = el[4 * i + 2] * om[4 * i + 2]; el[4 * i] = el[4 * i + 1] * om[4 * i + 1]; G[i] = el[4 * i] * om[4 * i]; }
#pragma unroll
        for (int i = 0; i < 4; ++i) PG[i] = __shfl_xor(G[i], 32);
        float sG[4], sP[4];
        sG[3] = 1.f; sG[2] = G[3]; sG[1] = G[3] * G[2]; sG[0] = sG[1] * G[1];
        sP[3] = 1.f; sP[2] = PG[3]; sP[1] = PG[3] * PG[2]; sP[0] = sP[1] * PG[1];
        const float total = (sG[0] * G[0]) * (sP[0] * PG[0]);
        float A[16];
#pragma unroll
        for (int i = 0; i < 4; ++i) { const float eg = sG[i] * (hi ? sP[i] : sP[i] * PG[i]) * carry;
#pragma unroll
            for (int j = 0; j < 4; ++j) A[4 * i + j] = be[4 * i + j] * el[4 * i + j] * eg; }
        carry *= total;
        bf16x8 pf[2];
#pragma unroll
        for (int s = 0; s < 2; ++s) { u32x4 w; w.x = pk2(A[8 * s], A[8 * s + 1]); w.y = pk2(A[8 * s + 2], A[8 * s + 3]); w.z = pk2(A[8 * s + 4], A[8 * s + 5]); w.w = pk2(A[8 * s + 6], A[8 * s + 7]); pf[s] = __builtin_bit_cast(bf16x8, w); }
#pragma unroll
        for (int s = 0; s < 2; ++s) {
            const u32x4 a0 = (u32x4){vlo[0][s].x, vlo[0][s].y, vhi[0][s].x, vhi[0][s].y}, a1 = (u32x4){vlo[1][s].x, vlo[1][s].y, vhi[1][s].x, vhi[1][s].y};
            y0 = __builtin_amdgcn_mfma_f32_32x32x16_bf16(__builtin_bit_cast(bf16x8, a0), pf[s], y0, 0, 0, 0);
            y1 = __builtin_amdgcn_mfma_f32_32x32x16_bf16(__builtin_bit_cast(bf16x8, a1), pf[s], y1, 0, 0, 0);
        }
        if (__all(carry < 5.6e-14f) || (ATT_FORCE && s0 <= t0 - 64)) break;
#pragma unroll
        for (int d0 = 0; d0 < 4; ++d0) { kf[d0] = kfn[d0]; kfn[d0] = kfm[d0]; }
#pragma unroll
        for (int dt = 0; dt < 2; ++dt)
#pragma unroll
            for (int s_ = 0; s_ < 2; ++s_) { vlo[dt][s_] = vlon[dt][s_]; vhi[dt][s_] = vhin[dt][s_]; vlon[dt][s_] = vlom[dt][s_]; vhin[dt][s_] = vhim[dt][s_]; }
    }
#undef ATT_LOAD
    bf16* Yp = YA + (tokbase + t0 + q) * 512 + h * 64 + 4 * hi;
#pragma unroll
    for (int i = 0; i < 4; ++i) {
        u32x2 w0, w1; w0.x = pk2(y0[4 * i], y0[4 * i + 1]); w0.y = pk2(y0[4 * i + 2], y0[4 * i + 3]); w1.x = pk2(y1[4 * i], y1[4 * i + 1]); w1.y = pk2(y1[4 * i + 2], y1[4 * i + 3]);
        *(u32x2*)(Yp + 8 * i) = w0; *(u32x2*)(Yp + 32 + 8 * i) = w1;
    }
}

__device__ __forceinline__ void p5a_router(const Args& args, Frame& F) {
    LAS float* LG = (LAS float*)F.lds;
    LAS unsigned* HIST = (LAS unsigned*)(F.lds + 32768); LAS unsigned* BASE = HIST + 32;
    const float* X1 = WSP(float, WS_X1); const float* GW = WSP(float, WS_GW); const float* rb = FIN(20);
    unsigned* cnt = F.ctl + CW_CNT; int* LIST = WSP(int, WS_LIST); float* GATEW = WSP(float, WS_GATEW); float* R1 = WSP(float, WS_RSTD1);
    const int tid = F.tid, lane = F.lane, wave = F.wave;
    for (int tb = blockIdx.x; tb < M / 128; tb += F.G) {
        if (tid < 32) HIST[tid] = 0u;
        __syncthreads();
        int ex[4] = {0, 0, 0, 0}; float gt[4] = {0.f, 0.f, 0.f, 0.f}; unsigned lr[4] = {0u, 0u, 0u, 0u}; int tok = 0;
        if (wave < 4) {
            const int i = lane & 31, kh = lane >> 5; tok = tb * 128 + wave * 32 + i;
            const float* xr = X1 + (size_t)tok * D + 4 * kh;
            f32x16 acc;
#pragma unroll
            for (int r = 0; r < 16; ++r) acc[r] = 0.f;
            float ss = 0.f;
#pragma unroll 4
            for (int u = 0; u < 128; ++u) {
                const f32x4 a = *(const f32x4*)(xr + 8 * u); ss += (a[0] * a[0] + a[1] * a[1]) + (a[2] * a[2] + a[3] * a[3]);
                const float* gp = GW + (size_t)(8 * u + 4 * kh) * 32 + i;
#pragma unroll
                for (int j = 0; j < 4; ++j) acc = __builtin_amdgcn_mfma_f32_32x32x2f32(a[j], gp[32 * j], acc, 0, 0, 0);
            }
            ss += __shfl_xor(ss, 32);
            const float rstd = 1.0f / sqrtf(ss * (1.f / D) + RMS_EPS);
            if (kh == 0) R1[tok] = rstd;
            LAS float* L = LG + wave * (32 * 33);
#pragma unroll
            for (int r = 0; r < 16; ++r) L[crow(r, kh) * 33 + i] = acc[r];
            asm volatile("s_waitcnt lgkmcnt(0)" ::: "memory");
            if (kh == 0) {
                float v0 = -3.0e38f, v1 = -3.0e38f, v2 = -3.0e38f, v3 = -3.0e38f; int i0 = 0, i1 = 0, i2 = 0, i3 = 0;
                for (int e = 0; e < 32; ++e) { const float v = L[i * 33 + e] * rstd + rb[e];
                    if (v > v3) { if (v > v2) { v3 = v2; i3 = i2; if (v > v1) { v2 = v1; i2 = i1; if (v > v0) { v1 = v0; i1 = i0; v0 = v; i0 = e; } else { v1 = v; i1 = e; } } else { v2 = v; i2 = e; } } else { v3 = v; i3 = e; } } }
                const float e1 = __expf(v1 - v0), e2 = __expf(v2 - v0), e3 = __expf(v3 - v0), inv = 1.0f / (1.f + e1 + e2 + e3);
                ex[0] = i0; ex[1] = i1; ex[2] = i2; ex[3] = i3; gt[0] = inv; gt[1] = e1 * inv; gt[2] = e2 * inv; gt[3] = e3 * inv;
#pragma unroll
                for (int k = 0; k < 4; ++k) lr[k] = __hip_atomic_fetch_add(&HIST[ex[k]], 1u, __ATOMIC_RELAXED, __HIP_MEMORY_SCOPE_WORKGROUP);
            }
        }
        __syncthreads();
        if (tid < 32) BASE[tid] = __hip_atomic_fetch_add(cnt + tid, HIST[tid], RLX_AGENT);
        __syncthreads();
        if (wave < 4 && lane < 32) {
#pragma unroll
            for (int k = 0; k < 4; ++k) { const unsigned pos = BASE[ex[k]] + lr[k]; LIST[(size_t)ex[k] * CAP + pos] = tok * 4 + k; GATEW[tok * 4 + k] = gt[k]; }
        }
        __syncthreads();
    }
}
__device__ __forceinline__ int moe_tables(Frame& F) {
    LAS int* CS = (LAS int*)(F.lds + MOE_OFF); LAS int* OFF = CS + 32; LAS unsigned char* TE = F.lds + MOE_TE;
    if (F.tid < 32) { int c = (int)__hip_atomic_load(F.ctl + CW_CNT + F.tid, RLX_AGENT); CS[F.tid] = c > CAP ? CAP : c; }
    __syncthreads();
    if (F.tid == 0) { int off = 0; for (int e = 0; e < 32; ++e) { OFF[e] = off; off += ((CS[e] + 255) >> 8) << 8; } OFF[32] = off; }
    __syncthreads();
    const int ntiles = OFF[32] >> 8;
    for (int t = F.tid; t < ntiles; t += 512) { int e = 0; while (e < 31 && OFF[e + 1] <= t * 256) ++e; TE[t] = (unsigned char)e; }
    __syncthreads();
    return ntiles;
}
__device__ __forceinline__ void p8_combine(Frame& F) {
    float* X1 = WSP(float, WS_X1); const bf16* YBF = WSP(bf16, WS_YBUF); bf16* X2B = WSP(bf16, WS_X2B); float* R2 = WSP(float, WS_RSTD2); float* RSS = WSP(float, WS_ROWSS);
    const int gw = F.vcu * 8 + F.wave, NGW = F.G * 8, lane = F.lane;
    for (int t = gw; t < M; t += NGW) {
        f32x4* xr = (f32x4*)(X1 + (size_t)t * D) + lane; f32x4 v[4]; float s = 0.f;
#pragma unroll
        for (int j = 0; j < 4; ++j) v[j] = xr[64 * j];
#pragma unroll
        for (int k = 0; k < 4; ++k) { const u32x2* yr = (const u32x2*)(YBF + (size_t)(4 * t + k) * D) + lane;
#pragma unroll
            for (int j = 0; j < 4; ++j) { const u32x2 w = yr[64 * j]; v[j].x += bflo(w.x); v[j].y += bfhi(w.x); v[j].z += bflo(w.y); v[j].w += bfhi(w.y); } }
        u32x2* o = (u32x2*)(X2B + (size_t)t * D) + lane;
#pragma unroll
        for (int j = 0; j < 4; ++j) { s += (v[j].x * v[j].x + v[j].y * v[j].y) + (v[j].z * v[j].z + v[j].w * v[j].w); u32x2 w; w.x = pk2(v[j].x, v[j].y); w.y = pk2(v[j].z, v[j].w); o[64 * j] = w; }
        s = wave_sum(s);
        if (lane == 0) { R2[t] = 1.0f / sqrtf(s * (1.f / D) + RMS_EPS); RSS[t] = 0.f; }
    }
}
constexpr int NPHASE = 11;
__global__ void __launch_bounds__(512, 2) mega_fwd(Args args) {
    extern __shared__ __attribute__((aligned(16))) unsigned char lds[];
    Frame F;
    F.lds = (LAS unsigned char*)lds;
    F.wave = __builtin_amdgcn_readfirstlane((int)threadIdx.x >> 6); F.lane = lane_now(); F.tid = F.wave * 64 + F.lane;
    F.G = gridDim.x; { const int bx = blockIdx.x; F.vcu = (F.G % 8 == 0) ? (bx % 8) * (F.G / 8) + bx / 8 : bx; }
    F.ws = args.ws; F.ctl = (unsigned*)(args.ws + WS_CTL); F.out = args.out;
    volatile LAS unsigned* MISC = (volatile LAS unsigned*)(F.lds + LDSCTL_OFF);
    if (F.tid < 64) MISC[F.tid] = 0u;
    __syncthreads();
    const int lo = args.ph_lo, hi = args.ph_hi;
    XcdBarrier bar; bar.bar = F.ctl + CW_BAR; bar.x = 0; bar.st = nullptr;
    if (hi - lo > 1) bar = xcd_barrier_post(F.ctl + CW_BAR, MISC + 8, F.tid);
#ifndef PH_MASK
#define PH_MASK 0xFFFF
#endif
#define IN(k) ((((PH_MASK) >> (k)) & 1) && lo <= (k) && (k) < hi)
#define STAMP(k) do { if (TS_PROBE >= 0 && blockIdx.x == 0 && F.tid == 0) ((unsigned long long*)(F.ctl + 2048))[k] = __builtin_amdgcn_s_memrealtime(); } while (0)
#define SEAM(k) do { if (IN(k) && IN((k) + 1)) xcd_barrier(bar, F.wave); F.lane = lane_now(); F.tid = F.wave * 64 + F.lane; STAMP((k) + 1); } while (0)
    LAS unsigned char* ring = F.lds;
    STAMP(0);

    if (IN(0)) { p0_prologue(args, F); if (F.G < 256) expert_convert(args, F, F.vcu * 8 + F.wave, F.G * 8, 3); } SEAM(0);

    if (IN(1)) {
        pg8::Gemm g{WSP(bf16, WS_XB), WSP(bf16, WS_WIN), M, INC, D, 0, nullptr, nullptr, nullptr}; pg8::StaticOrder S; S.init(M, INC, F.G, (int)blockIdx.x);
        EpiG1 E{WSP(float, WS_RSTD0), WSP(bf16, WS_Q), WSP(bf16, WS_K), WSP(bf16, WS_VT), WSP(bf16, WS_ZR), WSP(bf16, WS_GT)};
        pg8::gemm_phase(ring, g, S, E, F.wave);
    } SEAM(1);

    if (IN(2)) {
        for (int c = blockIdx.x; c < 256; c += F.G) {
            const int x = c & 7, y = c >> 3; pg8::LoraOrder S; S.half = y & 1; S.pm = x + 8 * (y >> 1); S.nu = 3 + (F.G >> 30);
            build_alora(args, F, S.pm);
            asm volatile("s_waitcnt vmcnt(0)" ::: "memory"); __syncthreads();
            pg8::Gemm g{WSP(bf16, WS_ALORA), WSP(bf16, WS_WL), M, LORA_N, LORA_K, 0, nullptr, nullptr, nullptr};
            EpiLora E{FIN(5), FIN(7), WSP(float, WS_DEC), WSP(float, WS_AA), WSP(bf16, WS_GG)};
            pg8::gemm_phase(ring, g, S, E, F.wave);
        }
    } SEAM(2);

    if (IN(3)) {
        for (int u = blockIdx.x; u < 256; u += F.G) {
#ifndef P3_ONLY
#define P3_ONLY 0
#endif
            if (u < 128) { if (P3_ONLY != 2 && P3_ONLY != 3 && P3_ONLY != 4) scan_unit_chunked(args, F, u); else { bf16* YB = WSP(bf16, WS_YB); const int b = u >> 3, h = u & 7; for (int i = F.tid; i < SEQ * 8; i += 512) { const int tk = i >> 3, c8 = (i & 7) * 8; *(u32x4*)(YB + ((size_t)b * SEQ + tk) * 512 + h * 64 + c8) = (u32x4){0u, 0u, 0u, 0u}; } } }
            else if (P3_ONLY == 1 || P3_ONLY == 4) { bf16* YAz = WSP(bf16, WS_YA); const int bh = u - 128, b = bh >> 3, h = bh & 7; for (int i = F.tid; i < SEQ * 8; i += 512) { const int tk = i >> 3, c8 = (i & 7) * 8; *(u32x4*)(YAz + ((size_t)b * SEQ + tk) * 512 + h * 64 + c8) = (u32x4){0u, 0u, 0u, 0u}; } }
            else { const int bh = u - 128; for (int i = 0; i < 8; ++i) attn_tile(F, bh, F.wave + 8 * i);
                   if (F.G >= 256 && P3_ONLY != 3) expert_convert(args, F, bh * 8 + F.wave, 1024, 3); }
        }
    } SEAM(3);

    if (IN(4)) {
        pg8::StaticOrder S; S.init(M, D, F.G, (int)blockIdx.x);
        { pg8::Gemm g{WSP(bf16, WS_YA), WSP(bf16, WS_WA), M, D, AW, 0, nullptr, nullptr, nullptr}; EpiMerge<0> E{WSP(bf16, WS_GT), WSP(bf16, WS_MERGED)}; pg8::gemm_phase(ring, g, S, E, F.wave); }
        { pg8::Gemm g{WSP(bf16, WS_YB), WSP(bf16, WS_WB), M, D, RW, 0, nullptr, nullptr, nullptr}; EpiMerge<1> E{WSP(bf16, WS_GT), WSP(bf16, WS_MERGED)}; pg8::gemm_phase(ring, g, S, E, F.wave); }
    } SEAM(4);

    if (IN(5)) {
        pg8::Gemm g{WSP(bf16, WS_MERGED), WSP(bf16, WS_WO), M, D, D, 0, nullptr, nullptr, nullptr}; pg8::StaticOrder S; S.init(M, D, F.G, (int)blockIdx.x);
        EpiX1 E{FIN(0), WSP(float, WS_X1), FIN(18), WSP(bf16, WS_HN)};
        pg8::gemm_phase(ring, g, S, E, F.wave);
    } SEAM(5);

    if (IN(6)) { p5a_router(args, F); } SEAM(6);

    if (IN(7)) {
        const int ntiles = moe_tables(F);
        pg8::Gemm g{WSP(bf16, WS_HN), WSP(bf16, WS_W1), MAXROWS, F2, D, (size_t)F2 * D * 2, WSP(int, WS_LIST), (const LAS int*)(F.lds + MOE_OFF) + 32, (const LAS int*)(F.lds + MOE_OFF)};
        pg8::MoeOrder S{ntiles, F2 / 256, F.G, (int)blockIdx.x, F.lds + MOE_TE};
        EpiSwiglu E{FIN(22), WSP(bf16, WS_ACT), WSP(int, WS_LIST), WSP(float, WS_RSTD1), (const LAS int*)(F.lds + MOE_OFF) + 32, (const LAS int*)(F.lds + MOE_OFF)};
        pg8::gemm_phase<EpiSwiglu, pg8::MoeOrder, true>(ring, g, S, E, F.wave);
    } SEAM(7);

    if (IN(8)) {
        const int ntiles = moe_tables(F);
        pg8::Gemm g{WSP(bf16, WS_ACT), WSP(bf16, WS_W2), MAXROWS, D, FH, (size_t)D * FH * 2, nullptr, nullptr, nullptr};
        pg8::MoeOrder S{ntiles, D / 256, F.G, (int)blockIdx.x, F.lds + MOE_TE};
        EpiY E{FIN(24), WSP(int, WS_LIST), WSP(float, WS_GATEW), WSP(bf16, WS_YBUF), (const LAS int*)(F.lds + MOE_OFF) + 32, (const LAS int*)(F.lds + MOE_OFF)};
        pg8::gemm_phase(ring, g, S, E, F.wave);
    } SEAM(8);

    if (IN(9)) { p8_combine(F); } SEAM(9);

    if (IN(10)) {
        pg8::StaticOrder S; S.init(M, D, F.G, (int)blockIdx.x);
        { pg8::Gemm g{WSP(bf16, WS_X2B), WSP(bf16, WS_WG), M, D, D, 0, nullptr, nullptr, nullptr}; EpiGate E{WSP(float, WS_RSTD2), WSP(bf16, WS_PGT)}; pg8::gemm_phase(ring, g, S, E, F.wave); }
        { pg8::Gemm g{WSP(bf16, WS_PB), WSP(bf16, WS_WP), M, D, PLE, 0, nullptr, nullptr, nullptr}; EpiPle E{WSP(bf16, WS_X2B), WSP(bf16, WS_PGT), F.out, WSP(float, WS_ROWSS), F.ctl + CW_PCNT, FIN(28), F.ctl}; pg8::gemm_phase(ring, g, S, E, F.wave); }
    }
#undef IN
#undef SEAM
}

extern "C" void kernel_launch(void* const* d_in, const int* in_sizes, int n_in, void* d_out, int out_size, void* d_ws, size_t ws_size, hipStream_t stream) {
    static int grid = 0;
    if (grid == 0) {
        if (n_in != 29 || in_sizes[0] != M * D || out_size != M * D || ws_size < WS_END) {
            fprintf(stderr, "kernel_launch: unexpected shapes (n_in %d, in0 %d, out %d, ws %zu < %zu); nothing launched\n", n_in, n_in > 0 ? in_sizes[0] : -1, out_size, ws_size, (size_t)WS_END); grid = -1; return; }
        int dev = 0, cus = 0, per_cu = 0;
        if (hipGetDevice(&dev) != hipSuccess || hipDeviceGetAttribute(&cus, hipDeviceAttributeMultiprocessorCount, dev) != hipSuccess) { grid = -1; return; }
        if (hipFuncSetAttribute((const void*)mega_fwd, hipFuncAttributeMaxDynamicSharedMemorySize, LDS_BYTES) != hipSuccess) { fprintf(stderr, "kernel_launch: hipFuncSetAttribute failed\n"); grid = -1; return; }
        if (hipOccupancyMaxActiveBlocksPerMultiprocessor(&per_cu, (const void*)mega_fwd, 512, LDS_BYTES) != hipSuccess || per_cu < 1) { fprintf(stderr, "kernel_launch: occupancy query says %d blocks/CU\n", per_cu); }
        (void)hipGetLastError();
        grid = cus;
    }
    if (grid < 0) return;
    (void)hipMemsetAsync((char*)d_ws + WS_CTL, 0, CTL_ZERO_BYTES, stream);
    Args a{};
    for (int i = 0; i < 29; ++i) a.in[i] = (const float*)d_in[i];
    a.out = (float*)d_out; a.ws = (unsigned char*)d_ws;
#if MK_PER_PHASE
    for (int p = 0; p < NPHASE; ++p) { a.ph_lo = p; a.ph_hi = p + 1; hipLaunchKernelGGL(mega_fwd, dim3(grid), dim3(512), LDS_BYTES, stream, a); }
#else
    a.ph_lo = 0; a.ph_hi = NPHASE; hipLaunchKernelGGL(mega_fwd, dim3(grid), dim3(512), LDS_BYTES, stream, a);
#endif
}
```

```cpp
#include <hip/hip_runtime.h>
#include <cstdio>
#include <cstdint>

#ifndef P3_ONLY
#define P3_ONLY 0
#endif
#ifndef SCAN_STUB
#define SCAN_STUB 0
#endif
#ifndef ATT_FORCE
#define ATT_FORCE 0
#endif
#ifndef TS_PROBE
#define TS_PROBE -1
#endif
#ifndef MK_PER_PHASE
#define MK_PER_PHASE 0
#endif

#define LAS __attribute__((address_space(3)))
#define GAS __attribute__((address_space(1)))
typedef unsigned short bf16;
typedef short bf16x8 __attribute__((ext_vector_type(8)));
typedef float f32x2 __attribute__((ext_vector_type(2)));
typedef float f32x4 __attribute__((ext_vector_type(4)));
typedef float f32x16 __attribute__((ext_vector_type(16)));
typedef unsigned u32x2 __attribute__((ext_vector_type(2)));
typedef unsigned u32x4 __attribute__((ext_vector_type(4)));
typedef __bf16 bf16x2_t __attribute__((ext_vector_type(2)));

constexpr int NB = 16, SEQ = 2048, D = 1024, M = NB * SEQ;
constexpr int NH = 8, HD = 64, AW = 512, RW = 512, RWC = 1792, INC = 5376;
constexpr int NE = 32, FH = 1024, F2 = 2048, PLE = 256, TOPK = 4;
constexpr int LORA_K = 256, LORA_N = 1536;
constexpr int CAP = 32768;
constexpr int MAXROWS = M * TOPK + NE * 256;
constexpr float RMS_EPS = 1e-5f, GN_EPS = 64e-5f;

constexpr size_t MiB = 1u << 20;
constexpr size_t WS_CTL = 0, CTL_ZERO_BYTES = 1 * MiB;
constexpr size_t WS_WIN = 1 * MiB;
constexpr size_t WS_WA = 12 * MiB, WS_WB = 13 * MiB, WS_WO = 14 * MiB, WS_WG = 16 * MiB, WS_WP = 18 * MiB;
constexpr size_t WS_WL = 18 * MiB + 512 * 1024;
constexpr size_t WS_GW = 19 * MiB + 256 * 1024;
constexpr size_t WS_W1 = 20 * MiB;
constexpr size_t WS_W2 = 148 * MiB;
constexpr size_t WS_PB = 212 * MiB;
constexpr size_t WS_RSTD0 = 228 * MiB, WS_RSTD2 = WS_RSTD0 + 128 * 1024, WS_ROWSS = WS_RSTD0 + 256 * 1024;
constexpr size_t WS_RSTD1 = WS_RSTD0 + 384 * 1024;
constexpr size_t WS_GATEW = WS_RSTD0 + 512 * 1024;
constexpr size_t WS_ROWSLOT = 229 * MiB;
constexpr size_t WS_LIST = 230 * MiB;
constexpr size_t WS_X1 = 236 * MiB;
constexpr size_t WS_YA = 236 * MiB, WS_YB = 268 * MiB, WS_ALORA = 300 * MiB;
constexpr size_t WS_GT = 364 * MiB;
constexpr size_t WS_Q = 492 * MiB, WS_K = 524 * MiB, WS_VT = 556 * MiB;
constexpr size_t WS_ZR = 588 * MiB;
constexpr size_t WS_XB = 700 * MiB;
constexpr size_t WS_DEC = 764 * MiB, WS_AA = 828 * MiB, WS_GG = 892 * MiB;
constexpr size_t WS_MERGED = 492 * MiB;
constexpr size_t WS_XS = 364 * MiB;
constexpr size_t WS_ACT = 684 * MiB;
constexpr size_t WS_HN = 364 * MiB;
constexpr size_t WS_YBUF = 428 * MiB;
constexpr size_t WS_X2B = 684 * MiB;
constexpr size_t WS_PGT = 748 * MiB;
constexpr size_t WS_LRS = 956 * MiB, WS_LGT = 960 * MiB;
constexpr size_t WS_END = 964 * MiB;
constexpr int CW_CNT = 64;
constexpr int CW_PCNT = 8192;
constexpr int CW_BAR = 4096;

constexpr int RING_BYTES = 131072;
constexpr int LDSCTL_OFF = RING_BYTES;
constexpr int MOE_OFF = RING_BYTES + 1024;
constexpr int MOE_TE = RING_BYTES + 2048;
constexpr int LDS_BYTES = 147456;

#define RLX_AGENT __ATOMIC_RELAXED, __HIP_MEMORY_SCOPE_AGENT
__device__ __forceinline__ unsigned pk2(float lo, float hi) { f32x2 v = {lo, hi}; bf16x2_t b = __builtin_convertvector(v, bf16x2_t); return __builtin_bit_cast(unsigned, b); }
__device__ __forceinline__ float bflo(unsigned u) { return __uint_as_float(u << 16); }
__device__ __forceinline__ float bfhi(unsigned u) { return __uint_as_float(u & 0xffff0000u); }
__device__ __forceinline__ float sigm(float x) { return __builtin_amdgcn_rcpf(1.f + __expf(-x)); }
__device__ __forceinline__ float wave_sum(float v) {
#pragma unroll
    for (int o = 1; o < 64; o <<= 1) v += __shfl_xor(v, o);
    return v;
}
template <int CTRL> __device__ __forceinline__ float dppf(float v) { return __builtin_bit_cast(float, __builtin_amdgcn_update_dpp(0, __builtin_bit_cast(int, v), CTRL, 0xF, 0xF, true)); }
__device__ __forceinline__ float red8(float v) { v += dppf<0xB1>(v); v += dppf<0x4E>(v); v += dppf<0x141>(v); return v; }
__device__ __forceinline__ int lane_now() { int l; asm volatile("v_mbcnt_lo_u32_b32 %0, -1, 0\n\tv_mbcnt_hi_u32_b32 %0, -1, %0" : "=v"(l)); return l; }
__device__ __forceinline__ int crow(int r, int hi) { return (r & 3) + 8 * (r >> 2) + 4 * hi; }

struct PreNone {}; struct PreF { float f[8]; }; struct PreI { int i[8]; };
namespace pg8 {
#define PG8_LAS __attribute__((address_space(3)))
typedef unsigned short bf16_t;
constexpr int BM = 256, BK = 64, HALF = 128, HTB = HALF * BK * 2, STAGE_BYTES = 8 * HTB, NXCD = 8, WGM = 8;
__host__ __device__ __forceinline__ int lds_byte(int r, int c) { const int st = (r >> 4) * 2 + (c >> 5), rr = r & 15, cc = c & 31, ob = rr * 64 + cc * 2; return st * 1024 + (ob ^ (((ob >> 9) & 1) << 5)); }
__host__ __device__ __forceinline__ void stage_rc(int b, int& R, int& C) { const int st = b / 1024, sb = b % 1024, swz = sb ^ (((sb >> 9) & 1) << 5); R = (st >> 1) * 16 + swz / 64; C = (st & 1) * 32 + (swz % 64) / 2; }
__host__ __device__ __forceinline__ int perm32(int rho) { const int n = rho >> 4, i = rho & 15; return 8 * (i >> 2) + 4 * n + (i & 3); }

struct Unit { int pm, pn, e; };
struct Gemm { const bf16_t* A; const bf16_t* Bt; int M, N, K; size_t bsel_bytes; const int* glist; const PG8_LAS int* goff; const PG8_LAS int* gcnt; };

struct StaticOrder {
    int nM, nN, nwg, G, c;
    __device__ void init(int M_, int N_, int G_, int c_) { nM = M_ / BM; nN = N_ / BM; nwg = nM * nN; G = G_; c = c_; }
    __device__ bool next(int i, Unit& u) const {
        const long L = (long)i * G + c; if (L >= nwg) return false;
        int wgid = (int)L; { const int q = nwg / NXCD, r = nwg % NXCD, xcd = wgid % NXCD, off = wgid / NXCD; wgid = (xcd < r ? xcd * (q + 1) : r * (q + 1) + (xcd - r) * q) + off; }
        const int nig = WGM * nN, gid = wgid / nig, fm = gid * WGM, gsz = (nM - fm) < WGM ? (nM - fm) : WGM;
        u.pm = fm + ((wgid % nig) % gsz); u.pn = (wgid % nig) / gsz; u.e = 0; return true;
    }
};
struct LoraOrder {
    int pm, half, nu;
    __device__ bool next(int i, Unit& u) const { if (i >= nu) return false; u.pm = pm; u.pn = 3 * half + i; u.e = 0; return true; }
};
struct MoeOrder {
    int ntiles, npn, G, c; const PG8_LAS unsigned char* te;
    __device__ bool next(int i, Unit& u) const {
        int rt, pn;
        if ((G & 255) == 0 && (npn == 8 || npn == 4)) { const int x = c & 7, j = (c >> 3) & 31, rpx = 32 / npn, blk = c >> 8; rt = ((i * (G >> 8) + blk) * 8 + x) * rpx + j / npn; pn = j % npn; }
        else { const long L = (long)i * G + c; rt = (int)(L / npn); pn = (int)(L % npn); }
        if (rt >= ntiles) return false;
        u.pm = rt; u.pn = pn; u.e = te[rt]; return true;
    }
};

template <class Epi, class Sched, bool GATHER = false>
__device__ __forceinline__ void gemm_phase(PG8_LAS unsigned char* lds, const Gemm g, const Sched& S, const Epi& E, const int wid) {
    const int lane = lane_now(), tid = wid * 64 + lane,
              wr = wid >> 2, wc = wid & 3, fr = lane & 15, fq = lane >> 4;
    const int K = g.K, nt = K / BK;
    unsigned voffA[2], voffB[2];
#pragma unroll
    for (int i = 0; i < 2; ++i) { int R, C; stage_rc(tid * 16 + i * 8192, R, C); const int Rb = Epi::PERM ? ((R & ~31) + perm32(R & 31)) : R;
        voffA[i] = (unsigned)(R * K + C) * 2u; voffB[i] = (unsigned)(Rb * K + C) * 2u; }
    const size_t kstep = (size_t)(BK * 2);
    const size_t hstep = (size_t)HALF * K * 2;
    const size_t tstep = 2 * hstep;
    const unsigned ldsw = (unsigned)wid * 1024u;
    const int aoff = lds_byte(wr * 64 + fr, fq * 8), boff = lds_byte(wc * 32 + fr, fq * 8);
    unsigned vgC[2][2] = {{0u, 0u}, {0u, 0u}}, vgN[2][2] = {{0u, 0u}, {0u, 0u}};
#define PG8_GOFF(u, vo) do { _Pragma("unroll") for (int _h = 0; _h < 2; ++_h) _Pragma("unroll") for (int _i = 0; _i < 2; ++_i) { int R_, C_; stage_rc(tid * 16 + _i * 8192, R_, C_); \
        const int r_ = (u).pm * BM + _h * HALF + R_ - g.goff[(u).e]; int tok_ = 0; if (r_ < g.gcnt[(u).e]) tok_ = g.glist[(size_t)(u).e * 32768 + r_] >> 2; (vo)[_h][_i] = (unsigned)(tok_ * K + C_) * 2u; } } while (0)
#define PG8_SA(b, h) (((b) * 2 + (h)) * HTB)
#define PG8_SB(b, h) ((4 + (b) * 2 + (h)) * HTB)
#define PG8_STAGE(bufoff, gbase, voff) do { _Pragma("unroll") for (int _i = 0; _i < 2; ++_i) \
        __builtin_amdgcn_global_load_lds((const unsigned*)((const char*)(gbase) + (voff)[_i]), (PG8_LAS unsigned*)(lds + (bufoff) + ldsw + _i * 8192), 16, 0, 0); } while (0)
#define PG8_STA(bufoff, h, ptr, kbyte, usenext) do { if constexpr (GATHER) { unsigned vo_[2] = {(usenext) ? vgN[h][0] : vgC[h][0], (usenext) ? vgN[h][1] : vgC[h][1]}; PG8_STAGE(bufoff, (const char*)g.A + (kbyte), vo_); } else { PG8_STAGE(bufoff, ptr, voffA); } } while (0)
#define PG8_LDA(dst, b, h) do { _Pragma("unroll") for (int m = 0; m < 4; ++m) _Pragma("unroll") for (int k = 0; k < 2; ++k) dst[m][k] = *(const PG8_LAS bf16x8*)(lds + PG8_SA(b, h) + aoff + m * 2048 + k * 1024); } while (0)
#define PG8_LDB(dst, b, h) do { _Pragma("unroll") for (int n = 0; n < 2; ++n) _Pragma("unroll") for (int k = 0; k < 2; ++k) dst[n][k] = *(const PG8_LAS bf16x8*)(lds + PG8_SB(b, h) + boff + n * 2048 + k * 1024); } while (0)
#define PG8_MMA(ai, bj, At, Bt) do { __builtin_amdgcn_s_setprio(1); _Pragma("unroll") for (int m = 0; m < 4; ++m) _Pragma("unroll") for (int n = 0; n < 2; ++n) _Pragma("unroll") for (int k = 0; k < 2; ++k) \
        acc[ai][bj][m][n] = __builtin_amdgcn_mfma_f32_16x16x32_bf16(Bt[n][k], At[m][k], acc[ai][bj][m][n], 0, 0, 0); __builtin_amdgcn_s_setprio(0); } while (0)
#define PG8_WAIT_V(n) asm volatile("s_waitcnt vmcnt(" #n ")" ::: "memory")
#define PG8_WAIT_L(n) asm volatile("s_waitcnt lgkmcnt(" #n ")" ::: "memory")
#define PG8_BAR __builtin_amdgcn_s_barrier()
#define PG8_SCHED __builtin_amdgcn_sched_barrier(0)
    Unit cur, nxt; int ui = 0;
    if (!S.next(0, cur)) return;
    typename Epi::Pre preC;
    f32x4 acc[2][2][4][2];
#pragma unroll
    for (int a = 0; a < 2; ++a)
#pragma unroll
        for (int b = 0; b < 2; ++b)
#pragma unroll
            for (int m = 0; m < 4; ++m)
#pragma unroll
                for (int n = 0; n < 2; ++n) acc[a][b][m][n] = (f32x4){0.f, 0.f, 0.f, 0.f};
    bf16x8 At[4][2], B0[2][2], B1[2][2];
    const char* cA = (const char*)g.A + (size_t)cur.pm * tstep; const char* cB = (const char*)g.Bt + (size_t)cur.e * g.bsel_bytes + (size_t)cur.pn * tstep;
    if constexpr (GATHER) PG8_GOFF(cur, vgC);
    PG8_STAGE(PG8_SB(0, 0), cB, voffB); PG8_STAGE(PG8_SB(0, 1), cB + hstep, voffB); PG8_STA(PG8_SA(0, 0), 0, cA, 0, false); PG8_STA(PG8_SA(0, 1), 1, cA + hstep, 0, false);
    if (wr == 1) PG8_BAR;
    PG8_WAIT_V(2); PG8_BAR;
    PG8_STAGE(PG8_SB(1, 0), cB + kstep, voffB); PG8_STA(PG8_SA(1, 0), 0, cA + kstep, kstep, false); PG8_STAGE(PG8_SB(1, 1), cB + hstep + kstep, voffB);
    PG8_WAIT_V(6); PG8_BAR;
    for (;;) {
        const bool has_next = S.next(ui + 1, nxt);
        E.pre(cur, wr, fr, preC);
        f32x4 biasq = (f32x4){0.f, 0.f, 0.f, 0.f}; if constexpr (Epi::LBIAS) { if (wid == 0) biasq = *(const f32x4*)(E.bias_tile(cur) + 4 * lane); }
        if constexpr (GATHER) { if (has_next) PG8_GOFF(nxt, vgN); else { vgN[0][0] = vgC[0][0]; vgN[0][1] = vgC[0][1]; vgN[1][0] = vgC[1][0]; vgN[1][1] = vgC[1][1]; } }
        const char* nA = has_next ? (const char*)g.A + (size_t)nxt.pm * tstep : cA;
        const char* nB = has_next ? (const char*)g.Bt + (size_t)nxt.e * g.bsel_bytes + (size_t)nxt.pn * tstep : cB;
        for (int t = 0; t < nt; t += 2) {
            const bool last = (t == nt - 2);
            const char* a1 = cA + (size_t)(t + 1) * kstep;
            const char* a2 = last ? nA : cA + (size_t)(t + 2) * kstep; const char* b2 = last ? nB : cB + (size_t)(t + 2) * kstep;
            const char* a3 = a2 + kstep; const char* b3 = b2 + kstep;
            const size_t k2 = last ? 0 : (size_t)(t + 2) * kstep;
            PG8_LDB(B0, 0, 0); PG8_LDB(B1, 0, 1); PG8_SCHED; PG8_LDA(At, 0, 0); PG8_STA(PG8_SA(1, 1), 1, a1 + hstep, (size_t)(t + 1) * kstep, false);
            PG8_WAIT_V(8); PG8_WAIT_L(0); PG8_BAR; PG8_MMA(0, 0, At, B0); PG8_MMA(0, 1, At, B1); PG8_BAR; PG8_SCHED;
            PG8_LDA(At, 0, 1); PG8_STAGE(PG8_SB(0, 0), b2, voffB); PG8_STAGE(PG8_SB(0, 1), b2 + hstep, voffB); PG8_STA(PG8_SA(0, 0), 0, a2, k2, last);
            PG8_WAIT_V(8); PG8_WAIT_L(0); PG8_BAR; PG8_MMA(1, 0, At, B0); PG8_MMA(1, 1, At, B1); PG8_BAR; PG8_SCHED;
            PG8_LDB(B0, 1, 0); PG8_LDB(B1, 1, 1); PG8_SCHED; PG8_LDA(At, 1, 0); PG8_STA(PG8_SA(0, 1), 1, a2 + hstep, k2, last);
            PG8_WAIT_V(8); PG8_WAIT_L(0); PG8_BAR; PG8_MMA(0, 0, At, B0); PG8_MMA(0, 1, At, B1); PG8_BAR; PG8_SCHED;
            PG8_LDA(At, 1, 1); PG8_STAGE(PG8_SB(1, 0), b3, voffB); PG8_STAGE(PG8_SB(1, 1), b3 + hstep, voffB); PG8_STA(PG8_SA(1, 0), 0, a3, k2 + kstep, last);
            PG8_WAIT_V(8); PG8_WAIT_L(0); PG8_BAR; PG8_MMA(1, 0, At, B0); PG8_MMA(1, 1, At, B1); PG8_BAR; PG8_SCHED;
        }
        if constexpr (Epi::LBIAS) { if (wid == 0) { *(PG8_LAS f32x4*)(lds + RING_BYTES + 4096 + 16 * lane) = biasq; asm volatile("s_waitcnt lgkmcnt(0)" ::: "memory"); } }
        if (wr == 0) PG8_BAR;
        E(acc, cur, wr, wc, fr, fq, preC);
        if (!has_next) break;
#pragma unroll
        for (int a = 0; a < 2; ++a)
#pragma unroll
            for (int b = 0; b < 2; ++b)
#pragma unroll
                for (int m = 0; m < 4; ++m)
#pragma unroll
                    for (int n = 0; n < 2; ++n) acc[a][b][m][n] = (f32x4){0.f, 0.f, 0.f, 0.f};
        cur = nxt; cA = nA; cB = nB; ++ui;
        if constexpr (GATHER) { vgC[0][0] = vgN[0][0]; vgC[0][1] = vgN[0][1]; vgC[1][0] = vgN[1][0]; vgC[1][1] = vgN[1][1]; }
        if (wr == 1) PG8_BAR;
    }
    PG8_WAIT_V(0);
    PG8_BAR;
#undef PG8_SA
#undef PG8_SB
#undef PG8_STAGE
#undef PG8_LDA
#undef PG8_STA
#undef PG8_GOFF
#undef PG8_LDB
#undef PG8_MMA
#undef PG8_WAIT_V
#undef PG8_WAIT_L
#undef PG8_BAR
#undef PG8_SCHED
}
}
using pg8::Unit;
typedef const f32x4 (&AccRef)[2][2][4][2];

#define XB_TMO      128
#define XB_XCNT(j)  (256  + 64 * (j))
#define XB_XSUB(j)  (1280 + 64 * (j))
#define XB_XGEN(j)  (2304 + 64 * (j))
#define XB_TOP      3328
#define XB_TOPGEN   3392
#define XCD_BAR_WORDS 3456
#define XB_SPIN_CAP (1u << 22)
__device__ __forceinline__ unsigned xb_ld(unsigned* p)              { return __hip_atomic_load(p, __ATOMIC_RELAXED, __HIP_MEMORY_SCOPE_AGENT); }
__device__ __forceinline__ unsigned xb_add(unsigned* p, unsigned v) { return __hip_atomic_fetch_add(p, v, __ATOMIC_RELAXED, __HIP_MEMORY_SCOPE_AGENT); }
__device__ __forceinline__ unsigned xb_xcc_id() { return (unsigned)__builtin_amdgcn_s_getreg((3 << 11) | 20) & 0xFu; }
#define XB_SPIN(cond, bar) do { unsigned _sp = 0; while (cond) { __builtin_amdgcn_s_sleep(1); \
    if ((++_sp & 255u) == 0u) { if (xb_ld(&(bar)[XB_TMO])) break; if (_sp > XB_SPIN_CAP) { atomicAdd(&(bar)[XB_TMO], 1u); break; } } } } while (0)
struct XcdBarrier { unsigned* bar; unsigned x; volatile LAS unsigned* st; };
__device__ __forceinline__ XcdBarrier xcd_barrier_post(unsigned* bar, volatile LAS unsigned* st, int tid) {
    XcdBarrier b; b.bar = bar; b.x = xb_xcc_id(); b.st = st;
    if (tid == 0) (void)xb_add(&bar[XB_XCNT(b.x)], 1u);
    return b;
}
__device__ __forceinline__ void xcd_barrier_complete(unsigned* bar, unsigned x, unsigned& nloc, unsigned& nx) {
    const unsigned G = gridDim.x * gridDim.y * gridDim.z;
    unsigned sum, cnt, mine, sp = 0u;
    for (;;) {
        sum = 0u; cnt = 0u; mine = 0u;
#pragma unroll
        for (unsigned j = 0; j < 16; ++j) { const unsigned c = xb_ld(&bar[XB_XCNT(j)]); sum += c; cnt += (c > 0u) ? 1u : 0u; mine = (j == x) ? c : mine; }
        if (sum == G) break;
        __builtin_amdgcn_s_sleep(1);
        if ((++sp & 255u) == 0u) { if (xb_ld(&bar[XB_TMO])) break; if (sp > XB_SPIN_CAP) { atomicAdd(&bar[XB_TMO], 1u); break; } }
    }
    nloc = mine > 0u ? mine : 1u; nx = cnt > 0u ? cnt : 1u;
}
__device__ __forceinline__ void xcd_barrier(const XcdBarrier& b, int wave) {
    asm volatile("s_waitcnt vmcnt(0)" ::: "memory");
    __syncthreads();
    if (wave == 0 && lane_now() == 0) {
        unsigned* bar = b.bar;
        __builtin_amdgcn_s_waitcnt(0);
        unsigned nloc = b.st[0], nx = b.st[1];
        if (nloc == 0u) { xcd_barrier_complete(bar, b.x, nloc, nx); b.st[0] = nloc; b.st[1] = nx; }
        const unsigned old = xb_add(&bar[XB_XSUB(b.x)], 1u);
        const unsigned gen = old / nloc;
        if (old + 1u == (gen + 1u) * nloc) {
            __builtin_amdgcn_fence(__ATOMIC_RELEASE, "agent");
            asm volatile("s_waitcnt vmcnt(0)" ::: "memory");
            const unsigned og = xb_add(&bar[XB_TOP], 1u);
            const unsigned tg = og / nx;
            if (og + 1u == (tg + 1u) * nx) xb_add(&bar[XB_TOPGEN], 1u);
            else XB_SPIN(xb_ld(&bar[XB_TOPGEN]) == tg, bar);
            __builtin_amdgcn_fence(__ATOMIC_ACQUIRE, "agent");
            xb_add(&bar[XB_XGEN(b.x)], 1u);
            asm volatile("s_waitcnt vmcnt(0)" ::: "memory");
        } else {
            XB_SPIN(xb_ld(&bar[XB_XGEN(b.x)]) == gen, bar);
            __builtin_amdgcn_fence(__ATOMIC_ACQUIRE, "agent");
            asm volatile("s_waitcnt vmcnt(0)" ::: "memory");
        }
    }
    __syncthreads();
}

struct Frame {
    LAS unsigned char* lds;
    unsigned* ctl;
    int tid, lane, wave, vcu, G;
    unsigned char* ws;
    float* out;
};
#define WSP(T, off) ((T*)(F.ws + (off)))
struct Args { const float* in[29]; float* out; unsigned char* ws; int ph_lo, ph_hi; };
#define FIN(i) (args.in[i])

template <bool SWZ = false>
__device__ __forceinline__ void p0_transpose_item(const float* W, int K, int N, bf16* WT, LAS float* scr, int item, int lane, const float* kscale) {
    const int nblk = N / 32, kb = item / nblk, nb = item % nblk, k0 = 64 * kb, n0 = 32 * nb;
#pragma unroll 8
    for (int i = 0; i < 32; ++i) { const int kk = 2 * i + (lane >> 5); float v = W[(size_t)(k0 + kk) * N + n0 + (lane & 31)]; if (kscale) v *= kscale[k0 + kk]; scr[kk * 33 + (lane & 31)] = v; }
    asm volatile("s_waitcnt lgkmcnt(0)" ::: "memory");
    const int c = lane & 7;
#pragma unroll
    for (int j = 0; j < 4; ++j) { const int n = (lane >> 3) + 8 * j; const LAS float* s = scr + (8 * c) * 33 + n;
        u32x4 o; o.x = pk2(s[0 * 33], s[1 * 33]); o.y = pk2(s[2 * 33], s[3 * 33]); o.z = pk2(s[4 * 33], s[5 * 33]); o.w = pk2(s[6 * 33], s[7 * 33]);
        int nr = n0 + n; if (SWZ) { const int cl = nr & 255; nr = (nr & ~255) + 128 * ((cl >> 3) & 1) + 32 * (cl >> 6) + 8 * ((cl >> 4) & 3) + (cl & 7); }
        *(u32x4*)(WT + (size_t)nr * K + k0 + 8 * c) = o; }
    asm volatile("s_waitcnt lgkmcnt(0)" ::: "memory");
}
__device__ __forceinline__ void p0_prologue(const Args& args, Frame& F) {
    LAS float* scr = (LAS float*)(F.lds + F.wave * 16384);
    const int gw = F.vcu * 8 + F.wave, NGW = F.G * 8, lane = F.lane;
    constexpr int I_IN = (D / 64) * (INC / 32), I_A = (AW / 64) * (D / 32), I_O = (D / 64) * (D / 32), I_P = (PLE / 64) * (D / 32);
    constexpr int I_W1 = (D / 64) * (F2 / 32), I_W2 = (FH / 64) * (D / 32);
    constexpr int NITEMS = I_IN + 2 * I_A + 2 * I_O + I_P;
    for (int it = gw; it < NITEMS; it += NGW) {
        int r = it;
        if (r < I_IN) { p0_transpose_item(FIN(3), D, INC, WSP(bf16, WS_WIN), scr, r, lane, FIN(2)); continue; } r -= I_IN;
        if (r < I_A) { p0_transpose_item(FIN(15), AW, D, WSP(bf16, WS_WA), scr, r, lane, nullptr); continue; } r -= I_A;
        if (r < I_A) { p0_transpose_item(FIN(16), RW, D, WSP(bf16, WS_WB), scr, r, lane, nullptr); continue; } r -= I_A;
        if (r < I_O) { p0_transpose_item(FIN(17), D, D, WSP(bf16, WS_WO), scr, r, lane, nullptr); continue; } r -= I_O;
        if (r < I_O) { p0_transpose_item(FIN(26), D, D, WSP(bf16, WS_WG), scr, r, lane, FIN(25)); continue; } r -= I_O;
        p0_transpose_item(FIN(27), PLE, D, WSP(bf16, WS_WP), scr, r, lane, nullptr);
    }
    { const int gt = (F.vcu * 512 + F.tid), NT = F.G * 512;
      bf16* WL = WSP(bf16, WS_WL);
      for (int i = gt; i < LORA_N * LORA_K; i += NT) { const int n = i >> 8, k = i & 255; float v = 0.f;
          if (n < 512) { if (k < 64) v = FIN(6)[k * 512 + n]; }
          else if (n < 1024) { if (k >= 64 && k < 128) v = FIN(8)[(k - 64) * 512 + (n - 512)]; }
          else { if (k >= 128) v = FIN(9)[(k - 128) * 512 + (n - 1024)]; }
          WL[i] = (bf16)(pk2(v, 0.f) & 0xffffu); }
      float* GW = WSP(float, WS_GW);
      for (int i = gt; i < D * NE; i += NT) GW[i] = FIN(19)[i] * FIN(18)[i >> 5];
    }
    { bf16* XB = WSP(bf16, WS_XB); float* R0 = WSP(float, WS_RSTD0); bf16* PB = WSP(bf16, WS_PB);
      for (int m = gw; m < M; m += NGW) {
          const f32x4* xr = (const f32x4*)(FIN(0) + (size_t)m * D) + lane;
          f32x4 v[4]; float s = 0.f;
#pragma unroll
          for (int j = 0; j < 4; ++j) { v[j] = xr[64 * j]; s += (v[j].x * v[j].x + v[j].y * v[j].y) + (v[j].z * v[j].z + v[j].w * v[j].w); }
          s = wave_sum(s);
          u32x2* o = (u32x2*)(XB + (size_t)m * D) + lane;
#pragma unroll
          for (int j = 0; j < 4; ++j) { u32x2 w; w.x = pk2(v[j].x, v[j].y); w.y = pk2(v[j].z, v[j].w); o[64 * j] = w; }
          if (lane == 0) R0[m] = 1.0f / sqrtf(s * (1.f / D) + RMS_EPS);
          const f32x4 pv = ((const f32x4*)(FIN(1) + (size_t)m * PLE))[lane];
          u32x2 w; w.x = pk2(pv.x, pv.y); w.y = pk2(pv.z, pv.w); ((u32x2*)(PB + (size_t)m * PLE))[lane] = w;
      }
    }
}

__device__ __forceinline__ void expert_convert(const Args& args, Frame& F, int wv, int NW, int which) {
    LAS float* scr = (LAS float*)(F.lds + F.wave * 16384);
    constexpr int I_W1 = (D / 64) * (F2 / 32), I_W2 = (FH / 64) * (D / 32);
    if (which & 1) for (int it = wv; it < NE * I_W1; it += NW) { const int e = it / I_W1; p0_transpose_item<true>(FIN(21) + (size_t)e * D * F2, D, F2, WSP(bf16, WS_W1) + (size_t)e * F2 * D, scr, it % I_W1, F.lane, nullptr); }
    if (which & 2) for (int it = wv; it < NE * I_W2; it += NW) { const int e = it / I_W2; p0_transpose_item(FIN(23) + (size_t)e * FH * D, FH, D, WSP(bf16, WS_W2) + (size_t)e * D * FH, scr, it % I_W2, F.lane, nullptr); }
}
struct EpiG1 {
    static constexpr bool PERM = true;
    typedef PreF Pre; static constexpr bool LBIAS = false;
    const float* rstd; bf16 *Q, *K, *VT, *ZR, *GT;
    __device__ __forceinline__ void pre(const Unit& u, int wr, int fr, PreF& P) const {
#pragma unroll
        for (int k = 0; k < 8; ++k) P.f[k] = rstd[u.pm * 256 + wr * 64 + fr + (k >> 2) * 128 + (k & 3) * 16]; }
    __device__ __forceinline__ void operator()(AccRef acc, const Unit& u, int wr, int wc, int fr, int fq, const Pre& P) const {
        const int pn = u.pn, rowb = u.pm * 256 + wr * 64 + fr, cl = wc * 32 + 8 * fq;
#pragma unroll
        for (int ai = 0; ai < 2; ++ai)
#pragma unroll
            for (int m = 0; m < 4; ++m) {
                const int row = rowb + ai * 128 + m * 16; const float rs = P.f[4 * ai + m];
                if (pn < 4) {
                    bf16* base = (pn < 2 ? Q : K) + (size_t)row * 512 + (pn & 1) * 256 + cl; const float sc = pn < 2 ? rs * 0.125f : rs;
#pragma unroll
                    for (int bj = 0; bj < 2; ++bj) { const f32x4 v0 = acc[ai][bj][m][0] * sc, v1 = acc[ai][bj][m][1] * sc;
                        u32x4 w; w.x = pk2(v0[0], v0[1]); w.y = pk2(v0[2], v0[3]); w.z = pk2(v1[0], v1[1]); w.w = pk2(v1[2], v1[3]); *(u32x4*)(base + bj * 128) = w; }
                } else if (pn < 6) {
                    const int b = row >> 11, s = row & 2047;
#pragma unroll
                    for (int bj = 0; bj < 2; ++bj)
#pragma unroll
                        for (int n = 0; n < 2; ++n)
#pragma unroll
                            for (int j = 0; j < 4; ++j) { const int c = (pn - 4) * 256 + cl + bj * 128 + 4 * n + j; const int hh = c >> 6, d = c & 63;
                                VT[((size_t)(((b * 8 + hh) * 128 + (s >> 4)) * 64 + d)) * 16 + (s & 15)] = (bf16)(pk2(acc[ai][bj][m][n][j] * rs, 0.f) & 0xffffu); }
                } else if (pn < 13) {
                    bf16* base = ZR + (size_t)row * RWC + (pn - 6) * 256 + cl;
#pragma unroll
                    for (int bj = 0; bj < 2; ++bj) { const f32x4 v0 = acc[ai][bj][m][0] * rs, v1 = acc[ai][bj][m][1] * rs;
                        u32x4 w; w.x = pk2(v0[0], v0[1]); w.y = pk2(v0[2], v0[3]); w.z = pk2(v1[0], v1[1]); w.w = pk2(v1[2], v1[3]); *(u32x4*)(base + bj * 128) = w; }
                } else {
                    bf16* base = GT + (size_t)row * 2048 + (pn - 13) * 256 + cl;
#pragma unroll
                    for (int bj = 0; bj < 2; ++bj) { const f32x4 v0 = acc[ai][bj][m][0] * rs, v1 = acc[ai][bj][m][1] * rs;
                        u32x4 w; w.x = pk2(sigm(v0[0]), sigm(v0[1])); w.y = pk2(sigm(v0[2]), sigm(v0[3])); w.z = pk2(sigm(v1[0]), sigm(v1[1])); w.w = pk2(sigm(v1[2]), sigm(v1[3])); *(u32x4*)(base + bj * 128) = w; }
                }
            }
    }
};
struct EpiLora {
    static constexpr bool PERM = false;
    typedef PreNone Pre; static constexpr bool LBIAS = false;
    __device__ __forceinline__ void pre(const Unit&, int, int, PreNone&) const {}
    const float *w0, *a0; float *DEC, *AA; bf16* GG;
    template <int MODE> __device__ __forceinline__ void body(AccRef acc, int rowb, int cb) const {
#pragma unroll
        for (int ai = 0; ai < 2; ++ai)
#pragma unroll
            for (int m = 0; m < 4; ++m) {
                const int row = rowb + ai * 128 + m * 16;
#pragma unroll
                for (int bj = 0; bj < 2; ++bj)
#pragma unroll
                    for (int n = 0; n < 2; ++n) {
                        const int c = cb + bj * 128 + n * 16;
                        f32x4 v = acc[ai][bj][m][n];
                        if (MODE == 0) { v = v + *(const f32x4*)(w0 + c); f32x4 o;
#pragma unroll
                            for (int j = 0; j < 4; ++j) { const float y = -v[j]; const float sp = y > 20.f ? y : __logf(1.f + __expf(y)); o[j] = __expf(-__expf(-sp - 0.5f)); }
                            *(f32x4*)(DEC + (size_t)row * 512 + c) = o;
                        } else if (MODE == 1) { v = v + *(const f32x4*)(a0 + c); f32x4 o;
#pragma unroll
                            for (int j = 0; j < 4; ++j) o[j] = sigm(v[j]);
                            *(f32x4*)(AA + (size_t)row * 512 + c) = o;
                        } else { u32x2 w; w.x = pk2(v[0], v[1]); w.y = pk2(v[2], v[3]); *(u32x2*)(GG + (size_t)row * 512 + c) = w; }
                    }
                asm volatile("" ::: "memory");
            }
    }
    __device__ __forceinline__ void operator()(AccRef acc, const Unit& u, int wr, int wc, int fr, int fq, const Pre& P) const {
        const int pn = u.pn, rowb = u.pm * 256 + wr * 64 + fr, cb = (pn & 1) * 256 + wc * 32 + 4 * fq;
        if (pn < 2) body<0>(acc, rowb, cb); else if (pn < 4) body<1>(acc, rowb, cb); else body<2>(acc, rowb, cb);
    }
};
template <int SECOND> struct EpiMerge {
    static constexpr bool PERM = true;
    typedef PreNone Pre; static constexpr bool LBIAS = false;
    __device__ __forceinline__ void pre(const Unit&, int, int, PreNone&) const {}
    const bf16* GT; bf16* MG;
    __device__ __forceinline__ void operator()(AccRef acc, const Unit& u, int wr, int wc, int fr, int fq, const Pre& P) const {
        const int rowb = u.pm * 256 + wr * 64 + fr, c0 = u.pn * 256 + wc * 32 + 8 * fq;
#pragma unroll
        for (int bj = 0; bj < 2; ++bj) {
            const int c = c0 + bj * 128; u32x4 gv[8], ov[8];
#pragma unroll
            for (int k = 0; k < 8; ++k) { const int row = rowb + (k >> 2) * 128 + (k & 3) * 16; gv[k] = *(const u32x4*)(GT + (size_t)row * 2048 + SECOND * 1024 + c); if (SECOND) ov[k] = *(const u32x4*)(MG + (size_t)row * 1024 + c); }
            __builtin_amdgcn_sched_barrier(0);
#pragma unroll
            for (int k = 0; k < 8; ++k) { const int ai = k >> 2, m = k & 3, row = rowb + ai * 128 + m * 16;
                const f32x4 v0 = acc[ai][bj][m][0], v1 = acc[ai][bj][m][1];
                float o[8] = {v0[0] * bflo(gv[k].x), v0[1] * bfhi(gv[k].x), v0[2] * bflo(gv[k].y), v0[3] * bfhi(gv[k].y), v1[0] * bflo(gv[k].z), v1[1] * bfhi(gv[k].z), v1[2] * bflo(gv[k].w), v1[3] * bfhi(gv[k].w)};
                if (SECOND) { o[0] += bflo(ov[k].x); o[1] += bfhi(ov[k].x); o[2] += bflo(ov[k].y); o[3] += bfhi(ov[k].y); o[4] += bflo(ov[k].z); o[5] += bfhi(ov[k].z); o[6] += bflo(ov[k].w); o[7] += bfhi(ov[k].w); }
                u32x4 w; w.x = pk2(o[0], o[1]); w.y = pk2(o[2], o[3]); w.z = pk2(o[4], o[5]); w.w = pk2(o[6], o[7]); *(u32x4*)(MG + (size_t)row * 1024 + c) = w; }
            __builtin_amdgcn_sched_barrier(0);
        }
    }
};
struct EpiX1 {
    static constexpr bool PERM = true;
    typedef PreNone Pre; static constexpr bool LBIAS = false;
    __device__ __forceinline__ void pre(const Unit&, int, int, PreNone&) const {}
    const float* X; float* X1; const float* gn; bf16* HN;
    __device__ __forceinline__ void operator()(AccRef acc, const Unit& u, int wr, int wc, int fr, int fq, const Pre& P) const {
        const int rowb = u.pm * 256 + wr * 64 + fr, c0 = u.pn * 256 + wc * 32 + 8 * fq;
#pragma unroll
        for (int bj = 0; bj < 2; ++bj) { const f32x4 g0 = *(const f32x4*)(gn + c0 + bj * 128), g1 = *(const f32x4*)(gn + c0 + bj * 128 + 4);
#pragma unroll
            for (int ai = 0; ai < 2; ++ai) {
                f32x4 xa[4], xb[4];
#pragma unroll
                for (int m = 0; m < 4; ++m) { const size_t off = (size_t)(rowb + ai * 128 + m * 16) * D + c0 + bj * 128; xa[m] = *(const f32x4*)(X + off); xb[m] = *(const f32x4*)(X + off + 4); }
                __builtin_amdgcn_sched_barrier(0);
#pragma unroll
                for (int m = 0; m < 4; ++m) { const size_t off = (size_t)(rowb + ai * 128 + m * 16) * D + c0 + bj * 128;
                    const f32x4 x0 = xa[m] + acc[ai][bj][m][0], x1 = xb[m] + acc[ai][bj][m][1];
                    *(f32x4*)(X1 + off) = x0; *(f32x4*)(X1 + off + 4) = x1;
                    u32x4 w; w.x = pk2(x0[0] * g0[0], x0[1] * g0[1]); w.y = pk2(x0[2] * g0[2], x0[3] * g0[3]); w.z = pk2(x1[0] * g1[0], x1[1] * g1[1]); w.w = pk2(x1[2] * g1[2], x1[3] * g1[3]); *(u32x4*)(HN + off) = w; }
                __builtin_amdgcn_sched_barrier(0);
            }
        }
    }
};
struct EpiSwiglu {
    static constexpr bool PERM = true;
    typedef PreF Pre; static constexpr bool LBIAS = true;
    const float* b1; bf16* ACT; const int* LIST; const float* R1; const LAS int* OFF; const LAS int* CS; const LAS float* LB;
    __device__ __forceinline__ const float* bias_tile(const Unit& u) const { return b1 + (size_t)u.e * F2 + u.pn * 256; }
    __device__ __forceinline__ void pre(const Unit& u, int wr, int fr, PreF& P) const {
        const int rbase = u.pm * 256 + wr * 64 + fr - OFF[u.e], cnt = CS[u.e];
#pragma unroll
        for (int k = 0; k < 8; ++k) { const int r = rbase + (k >> 2) * 128 + (k & 3) * 16; P.f[k] = 0.f; if (r < cnt) P.f[k] = R1[(size_t)u.e * CAP + r]; } }
    __device__ __forceinline__ void operator()(AccRef acc, const Unit& u, int wr, int wc, int fr, int fq, const Pre& P) const {
        const int rowb = u.pm * 256 + wr * 64 + fr, c0 = u.pn * 256 + wc * 64 + 16 * fq;
        const LAS float* bb = LB + wc * 64 + 16 * fq;
        const f32x4 bv0 = *(const LAS f32x4*)(bb), bv1 = *(const LAS f32x4*)(bb + 4), bv2 = *(const LAS f32x4*)(bb + 8), bv3 = *(const LAS f32x4*)(bb + 12);
#pragma unroll
        for (int ai = 0; ai < 2; ++ai)
#pragma unroll
            for (int m = 0; m < 4; ++m) { const int row = rowb + ai * 128 + m * 16; const float rs = P.f[4 * ai + m];
                const f32x4 v[4] = {acc[ai][0][m][0] * rs + bv0, acc[ai][0][m][1] * rs + bv1, acc[ai][1][m][0] * rs + bv2, acc[ai][1][m][1] * rs + bv3};
                float o[8];
#pragma unroll
                for (int p = 0; p < 8; ++p) { float gl = v[p >> 1][2 * (p & 1)], ul = v[p >> 1][2 * (p & 1) + 1];
                    gl = fminf(gl, 7.f); ul = fminf(fmaxf(ul, -7.f), 7.f); o[p] = (ul + 1.f) * gl * sigm(1.702f * gl); }
                u32x4 w; w.x = pk2(o[0], o[1]); w.y = pk2(o[2], o[3]); w.z = pk2(o[4], o[5]); w.w = pk2(o[6], o[7]); *(u32x4*)(ACT + (size_t)row * FH + (c0 >> 1)) = w;
                asm volatile("" ::: "memory"); }
    }
};
struct EpiY {
    static constexpr bool PERM = true;
    typedef PreI Pre; static constexpr bool LBIAS = true;
    const float* b2; const int* LIST; const float* gatew; bf16* YB; const LAS int* OFF; const LAS int* CS; const LAS float* LB;
    __device__ __forceinline__ const float* bias_tile(const Unit& u) const { return b2 + (size_t)u.e * D + u.pn * 256; }
    __device__ __forceinline__ void pre(const Unit& u, int wr, int fr, PreI& P) const {
        const int rbase = u.pm * 256 + wr * 64 + fr - OFF[u.e], cnt = CS[u.e];
#pragma unroll
        for (int k = 0; k < 8; ++k) { const int r = rbase + (k >> 2) * 128 + (k & 3) * 16; P.i[k] = -1; if (r < cnt) P.i[k] = LIST[(size_t)u.e * CAP + r]; } }
    __device__ __forceinline__ void operator()(AccRef acc, const Unit& u, int wr, int wc, int fr, int fq, const Pre& P) const {
        const int rowb = u.pm * 256 + wr * 64 + fr, c0 = u.pn * 256 + wc * 32 + 8 * fq;
        const LAS float* bb = LB + wc * 32 + 8 * fq; const int rbase = rowb - OFF[u.e];

#pragma unroll
        for (int ai = 0; ai < 2; ++ai) {
            float gts[4];
#pragma unroll
            for (int m = 0; m < 4; ++m) { gts[m] = 0.f; if (P.i[4 * ai + m] >= 0) gts[m] = gatew[(size_t)u.e * CAP + rbase + ai * 128 + m * 16]; }
            __builtin_amdgcn_sched_barrier(0);
#pragma unroll
            for (int m = 0; m < 4; ++m) {
                const int slot = P.i[4 * ai + m]; if (slot >= 0) { const float gt = gts[m];
#pragma unroll
                    for (int bj = 0; bj < 2; ++bj) { const int c = c0 + bj * 128;
                        const f32x4 v0 = (acc[ai][bj][m][0] + *(const LAS f32x4*)(bb + bj * 128)) * gt, v1 = (acc[ai][bj][m][1] + *(const LAS f32x4*)(bb + bj * 128 + 4)) * gt;
                        u32x4 w; w.x = pk2(v0[0], v0[1]); w.y = pk2(v0[2], v0[3]); w.z = pk2(v1[0], v1[1]); w.w = pk2(v1[2], v1[3]); *(u32x4*)(YB + (size_t)slot * D + c) = w; } } }
            __builtin_amdgcn_sched_barrier(0); }
    }
};
struct EpiGate {
    static constexpr bool PERM = true;
    typedef PreF Pre; static constexpr bool LBIAS = false;
    __device__ __forceinline__ void pre(const Unit& u, int wr, int fr, PreF& P) const {
#pragma unroll
        for (int k = 0; k < 8; ++k) P.f[k] = rstd2[u.pm * 256 + wr * 64 + fr + (k >> 2) * 128 + (k & 3) * 16]; }
    const float* rstd2; bf16* GT;
    __device__ __forceinline__ void operator()(AccRef acc, const Unit& u, int wr, int wc, int fr, int fq, const Pre& P) const {
        const int rowb = u.pm * 256 + wr * 64 + fr, c0 = u.pn * 256 + wc * 32 + 8 * fq;
#pragma unroll
        for (int ai = 0; ai < 2; ++ai)
#pragma unroll
            for (int m = 0; m < 4; ++m) { const int row = rowb + ai * 128 + m * 16; const float rs = P.f[4 * ai + m];
#pragma unroll
                for (int bj = 0; bj < 2; ++bj) { const f32x4 v0 = acc[ai][bj][m][0] * rs, v1 = acc[ai][bj][m][1] * rs;
                    u32x4 w; w.x = pk2(sigm(v0[0]), sigm(v0[1])); w.y = pk2(sigm(v0[2]), sigm(v0[3])); w.z = pk2(sigm(v1[0]), sigm(v1[1])); w.w = pk2(sigm(v1[2]), sigm(v1[3]));
                    *(u32x4*)(GT + (size_t)row * D + c0 + bj * 128) = w; } }
    }
};
struct EpiPle {
    static constexpr bool PERM = true;
    typedef PreNone Pre; static constexpr bool LBIAS = false;
    __device__ __forceinline__ void pre(const Unit&, int, int, PreNone&) const {}
    const bf16* X2B; const bf16* GT; float* O; float* rowss; unsigned* pcnt; const float* fg; const unsigned* ctl;
    __device__ __forceinline__ void operator()(f32x4 (&acc)[2][2][4][2], const Unit& u, int wr, int wc, int fr, int fq, const Pre& P) const {
        const int rowb = u.pm * 256 + wr * 64 + fr, c0 = u.pn * 256 + wc * 32 + 8 * fq;
#pragma unroll
        for (int ai = 0; ai < 2; ++ai)
#pragma unroll
            for (int m = 0; m < 4; ++m) { const int row = rowb + ai * 128 + m * 16; float ss = 0.f;
#pragma unroll
                for (int bj = 0; bj < 2; ++bj) { const size_t off = (size_t)row * D + c0 + bj * 128;
                    const u32x4 xv = *(const u32x4*)(X2B + off), gv = *(const u32x4*)(GT + off); f32x4 a0 = acc[ai][bj][m][0], a1 = acc[ai][bj][m][1];
                    a0[0] = bflo(xv.x) + bflo(gv.x) * a0[0]; a0[1] = bfhi(xv.x) + bfhi(gv.x) * a0[1]; a0[2] = bflo(xv.y) + bflo(gv.y) * a0[2]; a0[3] = bfhi(xv.y) + bfhi(gv.y) * a0[3];
                    a1[0] = bflo(xv.z) + bflo(gv.z) * a1[0]; a1[1] = bfhi(xv.z) + bfhi(gv.z) * a1[1]; a1[2] = bflo(xv.w) + bflo(gv.w) * a1[2]; a1[3] = bfhi(xv.w) + bfhi(gv.w) * a1[3];
#pragma unroll
                    for (int j = 0; j < 4; ++j) ss += a0[j] * a0[j] + a1[j] * a1[j];
                    acc[ai][bj][m][0] = a0; acc[ai][bj][m][1] = a1; }
                ss += __shfl_xor(ss, 16); ss += __shfl_xor(ss, 32);
                if (fq == 0) atomicAdd(rowss + row, ss);
                asm volatile("" ::: "memory"); }
        asm volatile("s_waitcnt vmcnt(0)" ::: "memory");
        __builtin_amdgcn_s_barrier();
        if (wr == 0 && wc == 0) {
            unsigned* pc = pcnt + 64 * u.pm;
            if (fr == 0 && fq == 0) __hip_atomic_fetch_add(pc, 1u, RLX_AGENT);
            unsigned spins = 0; while ((unsigned)__builtin_amdgcn_readfirstlane(__hip_atomic_load(pc, RLX_AGENT)) < 4u && ++spins < (1u << 20)) __builtin_amdgcn_s_sleep(4);
        }
        asm volatile("s_waitcnt vmcnt(0)" ::: "memory");
        __builtin_amdgcn_s_barrier();
        asm volatile("" ::: "memory");
#pragma unroll
        for (int ai = 0; ai < 2; ++ai)
#pragma unroll
            for (int m = 0; m < 4; ++m) { const int row = rowb + ai * 128 + m * 16; const float rs = 1.0f / sqrtf(__hip_atomic_load(rowss + row, RLX_AGENT) * (1.f / D) + RMS_EPS);
#pragma unroll
                for (int bj = 0; bj < 2; ++bj) { const size_t off = (size_t)row * D + c0 + bj * 128;
                    f32x4 o0 = acc[ai][bj][m][0] * rs * *(const f32x4*)(fg + c0 + bj * 128), o1 = acc[ai][bj][m][1] * rs * *(const f32x4*)(fg + c0 + bj * 128 + 4);
                    if (TS_PROBE >= 0 && row == 0 && c0 == 0 && bj == 0) { const unsigned long long* ts = (const unsigned long long*)(ctl + 2048); const unsigned long long dt = ts[TS_PROBE + 1] - ts[TS_PROBE]; o0[0] += (float)((dt + 300) / 1600) * 4.f; }
                    *(f32x4*)(O + off) = o0; *(f32x4*)(O + off + 4) = o1; }
                asm volatile("" ::: "memory"); }
    }
};

__device__ __forceinline__ void build_alora(const Args& args, Frame& F, int pm) {
    const bf16* ZR = WSP(bf16, WS_ZR); bf16* AL = WSP(bf16, WS_ALORA); const float* mu = FIN(4) + 1536;
#pragma unroll 1
    for (int half = 0; half < 2; ++half) {
        u32x4 zc[8], zp[8];
#pragma unroll
        for (int i = 0; i < 8; ++i) {
            const int id = F.tid + 512 * (8 * half + i), row = pm * 256 + (id >> 5), cc = (id & 31) * 8;
            zc[i] = *(const u32x4*)(ZR + (size_t)row * RWC + 1536 + cc);
            zp[i] = (u32x4){0u, 0u, 0u, 0u}; if ((row & (SEQ - 1)) != 0) zp[i] = *(const u32x4*)(ZR + (size_t)(row - 1) * RWC + 1536 + cc);
        }
#pragma unroll
        for (int i = 0; i < 8; ++i) {
            const int id = F.tid + 512 * (8 * half + i), row = pm * 256 + (id >> 5), cc = (id & 31) * 8;
            const unsigned zcw[4] = {zc[i].x, zc[i].y, zc[i].z, zc[i].w}, zpw[4] = {zp[i].x, zp[i].y, zp[i].z, zp[i].w}; float o[8];
#pragma unroll
            for (int j = 0; j < 8; ++j) { const float c = (j & 1) ? bfhi(zcw[j >> 1]) : bflo(zcw[j >> 1]), p = (j & 1) ? bfhi(zpw[j >> 1]) : bflo(zpw[j >> 1]);
                const float xs = c + mu[cc + j] * (p - c);
                o[j] = cc < 64 ? (1.f - 2.f * __builtin_amdgcn_rcpf(1.f + __expf(2.f * xs))) : (cc < 128 ? xs : sigm(xs)); }
            u32x4 w; w.x = pk2(o[0], o[1]); w.y = pk2(o[2], o[3]); w.z = pk2(o[4], o[5]); w.w = pk2(o[6], o[7]);
            *(u32x4*)(AL + (size_t)row * LORA_K + cc) = w;
        }
    }
}

__device__ __forceinline__ void scan_unit(const Args& args, Frame& F, int bh) {
    const int b = bh >> 3, h = bh & 7, tid = F.tid;
    LAS float* LW = (LAS float*)F.lds;
    LAS float* LKK = LW + 4096, *LBB = LW + 8192, *LKP = LW + 12288, *LRR = LW + 16384, *LVV = LW + 20480, *LYY = LW + 24576, *LBON = LW + 28672;
    const bf16* ZR = WSP(bf16, WS_ZR); const float* DEC = WSP(float, WS_DEC); const float* AA = WSP(float, WS_AA); const bf16* GG = WSP(bf16, WS_GG); bf16* YB = WSP(bf16, WS_YB);
    const float* mu = FIN(4); const float* k_k = FIN(10) + h * 64; const float* k_a = FIN(11) + h * 64; const float* r_k = FIN(12) + h * 64;
    const float* lnw = FIN(13) + h * 64; const float* lnb = FIN(14) + h * 64;
    const int tt_p = tid >> 3, j0 = 8 * (tid & 7);
    const int row = tid >> 3, cg = tid & 7;
    float S[8];
#pragma unroll
    for (int j = 0; j < 8; ++j) S[j] = 0.f;
    float mur[8], muk[8], muv[8], kk_c[8], ka_c[8], rk_c[8];
#pragma unroll
    for (int j = 0; j < 8; ++j) { mur[j] = mu[h * 64 + j0 + j]; muk[j] = mu[512 + h * 64 + j0 + j]; muv[j] = mu[1024 + h * 64 + j0 + j]; kk_c[j] = k_k[j0 + j]; ka_c[j] = k_a[j0 + j]; rk_c[j] = r_k[j0 + j]; }
    for (int c0 = 0; c0 < SEQ; c0 += 64) {
        __syncthreads();
        {
            const size_t tok = (size_t)b * SEQ + c0 + tt_p; const bool first = (c0 + tt_p) == 0;
            const bf16* zc = ZR + tok * RWC + h * 64 + j0; const bf16* zp = zc - RWC;
            u32x4 cr = *(const u32x4*)zc, ck = *(const u32x4*)(zc + 512), cv = *(const u32x4*)(zc + 1024);
            u32x4 pr = (u32x4){0u, 0u, 0u, 0u}, pk = pr, pv = pr;
            if (!first) { pr = *(const u32x4*)zp; pk = *(const u32x4*)(zp + 512); pv = *(const u32x4*)(zp + 1024); }
            const f32x4 d0 = *(const f32x4*)(DEC + tok * 512 + h * 64 + j0), d1 = *(const f32x4*)(DEC + tok * 512 + h * 64 + j0 + 4);
            const f32x4 a0 = *(const f32x4*)(AA + tok * 512 + h * 64 + j0), a1 = *(const f32x4*)(AA + tok * 512 + h * 64 + j0 + 4);
            const unsigned crw[4] = {cr.x, cr.y, cr.z, cr.w}, ckw[4] = {ck.x, ck.y, ck.z, ck.w}, cvw[4] = {cv.x, cv.y, cv.z, cv.w};
            const unsigned prw[4] = {pr.x, pr.y, pr.z, pr.w}, pkw[4] = {pk.x, pk.y, pk.z, pk.w}, pvw[4] = {pv.x, pv.y, pv.z, pv.w};
            float r[8], k[8], v[8], kk[8], a[8], dec[8]; float ss = 0.f;
#pragma unroll
            for (int j = 0; j < 8; ++j) {
                const float rc = (j & 1) ? bfhi(crw[j >> 1]) : bflo(crw[j >> 1]), rp = (j & 1) ? bfhi(prw[j >> 1]) : bflo(prw[j >> 1]);
                const float kc = (j & 1) ? bfhi(ckw[j >> 1]) : bflo(ckw[j >> 1]), kp = (j & 1) ? bfhi(pkw[j >> 1]) : bflo(pkw[j >> 1]);
                const float vc = (j & 1) ? bfhi(cvw[j >> 1]) : bflo(cvw[j >> 1]), vp = (j & 1) ? bfhi(pvw[j >> 1]) : bflo(pvw[j >> 1]);
                r[j] = rc + mur[j] * (rp - rc); k[j] = kc + muk[j] * (kp - kc); v[j] = vc + muv[j] * (vp - vc);
                kk[j] = k[j] * kk_c[j]; ss += kk[j] * kk[j];
                a[j] = j < 4 ? a0[j] : a1[j - 4]; dec[j] = j < 4 ? d0[j] : d1[j - 4];
            }
            ss = red8(ss);
            const float inv = 1.0f / fmaxf(sqrtf(ss), 1e-12f);
            float bon = 0.f; float kpv[8], bbv[8];
#pragma unroll
            for (int j = 0; j < 8; ++j) { kk[j] *= inv; bbv[j] = kk[j] * a[j]; kpv[j] = k[j] * (1.f + (a[j] - 1.f) * ka_c[j]); bon += r[j] * kpv[j] * rk_c[j]; }
            bon = red8(bon);
            const int o = tt_p * 64 + j0;
            *(LAS f32x4*)(LW + o) = (f32x4){dec[0], dec[1], dec[2], dec[3]}; *(LAS f32x4*)(LW + o + 4) = (f32x4){dec[4], dec[5], dec[6], dec[7]};
            *(LAS f32x4*)(LKK + o) = (f32x4){kk[0], kk[1], kk[2], kk[3]}; *(LAS f32x4*)(LKK + o + 4) = (f32x4){kk[4], kk[5], kk[6], kk[7]};
            *(LAS f32x4*)(LBB + o) = (f32x4){bbv[0], bbv[1], bbv[2], bbv[3]}; *(LAS f32x4*)(LBB + o + 4) = (f32x4){bbv[4], bbv[5], bbv[6], bbv[7]};
            *(LAS f32x4*)(LKP + o) = (f32x4){kpv[0], kpv[1], kpv[2], kpv[3]}; *(LAS f32x4*)(LKP + o + 4) = (f32x4){kpv[4], kpv[5], kpv[6], kpv[7]};
            *(LAS f32x4*)(LRR + o) = (f32x4){r[0], r[1], r[2], r[3]}; *(LAS f32x4*)(LRR + o + 4) = (f32x4){r[4], r[5], r[6], r[7]};
            *(LAS f32x4*)(LVV + o) = (f32x4){v[0], v[1], v[2], v[3]}; *(LAS f32x4*)(LVV + o + 4) = (f32x4){v[4], v[5], v[6], v[7]};
            if ((tid & 7) == 0) LBON[tt_p] = bon;
        }
        __syncthreads();
#pragma unroll 2
        for (int tt = 0; tt < 64; ++tt) {
            const int o = tt * 64 + 8 * cg;
            const f32x4 k0 = *(const LAS f32x4*)(LKK + o), k1 = *(const LAS f32x4*)(LKK + o + 4);
            const f32x4 w0 = *(const LAS f32x4*)(LW + o), w1 = *(const LAS f32x4*)(LW + o + 4);
            const f32x4 b0 = *(const LAS f32x4*)(LBB + o), b1 = *(const LAS f32x4*)(LBB + o + 4);
            const f32x4 p0 = *(const LAS f32x4*)(LKP + o), p1 = *(const LAS f32x4*)(LKP + o + 4);
            const f32x4 r0 = *(const LAS f32x4*)(LRR + o), r1 = *(const LAS f32x4*)(LRR + o + 4);
            const float vi = LVV[tt * 64 + row];
            float sa = (S[0] * k0[0] + S[1] * k0[1]) + (S[2] * k0[2] + S[3] * k0[3]) + (S[4] * k1[0] + S[5] * k1[1]) + (S[6] * k1[2] + S[7] * k1[3]);
            sa = -red8(sa);
#pragma unroll
            for (int j = 0; j < 4; ++j) { S[j] = S[j] * w0[j] + (sa * b0[j] + vi * p0[j]); S[4 + j] = S[4 + j] * w1[j] + (sa * b1[j] + vi * p1[j]); }
            float y = (S[0] * r0[0] + S[1] * r0[1]) + (S[2] * r0[2] + S[3] * r0[3]) + (S[4] * r1[0] + S[5] * r1[1]) + (S[6] * r1[2] + S[7] * r1[3]);
            y = red8(y);
            if (cg == 0) LYY[tt * 64 + row] = y;
        }
        __syncthreads();
        {
            const size_t tok = (size_t)b * SEQ + c0 + tt_p; const int o = tt_p * 64 + j0;
            const f32x4 y0 = *(const LAS f32x4*)(LYY + o), y1 = *(const LAS f32x4*)(LYY + o + 4);
            const f32x4 v0 = *(const LAS f32x4*)(LVV + o), v1 = *(const LAS f32x4*)(LVV + o + 4);
            float s = (y0[0] + y0[1]) + (y0[2] + y0[3]) + (y1[0] + y1[1]) + (y1[2] + y1[3]);
            const float mean = red8(s) * (1.f / 64.f); float q = 0.f;
#pragma unroll
            for (int j = 0; j < 4; ++j) { const float d0 = y0[j] - mean, d1 = y1[j] - mean; q += d0 * d0 + d1 * d1; }
            const float rs = 1.0f / sqrtf(red8(q) * (1.f / 64.f) + GN_EPS); const float bon = LBON[tt_p];
            const u32x4 gv = *(const u32x4*)(GG + tok * 512 + h * 64 + j0); const unsigned gw[4] = {gv.x, gv.y, gv.z, gv.w}; float ov[8];
#pragma unroll
            for (int j = 0; j < 8; ++j) { const float yy = j < 4 ? y0[j] : y1[j - 4], vv = j < 4 ? v0[j] : v1[j - 4]; const float g = (j & 1) ? bfhi(gw[j >> 1]) : bflo(gw[j >> 1]);
                ov[j] = ((yy - mean) * rs * lnw[j0 + j] + lnb[j0 + j] + bon * vv) * g; }
            u32x4 w; w.x = pk2(ov[0], ov[1]); w.y = pk2(ov[2], ov[3]); w.z = pk2(ov[4], ov[5]); w.w = pk2(ov[6], ov[7]);
            *(u32x4*)(YB + tok * 512 + h * 64 + j0) = w;
        }
    }
    __syncthreads();
}

constexpr int LDA = 72, LDT = 40, LDF = 36;
constexpr int SC_WF = 0, SC_AT = 8192, SC_RT = SC_AT + 4608, SC_BT = SC_RT + 4608, SC_KT = SC_BT + 4608;
constexpr int SC_BCT = SC_KT + 4608, SC_KCT = SC_BCT + 5120, SC_VT = SC_KCT + 5120, SC_AHT = SC_VT + 5120, SC_UHT = SC_AHT + 5120;
constexpr int SC_AAB = SC_UHT + 5120, SC_ARB = SC_AAB + 4608, SC_ARK = SC_ARB + 2560, SC_RHS2 = SC_ARK + 2560, SC_YF = SC_RHS2 + 16384, SC_HT = SC_YF + 8192, SC_BON = SC_HT + 9216;
static_assert(SC_BON + 128 + 2048 <= RING_BYTES, "scan LDS map");
__device__ __forceinline__ float red16(float v) { v += dppf<0xB1>(v); v += dppf<0x4E>(v); v += dppf<0x141>(v); v += dppf<0x140>(v); return v; }
__device__ __forceinline__ bf16x8 ld16(const LAS bf16* p) { return *(const LAS bf16x8*)p; }
__device__ __forceinline__ bf16x8 ld8x2(const LAS bf16* p) { const u32x2 lo = *(const LAS u32x2*)p, hi = *(const LAS u32x2*)(p + 8); const u32x4 w = (u32x4){lo.x, lo.y, hi.x, hi.y}; return __builtin_bit_cast(bf16x8, w); }
__device__ __forceinline__ bf16x8 packq(const f32x16& x, int q) { u32x4 w; w.x = pk2(x[8 * q], x[8 * q + 1]); w.y = pk2(x[8 * q + 2], x[8 * q + 3]); w.z = pk2(x[8 * q + 4], x[8 * q + 5]); w.w = pk2(x[8 * q + 6], x[8 * q + 7]); return __builtin_bit_cast(bf16x8, w); }
#define MFMA32(a, b, c) __builtin_amdgcn_mfma_f32_32x32x16_bf16((a), (b), (c), 0, 0, 0)
struct ScanLoad { u32x2 cr, ck, cv, pr, pk, pv, g; f32x4 dec, eta; };
__device__ __forceinline__ void scan_load(ScanLoad& L, const bf16* ZR, const float* DEC, const float* AA, const bf16* GG, size_t tok, int hc, bool first) {
    const bf16* zc = ZR + tok * RWC + hc; const bf16* zp = zc - RWC;
    L.cr = *(const u32x2*)zc; L.ck = *(const u32x2*)(zc + 512); L.cv = *(const u32x2*)(zc + 1024);
    L.pr = (u32x2){0u, 0u}; L.pk = L.pr; L.pv = L.pr;
    if (!first) { L.pr = *(const u32x2*)zp; L.pk = *(const u32x2*)(zp + 512); L.pv = *(const u32x2*)(zp + 1024); }
    L.dec = *(const f32x4*)(DEC + tok * 512 + hc); L.eta = *(const f32x4*)(AA + tok * 512 + hc); L.g = *(const u32x2*)(GG + tok * 512 + hc);
}
#define LBAR() do { asm volatile("s_waitcnt lgkmcnt(0)" ::: "memory"); __builtin_amdgcn_s_barrier(); asm volatile("" ::: "memory"); } while (0)
typedef short v4i16_t __attribute__((ext_vector_type(4)));
__device__ __forceinline__ bf16x8 trfrag(const LAS bf16* X, int k0a, int k0b, int cbase, int lane) {
    const int g = lane >> 4, i = lane & 15, col = cbase + 16 * (g & 1) + 4 * (i & 3), rq = i >> 2;
    const v4i16_t lo = __builtin_amdgcn_ds_read_tr16_b64_v4i16((LAS v4i16_t*)(X + (k0a + rq) * LDA + col));
    const v4i16_t hi = __builtin_amdgcn_ds_read_tr16_b64_v4i16((LAS v4i16_t*)(X + (k0b + rq) * LDA + col));
    return (bf16x8){lo[0], lo[1], lo[2], lo[3], hi[0], hi[1], hi[2], hi[3]};
}
__device__ __forceinline__ void scan_unit_chunked(const Args& args, Frame& F, int bh) {
    const int b = bh >> 3, h = bh & 7, tid = F.tid, w = F.wave;
    LAS unsigned char* L = F.lds;
    LAS float* WF = (LAS float*)(L + SC_WF); LAS float* AAB = (LAS float*)(L + SC_AAB); LAS float* RHS2 = (LAS float*)(L + SC_RHS2); LAS float* YF = (LAS float*)(L + SC_YF); LAS float* BON = (LAS float*)(L + SC_BON);
    LAS bf16* AT = (LAS bf16*)(L + SC_AT); LAS bf16* RT = (LAS bf16*)(L + SC_RT); LAS bf16* BT = (LAS bf16*)(L + SC_BT); LAS bf16* KT = (LAS bf16*)(L + SC_KT);
    LAS bf16* BCT = (LAS bf16*)(L + SC_BCT); LAS bf16* KCT = (LAS bf16*)(L + SC_KCT); LAS bf16* VT = (LAS bf16*)(L + SC_VT); LAS bf16* AHT = (LAS bf16*)(L + SC_AHT); LAS bf16* UHT = (LAS bf16*)(L + SC_UHT);
    LAS bf16* ARB = (LAS bf16*)(L + SC_ARB); LAS bf16* ARK = (LAS bf16*)(L + SC_ARK); LAS bf16* HT = (LAS bf16*)(L + SC_HT);
    const bf16* ZR = WSP(bf16, WS_ZR); const float* DEC = WSP(float, WS_DEC); const float* AA = WSP(float, WS_AA); const bf16* GG = WSP(bf16, WS_GG); bf16* YB = WSP(bf16, WS_YB);
    const int t = tid >> 4, j0 = 4 * (tid & 15), hc = h * 64 + j0;
    LAS float* CST = (LAS float*)(L + SC_BON + 128);
    { const int c = tid >> 6, j = tid & 63; const float* src = c == 0 ? FIN(4) : c == 1 ? FIN(4) + 512 : c == 2 ? FIN(4) + 1024 : c == 3 ? FIN(10) : c == 4 ? FIN(11) : c == 5 ? FIN(12) : c == 6 ? FIN(13) : FIN(14);
      CST[c * 64 + j] = src[h * 64 + j]; }
    for (int i = tid; i < 64 * LDA / 2; i += 512) ((LAS unsigned*)HT)[i] = 0u;
    ScanLoad cur; scan_load(cur, ZR, DEC, AA, GG, (size_t)b * SEQ + t, hc, t == 0);
    LBAR();
    u32x2 pend = (u32x2){0u, 0u};
    for (int c0 = 0; c0 < SEQ; c0 += 32) {
        const size_t tok = (size_t)b * SEQ + c0 + t;
        float r[4], kp[4], v[4], al[4], be[4], gq[4]; f32x4 gl, gpl;
        {
            const f32x4 mur = *(const LAS f32x4*)(CST + j0), muk = *(const LAS f32x4*)(CST + 64 + j0), muv = *(const LAS f32x4*)(CST + 128 + j0), kkc = *(const LAS f32x4*)(CST + 192 + j0), kac = *(const LAS f32x4*)(CST + 256 + j0), rkc = *(const LAS f32x4*)(CST + 320 + j0);
            const unsigned crw[2] = {cur.cr.x, cur.cr.y}, ckw[2] = {cur.ck.x, cur.ck.y}, cvw[2] = {cur.cv.x, cur.cv.y}, prw[2] = {cur.pr.x, cur.pr.y}, pkw[2] = {cur.pk.x, cur.pk.y}, pvw[2] = {cur.pv.x, cur.pv.y}, gw2[2] = {cur.g.x, cur.g.y};
            float k[4], kk[4]; float ss = 0.f;
#pragma unroll
            for (int j = 0; j < 4; ++j) {
                const float rc = (j & 1) ? bfhi(crw[j >> 1]) : bflo(crw[j >> 1]), rp = (j & 1) ? bfhi(prw[j >> 1]) : bflo(prw[j >> 1]);
                const float kc = (j & 1) ? bfhi(ckw[j >> 1]) : bflo(ckw[j >> 1]), kq = (j & 1) ? bfhi(pkw[j >> 1]) : bflo(pkw[j >> 1]);
                const float vc = (j & 1) ? bfhi(cvw[j >> 1]) : bflo(cvw[j >> 1]), vq = (j & 1) ? bfhi(pvw[j >> 1]) : bflo(pvw[j >> 1]);
                r[j] = rc + mur[j] * (rp - rc); k[j] = kc + muk[j] * (kq - kc); v[j] = vc + muv[j] * (vq - vc);
                kk[j] = k[j] * kkc[j]; ss += kk[j] * kk[j]; gq[j] = (j & 1) ? bfhi(gw2[j >> 1]) : bflo(gw2[j >> 1]);
            }
            ss = red16(ss);
            const float inv = __builtin_amdgcn_rsqf(fmaxf(ss, 1e-24f)); float bon = 0.f;
#pragma unroll
            for (int j = 0; j < 4; ++j) { kk[j] *= inv; al[j] = -kk[j]; be[j] = kk[j] * cur.eta[j]; kp[j] = k[j] * (1.f + (cur.eta[j] - 1.f) * kac[j]); bon += r[j] * kp[j] * rkc[j]; }
            bon = red16(bon);
            gl = cur.dec; gpl = (f32x4){1.f, 1.f, 1.f, 1.f};
            { const int ln = tid & 63;
#pragma unroll
              for (int j = 0; j < 4; ++j) { const float u1 = __shfl_up(gl[j], 16); gl[j] = (ln >= 16) ? gl[j] * u1 : gl[j]; }
#pragma unroll
              for (int j = 0; j < 4; ++j) { const float u2 = __shfl_up(gl[j], 32); gl[j] = (ln >= 32) ? gl[j] * u2 : gl[j]; }
#pragma unroll
              for (int j = 0; j < 4; ++j) { const float u3 = __shfl_up(gl[j], 16); gpl[j] = (ln >= 16) ? u3 : 1.f; }
              if (ln >= 48) *(LAS f32x4*)(WF + w * 64 + j0) = gl; }
            if ((tid & 15) == 0) BON[t] = bon;
        }
        if (c0 + 32 < SEQ && !(SCAN_STUB & 32)) scan_load(cur, ZR, DEC, AA, GG, tok + 32, hc, false);
        if (c0 > 0) { const bf16* yp = YB + (tok - 32) * 512 + hc; asm volatile("global_store_dwordx2 %0, %1, off" :: "v"(yp), "v"(pend) : "memory"); }
        LBAR();
        {
            f32x4 pre = (f32x4){1.f, 1.f, 1.f, 1.f}, gC = pre;
#pragma unroll
            for (int ww = 0; ww < 8; ++ww) { const f32x4 wt = *(const LAS f32x4*)(WF + ww * 64 + j0); gC = gC * wt; if (ww < w) pre = pre * wt; }
            const f32x4 gt = pre * gl, gp = pre * gpl;
            if (t == 31) *(LAS f32x4*)(WF + 512 + j0) = gC;
            float a_[4], r_[4], b_[4], k_[4], bc[4], kc[4];
#pragma unroll
            for (int j = 0; j < 4; ++j) { const float ig = __builtin_amdgcn_rcpf(gt[j]); a_[j] = al[j] * gp[j]; r_[j] = r[j] * gt[j]; b_[j] = be[j] * ig; k_[j] = kp[j] * ig; bc[j] = b_[j] * gC[j]; kc[j] = k_[j] * gC[j]; }
            u32x2 wv; wv.x = pk2(a_[0], a_[1]); wv.y = pk2(a_[2], a_[3]); *(LAS u32x2*)(AT + t * LDA + j0) = wv;
            wv.x = pk2(r_[0], r_[1]); wv.y = pk2(r_[2], r_[3]); *(LAS u32x2*)(RT + t * LDA + j0) = wv;
            wv.x = pk2(b_[0], b_[1]); wv.y = pk2(b_[2], b_[3]); *(LAS u32x2*)(BT + t * LDA + j0) = wv;
            wv.x = pk2(k_[0], k_[1]); wv.y = pk2(k_[2], k_[3]); *(LAS u32x2*)(KT + t * LDA + j0) = wv;
            wv.x = pk2(bc[0], bc[1]); wv.y = pk2(bc[2], bc[3]); *(LAS u32x2*)(BCT + t * LDA + j0) = wv;
            wv.x = pk2(kc[0], kc[1]); wv.y = pk2(kc[2], kc[3]); *(LAS u32x2*)(KCT + t * LDA + j0) = wv;
            wv.x = pk2(v[0], v[1]); wv.y = pk2(v[2], v[3]); *(LAS u32x2*)(VT + t * LDA + j0) = wv;
        }
        LBAR();
        if (w < 4 && !(SCAN_STUB & 1)) {
            const int lane = lane_now(), r32 = lane & 31, hh = lane >> 5;
            f32x16 mT, mN;
#pragma unroll
            for (int i = 0; i < 16; ++i) { mT[i] = 0.f; mN[i] = 0.f; }
#pragma unroll
            for (int q = 0; q < 4; ++q) { const bf16x8 bfr = ld16(BT + r32 * LDA + 8 * hh + 16 * q), afr = ld16(AT + r32 * LDA + 8 * hh + 16 * q);
                mT = MFMA32(bfr, afr, mT);
                mN = MFMA32(afr, bfr, mN); }
#pragma unroll
            for (int i = 0; i < 16; ++i) { const int c_ = crow(i, hh); mT[i] = (c_ < r32) ? mT[i] : 0.f; mN[i] = (r32 < c_) ? mN[i] : 0.f; }
            f32x16 X;
            if (w < 2) {
#pragma unroll
                for (int i = 0; i < 16; ++i) X[i] = bflo((unsigned)AT[crow(i, hh) * LDA + 32 * w + r32]);
            } else {
                f32x16 kT;
#pragma unroll
                for (int i = 0; i < 16; ++i) { kT[i] = 0.f; X[i] = 0.f; }
#pragma unroll
                for (int q = 0; q < 4; ++q) kT = MFMA32(ld16(KT + r32 * LDA + 8 * hh + 16 * q), ld16(AT + r32 * LDA + 8 * hh + 16 * q), kT);
#pragma unroll
                for (int i = 0; i < 16; ++i) kT[i] = (crow(i, hh) < r32) ? kT[i] : 0.f;
#pragma unroll
                for (int q = 0; q < 2; ++q) X = MFMA32(packq(kT, q), trfrag(VT, 16 * q + 4 * hh, 16 * q + 8 + 4 * hh, 32 * (w - 2), lane), X);
            }
#pragma unroll
            for (int k = 0; k < 5; ++k) {
                const bf16x8 t0 = packq(mT, 0), t1 = packq(mT, 1), x0 = packq(X, 0), x1 = packq(X, 1);
                X = MFMA32(t0, x0, X); X = MFMA32(t1, x1, X);
                if (k < 4) {
                    const bf16x8 n0 = packq(mN, 0), n1 = packq(mN, 1);
                    f32x16 zT, zN;
#pragma unroll
                    for (int i = 0; i < 16; ++i) { zT[i] = 0.f; zN[i] = 0.f; }
                    zT = MFMA32(n0, t0, zT); zT = MFMA32(n1, t1, zT);
                    zN = MFMA32(t0, n0, zN); zN = MFMA32(t1, n1, zN);
                    mT = zT; mN = zN;
                }
            }
            LAS bf16* dst = ((w < 2) ? AHT : UHT) + (32 * (w & 1) + r32) * LDT + 4 * hh;
#pragma unroll
            for (int i4 = 0; i4 < 4; ++i4) { u32x2 wv; wv.x = pk2(X[4 * i4], X[4 * i4 + 1]); wv.y = pk2(X[4 * i4 + 2], X[4 * i4 + 3]); *(LAS u32x2*)(dst + 8 * i4) = wv; }
        } else if (w < 6 && !(SCAN_STUB & 1)) {
            const int lane = lane_now(), r32 = lane & 31, hh = lane >> 5;
            const LAS bf16* Aop = ((w & 1) ? KT : BT) + r32 * LDA + 8 * hh; const LAS bf16* Bop = RT + r32 * LDA + 8 * hh;
            f32x16 x;
#pragma unroll
            for (int i = 0; i < 16; ++i) x[i] = 0.f;
#pragma unroll
            for (int q = 0; q < 4; ++q) x = MFMA32(ld16(Aop + 16 * q), ld16(Bop + 16 * q), x);
#pragma unroll
            for (int i = 0; i < 16; ++i) x[i] = (crow(i, hh) <= r32) ? x[i] : 0.f;
            LAS bf16* dst = ((w & 1) ? ARK : ARB) + r32 * LDT + 4 * hh;
#pragma unroll
            for (int i4 = 0; i4 < 4; ++i4) { u32x2 wv; wv.x = pk2(x[4 * i4], x[4 * i4 + 1]); wv.y = pk2(x[4 * i4 + 2], x[4 * i4 + 3]); *(LAS u32x2*)(dst + 8 * i4) = wv; }
        }
        LBAR();
        f32x16 hn;
        if (SCAN_STUB & 4) { for (int i = 0; i < 16; ++i) hn[i] = 0.f; } else if (w < 4) {
            const int lane = lane_now(), r32 = lane & 31, hh = lane >> 5;
            const int jb = w >> 1, ib = w & 1;
            f32x16 pt[2];
#pragma unroll
            for (int a = 0; a < 2; ++a) {
#pragma unroll
                for (int i = 0; i < 16; ++i) pt[a][i] = 0.f;
#pragma unroll
                for (int q = 0; q < 2; ++q) pt[a] = MFMA32(ld16(AHT + (32 * a + r32) * LDT + 16 * q + 8 * hh), trfrag(BCT, 16 * q + 8 * hh, 16 * q + 8 * hh + 4, 32 * jb, lane), pt[a]);
            }
            { const float gC = WF[512 + 32 * jb + r32];
#pragma unroll
              for (int i = 0; i < 16; ++i) { const float add = (crow(i, hh) == r32) ? gC : 0.f; pt[0][i] += (jb == 0) ? add : 0.f; pt[1][i] += (jb == 0) ? 0.f : add; } }
#pragma unroll
            for (int i = 0; i < 16; ++i) hn[i] = 0.f;
#pragma unroll
            for (int q = 0; q < 2; ++q) {
                hn = MFMA32(trfrag(BCT, 16 * q + 8 * hh, 16 * q + 8 * hh + 4, 32 * jb, lane), ld16(UHT + (32 * ib + r32) * LDT + 16 * q + 8 * hh), hn);
                hn = MFMA32(trfrag(KCT, 16 * q + 8 * hh, 16 * q + 8 * hh + 4, 32 * jb, lane), trfrag(VT, 16 * q + 8 * hh, 16 * q + 8 * hh + 4, 32 * ib, lane), hn);
            }
#pragma unroll
            for (int a = 0; a < 2; ++a)
#pragma unroll
                for (int q = 0; q < 2; ++q) hn = MFMA32(packq(pt[a], q), ld8x2(HT + (32 * ib + r32) * LDA + 32 * a + 16 * q + 4 * hh), hn);
        } else if (w < 6) {
            const int lane = lane_now(), r32 = lane & 31, hh = lane >> 5;
            const int ib = w & 1;
            f32x16 rt[2];
#pragma unroll
            for (int a = 0; a < 2; ++a) {
#pragma unroll
                for (int i = 0; i < 16; ++i) rt[a][i] = bflo((unsigned)RT[r32 * LDA + 32 * a + crow(i, hh)]);
#pragma unroll
                for (int q = 0; q < 2; ++q) rt[a] = MFMA32(ld16(AHT + (32 * a + r32) * LDT + 16 * q + 8 * hh), ld16(ARB + r32 * LDT + 16 * q + 8 * hh), rt[a]);
            }
            f32x16 y;
#pragma unroll
            for (int i = 0; i < 16; ++i) y[i] = 0.f;
#pragma unroll
            for (int q = 0; q < 2; ++q) {
                y = MFMA32(ld16(ARB + r32 * LDT + 16 * q + 8 * hh), ld16(UHT + (32 * ib + r32) * LDT + 16 * q + 8 * hh), y);
                y = MFMA32(ld16(ARK + r32 * LDT + 16 * q + 8 * hh), trfrag(VT, 16 * q + 8 * hh, 16 * q + 8 * hh + 4, 32 * ib, lane), y);
            }
#pragma unroll
            for (int a = 0; a < 2; ++a)
#pragma unroll
                for (int q = 0; q < 2; ++q) y = MFMA32(packq(rt[a], q), ld8x2(HT + (32 * ib + r32) * LDA + 32 * a + 16 * q + 4 * hh), y);
#pragma unroll
            for (int i = 0; i < 16; ++i) YF[crow(i, hh) * 64 + 32 * ib + r32] = y[i];
        }
        LBAR();
        if (w < 4) {
            const int lane = lane_now(), r32 = lane & 31, hh = lane >> 5;
            const int jb = w >> 1, ib = w & 1; LAS bf16* dst = HT + (32 * ib + r32) * LDA + 32 * jb + 4 * hh;
#pragma unroll
            for (int i4 = 0; i4 < 4; ++i4) { u32x2 wv; wv.x = pk2(hn[4 * i4], hn[4 * i4 + 1]); wv.y = pk2(hn[4 * i4 + 2], hn[4 * i4 + 3]); *(LAS u32x2*)(dst + 8 * i4) = wv; }
        }
        {
            const f32x4 y4 = *(const LAS f32x4*)(YF + t * 64 + j0);
            const float mean = red16((y4[0] + y4[1]) + (y4[2] + y4[3])) * (1.f / 64.f); float qv = 0.f;
#pragma unroll
            for (int j = 0; j < 4; ++j) { const float d = y4[j] - mean; qv += d * d; }
            const float rs = __builtin_amdgcn_rsqf(red16(qv) * (1.f / 64.f) + GN_EPS); const float bon = BON[t]; float ov[4];
            const f32x4 lnw = *(const LAS f32x4*)(CST + 384 + j0), lnb = *(const LAS f32x4*)(CST + 448 + j0);
#pragma unroll
            for (int j = 0; j < 4; ++j) ov[j] = ((y4[j] - mean) * rs * lnw[j] + lnb[j] + bon * v[j]) * gq[j];
            pend.x = pk2(ov[0], ov[1]); pend.y = pk2(ov[2], ov[3]);
        }
    }
    *(u32x2*)(YB + ((size_t)b * SEQ + SEQ - 32 + t) * 512 + hc) = pend;
}

__device__ __forceinline__ bool attn_step(const bf16x8 (&qf)[4], const bf16x8 (&kf)[4], const u32x2 (&vlo)[2][2], const u32x2 (&vhi)[2][2], f32x16& y0, f32x16& y1, float& carry, int s0, int t0, int q, int hi) {
    f32x16 p;
#pragma unroll
    for (int r = 0; r < 16; ++r) p[r] = 0.f;
#pragma unroll
    for (int d0 = 0; d0 < 4; ++d0) p = __builtin_amdgcn_mfma_f32_32x32x16_bf16(kf[d0], qf[d0], p, 0, 0, 0);
    float om[16], be[16];
#pragma unroll
    for (int r = 0; r < 16; ++r) {
        const int kv = crow(r, hi); const bool valid = (s0 + kv) < (t0 + q);
        const float z = fminf(p[r], 80.f); const float t = __expf(z); const float o = __builtin_amdgcn_rcpf(1.f + t);
        om[r] = valid ? o : 1.f; be[r] = valid ? t * o : 0.f;
    }
    float el[16], G[4], PG[4];
#pragma unroll
    for (int i = 0; i < 4; ++i) { el[4 * i + 3] = 1.f; el[4 * i + 2] = om[4 * i + 3]; el[4 * i + 1] = el[4 * i + 2] * om[4 * i + 2]; el[4 * i] = el[4 * i + 1] * om[4 * i + 1]; G[i] = el[4 * i] * om[4 * i]; }
#pragma unroll
    for (int i = 0; i < 4; ++i) PG[i] = __shfl_xor(G[i], 32);
    float sG[4], sP[4];
    sG[3] = 1.f; sG[2] = G[3]; sG[1] = G[3] * G[2]; sG[0] = sG[1] * G[1];
    sP[3] = 1.f; sP[2] = PG[3]; sP[1] = PG[3] * PG[2]; sP[0] = sP[1] * PG[1];
    const float total = (sG[0] * G[0]) * (sP[0] * PG[0]);
    float A[16];
#pragma unroll
    for (int i = 0; i < 4; ++i) { const float eg = sG[i] * (hi ? sP[i] : sP[i] * PG[i]) * carry;
#pragma unroll
        for (int j = 0; j < 4; ++j) A[4 * i + j] = be[4 * i + j] * el[4 * i + j] * eg; }
    carry *= total;
    bf16x8 pf[2];
#pragma unroll
    for (int s = 0; s < 2; ++s) { u32x4 w; w.x = pk2(A[8 * s], A[8 * s + 1]); w.y = pk2(A[8 * s + 2], A[8 * s + 3]); w.z = pk2(A[8 * s + 4], A[8 * s + 5]); w.w = pk2(A[8 * s + 6], A[8 * s + 7]); pf[s] = __builtin_bit_cast(bf16x8, w); }
#pragma unroll
    for (int s = 0; s < 2; ++s) {
        const u32x4 a0 = (u32x4){vlo[0][s].x, vlo[0][s].y, vhi[0][s].x, vhi[0][s].y}, a1 = (u32x4){vlo[1][s].x, vlo[1][s].y, vhi[1][s].x, vhi[1][s].y};
        y0 = __builtin_amdgcn_mfma_f32_32x32x16_bf16(__builtin_bit_cast(bf16x8, a0), pf[s], y0, 0, 0, 0);
        y1 = __builtin_amdgcn_mfma_f32_32x32x16_bf16(__builtin_bit_cast(bf16x8, a1), pf[s], y1, 0, 0, 0);
    }
    return __all(carry < 5.6e-14f);
}
__device__ __forceinline__ void attn_tile(Frame& F, int bh, int qt) {
    const int lane = F.lane, q = lane & 31, hi = lane >> 5, b = bh >> 3, h = bh & 7, t0 = 32 * qt;
    const size_t tokbase = (size_t)b * SEQ;
    const bf16* QB = WSP(bf16, WS_Q); const bf16* KB = WSP(bf16, WS_K); const bf16* VT = WSP(bf16, WS_VT); bf16* YA = WSP(bf16, WS_YA);
    bf16x8 qf[4];
    { const bf16* Qp = QB + (tokbase + t0 + q) * 512 + h * 64 + 8 * hi;
#pragma unroll
      for (int d0 = 0; d0 < 4; ++d0) qf[d0] = *(const bf16x8*)(Qp + 16 * d0); }
    f32x16 y0, y1;
#pragma unroll
    for (int r = 0; r < 16; ++r) { y0[r] = 0.f; y1[r] = 0.f; }
    float carry = 1.f;
    const bf16* Vrow = VT + (size_t)bh * 128 * 1024 + q * 16 + 4 * hi;
    bf16x8 kA[4], kB[4]; u32x2 vloA[2][2], vhiA[2][2], vloB[2][2], vhiB[2][2];
#define ATT_LOAD(KF, VLO, VHI, S0) do { const bf16* Kp_ = KB + (tokbase + (S0) + q) * 512 + h * 64 + 8 * hi; \
        _Pragma("unroll") for (int d0 = 0; d0 < 4; ++d0) KF[d0] = *(const bf16x8*)(Kp_ + 16 * d0); \
        _Pragma("unroll") for (int dt = 0; dt < 2; ++dt) _Pragma("unroll") for (int s_ = 0; s_ < 2; ++s_) { const bf16* vp_ = Vrow + (size_t)(((S0) >> 4) + s_) * 1024 + dt * 512; VLO[dt][s_] = *(const u32x2*)vp_; VHI[dt][s_] = *(const u32x2*)(vp_ + 8); } } while (0)
    ATT_LOAD(kA, vloA, vhiA, t0);
    for (int s0 = t0; ; ) {
        { const int sn = s0 >= 32 ? s0 - 32 : 0; ATT_LOAD(kB, vloB, vhiB, sn); __builtin_amdgcn_sched_barrier(0); }
        if (attn_step(qf, kA, vloA, vhiA, y0, y1, carry, s0, t0, q, hi)) break;
        s0 -= 32; if (s0 < 0) break;
        { const int sn = s0 >= 32 ? s0 - 32 : 0; ATT_LOAD(kA, vloA, vhiA, sn); __builtin_amdgcn_sched_barrier(0); }
        if (attn_step(qf, kB, vloB, vhiB, y0, y1, carry, s0, t0, q, hi)) break;
        s0 -= 32; if (s0 < 0) break;
    }
#undef ATT_LOAD
    bf16* Yp = YA + (tokbase + t0 + q) * 512 + h * 64 + 4 * hi;
#pragma unroll
    for (int i = 0; i < 4; ++i) {
        u32x2 w0, w1; w0.x = pk2(y0[4 * i], y0[4 * i + 1]); w0.y = pk2(y0[4 * i + 2], y0[4 * i + 3]); w1.x = pk2(y1[4 * i], y1[4 * i + 1]); w1.y = pk2(y1[4 * i + 2], y1[4 * i + 3]);
        *(u32x2*)(Yp + 8 * i) = w0; *(u32x2*)(Yp + 32 + 8 * i) = w1;
    }
}

__device__ __forceinline__ void p5a_router(const Args& args, Frame& F) {
    LAS float* LG = (LAS float*)F.lds;
    LAS unsigned* HIST = (LAS unsigned*)(F.lds + 32768); LAS unsigned* BASE = HIST + 32;
    const float* X1 = WSP(float, WS_X1); const float* GW = WSP(float, WS_GW); const float* rb = FIN(20);
    unsigned* cnt = F.ctl + CW_CNT; int* LIST = WSP(int, WS_LIST); float* LRS = WSP(float, WS_LRS); float* LGT = WSP(float, WS_LGT);
    const int tid = F.tid, lane = F.lane, wave = F.wave;
    for (int tb = blockIdx.x; tb < M / 128; tb += F.G) {
        if (tid < 32) HIST[tid] = 0u;
        __syncthreads();
        int ex[4] = {0, 0, 0, 0}; float gt[4] = {0.f, 0.f, 0.f, 0.f}; unsigned lr[4] = {0u, 0u, 0u, 0u}; int tok = 0; float rstd_keep = 0.f;
        if (wave < 4) {
            const int i = lane & 31, kh = lane >> 5; tok = tb * 128 + wave * 32 + i;
            const float* xr = X1 + (size_t)tok * D + 4 * kh;
            f32x16 acc;
#pragma unroll
            for (int r = 0; r < 16; ++r) acc[r] = 0.f;
            float ss = 0.f;
#pragma unroll 4
            for (int u = 0; u < 128; ++u) {
                const f32x4 a = *(const f32x4*)(xr + 8 * u); ss += (a[0] * a[0] + a[1] * a[1]) + (a[2] * a[2] + a[3] * a[3]);
                const float* gp = GW + (size_t)(8 * u + 4 * kh) * 32 + i;
#pragma unroll
                for (int j = 0; j < 4; ++j) acc = __builtin_amdgcn_mfma_f32_32x32x2f32(a[j], gp[32 * j], acc, 0, 0, 0);
            }
            ss += __shfl_xor(ss, 32);
            const float rstd = 1.0f / sqrtf(ss * (1.f / D) + RMS_EPS);
            rstd_keep = rstd;
            LAS float* L = LG + wave * (32 * 33);
#pragma unroll
            for (int r = 0; r < 16; ++r) L[crow(r, kh) * 33 + i] = acc[r];
            asm volatile("s_waitcnt lgkmcnt(0)" ::: "memory");
            if (kh == 0) {
                float v0 = -3.0e38f, v1 = -3.0e38f, v2 = -3.0e38f, v3 = -3.0e38f; int i0 = 0, i1 = 0, i2 = 0, i3 = 0;
                for (int e = 0; e < 32; ++e) { const float v = L[i * 33 + e] * rstd + rb[e];
                    if (v > v3) { if (v > v2) { v3 = v2; i3 = i2; if (v > v1) { v2 = v1; i2 = i1; if (v > v0) { v1 = v0; i1 = i0; v0 = v; i0 = e; } else { v1 = v; i1 = e; } } else { v2 = v; i2 = e; } } else { v3 = v; i3 = e; } } }
                const float e1 = __expf(v1 - v0), e2 = __expf(v2 - v0), e3 = __expf(v3 - v0), inv = 1.0f / (1.f + e1 + e2 + e3);
                ex[0] = i0; ex[1] = i1; ex[2] = i2; ex[3] = i3; gt[0] = inv; gt[1] = e1 * inv; gt[2] = e2 * inv; gt[3] = e3 * inv;
#pragma unroll
                for (int k = 0; k < 4; ++k) lr[k] = __hip_atomic_fetch_add(&HIST[ex[k]], 1u, __ATOMIC_RELAXED, __HIP_MEMORY_SCOPE_WORKGROUP);
            }
        }
        __syncthreads();
        if (tid < 32) BASE[tid] = __hip_atomic_fetch_add(cnt + tid, HIST[tid], RLX_AGENT);
        __syncthreads();
        if (wave < 4 && lane < 32) {
#pragma unroll
            for (int k = 0; k < 4; ++k) { const unsigned pos = BASE[ex[k]] + lr[k]; const size_t li = (size_t)ex[k] * CAP + pos; LIST[li] = tok * 4 + k; LRS[li] = rstd_keep; LGT[li] = gt[k]; }
        }
        __syncthreads();
    }
}
__device__ __forceinline__ int moe_tables(Frame& F) {
    LAS int* CS = (LAS int*)(F.lds + MOE_OFF); LAS int* OFF = CS + 32; LAS unsigned char* TE = F.lds + MOE_TE;
    if (F.tid < 32) { int c = (int)__hip_atomic_load(F.ctl + CW_CNT + F.tid, RLX_AGENT); CS[F.tid] = c > CAP ? CAP : c; }
    __syncthreads();
    if (F.tid == 0) { int off = 0; for (int e = 0; e < 32; ++e) { OFF[e] = off; off += ((CS[e] + 255) >> 8) << 8; } OFF[32] = off; }
    __syncthreads();
    const int ntiles = OFF[32] >> 8;
    for (int t = F.tid; t < ntiles; t += 512) { int e = 0; while (e < 31 && OFF[e + 1] <= t * 256) ++e; TE[t] = (unsigned char)e; }
    __syncthreads();
    return ntiles;
}
__device__ __forceinline__ void p8_combine(Frame& F) {
    float* X1 = WSP(float, WS_X1); const bf16* YBF = WSP(bf16, WS_YBUF); bf16* X2B = WSP(bf16, WS_X2B); float* R2 = WSP(float, WS_RSTD2); float* RSS = WSP(float, WS_ROWSS);
    const int gw = F.vcu * 8 + F.wave, NGW = F.G * 8, lane = F.lane;
    for (int t = gw; t < M; t += NGW) {
        f32x4* xr = (f32x4*)(X1 + (size_t)t * D) + lane; f32x4 v[4]; float s = 0.f;
#pragma unroll
        for (int j = 0; j < 4; ++j) v[j] = xr[64 * j];
#pragma unroll
        for (int k = 0; k < 4; ++k) { const u32x2* yr = (const u32x2*)(YBF + (size_t)(4 * t + k) * D) + lane;
#pragma unroll
            for (int j = 0; j < 4; ++j) { const u32x2 w = yr[64 * j]; v[j].x += bflo(w.x); v[j].y += bfhi(w.x); v[j].z += bflo(w.y); v[j].w += bfhi(w.y); } }
        u32x2* o = (u32x2*)(X2B + (size_t)t * D) + lane;
#pragma unroll
        for (int j = 0; j < 4; ++j) { s += (v[j].x * v[j].x + v[j].y * v[j].y) + (v[j].z * v[j].z + v[j].w * v[j].w); u32x2 w; w.x = pk2(v[j].x, v[j].y); w.y = pk2(v[j].z, v[j].w); o[64 * j] = w; }
        s = wave_sum(s);
        if (lane == 0) { R2[t] = 1.0f / sqrtf(s * (1.f / D) + RMS_EPS); RSS[t] = 0.f; }
    }
}
constexpr int NPHASE = 11;
__global__ void __launch_bounds__(512, 2) mega_fwd(Args args) {
    extern __shared__ __attribute__((aligned(16))) unsigned char lds[];
    Frame F;
    F.lds = (LAS unsigned char*)lds;
    F.wave = __builtin_amdgcn_readfirstlane((int)threadIdx.x >> 6); F.lane = lane_now(); F.tid = F.wave * 64 + F.lane;
    F.G = gridDim.x; { const int bx = blockIdx.x; F.vcu = (F.G % 8 == 0) ? (bx % 8) * (F.G / 8) + bx / 8 : bx; }
    F.ws = args.ws; F.ctl = (unsigned*)(args.ws + WS_CTL); F.out = args.out;
    volatile LAS unsigned* MISC = (volatile LAS unsigned*)(F.lds + LDSCTL_OFF);
    if (F.tid < 64) MISC[F.tid] = 0u;
    __syncthreads();
    const int lo = args.ph_lo, hi = args.ph_hi;
    XcdBarrier bar; bar.bar = F.ctl + CW_BAR; bar.x = 0; bar.st = nullptr;
    if (hi - lo > 1) bar = xcd_barrier_post(F.ctl + CW_BAR, MISC + 8, F.tid);
#ifndef PH_MASK
#define PH_MASK 0xFFFF
#endif
#define IN(k) ((((PH_MASK) >> (k)) & 1) && lo <= (k) && (k) < hi)
#define STAMP(k) do { if (TS_PROBE >= 0 && blockIdx.x == 0 && F.tid == 0) ((unsigned long long*)(F.ctl + 2048))[k] = __builtin_amdgcn_s_memrealtime(); } while (0)
#define SEAM(k) do { if (IN(k) && IN((k) + 1)) xcd_barrier(bar, F.wave); F.lane = lane_now(); F.tid = F.wave * 64 + F.lane; STAMP((k) + 1); } while (0)
    LAS unsigned char* ring = F.lds;
    STAMP(0);

    if (IN(0)) { p0_prologue(args, F); if (F.G < 256) expert_convert(args, F, F.vcu * 8 + F.wave, F.G * 8, 3); } SEAM(0);

    if (IN(1)) {
        pg8::Gemm g{WSP(bf16, WS_XB), WSP(bf16, WS_WIN), M, INC, D, 0, nullptr, nullptr, nullptr}; pg8::StaticOrder S; S.init(M, INC, F.G, (int)blockIdx.x);
        EpiG1 E{WSP(float, WS_RSTD0), WSP(bf16, WS_Q), WSP(bf16, WS_K), WSP(bf16, WS_VT), WSP(bf16, WS_ZR), WSP(bf16, WS_GT)};
        pg8::gemm_phase(ring, g, S, E, F.wave);
    } SEAM(1);

    if (IN(2)) {
        for (int c = blockIdx.x; c < 256; c += F.G) {
            const int x = c & 7, y = c >> 3; pg8::LoraOrder S; S.half = y & 1; S.pm = x + 8 * (y >> 1); S.nu = 3 + (F.G >> 30);
            build_alora(args, F, S.pm);
            asm volatile("s_waitcnt vmcnt(0)" ::: "memory"); __syncthreads();
            pg8::Gemm g{WSP(bf16, WS_ALORA), WSP(bf16, WS_WL), M, LORA_N, LORA_K, 0, nullptr, nullptr, nullptr};
            EpiLora E{FIN(5), FIN(7), WSP(float, WS_DEC), WSP(float, WS_AA), WSP(bf16, WS_GG)};
            pg8::gemm_phase(ring, g, S, E, F.wave);
        }
    } SEAM(2);

    if (IN(3)) {
        for (int u = blockIdx.x; u < 256; u += F.G) {
#ifndef P3_ONLY
#define P3_ONLY 0
#endif
            if (u < 128) { if (P3_ONLY != 2 && P3_ONLY != 3 && P3_ONLY != 4) scan_unit_chunked(args, F, u); else { bf16* YB = WSP(bf16, WS_YB); const int b = u >> 3, h = u & 7; for (int i = F.tid; i < SEQ * 8; i += 512) { const int tk = i >> 3, c8 = (i & 7) * 8; *(u32x4*)(YB + ((size_t)b * SEQ + tk) * 512 + h * 64 + c8) = (u32x4){0u, 0u, 0u, 0u}; } } }
            else if (P3_ONLY == 1 || P3_ONLY == 4) { bf16* YAz = WSP(bf16, WS_YA); const int bh = u - 128, b = bh >> 3, h = bh & 7; for (int i = F.tid; i < SEQ * 8; i += 512) { const int tk = i >> 3, c8 = (i & 7) * 8; *(u32x4*)(YAz + ((size_t)b * SEQ + tk) * 512 + h * 64 + c8) = (u32x4){0u, 0u, 0u, 0u}; } }
            else { const int bh = u - 128; for (int i = 0; i < 8; ++i) attn_tile(F, bh, F.wave + 8 * i);
                   if (F.G >= 256 && P3_ONLY != 3) expert_convert(args, F, bh * 8 + F.wave, 1024, 3); }
        }
    } SEAM(3);

    if (IN(4)) {
        pg8::StaticOrder S; S.init(M, D, F.G, (int)blockIdx.x);
        { pg8::Gemm g{WSP(bf16, WS_YA), WSP(bf16, WS_WA), M, D, AW, 0, nullptr, nullptr, nullptr}; EpiMerge<0> E{WSP(bf16, WS_GT), WSP(bf16, WS_MERGED)}; pg8::gemm_phase(ring, g, S, E, F.wave); }
        { pg8::Gemm g{WSP(bf16, WS_YB), WSP(bf16, WS_WB), M, D, RW, 0, nullptr, nullptr, nullptr}; EpiMerge<1> E{WSP(bf16, WS_GT), WSP(bf16, WS_MERGED)}; pg8::gemm_phase(ring, g, S, E, F.wave); }
    } SEAM(4);

    if (IN(5)) {
        pg8::Gemm g{WSP(bf16, WS_MERGED), WSP(bf16, WS_WO), M, D, D, 0, nullptr, nullptr, nullptr}; pg8::StaticOrder S; S.init(M, D, F.G, (int)blockIdx.x);
        EpiX1 E{FIN(0), WSP(float, WS_X1), FIN(18), WSP(bf16, WS_HN)};
        pg8::gemm_phase(ring, g, S, E, F.wave);
    } SEAM(5);

    if (IN(6)) { p5a_router(args, F); } SEAM(6);

    if (IN(7)) {
        const int ntiles = moe_tables(F);
        pg8::Gemm g{WSP(bf16, WS_HN), WSP(bf16, WS_W1), MAXROWS, F2, D, (size_t)F2 * D * 2, WSP(int, WS_LIST), (const LAS int*)(F.lds + MOE_OFF) + 32, (const LAS int*)(F.lds + MOE_OFF)};
        pg8::MoeOrder S{ntiles, F2 / 256, F.G, (int)blockIdx.x, F.lds + MOE_TE};
        EpiSwiglu E{FIN(22), WSP(bf16, WS_ACT), WSP(int, WS_LIST), WSP(float, WS_LRS), (const LAS int*)(F.lds + MOE_OFF) + 32, (const LAS int*)(F.lds + MOE_OFF), (const LAS float*)(F.lds + RING_BYTES + 4096)};
        pg8::gemm_phase<EpiSwiglu, pg8::MoeOrder, true>(ring, g, S, E, F.wave);
    } SEAM(7);

    if (IN(8)) {
        const int ntiles = moe_tables(F);
        pg8::Gemm g{WSP(bf16, WS_ACT), WSP(bf16, WS_W2), MAXROWS, D, FH, (size_t)D * FH * 2, nullptr, nullptr, nullptr};
        pg8::MoeOrder S{ntiles, D / 256, F.G, (int)blockIdx.x, F.lds + MOE_TE};
        EpiY E{FIN(24), WSP(int, WS_LIST), WSP(float, WS_LGT), WSP(bf16, WS_YBUF), (const LAS int*)(F.lds + MOE_OFF) + 32, (const LAS int*)(F.lds + MOE_OFF), (const LAS float*)(F.lds + RING_BYTES + 4096)};
        pg8::gemm_phase(ring, g, S, E, F.wave);
    } SEAM(8);

    if (IN(9)) { p8_combine(F); } SEAM(9);

    if (IN(10)) {
        pg8::StaticOrder S; S.init(M, D, F.G, (int)blockIdx.x);
        { pg8::Gemm g{WSP(bf16, WS_X2B), WSP(bf16, WS_WG), M, D, D, 0, nullptr, nullptr, nullptr}; EpiGate E{WSP(float, WS_RSTD2), WSP(bf16, WS_PGT)}; pg8::gemm_phase(ring, g, S, E, F.wave); }
        { pg8::Gemm g{WSP(bf16, WS_PB), WSP(bf16, WS_WP), M, D, PLE, 0, nullptr, nullptr, nullptr}; EpiPle E{WSP(bf16, WS_X2B), WSP(bf16, WS_PGT), F.out, WSP(float, WS_ROWSS), F.ctl + CW_PCNT, FIN(28), F.ctl}; pg8::gemm_phase(ring, g, S, E, F.wave); }
    }
#undef IN
#undef SEAM
}

extern "C" void kernel_launch(void* const* d_in, const int* in_sizes, int n_in, void* d_out, int out_size, void* d_ws, size_t ws_size, hipStream_t stream) {
    static int grid = 0;
    if (grid == 0) {
        if (n_in != 29 || in_sizes[0] != M * D || out_size != M * D || ws_size < WS_END) {
            fprintf(stderr, "kernel_launch: unexpected shapes (n_in %d, in0 %d, out %d, ws %zu < %zu); nothing launched\n", n_in, n_in > 0 ? in_sizes[0] : -1, out_size, ws_size, (size_t)WS_END); grid = -1; return; }
        int dev = 0, cus = 0, per_cu = 0;
        if (hipGetDevice(&dev) != hipSuccess || hipDeviceGetAttribute(&cus, hipDeviceAttributeMultiprocessorCount, dev) != hipSuccess) { grid = -1; return; }
        if (hipFuncSetAttribute((const void*)mega_fwd, hipFuncAttributeMaxDynamicSharedMemorySize, LDS_BYTES) != hipSuccess) { fprintf(stderr, "kernel_launch: hipFuncSetAttribute failed\n"); grid = -1; return; }
        if (hipOccupancyMaxActiveBlocksPerMultiprocessor(&per_cu, (const void*)mega_fwd, 512, LDS_BYTES) != hipSuccess || per_cu < 1) { fprintf(stderr, "kernel_launch: occupancy query says %d blocks/CU\n", per_cu); }
        (void)hipGetLastError();
        grid = cus;
    }
    if (grid < 0) return;
    (void)hipMemsetAsync((char*)d_ws + WS_CTL, 0, CTL_ZERO_BYTES, stream);
    Args a{};
    for (int i = 0; i < 29; ++i) a.in[i] = (const float*)d_in[i];
    a.out = (float*)d_out; a.ws = (unsigned char*)d_ws;
#if MK_PER_PHASE
    for (int p = 0; p < NPHASE; ++p) { a.ph_lo = p; a.ph_hi = p + 1; hipLaunchKernelGGL(mega_fwd, dim3(grid), dim3(512), LDS_BYTES, stream, a); }
#else
    a.ph_lo = 0; a.ph_hi = NPHASE; hipLaunchKernelGGL(mega_fwd, dim3(grid), dim3(512), LDS_BYTES, stream, a);
#endif
}
```

```cpp
#include <hip/hip_runtime.h>
#include <cstdio>
#include <cstdint>

#ifndef P3_ONLY
#define P3_ONLY 0
#endif
#ifndef SCAN_STUB
#define SCAN_STUB 0
#endif
#ifndef ATT_FORCE
#define ATT_FORCE 0
#endif
#ifndef TS_PROBE
#define TS_PROBE -1
#endif
#ifndef MK_PER_PHASE
#define MK_PER_PHASE 0
#endif

#define LAS __attribute__((address_space(3)))
#define GAS __attribute__((address_space(1)))
typedef unsigned short bf16;
typedef short bf16x8 __attribute__((ext_vector_type(8)));
typedef float f32x2 __attribute__((ext_vector_type(2)));
typedef float f32x4 __attribute__((ext_vector_type(4)));
typedef float f32x16 __attribute__((ext_vector_type(16)));
typedef unsigned u32x2 __attribute__((ext_vector_type(2)));
typedef unsigned u32x4 __attribute__((ext_vector_type(4)));
typedef __bf16 bf16x2_t __attribute__((ext_vector_type(2)));

constexpr int NB = 16, SEQ = 2048, D = 1024, M = NB * SEQ;
constexpr int NH = 8, HD = 64, AW = 512, RW = 512, RWC = 1792, INC = 5376;
constexpr int NE = 32, FH = 1024, F2 = 2048, PLE = 256, TOPK = 4;
constexpr int LORA_K = 256, LORA_N = 1536;
constexpr int CAP = 32768;
constexpr int MAXROWS = M * TOPK + NE * 256;
constexpr float RMS_EPS = 1e-5f, GN_EPS = 64e-5f;

constexpr size_t MiB = 1u << 20;
constexpr size_t WS_CTL = 0, CTL_ZERO_BYTES = 1 * MiB;
constexpr size_t WS_WIN = 1 * MiB;
constexpr size_t WS_WA = 12 * MiB, WS_WB = 13 * MiB, WS_WO = 14 * MiB, WS_WG = 16 * MiB, WS_WP = 18 * MiB;
constexpr size_t WS_WL = 18 * MiB + 512 * 1024;
constexpr size_t WS_GW = 19 * MiB + 256 * 1024;
constexpr size_t WS_W1 = 20 * MiB;
constexpr size_t WS_W2 = 148 * MiB;
constexpr size_t WS_PB = 212 * MiB;
constexpr size_t WS_RSTD0 = 228 * MiB, WS_RSTD2 = WS_RSTD0 + 128 * 1024, WS_ROWSS = WS_RSTD0 + 256 * 1024;
constexpr size_t WS_RSTD1 = WS_RSTD0 + 384 * 1024;
constexpr size_t WS_GATEW = WS_RSTD0 + 512 * 1024;
constexpr size_t WS_ROWSLOT = 229 * MiB;
constexpr size_t WS_LIST = 230 * MiB;
constexpr size_t WS_X1 = 236 * MiB;
constexpr size_t WS_YA = 236 * MiB, WS_YB = 268 * MiB, WS_ALORA = 300 * MiB;
constexpr size_t WS_GT = 364 * MiB;
constexpr size_t WS_Q = 492 * MiB, WS_K = 524 * MiB, WS_VT = 556 * MiB;
constexpr size_t WS_ZR = 588 * MiB;
constexpr size_t WS_XB = 700 * MiB;
constexpr size_t WS_DEC = 764 * MiB, WS_AA = 828 * MiB, WS_GG = 892 * MiB;
constexpr size_t WS_MERGED = 492 * MiB;
constexpr size_t WS_XS = 364 * MiB;
constexpr size_t WS_ACT = 684 * MiB;
constexpr size_t WS_HN = 364 * MiB;
constexpr size_t WS_YBUF = 428 * MiB;
constexpr size_t WS_X2B = 684 * MiB;
constexpr size_t WS_PGT = 748 * MiB;
constexpr size_t WS_LRS = 956 * MiB, WS_LGT = 960 * MiB;
constexpr size_t WS_END = 964 * MiB;
constexpr int CW_CNT = 64;
constexpr int CW_PCNT = 8192;
constexpr int CW_BAR = 4096;

constexpr int RING_BYTES = 131072;
constexpr int LDSCTL_OFF = RING_BYTES;
constexpr int MOE_OFF = RING_BYTES + 1024;
constexpr int MOE_TE = RING_BYTES + 2048;
constexpr int LDS_BYTES = 147456;

#define RLX_AGENT __ATOMIC_RELAXED, __HIP_MEMORY_SCOPE_AGENT
__device__ __forceinline__ unsigned pk2(float lo, float hi) { f32x2 v = {lo, hi}; bf16x2_t b = __builtin_convertvector(v, bf16x2_t); return __builtin_bit_cast(unsigned, b); }
__device__ __forceinline__ float bflo(unsigned u) { return __uint_as_float(u << 16); }
__device__ __forceinline__ float bfhi(unsigned u) { return __uint_as_float(u & 0xffff0000u); }
__device__ __forceinline__ float sigm(float x) { return __builtin_amdgcn_rcpf(1.f + __expf(-x)); }
__device__ __forceinline__ float wave_sum(float v) {
#pragma unroll
    for (int o = 1; o < 64; o <<= 1) v += __shfl_xor(v, o);
    return v;
}
template <int CTRL> __device__ __forceinline__ float dppf(float v) { return __builtin_bit_cast(float, __builtin_amdgcn_update_dpp(0, __builtin_bit_cast(int, v), CTRL, 0xF, 0xF, true)); }
__device__ __forceinline__ float red8(float v) { v += dppf<0xB1>(v); v += dppf<0x4E>(v); v += dppf<0x141>(v); return v; }
__device__ __forceinline__ int lane_now() { int l; asm volatile("v_mbcnt_lo_u32_b32 %0, -1, 0\n\tv_mbcnt_hi_u32_b32 %0, -1, %0" : "=v"(l)); return l; }
__device__ __forceinline__ int crow(int r, int hi) { return (r & 3) + 8 * (r >> 2) + 4 * hi; }

struct PreNone {}; struct PreF { float f[8]; }; struct PreI { int i[8]; };
namespace pg8 {
#define PG8_LAS __attribute__((address_space(3)))
typedef unsigned short bf16_t;
constexpr int BM = 256, BK = 64, HALF = 128, HTB = HALF * BK * 2, STAGE_BYTES = 8 * HTB, NXCD = 8, WGM = 8;
__host__ __device__ __forceinline__ int lds_byte(int r, int c) { const int st = (r >> 4) * 2 + (c >> 5), rr = r & 15, cc = c & 31, ob = rr * 64 + cc * 2; return st * 1024 + (ob ^ (((ob >> 9) & 1) << 5)); }
__host__ __device__ __forceinline__ void stage_rc(int b, int& R, int& C) { const int st = b / 1024, sb = b % 1024, swz = sb ^ (((sb >> 9) & 1) << 5); R = (st >> 1) * 16 + swz / 64; C = (st & 1) * 32 + (swz % 64) / 2; }
__host__ __device__ __forceinline__ int perm32(int rho) { const int n = rho >> 4, i = rho & 15; return 8 * (i >> 2) + 4 * n + (i & 3); }

struct Unit { int pm, pn, e; };
struct Gemm { const bf16_t* A; const bf16_t* Bt; int M, N, K; size_t bsel_bytes; const int* glist; const PG8_LAS int* goff; const PG8_LAS int* gcnt; };

struct StaticOrder {
    int nM, nN, nwg, G, c;
    __device__ void init(int M_, int N_, int G_, int c_) { nM = M_ / BM; nN = N_ / BM; nwg = nM * nN; G = G_; c = c_; }
    __device__ bool next(int i, Unit& u) const {
        const long L = (long)i * G + c; if (L >= nwg) return false;
        int wgid = (int)L; { const int q = nwg / NXCD, r = nwg % NXCD, xcd = wgid % NXCD, off = wgid / NXCD; wgid = (xcd < r ? xcd * (q + 1) : r * (q + 1) + (xcd - r) * q) + off; }
        const int nig = WGM * nN, gid = wgid / nig, fm = gid * WGM, gsz = (nM - fm) < WGM ? (nM - fm) : WGM;
        u.pm = fm + ((wgid % nig) % gsz); u.pn = (wgid % nig) / gsz; u.e = 0; return true;
    }
};
struct LoraOrder {
    int pm, half, nu;
    __device__ bool next(int i, Unit& u) const { if (i >= nu) return false; u.pm = pm; u.pn = 3 * half + i; u.e = 0; return true; }
};
struct MoeOrder {
    int ntiles, npn, G, c; const PG8_LAS unsigned char* te;
    __device__ bool next(int i, Unit& u) const {
        int rt, pn;
        if ((G & 255) == 0 && (npn == 8 || npn == 4)) { const int x = c & 7, j = (c >> 3) & 31, rpx = 32 / npn, blk = c >> 8; rt = ((i * (G >> 8) + blk) * 8 + x) * rpx + j / npn; pn = j % npn; }
        else { const long L = (long)i * G + c; rt = (int)(L / npn); pn = (int)(L % npn); }
        if (rt >= ntiles) return false;
        u.pm = rt; u.pn = pn; u.e = te[rt]; return true;
    }
};

template <class Epi, class Sched, bool GATHER = false>
__device__ __forceinline__ void gemm_phase(PG8_LAS unsigned char* lds, const Gemm g, const Sched& S, const Epi& E, const int wid) {
    const int lane = lane_now(), tid = wid * 64 + lane,
              wr = wid >> 2, wc = wid & 3, fr = lane & 15, fq = lane >> 4;
    const int K = g.K, nt = K / BK;
    unsigned voffA[2], voffB[2];
#pragma unroll
    for (int i = 0; i < 2; ++i) { int R, C; stage_rc(tid * 16 + i * 8192, R, C); const int Rb = Epi::PERM ? ((R & ~31) + perm32(R & 31)) : R;
        voffA[i] = (unsigned)(R * K + C) * 2u; voffB[i] = (unsigned)(Rb * K + C) * 2u; }
    const size_t kstep = (size_t)(BK * 2);
    const size_t hstep = (size_t)HALF * K * 2;
    const size_t tstep = 2 * hstep;
    const unsigned ldsw = (unsigned)wid * 1024u;
    const int aoff = lds_byte(wr * 64 + fr, fq * 8), boff = lds_byte(wc * 32 + fr, fq * 8);
    unsigned vgC[2][2] = {{0u, 0u}, {0u, 0u}}, vgN[2][2] = {{0u, 0u}, {0u, 0u}};
#define PG8_GOFF(u, vo) do { _Pragma("unroll") for (int _h = 0; _h < 2; ++_h) _Pragma("unroll") for (int _i = 0; _i < 2; ++_i) { int R_, C_; stage_rc(tid * 16 + _i * 8192, R_, C_); \
        const int r_ = (u).pm * BM + _h * HALF + R_ - g.goff[(u).e]; int tok_ = 0; if (r_ < g.gcnt[(u).e]) tok_ = g.glist[(size_t)(u).e * 32768 + r_] >> 2; (vo)[_h][_i] = (unsigned)(tok_ * K + C_) * 2u; } } while (0)
#define PG8_SA(b, h) (((b) * 2 + (h)) * HTB)
#define PG8_SB(b, h) ((4 + (b) * 2 + (h)) * HTB)
#define PG8_STAGE(bufoff, gbase, voff) do { _Pragma("unroll") for (int _i = 0; _i < 2; ++_i) \
        __builtin_amdgcn_global_load_lds((const unsigned*)((const char*)(gbase) + (voff)[_i]), (PG8_LAS unsigned*)(lds + (bufoff) + ldsw + _i * 8192), 16, 0, 0); } while (0)
#define PG8_STA(bufoff, h, ptr, kbyte, usenext) do { if constexpr (GATHER) { unsigned vo_[2] = {(usenext) ? vgN[h][0] : vgC[h][0], (usenext) ? vgN[h][1] : vgC[h][1]}; PG8_STAGE(bufoff, (const char*)g.A + (kbyte), vo_); } else { PG8_STAGE(bufoff, ptr, voffA); } } while (0)
#define PG8_LDA(dst, b, h) do { _Pragma("unroll") for (int m = 0; m < 4; ++m) _Pragma("unroll") for (int k = 0; k < 2; ++k) dst[m][k] = *(const PG8_LAS bf16x8*)(lds + PG8_SA(b, h) + aoff + m * 2048 + k * 1024); } while (0)
#define PG8_LDB(dst, b, h) do { _Pragma("unroll") for (int n = 0; n < 2; ++n) _Pragma("unroll") for (int k = 0; k < 2; ++k) dst[n][k] = *(const PG8_LAS bf16x8*)(lds + PG8_SB(b, h) + boff + n * 2048 + k * 1024); } while (0)
#define PG8_MMA(ai, bj, At, Bt) do { __builtin_amdgcn_s_setprio(1); _Pragma("unroll") for (int m = 0; m < 4; ++m) _Pragma("unroll") for (int n = 0; n < 2; ++n) _Pragma("unroll") for (int k = 0; k < 2; ++k) \
        acc[ai][bj][m][n] = __builtin_amdgcn_mfma_f32_16x16x32_bf16(Bt[n][k], At[m][k], acc[ai][bj][m][n], 0, 0, 0); __builtin_amdgcn_s_setprio(0); } while (0)
#define PG8_WAIT_V(n) asm volatile("s_waitcnt vmcnt(" #n ")" ::: "memory")
#define PG8_WAIT_L(n) asm volatile("s_waitcnt lgkmcnt(" #n ")" ::: "memory")
#define PG8_BAR __builtin_amdgcn_s_barrier()
#define PG8_SCHED __builtin_amdgcn_sched_barrier(0)
    Unit cur, nxt; int ui = 0;
    if (!S.next(0, cur)) return;
    typename Epi::Pre preC;
    f32x4 acc[2][2][4][2];
#pragma unroll
    for (int a = 0; a < 2; ++a)
#pragma unroll
        for (int b = 0; b < 2; ++b)
#pragma unroll
            for (int m = 0; m < 4; ++m)
#pragma unroll
                for (int n = 0; n < 2; ++n) acc[a][b][m][n] = (f32x4){0.f, 0.f, 0.f, 0.f};
    bf16x8 At[4][2], B0[2][2], B1[2][2];
    const char* cA = (const char*)g.A + (size_t)cur.pm * tstep; const char* cB = (const char*)g.Bt + (size_t)cur.e * g.bsel_bytes + (size_t)cur.pn * tstep;
    if constexpr (GATHER) PG8_GOFF(cur, vgC);
    PG8_STAGE(PG8_SB(0, 0), cB, voffB); PG8_STAGE(PG8_SB(0, 1), cB + hstep, voffB); PG8_STA(PG8_SA(0, 0), 0, cA, 0, false); PG8_STA(PG8_SA(0, 1), 1, cA + hstep, 0, false);
    if (wr == 1) PG8_BAR;
    PG8_WAIT_V(2); PG8_BAR;
    PG8_STAGE(PG8_SB(1, 0), cB + kstep, voffB); PG8_STA(PG8_SA(1, 0), 0, cA + kstep, kstep, false); PG8_STAGE(PG8_SB(1, 1), cB + hstep + kstep, voffB);
    PG8_WAIT_V(6); PG8_BAR;
    for (;;) {
        const bool has_next = S.next(ui + 1, nxt);
        E.pre(cur, wr, fr, preC);
        f32x4 biasq = (f32x4){0.f, 0.f, 0.f, 0.f}; if constexpr (Epi::LBIAS) { if (wid == 0) biasq = *(const f32x4*)(E.bias_tile(cur) + 4 * lane); }
        if constexpr (GATHER) { if (has_next) PG8_GOFF(nxt, vgN); else { vgN[0][0] = vgC[0][0]; vgN[0][1] = vgC[0][1]; vgN[1][0] = vgC[1][0]; vgN[1][1] = vgC[1][1]; } }
        const char* nA = has_next ? (const char*)g.A + (size_t)nxt.pm * tstep : cA;
        const char* nB = has_next ? (const char*)g.Bt + (size_t)nxt.e * g.bsel_bytes + (size_t)nxt.pn * tstep : cB;
        for (int t = 0; t < nt; t += 2) {
            const bool last = (t == nt - 2);
            const char* a1 = cA + (size_t)(t + 1) * kstep;
            const char* a2 = last ? nA : cA + (size_t)(t + 2) * kstep; const char* b2 = last ? nB : cB + (size_t)(t + 2) * kstep;
            const char* a3 = a2 + kstep; const char* b3 = b2 + kstep;
            const size_t k2 = last ? 0 : (size_t)(t + 2) * kstep;
            PG8_LDB(B0, 0, 0); PG8_LDB(B1, 0, 1); PG8_SCHED; PG8_LDA(At, 0, 0); PG8_STA(PG8_SA(1, 1), 1, a1 + hstep, (size_t)(t + 1) * kstep, false);
            PG8_WAIT_V(8); PG8_WAIT_L(0); PG8_BAR; PG8_MMA(0, 0, At, B0); PG8_MMA(0, 1, At, B1); PG8_BAR; PG8_SCHED;
            PG8_LDA(At, 0, 1); PG8_STAGE(PG8_SB(0, 0), b2, voffB); PG8_STAGE(PG8_SB(0, 1), b2 + hstep, voffB); PG8_STA(PG8_SA(0, 0), 0, a2, k2, last);
            PG8_WAIT_V(8); PG8_WAIT_L(0); PG8_BAR; PG8_MMA(1, 0, At, B0); PG8_MMA(1, 1, At, B1); PG8_BAR; PG8_SCHED;
            PG8_LDB(B0, 1, 0); PG8_LDB(B1, 1, 1); PG8_SCHED; PG8_LDA(At, 1, 0); PG8_STA(PG8_SA(0, 1), 1, a2 + hstep, k2, last);
            PG8_WAIT_V(8); PG8_WAIT_L(0); PG8_BAR; PG8_MMA(0, 0, At, B0); PG8_MMA(0, 1, At, B1); PG8_BAR; PG8_SCHED;
            PG8_LDA(At, 1, 1); PG8_STAGE(PG8_SB(1, 0), b3, voffB); PG8_STAGE(PG8_SB(1, 1), b3 + hstep, voffB); PG8_STA(PG8_SA(1, 0), 0, a3, k2 + kstep, last);
            PG8_WAIT_V(8); PG8_WAIT_L(0); PG8_BAR; PG8_MMA(1, 0, At, B0); PG8_MMA(1, 1, At, B1); PG8_BAR; PG8_SCHED;
        }
        if constexpr (Epi::LBIAS) { if (wid == 0) { *(PG8_LAS f32x4*)(lds + RING_BYTES + 4096 + 16 * lane) = biasq; asm volatile("s_waitcnt lgkmcnt(0)" ::: "memory"); } }
        if (wr == 0) PG8_BAR;
        E(acc, cur, wr, wc, fr, fq, preC);
        if (!has_next) break;
#pragma unroll
        for (int a = 0; a < 2; ++a)
#pragma unroll
            for (int b = 0; b < 2; ++b)
#pragma unroll
                for (int m = 0; m < 4; ++m)
#pragma unroll
                    for (int n = 0; n < 2; ++n) acc[a][b][m][n] = (f32x4){0.f, 0.f, 0.f, 0.f};
        cur = nxt; cA = nA; cB = nB; ++ui;
        if constexpr (GATHER) { vgC[0][0] = vgN[0][0]; vgC[0][1] = vgN[0][1]; vgC[1][0] = vgN[1][0]; vgC[1][1] = vgN[1][1]; }
        if (wr == 1) PG8_BAR;
    }
    PG8_WAIT_V(0);
    PG8_BAR;
#undef PG8_SA
#undef PG8_SB
#undef PG8_STAGE
#undef PG8_LDA
#undef PG8_STA
#undef PG8_GOFF
#undef PG8_LDB
#undef PG8_MMA
#undef PG8_WAIT_V
#undef PG8_WAIT_L
#undef PG8_BAR
#undef PG8_SCHED
}
}
using pg8::Unit;
typedef const f32x4 (&AccRef)[2][2][4][2];

#define XB_TMO      128
#define XB_XCNT(j)  (256  + 64 * (j))
#define XB_XSUB(j)  (1280 + 64 * (j))
#define XB_XGEN(j)  (2304 + 64 * (j))
#define XB_TOP      3328
#define XB_TOPGEN   3392
#define XCD_BAR_WORDS 3456
#define XB_SPIN_CAP (1u << 22)
__device__ __forceinline__ unsigned xb_ld(unsigned* p)              { return __hip_atomic_load(p, __ATOMIC_RELAXED, __HIP_MEMORY_SCOPE_AGENT); }
__device__ __forceinline__ unsigned xb_add(unsigned* p, unsigned v) { return __hip_atomic_fetch_add(p, v, __ATOMIC_RELAXED, __HIP_MEMORY_SCOPE_AGENT); }
__device__ __forceinline__ unsigned xb_xcc_id() { return (unsigned)__builtin_amdgcn_s_getreg((3 << 11) | 20) & 0xFu; }
#define XB_SPIN(cond, bar) do { unsigned _sp = 0; while (cond) { __builtin_amdgcn_s_sleep(1); \
    if ((++_sp & 255u) == 0u) { if (xb_ld(&(bar)[XB_TMO])) break; if (_sp > XB_SPIN_CAP) { atomicAdd(&(bar)[XB_TMO], 1u); break; } } } } while (0)
struct XcdBarrier { unsigned* bar; unsigned x; volatile LAS unsigned* st; };
__device__ __forceinline__ XcdBarrier xcd_barrier_post(unsigned* bar, volatile LAS unsigned* st, int tid) {
    XcdBarrier b; b.bar = bar; b.x = xb_xcc_id(); b.st = st;
    if (tid == 0) (void)xb_add(&bar[XB_XCNT(b.x)], 1u);
    return b;
}
__device__ __forceinline__ void xcd_barrier_complete(unsigned* bar, unsigned x, unsigned& nloc, unsigned& nx) {
    const unsigned G = gridDim.x * gridDim.y * gridDim.z;
    unsigned sum, cnt, mine, sp = 0u;
    for (;;) {
        sum = 0u; cnt = 0u; mine = 0u;
#pragma unroll
        for (unsigned j = 0; j < 16; ++j) { const unsigned c = xb_ld(&bar[XB_XCNT(j)]); sum += c; cnt += (c > 0u) ? 1u : 0u; mine = (j == x) ? c : mine; }
        if (sum == G) break;
        __builtin_amdgcn_s_sleep(1);
        if ((++sp & 255u) == 0u) { if (xb_ld(&bar[XB_TMO])) break; if (sp > XB_SPIN_CAP) { atomicAdd(&bar[XB_TMO], 1u); break; } }
    }
    nloc = mine > 0u ? mine : 1u; nx = cnt > 0u ? cnt : 1u;
}
__device__ __forceinline__ void xcd_barrier(const XcdBarrier& b, int wave) {
    asm volatile("s_waitcnt vmcnt(0)" ::: "memory");
    __syncthreads();
    if (wave == 0 && lane_now() == 0) {
        unsigned* bar = b.bar;
        __builtin_amdgcn_s_waitcnt(0);
        unsigned nloc = b.st[0], nx = b.st[1];
        if (nloc == 0u) { xcd_barrier_complete(bar, b.x, nloc, nx); b.st[0] = nloc; b.st[1] = nx; }
        const unsigned old = xb_add(&bar[XB_XSUB(b.x)], 1u);
        const unsigned gen = old / nloc;
        if (old + 1u == (gen + 1u) * nloc) {
            __builtin_amdgcn_fence(__ATOMIC_RELEASE, "agent");
            asm volatile("s_waitcnt vmcnt(0)" ::: "memory");
            const unsigned og = xb_add(&bar[XB_TOP], 1u);
            const unsigned tg = og / nx;
            if (og + 1u == (tg + 1u) * nx) xb_add(&bar[XB_TOPGEN], 1u);
            else XB_SPIN(xb_ld(&bar[XB_TOPGEN]) == tg, bar);
            __builtin_amdgcn_fence(__ATOMIC_ACQUIRE, "agent");
            xb_add(&bar[XB_XGEN(b.x)], 1u);
            asm volatile("s_waitcnt vmcnt(0)" ::: "memory");
        } else {
            XB_SPIN(xb_ld(&bar[XB_XGEN(b.x)]) == gen, bar);
            __builtin_amdgcn_fence(__ATOMIC_ACQUIRE, "agent");
            asm volatile("s_waitcnt vmcnt(0)" ::: "memory");
        }
    }
    __syncthreads();
}

struct Frame {
    LAS unsigned char* lds;
    unsigned* ctl;
    int tid, lane, wave, vcu, G;
    unsigned char* ws;
    float* out;
};
#define WSP(T, off) ((T*)(F.ws + (off)))
struct Args { const float* in[29]; float* out; unsigned char* ws; int ph_lo, ph_hi; };
#define FIN(i) (args.in[i])

template <bool SWZ = false>
__device__ __forceinline__ void p0_transpose_item(const float* W, int K, int N, bf16* WT, LAS float* scr, int item, int lane, const float* kscale) {
    const int nblk = N / 32, kb = item / nblk, nb = item % nblk, k0 = 64 * kb, n0 = 32 * nb;
#pragma unroll 8
    for (int i = 0; i < 32; ++i) { const int kk = 2 * i + (lane >> 5); float v = W[(size_t)(k0 + kk) * N + n0 + (lane & 31)]; if (kscale) v *= kscale[k0 + kk]; scr[kk * 33 + (lane & 31)] = v; }
    asm volatile("s_waitcnt lgkmcnt(0)" ::: "memory");
    const int c = lane & 7;
#pragma unroll
    for (int j = 0; j < 4; ++j) { const int n = (lane >> 3) + 8 * j; const LAS float* s = scr + (8 * c) * 33 + n;
        u32x4 o; o.x = pk2(s[0 * 33], s[1 * 33]); o.y = pk2(s[2 * 33], s[3 * 33]); o.z = pk2(s[4 * 33], s[5 * 33]); o.w = pk2(s[6 * 33], s[7 * 33]);
        int nr = n0 + n; if (SWZ) { const int cl = nr & 255; nr = (nr & ~255) + 128 * ((cl >> 3) & 1) + 32 * (cl >> 6) + 8 * ((cl >> 4) & 3) + (cl & 7); }
        *(u32x4*)(WT + (size_t)nr * K + k0 + 8 * c) = o; }
    asm volatile("s_waitcnt lgkmcnt(0)" ::: "memory");
}
__device__ __forceinline__ void p0_prologue(const Args& args, Frame& F) {
    LAS float* scr = (LAS float*)(F.lds + F.wave * 16384);
    const int gw = F.vcu * 8 + F.wave, NGW = F.G * 8, lane = F.lane;
    constexpr int I_IN = (D / 64) * (INC / 32), I_A = (AW / 64) * (D / 32), I_O = (D / 64) * (D / 32), I_P = (PLE / 64) * (D / 32);
    constexpr int I_W1 = (D / 64) * (F2 / 32), I_W2 = (FH / 64) * (D / 32);
    constexpr int NITEMS = I_IN + 2 * I_A + 2 * I_O + I_P;
    for (int it = gw; it < NITEMS; it += NGW) {
        int r = it;
        if (r < I_IN) { p0_transpose_item(FIN(3), D, INC, WSP(bf16, WS_WIN), scr, r, lane, FIN(2)); continue; } r -= I_IN;
        if (r < I_A) { p0_transpose_item(FIN(15), AW, D, WSP(bf16, WS_WA), scr, r, lane, nullptr); continue; } r -= I_A;
        if (r < I_A) { p0_transpose_item(FIN(16), RW, D, WSP(bf16, WS_WB), scr, r, lane, nullptr); continue; } r -= I_A;
        if (r < I_O) { p0_transpose_item(FIN(17), D, D, WSP(bf16, WS_WO), scr, r, lane, nullptr); continue; } r -= I_O;
        if (r < I_O) { p0_transpose_item(FIN(26), D, D, WSP(bf16, WS_WG), scr, r, lane, FIN(25)); continue; } r -= I_O;
        p0_transpose_item(FIN(27), PLE, D, WSP(bf16, WS_WP), scr, r, lane, nullptr);
    }
    { const int gt = (F.vcu * 512 + F.tid), NT = F.G * 512;
      bf16* WL = WSP(bf16, WS_WL);
      for (int i = gt; i < LORA_N * LORA_K; i += NT) { const int n = i >> 8, k = i & 255; float v = 0.f;
          if (n < 512) { if (k < 64) v = FIN(6)[k * 512 + n]; }
          else if (n < 1024) { if (k >= 64 && k < 128) v = FIN(8)[(k - 64) * 512 + (n - 512)]; }
          else { if (k >= 128) v = FIN(9)[(k - 128) * 512 + (n - 1024)]; }
          WL[i] = (bf16)(pk2(v, 0.f) & 0xffffu); }
      float* GW = WSP(float, WS_GW);
      for (int i = gt; i < D * NE; i += NT) GW[i] = FIN(19)[i] * FIN(18)[i >> 5];
    }
    { bf16* XB = WSP(bf16, WS_XB); float* R0 = WSP(float, WS_RSTD0); bf16* PB = WSP(bf16, WS_PB);
      for (int m = gw; m < M; m += NGW) {
          const f32x4* xr = (const f32x4*)(FIN(0) + (size_t)m * D) + lane;
          f32x4 v[4]; float s = 0.f;
#pragma unroll
          for (int j = 0; j < 4; ++j) { v[j] = xr[64 * j]; s += (v[j].x * v[j].x + v[j].y * v[j].y) + (v[j].z * v[j].z + v[j].w * v[j].w); }
          s = wave_sum(s);
          u32x2* o = (u32x2*)(XB + (size_t)m * D) + lane;
#pragma unroll
          for (int j = 0; j < 4; ++j) { u32x2 w; w.x = pk2(v[j].x, v[j].y); w.y = pk2(v[j].z, v[j].w); o[64 * j] = w; }
          if (lane == 0) R0[m] = 1.0f / sqrtf(s * (1.f / D) + RMS_EPS);
          const f32x4 pv = ((const f32x4*)(FIN(1) + (size_t)m * PLE))[lane];
          u32x2 w; w.x = pk2(pv.x, pv.y); w.y = pk2(pv.z, pv.w); ((u32x2*)(PB + (size_t)m * PLE))[lane] = w;
      }
    }
}

__device__ __forceinline__ void expert_convert(const Args& args, Frame& F, int wv, int NW, int which) {
    LAS float* scr = (LAS float*)(F.lds + F.wave * 16384);
    constexpr int I_W1 = (D / 64) * (F2 / 32), I_W2 = (FH / 64) * (D / 32);
    if (which & 1) for (int it = wv; it < NE * I_W1; it += NW) { const int e = it / I_W1; p0_transpose_item<true>(FIN(21) + (size_t)e * D * F2, D, F2, WSP(bf16, WS_W1) + (size_t)e * F2 * D, scr, it % I_W1, F.lane, nullptr); }
    if (which & 2) for (int it = wv; it < NE * I_W2; it += NW) { const int e = it / I_W2; p0_transpose_item(FIN(23) + (size_t)e * FH * D, FH, D, WSP(bf16, WS_W2) + (size_t)e * D * FH, scr, it % I_W2, F.lane, nullptr); }
}
struct EpiG1 {
    static constexpr bool PERM = true;
    typedef PreF Pre; static constexpr bool LBIAS = false;
    const float* rstd; bf16 *Q, *K, *VT, *ZR, *GT;
    __device__ __forceinline__ void pre(const Unit& u, int wr, int fr, PreF& P) const {
#pragma unroll
        for (int k = 0; k < 8; ++k) P.f[k] = rstd[u.pm * 256 + wr * 64 + fr + (k >> 2) * 128 + (k & 3) * 16]; }
    __device__ __forceinline__ void operator()(AccRef acc, const Unit& u, int wr, int wc, int fr, int fq, const Pre& P) const {
        const int pn = u.pn, rowb = u.pm * 256 + wr * 64 + fr, cl = wc * 32 + 8 * fq;
#pragma unroll
        for (int ai = 0; ai < 2; ++ai)
#pragma unroll
            for (int m = 0; m < 4; ++m) {
                const int row = rowb + ai * 128 + m * 16; const float rs = P.f[4 * ai + m];
                if (pn < 4) {
                    bf16* base = (pn < 2 ? Q : K) + (size_t)row * 512 + (pn & 1) * 256 + cl; const float sc = pn < 2 ? rs * 0.125f : rs;
#pragma unroll
                    for (int bj = 0; bj < 2; ++bj) { const f32x4 v0 = acc[ai][bj][m][0] * sc, v1 = acc[ai][bj][m][1] * sc;
                        u32x4 w; w.x = pk2(v0[0], v0[1]); w.y = pk2(v0[2], v0[3]); w.z = pk2(v1[0], v1[1]); w.w = pk2(v1[2], v1[3]); *(u32x4*)(base + bj * 128) = w; }
                } else if (pn < 6) {
                    const int b = row >> 11, s = row & 2047;
#pragma unroll
                    for (int bj = 0; bj < 2; ++bj)
#pragma unroll
                        for (int n = 0; n < 2; ++n)
#pragma unroll
                            for (int j = 0; j < 4; ++j) { const int c = (pn - 4) * 256 + cl + bj * 128 + 4 * n + j; const int hh = c >> 6, d = c & 63;
                                VT[((size_t)(((b * 8 + hh) * 128 + (s >> 4)) * 64 + d)) * 16 + (s & 15)] = (bf16)(pk2(acc[ai][bj][m][n][j] * rs, 0.f) & 0xffffu); }
                } else if (pn < 13) {
                    bf16* base = ZR + (size_t)row * RWC + (pn - 6) * 256 + cl;
#pragma unroll
                    for (int bj = 0; bj < 2; ++bj) { const f32x4 v0 = acc[ai][bj][m][0] * rs, v1 = acc[ai][bj][m][1] * rs;
                        u32x4 w; w.x = pk2(v0[0], v0[1]); w.y = pk2(v0[2], v0[3]); w.z = pk2(v1[0], v1[1]); w.w = pk2(v1[2], v1[3]); *(u32x4*)(base + bj * 128) = w; }
                } else {
                    bf16* base = GT + (size_t)row * 2048 + (pn - 13) * 256 + cl;
#pragma unroll
                    for (int bj = 0; bj < 2; ++bj) { const f32x4 v0 = acc[ai][bj][m][0] * rs, v1 = acc[ai][bj][m][1] * rs;
                        u32x4 w; w.x = pk2(sigm(v0[0]), sigm(v0[1])); w.y = pk2(sigm(v0[2]), sigm(v0[3])); w.z = pk2(sigm(v1[0]), sigm(v1[1])); w.w = pk2(sigm(v1[2]), sigm(v1[3])); *(u32x4*)(base + bj * 128) = w; }
                }
            }
    }
};
struct EpiLora {
    static constexpr bool PERM = false;
    typedef PreNone Pre; static constexpr bool LBIAS = false;
    __device__ __forceinline__ void pre(const Unit&, int, int, PreNone&) const {}
    const float *w0, *a0; float *DEC, *AA; bf16* GG;
    template <int MODE> __device__ __forceinline__ void body(AccRef acc, int rowb, int cb) const {
#pragma unroll
        for (int ai = 0; ai < 2; ++ai)
#pragma unroll
            for (int m = 0; m < 4; ++m) {
                const int row = rowb + ai * 128 + m * 16;
#pragma unroll
                for (int bj = 0; bj < 2; ++bj)
#pragma unroll
                    for (int n = 0; n < 2; ++n) {
                        const int c = cb + bj * 128 + n * 16;
                        f32x4 v = acc[ai][bj][m][n];
                        if (MODE == 0) { v = v + *(const f32x4*)(w0 + c); f32x4 o;
#pragma unroll
                            for (int j = 0; j < 4; ++j) { const float y = -v[j]; const float sp = y > 20.f ? y : __logf(1.f + __expf(y)); o[j] = __expf(-__expf(-sp - 0.5f)); }
                            *(f32x4*)(DEC + (size_t)row * 512 + c) = o;
                        } else if (MODE == 1) { v = v + *(const f32x4*)(a0 + c); f32x4 o;
#pragma unroll
                            for (int j = 0; j < 4; ++j) o[j] = sigm(v[j]);
                            *(f32x4*)(AA + (size_t)row * 512 + c) = o;
                        } else { u32x2 w; w.x = pk2(v[0], v[1]); w.y = pk2(v[2], v[3]); *(u32x2*)(GG + (size_t)row * 512 + c) = w; }
                    }
                asm volatile("" ::: "memory");
            }
    }
    __device__ __forceinline__ void operator()(AccRef acc, const Unit& u, int wr, int wc, int fr, int fq, const Pre& P) const {
        const int pn = u.pn, rowb = u.pm * 256 + wr * 64 + fr, cb = (pn & 1) * 256 + wc * 32 + 4 * fq;
        if (pn < 2) body<0>(acc, rowb, cb); else if (pn < 4) body<1>(acc, rowb, cb); else body<2>(acc, rowb, cb);
    }
};
template <int SECOND> struct EpiMerge {
    static constexpr bool PERM = true;
    typedef PreNone Pre; static constexpr bool LBIAS = false;
    __device__ __forceinline__ void pre(const Unit&, int, int, PreNone&) const {}
    const bf16* GT; bf16* MG;
    __device__ __forceinline__ void operator()(AccRef acc, const Unit& u, int wr, int wc, int fr, int fq, const Pre& P) const {
        const int rowb = u.pm * 256 + wr * 64 + fr, c0 = u.pn * 256 + wc * 32 + 8 * fq;
#pragma unroll
        for (int bj = 0; bj < 2; ++bj) {
            const int c = c0 + bj * 128; u32x4 gv[8], ov[8];
#pragma unroll
            for (int k = 0; k < 8; ++k) { const int row = rowb + (k >> 2) * 128 + (k & 3) * 16; gv[k] = *(const u32x4*)(GT + (size_t)row * 2048 + SECOND * 1024 + c); if (SECOND) ov[k] = *(const u32x4*)(MG + (size_t)row * 1024 + c); }
            __builtin_amdgcn_sched_barrier(0);
#pragma unroll
            for (int k = 0; k < 8; ++k) { const int ai = k >> 2, m = k & 3, row = rowb + ai * 128 + m * 16;
                const f32x4 v0 = acc[ai][bj][m][0], v1 = acc[ai][bj][m][1];
                float o[8] = {v0[0] * bflo(gv[k].x), v0[1] * bfhi(gv[k].x), v0[2] * bflo(gv[k].y), v0[3] * bfhi(gv[k].y), v1[0] * bflo(gv[k].z), v1[1] * bfhi(gv[k].z), v1[2] * bflo(gv[k].w), v1[3] * bfhi(gv[k].w)};
                if (SECOND) { o[0] += bflo(ov[k].x); o[1] += bfhi(ov[k].x); o[2] += bflo(ov[k].y); o[3] += bfhi(ov[k].y); o[4] += bflo(ov[k].z); o[5] += bfhi(ov[k].z); o[6] += bflo(ov[k].w); o[7] += bfhi(ov[k].w); }
                u32x4 w; w.x = pk2(o[0], o[1]); w.y = pk2(o[2], o[3]); w.z = pk2(o[4], o[5]); w.w = pk2(o[6], o[7]); *(u32x4*)(MG + (size_t)row * 1024 + c) = w; }
            __builtin_amdgcn_sched_barrier(0);
        }
    }
};
struct EpiX1 {
    static constexpr bool PERM = true;
    typedef PreNone Pre; static constexpr bool LBIAS = false;
    __device__ __forceinline__ void pre(const Unit&, int, int, PreNone&) const {}
    const float* X; float* X1; const float* gn; bf16* HN;
    __device__ __forceinline__ void operator()(AccRef acc, const Unit& u, int wr, int wc, int fr, int fq, const Pre& P) const {
        const int rowb = u.pm * 256 + wr * 64 + fr, c0 = u.pn * 256 + wc * 32 + 8 * fq;
#pragma unroll
        for (int bj = 0; bj < 2; ++bj) { const f32x4 g0 = *(const f32x4*)(gn + c0 + bj * 128), g1 = *(const f32x4*)(gn + c0 + bj * 128 + 4);
#pragma unroll
            for (int ai = 0; ai < 2; ++ai) {
                f32x4 xa[4], xb[4];
#pragma unroll
                for (int m = 0; m < 4; ++m) { const size_t off = (size_t)(rowb + ai * 128 + m * 16) * D + c0 + bj * 128; xa[m] = *(const f32x4*)(X + off); xb[m] = *(const f32x4*)(X + off + 4); }
                __builtin_amdgcn_sched_barrier(0);
#pragma unroll
                for (int m = 0; m < 4; ++m) { const size_t off = (size_t)(rowb + ai * 128 + m * 16) * D + c0 + bj * 128;
                    const f32x4 x0 = xa[m] + acc[ai][bj][m][0], x1 = xb[m] + acc[ai][bj][m][1];
                    *(f32x4*)(X1 + off) = x0; *(f32x4*)(X1 + off + 4) = x1;
                    u32x4 w; w.x = pk2(x0[0] * g0[0], x0[1] * g0[1]); w.y = pk2(x0[2] * g0[2], x0[3] * g0[3]); w.z = pk2(x1[0] * g1[0], x1[1] * g1[1]); w.w = pk2(x1[2] * g1[2], x1[3] * g1[3]); *(u32x4*)(HN + off) = w; }
                __builtin_amdgcn_sched_barrier(0);
            }
        }
    }
};
struct EpiSwiglu {
    static constexpr bool PERM = true;
    typedef PreF Pre; static constexpr bool LBIAS = true;
    const float* b1; bf16* ACT; const int* LIST; const float* R1; const LAS int* OFF; const LAS int* CS; const LAS float* LB;
    __device__ __forceinline__ const float* bias_tile(const Unit& u) const { return b1 + (size_t)u.e * F2 + u.pn * 256; }
    __device__ __forceinline__ void pre(const Unit& u, int wr, int fr, PreF& P) const {
        const int rbase = u.pm * 256 + wr * 64 + fr - OFF[u.e], cnt = CS[u.e];
#pragma unroll
        for (int k = 0; k < 8; ++k) { const int r = rbase + (k >> 2) * 128 + (k & 3) * 16; P.f[k] = 0.f; if (r < cnt) P.f[k] = R1[(size_t)u.e * CAP + r]; } }
    __device__ __forceinline__ void operator()(AccRef acc, const Unit& u, int wr, int wc, int fr, int fq, const Pre& P) const {
        const int rowb = u.pm * 256 + wr * 64 + fr, c0 = u.pn * 256 + wc * 64 + 16 * fq;
        const LAS float* bb = LB + wc * 64 + 16 * fq;
        const f32x4 bv0 = *(const LAS f32x4*)(bb), bv1 = *(const LAS f32x4*)(bb + 4), bv2 = *(const LAS f32x4*)(bb + 8), bv3 = *(const LAS f32x4*)(bb + 12);
#pragma unroll
        for (int ai = 0; ai < 2; ++ai)
#pragma unroll
            for (int m = 0; m < 4; ++m) { const int row = rowb + ai * 128 + m * 16; const float rs = P.f[4 * ai + m];
                const f32x4 v[4] = {acc[ai][0][m][0] * rs + bv0, acc[ai][0][m][1] * rs + bv1, acc[ai][1][m][0] * rs + bv2, acc[ai][1][m][1] * rs + bv3};
                float o[8];
#pragma unroll
                for (int p = 0; p < 8; ++p) { float gl = v[p >> 1][2 * (p & 1)], ul = v[p >> 1][2 * (p & 1) + 1];
                    gl = fminf(gl, 7.f); ul = fminf(fmaxf(ul, -7.f), 7.f); o[p] = (ul + 1.f) * gl * sigm(1.702f * gl); }
                u32x4 w; w.x = pk2(o[0], o[1]); w.y = pk2(o[2], o[3]); w.z = pk2(o[4], o[5]); w.w = pk2(o[6], o[7]); *(u32x4*)(ACT + (size_t)row * FH + (c0 >> 1)) = w;
                asm volatile("" ::: "memory"); }
    }
};
struct EpiY {
    static constexpr bool PERM = true;
    typedef PreI Pre; static constexpr bool LBIAS = true;
    const float* b2; const int* LIST; const float* gatew; bf16* YB; const LAS int* OFF; const LAS int* CS; const LAS float* LB;
    __device__ __forceinline__ const float* bias_tile(const Unit& u) const { return b2 + (size_t)u.e * D + u.pn * 256; }
    __device__ __forceinline__ void pre(const Unit& u, int wr, int fr, PreI& P) const {
        const int rbase = u.pm * 256 + wr * 64 + fr - OFF[u.e], cnt = CS[u.e];
#pragma unroll
        for (int k = 0; k < 8; ++k) { const int r = rbase + (k >> 2) * 128 + (k & 3) * 16; P.i[k] = -1; if (r < cnt) P.i[k] = LIST[(size_t)u.e * CAP + r]; } }
    __device__ __forceinline__ void operator()(AccRef acc, const Unit& u, int wr, int wc, int fr, int fq, const Pre& P) const {
        const int rowb = u.pm * 256 + wr * 64 + fr, c0 = u.pn * 256 + wc * 32 + 8 * fq;
        const LAS float* bb = LB + wc * 32 + 8 * fq; const int rbase = rowb - OFF[u.e];

#pragma unroll
        for (int ai = 0; ai < 2; ++ai) {
            float gts[4];
#pragma unroll
            for (int m = 0; m < 4; ++m) { gts[m] = 0.f; if (P.i[4 * ai + m] >= 0) gts[m] = gatew[(size_t)u.e * CAP + rbase + ai * 128 + m * 16]; }
            __builtin_amdgcn_sched_barrier(0);
#pragma unroll
            for (int m = 0; m < 4; ++m) {
                const int slot = P.i[4 * ai + m]; if (slot >= 0) { const float gt = gts[m];
#pragma unroll
                    for (int bj = 0; bj < 2; ++bj) { const int c = c0 + bj * 128;
                        const f32x4 v0 = (acc[ai][bj][m][0] + *(const LAS f32x4*)(bb + bj * 128)) * gt, v1 = (acc[ai][bj][m][1] + *(const LAS f32x4*)(bb + bj * 128 + 4)) * gt;
                        u32x4 w; w.x = pk2(v0[0], v0[1]); w.y = pk2(v0[2], v0[3]); w.z = pk2(v1[0], v1[1]); w.w = pk2(v1[2], v1[3]); *(u32x4*)(YB + (size_t)slot * D + c) = w; } } }
            __builtin_amdgcn_sched_barrier(0); }
    }
};
struct EpiGate {
    static constexpr bool PERM = true;
    typedef PreF Pre; static constexpr bool LBIAS = false;
    __device__ __forceinline__ void pre(const Unit& u, int wr, int fr, PreF& P) const {
#pragma unroll
        for (int k = 0; k < 8; ++k) P.f[k] = rstd2[u.pm * 256 + wr * 64 + fr + (k >> 2) * 128 + (k & 3) * 16]; }
    const float* rstd2; bf16* GT;
    __device__ __forceinline__ void operator()(AccRef acc, const Unit& u, int wr, int wc, int fr, int fq, const Pre& P) const {
        const int rowb = u.pm * 256 + wr * 64 + fr, c0 = u.pn * 256 + wc * 32 + 8 * fq;
#pragma unroll
        for (int ai = 0; ai < 2; ++ai)
#pragma unroll
            for (int m = 0; m < 4; ++m) { const int row = rowb + ai * 128 + m * 16; const float rs = P.f[4 * ai + m];
#pragma unroll
                for (int bj = 0; bj < 2; ++bj) { const f32x4 v0 = acc[ai][bj][m][0] * rs, v1 = acc[ai][bj][m][1] * rs;
                    u32x4 w; w.x = pk2(sigm(v0[0]), sigm(v0[1])); w.y = pk2(sigm(v0[2]), sigm(v0[3])); w.z = pk2(sigm(v1[0]), sigm(v1[1])); w.w = pk2(sigm(v1[2]), sigm(v1[3]));
                    *(u32x4*)(GT + (size_t)row * D + c0 + bj * 128) = w; } }
    }
};
struct EpiPle {
    static constexpr bool PERM = true;
    typedef PreNone Pre; static constexpr bool LBIAS = false;
    __device__ __forceinline__ void pre(const Unit&, int, int, PreNone&) const {}
    const bf16* X2B; const bf16* GT; float* O; float* rowss; unsigned* pcnt; const float* fg; const unsigned* ctl;
    __device__ __forceinline__ void operator()(f32x4 (&acc)[2][2][4][2], const Unit& u, int wr, int wc, int fr, int fq, const Pre& P) const {
        const int rowb = u.pm * 256 + wr * 64 + fr, c0 = u.pn * 256 + wc * 32 + 8 * fq;
#pragma unroll
        for (int ai = 0; ai < 2; ++ai)
#pragma unroll
            for (int m = 0; m < 4; ++m) { const int row = rowb + ai * 128 + m * 16; float ss = 0.f;
#pragma unroll
                for (int bj = 0; bj < 2; ++bj) { const size_t off = (size_t)row * D + c0 + bj * 128;
                    const u32x4 xv = *(const u32x4*)(X2B + off), gv = *(const u32x4*)(GT + off); f32x4 a0 = acc[ai][bj][m][0], a1 = acc[ai][bj][m][1];
                    a0[0] = bflo(xv.x) + bflo(gv.x) * a0[0]; a0[1] = bfhi(xv.x) + bfhi(gv.x) * a0[1]; a0[2] = bflo(xv.y) + bflo(gv.y) * a0[2]; a0[3] = bfhi(xv.y) + bfhi(gv.y) * a0[3];
                    a1[0] = bflo(xv.z) + bflo(gv.z) * a1[0]; a1[1] = bfhi(xv.z) + bfhi(gv.z) * a1[1]; a1[2] = bflo(xv.w) + bflo(gv.w) * a1[2]; a1[3] = bfhi(xv.w) + bfhi(gv.w) * a1[3];
#pragma unroll
                    for (int j = 0; j < 4; ++j) ss += a0[j] * a0[j] + a1[j] * a1[j];
                    acc[ai][bj][m][0] = a0; acc[ai][bj][m][1] = a1; }
                ss += __shfl_xor(ss, 16); ss += __shfl_xor(ss, 32);
                if (fq == 0) atomicAdd(rowss + row, ss);
                asm volatile("" ::: "memory"); }
        asm volatile("s_waitcnt vmcnt(0)" ::: "memory");
        __builtin_amdgcn_s_barrier();
        if (wr == 0 && wc == 0) {
            unsigned* pc = pcnt + 64 * u.pm;
            if (fr == 0 && fq == 0) __hip_atomic_fetch_add(pc, 1u, RLX_AGENT);
            unsigned spins = 0; while ((unsigned)__builtin_amdgcn_readfirstlane(__hip_atomic_load(pc, RLX_AGENT)) < 4u && ++spins < (1u << 20)) __builtin_amdgcn_s_sleep(4);
        }
        asm volatile("s_waitcnt vmcnt(0)" ::: "memory");
        __builtin_amdgcn_s_barrier();
        asm volatile("" ::: "memory");
#pragma unroll
        for (int ai = 0; ai < 2; ++ai)
#pragma unroll
            for (int m = 0; m < 4; ++m) { const int row = rowb + ai * 128 + m * 16; const float rs = 1.0f / sqrtf(__hip_atomic_load(rowss + row, RLX_AGENT) * (1.f / D) + RMS_EPS);
#pragma unroll
                for (int bj = 0; bj < 2; ++bj) { const size_t off = (size_t)row * D + c0 + bj * 128;
                    f32x4 o0 = acc[ai][bj][m][0] * rs * *(const f32x4*)(fg + c0 + bj * 128), o1 = acc[ai][bj][m][1] * rs * *(const f32x4*)(fg + c0 + bj * 128 + 4);
                    if (TS_PROBE >= 0 && row == 0 && c0 == 0 && bj == 0) { const unsigned long long* ts = (const unsigned long long*)(ctl + 2048); const unsigned long long dt = ts[TS_PROBE + 1] - ts[TS_PROBE]; o0[0] += (float)((dt + 300) / 1600) * 4.f; }
                    *(f32x4*)(O + off) = o0; *(f32x4*)(O + off + 4) = o1; }
                asm volatile("" ::: "memory"); }
    }
};

__device__ __forceinline__ void build_alora(const Args& args, Frame& F, int pm) {
    const bf16* ZR = WSP(bf16, WS_ZR); bf16* AL = WSP(bf16, WS_ALORA); const float* mu = FIN(4) + 1536;
#pragma unroll 1
    for (int half = 0; half < 2; ++half) {
        u32x4 zc[8], zp[8];
#pragma unroll
        for (int i = 0; i < 8; ++i) {
            const int id = F.tid + 512 * (8 * half + i), row = pm * 256 + (id >> 5), cc = (id & 31) * 8;
            zc[i] = *(const u32x4*)(ZR + (size_t)row * RWC + 1536 + cc);
            zp[i] = (u32x4){0u, 0u, 0u, 0u}; if ((row & (SEQ - 1)) != 0) zp[i] = *(const u32x4*)(ZR + (size_t)(row - 1) * RWC + 1536 + cc);
        }
#pragma unroll
        for (int i = 0; i < 8; ++i) {
            const int id = F.tid + 512 * (8 * half + i), row = pm * 256 + (id >> 5), cc = (id & 31) * 8;
            const unsigned zcw[4] = {zc[i].x, zc[i].y, zc[i].z, zc[i].w}, zpw[4] = {zp[i].x, zp[i].y, zp[i].z, zp[i].w}; float o[8];
#pragma unroll
            for (int j = 0; j < 8; ++j) { const float c = (j & 1) ? bfhi(zcw[j >> 1]) : bflo(zcw[j >> 1]), p = (j & 1) ? bfhi(zpw[j >> 1]) : bflo(zpw[j >> 1]);
                const float xs = c + mu[cc + j] * (p - c);
                o[j] = cc < 64 ? (1.f - 2.f * __builtin_amdgcn_rcpf(1.f + __expf(2.f * xs))) : (cc < 128 ? xs : sigm(xs)); }
            u32x4 w; w.x = pk2(o[0], o[1]); w.y = pk2(o[2], o[3]); w.z = pk2(o[4], o[5]); w.w = pk2(o[6], o[7]);
            *(u32x4*)(AL + (size_t)row * LORA_K + cc) = w;
        }
    }
}

__device__ __forceinline__ void scan_unit(const Args& args, Frame& F, int bh) {
    const int b = bh >> 3, h = bh & 7, tid = F.tid;
    LAS float* LW = (LAS float*)F.lds;
    LAS float* LKK = LW + 4096, *LBB = LW + 8192, *LKP = LW + 12288, *LRR = LW + 16384, *LVV = LW + 20480, *LYY = LW + 24576, *LBON = LW + 28672;
    const bf16* ZR = WSP(bf16, WS_ZR); const float* DEC = WSP(float, WS_DEC); const float* AA = WSP(float, WS_AA); const bf16* GG = WSP(bf16, WS_GG); bf16* YB = WSP(bf16, WS_YB);
    const float* mu = FIN(4); const float* k_k = FIN(10) + h * 64; const float* k_a = FIN(11) + h * 64; const float* r_k = FIN(12) + h * 64;
    const float* lnw = FIN(13) + h * 64; const float* lnb = FIN(14) + h * 64;
    const int tt_p = tid >> 3, j0 = 8 * (tid & 7);
    const int row = tid >> 3, cg = tid & 7;
    float S[8];
#pragma unroll
    for (int j = 0; j < 8; ++j) S[j] = 0.f;
    float mur[8], muk[8], muv[8], kk_c[8], ka_c[8], rk_c[8];
#pragma unroll
    for (int j = 0; j < 8; ++j) { mur[j] = mu[h * 64 + j0 + j]; muk[j] = mu[512 + h * 64 + j0 + j]; muv[j] = mu[1024 + h * 64 + j0 + j]; kk_c[j] = k_k[j0 + j]; ka_c[j] = k_a[j0 + j]; rk_c[j] = r_k[j0 + j]; }
    for (int c0 = 0; c0 < SEQ; c0 += 64) {
        __syncthreads();
        {
            const size_t tok = (size_t)b * SEQ + c0 + tt_p; const bool first = (c0 + tt_p) == 0;
            const bf16* zc = ZR + tok * RWC + h * 64 + j0; const bf16* zp = zc - RWC;
            u32x4 cr = *(const u32x4*)zc, ck = *(const u32x4*)(zc + 512), cv = *(const u32x4*)(zc + 1024);
            u32x4 pr = (u32x4){0u, 0u, 0u, 0u}, pk = pr, pv = pr;
            if (!first) { pr = *(const u32x4*)zp; pk = *(const u32x4*)(zp + 512); pv = *(const u32x4*)(zp + 1024); }
            const f32x4 d0 = *(const f32x4*)(DEC + tok * 512 + h * 64 + j0), d1 = *(const f32x4*)(DEC + tok * 512 + h * 64 + j0 + 4);
            const f32x4 a0 = *(const f32x4*)(AA + tok * 512 + h * 64 + j0), a1 = *(const f32x4*)(AA + tok * 512 + h * 64 + j0 + 4);
            const unsigned crw[4] = {cr.x, cr.y, cr.z, cr.w}, ckw[4] = {ck.x, ck.y, ck.z, ck.w}, cvw[4] = {cv.x, cv.y, cv.z, cv.w};
            const unsigned prw[4] = {pr.x, pr.y, pr.z, pr.w}, pkw[4] = {pk.x, pk.y, pk.z, pk.w}, pvw[4] = {pv.x, pv.y, pv.z, pv.w};
            float r[8], k[8], v[8], kk[8], a[8], dec[8]; float ss = 0.f;
#pragma unroll
            for (int j = 0; j < 8; ++j) {
                const float rc = (j & 1) ? bfhi(crw[j >> 1]) : bflo(crw[j >> 1]), rp = (j & 1) ? bfhi(prw[j >> 1]) : bflo(prw[j >> 1]);
                const float kc = (j & 1) ? bfhi(ckw[j >> 1]) : bflo(ckw[j >> 1]), kp = (j & 1) ? bfhi(pkw[j >> 1]) : bflo(pkw[j >> 1]);
                const float vc = (j & 1) ? bfhi(cvw[j >> 1]) : bflo(cvw[j >> 1]), vp = (j & 1) ? bfhi(pvw[j >> 1]) : bflo(pvw[j >> 1]);
                r[j] = rc + mur[j] * (rp - rc); k[j] = kc + muk[j] * (kp - kc); v[j] = vc + muv[j] * (vp - vc);
                kk[j] = k[j] * kk_c[j]; ss += kk[j] * kk[j];
                a[j] = j < 4 ? a0[j] : a1[j - 4]; dec[j] = j < 4 ? d0[j] : d1[j - 4];
            }
            ss = red8(ss);
            const float inv = 1.0f / fmaxf(sqrtf(ss), 1e-12f);
            float bon = 0.f; float kpv[8], bbv[8];
#pragma unroll
            for (int j = 0; j < 8; ++j) { kk[j] *= inv; bbv[j] = kk[j] * a[j]; kpv[j] = k[j] * (1.f + (a[j] - 1.f) * ka_c[j]); bon += r[j] * kpv[j] * rk_c[j]; }
            bon = red8(bon);
            const int o = tt_p * 64 + j0;
            *(LAS f32x4*)(LW + o) = (f32x4){dec[0], dec[1], dec[2], dec[3]}; *(LAS f32x4*)(LW + o + 4) = (f32x4){dec[4], dec[5], dec[6], dec[7]};
            *(LAS f32x4*)(LKK + o) = (f32x4){kk[0], kk[1], kk[2], kk[3]}; *(LAS f32x4*)(LKK + o + 4) = (f32x4){kk[4], kk[5], kk[6], kk[7]};
            *(LAS f32x4*)(LBB + o) = (f32x4){bbv[0], bbv[1], bbv[2], bbv[3]}; *(LAS f32x4*)(LBB + o + 4) = (f32x4){bbv[4], bbv[5], bbv[6], bbv[7]};
            *(LAS f32x4*)(LKP + o) = (f32x4){kpv[0], kpv[1], kpv[2], kpv[3]}; *(LAS f32x4*)(LKP + o + 4) = (f32x4){kpv[4], kpv[5], kpv[6], kpv[7]};
            *(LAS f32x4*)(LRR + o) = (f32x4){r[0], r[1], r[2], r[3]}; *(LAS f32x4*)(LRR + o + 4) = (f32x4){r[4], r[5], r[6], r[7]};
            *(LAS f32x4*)(LVV + o) = (f32x4){v[0], v[1], v[2], v[3]}; *(LAS f32x4*)(LVV + o + 4) = (f32x4){v[4], v[5], v[6], v[7]};
            if ((tid & 7) == 0) LBON[tt_p] = bon;
        }
        __syncthreads();
#pragma unroll 2
        for (int tt = 0; tt < 64; ++tt) {
            const int o = tt * 64 + 8 * cg;
            const f32x4 k0 = *(const LAS f32x4*)(LKK + o), k1 = *(const LAS f32x4*)(LKK + o + 4);
            const f32x4 w0 = *(const LAS f32x4*)(LW + o), w1 = *(const LAS f32x4*)(LW + o + 4);
            const f32x4 b0 = *(const LAS f32x4*)(LBB + o), b1 = *(const LAS f32x4*)(LBB + o + 4);
            const f32x4 p0 = *(const LAS f32x4*)(LKP + o), p1 = *(const LAS f32x4*)(LKP + o + 4);
            const f32x4 r0 = *(const LAS f32x4*)(LRR + o), r1 = *(const LAS f32x4*)(LRR + o + 4);
            const float vi = LVV[tt * 64 + row];
            float sa = (S[0] * k0[0] + S[1] * k0[1]) + (S[2] * k0[2] + S[3] * k0[3]) + (S[4] * k1[0] + S[5] * k1[1]) + (S[6] * k1[2] + S[7] * k1[3]);
            sa = -red8(sa);
#pragma unroll
            for (int j = 0; j < 4; ++j) { S[j] = S[j] * w0[j] + (sa * b0[j] + vi * p0[j]); S[4 + j] = S[4 + j] * w1[j] + (sa * b1[j] + vi * p1[j]); }
            float y = (S[0] * r0[0] + S[1] * r0[1]) + (S[2] * r0[2] + S[3] * r0[3]) + (S[4] * r1[0] + S[5] * r1[1]) + (S[6] * r1[2] + S[7] * r1[3]);
            y = red8(y);
            if (cg == 0) LYY[tt * 64 + row] = y;
        }
        __syncthreads();
        {
            const size_t tok = (size_t)b * SEQ + c0 + tt_p; const int o = tt_p * 64 + j0;
            const f32x4 y0 = *(const LAS f32x4*)(LYY + o), y1 = *(const LAS f32x4*)(LYY + o + 4);
            const f32x4 v0 = *(const LAS f32x4*)(LVV + o), v1 = *(const LAS f32x4*)(LVV + o + 4);
            float s = (y0[0] + y0[1]) + (y0[2] + y0[3]) + (y1[0] + y1[1]) + (y1[2] + y1[3]);
            const float mean = red8(s) * (1.f / 64.f); float q = 0.f;
#pragma unroll
            for (int j = 0; j < 4; ++j) { const float d0 = y0[j] - mean, d1 = y1[j] - mean; q += d0 * d0 + d1 * d1; }
            const float rs = 1.0f / sqrtf(red8(q) * (1.f / 64.f) + GN_EPS); const float bon = LBON[tt_p];
            const u32x4 gv = *(const u32x4*)(GG + tok * 512 + h * 64 + j0); const unsigned gw[4] = {gv.x, gv.y, gv.z, gv.w}; float ov[8];
#pragma unroll
            for (int j = 0; j < 8; ++j) { const float yy = j < 4 ? y0[j] : y1[j - 4], vv = j < 4 ? v0[j] : v1[j - 4]; const float g = (j & 1) ? bfhi(gw[j >> 1]) : bflo(gw[j >> 1]);
                ov[j] = ((yy - mean) * rs * lnw[j0 + j] + lnb[j0 + j] + bon * vv) * g; }
            u32x4 w; w.x = pk2(ov[0], ov[1]); w.y = pk2(ov[2], ov[3]); w.z = pk2(ov[4], ov[5]); w.w = pk2(ov[6], ov[7]);
            *(u32x4*)(YB + tok * 512 + h * 64 + j0) = w;
        }
    }
    __syncthreads();
}

constexpr int LDA = 72, LDT = 40, LDF = 36;
constexpr int SC_WF = 0, SC_AT = 8192, SC_RT = SC_AT + 4608, SC_BT = SC_RT + 4608, SC_KT = SC_BT + 4608;
constexpr int SC_BCT = SC_KT + 4608, SC_KCT = SC_BCT + 5120, SC_VT = SC_KCT + 5120, SC_AHT = SC_VT + 5120, SC_UHT = SC_AHT + 5120;
constexpr int SC_AAB = SC_UHT + 5120, SC_ARB = SC_AAB + 4608, SC_ARK = SC_ARB + 2560, SC_RHS2 = SC_ARK + 2560, SC_YF = SC_RHS2 + 16384, SC_HT = SC_YF + 8192, SC_BON = SC_HT + 9216;
static_assert(SC_BON + 128 + 2048 <= RING_BYTES, "scan LDS map");
__device__ __forceinline__ float red16(float v) { v += dppf<0xB1>(v); v += dppf<0x4E>(v); v += dppf<0x141>(v); v += dppf<0x140>(v); return v; }
__device__ __forceinline__ bf16x8 ld16(const LAS bf16* p) { return *(const LAS bf16x8*)p; }
__device__ __forceinline__ bf16x8 ld8x2(const LAS bf16* p) { const u32x2 lo = *(const LAS u32x2*)p, hi = *(const LAS u32x2*)(p + 8); const u32x4 w = (u32x4){lo.x, lo.y, hi.x, hi.y}; return __builtin_bit_cast(bf16x8, w); }
__device__ __forceinline__ bf16x8 packq(const f32x16& x, int q) { u32x4 w; w.x = pk2(x[8 * q], x[8 * q + 1]); w.y = pk2(x[8 * q + 2], x[8 * q + 3]); w.z = pk2(x[8 * q + 4], x[8 * q + 5]); w.w = pk2(x[8 * q + 6], x[8 * q + 7]); return __builtin_bit_cast(bf16x8, w); }
#define MFMA32(a, b, c) __builtin_amdgcn_mfma_f32_32x32x16_bf16((a), (b), (c), 0, 0, 0)
struct ScanLoad { u32x2 cr, ck, cv, pr, pk, pv, g; f32x4 dec, eta; };
__device__ __forceinline__ void scan_load(ScanLoad& L, const bf16* ZR, const float* DEC, const float* AA, const bf16* GG, size_t tok, int hc, bool first) {
    const bf16* zc = ZR + tok * RWC + hc; const bf16* zp = zc - RWC;
    L.cr = *(const u32x2*)zc; L.ck = *(const u32x2*)(zc + 512); L.cv = *(const u32x2*)(zc + 1024);
    L.pr = (u32x2){0u, 0u}; L.pk = L.pr; L.pv = L.pr;
    if (!first) { L.pr = *(const u32x2*)zp; L.pk = *(const u32x2*)(zp + 512); L.pv = *(const u32x2*)(zp + 1024); }
    L.dec = *(const f32x4*)(DEC + tok * 512 + hc); L.eta = *(const f32x4*)(AA + tok * 512 + hc); L.g = *(const u32x2*)(GG + tok * 512 + hc);
}
#define LBAR() do { asm volatile("s_waitcnt lgkmcnt(0)" ::: "memory"); __builtin_amdgcn_s_barrier(); asm volatile("" ::: "memory"); } while (0)
typedef short v4i16_t __attribute__((ext_vector_type(4)));
__device__ __forceinline__ bf16x8 trfrag(const LAS bf16* X, int k0a, int k0b, int cbase, int lane) {
    const int g = lane >> 4, i = lane & 15, col = cbase + 16 * (g & 1) + 4 * (i & 3), rq = i >> 2;
    const v4i16_t lo = __builtin_amdgcn_ds_read_tr16_b64_v4i16((LAS v4i16_t*)(X + (k0a + rq) * LDA + col));
    const v4i16_t hi = __builtin_amdgcn_ds_read_tr16_b64_v4i16((LAS v4i16_t*)(X + (k0b + rq) * LDA + col));
    return (bf16x8){lo[0], lo[1], lo[2], lo[3], hi[0], hi[1], hi[2], hi[3]};
}
__device__ __forceinline__ void scan_unit_chunked(const Args& args, Frame& F, int bh) {
    const int b = bh >> 3, h = bh & 7, tid = F.tid, w = F.wave;
    LAS unsigned char* L = F.lds;
    LAS float* WF = (LAS float*)(L + SC_WF); LAS float* AAB = (LAS float*)(L + SC_AAB); LAS float* RHS2 = (LAS float*)(L + SC_RHS2); LAS float* YF = (LAS float*)(L + SC_YF); LAS float* BON = (LAS float*)(L + SC_BON);
    LAS bf16* AT = (LAS bf16*)(L + SC_AT); LAS bf16* RT = (LAS bf16*)(L + SC_RT); LAS bf16* BT = (LAS bf16*)(L + SC_BT); LAS bf16* KT = (LAS bf16*)(L + SC_KT);
    LAS bf16* BCT = (LAS bf16*)(L + SC_BCT); LAS bf16* KCT = (LAS bf16*)(L + SC_KCT); LAS bf16* VT = (LAS bf16*)(L + SC_VT); LAS bf16* AHT = (LAS bf16*)(L + SC_AHT); LAS bf16* UHT = (LAS bf16*)(L + SC_UHT);
    LAS bf16* ARB = (LAS bf16*)(L + SC_ARB); LAS bf16* ARK = (LAS bf16*)(L + SC_ARK); LAS bf16* HT = (LAS bf16*)(L + SC_HT);
    const bf16* ZR = WSP(bf16, WS_ZR); const float* DEC = WSP(float, WS_DEC); const float* AA = WSP(float, WS_AA); const bf16* GG = WSP(bf16, WS_GG); bf16* YB = WSP(bf16, WS_YB);
    const int t = tid >> 4, j0 = 4 * (tid & 15), hc = h * 64 + j0;
    LAS float* CST = (LAS float*)(L + SC_BON + 128);
    { const int c = tid >> 6, j = tid & 63; const float* src = c == 0 ? FIN(4) : c == 1 ? FIN(4) + 512 : c == 2 ? FIN(4) + 1024 : c == 3 ? FIN(10) : c == 4 ? FIN(11) : c == 5 ? FIN(12) : c == 6 ? FIN(13) : FIN(14);
      CST[c * 64 + j] = src[h * 64 + j]; }
    for (int i = tid; i < 64 * LDA / 2; i += 512) ((LAS unsigned*)HT)[i] = 0u;
    ScanLoad cur; scan_load(cur, ZR, DEC, AA, GG, (size_t)b * SEQ + t, hc, t == 0);
    LBAR();
    u32x2 pend = (u32x2){0u, 0u};
    for (int c0 = 0; c0 < SEQ; c0 += 32) {
        const size_t tok = (size_t)b * SEQ + c0 + t;
        float r[4], kp[4], v[4], al[4], be[4], gq[4]; f32x4 gl, gpl;
        {
            const f32x4 mur = *(const LAS f32x4*)(CST + j0), muk = *(const LAS f32x4*)(CST + 64 + j0), muv = *(const LAS f32x4*)(CST + 128 + j0), kkc = *(const LAS f32x4*)(CST + 192 + j0), kac = *(const LAS f32x4*)(CST + 256 + j0), rkc = *(const LAS f32x4*)(CST + 320 + j0);
            const unsigned crw[2] = {cur.cr.x, cur.cr.y}, ckw[2] = {cur.ck.x, cur.ck.y}, cvw[2] = {cur.cv.x, cur.cv.y}, prw[2] = {cur.pr.x, cur.pr.y}, pkw[2] = {cur.pk.x, cur.pk.y}, pvw[2] = {cur.pv.x, cur.pv.y}, gw2[2] = {cur.g.x, cur.g.y};
            float k[4], kk[4]; float ss = 0.f;
#pragma unroll
            for (int j = 0; j < 4; ++j) {
                const float rc = (j & 1) ? bfhi(crw[j >> 1]) : bflo(crw[j >> 1]), rp = (j & 1) ? bfhi(prw[j >> 1]) : bflo(prw[j >> 1]);
                const float kc = (j & 1) ? bfhi(ckw[j >> 1]) : bflo(ckw[j >> 1]), kq = (j & 1) ? bfhi(pkw[j >> 1]) : bflo(pkw[j >> 1]);
                const float vc = (j & 1) ? bfhi(cvw[j >> 1]) : bflo(cvw[j >> 1]), vq = (j & 1) ? bfhi(pvw[j >> 1]) : bflo(pvw[j >> 1]);
                r[j] = rc + mur[j] * (rp - rc); k[j] = kc + muk[j] * (kq - kc); v[j] = vc + muv[j] * (vq - vc);
                kk[j] = k[j] * kkc[j]; ss += kk[j] * kk[j]; gq[j] = (j & 1) ? bfhi(gw2[j >> 1]) : bflo(gw2[j >> 1]);
            }
            ss = red16(ss);
            const float inv = __builtin_amdgcn_rsqf(fmaxf(ss, 1e-24f)); float bon = 0.f;
#pragma unroll
            for (int j = 0; j < 4; ++j) { kk[j] *= inv; al[j] = -kk[j]; be[j] = kk[j] * cur.eta[j]; kp[j] = k[j] * (1.f + (cur.eta[j] - 1.f) * kac[j]); bon += r[j] * kp[j] * rkc[j]; }
            bon = red16(bon);
            gl = cur.dec; gpl = (f32x4){1.f, 1.f, 1.f, 1.f};
            { const int ln = tid & 63;
#pragma unroll
              for (int j = 0; j < 4; ++j) { const float u1 = __shfl_up(gl[j], 16); gl[j] = (ln >= 16) ? gl[j] * u1 : gl[j]; }
#pragma unroll
              for (int j = 0; j < 4; ++j) { const float u2 = __shfl_up(gl[j], 32); gl[j] = (ln >= 32) ? gl[j] * u2 : gl[j]; }
#pragma unroll
              for (int j = 0; j < 4; ++j) { const float u3 = __shfl_up(gl[j], 16); gpl[j] = (ln >= 16) ? u3 : 1.f; }
              if (ln >= 48) *(LAS f32x4*)(WF + w * 64 + j0) = gl; }
            if ((tid & 15) == 0) BON[t] = bon;
        }
        if (c0 + 32 < SEQ && !(SCAN_STUB & 32)) scan_load(cur, ZR, DEC, AA, GG, tok + 32, hc, false);
        if (c0 > 0) { const bf16* yp = YB + (tok - 32) * 512 + hc; asm volatile("global_store_dwordx2 %0, %1, off" :: "v"(yp), "v"(pend) : "memory"); }
        LBAR();
        {
            f32x4 pre = (f32x4){1.f, 1.f, 1.f, 1.f}, gC = pre;
#pragma unroll
            for (int ww = 0; ww < 8; ++ww) { const f32x4 wt = *(const LAS f32x4*)(WF + ww * 64 + j0); gC = gC * wt; if (ww < w) pre = pre * wt; }
            const f32x4 gt = pre * gl, gp = pre * gpl;
            if (t == 31) *(LAS f32x4*)(WF + 512 + j0) = gC;
            float a_[4], r_[4], b_[4], k_[4], bc[4], kc[4];
#pragma unroll
            for (int j = 0; j < 4; ++j) { const float ig = __builtin_amdgcn_rcpf(gt[j]); a_[j] = al[j] * gp[j]; r_[j] = r[j] * gt[j]; b_[j] = be[j] * ig; k_[j] = kp[j] * ig; bc[j] = b_[j] * gC[j]; kc[j] = k_[j] * gC[j]; }
            u32x2 wv; wv.x = pk2(a_[0], a_[1]); wv.y = pk2(a_[2], a_[3]); *(LAS u32x2*)(AT + t * LDA + j0) = wv;
            wv.x = pk2(r_[0], r_[1]); wv.y = pk2(r_[2], r_[3]); *(LAS u32x2*)(RT + t * LDA + j0) = wv;
            wv.x = pk2(b_[0], b_[1]); wv.y = pk2(b_[2], b_[3]); *(LAS u32x2*)(BT + t * LDA + j0) = wv;
            wv.x = pk2(k_[0], k_[1]); wv.y = pk2(k_[2], k_[3]); *(LAS u32x2*)(KT + t * LDA + j0) = wv;
            wv.x = pk2(bc[0], bc[1]); wv.y = pk2(bc[2], bc[3]); *(LAS u32x2*)(BCT + t * LDA + j0) = wv;
            wv.x = pk2(kc[0], kc[1]); wv.y = pk2(kc[2], kc[3]); *(LAS u32x2*)(KCT + t * LDA + j0) = wv;
            wv.x = pk2(v[0], v[1]); wv.y = pk2(v[2], v[3]); *(LAS u32x2*)(VT + t * LDA + j0) = wv;
        }
        LBAR();
        if (w < 4 && !(SCAN_STUB & 1)) {
            const int lane = lane_now(), r32 = lane & 31, hh = lane >> 5;
            f32x16 mT, mN;
#pragma unroll
            for (int i = 0; i < 16; ++i) { mT[i] = 0.f; mN[i] = 0.f; }
#pragma unroll
            for (int q = 0; q < 4; ++q) { const bf16x8 bfr = ld16(BT + r32 * LDA + 8 * hh + 16 * q), afr = ld16(AT + r32 * LDA + 8 * hh + 16 * q);
                mT = MFMA32(bfr, afr, mT);
                mN = MFMA32(afr, bfr, mN); }
#pragma unroll
            for (int i = 0; i < 16; ++i) { const int c_ = crow(i, hh); mT[i] = (c_ < r32) ? mT[i] : 0.f; mN[i] = (r32 < c_) ? mN[i] : 0.f; }
            f32x16 X;
            if (w < 2) {
#pragma unroll
                for (int i = 0; i < 16; ++i) X[i] = bflo((unsigned)AT[crow(i, hh) * LDA + 32 * w + r32]);
            } else {
                f32x16 kT;
#pragma unroll
                for (int i = 0; i < 16; ++i) { kT[i] = 0.f; X[i] = 0.f; }
#pragma unroll
                for (int q = 0; q < 4; ++q) kT = MFMA32(ld16(KT + r32 * LDA + 8 * hh + 16 * q), ld16(AT + r32 * LDA + 8 * hh + 16 * q), kT);
#pragma unroll
                for (int i = 0; i < 16; ++i) kT[i] = (crow(i, hh) < r32) ? kT[i] : 0.f;
#pragma unroll
                for (int q = 0; q < 2; ++q) X = MFMA32(packq(kT, q), trfrag(VT, 16 * q + 4 * hh, 16 * q + 8 + 4 * hh, 32 * (w - 2), lane), X);
            }
#pragma unroll
            for (int k = 0; k < 5; ++k) {
                const bf16x8 t0 = packq(mT, 0), t1 = packq(mT, 1), x0 = packq(X, 0), x1 = packq(X, 1);
                X = MFMA32(t0, x0, X); X = MFMA32(t1, x1, X);
                if (k < 4) {
                    const bf16x8 n0 = packq(mN, 0), n1 = packq(mN, 1);
                    f32x16 zT, zN;
#pragma unroll
                    for (int i = 0; i < 16; ++i) { zT[i] = 0.f; zN[i] = 0.f; }
                    zT = MFMA32(n0, t0, zT); zT = MFMA32(n1, t1, zT);
                    zN = MFMA32(t0, n0, zN); zN = MFMA32(t1, n1, zN);
                    mT = zT; mN = zN;
                }
            }
            LAS bf16* dst = ((w < 2) ? AHT : UHT) + (32 * (w & 1) + r32) * LDT + 4 * hh;
#pragma unroll
            for (int i4 = 0; i4 < 4; ++i4) { u32x2 wv; wv.x = pk2(X[4 * i4], X[4 * i4 + 1]); wv.y = pk2(X[4 * i4 + 2], X[4 * i4 + 3]); *(LAS u32x2*)(dst + 8 * i4) = wv; }
        } else if (w < 6 && !(SCAN_STUB & 1)) {
            const int lane = lane_now(), r32 = lane & 31, hh = lane >> 5;
            const LAS bf16* Aop = ((w & 1) ? KT : BT) + r32 * LDA + 8 * hh; const LAS bf16* Bop = RT + r32 * LDA + 8 * hh;
            f32x16 x;
#pragma unroll
            for (int i = 0; i < 16; ++i) x[i] = 0.f;
#pragma unroll
            for (int q = 0; q < 4; ++q) x = MFMA32(ld16(Aop + 16 * q), ld16(Bop + 16 * q), x);
#pragma unroll
            for (int i = 0; i < 16; ++i) x[i] = (crow(i, hh) <= r32) ? x[i] : 0.f;
            LAS bf16* dst = ((w & 1) ? ARK : ARB) + r32 * LDT + 4 * hh;
#pragma unroll
            for (int i4 = 0; i4 < 4; ++i4) { u32x2 wv; wv.x = pk2(x[4 * i4], x[4 * i4 + 1]); wv.y = pk2(x[4 * i4 + 2], x[4 * i4 + 3]); *(LAS u32x2*)(dst + 8 * i4) = wv; }
        }
        LBAR();
        f32x16 hn;
        if (SCAN_STUB & 4) { for (int i = 0; i < 16; ++i) hn[i] = 0.f; } else if (w < 4) {
            const int lane = lane_now(), r32 = lane & 31, hh = lane >> 5;
            const int jb = w >> 1, ib = w & 1;
            f32x16 pt[2];
#pragma unroll
            for (int a = 0; a < 2; ++a) {
#pragma unroll
                for (int i = 0; i < 16; ++i) pt[a][i] = 0.f;
#pragma unroll
                for (int q = 0; q < 2; ++q) pt[a] = MFMA32(ld16(AHT + (32 * a + r32) * LDT + 16 * q + 8 * hh), trfrag(BCT, 16 * q + 8 * hh, 16 * q + 8 * hh + 4, 32 * jb, lane), pt[a]);
            }
            { const float gC = WF[512 + 32 * jb + r32];
#pragma unroll
              for (int i = 0; i < 16; ++i) { const float add = (crow(i, hh) == r32) ? gC : 0.f; pt[0][i] += (jb == 0) ? add : 0.f; pt[1][i] += (jb == 0) ? 0.f : add; } }
#pragma unroll
            for (int i = 0; i < 16; ++i) hn[i] = 0.f;
#pragma unroll
            for (int q = 0; q < 2; ++q) {
                hn = MFMA32(trfrag(BCT, 16 * q + 8 * hh, 16 * q + 8 * hh + 4, 32 * jb, lane), ld16(UHT + (32 * ib + r32) * LDT + 16 * q + 8 * hh), hn);
                hn = MFMA32(trfrag(KCT, 16 * q + 8 * hh, 16 * q + 8 * hh + 4, 32 * jb, lane), trfrag(VT, 16 * q + 8 * hh, 16 * q + 8 * hh + 4, 32 * ib, lane), hn);
            }
#pragma unroll
            for (int a = 0; a < 2; ++a)
#pragma unroll
                for (int q = 0; q < 2; ++q) hn = MFMA32(packq(pt[a], q), ld8x2(HT + (32 * ib + r32) * LDA + 32 * a + 16 * q + 4 * hh), hn);
        } else if (w < 6) {
            const int lane = lane_now(), r32 = lane & 31, hh = lane >> 5;
            const int ib = w & 1;
            f32x16 rt[2];
#pragma unroll
            for (int a = 0; a < 2; ++a) {
#pragma unroll
                for (int i = 0; i < 16; ++i) rt[a][i] = bflo((unsigned)RT[r32 * LDA + 32 * a + crow(i, hh)]);
#pragma unroll
                for (int q = 0; q < 2; ++q) rt[a] = MFMA32(ld16(AHT + (32 * a + r32) * LDT + 16 * q + 8 * hh), ld16(ARB + r32 * LDT + 16 * q + 8 * hh), rt[a]);
            }
            f32x16 y;
#pragma unroll
            for (int i = 0; i < 16; ++i) y[i] = 0.f;
#pragma unroll
            for (int q = 0; q < 2; ++q) {
                y = MFMA32(ld16(ARB + r32 * LDT + 16 * q + 8 * hh), ld16(UHT + (32 * ib + r32) * LDT + 16 * q + 8 * hh), y);
                y = MFMA32(ld16(ARK + r32 * LDT + 16 * q + 8 * hh), trfrag(VT, 16 * q + 8 * hh, 16 * q + 8 * hh + 4, 32 * ib, lane), y);
            }
#pragma unroll
            for (int a = 0; a < 2; ++a)
#pragma unroll
                for (int q = 0; q < 2; ++q) y = MFMA32(packq(rt[a], q), ld8x2(HT + (32 * ib + r32) * LDA + 32 * a + 16 * q + 4 * hh), y);
#pragma unroll
            for (int i = 0; i < 16; ++i) YF[crow(i, hh) * 64 + 32 * ib + r32] = y[i];
        }
        LBAR();
        if (w < 4) {
            const int lane = lane_now(), r32 = lane & 31, hh = lane >> 5;
            const int jb = w >> 1, ib = w & 1; LAS bf16* dst = HT + (32 * ib + r32) * LDA + 32 * jb + 4 * hh;
#pragma unroll
            for (int i4 = 0; i4 < 4; ++i4) { u32x2 wv; wv.x = pk2(hn[4 * i4], hn[4 * i4 + 1]); wv.y = pk2(hn[4 * i4 + 2], hn[4 * i4 + 3]); *(LAS u32x2*)(dst + 8 * i4) = wv; }
        }
        {
            const f32x4 y4 = *(const LAS f32x4*)(YF + t * 64 + j0);
            const float mean = red16((y4[0] + y4[1]) + (y4[2] + y4[3])) * (1.f / 64.f); float qv = 0.f;
#pragma unroll
            for (int j = 0; j < 4; ++j) { const float d = y4[j] - mean; qv += d * d; }
            const float rs = __builtin_amdgcn_rsqf(red16(qv) * (1.f / 64.f) + GN_EPS); const float bon = BON[t]; float ov[4];
            const f32x4 lnw = *(const LAS f32x4*)(CST + 384 + j0), lnb = *(const LAS f32x4*)(CST + 448 + j0);
#pragma unroll
            for (int j = 0; j < 4; ++j) ov[j] = ((y4[j] - mean) * rs * lnw[j] + lnb[j] + bon * v[j]) * gq[j];
            pend.x = pk2(ov[0], ov[1]); pend.y = pk2(ov[2], ov[3]);
        }
    }
    *(u32x2*)(YB + ((size_t)b * SEQ + SEQ - 32 + t) * 512 + hc) = pend;
}

__device__ __forceinline__ bool attn_step(const bf16x8 (&qf)[4], const bf16x8 (&kf)[4], const u32x2 (&vlo)[2][2], const u32x2 (&vhi)[2][2], f32x16& y0, f32x16& y1, float& carry, int s0, int t0, int q, int hi) {
    f32x16 p;
#pragma unroll
    for (int r = 0; r < 16; ++r) p[r] = 0.f;
#pragma unroll
    for (int d0 = 0; d0 < 4; ++d0) p = __builtin_amdgcn_mfma_f32_32x32x16_bf16(kf[d0], qf[d0], p, 0, 0, 0);
    float om[16], be[16];
#pragma unroll
    for (int r = 0; r < 16; ++r) {
        const int kv = crow(r, hi); const bool valid = (s0 + kv) < (t0 + q);
        const float z = fminf(p[r], 80.f); const float t = __expf(z); const float o = __builtin_amdgcn_rcpf(1.f + t);
        om[r] = valid ? o : 1.f; be[r] = valid ? t * o : 0.f;
    }
    float el[16], G[4], PG[4];
#pragma unroll
    for (int i = 0; i < 4; ++i) { el[4 * i + 3] = 1.f; el[4 * i + 2] = om[4 * i + 3]; el[4 * i + 1] = el[4 * i + 2] * om[4 * i + 2]; el[4 * i] = el[4 * i + 1] * om[4 * i + 1]; G[i] = el[4 * i] * om[4 * i]; }
#pragma unroll
    for (int i = 0; i < 4; ++i) PG[i] = __shfl_xor(G[i], 32);
    float sG[4], sP[4];
    sG[3] = 1.f; sG[2] = G[3]; sG[1] = G[3] * G[2]; sG[0] = sG[1] * G[1];
    sP[3] = 1.f; sP[2] = PG[3]; sP[1] = PG[3] * PG[2]; sP[0] = sP[1] * PG[1];
    const float total = (sG[0] * G[0]) * (sP[0] * PG[0]);
    float A[16];
#pragma unroll
    for (int i = 0; i < 4; ++i) { const float eg = sG[i] * (hi ? sP[i] : sP[i] * PG[i]) * carry;
#pragma unroll
        for (int j = 0; j < 4; ++j) A[4 * i + j] = be[4 * i + j] * el[4 * i + j] * eg; }
    carry *= total;
    bf16x8 pf[2];
#pragma unroll
    for (int s = 0; s < 2; ++s) { u32x4 w; w.x = pk2(A[8 * s], A[8 * s + 1]); w.y = pk2(A[8 * s + 2], A[8 * s + 3]); w.z = pk2(A[8 * s + 4], A[8 * s + 5]); w.w = pk2(A[8 * s + 6], A[8 * s + 7]); pf[s] = __builtin_bit_cast(bf16x8, w); }
#pragma unroll
    for (int s = 0; s < 2; ++s) {
        const u32x4 a0 = (u32x4){vlo[0][s].x, vlo[0][s].y, vhi[0][s].x, vhi[0][s].y}, a1 = (u32x4){vlo[1][s].x, vlo[1][s].y, vhi[1][s].x, vhi[1][s].y};
        y0 = __builtin_amdgcn_mfma_f32_32x32x16_bf16(__builtin_bit_cast(bf16x8, a0), pf[s], y0, 0, 0, 0);
        y1 = __builtin_amdgcn_mfma_f32_32x32x16_bf16(__builtin_bit_cast(bf16x8, a1), pf[s], y1, 0, 0, 0);
    }
    return __all(carry < 5.6e-14f);
}
__device__ __forceinline__ void attn_tile(Frame& F, int bh, int qt) {
    const int lane = F.lane, q = lane & 31, hi = lane >> 5, b = bh >> 3, h = bh & 7, t0 = 32 * qt;
    const size_t tokbase = (size_t)b * SEQ;
    const bf16* QB = WSP(bf16, WS_Q); const bf16* KB = WSP(bf16, WS_K); const bf16* VT = WSP(bf16, WS_VT); bf16* YA = WSP(bf16, WS_YA);
    bf16x8 qf[4];
    { const bf16* Qp = QB + (tokbase + t0 + q) * 512 + h * 64 + 8 * hi;
#pragma unroll
      for (int d0 = 0; d0 < 4; ++d0) qf[d0] = *(const bf16x8*)(Qp + 16 * d0); }
    f32x16 y0, y1;
#pragma unroll
    for (int r = 0; r < 16; ++r) { y0[r] = 0.f; y1[r] = 0.f; }
    float carry = 1.f;
    const bf16* Vrow = VT + (size_t)bh * 128 * 1024 + q * 16 + 4 * hi;
    bf16x8 kA[4], kB[4]; u32x2 vloA[2][2], vhiA[2][2], vloB[2][2], vhiB[2][2];
#define ATT_LOAD(KF, VLO, VHI, S0) do { const bf16* Kp_ = KB + (tokbase + (S0) + q) * 512 + h * 64 + 8 * hi; \
        _Pragma("unroll") for (int d0 = 0; d0 < 4; ++d0) KF[d0] = *(const bf16x8*)(Kp_ + 16 * d0); \
        _Pragma("unroll") for (int dt = 0; dt < 2; ++dt) _Pragma("unroll") for (int s_ = 0; s_ < 2; ++s_) { const bf16* vp_ = Vrow + (size_t)(((S0) >> 4) + s_) * 1024 + dt * 512; VLO[dt][s_] = *(const u32x2*)vp_; VHI[dt][s_] = *(const u32x2*)(vp_ + 8); } } while (0)
    ATT_LOAD(kA, vloA, vhiA, t0);
    for (int s0 = t0; ; ) {
        { const int sn = s0 >= 32 ? s0 - 32 : 0; ATT_LOAD(kB, vloB, vhiB, sn); __builtin_amdgcn_sched_barrier(0); }
        if (attn_step(qf, kA, vloA, vhiA, y0, y1, carry, s0, t0, q, hi)) break;
        s0 -= 32; if (s0 < 0) break;
        { const int sn = s0 >= 32 ? s0 - 32 : 0; ATT_LOAD(kA, vloA, vhiA, sn); __builtin_amdgcn_sched_barrier(0); }
        if (attn_step(qf, kB, vloB, vhiB, y0, y1, carry, s0, t0, q, hi)) break;
        s0 -= 32; if (s0 < 0) break;
    }
#undef ATT_LOAD
    bf16* Yp = YA + (tokbase + t0 + q) * 512 + h * 64 + 4 * hi;
#pragma unroll
    for (int i = 0; i < 4; ++i) {
        u32x2 w0, w1; w0.x = pk2(y0[4 * i], y0[4 * i + 1]); w0.y = pk2(y0[4 * i + 2], y0[4 * i + 3]); w1.x = pk2(y1[4 * i], y1[4 * i + 1]); w1.y = pk2(y1[4 * i + 2], y1[4 * i + 3]);
        *(u32x2*)(Yp + 8 * i) = w0; *(u32x2*)(Yp + 32 + 8 * i) = w1;
    }
}

__device__ __forceinline__ void p5a_router(const Args& args, Frame& F) {
    LAS float* LG = (LAS float*)F.lds;
    LAS unsigned* HIST = (LAS unsigned*)(F.lds + 32768); LAS unsigned* BASE = HIST + 32;
    const float* X1 = WSP(float, WS_X1); const float* GW = WSP(float, WS_GW); const float* rb = FIN(20);
    unsigned* cnt = F.ctl + CW_CNT; int* LIST = WSP(int, WS_LIST); float* LRS = WSP(float, WS_LRS); float* LGT = WSP(float, WS_LGT);
    const int tid = F.tid, lane = F.lane, wave = F.wave;
    for (int tb = blockIdx.x; tb < M / 128; tb += F.G) {
        if (tid < 32) HIST[tid] = 0u;
        __syncthreads();
        int ex[4] = {0, 0, 0, 0}; float gt[4] = {0.f, 0.f, 0.f, 0.f}; unsigned lr[4] = {0u, 0u, 0u, 0u}; int tok = 0; float rstd_keep = 0.f;
        {
            const int i = lane & 31, kh = lane >> 5, g = wave & 3, kq = wave >> 2; tok = tb * 128 + g * 32 + i;
            const float* xr = X1 + (size_t)tok * D + 512 * kq + 4 * kh;
            f32x16 acc;
#pragma unroll
            for (int r = 0; r < 16; ++r) acc[r] = 0.f;
            float ss = 0.f;
#pragma unroll 1
            for (int u0 = 0; u0 < 64; u0 += 8) {
                f32x4 a[8]; float gw[8][4];
#pragma unroll
                for (int uu = 0; uu < 8; ++uu) { a[uu] = *(const f32x4*)(xr + 8 * (u0 + uu)); const float* gp = GW + (size_t)(512 * kq + 8 * (u0 + uu) + 4 * kh) * 32 + i;
#pragma unroll
                    for (int j = 0; j < 4; ++j) gw[uu][j] = gp[32 * j]; }
#pragma unroll
                for (int uu = 0; uu < 8; ++uu) { ss += (a[uu][0] * a[uu][0] + a[uu][1] * a[uu][1]) + (a[uu][2] * a[uu][2] + a[uu][3] * a[uu][3]);
#pragma unroll
                    for (int j = 0; j < 4; ++j) acc = __builtin_amdgcn_mfma_f32_32x32x2f32(a[uu][j], gw[uu][j], acc, 0, 0, 0); }
            }
            ss += __shfl_xor(ss, 32);
            LAS float* RED = (LAS float*)(F.lds + 40960) + (g * 64 + lane) * 17;
            if (kq == 1) {
#pragma unroll
                for (int r = 0; r < 16; ++r) RED[r] = acc[r];
                RED[16] = ss; }
            __syncthreads();
            if (kq == 0) {
#pragma unroll
                for (int r = 0; r < 16; ++r) acc[r] += RED[r];
                ss += RED[16]; }
            if (wave < 4) {
            const float rstd = 1.0f / sqrtf(ss * (1.f / D) + RMS_EPS);
            rstd_keep = rstd;
            LAS float* L = LG + wave * (32 * 33);
#pragma unroll
            for (int r = 0; r < 16; ++r) L[crow(r, kh) * 33 + i] = acc[r];
            asm volatile("s_waitcnt lgkmcnt(0)" ::: "memory");
            if (kh == 0) {
                float v0 = -3.0e38f, v1 = -3.0e38f, v2 = -3.0e38f, v3 = -3.0e38f; int i0 = 0, i1 = 0, i2 = 0, i3 = 0;
                for (int e = 0; e < 32; ++e) { const float v = L[i * 33 + e] * rstd + rb[e];
                    if (v > v3) { if (v > v2) { v3 = v2; i3 = i2; if (v > v1) { v2 = v1; i2 = i1; if (v > v0) { v1 = v0; i1 = i0; v0 = v; i0 = e; } else { v1 = v; i1 = e; } } else { v2 = v; i2 = e; } } else { v3 = v; i3 = e; } } }
                const float e1 = __expf(v1 - v0), e2 = __expf(v2 - v0), e3 = __expf(v3 - v0), inv = 1.0f / (1.f + e1 + e2 + e3);
                ex[0] = i0; ex[1] = i1; ex[2] = i2; ex[3] = i3; gt[0] = inv; gt[1] = e1 * inv; gt[2] = e2 * inv; gt[3] = e3 * inv;
#pragma unroll
                for (int k = 0; k < 4; ++k) lr[k] = __hip_atomic_fetch_add(&HIST[ex[k]], 1u, __ATOMIC_RELAXED, __HIP_MEMORY_SCOPE_WORKGROUP);
            }
            }
        }
        __syncthreads();
        if (tid < 32) BASE[tid] = __hip_atomic_fetch_add(cnt + tid, HIST[tid], RLX_AGENT);
        __syncthreads();
        if (wave < 4 && lane < 32) {
#pragma unroll
            for (int k = 0; k < 4; ++k) { const unsigned pos = BASE[ex[k]] + lr[k]; const size_t li = (size_t)ex[k] * CAP + pos; LIST[li] = tok * 4 + k; LRS[li] = rstd_keep; LGT[li] = gt[k]; }
        }
        __syncthreads();
    }
}
__device__ __forceinline__ int moe_tables(Frame& F) {
    LAS int* CS = (LAS int*)(F.lds + MOE_OFF); LAS int* OFF = CS + 32; LAS unsigned char* TE = F.lds + MOE_TE;
    if (F.tid < 32) { int c = (int)__hip_atomic_load(F.ctl + CW_CNT + F.tid, RLX_AGENT); CS[F.tid] = c > CAP ? CAP : c; }
    __syncthreads();
    if (F.tid == 0) { int off = 0; for (int e = 0; e < 32; ++e) { OFF[e] = off; off += ((CS[e] + 255) >> 8) << 8; } OFF[32] = off; }
    __syncthreads();
    const int ntiles = OFF[32] >> 8;
    for (int t = F.tid; t < ntiles; t += 512) { int e = 0; while (e < 31 && OFF[e + 1] <= t * 256) ++e; TE[t] = (unsigned char)e; }
    __syncthreads();
    return ntiles;
}
__device__ __forceinline__ void p8_combine(Frame& F) {
    float* X1 = WSP(float, WS_X1); const bf16* YBF = WSP(bf16, WS_YBUF); bf16* X2B = WSP(bf16, WS_X2B); float* R2 = WSP(float, WS_RSTD2); float* RSS = WSP(float, WS_ROWSS);
    const int gw = F.vcu * 8 + F.wave, NGW = F.G * 8, lane = F.lane;
    for (int t = gw; t < M; t += NGW) {
        f32x4* xr = (f32x4*)(X1 + (size_t)t * D) + lane; f32x4 v[4]; float s = 0.f;
#pragma unroll
        for (int j = 0; j < 4; ++j) v[j] = xr[64 * j];
#pragma unroll
        for (int k = 0; k < 4; ++k) { const u32x2* yr = (const u32x2*)(YBF + (size_t)(4 * t + k) * D) + lane;
#pragma unroll
            for (int j = 0; j < 4; ++j) { const u32x2 w = yr[64 * j]; v[j].x += bflo(w.x); v[j].y += bfhi(w.x); v[j].z += bflo(w.y); v[j].w += bfhi(w.y); } }
        u32x2* o = (u32x2*)(X2B + (size_t)t * D) + lane;
#pragma unroll
        for (int j = 0; j < 4; ++j) { s += (v[j].x * v[j].x + v[j].y * v[j].y) + (v[j].z * v[j].z + v[j].w * v[j].w); u32x2 w; w.x = pk2(v[j].x, v[j].y); w.y = pk2(v[j].z, v[j].w); o[64 * j] = w; }
        s = wave_sum(s);
        if (lane == 0) { R2[t] = 1.0f / sqrtf(s * (1.f / D) + RMS_EPS); RSS[t] = 0.f; }
    }
}
constexpr int NPHASE = 11;
__global__ void __launch_bounds__(512, 2) mega_fwd(Args args) {
    extern __shared__ __attribute__((aligned(16))) unsigned char lds[];
    Frame F;
    F.lds = (LAS unsigned char*)lds;
    F.wave = __builtin_amdgcn_readfirstlane((int)threadIdx.x >> 6); F.lane = lane_now(); F.tid = F.wave * 64 + F.lane;
    F.G = gridDim.x; { const int bx = blockIdx.x; F.vcu = (F.G % 8 == 0) ? (bx % 8) * (F.G / 8) + bx / 8 : bx; }
    F.ws = args.ws; F.ctl = (unsigned*)(args.ws + WS_CTL); F.out = args.out;
    volatile LAS unsigned* MISC = (volatile LAS unsigned*)(F.lds + LDSCTL_OFF);
    if (F.tid < 64) MISC[F.tid] = 0u;
    __syncthreads();
    const int lo = args.ph_lo, hi = args.ph_hi;
    XcdBarrier bar; bar.bar = F.ctl + CW_BAR; bar.x = 0; bar.st = nullptr;
    if (hi - lo > 1) bar = xcd_barrier_post(F.ctl + CW_BAR, MISC + 8, F.tid);
#ifndef PH_MASK
#define PH_MASK 0xFFFF
#endif
#define IN(k) ((((PH_MASK) >> (k)) & 1) && lo <= (k) && (k) < hi)
#define STAMP(k) do { if (TS_PROBE >= 0 && blockIdx.x == 0 && F.tid == 0) ((unsigned long long*)(F.ctl + 2048))[k] = __builtin_amdgcn_s_memrealtime(); } while (0)
#define SEAM(k) do { if (IN(k) && IN((k) + 1)) xcd_barrier(bar, F.wave); F.lane = lane_now(); F.tid = F.wave * 64 + F.lane; STAMP((k) + 1); } while (0)
    LAS unsigned char* ring = F.lds;
    STAMP(0);

    if (IN(0)) { p0_prologue(args, F); if (F.G < 256) expert_convert(args, F, F.vcu * 8 + F.wave, F.G * 8, 3); } SEAM(0);

    if (IN(1)) {
        pg8::Gemm g{WSP(bf16, WS_XB), WSP(bf16, WS_WIN), M, INC, D, 0, nullptr, nullptr, nullptr}; pg8::StaticOrder S; S.init(M, INC, F.G, (int)blockIdx.x);
        EpiG1 E{WSP(float, WS_RSTD0), WSP(bf16, WS_Q), WSP(bf16, WS_K), WSP(bf16, WS_VT), WSP(bf16, WS_ZR), WSP(bf16, WS_GT)};
        pg8::gemm_phase(ring, g, S, E, F.wave);
    } SEAM(1);

    if (IN(2)) {
        for (int c = blockIdx.x; c < 256; c += F.G) {
            const int x = c & 7, y = c >> 3; pg8::LoraOrder S; S.half = y & 1; S.pm = x + 8 * (y >> 1); S.nu = 3 + (F.G >> 30);
            build_alora(args, F, S.pm);
            asm volatile("s_waitcnt vmcnt(0)" ::: "memory"); __syncthreads();
            pg8::Gemm g{WSP(bf16, WS_ALORA), WSP(bf16, WS_WL), M, LORA_N, LORA_K, 0, nullptr, nullptr, nullptr};
            EpiLora E{FIN(5), FIN(7), WSP(float, WS_DEC), WSP(float, WS_AA), WSP(bf16, WS_GG)};
            pg8::gemm_phase(ring, g, S, E, F.wave);
        }
    } SEAM(2);

    if (IN(3)) {
        for (int u = blockIdx.x; u < 256; u += F.G) {
#ifndef P3_ONLY
#define P3_ONLY 0
#endif
            if (u < 128) { if (P3_ONLY != 2 && P3_ONLY != 3 && P3_ONLY != 4) scan_unit_chunked(args, F, u); else { bf16* YB = WSP(bf16, WS_YB); const int b = u >> 3, h = u & 7; for (int i = F.tid; i < SEQ * 8; i += 512) { const int tk = i >> 3, c8 = (i & 7) * 8; *(u32x4*)(YB + ((size_t)b * SEQ + tk) * 512 + h * 64 + c8) = (u32x4){0u, 0u, 0u, 0u}; } } }
            else if (P3_ONLY == 1 || P3_ONLY == 4) { bf16* YAz = WSP(bf16, WS_YA); const int bh = u - 128, b = bh >> 3, h = bh & 7; for (int i = F.tid; i < SEQ * 8; i += 512) { const int tk = i >> 3, c8 = (i & 7) * 8; *(u32x4*)(YAz + ((size_t)b * SEQ + tk) * 512 + h * 64 + c8) = (u32x4){0u, 0u, 0u, 0u}; } }
            else { const int bh = u - 128; for (int i = 0; i < 8; ++i) attn_tile(F, bh, F.wave + 8 * i);
                   if (F.G >= 256 && P3_ONLY != 3) expert_convert(args, F, bh * 8 + F.wave, 1024, 3); }
        }
    } SEAM(3);

    if (IN(4)) {
        pg8::StaticOrder S; S.init(M, D, F.G, (int)blockIdx.x);
        { pg8::Gemm g{WSP(bf16, WS_YA), WSP(bf16, WS_WA), M, D, AW, 0, nullptr, nullptr, nullptr}; EpiMerge<0> E{WSP(bf16, WS_GT), WSP(bf16, WS_MERGED)}; pg8::gemm_phase(ring, g, S, E, F.wave); }
        { pg8::Gemm g{WSP(bf16, WS_YB), WSP(bf16, WS_WB), M, D, RW, 0, nullptr, nullptr, nullptr}; EpiMerge<1> E{WSP(bf16, WS_GT), WSP(bf16, WS_MERGED)}; pg8::gemm_phase(ring, g, S, E, F.wave); }
    } SEAM(4);

    if (IN(5)) {
        pg8::Gemm g{WSP(bf16, WS_MERGED), WSP(bf16, WS_WO), M, D, D, 0, nullptr, nullptr, nullptr}; pg8::StaticOrder S; S.init(M, D, F.G, (int)blockIdx.x);
        EpiX1 E{FIN(0), WSP(float, WS_X1), FIN(18), WSP(bf16, WS_HN)};
        pg8::gemm_phase(ring, g, S, E, F.wave);
    } SEAM(5);

    if (IN(6)) { p5a_router(args, F); } SEAM(6);

    if (IN(7)) {
        const int ntiles = moe_tables(F);
        pg8::Gemm g{WSP(bf16, WS_HN), WSP(bf16, WS_W1), MAXROWS, F2, D, (size_t)F2 * D * 2, WSP(int, WS_LIST), (const LAS int*)(F.lds + MOE_OFF) + 32, (const LAS int*)(F.lds + MOE_OFF)};
        pg8::MoeOrder S{ntiles, F2 / 256, F.G, (int)blockIdx.x, F.lds + MOE_TE};
        EpiSwiglu E{FIN(22), WSP(bf16, WS_ACT), WSP(int, WS_LIST), WSP(float, WS_LRS), (const LAS int*)(F.lds + MOE_OFF) + 32, (const LAS int*)(F.lds + MOE_OFF), (const LAS float*)(F.lds + RING_BYTES + 4096)};
        pg8::gemm_phase<EpiSwiglu, pg8::MoeOrder, true>(ring, g, S, E, F.wave);
    } SEAM(7);

    if (IN(8)) {
        const int ntiles = moe_tables(F);
        pg8::Gemm g{WSP(bf16, WS_ACT), WSP(bf16, WS_W2), MAXROWS, D, FH, (size_t)D * FH * 2, nullptr, nullptr, nullptr};
        pg8::MoeOrder S{ntiles, D / 256, F.G, (int)blockIdx.x, F.lds + MOE_TE};
        EpiY E{FIN(24), WSP(int, WS_LIST), WSP(float, WS_LGT), WSP(bf16, WS_YBUF), (const LAS int*)(F.lds + MOE_OFF) + 32, (const LAS int*)(F.lds + MOE_OFF), (const LAS float*)(F.lds + RING_BYTES + 4096)};
        pg8::gemm_phase(ring, g, S, E, F.wave);
    } SEAM(8);

    if (IN(9)) { p8_combine(F); } SEAM(9);

    if (IN(10)) {
        pg8::StaticOrder S; S.init(M, D, F.G, (int)blockIdx.x);
        { pg8::Gemm g{WSP(bf16, WS_X2B), WSP(bf16, WS_WG), M, D, D, 0, nullptr, nullptr, nullptr}; EpiGate E{WSP(float, WS_RSTD2), WSP(bf16, WS_PGT)}; pg8::gemm_phase(ring, g, S, E, F.wave); }
        { pg8::Gemm g{WSP(bf16, WS_PB), WSP(bf16, WS_WP), M, D, PLE, 0, nullptr, nullptr, nullptr}; EpiPle E{WSP(bf16, WS_X2B), WSP(bf16, WS_PGT), F.out, WSP(float, WS_ROWSS), F.ctl + CW_PCNT, FIN(28), F.ctl}; pg8::gemm_phase(ring, g, S, E, F.wave); }
    }
#undef IN
#undef SEAM
}

extern "C" void kernel_launch(void* const* d_in, const int* in_sizes, int n_in, void* d_out, int out_size, void* d_ws, size_t ws_size, hipStream_t stream) {
    static int grid = 0;
    if (grid == 0) {
        if (n_in != 29 || in_sizes[0] != M * D || out_size != M * D || ws_size < WS_END) {
            fprintf(stderr, "kernel_launch: unexpected shapes (n_in %d, in0 %d, out %d, ws %zu < %zu); nothing launched\n", n_in, n_in > 0 ? in_sizes[0] : -1, out_size, ws_size, (size_t)WS_END); grid = -1; return; }
        int dev = 0, cus = 0, per_cu = 0;
        if (hipGetDevice(&dev) != hipSuccess || hipDeviceGetAttribute(&cus, hipDeviceAttributeMultiprocessorCount, dev) != hipSuccess) { grid = -1; return; }
        if (hipFuncSetAttribute((const void*)mega_fwd, hipFuncAttributeMaxDynamicSharedMemorySize, LDS_BYTES) != hipSuccess) { fprintf(stderr, "kernel_launch: hipFuncSetAttribute failed\n"); grid = -1; return; }
        if (hipOccupancyMaxActiveBlocksPerMultiprocessor(&per_cu, (const void*)mega_fwd, 512, LDS_BYTES) != hipSuccess || per_cu < 1) { fprintf(stderr, "kernel_launch: occupancy query says %d blocks/CU\n", per_cu); }
        (void)hipGetLastError();
        grid = cus;
    }
    if (grid < 0) return;
    (void)hipMemsetAsync((char*)d_ws + WS_CTL, 0, CTL_ZERO_BYTES, stream);
    Args a{};
    for (int i = 0; i < 29; ++i) a.in[i] = (const float*)d_in[i];
    a.out = (float*)d_out; a.ws = (unsigned char*)d_ws;
#if MK_PER_PHASE
    for (int p = 0; p < NPHASE; ++p) { a.ph_lo = p; a.ph_hi = p + 1; hipLaunchKernelGGL(mega_fwd, dim3(grid), dim3(512), LDS_BYTES, stream, a); }
#else
    a.ph_lo = 0; a.ph_hi = NPHASE; hipLaunchKernelGGL(mega_fwd, dim3(grid), dim3(512), LDS_BYTES, stream, a);
#endif
}
```

```cpp
#include <hip/hip_runtime.h>
#include <cstdio>
#include <cstdint>

#ifndef P3_ONLY
#define P3_ONLY 0
#endif
#ifndef SCAN_STUB
#define SCAN_STUB 0
#endif
#ifndef ATT_FORCE
#define ATT_FORCE 0
#endif
#ifndef TS_PROBE
#define TS_PROBE -1
#endif
#ifndef TS_END_SLOT
#define TS_END_SLOT 20
#endif
#ifndef MK_PER_PHASE
#define MK_PER_PHASE 0
#endif

#define LAS __attribute__((address_space(3)))
#define GAS __attribute__((address_space(1)))
typedef unsigned short bf16;
typedef short bf16x8 __attribute__((ext_vector_type(8)));
typedef float f32x2 __attribute__((ext_vector_type(2)));
typedef float f32x4 __attribute__((ext_vector_type(4)));
typedef float f32x16 __attribute__((ext_vector_type(16)));
typedef unsigned u32x2 __attribute__((ext_vector_type(2)));
typedef unsigned u32x4 __attribute__((ext_vector_type(4)));
typedef __bf16 bf16x2_t __attribute__((ext_vector_type(2)));

constexpr int NB = 16, SEQ = 2048, D = 1024, M = NB * SEQ;
constexpr int NH = 8, HD = 64, AW = 512, RW = 512, RWC = 1792, INC = 5376;
constexpr int NE = 32, FH = 1024, F2 = 2048, PLE = 256, TOPK = 4;
constexpr int LORA_K = 256, LORA_N = 1536;
constexpr int CAP = 32768;
constexpr int MAXROWS = M * TOPK + NE * 256;
constexpr float RMS_EPS = 1e-5f, GN_EPS = 64e-5f;

constexpr size_t MiB = 1u << 20;
constexpr size_t WS_CTL = 0, CTL_ZERO_BYTES = 1 * MiB;
constexpr size_t WS_WIN = 1 * MiB;
constexpr size_t WS_WA = 12 * MiB, WS_WB = 13 * MiB, WS_WO = 14 * MiB, WS_WG = 16 * MiB, WS_WP = 18 * MiB;
constexpr size_t WS_WL = 18 * MiB + 512 * 1024;
constexpr size_t WS_GW = 19 * MiB + 256 * 1024;
constexpr size_t WS_W1 = 20 * MiB;
constexpr size_t WS_W2 = 148 * MiB;
constexpr size_t WS_PB = 212 * MiB;
constexpr size_t WS_RSTD0 = 228 * MiB, WS_RSTD2 = WS_RSTD0 + 128 * 1024, WS_ROWSS = WS_RSTD0 + 256 * 1024;
constexpr size_t WS_RSTD1 = WS_RSTD0 + 384 * 1024;
constexpr size_t WS_GATEW = WS_RSTD0 + 512 * 1024;
constexpr size_t WS_ROWSLOT = 229 * MiB;
constexpr size_t WS_LIST = 230 * MiB;
constexpr size_t WS_X1 = 236 * MiB;
constexpr size_t WS_YA = 236 * MiB, WS_YB = 268 * MiB, WS_ALORA = 300 * MiB;
constexpr size_t WS_GT = 364 * MiB;
constexpr size_t WS_Q = 492 * MiB, WS_K = 524 * MiB, WS_VT = 556 * MiB;
constexpr size_t WS_ZR = 588 * MiB;
constexpr size_t WS_XB = 700 * MiB;
constexpr size_t WS_DEC = 764 * MiB, WS_AA = 828 * MiB, WS_GG = 892 * MiB;
constexpr size_t WS_MERGED = 492 * MiB;
constexpr size_t WS_XS = 364 * MiB;
constexpr size_t WS_ACT = 684 * MiB;
constexpr size_t WS_HN = 364 * MiB;
constexpr size_t WS_YBUF = 428 * MiB;
constexpr size_t WS_X2B = 684 * MiB;
constexpr size_t WS_PGT = 748 * MiB;
constexpr size_t WS_LRS = 956 * MiB, WS_LGT = 960 * MiB;
constexpr size_t WS_END = 964 * MiB;
constexpr int CW_CNT = 64;
constexpr int CW_PCNT = 8192;
constexpr int CW_BAR = 4096;

constexpr int RING_BYTES = 131072;
constexpr int LDSCTL_OFF = RING_BYTES;
constexpr int MOE_OFF = RING_BYTES + 1024;
constexpr int MOE_TE = RING_BYTES + 2048;
constexpr int LDS_BYTES = 147456;

#define RLX_AGENT __ATOMIC_RELAXED, __HIP_MEMORY_SCOPE_AGENT
__device__ __forceinline__ unsigned pk2(float lo, float hi) { f32x2 v = {lo, hi}; bf16x2_t b = __builtin_convertvector(v, bf16x2_t); return __builtin_bit_cast(unsigned, b); }
__device__ __forceinline__ unsigned pk8(float a, float b, float c, float d) { int w = __builtin_amdgcn_cvt_pk_fp8_f32(a, b, 0, false); w = __builtin_amdgcn_cvt_pk_fp8_f32(c, d, w, true); return (unsigned)w; }
__device__ __forceinline__ float bflo(unsigned u) { return __uint_as_float(u << 16); }
__device__ __forceinline__ float bfhi(unsigned u) { return __uint_as_float(u & 0xffff0000u); }
__device__ __forceinline__ float sigm(float x) { return __builtin_amdgcn_rcpf(1.f + __expf(-x)); }
__device__ __forceinline__ float wave_sum(float v) {
#pragma unroll
    for (int o = 1; o < 64; o <<= 1) v += __shfl_xor(v, o);
    return v;
}
template <int CTRL> __device__ __forceinline__ float dppf(float v) { return __builtin_bit_cast(float, __builtin_amdgcn_update_dpp(0, __builtin_bit_cast(int, v), CTRL, 0xF, 0xF, true)); }
__device__ __forceinline__ float red8(float v) { v += dppf<0xB1>(v); v += dppf<0x4E>(v); v += dppf<0x141>(v); return v; }
__device__ __forceinline__ int lane_now() { int l; asm volatile("v_mbcnt_lo_u32_b32 %0, -1, 0\n\tv_mbcnt_hi_u32_b32 %0, -1, %0" : "=v"(l)); return l; }
__device__ __forceinline__ int crow(int r, int hi) { return (r & 3) + 8 * (r >> 2) + 4 * hi; }

struct PreNone {}; struct PreF { float f[8]; }; struct PreI { int i[8]; };
namespace pg8 {
#define PG8_LAS __attribute__((address_space(3)))
typedef unsigned short bf16_t;
constexpr int BM = 256, BK = 64, HALF = 128, HTB = HALF * BK * 2, STAGE_BYTES = 8 * HTB, NXCD = 8, WGM = 8;
__host__ __device__ __forceinline__ int lds_byte(int r, int c) { const int st = (r >> 4) * 2 + (c >> 5), rr = r & 15, cc = c & 31, ob = rr * 64 + cc * 2; return st * 1024 + (ob ^ (((ob >> 9) & 1) << 5)); }
__host__ __device__ __forceinline__ void stage_rc(int b, int& R, int& C) { const int st = b / 1024, sb = b % 1024, swz = sb ^ (((sb >> 9) & 1) << 5); R = (st >> 1) * 16 + swz / 64; C = (st & 1) * 32 + (swz % 64) / 2; }
__host__ __device__ __forceinline__ int perm32(int rho) { const int n = rho >> 4, i = rho & 15; return 8 * (i >> 2) + 4 * n + (i & 3); }

struct Unit { int pm, pn, e; };
struct Gemm { const bf16_t* A; const bf16_t* Bt; int M, N, K; size_t bsel_bytes; const int* glist; const PG8_LAS int* goff; const PG8_LAS int* gcnt; };

struct StaticOrder {
    int nM, nN, nwg, G, c;
    __device__ void init(int M_, int N_, int G_, int c_) { nM = M_ / BM; nN = N_ / BM; nwg = nM * nN; G = G_; c = c_; }
    __device__ bool next(int i, Unit& u) const {
        const long L = (long)i * G + c; if (L >= nwg) return false;
        int wgid = (int)L; { const int q = nwg / NXCD, r = nwg % NXCD, xcd = wgid % NXCD, off = wgid / NXCD; wgid = (xcd < r ? xcd * (q + 1) : r * (q + 1) + (xcd - r) * q) + off; }
        const int nig = WGM * nN, gid = wgid / nig, fm = gid * WGM, gsz = (nM - fm) < WGM ? (nM - fm) : WGM;
        u.pm = fm + ((wgid % nig) % gsz); u.pn = (wgid % nig) / gsz; u.e = 0; return true;
    }
};
struct LoraOrder {
    int pm, half, nu;
    __device__ bool next(int i, Unit& u) const { if (i >= nu) return false; u.pm = pm; u.pn = 3 * half + i; u.e = 0; return true; }
};
struct MoeOrder {
    int ntiles, npn, G, c; const PG8_LAS unsigned char* te;
    __device__ bool next(int i, Unit& u) const {
        int rt, pn;
        if ((G & 255) == 0 && (npn == 8 || npn == 4)) { const int x = c & 7, j = (c >> 3) & 31, rpx = 32 / npn, blk = c >> 8; rt = ((i * (G >> 8) + blk) * 8 + x) * rpx + j / npn; pn = j % npn; }
        else { const long L = (long)i * G + c; rt = (int)(L / npn); pn = (int)(L % npn); }
        if (rt >= ntiles) return false;
        u.pm = rt; u.pn = pn; u.e = te[rt]; return true;
    }
};

typedef int i32x4 __attribute__((ext_vector_type(4))); typedef int i32x8 __attribute__((ext_vector_type(8)));
template <class Epi, class Sched, bool GATHER = false, bool F8 = false>
__device__ __forceinline__ void gemm_phase(PG8_LAS unsigned char* lds, const Gemm g, const Sched& S, const Epi& E, const int wid) {
    const int lane = lane_now(), tid = wid * 64 + lane,
              wr = wid >> 2, wc = wid & 3, fr = lane & 15, fq = lane >> 4;
    const int K = g.K, nt = F8 ? K / (2 * BK) : K / BK;
    unsigned voffA[2], voffB[2];
#pragma unroll
    for (int i = 0; i < 2; ++i) { int R, C; stage_rc(tid * 16 + i * 8192, R, C); const int Rb = Epi::PERM ? ((R & ~31) + perm32(R & 31)) : R;
        voffA[i] = F8 ? (unsigned)(R * K + C * 2) : (unsigned)(R * K + C) * 2u; voffB[i] = F8 ? (unsigned)(Rb * K + C * 2) : (unsigned)(Rb * K + C) * 2u; }
    const size_t kstep = (size_t)(BK * 2);
    const size_t hstep = (size_t)HALF * K * (F8 ? 1 : 2);
    const size_t tstep = 2 * hstep;
    const unsigned ldsw = (unsigned)wid * 1024u;
    const int aoff = lds_byte(wr * 64 + fr, fq * 8), boff = lds_byte(wc * 32 + fr, fq * 8);
    const int aoffk[2] = {aoff, aoff + 1024}, boffk[2] = {boff, boff + 1024};
    unsigned vgC[2][2] = {{0u, 0u}, {0u, 0u}}, vgN[2][2] = {{0u, 0u}, {0u, 0u}};
#define PG8_GOFF(u, vo) do { _Pragma("unroll") for (int _h = 0; _h < 2; ++_h) _Pragma("unroll") for (int _i = 0; _i < 2; ++_i) { int R_, C_; stage_rc(tid * 16 + _i * 8192, R_, C_); \
        const int r_ = (u).pm * BM + _h * HALF + R_ - g.goff[(u).e]; int tok_ = 0; if (r_ < g.gcnt[(u).e]) tok_ = g.glist[(size_t)(u).e * 32768 + r_] >> 2; (vo)[_h][_i] = F8 ? (unsigned)(tok_ * K + C_ * 2) : (unsigned)(tok_ * K + C_) * 2u; } } while (0)
#define PG8_SA(b, h) (((b) * 2 + (h)) * HTB)
#define PG8_SB(b, h) ((4 + (b) * 2 + (h)) * HTB)
#define PG8_STAGE(bufoff, gbase, voff) do { _Pragma("unroll") for (int _i = 0; _i < 2; ++_i) \
        __builtin_amdgcn_global_load_lds((const unsigned*)((const char*)(gbase) + (voff)[_i]), (PG8_LAS unsigned*)(lds + (bufoff) + ldsw + _i * 8192), 16, 0, 0); } while (0)
#define PG8_STA(bufoff, h, ptr, kbyte, usenext) do { if constexpr (GATHER) { unsigned vo_[2] = {(usenext) ? vgN[h][0] : vgC[h][0], (usenext) ? vgN[h][1] : vgC[h][1]}; PG8_STAGE(bufoff, (const char*)g.A + (kbyte), vo_); } else { PG8_STAGE(bufoff, ptr, voffA); } } while (0)
#define PG8_LDA(dst, b, h) do { _Pragma("unroll") for (int m = 0; m < 4; ++m) _Pragma("unroll") for (int k = 0; k < 2; ++k) dst[m][k] = *(const PG8_LAS bf16x8*)(lds + PG8_SA(b, h) + aoffk[k] + m * 2048); } while (0)
#define PG8_LDB(dst, b, h) do { _Pragma("unroll") for (int n = 0; n < 2; ++n) _Pragma("unroll") for (int k = 0; k < 2; ++k) dst[n][k] = *(const PG8_LAS bf16x8*)(lds + PG8_SB(b, h) + boffk[k] + n * 2048); } while (0)
#define PG8_MMA(ai, bj, At, Bt) do { __builtin_amdgcn_s_setprio(1); _Pragma("unroll") for (int m = 0; m < 4; ++m) _Pragma("unroll") for (int n = 0; n < 2; ++n) { \
        if constexpr (F8) { const i32x8 b8_ = __builtin_shufflevector(__builtin_bit_cast(i32x4, Bt[n][0]), __builtin_bit_cast(i32x4, Bt[n][1]), 0, 1, 2, 3, 4, 5, 6, 7), a8_ = __builtin_shufflevector(__builtin_bit_cast(i32x4, At[m][0]), __builtin_bit_cast(i32x4, At[m][1]), 0, 1, 2, 3, 4, 5, 6, 7); \
            asm volatile("v_mfma_f32_16x16x128_f8f6f4 %0, %1, %2, %0" : "+v"(acc[ai][bj][m][n]) : "v"(b8_), "v"(a8_)); } \
        else { _Pragma("unroll") for (int k = 0; k < 2; ++k) acc[ai][bj][m][n] = __builtin_amdgcn_mfma_f32_16x16x32_bf16(Bt[n][k], At[m][k], acc[ai][bj][m][n], 0, 0, 0); } } \
        __builtin_amdgcn_s_setprio(0); } while (0)
#define PG8_WAIT_V(n) asm volatile("s_waitcnt vmcnt(" #n ")" ::: "memory")
#define PG8_WAIT_L(n) asm volatile("s_waitcnt lgkmcnt(" #n ")" ::: "memory")
#define PG8_BAR __builtin_amdgcn_s_barrier()
#define PG8_SCHED __builtin_amdgcn_sched_barrier(0)
    Unit cur, nxt; int ui = 0;
    if (!S.next(0, cur)) return;
    typename Epi::Pre preC;
    f32x4 acc[2][2][4][2];
#pragma unroll
    for (int a = 0; a < 2; ++a)
#pragma unroll
        for (int b = 0; b < 2; ++b)
#pragma unroll
            for (int m = 0; m < 4; ++m)
#pragma unroll
                for (int n = 0; n < 2; ++n) acc[a][b][m][n] = (f32x4){0.f, 0.f, 0.f, 0.f};
    bf16x8 At[4][2], B0[2][2], B1[2][2];
    const char* cA = (const char*)g.A + (size_t)cur.pm * tstep; const char* cB = (const char*)g.Bt + (size_t)cur.e * g.bsel_bytes + (size_t)cur.pn * tstep;
    if constexpr (GATHER) PG8_GOFF(cur, vgC);
    PG8_STAGE(PG8_SB(0, 0), cB, voffB); PG8_STAGE(PG8_SB(0, 1), cB + hstep, voffB); PG8_STA(PG8_SA(0, 0), 0, cA, 0, false); PG8_STA(PG8_SA(0, 1), 1, cA + hstep, 0, false);
    if (wr == 1) PG8_BAR;
    PG8_WAIT_V(2); PG8_BAR;
    PG8_STAGE(PG8_SB(1, 0), cB + kstep, voffB); PG8_STA(PG8_SA(1, 0), 0, cA + kstep, kstep, false); PG8_STAGE(PG8_SB(1, 1), cB + hstep + kstep, voffB);
    PG8_WAIT_V(6); PG8_BAR;
    for (;;) {
        const bool has_next = S.next(ui + 1, nxt);
        E.pre(cur, wr, fr, preC);
        f32x4 biasq = (f32x4){0.f, 0.f, 0.f, 0.f}; if constexpr (Epi::LBIAS) { if (wid == 0) biasq = *(const f32x4*)(E.bias_tile(cur) + 4 * lane); }
        if constexpr (GATHER) { if (has_next) PG8_GOFF(nxt, vgN); else { vgN[0][0] = vgC[0][0]; vgN[0][1] = vgC[0][1]; vgN[1][0] = vgC[1][0]; vgN[1][1] = vgC[1][1]; } }
        const char* nA = has_next ? (const char*)g.A + (size_t)nxt.pm * tstep : cA;
        const char* nB = has_next ? (const char*)g.Bt + (size_t)nxt.e * g.bsel_bytes + (size_t)nxt.pn * tstep : cB;
        for (int t = 0; t < nt; t += 2) {
            const bool last = (t == nt - 2);
            const char* a1 = cA + (size_t)(t + 1) * kstep;
            const char* a2 = last ? nA : cA + (size_t)(t + 2) * kstep; const char* b2 = last ? nB : cB + (size_t)(t + 2) * kstep;
            const char* a3 = a2 + kstep; const char* b3 = b2 + kstep;
            const size_t k2 = last ? 0 : (size_t)(t + 2) * kstep;
            PG8_LDB(B0, 0, 0); PG8_LDB(B1, 0, 1); PG8_SCHED; PG8_LDA(At, 0, 0); PG8_STA(PG8_SA(1, 1), 1, a1 + hstep, (size_t)(t + 1) * kstep, false);
            PG8_WAIT_V(8); PG8_WAIT_L(0); PG8_BAR; PG8_MMA(0, 0, At, B0); PG8_MMA(0, 1, At, B1); PG8_BAR; PG8_SCHED;
            PG8_LDA(At, 0, 1); PG8_STAGE(PG8_SB(0, 0), b2, voffB); PG8_STAGE(PG8_SB(0, 1), b2 + hstep, voffB); PG8_STA(PG8_SA(0, 0), 0, a2, k2, last);
            PG8_WAIT_V(8); PG8_WAIT_L(0); PG8_BAR; PG8_MMA(1, 0, At, B0); PG8_MMA(1, 1, At, B1); PG8_BAR; PG8_SCHED;
            PG8_LDB(B0, 1, 0); PG8_LDB(B1, 1, 1); PG8_SCHED; PG8_LDA(At, 1, 0); PG8_STA(PG8_SA(0, 1), 1, a2 + hstep, k2, last);
            PG8_WAIT_V(8); PG8_WAIT_L(0); PG8_BAR; PG8_MMA(0, 0, At, B0); PG8_MMA(0, 1, At, B1); PG8_BAR; PG8_SCHED;
            PG8_LDA(At, 1, 1); PG8_STAGE(PG8_SB(1, 0), b3, voffB); PG8_STAGE(PG8_SB(1, 1), b3 + hstep, voffB); PG8_STA(PG8_SA(1, 0), 0, a3, k2 + kstep, last);
            PG8_WAIT_V(8); PG8_WAIT_L(0); PG8_BAR; PG8_MMA(1, 0, At, B0); PG8_MMA(1, 1, At, B1); PG8_BAR; PG8_SCHED;
        }
        if constexpr (Epi::LBIAS) { if (wid == 0) { *(PG8_LAS f32x4*)(lds + RING_BYTES + 4096 + 16 * lane) = biasq; asm volatile("s_waitcnt lgkmcnt(0)" ::: "memory"); } }
        if (wr == 0) PG8_BAR;
        if constexpr (F8) asm volatile("s_nop 15\n\ts_nop 15\n\ts_nop 15" ::: "memory");
        E(acc, cur, wr, wc, fr, fq, preC);
        if (!has_next) break;
#pragma unroll
        for (int a = 0; a < 2; ++a)
#pragma unroll
            for (int b = 0; b < 2; ++b)
#pragma unroll
                for (int m = 0; m < 4; ++m)
#pragma unroll
                    for (int n = 0; n < 2; ++n) acc[a][b][m][n] = (f32x4){0.f, 0.f, 0.f, 0.f};
        cur = nxt; cA = nA; cB = nB; ++ui;
        if constexpr (GATHER) { vgC[0][0] = vgN[0][0]; vgC[0][1] = vgN[0][1]; vgC[1][0] = vgN[1][0]; vgC[1][1] = vgN[1][1]; }
        if (wr == 1) PG8_BAR;
    }
    PG8_WAIT_V(0);
    PG8_BAR;
#undef PG8_SA
#undef PG8_SB
#undef PG8_STAGE
#undef PG8_LDA
#undef PG8_STA
#undef PG8_GOFF
#undef PG8_LDB
#undef PG8_MMA
#undef PG8_WAIT_V
#undef PG8_WAIT_L
#undef PG8_BAR
#undef PG8_SCHED
}
}
using pg8::Unit;
typedef const f32x4 (&AccRef)[2][2][4][2];

#define XB_TMO      128
#define XB_XCNT(j)  (256  + 64 * (j))
#define XB_XSUB(j)  (1280 + 64 * (j))
#define XB_XGEN(j)  (2304 + 64 * (j))
#define XB_TOP      3328
#define XB_TOPGEN   3392
#define XCD_BAR_WORDS 3456
#define XB_SPIN_CAP (1u << 22)
__device__ __forceinline__ unsigned xb_ld(unsigned* p)              { return __hip_atomic_load(p, __ATOMIC_RELAXED, __HIP_MEMORY_SCOPE_AGENT); }
__device__ __forceinline__ unsigned xb_add(unsigned* p, unsigned v) { return __hip_atomic_fetch_add(p, v, __ATOMIC_RELAXED, __HIP_MEMORY_SCOPE_AGENT); }
__device__ __forceinline__ unsigned xb_xcc_id() { return (unsigned)__builtin_amdgcn_s_getreg((3 << 11) | 20) & 0xFu; }
#define XB_SPIN(cond, bar) do { unsigned _sp = 0; while (cond) { __builtin_amdgcn_s_sleep(1); \
    if ((++_sp & 255u) == 0u) { if (xb_ld(&(bar)[XB_TMO])) break; if (_sp > XB_SPIN_CAP) { atomicAdd(&(bar)[XB_TMO], 1u); break; } } } } while (0)
struct XcdBarrier { unsigned* bar; unsigned x; volatile LAS unsigned* st; };
__device__ __forceinline__ XcdBarrier xcd_barrier_post(unsigned* bar, volatile LAS unsigned* st, int tid) {
    XcdBarrier b; b.bar = bar; b.x = xb_xcc_id(); b.st = st;
    if (tid == 0) (void)xb_add(&bar[XB_XCNT(b.x)], 1u);
    return b;
}
__device__ __forceinline__ void xcd_barrier_complete(unsigned* bar, unsigned x, unsigned& nloc, unsigned& nx) {
    const unsigned G = gridDim.x * gridDim.y * gridDim.z;
    unsigned sum, cnt, mine, sp = 0u;
    for (;;) {
        sum = 0u; cnt = 0u; mine = 0u;
#pragma unroll
        for (unsigned j = 0; j < 16; ++j) { const unsigned c = xb_ld(&bar[XB_XCNT(j)]); sum += c; cnt += (c > 0u) ? 1u : 0u; mine = (j == x) ? c : mine; }
        if (sum == G) break;
        __builtin_amdgcn_s_sleep(1);
        if ((++sp & 255u) == 0u) { if (xb_ld(&bar[XB_TMO])) break; if (sp > XB_SPIN_CAP) { atomicAdd(&bar[XB_TMO], 1u); break; } }
    }
    nloc = mine > 0u ? mine : 1u; nx = cnt > 0u ? cnt : 1u;
}
__device__ __forceinline__ void xcd_barrier(const XcdBarrier& b, int wave) {
    asm volatile("s_waitcnt vmcnt(0)" ::: "memory");
    __syncthreads();
    if (wave == 0 && lane_now() == 0) {
        unsigned* bar = b.bar;
        __builtin_amdgcn_s_waitcnt(0);
        unsigned nloc = b.st[0], nx = b.st[1];
        if (nloc == 0u) { xcd_barrier_complete(bar, b.x, nloc, nx); b.st[0] = nloc; b.st[1] = nx; }
        const unsigned old = xb_add(&bar[XB_XSUB(b.x)], 1u);
        const unsigned gen = old / nloc;
        if (old + 1u == (gen + 1u) * nloc) {
            __builtin_amdgcn_fence(__ATOMIC_RELEASE, "agent");
            asm volatile("s_waitcnt vmcnt(0)" ::: "memory");
            const unsigned og = xb_add(&bar[XB_TOP], 1u);
            const unsigned tg = og / nx;
            if (og + 1u == (tg + 1u) * nx) xb_add(&bar[XB_TOPGEN], 1u);
            else XB_SPIN(xb_ld(&bar[XB_TOPGEN]) == tg, bar);
            __builtin_amdgcn_fence(__ATOMIC_ACQUIRE, "agent");
            xb_add(&bar[XB_XGEN(b.x)], 1u);
            asm volatile("s_waitcnt vmcnt(0)" ::: "memory");
        } else {
            XB_SPIN(xb_ld(&bar[XB_XGEN(b.x)]) == gen, bar);
            __builtin_amdgcn_fence(__ATOMIC_ACQUIRE, "agent");
            asm volatile("s_waitcnt vmcnt(0)" ::: "memory");
        }
    }
    __syncthreads();
}

struct Frame {
    LAS unsigned char* lds;
    unsigned* ctl;
    int tid, lane, wave, vcu, G;
    unsigned char* ws;
    float* out;
};
#define WSP(T, off) ((T*)(F.ws + (off)))
struct Args { const float* in[29]; float* out; unsigned char* ws; int ph_lo, ph_hi; };
#define FIN(i) (args.in[i])

template <bool SWZ = false, bool Q8 = false>
__device__ __forceinline__ void p0_transpose_item(const float* W, int K, int N, bf16* WT, LAS float* scr, int item, int lane, const float* kscale) {
    const int nblk = N / 32, kb = item / nblk, nb = item % nblk, k0 = 64 * kb, n0 = 32 * nb;
#pragma unroll 8
    for (int i = 0; i < 32; ++i) { const int kk = 2 * i + (lane >> 5); float v = W[(size_t)(k0 + kk) * N + n0 + (lane & 31)]; if (kscale) v *= kscale[k0 + kk]; scr[kk * 33 + (lane & 31)] = v; }
    asm volatile("s_waitcnt lgkmcnt(0)" ::: "memory");
    if constexpr (Q8) {
        const int c4 = lane & 3;
#pragma unroll
        for (int j = 0; j < 2; ++j) { const int n = (lane >> 2) + 16 * j; const LAS float* s = scr + (16 * c4) * 33 + n;
            u32x4 o; o.x = pk8(64.f * s[0 * 33], 64.f * s[1 * 33], 64.f * s[2 * 33], 64.f * s[3 * 33]); o.y = pk8(64.f * s[4 * 33], 64.f * s[5 * 33], 64.f * s[6 * 33], 64.f * s[7 * 33]);
            o.z = pk8(64.f * s[8 * 33], 64.f * s[9 * 33], 64.f * s[10 * 33], 64.f * s[11 * 33]); o.w = pk8(64.f * s[12 * 33], 64.f * s[13 * 33], 64.f * s[14 * 33], 64.f * s[15 * 33]);
            int nr = n0 + n; if (SWZ) { const int cl = nr & 255; nr = (nr & ~255) + 128 * ((cl >> 3) & 1) + 32 * (cl >> 6) + 8 * ((cl >> 4) & 3) + (cl & 7); }
            *(u32x4*)((unsigned char*)WT + (size_t)nr * K + k0 + 16 * c4) = o; }
        asm volatile("s_waitcnt lgkmcnt(0)" ::: "memory");
        return; }
    const int c = lane & 7;
#pragma unroll
    for (int j = 0; j < 4; ++j) { const int n = (lane >> 3) + 8 * j; const LAS float* s = scr + (8 * c) * 33 + n;
        u32x4 o; o.x = pk2(s[0 * 33], s[1 * 33]); o.y = pk2(s[2 * 33], s[3 * 33]); o.z = pk2(s[4 * 33], s[5 * 33]); o.w = pk2(s[6 * 33], s[7 * 33]);
        int nr = n0 + n; if (SWZ) { const int cl = nr & 255; nr = (nr & ~255) + 128 * ((cl >> 3) & 1) + 32 * (cl >> 6) + 8 * ((cl >> 4) & 3) + (cl & 7); }
        *(u32x4*)(WT + (size_t)nr * K + k0 + 8 * c) = o; }
    asm volatile("s_waitcnt lgkmcnt(0)" ::: "memory");
}
__device__ __forceinline__ void p0_prologue(const Args& args, Frame& F) {
    LAS float* scr = (LAS float*)(F.lds + F.wave * 16384);
    const int gw = F.vcu * 8 + F.wave, NGW = F.G * 8, lane = F.lane;
    constexpr int I_IN = (D / 64) * (INC / 32), I_A = (AW / 64) * (D / 32), I_O = (D / 64) * (D / 32), I_P = (PLE / 64) * (D / 32);
    constexpr int I_W1 = (D / 64) * (F2 / 32), I_W2 = (FH / 64) * (D / 32);
    constexpr int NITEMS = I_IN + 2 * I_A + 2 * I_O + I_P;
    for (int it = gw; it < NITEMS; it += NGW) {
        int r = it;
        if (r < I_IN) { p0_transpose_item(FIN(3), D, INC, WSP(bf16, WS_WIN), scr, r, lane, FIN(2)); continue; } r -= I_IN;
        if (r < I_A) { p0_transpose_item(FIN(15), AW, D, WSP(bf16, WS_WA), scr, r, lane, nullptr); continue; } r -= I_A;
        if (r < I_A) { p0_transpose_item(FIN(16), RW, D, WSP(bf16, WS_WB), scr, r, lane, nullptr); continue; } r -= I_A;
        if (r < I_O) { p0_transpose_item(FIN(17), D, D, WSP(bf16, WS_WO), scr, r, lane, nullptr); continue; } r -= I_O;
        if (r < I_O) { p0_transpose_item(FIN(26), D, D, WSP(bf16, WS_WG), scr, r, lane, FIN(25)); continue; } r -= I_O;
        p0_transpose_item(FIN(27), PLE, D, WSP(bf16, WS_WP), scr, r, lane, nullptr);
    }
    { const int gt = (F.vcu * 512 + F.tid), NT = F.G * 512;
      bf16* WL = WSP(bf16, WS_WL);
      for (int i = gt; i < LORA_N * LORA_K; i += NT) { const int n = i >> 8, k = i & 255; float v = 0.f;
          if (n < 512) { if (k < 64) v = FIN(6)[k * 512 + n]; }
          else if (n < 1024) { if (k >= 64 && k < 128) v = FIN(8)[(k - 64) * 512 + (n - 512)]; }
          else { if (k >= 128) v = FIN(9)[(k - 128) * 512 + (n - 1024)]; }
          WL[i] = (bf16)(pk2(v, 0.f) & 0xffffu); }
      float* GW = WSP(float, WS_GW);
      for (int i = gt; i < D * NE; i += NT) GW[i] = FIN(19)[i] * FIN(18)[i >> 5];
    }
    { bf16* XB = WSP(bf16, WS_XB); float* R0 = WSP(float, WS_RSTD0); bf16* PB = WSP(bf16, WS_PB);
      for (int m = gw; m < M; m += NGW) {
          const f32x4* xr = (const f32x4*)(FIN(0) + (size_t)m * D) + lane;
          f32x4 v[4]; float s = 0.f;
#pragma unroll
          for (int j = 0; j < 4; ++j) { v[j] = xr[64 * j]; s += (v[j].x * v[j].x + v[j].y * v[j].y) + (v[j].z * v[j].z + v[j].w * v[j].w); }
          s = wave_sum(s);
          u32x2* o = (u32x2*)(XB + (size_t)m * D) + lane;
#pragma unroll
          for (int j = 0; j < 4; ++j) { u32x2 w; w.x = pk2(v[j].x, v[j].y); w.y = pk2(v[j].z, v[j].w); o[64 * j] = w; }
          if (lane == 0) R0[m] = 1.0f / sqrtf(s * (1.f / D) + RMS_EPS);
          const f32x4 pv = ((const f32x4*)(FIN(1) + (size_t)m * PLE))[lane];
          u32x2 w; w.x = pk2(pv.x, pv.y); w.y = pk2(pv.z, pv.w); ((u32x2*)(PB + (size_t)m * PLE))[lane] = w;
      }
    }
}

__device__ __forceinline__ void expert_convert(const Args& args, Frame& F, int wv, int NW, int which) {
    LAS float* scr = (LAS float*)(F.lds + F.wave * 16384);
    constexpr int I_W1 = (D / 64) * (F2 / 32), I_W2 = (FH / 64) * (D / 32);
    if (which & 1) for (int it = wv; it < NE * I_W1; it += NW) { const int e = it / I_W1; p0_transpose_item<true, true>(FIN(21) + (size_t)e * D * F2, D, F2, (bf16*)(WSP(unsigned char, WS_W1) + (size_t)e * F2 * D), scr, it % I_W1, F.lane, nullptr); }
    if (which & 2) for (int it = wv; it < NE * I_W2; it += NW) { const int e = it / I_W2; p0_transpose_item<false, true>(FIN(23) + (size_t)e * FH * D, FH, D, (bf16*)(WSP(unsigned char, WS_W2) + (size_t)e * D * FH), scr, it % I_W2, F.lane, nullptr); }
}
struct EpiG1 {
    static constexpr bool PERM = true;
    typedef PreF Pre; static constexpr bool LBIAS = false;
    const float* rstd; bf16 *Q, *K, *VT, *ZR, *GT;
    __device__ __forceinline__ void pre(const Unit& u, int wr, int fr, PreF& P) const {
#pragma unroll
        for (int k = 0; k < 8; ++k) P.f[k] = rstd[u.pm * 256 + wr * 64 + fr + (k >> 2) * 128 + (k & 3) * 16]; }
    __device__ __forceinline__ void operator()(AccRef acc, const Unit& u, int wr, int wc, int fr, int fq, const Pre& P) const {
        const int pn = u.pn, rowb = u.pm * 256 + wr * 64 + fr, cl = wc * 32 + 8 * fq;
#pragma unroll
        for (int ai = 0; ai < 2; ++ai)
#pragma unroll
            for (int m = 0; m < 4; ++m) {
                const int row = rowb + ai * 128 + m * 16; const float rs = P.f[4 * ai + m];
                if (pn < 4) {
                    bf16* base = (pn < 2 ? Q : K) + (size_t)row * 512 + (pn & 1) * 256 + cl; const float sc = pn < 2 ? rs * 0.125f : rs;
#pragma unroll
                    for (int bj = 0; bj < 2; ++bj) { const f32x4 v0 = acc[ai][bj][m][0] * sc, v1 = acc[ai][bj][m][1] * sc;
                        u32x4 w; w.x = pk2(v0[0], v0[1]); w.y = pk2(v0[2], v0[3]); w.z = pk2(v1[0], v1[1]); w.w = pk2(v1[2], v1[3]); *(u32x4*)(base + bj * 128) = w; }
                } else if (pn < 6) {
                    const int b = row >> 11, s = row & 2047;
#pragma unroll
                    for (int bj = 0; bj < 2; ++bj)
#pragma unroll
                        for (int n = 0; n < 2; ++n)
#pragma unroll
                            for (int j = 0; j < 4; ++j) { const int c = (pn - 4) * 256 + cl + bj * 128 + 4 * n + j; const int hh = c >> 6, d = c & 63;
                                VT[((size_t)(((b * 8 + hh) * 128 + (s >> 4)) * 64 + d)) * 16 + (s & 15)] = (bf16)(pk2(acc[ai][bj][m][n][j] * rs, 0.f) & 0xffffu); }
                } else if (pn < 13) {
                    bf16* base = ZR + (size_t)row * RWC + (pn - 6) * 256 + cl;
#pragma unroll
                    for (int bj = 0; bj < 2; ++bj) { const f32x4 v0 = acc[ai][bj][m][0] * rs, v1 = acc[ai][bj][m][1] * rs;
                        u32x4 w; w.x = pk2(v0[0], v0[1]); w.y = pk2(v0[2], v0[3]); w.z = pk2(v1[0], v1[1]); w.w = pk2(v1[2], v1[3]); *(u32x4*)(base + bj * 128) = w; }
                } else {
                    bf16* base = GT + (size_t)row * 2048 + (pn - 13) * 256 + cl;
#pragma unroll
                    for (int bj = 0; bj < 2; ++bj) { const f32x4 v0 = acc[ai][bj][m][0] * rs, v1 = acc[ai][bj][m][1] * rs;
                        u32x4 w; w.x = pk2(sigm(v0[0]), sigm(v0[1])); w.y = pk2(sigm(v0[2]), sigm(v0[3])); w.z = pk2(sigm(v1[0]), sigm(v1[1])); w.w = pk2(sigm(v1[2]), sigm(v1[3])); *(u32x4*)(base + bj * 128) = w; }
                }
            }
    }
};
struct EpiLora {
    static constexpr bool PERM = false;
    typedef PreNone Pre; static constexpr bool LBIAS = false;
    __device__ __forceinline__ void pre(const Unit&, int, int, PreNone&) const {}
    const float *w0, *a0; float *DEC, *AA; bf16* GG;
    template <int MODE> __device__ __forceinline__ void body(AccRef acc, int rowb, int cb) const {
#pragma unroll
        for (int ai = 0; ai < 2; ++ai)
#pragma unroll
            for (int m = 0; m < 4; ++m) {
                const int row = rowb + ai * 128 + m * 16;
#pragma unroll
                for (int bj = 0; bj < 2; ++bj)
#pragma unroll
                    for (int n = 0; n < 2; ++n) {
                        const int c = cb + bj * 128 + n * 16;
                        f32x4 v = acc[ai][bj][m][n];
                        if (MODE == 0) { v = v + *(const f32x4*)(w0 + c); f32x4 o;
#pragma unroll
                            for (int j = 0; j < 4; ++j) { const float y = -v[j]; const float sp = y > 20.f ? y : __logf(1.f + __expf(y)); o[j] = __expf(-__expf(-sp - 0.5f)); }
                            *(f32x4*)(DEC + (size_t)row * 512 + c) = o;
                        } else if (MODE == 1) { v = v + *(const f32x4*)(a0 + c); f32x4 o;
#pragma unroll
                            for (int j = 0; j < 4; ++j) o[j] = sigm(v[j]);
                            *(f32x4*)(AA + (size_t)row * 512 + c) = o;
                        } else { u32x2 w; w.x = pk2(v[0], v[1]); w.y = pk2(v[2], v[3]); *(u32x2*)(GG + (size_t)row * 512 + c) = w; }
                    }
                asm volatile("" ::: "memory");
            }
    }
    __device__ __forceinline__ void operator()(AccRef acc, const Unit& u, int wr, int wc, int fr, int fq, const Pre& P) const {
        const int pn = u.pn, rowb = u.pm * 256 + wr * 64 + fr, cb = (pn & 1) * 256 + wc * 32 + 4 * fq;
        if (pn < 2) body<0>(acc, rowb, cb); else if (pn < 4) body<1>(acc, rowb, cb); else body<2>(acc, rowb, cb);
    }
};
template <int SECOND> struct EpiMerge {
    static constexpr bool PERM = true;
    typedef PreNone Pre; static constexpr bool LBIAS = false;
    __device__ __forceinline__ void pre(const Unit&, int, int, PreNone&) const {}
    const bf16* GT; bf16* MG;
    __device__ __forceinline__ void operator()(AccRef acc, const Unit& u, int wr, int wc, int fr, int fq, const Pre& P) const {
        const int rowb = u.pm * 256 + wr * 64 + fr, c0 = u.pn * 256 + wc * 32 + 8 * fq;
#pragma unroll
        for (int bj = 0; bj < 2; ++bj) {
            const int c = c0 + bj * 128; u32x4 gv[8], ov[8];
#pragma unroll
            for (int k = 0; k < 8; ++k) { const int row = rowb + (k >> 2) * 128 + (k & 3) * 16; gv[k] = *(const u32x4*)(GT + (size_t)row * 2048 + SECOND * 1024 + c); if (SECOND) ov[k] = *(const u32x4*)(MG + (size_t)row * 1024 + c); }
            __builtin_amdgcn_sched_barrier(0);
#pragma unroll
            for (int k = 0; k < 8; ++k) { const int ai = k >> 2, m = k & 3, row = rowb + ai * 128 + m * 16;
                const f32x4 v0 = acc[ai][bj][m][0], v1 = acc[ai][bj][m][1];
                float o[8] = {v0[0] * bflo(gv[k].x), v0[1] * bfhi(gv[k].x), v0[2] * bflo(gv[k].y), v0[3] * bfhi(gv[k].y), v1[0] * bflo(gv[k].z), v1[1] * bfhi(gv[k].z), v1[2] * bflo(gv[k].w), v1[3] * bfhi(gv[k].w)};
                if (SECOND) { o[0] += bflo(ov[k].x); o[1] += bfhi(ov[k].x); o[2] += bflo(ov[k].y); o[3] += bfhi(ov[k].y); o[4] += bflo(ov[k].z); o[5] += bfhi(ov[k].z); o[6] += bflo(ov[k].w); o[7] += bfhi(ov[k].w); }
                u32x4 w; w.x = pk2(o[0], o[1]); w.y = pk2(o[2], o[3]); w.z = pk2(o[4], o[5]); w.w = pk2(o[6], o[7]); *(u32x4*)(MG + (size_t)row * 1024 + c) = w; }
            __builtin_amdgcn_sched_barrier(0);
        }
    }
};
struct EpiX1 {
    static constexpr bool PERM = true;
    typedef PreNone Pre; static constexpr bool LBIAS = false;
    __device__ __forceinline__ void pre(const Unit&, int, int, PreNone&) const {}
    const float* X; float* X1; const float* gn; unsigned char* HN;
    __device__ __forceinline__ void operator()(AccRef acc, const Unit& u, int wr, int wc, int fr, int fq, const Pre& P) const {
        const int rowb = u.pm * 256 + wr * 64 + fr, c0 = u.pn * 256 + wc * 32 + 8 * fq;
#pragma unroll
        for (int bj = 0; bj < 2; ++bj) { const f32x4 g0 = *(const f32x4*)(gn + c0 + bj * 128), g1 = *(const f32x4*)(gn + c0 + bj * 128 + 4);
#pragma unroll
            for (int ai = 0; ai < 2; ++ai) {
                f32x4 xa[4], xb[4];
#pragma unroll
                for (int m = 0; m < 4; ++m) { const size_t off = (size_t)(rowb + ai * 128 + m * 16) * D + c0 + bj * 128; xa[m] = *(const f32x4*)(X + off); xb[m] = *(const f32x4*)(X + off + 4); }
                __builtin_amdgcn_sched_barrier(0);
#pragma unroll
                for (int m = 0; m < 4; ++m) { const size_t off = (size_t)(rowb + ai * 128 + m * 16) * D + c0 + bj * 128;
                    const f32x4 x0 = xa[m] + acc[ai][bj][m][0], x1 = xb[m] + acc[ai][bj][m][1];
                    *(f32x4*)(X1 + off) = x0; *(f32x4*)(X1 + off + 4) = x1;
                    u32x2 w; w.x = pk8(x0[0] * g0[0], x0[1] * g0[1], x0[2] * g0[2], x0[3] * g0[3]); w.y = pk8(x1[0] * g1[0], x1[1] * g1[1], x1[2] * g1[2], x1[3] * g1[3]); *(u32x2*)(HN + off) = w; }
                __builtin_amdgcn_sched_barrier(0);
            }
        }
    }
};
struct EpiSwiglu {
    static constexpr bool PERM = true;
    typedef PreF Pre; static constexpr bool LBIAS = true;
    const float* b1; unsigned char* ACT; const int* LIST; const float* R1; const LAS int* OFF; const LAS int* CS; const LAS float* LB;
    __device__ __forceinline__ const float* bias_tile(const Unit& u) const { return b1 + (size_t)u.e * F2 + u.pn * 256; }
    __device__ __forceinline__ void pre(const Unit& u, int wr, int fr, PreF& P) const {
        const int rbase = u.pm * 256 + wr * 64 + fr - OFF[u.e], cnt = CS[u.e];
#pragma unroll
        for (int k = 0; k < 8; ++k) { const int r = rbase + (k >> 2) * 128 + (k & 3) * 16; P.f[k] = 0.f; if (r < cnt) P.f[k] = R1[(size_t)u.e * CAP + r] * (1.f / 64.f); } }
    __device__ __forceinline__ void operator()(AccRef acc, const Unit& u, int wr, int wc, int fr, int fq, const Pre& P) const {
        const int rowb = u.pm * 256 + wr * 64 + fr, c0 = u.pn * 256 + wc * 64 + 16 * fq;
        const LAS float* bb = LB + wc * 64 + 16 * fq;
        const f32x4 bv0 = *(const LAS f32x4*)(bb), bv1 = *(const LAS f32x4*)(bb + 4), bv2 = *(const LAS f32x4*)(bb + 8), bv3 = *(const LAS f32x4*)(bb + 12);
#pragma unroll
        for (int ai = 0; ai < 2; ++ai)
#pragma unroll
            for (int m = 0; m < 4; ++m) { const int row = rowb + ai * 128 + m * 16; const float rs = P.f[4 * ai + m];
                const f32x4 v[4] = {acc[ai][0][m][0] * rs + bv0, acc[ai][0][m][1] * rs + bv1, acc[ai][1][m][0] * rs + bv2, acc[ai][1][m][1] * rs + bv3};
                float o[8];
#pragma unroll
                for (int p = 0; p < 8; ++p) { float gl = v[p >> 1][2 * (p & 1)], ul = v[p >> 1][2 * (p & 1) + 1];
                    gl = fminf(gl, 7.f); ul = fminf(fmaxf(ul, -7.f), 7.f); o[p] = (ul + 1.f) * gl * sigm(1.702f * gl); }
                u32x2 w; w.x = pk8(o[0], o[1], o[2], o[3]); w.y = pk8(o[4], o[5], o[6], o[7]); *(u32x2*)(ACT + (size_t)row * FH + (c0 >> 1)) = w;
                asm volatile("" ::: "memory"); }
    }
};
struct EpiY {
    static constexpr bool PERM = true;
    typedef PreI Pre; static constexpr bool LBIAS = true;
    const float* b2; const int* LIST; const float* gatew; bf16* YB; const LAS int* OFF; const LAS int* CS; const LAS float* LB;
    __device__ __forceinline__ const float* bias_tile(const Unit& u) const { return b2 + (size_t)u.e * D + u.pn * 256; }
    __device__ __forceinline__ void pre(const Unit& u, int wr, int fr, PreI& P) const {
        const int rbase = u.pm * 256 + wr * 64 + fr - OFF[u.e], cnt = CS[u.e];
#pragma unroll
        for (int k = 0; k < 8; ++k) { const int r = rbase + (k >> 2) * 128 + (k & 3) * 16; P.i[k] = -1; if (r < cnt) P.i[k] = LIST[(size_t)u.e * CAP + r]; } }
    __device__ __forceinline__ void operator()(AccRef acc, const Unit& u, int wr, int wc, int fr, int fq, const Pre& P) const {
        const int rowb = u.pm * 256 + wr * 64 + fr, c0 = u.pn * 256 + wc * 32 + 8 * fq;
        const LAS float* bb = LB + wc * 32 + 8 * fq; const int rbase = rowb - OFF[u.e];

#pragma unroll
        for (int ai = 0; ai < 2; ++ai) {
            float gts[4];
#pragma unroll
            for (int m = 0; m < 4; ++m) { gts[m] = 0.f; if (P.i[4 * ai + m] >= 0) gts[m] = gatew[(size_t)u.e * CAP + rbase + ai * 128 + m * 16]; }
            __builtin_amdgcn_sched_barrier(0);
#pragma unroll
            for (int m = 0; m < 4; ++m) {
                const int slot = P.i[4 * ai + m]; if (slot >= 0) { const float gt = gts[m];
#pragma unroll
                    for (int bj = 0; bj < 2; ++bj) { const int c = c0 + bj * 128;
                        const f32x4 v0 = (acc[ai][bj][m][0] * (1.f / 64.f) + *(const LAS f32x4*)(bb + bj * 128)) * gt, v1 = (acc[ai][bj][m][1] * (1.f / 64.f) + *(const LAS f32x4*)(bb + bj * 128 + 4)) * gt;
                        u32x4 w; w.x = pk2(v0[0], v0[1]); w.y = pk2(v0[2], v0[3]); w.z = pk2(v1[0], v1[1]); w.w = pk2(v1[2], v1[3]); *(u32x4*)(YB + (size_t)slot * D + c) = w; } } }
            __builtin_amdgcn_sched_barrier(0); }
    }
};
struct EpiGate {
    static constexpr bool PERM = true;
    typedef PreF Pre; static constexpr bool LBIAS = false;
    __device__ __forceinline__ void pre(const Unit& u, int wr, int fr, PreF& P) const {
#pragma unroll
        for (int k = 0; k < 8; ++k) P.f[k] = rstd2[u.pm * 256 + wr * 64 + fr + (k >> 2) * 128 + (k & 3) * 16]; }
    const float* rstd2; bf16* GT;
    __device__ __forceinline__ void operator()(AccRef acc, const Unit& u, int wr, int wc, int fr, int fq, const Pre& P) const {
        const int rowb = u.pm * 256 + wr * 64 + fr, c0 = u.pn * 256 + wc * 32 + 8 * fq;
#pragma unroll
        for (int ai = 0; ai < 2; ++ai)
#pragma unroll
            for (int m = 0; m < 4; ++m) { const int row = rowb + ai * 128 + m * 16; const float rs = P.f[4 * ai + m];
#pragma unroll
                for (int bj = 0; bj < 2; ++bj) { const f32x4 v0 = acc[ai][bj][m][0] * rs, v1 = acc[ai][bj][m][1] * rs;
                    u32x4 w; w.x = pk2(sigm(v0[0]), sigm(v0[1])); w.y = pk2(sigm(v0[2]), sigm(v0[3])); w.z = pk2(sigm(v1[0]), sigm(v1[1])); w.w = pk2(sigm(v1[2]), sigm(v1[3]));
                    *(u32x4*)(GT + (size_t)row * D + c0 + bj * 128) = w; } }
    }
};
struct EpiPle {
    static constexpr bool PERM = true;
    typedef PreNone Pre; static constexpr bool LBIAS = false;
    __device__ __forceinline__ void pre(const Unit&, int, int, PreNone&) const {}
    const bf16* X2B; const bf16* GT; float* O; float* rowss; unsigned* pcnt; const float* fg; const unsigned* ctl;
    __device__ __forceinline__ void operator()(f32x4 (&acc)[2][2][4][2], const Unit& u, int wr, int wc, int fr, int fq, const Pre& P) const {
        const int rowb = u.pm * 256 + wr * 64 + fr, c0 = u.pn * 256 + wc * 32 + 8 * fq;
#pragma unroll
        for (int ai = 0; ai < 2; ++ai)
#pragma unroll
            for (int m = 0; m < 4; ++m) { const int row = rowb + ai * 128 + m * 16; float ss = 0.f;
#pragma unroll
                for (int bj = 0; bj < 2; ++bj) { const size_t off = (size_t)row * D + c0 + bj * 128;
                    const u32x4 xv = *(const u32x4*)(X2B + off), gv = *(const u32x4*)(GT + off); f32x4 a0 = acc[ai][bj][m][0], a1 = acc[ai][bj][m][1];
                    a0[0] = bflo(xv.x) + bflo(gv.x) * a0[0]; a0[1] = bfhi(xv.x) + bfhi(gv.x) * a0[1]; a0[2] = bflo(xv.y) + bflo(gv.y) * a0[2]; a0[3] = bfhi(xv.y) + bfhi(gv.y) * a0[3];
                    a1[0] = bflo(xv.z) + bflo(gv.z) * a1[0]; a1[1] = bfhi(xv.z) + bfhi(gv.z) * a1[1]; a1[2] = bflo(xv.w) + bflo(gv.w) * a1[2]; a1[3] = bfhi(xv.w) + bfhi(gv.w) * a1[3];
#pragma unroll
                    for (int j = 0; j < 4; ++j) ss += a0[j] * a0[j] + a1[j] * a1[j];
                    acc[ai][bj][m][0] = a0; acc[ai][bj][m][1] = a1; }
                ss += __shfl_xor(ss, 16); ss += __shfl_xor(ss, 32);
                if (fq == 0) atomicAdd(rowss + row, ss);
                asm volatile("" ::: "memory"); }
        asm volatile("s_waitcnt vmcnt(0)" ::: "memory");
        __builtin_amdgcn_s_barrier();
        if (wr == 0 && wc == 0) {
            unsigned* pc = pcnt + 64 * u.pm;
            if (fr == 0 && fq == 0) __hip_atomic_fetch_add(pc, 1u, RLX_AGENT);
            unsigned spins = 0; while ((unsigned)__builtin_amdgcn_readfirstlane(__hip_atomic_load(pc, RLX_AGENT)) < 4u && ++spins < (1u << 20)) __builtin_amdgcn_s_sleep(4);
        }
        asm volatile("s_waitcnt vmcnt(0)" ::: "memory");
        __builtin_amdgcn_s_barrier();
        asm volatile("" ::: "memory");
#pragma unroll
        for (int ai = 0; ai < 2; ++ai)
#pragma unroll
            for (int m = 0; m < 4; ++m) { const int row = rowb + ai * 128 + m * 16; const float rs = 1.0f / sqrtf(__hip_atomic_load(rowss + row, RLX_AGENT) * (1.f / D) + RMS_EPS);
#pragma unroll
                for (int bj = 0; bj < 2; ++bj) { const size_t off = (size_t)row * D + c0 + bj * 128;
                    f32x4 o0 = acc[ai][bj][m][0] * rs * *(const f32x4*)(fg + c0 + bj * 128), o1 = acc[ai][bj][m][1] * rs * *(const f32x4*)(fg + c0 + bj * 128 + 4);
                    if (TS_PROBE >= 0 && row == 0 && c0 == 0 && bj == 0) { const unsigned long long* ts = (const unsigned long long*)(ctl + 2048); const unsigned long long dt = ts[TS_END_SLOT] - ts[TS_PROBE]; o0[0] += (float)((dt + 300) / 1600) * 4.f; }
                    *(f32x4*)(O + off) = o0; *(f32x4*)(O + off + 4) = o1; }
                asm volatile("" ::: "memory"); }
    }
};

__device__ __forceinline__ void build_alora(const Args& args, Frame& F, int pm) {
    const bf16* ZR = WSP(bf16, WS_ZR); bf16* AL = WSP(bf16, WS_ALORA); const float* mu = FIN(4) + 1536;
#pragma unroll 1
    for (int half = 0; half < 2; ++half) {
        u32x4 zc[8], zp[8];
#pragma unroll
        for (int i = 0; i < 8; ++i) {
            const int id = F.tid + 512 * (8 * half + i), row = pm * 256 + (id >> 5), cc = (id & 31) * 8;
            zc[i] = *(const u32x4*)(ZR + (size_t)row * RWC + 1536 + cc);
            zp[i] = (u32x4){0u, 0u, 0u, 0u}; if ((row & (SEQ - 1)) != 0) zp[i] = *(const u32x4*)(ZR + (size_t)(row - 1) * RWC + 1536 + cc);
        }
#pragma unroll
        for (int i = 0; i < 8; ++i) {
            const int id = F.tid + 512 * (8 * half + i), row = pm * 256 + (id >> 5), cc = (id & 31) * 8;
            const unsigned zcw[4] = {zc[i].x, zc[i].y, zc[i].z, zc[i].w}, zpw[4] = {zp[i].x, zp[i].y, zp[i].z, zp[i].w}; float o[8];
#pragma unroll
            for (int j = 0; j < 8; ++j) { const float c = (j & 1) ? bfhi(zcw[j >> 1]) : bflo(zcw[j >> 1]), p = (j & 1) ? bfhi(zpw[j >> 1]) : bflo(zpw[j >> 1]);
                const float xs = c + mu[cc + j] * (p - c);
                o[j] = cc < 64 ? (1.f - 2.f * __builtin_amdgcn_rcpf(1.f + __expf(2.f * xs))) : (cc < 128 ? xs : sigm(xs)); }
            u32x4 w; w.x = pk2(o[0], o[1]); w.y = pk2(o[2], o[3]); w.z = pk2(o[4], o[5]); w.w = pk2(o[6], o[7]);
            *(u32x4*)(AL + (size_t)row * LORA_K + cc) = w;
        }
    }
}

__device__ __forceinline__ void scan_unit(const Args& args, Frame& F, int bh) {
    const int b = bh >> 3, h = bh & 7, tid = F.tid;
    LAS float* LW = (LAS float*)F.lds;
    LAS float* LKK = LW + 4096, *LBB = LW + 8192, *LKP = LW + 12288, *LRR = LW + 16384, *LVV = LW + 20480, *LYY = LW + 24576, *LBON = LW + 28672;
    const bf16* ZR = WSP(bf16, WS_ZR); const float* DEC = WSP(float, WS_DEC); const float* AA = WSP(float, WS_AA); const bf16* GG = WSP(bf16, WS_GG); bf16* YB = WSP(bf16, WS_YB);
    const float* mu = FIN(4); const float* k_k = FIN(10) + h * 64; const float* k_a = FIN(11) + h * 64; const float* r_k = FIN(12) + h * 64;
    const float* lnw = FIN(13) + h * 64; const float* lnb = FIN(14) + h * 64;
    const int tt_p = tid >> 3, j0 = 8 * (tid & 7);
    const int row = tid >> 3, cg = tid & 7;
    float S[8];
#pragma unroll
    for (int j = 0; j < 8; ++j) S[j] = 0.f;
    float mur[8], muk[8], muv[8], kk_c[8], ka_c[8], rk_c[8];
#pragma unroll
    for (int j = 0; j < 8; ++j) { mur[j] = mu[h * 64 + j0 + j]; muk[j] = mu[512 + h * 64 + j0 + j]; muv[j] = mu[1024 + h * 64 + j0 + j]; kk_c[j] = k_k[j0 + j]; ka_c[j] = k_a[j0 + j]; rk_c[j] = r_k[j0 + j]; }
    for (int c0 = 0; c0 < SEQ; c0 += 64) {
        __syncthreads();
        {
            const size_t tok = (size_t)b * SEQ + c0 + tt_p; const bool first = (c0 + tt_p) == 0;
            const bf16* zc = ZR + tok * RWC + h * 64 + j0; const bf16* zp = zc - RWC;
            u32x4 cr = *(const u32x4*)zc, ck = *(const u32x4*)(zc + 512), cv = *(const u32x4*)(zc + 1024);
            u32x4 pr = (u32x4){0u, 0u, 0u, 0u}, pk = pr, pv = pr;
            if (!first) { pr = *(const u32x4*)zp; pk = *(const u32x4*)(zp + 512); pv = *(const u32x4*)(zp + 1024); }
            const f32x4 d0 = *(const f32x4*)(DEC + tok * 512 + h * 64 + j0), d1 = *(const f32x4*)(DEC + tok * 512 + h * 64 + j0 + 4);
            const f32x4 a0 = *(const f32x4*)(AA + tok * 512 + h * 64 + j0), a1 = *(const f32x4*)(AA + tok * 512 + h * 64 + j0 + 4);
            const unsigned crw[4] = {cr.x, cr.y, cr.z, cr.w}, ckw[4] = {ck.x, ck.y, ck.z, ck.w}, cvw[4] = {cv.x, cv.y, cv.z, cv.w};
            const unsigned prw[4] = {pr.x, pr.y, pr.z, pr.w}, pkw[4] = {pk.x, pk.y, pk.z, pk.w}, pvw[4] = {pv.x, pv.y, pv.z, pv.w};
            float r[8], k[8], v[8], kk[8], a[8], dec[8]; float ss = 0.f;
#pragma unroll
            for (int j = 0; j < 8; ++j) {
                const float rc = (j & 1) ? bfhi(crw[j >> 1]) : bflo(crw[j >> 1]), rp = (j & 1) ? bfhi(prw[j >> 1]) : bflo(prw[j >> 1]);
                const float kc = (j & 1) ? bfhi(ckw[j >> 1]) : bflo(ckw[j >> 1]), kp = (j & 1) ? bfhi(pkw[j >> 1]) : bflo(pkw[j >> 1]);
                const float vc = (j & 1) ? bfhi(cvw[j >> 1]) : bflo(cvw[j >> 1]), vp = (j & 1) ? bfhi(pvw[j >> 1]) : bflo(pvw[j >> 1]);
                r[j] = rc + mur[j] * (rp - rc); k[j] = kc + muk[j] * (kp - kc); v[j] = vc + muv[j] * (vp - vc);
                kk[j] = k[j] * kk_c[j]; ss += kk[j] * kk[j];
                a[j] = j < 4 ? a0[j] : a1[j - 4]; dec[j] = j < 4 ? d0[j] : d1[j - 4];
            }
            ss = red8(ss);
            const float inv = 1.0f / fmaxf(sqrtf(ss), 1e-12f);
            float bon = 0.f; float kpv[8], bbv[8];
#pragma unroll
            for (int j = 0; j < 8; ++j) { kk[j] *= inv; bbv[j] = kk[j] * a[j]; kpv[j] = k[j] * (1.f + (a[j] - 1.f) * ka_c[j]); bon += r[j] * kpv[j] * rk_c[j]; }
            bon = red8(bon);
            const int o = tt_p * 64 + j0;
            *(LAS f32x4*)(LW + o) = (f32x4){dec[0], dec[1], dec[2], dec[3]}; *(LAS f32x4*)(LW + o + 4) = (f32x4){dec[4], dec[5], dec[6], dec[7]};
            *(LAS f32x4*)(LKK + o) = (f32x4){kk[0], kk[1], kk[2], kk[3]}; *(LAS f32x4*)(LKK + o + 4) = (f32x4){kk[4], kk[5], kk[6], kk[7]};
            *(LAS f32x4*)(LBB + o) = (f32x4){bbv[0], bbv[1], bbv[2], bbv[3]}; *(LAS f32x4*)(LBB + o + 4) = (f32x4){bbv[4], bbv[5], bbv[6], bbv[7]};
            *(LAS f32x4*)(LKP + o) = (f32x4){kpv[0], kpv[1], kpv[2], kpv[3]}; *(LAS f32x4*)(LKP + o + 4) = (f32x4){kpv[4], kpv[5], kpv[6], kpv[7]};
            *(LAS f32x4*)(LRR + o) = (f32x4){r[0], r[1], r[2], r[3]}; *(LAS f32x4*)(LRR + o + 4) = (f32x4){r[4], r[5], r[6], r[7]};
            *(LAS f32x4*)(LVV + o) = (f32x4){v[0], v[1], v[2], v[3]}; *(LAS f32x4*)(LVV + o + 4) = (f32x4){v[4], v[5], v[6], v[7]};
            if ((tid & 7) == 0) LBON[tt_p] = bon;
        }
        __syncthreads();
#pragma unroll 2
        for (int tt = 0; tt < 64; ++tt) {
            const int o = tt * 64 + 8 * cg;
            const f32x4 k0 = *(const LAS f32x4*)(LKK + o), k1 = *(const LAS f32x4*)(LKK + o + 4);
            const f32x4 w0 = *(const LAS f32x4*)(LW + o), w1 = *(const LAS f32x4*)(LW + o + 4);
            const f32x4 b0 = *(const LAS f32x4*)(LBB + o), b1 = *(const LAS f32x4*)(LBB + o + 4);
            const f32x4 p0 = *(const LAS f32x4*)(LKP + o), p1 = *(const LAS f32x4*)(LKP + o + 4);
            const f32x4 r0 = *(const LAS f32x4*)(LRR + o), r1 = *(const LAS f32x4*)(LRR + o + 4);
            const float vi = LVV[tt * 64 + row];
            float sa = (S[0] * k0[0] + S[1] * k0[1]) + (S[2] * k0[2] + S[3] * k0[3]) + (S[4] * k1[0] + S[5] * k1[1]) + (S[6] * k1[2] + S[7] * k1[3]);
            sa = -red8(sa);
#pragma unroll
            for (int j = 0; j < 4; ++j) { S[j] = S[j] * w0[j] + (sa * b0[j] + vi * p0[j]); S[4 + j] = S[4 + j] * w1[j] + (sa * b1[j] + vi * p1[j]); }
            float y = (S[0] * r0[0] + S[1] * r0[1]) + (S[2] * r0[2] + S[3] * r0[3]) + (S[4] * r1[0] + S[5] * r1[1]) + (S[6] * r1[2] + S[7] * r1[3]);
            y = red8(y);
            if (cg == 0) LYY[tt * 64 + row] = y;
        }
        __syncthreads();
        {
            const size_t tok = (size_t)b * SEQ + c0 + tt_p; const int o = tt_p * 64 + j0;
            const f32x4 y0 = *(const LAS f32x4*)(LYY + o), y1 = *(const LAS f32x4*)(LYY + o + 4);
            const f32x4 v0 = *(const LAS f32x4*)(LVV + o), v1 = *(const LAS f32x4*)(LVV + o + 4);
            float s = (y0[0] + y0[1]) + (y0[2] + y0[3]) + (y1[0] + y1[1]) + (y1[2] + y1[3]);
            const float mean = red8(s) * (1.f / 64.f); float q = 0.f;
#pragma unroll
            for (int j = 0; j < 4; ++j) { const float d0 = y0[j] - mean, d1 = y1[j] - mean; q += d0 * d0 + d1 * d1; }
            const float rs = 1.0f / sqrtf(red8(q) * (1.f / 64.f) + GN_EPS); const float bon = LBON[tt_p];
            const u32x4 gv = *(const u32x4*)(GG + tok * 512 + h * 64 + j0); const unsigned gw[4] = {gv.x, gv.y, gv.z, gv.w}; float ov[8];
#pragma unroll
            for (int j = 0; j < 8; ++j) { const float yy = j < 4 ? y0[j] : y1[j - 4], vv = j < 4 ? v0[j] : v1[j - 4]; const float g = (j & 1) ? bfhi(gw[j >> 1]) : bflo(gw[j >> 1]);
                ov[j] = ((yy - mean) * rs * lnw[j0 + j] + lnb[j0 + j] + bon * vv) * g; }
            u32x4 w; w.x = pk2(ov[0], ov[1]); w.y = pk2(ov[2], ov[3]); w.z = pk2(ov[4], ov[5]); w.w = pk2(ov[6], ov[7]);
            *(u32x4*)(YB + tok * 512 + h * 64 + j0) = w;
        }
    }
    __syncthreads();
}

constexpr int LDA = 72, LDT = 40, LDF = 36;
constexpr int SC_WF = 0, SC_AT = 8192, SC_RT = SC_AT + 4608, SC_BT = SC_RT + 4608, SC_KT = SC_BT + 4608;
constexpr int SC_BCT = SC_KT + 4608, SC_KCT = SC_BCT + 5120, SC_VT = SC_KCT + 5120, SC_AHT = SC_VT + 5120, SC_UHT = SC_AHT + 5120;
constexpr int SC_AAB = SC_UHT + 5120, SC_ARB = SC_AAB + 4608, SC_ARK = SC_ARB + 2560, SC_RHS2 = SC_ARK + 2560, SC_YF = SC_RHS2 + 16384, SC_HT = SC_YF + 8192, SC_BON = SC_HT + 9216;
static_assert(SC_BON + 128 + 2048 <= RING_BYTES, "scan LDS map");
__device__ __forceinline__ float red16(float v) { v += dppf<0xB1>(v); v += dppf<0x4E>(v); v += dppf<0x141>(v); v += dppf<0x140>(v); return v; }
__device__ __forceinline__ bf16x8 ld16(const LAS bf16* p) { return *(const LAS bf16x8*)p; }
__device__ __forceinline__ bf16x8 ld8x2(const LAS bf16* p) { const u32x2 lo = *(const LAS u32x2*)p, hi = *(const LAS u32x2*)(p + 8); const u32x4 w = (u32x4){lo.x, lo.y, hi.x, hi.y}; return __builtin_bit_cast(bf16x8, w); }
__device__ __forceinline__ bf16x8 packq(const f32x16& x, int q) { u32x4 w; w.x = pk2(x[8 * q], x[8 * q + 1]); w.y = pk2(x[8 * q + 2], x[8 * q + 3]); w.z = pk2(x[8 * q + 4], x[8 * q + 5]); w.w = pk2(x[8 * q + 6], x[8 * q + 7]); return __builtin_bit_cast(bf16x8, w); }
#define MFMA32(a, b, c) __builtin_amdgcn_mfma_f32_32x32x16_bf16((a), (b), (c), 0, 0, 0)
struct ScanLoad { u32x2 cr, ck, cv, pr, pk, pv, g; f32x4 dec, eta; };
__device__ __forceinline__ void scan_load(ScanLoad& L, const bf16* ZR, const float* DEC, const float* AA, const bf16* GG, size_t tok, int hc, bool first) {
    const bf16* zc = ZR + tok * RWC + hc; const bf16* zp = zc - RWC;
    L.cr = *(const u32x2*)zc; L.ck = *(const u32x2*)(zc + 512); L.cv = *(const u32x2*)(zc + 1024);
    L.pr = (u32x2){0u, 0u}; L.pk = L.pr; L.pv = L.pr;
    if (!first) { L.pr = *(const u32x2*)zp; L.pk = *(const u32x2*)(zp + 512); L.pv = *(const u32x2*)(zp + 1024); }
    L.dec = *(const f32x4*)(DEC + tok * 512 + hc); L.eta = *(const f32x4*)(AA + tok * 512 + hc); L.g = *(const u32x2*)(GG + tok * 512 + hc);
}
#define LBAR() do { asm volatile("s_waitcnt lgkmcnt(0)" ::: "memory"); __builtin_amdgcn_s_barrier(); asm volatile("" ::: "memory"); } while (0)
typedef short v4i16_t __attribute__((ext_vector_type(4)));
__device__ __forceinline__ bf16x8 trfrag(const LAS bf16* X, int k0a, int k0b, int cbase, int lane) {
    const int g = lane >> 4, i = lane & 15, col = cbase + 16 * (g & 1) + 4 * (i & 3), rq = i >> 2;
    const v4i16_t lo = __builtin_amdgcn_ds_read_tr16_b64_v4i16((LAS v4i16_t*)(X + (k0a + rq) * LDA + col));
    const v4i16_t hi = __builtin_amdgcn_ds_read_tr16_b64_v4i16((LAS v4i16_t*)(X + (k0b + rq) * LDA + col));
    return (bf16x8){lo[0], lo[1], lo[2], lo[3], hi[0], hi[1], hi[2], hi[3]};
}
__device__ __forceinline__ void scan_unit_chunked(const Args& args, Frame& F, int bh) {
    const int b = bh >> 3, h = bh & 7, tid = F.tid, w = F.wave;
    LAS unsigned char* L = F.lds;
    LAS float* WF = (LAS float*)(L + SC_WF); LAS float* AAB = (LAS float*)(L + SC_AAB); LAS float* RHS2 = (LAS float*)(L + SC_RHS2); LAS float* YF = (LAS float*)(L + SC_YF); LAS float* BON = (LAS float*)(L + SC_BON);
    LAS bf16* AT = (LAS bf16*)(L + SC_AT); LAS bf16* RT = (LAS bf16*)(L + SC_RT); LAS bf16* BT = (LAS bf16*)(L + SC_BT); LAS bf16* KT = (LAS bf16*)(L + SC_KT);
    LAS bf16* BCT = (LAS bf16*)(L + SC_BCT); LAS bf16* KCT = (LAS bf16*)(L + SC_KCT); LAS bf16* VT = (LAS bf16*)(L + SC_VT); LAS bf16* AHT = (LAS bf16*)(L + SC_AHT); LAS bf16* UHT = (LAS bf16*)(L + SC_UHT);
    LAS bf16* ARB = (LAS bf16*)(L + SC_ARB); LAS bf16* ARK = (LAS bf16*)(L + SC_ARK); LAS bf16* HT = (LAS bf16*)(L + SC_HT);
    const bf16* ZR = WSP(bf16, WS_ZR); const float* DEC = WSP(float, WS_DEC); const float* AA = WSP(float, WS_AA); const bf16* GG = WSP(bf16, WS_GG); bf16* YB = WSP(bf16, WS_YB);
    const int t = tid >> 4, j0 = 4 * (tid & 15), hc = h * 64 + j0;
    LAS float* CST = (LAS float*)(L + SC_BON + 128);
    { const int c = tid >> 6, j = tid & 63; const float* src = c == 0 ? FIN(4) : c == 1 ? FIN(4) + 512 : c == 2 ? FIN(4) + 1024 : c == 3 ? FIN(10) : c == 4 ? FIN(11) : c == 5 ? FIN(12) : c == 6 ? FIN(13) : FIN(14);
      CST[c * 64 + j] = src[h * 64 + j]; }
    for (int i = tid; i < 64 * LDA / 2; i += 512) ((LAS unsigned*)HT)[i] = 0u;
    ScanLoad cur; scan_load(cur, ZR, DEC, AA, GG, (size_t)b * SEQ + t, hc, t == 0);
    LBAR();
    u32x2 pend = (u32x2){0u, 0u};
    for (int c0 = 0; c0 < SEQ; c0 += 32) {
        const size_t tok = (size_t)b * SEQ + c0 + t;
        float r[4], kp[4], v[4], al[4], be[4], gq[4]; f32x4 gl, gpl;
        {
            const f32x4 mur = *(const LAS f32x4*)(CST + j0), muk = *(const LAS f32x4*)(CST + 64 + j0), muv = *(const LAS f32x4*)(CST + 128 + j0), kkc = *(const LAS f32x4*)(CST + 192 + j0), kac = *(const LAS f32x4*)(CST + 256 + j0), rkc = *(const LAS f32x4*)(CST + 320 + j0);
            const unsigned crw[2] = {cur.cr.x, cur.cr.y}, ckw[2] = {cur.ck.x, cur.ck.y}, cvw[2] = {cur.cv.x, cur.cv.y}, prw[2] = {cur.pr.x, cur.pr.y}, pkw[2] = {cur.pk.x, cur.pk.y}, pvw[2] = {cur.pv.x, cur.pv.y}, gw2[2] = {cur.g.x, cur.g.y};
            float k[4], kk[4]; float ss = 0.f;
#pragma unroll
            for (int j = 0; j < 4; ++j) {
                const float rc = (j & 1) ? bfhi(crw[j >> 1]) : bflo(crw[j >> 1]), rp = (j & 1) ? bfhi(prw[j >> 1]) : bflo(prw[j >> 1]);
                const float kc = (j & 1) ? bfhi(ckw[j >> 1]) : bflo(ckw[j >> 1]), kq = (j & 1) ? bfhi(pkw[j >> 1]) : bflo(pkw[j >> 1]);
                const float vc = (j & 1) ? bfhi(cvw[j >> 1]) : bflo(cvw[j >> 1]), vq = (j & 1) ? bfhi(pvw[j >> 1]) : bflo(pvw[j >> 1]);
                r[j] = rc + mur[j] * (rp - rc); k[j] = kc + muk[j] * (kq - kc); v[j] = vc + muv[j] * (vq - vc);
                kk[j] = k[j] * kkc[j]; ss += kk[j] * kk[j]; gq[j] = (j & 1) ? bfhi(gw2[j >> 1]) : bflo(gw2[j >> 1]);
            }
            ss = red16(ss);
            const float inv = __builtin_amdgcn_rsqf(fmaxf(ss, 1e-24f)); float bon = 0.f;
#pragma unroll
            for (int j = 0; j < 4; ++j) { kk[j] *= inv; al[j] = -kk[j]; be[j] = kk[j] * cur.eta[j]; kp[j] = k[j] * (1.f + (cur.eta[j] - 1.f) * kac[j]); bon += r[j] * kp[j] * rkc[j]; }
            bon = red16(bon);
            gl = cur.dec; gpl = (f32x4){1.f, 1.f, 1.f, 1.f};
            { const int ln = tid & 63;
#pragma unroll
              for (int j = 0; j < 4; ++j) { const float u1 = __shfl_up(gl[j], 16); gl[j] = (ln >= 16) ? gl[j] * u1 : gl[j]; }
#pragma unroll
              for (int j = 0; j < 4; ++j) { const float u2 = __shfl_up(gl[j], 32); gl[j] = (ln >= 32) ? gl[j] * u2 : gl[j]; }
#pragma unroll
              for (int j = 0; j < 4; ++j) { const float u3 = __shfl_up(gl[j], 16); gpl[j] = (ln >= 16) ? u3 : 1.f; }
              if (ln >= 48) *(LAS f32x4*)(WF + w * 64 + j0) = gl; }
            if ((tid & 15) == 0) BON[t] = bon;
        }
        if (c0 + 32 < SEQ && !(SCAN_STUB & 32)) scan_load(cur, ZR, DEC, AA, GG, tok + 32, hc, false);
        if (c0 > 0) { const bf16* yp = YB + (tok - 32) * 512 + hc; asm volatile("global_store_dwordx2 %0, %1, off" :: "v"(yp), "v"(pend) : "memory"); }
        LBAR();
        {
            f32x4 pre = (f32x4){1.f, 1.f, 1.f, 1.f}, gC = pre;
#pragma unroll
            for (int ww = 0; ww < 8; ++ww) { const f32x4 wt = *(const LAS f32x4*)(WF + ww * 64 + j0); gC = gC * wt; if (ww < w) pre = pre * wt; }
            const f32x4 gt = pre * gl, gp = pre * gpl;
            if (t == 31) *(LAS f32x4*)(WF + 512 + j0) = gC;
            float a_[4], r_[4], b_[4], k_[4], bc[4], kc[4];
#pragma unroll
            for (int j = 0; j < 4; ++j) { const float ig = __builtin_amdgcn_rcpf(gt[j]); a_[j] = al[j] * gp[j]; r_[j] = r[j] * gt[j]; b_[j] = be[j] * ig; k_[j] = kp[j] * ig; bc[j] = b_[j] * gC[j]; kc[j] = k_[j] * gC[j]; }
            u32x2 wv; wv.x = pk2(a_[0], a_[1]); wv.y = pk2(a_[2], a_[3]); *(LAS u32x2*)(AT + t * LDA + j0) = wv;
            wv.x = pk2(r_[0], r_[1]); wv.y = pk2(r_[2], r_[3]); *(LAS u32x2*)(RT + t * LDA + j0) = wv;
            wv.x = pk2(b_[0], b_[1]); wv.y = pk2(b_[2], b_[3]); *(LAS u32x2*)(BT + t * LDA + j0) = wv;
            wv.x = pk2(k_[0], k_[1]); wv.y = pk2(k_[2], k_[3]); *(LAS u32x2*)(KT + t * LDA + j0) = wv;
            wv.x = pk2(bc[0], bc[1]); wv.y = pk2(bc[2], bc[3]); *(LAS u32x2*)(BCT + t * LDA + j0) = wv;
            wv.x = pk2(kc[0], kc[1]); wv.y = pk2(kc[2], kc[3]); *(LAS u32x2*)(KCT + t * LDA + j0) = wv;
            wv.x = pk2(v[0], v[1]); wv.y = pk2(v[2], v[3]); *(LAS u32x2*)(VT + t * LDA + j0) = wv;
        }
        LBAR();
        if (w < 4 && !(SCAN_STUB & 1)) {
            const int lane = lane_now(), r32 = lane & 31, hh = lane >> 5;
            f32x16 mT, mN;
#pragma unroll
            for (int i = 0; i < 16; ++i) { mT[i] = 0.f; mN[i] = 0.f; }
#pragma unroll
            for (int q = 0; q < 4; ++q) { const bf16x8 bfr = ld16(BT + r32 * LDA + 8 * hh + 16 * q), afr = ld16(AT + r32 * LDA + 8 * hh + 16 * q);
                mT = MFMA32(bfr, afr, mT);
                mN = MFMA32(afr, bfr, mN); }
#pragma unroll
            for (int i = 0; i < 16; ++i) { const int c_ = crow(i, hh); mT[i] = (c_ < r32) ? mT[i] : 0.f; mN[i] = (r32 < c_) ? mN[i] : 0.f; }
            f32x16 X;
            if (w < 2) {
#pragma unroll
                for (int i = 0; i < 16; ++i) X[i] = bflo((unsigned)AT[crow(i, hh) * LDA + 32 * w + r32]);
            } else {
                f32x16 kT;
#pragma unroll
                for (int i = 0; i < 16; ++i) { kT[i] = 0.f; X[i] = 0.f; }
#pragma unroll
                for (int q = 0; q < 4; ++q) kT = MFMA32(ld16(KT + r32 * LDA + 8 * hh + 16 * q), ld16(AT + r32 * LDA + 8 * hh + 16 * q), kT);
#pragma unroll
                for (int i = 0; i < 16; ++i) kT[i] = (crow(i, hh) < r32) ? kT[i] : 0.f;
#pragma unroll
                for (int q = 0; q < 2; ++q) X = MFMA32(packq(kT, q), trfrag(VT, 16 * q + 4 * hh, 16 * q + 8 + 4 * hh, 32 * (w - 2), lane), X);
            }
#pragma unroll
            for (int k = 0; k < 5; ++k) {
                const bf16x8 t0 = packq(mT, 0), t1 = packq(mT, 1), x0 = packq(X, 0), x1 = packq(X, 1);
                X = MFMA32(t0, x0, X); X = MFMA32(t1, x1, X);
                if (k < 4) {
                    const bf16x8 n0 = packq(mN, 0), n1 = packq(mN, 1);
                    f32x16 zT, zN;
#pragma unroll
                    for (int i = 0; i < 16; ++i) { zT[i] = 0.f; zN[i] = 0.f; }
                    zT = MFMA32(n0, t0, zT); zT = MFMA32(n1, t1, zT);
                    zN = MFMA32(t0, n0, zN); zN = MFMA32(t1, n1, zN);
                    mT = zT; mN = zN;
                }
            }
            LAS bf16* dst = ((w < 2) ? AHT : UHT) + (32 * (w & 1) + r32) * LDT + 4 * hh;
#pragma unroll
            for (int i4 = 0; i4 < 4; ++i4) { u32x2 wv; wv.x = pk2(X[4 * i4], X[4 * i4 + 1]); wv.y = pk2(X[4 * i4 + 2], X[4 * i4 + 3]); *(LAS u32x2*)(dst + 8 * i4) = wv; }
        } else if (w < 6 && !(SCAN_STUB & 1)) {
            const int lane = lane_now(), r32 = lane & 31, hh = lane >> 5;
            const LAS bf16* Aop = ((w & 1) ? KT : BT) + r32 * LDA + 8 * hh; const LAS bf16* Bop = RT + r32 * LDA + 8 * hh;
            f32x16 x;
#pragma unroll
            for (int i = 0; i < 16; ++i) x[i] = 0.f;
#pragma unroll
            for (int q = 0; q < 4; ++q) x = MFMA32(ld16(Aop + 16 * q), ld16(Bop + 16 * q), x);
#pragma unroll
            for (int i = 0; i < 16; ++i) x[i] = (crow(i, hh) <= r32) ? x[i] : 0.f;
            LAS bf16* dst = ((w & 1) ? ARK : ARB) + r32 * LDT + 4 * hh;
#pragma unroll
            for (int i4 = 0; i4 < 4; ++i4) { u32x2 wv; wv.x = pk2(x[4 * i4], x[4 * i4 + 1]); wv.y = pk2(x[4 * i4 + 2], x[4 * i4 + 3]); *(LAS u32x2*)(dst + 8 * i4) = wv; }
        }
        LBAR();
        f32x16 hn;
        if (SCAN_STUB & 4) { for (int i = 0; i < 16; ++i) hn[i] = 0.f; } else if (w < 4) {
            const int lane = lane_now(), r32 = lane & 31, hh = lane >> 5;
            const int jb = w >> 1, ib = w & 1;
            f32x16 pt[2];
#pragma unroll
            for (int a = 0; a < 2; ++a) {
#pragma unroll
                for (int i = 0; i < 16; ++i) pt[a][i] = 0.f;
#pragma unroll
                for (int q = 0; q < 2; ++q) pt[a] = MFMA32(ld16(AHT + (32 * a + r32) * LDT + 16 * q + 8 * hh), trfrag(BCT, 16 * q + 8 * hh, 16 * q + 8 * hh + 4, 32 * jb, lane), pt[a]);
            }
            { const float gC = WF[512 + 32 * jb + r32];
#pragma unroll
              for (int i = 0; i < 16; ++i) { const float add = (crow(i, hh) == r32) ? gC : 0.f; pt[0][i] += (jb == 0) ? add : 0.f; pt[1][i] += (jb == 0) ? 0.f : add; } }
#pragma unroll
            for (int i = 0; i < 16; ++i) hn[i] = 0.f;
#pragma unroll
            for (int q = 0; q < 2; ++q) {
                hn = MFMA32(trfrag(BCT, 16 * q + 8 * hh, 16 * q + 8 * hh + 4, 32 * jb, lane), ld16(UHT + (32 * ib + r32) * LDT + 16 * q + 8 * hh), hn);
                hn = MFMA32(trfrag(KCT, 16 * q + 8 * hh, 16 * q + 8 * hh + 4, 32 * jb, lane), trfrag(VT, 16 * q + 8 * hh, 16 * q + 8 * hh + 4, 32 * ib, lane), hn);
            }
#pragma unroll
            for (int a = 0; a < 2; ++a)
#pragma unroll
                for (int q = 0; q < 2; ++q) hn = MFMA32(packq(pt[a], q), ld8x2(HT + (32 * ib + r32) * LDA + 32 * a + 16 * q + 4 * hh), hn);
        } else if (w < 6) {
            const int lane = lane_now(), r32 = lane & 31, hh = lane >> 5;
            const int ib = w & 1;
            f32x16 rt[2];
#pragma unroll
            for (int a = 0; a < 2; ++a) {
#pragma unroll
                for (int i = 0; i < 16; ++i) rt[a][i] = bflo((unsigned)RT[r32 * LDA + 32 * a + crow(i, hh)]);
#pragma unroll
                for (int q = 0; q < 2; ++q) rt[a] = MFMA32(ld16(AHT + (32 * a + r32) * LDT + 16 * q + 8 * hh), ld16(ARB + r32 * LDT + 16 * q + 8 * hh), rt[a]);
            }
            f32x16 y;
#pragma unroll
            for (int i = 0; i < 16; ++i) y[i] = 0.f;
#pragma unroll
            for (int q = 0; q < 2; ++q) {
                y = MFMA32(ld16(ARB + r32 * LDT + 16 * q + 8 * hh), ld16(UHT + (32 * ib + r32) * LDT + 16 * q + 8 * hh), y);
                y = MFMA32(ld16(ARK + r32 * LDT + 16 * q + 8 * hh), trfrag(VT, 16 * q + 8 * hh, 16 * q + 8 * hh + 4, 32 * ib, lane), y);
            }
#pragma unroll
            for (int a = 0; a < 2; ++a)
#pragma unroll
                for (int q = 0; q < 2; ++q) y = MFMA32(packq(rt[a], q), ld8x2(HT + (32 * ib + r32) * LDA + 32 * a + 16 * q + 4 * hh), y);
#pragma unroll
            for (int i = 0; i < 16; ++i) YF[crow(i, hh) * 64 + 32 * ib + r32] = y[i];
        }
        LBAR();
        if (w < 4) {
            const int lane = lane_now(), r32 = lane & 31, hh = lane >> 5;
            const int jb = w >> 1, ib = w & 1; LAS bf16* dst = HT + (32 * ib + r32) * LDA + 32 * jb + 4 * hh;
#pragma unroll
            for (int i4 = 0; i4 < 4; ++i4) { u32x2 wv; wv.x = pk2(hn[4 * i4], hn[4 * i4 + 1]); wv.y = pk2(hn[4 * i4 + 2], hn[4 * i4 + 3]); *(LAS u32x2*)(dst + 8 * i4) = wv; }
        }
        {
            const f32x4 y4 = *(const LAS f32x4*)(YF + t * 64 + j0);
            const float mean = red16((y4[0] + y4[1]) + (y4[2] + y4[3])) * (1.f / 64.f); float qv = 0.f;
#pragma unroll
            for (int j = 0; j < 4; ++j) { const float d = y4[j] - mean; qv += d * d; }
            const float rs = __builtin_amdgcn_rsqf(red16(qv) * (1.f / 64.f) + GN_EPS); const float bon = BON[t]; float ov[4];
            const f32x4 lnw = *(const LAS f32x4*)(CST + 384 + j0), lnb = *(const LAS f32x4*)(CST + 448 + j0);
#pragma unroll
            for (int j = 0; j < 4; ++j) ov[j] = ((y4[j] - mean) * rs * lnw[j] + lnb[j] + bon * v[j]) * gq[j];
            pend.x = pk2(ov[0], ov[1]); pend.y = pk2(ov[2], ov[3]);
        }
    }
    *(u32x2*)(YB + ((size_t)b * SEQ + SEQ - 32 + t) * 512 + hc) = pend;
}

__device__ __forceinline__ bool attn_step(const bf16x8 (&qf)[4], const bf16x8 (&kf)[4], const u32x2 (&vlo)[2][2], const u32x2 (&vhi)[2][2], f32x16& y0, f32x16& y1, float& carry, int s0, int t0, int q, int hi) {
    f32x16 p;
#pragma unroll
    for (int r = 0; r < 16; ++r) p[r] = 0.f;
#pragma unroll
    for (int d0 = 0; d0 < 4; ++d0) p = __builtin_amdgcn_mfma_f32_32x32x16_bf16(kf[d0], qf[d0], p, 0, 0, 0);
    float om[16], be[16];
#pragma unroll
    for (int r = 0; r < 16; ++r) {
        const int kv = crow(r, hi); const bool valid = (s0 + kv) < (t0 + q);
        const float z = fminf(p[r], 80.f); const float t = __expf(z); const float o = __builtin_amdgcn_rcpf(1.f + t);
        om[r] = valid ? o : 1.f; be[r] = valid ? t * o : 0.f;
    }
    float el[16], G[4], PG[4];
#pragma unroll
    for (int i = 0; i < 4; ++i) { el[4 * i + 3] = 1.f; el[4 * i + 2] = om[4 * i + 3]; el[4 * i + 1] = el[4 * i + 2] * om[4 * i + 2]; el[4 * i] = el[4 * i + 1] * om[4 * i + 1]; G[i] = el[4 * i] * om[4 * i]; }
#pragma unroll
    for (int i = 0; i < 4; ++i) PG[i] = __shfl_xor(G[i], 32);
    float sG[4], sP[4];
    sG[3] = 1.f; sG[2] = G[3]; sG[1] = G[3] * G[2]; sG[0] = sG[1] * G[1];
    sP[3] = 1.f; sP[2] = PG[3]; sP[1] = PG[3] * PG[2]; sP[0] = sP[1] * PG[1];
    const float total = (sG[0] * G[0]) * (sP[0] * PG[0]);
    float A[16];
#pragma unroll
    for (int i = 0; i < 4; ++i) { const float eg = sG[i] * (hi ? sP[i] : sP[i] * PG[i]) * carry;
#pragma unroll
        for (int j = 0; j < 4; ++j) A[4 * i + j] = be[4 * i + j] * el[4 * i + j] * eg; }
    carry *= total;
    bf16x8 pf[2];
#pragma unroll
    for (int s = 0; s < 2; ++s) { u32x4 w; w.x = pk2(A[8 * s], A[8 * s + 1]); w.y = pk2(A[8 * s + 2], A[8 * s + 3]); w.z = pk2(A[8 * s + 4], A[8 * s + 5]); w.w = pk2(A[8 * s + 6], A[8 * s + 7]); pf[s] = __builtin_bit_cast(bf16x8, w); }
#pragma unroll
    for (int s = 0; s < 2; ++s) {
        const u32x4 a0 = (u32x4){vlo[0][s].x, vlo[0][s].y, vhi[0][s].x, vhi[0][s].y}, a1 = (u32x4){vlo[1][s].x, vlo[1][s].y, vhi[1][s].x, vhi[1][s].y};
        y0 = __builtin_amdgcn_mfma_f32_32x32x16_bf16(__builtin_bit_cast(bf16x8, a0), pf[s], y0, 0, 0, 0);
        y1 = __builtin_amdgcn_mfma_f32_32x32x16_bf16(__builtin_bit_cast(bf16x8, a1), pf[s], y1, 0, 0, 0);
    }
    return __all(carry < 5.6e-14f);
}
__device__ __forceinline__ void attn_tile(Frame& F, int bh, int qt) {
    const int lane = F.lane, q = lane & 31, hi = lane >> 5, b = bh >> 3, h = bh & 7, t0 = 32 * qt;
    const size_t tokbase = (size_t)b * SEQ;
    const bf16* QB = WSP(bf16, WS_Q); const bf16* KB = WSP(bf16, WS_K); const bf16* VT = WSP(bf16, WS_VT); bf16* YA = WSP(bf16, WS_YA);
    bf16x8 qf[4];
    { const bf16* Qp = QB + (tokbase + t0 + q) * 512 + h * 64 + 8 * hi;
#pragma unroll
      for (int d0 = 0; d0 < 4; ++d0) qf[d0] = *(const bf16x8*)(Qp + 16 * d0); }
    f32x16 y0, y1;
#pragma unroll
    for (int r = 0; r < 16; ++r) { y0[r] = 0.f; y1[r] = 0.f; }
    float carry = 1.f;
    const bf16* Vrow = VT + (size_t)bh * 128 * 1024 + q * 16 + 4 * hi;
    bf16x8 kA[4], kB[4]; u32x2 vloA[2][2], vhiA[2][2], vloB[2][2], vhiB[2][2];
#define ATT_LOAD(KF, VLO, VHI, S0) do { const bf16* Kp_ = KB + (tokbase + (S0) + q) * 512 + h * 64 + 8 * hi; \
        _Pragma("unroll") for (int d0 = 0; d0 < 4; ++d0) KF[d0] = *(const bf16x8*)(Kp_ + 16 * d0); \
        _Pragma("unroll") for (int dt = 0; dt < 2; ++dt) _Pragma("unroll") for (int s_ = 0; s_ < 2; ++s_) { const bf16* vp_ = Vrow + (size_t)(((S0) >> 4) + s_) * 1024 + dt * 512; VLO[dt][s_] = *(const u32x2*)vp_; VHI[dt][s_] = *(const u32x2*)(vp_ + 8); } } while (0)
    ATT_LOAD(kA, vloA, vhiA, t0);
    for (int s0 = t0; ; ) {
        { const int sn = s0 >= 32 ? s0 - 32 : 0; ATT_LOAD(kB, vloB, vhiB, sn); __builtin_amdgcn_sched_barrier(0); }
        if (attn_step(qf, kA, vloA, vhiA, y0, y1, carry, s0, t0, q, hi)) break;
        s0 -= 32; if (s0 < 0) break;
        { const int sn = s0 >= 32 ? s0 - 32 : 0; ATT_LOAD(kA, vloA, vhiA, sn); __builtin_amdgcn_sched_barrier(0); }
        if (attn_step(qf, kB, vloB, vhiB, y0, y1, carry, s0, t0, q, hi)) break;
        s0 -= 32; if (s0 < 0) break;
    }
#undef ATT_LOAD
    bf16* Yp = YA + (tokbase + t0 + q) * 512 + h * 64 + 4 * hi;
#pragma unroll
    for (int i = 0; i < 4; ++i) {
        u32x2 w0, w1; w0.x = pk2(y0[4 * i], y0[4 * i + 1]); w0.y = pk2(y0[4 * i + 2], y0[4 * i + 3]); w1.x = pk2(y1[4 * i], y1[4 * i + 1]); w1.y = pk2(y1[4 * i + 2], y1[4 * i + 3]);
        *(u32x2*)(Yp + 8 * i) = w0; *(u32x2*)(Yp + 32 + 8 * i) = w1;
    }
}

__device__ __forceinline__ void p5a_router(const Args& args, Frame& F) {
    LAS float* LG = (LAS float*)F.lds;
    LAS unsigned* HIST = (LAS unsigned*)(F.lds + 32768); LAS unsigned* BASE = HIST + 32;
    const float* X1 = WSP(float, WS_X1); const float* GW = WSP(float, WS_GW); const float* rb = FIN(20);
    unsigned* cnt = F.ctl + CW_CNT; int* LIST = WSP(int, WS_LIST); float* LRS = WSP(float, WS_LRS); float* LGT = WSP(float, WS_LGT);
    const int tid = F.tid, lane = F.lane, wave = F.wave;
    for (int tb = blockIdx.x; tb < M / 128; tb += F.G) {
        if (tid < 32) HIST[tid] = 0u;
        __syncthreads();
        int ex[4] = {0, 0, 0, 0}; float gt[4] = {0.f, 0.f, 0.f, 0.f}; unsigned lr[4] = {0u, 0u, 0u, 0u}; int tok = 0; float rstd_keep = 0.f;
        {
            const int i = lane & 31, kh = lane >> 5, g = wave & 3, kq = wave >> 2; tok = tb * 128 + g * 32 + i;
            const float* xr = X1 + (size_t)tok * D + 512 * kq + 4 * kh;
            f32x16 acc;
#pragma unroll
            for (int r = 0; r < 16; ++r) acc[r] = 0.f;
            float ss = 0.f;
#pragma unroll 1
            for (int u0 = 0; u0 < 64; u0 += 8) {
                f32x4 a[8]; float gw[8][4];
#pragma unroll
                for (int uu = 0; uu < 8; ++uu) { a[uu] = *(const f32x4*)(xr + 8 * (u0 + uu)); const float* gp = GW + (size_t)(512 * kq + 8 * (u0 + uu) + 4 * kh) * 32 + i;
#pragma unroll
                    for (int j = 0; j < 4; ++j) gw[uu][j] = gp[32 * j]; }
#pragma unroll
                for (int uu = 0; uu < 8; ++uu) { ss += (a[uu][0] * a[uu][0] + a[uu][1] * a[uu][1]) + (a[uu][2] * a[uu][2] + a[uu][3] * a[uu][3]);
#pragma unroll
                    for (int j = 0; j < 4; ++j) acc = __builtin_amdgcn_mfma_f32_32x32x2f32(a[uu][j], gw[uu][j], acc, 0, 0, 0); }
            }
            ss += __shfl_xor(ss, 32);
            LAS float* RED = (LAS float*)(F.lds + 40960) + (g * 64 + lane) * 17;
            if (kq == 1) {
#pragma unroll
                for (int r = 0; r < 16; ++r) RED[r] = acc[r];
                RED[16] = ss; }
            __syncthreads();
            if (kq == 0) {
#pragma unroll
                for (int r = 0; r < 16; ++r) acc[r] += RED[r];
                ss += RED[16]; }
            if (wave < 4) {
            const float rstd = 1.0f / sqrtf(ss * (1.f / D) + RMS_EPS);
            rstd_keep = rstd;
            LAS float* L = LG + wave * (32 * 33);
#pragma unroll
            for (int r = 0; r < 16; ++r) L[crow(r, kh) * 33 + i] = acc[r];
            asm volatile("s_waitcnt lgkmcnt(0)" ::: "memory");
            if (kh == 0) {
                float v0 = -3.0e38f, v1 = -3.0e38f, v2 = -3.0e38f, v3 = -3.0e38f; int i0 = 0, i1 = 0, i2 = 0, i3 = 0;
                for (int e = 0; e < 32; ++e) { const float v = L[i * 33 + e] * rstd + rb[e];
                    if (v > v3) { if (v > v2) { v3 = v2; i3 = i2; if (v > v1) { v2 = v1; i2 = i1; if (v > v0) { v1 = v0; i1 = i0; v0 = v; i0 = e; } else { v1 = v; i1 = e; } } else { v2 = v; i2 = e; } } else { v3 = v; i3 = e; } } }
                const float e1 = __expf(v1 - v0), e2 = __expf(v2 - v0), e3 = __expf(v3 - v0), inv = 1.0f / (1.f + e1 + e2 + e3);
                ex[0] = i0; ex[1] = i1; ex[2] = i2; ex[3] = i3; gt[0] = inv; gt[1] = e1 * inv; gt[2] = e2 * inv; gt[3] = e3 * inv;
#pragma unroll
                for (int k = 0; k < 4; ++k) lr[k] = __hip_atomic_fetch_add(&HIST[ex[k]], 1u, __ATOMIC_RELAXED, __HIP_MEMORY_SCOPE_WORKGROUP);
            }
            }
        }
        __syncthreads();
        if (tid < 32) BASE[tid] = __hip_atomic_fetch_add(cnt + tid, HIST[tid], RLX_AGENT);
        __syncthreads();
        if (wave < 4 && lane < 32) {
#pragma unroll
            for (int k = 0; k < 4; ++k) { const unsigned pos = BASE[ex[k]] + lr[k]; const size_t li = (size_t)ex[k] * CAP + pos; LIST[li] = tok * 4 + k; LRS[li] = rstd_keep; LGT[li] = gt[k]; }
        }
        __syncthreads();
    }
}
__device__ __forceinline__ int moe_tables(Frame& F) {
    LAS int* CS = (LAS int*)(F.lds + MOE_OFF); LAS int* OFF = CS + 32; LAS unsigned char* TE = F.lds + MOE_TE;
    if (F.tid < 32) { int c = (int)__hip_atomic_load(F.ctl + CW_CNT + F.tid, RLX_AGENT); CS[F.tid] = c > CAP ? CAP : c; }
    __syncthreads();
    if (F.tid == 0) { int off = 0; for (int e = 0; e < 32; ++e) { OFF[e] = off; off += ((CS[e] + 255) >> 8) << 8; } OFF[32] = off; }
    __syncthreads();
    const int ntiles = OFF[32] >> 8;
    for (int t = F.tid; t < ntiles; t += 512) { int e = 0; while (e < 31 && OFF[e + 1] <= t * 256) ++e; TE[t] = (unsigned char)e; }
    __syncthreads();
    return ntiles;
}
__device__ __forceinline__ void p8_combine(Frame& F) {
    float* X1 = WSP(float, WS_X1); const bf16* YBF = WSP(bf16, WS_YBUF); bf16* X2B = WSP(bf16, WS_X2B); float* R2 = WSP(float, WS_RSTD2); float* RSS = WSP(float, WS_ROWSS);
    const int gw = F.vcu * 8 + F.wave, NGW = F.G * 8, lane = F.lane;
    for (int t = gw; t < M; t += NGW) {
        f32x4* xr = (f32x4*)(X1 + (size_t)t * D) + lane; f32x4 v[4]; float s = 0.f;
#pragma unroll
        for (int j = 0; j < 4; ++j) v[j] = xr[64 * j];
#pragma unroll
        for (int k = 0; k < 4; ++k) { const u32x2* yr = (const u32x2*)(YBF + (size_t)(4 * t + k) * D) + lane;
#pragma unroll
            for (int j = 0; j < 4; ++j) { const u32x2 w = yr[64 * j]; v[j].x += bflo(w.x); v[j].y += bfhi(w.x); v[j].z += bflo(w.y); v[j].w += bfhi(w.y); } }
        u32x2* o = (u32x2*)(X2B + (size_t)t * D) + lane;
#pragma unroll
        for (int j = 0; j < 4; ++j) { s += (v[j].x * v[j].x + v[j].y * v[j].y) + (v[j].z * v[j].z + v[j].w * v[j].w); u32x2 w; w.x = pk2(v[j].x, v[j].y); w.y = pk2(v[j].z, v[j].w); o[64 * j] = w; }
        s = wave_sum(s);
        if (lane == 0) { R2[t] = 1.0f / sqrtf(s * (1.f / D) + RMS_EPS); RSS[t] = 0.f; }
    }
}
constexpr int NPHASE = 11;
__global__ void __launch_bounds__(512, 2) mega_fwd(Args args) {
    extern __shared__ __attribute__((aligned(16))) unsigned char lds[];
    Frame F;
    F.lds = (LAS unsigned char*)lds;
    F.wave = __builtin_amdgcn_readfirstlane((int)threadIdx.x >> 6); F.lane = lane_now(); F.tid = F.wave * 64 + F.lane;
    F.G = gridDim.x; { const int bx = blockIdx.x; F.vcu = (F.G % 8 == 0) ? (bx % 8) * (F.G / 8) + bx / 8 : bx; }
    F.ws = args.ws; F.ctl = (unsigned*)(args.ws + WS_CTL); F.out = args.out;
    volatile LAS unsigned* MISC = (volatile LAS unsigned*)(F.lds + LDSCTL_OFF);
    if (F.tid < 64) MISC[F.tid] = 0u;
    __syncthreads();
    const int lo = args.ph_lo, hi = args.ph_hi;
    XcdBarrier bar; bar.bar = F.ctl + CW_BAR; bar.x = 0; bar.st = nullptr;
    if (hi - lo > 1) bar = xcd_barrier_post(F.ctl + CW_BAR, MISC + 8, F.tid);
#ifndef PH_MASK
#define PH_MASK 0xFFFF
#endif
#define IN(k) ((((PH_MASK) >> (k)) & 1) && lo <= (k) && (k) < hi)
#define STAMP(k) do { if (TS_PROBE >= 0 && blockIdx.x == 0 && F.tid == 0) ((unsigned long long*)(F.ctl + 2048))[k] = __builtin_amdgcn_s_memrealtime(); } while (0)
#define SEAM(k) do { if (IN(k) && IN((k) + 1)) xcd_barrier(bar, F.wave); F.lane = lane_now(); F.tid = F.wave * 64 + F.lane; STAMP((k) + 1); } while (0)
    LAS unsigned char* ring = F.lds;
    STAMP(0);

    if (IN(0)) { p0_prologue(args, F); expert_convert(args, F, F.vcu * 8 + F.wave, F.G * 8, 3); } SEAM(0);

    if (IN(1)) {
        pg8::Gemm g{WSP(bf16, WS_XB), WSP(bf16, WS_WIN), M, INC, D, 0, nullptr, nullptr, nullptr}; pg8::StaticOrder S; S.init(M, INC, F.G, (int)blockIdx.x);
        EpiG1 E{WSP(float, WS_RSTD0), WSP(bf16, WS_Q), WSP(bf16, WS_K), WSP(bf16, WS_VT), WSP(bf16, WS_ZR), WSP(bf16, WS_GT)};
        pg8::gemm_phase(ring, g, S, E, F.wave);
    } SEAM(1);

    if (IN(2)) {
        for (int c = blockIdx.x; c < 256; c += F.G) {
            const int x = c & 7, y = c >> 3; pg8::LoraOrder S; S.half = y & 1; S.pm = x + 8 * (y >> 1); S.nu = 3 + (F.G >> 30);
            build_alora(args, F, S.pm);
            asm volatile("s_waitcnt vmcnt(0)" ::: "memory"); __syncthreads();
            pg8::Gemm g{WSP(bf16, WS_ALORA), WSP(bf16, WS_WL), M, LORA_N, LORA_K, 0, nullptr, nullptr, nullptr};
            EpiLora E{FIN(5), FIN(7), WSP(float, WS_DEC), WSP(float, WS_AA), WSP(bf16, WS_GG)};
            pg8::gemm_phase(ring, g, S, E, F.wave);
        }
    } SEAM(2);

    if (IN(3)) {
        for (int u = blockIdx.x; u < 256; u += F.G) {
#ifndef P3_ONLY
#define P3_ONLY 5
#endif
            if (u < 128) { if (P3_ONLY != 2 && P3_ONLY != 3 && P3_ONLY != 4) scan_unit_chunked(args, F, u); else { bf16* YB = WSP(bf16, WS_YB); const int b = u >> 3, h = u & 7; for (int i = F.tid; i < SEQ * 8; i += 512) { const int tk = i >> 3, c8 = (i & 7) * 8; *(u32x4*)(YB + ((size_t)b * SEQ + tk) * 512 + h * 64 + c8) = (u32x4){0u, 0u, 0u, 0u}; } } }
            else if (P3_ONLY == 1 || P3_ONLY == 4) { bf16* YAz = WSP(bf16, WS_YA); const int bh = u - 128, b = bh >> 3, h = bh & 7; for (int i = F.tid; i < SEQ * 8; i += 512) { const int tk = i >> 3, c8 = (i & 7) * 8; *(u32x4*)(YAz + ((size_t)b * SEQ + tk) * 512 + h * 64 + c8) = (u32x4){0u, 0u, 0u, 0u}; } }
            else { const int bh = u - 128; for (int i = 0; i < 8; ++i) attn_tile(F, bh, F.wave + 8 * i);
                    }
        }
    if (TS_PROBE >= 0 && blockIdx.x == 0 && F.tid == 0) ((unsigned long long*)(F.ctl + 2048))[20] = __builtin_amdgcn_s_memrealtime();
    } SEAM(3);

    if (IN(4)) {
        pg8::StaticOrder S; S.init(M, D, F.G, (int)blockIdx.x);
        { pg8::Gemm g{WSP(bf16, WS_YA), WSP(bf16, WS_WA), M, D, AW, 0, nullptr, nullptr, nullptr}; EpiMerge<0> E{WSP(bf16, WS_GT), WSP(bf16, WS_MERGED)}; pg8::gemm_phase(ring, g, S, E, F.wave); }
        { pg8::Gemm g{WSP(bf16, WS_YB), WSP(bf16, WS_WB), M, D, RW, 0, nullptr, nullptr, nullptr}; EpiMerge<1> E{WSP(bf16, WS_GT), WSP(bf16, WS_MERGED)}; pg8::gemm_phase(ring, g, S, E, F.wave); }
    } SEAM(4);

    if (IN(5)) {
        pg8::Gemm g{WSP(bf16, WS_MERGED), WSP(bf16, WS_WO), M, D, D, 0, nullptr, nullptr, nullptr}; pg8::StaticOrder S; S.init(M, D, F.G, (int)blockIdx.x);
        EpiX1 E{FIN(0), WSP(float, WS_X1), FIN(18), WSP(unsigned char, WS_HN)};
        pg8::gemm_phase(ring, g, S, E, F.wave);
    } SEAM(5);

    if (IN(6)) { p5a_router(args, F); } SEAM(6);

    if (IN(7)) {
        const int ntiles = moe_tables(F);
        pg8::Gemm g{WSP(bf16, WS_HN), WSP(bf16, WS_W1), MAXROWS, F2, D, (size_t)F2 * D, WSP(int, WS_LIST), (const LAS int*)(F.lds + MOE_OFF) + 32, (const LAS int*)(F.lds + MOE_OFF)};
        pg8::MoeOrder S{ntiles, F2 / 256, F.G, (int)blockIdx.x, F.lds + MOE_TE};
        EpiSwiglu E{FIN(22), WSP(unsigned char, WS_ACT), WSP(int, WS_LIST), WSP(float, WS_LRS), (const LAS int*)(F.lds + MOE_OFF) + 32, (const LAS int*)(F.lds + MOE_OFF), (const LAS float*)(F.lds + RING_BYTES + 4096)};
        pg8::gemm_phase<EpiSwiglu, pg8::MoeOrder, true, true>(ring, g, S, E, F.wave);
    } SEAM(7);

    if (IN(8)) {
        const int ntiles = moe_tables(F);
        pg8::Gemm g{WSP(bf16, WS_ACT), WSP(bf16, WS_W2), MAXROWS, D, FH, (size_t)D * FH, nullptr, nullptr, nullptr};
        pg8::MoeOrder S{ntiles, D / 256, F.G, (int)blockIdx.x, F.lds + MOE_TE};
        EpiY E{FIN(24), WSP(int, WS_LIST), WSP(float, WS_LGT), WSP(bf16, WS_YBUF), (const LAS int*)(F.lds + MOE_OFF) + 32, (const LAS int*)(F.lds + MOE_OFF), (const LAS float*)(F.lds + RING_BYTES + 4096)};
        pg8::gemm_phase<EpiY, pg8::MoeOrder, false, true>(ring, g, S, E, F.wave);
    } SEAM(8);

    if (IN(9)) { p8_combine(F); } SEAM(9);

    if (IN(10)) {
        pg8::StaticOrder S; S.init(M, D, F.G, (int)blockIdx.x);
        { pg8::Gemm g{WSP(bf16, WS_X2B), WSP(bf16, WS_WG), M, D, D, 0, nullptr, nullptr, nullptr}; EpiGate E{WSP(float, WS_RSTD2), WSP(bf16, WS_PGT)}; pg8::gemm_phase(ring, g, S, E, F.wave); }
        { pg8::Gemm g{WSP(bf16, WS_PB), WSP(bf16, WS_WP), M, D, PLE, 0, nullptr, nullptr, nullptr}; EpiPle E{WSP(bf16, WS_X2B), WSP(bf16, WS_PGT), F.out, WSP(float, WS_ROWSS), F.ctl + CW_PCNT, FIN(28), F.ctl}; pg8::gemm_phase(ring, g, S, E, F.wave); }
    }
#undef IN
#undef SEAM
}

extern "C" void kernel_launch(void* const* d_in, const int* in_sizes, int n_in, void* d_out, int out_size, void* d_ws, size_t ws_size, hipStream_t stream) {
    static int grid = 0;
    if (grid == 0) {
        if (n_in != 29 || in_sizes[0] != M * D || out_size != M * D || ws_size < WS_END) {
            fprintf(stderr, "kernel_launch: unexpected shapes (n_in %d, in0 %d, out %d, ws %zu < %zu); nothing launched\n", n_in, n_in > 0 ? in_sizes[0] : -1, out_size, ws_size, (size_t)WS_END); grid = -1; return; }
        int dev = 0, cus = 0, per_cu = 0;
        if (hipGetDevice(&dev) != hipSuccess || hipDeviceGetAttribute(&cus, hipDeviceAttributeMultiprocessorCount, dev) != hipSuccess) { grid = -1; return; }
        if (hipFuncSetAttribute((const void*)mega_fwd, hipFuncAttributeMaxDynamicSharedMemorySize, LDS_BYTES) != hipSuccess) { fprintf(stderr, "kernel_launch: hipFuncSetAttribute failed\n"); grid = -1; return; }
        if (hipOccupancyMaxActiveBlocksPerMultiprocessor(&per_cu, (const void*)mega_fwd, 512, LDS_BYTES) != hipSuccess || per_cu < 1) { fprintf(stderr, "kernel_launch: occupancy query says %d blocks/CU\n", per_cu); }
        (void)hipGetLastError();
        grid = cus;
    }
    if (grid < 0) return;
    (void)hipMemsetAsync((char*)d_ws + WS_CTL, 0, CTL_ZERO_BYTES, stream);
    Args a{};
    for (int i = 0; i < 29; ++i) a.in[i] = (const float*)d_in[i];
    a.out = (float*)d_out; a.ws = (unsigned char*)d_ws;
#if MK_PER_PHASE
    for (int p = 0; p < NPHASE; ++p) { a.ph_lo = p; a.ph_hi = p + 1; hipLaunchKernelGGL(mega_fwd, dim3(grid), dim3(512), LDS_BYTES, stream, a); }
#else
    a.ph_lo = 0; a.ph_hi = NPHASE; hipLaunchKernelGGL(mega_fwd, dim3(grid), dim3(512), LDS_BYTES, stream, a);
#endif
}
```

```cpp
#include <hip/hip_runtime.h>
#include <cstdio>
#include <cstdint>

#ifndef P3_ONLY
#define P3_ONLY 0
#endif
#ifndef SCAN_STUB
#define SCAN_STUB 0
#endif
#ifndef ATT_FORCE
#define ATT_FORCE 0
#endif
#ifndef G1_F8_TILES
#define G1_F8_TILES 0x1FE030u
#endif
#ifndef TS_PROBE
#define TS_PROBE -1
#endif
#ifndef TS_END_SLOT
#define TS_END_SLOT (TS_PROBE + 1)
#endif
#ifndef MK_PER_PHASE
#define MK_PER_PHASE 0
#endif

#define LAS __attribute__((address_space(3)))
#define GAS __attribute__((address_space(1)))
typedef unsigned short bf16;
typedef short bf16x8 __attribute__((ext_vector_type(8)));
typedef float f32x2 __attribute__((ext_vector_type(2)));
typedef float f32x4 __attribute__((ext_vector_type(4)));
typedef float f32x16 __attribute__((ext_vector_type(16)));
typedef unsigned u32x2 __attribute__((ext_vector_type(2)));
typedef unsigned u32x4 __attribute__((ext_vector_type(4)));
typedef __bf16 bf16x2_t __attribute__((ext_vector_type(2)));

constexpr int NB = 16, SEQ = 2048, D = 1024, M = NB * SEQ;
constexpr int NH = 8, HD = 64, AW = 512, RW = 512, RWC = 1792, INC = 5376;
constexpr int NE = 32, FH = 1024, F2 = 2048, PLE = 256, TOPK = 4;
constexpr int LORA_K = 256, LORA_N = 1536;
constexpr int CAP = 32768;
constexpr int MAXROWS = M * TOPK + NE * 256;
constexpr float RMS_EPS = 1e-5f, GN_EPS = 64e-5f;

constexpr size_t MiB = 1u << 20;
constexpr size_t WS_CTL = 0, CTL_ZERO_BYTES = 1 * MiB;
constexpr size_t WS_WIN = 1 * MiB;
constexpr size_t WS_WA = 12 * MiB, WS_WB = 13 * MiB, WS_WO = 14 * MiB, WS_WG = 16 * MiB, WS_WP = 18 * MiB;
constexpr size_t WS_WL = 18 * MiB + 512 * 1024;
constexpr size_t WS_GW = 19 * MiB + 256 * 1024;
constexpr size_t WS_W1 = 20 * MiB;
constexpr size_t WS_W2 = 148 * MiB;
constexpr size_t WS_PB = 212 * MiB;
constexpr size_t WS_RSTD0 = 228 * MiB, WS_RSTD2 = WS_RSTD0 + 128 * 1024, WS_ROWSS = WS_RSTD0 + 256 * 1024;
constexpr size_t WS_RSTD1 = WS_RSTD0 + 384 * 1024;
constexpr size_t WS_GATEW = WS_RSTD0 + 512 * 1024;
constexpr size_t WS_ROWSLOT = 229 * MiB;
constexpr size_t WS_LIST = 230 * MiB;
constexpr size_t WS_X1 = 236 * MiB;
constexpr size_t WS_YA = 236 * MiB, WS_YB = 268 * MiB, WS_ALORA = 300 * MiB;
constexpr size_t WS_GT = 364 * MiB;
constexpr size_t WS_Q = 492 * MiB, WS_K = 524 * MiB, WS_VT = 556 * MiB;
constexpr size_t WS_ZR = 588 * MiB;
constexpr size_t WS_XB = 700 * MiB;
constexpr size_t WS_DEC = 764 * MiB, WS_AA = 828 * MiB, WS_GG = 892 * MiB;
constexpr size_t WS_MERGED = 492 * MiB;
constexpr size_t WS_XS = 364 * MiB;
constexpr size_t WS_ACT = 684 * MiB;
constexpr size_t WS_HN = 364 * MiB;
constexpr size_t WS_YBUF = 428 * MiB;
constexpr size_t WS_X2B = 684 * MiB;
constexpr size_t WS_PGT = 748 * MiB;
constexpr size_t WS_LRS = 956 * MiB, WS_LGT = 960 * MiB;
constexpr size_t WS_WIN8 = 84 * MiB;
constexpr size_t WS_XB8 = 96 * MiB;
constexpr size_t WS_END = 964 * MiB;
constexpr int CW_CNT = 64;
constexpr int CW_PCNT = 8192;
constexpr int CW_BAR = 4096;

constexpr int RING_BYTES = 131072;
constexpr int LDSCTL_OFF = RING_BYTES;
constexpr int MOE_OFF = RING_BYTES + 1024;
constexpr int MOE_TE = RING_BYTES + 2048;
constexpr int LDS_BYTES = 147456;

#define RLX_AGENT __ATOMIC_RELAXED, __HIP_MEMORY_SCOPE_AGENT
__device__ __forceinline__ unsigned pk2(float lo, float hi) { f32x2 v = {lo, hi}; bf16x2_t b = __builtin_convertvector(v, bf16x2_t); return __builtin_bit_cast(unsigned, b); }
__device__ __forceinline__ unsigned pk8(float a, float b, float c, float d) { int w = __builtin_amdgcn_cvt_pk_fp8_f32(a, b, 0, false); w = __builtin_amdgcn_cvt_pk_fp8_f32(c, d, w, true); return (unsigned)w; }
__device__ __forceinline__ float bflo(unsigned u) { return __uint_as_float(u << 16); }
__device__ __forceinline__ float bfhi(unsigned u) { return __uint_as_float(u & 0xffff0000u); }
__device__ __forceinline__ float sigm(float x) { return __builtin_amdgcn_rcpf(1.f + __expf(-x)); }
__device__ __forceinline__ float wave_sum(float v) {
#pragma unroll
    for (int o = 1; o < 64; o <<= 1) v += __shfl_xor(v, o);
    return v;
}
template <int CTRL> __device__ __forceinline__ float dppf(float v) { return __builtin_bit_cast(float, __builtin_amdgcn_update_dpp(0, __builtin_bit_cast(int, v), CTRL, 0xF, 0xF, true)); }
__device__ __forceinline__ float red8(float v) { v += dppf<0xB1>(v); v += dppf<0x4E>(v); v += dppf<0x141>(v); return v; }
__device__ __forceinline__ int lane_now() { int l; asm volatile("v_mbcnt_lo_u32_b32 %0, -1, 0\n\tv_mbcnt_hi_u32_b32 %0, -1, %0" : "=v"(l)); return l; }
__device__ __forceinline__ int crow(int r, int hi) { return (r & 3) + 8 * (r >> 2) + 4 * hi; }

struct PreNone {}; struct PreF { float f[8]; }; struct PreI { int i[8]; };
namespace pg8 {
#define PG8_LAS __attribute__((address_space(3)))
typedef unsigned short bf16_t;
constexpr int BM = 256, BK = 64, HALF = 128, HTB = HALF * BK * 2, STAGE_BYTES = 8 * HTB, NXCD = 8, WGM = 8;
__host__ __device__ __forceinline__ int lds_byte(int r, int c) { const int st = (r >> 4) * 2 + (c >> 5), rr = r & 15, cc = c & 31, ob = rr * 64 + cc * 2; return st * 1024 + (ob ^ (((ob >> 9) & 1) << 5)); }
__host__ __device__ __forceinline__ void stage_rc(int b, int& R, int& C) { const int st = b / 1024, sb = b % 1024, swz = sb ^ (((sb >> 9) & 1) << 5); R = (st >> 1) * 16 + swz / 64; C = (st & 1) * 32 + (swz % 64) / 2; }
__host__ __device__ __forceinline__ int perm32(int rho) { const int n = rho >> 4, i = rho & 15; return 8 * (i >> 2) + 4 * n + (i & 3); }

struct Unit { int pm, pn, e; };
struct Gemm { const bf16_t* A; const bf16_t* Bt; int M, N, K; size_t bsel_bytes; const int* glist; const PG8_LAS int* goff; const PG8_LAS int* gcnt; };

struct StaticOrder {
    int nM, nN, nwg, G, c;
    __device__ void init(int M_, int N_, int G_, int c_) { nM = M_ / BM; nN = N_ / BM; nwg = nM * nN; G = G_; c = c_; }
    __device__ bool next(int i, Unit& u) const {
        const long L = (long)i * G + c; if (L >= nwg) return false;
        int wgid = (int)L; { const int q = nwg / NXCD, r = nwg % NXCD, xcd = wgid % NXCD, off = wgid / NXCD; wgid = (xcd < r ? xcd * (q + 1) : r * (q + 1) + (xcd - r) * q) + off; }
        const int nig = WGM * nN, gid = wgid / nig, fm = gid * WGM, gsz = (nM - fm) < WGM ? (nM - fm) : WGM;
        u.pm = fm + ((wgid % nig) % gsz); u.pn = (wgid % nig) / gsz; u.e = 0; return true;
    }
};
struct MaskOrder {
    StaticOrder S; unsigned mask;
    __device__ void init(int M_, unsigned mask_, int G_, int c_) { mask = mask_; S.init(M_, BM * __builtin_popcount(mask_), G_, c_); }
    __device__ bool next(int i, Unit& u) const {
        if (!S.next(i, u)) return false;
        int n = u.pn, idx = 0;
#pragma unroll
        for (int t = 0; t < 21; ++t) if ((mask >> t) & 1u) { if (n == 0) idx = t; --n; }
        u.pn = idx; return true;
    }
};
struct LoraOrder {
    int pm, half, nu;
    __device__ bool next(int i, Unit& u) const { if (i >= nu) return false; u.pm = pm; u.pn = 3 * half + i; u.e = 0; return true; }
};
struct MoeOrder {
    int ntiles, npn, G, c; const PG8_LAS unsigned char* te;
    __device__ bool next(int i, Unit& u) const {
        int rt, pn;
        if ((G & 255) == 0 && (npn == 8 || npn == 4)) { const int x = c & 7, j = (c >> 3) & 31, rpx = 32 / npn, blk = c >> 8; rt = ((i * (G >> 8) + blk) * 8 + x) * rpx + j / npn; pn = j % npn; }
        else { const long L = (long)i * G + c; rt = (int)(L / npn); pn = (int)(L % npn); }
        if (rt >= ntiles) return false;
        u.pm = rt; u.pn = pn; u.e = te[rt]; return true;
    }
};

typedef int i32x4 __attribute__((ext_vector_type(4))); typedef int i32x8 __attribute__((ext_vector_type(8)));
template <class Epi, class Sched, bool GATHER = false, bool F8 = false>
__device__ __forceinline__ void gemm_phase(PG8_LAS unsigned char* lds, const Gemm g, const Sched& S, const Epi& E, const int wid) {
    const int lane = lane_now(), tid = wid * 64 + lane,
              wr = wid >> 2, wc = wid & 3, fr = lane & 15, fq = lane >> 4;
    const int K = g.K, nt = F8 ? K / (2 * BK) : K / BK;
    unsigned voffA[2], voffB[2];
#pragma unroll
    for (int i = 0; i < 2; ++i) { int R, C; stage_rc(tid * 16 + i * 8192, R, C); const int Rb = Epi::PERM ? ((R & ~31) + perm32(R & 31)) : R;
        voffA[i] = F8 ? (unsigned)(R * K + C * 2) : (unsigned)(R * K + C) * 2u; voffB[i] = F8 ? (unsigned)(Rb * K + C * 2) : (unsigned)(Rb * K + C) * 2u; }
    const size_t kstep = (size_t)(BK * 2);
    const size_t hstep = (size_t)HALF * K * (F8 ? 1 : 2);
    const size_t tstep = 2 * hstep;
    const unsigned ldsw = (unsigned)wid * 1024u;
    const int aoff = lds_byte(wr * 64 + fr, fq * 8), boff = lds_byte(wc * 32 + fr, fq * 8);
    const int aoffk[2] = {aoff, aoff + 1024}, boffk[2] = {boff, boff + 1024};
    unsigned vgC[2][2] = {{0u, 0u}, {0u, 0u}}, vgN[2][2] = {{0u, 0u}, {0u, 0u}};
#define PG8_GOFF(u, vo) do { _Pragma("unroll") for (int _h = 0; _h < 2; ++_h) _Pragma("unroll") for (int _i = 0; _i < 2; ++_i) { int R_, C_; stage_rc(tid * 16 + _i * 8192, R_, C_); \
        const int r_ = (u).pm * BM + _h * HALF + R_ - g.goff[(u).e]; int tok_ = 0; if (r_ < g.gcnt[(u).e]) tok_ = g.glist[(size_t)(u).e * 32768 + r_] >> 2; (vo)[_h][_i] = F8 ? (unsigned)(tok_ * K + C_ * 2) : (unsigned)(tok_ * K + C_) * 2u; } } while (0)
#define PG8_SA(b, h) (((b) * 2 + (h)) * HTB)
#define PG8_SB(b, h) ((4 + (b) * 2 + (h)) * HTB)
#define PG8_STAGE(bufoff, gbase, voff) do { _Pragma("unroll") for (int _i = 0; _i < 2; ++_i) \
        __builtin_amdgcn_global_load_lds((const unsigned*)((const char*)(gbase) + (voff)[_i]), (PG8_LAS unsigned*)(lds + (bufoff) + ldsw + _i * 8192), 16, 0, 0); } while (0)
#define PG8_STA(bufoff, h, ptr, kbyte, usenext) do { if constexpr (GATHER) { unsigned vo_[2] = {(usenext) ? vgN[h][0] : vgC[h][0], (usenext) ? vgN[h][1] : vgC[h][1]}; PG8_STAGE(bufoff, (const char*)g.A + (kbyte), vo_); } else { PG8_STAGE(bufoff, ptr, voffA); } } while (0)
#define PG8_LDA(dst, b, h) do { _Pragma("unroll") for (int m = 0; m < 4; ++m) _Pragma("unroll") for (int k = 0; k < 2; ++k) dst[m][k] = *(const PG8_LAS bf16x8*)(lds + PG8_SA(b, h) + aoffk[k] + m * 2048); } while (0)
#define PG8_LDB(dst, b, h) do { _Pragma("unroll") for (int n = 0; n < 2; ++n) _Pragma("unroll") for (int k = 0; k < 2; ++k) dst[n][k] = *(const PG8_LAS bf16x8*)(lds + PG8_SB(b, h) + boffk[k] + n * 2048); } while (0)
#define PG8_MMA(ai, bj, At, Bt) do { __builtin_amdgcn_s_setprio(1); _Pragma("unroll") for (int m = 0; m < 4; ++m) _Pragma("unroll") for (int n = 0; n < 2; ++n) { \
        if constexpr (F8) { const i32x8 b8_ = __builtin_shufflevector(__builtin_bit_cast(i32x4, Bt[n][0]), __builtin_bit_cast(i32x4, Bt[n][1]), 0, 1, 2, 3, 4, 5, 6, 7), a8_ = __builtin_shufflevector(__builtin_bit_cast(i32x4, At[m][0]), __builtin_bit_cast(i32x4, At[m][1]), 0, 1, 2, 3, 4, 5, 6, 7); \
            asm volatile("v_mfma_f32_16x16x128_f8f6f4 %0, %1, %2, %0" : "+v"(acc[ai][bj][m][n]) : "v"(b8_), "v"(a8_)); } \
        else { _Pragma("unroll") for (int k = 0; k < 2; ++k) acc[ai][bj][m][n] = __builtin_amdgcn_mfma_f32_16x16x32_bf16(Bt[n][k], At[m][k], acc[ai][bj][m][n], 0, 0, 0); } } \
        __builtin_amdgcn_s_setprio(0); } while (0)
#define PG8_WAIT_V(n) asm volatile("s_waitcnt vmcnt(" #n ")" ::: "memory")
#define PG8_WAIT_L(n) asm volatile("s_waitcnt lgkmcnt(" #n ")" ::: "memory")
#define PG8_BAR __builtin_amdgcn_s_barrier()
#define PG8_SCHED __builtin_amdgcn_sched_barrier(0)
    Unit cur, nxt; int ui = 0;
    if (!S.next(0, cur)) return;
    typename Epi::Pre preC;
    f32x4 acc[2][2][4][2];
#pragma unroll
    for (int a = 0; a < 2; ++a)
#pragma unroll
        for (int b = 0; b < 2; ++b)
#pragma unroll
            for (int m = 0; m < 4; ++m)
#pragma unroll
                for (int n = 0; n < 2; ++n) acc[a][b][m][n] = (f32x4){0.f, 0.f, 0.f, 0.f};
    bf16x8 At[4][2], B0[2][2], B1[2][2];
    const char* cA = (const char*)g.A + (size_t)cur.pm * tstep; const char* cB = (const char*)g.Bt + (size_t)cur.e * g.bsel_bytes + (size_t)cur.pn * tstep;
    if constexpr (GATHER) PG8_GOFF(cur, vgC);
    PG8_STAGE(PG8_SB(0, 0), cB, voffB); PG8_STAGE(PG8_SB(0, 1), cB + hstep, voffB); PG8_STA(PG8_SA(0, 0), 0, cA, 0, false); PG8_STA(PG8_SA(0, 1), 1, cA + hstep, 0, false);
    if (wr == 1) PG8_BAR;
    PG8_WAIT_V(2); PG8_BAR;
    PG8_STAGE(PG8_SB(1, 0), cB + kstep, voffB); PG8_STA(PG8_SA(1, 0), 0, cA + kstep, kstep, false); PG8_STAGE(PG8_SB(1, 1), cB + hstep + kstep, voffB);
    PG8_WAIT_V(6); PG8_BAR;
    for (;;) {
        const bool has_next = S.next(ui + 1, nxt);
        E.pre(cur, wr, fr, preC);
        f32x4 biasq = (f32x4){0.f, 0.f, 0.f, 0.f}; if constexpr (Epi::LBIAS) { if (wid == 0) biasq = *(const f32x4*)(E.bias_tile(cur) + 4 * lane); }
        if constexpr (GATHER) { if (has_next) PG8_GOFF(nxt, vgN); else { vgN[0][0] = vgC[0][0]; vgN[0][1] = vgC[0][1]; vgN[1][0] = vgC[1][0]; vgN[1][1] = vgC[1][1]; } }
        const char* nA = has_next ? (const char*)g.A + (size_t)nxt.pm * tstep : cA;
        const char* nB = has_next ? (const char*)g.Bt + (size_t)nxt.e * g.bsel_bytes + (size_t)nxt.pn * tstep : cB;
        for (int t = 0; t < nt; t += 2) {
            const bool last = (t == nt - 2);
            const char* a1 = cA + (size_t)(t + 1) * kstep;
            const char* a2 = last ? nA : cA + (size_t)(t + 2) * kstep; const char* b2 = last ? nB : cB + (size_t)(t + 2) * kstep;
            const char* a3 = a2 + kstep; const char* b3 = b2 + kstep;
            const size_t k2 = last ? 0 : (size_t)(t + 2) * kstep;
            PG8_LDB(B0, 0, 0); PG8_LDB(B1, 0, 1); PG8_SCHED; PG8_LDA(At, 0, 0); PG8_STA(PG8_SA(1, 1), 1, a1 + hstep, (size_t)(t + 1) * kstep, false);
            PG8_WAIT_V(8); PG8_WAIT_L(0); PG8_BAR; PG8_MMA(0, 0, At, B0); PG8_MMA(0, 1, At, B1); PG8_BAR; PG8_SCHED;
            PG8_LDA(At, 0, 1); PG8_STAGE(PG8_SB(0, 0), b2, voffB); PG8_STAGE(PG8_SB(0, 1), b2 + hstep, voffB); PG8_STA(PG8_SA(0, 0), 0, a2, k2, last);
            PG8_WAIT_V(8); PG8_WAIT_L(0); PG8_BAR; PG8_MMA(1, 0, At, B0); PG8_MMA(1, 1, At, B1); PG8_BAR; PG8_SCHED;
            PG8_LDB(B0, 1, 0); PG8_LDB(B1, 1, 1); PG8_SCHED; PG8_LDA(At, 1, 0); PG8_STA(PG8_SA(0, 1), 1, a2 + hstep, k2, last);
            PG8_WAIT_V(8); PG8_WAIT_L(0); PG8_BAR; PG8_MMA(0, 0, At, B0); PG8_MMA(0, 1, At, B1); PG8_BAR; PG8_SCHED;
            PG8_LDA(At, 1, 1); PG8_STAGE(PG8_SB(1, 0), b3, voffB); PG8_STAGE(PG8_SB(1, 1), b3 + hstep, voffB); PG8_STA(PG8_SA(1, 0), 0, a3, k2 + kstep, last);
            PG8_WAIT_V(8); PG8_WAIT_L(0); PG8_BAR; PG8_MMA(1, 0, At, B0); PG8_MMA(1, 1, At, B1); PG8_BAR; PG8_SCHED;
        }
        if constexpr (Epi::LBIAS) { if (wid == 0) { *(PG8_LAS f32x4*)(lds + RING_BYTES + 4096 + 16 * lane) = biasq; asm volatile("s_waitcnt lgkmcnt(0)" ::: "memory"); } }
        if (wr == 0) PG8_BAR;
        if constexpr (F8) asm volatile("s_nop 15\n\ts_nop 15\n\ts_nop 15" ::: "memory");
        E(acc, cur, wr, wc, fr, fq, preC);
        if (!has_next) break;
#pragma unroll
        for (int a = 0; a < 2; ++a)
#pragma unroll
            for (int b = 0; b < 2; ++b)
#pragma unroll
                for (int m = 0; m < 4; ++m)
#pragma unroll
                    for (int n = 0; n < 2; ++n) acc[a][b][m][n] = (f32x4){0.f, 0.f, 0.f, 0.f};
        cur = nxt; cA = nA; cB = nB; ++ui;
        if constexpr (GATHER) { vgC[0][0] = vgN[0][0]; vgC[0][1] = vgN[0][1]; vgC[1][0] = vgN[1][0]; vgC[1][1] = vgN[1][1]; }
        if (wr == 1) PG8_BAR;
    }
    PG8_WAIT_V(0);
    PG8_BAR;
#undef PG8_SA
#undef PG8_SB
#undef PG8_STAGE
#undef PG8_LDA
#undef PG8_STA
#undef PG8_GOFF
#undef PG8_LDB
#undef PG8_MMA
#undef PG8_WAIT_V
#undef PG8_WAIT_L
#undef PG8_BAR
#undef PG8_SCHED
}
}
using pg8::Unit;
typedef const f32x4 (&AccRef)[2][2][4][2];

#define XB_TMO      128
#define XB_XCNT(j)  (256  + 64 * (j))
#define XB_XSUB(j)  (1280 + 64 * (j))
#define XB_XGEN(j)  (2304 + 64 * (j))
#define XB_TOP      3328
#define XB_TOPGEN   3392
#define XCD_BAR_WORDS 3456
#define XB_SPIN_CAP (1u << 22)
__device__ __forceinline__ unsigned xb_ld(unsigned* p)              { return __hip_atomic_load(p, __ATOMIC_RELAXED, __HIP_MEMORY_SCOPE_AGENT); }
__device__ __forceinline__ unsigned xb_add(unsigned* p, unsigned v) { return __hip_atomic_fetch_add(p, v, __ATOMIC_RELAXED, __HIP_MEMORY_SCOPE_AGENT); }
__device__ __forceinline__ unsigned xb_xcc_id() { return (unsigned)__builtin_amdgcn_s_getreg((3 << 11) | 20) & 0xFu; }
#define XB_SPIN(cond, bar) do { unsigned _sp = 0; while (cond) { __builtin_amdgcn_s_sleep(1); \
    if ((++_sp & 255u) == 0u) { if (xb_ld(&(bar)[XB_TMO])) break; if (_sp > XB_SPIN_CAP) { atomicAdd(&(bar)[XB_TMO], 1u); break; } } } } while (0)
struct XcdBarrier { unsigned* bar; unsigned x; volatile LAS unsigned* st; };
__device__ __forceinline__ XcdBarrier xcd_barrier_post(unsigned* bar, volatile LAS unsigned* st, int tid) {
    XcdBarrier b; b.bar = bar; b.x = xb_xcc_id(); b.st = st;
    if (tid == 0) (void)xb_add(&bar[XB_XCNT(b.x)], 1u);
    return b;
}
__device__ __forceinline__ void xcd_barrier_complete(unsigned* bar, unsigned x, unsigned& nloc, unsigned& nx) {
    const unsigned G = gridDim.x * gridDim.y * gridDim.z;
    unsigned sum, cnt, mine, sp = 0u;
    for (;;) {
        sum = 0u; cnt = 0u; mine = 0u;
#pragma unroll
        for (unsigned j = 0; j < 16; ++j) { const unsigned c = xb_ld(&bar[XB_XCNT(j)]); sum += c; cnt += (c > 0u) ? 1u : 0u; mine = (j == x) ? c : mine; }
        if (sum == G) break;
        __builtin_amdgcn_s_sleep(1);
        if ((++sp & 255u) == 0u) { if (xb_ld(&bar[XB_TMO])) break; if (sp > XB_SPIN_CAP) { atomicAdd(&bar[XB_TMO], 1u); break; } }
    }
    nloc = mine > 0u ? mine : 1u; nx = cnt > 0u ? cnt : 1u;
}
__device__ __forceinline__ void xcd_barrier(const XcdBarrier& b, int wave) {
    asm volatile("s_waitcnt vmcnt(0)" ::: "memory");
    __syncthreads();
    if (wave == 0 && lane_now() == 0) {
        unsigned* bar = b.bar;
        __builtin_amdgcn_s_waitcnt(0);
        unsigned nloc = b.st[0], nx = b.st[1];
        if (nloc == 0u) { xcd_barrier_complete(bar, b.x, nloc, nx); b.st[0] = nloc; b.st[1] = nx; }
        const unsigned old = xb_add(&bar[XB_XSUB(b.x)], 1u);
        const unsigned gen = old / nloc;
        if (old + 1u == (gen + 1u) * nloc) {
            __builtin_amdgcn_fence(__ATOMIC_RELEASE, "agent");
            asm volatile("s_waitcnt vmcnt(0)" ::: "memory");
            const unsigned og = xb_add(&bar[XB_TOP], 1u);
            const unsigned tg = og / nx;
            if (og + 1u == (tg + 1u) * nx) xb_add(&bar[XB_TOPGEN], 1u);
            else XB_SPIN(xb_ld(&bar[XB_TOPGEN]) == tg, bar);
            __builtin_amdgcn_fence(__ATOMIC_ACQUIRE, "agent");
            xb_add(&bar[XB_XGEN(b.x)], 1u);
            asm volatile("s_waitcnt vmcnt(0)" ::: "memory");
        } else {
            XB_SPIN(xb_ld(&bar[XB_XGEN(b.x)]) == gen, bar);
            __builtin_amdgcn_fence(__ATOMIC_ACQUIRE, "agent");
            asm volatile("s_waitcnt vmcnt(0)" ::: "memory");
        }
    }
    __syncthreads();
}

struct Frame {
    LAS unsigned char* lds;
    unsigned* ctl;
    int tid, lane, wave, vcu, G;
    unsigned char* ws;
    float* out;
};
#define WSP(T, off) ((T*)(F.ws + (off)))
struct Args { const float* in[29]; float* out; unsigned char* ws; int ph_lo, ph_hi; };
#define FIN(i) (args.in[i])

template <bool SWZ = false, bool Q8 = false>
__device__ __forceinline__ void p0_transpose_item(const float* W, int K, int N, bf16* WT, LAS float* scr, int item, int lane, const float* kscale) {
    const int nblk = N / 32, kb = item / nblk, nb = item % nblk, k0 = 64 * kb, n0 = 32 * nb;
#pragma unroll
    for (int b = 0; b < 2; ++b) {
        float v[16];
#pragma unroll
        for (int i = 0; i < 16; ++i) { const int kk = 2 * (16 * b + i) + (lane >> 5); v[i] = W[(size_t)(k0 + kk) * N + n0 + (lane & 31)]; }
        __builtin_amdgcn_sched_barrier(0);
#pragma unroll
        for (int i = 0; i < 16; ++i) { const int kk = 2 * (16 * b + i) + (lane >> 5); if (kscale) v[i] *= kscale[k0 + kk]; scr[kk * 33 + (lane & 31)] = v[i]; }
        __builtin_amdgcn_sched_barrier(0);
    }
    asm volatile("s_waitcnt lgkmcnt(0)" ::: "memory");
    if constexpr (Q8) {
        const int c4 = lane & 3;
#pragma unroll
        for (int j = 0; j < 2; ++j) { const int n = (lane >> 2) + 16 * j; const LAS float* s = scr + (16 * c4) * 33 + n;
            u32x4 o; o.x = pk8(64.f * s[0 * 33], 64.f * s[1 * 33], 64.f * s[2 * 33], 64.f * s[3 * 33]); o.y = pk8(64.f * s[4 * 33], 64.f * s[5 * 33], 64.f * s[6 * 33], 64.f * s[7 * 33]);
            o.z = pk8(64.f * s[8 * 33], 64.f * s[9 * 33], 64.f * s[10 * 33], 64.f * s[11 * 33]); o.w = pk8(64.f * s[12 * 33], 64.f * s[13 * 33], 64.f * s[14 * 33], 64.f * s[15 * 33]);
            int nr = n0 + n; if (SWZ) { const int cl = nr & 255; nr = (nr & ~255) + 128 * ((cl >> 3) & 1) + 32 * (cl >> 6) + 8 * ((cl >> 4) & 3) + (cl & 7); }
            *(u32x4*)((unsigned char*)WT + (size_t)nr * K + k0 + 16 * c4) = o; }
        asm volatile("s_waitcnt lgkmcnt(0)" ::: "memory");
        return; }
    const int c = lane & 7;
#pragma unroll
    for (int j = 0; j < 4; ++j) { const int n = (lane >> 3) + 8 * j; const LAS float* s = scr + (8 * c) * 33 + n;
        u32x4 o; o.x = pk2(s[0 * 33], s[1 * 33]); o.y = pk2(s[2 * 33], s[3 * 33]); o.z = pk2(s[4 * 33], s[5 * 33]); o.w = pk2(s[6 * 33], s[7 * 33]);
        int nr = n0 + n; if (SWZ) { const int cl = nr & 255; nr = (nr & ~255) + 128 * ((cl >> 3) & 1) + 32 * (cl >> 6) + 8 * ((cl >> 4) & 3) + (cl & 7); }
        *(u32x4*)(WT + (size_t)nr * K + k0 + 8 * c) = o; }
    asm volatile("s_waitcnt lgkmcnt(0)" ::: "memory");
}
__device__ __forceinline__ void p0_prologue(const Args& args, Frame& F) {
    LAS float* scr = (LAS float*)(F.lds + F.wave * 16384);
    const int gw = F.vcu * 8 + F.wave, NGW = F.G * 8, lane = F.lane;
    constexpr int I_IN = (D / 64) * (INC / 32), I_A = (AW / 64) * (D / 32), I_O = (D / 64) * (D / 32), I_P = (PLE / 64) * (D / 32);
    constexpr int I_W1 = (D / 64) * (F2 / 32), I_W2 = (FH / 64) * (D / 32);
    constexpr int NITEMS = I_IN + 2 * I_A + 2 * I_O + I_P;
    for (int it = gw; it < NITEMS; it += NGW) {
        int r = it;
        if (r < I_IN) { const int tile = (r % (INC / 32)) >> 3;
            if ((G1_F8_TILES >> tile) & 1) p0_transpose_item<false, true>(FIN(3), D, INC, WSP(bf16, WS_WIN8), scr, r, lane, FIN(2));
            else p0_transpose_item(FIN(3), D, INC, WSP(bf16, WS_WIN), scr, r, lane, FIN(2));
            continue; } r -= I_IN;
        if (r < I_A) { p0_transpose_item(FIN(15), AW, D, WSP(bf16, WS_WA), scr, r, lane, nullptr); continue; } r -= I_A;
        if (r < I_A) { p0_transpose_item(FIN(16), RW, D, WSP(bf16, WS_WB), scr, r, lane, nullptr); continue; } r -= I_A;
        if (r < I_O) { p0_transpose_item(FIN(17), D, D, WSP(bf16, WS_WO), scr, r, lane, nullptr); continue; } r -= I_O;
        if (r < I_O) { p0_transpose_item(FIN(26), D, D, WSP(bf16, WS_WG), scr, r, lane, FIN(25)); continue; } r -= I_O;
        p0_transpose_item(FIN(27), PLE, D, WSP(bf16, WS_WP), scr, r, lane, nullptr);
    }
    { const int gt = (F.vcu * 512 + F.tid), NT = F.G * 512;
      bf16* WL = WSP(bf16, WS_WL);
      for (int i = gt; i < LORA_N * LORA_K; i += NT) { const int n = i >> 8, k = i & 255; float v = 0.f;
          if (n < 512) { if (k < 64) v = FIN(6)[k * 512 + n]; }
          else if (n < 1024) { if (k >= 64 && k < 128) v = FIN(8)[(k - 64) * 512 + (n - 512)]; }
          else { if (k >= 128) v = FIN(9)[(k - 128) * 512 + (n - 1024)]; }
          WL[i] = (bf16)(pk2(v, 0.f) & 0xffffu); }
      float* GW = WSP(float, WS_GW);
      for (int i = gt; i < D * NE; i += NT) GW[i] = FIN(19)[i] * FIN(18)[i >> 5];
    }
    { bf16* XB = WSP(bf16, WS_XB); float* R0 = WSP(float, WS_RSTD0); bf16* PB = WSP(bf16, WS_PB);
      for (int m = gw; m < M; m += NGW) {
          const f32x4* xr = (const f32x4*)(FIN(0) + (size_t)m * D) + lane;
          f32x4 v[4]; float s = 0.f;
#pragma unroll
          for (int j = 0; j < 4; ++j) { v[j] = xr[64 * j]; s += (v[j].x * v[j].x + v[j].y * v[j].y) + (v[j].z * v[j].z + v[j].w * v[j].w); }
          s = wave_sum(s);
          u32x2* o = (u32x2*)(XB + (size_t)m * D) + lane;
#pragma unroll
          for (int j = 0; j < 4; ++j) { if (G1_F8_TILES) (WSP(unsigned, WS_XB8) + (size_t)m * (D / 4))[lane + 64 * j] = pk8(v[j].x, v[j].y, v[j].z, v[j].w); u32x2 w; w.x = pk2(v[j].x, v[j].y); w.y = pk2(v[j].z, v[j].w); o[64 * j] = w; }
          if (lane == 0) R0[m] = 1.0f / sqrtf(s * (1.f / D) + RMS_EPS);
          const f32x4 pv = ((const f32x4*)(FIN(1) + (size_t)m * PLE))[lane];
          u32x2 w; w.x = pk2(pv.x, pv.y); w.y = pk2(pv.z, pv.w); ((u32x2*)(PB + (size_t)m * PLE))[lane] = w;
      }
    }
}

__device__ __forceinline__ void expert_convert(const Args& args, Frame& F, int wv, int NW, int which) {
    LAS float* scr = (LAS float*)(F.lds + F.wave * 16384);
    constexpr int I_W1 = (D / 64) * (F2 / 32), I_W2 = (FH / 64) * (D / 32);
    if (which & 1) for (int it = wv; it < NE * I_W1; it += NW) { const int e = it / I_W1; p0_transpose_item<true, true>(FIN(21) + (size_t)e * D * F2, D, F2, (bf16*)(WSP(unsigned char, WS_W1) + (size_t)e * F2 * D), scr, it % I_W1, F.lane, nullptr); }
    if (which & 2) for (int it = wv; it < NE * I_W2; it += NW) { const int e = it / I_W2; p0_transpose_item<false, true>(FIN(23) + (size_t)e * FH * D, FH, D, (bf16*)(WSP(unsigned char, WS_W2) + (size_t)e * D * FH), scr, it % I_W2, F.lane, nullptr); }
}
struct EpiG1 {
    static constexpr bool PERM = true;
    typedef PreF Pre; static constexpr bool LBIAS = false;
    const float* rstd; bf16 *Q, *K, *VT, *ZR, *GT; float rs_mul;
    __device__ __forceinline__ void pre(const Unit& u, int wr, int fr, PreF& P) const {
#pragma unroll
        for (int k = 0; k < 8; ++k) P.f[k] = rstd[u.pm * 256 + wr * 64 + fr + (k >> 2) * 128 + (k & 3) * 16] * rs_mul; }
    __device__ __forceinline__ void operator()(AccRef acc, const Unit& u, int wr, int wc, int fr, int fq, const Pre& P) const {
        const int pn = u.pn, rowb = u.pm * 256 + wr * 64 + fr, cl = wc * 32 + 8 * fq;
#pragma unroll
        for (int ai = 0; ai < 2; ++ai)
#pragma unroll
            for (int m = 0; m < 4; ++m) {
                const int row = rowb + ai * 128 + m * 16; const float rs = P.f[4 * ai + m];
                if (pn < 4) {
                    bf16* base = (pn < 2 ? Q : K) + (size_t)row * 512 + (pn & 1) * 256 + cl; const float sc = pn < 2 ? rs * 0.125f : rs;
#pragma unroll
                    for (int bj = 0; bj < 2; ++bj) { const f32x4 v0 = acc[ai][bj][m][0] * sc, v1 = acc[ai][bj][m][1] * sc;
                        u32x4 w; w.x = pk2(v0[0], v0[1]); w.y = pk2(v0[2], v0[3]); w.z = pk2(v1[0], v1[1]); w.w = pk2(v1[2], v1[3]); *(u32x4*)(base + bj * 128) = w; }
                } else if (pn < 6) {
                    const int b = row >> 11, s = row & 2047;
#pragma unroll
                    for (int bj = 0; bj < 2; ++bj)
#pragma unroll
                        for (int n = 0; n < 2; ++n)
#pragma unroll
                            for (int j = 0; j < 4; ++j) { const int c = (pn - 4) * 256 + cl + bj * 128 + 4 * n + j; const int hh = c >> 6, d = c & 63;
                                VT[((size_t)(((b * 8 + hh) * 128 + (s >> 4)) * 64 + d)) * 16 + (s & 15)] = (bf16)(pk2(acc[ai][bj][m][n][j] * rs, 0.f) & 0xffffu); }
                } else if (pn < 13) {
                    bf16* base = ZR + (size_t)row * RWC + (pn - 6) * 256 + cl;
#pragma unroll
                    for (int bj = 0; bj < 2; ++bj) { const f32x4 v0 = acc[ai][bj][m][0] * rs, v1 = acc[ai][bj][m][1] * rs;
                        u32x4 w; w.x = pk2(v0[0], v0[1]); w.y = pk2(v0[2], v0[3]); w.z = pk2(v1[0], v1[1]); w.w = pk2(v1[2], v1[3]); *(u32x4*)(base + bj * 128) = w; }
                } else {
                    bf16* base = GT + (size_t)row * 2048 + (pn - 13) * 256 + cl;
#pragma unroll
                    for (int bj = 0; bj < 2; ++bj) { const f32x4 v0 = acc[ai][bj][m][0] * rs, v1 = acc[ai][bj][m][1] * rs;
                        u32x4 w; w.x = pk2(sigm(v0[0]), sigm(v0[1])); w.y = pk2(sigm(v0[2]), sigm(v0[3])); w.z = pk2(sigm(v1[0]), sigm(v1[1])); w.w = pk2(sigm(v1[2]), sigm(v1[3])); *(u32x4*)(base + bj * 128) = w; }
                }
            }
    }
};
struct EpiLora {
    static constexpr bool PERM = false;
    typedef PreNone Pre; static constexpr bool LBIAS = false;
    __device__ __forceinline__ void pre(const Unit&, int, int, PreNone&) const {}
    const float *w0, *a0; float *DEC, *AA; bf16* GG;
    template <int MODE> __device__ __forceinline__ void body(AccRef acc, int rowb, int cb) const {
#pragma unroll
        for (int ai = 0; ai < 2; ++ai)
#pragma unroll
            for (int m = 0; m < 4; ++m) {
                const int row = rowb + ai * 128 + m * 16;
#pragma unroll
                for (int bj = 0; bj < 2; ++bj)
#pragma unroll
                    for (int n = 0; n < 2; ++n) {
                        const int c = cb + bj * 128 + n * 16;
                        f32x4 v = acc[ai][bj][m][n];
                        if (MODE == 0) { v = v + *(const f32x4*)(w0 + c); f32x4 o;
#pragma unroll
                            for (int j = 0; j < 4; ++j) { const float y = -v[j]; const float sp = y > 20.f ? y : __logf(1.f + __expf(y)); o[j] = __expf(-__expf(-sp - 0.5f)); }
                            *(f32x4*)(DEC + (size_t)row * 512 + c) = o;
                        } else if (MODE == 1) { v = v + *(const f32x4*)(a0 + c); f32x4 o;
#pragma unroll
                            for (int j = 0; j < 4; ++j) o[j] = sigm(v[j]);
                            *(f32x4*)(AA + (size_t)row * 512 + c) = o;
                        } else { u32x2 w; w.x = pk2(v[0], v[1]); w.y = pk2(v[2], v[3]); *(u32x2*)(GG + (size_t)row * 512 + c) = w; }
                    }
                asm volatile("" ::: "memory");
            }
    }
    __device__ __forceinline__ void operator()(AccRef acc, const Unit& u, int wr, int wc, int fr, int fq, const Pre& P) const {
        const int pn = u.pn, rowb = u.pm * 256 + wr * 64 + fr, cb = (pn & 1) * 256 + wc * 32 + 4 * fq;
        if (pn < 2) body<0>(acc, rowb, cb); else if (pn < 4) body<1>(acc, rowb, cb); else body<2>(acc, rowb, cb);
    }
};
template <int SECOND> struct EpiMerge {
    static constexpr bool PERM = true;
    typedef PreNone Pre; static constexpr bool LBIAS = false;
    __device__ __forceinline__ void pre(const Unit&, int, int, PreNone&) const {}
    const bf16* GT; bf16* MG;
    __device__ __forceinline__ void operator()(AccRef acc, const Unit& u, int wr, int wc, int fr, int fq, const Pre& P) const {
        const int rowb = u.pm * 256 + wr * 64 + fr, c0 = u.pn * 256 + wc * 32 + 8 * fq;
#pragma unroll
        for (int bj = 0; bj < 2; ++bj) {
            const int c = c0 + bj * 128; u32x4 gv[8], ov[8];
#pragma unroll
            for (int k = 0; k < 8; ++k) { const int row = rowb + (k >> 2) * 128 + (k & 3) * 16; gv[k] = *(const u32x4*)(GT + (size_t)row * 2048 + SECOND * 1024 + c); if (SECOND) ov[k] = *(const u32x4*)(MG + (size_t)row * 1024 + c); }
            __builtin_amdgcn_sched_barrier(0);
#pragma unroll
            for (int k = 0; k < 8; ++k) { const int ai = k >> 2, m = k & 3, row = rowb + ai * 128 + m * 16;
                const f32x4 v0 = acc[ai][bj][m][0], v1 = acc[ai][bj][m][1];
                float o[8] = {v0[0] * bflo(gv[k].x), v0[1] * bfhi(gv[k].x), v0[2] * bflo(gv[k].y), v0[3] * bfhi(gv[k].y), v1[0] * bflo(gv[k].z), v1[1] * bfhi(gv[k].z), v1[2] * bflo(gv[k].w), v1[3] * bfhi(gv[k].w)};
                if (SECOND) { o[0] += bflo(ov[k].x); o[1] += bfhi(ov[k].x); o[2] += bflo(ov[k].y); o[3] += bfhi(ov[k].y); o[4] += bflo(ov[k].z); o[5] += bfhi(ov[k].z); o[6] += bflo(ov[k].w); o[7] += bfhi(ov[k].w); }
                u32x4 w; w.x = pk2(o[0], o[1]); w.y = pk2(o[2], o[3]); w.z = pk2(o[4], o[5]); w.w = pk2(o[6], o[7]); *(u32x4*)(MG + (size_t)row * 1024 + c) = w; }
            __builtin_amdgcn_sched_barrier(0);
        }
    }
};
struct EpiX1 {
    static constexpr bool PERM = true;
    typedef PreNone Pre; static constexpr bool LBIAS = false;
    __device__ __forceinline__ void pre(const Unit&, int, int, PreNone&) const {}
    const float* X; float* X1; const float* gn; unsigned char* HN;
    __device__ __forceinline__ void operator()(AccRef acc, const Unit& u, int wr, int wc, int fr, int fq, const Pre& P) const {
        const int rowb = u.pm * 256 + wr * 64 + fr, c0 = u.pn * 256 + wc * 32 + 8 * fq;
#pragma unroll
        for (int bj = 0; bj < 2; ++bj) { const f32x4 g0 = *(const f32x4*)(gn + c0 + bj * 128), g1 = *(const f32x4*)(gn + c0 + bj * 128 + 4);
#pragma unroll
            for (int ai = 0; ai < 2; ++ai) {
                f32x4 xa[4], xb[4];
#pragma unroll
                for (int m = 0; m < 4; ++m) { const size_t off = (size_t)(rowb + ai * 128 + m * 16) * D + c0 + bj * 128; xa[m] = *(const f32x4*)(X + off); xb[m] = *(const f32x4*)(X + off + 4); }
                __builtin_amdgcn_sched_barrier(0);
#pragma unroll
                for (int m = 0; m < 4; ++m) { const size_t off = (size_t)(rowb + ai * 128 + m * 16) * D + c0 + bj * 128;
                    const f32x4 x0 = xa[m] + acc[ai][bj][m][0], x1 = xb[m] + acc[ai][bj][m][1];
                    *(f32x4*)(X1 + off) = x0; *(f32x4*)(X1 + off + 4) = x1;
                    u32x2 w; w.x = pk8(x0[0] * g0[0], x0[1] * g0[1], x0[2] * g0[2], x0[3] * g0[3]); w.y = pk8(x1[0] * g1[0], x1[1] * g1[1], x1[2] * g1[2], x1[3] * g1[3]); *(u32x2*)(HN + off) = w; }
                __builtin_amdgcn_sched_barrier(0);
            }
        }
    }
};
struct EpiSwiglu {
    static constexpr bool PERM = true;
    typedef PreF Pre; static constexpr bool LBIAS = true;
    const float* b1; unsigned char* ACT; const int* LIST; const float* R1; const LAS int* OFF; const LAS int* CS; const LAS float* LB;
    __device__ __forceinline__ const float* bias_tile(const Unit& u) const { return b1 + (size_t)u.e * F2 + u.pn * 256; }
    __device__ __forceinline__ void pre(const Unit& u, int wr, int fr, PreF& P) const {
        const int rbase = u.pm * 256 + wr * 64 + fr - OFF[u.e], cnt = CS[u.e];
#pragma unroll
        for (int k = 0; k < 8; ++k) { const int r = rbase + (k >> 2) * 128 + (k & 3) * 16; P.f[k] = 0.f; if (r < cnt) P.f[k] = R1[(size_t)u.e * CAP + r] * (1.f / 64.f); } }
    __device__ __forceinline__ void operator()(AccRef acc, const Unit& u, int wr, int wc, int fr, int fq, const Pre& P) const {
        const int rowb = u.pm * 256 + wr * 64 + fr, c0 = u.pn * 256 + wc * 64 + 16 * fq;
        const LAS float* bb = LB + wc * 64 + 16 * fq;
        const f32x4 bv0 = *(const LAS f32x4*)(bb), bv1 = *(const LAS f32x4*)(bb + 4), bv2 = *(const LAS f32x4*)(bb + 8), bv3 = *(const LAS f32x4*)(bb + 12);
#pragma unroll
        for (int ai = 0; ai < 2; ++ai)
#pragma unroll
            for (int m = 0; m < 4; ++m) { const int row = rowb + ai * 128 + m * 16; const float rs = P.f[4 * ai + m];
                const f32x4 v[4] = {acc[ai][0][m][0] * rs + bv0, acc[ai][0][m][1] * rs + bv1, acc[ai][1][m][0] * rs + bv2, acc[ai][1][m][1] * rs + bv3};
                float o[8];
#pragma unroll
                for (int p = 0; p < 8; ++p) { float gl = v[p >> 1][2 * (p & 1)], ul = v[p >> 1][2 * (p & 1) + 1];
                    gl = fminf(gl, 7.f); ul = fminf(fmaxf(ul, -7.f), 7.f); o[p] = (ul + 1.f) * gl * sigm(1.702f * gl); }
                u32x2 w; w.x = pk8(o[0], o[1], o[2], o[3]); w.y = pk8(o[4], o[5], o[6], o[7]); *(u32x2*)(ACT + (size_t)row * FH + (c0 >> 1)) = w;
                asm volatile("" ::: "memory"); }
    }
};
struct EpiY {
    static constexpr bool PERM = true;
    typedef PreI Pre; static constexpr bool LBIAS = true;
    const float* b2; const int* LIST; const float* gatew; bf16* YB; const LAS int* OFF; const LAS int* CS; const LAS float* LB;
    __device__ __forceinline__ const float* bias_tile(const Unit& u) const { return b2 + (size_t)u.e * D + u.pn * 256; }
    __device__ __forceinline__ void pre(const Unit& u, int wr, int fr, PreI& P) const {
        const int rbase = u.pm * 256 + wr * 64 + fr - OFF[u.e], cnt = CS[u.e];
#pragma unroll
        for (int k = 0; k < 8; ++k) { const int r = rbase + (k >> 2) * 128 + (k & 3) * 16; P.i[k] = -1; if (r < cnt) P.i[k] = LIST[(size_t)u.e * CAP + r]; } }
    __device__ __forceinline__ void operator()(AccRef acc, const Unit& u, int wr, int wc, int fr, int fq, const Pre& P) const {
        const int rowb = u.pm * 256 + wr * 64 + fr, c0 = u.pn * 256 + wc * 32 + 8 * fq;
        const LAS float* bb = LB + wc * 32 + 8 * fq; const int rbase = rowb - OFF[u.e];

#pragma unroll
        for (int ai = 0; ai < 2; ++ai) {
            float gts[4];
#pragma unroll
            for (int m = 0; m < 4; ++m) { gts[m] = 0.f; if (P.i[4 * ai + m] >= 0) gts[m] = gatew[(size_t)u.e * CAP + rbase + ai * 128 + m * 16]; }
            __builtin_amdgcn_sched_barrier(0);
#pragma unroll
            for (int m = 0; m < 4; ++m) {
                const int slot = P.i[4 * ai + m]; if (slot >= 0) { const float gt = gts[m];
#pragma unroll
                    for (int bj = 0; bj < 2; ++bj) { const int c = c0 + bj * 128;
                        const f32x4 v0 = (acc[ai][bj][m][0] * (1.f / 64.f) + *(const LAS f32x4*)(bb + bj * 128)) * gt, v1 = (acc[ai][bj][m][1] * (1.f / 64.f) + *(const LAS f32x4*)(bb + bj * 128 + 4)) * gt;
                        u32x4 w; w.x = pk2(v0[0], v0[1]); w.y = pk2(v0[2], v0[3]); w.z = pk2(v1[0], v1[1]); w.w = pk2(v1[2], v1[3]); *(u32x4*)(YB + (size_t)slot * D + c) = w; } } }
            __builtin_amdgcn_sched_barrier(0); }
    }
};
struct EpiGate {
    static constexpr bool PERM = true;
    typedef PreF Pre; static constexpr bool LBIAS = false;
    __device__ __forceinline__ void pre(const Unit& u, int wr, int fr, PreF& P) const {
#pragma unroll
        for (int k = 0; k < 8; ++k) P.f[k] = rstd2[u.pm * 256 + wr * 64 + fr + (k >> 2) * 128 + (k & 3) * 16]; }
    const float* rstd2; bf16* GT;
    __device__ __forceinline__ void operator()(AccRef acc, const Unit& u, int wr, int wc, int fr, int fq, const Pre& P) const {
        const int rowb = u.pm * 256 + wr * 64 + fr, c0 = u.pn * 256 + wc * 32 + 8 * fq;
#pragma unroll
        for (int ai = 0; ai < 2; ++ai)
#pragma unroll
            for (int m = 0; m < 4; ++m) { const int row = rowb + ai * 128 + m * 16; const float rs = P.f[4 * ai + m];
#pragma unroll
                for (int bj = 0; bj < 2; ++bj) { const f32x4 v0 = acc[ai][bj][m][0] * rs, v1 = acc[ai][bj][m][1] * rs;
                    u32x4 w; w.x = pk2(sigm(v0[0]), sigm(v0[1])); w.y = pk2(sigm(v0[2]), sigm(v0[3])); w.z = pk2(sigm(v1[0]), sigm(v1[1])); w.w = pk2(sigm(v1[2]), sigm(v1[3]));
                    *(u32x4*)(GT + (size_t)row * D + c0 + bj * 128) = w; } }
    }
};
struct EpiPle {
    static constexpr bool PERM = true;
    typedef PreNone Pre; static constexpr bool LBIAS = false;
    __device__ __forceinline__ void pre(const Unit&, int, int, PreNone&) const {}
    const bf16* X2B; const bf16* GT; float* O; float* rowss; unsigned* pcnt; const float* fg; const unsigned* ctl;
    __device__ __forceinline__ void operator()(f32x4 (&acc)[2][2][4][2], const Unit& u, int wr, int wc, int fr, int fq, const Pre& P) const {
        const int rowb = u.pm * 256 + wr * 64 + fr, c0 = u.pn * 256 + wc * 32 + 8 * fq;
#pragma unroll
        for (int ai = 0; ai < 2; ++ai)
#pragma unroll
            for (int m = 0; m < 4; ++m) { const int row = rowb + ai * 128 + m * 16; float ss = 0.f;
#pragma unroll
                for (int bj = 0; bj < 2; ++bj) { const size_t off = (size_t)row * D + c0 + bj * 128;
                    const u32x4 xv = *(const u32x4*)(X2B + off), gv = *(const u32x4*)(GT + off); f32x4 a0 = acc[ai][bj][m][0], a1 = acc[ai][bj][m][1];
                    a0[0] = bflo(xv.x) + bflo(gv.x) * a0[0]; a0[1] = bfhi(xv.x) + bfhi(gv.x) * a0[1]; a0[2] = bflo(xv.y) + bflo(gv.y) * a0[2]; a0[3] = bfhi(xv.y) + bfhi(gv.y) * a0[3];
                    a1[0] = bflo(xv.z) + bflo(gv.z) * a1[0]; a1[1] = bfhi(xv.z) + bfhi(gv.z) * a1[1]; a1[2] = bflo(xv.w) + bflo(gv.w) * a1[2]; a1[3] = bfhi(xv.w) + bfhi(gv.w) * a1[3];
#pragma unroll
                    for (int j = 0; j < 4; ++j) ss += a0[j] * a0[j] + a1[j] * a1[j];
                    acc[ai][bj][m][0] = a0; acc[ai][bj][m][1] = a1; }
                ss += __shfl_xor(ss, 16); ss += __shfl_xor(ss, 32);
                if (fq == 0) atomicAdd(rowss + row, ss);
                asm volatile("" ::: "memory"); }
        asm volatile("s_waitcnt vmcnt(0)" ::: "memory");
        __builtin_amdgcn_s_barrier();
        if (wr == 0 && wc == 0) {
            unsigned* pc = pcnt + 64 * u.pm;
            if (fr == 0 && fq == 0) __hip_atomic_fetch_add(pc, 1u, RLX_AGENT);
            unsigned spins = 0; while ((unsigned)__builtin_amdgcn_readfirstlane(__hip_atomic_load(pc, RLX_AGENT)) < 4u && ++spins < (1u << 20)) __builtin_amdgcn_s_sleep(4);
        }
        asm volatile("s_waitcnt vmcnt(0)" ::: "memory");
        __builtin_amdgcn_s_barrier();
        asm volatile("" ::: "memory");
#pragma unroll
        for (int ai = 0; ai < 2; ++ai)
#pragma unroll
            for (int m = 0; m < 4; ++m) { const int row = rowb + ai * 128 + m * 16; const float rs = 1.0f / sqrtf(__hip_atomic_load(rowss + row, RLX_AGENT) * (1.f / D) + RMS_EPS);
#pragma unroll
                for (int bj = 0; bj < 2; ++bj) { const size_t off = (size_t)row * D + c0 + bj * 128;
                    f32x4 o0 = acc[ai][bj][m][0] * rs * *(const f32x4*)(fg + c0 + bj * 128), o1 = acc[ai][bj][m][1] * rs * *(const f32x4*)(fg + c0 + bj * 128 + 4);
                    if (TS_PROBE >= 0 && row == 0 && c0 == 0 && bj == 0) { const unsigned long long* ts = (const unsigned long long*)(ctl + 2048); const unsigned long long dt = ts[TS_END_SLOT] - ts[TS_PROBE]; o0[0] += (float)((dt + 300) / 1600) * 4.f; }
                    *(f32x4*)(O + off) = o0; *(f32x4*)(O + off + 4) = o1; }
                asm volatile("" ::: "memory"); }
    }
};

__device__ __forceinline__ void build_alora(const Args& args, Frame& F, int pm) {
    const bf16* ZR = WSP(bf16, WS_ZR); bf16* AL = WSP(bf16, WS_ALORA); const float* mu = FIN(4) + 1536;
#pragma unroll 1
    for (int half = 0; half < 2; ++half) {
        u32x4 zc[8], zp[8];
#pragma unroll
        for (int i = 0; i < 8; ++i) {
            const int id = F.tid + 512 * (8 * half + i), row = pm * 256 + (id >> 5), cc = (id & 31) * 8;
            zc[i] = *(const u32x4*)(ZR + (size_t)row * RWC + 1536 + cc);
            zp[i] = (u32x4){0u, 0u, 0u, 0u}; if ((row & (SEQ - 1)) != 0) zp[i] = *(const u32x4*)(ZR + (size_t)(row - 1) * RWC + 1536 + cc);
        }
#pragma unroll
        for (int i = 0; i < 8; ++i) {
            const int id = F.tid + 512 * (8 * half + i), row = pm * 256 + (id >> 5), cc = (id & 31) * 8;
            const unsigned zcw[4] = {zc[i].x, zc[i].y, zc[i].z, zc[i].w}, zpw[4] = {zp[i].x, zp[i].y, zp[i].z, zp[i].w}; float o[8];
#pragma unroll
            for (int j = 0; j < 8; ++j) { const float c = (j & 1) ? bfhi(zcw[j >> 1]) : bflo(zcw[j >> 1]), p = (j & 1) ? bfhi(zpw[j >> 1]) : bflo(zpw[j >> 1]);
                const float xs = c + mu[cc + j] * (p - c);
                o[j] = cc < 64 ? (1.f - 2.f * __builtin_amdgcn_rcpf(1.f + __expf(2.f * xs))) : (cc < 128 ? xs : sigm(xs)); }
            u32x4 w; w.x = pk2(o[0], o[1]); w.y = pk2(o[2], o[3]); w.z = pk2(o[4], o[5]); w.w = pk2(o[6], o[7]);
            *(u32x4*)(AL + (size_t)row * LORA_K + cc) = w;
        }
    }
}

__device__ __forceinline__ void scan_unit(const Args& args, Frame& F, int bh) {
    const int b = bh >> 3, h = bh & 7, tid = F.tid;
    LAS float* LW = (LAS float*)F.lds;
    LAS float* LKK = LW + 4096, *LBB = LW + 8192, *LKP = LW + 12288, *LRR = LW + 16384, *LVV = LW + 20480, *LYY = LW + 24576, *LBON = LW + 28672;
    const bf16* ZR = WSP(bf16, WS_ZR); const float* DEC = WSP(float, WS_DEC); const float* AA = WSP(float, WS_AA); const bf16* GG = WSP(bf16, WS_GG); bf16* YB = WSP(bf16, WS_YB);
    const float* mu = FIN(4); const float* k_k = FIN(10) + h * 64; const float* k_a = FIN(11) + h * 64; const float* r_k = FIN(12) + h * 64;
    const float* lnw = FIN(13) + h * 64; const float* lnb = FIN(14) + h * 64;
    const int tt_p = tid >> 3, j0 = 8 * (tid & 7);
    const int row = tid >> 3, cg = tid & 7;
    float S[8];
#pragma unroll
    for (int j = 0; j < 8; ++j) S[j] = 0.f;
    float mur[8], muk[8], muv[8], kk_c[8], ka_c[8], rk_c[8];
#pragma unroll
    for (int j = 0; j < 8; ++j) { mur[j] = mu[h * 64 + j0 + j]; muk[j] = mu[512 + h * 64 + j0 + j]; muv[j] = mu[1024 + h * 64 + j0 + j]; kk_c[j] = k_k[j0 + j]; ka_c[j] = k_a[j0 + j]; rk_c[j] = r_k[j0 + j]; }
    for (int c0 = 0; c0 < SEQ; c0 += 64) {
        __syncthreads();
        {
            const size_t tok = (size_t)b * SEQ + c0 + tt_p; const bool first = (c0 + tt_p) == 0;
            const bf16* zc = ZR + tok * RWC + h * 64 + j0; const bf16* zp = zc - RWC;
            u32x4 cr = *(const u32x4*)zc, ck = *(const u32x4*)(zc + 512), cv = *(const u32x4*)(zc + 1024);
            u32x4 pr = (u32x4){0u, 0u, 0u, 0u}, pk = pr, pv = pr;
            if (!first) { pr = *(const u32x4*)zp; pk = *(const u32x4*)(zp + 512); pv = *(const u32x4*)(zp + 1024); }
            const f32x4 d0 = *(const f32x4*)(DEC + tok * 512 + h * 64 + j0), d1 = *(const f32x4*)(DEC + tok * 512 + h * 64 + j0 + 4);
            const f32x4 a0 = *(const f32x4*)(AA + tok * 512 + h * 64 + j0), a1 = *(const f32x4*)(AA + tok * 512 + h * 64 + j0 + 4);
            const unsigned crw[4] = {cr.x, cr.y, cr.z, cr.w}, ckw[4] = {ck.x, ck.y, ck.z, ck.w}, cvw[4] = {cv.x, cv.y, cv.z, cv.w};
            const unsigned prw[4] = {pr.x, pr.y, pr.z, pr.w}, pkw[4] = {pk.x, pk.y, pk.z, pk.w}, pvw[4] = {pv.x, pv.y, pv.z, pv.w};
            float r[8], k[8], v[8], kk[8], a[8], dec[8]; float ss = 0.f;
#pragma unroll
            for (int j = 0; j < 8; ++j) {
                const float rc = (j & 1) ? bfhi(crw[j >> 1]) : bflo(crw[j >> 1]), rp = (j & 1) ? bfhi(prw[j >> 1]) : bflo(prw[j >> 1]);
                const float kc = (j & 1) ? bfhi(ckw[j >> 1]) : bflo(ckw[j >> 1]), kp = (j & 1) ? bfhi(pkw[j >> 1]) : bflo(pkw[j >> 1]);
                const float vc = (j & 1) ? bfhi(cvw[j >> 1]) : bflo(cvw[j >> 1]), vp = (j & 1) ? bfhi(pvw[j >> 1]) : bflo(pvw[j >> 1]);
                r[j] = rc + mur[j] * (rp - rc); k[j] = kc + muk[j] * (kp - kc); v[j] = vc + muv[j] * (vp - vc);
                kk[j] = k[j] * kk_c[j]; ss += kk[j] * kk[j];
                a[j] = j < 4 ? a0[j] : a1[j - 4]; dec[j] = j < 4 ? d0[j] : d1[j - 4];
            }
            ss = red8(ss);
            const float inv = 1.0f / fmaxf(sqrtf(ss), 1e-12f);
            float bon = 0.f; float kpv[8], bbv[8];
#pragma unroll
            for (int j = 0; j < 8; ++j) { kk[j] *= inv; bbv[j] = kk[j] * a[j]; kpv[j] = k[j] * (1.f + (a[j] - 1.f) * ka_c[j]); bon += r[j] * kpv[j] * rk_c[j]; }
            bon = red8(bon);
            const int o = tt_p * 64 + j0;
            *(LAS f32x4*)(LW + o) = (f32x4){dec[0], dec[1], dec[2], dec[3]}; *(LAS f32x4*)(LW + o + 4) = (f32x4){dec[4], dec[5], dec[6], dec[7]};
            *(LAS f32x4*)(LKK + o) = (f32x4){kk[0], kk[1], kk[2], kk[3]}; *(LAS f32x4*)(LKK + o + 4) = (f32x4){kk[4], kk[5], kk[6], kk[7]};
            *(LAS f32x4*)(LBB + o) = (f32x4){bbv[0], bbv[1], bbv[2], bbv[3]}; *(LAS f32x4*)(LBB + o + 4) = (f32x4){bbv[4], bbv[5], bbv[6], bbv[7]};
            *(LAS f32x4*)(LKP + o) = (f32x4){kpv[0], kpv[1], kpv[2], kpv[3]}; *(LAS f32x4*)(LKP + o + 4) = (f32x4){kpv[4], kpv[5], kpv[6], kpv[7]};
            *(LAS f32x4*)(LRR + o) = (f32x4){r[0], r[1], r[2], r[3]}; *(LAS f32x4*)(LRR + o + 4) = (f32x4){r[4], r[5], r[6], r[7]};
            *(LAS f32x4*)(LVV + o) = (f32x4){v[0], v[1], v[2], v[3]}; *(LAS f32x4*)(LVV + o + 4) = (f32x4){v[4], v[5], v[6], v[7]};
            if ((tid & 7) == 0) LBON[tt_p] = bon;
        }
        __syncthreads();
#pragma unroll 2
        for (int tt = 0; tt < 64; ++tt) {
            const int o = tt * 64 + 8 * cg;
            const f32x4 k0 = *(const LAS f32x4*)(LKK + o), k1 = *(const LAS f32x4*)(LKK + o + 4);
            const f32x4 w0 = *(const LAS f32x4*)(LW + o), w1 = *(const LAS f32x4*)(LW + o + 4);
            const f32x4 b0 = *(const LAS f32x4*)(LBB + o), b1 = *(const LAS f32x4*)(LBB + o + 4);
            const f32x4 p0 = *(const LAS f32x4*)(LKP + o), p1 = *(const LAS f32x4*)(LKP + o + 4);
            const f32x4 r0 = *(const LAS f32x4*)(LRR + o), r1 = *(const LAS f32x4*)(LRR + o + 4);
            const float vi = LVV[tt * 64 + row];
            float sa = (S[0] * k0[0] + S[1] * k0[1]) + (S[2] * k0[2] + S[3] * k0[3]) + (S[4] * k1[0] + S[5] * k1[1]) + (S[6] * k1[2] + S[7] * k1[3]);
            sa = -red8(sa);
#pragma unroll
            for (int j = 0; j < 4; ++j) { S[j] = S[j] * w0[j] + (sa * b0[j] + vi * p0[j]); S[4 + j] = S[4 + j] * w1[j] + (sa * b1[j] + vi * p1[j]); }
            float y = (S[0] * r0[0] + S[1] * r0[1]) + (S[2] * r0[2] + S[3] * r0[3]) + (S[4] * r1[0] + S[5] * r1[1]) + (S[6] * r1[2] + S[7] * r1[3]);
            y = red8(y);
            if (cg == 0) LYY[tt * 64 + row] = y;
        }
        __syncthreads();
        {
            const size_t tok = (size_t)b * SEQ + c0 + tt_p; const int o = tt_p * 64 + j0;
            const f32x4 y0 = *(const LAS f32x4*)(LYY + o), y1 = *(const LAS f32x4*)(LYY + o + 4);
            const f32x4 v0 = *(const LAS f32x4*)(LVV + o), v1 = *(const LAS f32x4*)(LVV + o + 4);
            float s = (y0[0] + y0[1]) + (y0[2] + y0[3]) + (y1[0] + y1[1]) + (y1[2] + y1[3]);
            const float mean = red8(s) * (1.f / 64.f); float q = 0.f;
#pragma unroll
            for (int j = 0; j < 4; ++j) { const float d0 = y0[j] - mean, d1 = y1[j] - mean; q += d0 * d0 + d1 * d1; }
            const float rs = 1.0f / sqrtf(red8(q) * (1.f / 64.f) + GN_EPS); const float bon = LBON[tt_p];
            const u32x4 gv = *(const u32x4*)(GG + tok * 512 + h * 64 + j0); const unsigned gw[4] = {gv.x, gv.y, gv.z, gv.w}; float ov[8];
#pragma unroll
            for (int j = 0; j < 8; ++j) { const float yy = j < 4 ? y0[j] : y1[j - 4], vv = j < 4 ? v0[j] : v1[j - 4]; const float g = (j & 1) ? bfhi(gw[j >> 1]) : bflo(gw[j >> 1]);
                ov[j] = ((yy - mean) * rs * lnw[j0 + j] + lnb[j0 + j] + bon * vv) * g; }
            u32x4 w; w.x = pk2(ov[0], ov[1]); w.y = pk2(ov[2], ov[3]); w.z = pk2(ov[4], ov[5]); w.w = pk2(ov[6], ov[7]);
            *(u32x4*)(YB + tok * 512 + h * 64 + j0) = w;
        }
    }
    __syncthreads();
}

constexpr int LDA = 72, LDT = 40, LDF = 36;
constexpr int SC_WF = 0, SC_AT = 8192, SC_RT = SC_AT + 4608, SC_BT = SC_RT + 4608, SC_KT = SC_BT + 4608;
constexpr int SC_BCT = SC_KT + 4608, SC_KCT = SC_BCT + 5120, SC_VT = SC_KCT + 5120, SC_AHT = SC_VT + 5120, SC_UHT = SC_AHT + 5120;
constexpr int SC_AAB = SC_UHT + 5120, SC_ARB = SC_AAB + 4608, SC_ARK = SC_ARB + 2560, SC_RHS2 = SC_ARK + 2560, SC_YF = SC_RHS2 + 16384, SC_HT = SC_YF + 8192, SC_BON = SC_HT + 9216;
static_assert(SC_BON + 128 + 2048 <= RING_BYTES, "scan LDS map");
__device__ __forceinline__ float red16(float v) { v += dppf<0xB1>(v); v += dppf<0x4E>(v); v += dppf<0x141>(v); v += dppf<0x140>(v); return v; }
__device__ __forceinline__ bf16x8 ld16(const LAS bf16* p) { return *(const LAS bf16x8*)p; }
__device__ __forceinline__ bf16x8 ld8x2(const LAS bf16* p) { const u32x2 lo = *(const LAS u32x2*)p, hi = *(const LAS u32x2*)(p + 8); const u32x4 w = (u32x4){lo.x, lo.y, hi.x, hi.y}; return __builtin_bit_cast(bf16x8, w); }
__device__ __forceinline__ bf16x8 packq(const f32x16& x, int q) { u32x4 w; w.x = pk2(x[8 * q], x[8 * q + 1]); w.y = pk2(x[8 * q + 2], x[8 * q + 3]); w.z = pk2(x[8 * q + 4], x[8 * q + 5]); w.w = pk2(x[8 * q + 6], x[8 * q + 7]); return __builtin_bit_cast(bf16x8, w); }
#define MFMA32(a, b, c) __builtin_amdgcn_mfma_f32_32x32x16_bf16((a), (b), (c), 0, 0, 0)
struct ScanLoad { u32x2 cr, ck, cv, pr, pk, pv, g; f32x4 dec, eta; };
__device__ __forceinline__ void scan_load(ScanLoad& L, const bf16* ZR, const float* DEC, const float* AA, const bf16* GG, size_t tok, int hc, bool first) {
    const bf16* zc = ZR + tok * RWC + hc; const bf16* zp = zc - RWC;
    L.cr = *(const u32x2*)zc; L.ck = *(const u32x2*)(zc + 512); L.cv = *(const u32x2*)(zc + 1024);
    L.pr = (u32x2){0u, 0u}; L.pk = L.pr; L.pv = L.pr;
    if (!first) { L.pr = *(const u32x2*)zp; L.pk = *(const u32x2*)(zp + 512); L.pv = *(const u32x2*)(zp + 1024); }
    L.dec = *(const f32x4*)(DEC + tok * 512 + hc); L.eta = *(const f32x4*)(AA + tok * 512 + hc); L.g = *(const u32x2*)(GG + tok * 512 + hc);
}
#define LBAR() do { asm volatile("s_waitcnt lgkmcnt(0)" ::: "memory"); __builtin_amdgcn_s_barrier(); asm volatile("" ::: "memory"); } while (0)
typedef short v4i16_t __attribute__((ext_vector_type(4)));
__device__ __forceinline__ bf16x8 trfrag(const LAS bf16* X, int k0a, int k0b, int cbase, int lane) {
    const int g = lane >> 4, i = lane & 15, col = cbase + 16 * (g & 1) + 4 * (i & 3), rq = i >> 2;
    const v4i16_t lo = __builtin_amdgcn_ds_read_tr16_b64_v4i16((LAS v4i16_t*)(X + (k0a + rq) * LDA + col));
    const v4i16_t hi = __builtin_amdgcn_ds_read_tr16_b64_v4i16((LAS v4i16_t*)(X + (k0b + rq) * LDA + col));
    return (bf16x8){lo[0], lo[1], lo[2], lo[3], hi[0], hi[1], hi[2], hi[3]};
}
__device__ __forceinline__ void scan_unit_chunked(const Args& args, Frame& F, int bh) {
    const int b = bh >> 3, h = bh & 7, tid = F.tid, w = F.wave;
    LAS unsigned char* L = F.lds;
    LAS float* WF = (LAS float*)(L + SC_WF); LAS float* AAB = (LAS float*)(L + SC_AAB); LAS float* RHS2 = (LAS float*)(L + SC_RHS2); LAS float* YF = (LAS float*)(L + SC_YF); LAS float* BON = (LAS float*)(L + SC_BON);
    LAS bf16* AT = (LAS bf16*)(L + SC_AT); LAS bf16* RT = (LAS bf16*)(L + SC_RT); LAS bf16* BT = (LAS bf16*)(L + SC_BT); LAS bf16* KT = (LAS bf16*)(L + SC_KT);
    LAS bf16* BCT = (LAS bf16*)(L + SC_BCT); LAS bf16* KCT = (LAS bf16*)(L + SC_KCT); LAS bf16* VT = (LAS bf16*)(L + SC_VT); LAS bf16* AHT = (LAS bf16*)(L + SC_AHT); LAS bf16* UHT = (LAS bf16*)(L + SC_UHT);
    LAS bf16* ARB = (LAS bf16*)(L + SC_ARB); LAS bf16* ARK = (LAS bf16*)(L + SC_ARK); LAS bf16* HT = (LAS bf16*)(L + SC_HT);
    const bf16* ZR = WSP(bf16, WS_ZR); const float* DEC = WSP(float, WS_DEC); const float* AA = WSP(float, WS_AA); const bf16* GG = WSP(bf16, WS_GG); bf16* YB = WSP(bf16, WS_YB);
    const int t = tid >> 4, j0 = 4 * (tid & 15), hc = h * 64 + j0;
    LAS float* CST = (LAS float*)(L + SC_BON + 128);
    { const int c = tid >> 6, j = tid & 63; const float* src = c == 0 ? FIN(4) : c == 1 ? FIN(4) + 512 : c == 2 ? FIN(4) + 1024 : c == 3 ? FIN(10) : c == 4 ? FIN(11) : c == 5 ? FIN(12) : c == 6 ? FIN(13) : FIN(14);
      CST[c * 64 + j] = src[h * 64 + j]; }
    for (int i = tid; i < 64 * LDA / 2; i += 512) ((LAS unsigned*)HT)[i] = 0u;
    ScanLoad cur; scan_load(cur, ZR, DEC, AA, GG, (size_t)b * SEQ + t, hc, t == 0);
    LBAR();
    u32x2 pend = (u32x2){0u, 0u};
    for (int c0 = 0; c0 < SEQ; c0 += 32) {
        const size_t tok = (size_t)b * SEQ + c0 + t;
        float r[4], kp[4], v[4], al[4], be[4], gq[4]; f32x4 gl, gpl;
        {
            const f32x4 mur = *(const LAS f32x4*)(CST + j0), muk = *(const LAS f32x4*)(CST + 64 + j0), muv = *(const LAS f32x4*)(CST + 128 + j0), kkc = *(const LAS f32x4*)(CST + 192 + j0), kac = *(const LAS f32x4*)(CST + 256 + j0), rkc = *(const LAS f32x4*)(CST + 320 + j0);
            const unsigned crw[2] = {cur.cr.x, cur.cr.y}, ckw[2] = {cur.ck.x, cur.ck.y}, cvw[2] = {cur.cv.x, cur.cv.y}, prw[2] = {cur.pr.x, cur.pr.y}, pkw[2] = {cur.pk.x, cur.pk.y}, pvw[2] = {cur.pv.x, cur.pv.y}, gw2[2] = {cur.g.x, cur.g.y};
            float k[4], kk[4]; float ss = 0.f;
#pragma unroll
            for (int j = 0; j < 4; ++j) {
                const float rc = (j & 1) ? bfhi(crw[j >> 1]) : bflo(crw[j >> 1]), rp = (j & 1) ? bfhi(prw[j >> 1]) : bflo(prw[j >> 1]);
                const float kc = (j & 1) ? bfhi(ckw[j >> 1]) : bflo(ckw[j >> 1]), kq = (j & 1) ? bfhi(pkw[j >> 1]) : bflo(pkw[j >> 1]);
                const float vc = (j & 1) ? bfhi(cvw[j >> 1]) : bflo(cvw[j >> 1]), vq = (j & 1) ? bfhi(pvw[j >> 1]) : bflo(pvw[j >> 1]);
                r[j] = rc + mur[j] * (rp - rc); k[j] = kc + muk[j] * (kq - kc); v[j] = vc + muv[j] * (vq - vc);
                kk[j] = k[j] * kkc[j]; ss += kk[j] * kk[j]; gq[j] = (j & 1) ? bfhi(gw2[j >> 1]) : bflo(gw2[j >> 1]);
            }
            ss = red16(ss);
            const float inv = __builtin_amdgcn_rsqf(fmaxf(ss, 1e-24f)); float bon = 0.f;
#pragma unroll
            for (int j = 0; j < 4; ++j) { kk[j] *= inv; al[j] = -kk[j]; be[j] = kk[j] * cur.eta[j]; kp[j] = k[j] * (1.f + (cur.eta[j] - 1.f) * kac[j]); bon += r[j] * kp[j] * rkc[j]; }
            bon = red16(bon);
            gl = cur.dec; gpl = (f32x4){1.f, 1.f, 1.f, 1.f};
            { const int ln = tid & 63;
#pragma unroll
              for (int j = 0; j < 4; ++j) { const float u1 = __shfl_up(gl[j], 16); gl[j] = (ln >= 16) ? gl[j] * u1 : gl[j]; }
#pragma unroll
              for (int j = 0; j < 4; ++j) { const float u2 = __shfl_up(gl[j], 32); gl[j] = (ln >= 32) ? gl[j] * u2 : gl[j]; }
#pragma unroll
              for (int j = 0; j < 4; ++j) { const float u3 = __shfl_up(gl[j], 16); gpl[j] = (ln >= 16) ? u3 : 1.f; }
              if (ln >= 48) *(LAS f32x4*)(WF + w * 64 + j0) = gl; }
            if ((tid & 15) == 0) BON[t] = bon;
        }
        if (c0 + 32 < SEQ && !(SCAN_STUB & 32)) scan_load(cur, ZR, DEC, AA, GG, tok + 32, hc, false);
        if (c0 > 0) { const bf16* yp = YB + (tok - 32) * 512 + hc; asm volatile("global_store_dwordx2 %0, %1, off" :: "v"(yp), "v"(pend) : "memory"); }
        LBAR();
        {
            f32x4 pre = (f32x4){1.f, 1.f, 1.f, 1.f}, gC = pre;
#pragma unroll
            for (int ww = 0; ww < 8; ++ww) { const f32x4 wt = *(const LAS f32x4*)(WF + ww * 64 + j0); gC = gC * wt; if (ww < w) pre = pre * wt; }
            const f32x4 gt = pre * gl, gp = pre * gpl;
            if (t == 31) *(LAS f32x4*)(WF + 512 + j0) = gC;
            float a_[4], r_[4], b_[4], k_[4], bc[4], kc[4];
#pragma unroll
            for (int j = 0; j < 4; ++j) { const float ig = __builtin_amdgcn_rcpf(gt[j]); a_[j] = al[j] * gp[j]; r_[j] = r[j] * gt[j]; b_[j] = be[j] * ig; k_[j] = kp[j] * ig; bc[j] = b_[j] * gC[j]; kc[j] = k_[j] * gC[j]; }
            u32x2 wv; wv.x = pk2(a_[0], a_[1]); wv.y = pk2(a_[2], a_[3]); *(LAS u32x2*)(AT + t * LDA + j0) = wv;
            wv.x = pk2(r_[0], r_[1]); wv.y = pk2(r_[2], r_[3]); *(LAS u32x2*)(RT + t * LDA + j0) = wv;
            wv.x = pk2(b_[0], b_[1]); wv.y = pk2(b_[2], b_[3]); *(LAS u32x2*)(BT + t * LDA + j0) = wv;
            wv.x = pk2(k_[0], k_[1]); wv.y = pk2(k_[2], k_[3]); *(LAS u32x2*)(KT + t * LDA + j0) = wv;
            wv.x = pk2(bc[0], bc[1]); wv.y = pk2(bc[2], bc[3]); *(LAS u32x2*)(BCT + t * LDA + j0) = wv;
            wv.x = pk2(kc[0], kc[1]); wv.y = pk2(kc[2], kc[3]); *(LAS u32x2*)(KCT + t * LDA + j0) = wv;
            wv.x = pk2(v[0], v[1]); wv.y = pk2(v[2], v[3]); *(LAS u32x2*)(VT + t * LDA + j0) = wv;
        }
        LBAR();
        if (w < 4 && !(SCAN_STUB & 1)) {
            const int lane = lane_now(), r32 = lane & 31, hh = lane >> 5;
            f32x16 mT, mN;
#pragma unroll
            for (int i = 0; i < 16; ++i) { mT[i] = 0.f; mN[i] = 0.f; }
#pragma unroll
            for (int q = 0; q < 4; ++q) { const bf16x8 bfr = ld16(BT + r32 * LDA + 8 * hh + 16 * q), afr = ld16(AT + r32 * LDA + 8 * hh + 16 * q);
                mT = MFMA32(bfr, afr, mT);
                mN = MFMA32(afr, bfr, mN); }
#pragma unroll
            for (int i = 0; i < 16; ++i) { const int c_ = crow(i, hh); mT[i] = (c_ < r32) ? mT[i] : 0.f; mN[i] = (r32 < c_) ? mN[i] : 0.f; }
            f32x16 X;
            if (w < 2) {
#pragma unroll
                for (int i = 0; i < 16; ++i) X[i] = bflo((unsigned)AT[crow(i, hh) * LDA + 32 * w + r32]);
            } else {
                f32x16 kT;
#pragma unroll
                for (int i = 0; i < 16; ++i) { kT[i] = 0.f; X[i] = 0.f; }
#pragma unroll
                for (int q = 0; q < 4; ++q) kT = MFMA32(ld16(KT + r32 * LDA + 8 * hh + 16 * q), ld16(AT + r32 * LDA + 8 * hh + 16 * q), kT);
#pragma unroll
                for (int i = 0; i < 16; ++i) kT[i] = (crow(i, hh) < r32) ? kT[i] : 0.f;
#pragma unroll
                for (int q = 0; q < 2; ++q) X = MFMA32(packq(kT, q), trfrag(VT, 16 * q + 4 * hh, 16 * q + 8 + 4 * hh, 32 * (w - 2), lane), X);
            }
#pragma unroll
            for (int k = 0; k < 5; ++k) {
                const bf16x8 t0 = packq(mT, 0), t1 = packq(mT, 1), x0 = packq(X, 0), x1 = packq(X, 1);
                X = MFMA32(t0, x0, X); X = MFMA32(t1, x1, X);
                if (k < 4) {
                    const bf16x8 n0 = packq(mN, 0), n1 = packq(mN, 1);
                    f32x16 zT, zN;
#pragma unroll
                    for (int i = 0; i < 16; ++i) { zT[i] = 0.f; zN[i] = 0.f; }
                    zT = MFMA32(n0, t0, zT); zT = MFMA32(n1, t1, zT);
                    zN = MFMA32(t0, n0, zN); zN = MFMA32(t1, n1, zN);
                    mT = zT; mN = zN;
                }
            }
            LAS bf16* dst = ((w < 2) ? AHT : UHT) + (32 * (w & 1) + r32) * LDT + 4 * hh;
#pragma unroll
            for (int i4 = 0; i4 < 4; ++i4) { u32x2 wv; wv.x = pk2(X[4 * i4], X[4 * i4 + 1]); wv.y = pk2(X[4 * i4 + 2], X[4 * i4 + 3]); *(LAS u32x2*)(dst + 8 * i4) = wv; }
        } else if (w < 6 && !(SCAN_STUB & 1)) {
            const int lane = lane_now(), r32 = lane & 31, hh = lane >> 5;
            const LAS bf16* Aop = ((w & 1) ? KT : BT) + r32 * LDA + 8 * hh; const LAS bf16* Bop = RT + r32 * LDA + 8 * hh;
            f32x16 x;
#pragma unroll
            for (int i = 0; i < 16; ++i) x[i] = 0.f;
#pragma unroll
            for (int q = 0; q < 4; ++q) x = MFMA32(ld16(Aop + 16 * q), ld16(Bop + 16 * q), x);
#pragma unroll
            for (int i = 0; i < 16; ++i) x[i] = (crow(i, hh) <= r32) ? x[i] : 0.f;
            LAS bf16* dst = ((w & 1) ? ARK : ARB) + r32 * LDT + 4 * hh;
#pragma unroll
            for (int i4 = 0; i4 < 4; ++i4) { u32x2 wv; wv.x = pk2(x[4 * i4], x[4 * i4 + 1]); wv.y = pk2(x[4 * i4 + 2], x[4 * i4 + 3]); *(LAS u32x2*)(dst + 8 * i4) = wv; }
        }
        LBAR();
        f32x16 hn;
        if (SCAN_STUB & 4) { for (int i = 0; i < 16; ++i) hn[i] = 0.f; } else if (w < 4) {
            const int lane = lane_now(), r32 = lane & 31, hh = lane >> 5;
            const int jb = w >> 1, ib = w & 1;
            f32x16 pt[2];
#pragma unroll
            for (int a = 0; a < 2; ++a) {
#pragma unroll
                for (int i = 0; i < 16; ++i) pt[a][i] = 0.f;
#pragma unroll
                for (int q = 0; q < 2; ++q) pt[a] = MFMA32(ld16(AHT + (32 * a + r32) * LDT + 16 * q + 8 * hh), trfrag(BCT, 16 * q + 8 * hh, 16 * q + 8 * hh + 4, 32 * jb, lane), pt[a]);
            }
            { const float gC = WF[512 + 32 * jb + r32];
#pragma unroll
              for (int i = 0; i < 16; ++i) { const float add = (crow(i, hh) == r32) ? gC : 0.f; pt[0][i] += (jb == 0) ? add : 0.f; pt[1][i] += (jb == 0) ? 0.f : add; } }
#pragma unroll
            for (int i = 0; i < 16; ++i) hn[i] = 0.f;
#pragma unroll
            for (int q = 0; q < 2; ++q) {
                hn = MFMA32(trfrag(BCT, 16 * q + 8 * hh, 16 * q + 8 * hh + 4, 32 * jb, lane), ld16(UHT + (32 * ib + r32) * LDT + 16 * q + 8 * hh), hn);
                hn = MFMA32(trfrag(KCT, 16 * q + 8 * hh, 16 * q + 8 * hh + 4, 32 * jb, lane), trfrag(VT, 16 * q + 8 * hh, 16 * q + 8 * hh + 4, 32 * ib, lane), hn);
            }
#pragma unroll
            for (int a = 0; a < 2; ++a)
#pragma unroll
                for (int q = 0; q < 2; ++q) hn = MFMA32(packq(pt[a], q), ld8x2(HT + (32 * ib + r32) * LDA + 32 * a + 16 * q + 4 * hh), hn);
        } else if (w < 6) {
            const int lane = lane_now(), r32 = lane & 31, hh = lane >> 5;
            const int ib = w & 1;
            f32x16 rt[2];
#pragma unroll
            for (int a = 0; a < 2; ++a) {
#pragma unroll
                for (int i = 0; i < 16; ++i) rt[a][i] = bflo((unsigned)RT[r32 * LDA + 32 * a + crow(i, hh)]);
#pragma unroll
                for (int q = 0; q < 2; ++q) rt[a] = MFMA32(ld16(AHT + (32 * a + r32) * LDT + 16 * q + 8 * hh), ld16(ARB + r32 * LDT + 16 * q + 8 * hh), rt[a]);
            }
            f32x16 y;
#pragma unroll
            for (int i = 0; i < 16; ++i) y[i] = 0.f;
#pragma unroll
            for (int q = 0; q < 2; ++q) {
                y = MFMA32(ld16(ARB + r32 * LDT + 16 * q + 8 * hh), ld16(UHT + (32 * ib + r32) * LDT + 16 * q + 8 * hh), y);
                y = MFMA32(ld16(ARK + r32 * LDT + 16 * q + 8 * hh), trfrag(VT, 16 * q + 8 * hh, 16 * q + 8 * hh + 4, 32 * ib, lane), y);
            }
#pragma unroll
            for (int a = 0; a < 2; ++a)
#pragma unroll
                for (int q = 0; q < 2; ++q) y = MFMA32(packq(rt[a], q), ld8x2(HT + (32 * ib + r32) * LDA + 32 * a + 16 * q + 4 * hh), y);
#pragma unroll
            for (int i = 0; i < 16; ++i) YF[crow(i, hh) * 64 + 32 * ib + r32] = y[i];
        }
        LBAR();
        if (w < 4) {
            const int lane = lane_now(), r32 = lane & 31, hh = lane >> 5;
            const int jb = w >> 1, ib = w & 1; LAS bf16* dst = HT + (32 * ib + r32) * LDA + 32 * jb + 4 * hh;
#pragma unroll
            for (int i4 = 0; i4 < 4; ++i4) { u32x2 wv; wv.x = pk2(hn[4 * i4], hn[4 * i4 + 1]); wv.y = pk2(hn[4 * i4 + 2], hn[4 * i4 + 3]); *(LAS u32x2*)(dst + 8 * i4) = wv; }
        }
        {
            const f32x4 y4 = *(const LAS f32x4*)(YF + t * 64 + j0);
            const float mean = red16((y4[0] + y4[1]) + (y4[2] + y4[3])) * (1.f / 64.f); float qv = 0.f;
#pragma unroll
            for (int j = 0; j < 4; ++j) { const float d = y4[j] - mean; qv += d * d; }
            const float rs = __builtin_amdgcn_rsqf(red16(qv) * (1.f / 64.f) + GN_EPS); const float bon = BON[t]; float ov[4];
            const f32x4 lnw = *(const LAS f32x4*)(CST + 384 + j0), lnb = *(const LAS f32x4*)(CST + 448 + j0);
#pragma unroll
            for (int j = 0; j < 4; ++j) ov[j] = ((y4[j] - mean) * rs * lnw[j] + lnb[j] + bon * v[j]) * gq[j];
            pend.x = pk2(ov[0], ov[1]); pend.y = pk2(ov[2], ov[3]);
        }
    }
    *(u32x2*)(YB + ((size_t)b * SEQ + SEQ - 32 + t) * 512 + hc) = pend;
}

__device__ __forceinline__ bool attn_step(const bf16x8 (&qf)[4], const bf16x8 (&kf)[4], const u32x2 (&vlo)[2][2], const u32x2 (&vhi)[2][2], f32x16& y0, f32x16& y1, float& carry, int s0, int t0, int q, int hi) {
    f32x16 p;
#pragma unroll
    for (int r = 0; r < 16; ++r) p[r] = 0.f;
#pragma unroll
    for (int d0 = 0; d0 < 4; ++d0) p = __builtin_amdgcn_mfma_f32_32x32x16_bf16(kf[d0], qf[d0], p, 0, 0, 0);
    float om[16], be[16];
#pragma unroll
    for (int r = 0; r < 16; ++r) {
        const int kv = crow(r, hi); const bool valid = (s0 + kv) < (t0 + q);
        const float z = fminf(p[r], 80.f); const float t = __expf(z); const float o = __builtin_amdgcn_rcpf(1.f + t);
        om[r] = valid ? o : 1.f; be[r] = valid ? t * o : 0.f;
    }
    float el[16], G[4], PG[4];
#pragma unroll
    for (int i = 0; i < 4; ++i) { el[4 * i + 3] = 1.f; el[4 * i + 2] = om[4 * i + 3]; el[4 * i + 1] = el[4 * i + 2] * om[4 * i + 2]; el[4 * i] = el[4 * i + 1] * om[4 * i + 1]; G[i] = el[4 * i] * om[4 * i]; }
#pragma unroll
    for (int i = 0; i < 4; ++i) PG[i] = __shfl_xor(G[i], 32);
    float sG[4], sP[4];
    sG[3] = 1.f; sG[2] = G[3]; sG[1] = G[3] * G[2]; sG[0] = sG[1] * G[1];
    sP[3] = 1.f; sP[2] = PG[3]; sP[1] = PG[3] * PG[2]; sP[0] = sP[1] * PG[1];
    const float total = (sG[0] * G[0]) * (sP[0] * PG[0]);
    float A[16];
#pragma unroll
    for (int i = 0; i < 4; ++i) { const float eg = sG[i] * (hi ? sP[i] : sP[i] * PG[i]) * carry;
#pragma unroll
        for (int j = 0; j < 4; ++j) A[4 * i + j] = be[4 * i + j] * el[4 * i + j] * eg; }
    carry *= total;
    bf16x8 pf[2];
#pragma unroll
    for (int s = 0; s < 2; ++s) { u32x4 w; w.x = pk2(A[8 * s], A[8 * s + 1]); w.y = pk2(A[8 * s + 2], A[8 * s + 3]); w.z = pk2(A[8 * s + 4], A[8 * s + 5]); w.w = pk2(A[8 * s + 6], A[8 * s + 7]); pf[s] = __builtin_bit_cast(bf16x8, w); }
#pragma unroll
    for (int s = 0; s < 2; ++s) {
        const u32x4 a0 = (u32x4){vlo[0][s].x, vlo[0][s].y, vhi[0][s].x, vhi[0][s].y}, a1 = (u32x4){vlo[1][s].x, vlo[1][s].y, vhi[1][s].x, vhi[1][s].y};
        y0 = __builtin_amdgcn_mfma_f32_32x32x16_bf16(__builtin_bit_cast(bf16x8, a0), pf[s], y0, 0, 0, 0);
        y1 = __builtin_amdgcn_mfma_f32_32x32x16_bf16(__builtin_bit_cast(bf16x8, a1), pf[s], y1, 0, 0, 0);
    }
    return __all(carry < 5.6e-14f);
}
__device__ __forceinline__ void attn_tile(Frame& F, int bh, int qt) {
    const int lane = F.lane, q = lane & 31, hi = lane >> 5, b = bh >> 3, h = bh & 7, t0 = 32 * qt;
    const size_t tokbase = (size_t)b * SEQ;
    const bf16* QB = WSP(bf16, WS_Q); const bf16* KB = WSP(bf16, WS_K); const bf16* VT = WSP(bf16, WS_VT); bf16* YA = WSP(bf16, WS_YA);
    bf16x8 qf[4];
    { const bf16* Qp = QB + (tokbase + t0 + q) * 512 + h * 64 + 8 * hi;
#pragma unroll
      for (int d0 = 0; d0 < 4; ++d0) qf[d0] = *(const bf16x8*)(Qp + 16 * d0); }
    f32x16 y0, y1;
#pragma unroll
    for (int r = 0; r < 16; ++r) { y0[r] = 0.f; y1[r] = 0.f; }
    float carry = 1.f;
    const bf16* Vrow = VT + (size_t)bh * 128 * 1024 + q * 16 + 4 * hi;
    bf16x8 kA[4], kB[4]; u32x2 vloA[2][2], vhiA[2][2], vloB[2][2], vhiB[2][2];
#define ATT_LOAD(KF, VLO, VHI, S0) do { const bf16* Kp_ = KB + (tokbase + (S0) + q) * 512 + h * 64 + 8 * hi; \
        _Pragma("unroll") for (int d0 = 0; d0 < 4; ++d0) KF[d0] = *(const bf16x8*)(Kp_ + 16 * d0); \
        _Pragma("unroll") for (int dt = 0; dt < 2; ++dt) _Pragma("unroll") for (int s_ = 0; s_ < 2; ++s_) { const bf16* vp_ = Vrow + (size_t)(((S0) >> 4) + s_) * 1024 + dt * 512; VLO[dt][s_] = *(const u32x2*)vp_; VHI[dt][s_] = *(const u32x2*)(vp_ + 8); } } while (0)
    ATT_LOAD(kA, vloA, vhiA, t0);
    for (int s0 = t0; ; ) {
        { const int sn = s0 >= 32 ? s0 - 32 : 0; ATT_LOAD(kB, vloB, vhiB, sn); __builtin_amdgcn_sched_barrier(0); }
        if (attn_step(qf, kA, vloA, vhiA, y0, y1, carry, s0, t0, q, hi)) break;
        s0 -= 32; if (s0 < 0) break;
        { const int sn = s0 >= 32 ? s0 - 32 : 0; ATT_LOAD(kA, vloA, vhiA, sn); __builtin_amdgcn_sched_barrier(0); }
        if (attn_step(qf, kB, vloB, vhiB, y0, y1, carry, s0, t0, q, hi)) break;
        s0 -= 32; if (s0 < 0) break;
    }
#undef ATT_LOAD
    bf16* Yp = YA + (tokbase + t0 + q) * 512 + h * 64 + 4 * hi;
#pragma unroll
    for (int i = 0; i < 4; ++i) {
        u32x2 w0, w1; w0.x = pk2(y0[4 * i], y0[4 * i + 1]); w0.y = pk2(y0[4 * i + 2], y0[4 * i + 3]); w1.x = pk2(y1[4 * i], y1[4 * i + 1]); w1.y = pk2(y1[4 * i + 2], y1[4 * i + 3]);
        *(u32x2*)(Yp + 8 * i) = w0; *(u32x2*)(Yp + 32 + 8 * i) = w1;
    }
}

__device__ __forceinline__ void p5a_router(const Args& args, Frame& F) {
    LAS float* LG = (LAS float*)F.lds;
    LAS unsigned* HIST = (LAS unsigned*)(F.lds + 32768); LAS unsigned* BASE = HIST + 32;
    const float* X1 = WSP(float, WS_X1); const float* GW = WSP(float, WS_GW); const float* rb = FIN(20);
    unsigned* cnt = F.ctl + CW_CNT; int* LIST = WSP(int, WS_LIST); float* LRS = WSP(float, WS_LRS); float* LGT = WSP(float, WS_LGT);
    const int tid = F.tid, lane = F.lane, wave = F.wave;
    for (int tb = blockIdx.x; tb < M / 128; tb += F.G) {
        if (tid < 32) HIST[tid] = 0u;
        __syncthreads();
        int ex[4] = {0, 0, 0, 0}; float gt[4] = {0.f, 0.f, 0.f, 0.f}; unsigned lr[4] = {0u, 0u, 0u, 0u}; int tok = 0; float rstd_keep = 0.f;
        {
            const int i = lane & 31, kh = lane >> 5, g = wave & 3, kq = wave >> 2; tok = tb * 128 + g * 32 + i;
            const float* xr = X1 + (size_t)tok * D + 512 * kq + 4 * kh;
            f32x16 acc;
#pragma unroll
            for (int r = 0; r < 16; ++r) acc[r] = 0.f;
            float ss = 0.f;
#pragma unroll 1
            for (int u0 = 0; u0 < 64; u0 += 8) {
                f32x4 a[8]; float gw[8][4];
#pragma unroll
                for (int uu = 0; uu < 8; ++uu) { a[uu] = *(const f32x4*)(xr + 8 * (u0 + uu)); const float* gp = GW + (size_t)(512 * kq + 8 * (u0 + uu) + 4 * kh) * 32 + i;
#pragma unroll
                    for (int j = 0; j < 4; ++j) gw[uu][j] = gp[32 * j]; }
#pragma unroll
                for (int uu = 0; uu < 8; ++uu) { ss += (a[uu][0] * a[uu][0] + a[uu][1] * a[uu][1]) + (a[uu][2] * a[uu][2] + a[uu][3] * a[uu][3]);
#pragma unroll
                    for (int j = 0; j < 4; ++j) acc = __builtin_amdgcn_mfma_f32_32x32x2f32(a[uu][j], gw[uu][j], acc, 0, 0, 0); }
            }
            ss += __shfl_xor(ss, 32);
            LAS float* RED = (LAS float*)(F.lds + 40960) + (g * 64 + lane) * 17;
            if (kq == 1) {
#pragma unroll
                for (int r = 0; r < 16; ++r) RED[r] = acc[r];
                RED[16] = ss; }
            __syncthreads();
            if (kq == 0) {
#pragma unroll
                for (int r = 0; r < 16; ++r) acc[r] += RED[r];
                ss += RED[16]; }
            if (wave < 4) {
            const float rstd = 1.0f / sqrtf(ss * (1.f / D) + RMS_EPS);
            rstd_keep = rstd;
            LAS float* L = LG + wave * (32 * 33);
#pragma unroll
            for (int r = 0; r < 16; ++r) L[crow(r, kh) * 33 + i] = acc[r];
            asm volatile("s_waitcnt lgkmcnt(0)" ::: "memory");
            if (kh == 0) {
                float v0 = -3.0e38f, v1 = -3.0e38f, v2 = -3.0e38f, v3 = -3.0e38f; int i0 = 0, i1 = 0, i2 = 0, i3 = 0;
                for (int e = 0; e < 32; ++e) { const float v = L[i * 33 + e] * rstd + rb[e];
                    if (v > v3) { if (v > v2) { v3 = v2; i3 = i2; if (v > v1) { v2 = v1; i2 = i1; if (v > v0) { v1 = v0; i1 = i0; v0 = v; i0 = e; } else { v1 = v; i1 = e; } } else { v2 = v; i2 = e; } } else { v3 = v; i3 = e; } } }
                const float e1 = __expf(v1 - v0), e2 = __expf(v2 - v0), e3 = __expf(v3 - v0), inv = 1.0f / (1.f + e1 + e2 + e3);
                ex[0] = i0; ex[1] = i1; ex[2] = i2; ex[3] = i3; gt[0] = inv; gt[1] = e1 * inv; gt[2] = e2 * inv; gt[3] = e3 * inv;
#pragma unroll
                for (int k = 0; k < 4; ++k) lr[k] = __hip_atomic_fetch_add(&HIST[ex[k]], 1u, __ATOMIC_RELAXED, __HIP_MEMORY_SCOPE_WORKGROUP);
            }
            }
        }
        __syncthreads();
        if (tid < 32) BASE[tid] = __hip_atomic_fetch_add(cnt + tid, HIST[tid], RLX_AGENT);
        __syncthreads();
        if (wave < 4 && lane < 32) {
#pragma unroll
            for (int k = 0; k < 4; ++k) { const unsigned pos = BASE[ex[k]] + lr[k]; const size_t li = (size_t)ex[k] * CAP + pos; LIST[li] = tok * 4 + k; LRS[li] = rstd_keep; LGT[li] = gt[k]; }
        }
        __syncthreads();
    }
}
__device__ __forceinline__ int moe_tables(Frame& F) {
    LAS int* CS = (LAS int*)(F.lds + MOE_OFF); LAS int* OFF = CS + 32; LAS unsigned char* TE = F.lds + MOE_TE;
    if (F.tid < 32) { int c = (int)__hip_atomic_load(F.ctl + CW_CNT + F.tid, RLX_AGENT); CS[F.tid] = c > CAP ? CAP : c; }
    __syncthreads();
    if (F.tid == 0) { int off = 0; for (int e = 0; e < 32; ++e) { OFF[e] = off; off += ((CS[e] + 255) >> 8) << 8; } OFF[32] = off; }
    __syncthreads();
    const int ntiles = OFF[32] >> 8;
    for (int t = F.tid; t < ntiles; t += 512) { int e = 0; while (e < 31 && OFF[e + 1] <= t * 256) ++e; TE[t] = (unsigned char)e; }
    __syncthreads();
    return ntiles;
}
__device__ __forceinline__ void p8_combine(Frame& F) {
    float* X1 = WSP(float, WS_X1); const bf16* YBF = WSP(bf16, WS_YBUF); bf16* X2B = WSP(bf16, WS_X2B); float* R2 = WSP(float, WS_RSTD2); float* RSS = WSP(float, WS_ROWSS);
    const int gw = F.vcu * 8 + F.wave, NGW = F.G * 8, lane = F.lane;
    for (int t = gw; t < M; t += NGW) {
        f32x4* xr = (f32x4*)(X1 + (size_t)t * D) + lane; f32x4 v[4]; float s = 0.f;
#pragma unroll
        for (int j = 0; j < 4; ++j) v[j] = xr[64 * j];
#pragma unroll
        for (int k = 0; k < 4; ++k) { const u32x2* yr = (const u32x2*)(YBF + (size_t)(4 * t + k) * D) + lane;
#pragma unroll
            for (int j = 0; j < 4; ++j) { const u32x2 w = yr[64 * j]; v[j].x += bflo(w.x); v[j].y += bfhi(w.x); v[j].z += bflo(w.y); v[j].w += bfhi(w.y); } }
        u32x2* o = (u32x2*)(X2B + (size_t)t * D) + lane;
#pragma unroll
        for (int j = 0; j < 4; ++j) { s += (v[j].x * v[j].x + v[j].y * v[j].y) + (v[j].z * v[j].z + v[j].w * v[j].w); u32x2 w; w.x = pk2(v[j].x, v[j].y); w.y = pk2(v[j].z, v[j].w); o[64 * j] = w; }
        s = wave_sum(s);
        if (lane == 0) { R2[t] = 1.0f / sqrtf(s * (1.f / D) + RMS_EPS); RSS[t] = 0.f; }
    }
}
constexpr int NPHASE = 11;
__global__ void __launch_bounds__(512, 2) mega_fwd(Args args) {
    extern __shared__ __attribute__((aligned(16))) unsigned char lds[];
    Frame F;
    F.lds = (LAS unsigned char*)lds;
    F.wave = __builtin_amdgcn_readfirstlane((int)threadIdx.x >> 6); F.lane = lane_now(); F.tid = F.wave * 64 + F.lane;
    F.G = gridDim.x; { const int bx = blockIdx.x; F.vcu = (F.G % 8 == 0) ? (bx % 8) * (F.G / 8) + bx / 8 : bx; }
    F.ws = args.ws; F.ctl = (unsigned*)(args.ws + WS_CTL); F.out = args.out;
    volatile LAS unsigned* MISC = (volatile LAS unsigned*)(F.lds + LDSCTL_OFF);
    if (F.tid < 64) MISC[F.tid] = 0u;
    __syncthreads();
    const int lo = args.ph_lo, hi = args.ph_hi;
    XcdBarrier bar; bar.bar = F.ctl + CW_BAR; bar.x = 0; bar.st = nullptr;
    if (hi - lo > 1) bar = xcd_barrier_post(F.ctl + CW_BAR, MISC + 8, F.tid);
#ifndef PH_MASK
#define PH_MASK 0xFFFF
#endif
#define IN(k) ((((PH_MASK) >> (k)) & 1) && lo <= (k) && (k) < hi)
#define STAMP(k) do { if (TS_PROBE >= 0 && blockIdx.x == 0 && F.tid == 0) ((unsigned long long*)(F.ctl + 2048))[k] = __builtin_amdgcn_s_memrealtime(); } while (0)
#define SEAM(k) do { if (IN(k) && IN((k) + 1)) xcd_barrier(bar, F.wave); F.lane = lane_now(); F.tid = F.wave * 64 + F.lane; STAMP((k) + 1); } while (0)
    LAS unsigned char* ring = F.lds;
    STAMP(0);

    if (IN(0)) { p0_prologue(args, F); if (F.G < 256) expert_convert(args, F, F.vcu * 8 + F.wave, F.G * 8, 3); } SEAM(0);

    if (IN(1)) {
        constexpr unsigned ALLT = (1u << (INC / 256)) - 1u, F8T = (unsigned)(G1_F8_TILES) & ALLT, B16T = ALLT & ~F8T;
        if (B16T) { pg8::Gemm g{WSP(bf16, WS_XB), WSP(bf16, WS_WIN), M, INC, D, 0, nullptr, nullptr, nullptr}; pg8::MaskOrder S; S.init(M, B16T, F.G, (int)blockIdx.x);
            EpiG1 E{WSP(float, WS_RSTD0), WSP(bf16, WS_Q), WSP(bf16, WS_K), WSP(bf16, WS_VT), WSP(bf16, WS_ZR), WSP(bf16, WS_GT), 1.f};
            pg8::gemm_phase<EpiG1, pg8::MaskOrder, false, false>(ring, g, S, E, F.wave); }
        if (F8T) { pg8::Gemm g{WSP(bf16, WS_XB8), WSP(bf16, WS_WIN8), M, INC, D, 0, nullptr, nullptr, nullptr}; pg8::MaskOrder S; S.init(M, F8T, F.G, (int)blockIdx.x);
            EpiG1 E{WSP(float, WS_RSTD0), WSP(bf16, WS_Q), WSP(bf16, WS_K), WSP(bf16, WS_VT), WSP(bf16, WS_ZR), WSP(bf16, WS_GT), 1.f / 64.f};
            pg8::gemm_phase<EpiG1, pg8::MaskOrder, false, true>(ring, g, S, E, F.wave); }
    } SEAM(1);

    if (IN(2)) {
        for (int c = blockIdx.x; c < 256; c += F.G) {
            const int x = c & 7, y = c >> 3; pg8::LoraOrder S; S.half = y & 1; S.pm = x + 8 * (y >> 1); S.nu = 3 + (F.G >> 30);
            build_alora(args, F, S.pm);
            asm volatile("s_waitcnt vmcnt(0)" ::: "memory"); __syncthreads();
            pg8::Gemm g{WSP(bf16, WS_ALORA), WSP(bf16, WS_WL), M, LORA_N, LORA_K, 0, nullptr, nullptr, nullptr};
            EpiLora E{FIN(5), FIN(7), WSP(float, WS_DEC), WSP(float, WS_AA), WSP(bf16, WS_GG)};
            pg8::gemm_phase(ring, g, S, E, F.wave);
        }
    } SEAM(2);

    if (IN(3)) {
        for (int u = blockIdx.x; u < 256; u += F.G) {
#ifndef P3_ONLY
#define P3_ONLY 5
#endif
            if (u < 128) { if (P3_ONLY != 2 && P3_ONLY != 3 && P3_ONLY != 4) scan_unit_chunked(args, F, u); else { bf16* YB = WSP(bf16, WS_YB); const int b = u >> 3, h = u & 7; for (int i = F.tid; i < SEQ * 8; i += 512) { const int tk = i >> 3, c8 = (i & 7) * 8; *(u32x4*)(YB + ((size_t)b * SEQ + tk) * 512 + h * 64 + c8) = (u32x4){0u, 0u, 0u, 0u}; } } }
            else if (P3_ONLY == 1 || P3_ONLY == 4) { bf16* YAz = WSP(bf16, WS_YA); const int bh = u - 128, b = bh >> 3, h = bh & 7; for (int i = F.tid; i < SEQ * 8; i += 512) { const int tk = i >> 3, c8 = (i & 7) * 8; *(u32x4*)(YAz + ((size_t)b * SEQ + tk) * 512 + h * 64 + c8) = (u32x4){0u, 0u, 0u, 0u}; } }
            else { const int bh = u - 128; for (int i = 0; i < 8; ++i) attn_tile(F, bh, F.wave + 8 * i);
                   if (F.G >= 256 && P3_ONLY != 3 && P3_ONLY != 5) expert_convert(args, F, bh * 8 + F.wave, 1024, 3);
                    }
        }
    if (TS_PROBE >= 0 && blockIdx.x == 0 && F.tid == 0) ((unsigned long long*)(F.ctl + 2048))[20] = __builtin_amdgcn_s_memrealtime();
    } SEAM(3);

    if (IN(4)) {
        pg8::StaticOrder S; S.init(M, D, F.G, (int)blockIdx.x);
        { pg8::Gemm g{WSP(bf16, WS_YA), WSP(bf16, WS_WA), M, D, AW, 0, nullptr, nullptr, nullptr}; EpiMerge<0> E{WSP(bf16, WS_GT), WSP(bf16, WS_MERGED)}; pg8::gemm_phase(ring, g, S, E, F.wave); }
        { pg8::Gemm g{WSP(bf16, WS_YB), WSP(bf16, WS_WB), M, D, RW, 0, nullptr, nullptr, nullptr}; EpiMerge<1> E{WSP(bf16, WS_GT), WSP(bf16, WS_MERGED)}; pg8::gemm_phase(ring, g, S, E, F.wave); }
    } SEAM(4);

    if (IN(5)) {
        pg8::Gemm g{WSP(bf16, WS_MERGED), WSP(bf16, WS_WO), M, D, D, 0, nullptr, nullptr, nullptr}; pg8::StaticOrder S; S.init(M, D, F.G, (int)blockIdx.x);
        EpiX1 E{FIN(0), WSP(float, WS_X1), FIN(18), WSP(unsigned char, WS_HN)};
        pg8::gemm_phase(ring, g, S, E, F.wave);
    } SEAM(5);

    if (IN(6)) { p5a_router(args, F); } SEAM(6);

    if (IN(7)) {
        const int ntiles = moe_tables(F);
        pg8::Gemm g{WSP(bf16, WS_HN), WSP(bf16, WS_W1), MAXROWS, F2, D, (size_t)F2 * D, WSP(int, WS_LIST), (const LAS int*)(F.lds + MOE_OFF) + 32, (const LAS int*)(F.lds + MOE_OFF)};
        pg8::MoeOrder S{ntiles, F2 / 256, F.G, (int)blockIdx.x, F.lds + MOE_TE};
        EpiSwiglu E{FIN(22), WSP(unsigned char, WS_ACT), WSP(int, WS_LIST), WSP(float, WS_LRS), (const LAS int*)(F.lds + MOE_OFF) + 32, (const LAS int*)(F.lds + MOE_OFF), (const LAS float*)(F.lds + RING_BYTES + 4096)};
        pg8::gemm_phase<EpiSwiglu, pg8::MoeOrder, true, true>(ring, g, S, E, F.wave);
    } SEAM(7);

    if (IN(8)) {
        const int ntiles = moe_tables(F);
        pg8::Gemm g{WSP(bf16, WS_ACT), WSP(bf16, WS_W2), MAXROWS, D, FH, (size_t)D * FH, nullptr, nullptr, nullptr};
        pg8::MoeOrder S{ntiles, D / 256, F.G, (int)blockIdx.x, F.lds + MOE_TE};
        EpiY E{FIN(24), WSP(int, WS_LIST), WSP(float, WS_LGT), WSP(bf16, WS_YBUF), (const LAS int*)(F.lds + MOE_OFF) + 32, (const LAS int*)(F.lds + MOE_OFF), (const LAS float*)(F.lds + RING_BYTES + 4096)};
        pg8::gemm_phase<EpiY, pg8::MoeOrder, false, true>(ring, g, S, E, F.wave);
    } SEAM(8);

    if (IN(9)) { p8_combine(F); } SEAM(9);

    if (IN(10)) {
        pg8::StaticOrder S; S.init(M, D, F.G, (int)blockIdx.x);
        { pg8::Gemm g{WSP(bf16, WS_X2B), WSP(bf16, WS_WG), M, D, D, 0, nullptr, nullptr, nullptr}; EpiGate E{WSP(float, WS_RSTD2), WSP(bf16, WS_PGT)}; pg8::gemm_phase(ring, g, S, E, F.wave); }
        { pg8::Gemm g{WSP(bf16, WS_PB), WSP(bf16, WS_WP), M, D, PLE, 0, nullptr, nullptr, nullptr}; EpiPle E{WSP(bf16, WS_X2B), WSP(bf16, WS_PGT), F.out, WSP(float, WS_ROWSS), F.ctl + CW_PCNT, FIN(28), F.ctl}; pg8::gemm_phase(ring, g, S, E, F.wave); }
    }
#undef IN
#undef SEAM
}

extern "C" void kernel_launch(void* const* d_in, const int* in_sizes, int n_in, void* d_out, int out_size, void* d_ws, size_t ws_size, hipStream_t stream) {
    static int grid = 0;
    if (grid == 0) {
        if (n_in != 29 || in_sizes[0] != M * D || out_size != M * D || ws_size < WS_END) {
            fprintf(stderr, "kernel_launch: unexpected shapes (n_in %d, in0 %d, out %d, ws %zu < %zu); nothing launched\n", n_in, n_in > 0 ? in_sizes[0] : -1, out_size, ws_size, (size_t)WS_END); grid = -1; return; }
        int dev = 0, cus = 0, per_cu = 0;
        if (hipGetDevice(&dev) != hipSuccess || hipDeviceGetAttribute(&cus, hipDeviceAttributeMultiprocessorCount, dev) != hipSuccess) { grid = -1; return; }
        if (hipFuncSetAttribute((const void*)mega_fwd, hipFuncAttributeMaxDynamicSharedMemorySize, LDS_BYTES) != hipSuccess) { fprintf(stderr, "kernel_launch: hipFuncSetAttribute failed\n"); grid = -1; return; }
        if (hipOccupancyMaxActiveBlocksPerMultiprocessor(&per_cu, (const void*)mega_fwd, 512, LDS_BYTES) != hipSuccess || per_cu < 1) { fprintf(stderr, "kernel_launch: occupancy query says %d blocks/CU\n", per_cu); }
        (void)hipGetLastError();
        grid = cus;
    }
    if (grid < 0) return;
    (void)hipMemsetAsync((char*)d_ws + WS_CTL, 0, CTL_ZERO_BYTES, stream);
    Args a{};
    for (int i = 0; i < 29; ++i) a.in[i] = (const float*)d_in[i];
    a.out = (float*)d_out; a.ws = (unsigned char*)d_ws;
#if MK_PER_PHASE
    for (int p = 0; p < NPHASE; ++p) { a.ph_lo = p; a.ph_hi = p + 1; hipLaunchKernelGGL(mega_fwd, dim3(grid), dim3(512), LDS_BYTES, stream, a); }
#else
    a.ph_lo = 0; a.ph_hi = NPHASE; hipLaunchKernelGGL(mega_fwd, dim3(grid), dim3(512), LDS_BYTES, stream, a);
#endif
}
```

```cpp
#include <hip/hip_runtime.h>
#include <cstdio>
#include <cstdint>

#ifndef P3_ONLY
#define P3_ONLY 0
#endif
#ifndef SCAN_STUB
#define SCAN_STUB 0
#endif
#ifndef ATT_FORCE
#define ATT_FORCE 0
#endif
#ifndef G1_F8_TILES
#define G1_F8_TILES 0x1FE030u
#endif
#ifndef EPI_STUB
#define EPI_STUB 0
#endif
#ifndef TS_PROBE
#define TS_PROBE -1
#endif
#ifndef TS_END_SLOT
#define TS_END_SLOT (TS_PROBE + 1)
#endif
#ifndef MK_PER_PHASE
#define MK_PER_PHASE 0
#endif

#define LAS __attribute__((address_space(3)))
#define GAS __attribute__((address_space(1)))
typedef unsigned short bf16;
typedef short bf16x8 __attribute__((ext_vector_type(8)));
typedef float f32x2 __attribute__((ext_vector_type(2)));
typedef float f32x4 __attribute__((ext_vector_type(4)));
typedef float f32x16 __attribute__((ext_vector_type(16)));
typedef unsigned u32x2 __attribute__((ext_vector_type(2)));
typedef unsigned u32x4 __attribute__((ext_vector_type(4)));
typedef __bf16 bf16x2_t __attribute__((ext_vector_type(2)));

constexpr int NB = 16, SEQ = 2048, D = 1024, M = NB * SEQ;
constexpr int NH = 8, HD = 64, AW = 512, RW = 512, RWC = 1792, INC = 5376;
constexpr int NE = 32, FH = 1024, F2 = 2048, PLE = 256, TOPK = 4;
constexpr int LORA_K = 256, LORA_N = 1536;
constexpr int CAP = 32768;
constexpr int MAXROWS = M * TOPK + NE * 256;
constexpr float RMS_EPS = 1e-5f, GN_EPS = 64e-5f;

constexpr size_t MiB = 1u << 20;
constexpr size_t WS_CTL = 0, CTL_ZERO_BYTES = 1 * MiB;
constexpr size_t WS_WIN = 1 * MiB;
constexpr size_t WS_WA = 12 * MiB, WS_WB = 13 * MiB, WS_WO = 14 * MiB, WS_WG = 16 * MiB, WS_WP = 18 * MiB;
constexpr size_t WS_WL = 18 * MiB + 512 * 1024;
constexpr size_t WS_GW = 19 * MiB + 256 * 1024;
constexpr size_t WS_W1 = 20 * MiB;
constexpr size_t WS_W2 = 148 * MiB;
constexpr size_t WS_PB = 212 * MiB;
constexpr size_t WS_RSTD0 = 228 * MiB, WS_RSTD2 = WS_RSTD0 + 128 * 1024, WS_ROWSS = WS_RSTD0 + 256 * 1024;
constexpr size_t WS_RSTD1 = WS_RSTD0 + 384 * 1024;
constexpr size_t WS_GATEW = WS_RSTD0 + 512 * 1024;
constexpr size_t WS_ROWSLOT = 229 * MiB;
constexpr size_t WS_LIST = 230 * MiB;
constexpr size_t WS_X1 = 236 * MiB;
constexpr size_t WS_YA = 236 * MiB, WS_YB = 268 * MiB, WS_ALORA = 300 * MiB;
constexpr size_t WS_GT = 364 * MiB;
constexpr size_t WS_Q = 492 * MiB, WS_K = 524 * MiB, WS_VT = 556 * MiB;
constexpr size_t WS_ZR = 588 * MiB;
constexpr size_t WS_XB = 700 * MiB;
constexpr size_t WS_DEC = 764 * MiB, WS_AA = 828 * MiB, WS_GG = 892 * MiB;
constexpr size_t WS_MERGED = 492 * MiB;
constexpr size_t WS_XS = 364 * MiB;
constexpr size_t WS_ACT = 684 * MiB;
constexpr size_t WS_HN = 364 * MiB;
constexpr size_t WS_YBUF = 428 * MiB;
constexpr size_t WS_X2B = 684 * MiB;
constexpr size_t WS_PGT = 748 * MiB;
constexpr size_t WS_LRS = 956 * MiB, WS_LGT = 960 * MiB;
constexpr size_t WS_WIN8 = 84 * MiB;
constexpr size_t WS_XB8 = 96 * MiB;
constexpr size_t WS_END = 964 * MiB;
constexpr int CW_CNT = 64;
constexpr int CW_PCNT = 8192;
constexpr int CW_BAR = 4096;

constexpr int RING_BYTES = 131072;
constexpr int LDSCTL_OFF = RING_BYTES;
constexpr int MOE_OFF = RING_BYTES + 1024;
constexpr int MOE_TE = RING_BYTES + 2048;
constexpr int LDS_BYTES = 147456;

#define RLX_AGENT __ATOMIC_RELAXED, __HIP_MEMORY_SCOPE_AGENT
__device__ __forceinline__ unsigned pk2(float lo, float hi) { f32x2 v = {lo, hi}; bf16x2_t b = __builtin_convertvector(v, bf16x2_t); return __builtin_bit_cast(unsigned, b); }
__device__ __forceinline__ unsigned pk8(float a, float b, float c, float d) { int w = __builtin_amdgcn_cvt_pk_fp8_f32(a, b, 0, false); w = __builtin_amdgcn_cvt_pk_fp8_f32(c, d, w, true); return (unsigned)w; }
__device__ __forceinline__ float bflo(unsigned u) { return __uint_as_float(u << 16); }
__device__ __forceinline__ float bfhi(unsigned u) { return __uint_as_float(u & 0xffff0000u); }
__device__ __forceinline__ float sigm(float x) { return __builtin_amdgcn_rcpf(1.f + __expf(-x)); }
__device__ __forceinline__ float wave_sum(float v) {
#pragma unroll
    for (int o = 1; o < 64; o <<= 1) v += __shfl_xor(v, o);
    return v;
}
template <int CTRL> __device__ __forceinline__ float dppf(float v) { return __builtin_bit_cast(float, __builtin_amdgcn_update_dpp(0, __builtin_bit_cast(int, v), CTRL, 0xF, 0xF, true)); }
__device__ __forceinline__ float red8(float v) { v += dppf<0xB1>(v); v += dppf<0x4E>(v); v += dppf<0x141>(v); return v; }
__device__ __forceinline__ int lane_now() { int l; asm volatile("v_mbcnt_lo_u32_b32 %0, -1, 0\n\tv_mbcnt_hi_u32_b32 %0, -1, %0" : "=v"(l)); return l; }
__device__ __forceinline__ int crow(int r, int hi) { return (r & 3) + 8 * (r >> 2) + 4 * hi; }

struct PreNone {}; struct PreF { float f[8]; }; struct PreI { int i[8]; };
namespace pg8 {
#define PG8_LAS __attribute__((address_space(3)))
typedef unsigned short bf16_t;
constexpr int BM = 256, BK = 64, HALF = 128, HTB = HALF * BK * 2, STAGE_BYTES = 8 * HTB, NXCD = 8, WGM = 8;
__host__ __device__ __forceinline__ int lds_byte(int r, int c) { const int st = (r >> 4) * 2 + (c >> 5), rr = r & 15, cc = c & 31, ob = rr * 64 + cc * 2; return st * 1024 + (ob ^ (((ob >> 9) & 1) << 5)); }
__host__ __device__ __forceinline__ void stage_rc(int b, int& R, int& C) { const int st = b / 1024, sb = b % 1024, swz = sb ^ (((sb >> 9) & 1) << 5); R = (st >> 1) * 16 + swz / 64; C = (st & 1) * 32 + (swz % 64) / 2; }
__host__ __device__ __forceinline__ int perm32(int rho) { const int n = rho >> 4, i = rho & 15; return 8 * (i >> 2) + 4 * n + (i & 3); }

struct Unit { int pm, pn, e; };
struct Gemm { const bf16_t* A; const bf16_t* Bt; int M, N, K; size_t bsel_bytes; const int* glist; const PG8_LAS int* goff; const PG8_LAS int* gcnt; };

struct StaticOrder {
    int nM, nN, nwg, G, c;
    __device__ void init(int M_, int N_, int G_, int c_) { nM = M_ / BM; nN = N_ / BM; nwg = nM * nN; G = G_; c = c_; }
    __device__ bool next(int i, Unit& u) const {
        const long L = (long)i * G + c; if (L >= nwg) return false;
        int wgid = (int)L; { const int q = nwg / NXCD, r = nwg % NXCD, xcd = wgid % NXCD, off = wgid / NXCD; wgid = (xcd < r ? xcd * (q + 1) : r * (q + 1) + (xcd - r) * q) + off; }
        const int nig = WGM * nN, gid = wgid / nig, fm = gid * WGM, gsz = (nM - fm) < WGM ? (nM - fm) : WGM;
        u.pm = fm + ((wgid % nig) % gsz); u.pn = (wgid % nig) / gsz; u.e = 0; return true;
    }
};
struct MaskOrder {
    StaticOrder S; unsigned mask;
    __device__ void init(int M_, unsigned mask_, int G_, int c_) { mask = mask_; S.init(M_, BM * __builtin_popcount(mask_), G_, c_); }
    __device__ bool next(int i, Unit& u) const {
        if (!S.next(i, u)) return false;
        int n = u.pn, idx = 0;
#pragma unroll
        for (int t = 0; t < 21; ++t) if ((mask >> t) & 1u) { if (n == 0) idx = t; --n; }
        u.pn = idx; return true;
    }
};
struct LoraOrder {
    int pm, half, nu;
    __device__ bool next(int i, Unit& u) const { if (i >= nu) return false; u.pm = pm; u.pn = 3 * half + i; u.e = 0; return true; }
};
struct MoeOrder {
    int ntiles, npn, G, c; const PG8_LAS unsigned char* te;
    __device__ bool next(int i, Unit& u) const {
        int rt, pn;
        if ((G & 255) == 0 && (npn == 8 || npn == 4)) { const int x = c & 7, j = (c >> 3) & 31, rpx = 32 / npn, blk = c >> 8; rt = ((i * (G >> 8) + blk) * 8 + x) * rpx + j / npn; pn = j % npn; }
        else { const long L = (long)i * G + c; rt = (int)(L / npn); pn = (int)(L % npn); }
        if (rt >= ntiles) return false;
        u.pm = rt; u.pn = pn; u.e = te[rt]; return true;
    }
};

typedef int i32x4 __attribute__((ext_vector_type(4))); typedef int i32x8 __attribute__((ext_vector_type(8)));
template <class Epi, class Sched, bool GATHER = false, bool F8 = false>
__device__ __forceinline__ void gemm_phase(PG8_LAS unsigned char* lds, const Gemm g, const Sched& S, const Epi& E, const int wid) {
    const int lane = lane_now(), tid = wid * 64 + lane,
              wr = wid >> 2, wc = wid & 3, fr = lane & 15, fq = lane >> 4;
    const int K = g.K, nt = F8 ? K / (2 * BK) : K / BK;
    unsigned voffA[2], voffB[2];
#pragma unroll
    for (int i = 0; i < 2; ++i) { int R, C; stage_rc(tid * 16 + i * 8192, R, C); const int Rb = Epi::PERM ? ((R & ~31) + perm32(R & 31)) : R;
        voffA[i] = F8 ? (unsigned)(R * K + C * 2) : (unsigned)(R * K + C) * 2u; voffB[i] = F8 ? (unsigned)(Rb * K + C * 2) : (unsigned)(Rb * K + C) * 2u; }
    const size_t kstep = (size_t)(BK * 2);
    const size_t hstep = (size_t)HALF * K * (F8 ? 1 : 2);
    const size_t tstep = 2 * hstep;
    const unsigned ldsw = (unsigned)wid * 1024u;
    const int aoff = lds_byte(wr * 64 + fr, fq * 8), boff = lds_byte(wc * 32 + fr, fq * 8);
    const int aoffk[2] = {aoff, aoff + 1024}, boffk[2] = {boff, boff + 1024};
    unsigned vgC[2][2] = {{0u, 0u}, {0u, 0u}}, vgN[2][2] = {{0u, 0u}, {0u, 0u}};
#define PG8_GOFF(u, vo) do { _Pragma("unroll") for (int _h = 0; _h < 2; ++_h) _Pragma("unroll") for (int _i = 0; _i < 2; ++_i) { int R_, C_; stage_rc(tid * 16 + _i * 8192, R_, C_); \
        const int r_ = (u).pm * BM + _h * HALF + R_ - g.goff[(u).e]; int tok_ = 0; if (r_ < g.gcnt[(u).e]) tok_ = g.glist[(size_t)(u).e * 32768 + r_] >> 2; (vo)[_h][_i] = F8 ? (unsigned)(tok_ * K + C_ * 2) : (unsigned)(tok_ * K + C_) * 2u; } } while (0)
#define PG8_SA(b, h) (((b) * 2 + (h)) * HTB)
#define PG8_SB(b, h) ((4 + (b) * 2 + (h)) * HTB)
#define PG8_STAGE(bufoff, gbase, voff) do { _Pragma("unroll") for (int _i = 0; _i < 2; ++_i) \
        __builtin_amdgcn_global_load_lds((const unsigned*)((const char*)(gbase) + (voff)[_i]), (PG8_LAS unsigned*)(lds + (bufoff) + ldsw + _i * 8192), 16, 0, 0); } while (0)
#define PG8_STA(bufoff, h, ptr, kbyte, usenext) do { if constexpr (GATHER) { unsigned vo_[2] = {(usenext) ? vgN[h][0] : vgC[h][0], (usenext) ? vgN[h][1] : vgC[h][1]}; PG8_STAGE(bufoff, (const char*)g.A + (kbyte), vo_); } else { PG8_STAGE(bufoff, ptr, voffA); } } while (0)
#define PG8_LDA(dst, b, h) do { _Pragma("unroll") for (int m = 0; m < 4; ++m) _Pragma("unroll") for (int k = 0; k < 2; ++k) dst[m][k] = *(const PG8_LAS bf16x8*)(lds + PG8_SA(b, h) + aoffk[k] + m * 2048); } while (0)
#define PG8_LDB(dst, b, h) do { _Pragma("unroll") for (int n = 0; n < 2; ++n) _Pragma("unroll") for (int k = 0; k < 2; ++k) dst[n][k] = *(const PG8_LAS bf16x8*)(lds + PG8_SB(b, h) + boffk[k] + n * 2048); } while (0)
#define PG8_MMA(ai, bj, At, Bt) do { __builtin_amdgcn_s_setprio(1); _Pragma("unroll") for (int m = 0; m < 4; ++m) _Pragma("unroll") for (int n = 0; n < 2; ++n) { \
        if constexpr (F8) { const i32x8 b8_ = __builtin_shufflevector(__builtin_bit_cast(i32x4, Bt[n][0]), __builtin_bit_cast(i32x4, Bt[n][1]), 0, 1, 2, 3, 4, 5, 6, 7), a8_ = __builtin_shufflevector(__builtin_bit_cast(i32x4, At[m][0]), __builtin_bit_cast(i32x4, At[m][1]), 0, 1, 2, 3, 4, 5, 6, 7); \
            asm volatile("v_mfma_f32_16x16x128_f8f6f4 %0, %1, %2, %0" : "+v"(acc[ai][bj][m][n]) : "v"(b8_), "v"(a8_)); } \
        else { _Pragma("unroll") for (int k = 0; k < 2; ++k) acc[ai][bj][m][n] = __builtin_amdgcn_mfma_f32_16x16x32_bf16(Bt[n][k], At[m][k], acc[ai][bj][m][n], 0, 0, 0); } } \
        __builtin_amdgcn_s_setprio(0); } while (0)
#define PG8_WAIT_V(n) asm volatile("s_waitcnt vmcnt(" #n ")" ::: "memory")
#define PG8_WAIT_L(n) asm volatile("s_waitcnt lgkmcnt(" #n ")" ::: "memory")
#define PG8_BAR __builtin_amdgcn_s_barrier()
#define PG8_SCHED __builtin_amdgcn_sched_barrier(0)
    Unit cur, nxt; int ui = 0;
    if (!S.next(0, cur)) return;
    typename Epi::Pre preC;
    f32x4 acc[2][2][4][2];
#pragma unroll
    for (int a = 0; a < 2; ++a)
#pragma unroll
        for (int b = 0; b < 2; ++b)
#pragma unroll
            for (int m = 0; m < 4; ++m)
#pragma unroll
                for (int n = 0; n < 2; ++n) acc[a][b][m][n] = (f32x4){0.f, 0.f, 0.f, 0.f};
    bf16x8 At[4][2], B0[2][2], B1[2][2];
    const char* cA = (const char*)g.A + (size_t)cur.pm * tstep; const char* cB = (const char*)g.Bt + (size_t)cur.e * g.bsel_bytes + (size_t)cur.pn * tstep;
    if constexpr (GATHER) PG8_GOFF(cur, vgC);
    PG8_STAGE(PG8_SB(0, 0), cB, voffB); PG8_STAGE(PG8_SB(0, 1), cB + hstep, voffB); PG8_STA(PG8_SA(0, 0), 0, cA, 0, false); PG8_STA(PG8_SA(0, 1), 1, cA + hstep, 0, false);
    if (wr == 1) PG8_BAR;
    PG8_WAIT_V(2); PG8_BAR;
    PG8_STAGE(PG8_SB(1, 0), cB + kstep, voffB); PG8_STA(PG8_SA(1, 0), 0, cA + kstep, kstep, false); PG8_STAGE(PG8_SB(1, 1), cB + hstep + kstep, voffB);
    PG8_WAIT_V(6); PG8_BAR;
    for (;;) {
        const bool has_next = S.next(ui + 1, nxt);
        E.pre(cur, wr, fr, preC);
        f32x4 biasq = (f32x4){0.f, 0.f, 0.f, 0.f}; if constexpr (Epi::LBIAS) { if (wid == 0) biasq = *(const f32x4*)(E.bias_tile(cur) + 4 * lane); }
        if constexpr (GATHER) { if (has_next) PG8_GOFF(nxt, vgN); else { vgN[0][0] = vgC[0][0]; vgN[0][1] = vgC[0][1]; vgN[1][0] = vgC[1][0]; vgN[1][1] = vgC[1][1]; } }
        const char* nA = has_next ? (const char*)g.A + (size_t)nxt.pm * tstep : cA;
        const char* nB = has_next ? (const char*)g.Bt + (size_t)nxt.e * g.bsel_bytes + (size_t)nxt.pn * tstep : cB;
        for (int t = 0; t < nt; t += 2) {
            const bool last = (t == nt - 2);
            const char* a1 = cA + (size_t)(t + 1) * kstep;
            const char* a2 = last ? nA : cA + (size_t)(t + 2) * kstep; const char* b2 = last ? nB : cB + (size_t)(t + 2) * kstep;
            const char* a3 = a2 + kstep; const char* b3 = b2 + kstep;
            const size_t k2 = last ? 0 : (size_t)(t + 2) * kstep;
            PG8_LDB(B0, 0, 0); PG8_LDB(B1, 0, 1); PG8_SCHED; PG8_LDA(At, 0, 0); PG8_STA(PG8_SA(1, 1), 1, a1 + hstep, (size_t)(t + 1) * kstep, false);
            PG8_WAIT_V(8); PG8_WAIT_L(0); PG8_BAR; PG8_MMA(0, 0, At, B0); PG8_MMA(0, 1, At, B1); PG8_BAR; PG8_SCHED;
            PG8_LDA(At, 0, 1); PG8_STAGE(PG8_SB(0, 0), b2, voffB); PG8_STAGE(PG8_SB(0, 1), b2 + hstep, voffB); PG8_STA(PG8_SA(0, 0), 0, a2, k2, last);
            PG8_WAIT_V(8); PG8_WAIT_L(0); PG8_BAR; PG8_MMA(1, 0, At, B0); PG8_MMA(1, 1, At, B1); PG8_BAR; PG8_SCHED;
            PG8_LDB(B0, 1, 0); PG8_LDB(B1, 1, 1); PG8_SCHED; PG8_LDA(At, 1, 0); PG8_STA(PG8_SA(0, 1), 1, a2 + hstep, k2, last);
            PG8_WAIT_V(8); PG8_WAIT_L(0); PG8_BAR; PG8_MMA(0, 0, At, B0); PG8_MMA(0, 1, At, B1); PG8_BAR; PG8_SCHED;
            PG8_LDA(At, 1, 1); PG8_STAGE(PG8_SB(1, 0), b3, voffB); PG8_STAGE(PG8_SB(1, 1), b3 + hstep, voffB); PG8_STA(PG8_SA(1, 0), 0, a3, k2 + kstep, last);
            PG8_WAIT_V(8); PG8_WAIT_L(0); PG8_BAR; PG8_MMA(1, 0, At, B0); PG8_MMA(1, 1, At, B1); PG8_BAR; PG8_SCHED;
        }
        if constexpr (Epi::LBIAS) { if (wid == 0) { *(PG8_LAS f32x4*)(lds + RING_BYTES + 4096 + 16 * lane) = biasq; asm volatile("s_waitcnt lgkmcnt(0)" ::: "memory"); } }
        if (wr == 0) PG8_BAR;
        if constexpr (F8) asm volatile("s_nop 15\n\ts_nop 15\n\ts_nop 15" ::: "memory");
        E(acc, cur, wr, wc, fr, fq, preC);
        if (!has_next) break;
#pragma unroll
        for (int a = 0; a < 2; ++a)
#pragma unroll
            for (int b = 0; b < 2; ++b)
#pragma unroll
                for (int m = 0; m < 4; ++m)
#pragma unroll
                    for (int n = 0; n < 2; ++n) acc[a][b][m][n] = (f32x4){0.f, 0.f, 0.f, 0.f};
        cur = nxt; cA = nA; cB = nB; ++ui;
        if constexpr (GATHER) { vgC[0][0] = vgN[0][0]; vgC[0][1] = vgN[0][1]; vgC[1][0] = vgN[1][0]; vgC[1][1] = vgN[1][1]; }
        if (wr == 1) PG8_BAR;
    }
    PG8_WAIT_V(0);
    PG8_BAR;
#undef PG8_SA
#undef PG8_SB
#undef PG8_STAGE
#undef PG8_LDA
#undef PG8_STA
#undef PG8_GOFF
#undef PG8_LDB
#undef PG8_MMA
#undef PG8_WAIT_V
#undef PG8_WAIT_L
#undef PG8_BAR
#undef PG8_SCHED
}
}
using pg8::Unit;
typedef const f32x4 (&AccRef)[2][2][4][2];

#define XB_TMO      128
#define XB_XCNT(j)  (256  + 64 * (j))
#define XB_XSUB(j)  (1280 + 64 * (j))
#define XB_XGEN(j)  (2304 + 64 * (j))
#define XB_TOP      3328
#define XB_TOPGEN   3392
#define XCD_BAR_WORDS 3456
#define XB_SPIN_CAP (1u << 22)
__device__ __forceinline__ unsigned xb_ld(unsigned* p)              { return __hip_atomic_load(p, __ATOMIC_RELAXED, __HIP_MEMORY_SCOPE_AGENT); }
__device__ __forceinline__ unsigned xb_add(unsigned* p, unsigned v) { return __hip_atomic_fetch_add(p, v, __ATOMIC_RELAXED, __HIP_MEMORY_SCOPE_AGENT); }
__device__ __forceinline__ unsigned xb_xcc_id() { return (unsigned)__builtin_amdgcn_s_getreg((3 << 11) | 20) & 0xFu; }
#define XB_SPIN(cond, bar) do { unsigned _sp = 0; while (cond) { __builtin_amdgcn_s_sleep(1); \
    if ((++_sp & 255u) == 0u) { if (xb_ld(&(bar)[XB_TMO])) break; if (_sp > XB_SPIN_CAP) { atomicAdd(&(bar)[XB_TMO], 1u); break; } } } } while (0)
struct XcdBarrier { unsigned* bar; unsigned x; volatile LAS unsigned* st; };
__device__ __forceinline__ XcdBarrier xcd_barrier_post(unsigned* bar, volatile LAS unsigned* st, int tid) {
    XcdBarrier b; b.bar = bar; b.x = xb_xcc_id(); b.st = st;
    if (tid == 0) (void)xb_add(&bar[XB_XCNT(b.x)], 1u);
    return b;
}
__device__ __forceinline__ void xcd_barrier_complete(unsigned* bar, unsigned x, unsigned& nloc, unsigned& nx) {
    const unsigned G = gridDim.x * gridDim.y * gridDim.z;
    unsigned sum, cnt, mine, sp = 0u;
    for (;;) {
        sum = 0u; cnt = 0u; mine = 0u;
#pragma unroll
        for (unsigned j = 0; j < 16; ++j) { const unsigned c = xb_ld(&bar[XB_XCNT(j)]); sum += c; cnt += (c > 0u) ? 1u : 0u; mine = (j == x) ? c : mine; }
        if (sum == G) break;
        __builtin_amdgcn_s_sleep(1);
        if ((++sp & 255u) == 0u) { if (xb_ld(&bar[XB_TMO])) break; if (sp > XB_SPIN_CAP) { atomicAdd(&bar[XB_TMO], 1u); break; } }
    }
    nloc = mine > 0u ? mine : 1u; nx = cnt > 0u ? cnt : 1u;
}
__device__ __forceinline__ void xcd_barrier(const XcdBarrier& b, int wave) {
    asm volatile("s_waitcnt vmcnt(0)" ::: "memory");
    __syncthreads();
    if (wave == 0 && lane_now() == 0) {
        unsigned* bar = b.bar;
        __builtin_amdgcn_s_waitcnt(0);
        unsigned nloc = b.st[0], nx = b.st[1];
        if (nloc == 0u) { xcd_barrier_complete(bar, b.x, nloc, nx); b.st[0] = nloc; b.st[1] = nx; }
        const unsigned old = xb_add(&bar[XB_XSUB(b.x)], 1u);
        const unsigned gen = old / nloc;
        if (old + 1u == (gen + 1u) * nloc) {
            __builtin_amdgcn_fence(__ATOMIC_RELEASE, "agent");
            asm volatile("s_waitcnt vmcnt(0)" ::: "memory");
            const unsigned og = xb_add(&bar[XB_TOP], 1u);
            const unsigned tg = og / nx;
            if (og + 1u == (tg + 1u) * nx) xb_add(&bar[XB_TOPGEN], 1u);
            else XB_SPIN(xb_ld(&bar[XB_TOPGEN]) == tg, bar);
            __builtin_amdgcn_fence(__ATOMIC_ACQUIRE, "agent");
            xb_add(&bar[XB_XGEN(b.x)], 1u);
            asm volatile("s_waitcnt vmcnt(0)" ::: "memory");
        } else {
            XB_SPIN(xb_ld(&bar[XB_XGEN(b.x)]) == gen, bar);
            __builtin_amdgcn_fence(__ATOMIC_ACQUIRE, "agent");
            asm volatile("s_waitcnt vmcnt(0)" ::: "memory");
        }
    }
    __syncthreads();
}

struct Frame {
    LAS unsigned char* lds;
    unsigned* ctl;
    int tid, lane, wave, vcu, G;
    unsigned char* ws;
    float* out;
};
#define WSP(T, off) ((T*)(F.ws + (off)))
struct Args { const float* in[29]; float* out; unsigned char* ws; int ph_lo, ph_hi; };
#define FIN(i) (args.in[i])

template <bool SWZ = false, bool Q8 = false>
__device__ __forceinline__ void p0_transpose_item(const float* W, int K, int N, bf16* WT, LAS float* scr, int item, int lane, const float* kscale) {
    const int nblk = N / 32, kb = item / nblk, nb = item % nblk, k0 = 64 * kb, n0 = 32 * nb;
#pragma unroll
    for (int b = 0; b < 2; ++b) {
        float v[16];
#pragma unroll
        for (int i = 0; i < 16; ++i) { const int kk = 2 * (16 * b + i) + (lane >> 5); v[i] = W[(size_t)(k0 + kk) * N + n0 + (lane & 31)]; }
        __builtin_amdgcn_sched_barrier(0);
#pragma unroll
        for (int i = 0; i < 16; ++i) { const int kk = 2 * (16 * b + i) + (lane >> 5); if (kscale) v[i] *= kscale[k0 + kk]; scr[kk * 33 + (lane & 31)] = v[i]; }
        __builtin_amdgcn_sched_barrier(0);
    }
    asm volatile("s_waitcnt lgkmcnt(0)" ::: "memory");
    if constexpr (Q8) {
        const int c4 = lane & 3;
#pragma unroll
        for (int j = 0; j < 2; ++j) { const int n = (lane >> 2) + 16 * j; const LAS float* s = scr + (16 * c4) * 33 + n;
            u32x4 o; o.x = pk8(64.f * s[0 * 33], 64.f * s[1 * 33], 64.f * s[2 * 33], 64.f * s[3 * 33]); o.y = pk8(64.f * s[4 * 33], 64.f * s[5 * 33], 64.f * s[6 * 33], 64.f * s[7 * 33]);
            o.z = pk8(64.f * s[8 * 33], 64.f * s[9 * 33], 64.f * s[10 * 33], 64.f * s[11 * 33]); o.w = pk8(64.f * s[12 * 33], 64.f * s[13 * 33], 64.f * s[14 * 33], 64.f * s[15 * 33]);
            int nr = n0 + n; if (SWZ) { const int cl = nr & 255; nr = (nr & ~255) + 128 * ((cl >> 3) & 1) + 32 * (cl >> 6) + 8 * ((cl >> 4) & 3) + (cl & 7); }
            *(u32x4*)((unsigned char*)WT + (size_t)nr * K + k0 + 16 * c4) = o; }
        asm volatile("s_waitcnt lgkmcnt(0)" ::: "memory");
        return; }
    const int c = lane & 7;
#pragma unroll
    for (int j = 0; j < 4; ++j) { const int n = (lane >> 3) + 8 * j; const LAS float* s = scr + (8 * c) * 33 + n;
        u32x4 o; o.x = pk2(s[0 * 33], s[1 * 33]); o.y = pk2(s[2 * 33], s[3 * 33]); o.z = pk2(s[4 * 33], s[5 * 33]); o.w = pk2(s[6 * 33], s[7 * 33]);
        int nr = n0 + n; if (SWZ) { const int cl = nr & 255; nr = (nr & ~255) + 128 * ((cl >> 3) & 1) + 32 * (cl >> 6) + 8 * ((cl >> 4) & 3) + (cl & 7); }
        *(u32x4*)(WT + (size_t)nr * K + k0 + 8 * c) = o; }
    asm volatile("s_waitcnt lgkmcnt(0)" ::: "memory");
}
__device__ __forceinline__ void p0_prologue(const Args& args, Frame& F) {
    LAS float* scr = (LAS float*)(F.lds + F.wave * 16384);
    const int gw = F.vcu * 8 + F.wave, NGW = F.G * 8, lane = F.lane;
    constexpr int I_IN = (D / 64) * (INC / 32), I_A = (AW / 64) * (D / 32), I_O = (D / 64) * (D / 32), I_P = (PLE / 64) * (D / 32);
    constexpr int I_W1 = (D / 64) * (F2 / 32), I_W2 = (FH / 64) * (D / 32);
    constexpr int NITEMS = I_IN + 2 * I_A + 2 * I_O + I_P;
    for (int it = gw; it < NITEMS; it += NGW) {
        int r = it;
        if (r < I_IN) { const int tile = (r % (INC / 32)) >> 3;
            if ((G1_F8_TILES >> tile) & 1) p0_transpose_item<false, true>(FIN(3), D, INC, WSP(bf16, WS_WIN8), scr, r, lane, FIN(2));
            else p0_transpose_item(FIN(3), D, INC, WSP(bf16, WS_WIN), scr, r, lane, FIN(2));
            continue; } r -= I_IN;
        if (r < I_A) { p0_transpose_item(FIN(15), AW, D, WSP(bf16, WS_WA), scr, r, lane, nullptr); continue; } r -= I_A;
        if (r < I_A) { p0_transpose_item(FIN(16), RW, D, WSP(bf16, WS_WB), scr, r, lane, nullptr); continue; } r -= I_A;
        if (r < I_O) { p0_transpose_item(FIN(17), D, D, WSP(bf16, WS_WO), scr, r, lane, nullptr); continue; } r -= I_O;
        if (r < I_O) { p0_transpose_item(FIN(26), D, D, WSP(bf16, WS_WG), scr, r, lane, FIN(25)); continue; } r -= I_O;
        p0_transpose_item(FIN(27), PLE, D, WSP(bf16, WS_WP), scr, r, lane, nullptr);
    }
    { const int gt = (F.vcu * 512 + F.tid), NT = F.G * 512;
      bf16* WL = WSP(bf16, WS_WL);
      for (int i = gt; i < LORA_N * LORA_K; i += NT) { const int n = i >> 8, k = i & 255; float v = 0.f;
          if (n < 512) { if (k < 64) v = FIN(6)[k * 512 + n]; }
          else if (n < 1024) { if (k >= 64 && k < 128) v = FIN(8)[(k - 64) * 512 + (n - 512)]; }
          else { if (k >= 128) v = FIN(9)[(k - 128) * 512 + (n - 1024)]; }
          WL[i] = (bf16)(pk2(v, 0.f) & 0xffffu); }
      float* GW = WSP(float, WS_GW);
      for (int i = gt; i < D * NE; i += NT) GW[i] = FIN(19)[i] * FIN(18)[i >> 5];
    }
    { bf16* XB = WSP(bf16, WS_XB); float* R0 = WSP(float, WS_RSTD0); bf16* PB = WSP(bf16, WS_PB);
      for (int m = gw; m < M; m += NGW) {
          const f32x4* xr = (const f32x4*)(FIN(0) + (size_t)m * D) + lane;
          f32x4 v[4]; float s = 0.f;
#pragma unroll
          for (int j = 0; j < 4; ++j) { v[j] = xr[64 * j]; s += (v[j].x * v[j].x + v[j].y * v[j].y) + (v[j].z * v[j].z + v[j].w * v[j].w); }
          s = wave_sum(s);
          u32x2* o = (u32x2*)(XB + (size_t)m * D) + lane;
#pragma unroll
          for (int j = 0; j < 4; ++j) { if (G1_F8_TILES) (WSP(unsigned, WS_XB8) + (size_t)m * (D / 4))[lane + 64 * j] = pk8(v[j].x, v[j].y, v[j].z, v[j].w); u32x2 w; w.x = pk2(v[j].x, v[j].y); w.y = pk2(v[j].z, v[j].w); o[64 * j] = w; }
          if (lane == 0) R0[m] = 1.0f / sqrtf(s * (1.f / D) + RMS_EPS);
          const f32x4 pv = ((const f32x4*)(FIN(1) + (size_t)m * PLE))[lane];
          u32x2 w; w.x = pk2(pv.x, pv.y); w.y = pk2(pv.z, pv.w); ((u32x2*)(PB + (size_t)m * PLE))[lane] = w;
      }
    }
}

__device__ __forceinline__ void expert_convert(const Args& args, Frame& F, int wv, int NW, int which) {
    LAS float* scr = (LAS float*)(F.lds + F.wave * 16384);
    constexpr int I_W1 = (D / 64) * (F2 / 32), I_W2 = (FH / 64) * (D / 32);
    if (which & 1) for (int it = wv; it < NE * I_W1; it += NW) { const int e = it / I_W1; p0_transpose_item<true, true>(FIN(21) + (size_t)e * D * F2, D, F2, (bf16*)(WSP(unsigned char, WS_W1) + (size_t)e * F2 * D), scr, it % I_W1, F.lane, nullptr); }
    if (which & 2) for (int it = wv; it < NE * I_W2; it += NW) { const int e = it / I_W2; p0_transpose_item<false, true>(FIN(23) + (size_t)e * FH * D, FH, D, (bf16*)(WSP(unsigned char, WS_W2) + (size_t)e * D * FH), scr, it % I_W2, F.lane, nullptr); }
}
struct EpiG1 {
    static constexpr bool PERM = true;
    typedef PreF Pre; static constexpr bool LBIAS = false;
    const float* rstd; bf16 *Q, *K, *VT, *ZR, *GT; float rs_mul;
    __device__ __forceinline__ void pre(const Unit& u, int wr, int fr, PreF& P) const {
#pragma unroll
        for (int k = 0; k < 8; ++k) P.f[k] = rstd[u.pm * 256 + wr * 64 + fr + (k >> 2) * 128 + (k & 3) * 16] * rs_mul; }
    __device__ __forceinline__ void operator()(AccRef acc, const Unit& u, int wr, int wc, int fr, int fq, const Pre& P) const {
        const int pn = u.pn, rowb = u.pm * 256 + wr * 64 + fr, cl = wc * 32 + 8 * fq;
#pragma unroll
        for (int ai = 0; ai < 2; ++ai)
#pragma unroll
            for (int m = 0; m < 4; ++m) {
                const int row = rowb + ai * 128 + m * 16; const float rs = P.f[4 * ai + m];
                if (pn < 4) {
                    bf16* base = (pn < 2 ? Q : K) + (size_t)row * 512 + (pn & 1) * 256 + cl; const float sc = pn < 2 ? rs * 0.125f : rs;
#pragma unroll
                    for (int bj = 0; bj < 2; ++bj) { const f32x4 v0 = acc[ai][bj][m][0] * sc, v1 = acc[ai][bj][m][1] * sc;
                        u32x4 w; w.x = pk2(v0[0], v0[1]); w.y = pk2(v0[2], v0[3]); w.z = pk2(v1[0], v1[1]); w.w = pk2(v1[2], v1[3]); *(u32x4*)(base + bj * 128) = w; }
                } else if (pn < 6) {
                    const int b = row >> 11, s = row & 2047;
#pragma unroll
                    for (int bj = 0; bj < 2; ++bj)
#pragma unroll
                        for (int n = 0; n < 2; ++n)
#pragma unroll
                            for (int j = 0; j < 4; ++j) { const int c = (pn - 4) * 256 + cl + bj * 128 + 4 * n + j; const int hh = c >> 6, d = c & 63;
                                VT[((size_t)(((b * 8 + hh) * 128 + (s >> 4)) * 64 + d)) * 16 + (s & 15)] = (bf16)(pk2(acc[ai][bj][m][n][j] * rs, 0.f) & 0xffffu); }
                } else if (pn < 13) {
                    bf16* base = ZR + (size_t)row * RWC + (pn - 6) * 256 + cl;
#pragma unroll
                    for (int bj = 0; bj < 2; ++bj) { const f32x4 v0 = acc[ai][bj][m][0] * rs, v1 = acc[ai][bj][m][1] * rs;
                        u32x4 w; w.x = pk2(v0[0], v0[1]); w.y = pk2(v0[2], v0[3]); w.z = pk2(v1[0], v1[1]); w.w = pk2(v1[2], v1[3]); *(u32x4*)(base + bj * 128) = w; }
                } else {
                    bf16* base = GT + (size_t)row * 2048 + (pn - 13) * 256 + cl;
#pragma unroll
                    for (int bj = 0; bj < 2; ++bj) { const f32x4 v0 = acc[ai][bj][m][0] * rs, v1 = acc[ai][bj][m][1] * rs;
                        u32x4 w; w.x = pk2(sigm(v0[0]), sigm(v0[1])); w.y = pk2(sigm(v0[2]), sigm(v0[3])); w.z = pk2(sigm(v1[0]), sigm(v1[1])); w.w = pk2(sigm(v1[2]), sigm(v1[3])); *(u32x4*)(base + bj * 128) = w; }
                }
            }
    }
};
struct EpiLora {
    static constexpr bool PERM = false;
    typedef PreNone Pre; static constexpr bool LBIAS = false;
    __device__ __forceinline__ void pre(const Unit&, int, int, PreNone&) const {}
    const float *w0, *a0; float *DEC, *AA; bf16* GG;
    template <int MODE> __device__ __forceinline__ void body(AccRef acc, int rowb, int cb) const {
#pragma unroll
        for (int ai = 0; ai < 2; ++ai)
#pragma unroll
            for (int m = 0; m < 4; ++m) {
                const int row = rowb + ai * 128 + m * 16;
#pragma unroll
                for (int bj = 0; bj < 2; ++bj)
#pragma unroll
                    for (int n = 0; n < 2; ++n) {
                        const int c = cb + bj * 128 + n * 16;
                        f32x4 v = acc[ai][bj][m][n];
                        if (MODE == 0) { v = v + *(const f32x4*)(w0 + c); f32x4 o;
#pragma unroll
                            for (int j = 0; j < 4; ++j) { const float y = -v[j]; const float sp = y > 20.f ? y : __logf(1.f + __expf(y)); o[j] = __expf(-__expf(-sp - 0.5f)); }
                            *(f32x4*)(DEC + (size_t)row * 512 + c) = o;
                        } else if (MODE == 1) { v = v + *(const f32x4*)(a0 + c); f32x4 o;
#pragma unroll
                            for (int j = 0; j < 4; ++j) o[j] = sigm(v[j]);
                            *(f32x4*)(AA + (size_t)row * 512 + c) = o;
                        } else { u32x2 w; w.x = pk2(v[0], v[1]); w.y = pk2(v[2], v[3]); *(u32x2*)(GG + (size_t)row * 512 + c) = w; }
                    }
                asm volatile("" ::: "memory");
            }
    }
    __device__ __forceinline__ void operator()(AccRef acc, const Unit& u, int wr, int wc, int fr, int fq, const Pre& P) const {
        const int pn = u.pn, rowb = u.pm * 256 + wr * 64 + fr, cb = (pn & 1) * 256 + wc * 32 + 4 * fq;
        if (pn < 2) body<0>(acc, rowb, cb); else if (pn < 4) body<1>(acc, rowb, cb); else body<2>(acc, rowb, cb);
    }
};
template <int SECOND> struct EpiMerge {
    static constexpr bool PERM = true;
    typedef PreNone Pre; static constexpr bool LBIAS = false;
    __device__ __forceinline__ void pre(const Unit&, int, int, PreNone&) const {}
    const bf16* GT; bf16* MG;
    __device__ __forceinline__ void operator()(AccRef acc, const Unit& u, int wr, int wc, int fr, int fq, const Pre& P) const {
        const int rowb = u.pm * 256 + wr * 64 + fr, c0 = u.pn * 256 + wc * 32 + 8 * fq;
#pragma unroll
        for (int bj = 0; bj < 2; ++bj) {
            const int c = c0 + bj * 128; u32x4 gv[8], ov[8];
#pragma unroll
            for (int k = 0; k < 8; ++k) { const int row = rowb + (k >> 2) * 128 + (k & 3) * 16; gv[k] = *(const u32x4*)(GT + (size_t)row * 2048 + SECOND * 1024 + c); if (SECOND) ov[k] = *(const u32x4*)(MG + (size_t)row * 1024 + c); }
            __builtin_amdgcn_sched_barrier(0);
#pragma unroll
            for (int k = 0; k < 8; ++k) { const int ai = k >> 2, m = k & 3, row = rowb + ai * 128 + m * 16;
                const f32x4 v0 = acc[ai][bj][m][0], v1 = acc[ai][bj][m][1];
                float o[8] = {v0[0] * bflo(gv[k].x), v0[1] * bfhi(gv[k].x), v0[2] * bflo(gv[k].y), v0[3] * bfhi(gv[k].y), v1[0] * bflo(gv[k].z), v1[1] * bfhi(gv[k].z), v1[2] * bflo(gv[k].w), v1[3] * bfhi(gv[k].w)};
                if (SECOND) { o[0] += bflo(ov[k].x); o[1] += bfhi(ov[k].x); o[2] += bflo(ov[k].y); o[3] += bfhi(ov[k].y); o[4] += bflo(ov[k].z); o[5] += bfhi(ov[k].z); o[6] += bflo(ov[k].w); o[7] += bfhi(ov[k].w); }
                u32x4 w; w.x = pk2(o[0], o[1]); w.y = pk2(o[2], o[3]); w.z = pk2(o[4], o[5]); w.w = pk2(o[6], o[7]); *(u32x4*)(MG + (size_t)row * 1024 + c) = w; }
            __builtin_amdgcn_sched_barrier(0);
        }
    }
};
struct EpiX1 {
    static constexpr bool PERM = true;
    typedef PreNone Pre; static constexpr bool LBIAS = false;
    __device__ __forceinline__ void pre(const Unit&, int, int, PreNone&) const {}
    const float* X; float* X1; const float* gn; unsigned char* HN;
    __device__ __forceinline__ void operator()(AccRef acc, const Unit& u, int wr, int wc, int fr, int fq, const Pre& P) const {
        const int rowb = u.pm * 256 + wr * 64 + fr, c0 = u.pn * 256 + wc * 32 + 8 * fq;
#pragma unroll
        for (int bj = 0; bj < 2; ++bj) { const f32x4 g0 = *(const f32x4*)(gn + c0 + bj * 128), g1 = *(const f32x4*)(gn + c0 + bj * 128 + 4);
#pragma unroll
            for (int ai = 0; ai < 2; ++ai) {
                f32x4 xa[4], xb[4];
#pragma unroll
                for (int m = 0; m < 4; ++m) { const size_t off = (size_t)(rowb + ai * 128 + m * 16) * D + c0 + bj * 128; xa[m] = *(const f32x4*)(X + off); xb[m] = *(const f32x4*)(X + off + 4); }
                __builtin_amdgcn_sched_barrier(0);
#pragma unroll
                for (int m = 0; m < 4; ++m) { const size_t off = (size_t)(rowb + ai * 128 + m * 16) * D + c0 + bj * 128;
                    const f32x4 x0 = xa[m] + acc[ai][bj][m][0], x1 = xb[m] + acc[ai][bj][m][1];
                    *(f32x4*)(X1 + off) = x0; *(f32x4*)(X1 + off + 4) = x1;
                    u32x2 w; w.x = pk8(x0[0] * g0[0], x0[1] * g0[1], x0[2] * g0[2], x0[3] * g0[3]); w.y = pk8(x1[0] * g1[0], x1[1] * g1[1], x1[2] * g1[2], x1[3] * g1[3]); *(u32x2*)(HN + off) = w; }
                __builtin_amdgcn_sched_barrier(0);
            }
        }
    }
};
struct EpiSwiglu {
    static constexpr bool PERM = true;
    typedef PreF Pre; static constexpr bool LBIAS = true;
    const float* b1; unsigned char* ACT; const int* LIST; const float* R1; const LAS int* OFF; const LAS int* CS; const LAS float* LB;
    __device__ __forceinline__ const float* bias_tile(const Unit& u) const { return b1 + (size_t)u.e * F2 + u.pn * 256; }
    __device__ __forceinline__ void pre(const Unit& u, int wr, int fr, PreF& P) const {
        const int rbase = u.pm * 256 + wr * 64 + fr - OFF[u.e], cnt = CS[u.e];
#pragma unroll
        for (int k = 0; k < 8; ++k) { const int r = rbase + (k >> 2) * 128 + (k & 3) * 16; P.f[k] = 0.f; if (r < cnt) P.f[k] = R1[(size_t)u.e * CAP + r] * (1.f / 64.f); } }
    __device__ __forceinline__ void operator()(AccRef acc, const Unit& u, int wr, int wc, int fr, int fq, const Pre& P) const {
        if (EPI_STUB & 1) return;
        const int rowb = u.pm * 256 + wr * 64 + fr, c0 = u.pn * 256 + wc * 64 + 16 * fq;
        const LAS float* bb = LB + wc * 64 + 16 * fq;
        const f32x4 bv0 = *(const LAS f32x4*)(bb), bv1 = *(const LAS f32x4*)(bb + 4), bv2 = *(const LAS f32x4*)(bb + 8), bv3 = *(const LAS f32x4*)(bb + 12);
#pragma unroll
        for (int ai = 0; ai < 2; ++ai)
#pragma unroll
            for (int m = 0; m < 4; ++m) { const int row = rowb + ai * 128 + m * 16; const float rs = P.f[4 * ai + m];
                const f32x4 v[4] = {acc[ai][0][m][0] * rs + bv0, acc[ai][0][m][1] * rs + bv1, acc[ai][1][m][0] * rs + bv2, acc[ai][1][m][1] * rs + bv3};
                float o[8];
#pragma unroll
                for (int p = 0; p < 8; ++p) { float gl = v[p >> 1][2 * (p & 1)], ul = v[p >> 1][2 * (p & 1) + 1];
                    gl = fminf(gl, 7.f); ul = fminf(fmaxf(ul, -7.f), 7.f); o[p] = (ul + 1.f) * gl * sigm(1.702f * gl); }
                u32x2 w; w.x = pk8(o[0], o[1], o[2], o[3]); w.y = pk8(o[4], o[5], o[6], o[7]); *(u32x2*)(ACT + (size_t)row * FH + (c0 >> 1)) = w;
                asm volatile("" ::: "memory"); }
    }
};
struct EpiY {
    static constexpr bool PERM = true;
    typedef PreI Pre; static constexpr bool LBIAS = true;
    const float* b2; const int* LIST; const float* gatew; unsigned char* YB; const LAS int* OFF; const LAS int* CS; const LAS float* LB;
    __device__ __forceinline__ const float* bias_tile(const Unit& u) const { return b2 + (size_t)u.e * D + u.pn * 256; }
    __device__ __forceinline__ void pre(const Unit& u, int wr, int fr, PreI& P) const {
        const int rbase = u.pm * 256 + wr * 64 + fr - OFF[u.e], cnt = CS[u.e];
#pragma unroll
        for (int k = 0; k < 8; ++k) { const int r = rbase + (k >> 2) * 128 + (k & 3) * 16; P.i[k] = -1; if (r < cnt) P.i[k] = LIST[(size_t)u.e * CAP + r]; } }
    __device__ __forceinline__ void operator()(AccRef acc, const Unit& u, int wr, int wc, int fr, int fq, const Pre& P) const {
        const int rowb = u.pm * 256 + wr * 64 + fr, c0 = u.pn * 256 + wc * 32 + 8 * fq;
        const LAS float* bb = LB + wc * 32 + 8 * fq; const int rbase = rowb - OFF[u.e];
        if (EPI_STUB & 2) return;

#pragma unroll
        for (int ai = 0; ai < 2; ++ai) {
            float gts[4];
#pragma unroll
            for (int m = 0; m < 4; ++m) { gts[m] = 0.f; if (P.i[4 * ai + m] >= 0) gts[m] = gatew[(size_t)u.e * CAP + rbase + ai * 128 + m * 16]; }
            __builtin_amdgcn_sched_barrier(0);
#pragma unroll
            for (int m = 0; m < 4; ++m) {
                const int slot = P.i[4 * ai + m]; if (slot >= 0) { const float gt = gts[m] * 32.f;
#pragma unroll
                    for (int bj = 0; bj < 2; ++bj) { const int c = c0 + bj * 128;
                        const f32x4 v0 = (acc[ai][bj][m][0] * (1.f / 64.f) + *(const LAS f32x4*)(bb + bj * 128)) * gt, v1 = (acc[ai][bj][m][1] * (1.f / 64.f) + *(const LAS f32x4*)(bb + bj * 128 + 4)) * gt;
                        u32x2 w; w.x = pk8(v0[0], v0[1], v0[2], v0[3]); w.y = pk8(v1[0], v1[1], v1[2], v1[3]); *(u32x2*)(YB + (size_t)slot * D + c) = w; } } }
            __builtin_amdgcn_sched_barrier(0); }
    }
};
struct EpiGate {
    static constexpr bool PERM = true;
    typedef PreF Pre; static constexpr bool LBIAS = false;
    __device__ __forceinline__ void pre(const Unit& u, int wr, int fr, PreF& P) const {
#pragma unroll
        for (int k = 0; k < 8; ++k) P.f[k] = rstd2[u.pm * 256 + wr * 64 + fr + (k >> 2) * 128 + (k & 3) * 16]; }
    const float* rstd2; bf16* GT;
    __device__ __forceinline__ void operator()(AccRef acc, const Unit& u, int wr, int wc, int fr, int fq, const Pre& P) const {
        const int rowb = u.pm * 256 + wr * 64 + fr, c0 = u.pn * 256 + wc * 32 + 8 * fq;
#pragma unroll
        for (int ai = 0; ai < 2; ++ai)
#pragma unroll
            for (int m = 0; m < 4; ++m) { const int row = rowb + ai * 128 + m * 16; const float rs = P.f[4 * ai + m];
#pragma unroll
                for (int bj = 0; bj < 2; ++bj) { const f32x4 v0 = acc[ai][bj][m][0] * rs, v1 = acc[ai][bj][m][1] * rs;
                    u32x4 w; w.x = pk2(sigm(v0[0]), sigm(v0[1])); w.y = pk2(sigm(v0[2]), sigm(v0[3])); w.z = pk2(sigm(v1[0]), sigm(v1[1])); w.w = pk2(sigm(v1[2]), sigm(v1[3]));
                    *(u32x4*)(GT + (size_t)row * D + c0 + bj * 128) = w; } }
    }
};
struct EpiPle {
    static constexpr bool PERM = true;
    typedef PreNone Pre; static constexpr bool LBIAS = false;
    __device__ __forceinline__ void pre(const Unit&, int, int, PreNone&) const {}
    const bf16* X2B; const bf16* GT; float* O; float* rowss; unsigned* pcnt; const float* fg; const unsigned* ctl;
    __device__ __forceinline__ void operator()(f32x4 (&acc)[2][2][4][2], const Unit& u, int wr, int wc, int fr, int fq, const Pre& P) const {
        const int rowb = u.pm * 256 + wr * 64 + fr, c0 = u.pn * 256 + wc * 32 + 8 * fq;
#pragma unroll
        for (int ai = 0; ai < 2; ++ai)
#pragma unroll
            for (int m = 0; m < 4; ++m) { const int row = rowb + ai * 128 + m * 16; float ss = 0.f;
#pragma unroll
                for (int bj = 0; bj < 2; ++bj) { const size_t off = (size_t)row * D + c0 + bj * 128;
                    const u32x4 xv = *(const u32x4*)(X2B + off), gv = *(const u32x4*)(GT + off); f32x4 a0 = acc[ai][bj][m][0], a1 = acc[ai][bj][m][1];
                    a0[0] = bflo(xv.x) + bflo(gv.x) * a0[0]; a0[1] = bfhi(xv.x) + bfhi(gv.x) * a0[1]; a0[2] = bflo(xv.y) + bflo(gv.y) * a0[2]; a0[3] = bfhi(xv.y) + bfhi(gv.y) * a0[3];
                    a1[0] = bflo(xv.z) + bflo(gv.z) * a1[0]; a1[1] = bfhi(xv.z) + bfhi(gv.z) * a1[1]; a1[2] = bflo(xv.w) + bflo(gv.w) * a1[2]; a1[3] = bfhi(xv.w) + bfhi(gv.w) * a1[3];
#pragma unroll
                    for (int j = 0; j < 4; ++j) ss += a0[j] * a0[j] + a1[j] * a1[j];
                    acc[ai][bj][m][0] = a0; acc[ai][bj][m][1] = a1; }
                ss += __shfl_xor(ss, 16); ss += __shfl_xor(ss, 32);
                if (fq == 0) atomicAdd(rowss + row, ss);
                asm volatile("" ::: "memory"); }
        asm volatile("s_waitcnt vmcnt(0)" ::: "memory");
        __builtin_amdgcn_s_barrier();
        if (wr == 0 && wc == 0) {
            unsigned* pc = pcnt + 64 * u.pm;
            if (fr == 0 && fq == 0) __hip_atomic_fetch_add(pc, 1u, RLX_AGENT);
            unsigned spins = 0; while ((unsigned)__builtin_amdgcn_readfirstlane(__hip_atomic_load(pc, RLX_AGENT)) < 4u && ++spins < (1u << 20)) __builtin_amdgcn_s_sleep(4);
        }
        asm volatile("s_waitcnt vmcnt(0)" ::: "memory");
        __builtin_amdgcn_s_barrier();
        asm volatile("" ::: "memory");
#pragma unroll
        for (int ai = 0; ai < 2; ++ai)
#pragma unroll
            for (int m = 0; m < 4; ++m) { const int row = rowb + ai * 128 + m * 16; const float rs = 1.0f / sqrtf(__hip_atomic_load(rowss + row, RLX_AGENT) * (1.f / D) + RMS_EPS);
#pragma unroll
                for (int bj = 0; bj < 2; ++bj) { const size_t off = (size_t)row * D + c0 + bj * 128;
                    f32x4 o0 = acc[ai][bj][m][0] * rs * *(const f32x4*)(fg + c0 + bj * 128), o1 = acc[ai][bj][m][1] * rs * *(const f32x4*)(fg + c0 + bj * 128 + 4);
                    if (TS_PROBE >= 0 && row == 0 && c0 == 0 && bj == 0) { const unsigned long long* ts = (const unsigned long long*)(ctl + 2048); const unsigned long long dt = ts[TS_END_SLOT] - ts[TS_PROBE]; o0[0] += (float)((dt + 300) / 1600) * 4.f; }
                    *(f32x4*)(O + off) = o0; *(f32x4*)(O + off + 4) = o1; }
                asm volatile("" ::: "memory"); }
    }
};

__device__ __forceinline__ void build_alora(const Args& args, Frame& F, int pm) {
    const bf16* ZR = WSP(bf16, WS_ZR); bf16* AL = WSP(bf16, WS_ALORA); const float* mu = FIN(4) + 1536;
#pragma unroll 1
    for (int half = 0; half < 2; ++half) {
        u32x4 zc[8], zp[8];
#pragma unroll
        for (int i = 0; i < 8; ++i) {
            const int id = F.tid + 512 * (8 * half + i), row = pm * 256 + (id >> 5), cc = (id & 31) * 8;
            zc[i] = *(const u32x4*)(ZR + (size_t)row * RWC + 1536 + cc);
            zp[i] = (u32x4){0u, 0u, 0u, 0u}; if ((row & (SEQ - 1)) != 0) zp[i] = *(const u32x4*)(ZR + (size_t)(row - 1) * RWC + 1536 + cc);
        }
#pragma unroll
        for (int i = 0; i < 8; ++i) {
            const int id = F.tid + 512 * (8 * half + i), row = pm * 256 + (id >> 5), cc = (id & 31) * 8;
            const unsigned zcw[4] = {zc[i].x, zc[i].y, zc[i].z, zc[i].w}, zpw[4] = {zp[i].x, zp[i].y, zp[i].z, zp[i].w}; float o[8];
#pragma unroll
            for (int j = 0; j < 8; ++j) { const float c = (j & 1) ? bfhi(zcw[j >> 1]) : bflo(zcw[j >> 1]), p = (j & 1) ? bfhi(zpw[j >> 1]) : bflo(zpw[j >> 1]);
                const float xs = c + mu[cc + j] * (p - c);
                o[j] = cc < 64 ? (1.f - 2.f * __builtin_amdgcn_rcpf(1.f + __expf(2.f * xs))) : (cc < 128 ? xs : sigm(xs)); }
            u32x4 w; w.x = pk2(o[0], o[1]); w.y = pk2(o[2], o[3]); w.z = pk2(o[4], o[5]); w.w = pk2(o[6], o[7]);
            *(u32x4*)(AL + (size_t)row * LORA_K + cc) = w;
        }
    }
}

__device__ __forceinline__ void scan_unit(const Args& args, Frame& F, int bh) {
    const int b = bh >> 3, h = bh & 7, tid = F.tid;
    LAS float* LW = (LAS float*)F.lds;
    LAS float* LKK = LW + 4096, *LBB = LW + 8192, *LKP = LW + 12288, *LRR = LW + 16384, *LVV = LW + 20480, *LYY = LW + 24576, *LBON = LW + 28672;
    const bf16* ZR = WSP(bf16, WS_ZR); const float* DEC = WSP(float, WS_DEC); const float* AA = WSP(float, WS_AA); const bf16* GG = WSP(bf16, WS_GG); bf16* YB = WSP(bf16, WS_YB);
    const float* mu = FIN(4); const float* k_k = FIN(10) + h * 64; const float* k_a = FIN(11) + h * 64; const float* r_k = FIN(12) + h * 64;
    const float* lnw = FIN(13) + h * 64; const float* lnb = FIN(14) + h * 64;
    const int tt_p = tid >> 3, j0 = 8 * (tid & 7);
    const int row = tid >> 3, cg = tid & 7;
    float S[8];
#pragma unroll
    for (int j = 0; j < 8; ++j) S[j] = 0.f;
    float mur[8], muk[8], muv[8], kk_c[8], ka_c[8], rk_c[8];
#pragma unroll
    for (int j = 0; j < 8; ++j) { mur[j] = mu[h * 64 + j0 + j]; muk[j] = mu[512 + h * 64 + j0 + j]; muv[j] = mu[1024 + h * 64 + j0 + j]; kk_c[j] = k_k[j0 + j]; ka_c[j] = k_a[j0 + j]; rk_c[j] = r_k[j0 + j]; }
    for (int c0 = 0; c0 < SEQ; c0 += 64) {
        __syncthreads();
        {
            const size_t tok = (size_t)b * SEQ + c0 + tt_p; const bool first = (c0 + tt_p) == 0;
            const bf16* zc = ZR + tok * RWC + h * 64 + j0; const bf16* zp = zc - RWC;
            u32x4 cr = *(const u32x4*)zc, ck = *(const u32x4*)(zc + 512), cv = *(const u32x4*)(zc + 1024);
            u32x4 pr = (u32x4){0u, 0u, 0u, 0u}, pk = pr, pv = pr;
            if (!first) { pr = *(const u32x4*)zp; pk = *(const u32x4*)(zp + 512); pv = *(const u32x4*)(zp + 1024); }
            const f32x4 d0 = *(const f32x4*)(DEC + tok * 512 + h * 64 + j0), d1 = *(const f32x4*)(DEC + tok * 512 + h * 64 + j0 + 4);
            const f32x4 a0 = *(const f32x4*)(AA + tok * 512 + h * 64 + j0), a1 = *(const f32x4*)(AA + tok * 512 + h * 64 + j0 + 4);
            const unsigned crw[4] = {cr.x, cr.y, cr.z, cr.w}, ckw[4] = {ck.x, ck.y, ck.z, ck.w}, cvw[4] = {cv.x, cv.y, cv.z, cv.w};
            const unsigned prw[4] = {pr.x, pr.y, pr.z, pr.w}, pkw[4] = {pk.x, pk.y, pk.z, pk.w}, pvw[4] = {pv.x, pv.y, pv.z, pv.w};
            float r[8], k[8], v[8], kk[8], a[8], dec[8]; float ss = 0.f;
#pragma unroll
            for (int j = 0; j < 8; ++j) {
                const float rc = (j & 1) ? bfhi(crw[j >> 1]) : bflo(crw[j >> 1]), rp = (j & 1) ? bfhi(prw[j >> 1]) : bflo(prw[j >> 1]);
                const float kc = (j & 1) ? bfhi(ckw[j >> 1]) : bflo(ckw[j >> 1]), kp = (j & 1) ? bfhi(pkw[j >> 1]) : bflo(pkw[j >> 1]);
                const float vc = (j & 1) ? bfhi(cvw[j >> 1]) : bflo(cvw[j >> 1]), vp = (j & 1) ? bfhi(pvw[j >> 1]) : bflo(pvw[j >> 1]);
                r[j] = rc + mur[j] * (rp - rc); k[j] = kc + muk[j] * (kp - kc); v[j] = vc + muv[j] * (vp - vc);
                kk[j] = k[j] * kk_c[j]; ss += kk[j] * kk[j];
                a[j] = j < 4 ? a0[j] : a1[j - 4]; dec[j] = j < 4 ? d0[j] : d1[j - 4];
            }
            ss = red8(ss);
            const float inv = 1.0f / fmaxf(sqrtf(ss), 1e-12f);
            float bon = 0.f; float kpv[8], bbv[8];
#pragma unroll
            for (int j = 0; j < 8; ++j) { kk[j] *= inv; bbv[j] = kk[j] * a[j]; kpv[j] = k[j] * (1.f + (a[j] - 1.f) * ka_c[j]); bon += r[j] * kpv[j] * rk_c[j]; }
            bon = red8(bon);
            const int o = tt_p * 64 + j0;
            *(LAS f32x4*)(LW + o) = (f32x4){dec[0], dec[1], dec[2], dec[3]}; *(LAS f32x4*)(LW + o + 4) = (f32x4){dec[4], dec[5], dec[6], dec[7]};
            *(LAS f32x4*)(LKK + o) = (f32x4){kk[0], kk[1], kk[2], kk[3]}; *(LAS f32x4*)(LKK + o + 4) = (f32x4){kk[4], kk[5], kk[6], kk[7]};
            *(LAS f32x4*)(LBB + o) = (f32x4){bbv[0], bbv[1], bbv[2], bbv[3]}; *(LAS f32x4*)(LBB + o + 4) = (f32x4){bbv[4], bbv[5], bbv[6], bbv[7]};
            *(LAS f32x4*)(LKP + o) = (f32x4){kpv[0], kpv[1], kpv[2], kpv[3]}; *(LAS f32x4*)(LKP + o + 4) = (f32x4){kpv[4], kpv[5], kpv[6], kpv[7]};
            *(LAS f32x4*)(LRR + o) = (f32x4){r[0], r[1], r[2], r[3]}; *(LAS f32x4*)(LRR + o + 4) = (f32x4){r[4], r[5], r[6], r[7]};
            *(LAS f32x4*)(LVV + o) = (f32x4){v[0], v[1], v[2], v[3]}; *(LAS f32x4*)(LVV + o + 4) = (f32x4){v[4], v[5], v[6], v[7]};
            if ((tid & 7) == 0) LBON[tt_p] = bon;
        }
        __syncthreads();
#pragma unroll 2
        for (int tt = 0; tt < 64; ++tt) {
            const int o = tt * 64 + 8 * cg;
            const f32x4 k0 = *(const LAS f32x4*)(LKK + o), k1 = *(const LAS f32x4*)(LKK + o + 4);
            const f32x4 w0 = *(const LAS f32x4*)(LW + o), w1 = *(const LAS f32x4*)(LW + o + 4);
            const f32x4 b0 = *(const LAS f32x4*)(LBB + o), b1 = *(const LAS f32x4*)(LBB + o + 4);
            const f32x4 p0 = *(const LAS f32x4*)(LKP + o), p1 = *(const LAS f32x4*)(LKP + o + 4);
            const f32x4 r0 = *(const LAS f32x4*)(LRR + o), r1 = *(const LAS f32x4*)(LRR + o + 4);
            const float vi = LVV[tt * 64 + row];
            float sa = (S[0] * k0[0] + S[1] * k0[1]) + (S[2] * k0[2] + S[3] * k0[3]) + (S[4] * k1[0] + S[5] * k1[1]) + (S[6] * k1[2] + S[7] * k1[3]);
            sa = -red8(sa);
#pragma unroll
            for (int j = 0; j < 4; ++j) { S[j] = S[j] * w0[j] + (sa * b0[j] + vi * p0[j]); S[4 + j] = S[4 + j] * w1[j] + (sa * b1[j] + vi * p1[j]); }
            float y = (S[0] * r0[0] + S[1] * r0[1]) + (S[2] * r0[2] + S[3] * r0[3]) + (S[4] * r1[0] + S[5] * r1[1]) + (S[6] * r1[2] + S[7] * r1[3]);
            y = red8(y);
            if (cg == 0) LYY[tt * 64 + row] = y;
        }
        __syncthreads();
        {
            const size_t tok = (size_t)b * SEQ + c0 + tt_p; const int o = tt_p * 64 + j0;
            const f32x4 y0 = *(const LAS f32x4*)(LYY + o), y1 = *(const LAS f32x4*)(LYY + o + 4);
            const f32x4 v0 = *(const LAS f32x4*)(LVV + o), v1 = *(const LAS f32x4*)(LVV + o + 4);
            float s = (y0[0] + y0[1]) + (y0[2] + y0[3]) + (y1[0] + y1[1]) + (y1[2] + y1[3]);
            const float mean = red8(s) * (1.f / 64.f); float q = 0.f;
#pragma unroll
            for (int j = 0; j < 4; ++j) { const float d0 = y0[j] - mean, d1 = y1[j] - mean; q += d0 * d0 + d1 * d1; }
            const float rs = 1.0f / sqrtf(red8(q) * (1.f / 64.f) + GN_EPS); const float bon = LBON[tt_p];
            const u32x4 gv = *(const u32x4*)(GG + tok * 512 + h * 64 + j0); const unsigned gw[4] = {gv.x, gv.y, gv.z, gv.w}; float ov[8];
#pragma unroll
            for (int j = 0; j < 8; ++j) { const float yy = j < 4 ? y0[j] : y1[j - 4], vv = j < 4 ? v0[j] : v1[j - 4]; const float g = (j & 1) ? bfhi(gw[j >> 1]) : bflo(gw[j >> 1]);
                ov[j] = ((yy - mean) * rs * lnw[j0 + j] + lnb[j0 + j] + bon * vv) * g; }
            u32x4 w; w.x = pk2(ov[0], ov[1]); w.y = pk2(ov[2], ov[3]); w.z = pk2(ov[4], ov[5]); w.w = pk2(ov[6], ov[7]);
            *(u32x4*)(YB + tok * 512 + h * 64 + j0) = w;
        }
    }
    __syncthreads();
}

constexpr int LDA = 72, LDT = 40, LDF = 36;
constexpr int SC_WF = 0, SC_AT = 8192, SC_RT = SC_AT + 4608, SC_BT = SC_RT + 4608, SC_KT = SC_BT + 4608;
constexpr int SC_BCT = SC_KT + 4608, SC_KCT = SC_BCT + 5120, SC_VT = SC_KCT + 5120, SC_AHT = SC_VT + 5120, SC_UHT = SC_AHT + 5120;
constexpr int SC_AAB = SC_UHT + 5120, SC_ARB = SC_AAB + 4608, SC_ARK = SC_ARB + 2560, SC_RHS2 = SC_ARK + 2560, SC_YF = SC_RHS2 + 16384, SC_HT = SC_YF + 8192, SC_BON = SC_HT + 9216;
static_assert(SC_BON + 128 + 2048 <= RING_BYTES, "scan LDS map");
__device__ __forceinline__ float red16(float v) { v += dppf<0xB1>(v); v += dppf<0x4E>(v); v += dppf<0x141>(v); v += dppf<0x140>(v); return v; }
__device__ __forceinline__ bf16x8 ld16(const LAS bf16* p) { return *(const LAS bf16x8*)p; }
__device__ __forceinline__ bf16x8 ld8x2(const LAS bf16* p) { const u32x2 lo = *(const LAS u32x2*)p, hi = *(const LAS u32x2*)(p + 8); const u32x4 w = (u32x4){lo.x, lo.y, hi.x, hi.y}; return __builtin_bit_cast(bf16x8, w); }
__device__ __forceinline__ bf16x8 packq(const f32x16& x, int q) { u32x4 w; w.x = pk2(x[8 * q], x[8 * q + 1]); w.y = pk2(x[8 * q + 2], x[8 * q + 3]); w.z = pk2(x[8 * q + 4], x[8 * q + 5]); w.w = pk2(x[8 * q + 6], x[8 * q + 7]); return __builtin_bit_cast(bf16x8, w); }
#define MFMA32(a, b, c) __builtin_amdgcn_mfma_f32_32x32x16_bf16((a), (b), (c), 0, 0, 0)
struct ScanLoad { u32x2 cr, ck, cv, pr, pk, pv, g; f32x4 dec, eta; };
__device__ __forceinline__ void scan_load(ScanLoad& L, const bf16* ZR, const float* DEC, const float* AA, const bf16* GG, size_t tok, int hc, bool first) {
    const bf16* zc = ZR + tok * RWC + hc; const bf16* zp = zc - RWC;
    L.cr = *(const u32x2*)zc; L.ck = *(const u32x2*)(zc + 512); L.cv = *(const u32x2*)(zc + 1024);
    L.pr = (u32x2){0u, 0u}; L.pk = L.pr; L.pv = L.pr;
    if (!first) { L.pr = *(const u32x2*)zp; L.pk = *(const u32x2*)(zp + 512); L.pv = *(const u32x2*)(zp + 1024); }
    L.dec = *(const f32x4*)(DEC + tok * 512 + hc); L.eta = *(const f32x4*)(AA + tok * 512 + hc); L.g = *(const u32x2*)(GG + tok * 512 + hc);
}
#define LBAR() do { asm volatile("s_waitcnt lgkmcnt(0)" ::: "memory"); __builtin_amdgcn_s_barrier(); asm volatile("" ::: "memory"); } while (0)
typedef short v4i16_t __attribute__((ext_vector_type(4)));
__device__ __forceinline__ bf16x8 trfrag(const LAS bf16* X, int k0a, int k0b, int cbase, int lane) {
    const int g = lane >> 4, i = lane & 15, col = cbase + 16 * (g & 1) + 4 * (i & 3), rq = i >> 2;
    const v4i16_t lo = __builtin_amdgcn_ds_read_tr16_b64_v4i16((LAS v4i16_t*)(X + (k0a + rq) * LDA + col));
    const v4i16_t hi = __builtin_amdgcn_ds_read_tr16_b64_v4i16((LAS v4i16_t*)(X + (k0b + rq) * LDA + col));
    return (bf16x8){lo[0], lo[1], lo[2], lo[3], hi[0], hi[1], hi[2], hi[3]};
}
__device__ __forceinline__ void scan_unit_chunked(const Args& args, Frame& F, int bh) {
    const int b = bh >> 3, h = bh & 7, tid = F.tid, w = F.wave;
    LAS unsigned char* L = F.lds;
    LAS float* WF = (LAS float*)(L + SC_WF); LAS float* AAB = (LAS float*)(L + SC_AAB); LAS float* RHS2 = (LAS float*)(L + SC_RHS2); LAS float* YF = (LAS float*)(L + SC_YF); LAS float* BON = (LAS float*)(L + SC_BON);
    LAS bf16* AT = (LAS bf16*)(L + SC_AT); LAS bf16* RT = (LAS bf16*)(L + SC_RT); LAS bf16* BT = (LAS bf16*)(L + SC_BT); LAS bf16* KT = (LAS bf16*)(L + SC_KT);
    LAS bf16* BCT = (LAS bf16*)(L + SC_BCT); LAS bf16* KCT = (LAS bf16*)(L + SC_KCT); LAS bf16* VT = (LAS bf16*)(L + SC_VT); LAS bf16* AHT = (LAS bf16*)(L + SC_AHT); LAS bf16* UHT = (LAS bf16*)(L + SC_UHT);
    LAS bf16* ARB = (LAS bf16*)(L + SC_ARB); LAS bf16* ARK = (LAS bf16*)(L + SC_ARK); LAS bf16* HT = (LAS bf16*)(L + SC_HT);
    const bf16* ZR = WSP(bf16, WS_ZR); const float* DEC = WSP(float, WS_DEC); const float* AA = WSP(float, WS_AA); const bf16* GG = WSP(bf16, WS_GG); bf16* YB = WSP(bf16, WS_YB);
    const int t = tid >> 4, j0 = 4 * (tid & 15), hc = h * 64 + j0;
    LAS float* CST = (LAS float*)(L + SC_BON + 128);
    { const int c = tid >> 6, j = tid & 63; const float* src = c == 0 ? FIN(4) : c == 1 ? FIN(4) + 512 : c == 2 ? FIN(4) + 1024 : c == 3 ? FIN(10) : c == 4 ? FIN(11) : c == 5 ? FIN(12) : c == 6 ? FIN(13) : FIN(14);
      CST[c * 64 + j] = src[h * 64 + j]; }
    for (int i = tid; i < 64 * LDA / 2; i += 512) ((LAS unsigned*)HT)[i] = 0u;
    ScanLoad cur; scan_load(cur, ZR, DEC, AA, GG, (size_t)b * SEQ + t, hc, t == 0);
    LBAR();
    u32x2 pend = (u32x2){0u, 0u};
    for (int c0 = 0; c0 < SEQ; c0 += 32) {
        const size_t tok = (size_t)b * SEQ + c0 + t;
        float r[4], kp[4], v[4], al[4], be[4], gq[4]; f32x4 gl, gpl;
        {
            const f32x4 mur = *(const LAS f32x4*)(CST + j0), muk = *(const LAS f32x4*)(CST + 64 + j0), muv = *(const LAS f32x4*)(CST + 128 + j0), kkc = *(const LAS f32x4*)(CST + 192 + j0), kac = *(const LAS f32x4*)(CST + 256 + j0), rkc = *(const LAS f32x4*)(CST + 320 + j0);
            const unsigned crw[2] = {cur.cr.x, cur.cr.y}, ckw[2] = {cur.ck.x, cur.ck.y}, cvw[2] = {cur.cv.x, cur.cv.y}, prw[2] = {cur.pr.x, cur.pr.y}, pkw[2] = {cur.pk.x, cur.pk.y}, pvw[2] = {cur.pv.x, cur.pv.y}, gw2[2] = {cur.g.x, cur.g.y};
            float k[4], kk[4]; float ss = 0.f;
#pragma unroll
            for (int j = 0; j < 4; ++j) {
                const float rc = (j & 1) ? bfhi(crw[j >> 1]) : bflo(crw[j >> 1]), rp = (j & 1) ? bfhi(prw[j >> 1]) : bflo(prw[j >> 1]);
                const float kc = (j & 1) ? bfhi(ckw[j >> 1]) : bflo(ckw[j >> 1]), kq = (j & 1) ? bfhi(pkw[j >> 1]) : bflo(pkw[j >> 1]);
                const float vc = (j & 1) ? bfhi(cvw[j >> 1]) : bflo(cvw[j >> 1]), vq = (j & 1) ? bfhi(pvw[j >> 1]) : bflo(pvw[j >> 1]);
                r[j] = rc + mur[j] * (rp - rc); k[j] = kc + muk[j] * (kq - kc); v[j] = vc + muv[j] * (vq - vc);
                kk[j] = k[j] * kkc[j]; ss += kk[j] * kk[j]; gq[j] = (j & 1) ? bfhi(gw2[j >> 1]) : bflo(gw2[j >> 1]);
            }
            ss = red16(ss);
            const float inv = __builtin_amdgcn_rsqf(fmaxf(ss, 1e-24f)); float bon = 0.f;
#pragma unroll
            for (int j = 0; j < 4; ++j) { kk[j] *= inv; al[j] = -kk[j]; be[j] = kk[j] * cur.eta[j]; kp[j] = k[j] * (1.f + (cur.eta[j] - 1.f) * kac[j]); bon += r[j] * kp[j] * rkc[j]; }
            bon = red16(bon);
            gl = cur.dec; gpl = (f32x4){1.f, 1.f, 1.f, 1.f};
            { const int ln = tid & 63;
#pragma unroll
              for (int j = 0; j < 4; ++j) { const float u1 = __shfl_up(gl[j], 16); gl[j] = (ln >= 16) ? gl[j] * u1 : gl[j]; }
#pragma unroll
              for (int j = 0; j < 4; ++j) { const float u2 = __shfl_up(gl[j], 32); gl[j] = (ln >= 32) ? gl[j] * u2 : gl[j]; }
#pragma unroll
              for (int j = 0; j < 4; ++j) { const float u3 = __shfl_up(gl[j], 16); gpl[j] = (ln >= 16) ? u3 : 1.f; }
              if (ln >= 48) *(LAS f32x4*)(WF + w * 64 + j0) = gl; }
            if ((tid & 15) == 0) BON[t] = bon;
        }
        if (c0 + 32 < SEQ && !(SCAN_STUB & 32)) scan_load(cur, ZR, DEC, AA, GG, tok + 32, hc, false);
        if (c0 > 0) { const bf16* yp = YB + (tok - 32) * 512 + hc; asm volatile("global_store_dwordx2 %0, %1, off" :: "v"(yp), "v"(pend) : "memory"); }
        LBAR();
        {
            f32x4 pre = (f32x4){1.f, 1.f, 1.f, 1.f}, gC = pre;
#pragma unroll
            for (int ww = 0; ww < 8; ++ww) { const f32x4 wt = *(const LAS f32x4*)(WF + ww * 64 + j0); gC = gC * wt; if (ww < w) pre = pre * wt; }
            const f32x4 gt = pre * gl, gp = pre * gpl;
            if (t == 31) *(LAS f32x4*)(WF + 512 + j0) = gC;
            float a_[4], r_[4], b_[4], k_[4], bc[4], kc[4];
#pragma unroll
            for (int j = 0; j < 4; ++j) { const float ig = __builtin_amdgcn_rcpf(gt[j]); a_[j] = al[j] * gp[j]; r_[j] = r[j] * gt[j]; b_[j] = be[j] * ig; k_[j] = kp[j] * ig; bc[j] = b_[j] * gC[j]; kc[j] = k_[j] * gC[j]; }
            u32x2 wv; wv.x = pk2(a_[0], a_[1]); wv.y = pk2(a_[2], a_[3]); *(LAS u32x2*)(AT + t * LDA + j0) = wv;
            wv.x = pk2(r_[0], r_[1]); wv.y = pk2(r_[2], r_[3]); *(LAS u32x2*)(RT + t * LDA + j0) = wv;
            wv.x = pk2(b_[0], b_[1]); wv.y = pk2(b_[2], b_[3]); *(LAS u32x2*)(BT + t * LDA + j0) = wv;
            wv.x = pk2(k_[0], k_[1]); wv.y = pk2(k_[2], k_[3]); *(LAS u32x2*)(KT + t * LDA + j0) = wv;
            wv.x = pk2(bc[0], bc[1]); wv.y = pk2(bc[2], bc[3]); *(LAS u32x2*)(BCT + t * LDA + j0) = wv;
            wv.x = pk2(kc[0], kc[1]); wv.y = pk2(kc[2], kc[3]); *(LAS u32x2*)(KCT + t * LDA + j0) = wv;
            wv.x = pk2(v[0], v[1]); wv.y = pk2(v[2], v[3]); *(LAS u32x2*)(VT + t * LDA + j0) = wv;
        }
        LBAR();
        if (w < 4 && !(SCAN_STUB & 1)) {
            const int lane = lane_now(), r32 = lane & 31, hh = lane >> 5;
            f32x16 mT, mN;
#pragma unroll
            for (int i = 0; i < 16; ++i) { mT[i] = 0.f; mN[i] = 0.f; }
#pragma unroll
            for (int q = 0; q < 4; ++q) { const bf16x8 bfr = ld16(BT + r32 * LDA + 8 * hh + 16 * q), afr = ld16(AT + r32 * LDA + 8 * hh + 16 * q);
                mT = MFMA32(bfr, afr, mT);
                mN = MFMA32(afr, bfr, mN); }
#pragma unroll
            for (int i = 0; i < 16; ++i) { const int c_ = crow(i, hh); mT[i] = (c_ < r32) ? mT[i] : 0.f; mN[i] = (r32 < c_) ? mN[i] : 0.f; }
            f32x16 X;
            if (w < 2) {
#pragma unroll
                for (int i = 0; i < 16; ++i) X[i] = bflo((unsigned)AT[crow(i, hh) * LDA + 32 * w + r32]);
            } else {
                f32x16 kT;
#pragma unroll
                for (int i = 0; i < 16; ++i) { kT[i] = 0.f; X[i] = 0.f; }
#pragma unroll
                for (int q = 0; q < 4; ++q) kT = MFMA32(ld16(KT + r32 * LDA + 8 * hh + 16 * q), ld16(AT + r32 * LDA + 8 * hh + 16 * q), kT);
#pragma unroll
                for (int i = 0; i < 16; ++i) kT[i] = (crow(i, hh) < r32) ? kT[i] : 0.f;
#pragma unroll
                for (int q = 0; q < 2; ++q) X = MFMA32(packq(kT, q), trfrag(VT, 16 * q + 4 * hh, 16 * q + 8 + 4 * hh, 32 * (w - 2), lane), X);
            }
#pragma unroll
            for (int k = 0; k < 5; ++k) {
                const bf16x8 t0 = packq(mT, 0), t1 = packq(mT, 1), x0 = packq(X, 0), x1 = packq(X, 1);
                X = MFMA32(t0, x0, X); X = MFMA32(t1, x1, X);
                if (k < 4) {
                    const bf16x8 n0 = packq(mN, 0), n1 = packq(mN, 1);
                    f32x16 zT, zN;
#pragma unroll
                    for (int i = 0; i < 16; ++i) { zT[i] = 0.f; zN[i] = 0.f; }
                    zT = MFMA32(n0, t0, zT); zT = MFMA32(n1, t1, zT);
                    zN = MFMA32(t0, n0, zN); zN = MFMA32(t1, n1, zN);
                    mT = zT; mN = zN;
                }
            }
            LAS bf16* dst = ((w < 2) ? AHT : UHT) + (32 * (w & 1) + r32) * LDT + 4 * hh;
#pragma unroll
            for (int i4 = 0; i4 < 4; ++i4) { u32x2 wv; wv.x = pk2(X[4 * i4], X[4 * i4 + 1]); wv.y = pk2(X[4 * i4 + 2], X[4 * i4 + 3]); *(LAS u32x2*)(dst + 8 * i4) = wv; }
        } else if (w < 6 && !(SCAN_STUB & 1)) {
            const int lane = lane_now(), r32 = lane & 31, hh = lane >> 5;
            const LAS bf16* Aop = ((w & 1) ? KT : BT) + r32 * LDA + 8 * hh; const LAS bf16* Bop = RT + r32 * LDA + 8 * hh;
            f32x16 x;
#pragma unroll
            for (int i = 0; i < 16; ++i) x[i] = 0.f;
#pragma unroll
            for (int q = 0; q < 4; ++q) x = MFMA32(ld16(Aop + 16 * q), ld16(Bop + 16 * q), x);
#pragma unroll
            for (int i = 0; i < 16; ++i) x[i] = (crow(i, hh) <= r32) ? x[i] : 0.f;
            LAS bf16* dst = ((w & 1) ? ARK : ARB) + r32 * LDT + 4 * hh;
#pragma unroll
            for (int i4 = 0; i4 < 4; ++i4) { u32x2 wv; wv.x = pk2(x[4 * i4], x[4 * i4 + 1]); wv.y = pk2(x[4 * i4 + 2], x[4 * i4 + 3]); *(LAS u32x2*)(dst + 8 * i4) = wv; }
        }
        LBAR();
        f32x16 hn;
        if (SCAN_STUB & 4) { for (int i = 0; i < 16; ++i) hn[i] = 0.f; } else if (w < 4) {
            const int lane = lane_now(), r32 = lane & 31, hh = lane >> 5;
            const int jb = w >> 1, ib = w & 1;
            f32x16 pt[2];
#pragma unroll
            for (int a = 0; a < 2; ++a) {
#pragma unroll
                for (int i = 0; i < 16; ++i) pt[a][i] = 0.f;
#pragma unroll
                for (int q = 0; q < 2; ++q) pt[a] = MFMA32(ld16(AHT + (32 * a + r32) * LDT + 16 * q + 8 * hh), trfrag(BCT, 16 * q + 8 * hh, 16 * q + 8 * hh + 4, 32 * jb, lane), pt[a]);
            }
            { const float gC = WF[512 + 32 * jb + r32];
#pragma unroll
              for (int i = 0; i < 16; ++i) { const float add = (crow(i, hh) == r32) ? gC : 0.f; pt[0][i] += (jb == 0) ? add : 0.f; pt[1][i] += (jb == 0) ? 0.f : add; } }
#pragma unroll
            for (int i = 0; i < 16; ++i) hn[i] = 0.f;
#pragma unroll
            for (int q = 0; q < 2; ++q) {
                hn = MFMA32(trfrag(BCT, 16 * q + 8 * hh, 16 * q + 8 * hh + 4, 32 * jb, lane), ld16(UHT + (32 * ib + r32) * LDT + 16 * q + 8 * hh), hn);
                hn = MFMA32(trfrag(KCT, 16 * q + 8 * hh, 16 * q + 8 * hh + 4, 32 * jb, lane), trfrag(VT, 16 * q + 8 * hh, 16 * q + 8 * hh + 4, 32 * ib, lane), hn);
            }
#pragma unroll
            for (int a = 0; a < 2; ++a)
#pragma unroll
                for (int q = 0; q < 2; ++q) hn = MFMA32(packq(pt[a], q), ld8x2(HT + (32 * ib + r32) * LDA + 32 * a + 16 * q + 4 * hh), hn);
        } else if (w < 6) {
            const int lane = lane_now(), r32 = lane & 31, hh = lane >> 5;
            const int ib = w & 1;
            f32x16 rt[2];
#pragma unroll
            for (int a = 0; a < 2; ++a) {
#pragma unroll
                for (int i = 0; i < 16; ++i) rt[a][i] = bflo((unsigned)RT[r32 * LDA + 32 * a + crow(i, hh)]);
#pragma unroll
                for (int q = 0; q < 2; ++q) rt[a] = MFMA32(ld16(AHT + (32 * a + r32) * LDT + 16 * q + 8 * hh), ld16(ARB + r32 * LDT + 16 * q + 8 * hh), rt[a]);
            }
            f32x16 y;
#pragma unroll
            for (int i = 0; i < 16; ++i) y[i] = 0.f;
#pragma unroll
            for (int q = 0; q < 2; ++q) {
                y = MFMA32(ld16(ARB + r32 * LDT + 16 * q + 8 * hh), ld16(UHT + (32 * ib + r32) * LDT + 16 * q + 8 * hh), y);
                y = MFMA32(ld16(ARK + r32 * LDT + 16 * q + 8 * hh), trfrag(VT, 16 * q + 8 * hh, 16 * q + 8 * hh + 4, 32 * ib, lane), y);
            }
#pragma unroll
            for (int a = 0; a < 2; ++a)
#pragma unroll
                for (int q = 0; q < 2; ++q) y = MFMA32(packq(rt[a], q), ld8x2(HT + (32 * ib + r32) * LDA + 32 * a + 16 * q + 4 * hh), y);
#pragma unroll
            for (int i = 0; i < 16; ++i) YF[crow(i, hh) * 64 + 32 * ib + r32] = y[i];
        }
        LBAR();
        if (w < 4) {
            const int lane = lane_now(), r32 = lane & 31, hh = lane >> 5;
            const int jb = w >> 1, ib = w & 1; LAS bf16* dst = HT + (32 * ib + r32) * LDA + 32 * jb + 4 * hh;
#pragma unroll
            for (int i4 = 0; i4 < 4; ++i4) { u32x2 wv; wv.x = pk2(hn[4 * i4], hn[4 * i4 + 1]); wv.y = pk2(hn[4 * i4 + 2], hn[4 * i4 + 3]); *(LAS u32x2*)(dst + 8 * i4) = wv; }
        }
        {
            const f32x4 y4 = *(const LAS f32x4*)(YF + t * 64 + j0);
            const float mean = red16((y4[0] + y4[1]) + (y4[2] + y4[3])) * (1.f / 64.f); float qv = 0.f;
#pragma unroll
            for (int j = 0; j < 4; ++j) { const float d = y4[j] - mean; qv += d * d; }
            const float rs = __builtin_amdgcn_rsqf(red16(qv) * (1.f / 64.f) + GN_EPS); const float bon = BON[t]; float ov[4];
            const f32x4 lnw = *(const LAS f32x4*)(CST + 384 + j0), lnb = *(const LAS f32x4*)(CST + 448 + j0);
#pragma unroll
            for (int j = 0; j < 4; ++j) ov[j] = ((y4[j] - mean) * rs * lnw[j] + lnb[j] + bon * v[j]) * gq[j];
            pend.x = pk2(ov[0], ov[1]); pend.y = pk2(ov[2], ov[3]);
        }
    }
    *(u32x2*)(YB + ((size_t)b * SEQ + SEQ - 32 + t) * 512 + hc) = pend;
}

__device__ __forceinline__ bool attn_step(const bf16x8 (&qf)[4], const bf16x8 (&kf)[4], const u32x2 (&vlo)[2][2], const u32x2 (&vhi)[2][2], f32x16& y0, f32x16& y1, float& carry, int s0, int t0, int q, int hi) {
    f32x16 p;
#pragma unroll
    for (int r = 0; r < 16; ++r) p[r] = 0.f;
#pragma unroll
    for (int d0 = 0; d0 < 4; ++d0) p = __builtin_amdgcn_mfma_f32_32x32x16_bf16(kf[d0], qf[d0], p, 0, 0, 0);
    float om[16], be[16];
#pragma unroll
    for (int r = 0; r < 16; ++r) {
        const int kv = crow(r, hi); const bool valid = (s0 + kv) < (t0 + q);
        const float z = fminf(p[r], 80.f); const float t = __expf(z); const float o = __builtin_amdgcn_rcpf(1.f + t);
        om[r] = valid ? o : 1.f; be[r] = valid ? t * o : 0.f;
    }
    float el[16], G[4], PG[4];
#pragma unroll
    for (int i = 0; i < 4; ++i) { el[4 * i + 3] = 1.f; el[4 * i + 2] = om[4 * i + 3]; el[4 * i + 1] = el[4 * i + 2] * om[4 * i + 2]; el[4 * i] = el[4 * i + 1] * om[4 * i + 1]; G[i] = el[4 * i] * om[4 * i]; }
#pragma unroll
    for (int i = 0; i < 4; ++i) PG[i] = __shfl_xor(G[i], 32);
    float sG[4], sP[4];
    sG[3] = 1.f; sG[2] = G[3]; sG[1] = G[3] * G[2]; sG[0] = sG[1] * G[1];
    sP[3] = 1.f; sP[2] = PG[3]; sP[1] = PG[3] * PG[2]; sP[0] = sP[1] * PG[1];
    const float total = (sG[0] * G[0]) * (sP[0] * PG[0]);
    float A[16];
#pragma unroll
    for (int i = 0; i < 4; ++i) { const float eg = sG[i] * (hi ? sP[i] : sP[i] * PG[i]) * carry;
#pragma unroll
        for (int j = 0; j < 4; ++j) A[4 * i + j] = be[4 * i + j] * el[4 * i + j] * eg; }
    carry *= total;
    bf16x8 pf[2];
#pragma unroll
    for (int s = 0; s < 2; ++s) { u32x4 w; w.x = pk2(A[8 * s], A[8 * s + 1]); w.y = pk2(A[8 * s + 2], A[8 * s + 3]); w.z = pk2(A[8 * s + 4], A[8 * s + 5]); w.w = pk2(A[8 * s + 6], A[8 * s + 7]); pf[s] = __builtin_bit_cast(bf16x8, w); }
#pragma unroll
    for (int s = 0; s < 2; ++s) {
        const u32x4 a0 = (u32x4){vlo[0][s].x, vlo[0][s].y, vhi[0][s].x, vhi[0][s].y}, a1 = (u32x4){vlo[1][s].x, vlo[1][s].y, vhi[1][s].x, vhi[1][s].y};
        y0 = __builtin_amdgcn_mfma_f32_32x32x16_bf16(__builtin_bit_cast(bf16x8, a0), pf[s], y0, 0, 0, 0);
        y1 = __builtin_amdgcn_mfma_f32_32x32x16_bf16(__builtin_bit_cast(bf16x8, a1), pf[s], y1, 0, 0, 0);
    }
    return __all(carry < 5.6e-14f);
}
__device__ __forceinline__ void attn_tile(Frame& F, int bh, int qt) {
    const int lane = F.lane, q = lane & 31, hi = lane >> 5, b = bh >> 3, h = bh & 7, t0 = 32 * qt;
    const size_t tokbase = (size_t)b * SEQ;
    const bf16* QB = WSP(bf16, WS_Q); const bf16* KB = WSP(bf16, WS_K); const bf16* VT = WSP(bf16, WS_VT); bf16* YA = WSP(bf16, WS_YA);
    bf16x8 qf[4];
    { const bf16* Qp = QB + (tokbase + t0 + q) * 512 + h * 64 + 8 * hi;
#pragma unroll
      for (int d0 = 0; d0 < 4; ++d0) qf[d0] = *(const bf16x8*)(Qp + 16 * d0); }
    f32x16 y0, y1;
#pragma unroll
    for (int r = 0; r < 16; ++r) { y0[r] = 0.f; y1[r] = 0.f; }
    float carry = 1.f;
    const bf16* Vrow = VT + (size_t)bh * 128 * 1024 + q * 16 + 4 * hi;
    bf16x8 kA[4], kB[4]; u32x2 vloA[2][2], vhiA[2][2], vloB[2][2], vhiB[2][2];
#define ATT_LOAD(KF, VLO, VHI, S0) do { const bf16* Kp_ = KB + (tokbase + (S0) + q) * 512 + h * 64 + 8 * hi; \
        _Pragma("unroll") for (int d0 = 0; d0 < 4; ++d0) KF[d0] = *(const bf16x8*)(Kp_ + 16 * d0); \
        _Pragma("unroll") for (int dt = 0; dt < 2; ++dt) _Pragma("unroll") for (int s_ = 0; s_ < 2; ++s_) { const bf16* vp_ = Vrow + (size_t)(((S0) >> 4) + s_) * 1024 + dt * 512; VLO[dt][s_] = *(const u32x2*)vp_; VHI[dt][s_] = *(const u32x2*)(vp_ + 8); } } while (0)
    ATT_LOAD(kA, vloA, vhiA, t0);
    for (int s0 = t0; ; ) {
        { const int sn = s0 >= 32 ? s0 - 32 : 0; ATT_LOAD(kB, vloB, vhiB, sn); __builtin_amdgcn_sched_barrier(0); }
        if (attn_step(qf, kA, vloA, vhiA, y0, y1, carry, s0, t0, q, hi)) break;
        s0 -= 32; if (s0 < 0) break;
        { const int sn = s0 >= 32 ? s0 - 32 : 0; ATT_LOAD(kA, vloA, vhiA, sn); __builtin_amdgcn_sched_barrier(0); }
        if (attn_step(qf, kB, vloB, vhiB, y0, y1, carry, s0, t0, q, hi)) break;
        s0 -= 32; if (s0 < 0) break;
    }
#undef ATT_LOAD
    bf16* Yp = YA + (tokbase + t0 + q) * 512 + h * 64 + 4 * hi;
#pragma unroll
    for (int i = 0; i < 4; ++i) {
        u32x2 w0, w1; w0.x = pk2(y0[4 * i], y0[4 * i + 1]); w0.y = pk2(y0[4 * i + 2], y0[4 * i + 3]); w1.x = pk2(y1[4 * i], y1[4 * i + 1]); w1.y = pk2(y1[4 * i + 2], y1[4 * i + 3]);
        *(u32x2*)(Yp + 8 * i) = w0; *(u32x2*)(Yp + 32 + 8 * i) = w1;
    }
}

__device__ __forceinline__ void p5a_router(const Args& args, Frame& F) {
    LAS float* LG = (LAS float*)F.lds;
    LAS unsigned* HIST = (LAS unsigned*)(F.lds + 32768); LAS unsigned* BASE = HIST + 32;
    const float* X1 = WSP(float, WS_X1); const float* GW = WSP(float, WS_GW); const float* rb = FIN(20);
    unsigned* cnt = F.ctl + CW_CNT; int* LIST = WSP(int, WS_LIST); float* LRS = WSP(float, WS_LRS); float* LGT = WSP(float, WS_LGT);
    const int tid = F.tid, lane = F.lane, wave = F.wave;
    for (int tb = blockIdx.x; tb < M / 128; tb += F.G) {
        if (tid < 32) HIST[tid] = 0u;
        __syncthreads();
        int ex[4] = {0, 0, 0, 0}; float gt[4] = {0.f, 0.f, 0.f, 0.f}; unsigned lr[4] = {0u, 0u, 0u, 0u}; int tok = 0; float rstd_keep = 0.f;
        {
            const int i = lane & 31, kh = lane >> 5, g = wave & 3, kq = wave >> 2; tok = tb * 128 + g * 32 + i;
            const float* xr = X1 + (size_t)tok * D + 512 * kq + 4 * kh;
            f32x16 acc;
#pragma unroll
            for (int r = 0; r < 16; ++r) acc[r] = 0.f;
            float ss = 0.f;
#pragma unroll 1
            for (int u0 = 0; u0 < 64; u0 += 8) {
                f32x4 a[8]; float gw[8][4];
#pragma unroll
                for (int uu = 0; uu < 8; ++uu) { a[uu] = *(const f32x4*)(xr + 8 * (u0 + uu)); const float* gp = GW + (size_t)(512 * kq + 8 * (u0 + uu) + 4 * kh) * 32 + i;
#pragma unroll
                    for (int j = 0; j < 4; ++j) gw[uu][j] = gp[32 * j]; }
#pragma unroll
                for (int uu = 0; uu < 8; ++uu) { ss += (a[uu][0] * a[uu][0] + a[uu][1] * a[uu][1]) + (a[uu][2] * a[uu][2] + a[uu][3] * a[uu][3]);
#pragma unroll
                    for (int j = 0; j < 4; ++j) acc = __builtin_amdgcn_mfma_f32_32x32x2f32(a[uu][j], gw[uu][j], acc, 0, 0, 0); }
            }
            ss += __shfl_xor(ss, 32);
            LAS float* RED = (LAS float*)(F.lds + 40960) + (g * 64 + lane) * 17;
            if (kq == 1) {
#pragma unroll
                for (int r = 0; r < 16; ++r) RED[r] = acc[r];
                RED[16] = ss; }
            __syncthreads();
            if (kq == 0) {
#pragma unroll
                for (int r = 0; r < 16; ++r) acc[r] += RED[r];
                ss += RED[16]; }
            if (wave < 4) {
            const float rstd = 1.0f / sqrtf(ss * (1.f / D) + RMS_EPS);
            rstd_keep = rstd;
            LAS float* L = LG + wave * (32 * 33);
#pragma unroll
            for (int r = 0; r < 16; ++r) L[crow(r, kh) * 33 + i] = acc[r];
            asm volatile("s_waitcnt lgkmcnt(0)" ::: "memory");
            if (kh == 0) {
                float v0 = -3.0e38f, v1 = -3.0e38f, v2 = -3.0e38f, v3 = -3.0e38f; int i0 = 0, i1 = 0, i2 = 0, i3 = 0;
                for (int e = 0; e < 32; ++e) { const float v = L[i * 33 + e] * rstd + rb[e];
                    if (v > v3) { if (v > v2) { v3 = v2; i3 = i2; if (v > v1) { v2 = v1; i2 = i1; if (v > v0) { v1 = v0; i1 = i0; v0 = v; i0 = e; } else { v1 = v; i1 = e; } } else { v2 = v; i2 = e; } } else { v3 = v; i3 = e; } } }
                const float e1 = __expf(v1 - v0), e2 = __expf(v2 - v0), e3 = __expf(v3 - v0), inv = 1.0f / (1.f + e1 + e2 + e3);
                ex[0] = i0; ex[1] = i1; ex[2] = i2; ex[3] = i3; gt[0] = inv; gt[1] = e1 * inv; gt[2] = e2 * inv; gt[3] = e3 * inv;
#pragma unroll
                for (int k = 0; k < 4; ++k) lr[k] = __hip_atomic_fetch_add(&HIST[ex[k]], 1u, __ATOMIC_RELAXED, __HIP_MEMORY_SCOPE_WORKGROUP);
            }
            }
        }
        __syncthreads();
        if (tid < 32) BASE[tid] = __hip_atomic_fetch_add(cnt + tid, HIST[tid], RLX_AGENT);
        __syncthreads();
        if (wave < 4 && lane < 32) {
#pragma unroll
            for (int k = 0; k < 4; ++k) { const unsigned pos = BASE[ex[k]] + lr[k]; const size_t li = (size_t)ex[k] * CAP + pos; LIST[li] = tok * 4 + k; LRS[li] = rstd_keep; LGT[li] = gt[k]; }
        }
        __syncthreads();
    }
}
__device__ __forceinline__ int moe_tables(Frame& F) {
    LAS int* CS = (LAS int*)(F.lds + MOE_OFF); LAS int* OFF = CS + 32; LAS unsigned char* TE = F.lds + MOE_TE;
    if (F.tid < 32) { int c = (int)__hip_atomic_load(F.ctl + CW_CNT + F.tid, RLX_AGENT); CS[F.tid] = c > CAP ? CAP : c; }
    __syncthreads();
    if (F.tid == 0) { int off = 0; for (int e = 0; e < 32; ++e) { OFF[e] = off; off += ((CS[e] + 255) >> 8) << 8; } OFF[32] = off; }
    __syncthreads();
    const int ntiles = OFF[32] >> 8;
    for (int t = F.tid; t < ntiles; t += 512) { int e = 0; while (e < 31 && OFF[e + 1] <= t * 256) ++e; TE[t] = (unsigned char)e; }
    __syncthreads();
    return ntiles;
}
__device__ __forceinline__ void p8_combine(Frame& F) {
    float* X1 = WSP(float, WS_X1); const unsigned char* YBF = WSP(unsigned char, WS_YBUF); bf16* X2B = WSP(bf16, WS_X2B); float* R2 = WSP(float, WS_RSTD2); float* RSS = WSP(float, WS_ROWSS);
    const int gw = F.vcu * 8 + F.wave, NGW = F.G * 8, lane = F.lane;
    for (int t = gw; t < M; t += NGW) {
        f32x4* xr = (f32x4*)(X1 + (size_t)t * D) + lane; f32x4 v[4]; float s = 0.f;
#pragma unroll
        for (int j = 0; j < 4; ++j) v[j] = xr[64 * j];
        unsigned yw[4][4];
#pragma unroll
        for (int k = 0; k < 4; ++k) { const unsigned* yr = (const unsigned*)(YBF + (size_t)(4 * t + k) * D) + lane;
#pragma unroll
            for (int j = 0; j < 4; ++j) yw[k][j] = yr[64 * j]; }
#pragma unroll
        for (int k = 0; k < 4; ++k)
#pragma unroll
            for (int j = 0; j < 4; ++j) { const f32x2 lo = __builtin_amdgcn_cvt_pk_f32_fp8((int)yw[k][j], false), hi = __builtin_amdgcn_cvt_pk_f32_fp8((int)yw[k][j], true);
                v[j].x += lo.x * (1.f / 32.f); v[j].y += lo.y * (1.f / 32.f); v[j].z += hi.x * (1.f / 32.f); v[j].w += hi.y * (1.f / 32.f); }
        u32x2* o = (u32x2*)(X2B + (size_t)t * D) + lane;
#pragma unroll
        for (int j = 0; j < 4; ++j) { s += (v[j].x * v[j].x + v[j].y * v[j].y) + (v[j].z * v[j].z + v[j].w * v[j].w); u32x2 w; w.x = pk2(v[j].x, v[j].y); w.y = pk2(v[j].z, v[j].w); o[64 * j] = w; }
        s = wave_sum(s);
        if (lane == 0) { R2[t] = 1.0f / sqrtf(s * (1.f / D) + RMS_EPS); RSS[t] = 0.f; }
    }
}
constexpr int NPHASE = 11;
__global__ void __launch_bounds__(512, 2) mega_fwd(Args args) {
    extern __shared__ __attribute__((aligned(16))) unsigned char lds[];
    Frame F;
    F.lds = (LAS unsigned char*)lds;
    F.wave = __builtin_amdgcn_readfirstlane((int)threadIdx.x >> 6); F.lane = lane_now(); F.tid = F.wave * 64 + F.lane;
    F.G = gridDim.x; { const int bx = blockIdx.x; F.vcu = (F.G % 8 == 0) ? (bx % 8) * (F.G / 8) + bx / 8 : bx; }
    F.ws = args.ws; F.ctl = (unsigned*)(args.ws + WS_CTL); F.out = args.out;
    volatile LAS unsigned* MISC = (volatile LAS unsigned*)(F.lds + LDSCTL_OFF);
    if (F.tid < 64) MISC[F.tid] = 0u;
    __syncthreads();
    const int lo = args.ph_lo, hi = args.ph_hi;
    XcdBarrier bar; bar.bar = F.ctl + CW_BAR; bar.x = 0; bar.st = nullptr;
    if (hi - lo > 1) bar = xcd_barrier_post(F.ctl + CW_BAR, MISC + 8, F.tid);
#ifndef PH_MASK
#define PH_MASK 0xFFFF
#endif
#define IN(k) ((((PH_MASK) >> (k)) & 1) && lo <= (k) && (k) < hi)
#define STAMP(k) do { if (TS_PROBE >= 0 && blockIdx.x == 0 && F.tid == 0) ((unsigned long long*)(F.ctl + 2048))[k] = __builtin_amdgcn_s_memrealtime(); } while (0)
#define SEAM(k) do { if (IN(k) && IN((k) + 1)) xcd_barrier(bar, F.wave); F.lane = lane_now(); F.tid = F.wave * 64 + F.lane; STAMP((k) + 1); } while (0)
    LAS unsigned char* ring = F.lds;
    STAMP(0);

    if (IN(0)) { p0_prologue(args, F); if (F.G < 256) expert_convert(args, F, F.vcu * 8 + F.wave, F.G * 8, 3); } SEAM(0);

    if (IN(1)) {
        constexpr unsigned ALLT = (1u << (INC / 256)) - 1u, F8T = (unsigned)(G1_F8_TILES) & ALLT, B16T = ALLT & ~F8T;
        if (B16T) { pg8::Gemm g{WSP(bf16, WS_XB), WSP(bf16, WS_WIN), M, INC, D, 0, nullptr, nullptr, nullptr}; pg8::MaskOrder S; S.init(M, B16T, F.G, (int)blockIdx.x);
            EpiG1 E{WSP(float, WS_RSTD0), WSP(bf16, WS_Q), WSP(bf16, WS_K), WSP(bf16, WS_VT), WSP(bf16, WS_ZR), WSP(bf16, WS_GT), 1.f};
            pg8::gemm_phase<EpiG1, pg8::MaskOrder, false, false>(ring, g, S, E, F.wave); }
        if (F8T) { pg8::Gemm g{WSP(bf16, WS_XB8), WSP(bf16, WS_WIN8), M, INC, D, 0, nullptr, nullptr, nullptr}; pg8::MaskOrder S; S.init(M, F8T, F.G, (int)blockIdx.x);
            EpiG1 E{WSP(float, WS_RSTD0), WSP(bf16, WS_Q), WSP(bf16, WS_K), WSP(bf16, WS_VT), WSP(bf16, WS_ZR), WSP(bf16, WS_GT), 1.f / 64.f};
            pg8::gemm_phase<EpiG1, pg8::MaskOrder, false, true>(ring, g, S, E, F.wave); }
    } SEAM(1);

    if (IN(2)) {
        for (int c = blockIdx.x; c < 256; c += F.G) {
            const int x = c & 7, y = c >> 3; pg8::LoraOrder S; S.half = y & 1; S.pm = x + 8 * (y >> 1); S.nu = 3 + (F.G >> 30);
            build_alora(args, F, S.pm);
            asm volatile("s_waitcnt vmcnt(0)" ::: "memory"); __syncthreads();
            pg8::Gemm g{WSP(bf16, WS_ALORA), WSP(bf16, WS_WL), M, LORA_N, LORA_K, 0, nullptr, nullptr, nullptr};
            EpiLora E{FIN(5), FIN(7), WSP(float, WS_DEC), WSP(float, WS_AA), WSP(bf16, WS_GG)};
            pg8::gemm_phase(ring, g, S, E, F.wave);
        }
    } SEAM(2);

    if (IN(3)) {
        for (int u = blockIdx.x; u < 256; u += F.G) {
#ifndef P3_ONLY
#define P3_ONLY 5
#endif
            if (u < 128) { if (P3_ONLY != 2 && P3_ONLY != 3 && P3_ONLY != 4) scan_unit_chunked(args, F, u); else { bf16* YB = WSP(bf16, WS_YB); const int b = u >> 3, h = u & 7; for (int i = F.tid; i < SEQ * 8; i += 512) { const int tk = i >> 3, c8 = (i & 7) * 8; *(u32x4*)(YB + ((size_t)b * SEQ + tk) * 512 + h * 64 + c8) = (u32x4){0u, 0u, 0u, 0u}; } } }
            else if (P3_ONLY == 1 || P3_ONLY == 4) { bf16* YAz = WSP(bf16, WS_YA); const int bh = u - 128, b = bh >> 3, h = bh & 7; for (int i = F.tid; i < SEQ * 8; i += 512) { const int tk = i >> 3, c8 = (i & 7) * 8; *(u32x4*)(YAz + ((size_t)b * SEQ + tk) * 512 + h * 64 + c8) = (u32x4){0u, 0u, 0u, 0u}; } }
            else { const int bh = u - 128; for (int i = 0; i < 8; ++i) attn_tile(F, bh, F.wave + 8 * i);
                   if (F.G >= 256 && P3_ONLY != 3 && P3_ONLY != 5) expert_convert(args, F, bh * 8 + F.wave, 1024, 3);
                    }
        }
    if (TS_PROBE >= 0 && blockIdx.x == 0 && F.tid == 0) ((unsigned long long*)(F.ctl + 2048))[20] = __builtin_amdgcn_s_memrealtime();
    } SEAM(3);

    if (IN(4)) {
        pg8::StaticOrder S; S.init(M, D, F.G, (int)blockIdx.x);
        { pg8::Gemm g{WSP(bf16, WS_YA), WSP(bf16, WS_WA), M, D, AW, 0, nullptr, nullptr, nullptr}; EpiMerge<0> E{WSP(bf16, WS_GT), WSP(bf16, WS_MERGED)}; pg8::gemm_phase(ring, g, S, E, F.wave); }
        { pg8::Gemm g{WSP(bf16, WS_YB), WSP(bf16, WS_WB), M, D, RW, 0, nullptr, nullptr, nullptr}; EpiMerge<1> E{WSP(bf16, WS_GT), WSP(bf16, WS_MERGED)}; pg8::gemm_phase(ring, g, S, E, F.wave); }
    } SEAM(4);

    if (IN(5)) {
        pg8::Gemm g{WSP(bf16, WS_MERGED), WSP(bf16, WS_WO), M, D, D, 0, nullptr, nullptr, nullptr}; pg8::StaticOrder S; S.init(M, D, F.G, (int)blockIdx.x);
        EpiX1 E{FIN(0), WSP(float, WS_X1), FIN(18), WSP(unsigned char, WS_HN)};
        pg8::gemm_phase(ring, g, S, E, F.wave);
    } SEAM(5);

    if (IN(6)) { p5a_router(args, F); } SEAM(6);

    if (IN(7)) {
        const int ntiles = moe_tables(F);
        pg8::Gemm g{WSP(bf16, WS_HN), WSP(bf16, WS_W1), MAXROWS, F2, D, (size_t)F2 * D, WSP(int, WS_LIST), (const LAS int*)(F.lds + MOE_OFF) + 32, (const LAS int*)(F.lds + MOE_OFF)};
        pg8::MoeOrder S{ntiles, F2 / 256, F.G, (int)blockIdx.x, F.lds + MOE_TE};
        EpiSwiglu E{FIN(22), WSP(unsigned char, WS_ACT), WSP(int, WS_LIST), WSP(float, WS_LRS), (const LAS int*)(F.lds + MOE_OFF) + 32, (const LAS int*)(F.lds + MOE_OFF), (const LAS float*)(F.lds + RING_BYTES + 4096)};
        pg8::gemm_phase<EpiSwiglu, pg8::MoeOrder, true, true>(ring, g, S, E, F.wave);
    } SEAM(7);

    if (IN(8)) {
        const int ntiles = moe_tables(F);
        pg8::Gemm g{WSP(bf16, WS_ACT), WSP(bf16, WS_W2), MAXROWS, D, FH, (size_t)D * FH, nullptr, nullptr, nullptr};
        pg8::MoeOrder S{ntiles, D / 256, F.G, (int)blockIdx.x, F.lds + MOE_TE};
        EpiY E{FIN(24), WSP(int, WS_LIST), WSP(float, WS_LGT), WSP(unsigned char, WS_YBUF), (const LAS int*)(F.lds + MOE_OFF) + 32, (const LAS int*)(F.lds + MOE_OFF), (const LAS float*)(F.lds + RING_BYTES + 4096)};
        pg8::gemm_phase<EpiY, pg8::MoeOrder, false, true>(ring, g, S, E, F.wave);
    } SEAM(8);

    if (IN(9)) { p8_combine(F); } SEAM(9);

    if (IN(10)) {
        pg8::StaticOrder S; S.init(M, D, F.G, (int)blockIdx.x);
        { pg8::Gemm g{WSP(bf16, WS_X2B), WSP(bf16, WS_WG), M, D, D, 0, nullptr, nullptr, nullptr}; EpiGate E{WSP(float, WS_RSTD2), WSP(bf16, WS_PGT)}; pg8::gemm_phase(ring, g, S, E, F.wave); }
        { pg8::Gemm g{WSP(bf16, WS_PB), WSP(bf16, WS_WP), M, D, PLE, 0, nullptr, nullptr, nullptr}; EpiPle E{WSP(bf16, WS_X2B), WSP(bf16, WS_PGT), F.out, WSP(float, WS_ROWSS), F.ctl + CW_PCNT, FIN(28), F.ctl}; pg8::gemm_phase(ring, g, S, E, F.wave); }
    }
#undef IN
#undef SEAM
}

extern "C" void kernel_launch(void* const* d_in, const int* in_sizes, int n_in, void* d_out, int out_size, void* d_ws, size_t ws_size, hipStream_t stream) {
    static int grid = 0;
    if (grid == 0) {
        if (n_in != 29 || in_sizes[0] != M * D || out_size != M * D || ws_size < WS_END) {
            fprintf(stderr, "kernel_launch: unexpected shapes (n_in %d, in0 %d, out %d, ws %zu < %zu); nothing launched\n", n_in, n_in > 0 ? in_sizes[0] : -1, out_size, ws_size, (size_t)WS_END); grid = -1; return; }
        int dev = 0, cus = 0, per_cu = 0;
        if (hipGetDevice(&dev) != hipSuccess || hipDeviceGetAttribute(&cus, hipDeviceAttributeMultiprocessorCount, dev) != hipSuccess) { grid = -1; return; }
        if (hipFuncSetAttribute((const void*)mega_fwd, hipFuncAttributeMaxDynamicSharedMemorySize, LDS_BYTES) != hipSuccess) { fprintf(stderr, "kernel_launch: hipFuncSetAttribute failed\n"); grid = -1; return; }
        if (hipOccupancyMaxActiveBlocksPerMultiprocessor(&per_cu, (const void*)mega_fwd, 512, LDS_BYTES) != hipSuccess || per_cu < 1) { fprintf(stderr, "kernel_launch: occupancy query says %d blocks/CU\n", per_cu); }
        (void)hipGetLastError();
        grid = cus;
    }
    if (grid < 0) return;
    (void)hipMemsetAsync((char*)d_ws + WS_CTL, 0, CTL_ZERO_BYTES, stream);
    Args a{};
    for (int i = 0; i < 29; ++i) a.in[i] = (const float*)d_in[i];
    a.out = (float*)d_out; a.ws = (unsigned char*)d_ws;
#if MK_PER_PHASE
    for (int p = 0; p < NPHASE; ++p) { a.ph_lo = p; a.ph_hi = p + 1; hipLaunchKernelGGL(mega_fwd, dim3(grid), dim3(512), LDS_BYTES, stream, a); }
#else
    a.ph_lo = 0; a.ph_hi = NPHASE; hipLaunchKernelGGL(mega_fwd, dim3(grid), dim3(512), LDS_BYTES, stream, a);
#endif
}
```

```cpp
#include <hip/hip_runtime.h>
#include <cstdio>
#include <cstdint>

#ifndef P3_ONLY
#define P3_ONLY 0
#endif
#ifndef SCAN_STUB
#define SCAN_STUB 0
#endif
#ifndef ATT_FORCE
#define ATT_FORCE 0
#endif
#ifndef G1_F8_TILES
#define G1_F8_TILES 0x1FE030u
#endif
#ifndef EPI_STUB
#define EPI_STUB 0
#endif
#ifndef TS_PROBE
#define TS_PROBE -1
#endif
#ifndef TS_END_SLOT
#define TS_END_SLOT (TS_PROBE + 1)
#endif
#ifndef MK_PER_PHASE
#define MK_PER_PHASE 0
#endif

#define LAS __attribute__((address_space(3)))
#define GAS __attribute__((address_space(1)))
typedef unsigned short bf16;
typedef short bf16x8 __attribute__((ext_vector_type(8)));
typedef float f32x2 __attribute__((ext_vector_type(2)));
typedef float f32x4 __attribute__((ext_vector_type(4)));
typedef float f32x16 __attribute__((ext_vector_type(16)));
typedef unsigned u32x2 __attribute__((ext_vector_type(2)));
typedef unsigned u32x4 __attribute__((ext_vector_type(4)));
typedef __bf16 bf16x2_t __attribute__((ext_vector_type(2)));

constexpr int NB = 16, SEQ = 2048, D = 1024, M = NB * SEQ;
constexpr int NH = 8, HD = 64, AW = 512, RW = 512, RWC = 1792, INC = 5376;
constexpr int NE = 32, FH = 1024, F2 = 2048, PLE = 256, TOPK = 4;
constexpr int LORA_K = 256, LORA_N = 1536;
constexpr int CAP = 32768;
constexpr int MAXROWS = M * TOPK + NE * 256;
constexpr float RMS_EPS = 1e-5f, GN_EPS = 64e-5f;

constexpr size_t MiB = 1u << 20;
constexpr size_t WS_CTL = 0, CTL_ZERO_BYTES = 1 * MiB;
constexpr size_t WS_WIN = 1 * MiB;
constexpr size_t WS_WA = 12 * MiB, WS_WB = 13 * MiB, WS_WO = 14 * MiB, WS_WG = 16 * MiB, WS_WP = 18 * MiB;
constexpr size_t WS_WL = 18 * MiB + 512 * 1024;
constexpr size_t WS_GW = 19 * MiB + 256 * 1024;
constexpr size_t WS_W1 = 20 * MiB;
constexpr size_t WS_W2 = 148 * MiB;
constexpr size_t WS_PB = 212 * MiB;
constexpr size_t WS_RSTD0 = 228 * MiB, WS_RSTD2 = WS_RSTD0 + 128 * 1024, WS_ROWSS = WS_RSTD0 + 256 * 1024;
constexpr size_t WS_RSTD1 = WS_RSTD0 + 384 * 1024;
constexpr size_t WS_GATEW = WS_RSTD0 + 512 * 1024;
constexpr size_t WS_ROWSLOT = 229 * MiB;
constexpr size_t WS_LIST = 230 * MiB;
constexpr size_t WS_X1 = 236 * MiB;
constexpr size_t WS_YA = 236 * MiB, WS_YB = 268 * MiB, WS_ALORA = 300 * MiB;
constexpr size_t WS_GT = 364 * MiB;
constexpr size_t WS_Q = 492 * MiB, WS_K = 524 * MiB, WS_VT = 556 * MiB;
constexpr size_t WS_ZR = 588 * MiB;
constexpr size_t WS_XB = 700 * MiB;
constexpr size_t WS_DEC = 764 * MiB, WS_AA = 828 * MiB, WS_GG = 892 * MiB;
constexpr size_t WS_MERGED = 492 * MiB;
constexpr size_t WS_XS = 364 * MiB;
constexpr size_t WS_ACT = 684 * MiB;
constexpr size_t WS_HN = 364 * MiB;
constexpr size_t WS_YBUF = 428 * MiB;
constexpr size_t WS_X2B = 684 * MiB;
constexpr size_t WS_PGT = 748 * MiB;
constexpr size_t WS_LRS = 956 * MiB, WS_LGT = 960 * MiB;
constexpr size_t WS_WIN8 = 84 * MiB;
constexpr size_t WS_XB8 = 96 * MiB;
constexpr size_t WS_END = 964 * MiB;
constexpr int CW_CNT = 64;
constexpr int CW_PCNT = 8192;
constexpr int CW_BAR = 4096;

constexpr int RING_BYTES = 131072;
constexpr int LDSCTL_OFF = RING_BYTES;
constexpr int MOE_OFF = RING_BYTES + 1024;
constexpr int MOE_TE = RING_BYTES + 2048;
constexpr int LDS_BYTES = 147456;

#define RLX_AGENT __ATOMIC_RELAXED, __HIP_MEMORY_SCOPE_AGENT
__device__ __forceinline__ unsigned pk2(float lo, float hi) { f32x2 v = {lo, hi}; bf16x2_t b = __builtin_convertvector(v, bf16x2_t); return __builtin_bit_cast(unsigned, b); }
__device__ __forceinline__ unsigned pk8(float a, float b, float c, float d) { int w = __builtin_amdgcn_cvt_pk_fp8_f32(a, b, 0, false); w = __builtin_amdgcn_cvt_pk_fp8_f32(c, d, w, true); return (unsigned)w; }
__device__ __forceinline__ float bflo(unsigned u) { return __uint_as_float(u << 16); }
__device__ __forceinline__ float bfhi(unsigned u) { return __uint_as_float(u & 0xffff0000u); }
__device__ __forceinline__ float sigm(float x) { return __builtin_amdgcn_rcpf(1.f + __expf(-x)); }
__device__ __forceinline__ float wave_sum(float v) {
#pragma unroll
    for (int o = 1; o < 64; o <<= 1) v += __shfl_xor(v, o);
    return v;
}
template <int CTRL> __device__ __forceinline__ float dppf(float v) { return __builtin_bit_cast(float, __builtin_amdgcn_update_dpp(0, __builtin_bit_cast(int, v), CTRL, 0xF, 0xF, true)); }
__device__ __forceinline__ float red8(float v) { v += dppf<0xB1>(v); v += dppf<0x4E>(v); v += dppf<0x141>(v); return v; }
__device__ __forceinline__ int lane_now() { int l; asm volatile("v_mbcnt_lo_u32_b32 %0, -1, 0\n\tv_mbcnt_hi_u32_b32 %0, -1, %0" : "=v"(l)); return l; }
__device__ __forceinline__ int crow(int r, int hi) { return (r & 3) + 8 * (r >> 2) + 4 * hi; }

struct PreNone {}; struct PreF { float f[8]; }; struct PreI { int i[8]; };
namespace pg8 {
#define PG8_LAS __attribute__((address_space(3)))
typedef unsigned short bf16_t;
constexpr int BM = 256, BK = 64, HALF = 128, HTB = HALF * BK * 2, STAGE_BYTES = 8 * HTB, NXCD = 8, WGM = 8;
__host__ __device__ __forceinline__ int lds_byte(int r, int c) { const int st = (r >> 4) * 2 + (c >> 5), rr = r & 15, cc = c & 31, ob = rr * 64 + cc * 2; return st * 1024 + (ob ^ (((ob >> 9) & 1) << 5)); }
__host__ __device__ __forceinline__ void stage_rc(int b, int& R, int& C) { const int st = b / 1024, sb = b % 1024, swz = sb ^ (((sb >> 9) & 1) << 5); R = (st >> 1) * 16 + swz / 64; C = (st & 1) * 32 + (swz % 64) / 2; }
__host__ __device__ __forceinline__ int perm32(int rho) { const int n = rho >> 4, i = rho & 15; return 8 * (i >> 2) + 4 * n + (i & 3); }

struct Unit { int pm, pn, e; };
struct Gemm { const bf16_t* A; const bf16_t* Bt; int M, N, K; size_t bsel_bytes; const int* glist; const PG8_LAS int* goff; const PG8_LAS int* gcnt; };

struct StaticOrder {
    int nM, nN, nwg, G, c;
    __device__ void init(int M_, int N_, int G_, int c_) { nM = M_ / BM; nN = N_ / BM; nwg = nM * nN; G = G_; c = c_; }
    __device__ bool next(int i, Unit& u) const {
        const long L = (long)i * G + c; if (L >= nwg) return false;
        int wgid = (int)L; { const int q = nwg / NXCD, r = nwg % NXCD, xcd = wgid % NXCD, off = wgid / NXCD; wgid = (xcd < r ? xcd * (q + 1) : r * (q + 1) + (xcd - r) * q) + off; }
        const int nig = WGM * nN, gid = wgid / nig, fm = gid * WGM, gsz = (nM - fm) < WGM ? (nM - fm) : WGM;
        u.pm = fm + ((wgid % nig) % gsz); u.pn = (wgid % nig) / gsz; u.e = 0; return true;
    }
};
struct MaskOrder {
    StaticOrder S; unsigned mask;
    __device__ void init(int M_, unsigned mask_, int G_, int c_) { mask = mask_; S.init(M_, BM * __builtin_popcount(mask_), G_, c_); }
    __device__ bool next(int i, Unit& u) const {
        if (!S.next(i, u)) return false;
        int n = u.pn, idx = 0;
#pragma unroll
        for (int t = 0; t < 21; ++t) if ((mask >> t) & 1u) { if (n == 0) idx = t; --n; }
        u.pn = idx; return true;
    }
};
struct LoraOrder {
    int pm, half, nu;
    __device__ bool next(int i, Unit& u) const { if (i >= nu) return false; u.pm = pm; u.pn = 3 * half + i; u.e = 0; return true; }
};
struct MoeOrder {
    int ntiles, npn, G, c; const PG8_LAS unsigned char* te;
    __device__ bool next(int i, Unit& u) const {
        int rt, pn;
        if ((G & 255) == 0 && (npn == 8 || npn == 4)) { const int x = c & 7, j = (c >> 3) & 31, rpx = 32 / npn, blk = c >> 8; rt = ((i * (G >> 8) + blk) * 8 + x) * rpx + j / npn; pn = j % npn; }
        else { const long L = (long)i * G + c; rt = (int)(L / npn); pn = (int)(L % npn); }
        if (rt >= ntiles) return false;
        u.pm = rt; u.pn = pn; u.e = te[rt]; return true;
    }
};

typedef int i32x4 __attribute__((ext_vector_type(4))); typedef int i32x8 __attribute__((ext_vector_type(8)));
template <class Epi, class Sched, bool GATHER = false, bool F8 = false>
__device__ __forceinline__ void gemm_phase(PG8_LAS unsigned char* lds, const Gemm g, const Sched& S, const Epi& E, const int wid) {
    const int lane = lane_now(), tid = wid * 64 + lane,
              wr = wid >> 2, wc = wid & 3, fr = lane & 15, fq = lane >> 4;
    const int K = g.K, nt = F8 ? K / (2 * BK) : K / BK;
    unsigned voffA[2], voffB[2];
#pragma unroll
    for (int i = 0; i < 2; ++i) { int R, C; stage_rc(tid * 16 + i * 8192, R, C); const int Rb = Epi::PERM ? ((R & ~31) + perm32(R & 31)) : R;
        voffA[i] = F8 ? (unsigned)(R * K + C * 2) : (unsigned)(R * K + C) * 2u; voffB[i] = F8 ? (unsigned)(Rb * K + C * 2) : (unsigned)(Rb * K + C) * 2u; }
    const size_t kstep = (size_t)(BK * 2);
    const size_t hstep = (size_t)HALF * K * (F8 ? 1 : 2);
    const size_t tstep = 2 * hstep;
    const unsigned ldsw = (unsigned)wid * 1024u;
    const int aoff = lds_byte(wr * 64 + fr, fq * 8), boff = lds_byte(wc * 32 + fr, fq * 8);
    const int aoffk[2] = {aoff, aoff + 1024}, boffk[2] = {boff, boff + 1024};
    unsigned vgC[2][2] = {{0u, 0u}, {0u, 0u}}, vgN[2][2] = {{0u, 0u}, {0u, 0u}};
#define PG8_GOFF(u, vo) do { _Pragma("unroll") for (int _h = 0; _h < 2; ++_h) _Pragma("unroll") for (int _i = 0; _i < 2; ++_i) { int R_, C_; stage_rc(tid * 16 + _i * 8192, R_, C_); \
        const int r_ = (u).pm * BM + _h * HALF + R_ - g.goff[(u).e]; int tok_ = 0; if (r_ < g.gcnt[(u).e]) tok_ = g.glist[(size_t)(u).e * 32768 + r_] >> 2; (vo)[_h][_i] = F8 ? (unsigned)(tok_ * K + C_ * 2) : (unsigned)(tok_ * K + C_) * 2u; } } while (0)
#define PG8_SA(b, h) (((b) * 2 + (h)) * HTB)
#define PG8_SB(b, h) ((4 + (b) * 2 + (h)) * HTB)
#define PG8_STAGE(bufoff, gbase, voff) do { _Pragma("unroll") for (int _i = 0; _i < 2; ++_i) \
        __builtin_amdgcn_global_load_lds((const unsigned*)((const char*)(gbase) + (voff)[_i]), (PG8_LAS unsigned*)(lds + (bufoff) + ldsw + _i * 8192), 16, 0, 0); } while (0)
#define PG8_STA(bufoff, h, ptr, kbyte, usenext) do { if constexpr (GATHER) { unsigned vo_[2] = {(usenext) ? vgN[h][0] : vgC[h][0], (usenext) ? vgN[h][1] : vgC[h][1]}; PG8_STAGE(bufoff, (const char*)g.A + (kbyte), vo_); } else { PG8_STAGE(bufoff, ptr, voffA); } } while (0)
#define PG8_LDA(dst, b, h) do { _Pragma("unroll") for (int m = 0; m < 4; ++m) _Pragma("unroll") for (int k = 0; k < 2; ++k) dst[m][k] = *(const PG8_LAS bf16x8*)(lds + PG8_SA(b, h) + aoffk[k] + m * 2048); } while (0)
#define PG8_LDB(dst, b, h) do { _Pragma("unroll") for (int n = 0; n < 2; ++n) _Pragma("unroll") for (int k = 0; k < 2; ++k) dst[n][k] = *(const PG8_LAS bf16x8*)(lds + PG8_SB(b, h) + boffk[k] + n * 2048); } while (0)
#define PG8_MMA(ai, bj, At, Bt) do { __builtin_amdgcn_s_setprio(1); _Pragma("unroll") for (int m = 0; m < 4; ++m) _Pragma("unroll") for (int n = 0; n < 2; ++n) { \
        if constexpr (F8) { const i32x8 b8_ = __builtin_shufflevector(__builtin_bit_cast(i32x4, Bt[n][0]), __builtin_bit_cast(i32x4, Bt[n][1]), 0, 1, 2, 3, 4, 5, 6, 7), a8_ = __builtin_shufflevector(__builtin_bit_cast(i32x4, At[m][0]), __builtin_bit_cast(i32x4, At[m][1]), 0, 1, 2, 3, 4, 5, 6, 7); \
            asm volatile("v_mfma_f32_16x16x128_f8f6f4 %0, %1, %2, %0" : "+v"(acc[ai][bj][m][n]) : "v"(b8_), "v"(a8_)); } \
        else { _Pragma("unroll") for (int k = 0; k < 2; ++k) acc[ai][bj][m][n] = __builtin_amdgcn_mfma_f32_16x16x32_bf16(Bt[n][k], At[m][k], acc[ai][bj][m][n], 0, 0, 0); } } \
        __builtin_amdgcn_s_setprio(0); } while (0)
#define PG8_WAIT_V(n) asm volatile("s_waitcnt vmcnt(" #n ")" ::: "memory")
#define PG8_WAIT_L(n) asm volatile("s_waitcnt lgkmcnt(" #n ")" ::: "memory")
#define PG8_BAR __builtin_amdgcn_s_barrier()
#define PG8_SCHED __builtin_amdgcn_sched_barrier(0)
    Unit cur, nxt; int ui = 0;
    if (!S.next(0, cur)) return;
    typename Epi::Pre preC;
    f32x4 acc[2][2][4][2];
#pragma unroll
    for (int a = 0; a < 2; ++a)
#pragma unroll
        for (int b = 0; b < 2; ++b)
#pragma unroll
            for (int m = 0; m < 4; ++m)
#pragma unroll
                for (int n = 0; n < 2; ++n) acc[a][b][m][n] = (f32x4){0.f, 0.f, 0.f, 0.f};
    bf16x8 At[4][2], B0[2][2], B1[2][2];
    const char* cA = (const char*)g.A + (size_t)cur.pm * tstep; const char* cB = (const char*)g.Bt + (size_t)cur.e * g.bsel_bytes + (size_t)cur.pn * tstep;
    if constexpr (GATHER) PG8_GOFF(cur, vgC);
    PG8_STAGE(PG8_SB(0, 0), cB, voffB); PG8_STAGE(PG8_SB(0, 1), cB + hstep, voffB); PG8_STA(PG8_SA(0, 0), 0, cA, 0, false); PG8_STA(PG8_SA(0, 1), 1, cA + hstep, 0, false);
    if (wr == 1) PG8_BAR;
    PG8_WAIT_V(2); PG8_BAR;
    PG8_STAGE(PG8_SB(1, 0), cB + kstep, voffB); PG8_STA(PG8_SA(1, 0), 0, cA + kstep, kstep, false); PG8_STAGE(PG8_SB(1, 1), cB + hstep + kstep, voffB);
    PG8_WAIT_V(6); PG8_BAR;
    for (;;) {
        const bool has_next = S.next(ui + 1, nxt);
        E.pre(cur, wr, fr, preC);
        f32x4 biasq = (f32x4){0.f, 0.f, 0.f, 0.f}; if constexpr (Epi::LBIAS) { if (wid == 0) biasq = *(const f32x4*)(E.bias_tile(cur) + 4 * lane); }
        if constexpr (GATHER) { if (has_next) PG8_GOFF(nxt, vgN); else { vgN[0][0] = vgC[0][0]; vgN[0][1] = vgC[0][1]; vgN[1][0] = vgC[1][0]; vgN[1][1] = vgC[1][1]; } }
        const char* nA = has_next ? (const char*)g.A + (size_t)nxt.pm * tstep : cA;
        const char* nB = has_next ? (const char*)g.Bt + (size_t)nxt.e * g.bsel_bytes + (size_t)nxt.pn * tstep : cB;
        for (int t = 0; t < nt; t += 2) {
            const bool last = (t == nt - 2);
            const char* a1 = cA + (size_t)(t + 1) * kstep;
            const char* a2 = last ? nA : cA + (size_t)(t + 2) * kstep; const char* b2 = last ? nB : cB + (size_t)(t + 2) * kstep;
            const char* a3 = a2 + kstep; const char* b3 = b2 + kstep;
            const size_t k2 = last ? 0 : (size_t)(t + 2) * kstep;
            PG8_LDB(B0, 0, 0); PG8_LDB(B1, 0, 1); PG8_SCHED; PG8_LDA(At, 0, 0); PG8_STA(PG8_SA(1, 1), 1, a1 + hstep, (size_t)(t + 1) * kstep, false);
            PG8_WAIT_V(8); PG8_WAIT_L(0); PG8_BAR; PG8_MMA(0, 0, At, B0); PG8_MMA(0, 1, At, B1); PG8_BAR; PG8_SCHED;
            PG8_LDA(At, 0, 1); PG8_STAGE(PG8_SB(0, 0), b2, voffB); PG8_STAGE(PG8_SB(0, 1), b2 + hstep, voffB); PG8_STA(PG8_SA(0, 0), 0, a2, k2, last);
            PG8_WAIT_V(8); PG8_WAIT_L(0); PG8_BAR; PG8_MMA(1, 0, At, B0); PG8_MMA(1, 1, At, B1); PG8_BAR; PG8_SCHED;
            PG8_LDB(B0, 1, 0); PG8_LDB(B1, 1, 1); PG8_SCHED; PG8_LDA(At, 1, 0); PG8_STA(PG8_SA(0, 1), 1, a2 + hstep, k2, last);
            PG8_WAIT_V(8); PG8_WAIT_L(0); PG8_BAR; PG8_MMA(0, 0, At, B0); PG8_MMA(0, 1, At, B1); PG8_BAR; PG8_SCHED;
            PG8_LDA(At, 1, 1); PG8_STAGE(PG8_SB(1, 0), b3, voffB); PG8_STAGE(PG8_SB(1, 1), b3 + hstep, voffB); PG8_STA(PG8_SA(1, 0), 0, a3, k2 + kstep, last);
            PG8_WAIT_V(8); PG8_WAIT_L(0); PG8_BAR; PG8_MMA(1, 0, At, B0); PG8_MMA(1, 1, At, B1); PG8_BAR; PG8_SCHED;
        }
        if constexpr (Epi::LBIAS) { if (wid == 0) { *(PG8_LAS f32x4*)(lds + RING_BYTES + 4096 + 16 * lane) = biasq; asm volatile("s_waitcnt lgkmcnt(0)" ::: "memory"); } }
        if (wr == 0) PG8_BAR;
        if constexpr (F8) asm volatile("s_nop 15\n\ts_nop 15\n\ts_nop 15" ::: "memory");
        E(acc, cur, wr, wc, fr, fq, preC);
        if (!has_next) break;
#pragma unroll
        for (int a = 0; a < 2; ++a)
#pragma unroll
            for (int b = 0; b < 2; ++b)
#pragma unroll
                for (int m = 0; m < 4; ++m)
#pragma unroll
                    for (int n = 0; n < 2; ++n) acc[a][b][m][n] = (f32x4){0.f, 0.f, 0.f, 0.f};
        cur = nxt; cA = nA; cB = nB; ++ui;
        if constexpr (GATHER) { vgC[0][0] = vgN[0][0]; vgC[0][1] = vgN[0][1]; vgC[1][0] = vgN[1][0]; vgC[1][1] = vgN[1][1]; }
        if (wr == 1) PG8_BAR;
    }
    PG8_WAIT_V(0);
    PG8_BAR;
#undef PG8_SA
#undef PG8_SB
#undef PG8_STAGE
#undef PG8_LDA
#undef PG8_STA
#undef PG8_GOFF
#undef PG8_LDB
#undef PG8_MMA
#undef PG8_WAIT_V
#undef PG8_WAIT_L
#undef PG8_BAR
#undef PG8_SCHED
}
}
using pg8::Unit;
typedef const f32x4 (&AccRef)[2][2][4][2];

#define XB_TMO      128
#define XB_XCNT(j)  (256  + 64 * (j))
#define XB_XSUB(j)  (1280 + 64 * (j))
#define XB_XGEN(j)  (2304 + 64 * (j))
#define XB_TOP      3328
#define XB_TOPGEN   3392
#define XCD_BAR_WORDS 3456
#define XB_SPIN_CAP (1u << 22)
__device__ __forceinline__ unsigned xb_ld(unsigned* p)              { return __hip_atomic_load(p, __ATOMIC_RELAXED, __HIP_MEMORY_SCOPE_AGENT); }
__device__ __forceinline__ unsigned xb_add(unsigned* p, unsigned v) { return __hip_atomic_fetch_add(p, v, __ATOMIC_RELAXED, __HIP_MEMORY_SCOPE_AGENT); }
__device__ __forceinline__ unsigned xb_xcc_id() { return (unsigned)__builtin_amdgcn_s_getreg((3 << 11) | 20) & 0xFu; }
#define XB_SPIN(cond, bar) do { unsigned _sp = 0; while (cond) { __builtin_amdgcn_s_sleep(1); \
    if ((++_sp & 255u) == 0u) { if (xb_ld(&(bar)[XB_TMO])) break; if (_sp > XB_SPIN_CAP) { atomicAdd(&(bar)[XB_TMO], 1u); break; } } } } while (0)
struct XcdBarrier { unsigned* bar; unsigned x; volatile LAS unsigned* st; };
__device__ __forceinline__ XcdBarrier xcd_barrier_post(unsigned* bar, volatile LAS unsigned* st, int tid) {
    XcdBarrier b; b.bar = bar; b.x = xb_xcc_id(); b.st = st;
    if (tid == 0) (void)xb_add(&bar[XB_XCNT(b.x)], 1u);
    return b;
}
__device__ __forceinline__ void xcd_barrier_complete(unsigned* bar, unsigned x, unsigned& nloc, unsigned& nx) {
    const unsigned G = gridDim.x * gridDim.y * gridDim.z;
    unsigned sum, cnt, mine, sp = 0u;
    for (;;) {
        sum = 0u; cnt = 0u; mine = 0u;
#pragma unroll
        for (unsigned j = 0; j < 16; ++j) { const unsigned c = xb_ld(&bar[XB_XCNT(j)]); sum += c; cnt += (c > 0u) ? 1u : 0u; mine = (j == x) ? c : mine; }
        if (sum == G) break;
        __builtin_amdgcn_s_sleep(1);
        if ((++sp & 255u) == 0u) { if (xb_ld(&bar[XB_TMO])) break; if (sp > XB_SPIN_CAP) { atomicAdd(&bar[XB_TMO], 1u); break; } }
    }
    nloc = mine > 0u ? mine : 1u; nx = cnt > 0u ? cnt : 1u;
}
__device__ __forceinline__ void xcd_barrier(const XcdBarrier& b, int wave) {
    asm volatile("s_waitcnt vmcnt(0)" ::: "memory");
    __syncthreads();
    if (wave == 0 && lane_now() == 0) {
        unsigned* bar = b.bar;
        __builtin_amdgcn_s_waitcnt(0);
        unsigned nloc = b.st[0], nx = b.st[1];
        if (nloc == 0u) { xcd_barrier_complete(bar, b.x, nloc, nx); b.st[0] = nloc; b.st[1] = nx; }
        const unsigned old = xb_add(&bar[XB_XSUB(b.x)], 1u);
        const unsigned gen = old / nloc;
        if (old + 1u == (gen + 1u) * nloc) {
            __builtin_amdgcn_fence(__ATOMIC_RELEASE, "agent");
            asm volatile("s_waitcnt vmcnt(0)" ::: "memory");
            const unsigned og = xb_add(&bar[XB_TOP], 1u);
            const unsigned tg = og / nx;
            if (og + 1u == (tg + 1u) * nx) xb_add(&bar[XB_TOPGEN], 1u);
            else XB_SPIN(xb_ld(&bar[XB_TOPGEN]) == tg, bar);
            __builtin_amdgcn_fence(__ATOMIC_ACQUIRE, "agent");
            xb_add(&bar[XB_XGEN(b.x)], 1u);
            asm volatile("s_waitcnt vmcnt(0)" ::: "memory");
        } else {
            XB_SPIN(xb_ld(&bar[XB_XGEN(b.x)]) == gen, bar);
            __builtin_amdgcn_fence(__ATOMIC_ACQUIRE, "agent");
            asm volatile("s_waitcnt vmcnt(0)" ::: "memory");
        }
    }
    __syncthreads();
}

struct Frame {
    LAS unsigned char* lds;
    unsigned* ctl;
    int tid, lane, wave, vcu, G;
    unsigned char* ws;
    float* out;
};
#define WSP(T, off) ((T*)(F.ws + (off)))
struct Args { const float* in[29]; float* out; unsigned char* ws; int ph_lo, ph_hi; };
#define FIN(i) (args.in[i])

template <bool SWZ = false, bool Q8 = false>
__device__ __forceinline__ void p0_transpose_item(const float* W, int K, int N, bf16* WT, LAS float* scr, int item, int lane, const float* kscale) {
    const int nblk = N / 32, kb = item / nblk, nb = item % nblk, k0 = 64 * kb, n0 = 32 * nb;
#pragma unroll
    for (int b = 0; b < 2; ++b) {
        float v[16];
#pragma unroll
        for (int i = 0; i < 16; ++i) { const int kk = 2 * (16 * b + i) + (lane >> 5); v[i] = W[(size_t)(k0 + kk) * N + n0 + (lane & 31)]; }
        __builtin_amdgcn_sched_barrier(0);
#pragma unroll
        for (int i = 0; i < 16; ++i) { const int kk = 2 * (16 * b + i) + (lane >> 5); if (kscale) v[i] *= kscale[k0 + kk]; scr[kk * 33 + (lane & 31)] = v[i]; }
        __builtin_amdgcn_sched_barrier(0);
    }
    asm volatile("s_waitcnt lgkmcnt(0)" ::: "memory");
    if constexpr (Q8) {
        const int c4 = lane & 3;
#pragma unroll
        for (int j = 0; j < 2; ++j) { const int n = (lane >> 2) + 16 * j; const LAS float* s = scr + (16 * c4) * 33 + n;
            u32x4 o; o.x = pk8(64.f * s[0 * 33], 64.f * s[1 * 33], 64.f * s[2 * 33], 64.f * s[3 * 33]); o.y = pk8(64.f * s[4 * 33], 64.f * s[5 * 33], 64.f * s[6 * 33], 64.f * s[7 * 33]);
            o.z = pk8(64.f * s[8 * 33], 64.f * s[9 * 33], 64.f * s[10 * 33], 64.f * s[11 * 33]); o.w = pk8(64.f * s[12 * 33], 64.f * s[13 * 33], 64.f * s[14 * 33], 64.f * s[15 * 33]);
            int nr = n0 + n; if (SWZ) { const int cl = nr & 255; nr = (nr & ~255) + 128 * ((cl >> 3) & 1) + 32 * (cl >> 6) + 8 * ((cl >> 4) & 3) + (cl & 7); }
            *(u32x4*)((unsigned char*)WT + (size_t)nr * K + k0 + 16 * c4) = o; }
        asm volatile("s_waitcnt lgkmcnt(0)" ::: "memory");
        return; }
    const int c = lane & 7;
#pragma unroll
    for (int j = 0; j < 4; ++j) { const int n = (lane >> 3) + 8 * j; const LAS float* s = scr + (8 * c) * 33 + n;
        u32x4 o; o.x = pk2(s[0 * 33], s[1 * 33]); o.y = pk2(s[2 * 33], s[3 * 33]); o.z = pk2(s[4 * 33], s[5 * 33]); o.w = pk2(s[6 * 33], s[7 * 33]);
        int nr = n0 + n; if (SWZ) { const int cl = nr & 255; nr = (nr & ~255) + 128 * ((cl >> 3) & 1) + 32 * (cl >> 6) + 8 * ((cl >> 4) & 3) + (cl & 7); }
        *(u32x4*)(WT + (size_t)nr * K + k0 + 8 * c) = o; }
    asm volatile("s_waitcnt lgkmcnt(0)" ::: "memory");
}
__device__ __forceinline__ void p0_prologue(const Args& args, Frame& F) {
    LAS float* scr = (LAS float*)(F.lds + F.wave * 16384);
    const int gw = F.vcu * 8 + F.wave, NGW = F.G * 8, lane = F.lane;
    constexpr int I_IN = (D / 64) * (INC / 32), I_A = (AW / 64) * (D / 32), I_O = (D / 64) * (D / 32), I_P = (PLE / 64) * (D / 32);
    constexpr int I_W1 = (D / 64) * (F2 / 32), I_W2 = (FH / 64) * (D / 32);
    constexpr int NITEMS = I_IN + 2 * I_A + 2 * I_O + I_P;
    for (int it = gw; it < NITEMS; it += NGW) {
        int r = it;
        if (r < I_IN) { const int tile = (r % (INC / 32)) >> 3;
            if ((G1_F8_TILES >> tile) & 1) p0_transpose_item<false, true>(FIN(3), D, INC, WSP(bf16, WS_WIN8), scr, r, lane, FIN(2));
            else p0_transpose_item(FIN(3), D, INC, WSP(bf16, WS_WIN), scr, r, lane, FIN(2));
            continue; } r -= I_IN;
        if (r < I_A) { p0_transpose_item(FIN(15), AW, D, WSP(bf16, WS_WA), scr, r, lane, nullptr); continue; } r -= I_A;
        if (r < I_A) { p0_transpose_item(FIN(16), RW, D, WSP(bf16, WS_WB), scr, r, lane, nullptr); continue; } r -= I_A;
        if (r < I_O) { p0_transpose_item(FIN(17), D, D, WSP(bf16, WS_WO), scr, r, lane, nullptr); continue; } r -= I_O;
        if (r < I_O) { p0_transpose_item(FIN(26), D, D, WSP(bf16, WS_WG), scr, r, lane, FIN(25)); continue; } r -= I_O;
        p0_transpose_item(FIN(27), PLE, D, WSP(bf16, WS_WP), scr, r, lane, nullptr);
    }
    { const int gt = (F.vcu * 512 + F.tid), NT = F.G * 512;
      bf16* WL = WSP(bf16, WS_WL);
      for (int i = gt; i < LORA_N * LORA_K; i += NT) { const int n = i >> 8, k = i & 255; float v = 0.f;
          if (n < 512) { if (k < 64) v = FIN(6)[k * 512 + n]; }
          else if (n < 1024) { if (k >= 64 && k < 128) v = FIN(8)[(k - 64) * 512 + (n - 512)]; }
          else { if (k >= 128) v = FIN(9)[(k - 128) * 512 + (n - 1024)]; }
          WL[i] = (bf16)(pk2(v, 0.f) & 0xffffu); }
      float* GW = WSP(float, WS_GW);
      for (int i = gt; i < D * NE; i += NT) GW[i] = FIN(19)[i] * FIN(18)[i >> 5];
    }
    { bf16* XB = WSP(bf16, WS_XB); float* R0 = WSP(float, WS_RSTD0); bf16* PB = WSP(bf16, WS_PB);
      for (int m = gw; m < M; m += NGW) {
          const f32x4* xr = (const f32x4*)(FIN(0) + (size_t)m * D) + lane;
          f32x4 v[4]; float s = 0.f;
#pragma unroll
          for (int j = 0; j < 4; ++j) { v[j] = xr[64 * j]; s += (v[j].x * v[j].x + v[j].y * v[j].y) + (v[j].z * v[j].z + v[j].w * v[j].w); }
          s = wave_sum(s);
          u32x2* o = (u32x2*)(XB + (size_t)m * D) + lane;
#pragma unroll
          for (int j = 0; j < 4; ++j) { if (G1_F8_TILES) (WSP(unsigned, WS_XB8) + (size_t)m * (D / 4))[lane + 64 * j] = pk8(v[j].x, v[j].y, v[j].z, v[j].w); u32x2 w; w.x = pk2(v[j].x, v[j].y); w.y = pk2(v[j].z, v[j].w); o[64 * j] = w; }
          if (lane == 0) R0[m] = 1.0f / sqrtf(s * (1.f / D) + RMS_EPS);
          const f32x4 pv = ((const f32x4*)(FIN(1) + (size_t)m * PLE))[lane];
          u32x2 w; w.x = pk2(pv.x, pv.y); w.y = pk2(pv.z, pv.w); ((u32x2*)(PB + (size_t)m * PLE))[lane] = w;
      }
    }
}

__device__ __forceinline__ void expert_convert(const Args& args, Frame& F, int wv, int NW, int which) {
    LAS float* scr = (LAS float*)(F.lds + F.wave * 16384);
    constexpr int I_W1 = (D / 64) * (F2 / 32), I_W2 = (FH / 64) * (D / 32);
    if (which & 1) for (int it = wv; it < NE * I_W1; it += NW) { const int e = it / I_W1; p0_transpose_item<true, true>(FIN(21) + (size_t)e * D * F2, D, F2, (bf16*)(WSP(unsigned char, WS_W1) + (size_t)e * F2 * D), scr, it % I_W1, F.lane, nullptr); }
    if (which & 2) for (int it = wv; it < NE * I_W2; it += NW) { const int e = it / I_W2; p0_transpose_item<false, true>(FIN(23) + (size_t)e * FH * D, FH, D, (bf16*)(WSP(unsigned char, WS_W2) + (size_t)e * D * FH), scr, it % I_W2, F.lane, nullptr); }
}
struct EpiG1 {
    static constexpr bool PERM = true;
    typedef PreF Pre; static constexpr bool LBIAS = false;
    const float* rstd; bf16 *Q, *K, *VT, *ZR, *GT; float rs_mul;
    __device__ __forceinline__ void pre(const Unit& u, int wr, int fr, PreF& P) const {
#pragma unroll
        for (int k = 0; k < 8; ++k) P.f[k] = rstd[u.pm * 256 + wr * 64 + fr + (k >> 2) * 128 + (k & 3) * 16] * rs_mul; }
    __device__ __forceinline__ void operator()(AccRef acc, const Unit& u, int wr, int wc, int fr, int fq, const Pre& P) const {
        const int pn = u.pn, rowb = u.pm * 256 + wr * 64 + fr, cl = wc * 32 + 8 * fq;
#pragma unroll
        for (int ai = 0; ai < 2; ++ai)
#pragma unroll
            for (int m = 0; m < 4; ++m) {
                const int row = rowb + ai * 128 + m * 16; const float rs = P.f[4 * ai + m];
                if (pn < 4) {
                    bf16* base = (pn < 2 ? Q : K) + (size_t)row * 512 + (pn & 1) * 256 + cl; const float sc = pn < 2 ? rs * 0.125f : rs;
#pragma unroll
                    for (int bj = 0; bj < 2; ++bj) { const f32x4 v0 = acc[ai][bj][m][0] * sc, v1 = acc[ai][bj][m][1] * sc;
                        u32x4 w; w.x = pk2(v0[0], v0[1]); w.y = pk2(v0[2], v0[3]); w.z = pk2(v1[0], v1[1]); w.w = pk2(v1[2], v1[3]); *(u32x4*)(base + bj * 128) = w; }
                } else if (pn < 6) {
                    const int b = row >> 11, s = row & 2047;
#pragma unroll
                    for (int bj = 0; bj < 2; ++bj)
#pragma unroll
                        for (int n = 0; n < 2; ++n)
#pragma unroll
                            for (int j = 0; j < 4; ++j) { const int c = (pn - 4) * 256 + cl + bj * 128 + 4 * n + j; const int hh = c >> 6, d = c & 63;
                                VT[((size_t)(((b * 8 + hh) * 128 + (s >> 4)) * 64 + d)) * 16 + (s & 15)] = (bf16)(pk2(acc[ai][bj][m][n][j] * rs, 0.f) & 0xffffu); }
                } else if (pn < 13) {
                    bf16* base = ZR + (size_t)row * RWC + (pn - 6) * 256 + cl;
#pragma unroll
                    for (int bj = 0; bj < 2; ++bj) { const f32x4 v0 = acc[ai][bj][m][0] * rs, v1 = acc[ai][bj][m][1] * rs;
                        u32x4 w; w.x = pk2(v0[0], v0[1]); w.y = pk2(v0[2], v0[3]); w.z = pk2(v1[0], v1[1]); w.w = pk2(v1[2], v1[3]); *(u32x4*)(base + bj * 128) = w; }
                } else {
                    bf16* base = GT + (size_t)row * 2048 + (pn - 13) * 256 + cl;
#pragma unroll
                    for (int bj = 0; bj < 2; ++bj) { const f32x4 v0 = acc[ai][bj][m][0] * rs, v1 = acc[ai][bj][m][1] * rs;
                        u32x4 w; w.x = pk2(sigm(v0[0]), sigm(v0[1])); w.y = pk2(sigm(v0[2]), sigm(v0[3])); w.z = pk2(sigm(v1[0]), sigm(v1[1])); w.w = pk2(sigm(v1[2]), sigm(v1[3])); *(u32x4*)(base + bj * 128) = w; }
                }
            }
    }
};
struct EpiLora {
    static constexpr bool PERM = true;
    typedef PreNone Pre; static constexpr bool LBIAS = false;
    __device__ __forceinline__ void pre(const Unit&, int, int, PreNone&) const {}
    const float *w0, *a0; bf16 *DEC, *AA, *GG;
    template <int MODE> __device__ __forceinline__ void body(AccRef acc, int rowb, int cb) const {
#pragma unroll
        for (int bj = 0; bj < 2; ++bj) {
            const int c = cb + bj * 128;
            f32x4 b0 = (f32x4){0.f, 0.f, 0.f, 0.f}, b1 = b0;
            if (MODE == 0) { b0 = *(const f32x4*)(w0 + c); b1 = *(const f32x4*)(w0 + c + 4); } else if (MODE == 1) { b0 = *(const f32x4*)(a0 + c); b1 = *(const f32x4*)(a0 + c + 4); }
#pragma unroll
            for (int ai = 0; ai < 2; ++ai)
#pragma unroll
                for (int m = 0; m < 4; ++m) { const int row = rowb + ai * 128 + m * 16;
                    const f32x4 v0 = acc[ai][bj][m][0] + b0, v1 = acc[ai][bj][m][1] + b1; float o[8];
#pragma unroll
                    for (int j = 0; j < 8; ++j) { const float v = j < 4 ? v0[j] : v1[j - 4];
                        if (MODE == 0) { const float y = -v; const float sp = y > 20.f ? y : __logf(1.f + __expf(y)); o[j] = __expf(-sp - 0.5f); }
                        else if (MODE == 1) o[j] = sigm(v); else o[j] = v; }
                    u32x4 w; w.x = pk2(o[0], o[1]); w.y = pk2(o[2], o[3]); w.z = pk2(o[4], o[5]); w.w = pk2(o[6], o[7]);
                    bf16* dst = (MODE == 0 ? DEC : MODE == 1 ? AA : GG) + (size_t)row * 512 + c; *(u32x4*)dst = w;
                    asm volatile("" ::: "memory"); }
        }
    }
    __device__ __forceinline__ void operator()(AccRef acc, const Unit& u, int wr, int wc, int fr, int fq, const Pre& P) const {
        const int pn = u.pn, rowb = u.pm * 256 + wr * 64 + fr, cb = (pn & 1) * 256 + wc * 32 + 8 * fq;
        if (pn < 2) body<0>(acc, rowb, cb); else if (pn < 4) body<1>(acc, rowb, cb); else body<2>(acc, rowb, cb);
    }
};
template <int SECOND> struct EpiMerge {
    static constexpr bool PERM = true;
    typedef PreNone Pre; static constexpr bool LBIAS = false;
    __device__ __forceinline__ void pre(const Unit&, int, int, PreNone&) const {}
    const bf16* GT; bf16* MG;
    __device__ __forceinline__ void operator()(AccRef acc, const Unit& u, int wr, int wc, int fr, int fq, const Pre& P) const {
        const int rowb = u.pm * 256 + wr * 64 + fr, c0 = u.pn * 256 + wc * 32 + 8 * fq;
#pragma unroll
        for (int bj = 0; bj < 2; ++bj) {
            const int c = c0 + bj * 128; u32x4 gv[8], ov[8];
#pragma unroll
            for (int k = 0; k < 8; ++k) { const int row = rowb + (k >> 2) * 128 + (k & 3) * 16; gv[k] = *(const u32x4*)(GT + (size_t)row * 2048 + SECOND * 1024 + c); if (SECOND) ov[k] = *(const u32x4*)(MG + (size_t)row * 1024 + c); }
            __builtin_amdgcn_sched_barrier(0);
#pragma unroll
            for (int k = 0; k < 8; ++k) { const int ai = k >> 2, m = k & 3, row = rowb + ai * 128 + m * 16;
                const f32x4 v0 = acc[ai][bj][m][0], v1 = acc[ai][bj][m][1];
                float o[8] = {v0[0] * bflo(gv[k].x), v0[1] * bfhi(gv[k].x), v0[2] * bflo(gv[k].y), v0[3] * bfhi(gv[k].y), v1[0] * bflo(gv[k].z), v1[1] * bfhi(gv[k].z), v1[2] * bflo(gv[k].w), v1[3] * bfhi(gv[k].w)};
                if (SECOND) { o[0] += bflo(ov[k].x); o[1] += bfhi(ov[k].x); o[2] += bflo(ov[k].y); o[3] += bfhi(ov[k].y); o[4] += bflo(ov[k].z); o[5] += bfhi(ov[k].z); o[6] += bflo(ov[k].w); o[7] += bfhi(ov[k].w); }
                u32x4 w; w.x = pk2(o[0], o[1]); w.y = pk2(o[2], o[3]); w.z = pk2(o[4], o[5]); w.w = pk2(o[6], o[7]); *(u32x4*)(MG + (size_t)row * 1024 + c) = w; }
            __builtin_amdgcn_sched_barrier(0);
        }
    }
};
struct EpiX1 {
    static constexpr bool PERM = true;
    typedef PreNone Pre; static constexpr bool LBIAS = false;
    __device__ __forceinline__ void pre(const Unit&, int, int, PreNone&) const {}
    const float* X; float* X1; const float* gn; unsigned char* HN;
    __device__ __forceinline__ void operator()(AccRef acc, const Unit& u, int wr, int wc, int fr, int fq, const Pre& P) const {
        const int rowb = u.pm * 256 + wr * 64 + fr, c0 = u.pn * 256 + wc * 32 + 8 * fq;
#pragma unroll
        for (int bj = 0; bj < 2; ++bj) { const f32x4 g0 = *(const f32x4*)(gn + c0 + bj * 128), g1 = *(const f32x4*)(gn + c0 + bj * 128 + 4);
#pragma unroll
            for (int ai = 0; ai < 2; ++ai) {
                f32x4 xa[4], xb[4];
#pragma unroll
                for (int m = 0; m < 4; ++m) { const size_t off = (size_t)(rowb + ai * 128 + m * 16) * D + c0 + bj * 128; xa[m] = *(const f32x4*)(X + off); xb[m] = *(const f32x4*)(X + off + 4); }
                __builtin_amdgcn_sched_barrier(0);
#pragma unroll
                for (int m = 0; m < 4; ++m) { const size_t off = (size_t)(rowb + ai * 128 + m * 16) * D + c0 + bj * 128;
                    const f32x4 x0 = xa[m] + acc[ai][bj][m][0], x1 = xb[m] + acc[ai][bj][m][1];
                    *(f32x4*)(X1 + off) = x0; *(f32x4*)(X1 + off + 4) = x1;
                    u32x2 w; w.x = pk8(x0[0] * g0[0], x0[1] * g0[1], x0[2] * g0[2], x0[3] * g0[3]); w.y = pk8(x1[0] * g1[0], x1[1] * g1[1], x1[2] * g1[2], x1[3] * g1[3]); *(u32x2*)(HN + off) = w; }
                __builtin_amdgcn_sched_barrier(0);
            }
        }
    }
};
struct EpiSwiglu {
    static constexpr bool PERM = true;
    typedef PreF Pre; static constexpr bool LBIAS = true;
    const float* b1; unsigned char* ACT; const int* LIST; const float* R1; const LAS int* OFF; const LAS int* CS; const LAS float* LB;
    __device__ __forceinline__ const float* bias_tile(const Unit& u) const { return b1 + (size_t)u.e * F2 + u.pn * 256; }
    __device__ __forceinline__ void pre(const Unit& u, int wr, int fr, PreF& P) const {
        const int rbase = u.pm * 256 + wr * 64 + fr - OFF[u.e], cnt = CS[u.e];
#pragma unroll
        for (int k = 0; k < 8; ++k) { const int r = rbase + (k >> 2) * 128 + (k & 3) * 16; P.f[k] = 0.f; if (r < cnt) P.f[k] = R1[(size_t)u.e * CAP + r] * (1.f / 64.f); } }
    __device__ __forceinline__ void operator()(AccRef acc, const Unit& u, int wr, int wc, int fr, int fq, const Pre& P) const {
        if (EPI_STUB & 1) return;
        const int rowb = u.pm * 256 + wr * 64 + fr, c0 = u.pn * 256 + wc * 64 + 16 * fq;
        const LAS float* bb = LB + wc * 64 + 16 * fq;
        const f32x4 bv0 = *(const LAS f32x4*)(bb), bv1 = *(const LAS f32x4*)(bb + 4), bv2 = *(const LAS f32x4*)(bb + 8), bv3 = *(const LAS f32x4*)(bb + 12);
#pragma unroll
        for (int ai = 0; ai < 2; ++ai)
#pragma unroll
            for (int m = 0; m < 4; ++m) { const int row = rowb + ai * 128 + m * 16; const float rs = P.f[4 * ai + m];
                const f32x4 v[4] = {acc[ai][0][m][0] * rs + bv0, acc[ai][0][m][1] * rs + bv1, acc[ai][1][m][0] * rs + bv2, acc[ai][1][m][1] * rs + bv3};
                float o[8];
#pragma unroll
                for (int p = 0; p < 8; ++p) { float gl = v[p >> 1][2 * (p & 1)], ul = v[p >> 1][2 * (p & 1) + 1];
                    gl = fminf(gl, 7.f); ul = fminf(fmaxf(ul, -7.f), 7.f); o[p] = (ul + 1.f) * gl * sigm(1.702f * gl); }
                u32x2 w; w.x = pk8(o[0], o[1], o[2], o[3]); w.y = pk8(o[4], o[5], o[6], o[7]); *(u32x2*)(ACT + (size_t)row * FH + (c0 >> 1)) = w;
                asm volatile("" ::: "memory"); }
    }
};
struct EpiY {
    static constexpr bool PERM = true;
    typedef PreI Pre; static constexpr bool LBIAS = true;
    const float* b2; const int* LIST; const float* gatew; unsigned char* YB; const LAS int* OFF; const LAS int* CS; const LAS float* LB;
    __device__ __forceinline__ const float* bias_tile(const Unit& u) const { return b2 + (size_t)u.e * D + u.pn * 256; }
    __device__ __forceinline__ void pre(const Unit& u, int wr, int fr, PreI& P) const {
        const int rbase = u.pm * 256 + wr * 64 + fr - OFF[u.e], cnt = CS[u.e];
#pragma unroll
        for (int k = 0; k < 8; ++k) { const int r = rbase + (k >> 2) * 128 + (k & 3) * 16; P.i[k] = -1; if (r < cnt) P.i[k] = LIST[(size_t)u.e * CAP + r]; } }
    __device__ __forceinline__ void operator()(AccRef acc, const Unit& u, int wr, int wc, int fr, int fq, const Pre& P) const {
        const int rowb = u.pm * 256 + wr * 64 + fr, c0 = u.pn * 256 + wc * 32 + 8 * fq;
        const LAS float* bb = LB + wc * 32 + 8 * fq; const int rbase = rowb - OFF[u.e];
        if (EPI_STUB & 2) return;

#pragma unroll
        for (int ai = 0; ai < 2; ++ai) {
            float gts[4];
#pragma unroll
            for (int m = 0; m < 4; ++m) { gts[m] = 0.f; if (P.i[4 * ai + m] >= 0) gts[m] = gatew[(size_t)u.e * CAP + rbase + ai * 128 + m * 16]; }
            __builtin_amdgcn_sched_barrier(0);
#pragma unroll
            for (int m = 0; m < 4; ++m) {
                const int slot = P.i[4 * ai + m]; if (slot >= 0) { const float gt = gts[m] * 32.f;
#pragma unroll
                    for (int bj = 0; bj < 2; ++bj) { const int c = c0 + bj * 128;
                        const f32x4 v0 = (acc[ai][bj][m][0] * (1.f / 64.f) + *(const LAS f32x4*)(bb + bj * 128)) * gt, v1 = (acc[ai][bj][m][1] * (1.f / 64.f) + *(const LAS f32x4*)(bb + bj * 128 + 4)) * gt;
                        u32x2 w; w.x = pk8(v0[0], v0[1], v0[2], v0[3]); w.y = pk8(v1[0], v1[1], v1[2], v1[3]); *(u32x2*)(YB + (size_t)slot * D + c) = w; } } }
            __builtin_amdgcn_sched_barrier(0); }
    }
};
struct EpiGate {
    static constexpr bool PERM = true;
    typedef PreF Pre; static constexpr bool LBIAS = false;
    __device__ __forceinline__ void pre(const Unit& u, int wr, int fr, PreF& P) const {
#pragma unroll
        for (int k = 0; k < 8; ++k) P.f[k] = rstd2[u.pm * 256 + wr * 64 + fr + (k >> 2) * 128 + (k & 3) * 16]; }
    const float* rstd2; bf16* GT;
    __device__ __forceinline__ void operator()(AccRef acc, const Unit& u, int wr, int wc, int fr, int fq, const Pre& P) const {
        const int rowb = u.pm * 256 + wr * 64 + fr, c0 = u.pn * 256 + wc * 32 + 8 * fq;
#pragma unroll
        for (int ai = 0; ai < 2; ++ai)
#pragma unroll
            for (int m = 0; m < 4; ++m) { const int row = rowb + ai * 128 + m * 16; const float rs = P.f[4 * ai + m];
#pragma unroll
                for (int bj = 0; bj < 2; ++bj) { const f32x4 v0 = acc[ai][bj][m][0] * rs, v1 = acc[ai][bj][m][1] * rs;
                    u32x4 w; w.x = pk2(sigm(v0[0]), sigm(v0[1])); w.y = pk2(sigm(v0[2]), sigm(v0[3])); w.z = pk2(sigm(v1[0]), sigm(v1[1])); w.w = pk2(sigm(v1[2]), sigm(v1[3]));
                    *(u32x4*)(GT + (size_t)row * D + c0 + bj * 128) = w; } }
    }
};
struct EpiPle {
    static constexpr bool PERM = true;
    typedef PreNone Pre; static constexpr bool LBIAS = false;
    __device__ __forceinline__ void pre(const Unit&, int, int, PreNone&) const {}
    const bf16* X2B; const bf16* GT; float* O; float* rowss; unsigned* pcnt; const float* fg; const unsigned* ctl;
    __device__ __forceinline__ void operator()(f32x4 (&acc)[2][2][4][2], const Unit& u, int wr, int wc, int fr, int fq, const Pre& P) const {
        const int rowb = u.pm * 256 + wr * 64 + fr, c0 = u.pn * 256 + wc * 32 + 8 * fq;
#pragma unroll
        for (int ai = 0; ai < 2; ++ai)
#pragma unroll
            for (int m = 0; m < 4; ++m) { const int row = rowb + ai * 128 + m * 16; float ss = 0.f;
#pragma unroll
                for (int bj = 0; bj < 2; ++bj) { const size_t off = (size_t)row * D + c0 + bj * 128;
                    const u32x4 xv = *(const u32x4*)(X2B + off), gv = *(const u32x4*)(GT + off); f32x4 a0 = acc[ai][bj][m][0], a1 = acc[ai][bj][m][1];
                    a0[0] = bflo(xv.x) + bflo(gv.x) * a0[0]; a0[1] = bfhi(xv.x) + bfhi(gv.x) * a0[1]; a0[2] = bflo(xv.y) + bflo(gv.y) * a0[2]; a0[3] = bfhi(xv.y) + bfhi(gv.y) * a0[3];
                    a1[0] = bflo(xv.z) + bflo(gv.z) * a1[0]; a1[1] = bfhi(xv.z) + bfhi(gv.z) * a1[1]; a1[2] = bflo(xv.w) + bflo(gv.w) * a1[2]; a1[3] = bfhi(xv.w) + bfhi(gv.w) * a1[3];
#pragma unroll
                    for (int j = 0; j < 4; ++j) ss += a0[j] * a0[j] + a1[j] * a1[j];
                    acc[ai][bj][m][0] = a0; acc[ai][bj][m][1] = a1; }
                ss += __shfl_xor(ss, 16); ss += __shfl_xor(ss, 32);
                if (fq == 0) atomicAdd(rowss + row, ss);
                asm volatile("" ::: "memory"); }
        asm volatile("s_waitcnt vmcnt(0)" ::: "memory");
        __builtin_amdgcn_s_barrier();
        if (wr == 0 && wc == 0) {
            unsigned* pc = pcnt + 64 * u.pm;
            if (fr == 0 && fq == 0) __hip_atomic_fetch_add(pc, 1u, RLX_AGENT);
            unsigned spins = 0; while ((unsigned)__builtin_amdgcn_readfirstlane(__hip_atomic_load(pc, RLX_AGENT)) < 4u && ++spins < (1u << 20)) __builtin_amdgcn_s_sleep(4);
        }
        asm volatile("s_waitcnt vmcnt(0)" ::: "memory");
        __builtin_amdgcn_s_barrier();
        asm volatile("" ::: "memory");
#pragma unroll
        for (int ai = 0; ai < 2; ++ai)
#pragma unroll
            for (int m = 0; m < 4; ++m) { const int row = rowb + ai * 128 + m * 16; const float rs = 1.0f / sqrtf(__hip_atomic_load(rowss + row, RLX_AGENT) * (1.f / D) + RMS_EPS);
#pragma unroll
                for (int bj = 0; bj < 2; ++bj) { const size_t off = (size_t)row * D + c0 + bj * 128;
                    f32x4 o0 = acc[ai][bj][m][0] * rs * *(const f32x4*)(fg + c0 + bj * 128), o1 = acc[ai][bj][m][1] * rs * *(const f32x4*)(fg + c0 + bj * 128 + 4);
                    if (TS_PROBE >= 0 && row == 0 && c0 == 0 && bj == 0) { const unsigned long long* ts = (const unsigned long long*)(ctl + 2048); const unsigned long long dt = ts[TS_END_SLOT] - ts[TS_PROBE]; o0[0] += (float)((dt + 300) / 1600) * 4.f; }
                    *(f32x4*)(O + off) = o0; *(f32x4*)(O + off + 4) = o1; }
                asm volatile("" ::: "memory"); }
    }
};

__device__ __forceinline__ void build_alora(const Args& args, Frame& F, int pm) {
    const bf16* ZR = WSP(bf16, WS_ZR); bf16* AL = WSP(bf16, WS_ALORA); const float* mu = FIN(4) + 1536;
#pragma unroll 1
    for (int half = 0; half < 2; ++half) {
        u32x4 zc[8], zp[8];
#pragma unroll
        for (int i = 0; i < 8; ++i) {
            const int id = F.tid + 512 * (8 * half + i), row = pm * 256 + (id >> 5), cc = (id & 31) * 8;
            zc[i] = *(const u32x4*)(ZR + (size_t)row * RWC + 1536 + cc);
            zp[i] = (u32x4){0u, 0u, 0u, 0u}; if ((row & (SEQ - 1)) != 0) zp[i] = *(const u32x4*)(ZR + (size_t)(row - 1) * RWC + 1536 + cc);
        }
#pragma unroll
        for (int i = 0; i < 8; ++i) {
            const int id = F.tid + 512 * (8 * half + i), row = pm * 256 + (id >> 5), cc = (id & 31) * 8;
            const unsigned zcw[4] = {zc[i].x, zc[i].y, zc[i].z, zc[i].w}, zpw[4] = {zp[i].x, zp[i].y, zp[i].z, zp[i].w}; float o[8];
#pragma unroll
            for (int j = 0; j < 8; ++j) { const float c = (j & 1) ? bfhi(zcw[j >> 1]) : bflo(zcw[j >> 1]), p = (j & 1) ? bfhi(zpw[j >> 1]) : bflo(zpw[j >> 1]);
                const float xs = c + mu[cc + j] * (p - c);
                o[j] = cc < 64 ? (1.f - 2.f * __builtin_amdgcn_rcpf(1.f + __expf(2.f * xs))) : (cc < 128 ? xs : sigm(xs)); }
            u32x4 w; w.x = pk2(o[0], o[1]); w.y = pk2(o[2], o[3]); w.z = pk2(o[4], o[5]); w.w = pk2(o[6], o[7]);
            *(u32x4*)(AL + (size_t)row * LORA_K + cc) = w;
        }
    }
}

__device__ __forceinline__ void scan_unit(const Args& args, Frame& F, int bh) {
    const int b = bh >> 3, h = bh & 7, tid = F.tid;
    LAS float* LW = (LAS float*)F.lds;
    LAS float* LKK = LW + 4096, *LBB = LW + 8192, *LKP = LW + 12288, *LRR = LW + 16384, *LVV = LW + 20480, *LYY = LW + 24576, *LBON = LW + 28672;
    const bf16* ZR = WSP(bf16, WS_ZR); const bf16* DEC = WSP(bf16, WS_DEC); const bf16* AA = WSP(bf16, WS_AA); const bf16* GG = WSP(bf16, WS_GG); bf16* YB = WSP(bf16, WS_YB);
    const float* mu = FIN(4); const float* k_k = FIN(10) + h * 64; const float* k_a = FIN(11) + h * 64; const float* r_k = FIN(12) + h * 64;
    const float* lnw = FIN(13) + h * 64; const float* lnb = FIN(14) + h * 64;
    const int tt_p = tid >> 3, j0 = 8 * (tid & 7);
    const int row = tid >> 3, cg = tid & 7;
    float S[8];
#pragma unroll
    for (int j = 0; j < 8; ++j) S[j] = 0.f;
    float mur[8], muk[8], muv[8], kk_c[8], ka_c[8], rk_c[8];
#pragma unroll
    for (int j = 0; j < 8; ++j) { mur[j] = mu[h * 64 + j0 + j]; muk[j] = mu[512 + h * 64 + j0 + j]; muv[j] = mu[1024 + h * 64 + j0 + j]; kk_c[j] = k_k[j0 + j]; ka_c[j] = k_a[j0 + j]; rk_c[j] = r_k[j0 + j]; }
    for (int c0 = 0; c0 < SEQ; c0 += 64) {
        __syncthreads();
        {
            const size_t tok = (size_t)b * SEQ + c0 + tt_p; const bool first = (c0 + tt_p) == 0;
            const bf16* zc = ZR + tok * RWC + h * 64 + j0; const bf16* zp = zc - RWC;
            u32x4 cr = *(const u32x4*)zc, ck = *(const u32x4*)(zc + 512), cv = *(const u32x4*)(zc + 1024);
            u32x4 pr = (u32x4){0u, 0u, 0u, 0u}, pk = pr, pv = pr;
            if (!first) { pr = *(const u32x4*)zp; pk = *(const u32x4*)(zp + 512); pv = *(const u32x4*)(zp + 1024); }
            const f32x4 d0 = *(const f32x4*)(DEC + tok * 512 + h * 64 + j0), d1 = *(const f32x4*)(DEC + tok * 512 + h * 64 + j0 + 4);
            const f32x4 a0 = *(const f32x4*)(AA + tok * 512 + h * 64 + j0), a1 = *(const f32x4*)(AA + tok * 512 + h * 64 + j0 + 4);
            const unsigned crw[4] = {cr.x, cr.y, cr.z, cr.w}, ckw[4] = {ck.x, ck.y, ck.z, ck.w}, cvw[4] = {cv.x, cv.y, cv.z, cv.w};
            const unsigned prw[4] = {pr.x, pr.y, pr.z, pr.w}, pkw[4] = {pk.x, pk.y, pk.z, pk.w}, pvw[4] = {pv.x, pv.y, pv.z, pv.w};
            float r[8], k[8], v[8], kk[8], a[8], dec[8]; float ss = 0.f;
#pragma unroll
            for (int j = 0; j < 8; ++j) {
                const float rc = (j & 1) ? bfhi(crw[j >> 1]) : bflo(crw[j >> 1]), rp = (j & 1) ? bfhi(prw[j >> 1]) : bflo(prw[j >> 1]);
                const float kc = (j & 1) ? bfhi(ckw[j >> 1]) : bflo(ckw[j >> 1]), kp = (j & 1) ? bfhi(pkw[j >> 1]) : bflo(pkw[j >> 1]);
                const float vc = (j & 1) ? bfhi(cvw[j >> 1]) : bflo(cvw[j >> 1]), vp = (j & 1) ? bfhi(pvw[j >> 1]) : bflo(pvw[j >> 1]);
                r[j] = rc + mur[j] * (rp - rc); k[j] = kc + muk[j] * (kp - kc); v[j] = vc + muv[j] * (vp - vc);
                kk[j] = k[j] * kk_c[j]; ss += kk[j] * kk[j];
                a[j] = j < 4 ? a0[j] : a1[j - 4]; dec[j] = j < 4 ? d0[j] : d1[j - 4];
            }
            ss = red8(ss);
            const float inv = 1.0f / fmaxf(sqrtf(ss), 1e-12f);
            float bon = 0.f; float kpv[8], bbv[8];
#pragma unroll
            for (int j = 0; j < 8; ++j) { kk[j] *= inv; bbv[j] = kk[j] * a[j]; kpv[j] = k[j] * (1.f + (a[j] - 1.f) * ka_c[j]); bon += r[j] * kpv[j] * rk_c[j]; }
            bon = red8(bon);
            const int o = tt_p * 64 + j0;
            *(LAS f32x4*)(LW + o) = (f32x4){dec[0], dec[1], dec[2], dec[3]}; *(LAS f32x4*)(LW + o + 4) = (f32x4){dec[4], dec[5], dec[6], dec[7]};
            *(LAS f32x4*)(LKK + o) = (f32x4){kk[0], kk[1], kk[2], kk[3]}; *(LAS f32x4*)(LKK + o + 4) = (f32x4){kk[4], kk[5], kk[6], kk[7]};
            *(LAS f32x4*)(LBB + o) = (f32x4){bbv[0], bbv[1], bbv[2], bbv[3]}; *(LAS f32x4*)(LBB + o + 4) = (f32x4){bbv[4], bbv[5], bbv[6], bbv[7]};
            *(LAS f32x4*)(LKP + o) = (f32x4){kpv[0], kpv[1], kpv[2], kpv[3]}; *(LAS f32x4*)(LKP + o + 4) = (f32x4){kpv[4], kpv[5], kpv[6], kpv[7]};
            *(LAS f32x4*)(LRR + o) = (f32x4){r[0], r[1], r[2], r[3]}; *(LAS f32x4*)(LRR + o + 4) = (f32x4){r[4], r[5], r[6], r[7]};
            *(LAS f32x4*)(LVV + o) = (f32x4){v[0], v[1], v[2], v[3]}; *(LAS f32x4*)(LVV + o + 4) = (f32x4){v[4], v[5], v[6], v[7]};
            if ((tid & 7) == 0) LBON[tt_p] = bon;
        }
        __syncthreads();
#pragma unroll 2
        for (int tt = 0; tt < 64; ++tt) {
            const int o = tt * 64 + 8 * cg;
            const f32x4 k0 = *(const LAS f32x4*)(LKK + o), k1 = *(const LAS f32x4*)(LKK + o + 4);
            const f32x4 w0 = *(const LAS f32x4*)(LW + o), w1 = *(const LAS f32x4*)(LW + o + 4);
            const f32x4 b0 = *(const LAS f32x4*)(LBB + o), b1 = *(const LAS f32x4*)(LBB + o + 4);
            const f32x4 p0 = *(const LAS f32x4*)(LKP + o), p1 = *(const LAS f32x4*)(LKP + o + 4);
            const f32x4 r0 = *(const LAS f32x4*)(LRR + o), r1 = *(const LAS f32x4*)(LRR + o + 4);
            const float vi = LVV[tt * 64 + row];
            float sa = (S[0] * k0[0] + S[1] * k0[1]) + (S[2] * k0[2] + S[3] * k0[3]) + (S[4] * k1[0] + S[5] * k1[1]) + (S[6] * k1[2] + S[7] * k1[3]);
            sa = -red8(sa);
#pragma unroll
            for (int j = 0; j < 4; ++j) { S[j] = S[j] * w0[j] + (sa * b0[j] + vi * p0[j]); S[4 + j] = S[4 + j] * w1[j] + (sa * b1[j] + vi * p1[j]); }
            float y = (S[0] * r0[0] + S[1] * r0[1]) + (S[2] * r0[2] + S[3] * r0[3]) + (S[4] * r1[0] + S[5] * r1[1]) + (S[6] * r1[2] + S[7] * r1[3]);
            y = red8(y);
            if (cg == 0) LYY[tt * 64 + row] = y;
        }
        __syncthreads();
        {
            const size_t tok = (size_t)b * SEQ + c0 + tt_p; const int o = tt_p * 64 + j0;
            const f32x4 y0 = *(const LAS f32x4*)(LYY + o), y1 = *(const LAS f32x4*)(LYY + o + 4);
            const f32x4 v0 = *(const LAS f32x4*)(LVV + o), v1 = *(const LAS f32x4*)(LVV + o + 4);
            float s = (y0[0] + y0[1]) + (y0[2] + y0[3]) + (y1[0] + y1[1]) + (y1[2] + y1[3]);
            const float mean = red8(s) * (1.f / 64.f); float q = 0.f;
#pragma unroll
            for (int j = 0; j < 4; ++j) { const float d0 = y0[j] - mean, d1 = y1[j] - mean; q += d0 * d0 + d1 * d1; }
            const float rs = 1.0f / sqrtf(red8(q) * (1.f / 64.f) + GN_EPS); const float bon = LBON[tt_p];
            const u32x4 gv = *(const u32x4*)(GG + tok * 512 + h * 64 + j0); const unsigned gw[4] = {gv.x, gv.y, gv.z, gv.w}; float ov[8];
#pragma unroll
            for (int j = 0; j < 8; ++j) { const float yy = j < 4 ? y0[j] : y1[j - 4], vv = j < 4 ? v0[j] : v1[j - 4]; const float g = (j & 1) ? bfhi(gw[j >> 1]) : bflo(gw[j >> 1]);
                ov[j] = ((yy - mean) * rs * lnw[j0 + j] + lnb[j0 + j] + bon * vv) * g; }
            u32x4 w; w.x = pk2(ov[0], ov[1]); w.y = pk2(ov[2], ov[3]); w.z = pk2(ov[4], ov[5]); w.w = pk2(ov[6], ov[7]);
            *(u32x4*)(YB + tok * 512 + h * 64 + j0) = w;
        }
    }
    __syncthreads();
}

constexpr int LDA = 72, LDT = 40, LDF = 36;
constexpr int SC_WF = 0, SC_AT = 8192, SC_RT = SC_AT + 4608, SC_BT = SC_RT + 4608, SC_KT = SC_BT + 4608;
constexpr int SC_BCT = SC_KT + 4608, SC_KCT = SC_BCT + 5120, SC_VT = SC_KCT + 5120, SC_AHT = SC_VT + 5120, SC_UHT = SC_AHT + 5120;
constexpr int SC_AAB = SC_UHT + 5120, SC_ARB = SC_AAB + 4608, SC_ARK = SC_ARB + 2560, SC_RHS2 = SC_ARK + 2560, SC_YF = SC_RHS2 + 16384, SC_HT = SC_YF + 8192, SC_BON = SC_HT + 9216;
static_assert(SC_BON + 128 + 2048 <= RING_BYTES, "scan LDS map");
__device__ __forceinline__ float red16(float v) { v += dppf<0xB1>(v); v += dppf<0x4E>(v); v += dppf<0x141>(v); v += dppf<0x140>(v); return v; }
__device__ __forceinline__ bf16x8 ld16(const LAS bf16* p) { return *(const LAS bf16x8*)p; }
__device__ __forceinline__ bf16x8 ld8x2(const LAS bf16* p) { const u32x2 lo = *(const LAS u32x2*)p, hi = *(const LAS u32x2*)(p + 8); const u32x4 w = (u32x4){lo.x, lo.y, hi.x, hi.y}; return __builtin_bit_cast(bf16x8, w); }
__device__ __forceinline__ bf16x8 packq(const f32x16& x, int q) { u32x4 w; w.x = pk2(x[8 * q], x[8 * q + 1]); w.y = pk2(x[8 * q + 2], x[8 * q + 3]); w.z = pk2(x[8 * q + 4], x[8 * q + 5]); w.w = pk2(x[8 * q + 6], x[8 * q + 7]); return __builtin_bit_cast(bf16x8, w); }
#define MFMA32(a, b, c) __builtin_amdgcn_mfma_f32_32x32x16_bf16((a), (b), (c), 0, 0, 0)
struct ScanLoad { u32x2 cr, ck, cv, pr, pk, pv, g, decb, etab; f32x4 dec, eta; };
__device__ __forceinline__ void scan_load(ScanLoad& L, const bf16* ZR, const bf16* DEC, const bf16* AA, const bf16* GG, size_t tok, int hc, bool first) {
    const bf16* zc = ZR + tok * RWC + hc; const bf16* zp = zc - RWC;
    L.cr = *(const u32x2*)zc; L.ck = *(const u32x2*)(zc + 512); L.cv = *(const u32x2*)(zc + 1024);
    L.pr = (u32x2){0u, 0u}; L.pk = L.pr; L.pv = L.pr;
    if (!first) { L.pr = *(const u32x2*)zp; L.pk = *(const u32x2*)(zp + 512); L.pv = *(const u32x2*)(zp + 1024); }
    L.decb = *(const u32x2*)(DEC + tok * 512 + hc); L.etab = *(const u32x2*)(AA + tok * 512 + hc); L.g = *(const u32x2*)(GG + tok * 512 + hc);
}
#define LBAR() do { asm volatile("s_waitcnt lgkmcnt(0)" ::: "memory"); __builtin_amdgcn_s_barrier(); asm volatile("" ::: "memory"); } while (0)
typedef short v4i16_t __attribute__((ext_vector_type(4)));
__device__ __forceinline__ bf16x8 trfrag(const LAS bf16* X, int k0a, int k0b, int cbase, int lane) {
    const int g = lane >> 4, i = lane & 15, col = cbase + 16 * (g & 1) + 4 * (i & 3), rq = i >> 2;
    const v4i16_t lo = __builtin_amdgcn_ds_read_tr16_b64_v4i16((LAS v4i16_t*)(X + (k0a + rq) * LDA + col));
    const v4i16_t hi = __builtin_amdgcn_ds_read_tr16_b64_v4i16((LAS v4i16_t*)(X + (k0b + rq) * LDA + col));
    return (bf16x8){lo[0], lo[1], lo[2], lo[3], hi[0], hi[1], hi[2], hi[3]};
}
__device__ __forceinline__ void scan_unit_chunked(const Args& args, Frame& F, int bh) {
    const int b = bh >> 3, h = bh & 7, tid = F.tid, w = F.wave;
    LAS unsigned char* L = F.lds;
    LAS float* WF = (LAS float*)(L + SC_WF); LAS float* AAB = (LAS float*)(L + SC_AAB); LAS float* RHS2 = (LAS float*)(L + SC_RHS2); LAS float* YF = (LAS float*)(L + SC_YF); LAS float* BON = (LAS float*)(L + SC_BON);
    LAS bf16* AT = (LAS bf16*)(L + SC_AT); LAS bf16* RT = (LAS bf16*)(L + SC_RT); LAS bf16* BT = (LAS bf16*)(L + SC_BT); LAS bf16* KT = (LAS bf16*)(L + SC_KT);
    LAS bf16* BCT = (LAS bf16*)(L + SC_BCT); LAS bf16* KCT = (LAS bf16*)(L + SC_KCT); LAS bf16* VT = (LAS bf16*)(L + SC_VT); LAS bf16* AHT = (LAS bf16*)(L + SC_AHT); LAS bf16* UHT = (LAS bf16*)(L + SC_UHT);
    LAS bf16* ARB = (LAS bf16*)(L + SC_ARB); LAS bf16* ARK = (LAS bf16*)(L + SC_ARK); LAS bf16* HT = (LAS bf16*)(L + SC_HT);
    const bf16* ZR = WSP(bf16, WS_ZR); const bf16* DEC = WSP(bf16, WS_DEC); const bf16* AA = WSP(bf16, WS_AA); const bf16* GG = WSP(bf16, WS_GG); bf16* YB = WSP(bf16, WS_YB);
    const int t = tid >> 4, j0 = 4 * (tid & 15), hc = h * 64 + j0;
    LAS float* CST = (LAS float*)(L + SC_BON + 128);
    { const int c = tid >> 6, j = tid & 63; const float* src = c == 0 ? FIN(4) : c == 1 ? FIN(4) + 512 : c == 2 ? FIN(4) + 1024 : c == 3 ? FIN(10) : c == 4 ? FIN(11) : c == 5 ? FIN(12) : c == 6 ? FIN(13) : FIN(14);
      CST[c * 64 + j] = src[h * 64 + j]; }
    for (int i = tid; i < 64 * LDA / 2; i += 512) ((LAS unsigned*)HT)[i] = 0u;
    ScanLoad cur; scan_load(cur, ZR, DEC, AA, GG, (size_t)b * SEQ + t, hc, t == 0);
    LBAR();
    u32x2 pend = (u32x2){0u, 0u};
    for (int c0 = 0; c0 < SEQ; c0 += 32) {
        const size_t tok = (size_t)b * SEQ + c0 + t;
        float r[4], kp[4], v[4], al[4], be[4], gq[4]; f32x4 gl, gpl;
        {
            cur.dec = (f32x4){__expf(-bflo(cur.decb.x)), __expf(-bfhi(cur.decb.x)), __expf(-bflo(cur.decb.y)), __expf(-bfhi(cur.decb.y))};
            cur.eta = (f32x4){bflo(cur.etab.x), bfhi(cur.etab.x), bflo(cur.etab.y), bfhi(cur.etab.y)};
            const f32x4 mur = *(const LAS f32x4*)(CST + j0), muk = *(const LAS f32x4*)(CST + 64 + j0), muv = *(const LAS f32x4*)(CST + 128 + j0), kkc = *(const LAS f32x4*)(CST + 192 + j0), kac = *(const LAS f32x4*)(CST + 256 + j0), rkc = *(const LAS f32x4*)(CST + 320 + j0);
            const unsigned crw[2] = {cur.cr.x, cur.cr.y}, ckw[2] = {cur.ck.x, cur.ck.y}, cvw[2] = {cur.cv.x, cur.cv.y}, prw[2] = {cur.pr.x, cur.pr.y}, pkw[2] = {cur.pk.x, cur.pk.y}, pvw[2] = {cur.pv.x, cur.pv.y}, gw2[2] = {cur.g.x, cur.g.y};
            float k[4], kk[4]; float ss = 0.f;
#pragma unroll
            for (int j = 0; j < 4; ++j) {
                const float rc = (j & 1) ? bfhi(crw[j >> 1]) : bflo(crw[j >> 1]), rp = (j & 1) ? bfhi(prw[j >> 1]) : bflo(prw[j >> 1]);
                const float kc = (j & 1) ? bfhi(ckw[j >> 1]) : bflo(ckw[j >> 1]), kq = (j & 1) ? bfhi(pkw[j >> 1]) : bflo(pkw[j >> 1]);
                const float vc = (j & 1) ? bfhi(cvw[j >> 1]) : bflo(cvw[j >> 1]), vq = (j & 1) ? bfhi(pvw[j >> 1]) : bflo(pvw[j >> 1]);
                r[j] = rc + mur[j] * (rp - rc); k[j] = kc + muk[j] * (kq - kc); v[j] = vc + muv[j] * (vq - vc);
                kk[j] = k[j] * kkc[j]; ss += kk[j] * kk[j]; gq[j] = (j & 1) ? bfhi(gw2[j >> 1]) : bflo(gw2[j >> 1]);
            }
            ss = red16(ss);
            const float inv = __builtin_amdgcn_rsqf(fmaxf(ss, 1e-24f)); float bon = 0.f;
#pragma unroll
            for (int j = 0; j < 4; ++j) { kk[j] *= inv; al[j] = -kk[j]; be[j] = kk[j] * cur.eta[j]; kp[j] = k[j] * (1.f + (cur.eta[j] - 1.f) * kac[j]); bon += r[j] * kp[j] * rkc[j]; }
            bon = red16(bon);
            gl = cur.dec; gpl = (f32x4){1.f, 1.f, 1.f, 1.f};
            { const int ln = tid & 63;
#pragma unroll
              for (int j = 0; j < 4; ++j) { const float u1 = __shfl_up(gl[j], 16); gl[j] = (ln >= 16) ? gl[j] * u1 : gl[j]; }
#pragma unroll
              for (int j = 0; j < 4; ++j) { const float u2 = __shfl_up(gl[j], 32); gl[j] = (ln >= 32) ? gl[j] * u2 : gl[j]; }
#pragma unroll
              for (int j = 0; j < 4; ++j) { const float u3 = __shfl_up(gl[j], 16); gpl[j] = (ln >= 16) ? u3 : 1.f; }
              if (ln >= 48) *(LAS f32x4*)(WF + w * 64 + j0) = gl; }
            if ((tid & 15) == 0) BON[t] = bon;
        }
        if (c0 + 32 < SEQ && !(SCAN_STUB & 32)) scan_load(cur, ZR, DEC, AA, GG, tok + 32, hc, false);
        if (c0 > 0) { const bf16* yp = YB + (tok - 32) * 512 + hc; asm volatile("global_store_dwordx2 %0, %1, off" :: "v"(yp), "v"(pend) : "memory"); }
        LBAR();
        {
            f32x4 pre = (f32x4){1.f, 1.f, 1.f, 1.f}, gC = pre;
#pragma unroll
            for (int ww = 0; ww < 8; ++ww) { const f32x4 wt = *(const LAS f32x4*)(WF + ww * 64 + j0); gC = gC * wt; if (ww < w) pre = pre * wt; }
            const f32x4 gt = pre * gl, gp = pre * gpl;
            if (t == 31) *(LAS f32x4*)(WF + 512 + j0) = gC;
            float a_[4], r_[4], b_[4], k_[4], bc[4], kc[4];
#pragma unroll
            for (int j = 0; j < 4; ++j) { const float ig = __builtin_amdgcn_rcpf(gt[j]); a_[j] = al[j] * gp[j]; r_[j] = r[j] * gt[j]; b_[j] = be[j] * ig; k_[j] = kp[j] * ig; bc[j] = b_[j] * gC[j]; kc[j] = k_[j] * gC[j]; }
            u32x2 wv; wv.x = pk2(a_[0], a_[1]); wv.y = pk2(a_[2], a_[3]); *(LAS u32x2*)(AT + t * LDA + j0) = wv;
            wv.x = pk2(r_[0], r_[1]); wv.y = pk2(r_[2], r_[3]); *(LAS u32x2*)(RT + t * LDA + j0) = wv;
            wv.x = pk2(b_[0], b_[1]); wv.y = pk2(b_[2], b_[3]); *(LAS u32x2*)(BT + t * LDA + j0) = wv;
            wv.x = pk2(k_[0], k_[1]); wv.y = pk2(k_[2], k_[3]); *(LAS u32x2*)(KT + t * LDA + j0) = wv;
            wv.x = pk2(bc[0], bc[1]); wv.y = pk2(bc[2], bc[3]); *(LAS u32x2*)(BCT + t * LDA + j0) = wv;
            wv.x = pk2(kc[0], kc[1]); wv.y = pk2(kc[2], kc[3]); *(LAS u32x2*)(KCT + t * LDA + j0) = wv;
            wv.x = pk2(v[0], v[1]); wv.y = pk2(v[2], v[3]); *(LAS u32x2*)(VT + t * LDA + j0) = wv;
        }
        LBAR();
        if (w < 4 && !(SCAN_STUB & 1)) {
            const int lane = lane_now(), r32 = lane & 31, hh = lane >> 5;
            f32x16 mT, mN;
#pragma unroll
            for (int i = 0; i < 16; ++i) { mT[i] = 0.f; mN[i] = 0.f; }
#pragma unroll
            for (int q = 0; q < 4; ++q) { const bf16x8 bfr = ld16(BT + r32 * LDA + 8 * hh + 16 * q), afr = ld16(AT + r32 * LDA + 8 * hh + 16 * q);
                mT = MFMA32(bfr, afr, mT);
                mN = MFMA32(afr, bfr, mN); }
#pragma unroll
            for (int i = 0; i < 16; ++i) { const int c_ = crow(i, hh); mT[i] = (c_ < r32) ? mT[i] : 0.f; mN[i] = (r32 < c_) ? mN[i] : 0.f; }
            f32x16 X;
            if (w < 2) {
#pragma unroll
                for (int i = 0; i < 16; ++i) X[i] = bflo((unsigned)AT[crow(i, hh) * LDA + 32 * w + r32]);
            } else {
                f32x16 kT;
#pragma unroll
                for (int i = 0; i < 16; ++i) { kT[i] = 0.f; X[i] = 0.f; }
#pragma unroll
                for (int q = 0; q < 4; ++q) kT = MFMA32(ld16(KT + r32 * LDA + 8 * hh + 16 * q), ld16(AT + r32 * LDA + 8 * hh + 16 * q), kT);
#pragma unroll
                for (int i = 0; i < 16; ++i) kT[i] = (crow(i, hh) < r32) ? kT[i] : 0.f;
#pragma unroll
                for (int q = 0; q < 2; ++q) X = MFMA32(packq(kT, q), trfrag(VT, 16 * q + 4 * hh, 16 * q + 8 + 4 * hh, 32 * (w - 2), lane), X);
            }
#pragma unroll
            for (int k = 0; k < 5; ++k) {
                const bf16x8 t0 = packq(mT, 0), t1 = packq(mT, 1), x0 = packq(X, 0), x1 = packq(X, 1);
                X = MFMA32(t0, x0, X); X = MFMA32(t1, x1, X);
                if (k < 4) {
                    const bf16x8 n0 = packq(mN, 0), n1 = packq(mN, 1);
                    f32x16 zT, zN;
#pragma unroll
                    for (int i = 0; i < 16; ++i) { zT[i] = 0.f; zN[i] = 0.f; }
                    zT = MFMA32(n0, t0, zT); zT = MFMA32(n1, t1, zT);
                    zN = MFMA32(t0, n0, zN); zN = MFMA32(t1, n1, zN);
                    mT = zT; mN = zN;
                }
            }
            LAS bf16* dst = ((w < 2) ? AHT : UHT) + (32 * (w & 1) + r32) * LDT + 4 * hh;
#pragma unroll
            for (int i4 = 0; i4 < 4; ++i4) { u32x2 wv; wv.x = pk2(X[4 * i4], X[4 * i4 + 1]); wv.y = pk2(X[4 * i4 + 2], X[4 * i4 + 3]); *(LAS u32x2*)(dst + 8 * i4) = wv; }
        } else if (w < 6 && !(SCAN_STUB & 1)) {
            const int lane = lane_now(), r32 = lane & 31, hh = lane >> 5;
            const LAS bf16* Aop = ((w & 1) ? KT : BT) + r32 * LDA + 8 * hh; const LAS bf16* Bop = RT + r32 * LDA + 8 * hh;
            f32x16 x;
#pragma unroll
            for (int i = 0; i < 16; ++i) x[i] = 0.f;
#pragma unroll
            for (int q = 0; q < 4; ++q) x = MFMA32(ld16(Aop + 16 * q), ld16(Bop + 16 * q), x);
#pragma unroll
            for (int i = 0; i < 16; ++i) x[i] = (crow(i, hh) <= r32) ? x[i] : 0.f;
            LAS bf16* dst = ((w & 1) ? ARK : ARB) + r32 * LDT + 4 * hh;
#pragma unroll
            for (int i4 = 0; i4 < 4; ++i4) { u32x2 wv; wv.x = pk2(x[4 * i4], x[4 * i4 + 1]); wv.y = pk2(x[4 * i4 + 2], x[4 * i4 + 3]); *(LAS u32x2*)(dst + 8 * i4) = wv; }
        }
        LBAR();
        f32x16 hn;
        if (SCAN_STUB & 4) { for (int i = 0; i < 16; ++i) hn[i] = 0.f; } else if (w < 4) {
            const int lane = lane_now(), r32 = lane & 31, hh = lane >> 5;
            const int jb = w >> 1, ib = w & 1;
            f32x16 pt[2];
#pragma unroll
            for (int a = 0; a < 2; ++a) {
#pragma unroll
                for (int i = 0; i < 16; ++i) pt[a][i] = 0.f;
#pragma unroll
                for (int q = 0; q < 2; ++q) pt[a] = MFMA32(ld16(AHT + (32 * a + r32) * LDT + 16 * q + 8 * hh), trfrag(BCT, 16 * q + 8 * hh, 16 * q + 8 * hh + 4, 32 * jb, lane), pt[a]);
            }
            { const float gC = WF[512 + 32 * jb + r32];
#pragma unroll
              for (int i = 0; i < 16; ++i) { const float add = (crow(i, hh) == r32) ? gC : 0.f; pt[0][i] += (jb == 0) ? add : 0.f; pt[1][i] += (jb == 0) ? 0.f : add; } }
#pragma unroll
            for (int i = 0; i < 16; ++i) hn[i] = 0.f;
#pragma unroll
            for (int q = 0; q < 2; ++q) {
                hn = MFMA32(trfrag(BCT, 16 * q + 8 * hh, 16 * q + 8 * hh + 4, 32 * jb, lane), ld16(UHT + (32 * ib + r32) * LDT + 16 * q + 8 * hh), hn);
                hn = MFMA32(trfrag(KCT, 16 * q + 8 * hh, 16 * q + 8 * hh + 4, 32 * jb, lane), trfrag(VT, 16 * q + 8 * hh, 16 * q + 8 * hh + 4, 32 * ib, lane), hn);
            }
#pragma unroll
            for (int a = 0; a < 2; ++a)
#pragma unroll
                for (int q = 0; q < 2; ++q) hn = MFMA32(packq(pt[a], q), ld8x2(HT + (32 * ib + r32) * LDA + 32 * a + 16 * q + 4 * hh), hn);
        } else if (w < 6) {
            const int lane = lane_now(), r32 = lane & 31, hh = lane >> 5;
            const int ib = w & 1;
            f32x16 rt[2];
#pragma unroll
            for (int a = 0; a < 2; ++a) {
#pragma unroll
                for (int i = 0; i < 16; ++i) rt[a][i] = bflo((unsigned)RT[r32 * LDA + 32 * a + crow(i, hh)]);
#pragma unroll
                for (int q = 0; q < 2; ++q) rt[a] = MFMA32(ld16(AHT + (32 * a + r32) * LDT + 16 * q + 8 * hh), ld16(ARB + r32 * LDT + 16 * q + 8 * hh), rt[a]);
            }
            f32x16 y;
#pragma unroll
            for (int i = 0; i < 16; ++i) y[i] = 0.f;
#pragma unroll
            for (int q = 0; q < 2; ++q) {
                y = MFMA32(ld16(ARB + r32 * LDT + 16 * q + 8 * hh), ld16(UHT + (32 * ib + r32) * LDT + 16 * q + 8 * hh), y);
                y = MFMA32(ld16(ARK + r32 * LDT + 16 * q + 8 * hh), trfrag(VT, 16 * q + 8 * hh, 16 * q + 8 * hh + 4, 32 * ib, lane), y);
            }
#pragma unroll
            for (int a = 0; a < 2; ++a)
#pragma unroll
                for (int q = 0; q < 2; ++q) y = MFMA32(packq(rt[a], q), ld8x2(HT + (32 * ib + r32) * LDA + 32 * a + 16 * q + 4 * hh), y);
#pragma unroll
            for (int i = 0; i < 16; ++i) YF[crow(i, hh) * 64 + 32 * ib + r32] = y[i];
        }
        LBAR();
        if (w < 4) {
            const int lane = lane_now(), r32 = lane & 31, hh = lane >> 5;
            const int jb = w >> 1, ib = w & 1; LAS bf16* dst = HT + (32 * ib + r32) * LDA + 32 * jb + 4 * hh;
#pragma unroll
            for (int i4 = 0; i4 < 4; ++i4) { u32x2 wv; wv.x = pk2(hn[4 * i4], hn[4 * i4 + 1]); wv.y = pk2(hn[4 * i4 + 2], hn[4 * i4 + 3]); *(LAS u32x2*)(dst + 8 * i4) = wv; }
        }
        {
            const f32x4 y4 = *(const LAS f32x4*)(YF + t * 64 + j0);
            const float mean = red16((y4[0] + y4[1]) + (y4[2] + y4[3])) * (1.f / 64.f); float qv = 0.f;
#pragma unroll
            for (int j = 0; j < 4; ++j) { const float d = y4[j] - mean; qv += d * d; }
            const float rs = __builtin_amdgcn_rsqf(red16(qv) * (1.f / 64.f) + GN_EPS); const float bon = BON[t]; float ov[4];
            const f32x4 lnw = *(const LAS f32x4*)(CST + 384 + j0), lnb = *(const LAS f32x4*)(CST + 448 + j0);
#pragma unroll
            for (int j = 0; j < 4; ++j) ov[j] = ((y4[j] - mean) * rs * lnw[j] + lnb[j] + bon * v[j]) * gq[j];
            pend.x = pk2(ov[0], ov[1]); pend.y = pk2(ov[2], ov[3]);
        }
    }
    *(u32x2*)(YB + ((size_t)b * SEQ + SEQ - 32 + t) * 512 + hc) = pend;
}

__device__ __forceinline__ bool attn_step(const bf16x8 (&qf)[4], const bf16x8 (&kf)[4], const u32x2 (&vlo)[2][2], const u32x2 (&vhi)[2][2], f32x16& y0, f32x16& y1, float& carry, int s0, int t0, int q, int hi) {
    f32x16 p;
#pragma unroll
    for (int r = 0; r < 16; ++r) p[r] = 0.f;
#pragma unroll
    for (int d0 = 0; d0 < 4; ++d0) p = __builtin_amdgcn_mfma_f32_32x32x16_bf16(kf[d0], qf[d0], p, 0, 0, 0);
    float om[16], be[16];
#pragma unroll
    for (int r = 0; r < 16; ++r) {
        const int kv = crow(r, hi); const bool valid = (s0 + kv) < (t0 + q);
        const float z = fminf(p[r], 80.f); const float t = __expf(z); const float o = __builtin_amdgcn_rcpf(1.f + t);
        om[r] = valid ? o : 1.f; be[r] = valid ? t * o : 0.f;
    }
    float el[16], G[4], PG[4];
#pragma unroll
    for (int i = 0; i < 4; ++i) { el[4 * i + 3] = 1.f; el[4 * i + 2] = om[4 * i + 3]; el[4 * i + 1] = el[4 * i + 2] * om[4 * i + 2]; el[4 * i] = el[4 * i + 1] * om[4 * i + 1]; G[i] = el[4 * i] * om[4 * i]; }
#pragma unroll
    for (int i = 0; i < 4; ++i) PG[i] = __shfl_xor(G[i], 32);
    float sG[4], sP[4];
    sG[3] = 1.f; sG[2] = G[3]; sG[1] = G[3] * G[2]; sG[0] = sG[1] * G[1];
    sP[3] = 1.f; sP[2] = PG[3]; sP[1] = PG[3] * PG[2]; sP[0] = sP[1] * PG[1];
    const float total = (sG[0] * G[0]) * (sP[0] * PG[0]);
    float A[16];
#pragma unroll
    for (int i = 0; i < 4; ++i) { const float eg = sG[i] * (hi ? sP[i] : sP[i] * PG[i]) * carry;
#pragma unroll
        for (int j = 0; j < 4; ++j) A[4 * i + j] = be[4 * i + j] * el[4 * i + j] * eg; }
    carry *= total;
    bf16x8 pf[2];
#pragma unroll
    for (int s = 0; s < 2; ++s) { u32x4 w; w.x = pk2(A[8 * s], A[8 * s + 1]); w.y = pk2(A[8 * s + 2], A[8 * s + 3]); w.z = pk2(A[8 * s + 4], A[8 * s + 5]); w.w = pk2(A[8 * s + 6], A[8 * s + 7]); pf[s] = __builtin_bit_cast(bf16x8, w); }
#pragma unroll
    for (int s = 0; s < 2; ++s) {
        const u32x4 a0 = (u32x4){vlo[0][s].x, vlo[0][s].y, vhi[0][s].x, vhi[0][s].y}, a1 = (u32x4){vlo[1][s].x, vlo[1][s].y, vhi[1][s].x, vhi[1][s].y};
        y0 = __builtin_amdgcn_mfma_f32_32x32x16_bf16(__builtin_bit_cast(bf16x8, a0), pf[s], y0, 0, 0, 0);
        y1 = __builtin_amdgcn_mfma_f32_32x32x16_bf16(__builtin_bit_cast(bf16x8, a1), pf[s], y1, 0, 0, 0);
    }
    return __all(carry < 5.6e-14f);
}
__device__ __forceinline__ void attn_tile(Frame& F, int bh, int qt) {
    const int lane = F.lane, q = lane & 31, hi = lane >> 5, b = bh >> 3, h = bh & 7, t0 = 32 * qt;
    const size_t tokbase = (size_t)b * SEQ;
    const bf16* QB = WSP(bf16, WS_Q); const bf16* KB = WSP(bf16, WS_K); const bf16* VT = WSP(bf16, WS_VT); bf16* YA = WSP(bf16, WS_YA);
    bf16x8 qf[4];
    { const bf16* Qp = QB + (tokbase + t0 + q) * 512 + h * 64 + 8 * hi;
#pragma unroll
      for (int d0 = 0; d0 < 4; ++d0) qf[d0] = *(const bf16x8*)(Qp + 16 * d0); }
    f32x16 y0, y1;
#pragma unroll
    for (int r = 0; r < 16; ++r) { y0[r] = 0.f; y1[r] = 0.f; }
    float carry = 1.f;
    const bf16* Vrow = VT + (size_t)bh * 128 * 1024 + q * 16 + 4 * hi;
    bf16x8 kA[4], kB[4]; u32x2 vloA[2][2], vhiA[2][2], vloB[2][2], vhiB[2][2];
#define ATT_LOAD(KF, VLO, VHI, S0) do { const bf16* Kp_ = KB + (tokbase + (S0) + q) * 512 + h * 64 + 8 * hi; \
        _Pragma("unroll") for (int d0 = 0; d0 < 4; ++d0) KF[d0] = *(const bf16x8*)(Kp_ + 16 * d0); \
        _Pragma("unroll") for (int dt = 0; dt < 2; ++dt) _Pragma("unroll") for (int s_ = 0; s_ < 2; ++s_) { const bf16* vp_ = Vrow + (size_t)(((S0) >> 4) + s_) * 1024 + dt * 512; VLO[dt][s_] = *(const u32x2*)vp_; VHI[dt][s_] = *(const u32x2*)(vp_ + 8); } } while (0)
    ATT_LOAD(kA, vloA, vhiA, t0);
    for (int s0 = t0; ; ) {
        { const int sn = s0 >= 32 ? s0 - 32 : 0; ATT_LOAD(kB, vloB, vhiB, sn); __builtin_amdgcn_sched_barrier(0); }
        if (attn_step(qf, kA, vloA, vhiA, y0, y1, carry, s0, t0, q, hi)) break;
        s0 -= 32; if (s0 < 0) break;
        { const int sn = s0 >= 32 ? s0 - 32 : 0; ATT_LOAD(kA, vloA, vhiA, sn); __builtin_amdgcn_sched_barrier(0); }
        if (attn_step(qf, kB, vloB, vhiB, y0, y1, carry, s0, t0, q, hi)) break;
        s0 -= 32; if (s0 < 0) break;
    }
#undef ATT_LOAD
    bf16* Yp = YA + (tokbase + t0 + q) * 512 + h * 64 + 4 * hi;
#pragma unroll
    for (int i = 0; i < 4; ++i) {
        u32x2 w0, w1; w0.x = pk2(y0[4 * i], y0[4 * i + 1]); w0.y = pk2(y0[4 * i + 2], y0[4 * i + 3]); w1.x = pk2(y1[4 * i], y1[4 * i + 1]); w1.y = pk2(y1[4 * i + 2], y1[4 * i + 3]);
        *(u32x2*)(Yp + 8 * i) = w0; *(u32x2*)(Yp + 32 + 8 * i) = w1;
    }
}

__device__ __forceinline__ void p5a_router(const Args& args, Frame& F) {
    LAS float* LG = (LAS float*)F.lds;
    LAS unsigned* HIST = (LAS unsigned*)(F.lds + 32768); LAS unsigned* BASE = HIST + 32;
    const float* X1 = WSP(float, WS_X1); const float* GW = WSP(float, WS_GW); const float* rb = FIN(20);
    unsigned* cnt = F.ctl + CW_CNT; int* LIST = WSP(int, WS_LIST); float* LRS = WSP(float, WS_LRS); float* LGT = WSP(float, WS_LGT);
    const int tid = F.tid, lane = F.lane, wave = F.wave;
    for (int tb = blockIdx.x; tb < M / 128; tb += F.G) {
        if (tid < 32) HIST[tid] = 0u;
        __syncthreads();
        int ex[4] = {0, 0, 0, 0}; float gt[4] = {0.f, 0.f, 0.f, 0.f}; unsigned lr[4] = {0u, 0u, 0u, 0u}; int tok = 0; float rstd_keep = 0.f;
        {
            const int i = lane & 31, kh = lane >> 5, g = wave & 3, kq = wave >> 2; tok = tb * 128 + g * 32 + i;
            const float* xr = X1 + (size_t)tok * D + 512 * kq + 4 * kh;
            f32x16 acc;
#pragma unroll
            for (int r = 0; r < 16; ++r) acc[r] = 0.f;
            float ss = 0.f;
#pragma unroll 1
            for (int u0 = 0; u0 < 64; u0 += 8) {
                f32x4 a[8]; float gw[8][4];
#pragma unroll
                for (int uu = 0; uu < 8; ++uu) { a[uu] = *(const f32x4*)(xr + 8 * (u0 + uu)); const float* gp = GW + (size_t)(512 * kq + 8 * (u0 + uu) + 4 * kh) * 32 + i;
#pragma unroll
                    for (int j = 0; j < 4; ++j) gw[uu][j] = gp[32 * j]; }
#pragma unroll
                for (int uu = 0; uu < 8; ++uu) { ss += (a[uu][0] * a[uu][0] + a[uu][1] * a[uu][1]) + (a[uu][2] * a[uu][2] + a[uu][3] * a[uu][3]);
#pragma unroll
                    for (int j = 0; j < 4; ++j) acc = __builtin_amdgcn_mfma_f32_32x32x2f32(a[uu][j], gw[uu][j], acc, 0, 0, 0); }
            }
            ss += __shfl_xor(ss, 32);
            LAS float* RED = (LAS float*)(F.lds + 40960) + (g * 64 + lane) * 17;
            if (kq == 1) {
#pragma unroll
                for (int r = 0; r < 16; ++r) RED[r] = acc[r];
                RED[16] = ss; }
            __syncthreads();
            if (kq == 0) {
#pragma unroll
                for (int r = 0; r < 16; ++r) acc[r] += RED[r];
                ss += RED[16]; }
            if (wave < 4) {
            const float rstd = 1.0f / sqrtf(ss * (1.f / D) + RMS_EPS);
            rstd_keep = rstd;
            LAS float* L = LG + wave * (32 * 33);
#pragma unroll
            for (int r = 0; r < 16; ++r) L[crow(r, kh) * 33 + i] = acc[r];
            asm volatile("s_waitcnt lgkmcnt(0)" ::: "memory");
            if (kh == 0) {
                float v0 = -3.0e38f, v1 = -3.0e38f, v2 = -3.0e38f, v3 = -3.0e38f; int i0 = 0, i1 = 0, i2 = 0, i3 = 0;
                for (int e = 0; e < 32; ++e) { const float v = L[i * 33 + e] * rstd + rb[e];
                    if (v > v3) { if (v > v2) { v3 = v2; i3 = i2; if (v > v1) { v2 = v1; i2 = i1; if (v > v0) { v1 = v0; i1 = i0; v0 = v; i0 = e; } else { v1 = v; i1 = e; } } else { v2 = v; i2 = e; } } else { v3 = v; i3 = e; } } }
                const float e1 = __expf(v1 - v0), e2 = __expf(v2 - v0), e3 = __expf(v3 - v0), inv = 1.0f / (1.f + e1 + e2 + e3);
                ex[0] = i0; ex[1] = i1; ex[2] = i2; ex[3] = i3; gt[0] = inv; gt[1] = e1 * inv; gt[2] = e2 * inv; gt[3] = e3 * inv;
#pragma unroll
                for (int k = 0; k < 4; ++k) lr[k] = __hip_atomic_fetch_add(&HIST[ex[k]], 1u, __ATOMIC_RELAXED, __HIP_MEMORY_SCOPE_WORKGROUP);
            }
            }
        }
        __syncthreads();
        if (tid < 32) BASE[tid] = __hip_atomic_fetch_add(cnt + tid, HIST[tid], RLX_AGENT);
        __syncthreads();
        if (wave < 4 && lane < 32) {
#pragma unroll
            for (int k = 0; k < 4; ++k) { const unsigned pos = BASE[ex[k]] + lr[k]; const size_t li = (size_t)ex[k] * CAP + pos; LIST[li] = tok * 4 + k; LRS[li] = rstd_keep; LGT[li] = gt[k]; }
        }
        __syncthreads();
    }
}
__device__ __forceinline__ int moe_tables(Frame& F) {
    LAS int* CS = (LAS int*)(F.lds + MOE_OFF); LAS int* OFF = CS + 32; LAS unsigned char* TE = F.lds + MOE_TE;
    if (F.tid < 32) { int c = (int)__hip_atomic_load(F.ctl + CW_CNT + F.tid, RLX_AGENT); CS[F.tid] = c > CAP ? CAP : c; }
    __syncthreads();
    if (F.tid == 0) { int off = 0; for (int e = 0; e < 32; ++e) { OFF[e] = off; off += ((CS[e] + 255) >> 8) << 8; } OFF[32] = off; }
    __syncthreads();
    const int ntiles = OFF[32] >> 8;
    for (int t = F.tid; t < ntiles; t += 512) { int e = 0; while (e < 31 && OFF[e + 1] <= t * 256) ++e; TE[t] = (unsigned char)e; }
    __syncthreads();
    return ntiles;
}
__device__ __forceinline__ void p8_combine(Frame& F) {
    float* X1 = WSP(float, WS_X1); const unsigned char* YBF = WSP(unsigned char, WS_YBUF); bf16* X2B = WSP(bf16, WS_X2B); float* R2 = WSP(float, WS_RSTD2); float* RSS = WSP(float, WS_ROWSS);
    const int gw = F.vcu * 8 + F.wave, NGW = F.G * 8, lane = F.lane;
    for (int t = gw; t < M; t += NGW) {
        f32x4* xr = (f32x4*)(X1 + (size_t)t * D) + lane; f32x4 v[4]; float s = 0.f;
#pragma unroll
        for (int j = 0; j < 4; ++j) v[j] = xr[64 * j];
        unsigned yw[4][4];
#pragma unroll
        for (int k = 0; k < 4; ++k) { const unsigned* yr = (const unsigned*)(YBF + (size_t)(4 * t + k) * D) + lane;
#pragma unroll
            for (int j = 0; j < 4; ++j) yw[k][j] = yr[64 * j]; }
#pragma unroll
        for (int k = 0; k < 4; ++k)
#pragma unroll
            for (int j = 0; j < 4; ++j) { const f32x2 lo = __builtin_amdgcn_cvt_pk_f32_fp8((int)yw[k][j], false), hi = __builtin_amdgcn_cvt_pk_f32_fp8((int)yw[k][j], true);
                v[j].x += lo.x * (1.f / 32.f); v[j].y += lo.y * (1.f / 32.f); v[j].z += hi.x * (1.f / 32.f); v[j].w += hi.y * (1.f / 32.f); }
        u32x2* o = (u32x2*)(X2B + (size_t)t * D) + lane;
#pragma unroll
        for (int j = 0; j < 4; ++j) { s += (v[j].x * v[j].x + v[j].y * v[j].y) + (v[j].z * v[j].z + v[j].w * v[j].w); u32x2 w; w.x = pk2(v[j].x, v[j].y); w.y = pk2(v[j].z, v[j].w); o[64 * j] = w; }
        s = wave_sum(s);
        if (lane == 0) { R2[t] = 1.0f / sqrtf(s * (1.f / D) + RMS_EPS); RSS[t] = 0.f; }
    }
}
constexpr int NPHASE = 11;
__global__ void __launch_bounds__(512, 2) mega_fwd(Args args) {
    extern __shared__ __attribute__((aligned(16))) unsigned char lds[];
    Frame F;
    F.lds = (LAS unsigned char*)lds;
    F.wave = __builtin_amdgcn_readfirstlane((int)threadIdx.x >> 6); F.lane = lane_now(); F.tid = F.wave * 64 + F.lane;
    F.G = gridDim.x; { const int bx = blockIdx.x; F.vcu = (F.G % 8 == 0) ? (bx % 8) * (F.G / 8) + bx / 8 : bx; }
    F.ws = args.ws; F.ctl = (unsigned*)(args.ws + WS_CTL); F.out = args.out;
    volatile LAS unsigned* MISC = (volatile LAS unsigned*)(F.lds + LDSCTL_OFF);
    if (F.tid < 64) MISC[F.tid] = 0u;
    __syncthreads();
    const int lo = args.ph_lo, hi = args.ph_hi;
    XcdBarrier bar; bar.bar = F.ctl + CW_BAR; bar.x = 0; bar.st = nullptr;
    if (hi - lo > 1) bar = xcd_barrier_post(F.ctl + CW_BAR, MISC + 8, F.tid);
#ifndef PH_MASK
#define PH_MASK 0xFFFF
#endif
#define IN(k) ((((PH_MASK) >> (k)) & 1) && lo <= (k) && (k) < hi)
#define STAMP(k) do { if (TS_PROBE >= 0 && blockIdx.x == 0 && F.tid == 0) ((unsigned long long*)(F.ctl + 2048))[k] = __builtin_amdgcn_s_memrealtime(); } while (0)
#define SEAM(k) do { if (IN(k) && IN((k) + 1)) xcd_barrier(bar, F.wave); F.lane = lane_now(); F.tid = F.wave * 64 + F.lane; STAMP((k) + 1); } while (0)
    LAS unsigned char* ring = F.lds;
    STAMP(0);

    if (IN(0)) { p0_prologue(args, F); if (F.G < 256) expert_convert(args, F, F.vcu * 8 + F.wave, F.G * 8, 3); } SEAM(0);

    if (IN(1)) {
        constexpr unsigned ALLT = (1u << (INC / 256)) - 1u, F8T = (unsigned)(G1_F8_TILES) & ALLT, B16T = ALLT & ~F8T;
        if (B16T) { pg8::Gemm g{WSP(bf16, WS_XB), WSP(bf16, WS_WIN), M, INC, D, 0, nullptr, nullptr, nullptr}; pg8::MaskOrder S; S.init(M, B16T, F.G, (int)blockIdx.x);
            EpiG1 E{WSP(float, WS_RSTD0), WSP(bf16, WS_Q), WSP(bf16, WS_K), WSP(bf16, WS_VT), WSP(bf16, WS_ZR), WSP(bf16, WS_GT), 1.f};
            pg8::gemm_phase<EpiG1, pg8::MaskOrder, false, false>(ring, g, S, E, F.wave); }
        if (F8T) { pg8::Gemm g{WSP(bf16, WS_XB8), WSP(bf16, WS_WIN8), M, INC, D, 0, nullptr, nullptr, nullptr}; pg8::MaskOrder S; S.init(M, F8T, F.G, (int)blockIdx.x);
            EpiG1 E{WSP(float, WS_RSTD0), WSP(bf16, WS_Q), WSP(bf16, WS_K), WSP(bf16, WS_VT), WSP(bf16, WS_ZR), WSP(bf16, WS_GT), 1.f / 64.f};
            pg8::gemm_phase<EpiG1, pg8::MaskOrder, false, true>(ring, g, S, E, F.wave); }
    } SEAM(1);

    if (IN(2)) {
        for (int c = blockIdx.x; c < 256; c += F.G) {
            const int x = c & 7, y = c >> 3; pg8::LoraOrder S; S.half = y & 1; S.pm = x + 8 * (y >> 1); S.nu = 3 + (F.G >> 30);
            build_alora(args, F, S.pm);
            asm volatile("s_waitcnt vmcnt(0)" ::: "memory"); __syncthreads();
            pg8::Gemm g{WSP(bf16, WS_ALORA), WSP(bf16, WS_WL), M, LORA_N, LORA_K + (F.G >> 30), 0, nullptr, nullptr, nullptr};
            EpiLora E{FIN(5), FIN(7), WSP(bf16, WS_DEC), WSP(bf16, WS_AA), WSP(bf16, WS_GG)};
            pg8::gemm_phase(ring, g, S, E, F.wave);
        }
    } SEAM(2);

    if (IN(3)) {
        for (int u = blockIdx.x; u < 256; u += F.G) {
#ifndef P3_ONLY
#define P3_ONLY 5
#endif
            if (u < 128) { if (P3_ONLY != 2 && P3_ONLY != 3 && P3_ONLY != 4) scan_unit_chunked(args, F, u); else { bf16* YB = WSP(bf16, WS_YB); const int b = u >> 3, h = u & 7; for (int i = F.tid; i < SEQ * 8; i += 512) { const int tk = i >> 3, c8 = (i & 7) * 8; *(u32x4*)(YB + ((size_t)b * SEQ + tk) * 512 + h * 64 + c8) = (u32x4){0u, 0u, 0u, 0u}; } } }
            else if (P3_ONLY == 1 || P3_ONLY == 4) { bf16* YAz = WSP(bf16, WS_YA); const int bh = u - 128, b = bh >> 3, h = bh & 7; for (int i = F.tid; i < SEQ * 8; i += 512) { const int tk = i >> 3, c8 = (i & 7) * 8; *(u32x4*)(YAz + ((size_t)b * SEQ + tk) * 512 + h * 64 + c8) = (u32x4){0u, 0u, 0u, 0u}; } }
            else { const int bh = u - 128; for (int i = 0; i < 8; ++i) attn_tile(F, bh, F.wave + 8 * i);
                   if (F.G >= 256 && P3_ONLY != 3 && P3_ONLY != 5) expert_convert(args, F, bh * 8 + F.wave, 1024, 3);
                    }
        }
    if (TS_PROBE >= 0 && blockIdx.x == 0 && F.tid == 0) ((unsigned long long*)(F.ctl + 2048))[20] = __builtin_amdgcn_s_memrealtime();
    } SEAM(3);

    if (IN(4)) {
        pg8::StaticOrder S; S.init(M, D, F.G, (int)blockIdx.x);
        { pg8::Gemm g{WSP(bf16, WS_YA), WSP(bf16, WS_WA), M, D, AW, 0, nullptr, nullptr, nullptr}; EpiMerge<0> E{WSP(bf16, WS_GT), WSP(bf16, WS_MERGED)}; pg8::gemm_phase(ring, g, S, E, F.wave); }
        { pg8::Gemm g{WSP(bf16, WS_YB), WSP(bf16, WS_WB), M, D, RW, 0, nullptr, nullptr, nullptr}; EpiMerge<1> E{WSP(bf16, WS_GT), WSP(bf16, WS_MERGED)}; pg8::gemm_phase(ring, g, S, E, F.wave); }
    } SEAM(4);

    if (IN(5)) {
        pg8::Gemm g{WSP(bf16, WS_MERGED), WSP(bf16, WS_WO), M, D, D, 0, nullptr, nullptr, nullptr}; pg8::StaticOrder S; S.init(M, D, F.G, (int)blockIdx.x);
        EpiX1 E{FIN(0), WSP(float, WS_X1), FIN(18), WSP(unsigned char, WS_HN)};
        pg8::gemm_phase(ring, g, S, E, F.wave);
    } SEAM(5);

    if (IN(6)) { p5a_router(args, F); } SEAM(6);

    if (IN(7)) {
        const int ntiles = moe_tables(F);
        pg8::Gemm g{WSP(bf16, WS_HN), WSP(bf16, WS_W1), MAXROWS, F2, D, (size_t)F2 * D, WSP(int, WS_LIST), (const LAS int*)(F.lds + MOE_OFF) + 32, (const LAS int*)(F.lds + MOE_OFF)};
        pg8::MoeOrder S{ntiles, F2 / 256, F.G, (int)blockIdx.x, F.lds + MOE_TE};
        EpiSwiglu E{FIN(22), WSP(unsigned char, WS_ACT), WSP(int, WS_LIST), WSP(float, WS_LRS), (const LAS int*)(F.lds + MOE_OFF) + 32, (const LAS int*)(F.lds + MOE_OFF), (const LAS float*)(F.lds + RING_BYTES + 4096)};
        pg8::gemm_phase<EpiSwiglu, pg8::MoeOrder, true, true>(ring, g, S, E, F.wave);
    } SEAM(7);

    if (IN(8)) {
        const int ntiles = moe_tables(F);
        pg8::Gemm g{WSP(bf16, WS_ACT), WSP(bf16, WS_W2), MAXROWS, D, FH, (size_t)D * FH, nullptr, nullptr, nullptr};
        pg8::MoeOrder S{ntiles, D / 256, F.G, (int)blockIdx.x, F.lds + MOE_TE};
        EpiY E{FIN(24), WSP(int, WS_LIST), WSP(float, WS_LGT), WSP(unsigned char, WS_YBUF), (const LAS int*)(F.lds + MOE_OFF) + 32, (const LAS int*)(F.lds + MOE_OFF), (const LAS float*)(F.lds + RING_BYTES + 4096)};
        pg8::gemm_phase<EpiY, pg8::MoeOrder, false, true>(ring, g, S, E, F.wave);
    } SEAM(8);

    if (IN(9)) { p8_combine(F); } SEAM(9);

    if (IN(10)) {
        pg8::StaticOrder S; S.init(M, D, F.G, (int)blockIdx.x);
        { pg8::Gemm g{WSP(bf16, WS_X2B), WSP(bf16, WS_WG), M, D, D, 0, nullptr, nullptr, nullptr}; EpiGate E{WSP(float, WS_RSTD2), WSP(bf16, WS_PGT)}; pg8::gemm_phase(ring, g, S, E, F.wave); }
        { pg8::Gemm g{WSP(bf16, WS_PB), WSP(bf16, WS_WP), M, D, PLE, 0, nullptr, nullptr, nullptr}; EpiPle E{WSP(bf16, WS_X2B), WSP(bf16, WS_PGT), F.out, WSP(float, WS_ROWSS), F.ctl + CW_PCNT, FIN(28), F.ctl}; pg8::gemm_phase(ring, g, S, E, F.wave); }
    }
#undef IN
#undef SEAM
}

extern "C" void kernel_launch(void* const* d_in, const int* in_sizes, int n_in, void* d_out, int out_size, void* d_ws, size_t ws_size, hipStream_t stream) {
    static int grid = 0;
    if (grid == 0) {
        if (n_in != 29 || in_sizes[0] != M * D || out_size != M * D || ws_size < WS_END) {
            fprintf(stderr, "kernel_launch: unexpected shapes (n_in %d, in0 %d, out %d, ws %zu < %zu); nothing launched\n", n_in, n_in > 0 ? in_sizes[0] : -1, out_size, ws_size, (size_t)WS_END); grid = -1; return; }
        int dev = 0, cus = 0, per_cu = 0;
        if (hipGetDevice(&dev) != hipSuccess || hipDeviceGetAttribute(&cus, hipDeviceAttributeMultiprocessorCount, dev) != hipSuccess) { grid = -1; return; }
        if (hipFuncSetAttribute((const void*)mega_fwd, hipFuncAttributeMaxDynamicSharedMemorySize, LDS_BYTES) != hipSuccess) { fprintf(stderr, "kernel_launch: hipFuncSetAttribute failed\n"); grid = -1; return; }
        if (hipOccupancyMaxActiveBlocksPerMultiprocessor(&per_cu, (const void*)mega_fwd, 512, LDS_BYTES) != hipSuccess || per_cu < 1) { fprintf(stderr, "kernel_launch: occupancy query says %d blocks/CU\n", per_cu); }
        (void)hipGetLastError();
        grid = cus;
    }
    if (grid < 0) return;
    (void)hipMemsetAsync((char*)d_ws + WS_CTL, 0, CTL_ZERO_BYTES, stream);
    Args a{};
    for (int i = 0; i < 29; ++i) a.in[i] = (const float*)d_in[i];
    a.out = (float*)d_out; a.ws = (unsigned char*)d_ws;
#if MK_PER_PHASE
    for (int p = 0; p < NPHASE; ++p) { a.ph_lo = p; a.ph_hi = p + 1; hipLaunchKernelGGL(mega_fwd, dim3(grid), dim3(512), LDS_BYTES, stream, a); }
#else
    a.ph_lo = 0; a.ph_hi = NPHASE; hipLaunchKernelGGL(mega_fwd, dim3(grid), dim3(512), LDS_BYTES, stream, a);
#endif
}
```

```cpp
#include <hip/hip_runtime.h>
#include <cstdio>
#include <cstdint>

#ifndef P3_ONLY
#define P3_ONLY 0
#endif
#ifndef SCAN_STUB
#define SCAN_STUB 0
#endif
#ifndef ATT_FORCE
#define ATT_FORCE 0
#endif
#ifndef G1_F8_TILES
#define G1_F8_TILES 0x1FE030u
#endif
#ifndef EPI_STUB
#define EPI_STUB 0
#endif
#ifndef TS_PROBE
#define TS_PROBE -1
#endif
#ifndef TS_END_SLOT
#define TS_END_SLOT (TS_PROBE + 1)
#endif
#ifndef MK_PER_PHASE
#define MK_PER_PHASE 0
#endif

#define LAS __attribute__((address_space(3)))
#define GAS __attribute__((address_space(1)))
typedef unsigned short bf16;
typedef short bf16x8 __attribute__((ext_vector_type(8)));
typedef float f32x2 __attribute__((ext_vector_type(2)));
typedef float f32x4 __attribute__((ext_vector_type(4)));
typedef float f32x16 __attribute__((ext_vector_type(16)));
typedef unsigned u32x2 __attribute__((ext_vector_type(2)));
typedef unsigned u32x4 __attribute__((ext_vector_type(4)));
typedef __bf16 bf16x2_t __attribute__((ext_vector_type(2)));

constexpr int NB = 16, SEQ = 2048, D = 1024, M = NB * SEQ;
constexpr int NH = 8, HD = 64, AW = 512, RW = 512, RWC = 1792, INC = 5376;
constexpr int NE = 32, FH = 1024, F2 = 2048, PLE = 256, TOPK = 4;
constexpr int LORA_K = 256, LORA_N = 1536;
constexpr int CAP = 32768;
constexpr int MAXROWS = M * TOPK + NE * 256;
constexpr float RMS_EPS = 1e-5f, GN_EPS = 64e-5f;

constexpr size_t MiB = 1u << 20;
constexpr size_t WS_CTL = 0, CTL_ZERO_BYTES = 1 * MiB;
constexpr size_t WS_WIN = 1 * MiB;
constexpr size_t WS_WA = 12 * MiB, WS_WB = 13 * MiB, WS_WO = 14 * MiB, WS_WG = 16 * MiB, WS_WP = 18 * MiB;
constexpr size_t WS_WL = 18 * MiB + 512 * 1024;
constexpr size_t WS_GW = 19 * MiB + 256 * 1024;
constexpr size_t WS_W1 = 20 * MiB;
constexpr size_t WS_W2 = 148 * MiB;
constexpr size_t WS_PB = 212 * MiB;
constexpr size_t WS_RSTD0 = 228 * MiB, WS_RSTD2 = WS_RSTD0 + 128 * 1024, WS_ROWSS = WS_RSTD0 + 256 * 1024;
constexpr size_t WS_RSTD1 = WS_RSTD0 + 384 * 1024;
constexpr size_t WS_GATEW = WS_RSTD0 + 512 * 1024;
constexpr size_t WS_ROWSLOT = 229 * MiB;
constexpr size_t WS_LIST = 230 * MiB;
constexpr size_t WS_X1 = 236 * MiB;
constexpr size_t WS_YA = 236 * MiB, WS_YB = 268 * MiB, WS_ALORA = 300 * MiB;
constexpr size_t WS_GT = 364 * MiB;
constexpr size_t WS_Q = 492 * MiB, WS_K = 524 * MiB, WS_VT = 556 * MiB;
constexpr size_t WS_ZR = 588 * MiB;
constexpr size_t WS_XB = 700 * MiB;
constexpr size_t WS_DEC = 764 * MiB, WS_AA = 828 * MiB, WS_GG = 892 * MiB;
constexpr size_t WS_MERGED = 492 * MiB;
constexpr size_t WS_XS = 364 * MiB;
constexpr size_t WS_ACT = 684 * MiB;
constexpr size_t WS_HN = 364 * MiB;
constexpr size_t WS_YBUF = 428 * MiB;
constexpr size_t WS_X2B8 = 820 * MiB;
constexpr size_t WS_X2B = 684 * MiB;
constexpr size_t WS_PGT = 748 * MiB;
constexpr size_t WS_LRS = 956 * MiB, WS_LGT = 960 * MiB;
constexpr size_t WS_WIN8 = 84 * MiB;
constexpr size_t WS_XB8 = 96 * MiB;
constexpr size_t WS_END = 964 * MiB;
constexpr int CW_CNT = 64;
constexpr int CW_PCNT = 8192;
constexpr int CW_BAR = 4096;

constexpr int RING_BYTES = 131072;
constexpr int LDSCTL_OFF = RING_BYTES;
constexpr int MOE_OFF = RING_BYTES + 1024;
constexpr int MOE_TE = RING_BYTES + 2048;
constexpr int LDS_BYTES = 147456;

#define RLX_AGENT __ATOMIC_RELAXED, __HIP_MEMORY_SCOPE_AGENT
__device__ __forceinline__ unsigned pk2(float lo, float hi) { f32x2 v = {lo, hi}; bf16x2_t b = __builtin_convertvector(v, bf16x2_t); return __builtin_bit_cast(unsigned, b); }
__device__ __forceinline__ unsigned pk8(float a, float b, float c, float d) { int w = __builtin_amdgcn_cvt_pk_fp8_f32(a, b, 0, false); w = __builtin_amdgcn_cvt_pk_fp8_f32(c, d, w, true); return (unsigned)w; }
__device__ __forceinline__ float bflo(unsigned u) { return __uint_as_float(u << 16); }
__device__ __forceinline__ float bfhi(unsigned u) { return __uint_as_float(u & 0xffff0000u); }
__device__ __forceinline__ float sigm(float x) { return __builtin_amdgcn_rcpf(1.f + __expf(-x)); }
__device__ __forceinline__ float wave_sum(float v) {
#pragma unroll
    for (int o = 1; o < 64; o <<= 1) v += __shfl_xor(v, o);
    return v;
}
template <int CTRL> __device__ __forceinline__ float dppf(float v) { return __builtin_bit_cast(float, __builtin_amdgcn_update_dpp(0, __builtin_bit_cast(int, v), CTRL, 0xF, 0xF, true)); }
__device__ __forceinline__ float red8(float v) { v += dppf<0xB1>(v); v += dppf<0x4E>(v); v += dppf<0x141>(v); return v; }
__device__ __forceinline__ int lane_now() { int l; asm volatile("v_mbcnt_lo_u32_b32 %0, -1, 0\n\tv_mbcnt_hi_u32_b32 %0, -1, %0" : "=v"(l)); return l; }
__device__ __forceinline__ int crow(int r, int hi) { return (r & 3) + 8 * (r >> 2) + 4 * hi; }

struct PreNone {}; struct PreF { float f[8]; }; struct PreI { int i[8]; };
namespace pg8 {
#define PG8_LAS __attribute__((address_space(3)))
typedef unsigned short bf16_t;
constexpr int BM = 256, BK = 64, HALF = 128, HTB = HALF * BK * 2, STAGE_BYTES = 8 * HTB, NXCD = 8, WGM = 8;
__host__ __device__ __forceinline__ int lds_byte(int r, int c) { const int st = (r >> 4) * 2 + (c >> 5), rr = r & 15, cc = c & 31, ob = rr * 64 + cc * 2; return st * 1024 + (ob ^ (((ob >> 9) & 1) << 5)); }
__host__ __device__ __forceinline__ void stage_rc(int b, int& R, int& C) { const int st = b / 1024, sb = b % 1024, swz = sb ^ (((sb >> 9) & 1) << 5); R = (st >> 1) * 16 + swz / 64; C = (st & 1) * 32 + (swz % 64) / 2; }
__host__ __device__ __forceinline__ int perm32(int rho) { const int n = rho >> 4, i = rho & 15; return 8 * (i >> 2) + 4 * n + (i & 3); }

struct Unit { int pm, pn, e, par; };
struct Gemm { const bf16_t* A; const bf16_t* Bt; int M, N, K; size_t bsel_bytes; const int* glist; const PG8_LAS int* goff; const PG8_LAS int* gcnt; };

struct StaticOrder {
    int nM, nN, nwg, G, c;
    __device__ void init(int M_, int N_, int G_, int c_) { nM = M_ / BM; nN = N_ / BM; nwg = nM * nN; G = G_; c = c_; }
    __device__ bool next(int i, Unit& u) const {
        const long L = (long)i * G + c; if (L >= nwg) return false;
        int wgid = (int)L; { const int q = nwg / NXCD, r = nwg % NXCD, xcd = wgid % NXCD, off = wgid / NXCD; wgid = (xcd < r ? xcd * (q + 1) : r * (q + 1) + (xcd - r) * q) + off; }
        const int nig = WGM * nN, gid = wgid / nig, fm = gid * WGM, gsz = (nM - fm) < WGM ? (nM - fm) : WGM;
        u.pm = fm + ((wgid % nig) % gsz); u.pn = (wgid % nig) / gsz; u.e = 0; return true;
    }
};
struct MaskOrder {
    StaticOrder S; unsigned mask;
    __device__ void init(int M_, unsigned mask_, int G_, int c_) { mask = mask_; S.init(M_, BM * __builtin_popcount(mask_), G_, c_); }
    __device__ bool next(int i, Unit& u) const {
        if (!S.next(i, u)) return false;
        int n = u.pn, idx = 0;
#pragma unroll
        for (int t = 0; t < 21; ++t) if ((mask >> t) & 1u) { if (n == 0) idx = t; --n; }
        u.pn = idx; return true;
    }
};
struct LoraOrder {
    int pm, half, nu;
    __device__ bool next(int i, Unit& u) const { if (i >= nu) return false; u.pm = pm; u.pn = 3 * half + i; u.e = 0; return true; }
};
struct MoeOrder {
    int ntiles, npn, G, c; const PG8_LAS unsigned char* te;
    __device__ bool next(int i, Unit& u) const {
        int rt, pn;
        if ((G & 255) == 0 && (npn == 8 || npn == 4)) { const int x = c & 7, j = (c >> 3) & 31, rpx = 32 / npn, blk = c >> 8; rt = ((i * (G >> 8) + blk) * 8 + x) * rpx + j / npn; pn = j % npn; }
        else { const long L = (long)i * G + c; rt = (int)(L / npn); pn = (int)(L % npn); }
        if (rt >= ntiles) return false;
        u.pm = rt; u.pn = pn; u.e = te[rt]; return true;
    }
};

typedef int i32x4 __attribute__((ext_vector_type(4))); typedef int i32x8 __attribute__((ext_vector_type(8)));
template <class Epi, class Sched, bool GATHER = false, bool F8 = false>
__device__ __forceinline__ void gemm_phase(PG8_LAS unsigned char* lds, const Gemm g, const Sched& S, const Epi& E, const int wid) {
    const int lane = lane_now(), tid = wid * 64 + lane,
              wr = wid >> 2, wc = wid & 3, fr = lane & 15, fq = lane >> 4;
    const int K = g.K, nt = F8 ? K / (2 * BK) : K / BK;
    unsigned voffA[2], voffB[2];
#pragma unroll
    for (int i = 0; i < 2; ++i) { int R, C; stage_rc(tid * 16 + i * 8192, R, C); const int Rb = Epi::PERM ? ((R & ~31) + perm32(R & 31)) : R;
        voffA[i] = F8 ? (unsigned)(R * K + C * 2) : (unsigned)(R * K + C) * 2u; voffB[i] = F8 ? (unsigned)(Rb * K + C * 2) : (unsigned)(Rb * K + C) * 2u; }
    const size_t kstep = (size_t)(BK * 2);
    const size_t hstep = (size_t)HALF * K * (F8 ? 1 : 2);
    const size_t tstep = 2 * hstep;
    const unsigned ldsw = (unsigned)wid * 1024u;
    const int aoff = lds_byte(wr * 64 + fr, fq * 8), boff = lds_byte(wc * 32 + fr, fq * 8);
    const int aoffk[2] = {aoff, aoff + 1024}, boffk[2] = {boff, boff + 1024};
    unsigned vgC[2][2] = {{0u, 0u}, {0u, 0u}}, vgN[2][2] = {{0u, 0u}, {0u, 0u}};
#define PG8_GOFF(u, vo) do { _Pragma("unroll") for (int _h = 0; _h < 2; ++_h) _Pragma("unroll") for (int _i = 0; _i < 2; ++_i) { int R_, C_; stage_rc(tid * 16 + _i * 8192, R_, C_); \
        const int r_ = (u).pm * BM + _h * HALF + R_ - g.goff[(u).e]; int tok_ = 0; if (r_ < g.gcnt[(u).e]) tok_ = g.glist[(size_t)(u).e * 32768 + r_] >> 2; (vo)[_h][_i] = F8 ? (unsigned)(tok_ * K + C_ * 2) : (unsigned)(tok_ * K + C_) * 2u; } } while (0)
#define PG8_SA(b, h) (((b) * 2 + (h)) * HTB)
#define PG8_SB(b, h) ((4 + (b) * 2 + (h)) * HTB)
#define PG8_STAGE(bufoff, gbase, voff) do { _Pragma("unroll") for (int _i = 0; _i < 2; ++_i) \
        __builtin_amdgcn_global_load_lds((const unsigned*)((const char*)(gbase) + (voff)[_i]), (PG8_LAS unsigned*)(lds + (bufoff) + ldsw + _i * 8192), 16, 0, 0); } while (0)
#define PG8_STA(bufoff, h, ptr, kbyte, usenext) do { if constexpr (GATHER) { unsigned vo_[2] = {(usenext) ? vgN[h][0] : vgC[h][0], (usenext) ? vgN[h][1] : vgC[h][1]}; PG8_STAGE(bufoff, (const char*)g.A + (kbyte), vo_); } else { PG8_STAGE(bufoff, ptr, voffA); } } while (0)
#define PG8_LDA(dst, b, h) do { _Pragma("unroll") for (int m = 0; m < 4; ++m) _Pragma("unroll") for (int k = 0; k < 2; ++k) dst[m][k] = *(const PG8_LAS bf16x8*)(lds + PG8_SA(b, h) + aoffk[k] + m * 2048); } while (0)
#define PG8_LDB(dst, b, h) do { _Pragma("unroll") for (int n = 0; n < 2; ++n) _Pragma("unroll") for (int k = 0; k < 2; ++k) dst[n][k] = *(const PG8_LAS bf16x8*)(lds + PG8_SB(b, h) + boffk[k] + n * 2048); } while (0)
#define PG8_MMA(ai, bj, At, Bt, Z) do { __builtin_amdgcn_s_setprio(1); \
        if constexpr (F8) { \
            if (Z) { _Pragma("unroll") for (int m = 0; m < 4; ++m) _Pragma("unroll") for (int n = 0; n < 2; ++n) { const i32x8 b8_ = __builtin_shufflevector(__builtin_bit_cast(i32x4, Bt[n][0]), __builtin_bit_cast(i32x4, Bt[n][1]), 0, 1, 2, 3, 4, 5, 6, 7), a8_ = __builtin_shufflevector(__builtin_bit_cast(i32x4, At[m][0]), __builtin_bit_cast(i32x4, At[m][1]), 0, 1, 2, 3, 4, 5, 6, 7); \
                asm volatile("v_mfma_f32_16x16x128_f8f6f4 %0, %1, %2, 0" : "=&v"(acc[ai][bj][m][n]) : "v"(b8_), "v"(a8_)); } } \
            else { _Pragma("unroll") for (int m = 0; m < 4; ++m) _Pragma("unroll") for (int n = 0; n < 2; ++n) { const i32x8 b8_ = __builtin_shufflevector(__builtin_bit_cast(i32x4, Bt[n][0]), __builtin_bit_cast(i32x4, Bt[n][1]), 0, 1, 2, 3, 4, 5, 6, 7), a8_ = __builtin_shufflevector(__builtin_bit_cast(i32x4, At[m][0]), __builtin_bit_cast(i32x4, At[m][1]), 0, 1, 2, 3, 4, 5, 6, 7); \
                asm volatile("v_mfma_f32_16x16x128_f8f6f4 %0, %1, %2, %0" : "+v"(acc[ai][bj][m][n]) : "v"(b8_), "v"(a8_)); } } } \
        else { _Pragma("unroll") for (int m = 0; m < 4; ++m) _Pragma("unroll") for (int n = 0; n < 2; ++n) _Pragma("unroll") for (int k = 0; k < 2; ++k) acc[ai][bj][m][n] = __builtin_amdgcn_mfma_f32_16x16x32_bf16(Bt[n][k], At[m][k], acc[ai][bj][m][n], 0, 0, 0); } \
        __builtin_amdgcn_s_setprio(0); } while (0)
#define PG8_WAIT_V(n) asm volatile("s_waitcnt vmcnt(" #n ")" ::: "memory")
#define PG8_WAIT_L(n) asm volatile("s_waitcnt lgkmcnt(" #n ")" ::: "memory")
#define PG8_BAR __builtin_amdgcn_s_barrier()
#define PG8_SCHED __builtin_amdgcn_sched_barrier(0)
    Unit cur, nxt; int ui = 0;
    if (!S.next(0, cur)) return;
    typename Epi::Pre preC;
    f32x4 acc[2][2][4][2];
#define PG8_ZERO_ACC do { if constexpr (!F8) { _Pragma("unroll") for (int a = 0; a < 2; ++a) _Pragma("unroll") for (int b = 0; b < 2; ++b) _Pragma("unroll") for (int m = 0; m < 4; ++m) _Pragma("unroll") for (int n = 0; n < 2; ++n) acc[a][b][m][n] = (f32x4){0.f, 0.f, 0.f, 0.f}; } } while (0)
    PG8_ZERO_ACC;
    bf16x8 At[4][2], B0[2][2], B1[2][2];
    const char* cA = (const char*)g.A + (size_t)cur.pm * tstep; const char* cB = (const char*)g.Bt + (size_t)cur.e * g.bsel_bytes + (size_t)cur.pn * tstep;
    if constexpr (GATHER) PG8_GOFF(cur, vgC);
    PG8_STAGE(PG8_SB(0, 0), cB, voffB); PG8_STAGE(PG8_SB(0, 1), cB + hstep, voffB); PG8_STA(PG8_SA(0, 0), 0, cA, 0, false); PG8_STA(PG8_SA(0, 1), 1, cA + hstep, 0, false);
    if (wr == 1) PG8_BAR;
    PG8_WAIT_V(2); PG8_BAR;
    PG8_STAGE(PG8_SB(1, 0), cB + kstep, voffB); PG8_STA(PG8_SA(1, 0), 0, cA + kstep, kstep, false); PG8_STAGE(PG8_SB(1, 1), cB + hstep + kstep, voffB);
    PG8_WAIT_V(6); PG8_BAR;
    for (;;) {
        const bool has_next = S.next(ui + 1, nxt);
        E.pre(cur, wr, fr, preC);
        cur.par = ui & 1;
        if constexpr (Epi::LBIAS) { if (wid == 0) __builtin_amdgcn_global_load_lds((const unsigned*)(E.bias_tile(cur) + 4 * lane), (PG8_LAS unsigned*)(lds + RING_BYTES + 4096 + 1024 * (ui & 1)), 16, 0, 0); }
        if constexpr (GATHER) { if (has_next) PG8_GOFF(nxt, vgN); else { vgN[0][0] = vgC[0][0]; vgN[0][1] = vgC[0][1]; vgN[1][0] = vgC[1][0]; vgN[1][1] = vgC[1][1]; } }
        const char* nA = has_next ? (const char*)g.A + (size_t)nxt.pm * tstep : cA;
        const char* nB = has_next ? (const char*)g.Bt + (size_t)nxt.e * g.bsel_bytes + (size_t)nxt.pn * tstep : cB;
        for (int t = 0; t < nt; t += 2) {
            const bool last = (t == nt - 2), first = (t == 0);
            const char* a1 = cA + (size_t)(t + 1) * kstep;
            const char* a2 = last ? nA : cA + (size_t)(t + 2) * kstep; const char* b2 = last ? nB : cB + (size_t)(t + 2) * kstep;
            const char* a3 = a2 + kstep; const char* b3 = b2 + kstep;
            const size_t k2 = last ? 0 : (size_t)(t + 2) * kstep;
            PG8_LDB(B0, 0, 0); PG8_LDB(B1, 0, 1); PG8_SCHED; PG8_LDA(At, 0, 0); PG8_STA(PG8_SA(1, 1), 1, a1 + hstep, (size_t)(t + 1) * kstep, false);
            PG8_WAIT_V(8); PG8_WAIT_L(0); PG8_BAR; PG8_MMA(0, 0, At, B0, first); PG8_MMA(0, 1, At, B1, first); PG8_BAR; PG8_SCHED;
            PG8_LDA(At, 0, 1); PG8_STAGE(PG8_SB(0, 0), b2, voffB); PG8_STAGE(PG8_SB(0, 1), b2 + hstep, voffB); PG8_STA(PG8_SA(0, 0), 0, a2, k2, last);
            PG8_WAIT_V(8); PG8_WAIT_L(0); PG8_BAR; PG8_MMA(1, 0, At, B0, first); PG8_MMA(1, 1, At, B1, first); PG8_BAR; PG8_SCHED;
            PG8_LDB(B0, 1, 0); PG8_LDB(B1, 1, 1); PG8_SCHED; PG8_LDA(At, 1, 0); PG8_STA(PG8_SA(0, 1), 1, a2 + hstep, k2, last);
            PG8_WAIT_V(8); PG8_WAIT_L(0); PG8_BAR; PG8_MMA(0, 0, At, B0, false); PG8_MMA(0, 1, At, B1, false); PG8_BAR; PG8_SCHED;
            PG8_LDA(At, 1, 1); PG8_STAGE(PG8_SB(1, 0), b3, voffB); PG8_STAGE(PG8_SB(1, 1), b3 + hstep, voffB); PG8_STA(PG8_SA(1, 0), 0, a3, k2 + kstep, last);
            PG8_WAIT_V(8); PG8_WAIT_L(0); PG8_BAR; PG8_MMA(1, 0, At, B0, false); PG8_MMA(1, 1, At, B1, false); PG8_BAR; PG8_SCHED;
        }
        if (wr == 0) PG8_BAR;
        if constexpr (F8) asm volatile("s_nop 15\n\ts_nop 15\n\ts_nop 15" ::: "memory");
        E(acc, cur, wr, wc, fr, fq, preC);
        if (!has_next) break;
        PG8_ZERO_ACC;
        cur = nxt; cA = nA; cB = nB; ++ui;
        if constexpr (GATHER) { vgC[0][0] = vgN[0][0]; vgC[0][1] = vgN[0][1]; vgC[1][0] = vgN[1][0]; vgC[1][1] = vgN[1][1]; }
        if (wr == 1) PG8_BAR;
    }
    PG8_WAIT_V(0);
    PG8_BAR;
#undef PG8_SA
#undef PG8_SB
#undef PG8_STAGE
#undef PG8_LDA
#undef PG8_STA
#undef PG8_GOFF
#undef PG8_LDB
#undef PG8_MMA
#undef PG8_ZERO_ACC
#undef PG8_WAIT_V
#undef PG8_WAIT_L
#undef PG8_BAR
#undef PG8_SCHED
}
}
using pg8::Unit;
typedef const f32x4 (&AccRef)[2][2][4][2];

#define XB_TMO      128
#define XB_XCNT(j)  (256  + 64 * (j))
#define XB_XSUB(j)  (1280 + 64 * (j))
#define XB_XGEN(j)  (2304 + 64 * (j))
#define XB_TOP      3328
#define XB_TOPGEN   3392
#define XCD_BAR_WORDS 3456
#define XB_SPIN_CAP (1u << 22)
__device__ __forceinline__ unsigned xb_ld(unsigned* p)              { return __hip_atomic_load(p, __ATOMIC_RELAXED, __HIP_MEMORY_SCOPE_AGENT); }
__device__ __forceinline__ unsigned xb_add(unsigned* p, unsigned v) { return __hip_atomic_fetch_add(p, v, __ATOMIC_RELAXED, __HIP_MEMORY_SCOPE_AGENT); }
__device__ __forceinline__ unsigned xb_xcc_id() { return (unsigned)__builtin_amdgcn_s_getreg((3 << 11) | 20) & 0xFu; }
#define XB_SPIN(cond, bar) do { unsigned _sp = 0; while (cond) { __builtin_amdgcn_s_sleep(1); \
    if ((++_sp & 255u) == 0u) { if (xb_ld(&(bar)[XB_TMO])) break; if (_sp > XB_SPIN_CAP) { atomicAdd(&(bar)[XB_TMO], 1u); break; } } } } while (0)
struct XcdBarrier { unsigned* bar; unsigned x; volatile LAS unsigned* st; };
__device__ __forceinline__ XcdBarrier xcd_barrier_post(unsigned* bar, volatile LAS unsigned* st, int tid) {
    XcdBarrier b; b.bar = bar; b.x = xb_xcc_id(); b.st = st;
    if (tid == 0) (void)xb_add(&bar[XB_XCNT(b.x)], 1u);
    return b;
}
__device__ __forceinline__ void xcd_barrier_complete(unsigned* bar, unsigned x, unsigned& nloc, unsigned& nx) {
    const unsigned G = gridDim.x * gridDim.y * gridDim.z;
    unsigned sum, cnt, mine, sp = 0u;
    for (;;) {
        sum = 0u; cnt = 0u; mine = 0u;
#pragma unroll
        for (unsigned j = 0; j < 16; ++j) { const unsigned c = xb_ld(&bar[XB_XCNT(j)]); sum += c; cnt += (c > 0u) ? 1u : 0u; mine = (j == x) ? c : mine; }
        if (sum == G) break;
        __builtin_amdgcn_s_sleep(1);
        if ((++sp & 255u) == 0u) { if (xb_ld(&bar[XB_TMO])) break; if (sp > XB_SPIN_CAP) { atomicAdd(&bar[XB_TMO], 1u); break; } }
    }
    nloc = mine > 0u ? mine : 1u; nx = cnt > 0u ? cnt : 1u;
}
__device__ __forceinline__ void xcd_barrier(const XcdBarrier& b, int wave) {
    asm volatile("s_waitcnt vmcnt(0)" ::: "memory");
    __syncthreads();
    if (wave == 0 && lane_now() == 0) {
        unsigned* bar = b.bar;
        __builtin_amdgcn_s_waitcnt(0);
        unsigned nloc = b.st[0], nx = b.st[1];
        if (nloc == 0u) { xcd_barrier_complete(bar, b.x, nloc, nx); b.st[0] = nloc; b.st[1] = nx; }
        const unsigned old = xb_add(&bar[XB_XSUB(b.x)], 1u);
        const unsigned gen = old / nloc;
        if (old + 1u == (gen + 1u) * nloc) {
            __builtin_amdgcn_fence(__ATOMIC_RELEASE, "agent");
            asm volatile("s_waitcnt vmcnt(0)" ::: "memory");
            const unsigned og = xb_add(&bar[XB_TOP], 1u);
            const unsigned tg = og / nx;
            if (og + 1u == (tg + 1u) * nx) xb_add(&bar[XB_TOPGEN], 1u);
            else XB_SPIN(xb_ld(&bar[XB_TOPGEN]) == tg, bar);
            __builtin_amdgcn_fence(__ATOMIC_ACQUIRE, "agent");
            xb_add(&bar[XB_XGEN(b.x)], 1u);
            asm volatile("s_waitcnt vmcnt(0)" ::: "memory");
        } else {
            XB_SPIN(xb_ld(&bar[XB_XGEN(b.x)]) == gen, bar);
            __builtin_amdgcn_fence(__ATOMIC_ACQUIRE, "agent");
            asm volatile("s_waitcnt vmcnt(0)" ::: "memory");
        }
    }
    __syncthreads();
}

struct Frame {
    LAS unsigned char* lds;
    unsigned* ctl;
    int tid, lane, wave, vcu, G;
    unsigned char* ws;
    float* out;
};
#define WSP(T, off) ((T*)(F.ws + (off)))
struct Args { const float* in[29]; float* out; unsigned char* ws; int ph_lo, ph_hi; };
#define FIN(i) (args.in[i])

template <bool SWZ = false, bool Q8 = false>
__device__ __forceinline__ void p0_transpose_item(const float* W, int K, int N, bf16* WT, LAS float* scr, int item, int lane, const float* kscale) {
    const int nblk = N / 32, kb = item / nblk, nb = item % nblk, k0 = 64 * kb, n0 = 32 * nb;
#pragma unroll
    for (int b = 0; b < 2; ++b) {
        float v[16];
#pragma unroll
        for (int i = 0; i < 16; ++i) { const int kk = 2 * (16 * b + i) + (lane >> 5); v[i] = W[(size_t)(k0 + kk) * N + n0 + (lane & 31)]; }
        __builtin_amdgcn_sched_barrier(0);
#pragma unroll
        for (int i = 0; i < 16; ++i) { const int kk = 2 * (16 * b + i) + (lane >> 5); if (kscale) v[i] *= kscale[k0 + kk]; scr[kk * 33 + (lane & 31)] = v[i]; }
        __builtin_amdgcn_sched_barrier(0);
    }
    asm volatile("s_waitcnt lgkmcnt(0)" ::: "memory");
    if constexpr (Q8) {
        const int c4 = lane & 3;
#pragma unroll
        for (int j = 0; j < 2; ++j) { const int n = (lane >> 2) + 16 * j; const LAS float* s = scr + (16 * c4) * 33 + n;
            u32x4 o; o.x = pk8(64.f * s[0 * 33], 64.f * s[1 * 33], 64.f * s[2 * 33], 64.f * s[3 * 33]); o.y = pk8(64.f * s[4 * 33], 64.f * s[5 * 33], 64.f * s[6 * 33], 64.f * s[7 * 33]);
            o.z = pk8(64.f * s[8 * 33], 64.f * s[9 * 33], 64.f * s[10 * 33], 64.f * s[11 * 33]); o.w = pk8(64.f * s[12 * 33], 64.f * s[13 * 33], 64.f * s[14 * 33], 64.f * s[15 * 33]);
            int nr = n0 + n; if (SWZ) { const int cl = nr & 255; nr = (nr & ~255) + 128 * ((cl >> 3) & 1) + 32 * (cl >> 6) + 8 * ((cl >> 4) & 3) + (cl & 7); }
            *(u32x4*)((unsigned char*)WT + (size_t)nr * K + k0 + 16 * c4) = o; }
        asm volatile("s_waitcnt lgkmcnt(0)" ::: "memory");
        return; }
    const int c = lane & 7;
#pragma unroll
    for (int j = 0; j < 4; ++j) { const int n = (lane >> 3) + 8 * j; const LAS float* s = scr + (8 * c) * 33 + n;
        u32x4 o; o.x = pk2(s[0 * 33], s[1 * 33]); o.y = pk2(s[2 * 33], s[3 * 33]); o.z = pk2(s[4 * 33], s[5 * 33]); o.w = pk2(s[6 * 33], s[7 * 33]);
        int nr = n0 + n; if (SWZ) { const int cl = nr & 255; nr = (nr & ~255) + 128 * ((cl >> 3) & 1) + 32 * (cl >> 6) + 8 * ((cl >> 4) & 3) + (cl & 7); }
        *(u32x4*)(WT + (size_t)nr * K + k0 + 8 * c) = o; }
    asm volatile("s_waitcnt lgkmcnt(0)" ::: "memory");
}
__device__ __forceinline__ void p0_prologue(const Args& args, Frame& F) {
    LAS float* scr = (LAS float*)(F.lds + F.wave * 16384);
    const int gw = F.vcu * 8 + F.wave, NGW = F.G * 8, lane = F.lane;
    constexpr int I_IN = (D / 64) * (INC / 32), I_A = (AW / 64) * (D / 32), I_O = (D / 64) * (D / 32), I_P = (PLE / 64) * (D / 32);
    constexpr int I_W1 = (D / 64) * (F2 / 32), I_W2 = (FH / 64) * (D / 32);
    constexpr int NITEMS = I_IN + 2 * I_A + 2 * I_O + I_P;
    for (int it = gw; it < NITEMS; it += NGW) {
        int r = it;
        if (r < I_IN) { const int tile = (r % (INC / 32)) >> 3;
            if ((G1_F8_TILES >> tile) & 1) p0_transpose_item<false, true>(FIN(3), D, INC, WSP(bf16, WS_WIN8), scr, r, lane, FIN(2));
            else p0_transpose_item(FIN(3), D, INC, WSP(bf16, WS_WIN), scr, r, lane, FIN(2));
            continue; } r -= I_IN;
        if (r < I_A) { p0_transpose_item(FIN(15), AW, D, WSP(bf16, WS_WA), scr, r, lane, nullptr); continue; } r -= I_A;
        if (r < I_A) { p0_transpose_item(FIN(16), RW, D, WSP(bf16, WS_WB), scr, r, lane, nullptr); continue; } r -= I_A;
        if (r < I_O) { p0_transpose_item(FIN(17), D, D, WSP(bf16, WS_WO), scr, r, lane, nullptr); continue; } r -= I_O;
        if (r < I_O) { p0_transpose_item<false, true>(FIN(26), D, D, WSP(bf16, WS_WG), scr, r, lane, FIN(25)); continue; } r -= I_O;
        p0_transpose_item(FIN(27), PLE, D, WSP(bf16, WS_WP), scr, r, lane, nullptr);
    }
    { const int gt = (F.vcu * 512 + F.tid), NT = F.G * 512;
      bf16* WL = WSP(bf16, WS_WL);
      for (int i = gt; i < LORA_N * LORA_K; i += NT) { const int n = i >> 8, k = i & 255; float v = 0.f;
          if (n < 512) { if (k < 64) v = FIN(6)[k * 512 + n]; }
          else if (n < 1024) { if (k >= 64 && k < 128) v = FIN(8)[(k - 64) * 512 + (n - 512)]; }
          else { if (k >= 128) v = FIN(9)[(k - 128) * 512 + (n - 1024)]; }
          WL[i] = (bf16)(pk2(v, 0.f) & 0xffffu); }
      float* GW = WSP(float, WS_GW);
      for (int i = gt; i < D * NE; i += NT) GW[i] = FIN(19)[i] * FIN(18)[i >> 5];
    }
    { bf16* XB = WSP(bf16, WS_XB); float* R0 = WSP(float, WS_RSTD0); bf16* PB = WSP(bf16, WS_PB);
      for (int m = gw; m < M; m += NGW) {
          const f32x4* xr = (const f32x4*)(FIN(0) + (size_t)m * D) + lane;
          f32x4 v[4]; float s = 0.f;
#pragma unroll
          for (int j = 0; j < 4; ++j) { v[j] = xr[64 * j]; s += (v[j].x * v[j].x + v[j].y * v[j].y) + (v[j].z * v[j].z + v[j].w * v[j].w); }
          s = wave_sum(s);
          u32x2* o = (u32x2*)(XB + (size_t)m * D) + lane;
#pragma unroll
          for (int j = 0; j < 4; ++j) { if (G1_F8_TILES) (WSP(unsigned, WS_XB8) + (size_t)m * (D / 4))[lane + 64 * j] = pk8(v[j].x, v[j].y, v[j].z, v[j].w); u32x2 w; w.x = pk2(v[j].x, v[j].y); w.y = pk2(v[j].z, v[j].w); o[64 * j] = w; }
          if (lane == 0) R0[m] = 1.0f / sqrtf(s * (1.f / D) + RMS_EPS);
          const f32x4 pv = ((const f32x4*)(FIN(1) + (size_t)m * PLE))[lane];
          u32x2 w; w.x = pk2(pv.x, pv.y); w.y = pk2(pv.z, pv.w); ((u32x2*)(PB + (size_t)m * PLE))[lane] = w;
      }
    }
}

__device__ __forceinline__ void expert_convert(const Args& args, Frame& F, int wv, int NW, int which) {
    LAS float* scr = (LAS float*)(F.lds + F.wave * 16384);
    constexpr int I_W1 = (D / 64) * (F2 / 32), I_W2 = (FH / 64) * (D / 32);
    if (which & 1) for (int it = wv; it < NE * I_W1; it += NW) { const int e = it / I_W1; p0_transpose_item<true, true>(FIN(21) + (size_t)e * D * F2, D, F2, (bf16*)(WSP(unsigned char, WS_W1) + (size_t)e * F2 * D), scr, it % I_W1, F.lane, nullptr); }
    if (which & 2) for (int it = wv; it < NE * I_W2; it += NW) { const int e = it / I_W2; p0_transpose_item<false, true>(FIN(23) + (size_t)e * FH * D, FH, D, (bf16*)(WSP(unsigned char, WS_W2) + (size_t)e * D * FH), scr, it % I_W2, F.lane, nullptr); }
}
struct EpiG1 {
    static constexpr bool PERM = true;
    typedef PreF Pre; static constexpr bool LBIAS = false;
    const float* rstd; bf16 *Q, *K, *VT, *ZR, *GT; float rs_mul;
    __device__ __forceinline__ void pre(const Unit& u, int wr, int fr, PreF& P) const {
#pragma unroll
        for (int k = 0; k < 8; ++k) P.f[k] = rstd[u.pm * 256 + wr * 64 + fr + (k >> 2) * 128 + (k & 3) * 16] * rs_mul; }
    __device__ __forceinline__ void operator()(AccRef acc, const Unit& u, int wr, int wc, int fr, int fq, const Pre& P) const {
        const int pn = u.pn, rowb = u.pm * 256 + wr * 64 + fr, cl = wc * 32 + 8 * fq;
#pragma unroll
        for (int ai = 0; ai < 2; ++ai)
#pragma unroll
            for (int m = 0; m < 4; ++m) {
                const int row = rowb + ai * 128 + m * 16; const float rs = P.f[4 * ai + m];
                if (pn < 4) {
                    bf16* base = (pn < 2 ? Q : K) + (size_t)row * 512 + (pn & 1) * 256 + cl; const float sc = pn < 2 ? rs * 0.125f : rs;
#pragma unroll
                    for (int bj = 0; bj < 2; ++bj) { const f32x4 v0 = acc[ai][bj][m][0] * sc, v1 = acc[ai][bj][m][1] * sc;
                        u32x4 w; w.x = pk2(v0[0], v0[1]); w.y = pk2(v0[2], v0[3]); w.z = pk2(v1[0], v1[1]); w.w = pk2(v1[2], v1[3]); *(u32x4*)(base + bj * 128) = w; }
                } else if (pn < 6) {
                    const int b = row >> 11, s = row & 2047;
#pragma unroll
                    for (int bj = 0; bj < 2; ++bj)
#pragma unroll
                        for (int n = 0; n < 2; ++n)
#pragma unroll
                            for (int j = 0; j < 4; ++j) { const int c = (pn - 4) * 256 + cl + bj * 128 + 4 * n + j; const int hh = c >> 6, d = c & 63;
                                VT[((size_t)(((b * 8 + hh) * 128 + (s >> 4)) * 64 + d)) * 16 + (s & 15)] = (bf16)(pk2(acc[ai][bj][m][n][j] * rs, 0.f) & 0xffffu); }
                } else if (pn < 13) {
                    bf16* base = ZR + (size_t)row * RWC + (pn - 6) * 256 + cl;
#pragma unroll
                    for (int bj = 0; bj < 2; ++bj) { const f32x4 v0 = acc[ai][bj][m][0] * rs, v1 = acc[ai][bj][m][1] * rs;
                        u32x4 w; w.x = pk2(v0[0], v0[1]); w.y = pk2(v0[2], v0[3]); w.z = pk2(v1[0], v1[1]); w.w = pk2(v1[2], v1[3]); *(u32x4*)(base + bj * 128) = w; }
                } else {
                    bf16* base = GT + (size_t)row * 2048 + (pn - 13) * 256 + cl;
#pragma unroll
                    for (int bj = 0; bj < 2; ++bj) { const f32x4 v0 = acc[ai][bj][m][0] * rs, v1 = acc[ai][bj][m][1] * rs;
                        u32x4 w; w.x = pk2(sigm(v0[0]), sigm(v0[1])); w.y = pk2(sigm(v0[2]), sigm(v0[3])); w.z = pk2(sigm(v1[0]), sigm(v1[1])); w.w = pk2(sigm(v1[2]), sigm(v1[3])); *(u32x4*)(base + bj * 128) = w; }
                }
            }
    }
};
struct EpiLora {
    static constexpr bool PERM = true;
    typedef PreNone Pre; static constexpr bool LBIAS = false;
    __device__ __forceinline__ void pre(const Unit&, int, int, PreNone&) const {}
    const float *w0, *a0; bf16 *DEC, *AA, *GG;
    template <int MODE> __device__ __forceinline__ void body(AccRef acc, int rowb, int cb) const {
#pragma unroll
        for (int bj = 0; bj < 2; ++bj) {
            const int c = cb + bj * 128;
            f32x4 b0 = (f32x4){0.f, 0.f, 0.f, 0.f}, b1 = b0;
            if (MODE == 0) { b0 = *(const f32x4*)(w0 + c); b1 = *(const f32x4*)(w0 + c + 4); } else if (MODE == 1) { b0 = *(const f32x4*)(a0 + c); b1 = *(const f32x4*)(a0 + c + 4); }
#pragma unroll
            for (int ai = 0; ai < 2; ++ai)
#pragma unroll
                for (int m = 0; m < 4; ++m) { const int row = rowb + ai * 128 + m * 16;
                    const f32x4 v0 = acc[ai][bj][m][0] + b0, v1 = acc[ai][bj][m][1] + b1; float o[8];
#pragma unroll
                    for (int j = 0; j < 8; ++j) { const float v = j < 4 ? v0[j] : v1[j - 4];
                        if (MODE == 0) { const float y = -v; const float sp = y > 20.f ? y : __logf(1.f + __expf(y)); o[j] = __expf(-sp - 0.5f); }
                        else if (MODE == 1) o[j] = sigm(v); else o[j] = v; }
                    u32x4 w; w.x = pk2(o[0], o[1]); w.y = pk2(o[2], o[3]); w.z = pk2(o[4], o[5]); w.w = pk2(o[6], o[7]);
                    bf16* dst = (MODE == 0 ? DEC : MODE == 1 ? AA : GG) + (size_t)row * 512 + c; *(u32x4*)dst = w;
                    asm volatile("" ::: "memory"); }
        }
    }
    __device__ __forceinline__ void operator()(AccRef acc, const Unit& u, int wr, int wc, int fr, int fq, const Pre& P) const {
        const int pn = u.pn, rowb = u.pm * 256 + wr * 64 + fr, cb = (pn & 1) * 256 + wc * 32 + 8 * fq;
        if (pn < 2) body<0>(acc, rowb, cb); else if (pn < 4) body<1>(acc, rowb, cb); else body<2>(acc, rowb, cb);
    }
};
template <int SECOND> struct EpiMerge {
    static constexpr bool PERM = true;
    typedef PreNone Pre; static constexpr bool LBIAS = false;
    __device__ __forceinline__ void pre(const Unit&, int, int, PreNone&) const {}
    const bf16* GT; bf16* MG;
    __device__ __forceinline__ void operator()(AccRef acc, const Unit& u, int wr, int wc, int fr, int fq, const Pre& P) const {
        const int rowb = u.pm * 256 + wr * 64 + fr, c0 = u.pn * 256 + wc * 32 + 8 * fq;
#pragma unroll
        for (int bj = 0; bj < 2; ++bj) {
            const int c = c0 + bj * 128; u32x4 gv[8], ov[8];
#pragma unroll
            for (int k = 0; k < 8; ++k) { const int row = rowb + (k >> 2) * 128 + (k & 3) * 16; gv[k] = *(const u32x4*)(GT + (size_t)row * 2048 + SECOND * 1024 + c); if (SECOND) ov[k] = *(const u32x4*)(MG + (size_t)row * 1024 + c); }
            __builtin_amdgcn_sched_barrier(0);
#pragma unroll
            for (int k = 0; k < 8; ++k) { const int ai = k >> 2, m = k & 3, row = rowb + ai * 128 + m * 16;
                const f32x4 v0 = acc[ai][bj][m][0], v1 = acc[ai][bj][m][1];
                float o[8] = {v0[0] * bflo(gv[k].x), v0[1] * bfhi(gv[k].x), v0[2] * bflo(gv[k].y), v0[3] * bfhi(gv[k].y), v1[0] * bflo(gv[k].z), v1[1] * bfhi(gv[k].z), v1[2] * bflo(gv[k].w), v1[3] * bfhi(gv[k].w)};
                if (SECOND) { o[0] += bflo(ov[k].x); o[1] += bfhi(ov[k].x); o[2] += bflo(ov[k].y); o[3] += bfhi(ov[k].y); o[4] += bflo(ov[k].z); o[5] += bfhi(ov[k].z); o[6] += bflo(ov[k].w); o[7] += bfhi(ov[k].w); }
                u32x4 w; w.x = pk2(o[0], o[1]); w.y = pk2(o[2], o[3]); w.z = pk2(o[4], o[5]); w.w = pk2(o[6], o[7]); *(u32x4*)(MG + (size_t)row * 1024 + c) = w; }
            __builtin_amdgcn_sched_barrier(0);
        }
    }
};
struct EpiX1 {
    static constexpr bool PERM = true;
    typedef PreNone Pre; static constexpr bool LBIAS = false;
    __device__ __forceinline__ void pre(const Unit&, int, int, PreNone&) const {}
    const float* X; float* X1; const float* gn; unsigned char* HN;
    __device__ __forceinline__ void operator()(AccRef acc, const Unit& u, int wr, int wc, int fr, int fq, const Pre& P) const {
        const int rowb = u.pm * 256 + wr * 64 + fr, c0 = u.pn * 256 + wc * 32 + 8 * fq;
#pragma unroll
        for (int bj = 0; bj < 2; ++bj) { const f32x4 g0 = *(const f32x4*)(gn + c0 + bj * 128), g1 = *(const f32x4*)(gn + c0 + bj * 128 + 4);
#pragma unroll
            for (int ai = 0; ai < 2; ++ai) {
                f32x4 xa[4], xb[4];
#pragma unroll
                for (int m = 0; m < 4; ++m) { const size_t off = (size_t)(rowb + ai * 128 + m * 16) * D + c0 + bj * 128; xa[m] = *(const f32x4*)(X + off); xb[m] = *(const f32x4*)(X + off + 4); }
                __builtin_amdgcn_sched_barrier(0);
#pragma unroll
                for (int m = 0; m < 4; ++m) { const size_t off = (size_t)(rowb + ai * 128 + m * 16) * D + c0 + bj * 128;
                    const f32x4 x0 = xa[m] + acc[ai][bj][m][0], x1 = xb[m] + acc[ai][bj][m][1];
                    *(f32x4*)(X1 + off) = x0; *(f32x4*)(X1 + off + 4) = x1;
                    u32x2 w; w.x = pk8(x0[0] * g0[0], x0[1] * g0[1], x0[2] * g0[2], x0[3] * g0[3]); w.y = pk8(x1[0] * g1[0], x1[1] * g1[1], x1[2] * g1[2], x1[3] * g1[3]); *(u32x2*)(HN + off) = w; }
                __builtin_amdgcn_sched_barrier(0);
            }
        }
    }
};
struct EpiSwiglu {
    static constexpr bool PERM = true;
    typedef PreF Pre; static constexpr bool LBIAS = true;
    const float* b1; unsigned char* ACT; const int* LIST; const float* R1; const LAS int* OFF; const LAS int* CS; const LAS float* LB;
    __device__ __forceinline__ const float* bias_tile(const Unit& u) const { return b1 + (size_t)u.e * F2 + u.pn * 256; }
    __device__ __forceinline__ void pre(const Unit& u, int wr, int fr, PreF& P) const {
        const int rbase = u.pm * 256 + wr * 64 + fr - OFF[u.e], cnt = CS[u.e];
#pragma unroll
        for (int k = 0; k < 8; ++k) { const int r = rbase + (k >> 2) * 128 + (k & 3) * 16; P.f[k] = 0.f; if (r < cnt) P.f[k] = R1[(size_t)u.e * CAP + r] * (1.f / 64.f); } }
    __device__ __forceinline__ void operator()(AccRef acc, const Unit& u, int wr, int wc, int fr, int fq, const Pre& P) const {
        if (EPI_STUB & 1) return;
        const int rowb = u.pm * 256 + wr * 64 + fr, c0 = u.pn * 256 + wc * 64 + 16 * fq;
        const LAS float* bb = LB + 256 * u.par + wc * 64 + 16 * fq;
        const f32x4 bv0 = *(const LAS f32x4*)(bb), bv1 = *(const LAS f32x4*)(bb + 4), bv2 = *(const LAS f32x4*)(bb + 8), bv3 = *(const LAS f32x4*)(bb + 12);
#pragma unroll
        for (int ai = 0; ai < 2; ++ai)
#pragma unroll
            for (int m = 0; m < 4; ++m) { const int row = rowb + ai * 128 + m * 16; const float rs = P.f[4 * ai + m];
                const f32x4 v[4] = {acc[ai][0][m][0] * rs + bv0, acc[ai][0][m][1] * rs + bv1, acc[ai][1][m][0] * rs + bv2, acc[ai][1][m][1] * rs + bv3};
                float o[8];
#pragma unroll
                for (int p = 0; p < 8; ++p) { float gl = v[p >> 1][2 * (p & 1)], ul = v[p >> 1][2 * (p & 1) + 1];
                    gl = fminf(gl, 7.f); ul = fminf(fmaxf(ul, -7.f), 7.f); o[p] = (ul + 1.f) * gl * sigm(1.702f * gl); }
                u32x2 w; w.x = pk8(o[0], o[1], o[2], o[3]); w.y = pk8(o[4], o[5], o[6], o[7]); *(u32x2*)(ACT + (size_t)row * FH + (c0 >> 1)) = w;
                asm volatile("" ::: "memory"); }
    }
};
struct EpiY {
    static constexpr bool PERM = true;
    typedef PreI Pre; static constexpr bool LBIAS = true;
    const float* b2; const int* LIST; const float* gatew; unsigned char* YB; const LAS int* OFF; const LAS int* CS; const LAS float* LB;
    __device__ __forceinline__ const float* bias_tile(const Unit& u) const { return b2 + (size_t)u.e * D + u.pn * 256; }
    __device__ __forceinline__ void pre(const Unit& u, int wr, int fr, PreI& P) const {
        const int rbase = u.pm * 256 + wr * 64 + fr - OFF[u.e], cnt = CS[u.e];
#pragma unroll
        for (int k = 0; k < 8; ++k) { const int r = rbase + (k >> 2) * 128 + (k & 3) * 16; P.i[k] = -1; if (r < cnt) P.i[k] = LIST[(size_t)u.e * CAP + r]; } }
    __device__ __forceinline__ void operator()(AccRef acc, const Unit& u, int wr, int wc, int fr, int fq, const Pre& P) const {
        const int rowb = u.pm * 256 + wr * 64 + fr, c0 = u.pn * 256 + wc * 32 + 8 * fq;
        const LAS float* bb = LB + 256 * u.par + wc * 32 + 8 * fq; const int rbase = rowb - OFF[u.e];
        if (EPI_STUB & 2) return;

#pragma unroll
        for (int ai = 0; ai < 2; ++ai) {
            float gts[4];
#pragma unroll
            for (int m = 0; m < 4; ++m) { gts[m] = 0.f; if (P.i[4 * ai + m] >= 0) gts[m] = gatew[(size_t)u.e * CAP + rbase + ai * 128 + m * 16]; }
            __builtin_amdgcn_sched_barrier(0);
#pragma unroll
            for (int m = 0; m < 4; ++m) {
                const int slot = P.i[4 * ai + m]; if (slot >= 0) { const float gt = gts[m] * 32.f;
#pragma unroll
                    for (int bj = 0; bj < 2; ++bj) { const int c = c0 + bj * 128;
                        const f32x4 v0 = (acc[ai][bj][m][0] * (1.f / 64.f) + *(const LAS f32x4*)(bb + bj * 128)) * gt, v1 = (acc[ai][bj][m][1] * (1.f / 64.f) + *(const LAS f32x4*)(bb + bj * 128 + 4)) * gt;
                        u32x2 w; w.x = pk8(v0[0], v0[1], v0[2], v0[3]); w.y = pk8(v1[0], v1[1], v1[2], v1[3]); *(u32x2*)(YB + (size_t)slot * D + c) = w; } } }
            __builtin_amdgcn_sched_barrier(0); }
    }
};
struct EpiGate {
    static constexpr bool PERM = true;
    typedef PreF Pre; static constexpr bool LBIAS = false;
    __device__ __forceinline__ void pre(const Unit& u, int wr, int fr, PreF& P) const {
#pragma unroll
        for (int k = 0; k < 8; ++k) P.f[k] = rstd2[u.pm * 256 + wr * 64 + fr + (k >> 2) * 128 + (k & 3) * 16] * (1.f / 64.f); }
    const float* rstd2; bf16* GT;
    __device__ __forceinline__ void operator()(AccRef acc, const Unit& u, int wr, int wc, int fr, int fq, const Pre& P) const {
        const int rowb = u.pm * 256 + wr * 64 + fr, c0 = u.pn * 256 + wc * 32 + 8 * fq;
#pragma unroll
        for (int ai = 0; ai < 2; ++ai)
#pragma unroll
            for (int m = 0; m < 4; ++m) { const int row = rowb + ai * 128 + m * 16; const float rs = P.f[4 * ai + m];
#pragma unroll
                for (int bj = 0; bj < 2; ++bj) { const f32x4 v0 = acc[ai][bj][m][0] * rs, v1 = acc[ai][bj][m][1] * rs;
                    u32x4 w; w.x = pk2(sigm(v0[0]), sigm(v0[1])); w.y = pk2(sigm(v0[2]), sigm(v0[3])); w.z = pk2(sigm(v1[0]), sigm(v1[1])); w.w = pk2(sigm(v1[2]), sigm(v1[3]));
                    *(u32x4*)(GT + (size_t)row * D + c0 + bj * 128) = w; } }
    }
};
struct EpiPle {
    static constexpr bool PERM = true;
    typedef PreNone Pre; static constexpr bool LBIAS = false;
    __device__ __forceinline__ void pre(const Unit&, int, int, PreNone&) const {}
    const bf16* X2B; const bf16* GT; float* O; float* rowss; unsigned* pcnt; const float* fg; const unsigned* ctl;
    __device__ __forceinline__ void operator()(f32x4 (&acc)[2][2][4][2], const Unit& u, int wr, int wc, int fr, int fq, const Pre& P) const {
        const int rowb = u.pm * 256 + wr * 64 + fr, c0 = u.pn * 256 + wc * 32 + 8 * fq;
#pragma unroll
        for (int ai = 0; ai < 2; ++ai)
#pragma unroll
            for (int m = 0; m < 4; ++m) { const int row = rowb + ai * 128 + m * 16; float ss = 0.f;
#pragma unroll
                for (int bj = 0; bj < 2; ++bj) { const size_t off = (size_t)row * D + c0 + bj * 128;
                    const u32x4 xv = *(const u32x4*)(X2B + off), gv = *(const u32x4*)(GT + off); f32x4 a0 = acc[ai][bj][m][0], a1 = acc[ai][bj][m][1];
                    a0[0] = bflo(xv.x) + bflo(gv.x) * a0[0]; a0[1] = bfhi(xv.x) + bfhi(gv.x) * a0[1]; a0[2] = bflo(xv.y) + bflo(gv.y) * a0[2]; a0[3] = bfhi(xv.y) + bfhi(gv.y) * a0[3];
                    a1[0] = bflo(xv.z) + bflo(gv.z) * a1[0]; a1[1] = bfhi(xv.z) + bfhi(gv.z) * a1[1]; a1[2] = bflo(xv.w) + bflo(gv.w) * a1[2]; a1[3] = bfhi(xv.w) + bfhi(gv.w) * a1[3];
#pragma unroll
                    for (int j = 0; j < 4; ++j) ss += a0[j] * a0[j] + a1[j] * a1[j];
                    acc[ai][bj][m][0] = a0; acc[ai][bj][m][1] = a1; }
                ss += __shfl_xor(ss, 16); ss += __shfl_xor(ss, 32);
                if (fq == 0) atomicAdd(rowss + row, ss);
                asm volatile("" ::: "memory"); }
        asm volatile("s_waitcnt vmcnt(0)" ::: "memory");
        __builtin_amdgcn_s_barrier();
        if (wr == 0 && wc == 0) {
            unsigned* pc = pcnt + 64 * u.pm;
            if (fr == 0 && fq == 0) __hip_atomic_fetch_add(pc, 1u, RLX_AGENT);
            unsigned spins = 0; while ((unsigned)__builtin_amdgcn_readfirstlane(__hip_atomic_load(pc, RLX_AGENT)) < 4u && ++spins < (1u << 20)) __builtin_amdgcn_s_sleep(4);
        }
        asm volatile("s_waitcnt vmcnt(0)" ::: "memory");
        __builtin_amdgcn_s_barrier();
        asm volatile("" ::: "memory");
#pragma unroll
        for (int ai = 0; ai < 2; ++ai)
#pragma unroll
            for (int m = 0; m < 4; ++m) { const int row = rowb + ai * 128 + m * 16; const float rs = 1.0f / sqrtf(__hip_atomic_load(rowss + row, RLX_AGENT) * (1.f / D) + RMS_EPS);
#pragma unroll
                for (int bj = 0; bj < 2; ++bj) { const size_t off = (size_t)row * D + c0 + bj * 128;
                    f32x4 o0 = acc[ai][bj][m][0] * rs * *(const f32x4*)(fg + c0 + bj * 128), o1 = acc[ai][bj][m][1] * rs * *(const f32x4*)(fg + c0 + bj * 128 + 4);
                    if (TS_PROBE >= 0 && row == 0 && c0 == 0 && bj == 0) { const unsigned long long* ts = (const unsigned long long*)(ctl + 2048); const unsigned long long dt = ts[TS_END_SLOT] - ts[TS_PROBE]; o0[0] += (float)((dt + 300) / 1600) * 4.f; }
                    *(f32x4*)(O + off) = o0; *(f32x4*)(O + off + 4) = o1; }
                asm volatile("" ::: "memory"); }
    }
};

__device__ __forceinline__ void build_alora(const Args& args, Frame& F, int pm) {
    const bf16* ZR = WSP(bf16, WS_ZR); bf16* AL = WSP(bf16, WS_ALORA); const float* mu = FIN(4) + 1536;
#pragma unroll 1
    for (int half = 0; half < 2; ++half) {
        u32x4 zc[8], zp[8];
#pragma unroll
        for (int i = 0; i < 8; ++i) {
            const int id = F.tid + 512 * (8 * half + i), row = pm * 256 + (id >> 5), cc = (id & 31) * 8;
            zc[i] = *(const u32x4*)(ZR + (size_t)row * RWC + 1536 + cc);
            zp[i] = (u32x4){0u, 0u, 0u, 0u}; if ((row & (SEQ - 1)) != 0) zp[i] = *(const u32x4*)(ZR + (size_t)(row - 1) * RWC + 1536 + cc);
        }
#pragma unroll
        for (int i = 0; i < 8; ++i) {
            const int id = F.tid + 512 * (8 * half + i), row = pm * 256 + (id >> 5), cc = (id & 31) * 8;
            const unsigned zcw[4] = {zc[i].x, zc[i].y, zc[i].z, zc[i].w}, zpw[4] = {zp[i].x, zp[i].y, zp[i].z, zp[i].w}; float o[8];
#pragma unroll
            for (int j = 0; j < 8; ++j) { const float c = (j & 1) ? bfhi(zcw[j >> 1]) : bflo(zcw[j >> 1]), p = (j & 1) ? bfhi(zpw[j >> 1]) : bflo(zpw[j >> 1]);
                const float xs = c + mu[cc + j] * (p - c);
                o[j] = cc < 64 ? (1.f - 2.f * __builtin_amdgcn_rcpf(1.f + __expf(2.f * xs))) : (cc < 128 ? xs : sigm(xs)); }
            u32x4 w; w.x = pk2(o[0], o[1]); w.y = pk2(o[2], o[3]); w.z = pk2(o[4], o[5]); w.w = pk2(o[6], o[7]);
            *(u32x4*)(AL + (size_t)row * LORA_K + cc) = w;
        }
    }
}

__device__ __forceinline__ void scan_unit(const Args& args, Frame& F, int bh) {
    const int b = bh >> 3, h = bh & 7, tid = F.tid;
    LAS float* LW = (LAS float*)F.lds;
    LAS float* LKK = LW + 4096, *LBB = LW + 8192, *LKP = LW + 12288, *LRR = LW + 16384, *LVV = LW + 20480, *LYY = LW + 24576, *LBON = LW + 28672;
    const bf16* ZR = WSP(bf16, WS_ZR); const bf16* DEC = WSP(bf16, WS_DEC); const bf16* AA = WSP(bf16, WS_AA); const bf16* GG = WSP(bf16, WS_GG); bf16* YB = WSP(bf16, WS_YB);
    const float* mu = FIN(4); const float* k_k = FIN(10) + h * 64; const float* k_a = FIN(11) + h * 64; const float* r_k = FIN(12) + h * 64;
    const float* lnw = FIN(13) + h * 64; const float* lnb = FIN(14) + h * 64;
    const int tt_p = tid >> 3, j0 = 8 * (tid & 7);
    const int row = tid >> 3, cg = tid & 7;
    float S[8];
#pragma unroll
    for (int j = 0; j < 8; ++j) S[j] = 0.f;
    float mur[8], muk[8], muv[8], kk_c[8], ka_c[8], rk_c[8];
#pragma unroll
    for (int j = 0; j < 8; ++j) { mur[j] = mu[h * 64 + j0 + j]; muk[j] = mu[512 + h * 64 + j0 + j]; muv[j] = mu[1024 + h * 64 + j0 + j]; kk_c[j] = k_k[j0 + j]; ka_c[j] = k_a[j0 + j]; rk_c[j] = r_k[j0 + j]; }
    for (int c0 = 0; c0 < SEQ; c0 += 64) {
        __syncthreads();
        {
            const size_t tok = (size_t)b * SEQ + c0 + tt_p; const bool first = (c0 + tt_p) == 0;
            const bf16* zc = ZR + tok * RWC + h * 64 + j0; const bf16* zp = zc - RWC;
            u32x4 cr = *(const u32x4*)zc, ck = *(const u32x4*)(zc + 512), cv = *(const u32x4*)(zc + 1024);
            u32x4 pr = (u32x4){0u, 0u, 0u, 0u}, pk = pr, pv = pr;
            if (!first) { pr = *(const u32x4*)zp; pk = *(const u32x4*)(zp + 512); pv = *(const u32x4*)(zp + 1024); }
            const f32x4 d0 = *(const f32x4*)(DEC + tok * 512 + h * 64 + j0), d1 = *(const f32x4*)(DEC + tok * 512 + h * 64 + j0 + 4);
            const f32x4 a0 = *(const f32x4*)(AA + tok * 512 + h * 64 + j0), a1 = *(const f32x4*)(AA + tok * 512 + h * 64 + j0 + 4);
            const unsigned crw[4] = {cr.x, cr.y, cr.z, cr.w}, ckw[4] = {ck.x, ck.y, ck.z, ck.w}, cvw[4] = {cv.x, cv.y, cv.z, cv.w};
            const unsigned prw[4] = {pr.x, pr.y, pr.z, pr.w}, pkw[4] = {pk.x, pk.y, pk.z, pk.w}, pvw[4] = {pv.x, pv.y, pv.z, pv.w};
            float r[8], k[8], v[8], kk[8], a[8], dec[8]; float ss = 0.f;
#pragma unroll
            for (int j = 0; j < 8; ++j) {
                const float rc = (j & 1) ? bfhi(crw[j >> 1]) : bflo(crw[j >> 1]), rp = (j & 1) ? bfhi(prw[j >> 1]) : bflo(prw[j >> 1]);
                const float kc = (j & 1) ? bfhi(ckw[j >> 1]) : bflo(ckw[j >> 1]), kp = (j & 1) ? bfhi(pkw[j >> 1]) : bflo(pkw[j >> 1]);
                const float vc = (j & 1) ? bfhi(cvw[j >> 1]) : bflo(cvw[j >> 1]), vp = (j & 1) ? bfhi(pvw[j >> 1]) : bflo(pvw[j >> 1]);
                r[j] = rc + mur[j] * (rp - rc); k[j] = kc + muk[j] * (kp - kc); v[j] = vc + muv[j] * (vp - vc);
                kk[j] = k[j] * kk_c[j]; ss += kk[j] * kk[j];
                a[j] = j < 4 ? a0[j] : a1[j - 4]; dec[j] = j < 4 ? d0[j] : d1[j - 4];
            }
            ss = red8(ss);
            const float inv = 1.0f / fmaxf(sqrtf(ss), 1e-12f);
            float bon = 0.f; float kpv[8], bbv[8];
#pragma unroll
            for (int j = 0; j < 8; ++j) { kk[j] *= inv; bbv[j] = kk[j] * a[j]; kpv[j] = k[j] * (1.f + (a[j] - 1.f) * ka_c[j]); bon += r[j] * kpv[j] * rk_c[j]; }
            bon = red8(bon);
            const int o = tt_p * 64 + j0;
            *(LAS f32x4*)(LW + o) = (f32x4){dec[0], dec[1], dec[2], dec[3]}; *(LAS f32x4*)(LW + o + 4) = (f32x4){dec[4], dec[5], dec[6], dec[7]};
            *(LAS f32x4*)(LKK + o) = (f32x4){kk[0], kk[1], kk[2], kk[3]}; *(LAS f32x4*)(LKK + o + 4) = (f32x4){kk[4], kk[5], kk[6], kk[7]};
            *(LAS f32x4*)(LBB + o) = (f32x4){bbv[0], bbv[1], bbv[2], bbv[3]}; *(LAS f32x4*)(LBB + o + 4) = (f32x4){bbv[4], bbv[5], bbv[6], bbv[7]};
            *(LAS f32x4*)(LKP + o) = (f32x4){kpv[0], kpv[1], kpv[2], kpv[3]}; *(LAS f32x4*)(LKP + o + 4) = (f32x4){kpv[4], kpv[5], kpv[6], kpv[7]};
            *(LAS f32x4*)(LRR + o) = (f32x4){r[0], r[1], r[2], r[3]}; *(LAS f32x4*)(LRR + o + 4) = (f32x4){r[4], r[5], r[6], r[7]};
            *(LAS f32x4*)(LVV + o) = (f32x4){v[0], v[1], v[2], v[3]}; *(LAS f32x4*)(LVV + o + 4) = (f32x4){v[4], v[5], v[6], v[7]};
            if ((tid & 7) == 0) LBON[tt_p] = bon;
        }
        __syncthreads();
#pragma unroll 2
        for (int tt = 0; tt < 64; ++tt) {
            const int o = tt * 64 + 8 * cg;
            const f32x4 k0 = *(const LAS f32x4*)(LKK + o), k1 = *(const LAS f32x4*)(LKK + o + 4);
            const f32x4 w0 = *(const LAS f32x4*)(LW + o), w1 = *(const LAS f32x4*)(LW + o + 4);
            const f32x4 b0 = *(const LAS f32x4*)(LBB + o), b1 = *(const LAS f32x4*)(LBB + o + 4);
            const f32x4 p0 = *(const LAS f32x4*)(LKP + o), p1 = *(const LAS f32x4*)(LKP + o + 4);
            const f32x4 r0 = *(const LAS f32x4*)(LRR + o), r1 = *(const LAS f32x4*)(LRR + o + 4);
            const float vi = LVV[tt * 64 + row];
            float sa = (S[0] * k0[0] + S[1] * k0[1]) + (S[2] * k0[2] + S[3] * k0[3]) + (S[4] * k1[0] + S[5] * k1[1]) + (S[6] * k1[2] + S[7] * k1[3]);
            sa = -red8(sa);
#pragma unroll
            for (int j = 0; j < 4; ++j) { S[j] = S[j] * w0[j] + (sa * b0[j] + vi * p0[j]); S[4 + j] = S[4 + j] * w1[j] + (sa * b1[j] + vi * p1[j]); }
            float y = (S[0] * r0[0] + S[1] * r0[1]) + (S[2] * r0[2] + S[3] * r0[3]) + (S[4] * r1[0] + S[5] * r1[1]) + (S[6] * r1[2] + S[7] * r1[3]);
            y = red8(y);
            if (cg == 0) LYY[tt * 64 + row] = y;
        }
        __syncthreads();
        {
            const size_t tok = (size_t)b * SEQ + c0 + tt_p; const int o = tt_p * 64 + j0;
            const f32x4 y0 = *(const LAS f32x4*)(LYY + o), y1 = *(const LAS f32x4*)(LYY + o + 4);
            const f32x4 v0 = *(const LAS f32x4*)(LVV + o), v1 = *(const LAS f32x4*)(LVV + o + 4);
            float s = (y0[0] + y0[1]) + (y0[2] + y0[3]) + (y1[0] + y1[1]) + (y1[2] + y1[3]);
            const float mean = red8(s) * (1.f / 64.f); float q = 0.f;
#pragma unroll
            for (int j = 0; j < 4; ++j) { const float d0 = y0[j] - mean, d1 = y1[j] - mean; q += d0 * d0 + d1 * d1; }
            const float rs = 1.0f / sqrtf(red8(q) * (1.f / 64.f) + GN_EPS); const float bon = LBON[tt_p];
            const u32x4 gv = *(const u32x4*)(GG + tok * 512 + h * 64 + j0); const unsigned gw[4] = {gv.x, gv.y, gv.z, gv.w}; float ov[8];
#pragma unroll
            for (int j = 0; j < 8; ++j) { const float yy = j < 4 ? y0[j] : y1[j - 4], vv = j < 4 ? v0[j] : v1[j - 4]; const float g = (j & 1) ? bfhi(gw[j >> 1]) : bflo(gw[j >> 1]);
                ov[j] = ((yy - mean) * rs * lnw[j0 + j] + lnb[j0 + j] + bon * vv) * g; }
            u32x4 w; w.x = pk2(ov[0], ov[1]); w.y = pk2(ov[2], ov[3]); w.z = pk2(ov[4], ov[5]); w.w = pk2(ov[6], ov[7]);
            *(u32x4*)(YB + tok * 512 + h * 64 + j0) = w;
        }
    }
    __syncthreads();
}

constexpr int LDA = 72, LDT = 40, LDF = 36;
constexpr int SC_WF = 0, SC_AT = 8192, SC_RT = SC_AT + 4608, SC_BT = SC_RT + 4608, SC_KT = SC_BT + 4608;
constexpr int SC_BCT = SC_KT + 4608, SC_KCT = SC_BCT + 5120, SC_VT = SC_KCT + 5120, SC_AHT = SC_VT + 5120, SC_UHT = SC_AHT + 5120;
constexpr int SC_AAB = SC_UHT + 5120, SC_ARB = SC_AAB + 4608, SC_ARK = SC_ARB + 2560, SC_RHS2 = SC_ARK + 2560, SC_YF = SC_RHS2 + 16384, SC_HT = SC_YF + 8192, SC_BON = SC_HT + 9216;
static_assert(SC_BON + 128 + 2048 <= RING_BYTES, "scan LDS map");
__device__ __forceinline__ float red16(float v) { v += dppf<0xB1>(v); v += dppf<0x4E>(v); v += dppf<0x141>(v); v += dppf<0x140>(v); return v; }
__device__ __forceinline__ bf16x8 ld16(const LAS bf16* p) { return *(const LAS bf16x8*)p; }
__device__ __forceinline__ bf16x8 ld8x2(const LAS bf16* p) { const u32x2 lo = *(const LAS u32x2*)p, hi = *(const LAS u32x2*)(p + 8); const u32x4 w = (u32x4){lo.x, lo.y, hi.x, hi.y}; return __builtin_bit_cast(bf16x8, w); }
__device__ __forceinline__ bf16x8 packq(const f32x16& x, int q) { u32x4 w; w.x = pk2(x[8 * q], x[8 * q + 1]); w.y = pk2(x[8 * q + 2], x[8 * q + 3]); w.z = pk2(x[8 * q + 4], x[8 * q + 5]); w.w = pk2(x[8 * q + 6], x[8 * q + 7]); return __builtin_bit_cast(bf16x8, w); }
#define MFMA32(a, b, c) __builtin_amdgcn_mfma_f32_32x32x16_bf16((a), (b), (c), 0, 0, 0)
struct ScanLoad { u32x2 cr, ck, cv, pr, pk, pv, g, decb, etab; f32x4 dec, eta; };
__device__ __forceinline__ void scan_load(ScanLoad& L, const bf16* ZR, const bf16* DEC, const bf16* AA, const bf16* GG, size_t tok, int hc, bool first) {
    const bf16* zc = ZR + tok * RWC + hc; const bf16* zp = zc - RWC;
    L.cr = *(const u32x2*)zc; L.ck = *(const u32x2*)(zc + 512); L.cv = *(const u32x2*)(zc + 1024);
    L.pr = (u32x2){0u, 0u}; L.pk = L.pr; L.pv = L.pr;
    if (!first) { L.pr = *(const u32x2*)zp; L.pk = *(const u32x2*)(zp + 512); L.pv = *(const u32x2*)(zp + 1024); }
    L.decb = *(const u32x2*)(DEC + tok * 512 + hc); L.etab = *(const u32x2*)(AA + tok * 512 + hc); L.g = *(const u32x2*)(GG + tok * 512 + hc);
}
#define LBAR() do { asm volatile("s_waitcnt lgkmcnt(0)" ::: "memory"); __builtin_amdgcn_s_barrier(); asm volatile("" ::: "memory"); } while (0)
typedef short v4i16_t __attribute__((ext_vector_type(4)));
__device__ __forceinline__ bf16x8 trfrag(const LAS bf16* X, int k0a, int k0b, int cbase, int lane) {
    const int g = lane >> 4, i = lane & 15, col = cbase + 16 * (g & 1) + 4 * (i & 3), rq = i >> 2;
    const v4i16_t lo = __builtin_amdgcn_ds_read_tr16_b64_v4i16((LAS v4i16_t*)(X + (k0a + rq) * LDA + col));
    const v4i16_t hi = __builtin_amdgcn_ds_read_tr16_b64_v4i16((LAS v4i16_t*)(X + (k0b + rq) * LDA + col));
    return (bf16x8){lo[0], lo[1], lo[2], lo[3], hi[0], hi[1], hi[2], hi[3]};
}
__device__ __forceinline__ void scan_unit_chunked(const Args& args, Frame& F, int bh) {
    const int b = bh >> 3, h = bh & 7, tid = F.tid, w = F.wave;
    LAS unsigned char* L = F.lds;
    LAS float* WF = (LAS float*)(L + SC_WF); LAS float* AAB = (LAS float*)(L + SC_AAB); LAS float* RHS2 = (LAS float*)(L + SC_RHS2); LAS float* YF = (LAS float*)(L + SC_YF); LAS float* BON = (LAS float*)(L + SC_BON);
    LAS bf16* AT = (LAS bf16*)(L + SC_AT); LAS bf16* RT = (LAS bf16*)(L + SC_RT); LAS bf16* BT = (LAS bf16*)(L + SC_BT); LAS bf16* KT = (LAS bf16*)(L + SC_KT);
    LAS bf16* BCT = (LAS bf16*)(L + SC_BCT); LAS bf16* KCT = (LAS bf16*)(L + SC_KCT); LAS bf16* VT = (LAS bf16*)(L + SC_VT); LAS bf16* AHT = (LAS bf16*)(L + SC_AHT); LAS bf16* UHT = (LAS bf16*)(L + SC_UHT);
    LAS bf16* ARB = (LAS bf16*)(L + SC_ARB); LAS bf16* ARK = (LAS bf16*)(L + SC_ARK); LAS bf16* HT = (LAS bf16*)(L + SC_HT);
    const bf16* ZR = WSP(bf16, WS_ZR); const bf16* DEC = WSP(bf16, WS_DEC); const bf16* AA = WSP(bf16, WS_AA); const bf16* GG = WSP(bf16, WS_GG); bf16* YB = WSP(bf16, WS_YB);
    const int t = tid >> 4, j0 = 4 * (tid & 15), hc = h * 64 + j0;
    LAS float* CST = (LAS float*)(L + SC_BON + 128);
    { const int c = tid >> 6, j = tid & 63; const float* src = c == 0 ? FIN(4) : c == 1 ? FIN(4) + 512 : c == 2 ? FIN(4) + 1024 : c == 3 ? FIN(10) : c == 4 ? FIN(11) : c == 5 ? FIN(12) : c == 6 ? FIN(13) : FIN(14);
      CST[c * 64 + j] = src[h * 64 + j]; }
    for (int i = tid; i < 64 * LDA / 2; i += 512) ((LAS unsigned*)HT)[i] = 0u;
    ScanLoad cur; scan_load(cur, ZR, DEC, AA, GG, (size_t)b * SEQ + t, hc, t == 0);
    LBAR();
    u32x2 pend = (u32x2){0u, 0u};
    for (int c0 = 0; c0 < SEQ; c0 += 32) {
        const size_t tok = (size_t)b * SEQ + c0 + t;
        float r[4], kp[4], v[4], al[4], be[4], gq[4]; f32x4 gl, gpl;
        {
            cur.dec = (f32x4){__expf(-bflo(cur.decb.x)), __expf(-bfhi(cur.decb.x)), __expf(-bflo(cur.decb.y)), __expf(-bfhi(cur.decb.y))};
            cur.eta = (f32x4){bflo(cur.etab.x), bfhi(cur.etab.x), bflo(cur.etab.y), bfhi(cur.etab.y)};
            const f32x4 mur = *(const LAS f32x4*)(CST + j0), muk = *(const LAS f32x4*)(CST + 64 + j0), muv = *(const LAS f32x4*)(CST + 128 + j0), kkc = *(const LAS f32x4*)(CST + 192 + j0), kac = *(const LAS f32x4*)(CST + 256 + j0), rkc = *(const LAS f32x4*)(CST + 320 + j0);
            const unsigned crw[2] = {cur.cr.x, cur.cr.y}, ckw[2] = {cur.ck.x, cur.ck.y}, cvw[2] = {cur.cv.x, cur.cv.y}, prw[2] = {cur.pr.x, cur.pr.y}, pkw[2] = {cur.pk.x, cur.pk.y}, pvw[2] = {cur.pv.x, cur.pv.y}, gw2[2] = {cur.g.x, cur.g.y};
            float k[4], kk[4]; float ss = 0.f;
#pragma unroll
            for (int j = 0; j < 4; ++j) {
                const float rc = (j & 1) ? bfhi(crw[j >> 1]) : bflo(crw[j >> 1]), rp = (j & 1) ? bfhi(prw[j >> 1]) : bflo(prw[j >> 1]);
                const float kc = (j & 1) ? bfhi(ckw[j >> 1]) : bflo(ckw[j >> 1]), kq = (j & 1) ? bfhi(pkw[j >> 1]) : bflo(pkw[j >> 1]);
                const float vc = (j & 1) ? bfhi(cvw[j >> 1]) : bflo(cvw[j >> 1]), vq = (j & 1) ? bfhi(pvw[j >> 1]) : bflo(pvw[j >> 1]);
                r[j] = rc + mur[j] * (rp - rc); k[j] = kc + muk[j] * (kq - kc); v[j] = vc + muv[j] * (vq - vc);
                kk[j] = k[j] * kkc[j]; ss += kk[j] * kk[j]; gq[j] = (j & 1) ? bfhi(gw2[j >> 1]) : bflo(gw2[j >> 1]);
            }
            ss = red16(ss);
            const float inv = __builtin_amdgcn_rsqf(fmaxf(ss, 1e-24f)); float bon = 0.f;
#pragma unroll
            for (int j = 0; j < 4; ++j) { kk[j] *= inv; al[j] = -kk[j]; be[j] = kk[j] * cur.eta[j]; kp[j] = k[j] * (1.f + (cur.eta[j] - 1.f) * kac[j]); bon += r[j] * kp[j] * rkc[j]; }
            bon = red16(bon);
            gl = cur.dec; gpl = (f32x4){1.f, 1.f, 1.f, 1.f};
            { const int ln = tid & 63;
#pragma unroll
              for (int j = 0; j < 4; ++j) { const float u1 = __shfl_up(gl[j], 16); gl[j] = (ln >= 16) ? gl[j] * u1 : gl[j]; }
#pragma unroll
              for (int j = 0; j < 4; ++j) { const float u2 = __shfl_up(gl[j], 32); gl[j] = (ln >= 32) ? gl[j] * u2 : gl[j]; }
#pragma unroll
              for (int j = 0; j < 4; ++j) { const float u3 = __shfl_up(gl[j], 16); gpl[j] = (ln >= 16) ? u3 : 1.f; }
              if (ln >= 48) *(LAS f32x4*)(WF + w * 64 + j0) = gl; }
            if ((tid & 15) == 0) BON[t] = bon;
        }
        if (c0 + 32 < SEQ && !(SCAN_STUB & 32)) scan_load(cur, ZR, DEC, AA, GG, tok + 32, hc, false);
        if (c0 > 0) { const bf16* yp = YB + (tok - 32) * 512 + hc; asm volatile("global_store_dwordx2 %0, %1, off" :: "v"(yp), "v"(pend) : "memory"); }
        LBAR();
        {
            f32x4 pre = (f32x4){1.f, 1.f, 1.f, 1.f}, gC = pre;
#pragma unroll
            for (int ww = 0; ww < 8; ++ww) { const f32x4 wt = *(const LAS f32x4*)(WF + ww * 64 + j0); gC = gC * wt; if (ww < w) pre = pre * wt; }
            const f32x4 gt = pre * gl, gp = pre * gpl;
            if (t == 31) *(LAS f32x4*)(WF + 512 + j0) = gC;
            float a_[4], r_[4], b_[4], k_[4], bc[4], kc[4];
#pragma unroll
            for (int j = 0; j < 4; ++j) { const float ig = __builtin_amdgcn_rcpf(gt[j]); a_[j] = al[j] * gp[j]; r_[j] = r[j] * gt[j]; b_[j] = be[j] * ig; k_[j] = kp[j] * ig; bc[j] = b_[j] * gC[j]; kc[j] = k_[j] * gC[j]; }
            u32x2 wv; wv.x = pk2(a_[0], a_[1]); wv.y = pk2(a_[2], a_[3]); *(LAS u32x2*)(AT + t * LDA + j0) = wv;
            wv.x = pk2(r_[0], r_[1]); wv.y = pk2(r_[2], r_[3]); *(LAS u32x2*)(RT + t * LDA + j0) = wv;
            wv.x = pk2(b_[0], b_[1]); wv.y = pk2(b_[2], b_[3]); *(LAS u32x2*)(BT + t * LDA + j0) = wv;
            wv.x = pk2(k_[0], k_[1]); wv.y = pk2(k_[2], k_[3]); *(LAS u32x2*)(KT + t * LDA + j0) = wv;
            wv.x = pk2(bc[0], bc[1]); wv.y = pk2(bc[2], bc[3]); *(LAS u32x2*)(BCT + t * LDA + j0) = wv;
            wv.x = pk2(kc[0], kc[1]); wv.y = pk2(kc[2], kc[3]); *(LAS u32x2*)(KCT + t * LDA + j0) = wv;
            wv.x = pk2(v[0], v[1]); wv.y = pk2(v[2], v[3]); *(LAS u32x2*)(VT + t * LDA + j0) = wv;
        }
        LBAR();
        if (w < 4 && !(SCAN_STUB & 1)) {
            const int lane = lane_now(), r32 = lane & 31, hh = lane >> 5;
            f32x16 mT, mN;
#pragma unroll
            for (int i = 0; i < 16; ++i) { mT[i] = 0.f; mN[i] = 0.f; }
#pragma unroll
            for (int q = 0; q < 4; ++q) { const bf16x8 bfr = ld16(BT + r32 * LDA + 8 * hh + 16 * q), afr = ld16(AT + r32 * LDA + 8 * hh + 16 * q);
                mT = MFMA32(bfr, afr, mT);
                mN = MFMA32(afr, bfr, mN); }
#pragma unroll
            for (int i = 0; i < 16; ++i) { const int c_ = crow(i, hh); mT[i] = (c_ < r32) ? mT[i] : 0.f; mN[i] = (r32 < c_) ? mN[i] : 0.f; }
            f32x16 X;
            if (w < 2) {
#pragma unroll
                for (int i = 0; i < 16; ++i) X[i] = bflo((unsigned)AT[crow(i, hh) * LDA + 32 * w + r32]);
            } else {
                f32x16 kT;
#pragma unroll
                for (int i = 0; i < 16; ++i) { kT[i] = 0.f; X[i] = 0.f; }
#pragma unroll
                for (int q = 0; q < 4; ++q) kT = MFMA32(ld16(KT + r32 * LDA + 8 * hh + 16 * q), ld16(AT + r32 * LDA + 8 * hh + 16 * q), kT);
#pragma unroll
                for (int i = 0; i < 16; ++i) kT[i] = (crow(i, hh) < r32) ? kT[i] : 0.f;
#pragma unroll
                for (int q = 0; q < 2; ++q) X = MFMA32(packq(kT, q), trfrag(VT, 16 * q + 4 * hh, 16 * q + 8 + 4 * hh, 32 * (w - 2), lane), X);
            }
#pragma unroll
            for (int k = 0; k < 5; ++k) {
                const bf16x8 t0 = packq(mT, 0), t1 = packq(mT, 1), x0 = packq(X, 0), x1 = packq(X, 1);
                X = MFMA32(t0, x0, X); X = MFMA32(t1, x1, X);
                if (k < 4) {
                    const bf16x8 n0 = packq(mN, 0), n1 = packq(mN, 1);
                    f32x16 zT, zN;
#pragma unroll
                    for (int i = 0; i < 16; ++i) { zT[i] = 0.f; zN[i] = 0.f; }
                    zT = MFMA32(n0, t0, zT); zT = MFMA32(n1, t1, zT);
                    zN = MFMA32(t0, n0, zN); zN = MFMA32(t1, n1, zN);
                    mT = zT; mN = zN;
                }
            }
            LAS bf16* dst = ((w < 2) ? AHT : UHT) + (32 * (w & 1) + r32) * LDT + 4 * hh;
#pragma unroll
            for (int i4 = 0; i4 < 4; ++i4) { u32x2 wv; wv.x = pk2(X[4 * i4], X[4 * i4 + 1]); wv.y = pk2(X[4 * i4 + 2], X[4 * i4 + 3]); *(LAS u32x2*)(dst + 8 * i4) = wv; }
        } else if (w < 6 && !(SCAN_STUB & 1)) {
            const int lane = lane_now(), r32 = lane & 31, hh = lane >> 5;
            const LAS bf16* Aop = ((w & 1) ? KT : BT) + r32 * LDA + 8 * hh; const LAS bf16* Bop = RT + r32 * LDA + 8 * hh;
            f32x16 x;
#pragma unroll
            for (int i = 0; i < 16; ++i) x[i] = 0.f;
#pragma unroll
            for (int q = 0; q < 4; ++q) x = MFMA32(ld16(Aop + 16 * q), ld16(Bop + 16 * q), x);
#pragma unroll
            for (int i = 0; i < 16; ++i) x[i] = (crow(i, hh) <= r32) ? x[i] : 0.f;
            LAS bf16* dst = ((w & 1) ? ARK : ARB) + r32 * LDT + 4 * hh;
#pragma unroll
            for (int i4 = 0; i4 < 4; ++i4) { u32x2 wv; wv.x = pk2(x[4 * i4], x[4 * i4 + 1]); wv.y = pk2(x[4 * i4 + 2], x[4 * i4 + 3]); *(LAS u32x2*)(dst + 8 * i4) = wv; }
        }
        LBAR();
        f32x16 hn;
        if (SCAN_STUB & 4) { for (int i = 0; i < 16; ++i) hn[i] = 0.f; } else if (w < 4) {
            const int lane = lane_now(), r32 = lane & 31, hh = lane >> 5;
            const int jb = w >> 1, ib = w & 1;
            f32x16 pt[2];
#pragma unroll
            for (int a = 0; a < 2; ++a) {
#pragma unroll
                for (int i = 0; i < 16; ++i) pt[a][i] = 0.f;
#pragma unroll
                for (int q = 0; q < 2; ++q) pt[a] = MFMA32(ld16(AHT + (32 * a + r32) * LDT + 16 * q + 8 * hh), trfrag(BCT, 16 * q + 8 * hh, 16 * q + 8 * hh + 4, 32 * jb, lane), pt[a]);
            }
            { const float gC = WF[512 + 32 * jb + r32];
#pragma unroll
              for (int i = 0; i < 16; ++i) { const float add = (crow(i, hh) == r32) ? gC : 0.f; pt[0][i] += (jb == 0) ? add : 0.f; pt[1][i] += (jb == 0) ? 0.f : add; } }
#pragma unroll
            for (int i = 0; i < 16; ++i) hn[i] = 0.f;
#pragma unroll
            for (int q = 0; q < 2; ++q) {
                hn = MFMA32(trfrag(BCT, 16 * q + 8 * hh, 16 * q + 8 * hh + 4, 32 * jb, lane), ld16(UHT + (32 * ib + r32) * LDT + 16 * q + 8 * hh), hn);
                hn = MFMA32(trfrag(KCT, 16 * q + 8 * hh, 16 * q + 8 * hh + 4, 32 * jb, lane), trfrag(VT, 16 * q + 8 * hh, 16 * q + 8 * hh + 4, 32 * ib, lane), hn);
            }
#pragma unroll
            for (int a = 0; a < 2; ++a)
#pragma unroll
                for (int q = 0; q < 2; ++q) hn = MFMA32(packq(pt[a], q), ld8x2(HT + (32 * ib + r32) * LDA + 32 * a + 16 * q + 4 * hh), hn);
        } else if (w < 6) {
            const int lane = lane_now(), r32 = lane & 31, hh = lane >> 5;
            const int ib = w & 1;
            f32x16 rt[2];
#pragma unroll
            for (int a = 0; a < 2; ++a) {
#pragma unroll
                for (int i = 0; i < 16; ++i) rt[a][i] = bflo((unsigned)RT[r32 * LDA + 32 * a + crow(i, hh)]);
#pragma unroll
                for (int q = 0; q < 2; ++q) rt[a] = MFMA32(ld16(AHT + (32 * a + r32) * LDT + 16 * q + 8 * hh), ld16(ARB + r32 * LDT + 16 * q + 8 * hh), rt[a]);
            }
            f32x16 y;
#pragma unroll
            for (int i = 0; i < 16; ++i) y[i] = 0.f;
#pragma unroll
            for (int q = 0; q < 2; ++q) {
                y = MFMA32(ld16(ARB + r32 * LDT + 16 * q + 8 * hh), ld16(UHT + (32 * ib + r32) * LDT + 16 * q + 8 * hh), y);
                y = MFMA32(ld16(ARK + r32 * LDT + 16 * q + 8 * hh), trfrag(VT, 16 * q + 8 * hh, 16 * q + 8 * hh + 4, 32 * ib, lane), y);
            }
#pragma unroll
            for (int a = 0; a < 2; ++a)
#pragma unroll
                for (int q = 0; q < 2; ++q) y = MFMA32(packq(rt[a], q), ld8x2(HT + (32 * ib + r32) * LDA + 32 * a + 16 * q + 4 * hh), y);
#pragma unroll
            for (int i = 0; i < 16; ++i) YF[crow(i, hh) * 64 + 32 * ib + r32] = y[i];
        }
        LBAR();
        if (w < 4) {
            const int lane = lane_now(), r32 = lane & 31, hh = lane >> 5;
            const int jb = w >> 1, ib = w & 1; LAS bf16* dst = HT + (32 * ib + r32) * LDA + 32 * jb + 4 * hh;
#pragma unroll
            for (int i4 = 0; i4 < 4; ++i4) { u32x2 wv; wv.x = pk2(hn[4 * i4], hn[4 * i4 + 1]); wv.y = pk2(hn[4 * i4 + 2], hn[4 * i4 + 3]); *(LAS u32x2*)(dst + 8 * i4) = wv; }
        }
        {
            const f32x4 y4 = *(const LAS f32x4*)(YF + t * 64 + j0);
            const float mean = red16((y4[0] + y4[1]) + (y4[2] + y4[3])) * (1.f / 64.f); float qv = 0.f;
#pragma unroll
            for (int j = 0; j < 4; ++j) { const float d = y4[j] - mean; qv += d * d; }
            const float rs = __builtin_amdgcn_rsqf(red16(qv) * (1.f / 64.f) + GN_EPS); const float bon = BON[t]; float ov[4];
            const f32x4 lnw = *(const LAS f32x4*)(CST + 384 + j0), lnb = *(const LAS f32x4*)(CST + 448 + j0);
#pragma unroll
            for (int j = 0; j < 4; ++j) ov[j] = ((y4[j] - mean) * rs * lnw[j] + lnb[j] + bon * v[j]) * gq[j];
            pend.x = pk2(ov[0], ov[1]); pend.y = pk2(ov[2], ov[3]);
        }
    }
    *(u32x2*)(YB + ((size_t)b * SEQ + SEQ - 32 + t) * 512 + hc) = pend;
}

__device__ __forceinline__ bool attn_step(const bf16x8 (&qf)[4], const bf16x8 (&kf)[4], const u32x2 (&vlo)[2][2], const u32x2 (&vhi)[2][2], f32x16& y0, f32x16& y1, float& carry, int s0, int t0, int q, int hi) {
    f32x16 p;
#pragma unroll
    for (int r = 0; r < 16; ++r) p[r] = 0.f;
#pragma unroll
    for (int d0 = 0; d0 < 4; ++d0) p = __builtin_amdgcn_mfma_f32_32x32x16_bf16(kf[d0], qf[d0], p, 0, 0, 0);
    float om[16], be[16];
#pragma unroll
    for (int r = 0; r < 16; ++r) {
        const int kv = crow(r, hi); const bool valid = (s0 + kv) < (t0 + q);
        const float z = fminf(p[r], 80.f); const float t = __expf(z); const float o = __builtin_amdgcn_rcpf(1.f + t);
        om[r] = valid ? o : 1.f; be[r] = valid ? t * o : 0.f;
    }
    float el[16], G[4], PG[4];
#pragma unroll
    for (int i = 0; i < 4; ++i) { el[4 * i + 3] = 1.f; el[4 * i + 2] = om[4 * i + 3]; el[4 * i + 1] = el[4 * i + 2] * om[4 * i + 2]; el[4 * i] = el[4 * i + 1] * om[4 * i + 1]; G[i] = el[4 * i] * om[4 * i]; }
#pragma unroll
    for (int i = 0; i < 4; ++i) PG[i] = __shfl_xor(G[i], 32);
    float sG[4], sP[4];
    sG[3] = 1.f; sG[2] = G[3]; sG[1] = G[3] * G[2]; sG[0] = sG[1] * G[1];
    sP[3] = 1.f; sP[2] = PG[3]; sP[1] = PG[3] * PG[2]; sP[0] = sP[1] * PG[1];
    const float total = (sG[0] * G[0]) * (sP[0] * PG[0]);
    float A[16];
#pragma unroll
    for (int i = 0; i < 4; ++i) { const float eg = sG[i] * (hi ? sP[i] : sP[i] * PG[i]) * carry;
#pragma unroll
        for (int j = 0; j < 4; ++j) A[4 * i + j] = be[4 * i + j] * el[4 * i + j] * eg; }
    carry *= total;
    bf16x8 pf[2];
#pragma unroll
    for (int s = 0; s < 2; ++s) { u32x4 w; w.x = pk2(A[8 * s], A[8 * s + 1]); w.y = pk2(A[8 * s + 2], A[8 * s + 3]); w.z = pk2(A[8 * s + 4], A[8 * s + 5]); w.w = pk2(A[8 * s + 6], A[8 * s + 7]); pf[s] = __builtin_bit_cast(bf16x8, w); }
#pragma unroll
    for (int s = 0; s < 2; ++s) {
        const u32x4 a0 = (u32x4){vlo[0][s].x, vlo[0][s].y, vhi[0][s].x, vhi[0][s].y}, a1 = (u32x4){vlo[1][s].x, vlo[1][s].y, vhi[1][s].x, vhi[1][s].y};
        y0 = __builtin_amdgcn_mfma_f32_32x32x16_bf16(__builtin_bit_cast(bf16x8, a0), pf[s], y0, 0, 0, 0);
        y1 = __builtin_amdgcn_mfma_f32_32x32x16_bf16(__builtin_bit_cast(bf16x8, a1), pf[s], y1, 0, 0, 0);
    }
    return __all(carry < 5.6e-14f);
}
__device__ __forceinline__ void attn_tile(Frame& F, int bh, int qt) {
    const int lane = F.lane, q = lane & 31, hi = lane >> 5, b = bh >> 3, h = bh & 7, t0 = 32 * qt;
    const size_t tokbase = (size_t)b * SEQ;
    const bf16* QB = WSP(bf16, WS_Q); const bf16* KB = WSP(bf16, WS_K); const bf16* VT = WSP(bf16, WS_VT); bf16* YA = WSP(bf16, WS_YA);
    bf16x8 qf[4];
    { const bf16* Qp = QB + (tokbase + t0 + q) * 512 + h * 64 + 8 * hi;
#pragma unroll
      for (int d0 = 0; d0 < 4; ++d0) qf[d0] = *(const bf16x8*)(Qp + 16 * d0); }
    f32x16 y0, y1;
#pragma unroll
    for (int r = 0; r < 16; ++r) { y0[r] = 0.f; y1[r] = 0.f; }
    float carry = 1.f;
    const bf16* Vrow = VT + (size_t)bh * 128 * 1024 + q * 16 + 4 * hi;
    bf16x8 kA[4], kB[4]; u32x2 vloA[2][2], vhiA[2][2], vloB[2][2], vhiB[2][2];
#define ATT_LOAD(KF, VLO, VHI, S0) do { const bf16* Kp_ = KB + (tokbase + (S0) + q) * 512 + h * 64 + 8 * hi; \
        _Pragma("unroll") for (int d0 = 0; d0 < 4; ++d0) KF[d0] = *(const bf16x8*)(Kp_ + 16 * d0); \
        _Pragma("unroll") for (int dt = 0; dt < 2; ++dt) _Pragma("unroll") for (int s_ = 0; s_ < 2; ++s_) { const bf16* vp_ = Vrow + (size_t)(((S0) >> 4) + s_) * 1024 + dt * 512; VLO[dt][s_] = *(const u32x2*)vp_; VHI[dt][s_] = *(const u32x2*)(vp_ + 8); } } while (0)
    ATT_LOAD(kA, vloA, vhiA, t0);
    for (int s0 = t0; ; ) {
        { const int sn = s0 >= 32 ? s0 - 32 : 0; ATT_LOAD(kB, vloB, vhiB, sn); __builtin_amdgcn_sched_barrier(0); }
        if (attn_step(qf, kA, vloA, vhiA, y0, y1, carry, s0, t0, q, hi)) break;
        s0 -= 32; if (s0 < 0) break;
        { const int sn = s0 >= 32 ? s0 - 32 : 0; ATT_LOAD(kA, vloA, vhiA, sn); __builtin_amdgcn_sched_barrier(0); }
        if (attn_step(qf, kB, vloB, vhiB, y0, y1, carry, s0, t0, q, hi)) break;
        s0 -= 32; if (s0 < 0) break;
    }
#undef ATT_LOAD
    bf16* Yp = YA + (tokbase + t0 + q) * 512 + h * 64 + 4 * hi;
#pragma unroll
    for (int i = 0; i < 4; ++i) {
        u32x2 w0, w1; w0.x = pk2(y0[4 * i], y0[4 * i + 1]); w0.y = pk2(y0[4 * i + 2], y0[4 * i + 3]); w1.x = pk2(y1[4 * i], y1[4 * i + 1]); w1.y = pk2(y1[4 * i + 2], y1[4 * i + 3]);
        *(u32x2*)(Yp + 8 * i) = w0; *(u32x2*)(Yp + 32 + 8 * i) = w1;
    }
}

__device__ __forceinline__ void p5a_router(const Args& args, Frame& F) {
    LAS float* LG = (LAS float*)F.lds;
    LAS unsigned* HIST = (LAS unsigned*)(F.lds + 32768); LAS unsigned* BASE = HIST + 32;
    const float* X1 = WSP(float, WS_X1); const float* GW = WSP(float, WS_GW); const float* rb = FIN(20);
    unsigned* cnt = F.ctl + CW_CNT; int* LIST = WSP(int, WS_LIST); float* LRS = WSP(float, WS_LRS); float* LGT = WSP(float, WS_LGT);
    const int tid = F.tid, lane = F.lane, wave = F.wave;
    for (int tb = blockIdx.x; tb < M / 128; tb += F.G) {
        if (tid < 32) HIST[tid] = 0u;
        __syncthreads();
        int ex[4] = {0, 0, 0, 0}; float gt[4] = {0.f, 0.f, 0.f, 0.f}; unsigned lr[4] = {0u, 0u, 0u, 0u}; int tok = 0; float rstd_keep = 0.f;
        {
            const int i = lane & 31, kh = lane >> 5, g = wave & 3, kq = wave >> 2; tok = tb * 128 + g * 32 + i;
            const float* xr = X1 + (size_t)tok * D + 512 * kq + 4 * kh;
            f32x16 acc;
#pragma unroll
            for (int r = 0; r < 16; ++r) acc[r] = 0.f;
            float ss = 0.f;
#pragma unroll 1
            for (int u0 = 0; u0 < 64; u0 += 8) {
                f32x4 a[8]; float gw[8][4];
#pragma unroll
                for (int uu = 0; uu < 8; ++uu) { a[uu] = *(const f32x4*)(xr + 8 * (u0 + uu)); const float* gp = GW + (size_t)(512 * kq + 8 * (u0 + uu) + 4 * kh) * 32 + i;
#pragma unroll
                    for (int j = 0; j < 4; ++j) gw[uu][j] = gp[32 * j]; }
#pragma unroll
                for (int uu = 0; uu < 8; ++uu) { ss += (a[uu][0] * a[uu][0] + a[uu][1] * a[uu][1]) + (a[uu][2] * a[uu][2] + a[uu][3] * a[uu][3]);
#pragma unroll
                    for (int j = 0; j < 4; ++j) acc = __builtin_amdgcn_mfma_f32_32x32x2f32(a[uu][j], gw[uu][j], acc, 0, 0, 0); }
            }
            ss += __shfl_xor(ss, 32);
            LAS float* RED = (LAS float*)(F.lds + 40960) + (g * 64 + lane) * 17;
            if (kq == 1) {
#pragma unroll
                for (int r = 0; r < 16; ++r) RED[r] = acc[r];
                RED[16] = ss; }
            __syncthreads();
            if (kq == 0) {
#pragma unroll
                for (int r = 0; r < 16; ++r) acc[r] += RED[r];
                ss += RED[16]; }
            if (wave < 4) {
            const float rstd = 1.0f / sqrtf(ss * (1.f / D) + RMS_EPS);
            rstd_keep = rstd;
            LAS float* L = LG + wave * (32 * 33);
#pragma unroll
            for (int r = 0; r < 16; ++r) L[crow(r, kh) * 33 + i] = acc[r];
            asm volatile("s_waitcnt lgkmcnt(0)" ::: "memory");
            if (kh == 0) {
                float v0 = -3.0e38f, v1 = -3.0e38f, v2 = -3.0e38f, v3 = -3.0e38f; int i0 = 0, i1 = 0, i2 = 0, i3 = 0;
                for (int e = 0; e < 32; ++e) { const float v = L[i * 33 + e] * rstd + rb[e];
                    if (v > v3) { if (v > v2) { v3 = v2; i3 = i2; if (v > v1) { v2 = v1; i2 = i1; if (v > v0) { v1 = v0; i1 = i0; v0 = v; i0 = e; } else { v1 = v; i1 = e; } } else { v2 = v; i2 = e; } } else { v3 = v; i3 = e; } } }
                const float e1 = __expf(v1 - v0), e2 = __expf(v2 - v0), e3 = __expf(v3 - v0), inv = 1.0f / (1.f + e1 + e2 + e3);
                ex[0] = i0; ex[1] = i1; ex[2] = i2; ex[3] = i3; gt[0] = inv; gt[1] = e1 * inv; gt[2] = e2 * inv; gt[3] = e3 * inv;
#pragma unroll
                for (int k = 0; k < 4; ++k) lr[k] = __hip_atomic_fetch_add(&HIST[ex[k]], 1u, __ATOMIC_RELAXED, __HIP_MEMORY_SCOPE_WORKGROUP);
            }
            }
        }
        __syncthreads();
        if (tid < 32) BASE[tid] = __hip_atomic_fetch_add(cnt + tid, HIST[tid], RLX_AGENT);
        __syncthreads();
        if (wave < 4 && lane < 32) {
#pragma unroll
            for (int k = 0; k < 4; ++k) { const unsigned pos = BASE[ex[k]] + lr[k]; const size_t li = (size_t)ex[k] * CAP + pos; LIST[li] = tok * 4 + k; LRS[li] = rstd_keep; LGT[li] = gt[k]; }
        }
        __syncthreads();
    }
}
__device__ __forceinline__ int moe_tables(Frame& F) {
    LAS int* CS = (LAS int*)(F.lds + MOE_OFF); LAS int* OFF = CS + 32; LAS unsigned char* TE = F.lds + MOE_TE;
    if (F.tid < 32) { int c = (int)__hip_atomic_load(F.ctl + CW_CNT + F.tid, RLX_AGENT); CS[F.tid] = c > CAP ? CAP : c; }
    __syncthreads();
    if (F.tid == 0) { int off = 0; for (int e = 0; e < 32; ++e) { OFF[e] = off; off += ((CS[e] + 255) >> 8) << 8; } OFF[32] = off; }
    __syncthreads();
    const int ntiles = OFF[32] >> 8;
    for (int t = F.tid; t < ntiles; t += 512) { int e = 0; while (e < 31 && OFF[e + 1] <= t * 256) ++e; TE[t] = (unsigned char)e; }
    __syncthreads();
    return ntiles;
}
__device__ __forceinline__ void p8_combine(Frame& F) {
    float* X1 = WSP(float, WS_X1); const unsigned char* YBF = WSP(unsigned char, WS_YBUF); bf16* X2B = WSP(bf16, WS_X2B); float* R2 = WSP(float, WS_RSTD2); float* RSS = WSP(float, WS_ROWSS);
    const int gw = F.vcu * 8 + F.wave, NGW = F.G * 8, lane = F.lane;
    for (int t = gw; t < M; t += NGW) {
        f32x4* xr = (f32x4*)(X1 + (size_t)t * D) + lane; f32x4 v[4]; float s = 0.f;
#pragma unroll
        for (int j = 0; j < 4; ++j) v[j] = xr[64 * j];
        unsigned yw[4][4];
#pragma unroll
        for (int k = 0; k < 4; ++k) { const unsigned* yr = (const unsigned*)(YBF + (size_t)(4 * t + k) * D) + lane;
#pragma unroll
            for (int j = 0; j < 4; ++j) yw[k][j] = yr[64 * j]; }
#pragma unroll
        for (int k = 0; k < 4; ++k)
#pragma unroll
            for (int j = 0; j < 4; ++j) { const f32x2 lo = __builtin_amdgcn_cvt_pk_f32_fp8((int)yw[k][j], false), hi = __builtin_amdgcn_cvt_pk_f32_fp8((int)yw[k][j], true);
                v[j].x += lo.x * (1.f / 32.f); v[j].y += lo.y * (1.f / 32.f); v[j].z += hi.x * (1.f / 32.f); v[j].w += hi.y * (1.f / 32.f); }
        u32x2* o = (u32x2*)(X2B + (size_t)t * D) + lane;
#pragma unroll
        for (int j = 0; j < 4; ++j) { s += (v[j].x * v[j].x + v[j].y * v[j].y) + (v[j].z * v[j].z + v[j].w * v[j].w); u32x2 w; w.x = pk2(v[j].x, v[j].y); w.y = pk2(v[j].z, v[j].w); o[64 * j] = w;
            (WSP(unsigned, WS_X2B8) + (size_t)t * (D / 4))[lane + 64 * j] = pk8(v[j].x, v[j].y, v[j].z, v[j].w); }
        s = wave_sum(s);
        if (lane == 0) { R2[t] = 1.0f / sqrtf(s * (1.f / D) + RMS_EPS); RSS[t] = 0.f; }
    }
}
constexpr int NPHASE = 11;
__global__ void __launch_bounds__(512, 2) mega_fwd(Args args) {
    extern __shared__ __attribute__((aligned(16))) unsigned char lds[];
    Frame F;
    F.lds = (LAS unsigned char*)lds;
    F.wave = __builtin_amdgcn_readfirstlane((int)threadIdx.x >> 6); F.lane = lane_now(); F.tid = F.wave * 64 + F.lane;
    F.G = gridDim.x; { const int bx = blockIdx.x; F.vcu = (F.G % 8 == 0) ? (bx % 8) * (F.G / 8) + bx / 8 : bx; }
    F.ws = args.ws; F.ctl = (unsigned*)(args.ws + WS_CTL); F.out = args.out;
    volatile LAS unsigned* MISC = (volatile LAS unsigned*)(F.lds + LDSCTL_OFF);
    if (F.tid < 64) MISC[F.tid] = 0u;
    __syncthreads();
    const int lo = args.ph_lo, hi = args.ph_hi;
    XcdBarrier bar; bar.bar = F.ctl + CW_BAR; bar.x = 0; bar.st = nullptr;
    if (hi - lo > 1) bar = xcd_barrier_post(F.ctl + CW_BAR, MISC + 8, F.tid);
#ifndef PH_MASK
#define PH_MASK 0xFFFF
#endif
#define IN(k) ((((PH_MASK) >> (k)) & 1) && lo <= (k) && (k) < hi)
#define STAMP(k) do { if (TS_PROBE >= 0 && blockIdx.x == 0 && F.tid == 0) ((unsigned long long*)(F.ctl + 2048))[k] = __builtin_amdgcn_s_memrealtime(); } while (0)
#define SEAM(k) do { if (IN(k) && IN((k) + 1)) xcd_barrier(bar, F.wave); F.lane = lane_now(); F.tid = F.wave * 64 + F.lane; STAMP((k) + 1); } while (0)
    LAS unsigned char* ring = F.lds;
    STAMP(0);

    if (IN(0)) { p0_prologue(args, F); if (F.G < 256) expert_convert(args, F, F.vcu * 8 + F.wave, F.G * 8, 3); } SEAM(0);

    if (IN(1)) {
        constexpr unsigned ALLT = (1u << (INC / 256)) - 1u, F8T = (unsigned)(G1_F8_TILES) & ALLT, B16T = ALLT & ~F8T;
        if (B16T) { pg8::Gemm g{WSP(bf16, WS_XB), WSP(bf16, WS_WIN), M, INC, D, 0, nullptr, nullptr, nullptr}; pg8::MaskOrder S; S.init(M, B16T, F.G, (int)blockIdx.x);
            EpiG1 E{WSP(float, WS_RSTD0), WSP(bf16, WS_Q), WSP(bf16, WS_K), WSP(bf16, WS_VT), WSP(bf16, WS_ZR), WSP(bf16, WS_GT), 1.f};
            pg8::gemm_phase<EpiG1, pg8::MaskOrder, false, false>(ring, g, S, E, F.wave); }
        if (F8T) { pg8::Gemm g{WSP(bf16, WS_XB8), WSP(bf16, WS_WIN8), M, INC, D, 0, nullptr, nullptr, nullptr}; pg8::MaskOrder S; S.init(M, F8T, F.G, (int)blockIdx.x);
            EpiG1 E{WSP(float, WS_RSTD0), WSP(bf16, WS_Q), WSP(bf16, WS_K), WSP(bf16, WS_VT), WSP(bf16, WS_ZR), WSP(bf16, WS_GT), 1.f / 64.f};
            pg8::gemm_phase<EpiG1, pg8::MaskOrder, false, true>(ring, g, S, E, F.wave); }
    } SEAM(1);

    if (IN(2)) {
        for (int c = blockIdx.x; c < 256; c += F.G) {
            const int x = c & 7, y = c >> 3; pg8::LoraOrder S; S.half = y & 1; S.pm = x + 8 * (y >> 1); S.nu = 3 + (F.G >> 30);
            build_alora(args, F, S.pm);
            asm volatile("s_waitcnt vmcnt(0)" ::: "memory"); __syncthreads();
            pg8::Gemm g{WSP(bf16, WS_ALORA), WSP(bf16, WS_WL), M, LORA_N, LORA_K + (F.G >> 30), 0, nullptr, nullptr, nullptr};
            EpiLora E{FIN(5), FIN(7), WSP(bf16, WS_DEC), WSP(bf16, WS_AA), WSP(bf16, WS_GG)};
            pg8::gemm_phase(ring, g, S, E, F.wave);
        }
    } SEAM(2);

    if (IN(3)) {
        for (int u = blockIdx.x; u < 256; u += F.G) {
#ifndef P3_ONLY
#define P3_ONLY 5
#endif
            if (u < 128) { if (P3_ONLY != 2 && P3_ONLY != 3 && P3_ONLY != 4) scan_unit_chunked(args, F, u); else { bf16* YB = WSP(bf16, WS_YB); const int b = u >> 3, h = u & 7; for (int i = F.tid; i < SEQ * 8; i += 512) { const int tk = i >> 3, c8 = (i & 7) * 8; *(u32x4*)(YB + ((size_t)b * SEQ + tk) * 512 + h * 64 + c8) = (u32x4){0u, 0u, 0u, 0u}; } } }
            else if (P3_ONLY == 1 || P3_ONLY == 4) { bf16* YAz = WSP(bf16, WS_YA); const int bh = u - 128, b = bh >> 3, h = bh & 7; for (int i = F.tid; i < SEQ * 8; i += 512) { const int tk = i >> 3, c8 = (i & 7) * 8; *(u32x4*)(YAz + ((size_t)b * SEQ + tk) * 512 + h * 64 + c8) = (u32x4){0u, 0u, 0u, 0u}; } }
            else { const int bh = u - 128; for (int i = 0; i < 8; ++i) attn_tile(F, bh, F.wave + 8 * i);
                   if (F.G >= 256 && P3_ONLY != 3 && P3_ONLY != 5) expert_convert(args, F, bh * 8 + F.wave, 1024, 3);
                    }
        }
    if (TS_PROBE >= 0 && blockIdx.x == 0 && F.tid == 0) ((unsigned long long*)(F.ctl + 2048))[20] = __builtin_amdgcn_s_memrealtime();
    } SEAM(3);

    if (IN(4)) {
        pg8::StaticOrder S; S.init(M, D, F.G, (int)blockIdx.x);
        { pg8::Gemm g{WSP(bf16, WS_YA), WSP(bf16, WS_WA), M, D, AW, 0, nullptr, nullptr, nullptr}; EpiMerge<0> E{WSP(bf16, WS_GT), WSP(bf16, WS_MERGED)}; pg8::gemm_phase(ring, g, S, E, F.wave); }
        { pg8::Gemm g{WSP(bf16, WS_YB), WSP(bf16, WS_WB), M, D, RW, 0, nullptr, nullptr, nullptr}; EpiMerge<1> E{WSP(bf16, WS_GT), WSP(bf16, WS_MERGED)}; pg8::gemm_phase(ring, g, S, E, F.wave); }
    } SEAM(4);

    if (IN(5)) {
        pg8::Gemm g{WSP(bf16, WS_MERGED), WSP(bf16, WS_WO), M, D, D, 0, nullptr, nullptr, nullptr}; pg8::StaticOrder S; S.init(M, D, F.G, (int)blockIdx.x);
        EpiX1 E{FIN(0), WSP(float, WS_X1), FIN(18), WSP(unsigned char, WS_HN)};
        pg8::gemm_phase(ring, g, S, E, F.wave);
    } SEAM(5);

    if (IN(6)) { p5a_router(args, F); } SEAM(6);

    if (IN(7)) {
        const int ntiles = moe_tables(F);
        pg8::Gemm g{WSP(bf16, WS_HN), WSP(bf16, WS_W1), MAXROWS, F2, D, (size_t)F2 * D, WSP(int, WS_LIST), (const LAS int*)(F.lds + MOE_OFF) + 32, (const LAS int*)(F.lds + MOE_OFF)};
        pg8::MoeOrder S{ntiles, F2 / 256, F.G, (int)blockIdx.x, F.lds + MOE_TE};
        EpiSwiglu E{FIN(22), WSP(unsigned char, WS_ACT), WSP(int, WS_LIST), WSP(float, WS_LRS), (const LAS int*)(F.lds + MOE_OFF) + 32, (const LAS int*)(F.lds + MOE_OFF), (const LAS float*)(F.lds + RING_BYTES + 4096)};
        pg8::gemm_phase<EpiSwiglu, pg8::MoeOrder, true, true>(ring, g, S, E, F.wave);
    } SEAM(7);

    if (IN(8)) {
        const int ntiles = moe_tables(F);
        pg8::Gemm g{WSP(bf16, WS_ACT), WSP(bf16, WS_W2), MAXROWS, D, FH, (size_t)D * FH, nullptr, nullptr, nullptr};
        pg8::MoeOrder S{ntiles, D / 256, F.G, (int)blockIdx.x, F.lds + MOE_TE};
        EpiY E{FIN(24), WSP(int, WS_LIST), WSP(float, WS_LGT), WSP(unsigned char, WS_YBUF), (const LAS int*)(F.lds + MOE_OFF) + 32, (const LAS int*)(F.lds + MOE_OFF), (const LAS float*)(F.lds + RING_BYTES + 4096)};
        pg8::gemm_phase<EpiY, pg8::MoeOrder, false, true>(ring, g, S, E, F.wave);
    } SEAM(8);

    if (IN(9)) { p8_combine(F); } SEAM(9);

    if (IN(10)) {
        pg8::StaticOrder S; S.init(M, D, F.G, (int)blockIdx.x);
        { pg8::Gemm g{WSP(bf16, WS_X2B8), WSP(bf16, WS_WG), M, D, D, 0, nullptr, nullptr, nullptr}; EpiGate E{WSP(float, WS_RSTD2), WSP(bf16, WS_PGT)}; pg8::gemm_phase<EpiGate, pg8::StaticOrder, false, true>(ring, g, S, E, F.wave); }
        { pg8::Gemm g{WSP(bf16, WS_PB), WSP(bf16, WS_WP), M, D, PLE, 0, nullptr, nullptr, nullptr}; EpiPle E{WSP(bf16, WS_X2B), WSP(bf16, WS_PGT), F.out, WSP(float, WS_ROWSS), F.ctl + CW_PCNT, FIN(28), F.ctl}; pg8::gemm_phase(ring, g, S, E, F.wave); }
    }
#undef IN
#undef SEAM
}

extern "C" void kernel_launch(void* const* d_in, const int* in_sizes, int n_in, void* d_out, int out_size, void* d_ws, size_t ws_size, hipStream_t stream) {
    static int grid = 0;
    if (grid == 0) {
        if (n_in != 29 || in_sizes[0] != M * D || out_size != M * D || ws_size < WS_END) {
            fprintf(stderr, "kernel_launch: unexpected shapes (n_in %d, in0 %d, out %d, ws %zu < %zu); nothing launched\n", n_in, n_in > 0 ? in_sizes[0] : -1, out_size, ws_size, (size_t)WS_END); grid = -1; return; }
        int dev = 0, cus = 0, per_cu = 0;
        if (hipGetDevice(&dev) != hipSuccess || hipDeviceGetAttribute(&cus, hipDeviceAttributeMultiprocessorCount, dev) != hipSuccess) { grid = -1; return; }
        if (hipFuncSetAttribute((const void*)mega_fwd, hipFuncAttributeMaxDynamicSharedMemorySize, LDS_BYTES) != hipSuccess) { fprintf(stderr, "kernel_launch: hipFuncSetAttribute failed\n"); grid = -1; return; }
        if (hipOccupancyMaxActiveBlocksPerMultiprocessor(&per_cu, (const void*)mega_fwd, 512, LDS_BYTES) != hipSuccess || per_cu < 1) { fprintf(stderr, "kernel_launch: occupancy query says %d blocks/CU\n", per_cu); }
        (void)hipGetLastError();
        grid = cus;
    }
    if (grid < 0) return;
    (void)hipMemsetAsync((char*)d_ws + WS_CTL, 0, CTL_ZERO_BYTES, stream);
    Args a{};
    for (int i = 0; i < 29; ++i) a.in[i] = (const float*)d_in[i];
    a.out = (float*)d_out; a.ws = (unsigned char*)d_ws;
#if MK_PER_PHASE
    for (int p = 0; p < NPHASE; ++p) { a.ph_lo = p; a.ph_hi = p + 1; hipLaunchKernelGGL(mega_fwd, dim3(grid), dim3(512), LDS_BYTES, stream, a); }
#else
    a.ph_lo = 0; a.ph_hi = NPHASE; hipLaunchKernelGGL(mega_fwd, dim3(grid), dim3(512), LDS_BYTES, stream, a);
#endif
}
```

```cpp
#include <hip/hip_runtime.h>
#include <cstdio>
#include <cstdint>

#ifndef P3_ONLY
#define P3_ONLY 0
#endif
#ifndef SCAN_STUB
#define SCAN_STUB 0
#endif
#ifndef ATT_FORCE
#define ATT_FORCE 0
#endif
#ifndef G1_F8_TILES
#define G1_F8_TILES 0x1FE030u
#endif
#ifndef EPI_STUB
#define EPI_STUB 0
#endif
#ifndef TS_PROBE
#define TS_PROBE -1
#endif
#ifndef TS_END_SLOT
#define TS_END_SLOT (TS_PROBE + 1)
#endif
#ifndef MK_PER_PHASE
#define MK_PER_PHASE 0
#endif

#define LAS __attribute__((address_space(3)))
#define GAS __attribute__((address_space(1)))
typedef unsigned short bf16;
typedef short bf16x8 __attribute__((ext_vector_type(8)));
typedef float f32x2 __attribute__((ext_vector_type(2)));
typedef float f32x4 __attribute__((ext_vector_type(4)));
typedef float f32x16 __attribute__((ext_vector_type(16)));
typedef unsigned u32x2 __attribute__((ext_vector_type(2)));
typedef unsigned u32x4 __attribute__((ext_vector_type(4)));
typedef __bf16 bf16x2_t __attribute__((ext_vector_type(2)));

constexpr int NB = 16, SEQ = 2048, D = 1024, M = NB * SEQ;
constexpr int NH = 8, HD = 64, AW = 512, RW = 512, RWC = 1792, INC = 5376;
constexpr int NE = 32, FH = 1024, F2 = 2048, PLE = 256, TOPK = 4;
constexpr int LORA_K = 256, LORA_N = 1536;
constexpr int CAP = 32768;
constexpr int MAXROWS = M * TOPK + NE * 256;
constexpr float RMS_EPS = 1e-5f, GN_EPS = 64e-5f;

constexpr size_t MiB = 1u << 20;
constexpr size_t WS_CTL = 0, CTL_ZERO_BYTES = 1 * MiB;
constexpr size_t WS_WIN = 1 * MiB;
constexpr size_t WS_WA = 12 * MiB, WS_WB = 13 * MiB, WS_WO = 14 * MiB, WS_WG = 16 * MiB, WS_WP = 18 * MiB;
constexpr size_t WS_WL = 18 * MiB + 512 * 1024;
constexpr size_t WS_GW = 19 * MiB + 256 * 1024;
constexpr size_t WS_W1 = 20 * MiB;
constexpr size_t WS_W2 = 148 * MiB;
constexpr size_t WS_PB = 212 * MiB;
constexpr size_t WS_RSTD0 = 228 * MiB, WS_RSTD2 = WS_RSTD0 + 128 * 1024, WS_ROWSS = WS_RSTD0 + 256 * 1024;
constexpr size_t WS_RSTD1 = WS_RSTD0 + 384 * 1024;
constexpr size_t WS_GATEW = WS_RSTD0 + 512 * 1024;
constexpr size_t WS_ROWSLOT = 229 * MiB;
constexpr size_t WS_LIST = 230 * MiB;
constexpr size_t WS_X1 = 236 * MiB;
constexpr size_t WS_YA = 236 * MiB, WS_YB = 268 * MiB, WS_ALORA = 300 * MiB;
constexpr size_t WS_GT = 364 * MiB;
constexpr size_t WS_Q = 492 * MiB, WS_K = 524 * MiB, WS_VT = 556 * MiB;
constexpr size_t WS_ZR = 588 * MiB;
constexpr size_t WS_XB = 700 * MiB;
constexpr size_t WS_DEC = 764 * MiB, WS_AA = 828 * MiB, WS_GG = 892 * MiB;
constexpr size_t WS_MERGED = 492 * MiB;
constexpr size_t WS_XS = 364 * MiB;
constexpr size_t WS_ACT = 684 * MiB;
constexpr size_t WS_HN = 364 * MiB;
constexpr size_t WS_YBUF = 428 * MiB;
constexpr size_t WS_X2B8 = 820 * MiB;
constexpr size_t WS_X2B = 684 * MiB;
constexpr size_t WS_PGT = 748 * MiB;
constexpr size_t WS_LRS = 956 * MiB, WS_LGT = 960 * MiB;
constexpr size_t WS_WIN8 = 84 * MiB;
constexpr size_t WS_XB8 = 96 * MiB;
constexpr size_t WS_END = 964 * MiB;
constexpr int CW_CNT = 64;
constexpr int CW_PCNT = 8192;
constexpr int CW_BAR = 4096;

constexpr int RING_BYTES = 131072;
constexpr int LDSCTL_OFF = RING_BYTES;
constexpr int MOE_OFF = RING_BYTES + 1024;
constexpr int MOE_TE = RING_BYTES + 2048;
constexpr int LDS_BYTES = 147456;

#define RLX_AGENT __ATOMIC_RELAXED, __HIP_MEMORY_SCOPE_AGENT
__device__ __forceinline__ unsigned pk2(float lo, float hi) { f32x2 v = {lo, hi}; bf16x2_t b = __builtin_convertvector(v, bf16x2_t); return __builtin_bit_cast(unsigned, b); }
__device__ __forceinline__ unsigned pk8(float a, float b, float c, float d) { int w = __builtin_amdgcn_cvt_pk_fp8_f32(a, b, 0, false); w = __builtin_amdgcn_cvt_pk_fp8_f32(c, d, w, true); return (unsigned)w; }
__device__ __forceinline__ float bflo(unsigned u) { return __uint_as_float(u << 16); }
__device__ __forceinline__ float bfhi(unsigned u) { return __uint_as_float(u & 0xffff0000u); }
__device__ __forceinline__ float sigm(float x) { return __builtin_amdgcn_rcpf(1.f + __expf(-x)); }
__device__ __forceinline__ float wave_sum(float v) {
#pragma unroll
    for (int o = 1; o < 64; o <<= 1) v += __shfl_xor(v, o);
    return v;
}
template <int CTRL> __device__ __forceinline__ float dppf(float v) { return __builtin_bit_cast(float, __builtin_amdgcn_update_dpp(0, __builtin_bit_cast(int, v), CTRL, 0xF, 0xF, true)); }
__device__ __forceinline__ float red8(float v) { v += dppf<0xB1>(v); v += dppf<0x4E>(v); v += dppf<0x141>(v); return v; }
__device__ __forceinline__ int lane_now() { int l; asm volatile("v_mbcnt_lo_u32_b32 %0, -1, 0\n\tv_mbcnt_hi_u32_b32 %0, -1, %0" : "=v"(l)); return l; }
__device__ __forceinline__ int crow(int r, int hi) { return (r & 3) + 8 * (r >> 2) + 4 * hi; }

struct PreNone {}; struct PreF { float f[8]; }; struct PreI { int i[8]; };
namespace pg8 {
#define PG8_LAS __attribute__((address_space(3)))
typedef unsigned short bf16_t;
constexpr int BM = 256, BK = 64, HALF = 128, HTB = HALF * BK * 2, STAGE_BYTES = 8 * HTB, NXCD = 8, WGM = 8;
__host__ __device__ __forceinline__ int lds_byte(int r, int c) { const int st = (r >> 4) * 2 + (c >> 5), rr = r & 15, cc = c & 31, ob = rr * 64 + cc * 2; return st * 1024 + (ob ^ (((ob >> 9) & 1) << 5)); }
__host__ __device__ __forceinline__ void stage_rc(int b, int& R, int& C) { const int st = b / 1024, sb = b % 1024, swz = sb ^ (((sb >> 9) & 1) << 5); R = (st >> 1) * 16 + swz / 64; C = (st & 1) * 32 + (swz % 64) / 2; }
__host__ __device__ __forceinline__ int perm32(int rho) { const int n = rho >> 4, i = rho & 15; return 8 * (i >> 2) + 4 * n + (i & 3); }

struct Unit { int pm, pn, e, par; };
struct Gemm { const bf16_t* A; const bf16_t* Bt; int M, N, K; size_t bsel_bytes; const int* glist; const PG8_LAS int* goff; const PG8_LAS int* gcnt; };

struct StaticOrder {
    int nM, nN, nwg, G, c;
    __device__ void init(int M_, int N_, int G_, int c_) { nM = M_ / BM; nN = N_ / BM; nwg = nM * nN; G = G_; c = c_; }
    __device__ bool next(int i, Unit& u) const {
        const long L = (long)i * G + c; if (L >= nwg) return false;
        int wgid = (int)L; { const int q = nwg / NXCD, r = nwg % NXCD, xcd = wgid % NXCD, off = wgid / NXCD; wgid = (xcd < r ? xcd * (q + 1) : r * (q + 1) + (xcd - r) * q) + off; }
        const int nig = WGM * nN, gid = wgid / nig, fm = gid * WGM, gsz = (nM - fm) < WGM ? (nM - fm) : WGM;
        u.pm = fm + ((wgid % nig) % gsz); u.pn = (wgid % nig) / gsz; u.e = 0; return true;
    }
};
struct MaskOrder {
    StaticOrder S; unsigned mask;
    __device__ void init(int M_, unsigned mask_, int G_, int c_) { mask = mask_; S.init(M_, BM * __builtin_popcount(mask_), G_, c_); }
    __device__ bool next(int i, Unit& u) const {
        if (!S.next(i, u)) return false;
        int n = u.pn, idx = 0;
#pragma unroll
        for (int t = 0; t < 21; ++t) if ((mask >> t) & 1u) { if (n == 0) idx = t; --n; }
        u.pn = idx; return true;
    }
};
struct LoraOrder {
    int pm, half, nu;
    __device__ bool next(int i, Unit& u) const { if (i >= nu) return false; u.pm = pm; u.pn = 3 * half + i; u.e = 0; return true; }
};
struct MoeOrder {
    int ntiles, npn, G, c; const PG8_LAS unsigned char* te;
    __device__ bool next(int i, Unit& u) const {
        int rt, pn;
        if ((G & 255) == 0 && (npn == 8 || npn == 4)) { const int x = c & 7, j = (c >> 3) & 31, rpx = 32 / npn, blk = c >> 8; rt = ((i * (G >> 8) + blk) * 8 + x) * rpx + j / npn; pn = j % npn; }
        else { const long L = (long)i * G + c; rt = (int)(L / npn); pn = (int)(L % npn); }
        if (rt >= ntiles) return false;
        u.pm = rt; u.pn = pn; u.e = te[rt]; return true;
    }
};

typedef int i32x4 __attribute__((ext_vector_type(4))); typedef int i32x8 __attribute__((ext_vector_type(8)));
template <class Epi, class Sched, bool GATHER = false, bool F8 = false>
__device__ __forceinline__ void gemm_phase(PG8_LAS unsigned char* lds, const Gemm g, const Sched& S, const Epi& E, const int wid) {
    const int lane = lane_now(), tid = wid * 64 + lane,
              wr = wid >> 2, wc = wid & 3, fr = lane & 15, fq = lane >> 4;
    const int K = g.K, nt = F8 ? K / (2 * BK) : K / BK;
    unsigned voffA[2], voffB[2];
#pragma unroll
    for (int i = 0; i < 2; ++i) { int R, C; stage_rc(tid * 16 + i * 8192, R, C); const int Rb = Epi::PERM ? ((R & ~31) + perm32(R & 31)) : R;
        voffA[i] = F8 ? (unsigned)(R * K + C * 2) : (unsigned)(R * K + C) * 2u; voffB[i] = F8 ? (unsigned)(Rb * K + C * 2) : (unsigned)(Rb * K + C) * 2u; }
    const size_t kstep = (size_t)(BK * 2);
    const size_t hstep = (size_t)HALF * K * (F8 ? 1 : 2);
    const size_t tstep = 2 * hstep;
    const unsigned ldsw = (unsigned)wid * 1024u;
    const int aoff = lds_byte(wr * 64 + fr, fq * 8), boff = lds_byte(wc * 32 + fr, fq * 8);
    const int aoffk[2] = {aoff, aoff + 1024}, boffk[2] = {boff, boff + 1024};
    unsigned vgC[2][2] = {{0u, 0u}, {0u, 0u}}, vgN[2][2] = {{0u, 0u}, {0u, 0u}};
#define PG8_GOFF(u, vo) do { _Pragma("unroll") for (int _h = 0; _h < 2; ++_h) _Pragma("unroll") for (int _i = 0; _i < 2; ++_i) { int R_, C_; stage_rc(tid * 16 + _i * 8192, R_, C_); \
        const int r_ = (u).pm * BM + _h * HALF + R_ - g.goff[(u).e]; int tok_ = 0; if (r_ < g.gcnt[(u).e]) tok_ = g.glist[(size_t)(u).e * 32768 + r_] >> 2; (vo)[_h][_i] = F8 ? (unsigned)(tok_ * K + C_ * 2) : (unsigned)(tok_ * K + C_) * 2u; } } while (0)
#define PG8_SA(b, h) (((b) * 2 + (h)) * HTB)
#define PG8_SB(b, h) ((4 + (b) * 2 + (h)) * HTB)
#define PG8_STAGE(bufoff, gbase, voff) do { _Pragma("unroll") for (int _i = 0; _i < 2; ++_i) \
        __builtin_amdgcn_global_load_lds((const unsigned*)((const char*)(gbase) + (voff)[_i]), (PG8_LAS unsigned*)(lds + (bufoff) + ldsw + _i * 8192), 16, 0, 0); } while (0)
#define PG8_STA(bufoff, h, ptr, kbyte, usenext) do { if constexpr (GATHER) { unsigned vo_[2] = {(usenext) ? vgN[h][0] : vgC[h][0], (usenext) ? vgN[h][1] : vgC[h][1]}; PG8_STAGE(bufoff, (const char*)g.A + (kbyte), vo_); } else { PG8_STAGE(bufoff, ptr, voffA); } } while (0)
#define PG8_LDA(dst, b, h) do { _Pragma("unroll") for (int m = 0; m < 4; ++m) _Pragma("unroll") for (int k = 0; k < 2; ++k) dst[m][k] = *(const PG8_LAS bf16x8*)(lds + PG8_SA(b, h) + aoffk[k] + m * 2048); } while (0)
#define PG8_LDB(dst, b, h) do { _Pragma("unroll") for (int n = 0; n < 2; ++n) _Pragma("unroll") for (int k = 0; k < 2; ++k) dst[n][k] = *(const PG8_LAS bf16x8*)(lds + PG8_SB(b, h) + boffk[k] + n * 2048); } while (0)
#define PG8_MMA(ai, bj, At, Bt, Z) do { __builtin_amdgcn_s_setprio(1); \
        if constexpr (F8) { \
            if (Z) { _Pragma("unroll") for (int m = 0; m < 4; ++m) _Pragma("unroll") for (int n = 0; n < 2; ++n) { const i32x8 b8_ = __builtin_shufflevector(__builtin_bit_cast(i32x4, Bt[n][0]), __builtin_bit_cast(i32x4, Bt[n][1]), 0, 1, 2, 3, 4, 5, 6, 7), a8_ = __builtin_shufflevector(__builtin_bit_cast(i32x4, At[m][0]), __builtin_bit_cast(i32x4, At[m][1]), 0, 1, 2, 3, 4, 5, 6, 7); \
                asm volatile("v_mfma_f32_16x16x128_f8f6f4 %0, %1, %2, 0" : "=&v"(acc[ai][bj][m][n]) : "v"(b8_), "v"(a8_)); } } \
            else { _Pragma("unroll") for (int m = 0; m < 4; ++m) _Pragma("unroll") for (int n = 0; n < 2; ++n) { const i32x8 b8_ = __builtin_shufflevector(__builtin_bit_cast(i32x4, Bt[n][0]), __builtin_bit_cast(i32x4, Bt[n][1]), 0, 1, 2, 3, 4, 5, 6, 7), a8_ = __builtin_shufflevector(__builtin_bit_cast(i32x4, At[m][0]), __builtin_bit_cast(i32x4, At[m][1]), 0, 1, 2, 3, 4, 5, 6, 7); \
                asm volatile("v_mfma_f32_16x16x128_f8f6f4 %0, %1, %2, %0" : "+v"(acc[ai][bj][m][n]) : "v"(b8_), "v"(a8_)); } } } \
        else { _Pragma("unroll") for (int m = 0; m < 4; ++m) _Pragma("unroll") for (int n = 0; n < 2; ++n) _Pragma("unroll") for (int k = 0; k < 2; ++k) acc[ai][bj][m][n] = __builtin_amdgcn_mfma_f32_16x16x32_bf16(Bt[n][k], At[m][k], acc[ai][bj][m][n], 0, 0, 0); } \
        __builtin_amdgcn_s_setprio(0); } while (0)
#define PG8_WAIT_V(n) asm volatile("s_waitcnt vmcnt(" #n ")" ::: "memory")
#define PG8_WAIT_L(n) asm volatile("s_waitcnt lgkmcnt(" #n ")" ::: "memory")
#define PG8_BAR __builtin_amdgcn_s_barrier()
#define PG8_SCHED __builtin_amdgcn_sched_barrier(0)
    Unit cur, nxt; int ui = 0;
    if (!S.next(0, cur)) return;
    typename Epi::Pre preC;
    f32x4 acc[2][2][4][2];
#define PG8_ZERO_ACC do { if constexpr (!F8) { _Pragma("unroll") for (int a = 0; a < 2; ++a) _Pragma("unroll") for (int b = 0; b < 2; ++b) _Pragma("unroll") for (int m = 0; m < 4; ++m) _Pragma("unroll") for (int n = 0; n < 2; ++n) acc[a][b][m][n] = (f32x4){0.f, 0.f, 0.f, 0.f}; } } while (0)
    PG8_ZERO_ACC;
    bf16x8 At[4][2], B0[2][2], B1[2][2];
    const char* cA = (const char*)g.A + (size_t)cur.pm * tstep; const char* cB = (const char*)g.Bt + (size_t)cur.e * g.bsel_bytes + (size_t)cur.pn * tstep;
    if constexpr (GATHER) PG8_GOFF(cur, vgC);
    PG8_STAGE(PG8_SB(0, 0), cB, voffB); PG8_STAGE(PG8_SB(0, 1), cB + hstep, voffB); PG8_STA(PG8_SA(0, 0), 0, cA, 0, false); PG8_STA(PG8_SA(0, 1), 1, cA + hstep, 0, false);
    if (wr == 1) PG8_BAR;
    PG8_WAIT_V(2); PG8_BAR;
    PG8_STAGE(PG8_SB(1, 0), cB + kstep, voffB); PG8_STA(PG8_SA(1, 0), 0, cA + kstep, kstep, false); PG8_STAGE(PG8_SB(1, 1), cB + hstep + kstep, voffB);
    PG8_WAIT_V(6); PG8_BAR;
    for (;;) {
        const bool has_next = S.next(ui + 1, nxt);
        E.pre(cur, wr, fr, preC);
        cur.par = ui & 1;
        if constexpr (Epi::LBIAS) { if (wid == 0) __builtin_amdgcn_global_load_lds((const unsigned*)(E.bias_tile(cur) + 4 * lane), (PG8_LAS unsigned*)(lds + RING_BYTES + 4096 + 1024 * (ui & 1)), 16, 0, 0); }
        if constexpr (GATHER) { if (has_next) PG8_GOFF(nxt, vgN); else { vgN[0][0] = vgC[0][0]; vgN[0][1] = vgC[0][1]; vgN[1][0] = vgC[1][0]; vgN[1][1] = vgC[1][1]; } }
        const char* nA = has_next ? (const char*)g.A + (size_t)nxt.pm * tstep : cA;
        const char* nB = has_next ? (const char*)g.Bt + (size_t)nxt.e * g.bsel_bytes + (size_t)nxt.pn * tstep : cB;
        for (int t = 0; t < nt; t += 2) {
            const bool last = (t == nt - 2), first = (t == 0);
            const char* a1 = cA + (size_t)(t + 1) * kstep;
            const char* a2 = last ? nA : cA + (size_t)(t + 2) * kstep; const char* b2 = last ? nB : cB + (size_t)(t + 2) * kstep;
            const char* a3 = a2 + kstep; const char* b3 = b2 + kstep;
            const size_t k2 = last ? 0 : (size_t)(t + 2) * kstep;
            PG8_LDB(B0, 0, 0); PG8_LDB(B1, 0, 1); PG8_SCHED; PG8_LDA(At, 0, 0); PG8_STA(PG8_SA(1, 1), 1, a1 + hstep, (size_t)(t + 1) * kstep, false);
            PG8_WAIT_V(8); PG8_WAIT_L(0); PG8_BAR; PG8_MMA(0, 0, At, B0, first); PG8_MMA(0, 1, At, B1, first); PG8_BAR; PG8_SCHED;
            PG8_LDA(At, 0, 1); PG8_STAGE(PG8_SB(0, 0), b2, voffB); PG8_STAGE(PG8_SB(0, 1), b2 + hstep, voffB); PG8_STA(PG8_SA(0, 0), 0, a2, k2, last);
            PG8_WAIT_V(8); PG8_WAIT_L(0); PG8_BAR; PG8_MMA(1, 0, At, B0, first); PG8_MMA(1, 1, At, B1, first); PG8_BAR; PG8_SCHED;
            PG8_LDB(B0, 1, 0); PG8_LDB(B1, 1, 1); PG8_SCHED; PG8_LDA(At, 1, 0); PG8_STA(PG8_SA(0, 1), 1, a2 + hstep, k2, last);
            PG8_WAIT_V(8); PG8_WAIT_L(0); PG8_BAR; PG8_MMA(0, 0, At, B0, false); PG8_MMA(0, 1, At, B1, false); PG8_BAR; PG8_SCHED;
            PG8_LDA(At, 1, 1); PG8_STAGE(PG8_SB(1, 0), b3, voffB); PG8_STAGE(PG8_SB(1, 1), b3 + hstep, voffB); PG8_STA(PG8_SA(1, 0), 0, a3, k2 + kstep, last);
            PG8_WAIT_V(8); PG8_WAIT_L(0); PG8_BAR; PG8_MMA(1, 0, At, B0, false); PG8_MMA(1, 1, At, B1, false); PG8_BAR; PG8_SCHED;
        }
        if (wr == 0) PG8_BAR;
        if constexpr (F8) asm volatile("s_nop 15\n\ts_nop 15\n\ts_nop 15" ::: "memory");
        E(acc, cur, wr, wc, fr, fq, preC);
        if (!has_next) break;
        PG8_ZERO_ACC;
        cur = nxt; cA = nA; cB = nB; ++ui;
        if constexpr (GATHER) { vgC[0][0] = vgN[0][0]; vgC[0][1] = vgN[0][1]; vgC[1][0] = vgN[1][0]; vgC[1][1] = vgN[1][1]; }
        if (wr == 1) PG8_BAR;
    }
    PG8_WAIT_V(0);
    PG8_BAR;
#undef PG8_SA
#undef PG8_SB
#undef PG8_STAGE
#undef PG8_LDA
#undef PG8_STA
#undef PG8_GOFF
#undef PG8_LDB
#undef PG8_MMA
#undef PG8_ZERO_ACC
#undef PG8_WAIT_V
#undef PG8_WAIT_L
#undef PG8_BAR
#undef PG8_SCHED
}
}
using pg8::Unit;
typedef const f32x4 (&AccRef)[2][2][4][2];

#define XB_TMO      128
#define XB_XCNT(j)  (256  + 64 * (j))
#define XB_XSUB(j)  (1280 + 64 * (j))
#define XB_XGEN(j)  (2304 + 64 * (j))
#define XB_TOP      3328
#define XB_TOPGEN   3392
#define XCD_BAR_WORDS 3456
#define XB_SPIN_CAP (1u << 22)
__device__ __forceinline__ unsigned xb_ld(unsigned* p)              { return __hip_atomic_load(p, __ATOMIC_RELAXED, __HIP_MEMORY_SCOPE_AGENT); }
__device__ __forceinline__ unsigned xb_add(unsigned* p, unsigned v) { return __hip_atomic_fetch_add(p, v, __ATOMIC_RELAXED, __HIP_MEMORY_SCOPE_AGENT); }
__device__ __forceinline__ unsigned xb_xcc_id() { return (unsigned)__builtin_amdgcn_s_getreg((3 << 11) | 20) & 0xFu; }
#define XB_SPIN(cond, bar) do { unsigned _sp = 0; while (cond) { __builtin_amdgcn_s_sleep(1); \
    if ((++_sp & 255u) == 0u) { if (xb_ld(&(bar)[XB_TMO])) break; if (_sp > XB_SPIN_CAP) { atomicAdd(&(bar)[XB_TMO], 1u); break; } } } } while (0)
struct XcdBarrier { unsigned* bar; unsigned x; volatile LAS unsigned* st; };
__device__ __forceinline__ XcdBarrier xcd_barrier_post(unsigned* bar, volatile LAS unsigned* st, int tid) {
    XcdBarrier b; b.bar = bar; b.x = xb_xcc_id(); b.st = st;
    if (tid == 0) (void)xb_add(&bar[XB_XCNT(b.x)], 1u);
    return b;
}
__device__ __forceinline__ void xcd_barrier_complete(unsigned* bar, unsigned x, unsigned& nloc, unsigned& nx) {
    const unsigned G = gridDim.x * gridDim.y * gridDim.z;
    unsigned sum, cnt, mine, sp = 0u;
    for (;;) {
        sum = 0u; cnt = 0u; mine = 0u;
#pragma unroll
        for (unsigned j = 0; j < 16; ++j) { const unsigned c = xb_ld(&bar[XB_XCNT(j)]); sum += c; cnt += (c > 0u) ? 1u : 0u; mine = (j == x) ? c : mine; }
        if (sum == G) break;
        __builtin_amdgcn_s_sleep(1);
        if ((++sp & 255u) == 0u) { if (xb_ld(&bar[XB_TMO])) break; if (sp > XB_SPIN_CAP) { atomicAdd(&bar[XB_TMO], 1u); break; } }
    }
    nloc = mine > 0u ? mine : 1u; nx = cnt > 0u ? cnt : 1u;
}
__device__ __forceinline__ void xcd_barrier(const XcdBarrier& b, int wave) {
    asm volatile("s_waitcnt vmcnt(0)" ::: "memory");
    __syncthreads();
    if (wave == 0 && lane_now() == 0) {
        unsigned* bar = b.bar;
        __builtin_amdgcn_s_waitcnt(0);
        unsigned nloc = b.st[0], nx = b.st[1];
        if (nloc == 0u) { xcd_barrier_complete(bar, b.x, nloc, nx); b.st[0] = nloc; b.st[1] = nx; }
        const unsigned old = xb_add(&bar[XB_XSUB(b.x)], 1u);
        const unsigned gen = old / nloc;
        if (old + 1u == (gen + 1u) * nloc) {
            __builtin_amdgcn_fence(__ATOMIC_RELEASE, "agent");
            asm volatile("s_waitcnt vmcnt(0)" ::: "memory");
            const unsigned og = xb_add(&bar[XB_TOP], 1u);
            const unsigned tg = og / nx;
            if (og + 1u == (tg + 1u) * nx) xb_add(&bar[XB_TOPGEN], 1u);
            else XB_SPIN(xb_ld(&bar[XB_TOPGEN]) == tg, bar);
            __builtin_amdgcn_fence(__ATOMIC_ACQUIRE, "agent");
            xb_add(&bar[XB_XGEN(b.x)], 1u);
            asm volatile("s_waitcnt vmcnt(0)" ::: "memory");
        } else {
            XB_SPIN(xb_ld(&bar[XB_XGEN(b.x)]) == gen, bar);
            __builtin_amdgcn_fence(__ATOMIC_ACQUIRE, "agent");
            asm volatile("s_waitcnt vmcnt(0)" ::: "memory");
        }
    }
    __syncthreads();
}

struct Frame {
    LAS unsigned char* lds;
    unsigned* ctl;
    int tid, lane, wave, vcu, G;
    unsigned char* ws;
    float* out;
};
#define WSP(T, off) ((T*)(F.ws + (off)))
struct Args { const float* in[29]; float* out; unsigned char* ws; int ph_lo, ph_hi; };
#define FIN(i) (args.in[i])

template <bool SWZ = false, bool Q8 = false>
__device__ __forceinline__ void p0_transpose_item(const float* W, int K, int N, bf16* WT, LAS float* scr, int item, int lane, const float* kscale) {
    const int nblk = N / 32, kb = item / nblk, nb = item % nblk, k0 = 64 * kb, n0 = 32 * nb;
#pragma unroll
    for (int b = 0; b < 2; ++b) {
        float v[16];
#pragma unroll
        for (int i = 0; i < 16; ++i) { const int kk = 2 * (16 * b + i) + (lane >> 5); v[i] = W[(size_t)(k0 + kk) * N + n0 + (lane & 31)]; }
        __builtin_amdgcn_sched_barrier(0);
#pragma unroll
        for (int i = 0; i < 16; ++i) { const int kk = 2 * (16 * b + i) + (lane >> 5); if (kscale) v[i] *= kscale[k0 + kk]; scr[kk * 33 + (lane & 31)] = v[i]; }
        __builtin_amdgcn_sched_barrier(0);
    }
    asm volatile("s_waitcnt lgkmcnt(0)" ::: "memory");
    if constexpr (Q8) {
        const int c4 = lane & 3;
#pragma unroll
        for (int j = 0; j < 2; ++j) { const int n = (lane >> 2) + 16 * j; const LAS float* s = scr + (16 * c4) * 33 + n;
            u32x4 o; o.x = pk8(64.f * s[0 * 33], 64.f * s[1 * 33], 64.f * s[2 * 33], 64.f * s[3 * 33]); o.y = pk8(64.f * s[4 * 33], 64.f * s[5 * 33], 64.f * s[6 * 33], 64.f * s[7 * 33]);
            o.z = pk8(64.f * s[8 * 33], 64.f * s[9 * 33], 64.f * s[10 * 33], 64.f * s[11 * 33]); o.w = pk8(64.f * s[12 * 33], 64.f * s[13 * 33], 64.f * s[14 * 33], 64.f * s[15 * 33]);
            int nr = n0 + n; if (SWZ) { const int cl = nr & 255; nr = (nr & ~255) + 128 * ((cl >> 3) & 1) + 32 * (cl >> 6) + 8 * ((cl >> 4) & 3) + (cl & 7); }
            *(u32x4*)((unsigned char*)WT + (size_t)nr * K + k0 + 16 * c4) = o; }
        asm volatile("s_waitcnt lgkmcnt(0)" ::: "memory");
        return; }
    const int c = lane & 7;
#pragma unroll
    for (int j = 0; j < 4; ++j) { const int n = (lane >> 3) + 8 * j; const LAS float* s = scr + (8 * c) * 33 + n;
        u32x4 o; o.x = pk2(s[0 * 33], s[1 * 33]); o.y = pk2(s[2 * 33], s[3 * 33]); o.z = pk2(s[4 * 33], s[5 * 33]); o.w = pk2(s[6 * 33], s[7 * 33]);
        int nr = n0 + n; if (SWZ) { const int cl = nr & 255; nr = (nr & ~255) + 128 * ((cl >> 3) & 1) + 32 * (cl >> 6) + 8 * ((cl >> 4) & 3) + (cl & 7); }
        *(u32x4*)(WT + (size_t)nr * K + k0 + 8 * c) = o; }
    asm volatile("s_waitcnt lgkmcnt(0)" ::: "memory");
}
__device__ __forceinline__ void p0_prologue(const Args& args, Frame& F) {
    LAS float* scr = (LAS float*)(F.lds + F.wave * 16384);
    const int gw = F.vcu * 8 + F.wave, NGW = F.G * 8, lane = F.lane;
    constexpr int I_IN = (D / 64) * (INC / 32), I_A = (AW / 64) * (D / 32), I_O = (D / 64) * (D / 32), I_P = (PLE / 64) * (D / 32);
    constexpr int I_W1 = (D / 64) * (F2 / 32), I_W2 = (FH / 64) * (D / 32);
    constexpr int NITEMS = I_IN + 2 * I_A + 2 * I_O + I_P;
    for (int it = gw; it < NITEMS; it += NGW) {
        int r = it;
        if (r < I_IN) { const int tile = (r % (INC / 32)) >> 3;
            if ((G1_F8_TILES >> tile) & 1) p0_transpose_item<false, true>(FIN(3), D, INC, WSP(bf16, WS_WIN8), scr, r, lane, FIN(2));
            else p0_transpose_item(FIN(3), D, INC, WSP(bf16, WS_WIN), scr, r, lane, FIN(2));
            continue; } r -= I_IN;
        if (r < I_A) { p0_transpose_item(FIN(15), AW, D, WSP(bf16, WS_WA), scr, r, lane, nullptr); continue; } r -= I_A;
        if (r < I_A) { p0_transpose_item(FIN(16), RW, D, WSP(bf16, WS_WB), scr, r, lane, nullptr); continue; } r -= I_A;
        if (r < I_O) { p0_transpose_item(FIN(17), D, D, WSP(bf16, WS_WO), scr, r, lane, nullptr); continue; } r -= I_O;
        if (r < I_O) { p0_transpose_item<false, true>(FIN(26), D, D, WSP(bf16, WS_WG), scr, r, lane, FIN(25)); continue; } r -= I_O;
        p0_transpose_item(FIN(27), PLE, D, WSP(bf16, WS_WP), scr, r, lane, nullptr);
    }
    { const int gt = (F.vcu * 512 + F.tid), NT = F.G * 512;
      bf16* WL = WSP(bf16, WS_WL);
      for (int i = gt; i < LORA_N * LORA_K; i += NT) { const int n = i >> 8, k = i & 255; float v = 0.f;
          if (n < 512) { if (k < 64) v = FIN(6)[k * 512 + n]; }
          else if (n < 1024) { if (k >= 64 && k < 128) v = FIN(8)[(k - 64) * 512 + (n - 512)]; }
          else { if (k >= 128) v = FIN(9)[(k - 128) * 512 + (n - 1024)]; }
          WL[i] = (bf16)(pk2(v, 0.f) & 0xffffu); }
      float* GW = WSP(float, WS_GW);
      for (int i = gt; i < D * NE; i += NT) GW[i] = FIN(19)[i] * FIN(18)[i >> 5];
    }
    { bf16* XB = WSP(bf16, WS_XB); float* R0 = WSP(float, WS_RSTD0); bf16* PB = WSP(bf16, WS_PB);
      for (int m = gw; m < M; m += NGW) {
          const f32x4* xr = (const f32x4*)(FIN(0) + (size_t)m * D) + lane;
          f32x4 v[4]; float s = 0.f;
#pragma unroll
          for (int j = 0; j < 4; ++j) { v[j] = xr[64 * j]; s += (v[j].x * v[j].x + v[j].y * v[j].y) + (v[j].z * v[j].z + v[j].w * v[j].w); }
          s = wave_sum(s);
          u32x2* o = (u32x2*)(XB + (size_t)m * D) + lane;
#pragma unroll
          for (int j = 0; j < 4; ++j) { if (G1_F8_TILES) (WSP(unsigned, WS_XB8) + (size_t)m * (D / 4))[lane + 64 * j] = pk8(v[j].x, v[j].y, v[j].z, v[j].w); u32x2 w; w.x = pk2(v[j].x, v[j].y); w.y = pk2(v[j].z, v[j].w); o[64 * j] = w; }
          if (lane == 0) R0[m] = 1.0f / sqrtf(s * (1.f / D) + RMS_EPS);
          const f32x4 pv = ((const f32x4*)(FIN(1) + (size_t)m * PLE))[lane];
          u32x2 w; w.x = pk2(pv.x, pv.y); w.y = pk2(pv.z, pv.w); ((u32x2*)(PB + (size_t)m * PLE))[lane] = w;
      }
    }
}

__device__ __forceinline__ void expert_convert(const Args& args, Frame& F, int wv, int NW, int which) {
    LAS float* scr = (LAS float*)(F.lds + F.wave * 16384);
    constexpr int I_W1 = (D / 64) * (F2 / 32), I_W2 = (FH / 64) * (D / 32);
    if (which & 1) for (int it = wv; it < NE * I_W1; it += NW) { const int e = it / I_W1; p0_transpose_item<true, true>(FIN(21) + (size_t)e * D * F2, D, F2, (bf16*)(WSP(unsigned char, WS_W1) + (size_t)e * F2 * D), scr, it % I_W1, F.lane, nullptr); }
    if (which & 2) for (int it = wv; it < NE * I_W2; it += NW) { const int e = it / I_W2; p0_transpose_item<false, true>(FIN(23) + (size_t)e * FH * D, FH, D, (bf16*)(WSP(unsigned char, WS_W2) + (size_t)e * D * FH), scr, it % I_W2, F.lane, nullptr); }
}
struct EpiG1 {
    static constexpr bool PERM = true;
    typedef PreF Pre; static constexpr bool LBIAS = false;
    const float* rstd; bf16 *Q, *K, *VT, *ZR, *GT; float rs_mul;
    __device__ __forceinline__ void pre(const Unit& u, int wr, int fr, PreF& P) const {
#pragma unroll
        for (int k = 0; k < 8; ++k) P.f[k] = rstd[u.pm * 256 + wr * 64 + fr + (k >> 2) * 128 + (k & 3) * 16] * rs_mul; }
    __device__ __forceinline__ void operator()(AccRef acc, const Unit& u, int wr, int wc, int fr, int fq, const Pre& P) const {
        const int pn = u.pn, rowb = u.pm * 256 + wr * 64 + fr, cl = wc * 32 + 8 * fq;
#pragma unroll
        for (int ai = 0; ai < 2; ++ai)
#pragma unroll
            for (int m = 0; m < 4; ++m) {
                const int row = rowb + ai * 128 + m * 16; const float rs = P.f[4 * ai + m];
                if (pn < 4) {
                    bf16* base = (pn < 2 ? Q : K) + (size_t)row * 512 + (pn & 1) * 256 + cl; const float sc = pn < 2 ? rs * 0.125f : rs;
#pragma unroll
                    for (int bj = 0; bj < 2; ++bj) { const f32x4 v0 = acc[ai][bj][m][0] * sc, v1 = acc[ai][bj][m][1] * sc;
                        u32x4 w; w.x = pk2(v0[0], v0[1]); w.y = pk2(v0[2], v0[3]); w.z = pk2(v1[0], v1[1]); w.w = pk2(v1[2], v1[3]); *(u32x4*)(base + bj * 128) = w; }
                } else if (pn < 6) {
                    const int b = row >> 11, s = row & 2047;
#pragma unroll
                    for (int bj = 0; bj < 2; ++bj)
#pragma unroll
                        for (int n = 0; n < 2; ++n)
#pragma unroll
                            for (int j = 0; j < 4; ++j) { const int c = (pn - 4) * 256 + cl + bj * 128 + 4 * n + j; const int hh = c >> 6, d = c & 63;
                                VT[((size_t)(((b * 8 + hh) * 128 + (s >> 4)) * 64 + d)) * 16 + (s & 15)] = (bf16)(pk2(acc[ai][bj][m][n][j] * rs, 0.f) & 0xffffu); }
                } else if (pn < 13) {
                    bf16* base = ZR + (size_t)row * RWC + (pn - 6) * 256 + cl;
#pragma unroll
                    for (int bj = 0; bj < 2; ++bj) { const f32x4 v0 = acc[ai][bj][m][0] * rs, v1 = acc[ai][bj][m][1] * rs;
                        u32x4 w; w.x = pk2(v0[0], v0[1]); w.y = pk2(v0[2], v0[3]); w.z = pk2(v1[0], v1[1]); w.w = pk2(v1[2], v1[3]); *(u32x4*)(base + bj * 128) = w; }
                } else {
                    bf16* base = GT + (size_t)row * 2048 + (pn - 13) * 256 + cl;
#pragma unroll
                    for (int bj = 0; bj < 2; ++bj) { const f32x4 v0 = acc[ai][bj][m][0] * rs, v1 = acc[ai][bj][m][1] * rs;
                        u32x4 w; w.x = pk2(sigm(v0[0]), sigm(v0[1])); w.y = pk2(sigm(v0[2]), sigm(v0[3])); w.z = pk2(sigm(v1[0]), sigm(v1[1])); w.w = pk2(sigm(v1[2]), sigm(v1[3])); *(u32x4*)(base + bj * 128) = w; }
                }
            }
    }
};
struct EpiLora {
    static constexpr bool PERM = true;
    typedef PreNone Pre; static constexpr bool LBIAS = false;
    __device__ __forceinline__ void pre(const Unit&, int, int, PreNone&) const {}
    const float *w0, *a0; bf16 *DEC, *AA, *GG;
    template <int MODE> __device__ __forceinline__ void body(AccRef acc, int rowb, int cb) const {
#pragma unroll
        for (int bj = 0; bj < 2; ++bj) {
            const int c = cb + bj * 128;
            f32x4 b0 = (f32x4){0.f, 0.f, 0.f, 0.f}, b1 = b0;
            if (MODE == 0) { b0 = *(const f32x4*)(w0 + c); b1 = *(const f32x4*)(w0 + c + 4); } else if (MODE == 1) { b0 = *(const f32x4*)(a0 + c); b1 = *(const f32x4*)(a0 + c + 4); }
#pragma unroll
            for (int ai = 0; ai < 2; ++ai)
#pragma unroll
                for (int m = 0; m < 4; ++m) { const int row = rowb + ai * 128 + m * 16;
                    const f32x4 v0 = acc[ai][bj][m][0] + b0, v1 = acc[ai][bj][m][1] + b1; float o[8];
#pragma unroll
                    for (int j = 0; j < 8; ++j) { const float v = j < 4 ? v0[j] : v1[j - 4];
                        if (MODE == 0) { const float y = -v; const float sp = y > 20.f ? y : __logf(1.f + __expf(y)); o[j] = __expf(-sp - 0.5f); }
                        else if (MODE == 1) o[j] = sigm(v); else o[j] = v; }
                    u32x4 w; w.x = pk2(o[0], o[1]); w.y = pk2(o[2], o[3]); w.z = pk2(o[4], o[5]); w.w = pk2(o[6], o[7]);
                    bf16* dst = (MODE == 0 ? DEC : MODE == 1 ? AA : GG) + (size_t)row * 512 + c; *(u32x4*)dst = w;
                    asm volatile("" ::: "memory"); }
        }
    }
    __device__ __forceinline__ void operator()(AccRef acc, const Unit& u, int wr, int wc, int fr, int fq, const Pre& P) const {
        const int pn = u.pn, rowb = u.pm * 256 + wr * 64 + fr, cb = (pn & 1) * 256 + wc * 32 + 8 * fq;
        if (pn < 2) body<0>(acc, rowb, cb); else if (pn < 4) body<1>(acc, rowb, cb); else body<2>(acc, rowb, cb);
    }
};
template <int SECOND> struct EpiMerge {
    static constexpr bool PERM = true;
    typedef PreNone Pre; static constexpr bool LBIAS = false;
    __device__ __forceinline__ void pre(const Unit&, int, int, PreNone&) const {}
    const bf16* GT; bf16* MG;
    __device__ __forceinline__ void operator()(AccRef acc, const Unit& u, int wr, int wc, int fr, int fq, const Pre& P) const {
        const int rowb = u.pm * 256 + wr * 64 + fr, c0 = u.pn * 256 + wc * 32 + 8 * fq;
#pragma unroll
        for (int bj = 0; bj < 2; ++bj) {
            const int c = c0 + bj * 128; u32x4 gv[8], ov[8];
#pragma unroll
            for (int k = 0; k < 8; ++k) { const int row = rowb + (k >> 2) * 128 + (k & 3) * 16; gv[k] = *(const u32x4*)(GT + (size_t)row * 2048 + SECOND * 1024 + c); if (SECOND) ov[k] = *(const u32x4*)(MG + (size_t)row * 1024 + c); }
            __builtin_amdgcn_sched_barrier(0);
#pragma unroll
            for (int k = 0; k < 8; ++k) { const int ai = k >> 2, m = k & 3, row = rowb + ai * 128 + m * 16;
                const f32x4 v0 = acc[ai][bj][m][0], v1 = acc[ai][bj][m][1];
                float o[8] = {v0[0] * bflo(gv[k].x), v0[1] * bfhi(gv[k].x), v0[2] * bflo(gv[k].y), v0[3] * bfhi(gv[k].y), v1[0] * bflo(gv[k].z), v1[1] * bfhi(gv[k].z), v1[2] * bflo(gv[k].w), v1[3] * bfhi(gv[k].w)};
                if (SECOND) { o[0] += bflo(ov[k].x); o[1] += bfhi(ov[k].x); o[2] += bflo(ov[k].y); o[3] += bfhi(ov[k].y); o[4] += bflo(ov[k].z); o[5] += bfhi(ov[k].z); o[6] += bflo(ov[k].w); o[7] += bfhi(ov[k].w); }
                u32x4 w; w.x = pk2(o[0], o[1]); w.y = pk2(o[2], o[3]); w.z = pk2(o[4], o[5]); w.w = pk2(o[6], o[7]); *(u32x4*)(MG + (size_t)row * 1024 + c) = w; }
            __builtin_amdgcn_sched_barrier(0);
        }
    }
};
struct EpiX1 {
    static constexpr bool PERM = true;
    typedef PreNone Pre; static constexpr bool LBIAS = false;
    __device__ __forceinline__ void pre(const Unit&, int, int, PreNone&) const {}
    const float* X; bf16* X1; const float* gn; unsigned char* HN;
    __device__ __forceinline__ void operator()(AccRef acc, const Unit& u, int wr, int wc, int fr, int fq, const Pre& P) const {
        const int rowb = u.pm * 256 + wr * 64 + fr, c0 = u.pn * 256 + wc * 32 + 8 * fq;
#pragma unroll
        for (int bj = 0; bj < 2; ++bj) { const f32x4 g0 = *(const f32x4*)(gn + c0 + bj * 128), g1 = *(const f32x4*)(gn + c0 + bj * 128 + 4);
#pragma unroll
            for (int ai = 0; ai < 2; ++ai) {
                f32x4 xa[4], xb[4];
#pragma unroll
                for (int m = 0; m < 4; ++m) { const size_t off = (size_t)(rowb + ai * 128 + m * 16) * D + c0 + bj * 128; xa[m] = *(const f32x4*)(X + off); xb[m] = *(const f32x4*)(X + off + 4); }
                __builtin_amdgcn_sched_barrier(0);
#pragma unroll
                for (int m = 0; m < 4; ++m) { const size_t off = (size_t)(rowb + ai * 128 + m * 16) * D + c0 + bj * 128;
                    const f32x4 x0 = xa[m] + acc[ai][bj][m][0], x1 = xb[m] + acc[ai][bj][m][1];
                    { u32x4 xw; xw.x = pk2(x0[0], x0[1]); xw.y = pk2(x0[2], x0[3]); xw.z = pk2(x1[0], x1[1]); xw.w = pk2(x1[2], x1[3]); *(u32x4*)(X1 + off) = xw; }
                    u32x2 w; w.x = pk8(x0[0] * g0[0], x0[1] * g0[1], x0[2] * g0[2], x0[3] * g0[3]); w.y = pk8(x1[0] * g1[0], x1[1] * g1[1], x1[2] * g1[2], x1[3] * g1[3]); *(u32x2*)(HN + off) = w; }
                __builtin_amdgcn_sched_barrier(0);
            }
        }
    }
};
struct EpiSwiglu {
    static constexpr bool PERM = true;
    typedef PreF Pre; static constexpr bool LBIAS = true;
    const float* b1; unsigned char* ACT; const int* LIST; const float* R1; const LAS int* OFF; const LAS int* CS; const LAS float* LB;
    __device__ __forceinline__ const float* bias_tile(const Unit& u) const { return b1 + (size_t)u.e * F2 + u.pn * 256; }
    __device__ __forceinline__ void pre(const Unit& u, int wr, int fr, PreF& P) const {
        const int rbase = u.pm * 256 + wr * 64 + fr - OFF[u.e], cnt = CS[u.e];
#pragma unroll
        for (int k = 0; k < 8; ++k) { const int r = rbase + (k >> 2) * 128 + (k & 3) * 16; P.f[k] = 0.f; if (r < cnt) P.f[k] = R1[(size_t)u.e * CAP + r] * (1.f / 64.f); } }
    __device__ __forceinline__ void operator()(AccRef acc, const Unit& u, int wr, int wc, int fr, int fq, const Pre& P) const {
        if (EPI_STUB & 1) return;
        const int rowb = u.pm * 256 + wr * 64 + fr, c0 = u.pn * 256 + wc * 64 + 16 * fq;
        const LAS float* bb = LB + 256 * u.par + wc * 64 + 16 * fq;
        const f32x4 bv0 = *(const LAS f32x4*)(bb), bv1 = *(const LAS f32x4*)(bb + 4), bv2 = *(const LAS f32x4*)(bb + 8), bv3 = *(const LAS f32x4*)(bb + 12);
#pragma unroll
        for (int ai = 0; ai < 2; ++ai)
#pragma unroll
            for (int m = 0; m < 4; ++m) { const int row = rowb + ai * 128 + m * 16; const float rs = P.f[4 * ai + m];
                const f32x4 v[4] = {acc[ai][0][m][0] * rs + bv0, acc[ai][0][m][1] * rs + bv1, acc[ai][1][m][0] * rs + bv2, acc[ai][1][m][1] * rs + bv3};
                float o[8];
#pragma unroll
                for (int p = 0; p < 8; ++p) { float gl = v[p >> 1][2 * (p & 1)], ul = v[p >> 1][2 * (p & 1) + 1];
                    gl = fminf(gl, 7.f); ul = fminf(fmaxf(ul, -7.f), 7.f); o[p] = (ul + 1.f) * gl * sigm(1.702f * gl); }
                u32x2 w; w.x = pk8(o[0], o[1], o[2], o[3]); w.y = pk8(o[4], o[5], o[6], o[7]); *(u32x2*)(ACT + (size_t)row * FH + (c0 >> 1)) = w;
                asm volatile("" ::: "memory"); }
    }
};
struct EpiY {
    static constexpr bool PERM = true;
    typedef PreI Pre; static constexpr bool LBIAS = true;
    const float* b2; const int* LIST; const float* gatew; unsigned char* YB; const LAS int* OFF; const LAS int* CS; const LAS float* LB;
    __device__ __forceinline__ const float* bias_tile(const Unit& u) const { return b2 + (size_t)u.e * D + u.pn * 256; }
    __device__ __forceinline__ void pre(const Unit& u, int wr, int fr, PreI& P) const {
        const int rbase = u.pm * 256 + wr * 64 + fr - OFF[u.e], cnt = CS[u.e];
#pragma unroll
        for (int k = 0; k < 8; ++k) { const int r = rbase + (k >> 2) * 128 + (k & 3) * 16; P.i[k] = -1; if (r < cnt) P.i[k] = LIST[(size_t)u.e * CAP + r]; } }
    __device__ __forceinline__ void operator()(AccRef acc, const Unit& u, int wr, int wc, int fr, int fq, const Pre& P) const {
        const int rowb = u.pm * 256 + wr * 64 + fr, c0 = u.pn * 256 + wc * 32 + 8 * fq;
        const LAS float* bb = LB + 256 * u.par + wc * 32 + 8 * fq; const int rbase = rowb - OFF[u.e];
        if (EPI_STUB & 2) return;

#pragma unroll
        for (int ai = 0; ai < 2; ++ai) {
            float gts[4];
#pragma unroll
            for (int m = 0; m < 4; ++m) { gts[m] = 0.f; if (P.i[4 * ai + m] >= 0) gts[m] = gatew[(size_t)u.e * CAP + rbase + ai * 128 + m * 16]; }
            __builtin_amdgcn_sched_barrier(0);
#pragma unroll
            for (int m = 0; m < 4; ++m) {
                const int slot = P.i[4 * ai + m]; if (slot >= 0) { const float gt = gts[m] * 32.f;
#pragma unroll
                    for (int bj = 0; bj < 2; ++bj) { const int c = c0 + bj * 128;
                        const f32x4 v0 = (acc[ai][bj][m][0] * (1.f / 64.f) + *(const LAS f32x4*)(bb + bj * 128)) * gt, v1 = (acc[ai][bj][m][1] * (1.f / 64.f) + *(const LAS f32x4*)(bb + bj * 128 + 4)) * gt;
                        u32x2 w; w.x = pk8(v0[0], v0[1], v0[2], v0[3]); w.y = pk8(v1[0], v1[1], v1[2], v1[3]); *(u32x2*)(YB + (size_t)slot * D + c) = w; } } }
            __builtin_amdgcn_sched_barrier(0); }
    }
};
struct EpiGate {
    static constexpr bool PERM = true;
    typedef PreF Pre; static constexpr bool LBIAS = false;
    __device__ __forceinline__ void pre(const Unit& u, int wr, int fr, PreF& P) const {
#pragma unroll
        for (int k = 0; k < 8; ++k) P.f[k] = rstd2[u.pm * 256 + wr * 64 + fr + (k >> 2) * 128 + (k & 3) * 16] * (1.f / 64.f); }
    const float* rstd2; bf16* GT;
    __device__ __forceinline__ void operator()(AccRef acc, const Unit& u, int wr, int wc, int fr, int fq, const Pre& P) const {
        const int rowb = u.pm * 256 + wr * 64 + fr, c0 = u.pn * 256 + wc * 32 + 8 * fq;
#pragma unroll
        for (int ai = 0; ai < 2; ++ai)
#pragma unroll
            for (int m = 0; m < 4; ++m) { const int row = rowb + ai * 128 + m * 16; const float rs = P.f[4 * ai + m];
#pragma unroll
                for (int bj = 0; bj < 2; ++bj) { const f32x4 v0 = acc[ai][bj][m][0] * rs, v1 = acc[ai][bj][m][1] * rs;
                    u32x4 w; w.x = pk2(sigm(v0[0]), sigm(v0[1])); w.y = pk2(sigm(v0[2]), sigm(v0[3])); w.z = pk2(sigm(v1[0]), sigm(v1[1])); w.w = pk2(sigm(v1[2]), sigm(v1[3]));
                    *(u32x4*)(GT + (size_t)row * D + c0 + bj * 128) = w; } }
    }
};
struct EpiPle {
    static constexpr bool PERM = true;
    typedef PreNone Pre; static constexpr bool LBIAS = false;
    __device__ __forceinline__ void pre(const Unit&, int, int, PreNone&) const {}
    const bf16* X2B; const bf16* GT; float* O; float* rowss; unsigned* pcnt; const float* fg; const unsigned* ctl;
    __device__ __forceinline__ void operator()(f32x4 (&acc)[2][2][4][2], const Unit& u, int wr, int wc, int fr, int fq, const Pre& P) const {
        const int rowb = u.pm * 256 + wr * 64 + fr, c0 = u.pn * 256 + wc * 32 + 8 * fq;
#pragma unroll
        for (int ai = 0; ai < 2; ++ai)
#pragma unroll
            for (int m = 0; m < 4; ++m) { const int row = rowb + ai * 128 + m * 16; float ss = 0.f;
#pragma unroll
                for (int bj = 0; bj < 2; ++bj) { const size_t off = (size_t)row * D + c0 + bj * 128;
                    const u32x4 xv = *(const u32x4*)(X2B + off), gv = *(const u32x4*)(GT + off); f32x4 a0 = acc[ai][bj][m][0], a1 = acc[ai][bj][m][1];
                    a0[0] = bflo(xv.x) + bflo(gv.x) * a0[0]; a0[1] = bfhi(xv.x) + bfhi(gv.x) * a0[1]; a0[2] = bflo(xv.y) + bflo(gv.y) * a0[2]; a0[3] = bfhi(xv.y) + bfhi(gv.y) * a0[3];
                    a1[0] = bflo(xv.z) + bflo(gv.z) * a1[0]; a1[1] = bfhi(xv.z) + bfhi(gv.z) * a1[1]; a1[2] = bflo(xv.w) + bflo(gv.w) * a1[2]; a1[3] = bfhi(xv.w) + bfhi(gv.w) * a1[3];
#pragma unroll
                    for (int j = 0; j < 4; ++j) ss += a0[j] * a0[j] + a1[j] * a1[j];
                    acc[ai][bj][m][0] = a0; acc[ai][bj][m][1] = a1; }
                ss += __shfl_xor(ss, 16); ss += __shfl_xor(ss, 32);
                if (fq == 0) atomicAdd(rowss + row, ss);
                asm volatile("" ::: "memory"); }
        asm volatile("s_waitcnt vmcnt(0)" ::: "memory");
        __builtin_amdgcn_s_barrier();
        if (wr == 0 && wc == 0) {
            unsigned* pc = pcnt + 64 * u.pm;
            if (fr == 0 && fq == 0) __hip_atomic_fetch_add(pc, 1u, RLX_AGENT);
            unsigned spins = 0; while ((unsigned)__builtin_amdgcn_readfirstlane(__hip_atomic_load(pc, RLX_AGENT)) < 4u && ++spins < (1u << 20)) __builtin_amdgcn_s_sleep(4);
        }
        asm volatile("s_waitcnt vmcnt(0)" ::: "memory");
        __builtin_amdgcn_s_barrier();
        asm volatile("" ::: "memory");
#pragma unroll
        for (int ai = 0; ai < 2; ++ai)
#pragma unroll
            for (int m = 0; m < 4; ++m) { const int row = rowb + ai * 128 + m * 16; const float rs = 1.0f / sqrtf(__hip_atomic_load(rowss + row, RLX_AGENT) * (1.f / D) + RMS_EPS);
#pragma unroll
                for (int bj = 0; bj < 2; ++bj) { const size_t off = (size_t)row * D + c0 + bj * 128;
                    f32x4 o0 = acc[ai][bj][m][0] * rs * *(const f32x4*)(fg + c0 + bj * 128), o1 = acc[ai][bj][m][1] * rs * *(const f32x4*)(fg + c0 + bj * 128 + 4);
                    if (TS_PROBE >= 0 && row == 0 && c0 == 0 && bj == 0) { const unsigned long long* ts = (const unsigned long long*)(ctl + 2048); const unsigned long long dt = ts[TS_END_SLOT] - ts[TS_PROBE]; o0[0] += (float)((dt + 300) / 1600) * 4.f; }
                    *(f32x4*)(O + off) = o0; *(f32x4*)(O + off + 4) = o1; }
                asm volatile("" ::: "memory"); }
    }
};

__device__ __forceinline__ void build_alora(const Args& args, Frame& F, int pm) {
    const bf16* ZR = WSP(bf16, WS_ZR); bf16* AL = WSP(bf16, WS_ALORA); const float* mu = FIN(4) + 1536;
#pragma unroll 1
    for (int half = 0; half < 2; ++half) {
        u32x4 zc[8], zp[8];
#pragma unroll
        for (int i = 0; i < 8; ++i) {
            const int id = F.tid + 512 * (8 * half + i), row = pm * 256 + (id >> 5), cc = (id & 31) * 8;
            zc[i] = *(const u32x4*)(ZR + (size_t)row * RWC + 1536 + cc);
            zp[i] = (u32x4){0u, 0u, 0u, 0u}; if ((row & (SEQ - 1)) != 0) zp[i] = *(const u32x4*)(ZR + (size_t)(row - 1) * RWC + 1536 + cc);
        }
#pragma unroll
        for (int i = 0; i < 8; ++i) {
            const int id = F.tid + 512 * (8 * half + i), row = pm * 256 + (id >> 5), cc = (id & 31) * 8;
            const unsigned zcw[4] = {zc[i].x, zc[i].y, zc[i].z, zc[i].w}, zpw[4] = {zp[i].x, zp[i].y, zp[i].z, zp[i].w}; float o[8];
#pragma unroll
            for (int j = 0; j < 8; ++j) { const float c = (j & 1) ? bfhi(zcw[j >> 1]) : bflo(zcw[j >> 1]), p = (j & 1) ? bfhi(zpw[j >> 1]) : bflo(zpw[j >> 1]);
                const float xs = c + mu[cc + j] * (p - c);
                o[j] = cc < 64 ? (1.f - 2.f * __builtin_amdgcn_rcpf(1.f + __expf(2.f * xs))) : (cc < 128 ? xs : sigm(xs)); }
            u32x4 w; w.x = pk2(o[0], o[1]); w.y = pk2(o[2], o[3]); w.z = pk2(o[4], o[5]); w.w = pk2(o[6], o[7]);
            *(u32x4*)(AL + (size_t)row * LORA_K + cc) = w;
        }
    }
}

__device__ __forceinline__ void scan_unit(const Args& args, Frame& F, int bh) {
    const int b = bh >> 3, h = bh & 7, tid = F.tid;
    LAS float* LW = (LAS float*)F.lds;
    LAS float* LKK = LW + 4096, *LBB = LW + 8192, *LKP = LW + 12288, *LRR = LW + 16384, *LVV = LW + 20480, *LYY = LW + 24576, *LBON = LW + 28672;
    const bf16* ZR = WSP(bf16, WS_ZR); const bf16* DEC = WSP(bf16, WS_DEC); const bf16* AA = WSP(bf16, WS_AA); const bf16* GG = WSP(bf16, WS_GG); bf16* YB = WSP(bf16, WS_YB);
    const float* mu = FIN(4); const float* k_k = FIN(10) + h * 64; const float* k_a = FIN(11) + h * 64; const float* r_k = FIN(12) + h * 64;
    const float* lnw = FIN(13) + h * 64; const float* lnb = FIN(14) + h * 64;
    const int tt_p = tid >> 3, j0 = 8 * (tid & 7);
    const int row = tid >> 3, cg = tid & 7;
    float S[8];
#pragma unroll
    for (int j = 0; j < 8; ++j) S[j] = 0.f;
    float mur[8], muk[8], muv[8], kk_c[8], ka_c[8], rk_c[8];
#pragma unroll
    for (int j = 0; j < 8; ++j) { mur[j] = mu[h * 64 + j0 + j]; muk[j] = mu[512 + h * 64 + j0 + j]; muv[j] = mu[1024 + h * 64 + j0 + j]; kk_c[j] = k_k[j0 + j]; ka_c[j] = k_a[j0 + j]; rk_c[j] = r_k[j0 + j]; }
    for (int c0 = 0; c0 < SEQ; c0 += 64) {
        __syncthreads();
        {
            const size_t tok = (size_t)b * SEQ + c0 + tt_p; const bool first = (c0 + tt_p) == 0;
            const bf16* zc = ZR + tok * RWC + h * 64 + j0; const bf16* zp = zc - RWC;
            u32x4 cr = *(const u32x4*)zc, ck = *(const u32x4*)(zc + 512), cv = *(const u32x4*)(zc + 1024);
            u32x4 pr = (u32x4){0u, 0u, 0u, 0u}, pk = pr, pv = pr;
            if (!first) { pr = *(const u32x4*)zp; pk = *(const u32x4*)(zp + 512); pv = *(const u32x4*)(zp + 1024); }
            const f32x4 d0 = *(const f32x4*)(DEC + tok * 512 + h * 64 + j0), d1 = *(const f32x4*)(DEC + tok * 512 + h * 64 + j0 + 4);
            const f32x4 a0 = *(const f32x4*)(AA + tok * 512 + h * 64 + j0), a1 = *(const f32x4*)(AA + tok * 512 + h * 64 + j0 + 4);
            const unsigned crw[4] = {cr.x, cr.y, cr.z, cr.w}, ckw[4] = {ck.x, ck.y, ck.z, ck.w}, cvw[4] = {cv.x, cv.y, cv.z, cv.w};
            const unsigned prw[4] = {pr.x, pr.y, pr.z, pr.w}, pkw[4] = {pk.x, pk.y, pk.z, pk.w}, pvw[4] = {pv.x, pv.y, pv.z, pv.w};
            float r[8], k[8], v[8], kk[8], a[8], dec[8]; float ss = 0.f;
#pragma unroll
            for (int j = 0; j < 8; ++j) {
                const float rc = (j & 1) ? bfhi(crw[j >> 1]) : bflo(crw[j >> 1]), rp = (j & 1) ? bfhi(prw[j >> 1]) : bflo(prw[j >> 1]);
                const float kc = (j & 1) ? bfhi(ckw[j >> 1]) : bflo(ckw[j >> 1]), kp = (j & 1) ? bfhi(pkw[j >> 1]) : bflo(pkw[j >> 1]);
                const float vc = (j & 1) ? bfhi(cvw[j >> 1]) : bflo(cvw[j >> 1]), vp = (j & 1) ? bfhi(pvw[j >> 1]) : bflo(pvw[j >> 1]);
                r[j] = rc + mur[j] * (rp - rc); k[j] = kc + muk[j] * (kp - kc); v[j] = vc + muv[j] * (vp - vc);
                kk[j] = k[j] * kk_c[j]; ss += kk[j] * kk[j];
                a[j] = j < 4 ? a0[j] : a1[j - 4]; dec[j] = j < 4 ? d0[j] : d1[j - 4];
            }
            ss = red8(ss);
            const float inv = 1.0f / fmaxf(sqrtf(ss), 1e-12f);
            float bon = 0.f; float kpv[8], bbv[8];
#pragma unroll
            for (int j = 0; j < 8; ++j) { kk[j] *= inv; bbv[j] = kk[j] * a[j]; kpv[j] = k[j] * (1.f + (a[j] - 1.f) * ka_c[j]); bon += r[j] * kpv[j] * rk_c[j]; }
            bon = red8(bon);
            const int o = tt_p * 64 + j0;
            *(LAS f32x4*)(LW + o) = (f32x4){dec[0], dec[1], dec[2], dec[3]}; *(LAS f32x4*)(LW + o + 4) = (f32x4){dec[4], dec[5], dec[6], dec[7]};
            *(LAS f32x4*)(LKK + o) = (f32x4){kk[0], kk[1], kk[2], kk[3]}; *(LAS f32x4*)(LKK + o + 4) = (f32x4){kk[4], kk[5], kk[6], kk[7]};
            *(LAS f32x4*)(LBB + o) = (f32x4){bbv[0], bbv[1], bbv[2], bbv[3]}; *(LAS f32x4*)(LBB + o + 4) = (f32x4){bbv[4], bbv[5], bbv[6], bbv[7]};
            *(LAS f32x4*)(LKP + o) = (f32x4){kpv[0], kpv[1], kpv[2], kpv[3]}; *(LAS f32x4*)(LKP + o + 4) = (f32x4){kpv[4], kpv[5], kpv[6], kpv[7]};
            *(LAS f32x4*)(LRR + o) = (f32x4){r[0], r[1], r[2], r[3]}; *(LAS f32x4*)(LRR + o + 4) = (f32x4){r[4], r[5], r[6], r[7]};
            *(LAS f32x4*)(LVV + o) = (f32x4){v[0], v[1], v[2], v[3]}; *(LAS f32x4*)(LVV + o + 4) = (f32x4){v[4], v[5], v[6], v[7]};
            if ((tid & 7) == 0) LBON[tt_p] = bon;
        }
        __syncthreads();
#pragma unroll 2
        for (int tt = 0; tt < 64; ++tt) {
            const int o = tt * 64 + 8 * cg;
            const f32x4 k0 = *(const LAS f32x4*)(LKK + o), k1 = *(const LAS f32x4*)(LKK + o + 4);
            const f32x4 w0 = *(const LAS f32x4*)(LW + o), w1 = *(const LAS f32x4*)(LW + o + 4);
            const f32x4 b0 = *(const LAS f32x4*)(LBB + o), b1 = *(const LAS f32x4*)(LBB + o + 4);
            const f32x4 p0 = *(const LAS f32x4*)(LKP + o), p1 = *(const LAS f32x4*)(LKP + o + 4);
            const f32x4 r0 = *(const LAS f32x4*)(LRR + o), r1 = *(const LAS f32x4*)(LRR + o + 4);
            const float vi = LVV[tt * 64 + row];
            float sa = (S[0] * k0[0] + S[1] * k0[1]) + (S[2] * k0[2] + S[3] * k0[3]) + (S[4] * k1[0] + S[5] * k1[1]) + (S[6] * k1[2] + S[7] * k1[3]);
            sa = -red8(sa);
#pragma unroll
            for (int j = 0; j < 4; ++j) { S[j] = S[j] * w0[j] + (sa * b0[j] + vi * p0[j]); S[4 + j] = S[4 + j] * w1[j] + (sa * b1[j] + vi * p1[j]); }
            float y = (S[0] * r0[0] + S[1] * r0[1]) + (S[2] * r0[2] + S[3] * r0[3]) + (S[4] * r1[0] + S[5] * r1[1]) + (S[6] * r1[2] + S[7] * r1[3]);
            y = red8(y);
            if (cg == 0) LYY[tt * 64 + row] = y;
        }
        __syncthreads();
        {
            const size_t tok = (size_t)b * SEQ + c0 + tt_p; const int o = tt_p * 64 + j0;
            const f32x4 y0 = *(const LAS f32x4*)(LYY + o), y1 = *(const LAS f32x4*)(LYY + o + 4);
            const f32x4 v0 = *(const LAS f32x4*)(LVV + o), v1 = *(const LAS f32x4*)(LVV + o + 4);
            float s = (y0[0] + y0[1]) + (y0[2] + y0[3]) + (y1[0] + y1[1]) + (y1[2] + y1[3]);
            const float mean = red8(s) * (1.f / 64.f); float q = 0.f;
#pragma unroll
            for (int j = 0; j < 4; ++j) { const float d0 = y0[j] - mean, d1 = y1[j] - mean; q += d0 * d0 + d1 * d1; }
            const float rs = 1.0f / sqrtf(red8(q) * (1.f / 64.f) + GN_EPS); const float bon = LBON[tt_p];
            const u32x4 gv = *(const u32x4*)(GG + tok * 512 + h * 64 + j0); const unsigned gw[4] = {gv.x, gv.y, gv.z, gv.w}; float ov[8];
#pragma unroll
            for (int j = 0; j < 8; ++j) { const float yy = j < 4 ? y0[j] : y1[j - 4], vv = j < 4 ? v0[j] : v1[j - 4]; const float g = (j & 1) ? bfhi(gw[j >> 1]) : bflo(gw[j >> 1]);
                ov[j] = ((yy - mean) * rs * lnw[j0 + j] + lnb[j0 + j] + bon * vv) * g; }
            u32x4 w; w.x = pk2(ov[0], ov[1]); w.y = pk2(ov[2], ov[3]); w.z = pk2(ov[4], ov[5]); w.w = pk2(ov[6], ov[7]);
            *(u32x4*)(YB + tok * 512 + h * 64 + j0) = w;
        }
    }
    __syncthreads();
}

constexpr int LDA = 72, LDT = 40, LDF = 36;
constexpr int SC_WF = 0, SC_AT = 8192, SC_RT = SC_AT + 4608, SC_BT = SC_RT + 4608, SC_KT = SC_BT + 4608;
constexpr int SC_BCT = SC_KT + 4608, SC_KCT = SC_BCT + 5120, SC_VT = SC_KCT + 5120, SC_AHT = SC_VT + 5120, SC_UHT = SC_AHT + 5120;
constexpr int SC_AAB = SC_UHT + 5120, SC_ARB = SC_AAB + 4608, SC_ARK = SC_ARB + 2560, SC_RHS2 = SC_ARK + 2560, SC_YF = SC_RHS2 + 16384, SC_HT = SC_YF + 8192, SC_BON = SC_HT + 9216;
static_assert(SC_BON + 128 + 2048 <= RING_BYTES, "scan LDS map");
__device__ __forceinline__ float red16(float v) { v += dppf<0xB1>(v); v += dppf<0x4E>(v); v += dppf<0x141>(v); v += dppf<0x140>(v); return v; }
__device__ __forceinline__ bf16x8 ld16(const LAS bf16* p) { return *(const LAS bf16x8*)p; }
__device__ __forceinline__ bf16x8 ld8x2(const LAS bf16* p) { const u32x2 lo = *(const LAS u32x2*)p, hi = *(const LAS u32x2*)(p + 8); const u32x4 w = (u32x4){lo.x, lo.y, hi.x, hi.y}; return __builtin_bit_cast(bf16x8, w); }
__device__ __forceinline__ bf16x8 packq(const f32x16& x, int q) { u32x4 w; w.x = pk2(x[8 * q], x[8 * q + 1]); w.y = pk2(x[8 * q + 2], x[8 * q + 3]); w.z = pk2(x[8 * q + 4], x[8 * q + 5]); w.w = pk2(x[8 * q + 6], x[8 * q + 7]); return __builtin_bit_cast(bf16x8, w); }
#define MFMA32(a, b, c) __builtin_amdgcn_mfma_f32_32x32x16_bf16((a), (b), (c), 0, 0, 0)
struct ScanLoad { u32x2 cr, ck, cv, pr, pk, pv, g, decb, etab; f32x4 dec, eta; };
__device__ __forceinline__ void scan_load(ScanLoad& L, const bf16* ZR, const bf16* DEC, const bf16* AA, const bf16* GG, size_t tok, int hc, bool first) {
    const bf16* zc = ZR + tok * RWC + hc; const bf16* zp = zc - RWC;
    L.cr = *(const u32x2*)zc; L.ck = *(const u32x2*)(zc + 512); L.cv = *(const u32x2*)(zc + 1024);
    L.pr = (u32x2){0u, 0u}; L.pk = L.pr; L.pv = L.pr;
    if (!first) { L.pr = *(const u32x2*)zp; L.pk = *(const u32x2*)(zp + 512); L.pv = *(const u32x2*)(zp + 1024); }
    L.decb = *(const u32x2*)(DEC + tok * 512 + hc); L.etab = *(const u32x2*)(AA + tok * 512 + hc); L.g = *(const u32x2*)(GG + tok * 512 + hc);
}
#define LBAR() do { asm volatile("s_waitcnt lgkmcnt(0)" ::: "memory"); __builtin_amdgcn_s_barrier(); asm volatile("" ::: "memory"); } while (0)
typedef short v4i16_t __attribute__((ext_vector_type(4)));
__device__ __forceinline__ bf16x8 trfrag(const LAS bf16* X, int k0a, int k0b, int cbase, int lane) {
    const int g = lane >> 4, i = lane & 15, col = cbase + 16 * (g & 1) + 4 * (i & 3), rq = i >> 2;
    const v4i16_t lo = __builtin_amdgcn_ds_read_tr16_b64_v4i16((LAS v4i16_t*)(X + (k0a + rq) * LDA + col));
    const v4i16_t hi = __builtin_amdgcn_ds_read_tr16_b64_v4i16((LAS v4i16_t*)(X + (k0b + rq) * LDA + col));
    return (bf16x8){lo[0], lo[1], lo[2], lo[3], hi[0], hi[1], hi[2], hi[3]};
}
__device__ __forceinline__ void scan_unit_chunked(const Args& args, Frame& F, int bh) {
    const int b = bh >> 3, h = bh & 7, tid = F.tid, w = F.wave;
    LAS unsigned char* L = F.lds;
    LAS float* WF = (LAS float*)(L + SC_WF); LAS float* AAB = (LAS float*)(L + SC_AAB); LAS float* RHS2 = (LAS float*)(L + SC_RHS2); LAS float* YF = (LAS float*)(L + SC_YF); LAS float* BON = (LAS float*)(L + SC_BON);
    LAS bf16* AT = (LAS bf16*)(L + SC_AT); LAS bf16* RT = (LAS bf16*)(L + SC_RT); LAS bf16* BT = (LAS bf16*)(L + SC_BT); LAS bf16* KT = (LAS bf16*)(L + SC_KT);
    LAS bf16* BCT = (LAS bf16*)(L + SC_BCT); LAS bf16* KCT = (LAS bf16*)(L + SC_KCT); LAS bf16* VT = (LAS bf16*)(L + SC_VT); LAS bf16* AHT = (LAS bf16*)(L + SC_AHT); LAS bf16* UHT = (LAS bf16*)(L + SC_UHT);
    LAS bf16* ARB = (LAS bf16*)(L + SC_ARB); LAS bf16* ARK = (LAS bf16*)(L + SC_ARK); LAS bf16* HT = (LAS bf16*)(L + SC_HT);
    const bf16* ZR = WSP(bf16, WS_ZR); const bf16* DEC = WSP(bf16, WS_DEC); const bf16* AA = WSP(bf16, WS_AA); const bf16* GG = WSP(bf16, WS_GG); bf16* YB = WSP(bf16, WS_YB);
    const int t = tid >> 4, j0 = 4 * (tid & 15), hc = h * 64 + j0;
    LAS float* CST = (LAS float*)(L + SC_BON + 128);
    { const int c = tid >> 6, j = tid & 63; const float* src = c == 0 ? FIN(4) : c == 1 ? FIN(4) + 512 : c == 2 ? FIN(4) + 1024 : c == 3 ? FIN(10) : c == 4 ? FIN(11) : c == 5 ? FIN(12) : c == 6 ? FIN(13) : FIN(14);
      CST[c * 64 + j] = src[h * 64 + j]; }
    for (int i = tid; i < 64 * LDA / 2; i += 512) ((LAS unsigned*)HT)[i] = 0u;
    ScanLoad cur; scan_load(cur, ZR, DEC, AA, GG, (size_t)b * SEQ + t, hc, t == 0);
    LBAR();
    u32x2 pend = (u32x2){0u, 0u};
    for (int c0 = 0; c0 < SEQ; c0 += 32) {
        const size_t tok = (size_t)b * SEQ + c0 + t;
        float r[4], kp[4], v[4], al[4], be[4], gq[4]; f32x4 gl, gpl;
        {
            cur.dec = (f32x4){__expf(-bflo(cur.decb.x)), __expf(-bfhi(cur.decb.x)), __expf(-bflo(cur.decb.y)), __expf(-bfhi(cur.decb.y))};
            cur.eta = (f32x4){bflo(cur.etab.x), bfhi(cur.etab.x), bflo(cur.etab.y), bfhi(cur.etab.y)};
            const f32x4 mur = *(const LAS f32x4*)(CST + j0), muk = *(const LAS f32x4*)(CST + 64 + j0), muv = *(const LAS f32x4*)(CST + 128 + j0), kkc = *(const LAS f32x4*)(CST + 192 + j0), kac = *(const LAS f32x4*)(CST + 256 + j0), rkc = *(const LAS f32x4*)(CST + 320 + j0);
            const unsigned crw[2] = {cur.cr.x, cur.cr.y}, ckw[2] = {cur.ck.x, cur.ck.y}, cvw[2] = {cur.cv.x, cur.cv.y}, prw[2] = {cur.pr.x, cur.pr.y}, pkw[2] = {cur.pk.x, cur.pk.y}, pvw[2] = {cur.pv.x, cur.pv.y}, gw2[2] = {cur.g.x, cur.g.y};
            float k[4], kk[4]; float ss = 0.f;
#pragma unroll
            for (int j = 0; j < 4; ++j) {
                const float rc = (j & 1) ? bfhi(crw[j >> 1]) : bflo(crw[j >> 1]), rp = (j & 1) ? bfhi(prw[j >> 1]) : bflo(prw[j >> 1]);
                const float kc = (j & 1) ? bfhi(ckw[j >> 1]) : bflo(ckw[j >> 1]), kq = (j & 1) ? bfhi(pkw[j >> 1]) : bflo(pkw[j >> 1]);
                const float vc = (j & 1) ? bfhi(cvw[j >> 1]) : bflo(cvw[j >> 1]), vq = (j & 1) ? bfhi(pvw[j >> 1]) : bflo(pvw[j >> 1]);
                r[j] = rc + mur[j] * (rp - rc); k[j] = kc + muk[j] * (kq - kc); v[j] = vc + muv[j] * (vq - vc);
                kk[j] = k[j] * kkc[j]; ss += kk[j] * kk[j]; gq[j] = (j & 1) ? bfhi(gw2[j >> 1]) : bflo(gw2[j >> 1]);
            }
            ss = red16(ss);
            const float inv = __builtin_amdgcn_rsqf(fmaxf(ss, 1e-24f)); float bon = 0.f;
#pragma unroll
            for (int j = 0; j < 4; ++j) { kk[j] *= inv; al[j] = -kk[j]; be[j] = kk[j] * cur.eta[j]; kp[j] = k[j] * (1.f + (cur.eta[j] - 1.f) * kac[j]); bon += r[j] * kp[j] * rkc[j]; }
            bon = red16(bon);
            gl = cur.dec; gpl = (f32x4){1.f, 1.f, 1.f, 1.f};
            { const int ln = tid & 63;
#pragma unroll
              for (int j = 0; j < 4; ++j) { const float u1 = __shfl_up(gl[j], 16); gl[j] = (ln >= 16) ? gl[j] * u1 : gl[j]; }
#pragma unroll
              for (int j = 0; j < 4; ++j) { const float u2 = __shfl_up(gl[j], 32); gl[j] = (ln >= 32) ? gl[j] * u2 : gl[j]; }
#pragma unroll
              for (int j = 0; j < 4; ++j) { const float u3 = __shfl_up(gl[j], 16); gpl[j] = (ln >= 16) ? u3 : 1.f; }
              if (ln >= 48) *(LAS f32x4*)(WF + w * 64 + j0) = gl; }
            if ((tid & 15) == 0) BON[t] = bon;
        }
        if (c0 + 32 < SEQ && !(SCAN_STUB & 32)) scan_load(cur, ZR, DEC, AA, GG, tok + 32, hc, false);
        if (c0 > 0) { const bf16* yp = YB + (tok - 32) * 512 + hc; asm volatile("global_store_dwordx2 %0, %1, off" :: "v"(yp), "v"(pend) : "memory"); }
        LBAR();
        {
            f32x4 pre = (f32x4){1.f, 1.f, 1.f, 1.f}, gC = pre;
#pragma unroll
            for (int ww = 0; ww < 8; ++ww) { const f32x4 wt = *(const LAS f32x4*)(WF + ww * 64 + j0); gC = gC * wt; if (ww < w) pre = pre * wt; }
            const f32x4 gt = pre * gl, gp = pre * gpl;
            if (t == 31) *(LAS f32x4*)(WF + 512 + j0) = gC;
            float a_[4], r_[4], b_[4], k_[4], bc[4], kc[4];
#pragma unroll
            for (int j = 0; j < 4; ++j) { const float ig = __builtin_amdgcn_rcpf(gt[j]); a_[j] = al[j] * gp[j]; r_[j] = r[j] * gt[j]; b_[j] = be[j] * ig; k_[j] = kp[j] * ig; bc[j] = b_[j] * gC[j]; kc[j] = k_[j] * gC[j]; }
            u32x2 wv; wv.x = pk2(a_[0], a_[1]); wv.y = pk2(a_[2], a_[3]); *(LAS u32x2*)(AT + t * LDA + j0) = wv;
            wv.x = pk2(r_[0], r_[1]); wv.y = pk2(r_[2], r_[3]); *(LAS u32x2*)(RT + t * LDA + j0) = wv;
            wv.x = pk2(b_[0], b_[1]); wv.y = pk2(b_[2], b_[3]); *(LAS u32x2*)(BT + t * LDA + j0) = wv;
            wv.x = pk2(k_[0], k_[1]); wv.y = pk2(k_[2], k_[3]); *(LAS u32x2*)(KT + t * LDA + j0) = wv;
            wv.x = pk2(bc[0], bc[1]); wv.y = pk2(bc[2], bc[3]); *(LAS u32x2*)(BCT + t * LDA + j0) = wv;
            wv.x = pk2(kc[0], kc[1]); wv.y = pk2(kc[2], kc[3]); *(LAS u32x2*)(KCT + t * LDA + j0) = wv;
            wv.x = pk2(v[0], v[1]); wv.y = pk2(v[2], v[3]); *(LAS u32x2*)(VT + t * LDA + j0) = wv;
        }
        LBAR();
        if (w < 4 && !(SCAN_STUB & 1)) {
            const int lane = lane_now(), r32 = lane & 31, hh = lane >> 5;
            f32x16 mT, mN;
#pragma unroll
            for (int i = 0; i < 16; ++i) { mT[i] = 0.f; mN[i] = 0.f; }
#pragma unroll
            for (int q = 0; q < 4; ++q) { const bf16x8 bfr = ld16(BT + r32 * LDA + 8 * hh + 16 * q), afr = ld16(AT + r32 * LDA + 8 * hh + 16 * q);
                mT = MFMA32(bfr, afr, mT);
                mN = MFMA32(afr, bfr, mN); }
#pragma unroll
            for (int i = 0; i < 16; ++i) { const int c_ = crow(i, hh); mT[i] = (c_ < r32) ? mT[i] : 0.f; mN[i] = (r32 < c_) ? mN[i] : 0.f; }
            f32x16 X;
            if (w < 2) {
#pragma unroll
                for (int i = 0; i < 16; ++i) X[i] = bflo((unsigned)AT[crow(i, hh) * LDA + 32 * w + r32]);
            } else {
                f32x16 kT;
#pragma unroll
                for (int i = 0; i < 16; ++i) { kT[i] = 0.f; X[i] = 0.f; }
#pragma unroll
                for (int q = 0; q < 4; ++q) kT = MFMA32(ld16(KT + r32 * LDA + 8 * hh + 16 * q), ld16(AT + r32 * LDA + 8 * hh + 16 * q), kT);
#pragma unroll
                for (int i = 0; i < 16; ++i) kT[i] = (crow(i, hh) < r32) ? kT[i] : 0.f;
#pragma unroll
                for (int q = 0; q < 2; ++q) X = MFMA32(packq(kT, q), trfrag(VT, 16 * q + 4 * hh, 16 * q + 8 + 4 * hh, 32 * (w - 2), lane), X);
            }
#pragma unroll
            for (int k = 0; k < 5; ++k) {
                const bf16x8 t0 = packq(mT, 0), t1 = packq(mT, 1), x0 = packq(X, 0), x1 = packq(X, 1);
                X = MFMA32(t0, x0, X); X = MFMA32(t1, x1, X);
                if (k < 4) {
                    const bf16x8 n0 = packq(mN, 0), n1 = packq(mN, 1);
                    f32x16 zT, zN;
#pragma unroll
                    for (int i = 0; i < 16; ++i) { zT[i] = 0.f; zN[i] = 0.f; }
                    zT = MFMA32(n0, t0, zT); zT = MFMA32(n1, t1, zT);
                    zN = MFMA32(t0, n0, zN); zN = MFMA32(t1, n1, zN);
                    mT = zT; mN = zN;
                }
            }
            LAS bf16* dst = ((w < 2) ? AHT : UHT) + (32 * (w & 1) + r32) * LDT + 4 * hh;
#pragma unroll
            for (int i4 = 0; i4 < 4; ++i4) { u32x2 wv; wv.x = pk2(X[4 * i4], X[4 * i4 + 1]); wv.y = pk2(X[4 * i4 + 2], X[4 * i4 + 3]); *(LAS u32x2*)(dst + 8 * i4) = wv; }
        } else if (w < 6 && !(SCAN_STUB & 1)) {
            const int lane = lane_now(), r32 = lane & 31, hh = lane >> 5;
            const LAS bf16* Aop = ((w & 1) ? KT : BT) + r32 * LDA + 8 * hh; const LAS bf16* Bop = RT + r32 * LDA + 8 * hh;
            f32x16 x;
#pragma unroll
            for (int i = 0; i < 16; ++i) x[i] = 0.f;
#pragma unroll
            for (int q = 0; q < 4; ++q) x = MFMA32(ld16(Aop + 16 * q), ld16(Bop + 16 * q), x);
#pragma unroll
            for (int i = 0; i < 16; ++i) x[i] = (crow(i, hh) <= r32) ? x[i] : 0.f;
            LAS bf16* dst = ((w & 1) ? ARK : ARB) + r32 * LDT + 4 * hh;
#pragma unroll
            for (int i4 = 0; i4 < 4; ++i4) { u32x2 wv; wv.x = pk2(x[4 * i4], x[4 * i4 + 1]); wv.y = pk2(x[4 * i4 + 2], x[4 * i4 + 3]); *(LAS u32x2*)(dst + 8 * i4) = wv; }
        }
        LBAR();
        f32x16 hn;
        if (SCAN_STUB & 4) { for (int i = 0; i < 16; ++i) hn[i] = 0.f; } else if (w < 4) {
            const int lane = lane_now(), r32 = lane & 31, hh = lane >> 5;
            const int jb = w >> 1, ib = w & 1;
            f32x16 pt[2];
#pragma unroll
            for (int a = 0; a < 2; ++a) {
#pragma unroll
                for (int i = 0; i < 16; ++i) pt[a][i] = 0.f;
#pragma unroll
                for (int q = 0; q < 2; ++q) pt[a] = MFMA32(ld16(AHT + (32 * a + r32) * LDT + 16 * q + 8 * hh), trfrag(BCT, 16 * q + 8 * hh, 16 * q + 8 * hh + 4, 32 * jb, lane), pt[a]);
            }
            { const float gC = WF[512 + 32 * jb + r32];
#pragma unroll
              for (int i = 0; i < 16; ++i) { const float add = (crow(i, hh) == r32) ? gC : 0.f; pt[0][i] += (jb == 0) ? add : 0.f; pt[1][i] += (jb == 0) ? 0.f : add; } }
#pragma unroll
            for (int i = 0; i < 16; ++i) hn[i] = 0.f;
#pragma unroll
            for (int q = 0; q < 2; ++q) {
                hn = MFMA32(trfrag(BCT, 16 * q + 8 * hh, 16 * q + 8 * hh + 4, 32 * jb, lane), ld16(UHT + (32 * ib + r32) * LDT + 16 * q + 8 * hh), hn);
                hn = MFMA32(trfrag(KCT, 16 * q + 8 * hh, 16 * q + 8 * hh + 4, 32 * jb, lane), trfrag(VT, 16 * q + 8 * hh, 16 * q + 8 * hh + 4, 32 * ib, lane), hn);
            }
#pragma unroll
            for (int a = 0; a < 2; ++a)
#pragma unroll
                for (int q = 0; q < 2; ++q) hn = MFMA32(packq(pt[a], q), ld8x2(HT + (32 * ib + r32) * LDA + 32 * a + 16 * q + 4 * hh), hn);
        } else if (w < 6) {
            const int lane = lane_now(), r32 = lane & 31, hh = lane >> 5;
            const int ib = w & 1;
            f32x16 rt[2];
#pragma unroll
            for (int a = 0; a < 2; ++a) {
#pragma unroll
                for (int i = 0; i < 16; ++i) rt[a][i] = bflo((unsigned)RT[r32 * LDA + 32 * a + crow(i, hh)]);
#pragma unroll
                for (int q = 0; q < 2; ++q) rt[a] = MFMA32(ld16(AHT + (32 * a + r32) * LDT + 16 * q + 8 * hh), ld16(ARB + r32 * LDT + 16 * q + 8 * hh), rt[a]);
            }
            f32x16 y;
#pragma unroll
            for (int i = 0; i < 16; ++i) y[i] = 0.f;
#pragma unroll
            for (int q = 0; q < 2; ++q) {
                y = MFMA32(ld16(ARB + r32 * LDT + 16 * q + 8 * hh), ld16(UHT + (32 * ib + r32) * LDT + 16 * q + 8 * hh), y);
                y = MFMA32(ld16(ARK + r32 * LDT + 16 * q + 8 * hh), trfrag(VT, 16 * q + 8 * hh, 16 * q + 8 * hh + 4, 32 * ib, lane), y);
            }
#pragma unroll
            for (int a = 0; a < 2; ++a)
#pragma unroll
                for (int q = 0; q < 2; ++q) y = MFMA32(packq(rt[a], q), ld8x2(HT + (32 * ib + r32) * LDA + 32 * a + 16 * q + 4 * hh), y);
#pragma unroll
            for (int i = 0; i < 16; ++i) YF[crow(i, hh) * 64 + 32 * ib + r32] = y[i];
        }
        LBAR();
        if (w < 4) {
            const int lane = lane_now(), r32 = lane & 31, hh = lane >> 5;
            const int jb = w >> 1, ib = w & 1; LAS bf16* dst = HT + (32 * ib + r32) * LDA + 32 * jb + 4 * hh;
#pragma unroll
            for (int i4 = 0; i4 < 4; ++i4) { u32x2 wv; wv.x = pk2(hn[4 * i4], hn[4 * i4 + 1]); wv.y = pk2(hn[4 * i4 + 2], hn[4 * i4 + 3]); *(LAS u32x2*)(dst + 8 * i4) = wv; }
        }
        {
            const f32x4 y4 = *(const LAS f32x4*)(YF + t * 64 + j0);
            const float mean = red16((y4[0] + y4[1]) + (y4[2] + y4[3])) * (1.f / 64.f); float qv = 0.f;
#pragma unroll
            for (int j = 0; j < 4; ++j) { const float d = y4[j] - mean; qv += d * d; }
            const float rs = __builtin_amdgcn_rsqf(red16(qv) * (1.f / 64.f) + GN_EPS); const float bon = BON[t]; float ov[4];
            const f32x4 lnw = *(const LAS f32x4*)(CST + 384 + j0), lnb = *(const LAS f32x4*)(CST + 448 + j0);
#pragma unroll
            for (int j = 0; j < 4; ++j) ov[j] = ((y4[j] - mean) * rs * lnw[j] + lnb[j] + bon * v[j]) * gq[j];
            pend.x = pk2(ov[0], ov[1]); pend.y = pk2(ov[2], ov[3]);
        }
    }
    *(u32x2*)(YB + ((size_t)b * SEQ + SEQ - 32 + t) * 512 + hc) = pend;
}

__device__ __forceinline__ bool attn_step(const bf16x8 (&qf)[4], const bf16x8 (&kf)[4], const u32x2 (&vlo)[2][2], const u32x2 (&vhi)[2][2], f32x16& y0, f32x16& y1, float& carry, int s0, int t0, int q, int hi) {
    f32x16 p;
#pragma unroll
    for (int r = 0; r < 16; ++r) p[r] = 0.f;
#pragma unroll
    for (int d0 = 0; d0 < 4; ++d0) p = __builtin_amdgcn_mfma_f32_32x32x16_bf16(kf[d0], qf[d0], p, 0, 0, 0);
    float om[16], be[16];
#pragma unroll
    for (int r = 0; r < 16; ++r) {
        const int kv = crow(r, hi); const bool valid = (s0 + kv) < (t0 + q);
        const float z = fminf(p[r], 80.f); const float t = __expf(z); const float o = __builtin_amdgcn_rcpf(1.f + t);
        om[r] = valid ? o : 1.f; be[r] = valid ? t * o : 0.f;
    }
    float el[16], G[4], PG[4];
#pragma unroll
    for (int i = 0; i < 4; ++i) { el[4 * i + 3] = 1.f; el[4 * i + 2] = om[4 * i + 3]; el[4 * i + 1] = el[4 * i + 2] * om[4 * i + 2]; el[4 * i] = el[4 * i + 1] * om[4 * i + 1]; G[i] = el[4 * i] * om[4 * i]; }
#pragma unroll
    for (int i = 0; i < 4; ++i) PG[i] = __shfl_xor(G[i], 32);
    float sG[4], sP[4];
    sG[3] = 1.f; sG[2] = G[3]; sG[1] = G[3] * G[2]; sG[0] = sG[1] * G[1];
    sP[3] = 1.f; sP[2] = PG[3]; sP[1] = PG[3] * PG[2]; sP[0] = sP[1] * PG[1];
    const float total = (sG[0] * G[0]) * (sP[0] * PG[0]);
    float A[16];
#pragma unroll
    for (int i = 0; i < 4; ++i) { const float eg = sG[i] * (hi ? sP[i] : sP[i] * PG[i]) * carry;
#pragma unroll
        for (int j = 0; j < 4; ++j) A[4 * i + j] = be[4 * i + j] * el[4 * i + j] * eg; }
    carry *= total;
    bf16x8 pf[2];
#pragma unroll
    for (int s = 0; s < 2; ++s) { u32x4 w; w.x = pk2(A[8 * s], A[8 * s + 1]); w.y = pk2(A[8 * s + 2], A[8 * s + 3]); w.z = pk2(A[8 * s + 4], A[8 * s + 5]); w.w = pk2(A[8 * s + 6], A[8 * s + 7]); pf[s] = __builtin_bit_cast(bf16x8, w); }
#pragma unroll
    for (int s = 0; s < 2; ++s) {
        const u32x4 a0 = (u32x4){vlo[0][s].x, vlo[0][s].y, vhi[0][s].x, vhi[0][s].y}, a1 = (u32x4){vlo[1][s].x, vlo[1][s].y, vhi[1][s].x, vhi[1][s].y};
        y0 = __builtin_amdgcn_mfma_f32_32x32x16_bf16(__builtin_bit_cast(bf16x8, a0), pf[s], y0, 0, 0, 0);
        y1 = __builtin_amdgcn_mfma_f32_32x32x16_bf16(__builtin_bit_cast(bf16x8, a1), pf[s], y1, 0, 0, 0);
    }
    return __all(carry < 5.6e-14f);
}
__device__ __forceinline__ void attn_tile(Frame& F, int bh, int qt) {
    const int lane = F.lane, q = lane & 31, hi = lane >> 5, b = bh >> 3, h = bh & 7, t0 = 32 * qt;
    const size_t tokbase = (size_t)b * SEQ;
    const bf16* QB = WSP(bf16, WS_Q); const bf16* KB = WSP(bf16, WS_K); const bf16* VT = WSP(bf16, WS_VT); bf16* YA = WSP(bf16, WS_YA);
    bf16x8 qf[4];
    { const bf16* Qp = QB + (tokbase + t0 + q) * 512 + h * 64 + 8 * hi;
#pragma unroll
      for (int d0 = 0; d0 < 4; ++d0) qf[d0] = *(const bf16x8*)(Qp + 16 * d0); }
    f32x16 y0, y1;
#pragma unroll
    for (int r = 0; r < 16; ++r) { y0[r] = 0.f; y1[r] = 0.f; }
    float carry = 1.f;
    const bf16* Vrow = VT + (size_t)bh * 128 * 1024 + q * 16 + 4 * hi;
    bf16x8 kA[4], kB[4]; u32x2 vloA[2][2], vhiA[2][2], vloB[2][2], vhiB[2][2];
#define ATT_LOAD(KF, VLO, VHI, S0) do { const bf16* Kp_ = KB + (tokbase + (S0) + q) * 512 + h * 64 + 8 * hi; \
        _Pragma("unroll") for (int d0 = 0; d0 < 4; ++d0) KF[d0] = *(const bf16x8*)(Kp_ + 16 * d0); \
        _Pragma("unroll") for (int dt = 0; dt < 2; ++dt) _Pragma("unroll") for (int s_ = 0; s_ < 2; ++s_) { const bf16* vp_ = Vrow + (size_t)(((S0) >> 4) + s_) * 1024 + dt * 512; VLO[dt][s_] = *(const u32x2*)vp_; VHI[dt][s_] = *(const u32x2*)(vp_ + 8); } } while (0)
    ATT_LOAD(kA, vloA, vhiA, t0);
    for (int s0 = t0; ; ) {
        { const int sn = s0 >= 32 ? s0 - 32 : 0; ATT_LOAD(kB, vloB, vhiB, sn); __builtin_amdgcn_sched_barrier(0); }
        if (attn_step(qf, kA, vloA, vhiA, y0, y1, carry, s0, t0, q, hi)) break;
        s0 -= 32; if (s0 < 0) break;
        { const int sn = s0 >= 32 ? s0 - 32 : 0; ATT_LOAD(kA, vloA, vhiA, sn); __builtin_amdgcn_sched_barrier(0); }
        if (attn_step(qf, kB, vloB, vhiB, y0, y1, carry, s0, t0, q, hi)) break;
        s0 -= 32; if (s0 < 0) break;
    }
#undef ATT_LOAD
    bf16* Yp = YA + (tokbase + t0 + q) * 512 + h * 64 + 4 * hi;
#pragma unroll
    for (int i = 0; i < 4; ++i) {
        u32x2 w0, w1; w0.x = pk2(y0[4 * i], y0[4 * i + 1]); w0.y = pk2(y0[4 * i + 2], y0[4 * i + 3]); w1.x = pk2(y1[4 * i], y1[4 * i + 1]); w1.y = pk2(y1[4 * i + 2], y1[4 * i + 3]);
        *(u32x2*)(Yp + 8 * i) = w0; *(u32x2*)(Yp + 32 + 8 * i) = w1;
    }
}

__device__ __forceinline__ void p5a_router(const Args& args, Frame& F) {
    LAS float* LG = (LAS float*)F.lds;
    LAS unsigned* HIST = (LAS unsigned*)(F.lds + 32768); LAS unsigned* BASE = HIST + 32;
    const bf16* X1 = WSP(bf16, WS_X1); const float* GW = WSP(float, WS_GW); const float* rb = FIN(20);
    unsigned* cnt = F.ctl + CW_CNT; int* LIST = WSP(int, WS_LIST); float* LRS = WSP(float, WS_LRS); float* LGT = WSP(float, WS_LGT);
    const int tid = F.tid, lane = F.lane, wave = F.wave;
    for (int tb = blockIdx.x; tb < M / 128; tb += F.G) {
        if (tid < 32) HIST[tid] = 0u;
        __syncthreads();
        int ex[4] = {0, 0, 0, 0}; float gt[4] = {0.f, 0.f, 0.f, 0.f}; unsigned lr[4] = {0u, 0u, 0u, 0u}; int tok = 0; float rstd_keep = 0.f;
        {
            const int i = lane & 31, kh = lane >> 5, g = wave & 3, kq = wave >> 2; tok = tb * 128 + g * 32 + i;
            const bf16* xr = X1 + (size_t)tok * D + 512 * kq + 4 * kh;
            f32x16 acc;
#pragma unroll
            for (int r = 0; r < 16; ++r) acc[r] = 0.f;
            float ss = 0.f;
#pragma unroll 1
            for (int u0 = 0; u0 < 64; u0 += 8) {
                f32x4 a[8]; float gw[8][4];
#pragma unroll
                for (int uu = 0; uu < 8; ++uu) { const u32x2 xw = *(const u32x2*)(xr + 8 * (u0 + uu)); a[uu] = (f32x4){bflo(xw.x), bfhi(xw.x), bflo(xw.y), bfhi(xw.y)}; const float* gp = GW + (size_t)(512 * kq + 8 * (u0 + uu) + 4 * kh) * 32 + i;
#pragma unroll
                    for (int j = 0; j < 4; ++j) gw[uu][j] = gp[32 * j]; }
#pragma unroll
                for (int uu = 0; uu < 8; ++uu) { ss += (a[uu][0] * a[uu][0] + a[uu][1] * a[uu][1]) + (a[uu][2] * a[uu][2] + a[uu][3] * a[uu][3]);
#pragma unroll
                    for (int j = 0; j < 4; ++j) acc = __builtin_amdgcn_mfma_f32_32x32x2f32(a[uu][j], gw[uu][j], acc, 0, 0, 0); }
            }
            ss += __shfl_xor(ss, 32);
            LAS float* RED = (LAS float*)(F.lds + 40960) + (g * 64 + lane) * 17;
            if (kq == 1) {
#pragma unroll
                for (int r = 0; r < 16; ++r) RED[r] = acc[r];
                RED[16] = ss; }
            __syncthreads();
            if (kq == 0) {
#pragma unroll
                for (int r = 0; r < 16; ++r) acc[r] += RED[r];
                ss += RED[16]; }
            if (wave < 4) {
            const float rstd = 1.0f / sqrtf(ss * (1.f / D) + RMS_EPS);
            rstd_keep = rstd;
            LAS float* L = LG + wave * (32 * 33);
#pragma unroll
            for (int r = 0; r < 16; ++r) L[crow(r, kh) * 33 + i] = acc[r];
            asm volatile("s_waitcnt lgkmcnt(0)" ::: "memory");
            if (kh == 0) {
                float v0 = -3.0e38f, v1 = -3.0e38f, v2 = -3.0e38f, v3 = -3.0e38f; int i0 = 0, i1 = 0, i2 = 0, i3 = 0;
                for (int e = 0; e < 32; ++e) { const float v = L[i * 33 + e] * rstd + rb[e];
                    if (v > v3) { if (v > v2) { v3 = v2; i3 = i2; if (v > v1) { v2 = v1; i2 = i1; if (v > v0) { v1 = v0; i1 = i0; v0 = v; i0 = e; } else { v1 = v; i1 = e; } } else { v2 = v; i2 = e; } } else { v3 = v; i3 = e; } } }
                const float e1 = __expf(v1 - v0), e2 = __expf(v2 - v0), e3 = __expf(v3 - v0), inv = 1.0f / (1.f + e1 + e2 + e3);
                ex[0] = i0; ex[1] = i1; ex[2] = i2; ex[3] = i3; gt[0] = inv; gt[1] = e1 * inv; gt[2] = e2 * inv; gt[3] = e3 * inv;
#pragma unroll
                for (int k = 0; k < 4; ++k) lr[k] = __hip_atomic_fetch_add(&HIST[ex[k]], 1u, __ATOMIC_RELAXED, __HIP_MEMORY_SCOPE_WORKGROUP);
            }
            }
        }
        __syncthreads();
        if (tid < 32) BASE[tid] = __hip_atomic_fetch_add(cnt + tid, HIST[tid], RLX_AGENT);
        __syncthreads();
        if (wave < 4 && lane < 32) {
#pragma unroll
            for (int k = 0; k < 4; ++k) { const unsigned pos = BASE[ex[k]] + lr[k]; const size_t li = (size_t)ex[k] * CAP + pos; LIST[li] = tok * 4 + k; LRS[li] = rstd_keep; LGT[li] = gt[k]; }
        }
        __syncthreads();
    }
}
__device__ __forceinline__ int moe_tables(Frame& F) {
    LAS int* CS = (LAS int*)(F.lds + MOE_OFF); LAS int* OFF = CS + 32; LAS unsigned char* TE = F.lds + MOE_TE;
    if (F.tid < 32) { int c = (int)__hip_atomic_load(F.ctl + CW_CNT + F.tid, RLX_AGENT); CS[F.tid] = c > CAP ? CAP : c; }
    __syncthreads();
    if (F.tid == 0) { int off = 0; for (int e = 0; e < 32; ++e) { OFF[e] = off; off += ((CS[e] + 255) >> 8) << 8; } OFF[32] = off; }
    __syncthreads();
    const int ntiles = OFF[32] >> 8;
    for (int t = F.tid; t < ntiles; t += 512) { int e = 0; while (e < 31 && OFF[e + 1] <= t * 256) ++e; TE[t] = (unsigned char)e; }
    __syncthreads();
    return ntiles;
}
__device__ __forceinline__ void p8_combine(Frame& F) {
    const bf16* X1 = WSP(bf16, WS_X1); const unsigned char* YBF = WSP(unsigned char, WS_YBUF); bf16* X2B = WSP(bf16, WS_X2B); float* R2 = WSP(float, WS_RSTD2); float* RSS = WSP(float, WS_ROWSS);
    const int gw = F.vcu * 8 + F.wave, NGW = F.G * 8, lane = F.lane;
    for (int t = gw; t < M; t += NGW) {
        const u32x2* xr = (const u32x2*)(X1 + (size_t)t * D) + lane; f32x4 v[4]; float s = 0.f; u32x2 xw[4];
#pragma unroll
        for (int j = 0; j < 4; ++j) xw[j] = xr[64 * j];
        unsigned yw[4][4];
#pragma unroll
        for (int k = 0; k < 4; ++k) { const unsigned* yr = (const unsigned*)(YBF + (size_t)(4 * t + k) * D) + lane;
#pragma unroll
            for (int j = 0; j < 4; ++j) yw[k][j] = yr[64 * j]; }
#pragma unroll
        for (int j = 0; j < 4; ++j) v[j] = (f32x4){bflo(xw[j].x), bfhi(xw[j].x), bflo(xw[j].y), bfhi(xw[j].y)};
#pragma unroll
        for (int k = 0; k < 4; ++k)
#pragma unroll
            for (int j = 0; j < 4; ++j) { const f32x2 lo = __builtin_amdgcn_cvt_pk_f32_fp8((int)yw[k][j], false), hi = __builtin_amdgcn_cvt_pk_f32_fp8((int)yw[k][j], true);
                v[j].x += lo.x * (1.f / 32.f); v[j].y += lo.y * (1.f / 32.f); v[j].z += hi.x * (1.f / 32.f); v[j].w += hi.y * (1.f / 32.f); }
        u32x2* o = (u32x2*)(X2B + (size_t)t * D) + lane;
#pragma unroll
        for (int j = 0; j < 4; ++j) { s += (v[j].x * v[j].x + v[j].y * v[j].y) + (v[j].z * v[j].z + v[j].w * v[j].w); u32x2 w; w.x = pk2(v[j].x, v[j].y); w.y = pk2(v[j].z, v[j].w); o[64 * j] = w;
            (WSP(unsigned, WS_X2B8) + (size_t)t * (D / 4))[lane + 64 * j] = pk8(v[j].x, v[j].y, v[j].z, v[j].w); }
        s = wave_sum(s);
        if (lane == 0) { R2[t] = 1.0f / sqrtf(s * (1.f / D) + RMS_EPS); RSS[t] = 0.f; }
    }
}
constexpr int NPHASE = 11;
__global__ void __launch_bounds__(512, 2) mega_fwd(Args args) {
    extern __shared__ __attribute__((aligned(16))) unsigned char lds[];
    Frame F;
    F.lds = (LAS unsigned char*)lds;
    F.wave = __builtin_amdgcn_readfirstlane((int)threadIdx.x >> 6); F.lane = lane_now(); F.tid = F.wave * 64 + F.lane;
    F.G = gridDim.x; { const int bx = blockIdx.x; F.vcu = (F.G % 8 == 0) ? (bx % 8) * (F.G / 8) + bx / 8 : bx; }
    F.ws = args.ws; F.ctl = (unsigned*)(args.ws + WS_CTL); F.out = args.out;
    volatile LAS unsigned* MISC = (volatile LAS unsigned*)(F.lds + LDSCTL_OFF);
    if (F.tid < 64) MISC[F.tid] = 0u;
    __syncthreads();
    const int lo = args.ph_lo, hi = args.ph_hi;
    XcdBarrier bar; bar.bar = F.ctl + CW_BAR; bar.x = 0; bar.st = nullptr;
    if (hi - lo > 1) bar = xcd_barrier_post(F.ctl + CW_BAR, MISC + 8, F.tid);
#ifndef PH_MASK
#define PH_MASK 0xFFFF
#endif
#define IN(k) ((((PH_MASK) >> (k)) & 1) && lo <= (k) && (k) < hi)
#define STAMP(k) do { if (TS_PROBE >= 0 && blockIdx.x == 0 && F.tid == 0) ((unsigned long long*)(F.ctl + 2048))[k] = __builtin_amdgcn_s_memrealtime(); } while (0)
#define SEAM(k) do { if (IN(k) && IN((k) + 1)) xcd_barrier(bar, F.wave); F.lane = lane_now(); F.tid = F.wave * 64 + F.lane; STAMP((k) + 1); } while (0)
    LAS unsigned char* ring = F.lds;
    STAMP(0);

    if (IN(0)) { p0_prologue(args, F); if (F.G < 256) expert_convert(args, F, F.vcu * 8 + F.wave, F.G * 8, 3); } SEAM(0);

    if (IN(1)) {
        constexpr unsigned ALLT = (1u << (INC / 256)) - 1u, F8T = (unsigned)(G1_F8_TILES) & ALLT, B16T = ALLT & ~F8T;
        if (B16T) { pg8::Gemm g{WSP(bf16, WS_XB), WSP(bf16, WS_WIN), M, INC, D, 0, nullptr, nullptr, nullptr}; pg8::MaskOrder S; S.init(M, B16T, F.G, (int)blockIdx.x);
            EpiG1 E{WSP(float, WS_RSTD0), WSP(bf16, WS_Q), WSP(bf16, WS_K), WSP(bf16, WS_VT), WSP(bf16, WS_ZR), WSP(bf16, WS_GT), 1.f};
            pg8::gemm_phase<EpiG1, pg8::MaskOrder, false, false>(ring, g, S, E, F.wave); }
        if (F8T) { pg8::Gemm g{WSP(bf16, WS_XB8), WSP(bf16, WS_WIN8), M, INC, D, 0, nullptr, nullptr, nullptr}; pg8::MaskOrder S; S.init(M, F8T, F.G, (int)blockIdx.x);
            EpiG1 E{WSP(float, WS_RSTD0), WSP(bf16, WS_Q), WSP(bf16, WS_K), WSP(bf16, WS_VT), WSP(bf16, WS_ZR), WSP(bf16, WS_GT), 1.f / 64.f};
            pg8::gemm_phase<EpiG1, pg8::MaskOrder, false, true>(ring, g, S, E, F.wave); }
    } SEAM(1);

    if (IN(2)) {
        for (int c = blockIdx.x; c < 256; c += F.G) {
            const int x = c & 7, y = c >> 3; pg8::LoraOrder S; S.half = y & 1; S.pm = x + 8 * (y >> 1); S.nu = 3 + (F.G >> 30);
            build_alora(args, F, S.pm);
            asm volatile("s_waitcnt vmcnt(0)" ::: "memory"); __syncthreads();
            pg8::Gemm g{WSP(bf16, WS_ALORA), WSP(bf16, WS_WL), M, LORA_N, LORA_K + (F.G >> 30), 0, nullptr, nullptr, nullptr};
            EpiLora E{FIN(5), FIN(7), WSP(bf16, WS_DEC), WSP(bf16, WS_AA), WSP(bf16, WS_GG)};
            pg8::gemm_phase(ring, g, S, E, F.wave);
        }
    } SEAM(2);

    if (IN(3)) {
        for (int u = blockIdx.x; u < 256; u += F.G) {
#ifndef P3_ONLY
#define P3_ONLY 5
#endif
            if (u < 128) { if (P3_ONLY != 2 && P3_ONLY != 3 && P3_ONLY != 4) scan_unit_chunked(args, F, u); else { bf16* YB = WSP(bf16, WS_YB); const int b = u >> 3, h = u & 7; for (int i = F.tid; i < SEQ * 8; i += 512) { const int tk = i >> 3, c8 = (i & 7) * 8; *(u32x4*)(YB + ((size_t)b * SEQ + tk) * 512 + h * 64 + c8) = (u32x4){0u, 0u, 0u, 0u}; } } }
            else if (P3_ONLY == 1 || P3_ONLY == 4) { bf16* YAz = WSP(bf16, WS_YA); const int bh = u - 128, b = bh >> 3, h = bh & 7; for (int i = F.tid; i < SEQ * 8; i += 512) { const int tk = i >> 3, c8 = (i & 7) * 8; *(u32x4*)(YAz + ((size_t)b * SEQ + tk) * 512 + h * 64 + c8) = (u32x4){0u, 0u, 0u, 0u}; } }
            else { const int bh = u - 128; for (int i = 0; i < 8; ++i) attn_tile(F, bh, F.wave + 8 * i);
                   if (F.G >= 256 && P3_ONLY != 3 && P3_ONLY != 5) expert_convert(args, F, bh * 8 + F.wave, 1024, 3);
                    }
        }
    if (TS_PROBE >= 0 && blockIdx.x == 0 && F.tid == 0) ((unsigned long long*)(F.ctl + 2048))[20] = __builtin_amdgcn_s_memrealtime();
    } SEAM(3);

    if (IN(4)) {
        pg8::StaticOrder S; S.init(M, D, F.G, (int)blockIdx.x);
        { pg8::Gemm g{WSP(bf16, WS_YA), WSP(bf16, WS_WA), M, D, AW, 0, nullptr, nullptr, nullptr}; EpiMerge<0> E{WSP(bf16, WS_GT), WSP(bf16, WS_MERGED)}; pg8::gemm_phase(ring, g, S, E, F.wave); }
        { pg8::Gemm g{WSP(bf16, WS_YB), WSP(bf16, WS_WB), M, D, RW, 0, nullptr, nullptr, nullptr}; EpiMerge<1> E{WSP(bf16, WS_GT), WSP(bf16, WS_MERGED)}; pg8::gemm_phase(ring, g, S, E, F.wave); }
    } SEAM(4);

    if (IN(5)) {
        pg8::Gemm g{WSP(bf16, WS_MERGED), WSP(bf16, WS_WO), M, D, D, 0, nullptr, nullptr, nullptr}; pg8::StaticOrder S; S.init(M, D, F.G, (int)blockIdx.x);
        EpiX1 E{FIN(0), WSP(bf16, WS_X1), FIN(18), WSP(unsigned char, WS_HN)};
        pg8::gemm_phase(ring, g, S, E, F.wave);
    } SEAM(5);

    if (IN(6)) { p5a_router(args, F); } SEAM(6);

    if (IN(7)) {
        const int ntiles = moe_tables(F);
        pg8::Gemm g{WSP(bf16, WS_HN), WSP(bf16, WS_W1), MAXROWS, F2, D, (size_t)F2 * D, WSP(int, WS_LIST), (const LAS int*)(F.lds + MOE_OFF) + 32, (const LAS int*)(F.lds + MOE_OFF)};
        pg8::MoeOrder S{ntiles, F2 / 256, F.G, (int)blockIdx.x, F.lds + MOE_TE};
        EpiSwiglu E{FIN(22), WSP(unsigned char, WS_ACT), WSP(int, WS_LIST), WSP(float, WS_LRS), (const LAS int*)(F.lds + MOE_OFF) + 32, (const LAS int*)(F.lds + MOE_OFF), (const LAS float*)(F.lds + RING_BYTES + 4096)};
        pg8::gemm_phase<EpiSwiglu, pg8::MoeOrder, true, true>(ring, g, S, E, F.wave);
    } SEAM(7);

    if (IN(8)) {
        const int ntiles = moe_tables(F);
        pg8::Gemm g{WSP(bf16, WS_ACT), WSP(bf16, WS_W2), MAXROWS, D, FH, (size_t)D * FH, nullptr, nullptr, nullptr};
        pg8::MoeOrder S{ntiles, D / 256, F.G, (int)blockIdx.x, F.lds + MOE_TE};
        EpiY E{FIN(24), WSP(int, WS_LIST), WSP(float, WS_LGT), WSP(unsigned char, WS_YBUF), (const LAS int*)(F.lds + MOE_OFF) + 32, (const LAS int*)(F.lds + MOE_OFF), (const LAS float*)(F.lds + RING_BYTES + 4096)};
        pg8::gemm_phase<EpiY, pg8::MoeOrder, false, true>(ring, g, S, E, F.wave);
    } SEAM(8);

    if (IN(9)) { p8_combine(F); } SEAM(9);

    if (IN(10)) {
        pg8::StaticOrder S; S.init(M, D, F.G, (int)blockIdx.x);
        { pg8::Gemm g{WSP(bf16, WS_X2B8), WSP(bf16, WS_WG), M, D, D, 0, nullptr, nullptr, nullptr}; EpiGate E{WSP(float, WS_RSTD2), WSP(bf16, WS_PGT)}; pg8::gemm_phase<EpiGate, pg8::StaticOrder, false, true>(ring, g, S, E, F.wave); }
        { pg8::Gemm g{WSP(bf16, WS_PB), WSP(bf16, WS_WP), M, D, PLE, 0, nullptr, nullptr, nullptr}; EpiPle E{WSP(bf16, WS_X2B), WSP(bf16, WS_PGT), F.out, WSP(float, WS_ROWSS), F.ctl + CW_PCNT, FIN(28), F.ctl}; pg8::gemm_phase(ring, g, S, E, F.wave); }
    }
#undef IN
#undef SEAM
}

extern "C" void kernel_launch(void* const* d_in, const int* in_sizes, int n_in, void* d_out, int out_size, void* d_ws, size_t ws_size, hipStream_t stream) {
    static int grid = 0;
    if (grid == 0) {
        if (n_in != 29 || in_sizes[0] != M * D || out_size != M * D || ws_size < WS_END) {
            fprintf(stderr, "kernel_launch: unexpected shapes (n_in %d, in0 %d, out %d, ws %zu < %zu); nothing launched\n", n_in, n_in > 0 ? in_sizes[0] : -1, out_size, ws_size, (size_t)WS_END); grid = -1; return; }
        int dev = 0, cus = 0, per_cu = 0;
        if (hipGetDevice(&dev) != hipSuccess || hipDeviceGetAttribute(&cus, hipDeviceAttributeMultiprocessorCount, dev) != hipSuccess) { grid = -1; return; }
        if (hipFuncSetAttribute((const void*)mega_fwd, hipFuncAttributeMaxDynamicSharedMemorySize, LDS_BYTES) != hipSuccess) { fprintf(stderr, "kernel_launch: hipFuncSetAttribute failed\n"); grid = -1; return; }
        if (hipOccupancyMaxActiveBlocksPerMultiprocessor(&per_cu, (const void*)mega_fwd, 512, LDS_BYTES) != hipSuccess || per_cu < 1) { fprintf(stderr, "kernel_launch: occupancy query says %d blocks/CU\n", per_cu); }
        (void)hipGetLastError();
        grid = cus;
    }
    if (grid < 0) return;
    (void)hipMemsetAsync((char*)d_ws + WS_CTL, 0, CTL_ZERO_BYTES, stream);
    Args a{};
    for (int i = 0; i < 29; ++i) a.in[i] = (const float*)d_in[i];
    a.out = (float*)d_out; a.ws = (unsigned char*)d_ws;
#if MK_PER_PHASE
    for (int p = 0; p < NPHASE; ++p) { a.ph_lo = p; a.ph_hi = p + 1; hipLaunchKernelGGL(mega_fwd, dim3(grid), dim3(512), LDS_BYTES, stream, a); }
#else
    a.ph_lo = 0; a.ph_hi = NPHASE; hipLaunchKernelGGL(mega_fwd, dim3(grid), dim3(512), LDS_BYTES, stream, a);
#endif
}
```

```cpp
#include <hip/hip_runtime.h>
#include <cstdio>
#include <cstdint>

#ifndef P3_ONLY
#define P3_ONLY 0
#endif
#ifndef SCAN_STUB
#define SCAN_STUB 0
#endif
#ifndef ATT_FORCE
#define ATT_FORCE 0
#endif
#ifndef G1_F8_TILES
#define G1_F8_TILES 0x1FE030u
#endif
#ifndef EPI_STUB
#define EPI_STUB 0
#endif
#ifndef TS_PROBE
#define TS_PROBE -1
#endif
#ifndef TS_END_SLOT
#define TS_END_SLOT (TS_PROBE + 1)
#endif
#ifndef MK_PER_PHASE
#define MK_PER_PHASE 0
#endif

#define LAS __attribute__((address_space(3)))
#define GAS __attribute__((address_space(1)))
typedef unsigned short bf16;
typedef short bf16x8 __attribute__((ext_vector_type(8)));
typedef float f32x2 __attribute__((ext_vector_type(2)));
typedef float f32x4 __attribute__((ext_vector_type(4)));
typedef float f32x16 __attribute__((ext_vector_type(16)));
typedef unsigned u32x2 __attribute__((ext_vector_type(2)));
typedef unsigned u32x4 __attribute__((ext_vector_type(4)));
typedef __bf16 bf16x2_t __attribute__((ext_vector_type(2)));

constexpr int NB = 16, SEQ = 2048, D = 1024, M = NB * SEQ;
constexpr int NH = 8, HD = 64, AW = 512, RW = 512, RWC = 1792, INC = 5376;
constexpr int NE = 32, FH = 1024, F2 = 2048, PLE = 256, TOPK = 4;
constexpr int LORA_K = 256, LORA_N = 1536;
constexpr int CAP = 32768;
constexpr int MAXROWS = M * TOPK + NE * 256;
constexpr float RMS_EPS = 1e-5f, GN_EPS = 64e-5f;

constexpr size_t MiB = 1u << 20;
constexpr size_t WS_CTL = 0, CTL_ZERO_BYTES = 1 * MiB;
constexpr size_t WS_WIN = 1 * MiB;
constexpr size_t WS_WA = 12 * MiB, WS_WB = 13 * MiB, WS_WO = 14 * MiB, WS_WG = 16 * MiB, WS_WP = 18 * MiB;
constexpr size_t WS_WL = 18 * MiB + 512 * 1024;
constexpr size_t WS_GW = 19 * MiB + 256 * 1024;
constexpr size_t WS_W1 = 20 * MiB;
constexpr size_t WS_W2 = 148 * MiB;
constexpr size_t WS_PB = 212 * MiB;
constexpr size_t WS_RSTD0 = 228 * MiB, WS_RSTD2 = WS_RSTD0 + 128 * 1024, WS_ROWSS = WS_RSTD0 + 256 * 1024;
constexpr size_t WS_RSTD1 = WS_RSTD0 + 384 * 1024;
constexpr size_t WS_GATEW = WS_RSTD0 + 512 * 1024;
constexpr size_t WS_ROWSLOT = 229 * MiB;
constexpr size_t WS_LIST = 230 * MiB;
constexpr size_t WS_X1 = 236 * MiB;
constexpr size_t WS_YA = 236 * MiB, WS_YB = 268 * MiB, WS_ALORA = 300 * MiB;
constexpr size_t WS_GT = 364 * MiB;
constexpr size_t WS_Q = 492 * MiB, WS_K = 524 * MiB, WS_VT = 556 * MiB;
constexpr size_t WS_ZR = 588 * MiB;
constexpr size_t WS_XB = 700 * MiB;
constexpr size_t WS_DEC = 764 * MiB, WS_AA = 828 * MiB, WS_GG = 892 * MiB;
constexpr size_t WS_MERGED = 492 * MiB;
constexpr size_t WS_XS = 364 * MiB;
constexpr size_t WS_ACT = 684 * MiB;
constexpr size_t WS_HN = 364 * MiB;
constexpr size_t WS_YBUF = 428 * MiB;
constexpr size_t WS_X2B8 = 820 * MiB;
constexpr size_t WS_X2B = 684 * MiB;
constexpr size_t WS_PGT = 748 * MiB;
constexpr size_t WS_LRS = 956 * MiB, WS_LGT = 960 * MiB;
constexpr size_t WS_WIN8 = 84 * MiB;
constexpr size_t WS_XB8 = 96 * MiB;
constexpr size_t WS_END = 964 * MiB;
constexpr int CW_CNT = 64;
constexpr int CW_PCNT = 8192;
constexpr int CW_BAR = 4096;

constexpr int RING_BYTES = 131072;
constexpr int LDSCTL_OFF = RING_BYTES;
constexpr int MOE_OFF = RING_BYTES + 1024;
constexpr int MOE_TE = RING_BYTES + 2048;
constexpr int LDS_BYTES = 147456;

#define RLX_AGENT __ATOMIC_RELAXED, __HIP_MEMORY_SCOPE_AGENT
__device__ __forceinline__ unsigned pk2(float lo, float hi) { f32x2 v = {lo, hi}; bf16x2_t b = __builtin_convertvector(v, bf16x2_t); return __builtin_bit_cast(unsigned, b); }
__device__ __forceinline__ unsigned pk8(float a, float b, float c, float d) { int w = __builtin_amdgcn_cvt_pk_fp8_f32(a, b, 0, false); w = __builtin_amdgcn_cvt_pk_fp8_f32(c, d, w, true); return (unsigned)w; }
__device__ __forceinline__ float bflo(unsigned u) { return __uint_as_float(u << 16); }
__device__ __forceinline__ float bfhi(unsigned u) { return __uint_as_float(u & 0xffff0000u); }
__device__ __forceinline__ float sigm(float x) { return __builtin_amdgcn_rcpf(1.f + __expf(-x)); }
__device__ __forceinline__ float wave_sum(float v) {
#pragma unroll
    for (int o = 1; o < 64; o <<= 1) v += __shfl_xor(v, o);
    return v;
}
template <int CTRL> __device__ __forceinline__ float dppf(float v) { return __builtin_bit_cast(float, __builtin_amdgcn_update_dpp(0, __builtin_bit_cast(int, v), CTRL, 0xF, 0xF, true)); }
__device__ __forceinline__ float red8(float v) { v += dppf<0xB1>(v); v += dppf<0x4E>(v); v += dppf<0x141>(v); return v; }
__device__ __forceinline__ int lane_now() { int l; asm volatile("v_mbcnt_lo_u32_b32 %0, -1, 0\n\tv_mbcnt_hi_u32_b32 %0, -1, %0" : "=v"(l)); return l; }
__device__ __forceinline__ int crow(int r, int hi) { return (r & 3) + 8 * (r >> 2) + 4 * hi; }

struct PreNone {}; struct PreF { float f[8]; }; struct PreI { int i[8]; };
namespace pg8 {
#define PG8_LAS __attribute__((address_space(3)))
typedef unsigned short bf16_t;
constexpr int BM = 256, BK = 64, HALF = 128, HTB = HALF * BK * 2, STAGE_BYTES = 8 * HTB, NXCD = 8, WGM = 8;
__host__ __device__ __forceinline__ int lds_byte(int r, int c) { const int st = (r >> 4) * 2 + (c >> 5), rr = r & 15, cc = c & 31, ob = rr * 64 + cc * 2; return st * 1024 + (ob ^ (((ob >> 9) & 1) << 5)); }
__host__ __device__ __forceinline__ void stage_rc(int b, int& R, int& C) { const int st = b / 1024, sb = b % 1024, swz = sb ^ (((sb >> 9) & 1) << 5); R = (st >> 1) * 16 + swz / 64; C = (st & 1) * 32 + (swz % 64) / 2; }
__host__ __device__ __forceinline__ int perm32(int rho) { const int n = rho >> 4, i = rho & 15; return 8 * (i >> 2) + 4 * n + (i & 3); }

struct Unit { int pm, pn, e, par; };
struct Gemm { const bf16_t* A; const bf16_t* Bt; int M, N, K; size_t bsel_bytes; const int* glist; const PG8_LAS int* goff; const PG8_LAS int* gcnt; };

struct StaticOrder {
    int nM, nN, nwg, G, c;
    __device__ void init(int M_, int N_, int G_, int c_) { nM = M_ / BM; nN = N_ / BM; nwg = nM * nN; G = G_; c = c_; }
    __device__ bool next(int i, Unit& u) const {
        const long L = (long)i * G + c; if (L >= nwg) return false;
        int wgid = (int)L; { const int q = nwg / NXCD, r = nwg % NXCD, xcd = wgid % NXCD, off = wgid / NXCD; wgid = (xcd < r ? xcd * (q + 1) : r * (q + 1) + (xcd - r) * q) + off; }
        const int nig = WGM * nN, gid = wgid / nig, fm = gid * WGM, gsz = (nM - fm) < WGM ? (nM - fm) : WGM;
        u.pm = fm + ((wgid % nig) % gsz); u.pn = (wgid % nig) / gsz; u.e = 0; return true;
    }
};
struct MaskOrder {
    StaticOrder S; unsigned mask;
    __device__ void init(int M_, unsigned mask_, int G_, int c_) { mask = mask_; S.init(M_, BM * __builtin_popcount(mask_), G_, c_); }
    __device__ bool next(int i, Unit& u) const {
        if (!S.next(i, u)) return false;
        int n = u.pn, idx = 0;
#pragma unroll
        for (int t = 0; t < 21; ++t) if ((mask >> t) & 1u) { if (n == 0) idx = t; --n; }
        u.pn = idx; return true;
    }
};
struct LoraOrder {
    int pm, half, nu;
    __device__ bool next(int i, Unit& u) const { if (i >= nu) return false; u.pm = pm; u.pn = 3 * half + i; u.e = 0; return true; }
};
struct MoeOrder {
    int ntiles, npn, G, c; const PG8_LAS unsigned char* te;
    __device__ bool next(int i, Unit& u) const {
        int rt, pn;
        if ((G & 255) == 0 && (npn == 8 || npn == 4)) { const int x = c & 7, j = (c >> 3) & 31, rpx = 32 / npn, blk = c >> 8; rt = ((i * (G >> 8) + blk) * 8 + x) * rpx + j / npn; pn = j % npn; }
        else { const long L = (long)i * G + c; rt = (int)(L / npn); pn = (int)(L % npn); }
        if (rt >= ntiles) return false;
        u.pm = rt; u.pn = pn; u.e = te[rt]; return true;
    }
};

typedef int i32x4 __attribute__((ext_vector_type(4))); typedef int i32x8 __attribute__((ext_vector_type(8)));
template <class Epi, class Sched, bool GATHER = false, bool F8 = false>
__device__ __forceinline__ void gemm_phase(PG8_LAS unsigned char* lds, const Gemm g, const Sched& S, const Epi& E, const int wid) {
    const int lane = lane_now(), tid = wid * 64 + lane,
              wr = wid >> 2, wc = wid & 3, fr = lane & 15, fq = lane >> 4;
    const int K = g.K, nt = F8 ? K / (2 * BK) : K / BK;
    unsigned voffA[2], voffB[2];
#pragma unroll
    for (int i = 0; i < 2; ++i) { int R, C; stage_rc(tid * 16 + i * 8192, R, C); const int Rb = Epi::PERM ? ((R & ~31) + perm32(R & 31)) : R;
        voffA[i] = F8 ? (unsigned)(R * K + C * 2) : (unsigned)(R * K + C) * 2u; voffB[i] = F8 ? (unsigned)(Rb * K + C * 2) : (unsigned)(Rb * K + C) * 2u; }
    const size_t kstep = (size_t)(BK * 2);
    const size_t hstep = (size_t)HALF * K * (F8 ? 1 : 2);
    const size_t tstep = 2 * hstep;
    const unsigned ldsw = (unsigned)wid * 1024u;
    const int aoff = lds_byte(wr * 64 + fr, fq * 8), boff = lds_byte(wc * 32 + fr, fq * 8);
    const int aoffk[2] = {aoff, aoff + 1024}, boffk[2] = {boff, boff + 1024};
    unsigned vgC[2][2] = {{0u, 0u}, {0u, 0u}}, vgN[2][2] = {{0u, 0u}, {0u, 0u}};
#define PG8_GOFF(u, vo) do { _Pragma("unroll") for (int _h = 0; _h < 2; ++_h) _Pragma("unroll") for (int _i = 0; _i < 2; ++_i) { int R_, C_; stage_rc(tid * 16 + _i * 8192, R_, C_); \
        const int r_ = (u).pm * BM + _h * HALF + R_ - g.goff[(u).e]; int tok_ = 0; if (r_ < g.gcnt[(u).e]) tok_ = g.glist[(size_t)(u).e * 32768 + r_] >> 2; (vo)[_h][_i] = F8 ? (unsigned)(tok_ * K + C_ * 2) : (unsigned)(tok_ * K + C_) * 2u; } } while (0)
#define PG8_SA(b, h) (((b) * 2 + (h)) * HTB)
#define PG8_SB(b, h) ((4 + (b) * 2 + (h)) * HTB)
#define PG8_STAGE(bufoff, gbase, voff) do { _Pragma("unroll") for (int _i = 0; _i < 2; ++_i) \
        __builtin_amdgcn_global_load_lds((const unsigned*)((const char*)(gbase) + (voff)[_i]), (PG8_LAS unsigned*)(lds + (bufoff) + ldsw + _i * 8192), 16, 0, 0); } while (0)
#define PG8_STA(bufoff, h, ptr, kbyte, usenext) do { if constexpr (GATHER) { unsigned vo_[2] = {(usenext) ? vgN[h][0] : vgC[h][0], (usenext) ? vgN[h][1] : vgC[h][1]}; PG8_STAGE(bufoff, (const char*)g.A + (kbyte), vo_); } else { PG8_STAGE(bufoff, ptr, voffA); } } while (0)
#define PG8_LDA(dst, b, h) do { _Pragma("unroll") for (int m = 0; m < 4; ++m) _Pragma("unroll") for (int k = 0; k < 2; ++k) dst[m][k] = *(const PG8_LAS bf16x8*)(lds + PG8_SA(b, h) + aoffk[k] + m * 2048); } while (0)
#define PG8_LDB(dst, b, h) do { _Pragma("unroll") for (int n = 0; n < 2; ++n) _Pragma("unroll") for (int k = 0; k < 2; ++k) dst[n][k] = *(const PG8_LAS bf16x8*)(lds + PG8_SB(b, h) + boffk[k] + n * 2048); } while (0)
#define PG8_MMA(ai, bj, At, Bt, Z) do { __builtin_amdgcn_s_setprio(1); \
        if constexpr (F8) { \
            if (Z) { _Pragma("unroll") for (int m = 0; m < 4; ++m) _Pragma("unroll") for (int n = 0; n < 2; ++n) { const i32x8 b8_ = __builtin_shufflevector(__builtin_bit_cast(i32x4, Bt[n][0]), __builtin_bit_cast(i32x4, Bt[n][1]), 0, 1, 2, 3, 4, 5, 6, 7), a8_ = __builtin_shufflevector(__builtin_bit_cast(i32x4, At[m][0]), __builtin_bit_cast(i32x4, At[m][1]), 0, 1, 2, 3, 4, 5, 6, 7); \
                asm volatile("v_mfma_f32_16x16x128_f8f6f4 %0, %1, %2, 0" : "=&v"(acc[ai][bj][m][n]) : "v"(b8_), "v"(a8_)); } } \
            else { _Pragma("unroll") for (int m = 0; m < 4; ++m) _Pragma("unroll") for (int n = 0; n < 2; ++n) { const i32x8 b8_ = __builtin_shufflevector(__builtin_bit_cast(i32x4, Bt[n][0]), __builtin_bit_cast(i32x4, Bt[n][1]), 0, 1, 2, 3, 4, 5, 6, 7), a8_ = __builtin_shufflevector(__builtin_bit_cast(i32x4, At[m][0]), __builtin_bit_cast(i32x4, At[m][1]), 0, 1, 2, 3, 4, 5, 6, 7); \
                asm volatile("v_mfma_f32_16x16x128_f8f6f4 %0, %1, %2, %0" : "+v"(acc[ai][bj][m][n]) : "v"(b8_), "v"(a8_)); } } } \
        else { _Pragma("unroll") for (int m = 0; m < 4; ++m) _Pragma("unroll") for (int n = 0; n < 2; ++n) _Pragma("unroll") for (int k = 0; k < 2; ++k) acc[ai][bj][m][n] = __builtin_amdgcn_mfma_f32_16x16x32_bf16(Bt[n][k], At[m][k], acc[ai][bj][m][n], 0, 0, 0); } \
        __builtin_amdgcn_s_setprio(0); } while (0)
#define PG8_WAIT_V(n) asm volatile("s_waitcnt vmcnt(" #n ")" ::: "memory")
#define PG8_WAIT_L(n) asm volatile("s_waitcnt lgkmcnt(" #n ")" ::: "memory")
#define PG8_BAR __builtin_amdgcn_s_barrier()
#define PG8_SCHED __builtin_amdgcn_sched_barrier(0)
    Unit cur, nxt; int ui = 0;
    if (!S.next(0, cur)) return;
    typename Epi::Pre preC;
    f32x4 acc[2][2][4][2];
#define PG8_ZERO_ACC do { if constexpr (!F8) { _Pragma("unroll") for (int a = 0; a < 2; ++a) _Pragma("unroll") for (int b = 0; b < 2; ++b) _Pragma("unroll") for (int m = 0; m < 4; ++m) _Pragma("unroll") for (int n = 0; n < 2; ++n) acc[a][b][m][n] = (f32x4){0.f, 0.f, 0.f, 0.f}; } } while (0)
    PG8_ZERO_ACC;
    bf16x8 At[4][2], B0[2][2], B1[2][2];
    const char* cA = (const char*)g.A + (size_t)cur.pm * tstep; const char* cB = (const char*)g.Bt + (size_t)cur.e * g.bsel_bytes + (size_t)cur.pn * tstep;
    if constexpr (GATHER) PG8_GOFF(cur, vgC);
    PG8_STAGE(PG8_SB(0, 0), cB, voffB); PG8_STAGE(PG8_SB(0, 1), cB + hstep, voffB); PG8_STA(PG8_SA(0, 0), 0, cA, 0, false); PG8_STA(PG8_SA(0, 1), 1, cA + hstep, 0, false);
    if (wr == 1) PG8_BAR;
    PG8_WAIT_V(2); PG8_BAR;
    PG8_STAGE(PG8_SB(1, 0), cB + kstep, voffB); PG8_STA(PG8_SA(1, 0), 0, cA + kstep, kstep, false); PG8_STAGE(PG8_SB(1, 1), cB + hstep + kstep, voffB);
    PG8_WAIT_V(6); PG8_BAR;
    for (;;) {
        const bool has_next = S.next(ui + 1, nxt);
        E.pre(cur, wr, fr, preC);
        cur.par = ui & 1;
        if constexpr (Epi::LBIAS) { if (wid == 0) __builtin_amdgcn_global_load_lds((const unsigned*)(E.bias_tile(cur) + 4 * lane), (PG8_LAS unsigned*)(lds + RING_BYTES + 4096 + 1024 * (ui & 1)), 16, 0, 0); }
        if constexpr (GATHER) { if (has_next) PG8_GOFF(nxt, vgN); else { vgN[0][0] = vgC[0][0]; vgN[0][1] = vgC[0][1]; vgN[1][0] = vgC[1][0]; vgN[1][1] = vgC[1][1]; } }
        const char* nA = has_next ? (const char*)g.A + (size_t)nxt.pm * tstep : cA;
        const char* nB = has_next ? (const char*)g.Bt + (size_t)nxt.e * g.bsel_bytes + (size_t)nxt.pn * tstep : cB;
        for (int t = 0; t < nt; t += 2) {
            const bool last = (t == nt - 2), first = (t == 0);
            const char* a1 = cA + (size_t)(t + 1) * kstep;
            const char* a2 = last ? nA : cA + (size_t)(t + 2) * kstep; const char* b2 = last ? nB : cB + (size_t)(t + 2) * kstep;
            const char* a3 = a2 + kstep; const char* b3 = b2 + kstep;
            const size_t k2 = last ? 0 : (size_t)(t + 2) * kstep;
            PG8_LDB(B0, 0, 0); PG8_LDB(B1, 0, 1); PG8_SCHED; PG8_LDA(At, 0, 0); PG8_STA(PG8_SA(1, 1), 1, a1 + hstep, (size_t)(t + 1) * kstep, false);
            PG8_WAIT_V(8); PG8_WAIT_L(0); PG8_BAR; PG8_MMA(0, 0, At, B0, first); PG8_MMA(0, 1, At, B1, first); PG8_BAR; PG8_SCHED;
            PG8_LDA(At, 0, 1); PG8_STAGE(PG8_SB(0, 0), b2, voffB); PG8_STAGE(PG8_SB(0, 1), b2 + hstep, voffB); PG8_STA(PG8_SA(0, 0), 0, a2, k2, last);
            PG8_WAIT_V(8); PG8_WAIT_L(0); PG8_BAR; PG8_MMA(1, 0, At, B0, first); PG8_MMA(1, 1, At, B1, first); PG8_BAR; PG8_SCHED;
            PG8_LDB(B0, 1, 0); PG8_LDB(B1, 1, 1); PG8_SCHED; PG8_LDA(At, 1, 0); PG8_STA(PG8_SA(0, 1), 1, a2 + hstep, k2, last);
            PG8_WAIT_V(8); PG8_WAIT_L(0); PG8_BAR; PG8_MMA(0, 0, At, B0, false); PG8_MMA(0, 1, At, B1, false); PG8_BAR; PG8_SCHED;
            PG8_LDA(At, 1, 1); PG8_STAGE(PG8_SB(1, 0), b3, voffB); PG8_STAGE(PG8_SB(1, 1), b3 + hstep, voffB); PG8_STA(PG8_SA(1, 0), 0, a3, k2 + kstep, last);
            PG8_WAIT_V(8); PG8_WAIT_L(0); PG8_BAR; PG8_MMA(1, 0, At, B0, false); PG8_MMA(1, 1, At, B1, false); PG8_BAR; PG8_SCHED;
        }
        if (wr == 0) PG8_BAR;
        if constexpr (F8) asm volatile("s_nop 15\n\ts_nop 15\n\ts_nop 15" ::: "memory");
        E(acc, cur, wr, wc, fr, fq, preC);
        if (!has_next) break;
        PG8_ZERO_ACC;
        cur = nxt; cA = nA; cB = nB; ++ui;
        if constexpr (GATHER) { vgC[0][0] = vgN[0][0]; vgC[0][1] = vgN[0][1]; vgC[1][0] = vgN[1][0]; vgC[1][1] = vgN[1][1]; }
        if (wr == 1) PG8_BAR;
    }
    PG8_WAIT_V(0);
    PG8_BAR;
#undef PG8_SA
#undef PG8_SB
#undef PG8_STAGE
#undef PG8_LDA
#undef PG8_STA
#undef PG8_GOFF
#undef PG8_LDB
#undef PG8_MMA
#undef PG8_ZERO_ACC
#undef PG8_WAIT_V
#undef PG8_WAIT_L
#undef PG8_BAR
#undef PG8_SCHED
}
}
using pg8::Unit;
typedef const f32x4 (&AccRef)[2][2][4][2];

#define XB_TMO      128
#define XB_XCNT(j)  (256  + 64 * (j))
#define XB_XSUB(j)  (1280 + 64 * (j))
#define XB_XGEN(j)  (2304 + 64 * (j))
#define XB_TOP      3328
#define XB_TOPGEN   3392
#define XCD_BAR_WORDS 3456
#define XB_SPIN_CAP (1u << 22)
__device__ __forceinline__ unsigned xb_ld(unsigned* p)              { return __hip_atomic_load(p, __ATOMIC_RELAXED, __HIP_MEMORY_SCOPE_AGENT); }
__device__ __forceinline__ unsigned xb_add(unsigned* p, unsigned v) { return __hip_atomic_fetch_add(p, v, __ATOMIC_RELAXED, __HIP_MEMORY_SCOPE_AGENT); }
__device__ __forceinline__ unsigned xb_xcc_id() { return (unsigned)__builtin_amdgcn_s_getreg((3 << 11) | 20) & 0xFu; }
#define XB_SPIN(cond, bar) do { unsigned _sp = 0; while (cond) { __builtin_amdgcn_s_sleep(1); \
    if ((++_sp & 255u) == 0u) { if (xb_ld(&(bar)[XB_TMO])) break; if (_sp > XB_SPIN_CAP) { atomicAdd(&(bar)[XB_TMO], 1u); break; } } } } while (0)
struct XcdBarrier { unsigned* bar; unsigned x; volatile LAS unsigned* st; };
__device__ __forceinline__ XcdBarrier xcd_barrier_post(unsigned* bar, volatile LAS unsigned* st, int tid) {
    XcdBarrier b; b.bar = bar; b.x = xb_xcc_id(); b.st = st;
    if (tid == 0) (void)xb_add(&bar[XB_XCNT(b.x)], 1u);
    return b;
}
__device__ __forceinline__ void xcd_barrier_complete(unsigned* bar, unsigned x, unsigned& nloc, unsigned& nx) {
    const unsigned G = gridDim.x * gridDim.y * gridDim.z;
    unsigned sum, cnt, mine, sp = 0u;
    for (;;) {
        sum = 0u; cnt = 0u; mine = 0u;
#pragma unroll
        for (unsigned j = 0; j < 16; ++j) { const unsigned c = xb_ld(&bar[XB_XCNT(j)]); sum += c; cnt += (c > 0u) ? 1u : 0u; mine = (j == x) ? c : mine; }
        if (sum == G) break;
        __builtin_amdgcn_s_sleep(1);
        if ((++sp & 255u) == 0u) { if (xb_ld(&bar[XB_TMO])) break; if (sp > XB_SPIN_CAP) { atomicAdd(&bar[XB_TMO], 1u); break; } }
    }
    nloc = mine > 0u ? mine : 1u; nx = cnt > 0u ? cnt : 1u;
}
__device__ __forceinline__ void xcd_barrier(const XcdBarrier& b, int wave) {
    asm volatile("s_waitcnt vmcnt(0)" ::: "memory");
    __syncthreads();
    if (wave == 0 && lane_now() == 0) {
        unsigned* bar = b.bar;
        __builtin_amdgcn_s_waitcnt(0);
        unsigned nloc = b.st[0], nx = b.st[1];
        if (nloc == 0u) { xcd_barrier_complete(bar, b.x, nloc, nx); b.st[0] = nloc; b.st[1] = nx; }
        const unsigned old = xb_add(&bar[XB_XSUB(b.x)], 1u);
        const unsigned gen = old / nloc;
        if (old + 1u == (gen + 1u) * nloc) {
            __builtin_amdgcn_fence(__ATOMIC_RELEASE, "agent");
            asm volatile("s_waitcnt vmcnt(0)" ::: "memory");
            const unsigned og = xb_add(&bar[XB_TOP], 1u);
            const unsigned tg = og / nx;
            if (og + 1u == (tg + 1u) * nx) xb_add(&bar[XB_TOPGEN], 1u);
            else XB_SPIN(xb_ld(&bar[XB_TOPGEN]) == tg, bar);
            __builtin_amdgcn_fence(__ATOMIC_ACQUIRE, "agent");
            xb_add(&bar[XB_XGEN(b.x)], 1u);
            asm volatile("s_waitcnt vmcnt(0)" ::: "memory");
        } else {
            XB_SPIN(xb_ld(&bar[XB_XGEN(b.x)]) == gen, bar);
            __builtin_amdgcn_fence(__ATOMIC_ACQUIRE, "agent");
            asm volatile("s_waitcnt vmcnt(0)" ::: "memory");
        }
    }
    __syncthreads();
}

struct Frame {
    LAS unsigned char* lds;
    unsigned* ctl;
    int tid, lane, wave, vcu, G;
    unsigned char* ws;
    float* out;
};
#define WSP(T, off) ((T*)(F.ws + (off)))
struct Args { const float* in[29]; float* out; unsigned char* ws; int ph_lo, ph_hi; };
#define FIN(i) (args.in[i])

template <bool SWZ = false, bool Q8 = false>
__device__ __forceinline__ void p0_transpose_item(const float* W, int K, int N, bf16* WT, LAS float* scr, int item, int lane, const float* kscale) {
    const int nblk = N / 32, kb = item / nblk, nb = item % nblk, k0 = 64 * kb, n0 = 32 * nb;
#pragma unroll
    for (int b = 0; b < 2; ++b) {
        float v[16];
#pragma unroll
        for (int i = 0; i < 16; ++i) { const int kk = 2 * (16 * b + i) + (lane >> 5); v[i] = W[(size_t)(k0 + kk) * N + n0 + (lane & 31)]; }
        __builtin_amdgcn_sched_barrier(0);
#pragma unroll
        for (int i = 0; i < 16; ++i) { const int kk = 2 * (16 * b + i) + (lane >> 5); if (kscale) v[i] *= kscale[k0 + kk]; scr[kk * 33 + (lane & 31)] = v[i]; }
        __builtin_amdgcn_sched_barrier(0);
    }
    asm volatile("s_waitcnt lgkmcnt(0)" ::: "memory");
    if constexpr (Q8) {
        const int c4 = lane & 3;
#pragma unroll
        for (int j = 0; j < 2; ++j) { const int n = (lane >> 2) + 16 * j; const LAS float* s = scr + (16 * c4) * 33 + n;
            u32x4 o; o.x = pk8(64.f * s[0 * 33], 64.f * s[1 * 33], 64.f * s[2 * 33], 64.f * s[3 * 33]); o.y = pk8(64.f * s[4 * 33], 64.f * s[5 * 33], 64.f * s[6 * 33], 64.f * s[7 * 33]);
            o.z = pk8(64.f * s[8 * 33], 64.f * s[9 * 33], 64.f * s[10 * 33], 64.f * s[11 * 33]); o.w = pk8(64.f * s[12 * 33], 64.f * s[13 * 33], 64.f * s[14 * 33], 64.f * s[15 * 33]);
            int nr = n0 + n; if (SWZ) { const int cl = nr & 255; nr = (nr & ~255) + 128 * ((cl >> 3) & 1) + 32 * (cl >> 6) + 8 * ((cl >> 4) & 3) + (cl & 7); }
            *(u32x4*)((unsigned char*)WT + (size_t)nr * K + k0 + 16 * c4) = o; }
        asm volatile("s_waitcnt lgkmcnt(0)" ::: "memory");
        return; }
    const int c = lane & 7;
#pragma unroll
    for (int j = 0; j < 4; ++j) { const int n = (lane >> 3) + 8 * j; const LAS float* s = scr + (8 * c) * 33 + n;
        u32x4 o; o.x = pk2(s[0 * 33], s[1 * 33]); o.y = pk2(s[2 * 33], s[3 * 33]); o.z = pk2(s[4 * 33], s[5 * 33]); o.w = pk2(s[6 * 33], s[7 * 33]);
        int nr = n0 + n; if (SWZ) { const int cl = nr & 255; nr = (nr & ~255) + 128 * ((cl >> 3) & 1) + 32 * (cl >> 6) + 8 * ((cl >> 4) & 3) + (cl & 7); }
        *(u32x4*)(WT + (size_t)nr * K + k0 + 8 * c) = o; }
    asm volatile("s_waitcnt lgkmcnt(0)" ::: "memory");
}
__device__ __forceinline__ void p0_prologue(const Args& args, Frame& F) {
    LAS float* scr = (LAS float*)(F.lds + F.wave * 16384);
    const int gw = F.vcu * 8 + F.wave, NGW = F.G * 8, lane = F.lane;
    constexpr int I_IN = (D / 64) * (INC / 32), I_A = (AW / 64) * (D / 32), I_O = (D / 64) * (D / 32), I_P = (PLE / 64) * (D / 32);
    constexpr int I_W1 = (D / 64) * (F2 / 32), I_W2 = (FH / 64) * (D / 32);
    constexpr int NITEMS = I_IN + 2 * I_A + 2 * I_O + I_P;
    for (int it = gw; it < NITEMS; it += NGW) {
        int r = it;
        if (r < I_IN) { const int tile = (r % (INC / 32)) >> 3;
            if ((G1_F8_TILES >> tile) & 1) p0_transpose_item<false, true>(FIN(3), D, INC, WSP(bf16, WS_WIN8), scr, r, lane, FIN(2));
            else p0_transpose_item(FIN(3), D, INC, WSP(bf16, WS_WIN), scr, r, lane, FIN(2));
            continue; } r -= I_IN;
        if (r < I_A) { p0_transpose_item(FIN(15), AW, D, WSP(bf16, WS_WA), scr, r, lane, nullptr); continue; } r -= I_A;
        if (r < I_A) { p0_transpose_item(FIN(16), RW, D, WSP(bf16, WS_WB), scr, r, lane, nullptr); continue; } r -= I_A;
        if (r < I_O) { p0_transpose_item(FIN(17), D, D, WSP(bf16, WS_WO), scr, r, lane, nullptr); continue; } r -= I_O;
        if (r < I_O) { p0_transpose_item<false, true>(FIN(26), D, D, WSP(bf16, WS_WG), scr, r, lane, FIN(25)); continue; } r -= I_O;
        p0_transpose_item(FIN(27), PLE, D, WSP(bf16, WS_WP), scr, r, lane, nullptr);
    }
    { const int gt = (F.vcu * 512 + F.tid), NT = F.G * 512;
      bf16* WL = WSP(bf16, WS_WL);
      for (int i = gt; i < LORA_N * LORA_K; i += NT) { const int n = i >> 8, k = i & 255; float v = 0.f;
          if (n < 512) { if (k < 64) v = FIN(6)[k * 512 + n]; }
          else if (n < 1024) { if (k >= 64 && k < 128) v = FIN(8)[(k - 64) * 512 + (n - 512)]; }
          else { if (k >= 128) v = FIN(9)[(k - 128) * 512 + (n - 1024)]; }
          WL[i] = (bf16)(pk2(v, 0.f) & 0xffffu); }
      float* GW = WSP(float, WS_GW);
      for (int i = gt; i < D * NE; i += NT) GW[i] = FIN(19)[i] * FIN(18)[i >> 5];
    }
    { bf16* XB = WSP(bf16, WS_XB); float* R0 = WSP(float, WS_RSTD0); bf16* PB = WSP(bf16, WS_PB);
      for (int m = gw; m < M; m += NGW) {
          const f32x4* xr = (const f32x4*)(FIN(0) + (size_t)m * D) + lane;
          f32x4 v[4]; float s = 0.f;
#pragma unroll
          for (int j = 0; j < 4; ++j) { v[j] = xr[64 * j]; s += (v[j].x * v[j].x + v[j].y * v[j].y) + (v[j].z * v[j].z + v[j].w * v[j].w); }
          s = wave_sum(s);
          u32x2* o = (u32x2*)(XB + (size_t)m * D) + lane;
#pragma unroll
          for (int j = 0; j < 4; ++j) { if (G1_F8_TILES) (WSP(unsigned, WS_XB8) + (size_t)m * (D / 4))[lane + 64 * j] = pk8(v[j].x, v[j].y, v[j].z, v[j].w); u32x2 w; w.x = pk2(v[j].x, v[j].y); w.y = pk2(v[j].z, v[j].w); o[64 * j] = w; }
          if (lane == 0) R0[m] = 1.0f / sqrtf(s * (1.f / D) + RMS_EPS);
          const f32x4 pv = ((const f32x4*)(FIN(1) + (size_t)m * PLE))[lane];
          u32x2 w; w.x = pk2(pv.x, pv.y); w.y = pk2(pv.z, pv.w); ((u32x2*)(PB + (size_t)m * PLE))[lane] = w;
      }
    }
}

__device__ __forceinline__ void expert_convert(const Args& args, Frame& F, int wv, int NW, int which) {
    LAS float* scr = (LAS float*)(F.lds + F.wave * 16384);
    constexpr int I_W1 = (D / 64) * (F2 / 32), I_W2 = (FH / 64) * (D / 32);
    if (which & 1) for (int it = wv; it < NE * I_W1; it += NW) { const int e = it / I_W1; p0_transpose_item<true, true>(FIN(21) + (size_t)e * D * F2, D, F2, (bf16*)(WSP(unsigned char, WS_W1) + (size_t)e * F2 * D), scr, it % I_W1, F.lane, nullptr); }
    if (which & 2) for (int it = wv; it < NE * I_W2; it += NW) { const int e = it / I_W2; p0_transpose_item<false, true>(FIN(23) + (size_t)e * FH * D, FH, D, (bf16*)(WSP(unsigned char, WS_W2) + (size_t)e * D * FH), scr, it % I_W2, F.lane, nullptr); }
}
struct EpiG1 {
    static constexpr bool PERM = true;
    typedef PreF Pre; static constexpr bool LBIAS = false;
    const float* rstd; bf16 *Q, *K, *VT, *ZR, *GT; float rs_mul;
    __device__ __forceinline__ void pre(const Unit& u, int wr, int fr, PreF& P) const {
#pragma unroll
        for (int k = 0; k < 8; ++k) P.f[k] = rstd[u.pm * 256 + wr * 64 + fr + (k >> 2) * 128 + (k & 3) * 16] * rs_mul; }
    __device__ __forceinline__ void operator()(AccRef acc, const Unit& u, int wr, int wc, int fr, int fq, const Pre& P) const {
        const int pn = u.pn, rowb = u.pm * 256 + wr * 64 + fr, cl = wc * 32 + 8 * fq;
#pragma unroll
        for (int ai = 0; ai < 2; ++ai)
#pragma unroll
            for (int m = 0; m < 4; ++m) {
                const int row = rowb + ai * 128 + m * 16; const float rs = P.f[4 * ai + m];
                if (pn < 4) {
                    bf16* base = (pn < 2 ? Q : K) + (size_t)row * 512 + (pn & 1) * 256 + cl; const float sc = pn < 2 ? rs * 0.125f : rs;
#pragma unroll
                    for (int bj = 0; bj < 2; ++bj) { const f32x4 v0 = acc[ai][bj][m][0] * sc, v1 = acc[ai][bj][m][1] * sc;
                        u32x4 w; w.x = pk2(v0[0], v0[1]); w.y = pk2(v0[2], v0[3]); w.z = pk2(v1[0], v1[1]); w.w = pk2(v1[2], v1[3]); *(u32x4*)(base + bj * 128) = w; }
                } else if (pn < 6) {
                    const int b = row >> 11, s = row & 2047;
#pragma unroll
                    for (int bj = 0; bj < 2; ++bj)
#pragma unroll
                        for (int n = 0; n < 2; ++n)
#pragma unroll
                            for (int j = 0; j < 4; ++j) { const int c = (pn - 4) * 256 + cl + bj * 128 + 4 * n + j; const int hh = c >> 6, d = c & 63;
                                VT[((size_t)(((b * 8 + hh) * 128 + (s >> 4)) * 64 + d)) * 16 + (s & 15)] = (bf16)(pk2(acc[ai][bj][m][n][j] * rs, 0.f) & 0xffffu); }
                } else if (pn < 13) {
                    bf16* base = ZR + (size_t)row * RWC + (pn - 6) * 256 + cl;
#pragma unroll
                    for (int bj = 0; bj < 2; ++bj) { const f32x4 v0 = acc[ai][bj][m][0] * rs, v1 = acc[ai][bj][m][1] * rs;
                        u32x4 w; w.x = pk2(v0[0], v0[1]); w.y = pk2(v0[2], v0[3]); w.z = pk2(v1[0], v1[1]); w.w = pk2(v1[2], v1[3]); *(u32x4*)(base + bj * 128) = w; }
                } else {
                    bf16* base = GT + (size_t)row * 2048 + (pn - 13) * 256 + cl;
#pragma unroll
                    for (int bj = 0; bj < 2; ++bj) { const f32x4 v0 = acc[ai][bj][m][0] * rs, v1 = acc[ai][bj][m][1] * rs;
                        u32x4 w; w.x = pk2(sigm(v0[0]), sigm(v0[1])); w.y = pk2(sigm(v0[2]), sigm(v0[3])); w.z = pk2(sigm(v1[0]), sigm(v1[1])); w.w = pk2(sigm(v1[2]), sigm(v1[3])); *(u32x4*)(base + bj * 128) = w; }
                }
            }
    }
};
struct EpiLora {
    static constexpr bool PERM = true;
    typedef PreNone Pre; static constexpr bool LBIAS = false;
    __device__ __forceinline__ void pre(const Unit&, int, int, PreNone&) const {}
    const float *w0, *a0; bf16 *DEC, *AA, *GG;
    template <int MODE> __device__ __forceinline__ void body(AccRef acc, int rowb, int cb) const {
#pragma unroll
        for (int bj = 0; bj < 2; ++bj) {
            const int c = cb + bj * 128;
            f32x4 b0 = (f32x4){0.f, 0.f, 0.f, 0.f}, b1 = b0;
            if (MODE == 0) { b0 = *(const f32x4*)(w0 + c); b1 = *(const f32x4*)(w0 + c + 4); } else if (MODE == 1) { b0 = *(const f32x4*)(a0 + c); b1 = *(const f32x4*)(a0 + c + 4); }
#pragma unroll
            for (int ai = 0; ai < 2; ++ai)
#pragma unroll
                for (int m = 0; m < 4; ++m) { const int row = rowb + ai * 128 + m * 16;
                    const f32x4 v0 = acc[ai][bj][m][0] + b0, v1 = acc[ai][bj][m][1] + b1; float o[8];
#pragma unroll
                    for (int j = 0; j < 8; ++j) { const float v = j < 4 ? v0[j] : v1[j - 4];
                        if (MODE == 0) { const float y = -v; const float sp = y > 20.f ? y : __logf(1.f + __expf(y)); o[j] = __expf(-sp - 0.5f); }
                        else if (MODE == 1) o[j] = sigm(v); else o[j] = v; }
                    u32x4 w; w.x = pk2(o[0], o[1]); w.y = pk2(o[2], o[3]); w.z = pk2(o[4], o[5]); w.w = pk2(o[6], o[7]);
                    bf16* dst = (MODE == 0 ? DEC : MODE == 1 ? AA : GG) + (size_t)row * 512 + c; *(u32x4*)dst = w;
                    asm volatile("" ::: "memory"); }
        }
    }
    __device__ __forceinline__ void operator()(AccRef acc, const Unit& u, int wr, int wc, int fr, int fq, const Pre& P) const {
        const int pn = u.pn, rowb = u.pm * 256 + wr * 64 + fr, cb = (pn & 1) * 256 + wc * 32 + 8 * fq;
        if (pn < 2) body<0>(acc, rowb, cb); else if (pn < 4) body<1>(acc, rowb, cb); else body<2>(acc, rowb, cb);
    }
};
template <int SECOND> struct EpiMerge {
    static constexpr bool PERM = true;
    typedef PreNone Pre; static constexpr bool LBIAS = false;
    __device__ __forceinline__ void pre(const Unit&, int, int, PreNone&) const {}
    const bf16* GT; bf16* MG;
    __device__ __forceinline__ void operator()(AccRef acc, const Unit& u, int wr, int wc, int fr, int fq, const Pre& P) const {
        const int rowb = u.pm * 256 + wr * 64 + fr, c0 = u.pn * 256 + wc * 32 + 8 * fq;
#pragma unroll
        for (int bj = 0; bj < 2; ++bj) {
            const int c = c0 + bj * 128; u32x4 gv[8], ov[8];
#pragma unroll
            for (int k = 0; k < 8; ++k) { const int row = rowb + (k >> 2) * 128 + (k & 3) * 16; gv[k] = *(const u32x4*)(GT + (size_t)row * 2048 + SECOND * 1024 + c); if (SECOND) ov[k] = *(const u32x4*)(MG + (size_t)row * 1024 + c); }
            __builtin_amdgcn_sched_barrier(0);
#pragma unroll
            for (int k = 0; k < 8; ++k) { const int ai = k >> 2, m = k & 3, row = rowb + ai * 128 + m * 16;
                const f32x4 v0 = acc[ai][bj][m][0], v1 = acc[ai][bj][m][1];
                float o[8] = {v0[0] * bflo(gv[k].x), v0[1] * bfhi(gv[k].x), v0[2] * bflo(gv[k].y), v0[3] * bfhi(gv[k].y), v1[0] * bflo(gv[k].z), v1[1] * bfhi(gv[k].z), v1[2] * bflo(gv[k].w), v1[3] * bfhi(gv[k].w)};
                if (SECOND) { o[0] += bflo(ov[k].x); o[1] += bfhi(ov[k].x); o[2] += bflo(ov[k].y); o[3] += bfhi(ov[k].y); o[4] += bflo(ov[k].z); o[5] += bfhi(ov[k].z); o[6] += bflo(ov[k].w); o[7] += bfhi(ov[k].w); }
                u32x4 w; w.x = pk2(o[0], o[1]); w.y = pk2(o[2], o[3]); w.z = pk2(o[4], o[5]); w.w = pk2(o[6], o[7]); *(u32x4*)(MG + (size_t)row * 1024 + c) = w; }
            __builtin_amdgcn_sched_barrier(0);
        }
    }
};
struct EpiX1 {
    static constexpr bool PERM = true;
    typedef PreNone Pre; static constexpr bool LBIAS = false;
    __device__ __forceinline__ void pre(const Unit&, int, int, PreNone&) const {}
    const bf16* X; bf16* X1; const float* gn; unsigned char* HN;
    __device__ __forceinline__ void operator()(AccRef acc, const Unit& u, int wr, int wc, int fr, int fq, const Pre& P) const {
        const int rowb = u.pm * 256 + wr * 64 + fr, c0 = u.pn * 256 + wc * 32 + 8 * fq;
#pragma unroll
        for (int bj = 0; bj < 2; ++bj) { const f32x4 g0 = *(const f32x4*)(gn + c0 + bj * 128), g1 = *(const f32x4*)(gn + c0 + bj * 128 + 4);
#pragma unroll
            for (int ai = 0; ai < 2; ++ai) {
                u32x4 xw_[4];
#pragma unroll
                for (int m = 0; m < 4; ++m) { const size_t off = (size_t)(rowb + ai * 128 + m * 16) * D + c0 + bj * 128; xw_[m] = *(const u32x4*)(X + off); }
                __builtin_amdgcn_sched_barrier(0);
#pragma unroll
                for (int m = 0; m < 4; ++m) { const size_t off = (size_t)(rowb + ai * 128 + m * 16) * D + c0 + bj * 128;
                    const f32x4 x0 = (f32x4){bflo(xw_[m].x), bfhi(xw_[m].x), bflo(xw_[m].y), bfhi(xw_[m].y)} + acc[ai][bj][m][0], x1 = (f32x4){bflo(xw_[m].z), bfhi(xw_[m].z), bflo(xw_[m].w), bfhi(xw_[m].w)} + acc[ai][bj][m][1];
                    { u32x4 xw; xw.x = pk2(x0[0], x0[1]); xw.y = pk2(x0[2], x0[3]); xw.z = pk2(x1[0], x1[1]); xw.w = pk2(x1[2], x1[3]); *(u32x4*)(X1 + off) = xw; }
                    u32x2 w; w.x = pk8(x0[0] * g0[0], x0[1] * g0[1], x0[2] * g0[2], x0[3] * g0[3]); w.y = pk8(x1[0] * g1[0], x1[1] * g1[1], x1[2] * g1[2], x1[3] * g1[3]); *(u32x2*)(HN + off) = w; }
                __builtin_amdgcn_sched_barrier(0);
            }
        }
    }
};
struct EpiSwiglu {
    static constexpr bool PERM = true;
    typedef PreF Pre; static constexpr bool LBIAS = true;
    const float* b1; unsigned char* ACT; const int* LIST; const float* R1; const LAS int* OFF; const LAS int* CS; const LAS float* LB;
    __device__ __forceinline__ const float* bias_tile(const Unit& u) const { return b1 + (size_t)u.e * F2 + u.pn * 256; }
    __device__ __forceinline__ void pre(const Unit& u, int wr, int fr, PreF& P) const {
        const int rbase = u.pm * 256 + wr * 64 + fr - OFF[u.e], cnt = CS[u.e];
#pragma unroll
        for (int k = 0; k < 8; ++k) { const int r = rbase + (k >> 2) * 128 + (k & 3) * 16; P.f[k] = 0.f; if (r < cnt) P.f[k] = R1[(size_t)u.e * CAP + r] * (1.f / 64.f); } }
    __device__ __forceinline__ void operator()(AccRef acc, const Unit& u, int wr, int wc, int fr, int fq, const Pre& P) const {
        if (EPI_STUB & 1) return;
        const int rowb = u.pm * 256 + wr * 64 + fr, c0 = u.pn * 256 + wc * 64 + 16 * fq;
        const LAS float* bb = LB + 256 * u.par + wc * 64 + 16 * fq;
        const f32x4 bv0 = *(const LAS f32x4*)(bb), bv1 = *(const LAS f32x4*)(bb + 4), bv2 = *(const LAS f32x4*)(bb + 8), bv3 = *(const LAS f32x4*)(bb + 12);
#pragma unroll
        for (int ai = 0; ai < 2; ++ai)
#pragma unroll
            for (int m = 0; m < 4; ++m) { const int row = rowb + ai * 128 + m * 16; const float rs = P.f[4 * ai + m];
                const f32x4 v[4] = {acc[ai][0][m][0] * rs + bv0, acc[ai][0][m][1] * rs + bv1, acc[ai][1][m][0] * rs + bv2, acc[ai][1][m][1] * rs + bv3};
                float o[8];
#pragma unroll
                for (int p = 0; p < 8; ++p) { float gl = v[p >> 1][2 * (p & 1)], ul = v[p >> 1][2 * (p & 1) + 1];
                    gl = fminf(gl, 7.f); ul = fminf(fmaxf(ul, -7.f), 7.f); o[p] = (ul + 1.f) * gl * sigm(1.702f * gl); }
                u32x2 w; w.x = pk8(o[0], o[1], o[2], o[3]); w.y = pk8(o[4], o[5], o[6], o[7]); *(u32x2*)(ACT + (size_t)row * FH + (c0 >> 1)) = w;
                asm volatile("" ::: "memory"); }
    }
};
struct EpiY {
    static constexpr bool PERM = true;
    typedef PreI Pre; static constexpr bool LBIAS = true;
    const float* b2; const int* LIST; const float* gatew; unsigned char* YB; const LAS int* OFF; const LAS int* CS; const LAS float* LB;
    __device__ __forceinline__ const float* bias_tile(const Unit& u) const { return b2 + (size_t)u.e * D + u.pn * 256; }
    __device__ __forceinline__ void pre(const Unit& u, int wr, int fr, PreI& P) const {
        const int rbase = u.pm * 256 + wr * 64 + fr - OFF[u.e], cnt = CS[u.e];
#pragma unroll
        for (int k = 0; k < 8; ++k) { const int r = rbase + (k >> 2) * 128 + (k & 3) * 16; P.i[k] = -1; if (r < cnt) P.i[k] = LIST[(size_t)u.e * CAP + r]; } }
    __device__ __forceinline__ void operator()(AccRef acc, const Unit& u, int wr, int wc, int fr, int fq, const Pre& P) const {
        const int rowb = u.pm * 256 + wr * 64 + fr, c0 = u.pn * 256 + wc * 32 + 8 * fq;
        const LAS float* bb = LB + 256 * u.par + wc * 32 + 8 * fq; const int rbase = rowb - OFF[u.e];
        if (EPI_STUB & 2) return;

#pragma unroll
        for (int ai = 0; ai < 2; ++ai) {
            float gts[4];
#pragma unroll
            for (int m = 0; m < 4; ++m) { gts[m] = 0.f; if (P.i[4 * ai + m] >= 0) gts[m] = gatew[(size_t)u.e * CAP + rbase + ai * 128 + m * 16]; }
            __builtin_amdgcn_sched_barrier(0);
#pragma unroll
            for (int m = 0; m < 4; ++m) {
                const int slot = P.i[4 * ai + m]; if (slot >= 0) { const float gt = gts[m] * 32.f;
#pragma unroll
                    for (int bj = 0; bj < 2; ++bj) { const int c = c0 + bj * 128;
                        const f32x4 v0 = (acc[ai][bj][m][0] * (1.f / 64.f) + *(const LAS f32x4*)(bb + bj * 128)) * gt, v1 = (acc[ai][bj][m][1] * (1.f / 64.f) + *(const LAS f32x4*)(bb + bj * 128 + 4)) * gt;
                        u32x2 w; w.x = pk8(v0[0], v0[1], v0[2], v0[3]); w.y = pk8(v1[0], v1[1], v1[2], v1[3]); *(u32x2*)(YB + (size_t)slot * D + c) = w; } } }
            __builtin_amdgcn_sched_barrier(0); }
    }
};
struct EpiGate {
    static constexpr bool PERM = true;
    typedef PreF Pre; static constexpr bool LBIAS = false;
    __device__ __forceinline__ void pre(const Unit& u, int wr, int fr, PreF& P) const {
#pragma unroll
        for (int k = 0; k < 8; ++k) P.f[k] = rstd2[u.pm * 256 + wr * 64 + fr + (k >> 2) * 128 + (k & 3) * 16] * (1.f / 64.f); }
    const float* rstd2; bf16* GT;
    __device__ __forceinline__ void operator()(AccRef acc, const Unit& u, int wr, int wc, int fr, int fq, const Pre& P) const {
        const int rowb = u.pm * 256 + wr * 64 + fr, c0 = u.pn * 256 + wc * 32 + 8 * fq;
#pragma unroll
        for (int ai = 0; ai < 2; ++ai)
#pragma unroll
            for (int m = 0; m < 4; ++m) { const int row = rowb + ai * 128 + m * 16; const float rs = P.f[4 * ai + m];
#pragma unroll
                for (int bj = 0; bj < 2; ++bj) { const f32x4 v0 = acc[ai][bj][m][0] * rs, v1 = acc[ai][bj][m][1] * rs;
                    u32x4 w; w.x = pk2(sigm(v0[0]), sigm(v0[1])); w.y = pk2(sigm(v0[2]), sigm(v0[3])); w.z = pk2(sigm(v1[0]), sigm(v1[1])); w.w = pk2(sigm(v1[2]), sigm(v1[3]));
                    *(u32x4*)(GT + (size_t)row * D + c0 + bj * 128) = w; } }
    }
};
struct EpiPle {
    static constexpr bool PERM = true;
    typedef PreNone Pre; static constexpr bool LBIAS = false;
    __device__ __forceinline__ void pre(const Unit&, int, int, PreNone&) const {}
    const bf16* X2B; const bf16* GT; float* O; float* rowss; unsigned* pcnt; const float* fg; const unsigned* ctl;
    __device__ __forceinline__ void operator()(f32x4 (&acc)[2][2][4][2], const Unit& u, int wr, int wc, int fr, int fq, const Pre& P) const {
        const int rowb = u.pm * 256 + wr * 64 + fr, c0 = u.pn * 256 + wc * 32 + 8 * fq;
#pragma unroll
        for (int ai = 0; ai < 2; ++ai)
#pragma unroll
            for (int m = 0; m < 4; ++m) { const int row = rowb + ai * 128 + m * 16; float ss = 0.f;
#pragma unroll
                for (int bj = 0; bj < 2; ++bj) { const size_t off = (size_t)row * D + c0 + bj * 128;
                    const u32x4 xv = *(const u32x4*)(X2B + off), gv = *(const u32x4*)(GT + off); f32x4 a0 = acc[ai][bj][m][0], a1 = acc[ai][bj][m][1];
                    a0[0] = bflo(xv.x) + bflo(gv.x) * a0[0]; a0[1] = bfhi(xv.x) + bfhi(gv.x) * a0[1]; a0[2] = bflo(xv.y) + bflo(gv.y) * a0[2]; a0[3] = bfhi(xv.y) + bfhi(gv.y) * a0[3];
                    a1[0] = bflo(xv.z) + bflo(gv.z) * a1[0]; a1[1] = bfhi(xv.z) + bfhi(gv.z) * a1[1]; a1[2] = bflo(xv.w) + bflo(gv.w) * a1[2]; a1[3] = bfhi(xv.w) + bfhi(gv.w) * a1[3];
#pragma unroll
                    for (int j = 0; j < 4; ++j) ss += a0[j] * a0[j] + a1[j] * a1[j];
                    acc[ai][bj][m][0] = a0; acc[ai][bj][m][1] = a1; }
                ss += __shfl_xor(ss, 16); ss += __shfl_xor(ss, 32);
                if (fq == 0) atomicAdd(rowss + row, ss);
                asm volatile("" ::: "memory"); }
        asm volatile("s_waitcnt vmcnt(0)" ::: "memory");
        __builtin_amdgcn_s_barrier();
        if (wr == 0 && wc == 0) {
            unsigned* pc = pcnt + 64 * u.pm;
            if (fr == 0 && fq == 0) __hip_atomic_fetch_add(pc, 1u, RLX_AGENT);
            unsigned spins = 0; while ((unsigned)__builtin_amdgcn_readfirstlane(__hip_atomic_load(pc, RLX_AGENT)) < 4u && ++spins < (1u << 20)) __builtin_amdgcn_s_sleep(4);
        }
        asm volatile("s_waitcnt vmcnt(0)" ::: "memory");
        __builtin_amdgcn_s_barrier();
        asm volatile("" ::: "memory");
#pragma unroll
        for (int ai = 0; ai < 2; ++ai)
#pragma unroll
            for (int m = 0; m < 4; ++m) { const int row = rowb + ai * 128 + m * 16; const float rs = 1.0f / sqrtf(__hip_atomic_load(rowss + row, RLX_AGENT) * (1.f / D) + RMS_EPS);
#pragma unroll
                for (int bj = 0; bj < 2; ++bj) { const size_t off = (size_t)row * D + c0 + bj * 128;
                    f32x4 o0 = acc[ai][bj][m][0] * rs * *(const f32x4*)(fg + c0 + bj * 128), o1 = acc[ai][bj][m][1] * rs * *(const f32x4*)(fg + c0 + bj * 128 + 4);
                    if (TS_PROBE >= 0 && row == 0 && c0 == 0 && bj == 0) { const unsigned long long* ts = (const unsigned long long*)(ctl + 2048); const unsigned long long dt = ts[TS_END_SLOT] - ts[TS_PROBE]; o0[0] += (float)((dt + 300) / 1600) * 4.f; }
                    *(f32x4*)(O + off) = o0; *(f32x4*)(O + off + 4) = o1; }
                asm volatile("" ::: "memory"); }
    }
};

__device__ __forceinline__ void build_alora(const Args& args, Frame& F, int pm) {
    const bf16* ZR = WSP(bf16, WS_ZR); bf16* AL = WSP(bf16, WS_ALORA); const float* mu = FIN(4) + 1536;
#pragma unroll 1
    for (int half = 0; half < 2; ++half) {
        u32x4 zc[8], zp[8];
#pragma unroll
        for (int i = 0; i < 8; ++i) {
            const int id = F.tid + 512 * (8 * half + i), row = pm * 256 + (id >> 5), cc = (id & 31) * 8;
            zc[i] = *(const u32x4*)(ZR + (size_t)row * RWC + 1536 + cc);
            zp[i] = (u32x4){0u, 0u, 0u, 0u}; if ((row & (SEQ - 1)) != 0) zp[i] = *(const u32x4*)(ZR + (size_t)(row - 1) * RWC + 1536 + cc);
        }
#pragma unroll
        for (int i = 0; i < 8; ++i) {
            const int id = F.tid + 512 * (8 * half + i), row = pm * 256 + (id >> 5), cc = (id & 31) * 8;
            const unsigned zcw[4] = {zc[i].x, zc[i].y, zc[i].z, zc[i].w}, zpw[4] = {zp[i].x, zp[i].y, zp[i].z, zp[i].w}; float o[8];
#pragma unroll
            for (int j = 0; j < 8; ++j) { const float c = (j & 1) ? bfhi(zcw[j >> 1]) : bflo(zcw[j >> 1]), p = (j & 1) ? bfhi(zpw[j >> 1]) : bflo(zpw[j >> 1]);
                const float xs = c + mu[cc + j] * (p - c);
                o[j] = cc < 64 ? (1.f - 2.f * __builtin_amdgcn_rcpf(1.f + __expf(2.f * xs))) : (cc < 128 ? xs : sigm(xs)); }
            u32x4 w; w.x = pk2(o[0], o[1]); w.y = pk2(o[2], o[3]); w.z = pk2(o[4], o[5]); w.w = pk2(o[6], o[7]);
            *(u32x4*)(AL + (size_t)row * LORA_K + cc) = w;
        }
    }
}

__device__ __forceinline__ void scan_unit(const Args& args, Frame& F, int bh) {
    const int b = bh >> 3, h = bh & 7, tid = F.tid;
    LAS float* LW = (LAS float*)F.lds;
    LAS float* LKK = LW + 4096, *LBB = LW + 8192, *LKP = LW + 12288, *LRR = LW + 16384, *LVV = LW + 20480, *LYY = LW + 24576, *LBON = LW + 28672;
    const bf16* ZR = WSP(bf16, WS_ZR); const bf16* DEC = WSP(bf16, WS_DEC); const bf16* AA = WSP(bf16, WS_AA); const bf16* GG = WSP(bf16, WS_GG); bf16* YB = WSP(bf16, WS_YB);
    const float* mu = FIN(4); const float* k_k = FIN(10) + h * 64; const float* k_a = FIN(11) + h * 64; const float* r_k = FIN(12) + h * 64;
    const float* lnw = FIN(13) + h * 64; const float* lnb = FIN(14) + h * 64;
    const int tt_p = tid >> 3, j0 = 8 * (tid & 7);
    const int row = tid >> 3, cg = tid & 7;
    float S[8];
#pragma unroll
    for (int j = 0; j < 8; ++j) S[j] = 0.f;
    float mur[8], muk[8], muv[8], kk_c[8], ka_c[8], rk_c[8];
#pragma unroll
    for (int j = 0; j < 8; ++j) { mur[j] = mu[h * 64 + j0 + j]; muk[j] = mu[512 + h * 64 + j0 + j]; muv[j] = mu[1024 + h * 64 + j0 + j]; kk_c[j] = k_k[j0 + j]; ka_c[j] = k_a[j0 + j]; rk_c[j] = r_k[j0 + j]; }
    for (int c0 = 0; c0 < SEQ; c0 += 64) {
        __syncthreads();
        {
            const size_t tok = (size_t)b * SEQ + c0 + tt_p; const bool first = (c0 + tt_p) == 0;
            const bf16* zc = ZR + tok * RWC + h * 64 + j0; const bf16* zp = zc - RWC;
            u32x4 cr = *(const u32x4*)zc, ck = *(const u32x4*)(zc + 512), cv = *(const u32x4*)(zc + 1024);
            u32x4 pr = (u32x4){0u, 0u, 0u, 0u}, pk = pr, pv = pr;
            if (!first) { pr = *(const u32x4*)zp; pk = *(const u32x4*)(zp + 512); pv = *(const u32x4*)(zp + 1024); }
            const f32x4 d0 = *(const f32x4*)(DEC + tok * 512 + h * 64 + j0), d1 = *(const f32x4*)(DEC + tok * 512 + h * 64 + j0 + 4);
            const f32x4 a0 = *(const f32x4*)(AA + tok * 512 + h * 64 + j0), a1 = *(const f32x4*)(AA + tok * 512 + h * 64 + j0 + 4);
            const unsigned crw[4] = {cr.x, cr.y, cr.z, cr.w}, ckw[4] = {ck.x, ck.y, ck.z, ck.w}, cvw[4] = {cv.x, cv.y, cv.z, cv.w};
            const unsigned prw[4] = {pr.x, pr.y, pr.z, pr.w}, pkw[4] = {pk.x, pk.y, pk.z, pk.w}, pvw[4] = {pv.x, pv.y, pv.z, pv.w};
            float r[8], k[8], v[8], kk[8], a[8], dec[8]; float ss = 0.f;
#pragma unroll
            for (int j = 0; j < 8; ++j) {
                const float rc = (j & 1) ? bfhi(crw[j >> 1]) : bflo(crw[j >> 1]), rp = (j & 1) ? bfhi(prw[j >> 1]) : bflo(prw[j >> 1]);
                const float kc = (j & 1) ? bfhi(ckw[j >> 1]) : bflo(ckw[j >> 1]), kp = (j & 1) ? bfhi(pkw[j >> 1]) : bflo(pkw[j >> 1]);
                const float vc = (j & 1) ? bfhi(cvw[j >> 1]) : bflo(cvw[j >> 1]), vp = (j & 1) ? bfhi(pvw[j >> 1]) : bflo(pvw[j >> 1]);
                r[j] = rc + mur[j] * (rp - rc); k[j] = kc + muk[j] * (kp - kc); v[j] = vc + muv[j] * (vp - vc);
                kk[j] = k[j] * kk_c[j]; ss += kk[j] * kk[j];
                a[j] = j < 4 ? a0[j] : a1[j - 4]; dec[j] = j < 4 ? d0[j] : d1[j - 4];
            }
            ss = red8(ss);
            const float inv = 1.0f / fmaxf(sqrtf(ss), 1e-12f);
            float bon = 0.f; float kpv[8], bbv[8];
#pragma unroll
            for (int j = 0; j < 8; ++j) { kk[j] *= inv; bbv[j] = kk[j] * a[j]; kpv[j] = k[j] * (1.f + (a[j] - 1.f) * ka_c[j]); bon += r[j] * kpv[j] * rk_c[j]; }
            bon = red8(bon);
            const int o = tt_p * 64 + j0;
            *(LAS f32x4*)(LW + o) = (f32x4){dec[0], dec[1], dec[2], dec[3]}; *(LAS f32x4*)(LW + o + 4) = (f32x4){dec[4], dec[5], dec[6], dec[7]};
            *(LAS f32x4*)(LKK + o) = (f32x4){kk[0], kk[1], kk[2], kk[3]}; *(LAS f32x4*)(LKK + o + 4) = (f32x4){kk[4], kk[5], kk[6], kk[7]};
            *(LAS f32x4*)(LBB + o) = (f32x4){bbv[0], bbv[1], bbv[2], bbv[3]}; *(LAS f32x4*)(LBB + o + 4) = (f32x4){bbv[4], bbv[5], bbv[6], bbv[7]};
            *(LAS f32x4*)(LKP + o) = (f32x4){kpv[0], kpv[1], kpv[2], kpv[3]}; *(LAS f32x4*)(LKP + o + 4) = (f32x4){kpv[4], kpv[5], kpv[6], kpv[7]};
            *(LAS f32x4*)(LRR + o) = (f32x4){r[0], r[1], r[2], r[3]}; *(LAS f32x4*)(LRR + o + 4) = (f32x4){r[4], r[5], r[6], r[7]};
            *(LAS f32x4*)(LVV + o) = (f32x4){v[0], v[1], v[2], v[3]}; *(LAS f32x4*)(LVV + o + 4) = (f32x4){v[4], v[5], v[6], v[7]};
            if ((tid & 7) == 0) LBON[tt_p] = bon;
        }
        __syncthreads();
#pragma unroll 2
        for (int tt = 0; tt < 64; ++tt) {
            const int o = tt * 64 + 8 * cg;
            const f32x4 k0 = *(const LAS f32x4*)(LKK + o), k1 = *(const LAS f32x4*)(LKK + o + 4);
            const f32x4 w0 = *(const LAS f32x4*)(LW + o), w1 = *(const LAS f32x4*)(LW + o + 4);
            const f32x4 b0 = *(const LAS f32x4*)(LBB + o), b1 = *(const LAS f32x4*)(LBB + o + 4);
            const f32x4 p0 = *(const LAS f32x4*)(LKP + o), p1 = *(const LAS f32x4*)(LKP + o + 4);
            const f32x4 r0 = *(const LAS f32x4*)(LRR + o), r1 = *(const LAS f32x4*)(LRR + o + 4);
            const float vi = LVV[tt * 64 + row];
            float sa = (S[0] * k0[0] + S[1] * k0[1]) + (S[2] * k0[2] + S[3] * k0[3]) + (S[4] * k1[0] + S[5] * k1[1]) + (S[6] * k1[2] + S[7] * k1[3]);
            sa = -red8(sa);
#pragma unroll
            for (int j = 0; j < 4; ++j) { S[j] = S[j] * w0[j] + (sa * b0[j] + vi * p0[j]); S[4 + j] = S[4 + j] * w1[j] + (sa * b1[j] + vi * p1[j]); }
            float y = (S[0] * r0[0] + S[1] * r0[1]) + (S[2] * r0[2] + S[3] * r0[3]) + (S[4] * r1[0] + S[5] * r1[1]) + (S[6] * r1[2] + S[7] * r1[3]);
            y = red8(y);
            if (cg == 0) LYY[tt * 64 + row] = y;
        }
        __syncthreads();
        {
            const size_t tok = (size_t)b * SEQ + c0 + tt_p; const int o = tt_p * 64 + j0;
            const f32x4 y0 = *(const LAS f32x4*)(LYY + o), y1 = *(const LAS f32x4*)(LYY + o + 4);
            const f32x4 v0 = *(const LAS f32x4*)(LVV + o), v1 = *(const LAS f32x4*)(LVV + o + 4);
            float s = (y0[0] + y0[1]) + (y0[2] + y0[3]) + (y1[0] + y1[1]) + (y1[2] + y1[3]);
            const float mean = red8(s) * (1.f / 64.f); float q = 0.f;
#pragma unroll
            for (int j = 0; j < 4; ++j) { const float d0 = y0[j] - mean, d1 = y1[j] - mean; q += d0 * d0 + d1 * d1; }
            const float rs = 1.0f / sqrtf(red8(q) * (1.f / 64.f) + GN_EPS); const float bon = LBON[tt_p];
            const u32x4 gv = *(const u32x4*)(GG + tok * 512 + h * 64 + j0); const unsigned gw[4] = {gv.x, gv.y, gv.z, gv.w}; float ov[8];
#pragma unroll
            for (int j = 0; j < 8; ++j) { const float yy = j < 4 ? y0[j] : y1[j - 4], vv = j < 4 ? v0[j] : v1[j - 4]; const float g = (j & 1) ? bfhi(gw[j >> 1]) : bflo(gw[j >> 1]);
                ov[j] = ((yy - mean) * rs * lnw[j0 + j] + lnb[j0 + j] + bon * vv) * g; }
            u32x4 w; w.x = pk2(ov[0], ov[1]); w.y = pk2(ov[2], ov[3]); w.z = pk2(ov[4], ov[5]); w.w = pk2(ov[6], ov[7]);
            *(u32x4*)(YB + tok * 512 + h * 64 + j0) = w;
        }
    }
    __syncthreads();
}

constexpr int LDA = 72, LDT = 40, LDF = 36;
constexpr int SC_WF = 0, SC_AT = 8192, SC_RT = SC_AT + 4608, SC_BT = SC_RT + 4608, SC_KT = SC_BT + 4608;
constexpr int SC_BCT = SC_KT + 4608, SC_KCT = SC_BCT + 5120, SC_VT = SC_KCT + 5120, SC_AHT = SC_VT + 5120, SC_UHT = SC_AHT + 5120;
constexpr int SC_AAB = SC_UHT + 5120, SC_ARB = SC_AAB + 4608, SC_ARK = SC_ARB + 2560, SC_RHS2 = SC_ARK + 2560, SC_YF = SC_RHS2 + 16384, SC_HT = SC_YF + 8192, SC_BON = SC_HT + 9216;
static_assert(SC_BON + 128 + 2048 <= RING_BYTES, "scan LDS map");
__device__ __forceinline__ float red16(float v) { v += dppf<0xB1>(v); v += dppf<0x4E>(v); v += dppf<0x141>(v); v += dppf<0x140>(v); return v; }
__device__ __forceinline__ bf16x8 ld16(const LAS bf16* p) { return *(const LAS bf16x8*)p; }
__device__ __forceinline__ bf16x8 ld8x2(const LAS bf16* p) { const u32x2 lo = *(const LAS u32x2*)p, hi = *(const LAS u32x2*)(p + 8); const u32x4 w = (u32x4){lo.x, lo.y, hi.x, hi.y}; return __builtin_bit_cast(bf16x8, w); }
__device__ __forceinline__ bf16x8 packq(const f32x16& x, int q) { u32x4 w; w.x = pk2(x[8 * q], x[8 * q + 1]); w.y = pk2(x[8 * q + 2], x[8 * q + 3]); w.z = pk2(x[8 * q + 4], x[8 * q + 5]); w.w = pk2(x[8 * q + 6], x[8 * q + 7]); return __builtin_bit_cast(bf16x8, w); }
#define MFMA32(a, b, c) __builtin_amdgcn_mfma_f32_32x32x16_bf16((a), (b), (c), 0, 0, 0)
struct ScanLoad { u32x2 cr, ck, cv, pr, pk, pv, g, decb, etab; f32x4 dec, eta; };
__device__ __forceinline__ void scan_load(ScanLoad& L, const bf16* ZR, const bf16* DEC, const bf16* AA, const bf16* GG, size_t tok, int hc, bool first) {
    const bf16* zc = ZR + tok * RWC + hc; const bf16* zp = zc - RWC;
    L.cr = *(const u32x2*)zc; L.ck = *(const u32x2*)(zc + 512); L.cv = *(const u32x2*)(zc + 1024);
    L.pr = (u32x2){0u, 0u}; L.pk = L.pr; L.pv = L.pr;
    if (!first) { L.pr = *(const u32x2*)zp; L.pk = *(const u32x2*)(zp + 512); L.pv = *(const u32x2*)(zp + 1024); }
    L.decb = *(const u32x2*)(DEC + tok * 512 + hc); L.etab = *(const u32x2*)(AA + tok * 512 + hc); L.g = *(const u32x2*)(GG + tok * 512 + hc);
}
#define LBAR() do { asm volatile("s_waitcnt lgkmcnt(0)" ::: "memory"); __builtin_amdgcn_s_barrier(); asm volatile("" ::: "memory"); } while (0)
typedef short v4i16_t __attribute__((ext_vector_type(4)));
__device__ __forceinline__ bf16x8 trfrag(const LAS bf16* X, int k0a, int k0b, int cbase, int lane) {
    const int g = lane >> 4, i = lane & 15, col = cbase + 16 * (g & 1) + 4 * (i & 3), rq = i >> 2;
    const v4i16_t lo = __builtin_amdgcn_ds_read_tr16_b64_v4i16((LAS v4i16_t*)(X + (k0a + rq) * LDA + col));
    const v4i16_t hi = __builtin_amdgcn_ds_read_tr16_b64_v4i16((LAS v4i16_t*)(X + (k0b + rq) * LDA + col));
    return (bf16x8){lo[0], lo[1], lo[2], lo[3], hi[0], hi[1], hi[2], hi[3]};
}
__device__ __forceinline__ void scan_unit_chunked(const Args& args, Frame& F, int bh) {
    const int b = bh >> 3, h = bh & 7, tid = F.tid, w = F.wave;
    LAS unsigned char* L = F.lds;
    LAS float* WF = (LAS float*)(L + SC_WF); LAS float* AAB = (LAS float*)(L + SC_AAB); LAS float* RHS2 = (LAS float*)(L + SC_RHS2); LAS float* YF = (LAS float*)(L + SC_YF); LAS float* BON = (LAS float*)(L + SC_BON);
    LAS bf16* AT = (LAS bf16*)(L + SC_AT); LAS bf16* RT = (LAS bf16*)(L + SC_RT); LAS bf16* BT = (LAS bf16*)(L + SC_BT); LAS bf16* KT = (LAS bf16*)(L + SC_KT);
    LAS bf16* BCT = (LAS bf16*)(L + SC_BCT); LAS bf16* KCT = (LAS bf16*)(L + SC_KCT); LAS bf16* VT = (LAS bf16*)(L + SC_VT); LAS bf16* AHT = (LAS bf16*)(L + SC_AHT); LAS bf16* UHT = (LAS bf16*)(L + SC_UHT);
    LAS bf16* ARB = (LAS bf16*)(L + SC_ARB); LAS bf16* ARK = (LAS bf16*)(L + SC_ARK); LAS bf16* HT = (LAS bf16*)(L + SC_HT);
    const bf16* ZR = WSP(bf16, WS_ZR); const bf16* DEC = WSP(bf16, WS_DEC); const bf16* AA = WSP(bf16, WS_AA); const bf16* GG = WSP(bf16, WS_GG); bf16* YB = WSP(bf16, WS_YB);
    const int t = tid >> 4, j0 = 4 * (tid & 15), hc = h * 64 + j0;
    LAS float* CST = (LAS float*)(L + SC_BON + 128);
    { const int c = tid >> 6, j = tid & 63; const float* src = c == 0 ? FIN(4) : c == 1 ? FIN(4) + 512 : c == 2 ? FIN(4) + 1024 : c == 3 ? FIN(10) : c == 4 ? FIN(11) : c == 5 ? FIN(12) : c == 6 ? FIN(13) : FIN(14);
      CST[c * 64 + j] = src[h * 64 + j]; }
    for (int i = tid; i < 64 * LDA / 2; i += 512) ((LAS unsigned*)HT)[i] = 0u;
    ScanLoad cur; scan_load(cur, ZR, DEC, AA, GG, (size_t)b * SEQ + t, hc, t == 0);
    LBAR();
    u32x2 pend = (u32x2){0u, 0u};
    for (int c0 = 0; c0 < SEQ; c0 += 32) {
        const size_t tok = (size_t)b * SEQ + c0 + t;
        float r[4], kp[4], v[4], al[4], be[4], gq[4]; f32x4 gl, gpl;
        {
            cur.dec = (f32x4){__expf(-bflo(cur.decb.x)), __expf(-bfhi(cur.decb.x)), __expf(-bflo(cur.decb.y)), __expf(-bfhi(cur.decb.y))};
            cur.eta = (f32x4){bflo(cur.etab.x), bfhi(cur.etab.x), bflo(cur.etab.y), bfhi(cur.etab.y)};
            const f32x4 mur = *(const LAS f32x4*)(CST + j0), muk = *(const LAS f32x4*)(CST + 64 + j0), muv = *(const LAS f32x4*)(CST + 128 + j0), kkc = *(const LAS f32x4*)(CST + 192 + j0), kac = *(const LAS f32x4*)(CST + 256 + j0), rkc = *(const LAS f32x4*)(CST + 320 + j0);
            const unsigned crw[2] = {cur.cr.x, cur.cr.y}, ckw[2] = {cur.ck.x, cur.ck.y}, cvw[2] = {cur.cv.x, cur.cv.y}, prw[2] = {cur.pr.x, cur.pr.y}, pkw[2] = {cur.pk.x, cur.pk.y}, pvw[2] = {cur.pv.x, cur.pv.y}, gw2[2] = {cur.g.x, cur.g.y};
            float k[4], kk[4]; float ss = 0.f;
#pragma unroll
            for (int j = 0; j < 4; ++j) {
                const float rc = (j & 1) ? bfhi(crw[j >> 1]) : bflo(crw[j >> 1]), rp = (j & 1) ? bfhi(prw[j >> 1]) : bflo(prw[j >> 1]);
                const float kc = (j & 1) ? bfhi(ckw[j >> 1]) : bflo(ckw[j >> 1]), kq = (j & 1) ? bfhi(pkw[j >> 1]) : bflo(pkw[j >> 1]);
                const float vc = (j & 1) ? bfhi(cvw[j >> 1]) : bflo(cvw[j >> 1]), vq = (j & 1) ? bfhi(pvw[j >> 1]) : bflo(pvw[j >> 1]);
                r[j] = rc + mur[j] * (rp - rc); k[j] = kc + muk[j] * (kq - kc); v[j] = vc + muv[j] * (vq - vc);
                kk[j] = k[j] * kkc[j]; ss += kk[j] * kk[j]; gq[j] = (j & 1) ? bfhi(gw2[j >> 1]) : bflo(gw2[j >> 1]);
            }
            ss = red16(ss);
            const float inv = __builtin_amdgcn_rsqf(fmaxf(ss, 1e-24f)); float bon = 0.f;
#pragma unroll
            for (int j = 0; j < 4; ++j) { kk[j] *= inv; al[j] = -kk[j]; be[j] = kk[j] * cur.eta[j]; kp[j] = k[j] * (1.f + (cur.eta[j] - 1.f) * kac[j]); bon += r[j] * kp[j] * rkc[j]; }
            bon = red16(bon);
            gl = cur.dec; gpl = (f32x4){1.f, 1.f, 1.f, 1.f};
            { const int ln = tid & 63;
#pragma unroll
              for (int j = 0; j < 4; ++j) { const float u1 = __shfl_up(gl[j], 16); gl[j] = (ln >= 16) ? gl[j] * u1 : gl[j]; }
#pragma unroll
              for (int j = 0; j < 4; ++j) { const float u2 = __shfl_up(gl[j], 32); gl[j] = (ln >= 32) ? gl[j] * u2 : gl[j]; }
#pragma unroll
              for (int j = 0; j < 4; ++j) { const float u3 = __shfl_up(gl[j], 16); gpl[j] = (ln >= 16) ? u3 : 1.f; }
              if (ln >= 48) *(LAS f32x4*)(WF + w * 64 + j0) = gl; }
            if ((tid & 15) == 0) BON[t] = bon;
        }
        if (c0 + 32 < SEQ && !(SCAN_STUB & 32)) scan_load(cur, ZR, DEC, AA, GG, tok + 32, hc, false);
        if (c0 > 0) { const bf16* yp = YB + (tok - 32) * 512 + hc; asm volatile("global_store_dwordx2 %0, %1, off" :: "v"(yp), "v"(pend) : "memory"); }
        LBAR();
        {
            f32x4 pre = (f32x4){1.f, 1.f, 1.f, 1.f}, gC = pre;
#pragma unroll
            for (int ww = 0; ww < 8; ++ww) { const f32x4 wt = *(const LAS f32x4*)(WF + ww * 64 + j0); gC = gC * wt; if (ww < w) pre = pre * wt; }
            const f32x4 gt = pre * gl, gp = pre * gpl;
            if (t == 31) *(LAS f32x4*)(WF + 512 + j0) = gC;
            float a_[4], r_[4], b_[4], k_[4], bc[4], kc[4];
#pragma unroll
            for (int j = 0; j < 4; ++j) { const float ig = __builtin_amdgcn_rcpf(gt[j]); a_[j] = al[j] * gp[j]; r_[j] = r[j] * gt[j]; b_[j] = be[j] * ig; k_[j] = kp[j] * ig; bc[j] = b_[j] * gC[j]; kc[j] = k_[j] * gC[j]; }
            u32x2 wv; wv.x = pk2(a_[0], a_[1]); wv.y = pk2(a_[2], a_[3]); *(LAS u32x2*)(AT + t * LDA + j0) = wv;
            wv.x = pk2(r_[0], r_[1]); wv.y = pk2(r_[2], r_[3]); *(LAS u32x2*)(RT + t * LDA + j0) = wv;
            wv.x = pk2(b_[0], b_[1]); wv.y = pk2(b_[2], b_[3]); *(LAS u32x2*)(BT + t * LDA + j0) = wv;
            wv.x = pk2(k_[0], k_[1]); wv.y = pk2(k_[2], k_[3]); *(LAS u32x2*)(KT + t * LDA + j0) = wv;
            wv.x = pk2(bc[0], bc[1]); wv.y = pk2(bc[2], bc[3]); *(LAS u32x2*)(BCT + t * LDA + j0) = wv;
            wv.x = pk2(kc[0], kc[1]); wv.y = pk2(kc[2], kc[3]); *(LAS u32x2*)(KCT + t * LDA + j0) = wv;
            wv.x = pk2(v[0], v[1]); wv.y = pk2(v[2], v[3]); *(LAS u32x2*)(VT + t * LDA + j0) = wv;
        }
        LBAR();
        if (w < 4 && !(SCAN_STUB & 1)) {
            const int lane = lane_now(), r32 = lane & 31, hh = lane >> 5;
            f32x16 mT, mN;
#pragma unroll
            for (int i = 0; i < 16; ++i) { mT[i] = 0.f; mN[i] = 0.f; }
#pragma unroll
            for (int q = 0; q < 4; ++q) { const bf16x8 bfr = ld16(BT + r32 * LDA + 8 * hh + 16 * q), afr = ld16(AT + r32 * LDA + 8 * hh + 16 * q);
                mT = MFMA32(bfr, afr, mT);
                mN = MFMA32(afr, bfr, mN); }
#pragma unroll
            for (int i = 0; i < 16; ++i) { const int c_ = crow(i, hh); mT[i] = (c_ < r32) ? mT[i] : 0.f; mN[i] = (r32 < c_) ? mN[i] : 0.f; }
            f32x16 X;
            if (w < 2) {
#pragma unroll
                for (int i = 0; i < 16; ++i) X[i] = bflo((unsigned)AT[crow(i, hh) * LDA + 32 * w + r32]);
            } else {
                f32x16 kT;
#pragma unroll
                for (int i = 0; i < 16; ++i) { kT[i] = 0.f; X[i] = 0.f; }
#pragma unroll
                for (int q = 0; q < 4; ++q) kT = MFMA32(ld16(KT + r32 * LDA + 8 * hh + 16 * q), ld16(AT + r32 * LDA + 8 * hh + 16 * q), kT);
#pragma unroll
                for (int i = 0; i < 16; ++i) kT[i] = (crow(i, hh) < r32) ? kT[i] : 0.f;
#pragma unroll
                for (int q = 0; q < 2; ++q) X = MFMA32(packq(kT, q), trfrag(VT, 16 * q + 4 * hh, 16 * q + 8 + 4 * hh, 32 * (w - 2), lane), X);
            }
#pragma unroll
            for (int k = 0; k < 5; ++k) {
                const bf16x8 t0 = packq(mT, 0), t1 = packq(mT, 1), x0 = packq(X, 0), x1 = packq(X, 1);
                X = MFMA32(t0, x0, X); X = MFMA32(t1, x1, X);
                if (k < 4) {
                    const bf16x8 n0 = packq(mN, 0), n1 = packq(mN, 1);
                    f32x16 zT, zN;
#pragma unroll
                    for (int i = 0; i < 16; ++i) { zT[i] = 0.f; zN[i] = 0.f; }
                    zT = MFMA32(n0, t0, zT); zT = MFMA32(n1, t1, zT);
                    zN = MFMA32(t0, n0, zN); zN = MFMA32(t1, n1, zN);
                    mT = zT; mN = zN;
                }
            }
            LAS bf16* dst = ((w < 2) ? AHT : UHT) + (32 * (w & 1) + r32) * LDT + 4 * hh;
#pragma unroll
            for (int i4 = 0; i4 < 4; ++i4) { u32x2 wv; wv.x = pk2(X[4 * i4], X[4 * i4 + 1]); wv.y = pk2(X[4 * i4 + 2], X[4 * i4 + 3]); *(LAS u32x2*)(dst + 8 * i4) = wv; }
        } else if (w < 6 && !(SCAN_STUB & 1)) {
            const int lane = lane_now(), r32 = lane & 31, hh = lane >> 5;
            const LAS bf16* Aop = ((w & 1) ? KT : BT) + r32 * LDA + 8 * hh; const LAS bf16* Bop = RT + r32 * LDA + 8 * hh;
            f32x16 x;
#pragma unroll
            for (int i = 0; i < 16; ++i) x[i] = 0.f;
#pragma unroll
            for (int q = 0; q < 4; ++q) x = MFMA32(ld16(Aop + 16 * q), ld16(Bop + 16 * q), x);
#pragma unroll
            for (int i = 0; i < 16; ++i) x[i] = (crow(i, hh) <= r32) ? x[i] : 0.f;
            LAS bf16* dst = ((w & 1) ? ARK : ARB) + r32 * LDT + 4 * hh;
#pragma unroll
            for (int i4 = 0; i4 < 4; ++i4) { u32x2 wv; wv.x = pk2(x[4 * i4], x[4 * i4 + 1]); wv.y = pk2(x[4 * i4 + 2], x[4 * i4 + 3]); *(LAS u32x2*)(dst + 8 * i4) = wv; }
        }
        LBAR();
        f32x16 hn;
        if (SCAN_STUB & 4) { for (int i = 0; i < 16; ++i) hn[i] = 0.f; } else if (w < 4) {
            const int lane = lane_now(), r32 = lane & 31, hh = lane >> 5;
            const int jb = w >> 1, ib = w & 1;
            f32x16 pt[2];
#pragma unroll
            for (int a = 0; a < 2; ++a) {
#pragma unroll
                for (int i = 0; i < 16; ++i) pt[a][i] = 0.f;
#pragma unroll
                for (int q = 0; q < 2; ++q) pt[a] = MFMA32(ld16(AHT + (32 * a + r32) * LDT + 16 * q + 8 * hh), trfrag(BCT, 16 * q + 8 * hh, 16 * q + 8 * hh + 4, 32 * jb, lane), pt[a]);
            }
            { const float gC = WF[512 + 32 * jb + r32];
#pragma unroll
              for (int i = 0; i < 16; ++i) { const float add = (crow(i, hh) == r32) ? gC : 0.f; pt[0][i] += (jb == 0) ? add : 0.f; pt[1][i] += (jb == 0) ? 0.f : add; } }
#pragma unroll
            for (int i = 0; i < 16; ++i) hn[i] = 0.f;
#pragma unroll
            for (int q = 0; q < 2; ++q) {
                hn = MFMA32(trfrag(BCT, 16 * q + 8 * hh, 16 * q + 8 * hh + 4, 32 * jb, lane), ld16(UHT + (32 * ib + r32) * LDT + 16 * q + 8 * hh), hn);
                hn = MFMA32(trfrag(KCT, 16 * q + 8 * hh, 16 * q + 8 * hh + 4, 32 * jb, lane), trfrag(VT, 16 * q + 8 * hh, 16 * q + 8 * hh + 4, 32 * ib, lane), hn);
            }
#pragma unroll
            for (int a = 0; a < 2; ++a)
#pragma unroll
                for (int q = 0; q < 2; ++q) hn = MFMA32(packq(pt[a], q), ld8x2(HT + (32 * ib + r32) * LDA + 32 * a + 16 * q + 4 * hh), hn);
        } else if (w < 6) {
            const int lane = lane_now(), r32 = lane & 31, hh = lane >> 5;
            const int ib = w & 1;
            f32x16 rt[2];
#pragma unroll
            for (int a = 0; a < 2; ++a) {
#pragma unroll
                for (int i = 0; i < 16; ++i) rt[a][i] = bflo((unsigned)RT[r32 * LDA + 32 * a + crow(i, hh)]);
#pragma unroll
                for (int q = 0; q < 2; ++q) rt[a] = MFMA32(ld16(AHT + (32 * a + r32) * LDT + 16 * q + 8 * hh), ld16(ARB + r32 * LDT + 16 * q + 8 * hh), rt[a]);
            }
            f32x16 y;
#pragma unroll
            for (int i = 0; i < 16; ++i) y[i] = 0.f;
#pragma unroll
            for (int q = 0; q < 2; ++q) {
                y = MFMA32(ld16(ARB + r32 * LDT + 16 * q + 8 * hh), ld16(UHT + (32 * ib + r32) * LDT + 16 * q + 8 * hh), y);
                y = MFMA32(ld16(ARK + r32 * LDT + 16 * q + 8 * hh), trfrag(VT, 16 * q + 8 * hh, 16 * q + 8 * hh + 4, 32 * ib, lane), y);
            }
#pragma unroll
            for (int a = 0; a < 2; ++a)
#pragma unroll
                for (int q = 0; q < 2; ++q) y = MFMA32(packq(rt[a], q), ld8x2(HT + (32 * ib + r32) * LDA + 32 * a + 16 * q + 4 * hh), y);
#pragma unroll
            for (int i = 0; i < 16; ++i) YF[crow(i, hh) * 64 + 32 * ib + r32] = y[i];
        }
        LBAR();
        if (w < 4) {
            const int lane = lane_now(), r32 = lane & 31, hh = lane >> 5;
            const int jb = w >> 1, ib = w & 1; LAS bf16* dst = HT + (32 * ib + r32) * LDA + 32 * jb + 4 * hh;
#pragma unroll
            for (int i4 = 0; i4 < 4; ++i4) { u32x2 wv; wv.x = pk2(hn[4 * i4], hn[4 * i4 + 1]); wv.y = pk2(hn[4 * i4 + 2], hn[4 * i4 + 3]); *(LAS u32x2*)(dst + 8 * i4) = wv; }
        }
        {
            const f32x4 y4 = *(const LAS f32x4*)(YF + t * 64 + j0);
            const float mean = red16((y4[0] + y4[1]) + (y4[2] + y4[3])) * (1.f / 64.f); float qv = 0.f;
#pragma unroll
            for (int j = 0; j < 4; ++j) { const float d = y4[j] - mean; qv += d * d; }
            const float rs = __builtin_amdgcn_rsqf(red16(qv) * (1.f / 64.f) + GN_EPS); const float bon = BON[t]; float ov[4];
            const f32x4 lnw = *(const LAS f32x4*)(CST + 384 + j0), lnb = *(const LAS f32x4*)(CST + 448 + j0);
#pragma unroll
            for (int j = 0; j < 4; ++j) ov[j] = ((y4[j] - mean) * rs * lnw[j] + lnb[j] + bon * v[j]) * gq[j];
            pend.x = pk2(ov[0], ov[1]); pend.y = pk2(ov[2], ov[3]);
        }
    }
    *(u32x2*)(YB + ((size_t)b * SEQ + SEQ - 32 + t) * 512 + hc) = pend;
}

__device__ __forceinline__ bool attn_step(const bf16x8 (&qf)[4], const bf16x8 (&kf)[4], const u32x2 (&vlo)[2][2], const u32x2 (&vhi)[2][2], f32x16& y0, f32x16& y1, float& carry, int s0, int t0, int q, int hi) {
    f32x16 p;
#pragma unroll
    for (int r = 0; r < 16; ++r) p[r] = 0.f;
#pragma unroll
    for (int d0 = 0; d0 < 4; ++d0) p = __builtin_amdgcn_mfma_f32_32x32x16_bf16(kf[d0], qf[d0], p, 0, 0, 0);
    float om[16], be[16];
#pragma unroll
    for (int r = 0; r < 16; ++r) {
        const int kv = crow(r, hi); const bool valid = (s0 + kv) < (t0 + q);
        const float z = fminf(p[r], 80.f); const float t = __expf(z); const float o = __builtin_amdgcn_rcpf(1.f + t);
        om[r] = valid ? o : 1.f; be[r] = valid ? t * o : 0.f;
    }
    float el[16], G[4], PG[4];
#pragma unroll
    for (int i = 0; i < 4; ++i) { el[4 * i + 3] = 1.f; el[4 * i + 2] = om[4 * i + 3]; el[4 * i + 1] = el[4 * i + 2] * om[4 * i + 2]; el[4 * i] = el[4 * i + 1] * om[4 * i + 1]; G[i] = el[4 * i] * om[4 * i]; }
#pragma unroll
    for (int i = 0; i < 4; ++i) PG[i] = __shfl_xor(G[i], 32);
    float sG[4], sP[4];
    sG[3] = 1.f; sG[2] = G[3]; sG[1] = G[3] * G[2]; sG[0] = sG[1] * G[1];
    sP[3] = 1.f; sP[2] = PG[3]; sP[1] = PG[3] * PG[2]; sP[0] = sP[1] * PG[1];
    const float total = (sG[0] * G[0]) * (sP[0] * PG[0]);
    float A[16];
#pragma unroll
    for (int i = 0; i < 4; ++i) { const float eg = sG[i] * (hi ? sP[i] : sP[i] * PG[i]) * carry;
#pragma unroll
        for (int j = 0; j < 4; ++j) A[4 * i + j] = be[4 * i + j] * el[4 * i + j] * eg; }
    carry *= total;
    bf16x8 pf[2];
#pragma unroll
    for (int s = 0; s < 2; ++s) { u32x4 w; w.x = pk2(A[8 * s], A[8 * s + 1]); w.y = pk2(A[8 * s + 2], A[8 * s + 3]); w.z = pk2(A[8 * s + 4], A[8 * s + 5]); w.w = pk2(A[8 * s + 6], A[8 * s + 7]); pf[s] = __builtin_bit_cast(bf16x8, w); }
#pragma unroll
    for (int s = 0; s < 2; ++s) {
        const u32x4 a0 = (u32x4){vlo[0][s].x, vlo[0][s].y, vhi[0][s].x, vhi[0][s].y}, a1 = (u32x4){vlo[1][s].x, vlo[1][s].y, vhi[1][s].x, vhi[1][s].y};
        y0 = __builtin_amdgcn_mfma_f32_32x32x16_bf16(__builtin_bit_cast(bf16x8, a0), pf[s], y0, 0, 0, 0);
        y1 = __builtin_amdgcn_mfma_f32_32x32x16_bf16(__builtin_bit_cast(bf16x8, a1), pf[s], y1, 0, 0, 0);
    }
    return __all(carry < 5.6e-14f);
}
__device__ __forceinline__ void attn_tile(Frame& F, int bh, int qt) {
    const int lane = F.lane, q = lane & 31, hi = lane >> 5, b = bh >> 3, h = bh & 7, t0 = 32 * qt;
    const size_t tokbase = (size_t)b * SEQ;
    const bf16* QB = WSP(bf16, WS_Q); const bf16* KB = WSP(bf16, WS_K); const bf16* VT = WSP(bf16, WS_VT); bf16* YA = WSP(bf16, WS_YA);
    bf16x8 qf[4];
    { const bf16* Qp = QB + (tokbase + t0 + q) * 512 + h * 64 + 8 * hi;
#pragma unroll
      for (int d0 = 0; d0 < 4; ++d0) qf[d0] = *(const bf16x8*)(Qp + 16 * d0); }
    f32x16 y0, y1;
#pragma unroll
    for (int r = 0; r < 16; ++r) { y0[r] = 0.f; y1[r] = 0.f; }
    float carry = 1.f;
    const bf16* Vrow = VT + (size_t)bh * 128 * 1024 + q * 16 + 4 * hi;
    bf16x8 kA[4], kB[4]; u32x2 vloA[2][2], vhiA[2][2], vloB[2][2], vhiB[2][2];
#define ATT_LOAD(KF, VLO, VHI, S0) do { const bf16* Kp_ = KB + (tokbase + (S0) + q) * 512 + h * 64 + 8 * hi; \
        _Pragma("unroll") for (int d0 = 0; d0 < 4; ++d0) KF[d0] = *(const bf16x8*)(Kp_ + 16 * d0); \
        _Pragma("unroll") for (int dt = 0; dt < 2; ++dt) _Pragma("unroll") for (int s_ = 0; s_ < 2; ++s_) { const bf16* vp_ = Vrow + (size_t)(((S0) >> 4) + s_) * 1024 + dt * 512; VLO[dt][s_] = *(const u32x2*)vp_; VHI[dt][s_] = *(const u32x2*)(vp_ + 8); } } while (0)
    ATT_LOAD(kA, vloA, vhiA, t0);
    for (int s0 = t0; ; ) {
        { const int sn = s0 >= 32 ? s0 - 32 : 0; ATT_LOAD(kB, vloB, vhiB, sn); __builtin_amdgcn_sched_barrier(0); }
        if (attn_step(qf, kA, vloA, vhiA, y0, y1, carry, s0, t0, q, hi)) break;
        s0 -= 32; if (s0 < 0) break;
        { const int sn = s0 >= 32 ? s0 - 32 : 0; ATT_LOAD(kA, vloA, vhiA, sn); __builtin_amdgcn_sched_barrier(0); }
        if (attn_step(qf, kB, vloB, vhiB, y0, y1, carry, s0, t0, q, hi)) break;
        s0 -= 32; if (s0 < 0) break;
    }
#undef ATT_LOAD
    bf16* Yp = YA + (tokbase + t0 + q) * 512 + h * 64 + 4 * hi;
#pragma unroll
    for (int i = 0; i < 4; ++i) {
        u32x2 w0, w1; w0.x = pk2(y0[4 * i], y0[4 * i + 1]); w0.y = pk2(y0[4 * i + 2], y0[4 * i + 3]); w1.x = pk2(y1[4 * i], y1[4 * i + 1]); w1.y = pk2(y1[4 * i + 2], y1[4 * i + 3]);
        *(u32x2*)(Yp + 8 * i) = w0; *(u32x2*)(Yp + 32 + 8 * i) = w1;
    }
}

__device__ __forceinline__ void p5a_router(const Args& args, Frame& F) {
    LAS float* LG = (LAS float*)F.lds;
    LAS unsigned* HIST = (LAS unsigned*)(F.lds + 32768); LAS unsigned* BASE = HIST + 32;
    const bf16* X1 = WSP(bf16, WS_X1); const float* GW = WSP(float, WS_GW); const float* rb = FIN(20);
    unsigned* cnt = F.ctl + CW_CNT; int* LIST = WSP(int, WS_LIST); float* LRS = WSP(float, WS_LRS); float* LGT = WSP(float, WS_LGT);
    const int tid = F.tid, lane = F.lane, wave = F.wave;
    for (int tb = blockIdx.x; tb < M / 128; tb += F.G) {
        if (tid < 32) HIST[tid] = 0u;
        __syncthreads();
        int ex[4] = {0, 0, 0, 0}; float gt[4] = {0.f, 0.f, 0.f, 0.f}; unsigned lr[4] = {0u, 0u, 0u, 0u}; int tok = 0; float rstd_keep = 0.f;
        {
            const int i = lane & 31, kh = lane >> 5, g = wave & 3, kq = wave >> 2; tok = tb * 128 + g * 32 + i;
            const bf16* xr = X1 + (size_t)tok * D + 512 * kq + 4 * kh;
            f32x16 acc;
#pragma unroll
            for (int r = 0; r < 16; ++r) acc[r] = 0.f;
            float ss = 0.f;
#pragma unroll 1
            for (int u0 = 0; u0 < 64; u0 += 8) {
                f32x4 a[8]; float gw[8][4];
#pragma unroll
                for (int uu = 0; uu < 8; ++uu) { const u32x2 xw = *(const u32x2*)(xr + 8 * (u0 + uu)); a[uu] = (f32x4){bflo(xw.x), bfhi(xw.x), bflo(xw.y), bfhi(xw.y)}; const float* gp = GW + (size_t)(512 * kq + 8 * (u0 + uu) + 4 * kh) * 32 + i;
#pragma unroll
                    for (int j = 0; j < 4; ++j) gw[uu][j] = gp[32 * j]; }
#pragma unroll
                for (int uu = 0; uu < 8; ++uu) { ss += (a[uu][0] * a[uu][0] + a[uu][1] * a[uu][1]) + (a[uu][2] * a[uu][2] + a[uu][3] * a[uu][3]);
#pragma unroll
                    for (int j = 0; j < 4; ++j) acc = __builtin_amdgcn_mfma_f32_32x32x2f32(a[uu][j], gw[uu][j], acc, 0, 0, 0); }
            }
            ss += __shfl_xor(ss, 32);
            LAS float* RED = (LAS float*)(F.lds + 40960) + (g * 64 + lane) * 17;
            if (kq == 1) {
#pragma unroll
                for (int r = 0; r < 16; ++r) RED[r] = acc[r];
                RED[16] = ss; }
            __syncthreads();
            if (kq == 0) {
#pragma unroll
                for (int r = 0; r < 16; ++r) acc[r] += RED[r];
                ss += RED[16]; }
            if (wave < 4) {
            const float rstd = 1.0f / sqrtf(ss * (1.f / D) + RMS_EPS);
            rstd_keep = rstd;
            LAS float* L = LG + wave * (32 * 33);
#pragma unroll
            for (int r = 0; r < 16; ++r) L[crow(r, kh) * 33 + i] = acc[r];
            asm volatile("s_waitcnt lgkmcnt(0)" ::: "memory");
            if (kh == 0) {
                float v0 = -3.0e38f, v1 = -3.0e38f, v2 = -3.0e38f, v3 = -3.0e38f; int i0 = 0, i1 = 0, i2 = 0, i3 = 0;
                for (int e = 0; e < 32; ++e) { const float v = L[i * 33 + e] * rstd + rb[e];
                    if (v > v3) { if (v > v2) { v3 = v2; i3 = i2; if (v > v1) { v2 = v1; i2 = i1; if (v > v0) { v1 = v0; i1 = i0; v0 = v; i0 = e; } else { v1 = v; i1 = e; } } else { v2 = v; i2 = e; } } else { v3 = v; i3 = e; } } }
                const float e1 = __expf(v1 - v0), e2 = __expf(v2 - v0), e3 = __expf(v3 - v0), inv = 1.0f / (1.f + e1 + e2 + e3);
                ex[0] = i0; ex[1] = i1; ex[2] = i2; ex[3] = i3; gt[0] = inv; gt[1] = e1 * inv; gt[2] = e2 * inv; gt[3] = e3 * inv;
#pragma unroll
                for (int k = 0; k < 4; ++k) lr[k] = __hip_atomic_fetch_add(&HIST[ex[k]], 1u, __ATOMIC_RELAXED, __HIP_MEMORY_SCOPE_WORKGROUP);
            }
            }
        }
        __syncthreads();
        if (tid < 32) BASE[tid] = __hip_atomic_fetch_add(cnt + tid, HIST[tid], RLX_AGENT);
        __syncthreads();
        if (wave < 4 && lane < 32) {
#pragma unroll
            for (int k = 0; k < 4; ++k) { const unsigned pos = BASE[ex[k]] + lr[k]; const size_t li = (size_t)ex[k] * CAP + pos; LIST[li] = tok * 4 + k; LRS[li] = rstd_keep; LGT[li] = gt[k]; }
        }
        __syncthreads();
    }
}
__device__ __forceinline__ int moe_tables(Frame& F) {
    LAS int* CS = (LAS int*)(F.lds + MOE_OFF); LAS int* OFF = CS + 32; LAS unsigned char* TE = F.lds + MOE_TE;
    if (F.tid < 32) { int c = (int)__hip_atomic_load(F.ctl + CW_CNT + F.tid, RLX_AGENT); CS[F.tid] = c > CAP ? CAP : c; }
    __syncthreads();
    if (F.tid == 0) { int off = 0; for (int e = 0; e < 32; ++e) { OFF[e] = off; off += ((CS[e] + 255) >> 8) << 8; } OFF[32] = off; }
    __syncthreads();
    const int ntiles = OFF[32] >> 8;
    for (int t = F.tid; t < ntiles; t += 512) { int e = 0; while (e < 31 && OFF[e + 1] <= t * 256) ++e; TE[t] = (unsigned char)e; }
    __syncthreads();
    return ntiles;
}
__device__ __forceinline__ void p8_combine(Frame& F) {
    const bf16* X1 = WSP(bf16, WS_X1); const unsigned char* YBF = WSP(unsigned char, WS_YBUF); bf16* X2B = WSP(bf16, WS_X2B); float* R2 = WSP(float, WS_RSTD2); float* RSS = WSP(float, WS_ROWSS);
    const int gw = F.vcu * 8 + F.wave, NGW = F.G * 8, lane = F.lane;
    for (int t = gw; t < M; t += NGW) {
        const u32x2* xr = (const u32x2*)(X1 + (size_t)t * D) + lane; f32x4 v[4]; float s = 0.f; u32x2 xw[4];
#pragma unroll
        for (int j = 0; j < 4; ++j) xw[j] = xr[64 * j];
        unsigned yw[4][4];
#pragma unroll
        for (int k = 0; k < 4; ++k) { const unsigned* yr = (const unsigned*)(YBF + (size_t)(4 * t + k) * D) + lane;
#pragma unroll
            for (int j = 0; j < 4; ++j) yw[k][j] = yr[64 * j]; }
#pragma unroll
        for (int j = 0; j < 4; ++j) v[j] = (f32x4){bflo(xw[j].x), bfhi(xw[j].x), bflo(xw[j].y), bfhi(xw[j].y)};
#pragma unroll
        for (int k = 0; k < 4; ++k)
#pragma unroll
            for (int j = 0; j < 4; ++j) { const f32x2 lo = __builtin_amdgcn_cvt_pk_f32_fp8((int)yw[k][j], false), hi = __builtin_amdgcn_cvt_pk_f32_fp8((int)yw[k][j], true);
                v[j].x += lo.x * (1.f / 32.f); v[j].y += lo.y * (1.f / 32.f); v[j].z += hi.x * (1.f / 32.f); v[j].w += hi.y * (1.f / 32.f); }
        u32x2* o = (u32x2*)(X2B + (size_t)t * D) + lane;
#pragma unroll
        for (int j = 0; j < 4; ++j) { s += (v[j].x * v[j].x + v[j].y * v[j].y) + (v[j].z * v[j].z + v[j].w * v[j].w); u32x2 w; w.x = pk2(v[j].x, v[j].y); w.y = pk2(v[j].z, v[j].w); o[64 * j] = w;
            (WSP(unsigned, WS_X2B8) + (size_t)t * (D / 4))[lane + 64 * j] = pk8(v[j].x, v[j].y, v[j].z, v[j].w); }
        s = wave_sum(s);
        if (lane == 0) { R2[t] = 1.0f / sqrtf(s * (1.f / D) + RMS_EPS); RSS[t] = 0.f; }
    }
}
constexpr int NPHASE = 11;
__global__ void __launch_bounds__(512, 2) mega_fwd(Args args) {
    extern __shared__ __attribute__((aligned(16))) unsigned char lds[];
    Frame F;
    F.lds = (LAS unsigned char*)lds;
    F.wave = __builtin_amdgcn_readfirstlane((int)threadIdx.x >> 6); F.lane = lane_now(); F.tid = F.wave * 64 + F.lane;
    F.G = gridDim.x; { const int bx = blockIdx.x; F.vcu = (F.G % 8 == 0) ? (bx % 8) * (F.G / 8) + bx / 8 : bx; }
    F.ws = args.ws; F.ctl = (unsigned*)(args.ws + WS_CTL); F.out = args.out;
    volatile LAS unsigned* MISC = (volatile LAS unsigned*)(F.lds + LDSCTL_OFF);
    if (F.tid < 64) MISC[F.tid] = 0u;
    __syncthreads();
    const int lo = args.ph_lo, hi = args.ph_hi;
    XcdBarrier bar; bar.bar = F.ctl + CW_BAR; bar.x = 0; bar.st = nullptr;
    if (hi - lo > 1) bar = xcd_barrier_post(F.ctl + CW_BAR, MISC + 8, F.tid);
#ifndef PH_MASK
#define PH_MASK 0xFFFF
#endif
#define IN(k) ((((PH_MASK) >> (k)) & 1) && lo <= (k) && (k) < hi)
#define STAMP(k) do { if (TS_PROBE >= 0 && blockIdx.x == 0 && F.tid == 0) ((unsigned long long*)(F.ctl + 2048))[k] = __builtin_amdgcn_s_memrealtime(); } while (0)
#define SEAM(k) do { if (IN(k) && IN((k) + 1)) xcd_barrier(bar, F.wave); F.lane = lane_now(); F.tid = F.wave * 64 + F.lane; STAMP((k) + 1); } while (0)
    LAS unsigned char* ring = F.lds;
    STAMP(0);

    if (IN(0)) { p0_prologue(args, F); if (F.G < 256) expert_convert(args, F, F.vcu * 8 + F.wave, F.G * 8, 3); } SEAM(0);

    if (IN(1)) {
        constexpr unsigned ALLT = (1u << (INC / 256)) - 1u, F8T = (unsigned)(G1_F8_TILES) & ALLT, B16T = ALLT & ~F8T;
        if (B16T) { pg8::Gemm g{WSP(bf16, WS_XB), WSP(bf16, WS_WIN), M, INC, D, 0, nullptr, nullptr, nullptr}; pg8::MaskOrder S; S.init(M, B16T, F.G, (int)blockIdx.x);
            EpiG1 E{WSP(float, WS_RSTD0), WSP(bf16, WS_Q), WSP(bf16, WS_K), WSP(bf16, WS_VT), WSP(bf16, WS_ZR), WSP(bf16, WS_GT), 1.f};
            pg8::gemm_phase<EpiG1, pg8::MaskOrder, false, false>(ring, g, S, E, F.wave); }
        if (F8T) { pg8::Gemm g{WSP(bf16, WS_XB8), WSP(bf16, WS_WIN8), M, INC, D, 0, nullptr, nullptr, nullptr}; pg8::MaskOrder S; S.init(M, F8T, F.G, (int)blockIdx.x);
            EpiG1 E{WSP(float, WS_RSTD0), WSP(bf16, WS_Q), WSP(bf16, WS_K), WSP(bf16, WS_VT), WSP(bf16, WS_ZR), WSP(bf16, WS_GT), 1.f / 64.f};
            pg8::gemm_phase<EpiG1, pg8::MaskOrder, false, true>(ring, g, S, E, F.wave); }
    } SEAM(1);

    if (IN(2)) {
        for (int c = blockIdx.x; c < 256; c += F.G) {
            const int x = c & 7, y = c >> 3; pg8::LoraOrder S; S.half = y & 1; S.pm = x + 8 * (y >> 1); S.nu = 3 + (F.G >> 30);
            build_alora(args, F, S.pm);
            asm volatile("s_waitcnt vmcnt(0)" ::: "memory"); __syncthreads();
            pg8::Gemm g{WSP(bf16, WS_ALORA), WSP(bf16, WS_WL), M, LORA_N, LORA_K + (F.G >> 30), 0, nullptr, nullptr, nullptr};
            EpiLora E{FIN(5), FIN(7), WSP(bf16, WS_DEC), WSP(bf16, WS_AA), WSP(bf16, WS_GG)};
            pg8::gemm_phase(ring, g, S, E, F.wave);
        }
    } SEAM(2);

    if (IN(3)) {
        for (int u = blockIdx.x; u < 256; u += F.G) {
#ifndef P3_ONLY
#define P3_ONLY 5
#endif
            if (u < 128) { if (P3_ONLY != 2 && P3_ONLY != 3 && P3_ONLY != 4) scan_unit_chunked(args, F, u); else { bf16* YB = WSP(bf16, WS_YB); const int b = u >> 3, h = u & 7; for (int i = F.tid; i < SEQ * 8; i += 512) { const int tk = i >> 3, c8 = (i & 7) * 8; *(u32x4*)(YB + ((size_t)b * SEQ + tk) * 512 + h * 64 + c8) = (u32x4){0u, 0u, 0u, 0u}; } } }
            else if (P3_ONLY == 1 || P3_ONLY == 4) { bf16* YAz = WSP(bf16, WS_YA); const int bh = u - 128, b = bh >> 3, h = bh & 7; for (int i = F.tid; i < SEQ * 8; i += 512) { const int tk = i >> 3, c8 = (i & 7) * 8; *(u32x4*)(YAz + ((size_t)b * SEQ + tk) * 512 + h * 64 + c8) = (u32x4){0u, 0u, 0u, 0u}; } }
            else { const int bh = u - 128; for (int i = 0; i < 8; ++i) attn_tile(F, bh, F.wave + 8 * i);
                   if (F.G >= 256 && P3_ONLY != 3 && P3_ONLY != 5) expert_convert(args, F, bh * 8 + F.wave, 1024, 3);
                    }
        }
    if (TS_PROBE >= 0 && blockIdx.x == 0 && F.tid == 0) ((unsigned long long*)(F.ctl + 2048))[20] = __builtin_amdgcn_s_memrealtime();
    } SEAM(3);

    if (IN(4)) {
        pg8::StaticOrder S; S.init(M, D, F.G, (int)blockIdx.x);
        { pg8::Gemm g{WSP(bf16, WS_YA), WSP(bf16, WS_WA), M, D, AW, 0, nullptr, nullptr, nullptr}; EpiMerge<0> E{WSP(bf16, WS_GT), WSP(bf16, WS_MERGED)}; pg8::gemm_phase(ring, g, S, E, F.wave); }
        { pg8::Gemm g{WSP(bf16, WS_YB), WSP(bf16, WS_WB), M, D, RW, 0, nullptr, nullptr, nullptr}; EpiMerge<1> E{WSP(bf16, WS_GT), WSP(bf16, WS_MERGED)}; pg8::gemm_phase(ring, g, S, E, F.wave); }
    } SEAM(4);

    if (IN(5)) {
        pg8::Gemm g{WSP(bf16, WS_MERGED), WSP(bf16, WS_WO), M, D, D, 0, nullptr, nullptr, nullptr}; pg8::StaticOrder S; S.init(M, D, F.G, (int)blockIdx.x);
        EpiX1 E{WSP(bf16, WS_XB), WSP(bf16, WS_X1), FIN(18), WSP(unsigned char, WS_HN)};
        pg8::gemm_phase(ring, g, S, E, F.wave);
    } SEAM(5);

    if (IN(6)) { p5a_router(args, F); } SEAM(6);

    if (IN(7)) {
        const int ntiles = moe_tables(F);
        pg8::Gemm g{WSP(bf16, WS_HN), WSP(bf16, WS_W1), MAXROWS, F2, D, (size_t)F2 * D, WSP(int, WS_LIST), (const LAS int*)(F.lds + MOE_OFF) + 32, (const LAS int*)(F.lds + MOE_OFF)};
        pg8::MoeOrder S{ntiles, F2 / 256, F.G, (int)blockIdx.x, F.lds + MOE_TE};
        EpiSwiglu E{FIN(22), WSP(unsigned char, WS_ACT), WSP(int, WS_LIST), WSP(float, WS_LRS), (const LAS int*)(F.lds + MOE_OFF) + 32, (const LAS int*)(F.lds + MOE_OFF), (const LAS float*)(F.lds + RING_BYTES + 4096)};
        pg8::gemm_phase<EpiSwiglu, pg8::MoeOrder, true, true>(ring, g, S, E, F.wave);
    } SEAM(7);

    if (IN(8)) {
        const int ntiles = moe_tables(F);
        pg8::Gemm g{WSP(bf16, WS_ACT), WSP(bf16, WS_W2), MAXROWS, D, FH, (size_t)D * FH, nullptr, nullptr, nullptr};
        pg8::MoeOrder S{ntiles, D / 256, F.G, (int)blockIdx.x, F.lds + MOE_TE};
        EpiY E{FIN(24), WSP(int, WS_LIST), WSP(float, WS_LGT), WSP(unsigned char, WS_YBUF), (const LAS int*)(F.lds + MOE_OFF) + 32, (const LAS int*)(F.lds + MOE_OFF), (const LAS float*)(F.lds + RING_BYTES + 4096)};
        pg8::gemm_phase<EpiY, pg8::MoeOrder, false, true>(ring, g, S, E, F.wave);
    } SEAM(8);

    if (IN(9)) { p8_combine(F); } SEAM(9);

    if (IN(10)) {
        pg8::StaticOrder S; S.init(M, D, F.G, (int)blockIdx.x);
        { pg8::Gemm g{WSP(bf16, WS_X2B8), WSP(bf16, WS_WG), M, D, D, 0, nullptr, nullptr, nullptr}; EpiGate E{WSP(float, WS_RSTD2), WSP(bf16, WS_PGT)}; pg8::gemm_phase<EpiGate, pg8::StaticOrder, false, true>(ring, g, S, E, F.wave); }
        { pg8::Gemm g{WSP(bf16, WS_PB), WSP(bf16, WS_WP), M, D, PLE, 0, nullptr, nullptr, nullptr}; EpiPle E{WSP(bf16, WS_X2B), WSP(bf16, WS_PGT), F.out, WSP(float, WS_ROWSS), F.ctl + CW_PCNT, FIN(28), F.ctl}; pg8::gemm_phase(ring, g, S, E, F.wave); }
    }
#undef IN
#undef SEAM
}

extern "C" void kernel_launch(void* const* d_in, const int* in_sizes, int n_in, void* d_out, int out_size, void* d_ws, size_t ws_size, hipStream_t stream) {
    static int grid = 0;
    if (grid == 0) {
        if (n_in != 29 || in_sizes[0] != M * D || out_size != M * D || ws_size < WS_END) {
            fprintf(stderr, "kernel_launch: unexpected shapes (n_in %d, in0 %d, out %d, ws %zu < %zu); nothing launched\n", n_in, n_in > 0 ? in_sizes[0] : -1, out_size, ws_size, (size_t)WS_END); grid = -1; return; }
        int dev = 0, cus = 0, per_cu = 0;
        if (hipGetDevice(&dev) != hipSuccess || hipDeviceGetAttribute(&cus, hipDeviceAttributeMultiprocessorCount, dev) != hipSuccess) { grid = -1; return; }
        if (hipFuncSetAttribute((const void*)mega_fwd, hipFuncAttributeMaxDynamicSharedMemorySize, LDS_BYTES) != hipSuccess) { fprintf(stderr, "kernel_launch: hipFuncSetAttribute failed\n"); grid = -1; return; }
        if (hipOccupancyMaxActiveBlocksPerMultiprocessor(&per_cu, (const void*)mega_fwd, 512, LDS_BYTES) != hipSuccess || per_cu < 1) { fprintf(stderr, "kernel_launch: occupancy query says %d blocks/CU\n", per_cu); }
        (void)hipGetLastError();
        grid = cus;
    }
    if (grid < 0) return;
    (void)hipMemsetAsync((char*)d_ws + WS_CTL, 0, CTL_ZERO_BYTES, stream);
    Args a{};
    for (int i = 0; i < 29; ++i) a.in[i] = (const float*)d_in[i];
    a.out = (float*)d_out; a.ws = (unsigned char*)d_ws;
#if MK_PER_PHASE
    for (int p = 0; p < NPHASE; ++p) { a.ph_lo = p; a.ph_hi = p + 1; hipLaunchKernelGGL(mega_fwd, dim3(grid), dim3(512), LDS_BYTES, stream, a); }
#else
    a.ph_lo = 0; a.ph_hi = NPHASE; hipLaunchKernelGGL(mega_fwd, dim3(grid), dim3(512), LDS_BYTES, stream, a);
#endif
}
```

```cpp
#include <hip/hip_runtime.h>
#include <cstdio>
#include <cstdint>

#ifndef P3_ONLY
#define P3_ONLY 0
#endif
#ifndef SCAN_STUB
#define SCAN_STUB 0
#endif
#ifndef ATT_FORCE
#define ATT_FORCE 0
#endif
#ifndef G1_F8_TILES
#define G1_F8_TILES 0x1FE030u
#endif
#ifndef EPI_STUB
#define EPI_STUB 0
#endif
#ifndef TS_PROBE
#define TS_PROBE -1
#endif
#ifndef TS_END_SLOT
#define TS_END_SLOT (TS_PROBE + 1)
#endif
#ifndef MK_PER_PHASE
#define MK_PER_PHASE 0
#endif

#define LAS __attribute__((address_space(3)))
#define GAS __attribute__((address_space(1)))
typedef unsigned short bf16;
typedef short bf16x8 __attribute__((ext_vector_type(8)));
typedef float f32x2 __attribute__((ext_vector_type(2)));
typedef float f32x4 __attribute__((ext_vector_type(4)));
typedef float f32x16 __attribute__((ext_vector_type(16)));
typedef unsigned u32x2 __attribute__((ext_vector_type(2)));
typedef unsigned u32x4 __attribute__((ext_vector_type(4)));
typedef __bf16 bf16x2_t __attribute__((ext_vector_type(2)));

constexpr int NB = 16, SEQ = 2048, D = 1024, M = NB * SEQ;
constexpr int NH = 8, HD = 64, AW = 512, RW = 512, RWC = 1792, INC = 5376;
constexpr int NE = 32, FH = 1024, F2 = 2048, PLE = 256, TOPK = 4;
constexpr int LORA_K = 256, LORA_N = 1536;
constexpr int CAP = 32768;
constexpr int MAXROWS = M * TOPK + NE * 256;
constexpr float RMS_EPS = 1e-5f, GN_EPS = 64e-5f;

constexpr size_t MiB = 1u << 20;
constexpr size_t WS_CTL = 0, CTL_ZERO_BYTES = 1 * MiB;
constexpr size_t WS_WIN = 1 * MiB;
constexpr size_t WS_WA = 12 * MiB, WS_WB = 13 * MiB, WS_WO = 14 * MiB, WS_WG = 16 * MiB, WS_WP = 18 * MiB;
constexpr size_t WS_WL = 18 * MiB + 512 * 1024;
constexpr size_t WS_GW = 19 * MiB + 256 * 1024;
constexpr size_t WS_W1 = 20 * MiB;
constexpr size_t WS_W2 = 148 * MiB;
constexpr size_t WS_PB = 212 * MiB;
constexpr size_t WS_RSTD0 = 228 * MiB, WS_RSTD2 = WS_RSTD0 + 128 * 1024, WS_ROWSS = WS_RSTD0 + 256 * 1024;
constexpr size_t WS_RSTD1 = WS_RSTD0 + 384 * 1024;
constexpr size_t WS_GATEW = WS_RSTD0 + 512 * 1024;
constexpr size_t WS_ROWSLOT = 229 * MiB;
constexpr size_t WS_LIST = 230 * MiB;
constexpr size_t WS_X1 = 236 * MiB;
constexpr size_t WS_YA = 236 * MiB, WS_YB = 268 * MiB, WS_ALORA = 300 * MiB;
constexpr size_t WS_GT = 364 * MiB;
constexpr size_t WS_Q = 492 * MiB, WS_K = 524 * MiB, WS_VT = 556 * MiB;
constexpr size_t WS_ZR = 588 * MiB;
constexpr size_t WS_XB = 700 * MiB;
constexpr size_t WS_DEC = 764 * MiB, WS_AA = 828 * MiB, WS_GG = 892 * MiB;
constexpr size_t WS_MERGED = 492 * MiB;
constexpr size_t WS_XS = 364 * MiB;
constexpr size_t WS_ACT = 684 * MiB;
constexpr size_t WS_HN = 364 * MiB;
constexpr size_t WS_YBUF = 428 * MiB;
constexpr size_t WS_X2B8 = 820 * MiB;
constexpr size_t WS_X2B = 684 * MiB;
constexpr size_t WS_PGT = 748 * MiB;
constexpr size_t WS_LRS = 956 * MiB, WS_LGT = 960 * MiB;
constexpr size_t WS_WIN8 = 84 * MiB;
constexpr size_t WS_XB8 = 96 * MiB;
constexpr size_t WS_END = 964 * MiB;
constexpr int CW_CNT = 64;
constexpr int CW_PCNT = 8192;
constexpr int CW_BAR = 4096;

constexpr int RING_BYTES = 131072;
constexpr int LDSCTL_OFF = RING_BYTES;
constexpr int MOE_OFF = RING_BYTES + 1024;
constexpr int MOE_TE = RING_BYTES + 2048;
constexpr int LDS_BYTES = 147456;

#define RLX_AGENT __ATOMIC_RELAXED, __HIP_MEMORY_SCOPE_AGENT
__device__ __forceinline__ unsigned pk2(float lo, float hi) { f32x2 v = {lo, hi}; bf16x2_t b = __builtin_convertvector(v, bf16x2_t); return __builtin_bit_cast(unsigned, b); }
__device__ __forceinline__ unsigned pk8(float a, float b, float c, float d) { int w = __builtin_amdgcn_cvt_pk_fp8_f32(a, b, 0, false); w = __builtin_amdgcn_cvt_pk_fp8_f32(c, d, w, true); return (unsigned)w; }
__device__ __forceinline__ float bflo(unsigned u) { return __uint_as_float(u << 16); }
__device__ __forceinline__ float bfhi(unsigned u) { return __uint_as_float(u & 0xffff0000u); }
__device__ __forceinline__ float sigm(float x) { return __builtin_amdgcn_rcpf(1.f + __expf(-x)); }
__device__ __forceinline__ float wave_sum(float v) {
#pragma unroll
    for (int o = 1; o < 64; o <<= 1) v += __shfl_xor(v, o);
    return v;
}
template <int CTRL> __device__ __forceinline__ float dppf(float v) { return __builtin_bit_cast(float, __builtin_amdgcn_update_dpp(0, __builtin_bit_cast(int, v), CTRL, 0xF, 0xF, true)); }
__device__ __forceinline__ float red8(float v) { v += dppf<0xB1>(v); v += dppf<0x4E>(v); v += dppf<0x141>(v); return v; }
__device__ __forceinline__ int lane_now() { int l; asm volatile("v_mbcnt_lo_u32_b32 %0, -1, 0\n\tv_mbcnt_hi_u32_b32 %0, -1, %0" : "=v"(l)); return l; }
__device__ __forceinline__ int crow(int r, int hi) { return (r & 3) + 8 * (r >> 2) + 4 * hi; }

struct PreNone {}; struct PreF { float f[8]; }; struct PreI { int i[8]; };
namespace pg8 {
#define PG8_LAS __attribute__((address_space(3)))
typedef unsigned short bf16_t;
constexpr int BM = 256, BK = 64, HALF = 128, HTB = HALF * BK * 2, STAGE_BYTES = 8 * HTB, NXCD = 8, WGM = 8;
__host__ __device__ __forceinline__ int lds_byte(int r, int c) { const int st = (r >> 4) * 2 + (c >> 5), rr = r & 15, cc = c & 31, ob = rr * 64 + cc * 2; return st * 1024 + (ob ^ (((ob >> 9) & 1) << 5)); }
__host__ __device__ __forceinline__ void stage_rc(int b, int& R, int& C) { const int st = b / 1024, sb = b % 1024, swz = sb ^ (((sb >> 9) & 1) << 5); R = (st >> 1) * 16 + swz / 64; C = (st & 1) * 32 + (swz % 64) / 2; }
__host__ __device__ __forceinline__ int perm32(int rho) { const int n = rho >> 4, i = rho & 15; return 8 * (i >> 2) + 4 * n + (i & 3); }

struct Unit { int pm, pn, e, par; };
struct Gemm { const bf16_t* A; const bf16_t* Bt; int M, N, K; size_t bsel_bytes; const int* glist; const PG8_LAS int* goff; const PG8_LAS int* gcnt; };

struct StaticOrder {
    int nM, nN, nwg, G, c;
    __device__ void init(int M_, int N_, int G_, int c_) { nM = M_ / BM; nN = N_ / BM; nwg = nM * nN; G = G_; c = c_; }
    __device__ bool next(int i, Unit& u) const {
        const long L = (long)i * G + c; if (L >= nwg) return false;
        int wgid = (int)L; { const int q = nwg / NXCD, r = nwg % NXCD, xcd = wgid % NXCD, off = wgid / NXCD; wgid = (xcd < r ? xcd * (q + 1) : r * (q + 1) + (xcd - r) * q) + off; }
        const int nig = WGM * nN, gid = wgid / nig, fm = gid * WGM, gsz = (nM - fm) < WGM ? (nM - fm) : WGM;
        u.pm = fm + ((wgid % nig) % gsz); u.pn = (wgid % nig) / gsz; u.e = 0; return true;
    }
};
struct MaskOrder {
    StaticOrder S; unsigned mask;
    __device__ void init(int M_, unsigned mask_, int G_, int c_) { mask = mask_; S.init(M_, BM * __builtin_popcount(mask_), G_, c_); }
    __device__ bool next(int i, Unit& u) const {
        if (!S.next(i, u)) return false;
        int n = u.pn, idx = 0;
#pragma unroll
        for (int t = 0; t < 21; ++t) if ((mask >> t) & 1u) { if (n == 0) idx = t; --n; }
        u.pn = idx; return true;
    }
};
struct LoraOrder {
    int pm, half, nu;
    __device__ bool next(int i, Unit& u) const { if (i >= nu) return false; u.pm = pm; u.pn = 3 * half + i; u.e = 0; return true; }
};
struct MoeOrder {
    int ntiles, npn, G, c; const PG8_LAS unsigned char* te;
    __device__ bool next(int i, Unit& u) const {
        int rt, pn;
        if ((G & 255) == 0 && (npn == 8 || npn == 4)) { const int x = c & 7, j = (c >> 3) & 31, rpx = 32 / npn, blk = c >> 8; rt = ((i * (G >> 8) + blk) * 8 + x) * rpx + j / npn; pn = j % npn; }
        else { const long L = (long)i * G + c; rt = (int)(L / npn); pn = (int)(L % npn); }
        if (rt >= ntiles) return false;
        u.pm = rt; u.pn = pn; u.e = te[rt]; return true;
    }
};

typedef int i32x4 __attribute__((ext_vector_type(4))); typedef int i32x8 __attribute__((ext_vector_type(8)));
template <class Epi, class Sched, bool GATHER = false, bool F8 = false>
__device__ __forceinline__ void gemm_phase(PG8_LAS unsigned char* lds, const Gemm g, const Sched& S, const Epi& E, const int wid) {
    const int lane = lane_now(), tid = wid * 64 + lane,
              wr = wid >> 2, wc = wid & 3, fr = lane & 15, fq = lane >> 4;
    const int K = g.K, nt = F8 ? K / (2 * BK) : K / BK;
    unsigned voffA[2], voffB[2];
#pragma unroll
    for (int i = 0; i < 2; ++i) { int R, C; stage_rc(tid * 16 + i * 8192, R, C); const int Rb = Epi::PERM ? ((R & ~31) + perm32(R & 31)) : R;
        voffA[i] = F8 ? (unsigned)(R * K + C * 2) : (unsigned)(R * K + C) * 2u; voffB[i] = F8 ? (unsigned)(Rb * K + C * 2) : (unsigned)(Rb * K + C) * 2u; }
    const size_t kstep = (size_t)(BK * 2);
    const size_t hstep = (size_t)HALF * K * (F8 ? 1 : 2);
    const size_t tstep = 2 * hstep;
    const unsigned ldsw = (unsigned)wid * 1024u;
    const int aoff = lds_byte(wr * 64 + fr, fq * 8), boff = lds_byte(wc * 32 + fr, fq * 8);
    const int aoffk[2] = {aoff, aoff + 1024}, boffk[2] = {boff, boff + 1024};
    unsigned vgC[2][2] = {{0u, 0u}, {0u, 0u}}, vgN[2][2] = {{0u, 0u}, {0u, 0u}};
#define PG8_GOFF(u, vo) do { _Pragma("unroll") for (int _h = 0; _h < 2; ++_h) _Pragma("unroll") for (int _i = 0; _i < 2; ++_i) { int R_, C_; stage_rc(tid * 16 + _i * 8192, R_, C_); \
        const int r_ = (u).pm * BM + _h * HALF + R_ - g.goff[(u).e]; int tok_ = 0; if (r_ < g.gcnt[(u).e]) tok_ = g.glist[(size_t)(u).e * 32768 + r_] >> 2; (vo)[_h][_i] = F8 ? (unsigned)(tok_ * K + C_ * 2) : (unsigned)(tok_ * K + C_) * 2u; } } while (0)
#define PG8_SA(b, h) (((b) * 2 + (h)) * HTB)
#define PG8_SB(b, h) ((4 + (b) * 2 + (h)) * HTB)
#define PG8_STAGE(bufoff, gbase, voff) do { _Pragma("unroll") for (int _i = 0; _i < 2; ++_i) \
        __builtin_amdgcn_global_load_lds((const unsigned*)((const char*)(gbase) + (voff)[_i]), (PG8_LAS unsigned*)(lds + (bufoff) + ldsw + _i * 8192), 16, 0, 0); } while (0)
#define PG8_STA(bufoff, h, ptr, kbyte, usenext) do { if constexpr (GATHER) { unsigned vo_[2] = {(usenext) ? vgN[h][0] : vgC[h][0], (usenext) ? vgN[h][1] : vgC[h][1]}; PG8_STAGE(bufoff, (const char*)g.A + (kbyte), vo_); } else { PG8_STAGE(bufoff, ptr, voffA); } } while (0)
#define PG8_LDA(dst, b, h) do { _Pragma("unroll") for (int m = 0; m < 4; ++m) _Pragma("unroll") for (int k = 0; k < 2; ++k) dst[m][k] = *(const PG8_LAS bf16x8*)(lds + PG8_SA(b, h) + aoffk[k] + m * 2048); } while (0)
#define PG8_LDB(dst, b, h) do { _Pragma("unroll") for (int n = 0; n < 2; ++n) _Pragma("unroll") for (int k = 0; k < 2; ++k) dst[n][k] = *(const PG8_LAS bf16x8*)(lds + PG8_SB(b, h) + boffk[k] + n * 2048); } while (0)
#define PG8_MMA(ai, bj, At, Bt, Z) do { __builtin_amdgcn_s_setprio(1); \
        if constexpr (F8) { \
            if (Z) { _Pragma("unroll") for (int m = 0; m < 4; ++m) _Pragma("unroll") for (int n = 0; n < 2; ++n) { const i32x8 b8_ = __builtin_shufflevector(__builtin_bit_cast(i32x4, Bt[n][0]), __builtin_bit_cast(i32x4, Bt[n][1]), 0, 1, 2, 3, 4, 5, 6, 7), a8_ = __builtin_shufflevector(__builtin_bit_cast(i32x4, At[m][0]), __builtin_bit_cast(i32x4, At[m][1]), 0, 1, 2, 3, 4, 5, 6, 7); \
                asm volatile("v_mfma_f32_16x16x128_f8f6f4 %0, %1, %2, 0" : "=&v"(acc[ai][bj][m][n]) : "v"(b8_), "v"(a8_)); } } \
            else { _Pragma("unroll") for (int m = 0; m < 4; ++m) _Pragma("unroll") for (int n = 0; n < 2; ++n) { const i32x8 b8_ = __builtin_shufflevector(__builtin_bit_cast(i32x4, Bt[n][0]), __builtin_bit_cast(i32x4, Bt[n][1]), 0, 1, 2, 3, 4, 5, 6, 7), a8_ = __builtin_shufflevector(__builtin_bit_cast(i32x4, At[m][0]), __builtin_bit_cast(i32x4, At[m][1]), 0, 1, 2, 3, 4, 5, 6, 7); \
                asm volatile("v_mfma_f32_16x16x128_f8f6f4 %0, %1, %2, %0" : "+v"(acc[ai][bj][m][n]) : "v"(b8_), "v"(a8_)); } } } \
        else { _Pragma("unroll") for (int m = 0; m < 4; ++m) _Pragma("unroll") for (int n = 0; n < 2; ++n) _Pragma("unroll") for (int k = 0; k < 2; ++k) acc[ai][bj][m][n] = __builtin_amdgcn_mfma_f32_16x16x32_bf16(Bt[n][k], At[m][k], acc[ai][bj][m][n], 0, 0, 0); } \
        __builtin_amdgcn_s_setprio(0); } while (0)
#define PG8_WAIT_V(n) asm volatile("s_waitcnt vmcnt(" #n ")" ::: "memory")
#define PG8_WAIT_L(n) asm volatile("s_waitcnt lgkmcnt(" #n ")" ::: "memory")
#define PG8_BAR __builtin_amdgcn_s_barrier()
#define PG8_SCHED __builtin_amdgcn_sched_barrier(0)
    Unit cur, nxt; int ui = 0;
    if (!S.next(0, cur)) return;
    typename Epi::Pre preC;
    f32x4 acc[2][2][4][2];
#define PG8_ZERO_ACC do { if constexpr (!F8) { _Pragma("unroll") for (int a = 0; a < 2; ++a) _Pragma("unroll") for (int b = 0; b < 2; ++b) _Pragma("unroll") for (int m = 0; m < 4; ++m) _Pragma("unroll") for (int n = 0; n < 2; ++n) acc[a][b][m][n] = (f32x4){0.f, 0.f, 0.f, 0.f}; } } while (0)
    PG8_ZERO_ACC;
    bf16x8 At[4][2], B0[2][2], B1[2][2];
    const char* cA = (const char*)g.A + (size_t)cur.pm * tstep; const char* cB = (const char*)g.Bt + (size_t)cur.e * g.bsel_bytes + (size_t)cur.pn * tstep;
    if constexpr (GATHER) PG8_GOFF(cur, vgC);
    PG8_STAGE(PG8_SB(0, 0), cB, voffB); PG8_STAGE(PG8_SB(0, 1), cB + hstep, voffB); PG8_STA(PG8_SA(0, 0), 0, cA, 0, false); PG8_STA(PG8_SA(0, 1), 1, cA + hstep, 0, false);
    if (wr == 1) PG8_BAR;
    PG8_WAIT_V(2); PG8_BAR;
    PG8_STAGE(PG8_SB(1, 0), cB + kstep, voffB); PG8_STA(PG8_SA(1, 0), 0, cA + kstep, kstep, false); PG8_STAGE(PG8_SB(1, 1), cB + hstep + kstep, voffB);
    PG8_WAIT_V(6); PG8_BAR;
    for (;;) {
        const bool has_next = S.next(ui + 1, nxt);
        E.pre(cur, wr, fr, preC);
        cur.par = ui & 1;
        if constexpr (Epi::LBIAS) { if (wid == 0) __builtin_amdgcn_global_load_lds((const unsigned*)(E.bias_tile(cur) + 4 * lane), (PG8_LAS unsigned*)(lds + RING_BYTES + 4096 + 1024 * (ui & 1)), 16, 0, 0); }
        if constexpr (GATHER) { if (has_next) PG8_GOFF(nxt, vgN); else { vgN[0][0] = vgC[0][0]; vgN[0][1] = vgC[0][1]; vgN[1][0] = vgC[1][0]; vgN[1][1] = vgC[1][1]; } }
        const char* nA = has_next ? (const char*)g.A + (size_t)nxt.pm * tstep : cA;
        const char* nB = has_next ? (const char*)g.Bt + (size_t)nxt.e * g.bsel_bytes + (size_t)nxt.pn * tstep : cB;
        for (int t = 0; t < nt; t += 2) {
            const bool last = (t == nt - 2), first = (t == 0);
            const char* a1 = cA + (size_t)(t + 1) * kstep;
            const char* a2 = last ? nA : cA + (size_t)(t + 2) * kstep; const char* b2 = last ? nB : cB + (size_t)(t + 2) * kstep;
            const char* a3 = a2 + kstep; const char* b3 = b2 + kstep;
            const size_t k2 = last ? 0 : (size_t)(t + 2) * kstep;
            PG8_LDB(B0, 0, 0); PG8_LDB(B1, 0, 1); PG8_SCHED; PG8_LDA(At, 0, 0); PG8_STA(PG8_SA(1, 1), 1, a1 + hstep, (size_t)(t + 1) * kstep, false);
            PG8_WAIT_V(8); PG8_WAIT_L(0); PG8_BAR; PG8_MMA(0, 0, At, B0, first); PG8_MMA(0, 1, At, B1, first); PG8_BAR; PG8_SCHED;
            PG8_LDA(At, 0, 1); PG8_STAGE(PG8_SB(0, 0), b2, voffB); PG8_STAGE(PG8_SB(0, 1), b2 + hstep, voffB); PG8_STA(PG8_SA(0, 0), 0, a2, k2, last);
            PG8_WAIT_V(8); PG8_WAIT_L(0); PG8_BAR; PG8_MMA(1, 0, At, B0, first); PG8_MMA(1, 1, At, B1, first); PG8_BAR; PG8_SCHED;
            PG8_LDB(B0, 1, 0); PG8_LDB(B1, 1, 1); PG8_SCHED; PG8_LDA(At, 1, 0); PG8_STA(PG8_SA(0, 1), 1, a2 + hstep, k2, last);
            PG8_WAIT_V(8); PG8_WAIT_L(0); PG8_BAR; PG8_MMA(0, 0, At, B0, false); PG8_MMA(0, 1, At, B1, false); PG8_BAR; PG8_SCHED;
            PG8_LDA(At, 1, 1); PG8_STAGE(PG8_SB(1, 0), b3, voffB); PG8_STAGE(PG8_SB(1, 1), b3 + hstep, voffB); PG8_STA(PG8_SA(1, 0), 0, a3, k2 + kstep, last);
            PG8_WAIT_V(8); PG8_WAIT_L(0); PG8_BAR; PG8_MMA(1, 0, At, B0, false); PG8_MMA(1, 1, At, B1, false); PG8_BAR; PG8_SCHED;
        }
        if (wr == 0) PG8_BAR;
        if constexpr (F8) asm volatile("s_nop 15\n\ts_nop 15\n\ts_nop 15" ::: "memory");
        E(acc, cur, wr, wc, fr, fq, preC);
        if (!has_next) break;
        PG8_ZERO_ACC;
        cur = nxt; cA = nA; cB = nB; ++ui;
        if constexpr (GATHER) { vgC[0][0] = vgN[0][0]; vgC[0][1] = vgN[0][1]; vgC[1][0] = vgN[1][0]; vgC[1][1] = vgN[1][1]; }
        if (wr == 1) PG8_BAR;
    }
    PG8_WAIT_V(0);
    PG8_BAR;
#undef PG8_SA
#undef PG8_SB
#undef PG8_STAGE
#undef PG8_LDA
#undef PG8_STA
#undef PG8_GOFF
#undef PG8_LDB
#undef PG8_MMA
#undef PG8_ZERO_ACC
#undef PG8_WAIT_V
#undef PG8_WAIT_L
#undef PG8_BAR
#undef PG8_SCHED
}
}
using pg8::Unit;
typedef const f32x4 (&AccRef)[2][2][4][2];

#define XB_TMO      128
#define XB_XCNT(j)  (256  + 64 * (j))
#define XB_XSUB(j)  (1280 + 64 * (j))
#define XB_XGEN(j)  (2304 + 64 * (j))
#define XB_TOP      3328
#define XB_TOPGEN   3392
#define XCD_BAR_WORDS 3456
#define XB_SPIN_CAP (1u << 22)
__device__ __forceinline__ unsigned xb_ld(unsigned* p)              { return __hip_atomic_load(p, __ATOMIC_RELAXED, __HIP_MEMORY_SCOPE_AGENT); }
__device__ __forceinline__ unsigned xb_add(unsigned* p, unsigned v) { return __hip_atomic_fetch_add(p, v, __ATOMIC_RELAXED, __HIP_MEMORY_SCOPE_AGENT); }
__device__ __forceinline__ unsigned xb_xcc_id() { return (unsigned)__builtin_amdgcn_s_getreg((3 << 11) | 20) & 0xFu; }
#define XB_SPIN(cond, bar) do { unsigned _sp = 0; while (cond) { __builtin_amdgcn_s_sleep(1); \
    if ((++_sp & 255u) == 0u) { if (xb_ld(&(bar)[XB_TMO])) break; if (_sp > XB_SPIN_CAP) { atomicAdd(&(bar)[XB_TMO], 1u); break; } } } } while (0)
struct XcdBarrier { unsigned* bar; unsigned x; volatile LAS unsigned* st; };
__device__ __forceinline__ XcdBarrier xcd_barrier_post(unsigned* bar, volatile LAS unsigned* st, int tid) {
    XcdBarrier b; b.bar = bar; b.x = xb_xcc_id(); b.st = st;
    if (tid == 0) (void)xb_add(&bar[XB_XCNT(b.x)], 1u);
    return b;
}
__device__ __forceinline__ void xcd_barrier_complete(unsigned* bar, unsigned x, unsigned& nloc, unsigned& nx) {
    const unsigned G = gridDim.x * gridDim.y * gridDim.z;
    unsigned sum, cnt, mine, sp = 0u;
    for (;;) {
        sum = 0u; cnt = 0u; mine = 0u;
#pragma unroll
        for (unsigned j = 0; j < 16; ++j) { const unsigned c = xb_ld(&bar[XB_XCNT(j)]); sum += c; cnt += (c > 0u) ? 1u : 0u; mine = (j == x) ? c : mine; }
        if (sum == G) break;
        __builtin_amdgcn_s_sleep(1);
        if ((++sp & 255u) == 0u) { if (xb_ld(&bar[XB_TMO])) break; if (sp > XB_SPIN_CAP) { atomicAdd(&bar[XB_TMO], 1u); break; } }
    }
    nloc = mine > 0u ? mine : 1u; nx = cnt > 0u ? cnt : 1u;
}
__device__ __forceinline__ void xcd_barrier(const XcdBarrier& b, int wave) {
    asm volatile("s_waitcnt vmcnt(0)" ::: "memory");
    __syncthreads();
    if (wave == 0 && lane_now() == 0) {
        unsigned* bar = b.bar;
        __builtin_amdgcn_s_waitcnt(0);
        unsigned nloc = b.st[0], nx = b.st[1];
        if (nloc == 0u) { xcd_barrier_complete(bar, b.x, nloc, nx); b.st[0] = nloc; b.st[1] = nx; }
        const unsigned old = xb_add(&bar[XB_XSUB(b.x)], 1u);
        const unsigned gen = old / nloc;
        if (old + 1u == (gen + 1u) * nloc) {
            __builtin_amdgcn_fence(__ATOMIC_RELEASE, "agent");
            asm volatile("s_waitcnt vmcnt(0)" ::: "memory");
            const unsigned og = xb_add(&bar[XB_TOP], 1u);
            const unsigned tg = og / nx;
            if (og + 1u == (tg + 1u) * nx) xb_add(&bar[XB_TOPGEN], 1u);
            else XB_SPIN(xb_ld(&bar[XB_TOPGEN]) == tg, bar);
            __builtin_amdgcn_fence(__ATOMIC_ACQUIRE, "agent");
            xb_add(&bar[XB_XGEN(b.x)], 1u);
            asm volatile("s_waitcnt vmcnt(0)" ::: "memory");
        } else {
            XB_SPIN(xb_ld(&bar[XB_XGEN(b.x)]) == gen, bar);
            __builtin_amdgcn_fence(__ATOMIC_ACQUIRE, "agent");
            asm volatile("s_waitcnt vmcnt(0)" ::: "memory");
        }
    }
    __syncthreads();
}

struct Frame {
    LAS unsigned char* lds;
    unsigned* ctl;
    int tid, lane, wave, vcu, G;
    unsigned char* ws;
    float* out;
};
#define WSP(T, off) ((T*)(F.ws + (off)))
struct Args { const float* in[29]; float* out; unsigned char* ws; int ph_lo, ph_hi; };
#define FIN(i) (args.in[i])

template <bool SWZ = false, bool Q8 = false>
__device__ __forceinline__ void p0_transpose_item(const float* W, int K, int N, bf16* WT, LAS float* scr, int item, int lane, const float* kscale) {
    const int nblk = N / 32, kb = item / nblk, nb = item % nblk, k0 = 64 * kb, n0 = 32 * nb;
#pragma unroll
    for (int b = 0; b < 2; ++b) {
        float v[16];
#pragma unroll
        for (int i = 0; i < 16; ++i) { const int kk = 2 * (16 * b + i) + (lane >> 5); v[i] = W[(size_t)(k0 + kk) * N + n0 + (lane & 31)]; }
        __builtin_amdgcn_sched_barrier(0);
#pragma unroll
        for (int i = 0; i < 16; ++i) { const int kk = 2 * (16 * b + i) + (lane >> 5); if (kscale) v[i] *= kscale[k0 + kk]; scr[kk * 33 + (lane & 31)] = v[i]; }
        __builtin_amdgcn_sched_barrier(0);
    }
    asm volatile("s_waitcnt lgkmcnt(0)" ::: "memory");
    if constexpr (Q8) {
        const int c4 = lane & 3;
#pragma unroll
        for (int j = 0; j < 2; ++j) { const int n = (lane >> 2) + 16 * j; const LAS float* s = scr + (16 * c4) * 33 + n;
            u32x4 o; o.x = pk8(64.f * s[0 * 33], 64.f * s[1 * 33], 64.f * s[2 * 33], 64.f * s[3 * 33]); o.y = pk8(64.f * s[4 * 33], 64.f * s[5 * 33], 64.f * s[6 * 33], 64.f * s[7 * 33]);
            o.z = pk8(64.f * s[8 * 33], 64.f * s[9 * 33], 64.f * s[10 * 33], 64.f * s[11 * 33]); o.w = pk8(64.f * s[12 * 33], 64.f * s[13 * 33], 64.f * s[14 * 33], 64.f * s[15 * 33]);
            int nr = n0 + n; if (SWZ) { const int cl = nr & 255; nr = (nr & ~255) + 128 * ((cl >> 3) & 1) + 32 * (cl >> 6) + 8 * ((cl >> 4) & 3) + (cl & 7); }
            *(u32x4*)((unsigned char*)WT + (size_t)nr * K + k0 + 16 * c4) = o; }
        asm volatile("s_waitcnt lgkmcnt(0)" ::: "memory");
        return; }
    const int c = lane & 7;
#pragma unroll
    for (int j = 0; j < 4; ++j) { const int n = (lane >> 3) + 8 * j; const LAS float* s = scr + (8 * c) * 33 + n;
        u32x4 o; o.x = pk2(s[0 * 33], s[1 * 33]); o.y = pk2(s[2 * 33], s[3 * 33]); o.z = pk2(s[4 * 33], s[5 * 33]); o.w = pk2(s[6 * 33], s[7 * 33]);
        int nr = n0 + n; if (SWZ) { const int cl = nr & 255; nr = (nr & ~255) + 128 * ((cl >> 3) & 1) + 32 * (cl >> 6) + 8 * ((cl >> 4) & 3) + (cl & 7); }
        *(u32x4*)(WT + (size_t)nr * K + k0 + 8 * c) = o; }
    asm volatile("s_waitcnt lgkmcnt(0)" ::: "memory");
}
__device__ __forceinline__ void p0_prologue(const Args& args, Frame& F) {
    LAS float* scr = (LAS float*)(F.lds + F.wave * 16384);
    const int gw = F.vcu * 8 + F.wave, NGW = F.G * 8, lane = F.lane;
    constexpr int I_IN = (D / 64) * (INC / 32), I_A = (AW / 64) * (D / 32), I_O = (D / 64) * (D / 32), I_P = (PLE / 64) * (D / 32);
    constexpr int I_W1 = (D / 64) * (F2 / 32), I_W2 = (FH / 64) * (D / 32);
    constexpr int NITEMS = I_IN + 2 * I_A + 2 * I_O + I_P;
    for (int it = gw; it < NITEMS; it += NGW) {
        int r = it;
        if (r < I_IN) { const int tile = (r % (INC / 32)) >> 3;
            if ((G1_F8_TILES >> tile) & 1) p0_transpose_item<false, true>(FIN(3), D, INC, WSP(bf16, WS_WIN8), scr, r, lane, FIN(2));
            else p0_transpose_item(FIN(3), D, INC, WSP(bf16, WS_WIN), scr, r, lane, FIN(2));
            continue; } r -= I_IN;
        if (r < I_A) { p0_transpose_item(FIN(15), AW, D, WSP(bf16, WS_WA), scr, r, lane, nullptr); continue; } r -= I_A;
        if (r < I_A) { p0_transpose_item(FIN(16), RW, D, WSP(bf16, WS_WB), scr, r, lane, nullptr); continue; } r -= I_A;
        if (r < I_O) { p0_transpose_item(FIN(17), D, D, WSP(bf16, WS_WO), scr, r, lane, nullptr); continue; } r -= I_O;
        if (r < I_O) { p0_transpose_item<false, true>(FIN(26), D, D, WSP(bf16, WS_WG), scr, r, lane, FIN(25)); continue; } r -= I_O;
        p0_transpose_item(FIN(27), PLE, D, WSP(bf16, WS_WP), scr, r, lane, nullptr);
    }
    { const int gt = (F.vcu * 512 + F.tid), NT = F.G * 512;
      bf16* WL = WSP(bf16, WS_WL);
      for (int i = gt; i < LORA_N * LORA_K; i += NT) { const int n = i >> 8, k = i & 255; float v = 0.f;
          const int tl = n >> 8, md = tl % 3, cc = (tl / 3) * 256 + (n & 255);
          if (md == 0) { if (k < 64) v = FIN(6)[k * 512 + cc]; }
          else if (md == 1) { if (k >= 64 && k < 128) v = FIN(8)[(k - 64) * 512 + cc]; }
          else { if (k >= 128) v = FIN(9)[(k - 128) * 512 + cc]; }
          WL[i] = (bf16)(pk2(v, 0.f) & 0xffffu); }
      bf16* GW3 = WSP(bf16, WS_GW);
      for (int i = gt; i < D * NE; i += NT) { const int k = i >> 5, e = i & 31; const float w = FIN(19)[i] * FIN(18)[k];
          const unsigned h = pk2(w, 0.f) & 0xffffu; const float r1 = w - bflo(h); const unsigned m_ = pk2(r1, 0.f) & 0xffffu; const float r2 = r1 - bflo(m_); const unsigned l = pk2(r2, 0.f) & 0xffffu;
          GW3[e * D + k] = (bf16)h; GW3[NE * D + e * D + k] = (bf16)m_; GW3[2 * NE * D + e * D + k] = (bf16)l; }
    }
    { bf16* XB = WSP(bf16, WS_XB); float* R0 = WSP(float, WS_RSTD0); bf16* PB = WSP(bf16, WS_PB);
      for (int m = gw; m < M; m += NGW) {
          const f32x4* xr = (const f32x4*)(FIN(0) + (size_t)m * D) + lane;
          f32x4 v[4]; float s = 0.f;
#pragma unroll
          for (int j = 0; j < 4; ++j) { v[j] = xr[64 * j]; s += (v[j].x * v[j].x + v[j].y * v[j].y) + (v[j].z * v[j].z + v[j].w * v[j].w); }
          s = wave_sum(s);
          u32x2* o = (u32x2*)(XB + (size_t)m * D) + lane;
#pragma unroll
          for (int j = 0; j < 4; ++j) { if (G1_F8_TILES) (WSP(unsigned, WS_XB8) + (size_t)m * (D / 4))[lane + 64 * j] = pk8(v[j].x, v[j].y, v[j].z, v[j].w); u32x2 w; w.x = pk2(v[j].x, v[j].y); w.y = pk2(v[j].z, v[j].w); o[64 * j] = w; }
          if (lane == 0) R0[m] = 1.0f / sqrtf(s * (1.f / D) + RMS_EPS);
          const f32x4 pv = ((const f32x4*)(FIN(1) + (size_t)m * PLE))[lane];
          u32x2 w; w.x = pk2(pv.x, pv.y); w.y = pk2(pv.z, pv.w); ((u32x2*)(PB + (size_t)m * PLE))[lane] = w;
      }
    }
}

__device__ __forceinline__ void expert_convert(const Args& args, Frame& F, int wv, int NW, int which) {
    LAS float* scr = (LAS float*)(F.lds + F.wave * 16384);
    constexpr int I_W1 = (D / 64) * (F2 / 32), I_W2 = (FH / 64) * (D / 32);
    if (which & 1) for (int it = wv; it < NE * I_W1; it += NW) { const int e = it / I_W1; p0_transpose_item<true, true>(FIN(21) + (size_t)e * D * F2, D, F2, (bf16*)(WSP(unsigned char, WS_W1) + (size_t)e * F2 * D), scr, it % I_W1, F.lane, nullptr); }
    if (which & 2) for (int it = wv; it < NE * I_W2; it += NW) { const int e = it / I_W2; p0_transpose_item<false, true>(FIN(23) + (size_t)e * FH * D, FH, D, (bf16*)(WSP(unsigned char, WS_W2) + (size_t)e * D * FH), scr, it % I_W2, F.lane, nullptr); }
}
struct EpiG1 {
    static constexpr bool PERM = true;
    typedef PreF Pre; static constexpr bool LBIAS = false;
    const float* rstd; bf16 *Q, *K, *VT, *ZR, *GT; float rs_mul;
    __device__ __forceinline__ void pre(const Unit& u, int wr, int fr, PreF& P) const {
#pragma unroll
        for (int k = 0; k < 8; ++k) P.f[k] = rstd[u.pm * 256 + wr * 64 + fr + (k >> 2) * 128 + (k & 3) * 16] * rs_mul; }
    __device__ __forceinline__ void operator()(AccRef acc, const Unit& u, int wr, int wc, int fr, int fq, const Pre& P) const {
        const int pn = u.pn, rowb = u.pm * 256 + wr * 64 + fr, cl = wc * 32 + 8 * fq;
#pragma unroll
        for (int ai = 0; ai < 2; ++ai)
#pragma unroll
            for (int m = 0; m < 4; ++m) {
                const int row = rowb + ai * 128 + m * 16; const float rs = P.f[4 * ai + m];
                if (pn < 4) {
                    bf16* base = (pn < 2 ? Q : K) + (size_t)row * 512 + (pn & 1) * 256 + cl; const float sc = pn < 2 ? rs * 0.125f : rs;
#pragma unroll
                    for (int bj = 0; bj < 2; ++bj) { const f32x4 v0 = acc[ai][bj][m][0] * sc, v1 = acc[ai][bj][m][1] * sc;
                        u32x4 w; w.x = pk2(v0[0], v0[1]); w.y = pk2(v0[2], v0[3]); w.z = pk2(v1[0], v1[1]); w.w = pk2(v1[2], v1[3]); *(u32x4*)(base + bj * 128) = w; }
                } else if (pn < 6) {
                    const int b = row >> 11, s = row & 2047;
#pragma unroll
                    for (int bj = 0; bj < 2; ++bj)
#pragma unroll
                        for (int n = 0; n < 2; ++n)
#pragma unroll
                            for (int j = 0; j < 4; ++j) { const int c = (pn - 4) * 256 + cl + bj * 128 + 4 * n + j; const int hh = c >> 6, d = c & 63;
                                VT[((size_t)(((b * 8 + hh) * 128 + (s >> 4)) * 64 + d)) * 16 + (s & 15)] = (bf16)(pk2(acc[ai][bj][m][n][j] * rs, 0.f) & 0xffffu); }
                } else if (pn < 13) {
                    bf16* base = ZR + (size_t)row * RWC + (pn - 6) * 256 + cl;
#pragma unroll
                    for (int bj = 0; bj < 2; ++bj) { const f32x4 v0 = acc[ai][bj][m][0] * rs, v1 = acc[ai][bj][m][1] * rs;
                        u32x4 w; w.x = pk2(v0[0], v0[1]); w.y = pk2(v0[2], v0[3]); w.z = pk2(v1[0], v1[1]); w.w = pk2(v1[2], v1[3]); *(u32x4*)(base + bj * 128) = w; }
                } else {
                    bf16* base = GT + (size_t)row * 2048 + (pn - 13) * 256 + cl;
#pragma unroll
                    for (int bj = 0; bj < 2; ++bj) { const f32x4 v0 = acc[ai][bj][m][0] * rs, v1 = acc[ai][bj][m][1] * rs;
                        u32x4 w; w.x = pk2(sigm(v0[0]), sigm(v0[1])); w.y = pk2(sigm(v0[2]), sigm(v0[3])); w.z = pk2(sigm(v1[0]), sigm(v1[1])); w.w = pk2(sigm(v1[2]), sigm(v1[3])); *(u32x4*)(base + bj * 128) = w; }
                }
            }
    }
};
struct EpiLora {
    static constexpr bool PERM = true;
    typedef PreNone Pre; static constexpr bool LBIAS = false;
    __device__ __forceinline__ void pre(const Unit&, int, int, PreNone&) const {}
    const float *w0, *a0; bf16 *DEC, *AA, *GG;
    template <int MODE> __device__ __forceinline__ void body(AccRef acc, int rowb, int cb) const {
#pragma unroll
        for (int bj = 0; bj < 2; ++bj) {
            const int c = cb + bj * 128;
            f32x4 b0 = (f32x4){0.f, 0.f, 0.f, 0.f}, b1 = b0;
            if (MODE == 0) { b0 = *(const f32x4*)(w0 + c); b1 = *(const f32x4*)(w0 + c + 4); } else if (MODE == 1) { b0 = *(const f32x4*)(a0 + c); b1 = *(const f32x4*)(a0 + c + 4); }
#pragma unroll
            for (int ai = 0; ai < 2; ++ai)
#pragma unroll
                for (int m = 0; m < 4; ++m) { const int row = rowb + ai * 128 + m * 16;
                    const f32x4 v0 = acc[ai][bj][m][0] + b0, v1 = acc[ai][bj][m][1] + b1; float o[8];
#pragma unroll
                    for (int j = 0; j < 8; ++j) { const float v = j < 4 ? v0[j] : v1[j - 4];
                        if (MODE == 0) o[j] = 0.60653066f * sigm(v);
                        else if (MODE == 1) o[j] = sigm(v); else o[j] = v; }
                    u32x4 w; w.x = pk2(o[0], o[1]); w.y = pk2(o[2], o[3]); w.z = pk2(o[4], o[5]); w.w = pk2(o[6], o[7]);
                    bf16* dst = (MODE == 0 ? DEC : MODE == 1 ? AA : GG) + (size_t)row * 512 + c; *(u32x4*)dst = w;
                    asm volatile("" ::: "memory"); }
        }
    }
    __device__ __forceinline__ void operator()(AccRef acc, const Unit& u, int wr, int wc, int fr, int fq, const Pre& P) const {
        const int pn = u.pn, rowb = u.pm * 256 + wr * 64 + fr, cb = (pn >= 3 ? 256 : 0) + wc * 32 + 8 * fq;
        if (pn == 0 || pn == 3) body<0>(acc, rowb, cb); else if (pn == 1 || pn == 4) body<1>(acc, rowb, cb); else body<2>(acc, rowb, cb);
    }
};
template <int SECOND> struct EpiMerge {
    static constexpr bool PERM = true;
    typedef PreNone Pre; static constexpr bool LBIAS = false;
    __device__ __forceinline__ void pre(const Unit&, int, int, PreNone&) const {}
    const bf16* GT; bf16* MG;
    __device__ __forceinline__ void operator()(AccRef acc, const Unit& u, int wr, int wc, int fr, int fq, const Pre& P) const {
        const int rowb = u.pm * 256 + wr * 64 + fr, c0 = u.pn * 256 + wc * 32 + 8 * fq;
#pragma unroll
        for (int bj = 0; bj < 2; ++bj) {
            const int c = c0 + bj * 128; u32x4 gv[8], ov[8];
#pragma unroll
            for (int k = 0; k < 8; ++k) { const int row = rowb + (k >> 2) * 128 + (k & 3) * 16; gv[k] = *(const u32x4*)(GT + (size_t)row * 2048 + SECOND * 1024 + c); if (SECOND) ov[k] = *(const u32x4*)(MG + (size_t)row * 1024 + c); }
            __builtin_amdgcn_sched_barrier(0);
#pragma unroll
            for (int k = 0; k < 8; ++k) { const int ai = k >> 2, m = k & 3, row = rowb + ai * 128 + m * 16;
                const f32x4 v0 = acc[ai][bj][m][0], v1 = acc[ai][bj][m][1];
                float o[8] = {v0[0] * bflo(gv[k].x), v0[1] * bfhi(gv[k].x), v0[2] * bflo(gv[k].y), v0[3] * bfhi(gv[k].y), v1[0] * bflo(gv[k].z), v1[1] * bfhi(gv[k].z), v1[2] * bflo(gv[k].w), v1[3] * bfhi(gv[k].w)};
                if (SECOND) { o[0] += bflo(ov[k].x); o[1] += bfhi(ov[k].x); o[2] += bflo(ov[k].y); o[3] += bfhi(ov[k].y); o[4] += bflo(ov[k].z); o[5] += bfhi(ov[k].z); o[6] += bflo(ov[k].w); o[7] += bfhi(ov[k].w); }
                u32x4 w; w.x = pk2(o[0], o[1]); w.y = pk2(o[2], o[3]); w.z = pk2(o[4], o[5]); w.w = pk2(o[6], o[7]); *(u32x4*)(MG + (size_t)row * 1024 + c) = w; }
            __builtin_amdgcn_sched_barrier(0);
        }
    }
};
struct EpiX1 {
    static constexpr bool PERM = true;
    typedef PreNone Pre; static constexpr bool LBIAS = false;
    __device__ __forceinline__ void pre(const Unit&, int, int, PreNone&) const {}
    const bf16* X; bf16* X1; const float* gn; unsigned char* HN;
    __device__ __forceinline__ void operator()(AccRef acc, const Unit& u, int wr, int wc, int fr, int fq, const Pre& P) const {
        const int rowb = u.pm * 256 + wr * 64 + fr, c0 = u.pn * 256 + wc * 32 + 8 * fq;
#pragma unroll
        for (int bj = 0; bj < 2; ++bj) { const f32x4 g0 = *(const f32x4*)(gn + c0 + bj * 128), g1 = *(const f32x4*)(gn + c0 + bj * 128 + 4);
#pragma unroll
            for (int ai = 0; ai < 2; ++ai) {
                u32x4 xw_[4];
#pragma unroll
                for (int m = 0; m < 4; ++m) { const size_t off = (size_t)(rowb + ai * 128 + m * 16) * D + c0 + bj * 128; xw_[m] = *(const u32x4*)(X + off); }
                __builtin_amdgcn_sched_barrier(0);
#pragma unroll
                for (int m = 0; m < 4; ++m) { const size_t off = (size_t)(rowb + ai * 128 + m * 16) * D + c0 + bj * 128;
                    const f32x4 x0 = (f32x4){bflo(xw_[m].x), bfhi(xw_[m].x), bflo(xw_[m].y), bfhi(xw_[m].y)} + acc[ai][bj][m][0], x1 = (f32x4){bflo(xw_[m].z), bfhi(xw_[m].z), bflo(xw_[m].w), bfhi(xw_[m].w)} + acc[ai][bj][m][1];
                    { u32x4 xw; xw.x = pk2(x0[0], x0[1]); xw.y = pk2(x0[2], x0[3]); xw.z = pk2(x1[0], x1[1]); xw.w = pk2(x1[2], x1[3]); *(u32x4*)(X1 + off) = xw; }
                    u32x2 w; w.x = pk8(x0[0] * g0[0], x0[1] * g0[1], x0[2] * g0[2], x0[3] * g0[3]); w.y = pk8(x1[0] * g1[0], x1[1] * g1[1], x1[2] * g1[2], x1[3] * g1[3]); *(u32x2*)(HN + off) = w; }
                __builtin_amdgcn_sched_barrier(0);
            }
        }
    }
};
struct EpiSwiglu {
    static constexpr bool PERM = true;
    typedef PreF Pre; static constexpr bool LBIAS = true;
    const float* b1; unsigned char* ACT; const int* LIST; const float* R1; const LAS int* OFF; const LAS int* CS; const LAS float* LB;
    __device__ __forceinline__ const float* bias_tile(const Unit& u) const { return b1 + (size_t)u.e * F2 + u.pn * 256; }
    __device__ __forceinline__ void pre(const Unit& u, int wr, int fr, PreF& P) const {
        const int rbase = u.pm * 256 + wr * 64 + fr - OFF[u.e], cnt = CS[u.e];
#pragma unroll
        for (int k = 0; k < 8; ++k) { const int r = rbase + (k >> 2) * 128 + (k & 3) * 16; P.f[k] = 0.f; if (r < cnt) P.f[k] = R1[(size_t)u.e * CAP + r] * (1.f / 64.f); } }
    __device__ __forceinline__ void operator()(AccRef acc, const Unit& u, int wr, int wc, int fr, int fq, const Pre& P) const {
        if (EPI_STUB & 1) return;
        const int rowb = u.pm * 256 + wr * 64 + fr, c0 = u.pn * 256 + wc * 64 + 16 * fq;
        const LAS float* bb = LB + 256 * u.par + wc * 64 + 16 * fq;
        const f32x4 bv0 = *(const LAS f32x4*)(bb), bv1 = *(const LAS f32x4*)(bb + 4), bv2 = *(const LAS f32x4*)(bb + 8), bv3 = *(const LAS f32x4*)(bb + 12);
#pragma unroll
        for (int ai = 0; ai < 2; ++ai)
#pragma unroll
            for (int m = 0; m < 4; ++m) { const int row = rowb + ai * 128 + m * 16; const float rs = P.f[4 * ai + m];
                const f32x4 v[4] = {acc[ai][0][m][0] * rs + bv0, acc[ai][0][m][1] * rs + bv1, acc[ai][1][m][0] * rs + bv2, acc[ai][1][m][1] * rs + bv3};
                float o[8];
#pragma unroll
                for (int p = 0; p < 8; ++p) { float gl = v[p >> 1][2 * (p & 1)], ul = v[p >> 1][2 * (p & 1) + 1];
                    gl = fminf(gl, 7.f); ul = fminf(fmaxf(ul, -7.f), 7.f); o[p] = (ul + 1.f) * gl * sigm(1.702f * gl); }
                u32x2 w; w.x = pk8(o[0], o[1], o[2], o[3]); w.y = pk8(o[4], o[5], o[6], o[7]); *(u32x2*)(ACT + (size_t)row * FH + (c0 >> 1)) = w;
                asm volatile("" ::: "memory"); }
    }
};
struct EpiY {
    static constexpr bool PERM = true;
    typedef PreI Pre; static constexpr bool LBIAS = true;
    const float* b2; const int* LIST; const float* gatew; unsigned char* YB; const LAS int* OFF; const LAS int* CS; const LAS float* LB;
    __device__ __forceinline__ const float* bias_tile(const Unit& u) const { return b2 + (size_t)u.e * D + u.pn * 256; }
    __device__ __forceinline__ void pre(const Unit& u, int wr, int fr, PreI& P) const {
        const int rbase = u.pm * 256 + wr * 64 + fr - OFF[u.e], cnt = CS[u.e];
#pragma unroll
        for (int k = 0; k < 8; ++k) { const int r = rbase + (k >> 2) * 128 + (k & 3) * 16; P.i[k] = -1; if (r < cnt) P.i[k] = LIST[(size_t)u.e * CAP + r]; } }
    __device__ __forceinline__ void operator()(AccRef acc, const Unit& u, int wr, int wc, int fr, int fq, const Pre& P) const {
        const int rowb = u.pm * 256 + wr * 64 + fr, c0 = u.pn * 256 + wc * 32 + 8 * fq;
        const LAS float* bb = LB + 256 * u.par + wc * 32 + 8 * fq; const int rbase = rowb - OFF[u.e];
        if (EPI_STUB & 2) return;

#pragma unroll
        for (int ai = 0; ai < 2; ++ai) {
            float gts[4];
#pragma unroll
            for (int m = 0; m < 4; ++m) { gts[m] = 0.f; if (P.i[4 * ai + m] >= 0) gts[m] = gatew[(size_t)u.e * CAP + rbase + ai * 128 + m * 16]; }
            __builtin_amdgcn_sched_barrier(0);
#pragma unroll
            for (int m = 0; m < 4; ++m) {
                const int slot = P.i[4 * ai + m]; if (slot >= 0) { const float gt = gts[m] * 32.f;
#pragma unroll
                    for (int bj = 0; bj < 2; ++bj) { const int c = c0 + bj * 128;
                        const f32x4 v0 = (acc[ai][bj][m][0] * (1.f / 64.f) + *(const LAS f32x4*)(bb + bj * 128)) * gt, v1 = (acc[ai][bj][m][1] * (1.f / 64.f) + *(const LAS f32x4*)(bb + bj * 128 + 4)) * gt;
                        u32x2 w; w.x = pk8(v0[0], v0[1], v0[2], v0[3]); w.y = pk8(v1[0], v1[1], v1[2], v1[3]); *(u32x2*)(YB + (size_t)slot * D + c) = w; } } }
            __builtin_amdgcn_sched_barrier(0); }
    }
};
struct EpiGate {
    static constexpr bool PERM = true;
    typedef PreF Pre; static constexpr bool LBIAS = false;
    __device__ __forceinline__ void pre(const Unit& u, int wr, int fr, PreF& P) const {
#pragma unroll
        for (int k = 0; k < 8; ++k) P.f[k] = rstd2[u.pm * 256 + wr * 64 + fr + (k >> 2) * 128 + (k & 3) * 16] * (1.f / 64.f); }
    const float* rstd2; bf16* GT;
    __device__ __forceinline__ void operator()(AccRef acc, const Unit& u, int wr, int wc, int fr, int fq, const Pre& P) const {
        const int rowb = u.pm * 256 + wr * 64 + fr, c0 = u.pn * 256 + wc * 32 + 8 * fq;
#pragma unroll
        for (int ai = 0; ai < 2; ++ai)
#pragma unroll
            for (int m = 0; m < 4; ++m) { const int row = rowb + ai * 128 + m * 16; const float rs = P.f[4 * ai + m];
#pragma unroll
                for (int bj = 0; bj < 2; ++bj) { const f32x4 v0 = acc[ai][bj][m][0] * rs, v1 = acc[ai][bj][m][1] * rs;
                    u32x4 w; w.x = pk2(sigm(v0[0]), sigm(v0[1])); w.y = pk2(sigm(v0[2]), sigm(v0[3])); w.z = pk2(sigm(v1[0]), sigm(v1[1])); w.w = pk2(sigm(v1[2]), sigm(v1[3]));
                    *(u32x4*)(GT + (size_t)row * D + c0 + bj * 128) = w; } }
    }
};
struct EpiPle {
    static constexpr bool PERM = true;
    typedef PreNone Pre; static constexpr bool LBIAS = false;
    __device__ __forceinline__ void pre(const Unit&, int, int, PreNone&) const {}
    const bf16* X2B; const bf16* GT; float* O; float* rowss; unsigned* pcnt; const float* fg; const unsigned* ctl;
    __device__ __forceinline__ void operator()(f32x4 (&acc)[2][2][4][2], const Unit& u, int wr, int wc, int fr, int fq, const Pre& P) const {
        const int rowb = u.pm * 256 + wr * 64 + fr, c0 = u.pn * 256 + wc * 32 + 8 * fq;
#pragma unroll
        for (int ai = 0; ai < 2; ++ai)
#pragma unroll
            for (int m = 0; m < 4; ++m) { const int row = rowb + ai * 128 + m * 16; float ss = 0.f;
#pragma unroll
                for (int bj = 0; bj < 2; ++bj) { const size_t off = (size_t)row * D + c0 + bj * 128;
                    const u32x4 xv = *(const u32x4*)(X2B + off), gv = *(const u32x4*)(GT + off); f32x4 a0 = acc[ai][bj][m][0], a1 = acc[ai][bj][m][1];
                    a0[0] = bflo(xv.x) + bflo(gv.x) * a0[0]; a0[1] = bfhi(xv.x) + bfhi(gv.x) * a0[1]; a0[2] = bflo(xv.y) + bflo(gv.y) * a0[2]; a0[3] = bfhi(xv.y) + bfhi(gv.y) * a0[3];
                    a1[0] = bflo(xv.z) + bflo(gv.z) * a1[0]; a1[1] = bfhi(xv.z) + bfhi(gv.z) * a1[1]; a1[2] = bflo(xv.w) + bflo(gv.w) * a1[2]; a1[3] = bfhi(xv.w) + bfhi(gv.w) * a1[3];
#pragma unroll
                    for (int j = 0; j < 4; ++j) ss += a0[j] * a0[j] + a1[j] * a1[j];
                    acc[ai][bj][m][0] = a0; acc[ai][bj][m][1] = a1; }
                ss += __shfl_xor(ss, 16); ss += __shfl_xor(ss, 32);
                if (fq == 0) atomicAdd(rowss + row, ss);
                asm volatile("" ::: "memory"); }
        asm volatile("s_waitcnt vmcnt(0)" ::: "memory");
        __builtin_amdgcn_s_barrier();
        if (wr == 0 && wc == 0) {
            unsigned* pc = pcnt + 64 * u.pm;
            if (fr == 0 && fq == 0) __hip_atomic_fetch_add(pc, 1u, RLX_AGENT);
            unsigned spins = 0; while ((unsigned)__builtin_amdgcn_readfirstlane(__hip_atomic_load(pc, RLX_AGENT)) < 4u && ++spins < (1u << 20)) __builtin_amdgcn_s_sleep(4);
        }
        asm volatile("s_waitcnt vmcnt(0)" ::: "memory");
        __builtin_amdgcn_s_barrier();
        asm volatile("" ::: "memory");
#pragma unroll
        for (int ai = 0; ai < 2; ++ai)
#pragma unroll
            for (int m = 0; m < 4; ++m) { const int row = rowb + ai * 128 + m * 16; const float rs = 1.0f / sqrtf(__hip_atomic_load(rowss + row, RLX_AGENT) * (1.f / D) + RMS_EPS);
#pragma unroll
                for (int bj = 0; bj < 2; ++bj) { const size_t off = (size_t)row * D + c0 + bj * 128;
                    f32x4 o0 = acc[ai][bj][m][0] * rs * *(const f32x4*)(fg + c0 + bj * 128), o1 = acc[ai][bj][m][1] * rs * *(const f32x4*)(fg + c0 + bj * 128 + 4);
                    if (TS_PROBE >= 0 && row == 0 && c0 == 0 && bj == 0) { const unsigned long long* ts = (const unsigned long long*)(ctl + 2048); const unsigned long long dt = ts[TS_END_SLOT] - ts[TS_PROBE]; o0[0] += (float)((dt + 300) / 1600) * 4.f; }
                    *(f32x4*)(O + off) = o0; *(f32x4*)(O + off + 4) = o1; }
                asm volatile("" ::: "memory"); }
    }
};

__device__ __forceinline__ void build_alora(const Args& args, Frame& F, int pm) {
    const bf16* ZR = WSP(bf16, WS_ZR); bf16* AL = WSP(bf16, WS_ALORA); const float* mu = FIN(4) + 1536;
#pragma unroll 1
    for (int half = 0; half < 2; ++half) {
        u32x4 zc[8], zp[8];
#pragma unroll
        for (int i = 0; i < 8; ++i) {
            const int id = F.tid + 512 * (8 * half + i), row = pm * 256 + (id >> 5), cc = (id & 31) * 8;
            zc[i] = *(const u32x4*)(ZR + (size_t)row * RWC + 1536 + cc);
            zp[i] = (u32x4){0u, 0u, 0u, 0u}; if ((row & (SEQ - 1)) != 0) zp[i] = *(const u32x4*)(ZR + (size_t)(row - 1) * RWC + 1536 + cc);
        }
#pragma unroll
        for (int i = 0; i < 8; ++i) {
            const int id = F.tid + 512 * (8 * half + i), row = pm * 256 + (id >> 5), cc = (id & 31) * 8;
            const unsigned zcw[4] = {zc[i].x, zc[i].y, zc[i].z, zc[i].w}, zpw[4] = {zp[i].x, zp[i].y, zp[i].z, zp[i].w}; float o[8];
#pragma unroll
            for (int j = 0; j < 8; ++j) { const float c = (j & 1) ? bfhi(zcw[j >> 1]) : bflo(zcw[j >> 1]), p = (j & 1) ? bfhi(zpw[j >> 1]) : bflo(zpw[j >> 1]);
                const float xs = c + mu[cc + j] * (p - c);
                o[j] = cc < 64 ? (1.f - 2.f * __builtin_amdgcn_rcpf(1.f + __expf(2.f * xs))) : (cc < 128 ? xs : sigm(xs)); }
            u32x4 w; w.x = pk2(o[0], o[1]); w.y = pk2(o[2], o[3]); w.z = pk2(o[4], o[5]); w.w = pk2(o[6], o[7]);
            *(u32x4*)(AL + (size_t)row * LORA_K + cc) = w;
        }
    }
}

__device__ __forceinline__ void scan_unit(const Args& args, Frame& F, int bh) {
    const int b = bh >> 3, h = bh & 7, tid = F.tid;
    LAS float* LW = (LAS float*)F.lds;
    LAS float* LKK = LW + 4096, *LBB = LW + 8192, *LKP = LW + 12288, *LRR = LW + 16384, *LVV = LW + 20480, *LYY = LW + 24576, *LBON = LW + 28672;
    const bf16* ZR = WSP(bf16, WS_ZR); const bf16* DEC = WSP(bf16, WS_DEC); const bf16* AA = WSP(bf16, WS_AA); const bf16* GG = WSP(bf16, WS_GG); bf16* YB = WSP(bf16, WS_YB);
    const float* mu = FIN(4); const float* k_k = FIN(10) + h * 64; const float* k_a = FIN(11) + h * 64; const float* r_k = FIN(12) + h * 64;
    const float* lnw = FIN(13) + h * 64; const float* lnb = FIN(14) + h * 64;
    const int tt_p = tid >> 3, j0 = 8 * (tid & 7);
    const int row = tid >> 3, cg = tid & 7;
    float S[8];
#pragma unroll
    for (int j = 0; j < 8; ++j) S[j] = 0.f;
    float mur[8], muk[8], muv[8], kk_c[8], ka_c[8], rk_c[8];
#pragma unroll
    for (int j = 0; j < 8; ++j) { mur[j] = mu[h * 64 + j0 + j]; muk[j] = mu[512 + h * 64 + j0 + j]; muv[j] = mu[1024 + h * 64 + j0 + j]; kk_c[j] = k_k[j0 + j]; ka_c[j] = k_a[j0 + j]; rk_c[j] = r_k[j0 + j]; }
    for (int c0 = 0; c0 < SEQ; c0 += 64) {
        __syncthreads();
        {
            const size_t tok = (size_t)b * SEQ + c0 + tt_p; const bool first = (c0 + tt_p) == 0;
            const bf16* zc = ZR + tok * RWC + h * 64 + j0; const bf16* zp = zc - RWC;
            u32x4 cr = *(const u32x4*)zc, ck = *(const u32x4*)(zc + 512), cv = *(const u32x4*)(zc + 1024);
            u32x4 pr = (u32x4){0u, 0u, 0u, 0u}, pk = pr, pv = pr;
            if (!first) { pr = *(const u32x4*)zp; pk = *(const u32x4*)(zp + 512); pv = *(const u32x4*)(zp + 1024); }
            const f32x4 d0 = *(const f32x4*)(DEC + tok * 512 + h * 64 + j0), d1 = *(const f32x4*)(DEC + tok * 512 + h * 64 + j0 + 4);
            const f32x4 a0 = *(const f32x4*)(AA + tok * 512 + h * 64 + j0), a1 = *(const f32x4*)(AA + tok * 512 + h * 64 + j0 + 4);
            const unsigned crw[4] = {cr.x, cr.y, cr.z, cr.w}, ckw[4] = {ck.x, ck.y, ck.z, ck.w}, cvw[4] = {cv.x, cv.y, cv.z, cv.w};
            const unsigned prw[4] = {pr.x, pr.y, pr.z, pr.w}, pkw[4] = {pk.x, pk.y, pk.z, pk.w}, pvw[4] = {pv.x, pv.y, pv.z, pv.w};
            float r[8], k[8], v[8], kk[8], a[8], dec[8]; float ss = 0.f;
#pragma unroll
            for (int j = 0; j < 8; ++j) {
                const float rc = (j & 1) ? bfhi(crw[j >> 1]) : bflo(crw[j >> 1]), rp = (j & 1) ? bfhi(prw[j >> 1]) : bflo(prw[j >> 1]);
                const float kc = (j & 1) ? bfhi(ckw[j >> 1]) : bflo(ckw[j >> 1]), kp = (j & 1) ? bfhi(pkw[j >> 1]) : bflo(pkw[j >> 1]);
                const float vc = (j & 1) ? bfhi(cvw[j >> 1]) : bflo(cvw[j >> 1]), vp = (j & 1) ? bfhi(pvw[j >> 1]) : bflo(pvw[j >> 1]);
                r[j] = rc + mur[j] * (rp - rc); k[j] = kc + muk[j] * (kp - kc); v[j] = vc + muv[j] * (vp - vc);
                kk[j] = k[j] * kk_c[j]; ss += kk[j] * kk[j];
                a[j] = j < 4 ? a0[j] : a1[j - 4]; dec[j] = j < 4 ? d0[j] : d1[j - 4];
            }
            ss = red8(ss);
            const float inv = 1.0f / fmaxf(sqrtf(ss), 1e-12f);
            float bon = 0.f; float kpv[8], bbv[8];
#pragma unroll
            for (int j = 0; j < 8; ++j) { kk[j] *= inv; bbv[j] = kk[j] * a[j]; kpv[j] = k[j] * (1.f + (a[j] - 1.f) * ka_c[j]); bon += r[j] * kpv[j] * rk_c[j]; }
            bon = red8(bon);
            const int o = tt_p * 64 + j0;
            *(LAS f32x4*)(LW + o) = (f32x4){dec[0], dec[1], dec[2], dec[3]}; *(LAS f32x4*)(LW + o + 4) = (f32x4){dec[4], dec[5], dec[6], dec[7]};
            *(LAS f32x4*)(LKK + o) = (f32x4){kk[0], kk[1], kk[2], kk[3]}; *(LAS f32x4*)(LKK + o + 4) = (f32x4){kk[4], kk[5], kk[6], kk[7]};
            *(LAS f32x4*)(LBB + o) = (f32x4){bbv[0], bbv[1], bbv[2], bbv[3]}; *(LAS f32x4*)(LBB + o + 4) = (f32x4){bbv[4], bbv[5], bbv[6], bbv[7]};
            *(LAS f32x4*)(LKP + o) = (f32x4){kpv[0], kpv[1], kpv[2], kpv[3]}; *(LAS f32x4*)(LKP + o + 4) = (f32x4){kpv[4], kpv[5], kpv[6], kpv[7]};
            *(LAS f32x4*)(LRR + o) = (f32x4){r[0], r[1], r[2], r[3]}; *(LAS f32x4*)(LRR + o + 4) = (f32x4){r[4], r[5], r[6], r[7]};
            *(LAS f32x4*)(LVV + o) = (f32x4){v[0], v[1], v[2], v[3]}; *(LAS f32x4*)(LVV + o + 4) = (f32x4){v[4], v[5], v[6], v[7]};
            if ((tid & 7) == 0) LBON[tt_p] = bon;
        }
        __syncthreads();
#pragma unroll 2
        for (int tt = 0; tt < 64; ++tt) {
            const int o = tt * 64 + 8 * cg;
            const f32x4 k0 = *(const LAS f32x4*)(LKK + o), k1 = *(const LAS f32x4*)(LKK + o + 4);
            const f32x4 w0 = *(const LAS f32x4*)(LW + o), w1 = *(const LAS f32x4*)(LW + o + 4);
            const f32x4 b0 = *(const LAS f32x4*)(LBB + o), b1 = *(const LAS f32x4*)(LBB + o + 4);
            const f32x4 p0 = *(const LAS f32x4*)(LKP + o), p1 = *(const LAS f32x4*)(LKP + o + 4);
            const f32x4 r0 = *(const LAS f32x4*)(LRR + o), r1 = *(const LAS f32x4*)(LRR + o + 4);
            const float vi = LVV[tt * 64 + row];
            float sa = (S[0] * k0[0] + S[1] * k0[1]) + (S[2] * k0[2] + S[3] * k0[3]) + (S[4] * k1[0] + S[5] * k1[1]) + (S[6] * k1[2] + S[7] * k1[3]);
            sa = -red8(sa);
#pragma unroll
            for (int j = 0; j < 4; ++j) { S[j] = S[j] * w0[j] + (sa * b0[j] + vi * p0[j]); S[4 + j] = S[4 + j] * w1[j] + (sa * b1[j] + vi * p1[j]); }
            float y = (S[0] * r0[0] + S[1] * r0[1]) + (S[2] * r0[2] + S[3] * r0[3]) + (S[4] * r1[0] + S[5] * r1[1]) + (S[6] * r1[2] + S[7] * r1[3]);
            y = red8(y);
            if (cg == 0) LYY[tt * 64 + row] = y;
        }
        __syncthreads();
        {
            const size_t tok = (size_t)b * SEQ + c0 + tt_p; const int o = tt_p * 64 + j0;
            const f32x4 y0 = *(const LAS f32x4*)(LYY + o), y1 = *(const LAS f32x4*)(LYY + o + 4);
            const f32x4 v0 = *(const LAS f32x4*)(LVV + o), v1 = *(const LAS f32x4*)(LVV + o + 4);
            float s = (y0[0] + y0[1]) + (y0[2] + y0[3]) + (y1[0] + y1[1]) + (y1[2] + y1[3]);
            const float mean = red8(s) * (1.f / 64.f); float q = 0.f;
#pragma unroll
            for (int j = 0; j < 4; ++j) { const float d0 = y0[j] - mean, d1 = y1[j] - mean; q += d0 * d0 + d1 * d1; }
            const float rs = 1.0f / sqrtf(red8(q) * (1.f / 64.f) + GN_EPS); const float bon = LBON[tt_p];
            const u32x4 gv = *(const u32x4*)(GG + tok * 512 + h * 64 + j0); const unsigned gw[4] = {gv.x, gv.y, gv.z, gv.w}; float ov[8];
#pragma unroll
            for (int j = 0; j < 8; ++j) { const float yy = j < 4 ? y0[j] : y1[j - 4], vv = j < 4 ? v0[j] : v1[j - 4]; const float g = (j & 1) ? bfhi(gw[j >> 1]) : bflo(gw[j >> 1]);
                ov[j] = ((yy - mean) * rs * lnw[j0 + j] + lnb[j0 + j] + bon * vv) * g; }
            u32x4 w; w.x = pk2(ov[0], ov[1]); w.y = pk2(ov[2], ov[3]); w.z = pk2(ov[4], ov[5]); w.w = pk2(ov[6], ov[7]);
            *(u32x4*)(YB + tok * 512 + h * 64 + j0) = w;
        }
    }
    __syncthreads();
}

constexpr int LDA = 72, LDT = 40, LDF = 36;
constexpr int SC_WF = 0, SC_AT = 8192, SC_RT = SC_AT + 4608, SC_BT = SC_RT + 4608, SC_KT = SC_BT + 4608;
constexpr int SC_BCT = SC_KT + 4608, SC_KCT = SC_BCT + 5120, SC_VT = SC_KCT + 5120, SC_AHT = SC_VT + 5120, SC_UHT = SC_AHT + 5120;
constexpr int SC_AAB = SC_UHT + 5120, SC_ARB = SC_AAB + 4608, SC_ARK = SC_ARB + 2560, SC_RHS2 = SC_ARK + 2560, SC_YF = SC_RHS2 + 16384, SC_HT = SC_YF + 8192, SC_BON = SC_HT + 9216;
static_assert(SC_BON + 128 + 2048 <= RING_BYTES, "scan LDS map");
__device__ __forceinline__ float red16(float v) { v += dppf<0xB1>(v); v += dppf<0x4E>(v); v += dppf<0x141>(v); v += dppf<0x140>(v); return v; }
__device__ __forceinline__ bf16x8 ld16(const LAS bf16* p) { return *(const LAS bf16x8*)p; }
__device__ __forceinline__ bf16x8 ld8x2(const LAS bf16* p) { const u32x2 lo = *(const LAS u32x2*)p, hi = *(const LAS u32x2*)(p + 8); const u32x4 w = (u32x4){lo.x, lo.y, hi.x, hi.y}; return __builtin_bit_cast(bf16x8, w); }
__device__ __forceinline__ bf16x8 packq(const f32x16& x, int q) { u32x4 w; w.x = pk2(x[8 * q], x[8 * q + 1]); w.y = pk2(x[8 * q + 2], x[8 * q + 3]); w.z = pk2(x[8 * q + 4], x[8 * q + 5]); w.w = pk2(x[8 * q + 6], x[8 * q + 7]); return __builtin_bit_cast(bf16x8, w); }
#define MFMA32(a, b, c) __builtin_amdgcn_mfma_f32_32x32x16_bf16((a), (b), (c), 0, 0, 0)
struct ScanLoad { u32x2 cr, ck, cv, pr, pk, pv, g, decb, etab; f32x4 dec, eta; };
__device__ __forceinline__ void scan_load(ScanLoad& L, const bf16* ZR, const bf16* DEC, const bf16* AA, const bf16* GG, size_t tok, int hc, bool first) {
    const bf16* zc = ZR + tok * RWC + hc; const bf16* zp = zc - RWC;
    L.cr = *(const u32x2*)zc; L.ck = *(const u32x2*)(zc + 512); L.cv = *(const u32x2*)(zc + 1024);
    L.pr = (u32x2){0u, 0u}; L.pk = L.pr; L.pv = L.pr;
    if (!first) { L.pr = *(const u32x2*)zp; L.pk = *(const u32x2*)(zp + 512); L.pv = *(const u32x2*)(zp + 1024); }
    L.decb = *(const u32x2*)(DEC + tok * 512 + hc); L.etab = *(const u32x2*)(AA + tok * 512 + hc); L.g = *(const u32x2*)(GG + tok * 512 + hc);
}
#define LBAR() do { asm volatile("s_waitcnt lgkmcnt(0)" ::: "memory"); __builtin_amdgcn_s_barrier(); asm volatile("" ::: "memory"); } while (0)
typedef short v4i16_t __attribute__((ext_vector_type(4)));
__device__ __forceinline__ bf16x8 trfrag(const LAS bf16* X, int k0a, int k0b, int cbase, int lane) {
    const int g = lane >> 4, i = lane & 15, col = cbase + 16 * (g & 1) + 4 * (i & 3), rq = i >> 2;
    const v4i16_t lo = __builtin_amdgcn_ds_read_tr16_b64_v4i16((LAS v4i16_t*)(X + (k0a + rq) * LDA + col));
    const v4i16_t hi = __builtin_amdgcn_ds_read_tr16_b64_v4i16((LAS v4i16_t*)(X + (k0b + rq) * LDA + col));
    return (bf16x8){lo[0], lo[1], lo[2], lo[3], hi[0], hi[1], hi[2], hi[3]};
}
__device__ __forceinline__ void scan_unit_chunked(const Args& args, Frame& F, int bh) {
    const int b = bh >> 3, h = bh & 7, tid = F.tid, w = F.wave;
    LAS unsigned char* L = F.lds;
    LAS float* WF = (LAS float*)(L + SC_WF); LAS float* AAB = (LAS float*)(L + SC_AAB); LAS float* RHS2 = (LAS float*)(L + SC_RHS2); LAS float* YF = (LAS float*)(L + SC_YF); LAS float* BON = (LAS float*)(L + SC_BON);
    LAS bf16* AT = (LAS bf16*)(L + SC_AT); LAS bf16* RT = (LAS bf16*)(L + SC_RT); LAS bf16* BT = (LAS bf16*)(L + SC_BT); LAS bf16* KT = (LAS bf16*)(L + SC_KT);
    LAS bf16* BCT = (LAS bf16*)(L + SC_BCT); LAS bf16* KCT = (LAS bf16*)(L + SC_KCT); LAS bf16* VT = (LAS bf16*)(L + SC_VT); LAS bf16* AHT = (LAS bf16*)(L + SC_AHT); LAS bf16* UHT = (LAS bf16*)(L + SC_UHT);
    LAS bf16* ARB = (LAS bf16*)(L + SC_ARB); LAS bf16* ARK = (LAS bf16*)(L + SC_ARK); LAS bf16* HT = (LAS bf16*)(L + SC_HT);
    const bf16* ZR = WSP(bf16, WS_ZR); const bf16* DEC = WSP(bf16, WS_DEC); const bf16* AA = WSP(bf16, WS_AA); const bf16* GG = WSP(bf16, WS_GG); bf16* YB = WSP(bf16, WS_YB);
    const int t = tid >> 4, j0 = 4 * (tid & 15), hc = h * 64 + j0;
    LAS float* CST = (LAS float*)(L + SC_BON + 128);
    { const int c = tid >> 6, j = tid & 63; const float* src = c == 0 ? FIN(4) : c == 1 ? FIN(4) + 512 : c == 2 ? FIN(4) + 1024 : c == 3 ? FIN(10) : c == 4 ? FIN(11) : c == 5 ? FIN(12) : c == 6 ? FIN(13) : FIN(14);
      CST[c * 64 + j] = src[h * 64 + j]; }
    for (int i = tid; i < 64 * LDA / 2; i += 512) ((LAS unsigned*)HT)[i] = 0u;
    ScanLoad cur; scan_load(cur, ZR, DEC, AA, GG, (size_t)b * SEQ + t, hc, t == 0);
    LBAR();
    u32x2 pend = (u32x2){0u, 0u};
    for (int c0 = 0; c0 < SEQ; c0 += 32) {
        const size_t tok = (size_t)b * SEQ + c0 + t;
        float r[4], kp[4], v[4], al[4], be[4], gq[4]; f32x4 gl, gpl;
        {
            cur.dec = (f32x4){__expf(-bflo(cur.decb.x)), __expf(-bfhi(cur.decb.x)), __expf(-bflo(cur.decb.y)), __expf(-bfhi(cur.decb.y))};
            cur.eta = (f32x4){bflo(cur.etab.x), bfhi(cur.etab.x), bflo(cur.etab.y), bfhi(cur.etab.y)};
            const f32x4 mur = *(const LAS f32x4*)(CST + j0), muk = *(const LAS f32x4*)(CST + 64 + j0), muv = *(const LAS f32x4*)(CST + 128 + j0), kkc = *(const LAS f32x4*)(CST + 192 + j0), kac = *(const LAS f32x4*)(CST + 256 + j0), rkc = *(const LAS f32x4*)(CST + 320 + j0);
            const unsigned crw[2] = {cur.cr.x, cur.cr.y}, ckw[2] = {cur.ck.x, cur.ck.y}, cvw[2] = {cur.cv.x, cur.cv.y}, prw[2] = {cur.pr.x, cur.pr.y}, pkw[2] = {cur.pk.x, cur.pk.y}, pvw[2] = {cur.pv.x, cur.pv.y}, gw2[2] = {cur.g.x, cur.g.y};
            float k[4], kk[4]; float ss = 0.f;
#pragma unroll
            for (int j = 0; j < 4; ++j) {
                const float rc = (j & 1) ? bfhi(crw[j >> 1]) : bflo(crw[j >> 1]), rp = (j & 1) ? bfhi(prw[j >> 1]) : bflo(prw[j >> 1]);
                const float kc = (j & 1) ? bfhi(ckw[j >> 1]) : bflo(ckw[j >> 1]), kq = (j & 1) ? bfhi(pkw[j >> 1]) : bflo(pkw[j >> 1]);
                const float vc = (j & 1) ? bfhi(cvw[j >> 1]) : bflo(cvw[j >> 1]), vq = (j & 1) ? bfhi(pvw[j >> 1]) : bflo(pvw[j >> 1]);
                r[j] = rc + mur[j] * (rp - rc); k[j] = kc + muk[j] * (kq - kc); v[j] = vc + muv[j] * (vq - vc);
                kk[j] = k[j] * kkc[j]; ss += kk[j] * kk[j]; gq[j] = (j & 1) ? bfhi(gw2[j >> 1]) : bflo(gw2[j >> 1]);
            }
            ss = red16(ss);
            const float inv = __builtin_amdgcn_rsqf(fmaxf(ss, 1e-24f)); float bon = 0.f;
#pragma unroll
            for (int j = 0; j < 4; ++j) { kk[j] *= inv; al[j] = -kk[j]; be[j] = kk[j] * cur.eta[j]; kp[j] = k[j] * (1.f + (cur.eta[j] - 1.f) * kac[j]); bon += r[j] * kp[j] * rkc[j]; }
            bon = red16(bon);
            gl = cur.dec; gpl = (f32x4){1.f, 1.f, 1.f, 1.f};
            { const int ln = tid & 63;
#pragma unroll
              for (int j = 0; j < 4; ++j) { const float u1 = __shfl_up(gl[j], 16); gl[j] = (ln >= 16) ? gl[j] * u1 : gl[j]; }
#pragma unroll
              for (int j = 0; j < 4; ++j) { const float u2 = __shfl_up(gl[j], 32); gl[j] = (ln >= 32) ? gl[j] * u2 : gl[j]; }
#pragma unroll
              for (int j = 0; j < 4; ++j) { const float u3 = __shfl_up(gl[j], 16); gpl[j] = (ln >= 16) ? u3 : 1.f; }
              if (ln >= 48) *(LAS f32x4*)(WF + w * 64 + j0) = gl; }
            if ((tid & 15) == 0) BON[t] = bon;
        }
        if (c0 + 32 < SEQ && !(SCAN_STUB & 32)) scan_load(cur, ZR, DEC, AA, GG, tok + 32, hc, false);
        if (c0 > 0) { const bf16* yp = YB + (tok - 32) * 512 + hc; asm volatile("global_store_dwordx2 %0, %1, off" :: "v"(yp), "v"(pend) : "memory"); }
        LBAR();
        {
            f32x4 pre = (f32x4){1.f, 1.f, 1.f, 1.f}, gC = pre;
#pragma unroll
            for (int ww = 0; ww < 8; ++ww) { const f32x4 wt = *(const LAS f32x4*)(WF + ww * 64 + j0); gC = gC * wt; if (ww < w) pre = pre * wt; }
            const f32x4 gt = pre * gl, gp = pre * gpl;
            if (t == 31) *(LAS f32x4*)(WF + 512 + j0) = gC;
            float a_[4], r_[4], b_[4], k_[4], bc[4], kc[4];
#pragma unroll
            for (int j = 0; j < 4; ++j) { const float ig = __builtin_amdgcn_rcpf(gt[j]); a_[j] = al[j] * gp[j]; r_[j] = r[j] * gt[j]; b_[j] = be[j] * ig; k_[j] = kp[j] * ig; bc[j] = b_[j] * gC[j]; kc[j] = k_[j] * gC[j]; }
            u32x2 wv; wv.x = pk2(a_[0], a_[1]); wv.y = pk2(a_[2], a_[3]); *(LAS u32x2*)(AT + t * LDA + j0) = wv;
            wv.x = pk2(r_[0], r_[1]); wv.y = pk2(r_[2], r_[3]); *(LAS u32x2*)(RT + t * LDA + j0) = wv;
            wv.x = pk2(b_[0], b_[1]); wv.y = pk2(b_[2], b_[3]); *(LAS u32x2*)(BT + t * LDA + j0) = wv;
            wv.x = pk2(k_[0], k_[1]); wv.y = pk2(k_[2], k_[3]); *(LAS u32x2*)(KT + t * LDA + j0) = wv;
            wv.x = pk2(bc[0], bc[1]); wv.y = pk2(bc[2], bc[3]); *(LAS u32x2*)(BCT + t * LDA + j0) = wv;
            wv.x = pk2(kc[0], kc[1]); wv.y = pk2(kc[2], kc[3]); *(LAS u32x2*)(KCT + t * LDA + j0) = wv;
            wv.x = pk2(v[0], v[1]); wv.y = pk2(v[2], v[3]); *(LAS u32x2*)(VT + t * LDA + j0) = wv;
        }
        LBAR();
        if (w < 4 && !(SCAN_STUB & 1)) {
            const int lane = lane_now(), r32 = lane & 31, hh = lane >> 5;
            f32x16 mT, mN;
#pragma unroll
            for (int i = 0; i < 16; ++i) { mT[i] = 0.f; mN[i] = 0.f; }
#pragma unroll
            for (int q = 0; q < 4; ++q) { const bf16x8 bfr = ld16(BT + r32 * LDA + 8 * hh + 16 * q), afr = ld16(AT + r32 * LDA + 8 * hh + 16 * q);
                mT = MFMA32(bfr, afr, mT);
                mN = MFMA32(afr, bfr, mN); }
#pragma unroll
            for (int i = 0; i < 16; ++i) { const int c_ = crow(i, hh); mT[i] = (c_ < r32) ? mT[i] : 0.f; mN[i] = (r32 < c_) ? mN[i] : 0.f; }
            f32x16 X;
            if (w < 2) {
#pragma unroll
                for (int i = 0; i < 16; ++i) X[i] = bflo((unsigned)AT[crow(i, hh) * LDA + 32 * w + r32]);
            } else {
                f32x16 kT;
#pragma unroll
                for (int i = 0; i < 16; ++i) { kT[i] = 0.f; X[i] = 0.f; }
#pragma unroll
                for (int q = 0; q < 4; ++q) kT = MFMA32(ld16(KT + r32 * LDA + 8 * hh + 16 * q), ld16(AT + r32 * LDA + 8 * hh + 16 * q), kT);
#pragma unroll
                for (int i = 0; i < 16; ++i) kT[i] = (crow(i, hh) < r32) ? kT[i] : 0.f;
#pragma unroll
                for (int q = 0; q < 2; ++q) X = MFMA32(packq(kT, q), trfrag(VT, 16 * q + 4 * hh, 16 * q + 8 + 4 * hh, 32 * (w - 2), lane), X);
            }
#pragma unroll
            for (int k = 0; k < 5; ++k) {
                const bf16x8 t0 = packq(mT, 0), t1 = packq(mT, 1), x0 = packq(X, 0), x1 = packq(X, 1);
                X = MFMA32(t0, x0, X); X = MFMA32(t1, x1, X);
                if (k < 4) {
                    const bf16x8 n0 = packq(mN, 0), n1 = packq(mN, 1);
                    f32x16 zT, zN;
#pragma unroll
                    for (int i = 0; i < 16; ++i) { zT[i] = 0.f; zN[i] = 0.f; }
                    zT = MFMA32(n0, t0, zT); zT = MFMA32(n1, t1, zT);
                    zN = MFMA32(t0, n0, zN); zN = MFMA32(t1, n1, zN);
                    mT = zT; mN = zN;
                }
            }
            LAS bf16* dst = ((w < 2) ? AHT : UHT) + (32 * (w & 1) + r32) * LDT + 4 * hh;
#pragma unroll
            for (int i4 = 0; i4 < 4; ++i4) { u32x2 wv; wv.x = pk2(X[4 * i4], X[4 * i4 + 1]); wv.y = pk2(X[4 * i4 + 2], X[4 * i4 + 3]); *(LAS u32x2*)(dst + 8 * i4) = wv; }
        } else if (w < 6 && !(SCAN_STUB & 1)) {
            const int lane = lane_now(), r32 = lane & 31, hh = lane >> 5;
            const LAS bf16* Aop = ((w & 1) ? KT : BT) + r32 * LDA + 8 * hh; const LAS bf16* Bop = RT + r32 * LDA + 8 * hh;
            f32x16 x;
#pragma unroll
            for (int i = 0; i < 16; ++i) x[i] = 0.f;
#pragma unroll
            for (int q = 0; q < 4; ++q) x = MFMA32(ld16(Aop + 16 * q), ld16(Bop + 16 * q), x);
#pragma unroll
            for (int i = 0; i < 16; ++i) x[i] = (crow(i, hh) <= r32) ? x[i] : 0.f;
            LAS bf16* dst = ((w & 1) ? ARK : ARB) + r32 * LDT + 4 * hh;
#pragma unroll
            for (int i4 = 0; i4 < 4; ++i4) { u32x2 wv; wv.x = pk2(x[4 * i4], x[4 * i4 + 1]); wv.y = pk2(x[4 * i4 + 2], x[4 * i4 + 3]); *(LAS u32x2*)(dst + 8 * i4) = wv; }
        }
        LBAR();
        f32x16 hn;
        if (SCAN_STUB & 4) { for (int i = 0; i < 16; ++i) hn[i] = 0.f; } else if (w < 4) {
            const int lane = lane_now(), r32 = lane & 31, hh = lane >> 5;
            const int jb = w >> 1, ib = w & 1;
            f32x16 pt[2];
#pragma unroll
            for (int a = 0; a < 2; ++a) {
#pragma unroll
                for (int i = 0; i < 16; ++i) pt[a][i] = 0.f;
#pragma unroll
                for (int q = 0; q < 2; ++q) pt[a] = MFMA32(ld16(AHT + (32 * a + r32) * LDT + 16 * q + 8 * hh), trfrag(BCT, 16 * q + 8 * hh, 16 * q + 8 * hh + 4, 32 * jb, lane), pt[a]);
            }
            { const float gC = WF[512 + 32 * jb + r32];
#pragma unroll
              for (int i = 0; i < 16; ++i) { const float add = (crow(i, hh) == r32) ? gC : 0.f; pt[0][i] += (jb == 0) ? add : 0.f; pt[1][i] += (jb == 0) ? 0.f : add; } }
#pragma unroll
            for (int i = 0; i < 16; ++i) hn[i] = 0.f;
#pragma unroll
            for (int q = 0; q < 2; ++q) {
                hn = MFMA32(trfrag(BCT, 16 * q + 8 * hh, 16 * q + 8 * hh + 4, 32 * jb, lane), ld16(UHT + (32 * ib + r32) * LDT + 16 * q + 8 * hh), hn);
                hn = MFMA32(trfrag(KCT, 16 * q + 8 * hh, 16 * q + 8 * hh + 4, 32 * jb, lane), trfrag(VT, 16 * q + 8 * hh, 16 * q + 8 * hh + 4, 32 * ib, lane), hn);
            }
#pragma unroll
            for (int a = 0; a < 2; ++a)
#pragma unroll
                for (int q = 0; q < 2; ++q) hn = MFMA32(packq(pt[a], q), ld8x2(HT + (32 * ib + r32) * LDA + 32 * a + 16 * q + 4 * hh), hn);
        } else if (w < 6) {
            const int lane = lane_now(), r32 = lane & 31, hh = lane >> 5;
            const int ib = w & 1;
            f32x16 rt[2];
#pragma unroll
            for (int a = 0; a < 2; ++a) {
#pragma unroll
                for (int i = 0; i < 16; ++i) rt[a][i] = bflo((unsigned)RT[r32 * LDA + 32 * a + crow(i, hh)]);
#pragma unroll
                for (int q = 0; q < 2; ++q) rt[a] = MFMA32(ld16(AHT + (32 * a + r32) * LDT + 16 * q + 8 * hh), ld16(ARB + r32 * LDT + 16 * q + 8 * hh), rt[a]);
            }
            f32x16 y;
#pragma unroll
            for (int i = 0; i < 16; ++i) y[i] = 0.f;
#pragma unroll
            for (int q = 0; q < 2; ++q) {
                y = MFMA32(ld16(ARB + r32 * LDT + 16 * q + 8 * hh), ld16(UHT + (32 * ib + r32) * LDT + 16 * q + 8 * hh), y);
                y = MFMA32(ld16(ARK + r32 * LDT + 16 * q + 8 * hh), trfrag(VT, 16 * q + 8 * hh, 16 * q + 8 * hh + 4, 32 * ib, lane), y);
            }
#pragma unroll
            for (int a = 0; a < 2; ++a)
#pragma unroll
                for (int q = 0; q < 2; ++q) y = MFMA32(packq(rt[a], q), ld8x2(HT + (32 * ib + r32) * LDA + 32 * a + 16 * q + 4 * hh), y);
#pragma unroll
            for (int i = 0; i < 16; ++i) YF[crow(i, hh) * 64 + 32 * ib + r32] = y[i];
        }
        LBAR();
        if (w < 4) {
            const int lane = lane_now(), r32 = lane & 31, hh = lane >> 5;
            const int jb = w >> 1, ib = w & 1; LAS bf16* dst = HT + (32 * ib + r32) * LDA + 32 * jb + 4 * hh;
#pragma unroll
            for (int i4 = 0; i4 < 4; ++i4) { u32x2 wv; wv.x = pk2(hn[4 * i4], hn[4 * i4 + 1]); wv.y = pk2(hn[4 * i4 + 2], hn[4 * i4 + 3]); *(LAS u32x2*)(dst + 8 * i4) = wv; }
        }
        {
            const f32x4 y4 = *(const LAS f32x4*)(YF + t * 64 + j0);
            const float mean = red16((y4[0] + y4[1]) + (y4[2] + y4[3])) * (1.f / 64.f); float qv = 0.f;
#pragma unroll
            for (int j = 0; j < 4; ++j) { const float d = y4[j] - mean; qv += d * d; }
            const float rs = __builtin_amdgcn_rsqf(red16(qv) * (1.f / 64.f) + GN_EPS); const float bon = BON[t]; float ov[4];
            const f32x4 lnw = *(const LAS f32x4*)(CST + 384 + j0), lnb = *(const LAS f32x4*)(CST + 448 + j0);
#pragma unroll
            for (int j = 0; j < 4; ++j) ov[j] = ((y4[j] - mean) * rs * lnw[j] + lnb[j] + bon * v[j]) * gq[j];
            pend.x = pk2(ov[0], ov[1]); pend.y = pk2(ov[2], ov[3]);
        }
    }
    *(u32x2*)(YB + ((size_t)b * SEQ + SEQ - 32 + t) * 512 + hc) = pend;
}

__device__ __forceinline__ bool attn_step(const bf16x8 (&qf)[4], const bf16x8 (&kf)[4], const u32x2 (&vlo)[2][2], const u32x2 (&vhi)[2][2], f32x16& y0, f32x16& y1, float& carry, int s0, int t0, int q, int hi) {
    f32x16 p;
#pragma unroll
    for (int r = 0; r < 16; ++r) p[r] = 0.f;
#pragma unroll
    for (int d0 = 0; d0 < 4; ++d0) p = __builtin_amdgcn_mfma_f32_32x32x16_bf16(kf[d0], qf[d0], p, 0, 0, 0);
    float om[16], be[16];
#pragma unroll
    for (int r = 0; r < 16; ++r) {
        const int kv = crow(r, hi); const bool valid = (s0 + kv) < (t0 + q);
        const float z = fminf(p[r], 80.f); const float t = __expf(z); const float o = __builtin_amdgcn_rcpf(1.f + t);
        om[r] = valid ? o : 1.f; be[r] = valid ? t * o : 0.f;
    }
    float el[16], G[4], PG[4];
#pragma unroll
    for (int i = 0; i < 4; ++i) { el[4 * i + 3] = 1.f; el[4 * i + 2] = om[4 * i + 3]; el[4 * i + 1] = el[4 * i + 2] * om[4 * i + 2]; el[4 * i] = el[4 * i + 1] * om[4 * i + 1]; G[i] = el[4 * i] * om[4 * i]; }
#pragma unroll
    for (int i = 0; i < 4; ++i) PG[i] = __shfl_xor(G[i], 32);
    float sG[4], sP[4];
    sG[3] = 1.f; sG[2] = G[3]; sG[1] = G[3] * G[2]; sG[0] = sG[1] * G[1];
    sP[3] = 1.f; sP[2] = PG[3]; sP[1] = PG[3] * PG[2]; sP[0] = sP[1] * PG[1];
    const float total = (sG[0] * G[0]) * (sP[0] * PG[0]);
    float A[16];
#pragma unroll
    for (int i = 0; i < 4; ++i) { const float eg = sG[i] * (hi ? sP[i] : sP[i] * PG[i]) * carry;
#pragma unroll
        for (int j = 0; j < 4; ++j) A[4 * i + j] = be[4 * i + j] * el[4 * i + j] * eg; }
    carry *= total;
    bf16x8 pf[2];
#pragma unroll
    for (int s = 0; s < 2; ++s) { u32x4 w; w.x = pk2(A[8 * s], A[8 * s + 1]); w.y = pk2(A[8 * s + 2], A[8 * s + 3]); w.z = pk2(A[8 * s + 4], A[8 * s + 5]); w.w = pk2(A[8 * s + 6], A[8 * s + 7]); pf[s] = __builtin_bit_cast(bf16x8, w); }
#pragma unroll
    for (int s = 0; s < 2; ++s) {
        const u32x4 a0 = (u32x4){vlo[0][s].x, vlo[0][s].y, vhi[0][s].x, vhi[0][s].y}, a1 = (u32x4){vlo[1][s].x, vlo[1][s].y, vhi[1][s].x, vhi[1][s].y};
        y0 = __builtin_amdgcn_mfma_f32_32x32x16_bf16(__builtin_bit_cast(bf16x8, a0), pf[s], y0, 0, 0, 0);
        y1 = __builtin_amdgcn_mfma_f32_32x32x16_bf16(__builtin_bit_cast(bf16x8, a1), pf[s], y1, 0, 0, 0);
    }
    return __all(carry < 5.6e-14f);
}
__device__ __forceinline__ void attn_tile(Frame& F, int bh, int qt) {
    const int lane = F.lane, q = lane & 31, hi = lane >> 5, b = bh >> 3, h = bh & 7, t0 = 32 * qt;
    const size_t tokbase = (size_t)b * SEQ;
    const bf16* QB = WSP(bf16, WS_Q); const bf16* KB = WSP(bf16, WS_K); const bf16* VT = WSP(bf16, WS_VT); bf16* YA = WSP(bf16, WS_YA);
    bf16x8 qf[4];
    { const bf16* Qp = QB + (tokbase + t0 + q) * 512 + h * 64 + 8 * hi;
#pragma unroll
      for (int d0 = 0; d0 < 4; ++d0) qf[d0] = *(const bf16x8*)(Qp + 16 * d0); }
    f32x16 y0, y1;
#pragma unroll
    for (int r = 0; r < 16; ++r) { y0[r] = 0.f; y1[r] = 0.f; }
    float carry = 1.f;
    const bf16* Vrow = VT + (size_t)bh * 128 * 1024 + q * 16 + 4 * hi;
    bf16x8 kA[4], kB[4]; u32x2 vloA[2][2], vhiA[2][2], vloB[2][2], vhiB[2][2];
#define ATT_LOAD(KF, VLO, VHI, S0) do { const bf16* Kp_ = KB + (tokbase + (S0) + q) * 512 + h * 64 + 8 * hi; \
        _Pragma("unroll") for (int d0 = 0; d0 < 4; ++d0) KF[d0] = *(const bf16x8*)(Kp_ + 16 * d0); \
        _Pragma("unroll") for (int dt = 0; dt < 2; ++dt) _Pragma("unroll") for (int s_ = 0; s_ < 2; ++s_) { const bf16* vp_ = Vrow + (size_t)(((S0) >> 4) + s_) * 1024 + dt * 512; VLO[dt][s_] = *(const u32x2*)vp_; VHI[dt][s_] = *(const u32x2*)(vp_ + 8); } } while (0)
    ATT_LOAD(kA, vloA, vhiA, t0);
    for (int s0 = t0; ; ) {
        { const int sn = s0 >= 32 ? s0 - 32 : 0; ATT_LOAD(kB, vloB, vhiB, sn); __builtin_amdgcn_sched_barrier(0); }
        if (attn_step(qf, kA, vloA, vhiA, y0, y1, carry, s0, t0, q, hi)) break;
        s0 -= 32; if (s0 < 0) break;
        { const int sn = s0 >= 32 ? s0 - 32 : 0; ATT_LOAD(kA, vloA, vhiA, sn); __builtin_amdgcn_sched_barrier(0); }
        if (attn_step(qf, kB, vloB, vhiB, y0, y1, carry, s0, t0, q, hi)) break;
        s0 -= 32; if (s0 < 0) break;
    }
#undef ATT_LOAD
    bf16* Yp = YA + (tokbase + t0 + q) * 512 + h * 64 + 4 * hi;
#pragma unroll
    for (int i = 0; i < 4; ++i) {
        u32x2 w0, w1; w0.x = pk2(y0[4 * i], y0[4 * i + 1]); w0.y = pk2(y0[4 * i + 2], y0[4 * i + 3]); w1.x = pk2(y1[4 * i], y1[4 * i + 1]); w1.y = pk2(y1[4 * i + 2], y1[4 * i + 3]);
        *(u32x2*)(Yp + 8 * i) = w0; *(u32x2*)(Yp + 32 + 8 * i) = w1;
    }
}

__device__ __forceinline__ void p5a_router(const Args& args, Frame& F) {
    LAS float* LG = (LAS float*)F.lds;
    LAS unsigned* HIST = (LAS unsigned*)(F.lds + 32768); LAS unsigned* BASE = HIST + 32;
    const bf16* X1 = WSP(bf16, WS_X1); const bf16* GW3 = WSP(bf16, WS_GW); const float* rb = FIN(20);
    unsigned* cnt = F.ctl + CW_CNT; int* LIST = WSP(int, WS_LIST); float* LRS = WSP(float, WS_LRS); float* LGT = WSP(float, WS_LGT);
    const int tid = F.tid, lane = F.lane, wave = F.wave;
    for (int tb = blockIdx.x; tb < M / 128; tb += F.G) {
        if (tid < 32) HIST[tid] = 0u;
        __syncthreads();
        int ex[4] = {0, 0, 0, 0}; float gt[4] = {0.f, 0.f, 0.f, 0.f}; unsigned lr[4] = {0u, 0u, 0u, 0u}; int tok = 0; float rstd_keep = 0.f;
        {
            const int i = lane & 31, kh = lane >> 5, g = wave & 3, kq = wave >> 2; tok = tb * 128 + g * 32 + i;
            const bf16* xr = X1 + (size_t)tok * D + 512 * kq + 8 * kh;
            const bf16* gr = GW3 + (size_t)i * D + 512 * kq + 8 * kh;
            f32x16 acc;
#pragma unroll
            for (int r = 0; r < 16; ++r) acc[r] = 0.f;
            float ss = 0.f;
#pragma unroll 1
            for (int u0 = 0; u0 < 32; u0 += 4) {
                u32x4 a[4], bh[4], bm[4], bl[4];
#pragma unroll
                for (int uu = 0; uu < 4; ++uu) { a[uu] = *(const u32x4*)(xr + 16 * (u0 + uu)); bh[uu] = *(const u32x4*)(gr + 16 * (u0 + uu)); bm[uu] = *(const u32x4*)(gr + NE * D + 16 * (u0 + uu)); bl[uu] = *(const u32x4*)(gr + 2 * NE * D + 16 * (u0 + uu)); }
#pragma unroll
                for (int uu = 0; uu < 4; ++uu) {
                    const unsigned aw[4] = {a[uu].x, a[uu].y, a[uu].z, a[uu].w};
#pragma unroll
                    for (int j = 0; j < 4; ++j) { const float lo_ = bflo(aw[j]), hi_ = bfhi(aw[j]); ss += lo_ * lo_ + hi_ * hi_; }
                    const bf16x8 af = __builtin_bit_cast(bf16x8, a[uu]);
                    acc = MFMA32(af, __builtin_bit_cast(bf16x8, bl[uu]), acc); acc = MFMA32(af, __builtin_bit_cast(bf16x8, bm[uu]), acc); acc = MFMA32(af, __builtin_bit_cast(bf16x8, bh[uu]), acc); }
            }
            ss += __shfl_xor(ss, 32);
            LAS float* RED = (LAS float*)(F.lds + 40960) + (g * 64 + lane) * 17;
            if (kq == 1) {
#pragma unroll
                for (int r = 0; r < 16; ++r) RED[r] = acc[r];
                RED[16] = ss; }
            __syncthreads();
            if (kq == 0) {
#pragma unroll
                for (int r = 0; r < 16; ++r) acc[r] += RED[r];
                ss += RED[16]; }
            if (wave < 4) {
            const float rstd = 1.0f / sqrtf(ss * (1.f / D) + RMS_EPS);
            rstd_keep = rstd;
            LAS float* L = LG + wave * (32 * 33);
#pragma unroll
            for (int r = 0; r < 16; ++r) L[crow(r, kh) * 33 + i] = acc[r];
            asm volatile("s_waitcnt lgkmcnt(0)" ::: "memory");
            if (kh == 0) {
                float v0 = -3.0e38f, v1 = -3.0e38f, v2 = -3.0e38f, v3 = -3.0e38f; int i0 = 0, i1 = 0, i2 = 0, i3 = 0;
                for (int e = 0; e < 32; ++e) { const float v = L[i * 33 + e] * rstd + rb[e];
                    if (v > v3) { if (v > v2) { v3 = v2; i3 = i2; if (v > v1) { v2 = v1; i2 = i1; if (v > v0) { v1 = v0; i1 = i0; v0 = v; i0 = e; } else { v1 = v; i1 = e; } } else { v2 = v; i2 = e; } } else { v3 = v; i3 = e; } } }
                const float e1 = __expf(v1 - v0), e2 = __expf(v2 - v0), e3 = __expf(v3 - v0), inv = 1.0f / (1.f + e1 + e2 + e3);
                ex[0] = i0; ex[1] = i1; ex[2] = i2; ex[3] = i3; gt[0] = inv; gt[1] = e1 * inv; gt[2] = e2 * inv; gt[3] = e3 * inv;
#pragma unroll
                for (int k = 0; k < 4; ++k) lr[k] = __hip_atomic_fetch_add(&HIST[ex[k]], 1u, __ATOMIC_RELAXED, __HIP_MEMORY_SCOPE_WORKGROUP);
            }
            }
        }
        __syncthreads();
        if (tid < 32) BASE[tid] = __hip_atomic_fetch_add(cnt + tid, HIST[tid], RLX_AGENT);
        __syncthreads();
        if (wave < 4 && lane < 32) {
#pragma unroll
            for (int k = 0; k < 4; ++k) { const unsigned pos = BASE[ex[k]] + lr[k]; const size_t li = (size_t)ex[k] * CAP + pos; LIST[li] = tok * 4 + k; LRS[li] = rstd_keep; LGT[li] = gt[k]; }
        }
        __syncthreads();
    }
}
__device__ __forceinline__ int moe_tables(Frame& F) {
    LAS int* CS = (LAS int*)(F.lds + MOE_OFF); LAS int* OFF = CS + 32; LAS unsigned char* TE = F.lds + MOE_TE;
    if (F.tid < 32) { int c = (int)__hip_atomic_load(F.ctl + CW_CNT + F.tid, RLX_AGENT); CS[F.tid] = c > CAP ? CAP : c; }
    __syncthreads();
    if (F.tid == 0) { int off = 0; for (int e = 0; e < 32; ++e) { OFF[e] = off; off += ((CS[e] + 255) >> 8) << 8; } OFF[32] = off; }
    __syncthreads();
    const int ntiles = OFF[32] >> 8;
    for (int t = F.tid; t < ntiles; t += 512) { int e = 0; while (e < 31 && OFF[e + 1] <= t * 256) ++e; TE[t] = (unsigned char)e; }
    __syncthreads();
    return ntiles;
}
__device__ __forceinline__ void p8_combine(Frame& F) {
    const bf16* X1 = WSP(bf16, WS_X1); const unsigned char* YBF = WSP(unsigned char, WS_YBUF); bf16* X2B = WSP(bf16, WS_X2B); float* R2 = WSP(float, WS_RSTD2); float* RSS = WSP(float, WS_ROWSS);
    const int gw = F.vcu * 8 + F.wave, NGW = F.G * 8, lane = F.lane;
    for (int t = gw; t < M; t += NGW) {
        const u32x2* xr = (const u32x2*)(X1 + (size_t)t * D) + lane; f32x4 v[4]; float s = 0.f; u32x2 xw[4];
#pragma unroll
        for (int j = 0; j < 4; ++j) xw[j] = xr[64 * j];
        unsigned yw[4][4];
#pragma unroll
        for (int k = 0; k < 4; ++k) { const unsigned* yr = (const unsigned*)(YBF + (size_t)(4 * t + k) * D) + lane;
#pragma unroll
            for (int j = 0; j < 4; ++j) yw[k][j] = yr[64 * j]; }
#pragma unroll
        for (int j = 0; j < 4; ++j) v[j] = (f32x4){bflo(xw[j].x), bfhi(xw[j].x), bflo(xw[j].y), bfhi(xw[j].y)};
#pragma unroll
        for (int k = 0; k < 4; ++k)
#pragma unroll
            for (int j = 0; j < 4; ++j) { const f32x2 lo = __builtin_amdgcn_cvt_pk_f32_fp8((int)yw[k][j], false), hi = __builtin_amdgcn_cvt_pk_f32_fp8((int)yw[k][j], true);
                v[j].x += lo.x * (1.f / 32.f); v[j].y += lo.y * (1.f / 32.f); v[j].z += hi.x * (1.f / 32.f); v[j].w += hi.y * (1.f / 32.f); }
        u32x2* o = (u32x2*)(X2B + (size_t)t * D) + lane;
#pragma unroll
        for (int j = 0; j < 4; ++j) { s += (v[j].x * v[j].x + v[j].y * v[j].y) + (v[j].z * v[j].z + v[j].w * v[j].w); u32x2 w; w.x = pk2(v[j].x, v[j].y); w.y = pk2(v[j].z, v[j].w); o[64 * j] = w;
            (WSP(unsigned, WS_X2B8) + (size_t)t * (D / 4))[lane + 64 * j] = pk8(v[j].x, v[j].y, v[j].z, v[j].w); }
        s = wave_sum(s);
        if (lane == 0) { R2[t] = 1.0f / sqrtf(s * (1.f / D) + RMS_EPS); RSS[t] = 0.f; }
    }
}
constexpr int NPHASE = 11;
__global__ void __launch_bounds__(512, 2) mega_fwd(Args args) {
    extern __shared__ __attribute__((aligned(16))) unsigned char lds[];
    Frame F;
    F.lds = (LAS unsigned char*)lds;
    F.wave = __builtin_amdgcn_readfirstlane((int)threadIdx.x >> 6); F.lane = lane_now(); F.tid = F.wave * 64 + F.lane;
    F.G = gridDim.x; { const int bx = blockIdx.x; F.vcu = (F.G % 8 == 0) ? (bx % 8) * (F.G / 8) + bx / 8 : bx; }
    F.ws = args.ws; F.ctl = (unsigned*)(args.ws + WS_CTL); F.out = args.out;
    volatile LAS unsigned* MISC = (volatile LAS unsigned*)(F.lds + LDSCTL_OFF);
    if (F.tid < 64) MISC[F.tid] = 0u;
    __syncthreads();
    const int lo = args.ph_lo, hi = args.ph_hi;
    XcdBarrier bar; bar.bar = F.ctl + CW_BAR; bar.x = 0; bar.st = nullptr;
    if (hi - lo > 1) bar = xcd_barrier_post(F.ctl + CW_BAR, MISC + 8, F.tid);
#ifndef PH_MASK
#define PH_MASK 0xFFFF
#endif
#define IN(k) ((((PH_MASK) >> (k)) & 1) && lo <= (k) && (k) < hi)
#define STAMP(k) do { if (TS_PROBE >= 0 && blockIdx.x == 0 && F.tid == 0) ((unsigned long long*)(F.ctl + 2048))[k] = __builtin_amdgcn_s_memrealtime(); } while (0)
#define SEAM(k) do { if (IN(k) && IN((k) + 1)) xcd_barrier(bar, F.wave); F.lane = lane_now(); F.tid = F.wave * 64 + F.lane; STAMP((k) + 1); } while (0)
    LAS unsigned char* ring = F.lds;
    STAMP(0);

    if (IN(0)) { p0_prologue(args, F); if (F.G < 256) expert_convert(args, F, F.vcu * 8 + F.wave, F.G * 8, 3); } SEAM(0);

    if (IN(1)) {
        constexpr unsigned ALLT = (1u << (INC / 256)) - 1u, F8T = (unsigned)(G1_F8_TILES) & ALLT, B16T = ALLT & ~F8T;
        if (B16T) { pg8::Gemm g{WSP(bf16, WS_XB), WSP(bf16, WS_WIN), M, INC, D, 0, nullptr, nullptr, nullptr}; pg8::MaskOrder S; S.init(M, B16T, F.G, (int)blockIdx.x);
            EpiG1 E{WSP(float, WS_RSTD0), WSP(bf16, WS_Q), WSP(bf16, WS_K), WSP(bf16, WS_VT), WSP(bf16, WS_ZR), WSP(bf16, WS_GT), 1.f};
            pg8::gemm_phase<EpiG1, pg8::MaskOrder, false, false>(ring, g, S, E, F.wave); }
        if (F8T) { pg8::Gemm g{WSP(bf16, WS_XB8), WSP(bf16, WS_WIN8), M, INC, D, 0, nullptr, nullptr, nullptr}; pg8::MaskOrder S; S.init(M, F8T, F.G, (int)blockIdx.x);
            EpiG1 E{WSP(float, WS_RSTD0), WSP(bf16, WS_Q), WSP(bf16, WS_K), WSP(bf16, WS_VT), WSP(bf16, WS_ZR), WSP(bf16, WS_GT), 1.f / 64.f};
            pg8::gemm_phase<EpiG1, pg8::MaskOrder, false, true>(ring, g, S, E, F.wave); }
    } SEAM(1);

    if (IN(2)) {
        for (int c = blockIdx.x; c < 256; c += F.G) {
            const int x = c & 7, y = c >> 3; pg8::LoraOrder S; S.half = y & 1; S.pm = x + 8 * (y >> 1); S.nu = 3 + (F.G >> 30);
            build_alora(args, F, S.pm);
            asm volatile("s_waitcnt vmcnt(0)" ::: "memory"); __syncthreads();
            pg8::Gemm g{WSP(bf16, WS_ALORA), WSP(bf16, WS_WL), M, LORA_N, LORA_K + (F.G >> 30), 0, nullptr, nullptr, nullptr};
            EpiLora E{FIN(5), FIN(7), WSP(bf16, WS_DEC), WSP(bf16, WS_AA), WSP(bf16, WS_GG)};
            pg8::gemm_phase(ring, g, S, E, F.wave);
        }
    } SEAM(2);

    if (IN(3)) {
        for (int u = blockIdx.x; u < 256; u += F.G) {
#ifndef P3_ONLY
#define P3_ONLY 5
#endif
            if (u < 128) { if (P3_ONLY != 2 && P3_ONLY != 3 && P3_ONLY != 4) scan_unit_chunked(args, F, u); else { bf16* YB = WSP(bf16, WS_YB); const int b = u >> 3, h = u & 7; for (int i = F.tid; i < SEQ * 8; i += 512) { const int tk = i >> 3, c8 = (i & 7) * 8; *(u32x4*)(YB + ((size_t)b * SEQ + tk) * 512 + h * 64 + c8) = (u32x4){0u, 0u, 0u, 0u}; } } }
            else if (P3_ONLY == 1 || P3_ONLY == 4) { bf16* YAz = WSP(bf16, WS_YA); const int bh = u - 128, b = bh >> 3, h = bh & 7; for (int i = F.tid; i < SEQ * 8; i += 512) { const int tk = i >> 3, c8 = (i & 7) * 8; *(u32x4*)(YAz + ((size_t)b * SEQ + tk) * 512 + h * 64 + c8) = (u32x4){0u, 0u, 0u, 0u}; } }
            else { const int bh = u - 128; for (int i = 0; i < 8; ++i) attn_tile(F, bh, F.wave + 8 * i);
                   if (F.G >= 256 && P3_ONLY != 3 && P3_ONLY != 5) expert_convert(args, F, bh * 8 + F.wave, 1024, 3);
                    }
        }
    if (TS_PROBE >= 0 && blockIdx.x == 0 && F.tid == 0) ((unsigned long long*)(F.ctl + 2048))[20] = __builtin_amdgcn_s_memrealtime();
    } SEAM(3);

    if (IN(4)) {
        pg8::StaticOrder S; S.init(M, D, F.G, (int)blockIdx.x);
        { pg8::Gemm g{WSP(bf16, WS_YA), WSP(bf16, WS_WA), M, D, AW, 0, nullptr, nullptr, nullptr}; EpiMerge<0> E{WSP(bf16, WS_GT), WSP(bf16, WS_MERGED)}; pg8::gemm_phase(ring, g, S, E, F.wave); }
        { pg8::Gemm g{WSP(bf16, WS_YB), WSP(bf16, WS_WB), M, D, RW, 0, nullptr, nullptr, nullptr}; EpiMerge<1> E{WSP(bf16, WS_GT), WSP(bf16, WS_MERGED)}; pg8::gemm_phase(ring, g, S, E, F.wave); }
    } SEAM(4);

    if (IN(5)) {
        pg8::Gemm g{WSP(bf16, WS_MERGED), WSP(bf16, WS_WO), M, D, D, 0, nullptr, nullptr, nullptr}; pg8::StaticOrder S; S.init(M, D, F.G, (int)blockIdx.x);
        EpiX1 E{WSP(bf16, WS_XB), WSP(bf16, WS_X1), FIN(18), WSP(unsigned char, WS_HN)};
        pg8::gemm_phase(ring, g, S, E, F.wave);
    } SEAM(5);

    if (IN(6)) { p5a_router(args, F); } SEAM(6);

    if (IN(7)) {
        const int ntiles = moe_tables(F);
        pg8::Gemm g{WSP(bf16, WS_HN), WSP(bf16, WS_W1), MAXROWS, F2, D, (size_t)F2 * D, WSP(int, WS_LIST), (const LAS int*)(F.lds + MOE_OFF) + 32, (const LAS int*)(F.lds + MOE_OFF)};
        pg8::MoeOrder S{ntiles, F2 / 256, F.G, (int)blockIdx.x, F.lds + MOE_TE};
        EpiSwiglu E{FIN(22), WSP(unsigned char, WS_ACT), WSP(int, WS_LIST), WSP(float, WS_LRS), (const LAS int*)(F.lds + MOE_OFF) + 32, (const LAS int*)(F.lds + MOE_OFF), (const LAS float*)(F.lds + RING_BYTES + 4096)};
        pg8::gemm_phase<EpiSwiglu, pg8::MoeOrder, true, true>(ring, g, S, E, F.wave);
    } SEAM(7);

    if (IN(8)) {
        const int ntiles = moe_tables(F);
        pg8::Gemm g{WSP(bf16, WS_ACT), WSP(bf16, WS_W2), MAXROWS, D, FH, (size_t)D * FH, nullptr, nullptr, nullptr};
        pg8::MoeOrder S{ntiles, D / 256, F.G, (int)blockIdx.x, F.lds + MOE_TE};
        EpiY E{FIN(24), WSP(int, WS_LIST), WSP(float, WS_LGT), WSP(unsigned char, WS_YBUF), (const LAS int*)(F.lds + MOE_OFF) + 32, (const LAS int*)(F.lds + MOE_OFF), (const LAS float*)(F.lds + RING_BYTES + 4096)};
        pg8::gemm_phase<EpiY, pg8::MoeOrder, false, true>(ring, g, S, E, F.wave);
    } SEAM(8);

    if (IN(9)) { p8_combine(F); } SEAM(9);

    if (IN(10)) {
        pg8::StaticOrder S; S.init(M, D, F.G, (int)blockIdx.x);
        { pg8::Gemm g{WSP(bf16, WS_X2B8), WSP(bf16, WS_WG), M, D, D, 0, nullptr, nullptr, nullptr}; EpiGate E{WSP(float, WS_RSTD2), WSP(bf16, WS_PGT)}; pg8::gemm_phase<EpiGate, pg8::StaticOrder, false, true>(ring, g, S, E, F.wave); }
        { pg8::Gemm g{WSP(bf16, WS_PB), WSP(bf16, WS_WP), M, D, PLE, 0, nullptr, nullptr, nullptr}; EpiPle E{WSP(bf16, WS_X2B), WSP(bf16, WS_PGT), F.out, WSP(float, WS_ROWSS), F.ctl + CW_PCNT, FIN(28), F.ctl}; pg8::gemm_phase(ring, g, S, E, F.wave); }
    }
#undef IN
#undef SEAM
}

extern "C" void kernel_launch(void* const* d_in, const int* in_sizes, int n_in, void* d_out, int out_size, void* d_ws, size_t ws_size, hipStream_t stream) {
    static int grid = 0;
    if (grid == 0) {
        if (n_in != 29 || in_sizes[0] != M * D || out_size != M * D || ws_size < WS_END) {
            fprintf(stderr, "kernel_launch: unexpected shapes (n_in %d, in0 %d, out %d, ws %zu < %zu); nothing launched\n", n_in, n_in > 0 ? in_sizes[0] : -1, out_size, ws_size, (size_t)WS_END); grid = -1; return; }
        int dev = 0, cus = 0, per_cu = 0;
        if (hipGetDevice(&dev) != hipSuccess || hipDeviceGetAttribute(&cus, hipDeviceAttributeMultiprocessorCount, dev) != hipSuccess) { grid = -1; return; }
        if (hipFuncSetAttribute((const void*)mega_fwd, hipFuncAttributeMaxDynamicSharedMemorySize, LDS_BYTES) != hipSuccess) { fprintf(stderr, "kernel_launch: hipFuncSetAttribute failed\n"); grid = -1; return; }
        if (hipOccupancyMaxActiveBlocksPerMultiprocessor(&per_cu, (const void*)mega_fwd, 512, LDS_BYTES) != hipSuccess || per_cu < 1) { fprintf(stderr, "kernel_launch: occupancy query says %d blocks/CU\n", per_cu); }
        (void)hipGetLastError();
        grid = cus;
    }
    if (grid < 0) return;
    (void)hipMemsetAsync((char*)d_ws + WS_CTL, 0, CTL_ZERO_BYTES, stream);
    Args a{};
    for (int i = 0; i < 29; ++i) a.in[i] = (const float*)d_in[i];
    a.out = (float*)d_out; a.ws = (unsigned char*)d_ws;
#if MK_PER_PHASE
    for (int p = 0; p < NPHASE; ++p) { a.ph_lo = p; a.ph_hi = p + 1; hipLaunchKernelGGL(mega_fwd, dim3(grid), dim3(512), LDS_BYTES, stream, a); }
#else
    a.ph_lo = 0; a.ph_hi = NPHASE; hipLaunchKernelGGL(mega_fwd, dim3(grid), dim3(512), LDS_BYTES, stream, a);
#endif
}
```

```cpp
#include <hip/hip_runtime.h>
#include <cstdio>
#include <cstdint>

#ifndef P3_ONLY
#define P3_ONLY 0
#endif
#ifndef SCAN_STUB
#define SCAN_STUB 0
#endif
#ifndef ATT_FORCE
#define ATT_FORCE 0
#endif
#ifndef G1_F8_TILES
#define G1_F8_TILES 0x1FE030u
#endif
#ifndef EPI_STUB
#define EPI_STUB 0
#endif
#ifndef TS_PROBE
#define TS_PROBE -1
#endif
#ifndef TS_END_SLOT
#define TS_END_SLOT (TS_PROBE + 1)
#endif
#ifndef MK_PER_PHASE
#define MK_PER_PHASE 0
#endif

#define LAS __attribute__((address_space(3)))
#define GAS __attribute__((address_space(1)))
typedef unsigned short bf16;
typedef short bf16x8 __attribute__((ext_vector_type(8)));
typedef float f32x2 __attribute__((ext_vector_type(2)));
typedef float f32x4 __attribute__((ext_vector_type(4)));
typedef float f32x16 __attribute__((ext_vector_type(16)));
typedef unsigned u32x2 __attribute__((ext_vector_type(2)));
typedef unsigned u32x4 __attribute__((ext_vector_type(4)));
typedef __bf16 bf16x2_t __attribute__((ext_vector_type(2)));

constexpr int NB = 16, SEQ = 2048, D = 1024, M = NB * SEQ;
constexpr int NH = 8, HD = 64, AW = 512, RW = 512, RWC = 1792, INC = 5376;
constexpr int NE = 32, FH = 1024, F2 = 2048, PLE = 256, TOPK = 4;
constexpr int LORA_K = 256, LORA_N = 1536;
constexpr int CAP = 32768;
constexpr int MAXROWS = M * TOPK + NE * 256;
constexpr float RMS_EPS = 1e-5f, GN_EPS = 64e-5f;

constexpr size_t MiB = 1u << 20;
constexpr size_t WS_CTL = 0, CTL_ZERO_BYTES = 1 * MiB;
constexpr size_t WS_WIN = 1 * MiB;
constexpr size_t WS_WA = 12 * MiB, WS_WB = 13 * MiB, WS_WO = 14 * MiB, WS_WG = 16 * MiB, WS_WP = 18 * MiB;
constexpr size_t WS_WL = 18 * MiB + 512 * 1024;
constexpr size_t WS_GW = 19 * MiB + 256 * 1024;
constexpr size_t WS_W1 = 20 * MiB;
constexpr size_t WS_W2 = 148 * MiB;
constexpr size_t WS_PB = 212 * MiB;
constexpr size_t WS_RSTD0 = 228 * MiB, WS_RSTD2 = WS_RSTD0 + 128 * 1024, WS_ROWSS = WS_RSTD0 + 256 * 1024;
constexpr size_t WS_RSTD1 = WS_RSTD0 + 384 * 1024;
constexpr size_t WS_GATEW = WS_RSTD0 + 512 * 1024;
constexpr size_t WS_ROWSLOT = 229 * MiB;
constexpr size_t WS_LIST = 230 * MiB;
constexpr size_t WS_X1 = 236 * MiB;
constexpr size_t WS_YA = 236 * MiB, WS_YB = 268 * MiB, WS_ALORA = 300 * MiB;
constexpr size_t WS_GT = 364 * MiB;
constexpr size_t WS_Q = 492 * MiB, WS_K = 524 * MiB, WS_VT = 556 * MiB;
constexpr size_t WS_ZR = 588 * MiB;
constexpr size_t WS_XB = 700 * MiB;
constexpr size_t WS_DEC = 764 * MiB, WS_AA = 828 * MiB, WS_GG = 892 * MiB;
constexpr size_t WS_MERGED = 492 * MiB;
constexpr size_t WS_XS = 364 * MiB;
constexpr size_t WS_ACT = 684 * MiB;
constexpr size_t WS_HN = 364 * MiB;
constexpr size_t WS_YBUF = 428 * MiB;
constexpr size_t WS_X2B8 = 820 * MiB;
constexpr size_t WS_X2B = 684 * MiB;
constexpr size_t WS_PGT = 748 * MiB;
constexpr size_t WS_LRS = 956 * MiB, WS_LGT = 960 * MiB;
constexpr size_t WS_WIN8 = 84 * MiB;
constexpr size_t WS_XB8 = 96 * MiB;
constexpr size_t WS_END = 964 * MiB;
constexpr int CW_CNT = 64;
constexpr int CW_PCNT = 8192;
constexpr int CW_BAR = 4096;

constexpr int RING_BYTES = 131072;
constexpr int LDSCTL_OFF = RING_BYTES;
constexpr int MOE_OFF = RING_BYTES + 1024;
constexpr int MOE_TE = RING_BYTES + 2048;
constexpr int LDS_BYTES = 147456;

#define RLX_AGENT __ATOMIC_RELAXED, __HIP_MEMORY_SCOPE_AGENT
__device__ __forceinline__ unsigned pk2(float lo, float hi) { f32x2 v = {lo, hi}; bf16x2_t b = __builtin_convertvector(v, bf16x2_t); return __builtin_bit_cast(unsigned, b); }
__device__ __forceinline__ unsigned pk8(float a, float b, float c, float d) { int w = __builtin_amdgcn_cvt_pk_fp8_f32(a, b, 0, false); w = __builtin_amdgcn_cvt_pk_fp8_f32(c, d, w, true); return (unsigned)w; }
__device__ __forceinline__ float bflo(unsigned u) { return __uint_as_float(u << 16); }
__device__ __forceinline__ float bfhi(unsigned u) { return __uint_as_float(u & 0xffff0000u); }
__device__ __forceinline__ float sigm(float x) { return __builtin_amdgcn_rcpf(1.f + __expf(-x)); }
__device__ __forceinline__ float wave_sum(float v) {
#pragma unroll
    for (int o = 1; o < 64; o <<= 1) v += __shfl_xor(v, o);
    return v;
}
template <int CTRL> __device__ __forceinline__ float dppf(float v) { return __builtin_bit_cast(float, __builtin_amdgcn_update_dpp(0, __builtin_bit_cast(int, v), CTRL, 0xF, 0xF, true)); }
__device__ __forceinline__ float sum_x16(float x) { auto s = __builtin_amdgcn_permlane16_swap(__float_as_uint(x), __float_as_uint(x), false, false); return __uint_as_float(s[0]) + __uint_as_float(s[1]); }
__device__ __forceinline__ float sum_x32(float x) { auto s = __builtin_amdgcn_permlane32_swap(__float_as_uint(x), __float_as_uint(x), false, false); return __uint_as_float(s[0]) + __uint_as_float(s[1]); }
__device__ __forceinline__ float red8(float v) { v += dppf<0xB1>(v); v += dppf<0x4E>(v); v += dppf<0x141>(v); return v; }
__device__ __forceinline__ int lane_now() { int l; asm volatile("v_mbcnt_lo_u32_b32 %0, -1, 0\n\tv_mbcnt_hi_u32_b32 %0, -1, %0" : "=v"(l)); return l; }
__device__ __forceinline__ int crow(int r, int hi) { return (r & 3) + 8 * (r >> 2) + 4 * hi; }

struct PreNone {}; struct PreF { float f[8]; }; struct PreI { int i[8]; };
namespace pg8 {
#define PG8_LAS __attribute__((address_space(3)))
typedef unsigned short bf16_t;
constexpr int BM = 256, BK = 64, HALF = 128, HTB = HALF * BK * 2, STAGE_BYTES = 8 * HTB, NXCD = 8, WGM = 8;
__host__ __device__ __forceinline__ int lds_byte(int r, int c) { const int st = (r >> 4) * 2 + (c >> 5), rr = r & 15, cc = c & 31, ob = rr * 64 + cc * 2; return st * 1024 + (ob ^ (((ob >> 9) & 1) << 5)); }
__host__ __device__ __forceinline__ void stage_rc(int b, int& R, int& C) { const int st = b / 1024, sb = b % 1024, swz = sb ^ (((sb >> 9) & 1) << 5); R = (st >> 1) * 16 + swz / 64; C = (st & 1) * 32 + (swz % 64) / 2; }
__host__ __device__ __forceinline__ int perm32(int rho) { const int n = rho >> 4, i = rho & 15; return 8 * (i >> 2) + 4 * n + (i & 3); }

struct Unit { int pm, pn, e, par; };
struct Gemm { const bf16_t* A; const bf16_t* Bt; int M, N, K; size_t bsel_bytes; const int* glist; const PG8_LAS int* goff; const PG8_LAS int* gcnt; size_t asel_bytes; };

struct StaticOrder {
    int nM, nN, nwg, G, c;
    __device__ void init(int M_, int N_, int G_, int c_) { nM = M_ / BM; nN = N_ / BM; nwg = nM * nN; G = G_; c = c_; }
    __device__ bool next(int i, Unit& u) const {
        const long L = (long)i * G + c; if (L >= nwg) return false;
        int wgid = (int)L; { const int q = nwg / NXCD, r = nwg % NXCD, xcd = wgid % NXCD, off = wgid / NXCD; wgid = (xcd < r ? xcd * (q + 1) : r * (q + 1) + (xcd - r) * q) + off; }
        const int nig = WGM * nN, gid = wgid / nig, fm = gid * WGM, gsz = (nM - fm) < WGM ? (nM - fm) : WGM;
        u.pm = fm + ((wgid % nig) % gsz); u.pn = (wgid % nig) / gsz; u.e = 0; return true;
    }
};
struct MaskOrder {
    StaticOrder S; unsigned mask;
    __device__ void init(int M_, unsigned mask_, int G_, int c_) { mask = mask_; S.init(M_, BM * __builtin_popcount(mask_), G_, c_); }
    __device__ bool next(int i, Unit& u) const {
        if (!S.next(i, u)) return false;
        int n = u.pn, idx = 0;
#pragma unroll
        for (int t = 0; t < 21; ++t) if ((mask >> t) & 1u) { if (n == 0) idx = t; --n; }
        u.pn = idx; return true;
    }
};
struct PairOrder {
    StaticOrder S;
    __device__ bool next(int i, Unit& u) const { if (!S.next(i >> 1, u)) return false; u.e = i & 1; return true; }
};
struct LoraOrder {
    int pm, half, nu;
    __device__ bool next(int i, Unit& u) const { if (i >= nu) return false; u.pm = pm; u.pn = 3 * half + i; u.e = 0; return true; }
};
struct MoeOrder {
    int ntiles, npn, G, c; const PG8_LAS unsigned char* te;
    __device__ bool next(int i, Unit& u) const {
        int rt, pn;
        if ((G & 255) == 0 && (npn == 8 || npn == 4)) { const int x = c & 7, j = (c >> 3) & 31, rpx = 32 / npn, blk = c >> 8; rt = ((i * (G >> 8) + blk) * 8 + x) * rpx + j / npn; pn = j % npn; }
        else { const long L = (long)i * G + c; rt = (int)(L / npn); pn = (int)(L % npn); }
        if (rt >= ntiles) return false;
        u.pm = rt; u.pn = pn; u.e = te[rt]; return true;
    }
};

typedef int i32x4 __attribute__((ext_vector_type(4))); typedef int i32x8 __attribute__((ext_vector_type(8)));
template <class Epi, class Sched, bool GATHER = false, bool F8 = false>
__device__ __forceinline__ void gemm_phase(PG8_LAS unsigned char* lds, const Gemm g, const Sched& S, const Epi& E, const int wid) {
    const int lane = lane_now(), tid = wid * 64 + lane,
              wr = wid >> 2, wc = wid & 3, fr = lane & 15, fq = lane >> 4;
    const int K = g.K, nt = F8 ? K / (2 * BK) : K / BK;
    unsigned voffA[2], voffB[2];
#pragma unroll
    for (int i = 0; i < 2; ++i) { int R, C; stage_rc(tid * 16 + i * 8192, R, C); const int Rb = Epi::PERM ? ((R & ~31) + perm32(R & 31)) : R;
        voffA[i] = F8 ? (unsigned)(R * K + C * 2) : (unsigned)(R * K + C) * 2u; voffB[i] = F8 ? (unsigned)(Rb * K + C * 2) : (unsigned)(Rb * K + C) * 2u; }
    const size_t kstep = (size_t)(BK * 2);
    const size_t hstep = (size_t)HALF * K * (F8 ? 1 : 2);
    const size_t tstep = 2 * hstep;
    const unsigned ldsw = (unsigned)wid * 1024u;
    const int aoff = lds_byte(wr * 64 + fr, fq * 8), boff = lds_byte(wc * 32 + fr, fq * 8);
    const int aoffk[2] = {aoff, aoff + 1024}, boffk[2] = {boff, boff + 1024};
    unsigned vgC[2][2] = {{0u, 0u}, {0u, 0u}};
#define PG8_GOFF(u, vo) do { _Pragma("unroll") for (int _h = 0; _h < 2; ++_h) _Pragma("unroll") for (int _i = 0; _i < 2; ++_i) { int R_, C_; stage_rc(tid * 16 + _i * 8192, R_, C_); \
        const int r_ = (u).pm * BM + _h * HALF + R_ - g.goff[(u).e]; int tok_ = 0; if (r_ < g.gcnt[(u).e]) tok_ = g.glist[(size_t)(u).e * 32768 + r_] >> 2; (vo)[_h][_i] = F8 ? (unsigned)(tok_ * K + C_ * 2) : (unsigned)(tok_ * K + C_) * 2u; } } while (0)
#define PG8_SA(b, h) (((b) * 2 + (h)) * HTB)
#define PG8_SB(b, h) ((4 + (b) * 2 + (h)) * HTB)
#define PG8_STAGE(bufoff, gbase, voff) do { _Pragma("unroll") for (int _i = 0; _i < 2; ++_i) \
        __builtin_amdgcn_global_load_lds((const unsigned*)((const char*)(gbase) + (voff)[_i]), (PG8_LAS unsigned*)(lds + (bufoff) + ldsw + _i * 8192), 16, 0, 0); } while (0)
#define PG8_STA(bufoff, h, ptr, kbyte, usenext) do { if constexpr (GATHER) { unsigned vo_[2] = {vgC[h][0], vgC[h][1]}; PG8_STAGE(bufoff, (const char*)g.A + (kbyte), vo_); } else { PG8_STAGE(bufoff, ptr, voffA); } } while (0)
#define PG8_LDA(dst, b, h) do { _Pragma("unroll") for (int m = 0; m < 4; ++m) _Pragma("unroll") for (int k = 0; k < 2; ++k) dst[m][k] = *(const PG8_LAS bf16x8*)(lds + PG8_SA(b, h) + aoffk[k] + m * 2048); } while (0)
#define PG8_LDB(dst, b, h) do { _Pragma("unroll") for (int n = 0; n < 2; ++n) _Pragma("unroll") for (int k = 0; k < 2; ++k) dst[n][k] = *(const PG8_LAS bf16x8*)(lds + PG8_SB(b, h) + boffk[k] + n * 2048); } while (0)
#define PG8_MMA(ai, bj, At, Bt, Z) do { __builtin_amdgcn_s_setprio(1); \
        if constexpr (F8) { \
            if (Z) { _Pragma("unroll") for (int m = 0; m < 4; ++m) _Pragma("unroll") for (int n = 0; n < 2; ++n) { const i32x8 b8_ = __builtin_shufflevector(__builtin_bit_cast(i32x4, Bt[n][0]), __builtin_bit_cast(i32x4, Bt[n][1]), 0, 1, 2, 3, 4, 5, 6, 7), a8_ = __builtin_shufflevector(__builtin_bit_cast(i32x4, At[m][0]), __builtin_bit_cast(i32x4, At[m][1]), 0, 1, 2, 3, 4, 5, 6, 7); \
                asm volatile("v_mfma_f32_16x16x128_f8f6f4 %0, %1, %2, 0" : "=&v"(acc[ai][bj][m][n]) : "v"(b8_), "v"(a8_)); } } \
            else { _Pragma("unroll") for (int m = 0; m < 4; ++m) _Pragma("unroll") for (int n = 0; n < 2; ++n) { const i32x8 b8_ = __builtin_shufflevector(__builtin_bit_cast(i32x4, Bt[n][0]), __builtin_bit_cast(i32x4, Bt[n][1]), 0, 1, 2, 3, 4, 5, 6, 7), a8_ = __builtin_shufflevector(__builtin_bit_cast(i32x4, At[m][0]), __builtin_bit_cast(i32x4, At[m][1]), 0, 1, 2, 3, 4, 5, 6, 7); \
                asm volatile("v_mfma_f32_16x16x128_f8f6f4 %0, %1, %2, %0" : "+v"(acc[ai][bj][m][n]) : "v"(b8_), "v"(a8_)); } } } \
        else { _Pragma("unroll") for (int m = 0; m < 4; ++m) _Pragma("unroll") for (int n = 0; n < 2; ++n) _Pragma("unroll") for (int k = 0; k < 2; ++k) acc[ai][bj][m][n] = __builtin_amdgcn_mfma_f32_16x16x32_bf16(Bt[n][k], At[m][k], acc[ai][bj][m][n], 0, 0, 0); } \
        __builtin_amdgcn_s_setprio(0); } while (0)
#define PG8_WAIT_V(n) asm volatile("s_waitcnt vmcnt(" #n ")" ::: "memory")
#define PG8_WAIT_L(n) asm volatile("s_waitcnt lgkmcnt(" #n ")" ::: "memory")
#define PG8_BAR __builtin_amdgcn_s_barrier()
#define PG8_SCHED __builtin_amdgcn_sched_barrier(0)
    Unit cur, nxt; int ui = 0;
    if (!S.next(0, cur)) return;
    typename Epi::Pre preC;
    f32x4 acc[2][2][4][2];
#define PG8_ZERO_ACC do { if constexpr (!F8) { _Pragma("unroll") for (int a = 0; a < 2; ++a) _Pragma("unroll") for (int b = 0; b < 2; ++b) _Pragma("unroll") for (int m = 0; m < 4; ++m) _Pragma("unroll") for (int n = 0; n < 2; ++n) acc[a][b][m][n] = (f32x4){0.f, 0.f, 0.f, 0.f}; } } while (0)
    PG8_ZERO_ACC;
    bf16x8 At[4][2], B0[2][2], B1[2][2];
    const char* cA = (const char*)g.A + (size_t)cur.e * g.asel_bytes + (size_t)cur.pm * tstep; const char* cB = (const char*)g.Bt + (size_t)cur.e * g.bsel_bytes + (size_t)cur.pn * tstep;
    if constexpr (GATHER) PG8_GOFF(cur, vgC);
    PG8_STAGE(PG8_SB(0, 0), cB, voffB); PG8_STAGE(PG8_SB(0, 1), cB + hstep, voffB); PG8_STA(PG8_SA(0, 0), 0, cA, 0, false); PG8_STA(PG8_SA(0, 1), 1, cA + hstep, 0, false);
    if (wr == 1) PG8_BAR;
    PG8_WAIT_V(2); PG8_BAR;
    PG8_STAGE(PG8_SB(1, 0), cB + kstep, voffB); PG8_STA(PG8_SA(1, 0), 0, cA + kstep, kstep, false); PG8_STAGE(PG8_SB(1, 1), cB + hstep + kstep, voffB);
    PG8_WAIT_V(6); PG8_BAR;
    for (;;) {
        const bool has_next = S.next(ui + 1, nxt);
        E.pre(cur, wr, fr, preC);
        cur.par = ui & 1;
        if constexpr (Epi::NROW > 0) { if (wid >= 2 && wid < 2 + Epi::NROW) __builtin_amdgcn_global_load_lds((const unsigned*)E.row_tile(cur, wid - 2) + 4 * lane, (PG8_LAS unsigned*)(lds + RING_BYTES + 8192 + 2048 * (ui & 1) + 1024 * (wid - 2)), 16, 0, 0); }
        if constexpr (Epi::LBIAS) { if (wid == 0) __builtin_amdgcn_global_load_lds((const unsigned*)(E.bias_tile(cur) + 4 * lane), (PG8_LAS unsigned*)(lds + RING_BYTES + 4096 + 1024 * (ui & 1)), 16, 0, 0); }
        if constexpr (GATHER) { if (has_next && wid == 1) __builtin_amdgcn_global_load_lds((const unsigned*)(g.glist + (size_t)nxt.e * 32768 + (nxt.pm * BM - g.goff[nxt.e]) + 4 * lane), (PG8_LAS unsigned*)(lds + RING_BYTES + 6144 + 1024 * ((ui + 1) & 1)), 16, 0, 0); }
        const char* nA = has_next ? (const char*)g.A + (size_t)nxt.e * g.asel_bytes + (size_t)nxt.pm * tstep : cA;
        const char* nB = has_next ? (const char*)g.Bt + (size_t)nxt.e * g.bsel_bytes + (size_t)nxt.pn * tstep : cB;
        for (int t = 0; t < nt; t += 2) {
            const bool last = (t == nt - 2), first = (t == 0);
            const char* a1 = cA + (size_t)(t + 1) * kstep;
            const char* a2 = last ? nA : cA + (size_t)(t + 2) * kstep; const char* b2 = last ? nB : cB + (size_t)(t + 2) * kstep;
            const char* a3 = a2 + kstep; const char* b3 = b2 + kstep;
            const size_t k2 = last ? 0 : (size_t)(t + 2) * kstep;
            PG8_LDB(B0, 0, 0); PG8_LDB(B1, 0, 1); PG8_SCHED; PG8_LDA(At, 0, 0); PG8_STA(PG8_SA(1, 1), 1, a1 + hstep, (size_t)(t + 1) * kstep, false);
            if constexpr (GATHER) { if (last) {
                if (has_next) { const PG8_LAS int* gl_ = (const PG8_LAS int*)(lds + RING_BYTES + 6144 + 1024 * ((ui + 1) & 1)); const int rb_ = nxt.pm * BM - g.goff[nxt.e], cn_ = g.gcnt[nxt.e];
                    const int tid_ = wid * 64 + lane_now();
                    _Pragma("unroll") for (int _h = 0; _h < 2; ++_h) _Pragma("unroll") for (int _i = 0; _i < 2; ++_i) { int R_, C_; stage_rc(tid_ * 16 + _i * 8192, R_, C_);
                        const int tk_ = gl_[_h * HALF + R_] >> 2; const int tok_ = (rb_ + _h * HALF + R_ < cn_) ? tk_ : 0; vgC[_h][_i] = F8 ? (unsigned)(tok_ * K + C_ * 2) : (unsigned)(tok_ * K + C_) * 2u; } }
                } }
            PG8_WAIT_V(8); PG8_WAIT_L(0); PG8_BAR; PG8_MMA(0, 0, At, B0, first); PG8_MMA(0, 1, At, B1, first); PG8_BAR; PG8_SCHED;
            PG8_LDA(At, 0, 1); PG8_STAGE(PG8_SB(0, 0), b2, voffB); PG8_STAGE(PG8_SB(0, 1), b2 + hstep, voffB); PG8_STA(PG8_SA(0, 0), 0, a2, k2, last);
            PG8_WAIT_V(8); PG8_WAIT_L(0); PG8_BAR; PG8_MMA(1, 0, At, B0, first); PG8_MMA(1, 1, At, B1, first); PG8_BAR; PG8_SCHED;
            PG8_LDB(B0, 1, 0); PG8_LDB(B1, 1, 1); PG8_SCHED; PG8_LDA(At, 1, 0); PG8_STA(PG8_SA(0, 1), 1, a2 + hstep, k2, last);
            PG8_WAIT_V(8); PG8_WAIT_L(0); PG8_BAR; PG8_MMA(0, 0, At, B0, false); PG8_MMA(0, 1, At, B1, false); PG8_BAR; PG8_SCHED;
            PG8_LDA(At, 1, 1); PG8_STAGE(PG8_SB(1, 0), b3, voffB); PG8_STAGE(PG8_SB(1, 1), b3 + hstep, voffB); PG8_STA(PG8_SA(1, 0), 0, a3, k2 + kstep, last);
            PG8_WAIT_V(8); PG8_WAIT_L(0); PG8_BAR; PG8_MMA(1, 0, At, B0, false); PG8_MMA(1, 1, At, B1, false); PG8_BAR; PG8_SCHED;
        }
        if (wr == 0) PG8_BAR;
        if constexpr (F8) asm volatile("s_nop 15\n\ts_nop 15\n\ts_nop 15" ::: "memory");
        E(acc, cur, wr, wc, fr, fq, preC);
        if (!has_next) break;
        if constexpr (Epi::KEEPACC) { if (cur.e != 0) PG8_ZERO_ACC; } else PG8_ZERO_ACC;
        cur = nxt; cA = nA; cB = nB; ++ui;
        if (wr == 1) PG8_BAR;
    }
    PG8_WAIT_V(0);
    PG8_BAR;
#undef PG8_SA
#undef PG8_SB
#undef PG8_STAGE
#undef PG8_LDA
#undef PG8_STA
#undef PG8_GOFF
#undef PG8_LDB
#undef PG8_MMA
#undef PG8_ZERO_ACC
#undef PG8_WAIT_V
#undef PG8_WAIT_L
#undef PG8_BAR
#undef PG8_SCHED
}
}
using pg8::Unit;
typedef const f32x4 (&AccRef)[2][2][4][2];

#define XB_TMO      128
#define XB_XCNT(j)  (256  + 64 * (j))
#define XB_XSUB(j)  (1280 + 64 * (j))
#define XB_XGEN(j)  (2304 + 64 * (j))
#define XB_TOP      3328
#define XB_TOPGEN   3392
#define XCD_BAR_WORDS 3456
#define XB_SPIN_CAP (1u << 22)
__device__ __forceinline__ unsigned xb_ld(unsigned* p)              { return __hip_atomic_load(p, __ATOMIC_RELAXED, __HIP_MEMORY_SCOPE_AGENT); }
__device__ __forceinline__ unsigned xb_add(unsigned* p, unsigned v) { return __hip_atomic_fetch_add(p, v, __ATOMIC_RELAXED, __HIP_MEMORY_SCOPE_AGENT); }
__device__ __forceinline__ unsigned xb_xcc_id() { return (unsigned)__builtin_amdgcn_s_getreg((3 << 11) | 20) & 0xFu; }
#define XB_SPIN(cond, bar) do { unsigned _sp = 0; while (cond) { __builtin_amdgcn_s_sleep(1); \
    if ((++_sp & 255u) == 0u) { if (xb_ld(&(bar)[XB_TMO])) break; if (_sp > XB_SPIN_CAP) { atomicAdd(&(bar)[XB_TMO], 1u); break; } } } } while (0)
struct XcdBarrier { unsigned* bar; unsigned x; volatile LAS unsigned* st; };
__device__ __forceinline__ XcdBarrier xcd_barrier_post(unsigned* bar, volatile LAS unsigned* st, int tid) {
    XcdBarrier b; b.bar = bar; b.x = xb_xcc_id(); b.st = st;
    if (tid == 0) (void)xb_add(&bar[XB_XCNT(b.x)], 1u);
    return b;
}
__device__ __forceinline__ void xcd_barrier_complete(unsigned* bar, unsigned x, unsigned& nloc, unsigned& nx) {
    const unsigned G = gridDim.x * gridDim.y * gridDim.z;
    unsigned sum, cnt, mine, sp = 0u;
    for (;;) {
        sum = 0u; cnt = 0u; mine = 0u;
#pragma unroll
        for (unsigned j = 0; j < 16; ++j) { const unsigned c = xb_ld(&bar[XB_XCNT(j)]); sum += c; cnt += (c > 0u) ? 1u : 0u; mine = (j == x) ? c : mine; }
        if (sum == G) break;
        __builtin_amdgcn_s_sleep(1);
        if ((++sp & 255u) == 0u) { if (xb_ld(&bar[XB_TMO])) break; if (sp > XB_SPIN_CAP) { atomicAdd(&bar[XB_TMO], 1u); break; } }
    }
    nloc = mine > 0u ? mine : 1u; nx = cnt > 0u ? cnt : 1u;
}
__device__ __forceinline__ void xcd_barrier(const XcdBarrier& b, int wave) {
    asm volatile("s_waitcnt vmcnt(0)" ::: "memory");
    __syncthreads();
    if (wave == 0 && lane_now() == 0) {
        unsigned* bar = b.bar;
        __builtin_amdgcn_s_waitcnt(0);
        unsigned nloc = b.st[0], nx = b.st[1];
        if (nloc == 0u) { xcd_barrier_complete(bar, b.x, nloc, nx); b.st[0] = nloc; b.st[1] = nx; }
        const unsigned old = xb_add(&bar[XB_XSUB(b.x)], 1u);
        const unsigned gen = old / nloc;
        if (old + 1u == (gen + 1u) * nloc) {
            __builtin_amdgcn_fence(__ATOMIC_RELEASE, "agent");
            asm volatile("s_waitcnt vmcnt(0)" ::: "memory");
            const unsigned og = xb_add(&bar[XB_TOP], 1u);
            const unsigned tg = og / nx;
            if (og + 1u == (tg + 1u) * nx) xb_add(&bar[XB_TOPGEN], 1u);
            else XB_SPIN(xb_ld(&bar[XB_TOPGEN]) == tg, bar);
            __builtin_amdgcn_fence(__ATOMIC_ACQUIRE, "agent");
            xb_add(&bar[XB_XGEN(b.x)], 1u);
            asm volatile("s_waitcnt vmcnt(0)" ::: "memory");
        } else {
            XB_SPIN(xb_ld(&bar[XB_XGEN(b.x)]) == gen, bar);
            __builtin_amdgcn_fence(__ATOMIC_ACQUIRE, "agent");
            asm volatile("s_waitcnt vmcnt(0)" ::: "memory");
        }
    }
    __syncthreads();
}

struct Frame {
    LAS unsigned char* lds;
    unsigned* ctl;
    int tid, lane, wave, vcu, G;
    unsigned char* ws;
    float* out;
};
#define WSP(T, off) ((T*)(F.ws + (off)))
struct Args { const float* in[29]; float* out; unsigned char* ws; int ph_lo, ph_hi; };
#define FIN(i) (args.in[i])

template <bool SWZ = false, bool Q8 = false>
__device__ __forceinline__ void p0_transpose_item(const float* W, int K, int N, bf16* WT, LAS float* scr, int item, int lane, const float* kscale) {
    const int nblk = N / 32, kb = item / nblk, nb = item % nblk, k0 = 64 * kb, n0 = 32 * nb;
#pragma unroll
    for (int b = 0; b < 2; ++b) {
        float v[16];
#pragma unroll
        for (int i = 0; i < 16; ++i) { const int kk = 2 * (16 * b + i) + (lane >> 5); v[i] = W[(size_t)(k0 + kk) * N + n0 + (lane & 31)]; }
        __builtin_amdgcn_sched_barrier(0);
#pragma unroll
        for (int i = 0; i < 16; ++i) { const int kk = 2 * (16 * b + i) + (lane >> 5); if (kscale) v[i] *= kscale[k0 + kk]; scr[kk * 33 + (lane & 31)] = v[i]; }
        __builtin_amdgcn_sched_barrier(0);
    }
    asm volatile("s_waitcnt lgkmcnt(0)" ::: "memory");
    if constexpr (Q8) {
        const int c4 = lane & 3;
#pragma unroll
        for (int j = 0; j < 2; ++j) { const int n = (lane >> 2) + 16 * j; const LAS float* s = scr + (16 * c4) * 33 + n;
            u32x4 o; o.x = pk8(64.f * s[0 * 33], 64.f * s[1 * 33], 64.f * s[2 * 33], 64.f * s[3 * 33]); o.y = pk8(64.f * s[4 * 33], 64.f * s[5 * 33], 64.f * s[6 * 33], 64.f * s[7 * 33]);
            o.z = pk8(64.f * s[8 * 33], 64.f * s[9 * 33], 64.f * s[10 * 33], 64.f * s[11 * 33]); o.w = pk8(64.f * s[12 * 33], 64.f * s[13 * 33], 64.f * s[14 * 33], 64.f * s[15 * 33]);
            int nr = n0 + n; if (SWZ) { const int cl = nr & 255; nr = (nr & ~255) + 128 * ((cl >> 3) & 1) + 32 * (cl >> 6) + 8 * ((cl >> 4) & 3) + (cl & 7); }
            *(u32x4*)((unsigned char*)WT + (size_t)nr * K + k0 + 16 * c4) = o; }
        asm volatile("s_waitcnt lgkmcnt(0)" ::: "memory");
        return; }
    const int c = lane & 7;
#pragma unroll
    for (int j = 0; j < 4; ++j) { const int n = (lane >> 3) + 8 * j; const LAS float* s = scr + (8 * c) * 33 + n;
        u32x4 o; o.x = pk2(s[0 * 33], s[1 * 33]); o.y = pk2(s[2 * 33], s[3 * 33]); o.z = pk2(s[4 * 33], s[5 * 33]); o.w = pk2(s[6 * 33], s[7 * 33]);
        int nr = n0 + n; if (SWZ) { const int cl = nr & 255; nr = (nr & ~255) + 128 * ((cl >> 3) & 1) + 32 * (cl >> 6) + 8 * ((cl >> 4) & 3) + (cl & 7); }
        *(u32x4*)(WT + (size_t)nr * K + k0 + 8 * c) = o; }
    asm volatile("s_waitcnt lgkmcnt(0)" ::: "memory");
}
__device__ __forceinline__ void build_small_weights(const Args& args, Frame& F, int gt, int NT) {
    {
      bf16* WL = WSP(bf16, WS_WL);
      for (int i = gt; i < LORA_N * LORA_K; i += NT) { const int n = i >> 8, k = i & 255; float v = 0.f;
          const int tl = n >> 8, md = tl % 3, cc = (tl / 3) * 256 + (n & 255);
          if (md == 0) { if (k < 64) v = FIN(6)[k * 512 + cc]; }
          else if (md == 1) { if (k >= 64 && k < 128) v = FIN(8)[(k - 64) * 512 + cc]; }
          else { if (k >= 128) v = FIN(9)[(k - 128) * 512 + cc]; }
          WL[i] = (bf16)(pk2(v, 0.f) & 0xffffu); }
      bf16* GW3 = WSP(bf16, WS_GW);
      for (int i = gt; i < D * NE; i += NT) { const int k = i >> 5, e = i & 31; const float w = FIN(19)[i] * FIN(18)[k];
          const unsigned h = pk2(w, 0.f) & 0xffffu; const float r1 = w - bflo(h); const unsigned m_ = pk2(r1, 0.f) & 0xffffu; const float r2 = r1 - bflo(m_); const unsigned l = pk2(r2, 0.f) & 0xffffu;
          GW3[e * D + k] = (bf16)h; GW3[NE * D + e * D + k] = (bf16)m_; GW3[2 * NE * D + e * D + k] = (bf16)l; }
    }
}
__device__ __forceinline__ void p0_prologue(const Args& args, Frame& F, int parts, int gw, int NGW) {
    LAS float* scr = (LAS float*)(F.lds + F.wave * 16384);
    const int lane = F.lane;
    constexpr int I_IN = (D / 64) * (INC / 32), I_A = (AW / 64) * (D / 32), I_O = (D / 64) * (D / 32), I_P = (PLE / 64) * (D / 32);
    constexpr int I_W1 = (D / 64) * (F2 / 32), I_W2 = (FH / 64) * (D / 32);
    constexpr int NITEMS = I_IN + 2 * I_A + 2 * I_O + I_P;
    if (parts & 5) for (int it = ((parts & 1) ? 0 : I_IN) + gw; it < ((parts & 4) ? NITEMS : I_IN); it += NGW) {
        int r = it;
        if (r < I_IN) { const int tile = (r % (INC / 32)) >> 3;
            if ((G1_F8_TILES >> tile) & 1) p0_transpose_item<false, true>(FIN(3), D, INC, WSP(bf16, WS_WIN8), scr, r, lane, FIN(2));
            else p0_transpose_item(FIN(3), D, INC, WSP(bf16, WS_WIN), scr, r, lane, FIN(2));
            continue; } r -= I_IN;
        if (r < I_A) { p0_transpose_item<true>(FIN(15), AW, D, WSP(bf16, WS_WA), scr, r, lane, nullptr); continue; } r -= I_A;
        if (r < I_A) { p0_transpose_item<true>(FIN(16), RW, D, WSP(bf16, WS_WB), scr, r, lane, nullptr); continue; } r -= I_A;
        if (r < I_O) { p0_transpose_item<true>(FIN(17), D, D, WSP(bf16, WS_WO), scr, r, lane, nullptr); continue; } r -= I_O;
        if (r < I_O) { p0_transpose_item<true, true>(FIN(26), D, D, WSP(bf16, WS_WG), scr, r, lane, FIN(25)); continue; } r -= I_O;
        p0_transpose_item<true>(FIN(27), PLE, D, WSP(bf16, WS_WP), scr, r, lane, nullptr);
    }
    if (parts & 8) build_small_weights(args, F, F.vcu * 512 + F.tid, F.G * 512);
    if (parts & 1) { bf16* XB = WSP(bf16, WS_XB); float* R0 = WSP(float, WS_RSTD0);
      for (int m = gw; m < M; m += NGW) {
          const f32x4* xr = (const f32x4*)(FIN(0) + (size_t)m * D) + lane;
          f32x4 v[4]; float s = 0.f;
#pragma unroll
          for (int j = 0; j < 4; ++j) { v[j] = xr[64 * j]; s += (v[j].x * v[j].x + v[j].y * v[j].y) + (v[j].z * v[j].z + v[j].w * v[j].w); }
          s = wave_sum(s);
          u32x2* o = (u32x2*)(XB + (size_t)m * D) + lane;
#pragma unroll
          for (int j = 0; j < 4; ++j) { if (G1_F8_TILES) (WSP(unsigned, WS_XB8) + (size_t)m * (D / 4))[lane + 64 * j] = pk8(v[j].x, v[j].y, v[j].z, v[j].w); u32x2 w; w.x = pk2(v[j].x, v[j].y); w.y = pk2(v[j].z, v[j].w); o[64 * j] = w; }
          if (lane == 0) R0[m] = 1.0f / sqrtf(s * (1.f / D) + RMS_EPS);
      }
    }
    if (parts & 2) { bf16* PB = WSP(bf16, WS_PB);
      for (int m = 4 * gw; m < M; m += 4 * NGW) {
          f32x4 pv[4];
#pragma unroll
          for (int j = 0; j < 4; ++j) pv[j] = ((const f32x4*)(FIN(1) + (size_t)(m + j) * PLE))[lane];
#pragma unroll
          for (int j = 0; j < 4; ++j) { u32x2 w; w.x = pk2(pv[j].x, pv[j].y); w.y = pk2(pv[j].z, pv[j].w); ((u32x2*)(PB + (size_t)(m + j) * PLE))[lane] = w; }
      }
    }
}

__device__ __forceinline__ void expert_convert(const Args& args, Frame& F, int wv, int NW, int which) {
    LAS float* scr = (LAS float*)(F.lds + F.wave * 16384);
    constexpr int I_W1 = (D / 64) * (F2 / 32), I_W2 = (FH / 64) * (D / 32);
    if (which & 1) for (int it = wv; it < NE * I_W1; it += NW) { const int e = it / I_W1; p0_transpose_item<true, true>(FIN(21) + (size_t)e * D * F2, D, F2, (bf16*)(WSP(unsigned char, WS_W1) + (size_t)e * F2 * D), scr, it % I_W1, F.lane, nullptr); }
    if (which & 2) for (int it = wv; it < NE * I_W2; it += NW) { const int e = it / I_W2; p0_transpose_item<true, true>(FIN(23) + (size_t)e * FH * D, FH, D, (bf16*)(WSP(unsigned char, WS_W2) + (size_t)e * D * FH), scr, it % I_W2, F.lane, nullptr); }
}
struct EpiG1 {
    static constexpr bool PERM = true;
    typedef PreNone Pre; static constexpr bool LBIAS = false; static constexpr int NROW = 1; static constexpr bool KEEPACC = false;
    const float* rstd; bf16 *Q, *K, *VT, *ZR, *GT; float rs_mul; const LAS float* LR;
    __device__ __forceinline__ const void* row_tile(const Unit& u, int) const { return rstd + u.pm * 256; }
    __device__ __forceinline__ void pre(const Unit&, int, int, PreNone&) const {}
    __device__ __forceinline__ void operator()(AccRef acc, const Unit& u, int wr, int wc, int fr, int fq, const Pre& P) const {
        const int pn = u.pn, rowb = u.pm * 256 + wr * 64 + fr, cl = wc * 32 + 8 * fq;
#pragma unroll
        for (int ai = 0; ai < 2; ++ai)
#pragma unroll
            for (int m = 0; m < 4; ++m) {
                const int row = rowb + ai * 128 + m * 16; const float rs = LR[512 * u.par + wr * 64 + fr + ai * 128 + m * 16] * rs_mul;
                if (pn < 4) {
                    bf16* base = (pn < 2 ? Q : K) + (size_t)row * 512 + (pn & 1) * 256 + cl; const float sc = pn < 2 ? rs * 0.125f : rs;
#pragma unroll
                    for (int bj = 0; bj < 2; ++bj) { const f32x4 v0 = acc[ai][bj][m][0] * sc, v1 = acc[ai][bj][m][1] * sc;
                        u32x4 w; w.x = pk2(v0[0], v0[1]); w.y = pk2(v0[2], v0[3]); w.z = pk2(v1[0], v1[1]); w.w = pk2(v1[2], v1[3]); *(u32x4*)(base + bj * 128) = w; }
                } else if (pn < 6) {
                    const int b = row >> 11, s = row & 2047;
#pragma unroll
                    for (int bj = 0; bj < 2; ++bj)
#pragma unroll
                        for (int n = 0; n < 2; ++n)
#pragma unroll
                            for (int j = 0; j < 4; ++j) { const int c = (pn - 4) * 256 + cl + bj * 128 + 4 * n + j; const int hh = c >> 6, d = c & 63;
                                VT[((size_t)(((b * 8 + hh) * 128 + (s >> 4)) * 64 + d)) * 16 + (s & 15)] = (bf16)(pk2(acc[ai][bj][m][n][j] * rs, 0.f) & 0xffffu); }
                } else if (pn < 13) {
                    bf16* base = ZR + (size_t)row * RWC + (pn - 6) * 256 + cl;
#pragma unroll
                    for (int bj = 0; bj < 2; ++bj) { const f32x4 v0 = acc[ai][bj][m][0] * rs, v1 = acc[ai][bj][m][1] * rs;
                        u32x4 w; w.x = pk2(v0[0], v0[1]); w.y = pk2(v0[2], v0[3]); w.z = pk2(v1[0], v1[1]); w.w = pk2(v1[2], v1[3]); *(u32x4*)(base + bj * 128) = w; }
                } else {
                    bf16* base = GT + (size_t)row * 2048 + (pn - 13) * 256 + cl;
#pragma unroll
                    for (int bj = 0; bj < 2; ++bj) { const f32x4 v0 = acc[ai][bj][m][0] * rs, v1 = acc[ai][bj][m][1] * rs;
                        u32x4 w; w.x = pk2(sigm(v0[0]), sigm(v0[1])); w.y = pk2(sigm(v0[2]), sigm(v0[3])); w.z = pk2(sigm(v1[0]), sigm(v1[1])); w.w = pk2(sigm(v1[2]), sigm(v1[3])); *(u32x4*)(base + bj * 128) = w; }
                }
            }
    }
};
struct EpiLora {
    static constexpr bool PERM = true;
    typedef PreNone Pre; static constexpr bool LBIAS = true; static constexpr int NROW = 0; static constexpr bool KEEPACC = false;
    __device__ __forceinline__ void pre(const Unit&, int, int, PreNone&) const {}
    const float *w0, *a0; bf16 *DEC, *AA, *GG; const LAS float* LB;
    __device__ __forceinline__ const float* bias_tile(const Unit& u) const { const int md = u.pn % 3; return (md == 1 ? a0 : w0) + (u.pn >= 3 ? 256 : 0); }
    template <int MODE> __device__ __forceinline__ void body(AccRef acc, int rowb, int cb, const LAS float* bb) const {
#pragma unroll
        for (int bj = 0; bj < 2; ++bj) {
            const int c = cb + bj * 128;
            f32x4 b0 = (f32x4){0.f, 0.f, 0.f, 0.f}, b1 = b0;
            if (MODE != 2) { b0 = *(const LAS f32x4*)(bb + bj * 128); b1 = *(const LAS f32x4*)(bb + bj * 128 + 4); }
#pragma unroll
            for (int ai = 0; ai < 2; ++ai)
#pragma unroll
                for (int m = 0; m < 4; ++m) { const int row = rowb + ai * 128 + m * 16;
                    const f32x4 v0 = acc[ai][bj][m][0] + b0, v1 = acc[ai][bj][m][1] + b1; float o[8];
#pragma unroll
                    for (int j = 0; j < 8; ++j) { const float v = j < 4 ? v0[j] : v1[j - 4];
                        if (MODE == 0) o[j] = 0.60653066f * sigm(v);
                        else if (MODE == 1) o[j] = sigm(v); else o[j] = v; }
                    u32x4 w; w.x = pk2(o[0], o[1]); w.y = pk2(o[2], o[3]); w.z = pk2(o[4], o[5]); w.w = pk2(o[6], o[7]);
                    bf16* dst = (MODE == 0 ? DEC : MODE == 1 ? AA : GG) + (size_t)row * 512 + c; *(u32x4*)dst = w;
                    asm volatile("" ::: "memory"); }
        }
    }
    __device__ __forceinline__ void operator()(AccRef acc, const Unit& u, int wr, int wc, int fr, int fq, const Pre& P) const {
        const int pn = u.pn, rowb = u.pm * 256 + wr * 64 + fr, cb = (pn >= 3 ? 256 : 0) + wc * 32 + 8 * fq;
        const LAS float* bb = LB + 256 * u.par + wc * 32 + 8 * fq;
        if (pn == 0 || pn == 3) body<0>(acc, rowb, cb, bb); else if (pn == 1 || pn == 4) body<1>(acc, rowb, cb, bb); else body<2>(acc, rowb, cb, bb);
    }
};
template <int SECOND> struct EpiMerge {
    static constexpr bool PERM = true;
    typedef PreNone Pre; static constexpr bool LBIAS = false; static constexpr int NROW = 0; static constexpr bool KEEPACC = false;
    __device__ __forceinline__ void pre(const Unit&, int, int, PreNone&) const {}
    const bf16* GT; bf16* MG;
    __device__ __forceinline__ void operator()(AccRef acc, const Unit& u, int wr, int wc, int fr, int fq, const Pre& P) const {
        const int rowb = u.pm * 256 + wr * 64 + fr, c0 = u.pn * 256 + wc * 64 + 16 * fq;
#pragma unroll
        for (int ai = 0; ai < 2; ++ai) {
            u32x4 gv[4][2], ov[4][2];
#pragma unroll
            for (int m = 0; m < 4; ++m) { const int row = rowb + ai * 128 + m * 16;
#pragma unroll
                for (int bj = 0; bj < 2; ++bj) { gv[m][bj] = *(const u32x4*)(GT + (size_t)row * 2048 + SECOND * 1024 + c0 + 8 * bj); if (SECOND) ov[m][bj] = *(const u32x4*)(MG + (size_t)row * 1024 + c0 + 8 * bj); } }
            __builtin_amdgcn_sched_barrier(0);
#pragma unroll
            for (int m = 0; m < 4; ++m) { const int row = rowb + ai * 128 + m * 16;
#pragma unroll
                for (int bj = 0; bj < 2; ++bj) { const f32x4 v0 = acc[ai][bj][m][0], v1 = acc[ai][bj][m][1]; const u32x4 gq = gv[m][bj];
                    float o[8] = {v0[0] * bflo(gq.x), v0[1] * bfhi(gq.x), v0[2] * bflo(gq.y), v0[3] * bfhi(gq.y), v1[0] * bflo(gq.z), v1[1] * bfhi(gq.z), v1[2] * bflo(gq.w), v1[3] * bfhi(gq.w)};
                    if (SECOND) { const u32x4 oq = ov[m][bj]; o[0] += bflo(oq.x); o[1] += bfhi(oq.x); o[2] += bflo(oq.y); o[3] += bfhi(oq.y); o[4] += bflo(oq.z); o[5] += bfhi(oq.z); o[6] += bflo(oq.w); o[7] += bfhi(oq.w); }
                    u32x4 w; w.x = pk2(o[0], o[1]); w.y = pk2(o[2], o[3]); w.z = pk2(o[4], o[5]); w.w = pk2(o[6], o[7]); *(u32x4*)(MG + (size_t)row * 1024 + c0 + 8 * bj) = w; } }
            __builtin_amdgcn_sched_barrier(0);
        }
    }
};
struct EpiMerge2 {
    static constexpr bool PERM = true;
    typedef PreNone Pre; static constexpr bool LBIAS = false; static constexpr int NROW = 0; static constexpr bool KEEPACC = true;
    __device__ __forceinline__ void pre(const Unit&, int, int, PreNone&) const {}
    const bf16* GT; bf16* MG;
    __device__ __forceinline__ void operator()(f32x4 (&acc)[2][2][4][2], const Unit& u, int wr, int wc, int fr, int fq, const Pre& P) const {
        const int rowb = u.pm * 256 + wr * 64 + fr, c0 = u.pn * 256 + wc * 64 + 16 * fq;
        if (u.e == 0) {
#pragma unroll
            for (int ai = 0; ai < 2; ++ai) {
                u32x4 ga[4][2], gb[4][2];
#pragma unroll
                for (int m = 0; m < 4; ++m) { const int row = rowb + ai * 128 + m * 16;
#pragma unroll
                    for (int bj = 0; bj < 2; ++bj) { ga[m][bj] = *(const u32x4*)(GT + (size_t)row * 2048 + c0 + 8 * bj); gb[m][bj] = *(const u32x4*)(GT + (size_t)row * 2048 + 1024 + c0 + 8 * bj); } }
                __builtin_amdgcn_sched_barrier(0);
#pragma unroll
                for (int m = 0; m < 4; ++m)
#pragma unroll
                    for (int bj = 0; bj < 2; ++bj) { const u32x4 a = ga[m][bj], b = gb[m][bj]; f32x4 v0 = acc[ai][bj][m][0], v1 = acc[ai][bj][m][1];
                        v0[0] *= bflo(a.x) * __builtin_amdgcn_rcpf(bflo(b.x)); v0[1] *= bfhi(a.x) * __builtin_amdgcn_rcpf(bfhi(b.x)); v0[2] *= bflo(a.y) * __builtin_amdgcn_rcpf(bflo(b.y)); v0[3] *= bfhi(a.y) * __builtin_amdgcn_rcpf(bfhi(b.y));
                        v1[0] *= bflo(a.z) * __builtin_amdgcn_rcpf(bflo(b.z)); v1[1] *= bfhi(a.z) * __builtin_amdgcn_rcpf(bfhi(b.z)); v1[2] *= bflo(a.w) * __builtin_amdgcn_rcpf(bflo(b.w)); v1[3] *= bfhi(a.w) * __builtin_amdgcn_rcpf(bfhi(b.w));
                        acc[ai][bj][m][0] = v0; acc[ai][bj][m][1] = v1; }
                __builtin_amdgcn_sched_barrier(0);
            }
        } else {
#pragma unroll
            for (int ai = 0; ai < 2; ++ai) {
                u32x4 gb[4][2];
#pragma unroll
                for (int m = 0; m < 4; ++m) { const int row = rowb + ai * 128 + m * 16;
#pragma unroll
                    for (int bj = 0; bj < 2; ++bj) gb[m][bj] = *(const u32x4*)(GT + (size_t)row * 2048 + 1024 + c0 + 8 * bj); }
                __builtin_amdgcn_sched_barrier(0);
#pragma unroll
                for (int m = 0; m < 4; ++m) { const int row = rowb + ai * 128 + m * 16;
#pragma unroll
                    for (int bj = 0; bj < 2; ++bj) { const u32x4 b = gb[m][bj]; const f32x4 v0 = acc[ai][bj][m][0], v1 = acc[ai][bj][m][1];
                        u32x4 w; w.x = pk2(v0[0] * bflo(b.x), v0[1] * bfhi(b.x)); w.y = pk2(v0[2] * bflo(b.y), v0[3] * bfhi(b.y)); w.z = pk2(v1[0] * bflo(b.z), v1[1] * bfhi(b.z)); w.w = pk2(v1[2] * bflo(b.w), v1[3] * bfhi(b.w));
                        *(u32x4*)(MG + (size_t)row * 1024 + c0 + 8 * bj) = w; } }
                __builtin_amdgcn_sched_barrier(0);
            }
        }
    }
};
struct EpiX1 {
    static constexpr bool PERM = true;
    typedef PreNone Pre; static constexpr bool LBIAS = false; static constexpr int NROW = 0; static constexpr bool KEEPACC = false;
    __device__ __forceinline__ void pre(const Unit&, int, int, PreNone&) const {}
    const bf16* X; bf16* X1; const float* gn; unsigned char* HN;
    __device__ __forceinline__ void operator()(AccRef acc, const Unit& u, int wr, int wc, int fr, int fq, const Pre& P) const {
        const int rowb = u.pm * 256 + wr * 64 + fr, c0 = u.pn * 256 + wc * 64 + 16 * fq;
        const f32x4 g0 = *(const f32x4*)(gn + c0), g1 = *(const f32x4*)(gn + c0 + 4), g2 = *(const f32x4*)(gn + c0 + 8), g3 = *(const f32x4*)(gn + c0 + 12);
#pragma unroll
        for (int ai = 0; ai < 2; ++ai) {
            u32x4 xa_[4], xb_[4];
#pragma unroll
            for (int m = 0; m < 4; ++m) { const size_t off = (size_t)(rowb + ai * 128 + m * 16) * D + c0; xa_[m] = *(const u32x4*)(X + off); xb_[m] = *(const u32x4*)(X + off + 8); }
            __builtin_amdgcn_sched_barrier(0);
#pragma unroll
            for (int m = 0; m < 4; ++m) { const size_t off = (size_t)(rowb + ai * 128 + m * 16) * D + c0;
                const f32x4 x0 = (f32x4){bflo(xa_[m].x), bfhi(xa_[m].x), bflo(xa_[m].y), bfhi(xa_[m].y)} + acc[ai][0][m][0], x1 = (f32x4){bflo(xa_[m].z), bfhi(xa_[m].z), bflo(xa_[m].w), bfhi(xa_[m].w)} + acc[ai][0][m][1];
                const f32x4 x2 = (f32x4){bflo(xb_[m].x), bfhi(xb_[m].x), bflo(xb_[m].y), bfhi(xb_[m].y)} + acc[ai][1][m][0], x3 = (f32x4){bflo(xb_[m].z), bfhi(xb_[m].z), bflo(xb_[m].w), bfhi(xb_[m].w)} + acc[ai][1][m][1];
                { u32x4 xw; xw.x = pk2(x0[0], x0[1]); xw.y = pk2(x0[2], x0[3]); xw.z = pk2(x1[0], x1[1]); xw.w = pk2(x1[2], x1[3]); *(u32x4*)(X1 + off) = xw;
                  xw.x = pk2(x2[0], x2[1]); xw.y = pk2(x2[2], x2[3]); xw.z = pk2(x3[0], x3[1]); xw.w = pk2(x3[2], x3[3]); *(u32x4*)(X1 + off + 8) = xw; }
                u32x4 w; w.x = pk8(x0[0] * g0[0], x0[1] * g0[1], x0[2] * g0[2], x0[3] * g0[3]); w.y = pk8(x1[0] * g1[0], x1[1] * g1[1], x1[2] * g1[2], x1[3] * g1[3]);
                w.z = pk8(x2[0] * g2[0], x2[1] * g2[1], x2[2] * g2[2], x2[3] * g2[3]); w.w = pk8(x3[0] * g3[0], x3[1] * g3[1], x3[2] * g3[2], x3[3] * g3[3]); *(u32x4*)(HN + off) = w; }
            __builtin_amdgcn_sched_barrier(0);
        }
    }
};
struct EpiSwiglu {
    static constexpr bool PERM = true;
    typedef PreNone Pre; static constexpr bool LBIAS = true; static constexpr int NROW = 1; static constexpr bool KEEPACC = false;
    const float* b1; unsigned char* ACT; const int* LIST; const float* R1; const LAS int* OFF; const LAS int* CS; const LAS float* LB;
    __device__ __forceinline__ const void* row_tile(const Unit& u, int) const { return R1 + (size_t)u.e * CAP + (u.pm * 256 - OFF[u.e]); }
    __device__ __forceinline__ const float* bias_tile(const Unit& u) const { return b1 + (size_t)u.e * F2 + u.pn * 256; }
    __device__ __forceinline__ void pre(const Unit&, int, int, PreNone&) const {}
    __device__ __forceinline__ void operator()(AccRef acc, const Unit& u, int wr, int wc, int fr, int fq, const Pre& P) const {
        if (EPI_STUB & 1) return;
        const int rowb = u.pm * 256 + wr * 64 + fr, c0 = u.pn * 256 + wc * 64 + 16 * fq;
        const LAS float* bb = LB + 256 * u.par + wc * 64 + 16 * fq; const LAS float* lr = LB + 1024 + 512 * u.par + wr * 64 + fr;
        const f32x4 bv0 = *(const LAS f32x4*)(bb), bv1 = *(const LAS f32x4*)(bb + 4), bv2 = *(const LAS f32x4*)(bb + 8), bv3 = *(const LAS f32x4*)(bb + 12);
#pragma unroll
        for (int ai = 0; ai < 2; ++ai)
#pragma unroll
            for (int m = 0; m < 4; ++m) { const int row = rowb + ai * 128 + m * 16; const float rs = lr[ai * 128 + m * 16] * (1.f / 64.f);
                const f32x4 v[4] = {acc[ai][0][m][0] * rs + bv0, acc[ai][0][m][1] * rs + bv1, acc[ai][1][m][0] * rs + bv2, acc[ai][1][m][1] * rs + bv3};
                float o[8];
#pragma unroll
                for (int p = 0; p < 8; ++p) { float gl = v[p >> 1][2 * (p & 1)], ul = v[p >> 1][2 * (p & 1) + 1];
                    gl = fminf(gl, 7.f); ul = fminf(fmaxf(ul, -7.f), 7.f); o[p] = (ul + 1.f) * gl * __builtin_amdgcn_rcpf(1.f + __builtin_amdgcn_exp2f(-2.4554670f * gl)); }
                u32x2 w; w.x = pk8(o[0], o[1], o[2], o[3]); w.y = pk8(o[4], o[5], o[6], o[7]); *(u32x2*)(ACT + (size_t)row * FH + (c0 >> 1)) = w;
                asm volatile("" ::: "memory"); }
    }
};
struct EpiY {
    static constexpr bool PERM = true;
    typedef PreNone Pre; static constexpr bool LBIAS = true; static constexpr int NROW = 2; static constexpr bool KEEPACC = false;
    const float* b2; const int* LIST; const float* gatew; unsigned char* YB; const LAS int* OFF; const LAS int* CS; const LAS float* LB;
    __device__ __forceinline__ const float* bias_tile(const Unit& u) const { return b2 + (size_t)u.e * D + u.pn * 256; }
    __device__ __forceinline__ void pre(const Unit&, int, int, PreNone&) const {}
    __device__ __forceinline__ const void* row_tile(const Unit& u, int j) const { const size_t o = (size_t)u.e * CAP + (u.pm * 256 - OFF[u.e]); return j == 0 ? (const void*)(LIST + o) : (const void*)(gatew + o); }
    __device__ __forceinline__ void operator()(AccRef acc, const Unit& u, int wr, int wc, int fr, int fq, const Pre& P) const {
        const int rowb = u.pm * 256 + wr * 64 + fr, c0 = u.pn * 256 + wc * 64 + 16 * fq;
        const LAS float* bb = LB + 256 * u.par + wc * 64 + 16 * fq; const int rbase = rowb - OFF[u.e]; const LAS float* lr = LB + 1024 + 512 * u.par + wr * 64 + fr;
        if (EPI_STUB & 2) return;

#pragma unroll
        for (int ai = 0; ai < 2; ++ai) {
            float gts[4]; const int cnt_ = CS[u.e];
#pragma unroll
            for (int m = 0; m < 4; ++m) gts[m] = lr[256 + ai * 128 + m * 16];
#pragma unroll
            for (int m = 0; m < 4; ++m) {
                const int slot = ((const LAS int*)lr)[ai * 128 + m * 16]; if (rbase + ai * 128 + m * 16 < cnt_) { const float gt = gts[m] * 32.f;
                    const f32x4 v0 = (acc[ai][0][m][0] * (1.f / 64.f) + *(const LAS f32x4*)(bb)) * gt, v1 = (acc[ai][0][m][1] * (1.f / 64.f) + *(const LAS f32x4*)(bb + 4)) * gt;
                    const f32x4 v2 = (acc[ai][1][m][0] * (1.f / 64.f) + *(const LAS f32x4*)(bb + 8)) * gt, v3 = (acc[ai][1][m][1] * (1.f / 64.f) + *(const LAS f32x4*)(bb + 12)) * gt;
                    u32x4 w; w.x = pk8(v0[0], v0[1], v0[2], v0[3]); w.y = pk8(v1[0], v1[1], v1[2], v1[3]); w.z = pk8(v2[0], v2[1], v2[2], v2[3]); w.w = pk8(v3[0], v3[1], v3[2], v3[3]);
                    *(u32x4*)(YB + (size_t)slot * D + c0) = w; } }
            __builtin_amdgcn_sched_barrier(0); }
    }
};
struct EpiGate {
    static constexpr bool PERM = true;
    typedef PreNone Pre; static constexpr bool LBIAS = false; static constexpr int NROW = 1; static constexpr bool KEEPACC = false;
    __device__ __forceinline__ void pre(const Unit&, int, int, PreNone&) const {}
    __device__ __forceinline__ const void* row_tile(const Unit& u, int) const { return rstd2 + u.pm * 256; }
    const float* rstd2; unsigned char* GT; const LAS float* LR;
    __device__ __forceinline__ void operator()(AccRef acc, const Unit& u, int wr, int wc, int fr, int fq, const Pre& P) const {
        const int rowb = u.pm * 256 + wr * 64 + fr, c0 = u.pn * 256 + wc * 64 + 16 * fq;
#pragma unroll
        for (int ai = 0; ai < 2; ++ai)
#pragma unroll
            for (int m = 0; m < 4; ++m) { const int row = rowb + ai * 128 + m * 16; const float rs = LR[512 * u.par + wr * 64 + fr + ai * 128 + m * 16] * (1.f / 64.f);

                const f32x4 v0 = acc[ai][0][m][0] * rs, v1 = acc[ai][0][m][1] * rs, v2 = acc[ai][1][m][0] * rs, v3 = acc[ai][1][m][1] * rs;
                u32x4 w; w.x = pk8(256.f * sigm(v0[0]), 256.f * sigm(v0[1]), 256.f * sigm(v0[2]), 256.f * sigm(v0[3])); w.y = pk8(256.f * sigm(v1[0]), 256.f * sigm(v1[1]), 256.f * sigm(v1[2]), 256.f * sigm(v1[3]));
                w.z = pk8(256.f * sigm(v2[0]), 256.f * sigm(v2[1]), 256.f * sigm(v2[2]), 256.f * sigm(v2[3])); w.w = pk8(256.f * sigm(v3[0]), 256.f * sigm(v3[1]), 256.f * sigm(v3[2]), 256.f * sigm(v3[3]));
                *(u32x4*)(GT + (size_t)row * D + c0) = w; }
    }
};
struct EpiPle {
    static constexpr bool PERM = true;
    typedef PreNone Pre; static constexpr bool LBIAS = true; static constexpr int NROW = 0; static constexpr bool KEEPACC = false;
    __device__ __forceinline__ void pre(const Unit&, int, int, PreNone&) const {}
    __device__ __forceinline__ const float* bias_tile(const Unit& u) const { return fg + u.pn * 256; }
    const LAS float* LB;
    const bf16* X2B; const unsigned char* GT; float* O; float* rowss; unsigned* pcnt; const float* fg; const unsigned* ctl;
    __device__ __forceinline__ void operator()(f32x4 (&acc)[2][2][4][2], const Unit& u, int wr, int wc, int fr, int fq, const Pre& P) const {
        const int rowb = u.pm * 256 + wr * 64 + fr, c0 = u.pn * 256 + wc * 64 + 16 * fq;
#pragma unroll
        for (int ai = 0; ai < 2; ++ai)
#pragma unroll
            for (int m = 0; m < 4; ++m) { const int row = rowb + ai * 128 + m * 16; float ss = 0.f;
                const u32x4 gq = *(const u32x4*)(GT + (size_t)row * D + c0);
#pragma unroll
                for (int bj = 0; bj < 2; ++bj) { const size_t off = (size_t)row * D + c0 + bj * 8;
                    const u32x4 xv = *(const u32x4*)(X2B + off); f32x4 a0 = acc[ai][bj][m][0], a1 = acc[ai][bj][m][1];
                    const int g0w = (int)(bj ? gq.z : gq.x), g1w = (int)(bj ? gq.w : gq.y);
                    const f32x2 ga = __builtin_amdgcn_cvt_pk_f32_fp8(g0w, false) * (1.f / 256.f), gb = __builtin_amdgcn_cvt_pk_f32_fp8(g0w, true) * (1.f / 256.f), gc = __builtin_amdgcn_cvt_pk_f32_fp8(g1w, false) * (1.f / 256.f), gd = __builtin_amdgcn_cvt_pk_f32_fp8(g1w, true) * (1.f / 256.f);
                    a0[0] = bflo(xv.x) + ga.x * a0[0]; a0[1] = bfhi(xv.x) + ga.y * a0[1]; a0[2] = bflo(xv.y) + gb.x * a0[2]; a0[3] = bfhi(xv.y) + gb.y * a0[3];
                    a1[0] = bflo(xv.z) + gc.x * a1[0]; a1[1] = bfhi(xv.z) + gc.y * a1[1]; a1[2] = bflo(xv.w) + gd.x * a1[2]; a1[3] = bfhi(xv.w) + gd.y * a1[3];
#pragma unroll
                    for (int j = 0; j < 4; ++j) ss += a0[j] * a0[j] + a1[j] * a1[j];
                    acc[ai][bj][m][0] = a0; acc[ai][bj][m][1] = a1; }
                ss = sum_x32(sum_x16(ss));
                if (fq == 0) atomicAdd(rowss + row, ss);
                asm volatile("" ::: "memory"); }
        asm volatile("s_waitcnt vmcnt(0)" ::: "memory");
        __builtin_amdgcn_s_barrier();
        if (wr == 0 && wc == 0) {
            unsigned* pc = pcnt + 64 * u.pm;
            if (fr == 0 && fq == 0) __hip_atomic_fetch_add(pc, 1u, RLX_AGENT);
            unsigned spins = 0; while ((unsigned)__builtin_amdgcn_readfirstlane(__hip_atomic_load(pc, RLX_AGENT)) < 4u && ++spins < (1u << 20)) __builtin_amdgcn_s_sleep(4);
        }
        asm volatile("s_waitcnt vmcnt(0)" ::: "memory");
        __builtin_amdgcn_s_barrier();
        asm volatile("" ::: "memory");
        float rss[8];
#pragma unroll
        for (int k = 0; k < 8; ++k) rss[k] = __hip_atomic_load(rowss + rowb + (k >> 2) * 128 + (k & 3) * 16, RLX_AGENT);
        __builtin_amdgcn_sched_barrier(0);
#pragma unroll
        for (int ai = 0; ai < 2; ++ai)
#pragma unroll
            for (int m = 0; m < 4; ++m) { const int row = rowb + ai * 128 + m * 16; const float rs = __builtin_amdgcn_rsqf(rss[4 * ai + m] * (1.f / D) + RMS_EPS);
#pragma unroll
                for (int bj = 0; bj < 2; ++bj) { const size_t off = (size_t)row * D + c0 + bj * 8;
                    const LAS float* fl_ = LB + 256 * u.par + wc * 64 + 16 * fq + bj * 8;
                    f32x4 o0 = acc[ai][bj][m][0] * rs * *(const LAS f32x4*)(fl_), o1 = acc[ai][bj][m][1] * rs * *(const LAS f32x4*)(fl_ + 4);
                    if (TS_PROBE >= 0 && row == 0 && c0 == 0 && bj == 0) { const unsigned long long* ts = (const unsigned long long*)(ctl + 2048); const unsigned long long dt = ts[TS_END_SLOT] - ts[TS_PROBE]; o0[0] += (float)((dt + 300) / 1600) * 4.f; }
                    *(f32x4*)(O + off) = o0; *(f32x4*)(O + off + 4) = o1; }
                asm volatile("" ::: "memory"); }
    }
};

__device__ __forceinline__ void build_alora(const Args& args, Frame& F, int pm) {
    const bf16* ZR = WSP(bf16, WS_ZR); bf16* AL = WSP(bf16, WS_ALORA); const float* mu = FIN(4) + 1536;
    const int cc0 = (F.tid & 31) * 8; const f32x4 mu0 = *(const f32x4*)(mu + cc0), mu1 = *(const f32x4*)(mu + cc0 + 4);
    const float m8[8] = {mu0[0], mu0[1], mu0[2], mu0[3], mu1[0], mu1[1], mu1[2], mu1[3]};
    const float sa = cc0 < 64 ? 2.f : 1.f, sb = cc0 < 64 ? 2.f : 1.f, sc_ = cc0 < 64 ? -1.f : 0.f; const bool ident = cc0 >= 64 && cc0 < 128;
#pragma unroll 1
    for (int half = 0; half < 2; ++half) {
        u32x4 zc[8], zp[8];
#pragma unroll
        for (int i = 0; i < 8; ++i) {
            const int id = F.tid + 512 * (8 * half + i), row = pm * 256 + (id >> 5), cc = (id & 31) * 8;
            zc[i] = *(const u32x4*)(ZR + (size_t)row * RWC + 1536 + cc);
            zp[i] = (u32x4){0u, 0u, 0u, 0u}; if ((row & (SEQ - 1)) != 0) zp[i] = *(const u32x4*)(ZR + (size_t)(row - 1) * RWC + 1536 + cc);
        }
#pragma unroll
        for (int i = 0; i < 8; ++i) {
            const int id = F.tid + 512 * (8 * half + i), row = pm * 256 + (id >> 5), cc = (id & 31) * 8;
            const unsigned zcw[4] = {zc[i].x, zc[i].y, zc[i].z, zc[i].w}, zpw[4] = {zp[i].x, zp[i].y, zp[i].z, zp[i].w}; float o[8];
#pragma unroll
            for (int j = 0; j < 8; ++j) { const float c = (j & 1) ? bfhi(zcw[j >> 1]) : bflo(zcw[j >> 1]), p = (j & 1) ? bfhi(zpw[j >> 1]) : bflo(zpw[j >> 1]);
                const float xs = c + m8[j] * (p - c);
                const float sg = sigm(sa * xs); o[j] = ident ? xs : sb * sg + sc_; }
            u32x4 w; w.x = pk2(o[0], o[1]); w.y = pk2(o[2], o[3]); w.z = pk2(o[4], o[5]); w.w = pk2(o[6], o[7]);
            *(u32x4*)(AL + (size_t)row * LORA_K + cc) = w;
        }
    }
}

__device__ __forceinline__ void scan_unit(const Args& args, Frame& F, int bh) {
    const int b = bh >> 3, h = bh & 7, tid = F.tid;
    LAS float* LW = (LAS float*)F.lds;
    LAS float* LKK = LW + 4096, *LBB = LW + 8192, *LKP = LW + 12288, *LRR = LW + 16384, *LVV = LW + 20480, *LYY = LW + 24576, *LBON = LW + 28672;
    const bf16* ZR = WSP(bf16, WS_ZR); const bf16* DEC = WSP(bf16, WS_DEC); const bf16* AA = WSP(bf16, WS_AA); const bf16* GG = WSP(bf16, WS_GG); bf16* YB = WSP(bf16, WS_YB);
    const float* mu = FIN(4); const float* k_k = FIN(10) + h * 64; const float* k_a = FIN(11) + h * 64; const float* r_k = FIN(12) + h * 64;
    const float* lnw = FIN(13) + h * 64; const float* lnb = FIN(14) + h * 64;
    const int tt_p = tid >> 3, j0 = 8 * (tid & 7);
    const int row = tid >> 3, cg = tid & 7;
    float S[8];
#pragma unroll
    for (int j = 0; j < 8; ++j) S[j] = 0.f;
    float mur[8], muk[8], muv[8], kk_c[8], ka_c[8], rk_c[8];
#pragma unroll
    for (int j = 0; j < 8; ++j) { mur[j] = mu[h * 64 + j0 + j]; muk[j] = mu[512 + h * 64 + j0 + j]; muv[j] = mu[1024 + h * 64 + j0 + j]; kk_c[j] = k_k[j0 + j]; ka_c[j] = k_a[j0 + j]; rk_c[j] = r_k[j0 + j]; }
    for (int c0 = 0; c0 < SEQ; c0 += 64) {
        __syncthreads();
        {
            const size_t tok = (size_t)b * SEQ + c0 + tt_p; const bool first = (c0 + tt_p) == 0;
            const bf16* zc = ZR + tok * RWC + h * 64 + j0; const bf16* zp = zc - RWC;
            u32x4 cr = *(const u32x4*)zc, ck = *(const u32x4*)(zc + 512), cv = *(const u32x4*)(zc + 1024);
            u32x4 pr = (u32x4){0u, 0u, 0u, 0u}, pk = pr, pv = pr;
            if (!first) { pr = *(const u32x4*)zp; pk = *(const u32x4*)(zp + 512); pv = *(const u32x4*)(zp + 1024); }
            const f32x4 d0 = *(const f32x4*)(DEC + tok * 512 + h * 64 + j0), d1 = *(const f32x4*)(DEC + tok * 512 + h * 64 + j0 + 4);
            const f32x4 a0 = *(const f32x4*)(AA + tok * 512 + h * 64 + j0), a1 = *(const f32x4*)(AA + tok * 512 + h * 64 + j0 + 4);
            const unsigned crw[4] = {cr.x, cr.y, cr.z, cr.w}, ckw[4] = {ck.x, ck.y, ck.z, ck.w}, cvw[4] = {cv.x, cv.y, cv.z, cv.w};
            const unsigned prw[4] = {pr.x, pr.y, pr.z, pr.w}, pkw[4] = {pk.x, pk.y, pk.z, pk.w}, pvw[4] = {pv.x, pv.y, pv.z, pv.w};
            float r[8], k[8], v[8], kk[8], a[8], dec[8]; float ss = 0.f;
#pragma unroll
            for (int j = 0; j < 8; ++j) {
                const float rc = (j & 1) ? bfhi(crw[j >> 1]) : bflo(crw[j >> 1]), rp = (j & 1) ? bfhi(prw[j >> 1]) : bflo(prw[j >> 1]);
                const float kc = (j & 1) ? bfhi(ckw[j >> 1]) : bflo(ckw[j >> 1]), kp = (j & 1) ? bfhi(pkw[j >> 1]) : bflo(pkw[j >> 1]);
                const float vc = (j & 1) ? bfhi(cvw[j >> 1]) : bflo(cvw[j >> 1]), vp = (j & 1) ? bfhi(pvw[j >> 1]) : bflo(pvw[j >> 1]);
                r[j] = rc + mur[j] * (rp - rc); k[j] = kc + muk[j] * (kp - kc); v[j] = vc + muv[j] * (vp - vc);
                kk[j] = k[j] * kk_c[j]; ss += kk[j] * kk[j];
                a[j] = j < 4 ? a0[j] : a1[j - 4]; dec[j] = j < 4 ? d0[j] : d1[j - 4];
            }
            ss = red8(ss);
            const float inv = 1.0f / fmaxf(sqrtf(ss), 1e-12f);
            float bon = 0.f; float kpv[8], bbv[8];
#pragma unroll
            for (int j = 0; j < 8; ++j) { kk[j] *= inv; bbv[j] = kk[j] * a[j]; kpv[j] = k[j] * (1.f + (a[j] - 1.f) * ka_c[j]); bon += r[j] * kpv[j] * rk_c[j]; }
            bon = red8(bon);
            const int o = tt_p * 64 + j0;
            *(LAS f32x4*)(LW + o) = (f32x4){dec[0], dec[1], dec[2], dec[3]}; *(LAS f32x4*)(LW + o + 4) = (f32x4){dec[4], dec[5], dec[6], dec[7]};
            *(LAS f32x4*)(LKK + o) = (f32x4){kk[0], kk[1], kk[2], kk[3]}; *(LAS f32x4*)(LKK + o + 4) = (f32x4){kk[4], kk[5], kk[6], kk[7]};
            *(LAS f32x4*)(LBB + o) = (f32x4){bbv[0], bbv[1], bbv[2], bbv[3]}; *(LAS f32x4*)(LBB + o + 4) = (f32x4){bbv[4], bbv[5], bbv[6], bbv[7]};
            *(LAS f32x4*)(LKP + o) = (f32x4){kpv[0], kpv[1], kpv[2], kpv[3]}; *(LAS f32x4*)(LKP + o + 4) = (f32x4){kpv[4], kpv[5], kpv[6], kpv[7]};
            *(LAS f32x4*)(LRR + o) = (f32x4){r[0], r[1], r[2], r[3]}; *(LAS f32x4*)(LRR + o + 4) = (f32x4){r[4], r[5], r[6], r[7]};
            *(LAS f32x4*)(LVV + o) = (f32x4){v[0], v[1], v[2], v[3]}; *(LAS f32x4*)(LVV + o + 4) = (f32x4){v[4], v[5], v[6], v[7]};
            if ((tid & 7) == 0) LBON[tt_p] = bon;
        }
        __syncthreads();
#pragma unroll 2
        for (int tt = 0; tt < 64; ++tt) {
            const int o = tt * 64 + 8 * cg;
            const f32x4 k0 = *(const LAS f32x4*)(LKK + o), k1 = *(const LAS f32x4*)(LKK + o + 4);
            const f32x4 w0 = *(const LAS f32x4*)(LW + o), w1 = *(const LAS f32x4*)(LW + o + 4);
            const f32x4 b0 = *(const LAS f32x4*)(LBB + o), b1 = *(const LAS f32x4*)(LBB + o + 4);
            const f32x4 p0 = *(const LAS f32x4*)(LKP + o), p1 = *(const LAS f32x4*)(LKP + o + 4);
            const f32x4 r0 = *(const LAS f32x4*)(LRR + o), r1 = *(const LAS f32x4*)(LRR + o + 4);
            const float vi = LVV[tt * 64 + row];
            float sa = (S[0] * k0[0] + S[1] * k0[1]) + (S[2] * k0[2] + S[3] * k0[3]) + (S[4] * k1[0] + S[5] * k1[1]) + (S[6] * k1[2] + S[7] * k1[3]);
            sa = -red8(sa);
#pragma unroll
            for (int j = 0; j < 4; ++j) { S[j] = S[j] * w0[j] + (sa * b0[j] + vi * p0[j]); S[4 + j] = S[4 + j] * w1[j] + (sa * b1[j] + vi * p1[j]); }
            float y = (S[0] * r0[0] + S[1] * r0[1]) + (S[2] * r0[2] + S[3] * r0[3]) + (S[4] * r1[0] + S[5] * r1[1]) + (S[6] * r1[2] + S[7] * r1[3]);
            y = red8(y);
            if (cg == 0) LYY[tt * 64 + row] = y;
        }
        __syncthreads();
        {
            const size_t tok = (size_t)b * SEQ + c0 + tt_p; const int o = tt_p * 64 + j0;
            const f32x4 y0 = *(const LAS f32x4*)(LYY + o), y1 = *(const LAS f32x4*)(LYY + o + 4);
            const f32x4 v0 = *(const LAS f32x4*)(LVV + o), v1 = *(const LAS f32x4*)(LVV + o + 4);
            float s = (y0[0] + y0[1]) + (y0[2] + y0[3]) + (y1[0] + y1[1]) + (y1[2] + y1[3]);
            const float mean = red8(s) * (1.f / 64.f); float q = 0.f;
#pragma unroll
            for (int j = 0; j < 4; ++j) { const float d0 = y0[j] - mean, d1 = y1[j] - mean; q += d0 * d0 + d1 * d1; }
            const float rs = 1.0f / sqrtf(red8(q) * (1.f / 64.f) + GN_EPS); const float bon = LBON[tt_p];
            const u32x4 gv = *(const u32x4*)(GG + tok * 512 + h * 64 + j0); const unsigned gw[4] = {gv.x, gv.y, gv.z, gv.w}; float ov[8];
#pragma unroll
            for (int j = 0; j < 8; ++j) { const float yy = j < 4 ? y0[j] : y1[j - 4], vv = j < 4 ? v0[j] : v1[j - 4]; const float g = (j & 1) ? bfhi(gw[j >> 1]) : bflo(gw[j >> 1]);
                ov[j] = ((yy - mean) * rs * lnw[j0 + j] + lnb[j0 + j] + bon * vv) * g; }
            u32x4 w; w.x = pk2(ov[0], ov[1]); w.y = pk2(ov[2], ov[3]); w.z = pk2(ov[4], ov[5]); w.w = pk2(ov[6], ov[7]);
            *(u32x4*)(YB + tok * 512 + h * 64 + j0) = w;
        }
    }
    __syncthreads();
}

constexpr int LDA = 72, LDT = 40, LDF = 36;
constexpr int SC_WF = 0, SC_AT = 8192, SC_RT = SC_AT + 4608, SC_BT = SC_RT + 4608, SC_KT = SC_BT + 4608;
constexpr int SC_BCT = SC_KT + 4608, SC_KCT = SC_BCT + 5120, SC_VT = SC_KCT + 5120, SC_AHT = SC_VT + 5120, SC_UHT = SC_AHT + 5120;
constexpr int SC_AAB = SC_UHT + 5120, SC_ARB = SC_AAB + 4608, SC_ARK = SC_ARB + 2560, SC_RHS2 = SC_ARK + 2560, SC_YF = SC_RHS2 + 16384, SC_HT = SC_YF + 8192, SC_BON = SC_HT + 9216;
static_assert(SC_BON + 128 + 2048 <= RING_BYTES, "scan LDS map");
__device__ __forceinline__ float red16(float v) { v += dppf<0xB1>(v); v += dppf<0x4E>(v); v += dppf<0x141>(v); v += dppf<0x140>(v); return v; }
__device__ __forceinline__ bf16x8 ld16(const LAS bf16* p) { return *(const LAS bf16x8*)p; }
__device__ __forceinline__ bf16x8 ld8x2(const LAS bf16* p) { const u32x2 lo = *(const LAS u32x2*)p, hi = *(const LAS u32x2*)(p + 8); const u32x4 w = (u32x4){lo.x, lo.y, hi.x, hi.y}; return __builtin_bit_cast(bf16x8, w); }
__device__ __forceinline__ bf16x8 packq(const f32x16& x, int q) { u32x4 w; w.x = pk2(x[8 * q], x[8 * q + 1]); w.y = pk2(x[8 * q + 2], x[8 * q + 3]); w.z = pk2(x[8 * q + 4], x[8 * q + 5]); w.w = pk2(x[8 * q + 6], x[8 * q + 7]); return __builtin_bit_cast(bf16x8, w); }
#define MFMA32(a, b, c) __builtin_amdgcn_mfma_f32_32x32x16_bf16((a), (b), (c), 0, 0, 0)
struct ScanLoad { u32x2 cr, ck, cv, pr, pk, pv, g, decb, etab; f32x4 dec, eta; };
__device__ __forceinline__ void scan_load(ScanLoad& L, const bf16* ZR, const bf16* DEC, const bf16* AA, const bf16* GG, size_t tok, int hc, bool first) {
    const bf16* zc = ZR + tok * RWC + hc; const bf16* zp = zc - RWC;
    L.cr = *(const u32x2*)zc; L.ck = *(const u32x2*)(zc + 512); L.cv = *(const u32x2*)(zc + 1024);
    L.pr = (u32x2){0u, 0u}; L.pk = L.pr; L.pv = L.pr;
    if (!first) { L.pr = *(const u32x2*)zp; L.pk = *(const u32x2*)(zp + 512); L.pv = *(const u32x2*)(zp + 1024); }
    L.decb = *(const u32x2*)(DEC + tok * 512 + hc); L.etab = *(const u32x2*)(AA + tok * 512 + hc); L.g = *(const u32x2*)(GG + tok * 512 + hc);
}
#define LBAR() do { asm volatile("s_waitcnt lgkmcnt(0)" ::: "memory"); __builtin_amdgcn_s_barrier(); asm volatile("" ::: "memory"); } while (0)
typedef short v4i16_t __attribute__((ext_vector_type(4)));
__device__ __forceinline__ bf16x8 trfrag(const LAS bf16* X, int k0a, int k0b, int cbase, int lane) {
    const int g = lane >> 4, i = lane & 15, col = cbase + 16 * (g & 1) + 4 * (i & 3), rq = i >> 2;
    const v4i16_t lo = __builtin_amdgcn_ds_read_tr16_b64_v4i16((LAS v4i16_t*)(X + (k0a + rq) * LDA + col));
    const v4i16_t hi = __builtin_amdgcn_ds_read_tr16_b64_v4i16((LAS v4i16_t*)(X + (k0b + rq) * LDA + col));
    return (bf16x8){lo[0], lo[1], lo[2], lo[3], hi[0], hi[1], hi[2], hi[3]};
}
__device__ __forceinline__ void scan_unit_chunked(const Args& args, Frame& F, int bh) {
    const int b = bh >> 3, h = bh & 7, tid = F.tid, w = F.wave;
    LAS unsigned char* L = F.lds;
    LAS float* WF = (LAS float*)(L + SC_WF); LAS float* AAB = (LAS float*)(L + SC_AAB); LAS float* RHS2 = (LAS float*)(L + SC_RHS2); LAS float* YF = (LAS float*)(L + SC_YF); LAS float* BON = (LAS float*)(L + SC_BON);
    LAS bf16* AT = (LAS bf16*)(L + SC_AT); LAS bf16* RT = (LAS bf16*)(L + SC_RT); LAS bf16* BT = (LAS bf16*)(L + SC_BT); LAS bf16* KT = (LAS bf16*)(L + SC_KT);
    LAS bf16* BCT = (LAS bf16*)(L + SC_BCT); LAS bf16* KCT = (LAS bf16*)(L + SC_KCT); LAS bf16* VT = (LAS bf16*)(L + SC_VT); LAS bf16* AHT = (LAS bf16*)(L + SC_AHT); LAS bf16* UHT = (LAS bf16*)(L + SC_UHT);
    LAS bf16* ARB = (LAS bf16*)(L + SC_ARB); LAS bf16* ARK = (LAS bf16*)(L + SC_ARK); LAS bf16* HT = (LAS bf16*)(L + SC_HT);
    const bf16* ZR = WSP(bf16, WS_ZR); const bf16* DEC = WSP(bf16, WS_DEC); const bf16* AA = WSP(bf16, WS_AA); const bf16* GG = WSP(bf16, WS_GG); bf16* YB = WSP(bf16, WS_YB);
    const int t = tid >> 4, j0 = 4 * (tid & 15), hc = h * 64 + j0;
    LAS float* CST = (LAS float*)(L + SC_BON + 128);
    { const int c = tid >> 6, j = tid & 63; const float* src = c == 0 ? FIN(4) : c == 1 ? FIN(4) + 512 : c == 2 ? FIN(4) + 1024 : c == 3 ? FIN(10) : c == 4 ? FIN(11) : c == 5 ? FIN(12) : c == 6 ? FIN(13) : FIN(14);
      CST[c * 64 + j] = src[h * 64 + j]; }
    for (int i = tid; i < 64 * LDA / 2; i += 512) ((LAS unsigned*)HT)[i] = 0u;
    ScanLoad cur; scan_load(cur, ZR, DEC, AA, GG, (size_t)b * SEQ + t, hc, t == 0);
    LBAR();
    u32x2 pend = (u32x2){0u, 0u};
    for (int c0 = 0; c0 < SEQ; c0 += 32) {
        const size_t tok = (size_t)b * SEQ + c0 + t;
        float r[4], kp[4], v[4], al[4], be[4], gq[4]; f32x4 gl, gpl;
        {
            cur.dec = (f32x4){__expf(-bflo(cur.decb.x)), __expf(-bfhi(cur.decb.x)), __expf(-bflo(cur.decb.y)), __expf(-bfhi(cur.decb.y))};
            cur.eta = (f32x4){bflo(cur.etab.x), bfhi(cur.etab.x), bflo(cur.etab.y), bfhi(cur.etab.y)};
            const f32x4 mur = *(const LAS f32x4*)(CST + j0), muk = *(const LAS f32x4*)(CST + 64 + j0), muv = *(const LAS f32x4*)(CST + 128 + j0), kkc = *(const LAS f32x4*)(CST + 192 + j0), kac = *(const LAS f32x4*)(CST + 256 + j0), rkc = *(const LAS f32x4*)(CST + 320 + j0);
            const unsigned crw[2] = {cur.cr.x, cur.cr.y}, ckw[2] = {cur.ck.x, cur.ck.y}, cvw[2] = {cur.cv.x, cur.cv.y}, prw[2] = {cur.pr.x, cur.pr.y}, pkw[2] = {cur.pk.x, cur.pk.y}, pvw[2] = {cur.pv.x, cur.pv.y}, gw2[2] = {cur.g.x, cur.g.y};
            float k[4], kk[4]; float ss = 0.f;
#pragma unroll
            for (int j = 0; j < 4; ++j) {
                const float rc = (j & 1) ? bfhi(crw[j >> 1]) : bflo(crw[j >> 1]), rp = (j & 1) ? bfhi(prw[j >> 1]) : bflo(prw[j >> 1]);
                const float kc = (j & 1) ? bfhi(ckw[j >> 1]) : bflo(ckw[j >> 1]), kq = (j & 1) ? bfhi(pkw[j >> 1]) : bflo(pkw[j >> 1]);
                const float vc = (j & 1) ? bfhi(cvw[j >> 1]) : bflo(cvw[j >> 1]), vq = (j & 1) ? bfhi(pvw[j >> 1]) : bflo(pvw[j >> 1]);
                r[j] = rc + mur[j] * (rp - rc); k[j] = kc + muk[j] * (kq - kc); v[j] = vc + muv[j] * (vq - vc);
                kk[j] = k[j] * kkc[j]; ss += kk[j] * kk[j]; gq[j] = (j & 1) ? bfhi(gw2[j >> 1]) : bflo(gw2[j >> 1]);
            }
            ss = red16(ss);
            const float inv = __builtin_amdgcn_rsqf(fmaxf(ss, 1e-24f)); float bon = 0.f;
#pragma unroll
            for (int j = 0; j < 4; ++j) { kk[j] *= inv; al[j] = -kk[j]; be[j] = kk[j] * cur.eta[j]; kp[j] = k[j] * (1.f + (cur.eta[j] - 1.f) * kac[j]); bon += r[j] * kp[j] * rkc[j]; }
            bon = red16(bon);
            gl = cur.dec; gpl = (f32x4){1.f, 1.f, 1.f, 1.f};
            { const int ln = tid & 63;
#pragma unroll
              for (int j = 0; j < 4; ++j) { const float u1 = __shfl_up(gl[j], 16); gl[j] = (ln >= 16) ? gl[j] * u1 : gl[j]; }
#pragma unroll
              for (int j = 0; j < 4; ++j) { const float u2 = __shfl_up(gl[j], 32); gl[j] = (ln >= 32) ? gl[j] * u2 : gl[j]; }
#pragma unroll
              for (int j = 0; j < 4; ++j) { const float u3 = __shfl_up(gl[j], 16); gpl[j] = (ln >= 16) ? u3 : 1.f; }
              if (ln >= 48) *(LAS f32x4*)(WF + w * 64 + j0) = gl; }
            if ((tid & 15) == 0) BON[t] = bon;
        }
        if (c0 + 32 < SEQ && !(SCAN_STUB & 32)) scan_load(cur, ZR, DEC, AA, GG, tok + 32, hc, false);
        if (c0 > 0) { const bf16* yp = YB + (tok - 32) * 512 + hc; asm volatile("global_store_dwordx2 %0, %1, off" :: "v"(yp), "v"(pend) : "memory"); }
        LBAR();
        {
            f32x4 pre = (f32x4){1.f, 1.f, 1.f, 1.f}, gC = pre;
#pragma unroll
            for (int ww = 0; ww < 8; ++ww) { const f32x4 wt = *(const LAS f32x4*)(WF + ww * 64 + j0); gC = gC * wt; if (ww < w) pre = pre * wt; }
            const f32x4 gt = pre * gl, gp = pre * gpl;
            if (t == 31) *(LAS f32x4*)(WF + 512 + j0) = gC;
            float a_[4], r_[4], b_[4], k_[4], bc[4], kc[4];
#pragma unroll
            for (int j = 0; j < 4; ++j) { const float ig = __builtin_amdgcn_rcpf(gt[j]); a_[j] = al[j] * gp[j]; r_[j] = r[j] * gt[j]; b_[j] = be[j] * ig; k_[j] = kp[j] * ig; bc[j] = b_[j] * gC[j]; kc[j] = k_[j] * gC[j]; }
            u32x2 wv; wv.x = pk2(a_[0], a_[1]); wv.y = pk2(a_[2], a_[3]); *(LAS u32x2*)(AT + t * LDA + j0) = wv;
            wv.x = pk2(r_[0], r_[1]); wv.y = pk2(r_[2], r_[3]); *(LAS u32x2*)(RT + t * LDA + j0) = wv;
            wv.x = pk2(b_[0], b_[1]); wv.y = pk2(b_[2], b_[3]); *(LAS u32x2*)(BT + t * LDA + j0) = wv;
            wv.x = pk2(k_[0], k_[1]); wv.y = pk2(k_[2], k_[3]); *(LAS u32x2*)(KT + t * LDA + j0) = wv;
            wv.x = pk2(bc[0], bc[1]); wv.y = pk2(bc[2], bc[3]); *(LAS u32x2*)(BCT + t * LDA + j0) = wv;
            wv.x = pk2(kc[0], kc[1]); wv.y = pk2(kc[2], kc[3]); *(LAS u32x2*)(KCT + t * LDA + j0) = wv;
            wv.x = pk2(v[0], v[1]); wv.y = pk2(v[2], v[3]); *(LAS u32x2*)(VT + t * LDA + j0) = wv;
        }
        LBAR();
        if (w < 4 && !(SCAN_STUB & 1)) {
            const int lane = lane_now(), r32 = lane & 31, hh = lane >> 5;
            f32x16 mT, mN;
#pragma unroll
            for (int i = 0; i < 16; ++i) { mT[i] = 0.f; mN[i] = 0.f; }
#pragma unroll
            for (int q = 0; q < 4; ++q) { const bf16x8 bfr = ld16(BT + r32 * LDA + 8 * hh + 16 * q), afr = ld16(AT + r32 * LDA + 8 * hh + 16 * q);
                mT = MFMA32(bfr, afr, mT);
                mN = MFMA32(afr, bfr, mN); }
#pragma unroll
            for (int i = 0; i < 16; ++i) { const int c_ = crow(i, hh); mT[i] = (c_ < r32) ? mT[i] : 0.f; mN[i] = (r32 < c_) ? mN[i] : 0.f; }
            f32x16 X;
            if (w < 2) {
#pragma unroll
                for (int i = 0; i < 16; ++i) X[i] = bflo((unsigned)AT[crow(i, hh) * LDA + 32 * w + r32]);
            } else {
                f32x16 kT;
#pragma unroll
                for (int i = 0; i < 16; ++i) { kT[i] = 0.f; X[i] = 0.f; }
#pragma unroll
                for (int q = 0; q < 4; ++q) kT = MFMA32(ld16(KT + r32 * LDA + 8 * hh + 16 * q), ld16(AT + r32 * LDA + 8 * hh + 16 * q), kT);
#pragma unroll
                for (int i = 0; i < 16; ++i) kT[i] = (crow(i, hh) < r32) ? kT[i] : 0.f;
#pragma unroll
                for (int q = 0; q < 2; ++q) X = MFMA32(packq(kT, q), trfrag(VT, 16 * q + 4 * hh, 16 * q + 8 + 4 * hh, 32 * (w - 2), lane), X);
            }
#pragma unroll
            for (int k = 0; k < 5; ++k) {
                const bf16x8 t0 = packq(mT, 0), t1 = packq(mT, 1), x0 = packq(X, 0), x1 = packq(X, 1);
                X = MFMA32(t0, x0, X); X = MFMA32(t1, x1, X);
                if (k < 4) {
                    const bf16x8 n0 = packq(mN, 0), n1 = packq(mN, 1);
                    f32x16 zT, zN;
#pragma unroll
                    for (int i = 0; i < 16; ++i) { zT[i] = 0.f; zN[i] = 0.f; }
                    zT = MFMA32(n0, t0, zT); zT = MFMA32(n1, t1, zT);
                    zN = MFMA32(t0, n0, zN); zN = MFMA32(t1, n1, zN);
                    mT = zT; mN = zN;
                }
            }
            LAS bf16* dst = ((w < 2) ? AHT : UHT) + (32 * (w & 1) + r32) * LDT + 4 * hh;
#pragma unroll
            for (int i4 = 0; i4 < 4; ++i4) { u32x2 wv; wv.x = pk2(X[4 * i4], X[4 * i4 + 1]); wv.y = pk2(X[4 * i4 + 2], X[4 * i4 + 3]); *(LAS u32x2*)(dst + 8 * i4) = wv; }
        } else if (w < 6 && !(SCAN_STUB & 1)) {
            const int lane = lane_now(), r32 = lane & 31, hh = lane >> 5;
            const LAS bf16* Aop = ((w & 1) ? KT : BT) + r32 * LDA + 8 * hh; const LAS bf16* Bop = RT + r32 * LDA + 8 * hh;
            f32x16 x;
#pragma unroll
            for (int i = 0; i < 16; ++i) x[i] = 0.f;
#pragma unroll
            for (int q = 0; q < 4; ++q) x = MFMA32(ld16(Aop + 16 * q), ld16(Bop + 16 * q), x);
#pragma unroll
            for (int i = 0; i < 16; ++i) x[i] = (crow(i, hh) <= r32) ? x[i] : 0.f;
            LAS bf16* dst = ((w & 1) ? ARK : ARB) + r32 * LDT + 4 * hh;
#pragma unroll
            for (int i4 = 0; i4 < 4; ++i4) { u32x2 wv; wv.x = pk2(x[4 * i4], x[4 * i4 + 1]); wv.y = pk2(x[4 * i4 + 2], x[4 * i4 + 3]); *(LAS u32x2*)(dst + 8 * i4) = wv; }
        }
        LBAR();
        f32x16 hn;
        if (SCAN_STUB & 4) { for (int i = 0; i < 16; ++i) hn[i] = 0.f; } else if (w < 4) {
            const int lane = lane_now(), r32 = lane & 31, hh = lane >> 5;
            const int jb = w >> 1, ib = w & 1;
            f32x16 pt[2];
#pragma unroll
            for (int a = 0; a < 2; ++a) {
#pragma unroll
                for (int i = 0; i < 16; ++i) pt[a][i] = 0.f;
#pragma unroll
                for (int q = 0; q < 2; ++q) pt[a] = MFMA32(ld16(AHT + (32 * a + r32) * LDT + 16 * q + 8 * hh), trfrag(BCT, 16 * q + 8 * hh, 16 * q + 8 * hh + 4, 32 * jb, lane), pt[a]);
            }
            { const float gC = WF[512 + 32 * jb + r32];
#pragma unroll
              for (int i = 0; i < 16; ++i) { const float add = (crow(i, hh) == r32) ? gC : 0.f; pt[0][i] += (jb == 0) ? add : 0.f; pt[1][i] += (jb == 0) ? 0.f : add; } }
#pragma unroll
            for (int i = 0; i < 16; ++i) hn[i] = 0.f;
#pragma unroll
            for (int q = 0; q < 2; ++q) {
                hn = MFMA32(trfrag(BCT, 16 * q + 8 * hh, 16 * q + 8 * hh + 4, 32 * jb, lane), ld16(UHT + (32 * ib + r32) * LDT + 16 * q + 8 * hh), hn);
                hn = MFMA32(trfrag(KCT, 16 * q + 8 * hh, 16 * q + 8 * hh + 4, 32 * jb, lane), trfrag(VT, 16 * q + 8 * hh, 16 * q + 8 * hh + 4, 32 * ib, lane), hn);
            }
#pragma unroll
            for (int a = 0; a < 2; ++a)
#pragma unroll
                for (int q = 0; q < 2; ++q) hn = MFMA32(packq(pt[a], q), ld8x2(HT + (32 * ib + r32) * LDA + 32 * a + 16 * q + 4 * hh), hn);
        } else if (w < 6) {
            const int lane = lane_now(), r32 = lane & 31, hh = lane >> 5;
            const int ib = w & 1;
            f32x16 rt[2];
#pragma unroll
            for (int a = 0; a < 2; ++a) {
#pragma unroll
                for (int i = 0; i < 16; ++i) rt[a][i] = bflo((unsigned)RT[r32 * LDA + 32 * a + crow(i, hh)]);
#pragma unroll
                for (int q = 0; q < 2; ++q) rt[a] = MFMA32(ld16(AHT + (32 * a + r32) * LDT + 16 * q + 8 * hh), ld16(ARB + r32 * LDT + 16 * q + 8 * hh), rt[a]);
            }
            f32x16 y;
#pragma unroll
            for (int i = 0; i < 16; ++i) y[i] = 0.f;
#pragma unroll
            for (int q = 0; q < 2; ++q) {
                y = MFMA32(ld16(ARB + r32 * LDT + 16 * q + 8 * hh), ld16(UHT + (32 * ib + r32) * LDT + 16 * q + 8 * hh), y);
                y = MFMA32(ld16(ARK + r32 * LDT + 16 * q + 8 * hh), trfrag(VT, 16 * q + 8 * hh, 16 * q + 8 * hh + 4, 32 * ib, lane), y);
            }
#pragma unroll
            for (int a = 0; a < 2; ++a)
#pragma unroll
                for (int q = 0; q < 2; ++q) y = MFMA32(packq(rt[a], q), ld8x2(HT + (32 * ib + r32) * LDA + 32 * a + 16 * q + 4 * hh), y);
#pragma unroll
            for (int i = 0; i < 16; ++i) YF[crow(i, hh) * 64 + 32 * ib + r32] = y[i];
        }
        LBAR();
        if (w < 4) {
            const int lane = lane_now(), r32 = lane & 31, hh = lane >> 5;
            const int jb = w >> 1, ib = w & 1; LAS bf16* dst = HT + (32 * ib + r32) * LDA + 32 * jb + 4 * hh;
#pragma unroll
            for (int i4 = 0; i4 < 4; ++i4) { u32x2 wv; wv.x = pk2(hn[4 * i4], hn[4 * i4 + 1]); wv.y = pk2(hn[4 * i4 + 2], hn[4 * i4 + 3]); *(LAS u32x2*)(dst + 8 * i4) = wv; }
        }
        {
            const f32x4 y4 = *(const LAS f32x4*)(YF + t * 64 + j0);
            const float mean = red16((y4[0] + y4[1]) + (y4[2] + y4[3])) * (1.f / 64.f); float qv = 0.f;
#pragma unroll
            for (int j = 0; j < 4; ++j) { const float d = y4[j] - mean; qv += d * d; }
            const float rs = __builtin_amdgcn_rsqf(red16(qv) * (1.f / 64.f) + GN_EPS); const float bon = BON[t]; float ov[4];
            const f32x4 lnw = *(const LAS f32x4*)(CST + 384 + j0), lnb = *(const LAS f32x4*)(CST + 448 + j0);
#pragma unroll
            for (int j = 0; j < 4; ++j) ov[j] = ((y4[j] - mean) * rs * lnw[j] + lnb[j] + bon * v[j]) * gq[j];
            pend.x = pk2(ov[0], ov[1]); pend.y = pk2(ov[2], ov[3]);
        }
    }
    *(u32x2*)(YB + ((size_t)b * SEQ + SEQ - 32 + t) * 512 + hc) = pend;
}

__device__ __forceinline__ bool attn_step(const bf16x8 (&qf)[4], const bf16x8 (&kf)[4], const u32x2 (&vlo)[2][2], const u32x2 (&vhi)[2][2], f32x16& y0, f32x16& y1, float& carry, int s0, int t0, int q, int hi) {
    f32x16 p;
#pragma unroll
    for (int r = 0; r < 16; ++r) p[r] = 0.f;
#pragma unroll
    for (int d0 = 0; d0 < 4; ++d0) p = __builtin_amdgcn_mfma_f32_32x32x16_bf16(kf[d0], qf[d0], p, 0, 0, 0);
    float om[16], be[16];
#pragma unroll
    for (int r = 0; r < 16; ++r) {
        const int kv = crow(r, hi); const bool valid = (s0 + kv) < (t0 + q);
        const float z = fminf(p[r], 80.f); const float t = __expf(z); const float o = __builtin_amdgcn_rcpf(1.f + t);
        om[r] = valid ? o : 1.f; be[r] = valid ? t * o : 0.f;
    }
    float el[16], G[4], PG[4];
#pragma unroll
    for (int i = 0; i < 4; ++i) { el[4 * i + 3] = 1.f; el[4 * i + 2] = om[4 * i + 3]; el[4 * i + 1] = el[4 * i + 2] * om[4 * i + 2]; el[4 * i] = el[4 * i + 1] * om[4 * i + 1]; G[i] = el[4 * i] * om[4 * i]; }
#pragma unroll
    for (int i = 0; i < 4; ++i) PG[i] = __shfl_xor(G[i], 32);
    float sG[4], sP[4];
    sG[3] = 1.f; sG[2] = G[3]; sG[1] = G[3] * G[2]; sG[0] = sG[1] * G[1];
    sP[3] = 1.f; sP[2] = PG[3]; sP[1] = PG[3] * PG[2]; sP[0] = sP[1] * PG[1];
    const float total = (sG[0] * G[0]) * (sP[0] * PG[0]);
    float A[16];
#pragma unroll
    for (int i = 0; i < 4; ++i) { const float eg = sG[i] * (hi ? sP[i] : sP[i] * PG[i]) * carry;
#pragma unroll
        for (int j = 0; j < 4; ++j) A[4 * i + j] = be[4 * i + j] * el[4 * i + j] * eg; }
    carry *= total;
    bf16x8 pf[2];
#pragma unroll
    for (int s = 0; s < 2; ++s) { u32x4 w; w.x = pk2(A[8 * s], A[8 * s + 1]); w.y = pk2(A[8 * s + 2], A[8 * s + 3]); w.z = pk2(A[8 * s + 4], A[8 * s + 5]); w.w = pk2(A[8 * s + 6], A[8 * s + 7]); pf[s] = __builtin_bit_cast(bf16x8, w); }
#pragma unroll
    for (int s = 0; s < 2; ++s) {
        const u32x4 a0 = (u32x4){vlo[0][s].x, vlo[0][s].y, vhi[0][s].x, vhi[0][s].y}, a1 = (u32x4){vlo[1][s].x, vlo[1][s].y, vhi[1][s].x, vhi[1][s].y};
        y0 = __builtin_amdgcn_mfma_f32_32x32x16_bf16(__builtin_bit_cast(bf16x8, a0), pf[s], y0, 0, 0, 0);
        y1 = __builtin_amdgcn_mfma_f32_32x32x16_bf16(__builtin_bit_cast(bf16x8, a1), pf[s], y1, 0, 0, 0);
    }
    return __all(carry < 5.6e-14f);
}
__device__ __forceinline__ void attn_tile(Frame& F, int bh, int qt) {
    const int lane = F.lane, q = lane & 31, hi = lane >> 5, b = bh >> 3, h = bh & 7, t0 = 32 * qt;
    const size_t tokbase = (size_t)b * SEQ;
    const bf16* QB = WSP(bf16, WS_Q); const bf16* KB = WSP(bf16, WS_K); const bf16* VT = WSP(bf16, WS_VT); bf16* YA = WSP(bf16, WS_YA);
    bf16x8 qf[4];
    { const bf16* Qp = QB + (tokbase + t0 + q) * 512 + h * 64 + 8 * hi;
#pragma unroll
      for (int d0 = 0; d0 < 4; ++d0) qf[d0] = *(const bf16x8*)(Qp + 16 * d0); }
    f32x16 y0, y1;
#pragma unroll
    for (int r = 0; r < 16; ++r) { y0[r] = 0.f; y1[r] = 0.f; }
    float carry = 1.f;
    const bf16* Vrow = VT + (size_t)bh * 128 * 1024 + q * 16 + 4 * hi;
    bf16x8 kA[4], kB[4]; u32x2 vloA[2][2], vhiA[2][2], vloB[2][2], vhiB[2][2];
#define ATT_LOAD(KF, VLO, VHI, S0) do { const bf16* Kp_ = KB + (tokbase + (S0) + q) * 512 + h * 64 + 8 * hi; \
        _Pragma("unroll") for (int d0 = 0; d0 < 4; ++d0) KF[d0] = *(const bf16x8*)(Kp_ + 16 * d0); \
        _Pragma("unroll") for (int dt = 0; dt < 2; ++dt) _Pragma("unroll") for (int s_ = 0; s_ < 2; ++s_) { const bf16* vp_ = Vrow + (size_t)(((S0) >> 4) + s_) * 1024 + dt * 512; VLO[dt][s_] = *(const u32x2*)vp_; VHI[dt][s_] = *(const u32x2*)(vp_ + 8); } } while (0)
    ATT_LOAD(kA, vloA, vhiA, t0);
    for (int s0 = t0; ; ) {
        { const int sn = s0 >= 32 ? s0 - 32 : 0; ATT_LOAD(kB, vloB, vhiB, sn); __builtin_amdgcn_sched_barrier(0); }
        if (attn_step(qf, kA, vloA, vhiA, y0, y1, carry, s0, t0, q, hi)) break;
        s0 -= 32; if (s0 < 0) break;
        { const int sn = s0 >= 32 ? s0 - 32 : 0; ATT_LOAD(kA, vloA, vhiA, sn); __builtin_amdgcn_sched_barrier(0); }
        if (attn_step(qf, kB, vloB, vhiB, y0, y1, carry, s0, t0, q, hi)) break;
        s0 -= 32; if (s0 < 0) break;
    }
#undef ATT_LOAD
    bf16* Yp = YA + (tokbase + t0 + q) * 512 + h * 64 + 4 * hi;
#pragma unroll
    for (int i = 0; i < 4; ++i) {
        u32x2 w0, w1; w0.x = pk2(y0[4 * i], y0[4 * i + 1]); w0.y = pk2(y0[4 * i + 2], y0[4 * i + 3]); w1.x = pk2(y1[4 * i], y1[4 * i + 1]); w1.y = pk2(y1[4 * i + 2], y1[4 * i + 3]);
        *(u32x2*)(Yp + 8 * i) = w0; *(u32x2*)(Yp + 32 + 8 * i) = w1;
    }
}

__device__ __forceinline__ void attn_tile_l(Frame& F, int bh, int qt, bool have1, bool have2) {
    const int lane = F.lane, q = lane & 31, hi = lane >> 5, b = bh >> 3, h = bh & 7, t0 = 32 * qt;
    const size_t tokbase = (size_t)b * SEQ;
    const bf16* QB = WSP(bf16, WS_Q); const bf16* KB = WSP(bf16, WS_K); const bf16* VT = WSP(bf16, WS_VT); bf16* YA = WSP(bf16, WS_YA);
    LAS unsigned char* slots = F.lds + F.wave * 16384 + lane * 16;
    bf16x8 qf[4];
    { const bf16* Qp = QB + (tokbase + t0 + q) * 512 + h * 64 + 8 * hi;
#pragma unroll
      for (int d0 = 0; d0 < 4; ++d0) qf[d0] = *(const bf16x8*)(Qp + 16 * d0); }
    f32x16 y0, y1;
#pragma unroll
    for (int r = 0; r < 16; ++r) { y0[r] = 0.f; y1[r] = 0.f; }
    float carry = 1.f;
    const bf16* Vrow = VT + (size_t)bh * 128 * 1024 + q * 16 + 4 * hi;
    bf16x8 kA[4], kB[4]; u32x2 vloA[2][2], vhiA[2][2], vloB[2][2], vhiB[2][2];
#define ATT_LOAD(KF, VLO, VHI, S0) do { const bf16* Kp_ = KB + (tokbase + (S0) + q) * 512 + h * 64 + 8 * hi; \
        _Pragma("unroll") for (int d0 = 0; d0 < 4; ++d0) KF[d0] = *(const bf16x8*)(Kp_ + 16 * d0); \
        _Pragma("unroll") for (int dt = 0; dt < 2; ++dt) _Pragma("unroll") for (int s_ = 0; s_ < 2; ++s_) { const bf16* vp_ = Vrow + (size_t)(((S0) >> 4) + s_) * 1024 + dt * 512; VLO[dt][s_] = *(const u32x2*)vp_; VHI[dt][s_] = *(const u32x2*)(vp_ + 8); } } while (0)
#define ATT_LDS_LD(KF, VLO, VHI, T) do { const LAS unsigned char* sp_ = slots + ((T) & 1) * 8192; \
        _Pragma("unroll") for (int d0 = 0; d0 < 4; ++d0) KF[d0] = *(const LAS bf16x8*)(sp_ + d0 * 1024); \
        _Pragma("unroll") for (int dt = 0; dt < 2; ++dt) _Pragma("unroll") for (int s_ = 0; s_ < 2; ++s_) { const u32x4 w_ = *(const LAS u32x4*)(sp_ + (4 + dt * 2 + s_) * 1024); VLO[dt][s_] = (u32x2){w_.x, w_.y}; VHI[dt][s_] = (u32x2){w_.z, w_.w}; } } while (0)
#define ATT_LDS_ST(KF, VLO, VHI, T) do { LAS unsigned char* sp_ = slots + ((T) & 1) * 8192; \
        _Pragma("unroll") for (int d0 = 0; d0 < 4; ++d0) *(LAS bf16x8*)(sp_ + d0 * 1024) = KF[d0]; \
        _Pragma("unroll") for (int dt = 0; dt < 2; ++dt) _Pragma("unroll") for (int s_ = 0; s_ < 2; ++s_) *(LAS u32x4*)(sp_ + (4 + dt * 2 + s_) * 1024) = (u32x4){VLO[dt][s_].x, VLO[dt][s_].y, VHI[dt][s_].x, VHI[dt][s_].y}; } while (0)
    ATT_LOAD(kA, vloA, vhiA, t0);
    if (t0 >= 32 && !have1) ATT_LOAD(kB, vloB, vhiB, t0 - 32);
    bool done = attn_step(qf, kA, vloA, vhiA, y0, y1, carry, t0, t0, q, hi) || t0 < 32;
    if (!done) { if (have1) ATT_LDS_LD(kB, vloB, vhiB, qt - 1);
        done = attn_step(qf, kB, vloB, vhiB, y0, y1, carry, t0 - 32, t0, q, hi) || t0 < 64; }
    if (!done) { if (have2) ATT_LDS_LD(kB, vloB, vhiB, qt - 2); else ATT_LOAD(kB, vloB, vhiB, t0 - 64);
        done = attn_step(qf, kB, vloB, vhiB, y0, y1, carry, t0 - 64, t0, q, hi) || t0 < 96; }
    ATT_LDS_ST(kA, vloA, vhiA, qt);
    if (!done) { ATT_LOAD(kA, vloA, vhiA, t0 - 96);
        for (int s0 = t0 - 96; ; ) {
            { const int sn = s0 >= 32 ? s0 - 32 : 0; ATT_LOAD(kB, vloB, vhiB, sn); __builtin_amdgcn_sched_barrier(0); }
            if (attn_step(qf, kA, vloA, vhiA, y0, y1, carry, s0, t0, q, hi)) break;
            s0 -= 32; if (s0 < 0) break;
            { const int sn = s0 >= 32 ? s0 - 32 : 0; ATT_LOAD(kA, vloA, vhiA, sn); __builtin_amdgcn_sched_barrier(0); }
            if (attn_step(qf, kB, vloB, vhiB, y0, y1, carry, s0, t0, q, hi)) break;
            s0 -= 32; if (s0 < 0) break;
        } }
#undef ATT_LOAD
#undef ATT_LDS_LD
#undef ATT_LDS_ST
    bf16* Yp = YA + (tokbase + t0 + q) * 512 + h * 64 + 4 * hi;
#pragma unroll
    for (int i = 0; i < 4; ++i) {
        u32x2 w0, w1; w0.x = pk2(y0[4 * i], y0[4 * i + 1]); w0.y = pk2(y0[4 * i + 2], y0[4 * i + 3]); w1.x = pk2(y1[4 * i], y1[4 * i + 1]); w1.y = pk2(y1[4 * i + 2], y1[4 * i + 3]);
        *(u32x2*)(Yp + 8 * i) = w0; *(u32x2*)(Yp + 32 + 8 * i) = w1;
    }
}

__device__ __forceinline__ void p5a_router(const Args& args, Frame& F) {
    LAS float* LG = (LAS float*)F.lds;
    LAS unsigned* HIST = (LAS unsigned*)(F.lds + 32768); LAS unsigned* BASE = HIST + 32;
    const bf16* X1 = WSP(bf16, WS_X1); const bf16* GW3 = WSP(bf16, WS_GW); const float* rb = FIN(20);
    unsigned* cnt = F.ctl + CW_CNT; int* LIST = WSP(int, WS_LIST); float* LRS = WSP(float, WS_LRS); float* LGT = WSP(float, WS_LGT);
    const int tid = F.tid, lane = F.lane, wave = F.wave;
    for (int tb = blockIdx.x; tb < M / 128; tb += F.G) {
        if (tid < 32) { HIST[tid] = 0u; ((LAS float*)(HIST + 64))[tid] = rb[tid]; }
        __syncthreads();
        int ex[4] = {0, 0, 0, 0}; float gt[4] = {0.f, 0.f, 0.f, 0.f}; unsigned lr[4] = {0u, 0u, 0u, 0u}; int tok = 0; float rstd_keep = 0.f;
        {
            const int i = lane & 31, kh = lane >> 5, g = wave & 3, kq = wave >> 2; tok = tb * 128 + g * 32 + i;
            const bf16* xr = X1 + (size_t)tok * D + 512 * kq + 8 * kh;
            LAS bf16* BL = (LAS bf16*)(F.lds + 65536);
            const int sq_ = tid >> 8, se_ = (tid >> 3) & 31, sc_ = tid & 7;
            const bf16* gsrc = GW3 + (size_t)se_ * D + 512 * sq_ + 8 * sc_;
            LAS bf16* ldst = BL + (sq_ * 32 + se_) * 72 + 8 * sc_;
            const LAS bf16* lsrc = BL + (kq * 32 + i) * 72 + 8 * kh;
            constexpr int ARR = 2 * 32 * 72, BUF = 3 * ARR;
            f32x16 acc;
#pragma unroll
            for (int r = 0; r < 16; ++r) acc[r] = 0.f;
            float ss = 0.f;
            u32x4 bq[3], an[4];
#pragma unroll
            for (int ar = 0; ar < 3; ++ar) bq[ar] = *(const u32x4*)(gsrc + (size_t)ar * NE * D);
#pragma unroll
            for (int uu = 0; uu < 4; ++uu) an[uu] = *(const u32x4*)(xr + 16 * uu);
#pragma unroll 1
            for (int it = 0; it < 8; ++it) {
                LAS bf16* wb = ldst + (it & 1) * BUF;
#pragma unroll
                for (int ar = 0; ar < 3; ++ar) *(LAS u32x4*)(wb + ar * ARR) = bq[ar];
                u32x4 a[4];
#pragma unroll
                for (int uu = 0; uu < 4; ++uu) a[uu] = an[uu];
                const int itn = it < 7 ? it + 1 : 7;
#pragma unroll
                for (int ar = 0; ar < 3; ++ar) bq[ar] = *(const u32x4*)(gsrc + (size_t)ar * NE * D + 64 * itn);
#pragma unroll
                for (int uu = 0; uu < 4; ++uu) an[uu] = *(const u32x4*)(xr + 16 * (4 * itn + uu));
                __syncthreads();
                const LAS bf16* rb_ = lsrc + (it & 1) * BUF;
#pragma unroll
                for (int uu = 0; uu < 4; ++uu) {
                    const unsigned aw[4] = {a[uu].x, a[uu].y, a[uu].z, a[uu].w};
#pragma unroll
                    for (int j = 0; j < 4; ++j) { const float lo_ = bflo(aw[j]), hi_ = bfhi(aw[j]); ss += lo_ * lo_ + hi_ * hi_; }
                    const bf16x8 af = __builtin_bit_cast(bf16x8, a[uu]);
                    acc = MFMA32(af, *(const LAS bf16x8*)(rb_ + 2 * ARR + 16 * uu), acc); acc = MFMA32(af, *(const LAS bf16x8*)(rb_ + ARR + 16 * uu), acc); acc = MFMA32(af, *(const LAS bf16x8*)(rb_ + 16 * uu), acc); }
            }
            ss += __shfl_xor(ss, 32);
            LAS float* RED = (LAS float*)(F.lds + 40960) + (g * 64 + lane) * 17;
            if (kq == 1) {
#pragma unroll
                for (int r = 0; r < 16; ++r) RED[r] = acc[r];
                RED[16] = ss; }
            __syncthreads();
            if (kq == 0) {
#pragma unroll
                for (int r = 0; r < 16; ++r) acc[r] += RED[r];
                ss += RED[16]; }
            if (wave < 4) {
            const float rstd = 1.0f / sqrtf(ss * (1.f / D) + RMS_EPS);
            rstd_keep = rstd;
            LAS float* L = LG + wave * (32 * 33);
#pragma unroll
            for (int r = 0; r < 16; ++r) L[crow(r, kh) * 33 + i] = acc[r];
            asm volatile("s_waitcnt lgkmcnt(0)" ::: "memory");
            if (kh == 0) {
                float v0 = -3.0e38f, v1 = -3.0e38f, v2 = -3.0e38f, v3 = -3.0e38f; int i0 = 0, i1 = 0, i2 = 0, i3 = 0;
                const LAS float* RB = (const LAS float*)(HIST + 64); float lg[32];
#pragma unroll
                for (int e = 0; e < 32; ++e) lg[e] = L[i * 33 + e] * rstd + RB[e];
#pragma unroll
                for (int e = 0; e < 32; ++e) { const float v = lg[e];
                    const bool c0 = v > v0, c1 = v > v1, c2 = v > v2, c3 = v > v3;
                    v3 = c2 ? v2 : (c3 ? v : v3); i3 = c2 ? i2 : (c3 ? e : i3);
                    v2 = c1 ? v1 : (c2 ? v : v2); i2 = c1 ? i1 : (c2 ? e : i2);
                    v1 = c0 ? v0 : (c1 ? v : v1); i1 = c0 ? i0 : (c1 ? e : i1);
                    v0 = c0 ? v : v0; i0 = c0 ? e : i0; }
                const float e1 = __expf(v1 - v0), e2 = __expf(v2 - v0), e3 = __expf(v3 - v0), inv = 1.0f / (1.f + e1 + e2 + e3);
                ex[0] = i0; ex[1] = i1; ex[2] = i2; ex[3] = i3; gt[0] = inv; gt[1] = e1 * inv; gt[2] = e2 * inv; gt[3] = e3 * inv;
#pragma unroll
                for (int k = 0; k < 4; ++k) lr[k] = __hip_atomic_fetch_add(&HIST[ex[k]], 1u, __ATOMIC_RELAXED, __HIP_MEMORY_SCOPE_WORKGROUP);
            }
            }
        }
        __syncthreads();
        if (tid < 32) BASE[tid] = __hip_atomic_fetch_add(cnt + tid, HIST[tid], RLX_AGENT);
        __syncthreads();
        if (wave < 4 && lane < 32) {
#pragma unroll
            for (int k = 0; k < 4; ++k) { const unsigned pos = BASE[ex[k]] + lr[k]; const size_t li = (size_t)ex[k] * CAP + pos; LIST[li] = tok * 4 + k; LRS[li] = rstd_keep; LGT[li] = gt[k]; }
        }
        __syncthreads();
    }
}
__device__ __forceinline__ int moe_tables(Frame& F) {
    LAS int* CS = (LAS int*)(F.lds + MOE_OFF); LAS int* OFF = CS + 32; LAS unsigned char* TE = F.lds + MOE_TE;
    if (F.tid < 32) { int c = (int)__hip_atomic_load(F.ctl + CW_CNT + F.tid, RLX_AGENT); CS[F.tid] = c > CAP ? CAP : c; }
    __syncthreads();
    if (F.tid == 0) { int off = 0; for (int e = 0; e < 32; ++e) { OFF[e] = off; off += ((CS[e] + 255) >> 8) << 8; } OFF[32] = off; }
    __syncthreads();
    const int ntiles = OFF[32] >> 8;
    for (int t = F.tid; t < ntiles; t += 512) { int e = 0; while (e < 31 && OFF[e + 1] <= t * 256) ++e; TE[t] = (unsigned char)e; }
    __syncthreads();
    return ntiles;
}
__device__ __forceinline__ void p8_combine(Frame& F) {
    const bf16* X1 = WSP(bf16, WS_X1); const unsigned char* YBF = WSP(unsigned char, WS_YBUF); bf16* X2B = WSP(bf16, WS_X2B); float* R2 = WSP(float, WS_RSTD2); float* RSS = WSP(float, WS_ROWSS);
    const int gw = F.vcu * 8 + F.wave, NGW = F.G * 8, lane = F.lane;
    for (int t = gw; t < M; t += NGW) {
        const u32x2* xr = (const u32x2*)(X1 + (size_t)t * D) + lane; f32x4 v[4]; float s = 0.f; u32x2 xw[4];
#pragma unroll
        for (int j = 0; j < 4; ++j) xw[j] = xr[64 * j];
        unsigned yw[4][4];
#pragma unroll
        for (int k = 0; k < 4; ++k) { const unsigned* yr = (const unsigned*)(YBF + (size_t)(4 * t + k) * D) + lane;
#pragma unroll
            for (int j = 0; j < 4; ++j) yw[k][j] = yr[64 * j]; }
#pragma unroll
        for (int j = 0; j < 4; ++j) v[j] = (f32x4){bflo(xw[j].x), bfhi(xw[j].x), bflo(xw[j].y), bfhi(xw[j].y)};
#pragma unroll
        for (int k = 0; k < 4; ++k)
#pragma unroll
            for (int j = 0; j < 4; ++j) { const f32x2 lo = __builtin_amdgcn_cvt_pk_f32_fp8((int)yw[k][j], false), hi = __builtin_amdgcn_cvt_pk_f32_fp8((int)yw[k][j], true);
                v[j].x += lo.x * (1.f / 32.f); v[j].y += lo.y * (1.f / 32.f); v[j].z += hi.x * (1.f / 32.f); v[j].w += hi.y * (1.f / 32.f); }
        u32x2* o = (u32x2*)(X2B + (size_t)t * D) + lane;
#pragma unroll
        for (int j = 0; j < 4; ++j) { s += (v[j].x * v[j].x + v[j].y * v[j].y) + (v[j].z * v[j].z + v[j].w * v[j].w); u32x2 w; w.x = pk2(v[j].x, v[j].y); w.y = pk2(v[j].z, v[j].w); o[64 * j] = w;
            (WSP(unsigned, WS_X2B8) + (size_t)t * (D / 4))[lane + 64 * j] = pk8(v[j].x, v[j].y, v[j].z, v[j].w); }
        s = wave_sum(s);
        if (lane == 0) { R2[t] = 1.0f / sqrtf(s * (1.f / D) + RMS_EPS); RSS[t] = 0.f; }
    }
}
constexpr int NPHASE = 11;
__global__ void __launch_bounds__(512, 2) mega_fwd(Args args) {
    extern __shared__ __attribute__((aligned(16))) unsigned char lds[];
    Frame F;
    F.lds = (LAS unsigned char*)lds;
    F.wave = __builtin_amdgcn_readfirstlane((int)threadIdx.x >> 6); F.lane = lane_now(); F.tid = F.wave * 64 + F.lane;
    F.G = gridDim.x; { const int bx = blockIdx.x; F.vcu = (F.G % 8 == 0) ? (bx % 8) * (F.G / 8) + bx / 8 : bx; }
    F.ws = args.ws; F.ctl = (unsigned*)(args.ws + WS_CTL); F.out = args.out;
    volatile LAS unsigned* MISC = (volatile LAS unsigned*)(F.lds + LDSCTL_OFF);
    if (F.tid < 64) MISC[F.tid] = 0u;
    __syncthreads();
    const int lo = args.ph_lo, hi = args.ph_hi;
    XcdBarrier bar; bar.bar = F.ctl + CW_BAR; bar.x = 0; bar.st = nullptr;
    if (hi - lo > 1) bar = xcd_barrier_post(F.ctl + CW_BAR, MISC + 8, F.tid);
#ifndef PH_MASK
#define PH_MASK 0xFFFF
#endif
#define IN(k) ((((PH_MASK) >> (k)) & 1) && lo <= (k) && (k) < hi)
#define STAMP(k) do { if (TS_PROBE >= 0 && blockIdx.x == 0 && F.tid == 0) ((unsigned long long*)(F.ctl + 2048))[k] = __builtin_amdgcn_s_memrealtime(); } while (0)
#define SEAM(k) do { if (IN(k) && IN((k) + 1)) xcd_barrier(bar, F.wave); F.lane = lane_now(); F.tid = F.wave * 64 + F.lane; STAMP((k) + 1); } while (0)
    LAS unsigned char* ring = F.lds;
    STAMP(0);

    if (IN(0)) { p0_prologue(args, F, F.G >= 256 ? 1 : 15, F.vcu * 8 + F.wave, F.G * 8); if (F.G < 256) expert_convert(args, F, F.vcu * 8 + F.wave, F.G * 8, 3); } SEAM(0);

    if (IN(1)) {
        constexpr unsigned ALLT = (1u << (INC / 256)) - 1u, F8T = (unsigned)(G1_F8_TILES) & ALLT, B16T = ALLT & ~F8T;
        if (B16T) { pg8::Gemm g{WSP(bf16, WS_XB), WSP(bf16, WS_WIN), M, INC, D, 0, nullptr, nullptr, nullptr}; pg8::MaskOrder S; S.init(M, B16T, F.G, (int)blockIdx.x);
            EpiG1 E{WSP(float, WS_RSTD0), WSP(bf16, WS_Q), WSP(bf16, WS_K), WSP(bf16, WS_VT), WSP(bf16, WS_ZR), WSP(bf16, WS_GT), 1.f, (const LAS float*)(F.lds + RING_BYTES + 8192)};
            pg8::gemm_phase<EpiG1, pg8::MaskOrder, false, false>(ring, g, S, E, F.wave); }
        if (F8T) { pg8::Gemm g{WSP(bf16, WS_XB8), WSP(bf16, WS_WIN8), M, INC, D, 0, nullptr, nullptr, nullptr}; pg8::MaskOrder S; S.init(M, F8T, F.G, (int)blockIdx.x);
            EpiG1 E{WSP(float, WS_RSTD0), WSP(bf16, WS_Q), WSP(bf16, WS_K), WSP(bf16, WS_VT), WSP(bf16, WS_ZR), WSP(bf16, WS_GT), 1.f / 64.f, (const LAS float*)(F.lds + RING_BYTES + 8192)};
            pg8::gemm_phase<EpiG1, pg8::MaskOrder, false, true>(ring, g, S, E, F.wave); }
        if (F.G >= 256 && blockIdx.x >= 128u) { build_small_weights(args, F, (int)(blockIdx.x - 128u) * 512 + F.tid, (F.G - 128) * 512); p0_prologue(args, F, 4, (int)(blockIdx.x - 128u) * 8 + F.wave, (F.G - 128) * 8); }
    } SEAM(1);

    if (IN(2)) {
        for (int c = blockIdx.x; c < 256; c += F.G) {
            const int x = c & 7, y = c >> 3; pg8::LoraOrder S; S.half = y & 1; S.pm = x + 8 * (y >> 1); S.nu = 3 + (F.G >> 30);
            build_alora(args, F, S.pm);
            asm volatile("s_waitcnt vmcnt(0)" ::: "memory"); __syncthreads();
            pg8::Gemm g{WSP(bf16, WS_ALORA), WSP(bf16, WS_WL), M, LORA_N, LORA_K + (F.G >> 30), 0, nullptr, nullptr, nullptr};
            EpiLora E{FIN(5), FIN(7), WSP(bf16, WS_DEC), WSP(bf16, WS_AA), WSP(bf16, WS_GG), (const LAS float*)(F.lds + RING_BYTES + 4096)};
            pg8::gemm_phase(ring, g, S, E, F.wave);
        }
    } SEAM(2);

    if (IN(3)) {
        for (int u = blockIdx.x; u < 256; u += F.G) {
#ifndef P3_ONLY
#define P3_ONLY 0
#endif
            if (u < 128) { if (P3_ONLY != 2 && P3_ONLY != 3 && P3_ONLY != 4) scan_unit_chunked(args, F, u); else { bf16* YB = WSP(bf16, WS_YB); const int b = u >> 3, h = u & 7; for (int i = F.tid; i < SEQ * 8; i += 512) { const int tk = i >> 3, c8 = (i & 7) * 8; *(u32x4*)(YB + ((size_t)b * SEQ + tk) * 512 + h * 64 + c8) = (u32x4){0u, 0u, 0u, 0u}; } } }
            else if (P3_ONLY == 1 || P3_ONLY == 4) { bf16* YAz = WSP(bf16, WS_YA); const int bh = u - 128, b = bh >> 3, h = bh & 7; for (int i = F.tid; i < SEQ * 8; i += 512) { const int tk = i >> 3, c8 = (i & 7) * 8; *(u32x4*)(YAz + ((size_t)b * SEQ + tk) * 512 + h * 64 + c8) = (u32x4){0u, 0u, 0u, 0u}; } }
            else { const int bh = u - 128; for (int i = 0; i < 8; ++i) attn_tile_l(F, bh, 8 * F.wave + i, i >= 1, i >= 2);
                   asm volatile("s_waitcnt lgkmcnt(0)" ::: "memory"); __syncthreads();
                   if (F.G >= 256 && P3_ONLY != 3 && P3_ONLY != 5) { p0_prologue(args, F, 2, bh * 8 + F.wave, 1024); expert_convert(args, F, bh * 8 + F.wave, 1024, 3); }
                    }
        }
    if (TS_PROBE >= 0 && blockIdx.x == 0 && F.tid == 0) ((unsigned long long*)(F.ctl + 2048))[20] = __builtin_amdgcn_s_memrealtime();
    } SEAM(3);

    if (IN(4)) {
        pg8::StaticOrder S; S.init(M, D, F.G, (int)blockIdx.x);
        { pg8::PairOrder S2; S2.S = S; pg8::Gemm g{WSP(bf16, WS_YA), WSP(bf16, WS_WA), M, D, AW, WS_WB - WS_WA, nullptr, nullptr, nullptr, WS_YB - WS_YA};
          EpiMerge2 E{WSP(bf16, WS_GT), WSP(bf16, WS_MERGED)}; pg8::gemm_phase(ring, g, S2, E, F.wave); }
    } SEAM(4);

    if (IN(5)) {
        pg8::Gemm g{WSP(bf16, WS_MERGED), WSP(bf16, WS_WO), M, D, D, 0, nullptr, nullptr, nullptr}; pg8::StaticOrder S; S.init(M, D, F.G, (int)blockIdx.x);
        EpiX1 E{WSP(bf16, WS_XB), WSP(bf16, WS_X1), FIN(18), WSP(unsigned char, WS_HN)};
        pg8::gemm_phase(ring, g, S, E, F.wave);
    } SEAM(5);

    if (IN(6)) { p5a_router(args, F); } SEAM(6);

    if (IN(7)) {
        const int ntiles = moe_tables(F);
        pg8::Gemm g{WSP(bf16, WS_HN), WSP(bf16, WS_W1), MAXROWS, F2, D, (size_t)F2 * D, WSP(int, WS_LIST), (const LAS int*)(F.lds + MOE_OFF) + 32, (const LAS int*)(F.lds + MOE_OFF)};
        pg8::MoeOrder S{ntiles, F2 / 256, F.G, (int)blockIdx.x, F.lds + MOE_TE};
        EpiSwiglu E{FIN(22), WSP(unsigned char, WS_ACT), WSP(int, WS_LIST), WSP(float, WS_LRS), (const LAS int*)(F.lds + MOE_OFF) + 32, (const LAS int*)(F.lds + MOE_OFF), (const LAS float*)(F.lds + RING_BYTES + 4096)};
        pg8::gemm_phase<EpiSwiglu, pg8::MoeOrder, true, true>(ring, g, S, E, F.wave);
    } SEAM(7);

    if (IN(8)) {
        const int ntiles = IN(7) ? (((const LAS int*)(F.lds + MOE_OFF))[64] >> 8) : moe_tables(F);
        pg8::Gemm g{WSP(bf16, WS_ACT), WSP(bf16, WS_W2), MAXROWS, D, FH, (size_t)D * FH, nullptr, nullptr, nullptr};
        pg8::MoeOrder S{ntiles, D / 256, F.G, (int)blockIdx.x, F.lds + MOE_TE};
        EpiY E{FIN(24), WSP(int, WS_LIST), WSP(float, WS_LGT), WSP(unsigned char, WS_YBUF), (const LAS int*)(F.lds + MOE_OFF) + 32, (const LAS int*)(F.lds + MOE_OFF), (const LAS float*)(F.lds + RING_BYTES + 4096)};
        pg8::gemm_phase<EpiY, pg8::MoeOrder, false, true>(ring, g, S, E, F.wave);
    } SEAM(8);

    if (IN(9)) { p8_combine(F); } SEAM(9);

    if (IN(10)) {
        pg8::StaticOrder S; S.init(M, D, F.G, (int)blockIdx.x);
        { pg8::Gemm g{WSP(bf16, WS_X2B8), WSP(bf16, WS_WG), M, D, D, 0, nullptr, nullptr, nullptr}; EpiGate E{WSP(float, WS_RSTD2), WSP(unsigned char, WS_PGT), (const LAS float*)(F.lds + RING_BYTES + 8192)}; pg8::gemm_phase<EpiGate, pg8::StaticOrder, false, true>(ring, g, S, E, F.wave); }
        { pg8::Gemm g{WSP(bf16, WS_PB), WSP(bf16, WS_WP), M, D, PLE, 0, nullptr, nullptr, nullptr}; EpiPle E{(const LAS float*)(F.lds + RING_BYTES + 4096), WSP(bf16, WS_X2B), WSP(unsigned char, WS_PGT), F.out, WSP(float, WS_ROWSS), F.ctl + CW_PCNT, FIN(28), F.ctl}; pg8::gemm_phase(ring, g, S, E, F.wave); }
    }
#undef IN
#undef SEAM
}

extern "C" void kernel_launch(void* const* d_in, const int* in_sizes, int n_in, void* d_out, int out_size, void* d_ws, size_t ws_size, hipStream_t stream) {
    static int grid = 0;
    if (grid == 0) {
        if (n_in != 29 || in_sizes[0] != M * D || out_size != M * D || ws_size < WS_END) {
            fprintf(stderr, "kernel_launch: unexpected shapes (n_in %d, in0 %d, out %d, ws %zu < %zu); nothing launched\n", n_in, n_in > 0 ? in_sizes[0] : -1, out_size, ws_size, (size_t)WS_END); grid = -1; return; }
        int dev = 0, cus = 0, per_cu = 0;
        if (hipGetDevice(&dev) != hipSuccess || hipDeviceGetAttribute(&cus, hipDeviceAttributeMultiprocessorCount, dev) != hipSuccess) { grid = -1; return; }
        if (hipFuncSetAttribute((const void*)mega_fwd, hipFuncAttributeMaxDynamicSharedMemorySize, LDS_BYTES) != hipSuccess) { fprintf(stderr, "kernel_launch: hipFuncSetAttribute failed\n"); grid = -1; return; }
        if (hipOccupancyMaxActiveBlocksPerMultiprocessor(&per_cu, (const void*)mega_fwd, 512, LDS_BYTES) != hipSuccess || per_cu < 1) { fprintf(stderr, "kernel_launch: occupancy query says %d blocks/CU\n", per_cu); }
        (void)hipGetLastError();
        grid = cus;
    }
    if (grid < 0) return;
    (void)hipMemsetAsync((char*)d_ws + WS_CTL, 0, CTL_ZERO_BYTES, stream);
    Args a{};
    for (int i = 0; i < 29; ++i) a.in[i] = (const float*)d_in[i];
    a.out = (float*)d_out; a.ws = (unsigned char*)d_ws;
#if MK_PER_PHASE
    for (int p = 0; p < NPHASE; ++p) { a.ph_lo = p; a.ph_hi = p + 1; hipLaunchKernelGGL(mega_fwd, dim3(grid), dim3(512), LDS_BYTES, stream, a); }
#else
    a.ph_lo = 0; a.ph_hi = NPHASE; hipLaunchKernelGGL(mega_fwd, dim3(grid), dim3(512), LDS_BYTES, stream, a);
#endif
}
```
